# Optimizing an MI355X kernel written in HIP

```python
import math
import jax, jax.numpy as jnp
from jax import lax
import numpy as np

D_MODEL = 1024
BATCH = 32
SEQ = 256
DEPTH = 2
DEC_BATCH = 8
DEC_SEQ = 2048
PAST_LEN = 256

GRID_W = 64
RWKV_HEAD = 64
N_RWKV = 4
D_RWKV = N_RWKV * RWKV_HEAD
LORA_W = 64
LORA_A = 64
GN_EPS = 64e-5
MLA_HEADS = 8
MLA_NOPE = 64
MLA_ROPE = 32
MLA_V = 64
D_MLA = MLA_HEADS * MLA_V
Q_RANK = 256
KV_RANK = 128
ROPE_BASE = 10000.0
ROPE_PAIRS_AXIS = MLA_ROPE // 4
SOFTMAX_SCALE = (MLA_NOPE + MLA_ROPE) ** -0.5
Q_BLOCK = 128
LRU_BLOCKS = 4
LRU_BLOCK = 64
D_LRU = LRU_BLOCKS * LRU_BLOCK
CONV_W = 4
CONV_LEFT = 2
LRU_C = 8.0
IN_SIZES = (D_RWKV, D_RWKV, D_RWKV, D_RWKV, Q_RANK, KV_RANK, MLA_ROPE, D_MLA, D_LRU, D_LRU)
D_IN = sum(IN_SIZES)
D_MIX = D_RWKV + D_MLA + D_LRU
ALPHA = (2 * DEPTH) ** 0.25
OUT_INIT = (8 * DEPTH) ** -0.25
LN_EPS = 1e-5

kernel_name = "hybrid_rwkv7_mla_rglru_diffusion_step"


def layer_norm(x, g=None, b=None):
    xf = x.astype(jnp.float32)
    mu = jnp.mean(xf, -1, keepdims=True)
    var = jnp.mean(jnp.square(xf - mu), -1, keepdims=True)
    y = (xf - mu) * lax.rsqrt(var + LN_EPS)
    if g is not None:
        y = y * g.astype(jnp.float32) + b.astype(jnp.float32)
    return y.astype(x.dtype)


def rms_norm(x, g):
    xf = x.astype(jnp.float32)
    y = xf * lax.rsqrt(jnp.mean(xf * xf, -1, keepdims=True) + 1e-6) * g.astype(jnp.float32)
    return y.astype(x.dtype)


def adaln(cvec, w, b):
    m = jax.nn.silu(cvec) @ w + b
    return jnp.split(m[:, None, :], 3, axis=-1)


def split_in(h):
    idx = [int(v) for v in np.cumsum(IN_SIZES)[:-1]]
    return jnp.split(h, idx, axis=-1)


def axial_rope_tables(L):
    rows = L // GRID_W
    row = jnp.repeat(jnp.arange(rows), GRID_W).astype(jnp.float32)
    col = jnp.tile(jnp.arange(GRID_W), rows).astype(jnp.float32)
    inv = ROPE_BASE ** (-jnp.arange(ROPE_PAIRS_AXIS, dtype=jnp.float32) / ROPE_PAIRS_AXIS)
    ang = jnp.concatenate([row[:, None] * inv, col[:, None] * inv], axis=-1)
    return jnp.cos(ang), jnp.sin(ang)


def apply_rope(x, cos, sin):
    xp = x.astype(jnp.float32).reshape(x.shape[:-1] + (MLA_ROPE // 2, 2))
    x1, x2 = xp[..., 0], xp[..., 1]
    y = jnp.stack([x1 * cos - x2 * sin, x1 * sin + x2 * cos], axis=-1)
    return y.reshape(x.shape).astype(x.dtype)


def rwkv_step(S, inp):
    r_t, w_t, k_t, v_t, kk_t, a_t = inp
    sa = jnp.einsum('ebhvk,ebhk->ebhv', S, -kk_t)
    S = (S * w_t[..., None, :] + sa[..., :, None] * (kk_t * a_t)[..., None, :]
         + v_t[..., :, None] * k_t[..., None, :])
    return S, jnp.einsum('ebhvk,ebhk->ebhv', S, r_t)


def bidir(t):
    return jnp.stack([t, jnp.flip(t, 1)])


def flip_second(t):
    return jnp.stack([t[0], jnp.flip(t[1], 1)])


def rwkv_branch(u, r, k, v, g, S0, l, P):
    B, L, _ = r.shape
    f32 = jnp.float32
    heads = lambda t: t.reshape(t.shape[:-1] + (N_RWKV, RWKV_HEAD))
    wl = P['rw_w0'][l][:, None, None, :] + jnp.einsum(
        'eblr,erc->eblc', jnp.tanh(jnp.einsum('bld,edr->eblr', u, P['rw_w1'][l])), P['rw_w2'][l])
    decay = jnp.exp(-jnp.exp(-jax.nn.softplus(-wl.astype(f32)) - 0.5))
    a = jax.nn.sigmoid((P['rw_a0'][l][:, None, None, :] + jnp.einsum(
        'eblr,erc->eblc', jnp.einsum('bld,edr->eblr', u, P['rw_a1'][l]), P['rw_a2'][l])).astype(f32))
    rf, kf, vf = r.astype(f32), k.astype(f32), v.astype(f32)
    kk = heads(kf * P['rw_kk'][l])
    kk = kk / jnp.maximum(jnp.sqrt(jnp.sum(kk * kk, -1, keepdims=True)), 1e-12)
    k_dir = kf[None] * (1.0 + (a - 1.0) * P['rw_ka'][l])
    seq = (bidir(heads(rf)), flip_second(heads(decay)), flip_second(heads(k_dir)),
           bidir(heads(vf)), bidir(kk), flip_second(heads(a)))
    seq = tuple(jnp.moveaxis(t, 2, 0) for t in seq)
    S_fin, ys = lax.scan(rwkv_step, S0.astype(f32), seq)
    ys = jnp.moveaxis(ys, 0, 2)
    y = ys[0] + jnp.flip(ys[1], 1)
    mu = jnp.mean(y, -1, keepdims=True)
    var = jnp.mean(jnp.square(y - mu), -1, keepdims=True)
    yn = (y - mu) * lax.rsqrt(var + GN_EPS)
    bonus = jnp.sum(heads(rf) * heads(kf) * P['rw_rk'][l], -1, keepdims=True) * heads(vf)
    yn = yn.reshape(B, L, D_RWKV) * P['rw_lnx_g'][l] + P['rw_lnx_b'][l]
    y = (yn + bonus.reshape(B, L, D_RWKV)) * jax.nn.silu(g.astype(f32))
    return y.astype(u.dtype), S_fin


def mla_queries(cq, l, P):
    B, L, _ = cq.shape
    q = (rms_norm(cq, P['mla_qnorm'][l]) @ P['mla_wuq'][l]).reshape(B, L, MLA_HEADS, MLA_NOPE + MLA_ROPE)
    return q[..., :MLA_NOPE], q[..., MLA_NOPE:]


def mla_keyvals(ckv_n, l, P):
    B, L, _ = ckv_n.shape
    kv = (ckv_n @ P['mla_wukv'][l]).reshape(B, L, MLA_HEADS, MLA_NOPE + MLA_V)
    return kv[..., :MLA_NOPE], kv[..., MLA_NOPE:]


def block_attention(qn, qr, kn, kr, v):
    B, Lq = qn.shape[:2]
    nb = Lq // Q_BLOCK

    def one_block(args):
        qn_b, qr_b = args
        s = (jnp.einsum('bqhd,bkhd->bhqk', qn_b, kn)
             + jnp.einsum('bqhr,bkr->bhqk', qr_b, kr)).astype(jnp.float32) * SOFTMAX_SCALE
        p = jax.nn.softmax(s, axis=-1).astype(v.dtype)
        return jnp.einsum('bhqk,bkhd->bqhd', p, v)

    to_blocks = lambda t: jnp.moveaxis(t.reshape((B, nb, Q_BLOCK) + t.shape[2:]), 1, 0)
    out = lax.map(one_block, (to_blocks(qn), to_blocks(qr)))
    return jnp.moveaxis(out, 0, 1).reshape(B, Lq, MLA_HEADS * MLA_V)


def centred_conv(x, w, b):
    L = x.shape[1]
    xp = jnp.pad(x, ((0, 0), (CONV_LEFT, CONV_W - 1 - CONV_LEFT), (0, 0)))
    y = b
    for j in range(CONV_W):
        y = y + xp[:, j:j + L] * w[j]
    return y


def lin_combine(p, q):
    a1, b1 = p
    a2, b2 = q
    return a1 * a2, a2 * b1 + b2


def lru_branch(xl, gl, h0, l, P):
    B, L, _ = xl.shape
    f32 = jnp.float32
    xc = centred_conv(xl, P['lru_conv_w'][l], P['lru_conv_b'][l])
    xblk = xc.reshape(B, L, LRU_BLOCKS, LRU_BLOCK)
    gr = jnp.einsum('blgi,egio->eblgo', xblk, P['lru_wa'][l]).reshape(2, B, L, D_LRU) + P['lru_ba'][l][:, None, None, :]
    gi = jnp.einsum('blgi,egio->eblgo', xblk, P['lru_wx'][l]).reshape(2, B, L, D_LRU) + P['lru_bx'][l][:, None, None, :]
    log_a = -LRU_C * jax.nn.sigmoid(gr.astype(f32)) * jax.nn.softplus(-P['lru_lambda'][l].astype(f32))[:, None, None, :]
    a = jnp.exp(log_a)
    bterm = jnp.sqrt(-jnp.expm1(2.0 * log_a)) * jax.nn.sigmoid(gi.astype(f32)) * xc.astype(f32)[None]
    a = flip_second(a)
    bterm = flip_second(bterm)
    bterm = bterm.at[:, :, 0].add(a[:, :, 0] * h0.astype(f32))
    _, h = lax.associative_scan(lin_combine, (a, bterm), axis=2)
    h_fin = h[:, :, -1]
    y = (h[0] + jnp.flip(h[1], 1)) * jax.nn.silu(gl.astype(f32))
    return y.astype(xl.dtype), h_fin


def trunk_layer(x, cvec, l, P, ctx=None):
    B, L, _ = x.shape
    shift, scale, gate = adaln(cvec, P['w_mod'][l], P['b_mod'][l])
    u = layer_norm(x) * (1.0 + scale) + shift
    r, k, v, g, cq, ckv, kr, gm, xl, gl = split_in(u @ P['w_in'][l])
    ckv_n = rms_norm(ckv, P['mla_kvnorm'][l])
    qn, qr = mla_queries(cq, l, P)
    kn, vv = mla_keyvals(ckv_n, l, P)
    if ctx is None:
        S0 = jnp.zeros((2, B, N_RWKV, RWKV_HEAD, RWKV_HEAD), jnp.float32)
        h0 = jnp.zeros((2, B, D_LRU), jnp.float32)
        kr_all = kr
    else:
        S_ctx, ckv_ctx, kr_ctx, h_ctx = ctx
        S0 = jnp.moveaxis(S_ctx, 1, 0)
        h0 = jnp.moveaxis(h_ctx, 1, 0)
        cos, sin = axial_rope_tables(L)
        qr = apply_rope(qr, cos[:, None, :], sin[:, None, :])
        kn_c, v_c = mla_keyvals(ckv_ctx.astype(x.dtype), l, P)
        kn = jnp.concatenate([kn_c, kn], axis=1)
        vv = jnp.concatenate([v_c, vv], axis=1)
        kr_all = jnp.concatenate([kr_ctx.astype(kr.dtype), apply_rope(kr, cos, sin)], axis=1)
    y_rw, S_fin = rwkv_branch(u, r, k, v, g, S0, l, P)
    y_mla = block_attention(qn, qr, kn, kr_all, vv) * jax.nn.silu(gm)
    y_lru, h_fin = lru_branch(xl, gl, h0, l, P)
    out = jnp.concatenate([y_rw, y_mla, y_lru], axis=-1) @ P['w_out'][l]
    x = layer_norm(ALPHA * x + gate * out, P['ln_g'][l], P['ln_b'][l])
    return x, (jnp.moveaxis(S_fin, 0, 1), ckv_n, kr, jnp.moveaxis(h_fin, 0, 1))


def setup_inputs(seed: int = 0) -> dict:
    key = jax.random.key(seed)
    ks = iter(jax.random.split(key, 48))
    D = D_MODEL

    def nrm(shape, s):
        return s * jax.random.normal(next(ks), shape, jnp.float32)

    a_c = jax.random.uniform(next(ks), (DEPTH, 2, D_LRU), jnp.float32, 0.9, 0.999)
    s_lam = a_c ** (1.0 / LRU_C)
    return {
        'x_prompt': nrm((BATCH, SEQ, D), 1.0),
        'x_sample': nrm((DEC_BATCH, DEC_SEQ, D), 1.0),
        'state_rwkv': nrm((DEC_BATCH, DEPTH, 2, N_RWKV, RWKV_HEAD, RWKV_HEAD), 0.1),
        'cache_mla_ckv': nrm((DEC_BATCH, DEPTH, PAST_LEN, KV_RANK), 1.0),
        'cache_mla_krope': nrm((DEC_BATCH, DEPTH, PAST_LEN, MLA_ROPE), 1.0),
        'state_lru': nrm((DEC_BATCH, DEPTH, 2, D_LRU), 0.5),
        'c': nrm((DEC_BATCH, D), 1.0),
        'c_ctx': nrm((D,), 1.0),
        'w_mod': nrm((DEPTH, D, 3 * D), 0.5 * D ** -0.5),
        'b_mod': nrm((DEPTH, 3 * D), 0.02),
        'w_in': nrm((DEPTH, D, D_IN), D ** -0.5),
        'rw_w0': jax.random.uniform(next(ks), (DEPTH, 2, D_RWKV), jnp.float32, -2.0, 2.0),
        'rw_w1': nrm((DEPTH, 2, D, LORA_W), D ** -0.5),
        'rw_w2': nrm((DEPTH, 2, LORA_W, D_RWKV), 0.1 * LORA_W ** -0.5),
        'rw_a0': nrm((DEPTH, 2, D_RWKV), 0.1),
        'rw_a1': nrm((DEPTH, 2, D, LORA_A), D ** -0.5),
        'rw_a2': nrm((DEPTH, 2, LORA_A, D_RWKV), 0.1 * LORA_A ** -0.5),
        'rw_kk': 0.85 + nrm((DEPTH, D_RWKV), 0.02),
        'rw_ka': 1.0 + nrm((DEPTH, D_RWKV), 0.02),
        'rw_rk': nrm((DEPTH, N_RWKV, RWKV_HEAD), 0.1),
        'rw_lnx_g': 1.0 + nrm((DEPTH, D_RWKV), 0.02),
        'rw_lnx_b': nrm((DEPTH, D_RWKV), 0.02),
        'mla_qnorm': 1.0 + nrm((DEPTH, Q_RANK), 0.02),
        'mla_wuq': nrm((DEPTH, Q_RANK, MLA_HEADS * (MLA_NOPE + MLA_ROPE)), Q_RANK ** -0.5),
        'mla_kvnorm': 1.0 + nrm((DEPTH, KV_RANK), 0.02),
        'mla_wukv': nrm((DEPTH, KV_RANK, MLA_HEADS * (MLA_NOPE + MLA_V)), KV_RANK ** -0.5),
        'lru_conv_w': nrm((DEPTH, CONV_W, D_LRU), CONV_W ** -0.5),
        'lru_conv_b': nrm((DEPTH, D_LRU), 0.02),
        'lru_wa': nrm((DEPTH, 2, LRU_BLOCKS, LRU_BLOCK, LRU_BLOCK), LRU_BLOCK ** -0.5),
        'lru_ba': nrm((DEPTH, 2, D_LRU), 0.02),
        'lru_wx': nrm((DEPTH, 2, LRU_BLOCKS, LRU_BLOCK, LRU_BLOCK), LRU_BLOCK ** -0.5),
        'lru_bx': nrm((DEPTH, 2, D_LRU), 0.02),
        'lru_lambda': jnp.log(s_lam) - jnp.log1p(-s_lam),
        'w_out': nrm((DEPTH, D_MIX, D), OUT_INIT * D_MIX ** -0.5),
        'ln_g': 1.0 + nrm((DEPTH, D), 0.02),
        'ln_b': nrm((DEPTH, D), 0.02),
    }


def reference(x_prompt, x_sample, state_rwkv, cache_mla_ckv, cache_mla_krope, state_lru, c,
              c_ctx, w_mod, b_mod, w_in, rw_w0, rw_w1, rw_w2, rw_a0, rw_a1, rw_a2, rw_kk, rw_ka,
              rw_rk, rw_lnx_g, rw_lnx_b, mla_qnorm, mla_wuq, mla_kvnorm, mla_wukv, lru_conv_w,
              lru_conv_b, lru_wa, lru_ba, lru_wx, lru_bx, lru_lambda, w_out, ln_g, ln_b):
    P = dict(w_mod=w_mod, b_mod=b_mod, w_in=w_in, rw_w0=rw_w0, rw_w1=rw_w1, rw_w2=rw_w2,
             rw_a0=rw_a0, rw_a1=rw_a1, rw_a2=rw_a2, rw_kk=rw_kk, rw_ka=rw_ka, rw_rk=rw_rk,
             rw_lnx_g=rw_lnx_g, rw_lnx_b=rw_lnx_b, mla_qnorm=mla_qnorm, mla_wuq=mla_wuq,
             mla_kvnorm=mla_kvnorm, mla_wukv=mla_wukv, lru_conv_w=lru_conv_w,
             lru_conv_b=lru_conv_b, lru_wa=lru_wa, lru_ba=lru_ba, lru_wx=lru_wx, lru_bx=lru_bx,
             lru_lambda=lru_lambda, w_out=w_out, ln_g=ln_g, ln_b=ln_b)
    xp = x_prompt
    rw_states, ckvs, krs, lru_states = [], [], [], []
    for l in range(DEPTH):
        xp, (S_l, ckv_l, kr_l, h_l) = trunk_layer(xp, c_ctx[None, :], l, P)
        rw_states.append(S_l)
        ckvs.append(ckv_l)
        krs.append(kr_l)
        lru_states.append(h_l)
    xs = x_sample
    for l in range(DEPTH):
        xs, _ = trunk_layer(xs, c, l, P, ctx=(state_rwkv[:, l], cache_mla_ckv[:, l],
                                              cache_mla_krope[:, l], state_lru[:, l]))
    new_state_rwkv = jnp.stack(rw_states, axis=1).astype(x_prompt.dtype)
    new_cache_mla_ckv = jnp.stack(ckvs, axis=1).astype(x_prompt.dtype)
    new_cache_mla_krope = jnp.stack(krs, axis=1).astype(x_prompt.dtype)
    new_state_lru = jnp.stack(lru_states, axis=1).astype(x_prompt.dtype)
    return (xp, xs, new_state_rwkv, new_cache_mla_ckv, new_cache_mla_krope, new_state_lru)
```

```cpp
#define MK_PER_PHASE 1
#include <hip/hip_runtime.h>
#include <cstdio>
#include <cstdint>

#define GAS __attribute__((address_space(1)))
#define LAS __attribute__((address_space(3)))
typedef unsigned short bf16;
typedef unsigned v4u __attribute__((ext_vector_type(4)));
typedef unsigned v2u __attribute__((ext_vector_type(2)));
typedef float f32x4 __attribute__((ext_vector_type(4)));
typedef short bf16x8 __attribute__((ext_vector_type(8)));

constexpr int D = 1024, T_CTX = 8192, T_LAT = 16384, T = 24576, L_CTX = 256, L_LAT = 2048, PAST = 256;
constexpr int NIN = 2816, G1W = 2304, G2W = 512;
constexpr int C_R = 0, C_K = 256, C_V = 512, C_G = 768, C_GM = 1024, C_XL = 1536, C_GL = 1792, C_LORA = 2048;
constexpr int LK_LAT = PAST + L_LAT;
constexpr int TK = T_CTX + 8 * LK_LAT;
constexpr int VT_LAT = 32 * 8 * 64 * 256;
constexpr float LN_EPS = 1e-5f, GN_EPS = 64e-5f;
constexpr float ALPHA = 1.4142135623730951f;
constexpr float QSCALE = 0.10206207261596575f * 1.4426950408889634f;
constexpr size_t O_Y = 0, O_RW = 25165824, O_CKV = 27262976, O_KR = 29360128, O_LRU = 29884416;
constexpr size_t MiB = 1u << 20;
constexpr size_t WS_CTL = 0, CTL_ZERO_BYTES = 1 * MiB;
constexpr size_t WS_MOD = 256 * 1024;
constexpr size_t WS_WUQ = 2 * MiB;
constexpr size_t WS_WUKV = 3 * MiB;
constexpr size_t WS_WIN = 4 * MiB;
constexpr size_t WS_WOUT = 16 * MiB;
constexpr size_t WS_G1 = 20 * MiB;
constexpr size_t WS_G2 = 128 * MiB;
constexpr size_t WS_Q = 152 * MiB;
constexpr size_t WS_U = 152 * MiB;
constexpr size_t WS_KN = 188 * MiB;
constexpr size_t WS_KR = 214 * MiB;
constexpr size_t WS_VT = 216 * MiB;
constexpr size_t WS_YMIX = 188 * MiB;
constexpr size_t WS_HF = 242 * MiB;
constexpr size_t WS_END = 254 * MiB;
constexpr int CW_BAR = 4096;
constexpr int CW_Q = 16384;

__device__ __forceinline__ float bf2f(unsigned b) { return __uint_as_float(b << 16); }
__device__ __forceinline__ float bflo(unsigned w) { return __uint_as_float(w << 16); }
__device__ __forceinline__ float bfhi(unsigned w) { return __uint_as_float(w & 0xffff0000u); }
__device__ __forceinline__ unsigned f2bf(float f) { unsigned u = __float_as_uint(f); return (u + 0x7fffu + ((u >> 16) & 1u)) >> 16; }
__device__ __forceinline__ unsigned pk2(float lo, float hi) { return f2bf(lo) | (f2bf(hi) << 16); }
__device__ __forceinline__ float sigmoidf_(float x) { return 1.f / (1.f + __expf(-x)); }
__device__ __forceinline__ float siluf_(float x) { return x / (1.f + __expf(-x)); }
__device__ __forceinline__ float wave_sum(float v) {
#pragma unroll
    for (int o = 1; o < 64; o <<= 1) v += __shfl_xor(v, o);
    return v;
}
#define XB_TMO      128
#define XB_XCNT(j)  (256  + 64 * (j))
#define XB_XSUB(j)  (1280 + 64 * (j))
#define XB_XGEN(j)  (2304 + 64 * (j))
#define XB_TOP      3328
#define XB_TOPGEN   3392
#define XCD_BAR_WORDS 3456
#define XB_SPIN_CAP (1u << 24)

__device__ __forceinline__ unsigned xb_ld(unsigned* p)              { return __hip_atomic_load(p, __ATOMIC_RELAXED, __HIP_MEMORY_SCOPE_AGENT); }
__device__ __forceinline__ unsigned xb_add(unsigned* p, unsigned v) { return __hip_atomic_fetch_add(p, v, __ATOMIC_RELAXED, __HIP_MEMORY_SCOPE_AGENT); }
__device__ __forceinline__ unsigned xb_xcc_id() { return (unsigned)__builtin_amdgcn_s_getreg((3 << 11) | 20) & 0xFu; }
#define XB_SPIN(cond, bar) do { unsigned _sp = 0; while (cond) { __builtin_amdgcn_s_sleep(1); \
    if ((++_sp & 255u) == 0u) { if (xb_ld(&(bar)[XB_TMO])) break; if (_sp > XB_SPIN_CAP) { atomicAdd(&(bar)[XB_TMO], 1u); break; } } } } while (0)

struct XcdBarrier {
    unsigned* bar; unsigned x;
    volatile LAS unsigned* st;
};

__device__ __forceinline__ XcdBarrier xcd_barrier_post(unsigned* bar, volatile LAS unsigned* st) {
    XcdBarrier b; b.bar = bar; b.x = xb_xcc_id(); b.st = st;
    if (threadIdx.x == 0) (void)xb_add(&bar[XB_XCNT(b.x)], 1u);
    return b;
}
__device__ __forceinline__ void xcd_barrier_complete(unsigned* bar, unsigned x, unsigned& nloc, unsigned& nx) {
    const unsigned G = gridDim.x * gridDim.y * gridDim.z;
    unsigned sum, cnt, mine, sp = 0u;
    for (;;) {
        sum = 0u; cnt = 0u; mine = 0u;
#pragma unroll
        for (unsigned j = 0; j < 16; ++j) { const unsigned c = xb_ld(&bar[XB_XCNT(j)]); sum += c; cnt += (c > 0u) ? 1u : 0u; mine = (j == x) ? c : mine; }
        if (sum == G) break;
        __builtin_amdgcn_s_sleep(1);
        if ((++sp & 255u) == 0u) { if (xb_ld(&bar[XB_TMO])) break; if (sp > XB_SPIN_CAP) { atomicAdd(&bar[XB_TMO], 1u); break; } }
    }
    nloc = mine > 0u ? mine : 1u; nx = cnt > 0u ? cnt : 1u;
}

__device__ __forceinline__ void xcd_barrier(const XcdBarrier& b) {
    asm volatile("s_waitcnt vmcnt(0)" ::: "memory");
    __syncthreads();
    if (threadIdx.x == 0) {
        unsigned* bar = b.bar;
        __builtin_amdgcn_s_waitcnt(0);
        unsigned nloc = b.st[0], nx = b.st[1];
        if (nloc == 0u) { xcd_barrier_complete(bar, b.x, nloc, nx); b.st[0] = nloc; b.st[1] = nx; }
        const unsigned old = xb_add(&bar[XB_XSUB(b.x)], 1u);
        const unsigned gen = old / nloc;
        if (old + 1u == (gen + 1u) * nloc) {
            __builtin_amdgcn_fence(__ATOMIC_RELEASE, "agent");
            asm volatile("s_waitcnt vmcnt(0)" ::: "memory");
            const unsigned og = xb_add(&bar[XB_TOP], 1u);
            const unsigned tg = og / nx;
            if (og + 1u == (tg + 1u) * nx) xb_add(&bar[XB_TOPGEN], 1u);
            else XB_SPIN(xb_ld(&bar[XB_TOPGEN]) == tg, bar);
            __builtin_amdgcn_fence(__ATOMIC_ACQUIRE, "agent");
            xb_add(&bar[XB_XGEN(b.x)], 1u);
            asm volatile("s_waitcnt vmcnt(0)" ::: "memory");
        } else {
            XB_SPIN(xb_ld(&bar[XB_XGEN(b.x)]) == gen, bar);
            __builtin_amdgcn_fence(__ATOMIC_ACQUIRE, "agent");
            asm volatile("s_waitcnt vmcnt(0)" ::: "memory");
        }
    }
    __syncthreads();
}
enum { I_XP = 0, I_XS, I_SRW, I_CCKV, I_CKR, I_SLRU, I_C, I_CCTX, I_WMOD, I_BMOD, I_WIN, I_W0, I_W1, I_W2, I_A0, I_A1, I_A2, I_KK, I_KA, I_RK,
       I_LNXG, I_LNXB, I_QNORM, I_WUQ, I_KVNORM, I_WUKV, I_CONVW, I_CONVB, I_WA, I_BA, I_WX, I_BX, I_LAMBDA, I_WOUT, I_LNG, I_LNB, N_IN };
struct Args { const float* in[N_IN]; float* out; unsigned char* ws; int ph_lo, ph_hi; };
constexpr int NTHREADS = 512;
constexpr int LDS_MISC = 139264;
constexpr int LDS_BYTES = 147456;

struct Tok { int n, b, t, L, lat, modrow, tok0, kidx; };
__device__ __forceinline__ Tok tok_of(int n) {
    Tok k; k.n = n;
    if (n < T_CTX) { k.lat = 0; k.b = n >> 8; k.t = n & 255; k.L = L_CTX; k.modrow = 0; k.tok0 = k.b * 256; k.kidx = n; }
    else { const int m = n - T_CTX; k.lat = 1; k.b = m >> 11; k.t = m & 2047; k.L = L_LAT; k.modrow = 1 + k.b; k.tok0 = T_CTX + k.b * 2048; k.kidx = T_CTX + k.b * LK_LAT + PAST + k.t; }
    return k;
}
__device__ __forceinline__ const float* xrow_src(const Args& a, int layer, int n) {
    if (layer == 0) return n < T_CTX ? a.in[I_XP] + (size_t)n * D : a.in[I_XS] + (size_t)(n - T_CTX) * D;
    return a.out + (size_t)n * D;
}
__device__ __forceinline__ float dot8(v4u a, v4u b, float acc) {
    acc = fmaf(bflo(a.x), bflo(b.x), acc); acc = fmaf(bfhi(a.x), bfhi(b.x), acc);
    acc = fmaf(bflo(a.y), bflo(b.y), acc); acc = fmaf(bfhi(a.y), bfhi(b.y), acc);
    acc = fmaf(bflo(a.z), bflo(b.z), acc); acc = fmaf(bfhi(a.z), bfhi(b.z), acc);
    acc = fmaf(bflo(a.w), bflo(b.w), acc); acc = fmaf(bfhi(a.w), bfhi(b.w), acc);
    return acc;
}

__device__ __forceinline__ void tr_item(const float* src, int ld, int col0, int k0, bf16* WT, int K, int row0, float scale, LAS float* scr, int lane) {
#pragma unroll 8
    for (int i = 0; i < 32; ++i) { const int kk = 2 * i + (lane >> 5); scr[kk * 33 + (lane & 31)] = src ? src[(size_t)(k0 + kk) * ld + col0 + (lane & 31)] * scale : 0.f; }
    asm volatile("s_waitcnt lgkmcnt(0)" ::: "memory");
    const int c = lane & 7;
#pragma unroll
    for (int j = 0; j < 4; ++j) { const int n = (lane >> 3) + 8 * j; const LAS float* s = scr + (8 * c) * 33 + n;
        v4u o; o.x = pk2(s[0 * 33], s[1 * 33]); o.y = pk2(s[2 * 33], s[3 * 33]); o.z = pk2(s[4 * 33], s[5 * 33]); o.w = pk2(s[6 * 33], s[7 * 33]);
        *(v4u*)(WT + (size_t)(row0 + n) * K + k0 + 8 * c) = o; }
    asm volatile("s_waitcnt lgkmcnt(0)" ::: "memory");
}
__device__ __forceinline__ void phase_p0(const Args& a, LAS unsigned char* lds) {
    const int tid = threadIdx.x, lane = tid & 63, wave = tid >> 6, G = gridDim.x;
    unsigned char* ws = a.ws;
    LAS float* scr = (LAS float*)(lds + wave * 8704);
    const int gw = blockIdx.x * 8 + wave, NGW = G * 8;
    constexpr int N_WIN = 2 * 16 * 88, N_WOUT = 2 * 16 * 32, N_WUQ = 2 * 4 * 24, N_WUKV = 2 * 2 * 32;
    for (int it = gw; it < N_WIN + N_WOUT + N_WUQ + N_WUKV; it += NGW) {
        int r = it;
        if (r < N_WIN) {
            const int l = r / (16 * 88), kb = (r / 88) % 16, nb = r % 88, j0 = nb * 32;
            const float* src; int ld, col0;
            const float* win = a.in[I_WIN] + (size_t)l * 1024 * 2464;
            if (j0 < 1024) { src = win; ld = 2464; col0 = j0; }
            else if (j0 < 1536) { src = win; ld = 2464; col0 = 1440 + (j0 - 1024); }
            else if (j0 < 1792) { src = win; ld = 2464; col0 = 1952 + (j0 - 1536); }
            else if (j0 < 2048) { src = win; ld = 2464; col0 = 2208 + (j0 - 1792); }
            else if (j0 < 2304) { const int q = (j0 - 2048) >> 6; src = (q < 2 ? a.in[I_W1] : a.in[I_A1]) + (size_t)(l * 2 + (q & 1)) * 1024 * 64; ld = 64; col0 = (j0 - 2048) & 63; }
            else if (j0 < 2560) { src = win; ld = 2464; col0 = 1024 + (j0 - 2304); }
            else if (j0 < 2688) { src = win; ld = 2464; col0 = 1280 + (j0 - 2560); }
            else if (j0 < 2720) { src = win; ld = 2464; col0 = 1408 + (j0 - 2688); }
            else { src = nullptr; ld = 0; col0 = 0; }
            tr_item(src, ld, col0, kb * 64, (bf16*)(ws + WS_WIN) + (size_t)l * NIN * 1024, 1024, j0, 1.f, scr, lane);
            continue;
        }
        r -= N_WIN;
        if (r < N_WOUT) { const int l = r / (16 * 32), kb = (r / 32) % 16, nb = r % 32;
            tr_item(a.in[I_WOUT] + (size_t)l * 1024 * 1024, 1024, nb * 32, kb * 64, (bf16*)(ws + WS_WOUT) + (size_t)l * 1024 * 1024, 1024, nb * 32, 1.f, scr, lane); continue; }
        r -= N_WOUT;
        if (r < N_WUQ) { const int l = r / (4 * 24), kb = (r / 24) % 4, nb = r % 24;
            tr_item(a.in[I_WUQ] + (size_t)l * 256 * 768, 768, nb * 32, kb * 64, (bf16*)(ws + WS_WUQ) + (size_t)l * 768 * 256, 256, nb * 32, QSCALE, scr, lane); continue; }
        r -= N_WUQ;
        { const int l = r / (2 * 32), kb = (r / 32) % 2, nb = r % 32;
            tr_item(a.in[I_WUKV] + (size_t)l * 128 * 1024, 1024, nb * 32, kb * 64, (bf16*)(ws + WS_WUKV) + (size_t)l * 1024 * 128, 128, nb * 32, 1.f, scr, lane); }
    }
    float* MOD = (float*)(ws + WS_MOD);
    for (int it = blockIdx.x; it < 2 * 6 * 32; it += G) {
        const int l = it / 192, nb = (it / 32) % 6, kq = it % 32, col = nb * 512 + tid;
        float acc[9];
#pragma unroll
        for (int j = 0; j < 9; ++j) acc[j] = 0.f;
        for (int kk = 0; kk < 32; ++kk) { const int k = kq * 32 + kk;
            const float w = a.in[I_WMOD][((size_t)l * 1024 + k) * 3072 + col];
#pragma unroll
            for (int j = 0; j < 9; ++j) { const float cj = (j == 0) ? a.in[I_CCTX][k] : a.in[I_C][(j - 1) * 1024 + k]; acc[j] = fmaf(siluf_(cj), w, acc[j]); } }
        const float bias = (kq == 0) ? a.in[I_BMOD][l * 3072 + col] : 0.f;
#pragma unroll
        for (int j = 0; j < 9; ++j) atomicAdd(&MOD[(l * 9 + j) * 3072 + col], acc[j] + bias);
    }
}

__device__ __forceinline__ void phase_a0(const Args& a, int layer) {
    const int tid = threadIdx.x, lane = tid & 63, wave = tid >> 6, G = gridDim.x;
    const float* MOD = (const float*)(a.ws + WS_MOD);
    bf16* U = (bf16*)(a.ws + WS_U);
    for (int n = blockIdx.x * 8 + wave; n < T; n += G * 8) {
        const Tok tk = tok_of(n);
        const float* xr = xrow_src(a, layer, n);
        f32x4 v[4]; float s = 0.f;
#pragma unroll
        for (int j = 0; j < 4; ++j) { v[j] = *(const f32x4*)(xr + lane * 4 + 256 * j); s += (v[j].x + v[j].y) + (v[j].z + v[j].w); }
        float mean = wave_sum(s) * (1.f / D), s2 = 0.f;
#pragma unroll
        for (int j = 0; j < 4; ++j) { v[j] = v[j] - mean; s2 += (v[j].x * v[j].x + v[j].y * v[j].y) + (v[j].z * v[j].z + v[j].w * v[j].w); }
        float rstd = rsqrtf(wave_sum(s2) * (1.f / D) + LN_EPS);
        if (layer == 1) {
            s = 0.f;
#pragma unroll
            for (int j = 0; j < 4; ++j) { const f32x4 g = *(const f32x4*)(a.in[I_LNG] + lane * 4 + 256 * j), b = *(const f32x4*)(a.in[I_LNB] + lane * 4 + 256 * j);
                v[j] = v[j] * rstd * g + b; *(f32x4*)(a.out + (size_t)n * D + lane * 4 + 256 * j) = v[j]; s += (v[j].x + v[j].y) + (v[j].z + v[j].w); }
            mean = wave_sum(s) * (1.f / D); s2 = 0.f;
#pragma unroll
            for (int j = 0; j < 4; ++j) { v[j] = v[j] - mean; s2 += (v[j].x * v[j].x + v[j].y * v[j].y) + (v[j].z * v[j].z + v[j].w * v[j].w); }
            rstd = rsqrtf(wave_sum(s2) * (1.f / D) + LN_EPS);
        }
        const float* m = MOD + (size_t)(layer * 9 + tk.modrow) * 3072;
#pragma unroll
        for (int j = 0; j < 4; ++j) { const int c = lane * 4 + 256 * j; const f32x4 sh = *(const f32x4*)(m + c), sc = *(const f32x4*)(m + 1024 + c);
            const f32x4 o = v[j] * rstd * (sc + 1.f) + sh;
            v2u p; p.x = pk2(o.x, o.y); p.y = pk2(o.z, o.w); *(v2u*)(U + (size_t)n * D + c) = p; }
    }
}
__device__ __forceinline__ void phase_final(const Args& a) {
    const int tid = threadIdx.x, lane = tid & 63, wave = tid >> 6, G = gridDim.x;
    for (int n = blockIdx.x * 8 + wave; n < T; n += G * 8) {
        float* xr = a.out + (size_t)n * D;
        f32x4 v[4]; float s = 0.f;
#pragma unroll
        for (int j = 0; j < 4; ++j) { v[j] = *(const f32x4*)(xr + lane * 4 + 256 * j); s += (v[j].x + v[j].y) + (v[j].z + v[j].w); }
        const float mean = wave_sum(s) * (1.f / D); float s2 = 0.f;
#pragma unroll
        for (int j = 0; j < 4; ++j) { v[j] = v[j] - mean; s2 += (v[j].x * v[j].x + v[j].y * v[j].y) + (v[j].z * v[j].z + v[j].w * v[j].w); }
        const float rstd = rsqrtf(wave_sum(s2) * (1.f / D) + LN_EPS);
#pragma unroll
        for (int j = 0; j < 4; ++j) { const f32x4 g = *(const f32x4*)(a.in[I_LNG] + 1024 + lane * 4 + 256 * j), b = *(const f32x4*)(a.in[I_LNB] + 1024 + lane * 4 + 256 * j);
            *(f32x4*)(xr + lane * 4 + 256 * j) = v[j] * rstd * g + b; }
    }
}

__device__ __forceinline__ void phase_a1_naive(const Args& a, int layer) {
    const bf16* U = (const bf16*)(a.ws + WS_U); const bf16* W = (const bf16*)(a.ws + WS_WIN) + (size_t)layer * NIN * 1024;
    bf16* G1 = (bf16*)(a.ws + WS_G1); bf16* G2 = (bf16*)(a.ws + WS_G2);
    const size_t total = (size_t)T * (NIN / 8), stride = (size_t)gridDim.x * NTHREADS;
    for (size_t idx = (size_t)blockIdx.x * NTHREADS + threadIdx.x; idx < total; idx += stride) {
        const int row = (int)(idx / (NIN / 8)), c0 = (int)(idx % (NIN / 8)) * 8;
        float acc[8];
#pragma unroll
        for (int c = 0; c < 8; ++c) acc[c] = 0.f;
        const v4u* ap = (const v4u*)(U + (size_t)row * 1024); const v4u* bp = (const v4u*)(W + (size_t)c0 * 1024);
        for (int kc = 0; kc < 128; ++kc) { const v4u av = ap[kc];
#pragma unroll
            for (int c = 0; c < 8; ++c) acc[c] = dot8(av, bp[c * 128 + kc], acc[c]); }
        v4u o; o.x = pk2(acc[0], acc[1]); o.y = pk2(acc[2], acc[3]); o.z = pk2(acc[4], acc[5]); o.w = pk2(acc[6], acc[7]);
        if (c0 < G1W) *(v4u*)(G1 + (size_t)row * G1W + c0) = o; else *(v4u*)(G2 + (size_t)row * G2W + (c0 - G1W)) = o;
    }
}
__device__ __forceinline__ void phase_c2_naive(const Args& a, int layer) {
    const bf16* Y = (const bf16*)(a.ws + WS_YMIX); const bf16* W = (const bf16*)(a.ws + WS_WOUT) + (size_t)layer * 1024 * 1024;
    const float* MOD = (const float*)(a.ws + WS_MOD);
    const size_t total = (size_t)T * 256, stride = (size_t)gridDim.x * NTHREADS;
    for (size_t idx = (size_t)blockIdx.x * NTHREADS + threadIdx.x; idx < total; idx += stride) {
        const int row = (int)(idx >> 8), c0 = (int)(idx & 255) * 4;
        float acc[4] = {0.f, 0.f, 0.f, 0.f};
        const v4u* ap = (const v4u*)(Y + (size_t)row * 1024); const v4u* bp = (const v4u*)(W + (size_t)c0 * 1024);
        for (int kc = 0; kc < 128; ++kc) { const v4u av = ap[kc];
#pragma unroll
            for (int c = 0; c < 4; ++c) acc[c] = dot8(av, bp[c * 128 + kc], acc[c]); }
        const Tok tk = tok_of(row);
        const f32x4 gate = *(const f32x4*)(MOD + (size_t)(layer * 9 + tk.modrow) * 3072 + 2048 + c0);
        const f32x4 x = *(const f32x4*)(xrow_src(a, layer, row) + c0);
        f32x4 z; z.x = ALPHA * x.x + gate.x * acc[0]; z.y = ALPHA * x.y + gate.y * acc[1]; z.z = ALPHA * x.z + gate.z * acc[2]; z.w = ALPHA * x.w + gate.w * acc[3];
        *(f32x4*)(a.out + (size_t)row * D + c0) = z;
    }
}

__device__ __forceinline__ void rope_angle(int t, int i, float& c, float& s) {
    const int row = t >> 6, col = t & 63; const int ii = i & 7;
    const float inv = exp2f(-(float)ii * (13.287712379549449f / 8.f));
    const float ang = (float)(i < 8 ? row : col) * inv;
    c = cosf(ang); s = sinf(ang);
}
__device__ __forceinline__ void phase_a2_naive(const Args& a, LAS unsigned char* lds, int layer) {
    const int tid = threadIdx.x, lane = tid & 63, wave = tid >> 6, G = gridDim.x;
    LAS float* AQ = (LAS float*)lds;
    LAS float* AKV = (LAS float*)(lds + 16384);
    LAS float* OT = (LAS float*)(lds + 24576);
    const bf16* G2 = (const bf16*)(a.ws + WS_G2);
    bf16* Q = (bf16*)(a.ws + WS_Q); bf16* KN = (bf16*)(a.ws + WS_KN); bf16* KR = (bf16*)(a.ws + WS_KR); bf16* VT = (bf16*)(a.ws + WS_VT);
    const bf16* WUQ = (const bf16*)(a.ws + WS_WUQ) + (size_t)layer * 768 * 256;
    const bf16* WUKV = (const bf16*)(a.ws + WS_WUKV) + (size_t)layer * 1024 * 128;
    constexpr int NT_TOK = T / 16, NT_CACHE = 8 * 256 / 16;
    for (int tile = blockIdx.x; tile < NT_TOK + NT_CACHE; tile += G) {
        const bool is_tok = tile < NT_TOK;
        for (int rr = 0; rr < 2; ++rr) {
            const int r = wave * 2 + rr;
            if (is_tok) {
                const int n = tile * 16 + r; const Tok tk = tok_of(n);
                const v2u cqv = *(const v2u*)(G2 + (size_t)n * G2W + lane * 4);
                const float c0 = bflo(cqv.x), c1 = bfhi(cqv.x), c2 = bflo(cqv.y), c3 = bfhi(cqv.y);
                const float rq = rsqrtf(wave_sum(c0 * c0 + c1 * c1 + c2 * c2 + c3 * c3) * (1.f / 256.f) + 1e-6f);
                const f32x4 qn = *(const f32x4*)(a.in[I_QNORM] + layer * 256 + lane * 4);
                AQ[r * 256 + lane * 4 + 0] = bf2f(f2bf(c0 * rq * qn.x)); AQ[r * 256 + lane * 4 + 1] = bf2f(f2bf(c1 * rq * qn.y));
                AQ[r * 256 + lane * 4 + 2] = bf2f(f2bf(c2 * rq * qn.z)); AQ[r * 256 + lane * 4 + 3] = bf2f(f2bf(c3 * rq * qn.w));
                float k0 = 0.f, k1 = 0.f, k2 = 0.f, k3 = 0.f;
                if (lane < 32) { const v2u kv = *(const v2u*)(G2 + (size_t)n * G2W + 256 + lane * 4); k0 = bflo(kv.x); k1 = bfhi(kv.x); k2 = bflo(kv.y); k3 = bfhi(kv.y); }
                const float rk = rsqrtf(wave_sum(k0 * k0 + k1 * k1 + k2 * k2 + k3 * k3) * (1.f / 128.f) + 1e-6f);
                if (lane < 32) {
                    const f32x4 kn = *(const f32x4*)(a.in[I_KVNORM] + layer * 128 + lane * 4);
                    f32x4 o; o.x = k0 * rk * kn.x; o.y = k1 * rk * kn.y; o.z = k2 * rk * kn.z; o.w = k3 * rk * kn.w;
                    if (!tk.lat) *(f32x4*)(a.out + O_CKV + ((size_t)(tk.b * 2 + layer) * 256 + tk.t) * 128 + lane * 4) = o;
                    AKV[r * 128 + lane * 4 + 0] = bf2f(f2bf(o.x)); AKV[r * 128 + lane * 4 + 1] = bf2f(f2bf(o.y));
                    AKV[r * 128 + lane * 4 + 2] = bf2f(f2bf(o.z)); AKV[r * 128 + lane * 4 + 3] = bf2f(f2bf(o.w));
                }
                float krv = (lane < 32) ? bf2f(G2[(size_t)n * G2W + 384 + lane]) : 0.f;
                const float other = __shfl_xor(krv, 1);
                if (lane < 32) {
                    if (!tk.lat) a.out[O_KR + ((size_t)(tk.b * 2 + layer) * 256 + tk.t) * 32 + lane] = krv;
                    else { float c, s; rope_angle(tk.t, lane >> 1, c, s); krv = (lane & 1) ? (other * s + krv * c) : (krv * c - other * s); }
                    KR[(size_t)tk.kidx * 32 + lane] = (bf16)f2bf(krv);
                }
            } else {
                const int cr = (tile - NT_TOK) * 16 + r, b = cr >> 8, j = cr & 255;
                const size_t src = ((size_t)(b * 2 + layer) * 256 + j);
                if (lane < 32) { const f32x4 v = *(const f32x4*)(a.in[I_CCKV] + src * 128 + lane * 4);
                    AKV[r * 128 + lane * 4 + 0] = bf2f(f2bf(v.x)); AKV[r * 128 + lane * 4 + 1] = bf2f(f2bf(v.y)); AKV[r * 128 + lane * 4 + 2] = bf2f(f2bf(v.z)); AKV[r * 128 + lane * 4 + 3] = bf2f(f2bf(v.w));
                    KR[(size_t)(T_CTX + b * LK_LAT + j) * 32 + lane] = (bf16)f2bf(a.in[I_CKR][src * 32 + lane]); }
            }
        }
        __syncthreads();
        if (is_tok) {
            for (int col = tid; col < 768; col += NTHREADS) {
                float acc[16];
#pragma unroll
                for (int r = 0; r < 16; ++r) acc[r] = 0.f;
                const v4u* wp = (const v4u*)(WUQ + (size_t)col * 256);
                for (int kc = 0; kc < 32; ++kc) { const v4u w = wp[kc];
                    const float w0 = bflo(w.x), w1 = bfhi(w.x), w2 = bflo(w.y), w3 = bfhi(w.y), w4 = bflo(w.z), w5 = bfhi(w.z), w6 = bflo(w.w), w7 = bfhi(w.w);
#pragma unroll
                    for (int r = 0; r < 16; ++r) { const f32x4 x0 = *(const LAS f32x4*)(AQ + r * 256 + kc * 8), x1 = *(const LAS f32x4*)(AQ + r * 256 + kc * 8 + 4);
                        acc[r] += x0.x * w0 + x0.y * w1 + x0.z * w2 + x0.w * w3 + x1.x * w4 + x1.y * w5 + x1.z * w6 + x1.w * w7; } }
#pragma unroll
                for (int r = 0; r < 16; ++r) OT[r * 1024 + col] = acc[r];
            }
            __syncthreads();
            for (int idx = tid; idx < 16 * 384; idx += NTHREADS) {
                const int r = idx / 384, col = (idx % 384) * 2, d = col % 96; const int n = tile * 16 + r; const Tok tk = tok_of(n);
                float v0 = OT[r * 1024 + col], v1 = OT[r * 1024 + col + 1];
                if (tk.lat && d >= 64) { float c, s; rope_angle(tk.t, (d - 64) >> 1, c, s); const float y0 = v0 * c - v1 * s, y1 = v0 * s + v1 * c; v0 = y0; v1 = y1; }
                *(unsigned*)(Q + (size_t)n * 768 + col) = pk2(v0, v1);
            }
            __syncthreads();
        }
        for (int col = tid; col < 1024; col += NTHREADS) {
            float acc[16];
#pragma unroll
            for (int r = 0; r < 16; ++r) acc[r] = 0.f;
            const v4u* wp = (const v4u*)(WUKV + (size_t)col * 128);
            for (int kc = 0; kc < 16; ++kc) { const v4u w = wp[kc];
                const float w0 = bflo(w.x), w1 = bfhi(w.x), w2 = bflo(w.y), w3 = bfhi(w.y), w4 = bflo(w.z), w5 = bfhi(w.z), w6 = bflo(w.w), w7 = bfhi(w.w);
#pragma unroll
                for (int r = 0; r < 16; ++r) { const f32x4 x0 = *(const LAS f32x4*)(AKV + r * 128 + kc * 8), x1 = *(const LAS f32x4*)(AKV + r * 128 + kc * 8 + 4);
                    acc[r] += x0.x * w0 + x0.y * w1 + x0.z * w2 + x0.w * w3 + x1.x * w4 + x1.y * w5 + x1.z * w6 + x1.w * w7; } }
#pragma unroll
            for (int r = 0; r < 16; ++r) OT[r * 1024 + col] = acc[r];
        }
        __syncthreads();
        for (int idx = tid; idx < 16 * 1024; idx += NTHREADS) {
            const int r = idx >> 10, col = idx & 1023, h = col >> 7, f = col & 127;
            int kidx, lat, b, kpos;
            if (is_tok) { const Tok tk = tok_of(tile * 16 + r); kidx = tk.kidx; lat = tk.lat; b = tk.b; kpos = tk.lat ? PAST + tk.t : tk.t; }
            else { const int cr = (tile - NT_TOK) * 16 + r; b = cr >> 8; kpos = cr & 255; lat = 1; kidx = T_CTX + b * LK_LAT + kpos; }
            const bf16 v = (bf16)f2bf(OT[r * 1024 + col]);
            if (f < 64) KN[(size_t)kidx * 512 + h * 64 + f] = v;
            else { const int dv = f - 64; const size_t base = lat ? (size_t)VT_LAT + ((size_t)(b * 8 + h) * 64 + dv) * LK_LAT : ((size_t)(b * 8 + h) * 64 + dv) * 256; VT[base + kpos] = v; }
        }
        __syncthreads();
    }
}

__device__ __forceinline__ void phase_att_naive(const Args& a) {
    const bf16* KN = (const bf16*)(a.ws + WS_KN); const bf16* KR = (const bf16*)(a.ws + WS_KR); const bf16* VT = (const bf16*)(a.ws + WS_VT);
    bf16* Q = (bf16*)(a.ws + WS_Q); const bf16* G1 = (const bf16*)(a.ws + WS_G1);
    const int total = T * 8, stride = gridDim.x * NTHREADS;
    for (int idx = blockIdx.x * NTHREADS + threadIdx.x; idx < total; idx += stride) {
        int n, h, Lk, kidx0; size_t vbase;
        if (idx < T_CTX * 8) { const int b = idx >> 11, hh = (idx >> 8) & 7, t = idx & 255; n = b * 256 + t; h = hh; Lk = 256; kidx0 = b * 256; vbase = ((size_t)(b * 8 + h) * 64) * 256; }
        else { const int m = idx - T_CTX * 8, b = m >> 14, hh = (m >> 11) & 7, t = m & 2047; n = T_CTX + b * 2048 + t; h = hh; Lk = LK_LAT; kidx0 = T_CTX + b * LK_LAT; vbase = (size_t)VT_LAT + ((size_t)(b * 8 + h) * 64) * LK_LAT; }
        v4u qp[12];
#pragma unroll
        for (int c = 0; c < 12; ++c) qp[c] = *(const v4u*)(Q + (size_t)n * 768 + h * 96 + c * 8);
        float acc[64];
#pragma unroll
        for (int d = 0; d < 64; ++d) acc[d] = 0.f;
        float m = -1e30f, l = 0.f;
        for (int j0 = 0; j0 < Lk; j0 += 8) {
            float s[8];
#pragma unroll
            for (int j = 0; j < 8; ++j) {
                const v4u* kp = (const v4u*)(KN + (size_t)(kidx0 + j0 + j) * 512 + h * 64); const v4u* rp = (const v4u*)(KR + (size_t)(kidx0 + j0 + j) * 32);
                float sv = 0.f;
#pragma unroll
                for (int c = 0; c < 8; ++c) sv = dot8(qp[c], kp[c], sv);
#pragma unroll
                for (int c = 0; c < 4; ++c) sv = dot8(qp[8 + c], rp[c], sv);
                s[j] = sv;
                __builtin_amdgcn_sched_barrier(0);
            }
            float mx = m;
#pragma unroll
            for (int j = 0; j < 8; ++j) mx = fmaxf(mx, s[j]);
            const float alpha = exp2f(m - mx); m = mx; float ps = 0.f;
#pragma unroll
            for (int j = 0; j < 8; ++j) { s[j] = exp2f(s[j] - mx); ps += s[j]; }
            l = l * alpha + ps;
            unsigned lk = (unsigned)Lk; asm volatile("" : "+v"(lk));
            const bf16* vp = VT + vbase + j0;
#pragma unroll
            for (int dg = 0; dg < 8; ++dg) {
#pragma unroll
                for (int dd = 0; dd < 8; ++dd) { const int d = dg * 8 + dd; const v4u w = *(const v4u*)(vp + (unsigned)d * lk);
                    acc[d] = acc[d] * alpha + s[0] * bflo(w.x) + s[1] * bfhi(w.x) + s[2] * bflo(w.y) + s[3] * bfhi(w.y) + s[4] * bflo(w.z) + s[5] * bfhi(w.z) + s[6] * bflo(w.w) + s[7] * bfhi(w.w); }
                __builtin_amdgcn_sched_barrier(0);
            }
        }
        const float inv = 1.f / l;
#pragma unroll
        for (int c = 0; c < 8; ++c) { const v4u g = *(const v4u*)(G1 + (size_t)n * G1W + C_GM + h * 64 + c * 8);
            v4u o;
            o.x = pk2(acc[c * 8 + 0] * inv * siluf_(bflo(g.x)), acc[c * 8 + 1] * inv * siluf_(bfhi(g.x)));
            o.y = pk2(acc[c * 8 + 2] * inv * siluf_(bflo(g.y)), acc[c * 8 + 3] * inv * siluf_(bfhi(g.y)));
            o.z = pk2(acc[c * 8 + 4] * inv * siluf_(bflo(g.z)), acc[c * 8 + 5] * inv * siluf_(bfhi(g.z)));
            o.w = pk2(acc[c * 8 + 6] * inv * siluf_(bflo(g.w)), acc[c * 8 + 7] * inv * siluf_(bfhi(g.w)));
            *(v4u*)(Q + (size_t)n * 768 + h * 96 + c * 8) = o; }
    }
}
__device__ __forceinline__ void rwkv_unit_seq(const Args& a, LAS unsigned char* lds, int layer, int u) {
    const int tid = threadIdx.x;
    LAS float* W2s = (LAS float*)lds;
    LAS float* A2s = W2s + 4096;
    LAS float* TH = A2s + 4096;
    LAS float* HA = TH + 2048;
    LAS float* Wd = HA + 2048;
    LAS float* KT = Wd + 2048; LAS float* KK = KT + 2048; LAS float* BB = KK + 2048; LAS float* RR = BB + 2048; LAS float* VV = RR + 2048; LAS float* YO = VV + 2048;
    const int lat = u < 64, uu = lat ? u : u - 64, b = uu >> 3, e = (uu >> 2) & 1, hh = uu & 3;
    const int L = lat ? L_LAT : L_CTX, tok0 = lat ? T_CTX + b * L_LAT : b * L_CTX;
    const bf16* G1 = (const bf16*)(a.ws + WS_G1);
    bf16* YS = (bf16*)(a.ws + WS_G2);
    for (int i = tid; i < 4096; i += NTHREADS) { const int j = i >> 6, c = i & 63;
        W2s[i] = a.in[I_W2][((size_t)(layer * 2 + e) * 64 + j) * 256 + hh * 64 + c];
        A2s[i] = a.in[I_A2][((size_t)(layer * 2 + e) * 64 + j) * 256 + hh * 64 + c]; }
    const int r = tid >> 3, ks = tid & 7;
    float S[8];
#pragma unroll
    for (int j = 0; j < 8; ++j) S[j] = lat ? a.in[I_SRW][(((size_t)((b * 2 + layer) * 2 + e) * 4 + hh) * 64 + r) * 64 + ks * 8 + j] : 0.f;
    const int tt = tid >> 4, q4 = (tid & 15) * 4;
    float w0v[4], a0v[4], kkw[4], kav[4];
#pragma unroll
    for (int i = 0; i < 4; ++i) { const int ch = hh * 64 + q4 + i;
        w0v[i] = a.in[I_W0][(layer * 2 + e) * 256 + ch]; a0v[i] = a.in[I_A0][(layer * 2 + e) * 256 + ch]; kkw[i] = a.in[I_KK][layer * 256 + ch]; kav[i] = a.in[I_KA][layer * 256 + ch]; }
    __syncthreads();
    for (int c = 0; c < L / 32; ++c) {
        const int step = c * 32 + tt, t = e ? L - 1 - step : step, n = tok0 + t;
        const bf16* g = G1 + (size_t)n * G1W;
        { const v2u hw = *(const v2u*)(g + C_LORA + e * 64 + q4), ha = *(const v2u*)(g + C_LORA + 128 + e * 64 + q4);
          TH[tt * 64 + q4 + 0] = tanhf(bflo(hw.x)); TH[tt * 64 + q4 + 1] = tanhf(bfhi(hw.x)); TH[tt * 64 + q4 + 2] = tanhf(bflo(hw.y)); TH[tt * 64 + q4 + 3] = tanhf(bfhi(hw.y));
          HA[tt * 64 + q4 + 0] = bflo(ha.x); HA[tt * 64 + q4 + 1] = bfhi(ha.x); HA[tt * 64 + q4 + 2] = bflo(ha.y); HA[tt * 64 + q4 + 3] = bfhi(ha.y); }
        __syncthreads();
        {
            float wl[4], al[4];
#pragma unroll
            for (int i = 0; i < 4; ++i) { wl[i] = w0v[i]; al[i] = a0v[i]; }
            for (int j = 0; j < 64; ++j) { const float th = TH[tt * 64 + j], hv = HA[tt * 64 + j];
                const f32x4 w2 = *(const LAS f32x4*)(W2s + j * 64 + q4), a2 = *(const LAS f32x4*)(A2s + j * 64 + q4);
                wl[0] = fmaf(th, w2.x, wl[0]); wl[1] = fmaf(th, w2.y, wl[1]); wl[2] = fmaf(th, w2.z, wl[2]); wl[3] = fmaf(th, w2.w, wl[3]);
                al[0] = fmaf(hv, a2.x, al[0]); al[1] = fmaf(hv, a2.y, al[1]); al[2] = fmaf(hv, a2.z, al[2]); al[3] = fmaf(hv, a2.w, al[3]); }
            const v2u kv = *(const v2u*)(g + C_K + hh * 64 + q4), rv = *(const v2u*)(g + C_R + hh * 64 + q4), vv = *(const v2u*)(g + C_V + hh * 64 + q4);
            const float kx[4] = {bflo(kv.x), bfhi(kv.x), bflo(kv.y), bfhi(kv.y)}, rx[4] = {bflo(rv.x), bfhi(rv.x), bflo(rv.y), bfhi(rv.y)}, vx[4] = {bflo(vv.x), bfhi(vv.x), bflo(vv.y), bfhi(vv.y)};
            float kkr[4], ss = 0.f;
#pragma unroll
            for (int i = 0; i < 4; ++i) { kkr[i] = kx[i] * kkw[i]; ss += kkr[i] * kkr[i]; }
            ss += __shfl_xor(ss, 1); ss += __shfl_xor(ss, 2); ss += __shfl_xor(ss, 4); ss += __shfl_xor(ss, 8);
            const float inrm = 1.f / fmaxf(sqrtf(ss), 1e-12f);
#pragma unroll
            for (int i = 0; i < 4; ++i) {
                const float dec = __expf(-0.6065306597126334f * sigmoidf_(wl[i])), av = sigmoidf_(al[i]), kk = kkr[i] * inrm;
                const int o = tt * 64 + q4 + i;
                Wd[o] = dec; KT[o] = kx[i] * (1.f + (av - 1.f) * kav[i]); KK[o] = kk; BB[o] = kk * av; RR[o] = rx[i]; VV[o] = vx[i]; }
        }
        __syncthreads();
        for (int s = 0; s < 32; ++s) {
            const int o = s * 64 + ks * 8;
            const f32x4 k0 = *(const LAS f32x4*)(KK + o), k1 = *(const LAS f32x4*)(KK + o + 4);
            float p = S[0] * k0.x + S[1] * k0.y + S[2] * k0.z + S[3] * k0.w + S[4] * k1.x + S[5] * k1.y + S[6] * k1.z + S[7] * k1.w;
            p += __shfl_xor(p, 1); p += __shfl_xor(p, 2); p += __shfl_xor(p, 4);
            const float sa = -p, vv = VV[s * 64 + r];
            const f32x4 w0 = *(const LAS f32x4*)(Wd + o), w1 = *(const LAS f32x4*)(Wd + o + 4), b0 = *(const LAS f32x4*)(BB + o), b1 = *(const LAS f32x4*)(BB + o + 4);
            const f32x4 t0 = *(const LAS f32x4*)(KT + o), t1 = *(const LAS f32x4*)(KT + o + 4), r0 = *(const LAS f32x4*)(RR + o), r1 = *(const LAS f32x4*)(RR + o + 4);
            S[0] = S[0] * w0.x + sa * b0.x + vv * t0.x; S[1] = S[1] * w0.y + sa * b0.y + vv * t0.y; S[2] = S[2] * w0.z + sa * b0.z + vv * t0.z; S[3] = S[3] * w0.w + sa * b0.w + vv * t0.w;
            S[4] = S[4] * w1.x + sa * b1.x + vv * t1.x; S[5] = S[5] * w1.y + sa * b1.y + vv * t1.y; S[6] = S[6] * w1.z + sa * b1.z + vv * t1.z; S[7] = S[7] * w1.w + sa * b1.w + vv * t1.w;
            float y = S[0] * r0.x + S[1] * r0.y + S[2] * r0.z + S[3] * r0.w + S[4] * r1.x + S[5] * r1.y + S[6] * r1.z + S[7] * r1.w;
            y += __shfl_xor(y, 1); y += __shfl_xor(y, 2); y += __shfl_xor(y, 4);
            if (ks == 0) YO[s * 64 + r] = y;
        }
        __syncthreads();
        { v2u o; o.x = pk2(YO[tt * 64 + q4], YO[tt * 64 + q4 + 1]); o.y = pk2(YO[tt * 64 + q4 + 2], YO[tt * 64 + q4 + 3]);
          *(v2u*)(YS + ((size_t)e * T + n) * 256 + hh * 64 + q4) = o; }
        __syncthreads();
    }
    if (!lat) {
        float* dst = a.out + O_RW + (((size_t)((b * 2 + layer) * 2 + e) * 4 + hh) * 64 + r) * 64 + ks * 8;
        *(f32x4*)dst = (f32x4){S[0], S[1], S[2], S[3]}; *(f32x4*)(dst + 4) = (f32x4){S[4], S[5], S[6], S[7]};
    }
}

__device__ __forceinline__ void lru_unit_seq(const Args& a, LAS unsigned char* lds, int layer, int u) {
    const int tid = threadIdx.x;
    LAS float* WA = (LAS float*)lds;
    LAS float* WX = WA + 4096;
    LAS float* XC = WX + 4096;
    LAS float* AA = XC + 4096; LAS float* BV = AA + 4096; LAS float* HH = BV + 4096;
    const int lat = u < 32, uu = lat ? u : u - 32, b = uu >> 2, g = uu & 3;
    const int L = lat ? L_LAT : L_CTX, tok0 = lat ? T_CTX + b * L_LAT : b * L_CTX;
    const bf16* G1 = (const bf16*)(a.ws + WS_G1);
    bf16* HF = (bf16*)(a.ws + WS_HF);
    const int tt = tid >> 3, q8 = (tid & 7) * 8;
    float cw[4][8], cb[8];
#pragma unroll
    for (int i = 0; i < 8; ++i) { const int ch = g * 64 + q8 + i; cb[i] = a.in[I_CONVB][layer * 256 + ch];
#pragma unroll
        for (int j = 0; j < 4; ++j) cw[j][i] = a.in[I_CONVW][(layer * 4 + j) * 256 + ch]; }
    for (int e = 0; e < 2; ++e) {
        __syncthreads();
        for (int i = tid; i < 4096; i += NTHREADS) { const size_t src = ((size_t)((layer * 2 + e) * 4 + g)) * 4096 + i; WA[i] = a.in[I_WA][src]; WX[i] = a.in[I_WX][src]; }
        float bav[8], bxv[8], spl[8];
#pragma unroll
        for (int i = 0; i < 8; ++i) { const int ch = (layer * 2 + e) * 256 + g * 64 + q8 + i; bav[i] = a.in[I_BA][ch]; bxv[i] = a.in[I_BX][ch]; spl[i] = log1pf(__expf(-a.in[I_LAMBDA][ch])); }
        float h = 0.f;
        if (tid < 64 && lat) h = a.in[I_SLRU][((size_t)(b * 2 + layer) * 2 + e) * 256 + g * 64 + tid];
        __syncthreads();
        for (int cc = 0; cc < L / 64; ++cc) {
            const int c = e ? L / 64 - 1 - cc : cc, t = c * 64 + tt, n = tok0 + t;
            {
                float xc[8];
#pragma unroll
                for (int i = 0; i < 8; ++i) xc[i] = cb[i];
#pragma unroll
                for (int j = 0; j < 4; ++j) { const int ts = t + j - 2;
                    if (ts >= 0 && ts < L) { const v4u x = *(const v4u*)(G1 + (size_t)(tok0 + ts) * G1W + C_XL + g * 64 + q8);
                        xc[0] += cw[j][0] * bflo(x.x); xc[1] += cw[j][1] * bfhi(x.x); xc[2] += cw[j][2] * bflo(x.y); xc[3] += cw[j][3] * bfhi(x.y);
                        xc[4] += cw[j][4] * bflo(x.z); xc[5] += cw[j][5] * bfhi(x.z); xc[6] += cw[j][6] * bflo(x.w); xc[7] += cw[j][7] * bfhi(x.w); } }
#pragma unroll
                for (int i = 0; i < 8; ++i) XC[tt * 64 + q8 + i] = xc[i];
            }
            __syncthreads();
            {
                float gr[8], gi[8];
#pragma unroll
                for (int i = 0; i < 8; ++i) { gr[i] = bav[i]; gi[i] = bxv[i]; }
                for (int i = 0; i < 64; ++i) { const float x = XC[tt * 64 + i];
                    const f32x4 a0 = *(const LAS f32x4*)(WA + i * 64 + q8), a1 = *(const LAS f32x4*)(WA + i * 64 + q8 + 4), x0 = *(const LAS f32x4*)(WX + i * 64 + q8), x1 = *(const LAS f32x4*)(WX + i * 64 + q8 + 4);
                    gr[0] = fmaf(x, a0.x, gr[0]); gr[1] = fmaf(x, a0.y, gr[1]); gr[2] = fmaf(x, a0.z, gr[2]); gr[3] = fmaf(x, a0.w, gr[3]);
                    gr[4] = fmaf(x, a1.x, gr[4]); gr[5] = fmaf(x, a1.y, gr[5]); gr[6] = fmaf(x, a1.z, gr[6]); gr[7] = fmaf(x, a1.w, gr[7]);
                    gi[0] = fmaf(x, x0.x, gi[0]); gi[1] = fmaf(x, x0.y, gi[1]); gi[2] = fmaf(x, x0.z, gi[2]); gi[3] = fmaf(x, x0.w, gi[3]);
                    gi[4] = fmaf(x, x1.x, gi[4]); gi[5] = fmaf(x, x1.y, gi[5]); gi[6] = fmaf(x, x1.z, gi[6]); gi[7] = fmaf(x, x1.w, gi[7]); }
#pragma unroll
                for (int i = 0; i < 8; ++i) { const float la = -8.f * sigmoidf_(gr[i]) * spl[i];
                    AA[tt * 64 + q8 + i] = __expf(la);
                    BV[tt * 64 + q8 + i] = sqrtf(-expm1f(2.f * la)) * sigmoidf_(gi[i]) * XC[tt * 64 + q8 + i]; }
            }
            __syncthreads();
            if (tid < 64) { for (int s = 0; s < 64; ++s) { const int st = e ? 63 - s : s; h = fmaf(AA[st * 64 + tid], h, BV[st * 64 + tid]); HH[st * 64 + tid] = h; } }
            __syncthreads();
            {
                bf16* dst = HF + (size_t)n * 256 + g * 64 + q8;
                float o[8];
#pragma unroll
                for (int i = 0; i < 8; ++i) o[i] = HH[tt * 64 + q8 + i];
                if (e) { const v4u hf = *(const v4u*)dst, gl = *(const v4u*)(G1 + (size_t)n * G1W + C_GL + g * 64 + q8);
                    o[0] = (o[0] + bflo(hf.x)) * siluf_(bflo(gl.x)); o[1] = (o[1] + bfhi(hf.x)) * siluf_(bfhi(gl.x)); o[2] = (o[2] + bflo(hf.y)) * siluf_(bflo(gl.y)); o[3] = (o[3] + bfhi(hf.y)) * siluf_(bfhi(gl.y));
                    o[4] = (o[4] + bflo(hf.z)) * siluf_(bflo(gl.z)); o[5] = (o[5] + bfhi(hf.z)) * siluf_(bfhi(gl.z)); o[6] = (o[6] + bflo(hf.w)) * siluf_(bflo(gl.w)); o[7] = (o[7] + bfhi(hf.w)) * siluf_(bfhi(gl.w)); }
                v4u ov; ov.x = pk2(o[0], o[1]); ov.y = pk2(o[2], o[3]); ov.z = pk2(o[4], o[5]); ov.w = pk2(o[6], o[7]);
                *(v4u*)dst = ov;
            }
            __syncthreads();
        }
        if (tid < 64 && !lat) a.out[O_LRU + ((size_t)(b * 2 + layer) * 2 + e) * 256 + g * 64 + tid] = h;
    }
}

__device__ __forceinline__ void phase_c1(const Args& a, int layer) {
    const int tid = threadIdx.x, lane = tid & 63, wave = tid >> 6, G = gridDim.x;
    const bf16* G1 = (const bf16*)(a.ws + WS_G1); const bf16* YS = (const bf16*)(a.ws + WS_G2); const bf16* Q = (const bf16*)(a.ws + WS_Q); const bf16* HF = (const bf16*)(a.ws + WS_HF);
    bf16* Y = (bf16*)(a.ws + WS_YMIX);
    const int ch = lane * 4;
    const f32x4 rk = *(const f32x4*)(a.in[I_RK] + layer * 256 + ch), lg = *(const f32x4*)(a.in[I_LNXG] + layer * 256 + ch), lb = *(const f32x4*)(a.in[I_LNXB] + layer * 256 + ch);
    for (int n = blockIdx.x * 8 + wave; n < T; n += G * 8) {
        const bf16* g = G1 + (size_t)n * G1W;
        const v2u y0 = *(const v2u*)(YS + (size_t)n * 256 + ch), y1 = *(const v2u*)(YS + ((size_t)T + n) * 256 + ch);
        float y[4] = {bflo(y0.x) + bflo(y1.x), bfhi(y0.x) + bfhi(y1.x), bflo(y0.y) + bflo(y1.y), bfhi(y0.y) + bfhi(y1.y)};
        const v2u rv = *(const v2u*)(g + C_R + ch), kv = *(const v2u*)(g + C_K + ch), vv = *(const v2u*)(g + C_V + ch), gv = *(const v2u*)(g + C_G + ch);
        float s = (y[0] + y[1]) + (y[2] + y[3]);
        float bon = bflo(rv.x) * bflo(kv.x) * rk.x + bfhi(rv.x) * bfhi(kv.x) * rk.y + bflo(rv.y) * bflo(kv.y) * rk.z + bfhi(rv.y) * bfhi(kv.y) * rk.w;
#pragma unroll
        for (int o = 1; o < 16; o <<= 1) { s += __shfl_xor(s, o); bon += __shfl_xor(bon, o); }
        const float mu = s * (1.f / 64.f);
        float s2 = (y[0] - mu) * (y[0] - mu) + (y[1] - mu) * (y[1] - mu) + (y[2] - mu) * (y[2] - mu) + (y[3] - mu) * (y[3] - mu);
#pragma unroll
        for (int o = 1; o < 16; o <<= 1) s2 += __shfl_xor(s2, o);
        const float rstd = rsqrtf(s2 * (1.f / 64.f) + GN_EPS);
        const float o0 = ((y[0] - mu) * rstd * lg.x + lb.x + bon * bflo(vv.x)) * siluf_(bflo(gv.x));
        const float o1 = ((y[1] - mu) * rstd * lg.y + lb.y + bon * bfhi(vv.x)) * siluf_(bfhi(gv.x));
        const float o2 = ((y[2] - mu) * rstd * lg.z + lb.z + bon * bflo(vv.y)) * siluf_(bflo(gv.y));
        const float o3 = ((y[3] - mu) * rstd * lg.w + lb.w + bon * bfhi(vv.y)) * siluf_(bfhi(gv.y));
        v2u ov; ov.x = pk2(o0, o1); ov.y = pk2(o2, o3);
        bf16* yr = Y + (size_t)n * 1024;
        *(v2u*)(yr + ch) = ov;
        *(v4u*)(yr + 256 + (lane >> 3) * 64 + (lane & 7) * 8) = *(const v4u*)(Q + (size_t)n * 768 + (lane >> 3) * 96 + (lane & 7) * 8);
        *(v2u*)(yr + 768 + ch) = *(const v2u*)(HF + (size_t)n * 256 + ch);
    }
}
constexpr int N_PHASES = 14;
#ifndef MK_PER_PHASE
#define MK_PER_PHASE 0
#endif

__device__ __forceinline__ void phase_b(const Args& a, LAS unsigned char* lds, int layer) {
    const int G = gridDim.x;
    phase_att_naive(a);
    for (int u = blockIdx.x; u < 320; u += G) { __syncthreads(); rwkv_unit_seq(a, lds, layer, u); }
    for (int u = G - 1 - blockIdx.x; u < 160; u += G) { __syncthreads(); lru_unit_seq(a, lds, layer, u); }
}

#if MK_PER_PHASE
template <int SUB> __global__ void __launch_bounds__(NTHREADS, 2) mk_phase(Args a, int layer) {
    extern __shared__ __attribute__((aligned(16))) unsigned char lds_raw[];
    LAS unsigned char* lds = (LAS unsigned char*)lds_raw;
    if (SUB == 0) phase_p0(a, lds);
    if (SUB == 1) phase_a0(a, layer);
    if (SUB == 2) phase_a1_naive(a, layer);
    if (SUB == 3) phase_a2_naive(a, lds, layer);
    if (SUB == 4) phase_att_naive(a);
    if (SUB == 5) { for (int u = blockIdx.x; u < 320; u += gridDim.x) { __syncthreads(); rwkv_unit_seq(a, lds, layer, u); } }
    if (SUB == 6) { for (int u = blockIdx.x; u < 160; u += gridDim.x) { __syncthreads(); lru_unit_seq(a, lds, layer, u); } }
    if (SUB == 7) phase_c1(a, layer);
    if (SUB == 8) phase_c2_naive(a, layer);
    if (SUB == 9) phase_final(a);
}
#else
__global__ void __launch_bounds__(NTHREADS, 2) mk_fwd(Args a) {
    extern __shared__ __attribute__((aligned(16))) unsigned char lds_raw[];
    LAS unsigned char* lds = (LAS unsigned char*)lds_raw;
    volatile LAS unsigned* MISC = (volatile LAS unsigned*)(lds + LDS_MISC);
    for (int u = threadIdx.x; u < 64; u += NTHREADS) MISC[u] = 0u;
    __syncthreads();
    XcdBarrier bar; bar.bar = (unsigned*)(a.ws + WS_CTL) + CW_BAR; bar.x = 0; bar.st = nullptr;
    if (!MK_PER_PHASE) bar = xcd_barrier_post((unsigned*)(a.ws + WS_CTL) + CW_BAR, MISC + 8);
    const int lo = a.ph_lo, hi = a.ph_hi;
#define IN(k) (lo <= (k) && (k) < hi)
#define SEAM(k) do { if (IN(k) && IN((k) + 1)) xcd_barrier(bar); } while (0)
    if (IN(0)) phase_p0(a, lds);
    SEAM(0);
    for (int layer = 0; layer < 2; ++layer) {
        const int p = 1 + 6 * layer;
        if (IN(p + 0)) phase_a0(a, layer);
        SEAM(p + 0);
        if (IN(p + 1)) phase_a1_naive(a, layer);
        SEAM(p + 1);
        if (IN(p + 2)) phase_a2_naive(a, lds, layer);
        SEAM(p + 2);
        if (IN(p + 3)) phase_b(a, lds, layer);
        SEAM(p + 3);
        if (IN(p + 4)) phase_c1(a, layer);
        SEAM(p + 4);
        if (IN(p + 5)) phase_c2_naive(a, layer);
        SEAM(p + 5);
    }
    if (IN(N_PHASES - 1)) phase_final(a);
#undef IN
#undef SEAM
}

#endif

extern "C" void kernel_launch(void* const* d_in, const int* in_sizes, int n_in, void* d_out, int out_size, void* d_ws, size_t ws_size, hipStream_t stream) {
    static int grid = 0;
    if (grid == 0) {
        if (n_in != N_IN || ws_size < WS_END) { fprintf(stderr, "kernel_launch: unexpected n_in %d / ws_size %zu\n", n_in, ws_size); grid = -1; return; }
        int dev = 0, cus = 0;
        if (hipGetDevice(&dev) != hipSuccess || hipDeviceGetAttribute(&cus, hipDeviceAttributeMultiprocessorCount, dev) != hipSuccess) { grid = -1; return; }
#if MK_PER_PHASE
#define SA(SUB) if (hipFuncSetAttribute((const void*)mk_phase<SUB>, hipFuncAttributeMaxDynamicSharedMemorySize, LDS_BYTES) != hipSuccess) { fprintf(stderr, "kernel_launch: hipFuncSetAttribute failed\n"); grid = -1; return; }
        SA(0) SA(1) SA(2) SA(3) SA(4) SA(5) SA(6) SA(7) SA(8) SA(9)
#undef SA
#else
        if (hipFuncSetAttribute((const void*)mk_fwd, hipFuncAttributeMaxDynamicSharedMemorySize, LDS_BYTES) != hipSuccess) { fprintf(stderr, "kernel_launch: hipFuncSetAttribute failed\n"); grid = -1; return; }
        int per_cu = 0;
        if (hipOccupancyMaxActiveBlocksPerMultiprocessor(&per_cu, (const void*)mk_fwd, NTHREADS, LDS_BYTES) != hipSuccess || per_cu < 1) fprintf(stderr, "kernel_launch: occupancy query reports %d\n", per_cu);
        (void)hipGetLastError();
#endif
        grid = cus;
    }
    if (grid < 0) return;
    if (hipMemsetAsync((char*)d_ws + WS_CTL, 0, CTL_ZERO_BYTES, stream) != hipSuccess) return;
    Args a{};
    for (int i = 0; i < N_IN; ++i) a.in[i] = (const float*)d_in[i];
    a.out = (float*)d_out; a.ws = (unsigned char*)d_ws;
#if MK_PER_PHASE
#define LP(SUB, layer) hipLaunchKernelGGL(mk_phase<SUB>, dim3(grid), dim3(NTHREADS), LDS_BYTES, stream, a, layer)
    LP(0, 0);
    for (int layer = 0; layer < 2; ++layer) { LP(1, layer); LP(2, layer); LP(3, layer); LP(4, layer); LP(5, layer); LP(6, layer); LP(7, layer); LP(8, layer); }
    LP(9, 0);
#undef LP
#else
    a.ph_lo = 0; a.ph_hi = N_PHASES;
    hipLaunchKernelGGL(mk_fwd, dim3(grid), dim3(NTHREADS), LDS_BYTES, stream, a);
#endif
}
```

```cpp
#define MK_PER_PHASE 0
#include <hip/hip_runtime.h>
#include <cstdio>
#include <cstdint>

#define GAS __attribute__((address_space(1)))
#define LAS __attribute__((address_space(3)))
typedef unsigned short bf16;
typedef unsigned v4u __attribute__((ext_vector_type(4)));
typedef unsigned v2u __attribute__((ext_vector_type(2)));
typedef float f32x4 __attribute__((ext_vector_type(4)));
typedef short bf16x8 __attribute__((ext_vector_type(8)));

constexpr int D = 1024, T_CTX = 8192, T_LAT = 16384, T = 24576, L_CTX = 256, L_LAT = 2048, PAST = 256;
constexpr int NIN = 2816, G1W = 2304, G2W = 512;
constexpr int C_R = 0, C_K = 256, C_V = 512, C_G = 768, C_GM = 1024, C_XL = 1536, C_GL = 1792, C_LORA = 2048;
constexpr int LK_LAT = PAST + L_LAT;
constexpr int TK = T_CTX + 8 * LK_LAT;
constexpr int VT_LAT = 32 * 8 * 64 * 256;
constexpr float LN_EPS = 1e-5f, GN_EPS = 64e-5f;
constexpr float ALPHA = 1.4142135623730951f;
constexpr float QSCALE = 0.10206207261596575f * 1.4426950408889634f;
constexpr size_t O_Y = 0, O_RW = 25165824, O_CKV = 27262976, O_KR = 29360128, O_LRU = 29884416;
constexpr size_t MiB = 1u << 20;
constexpr size_t WS_CTL = 0, CTL_ZERO_BYTES = 1 * MiB;
constexpr size_t WS_MOD = 256 * 1024;
constexpr size_t WS_ROPE = 1 * MiB;
constexpr size_t WS_WUQ = 2 * MiB;
constexpr size_t WS_WUKV = 3 * MiB;
constexpr size_t WS_WIN = 4 * MiB;
constexpr size_t WS_WOUT = 16 * MiB;
constexpr size_t WS_G1 = 20 * MiB;
constexpr size_t WS_G2 = 128 * MiB;
constexpr size_t WS_Q = 152 * MiB;
constexpr size_t WS_U = 152 * MiB;
constexpr size_t WS_KN = 188 * MiB;
constexpr size_t WS_KR = 214 * MiB;
constexpr size_t WS_VT = 216 * MiB;
constexpr size_t WS_YMIX = 188 * MiB;
constexpr size_t WS_HF = 242 * MiB;
constexpr size_t WS_END = 254 * MiB;
constexpr int CW_BAR = 4096;
constexpr int CW_Q = 16384;

__device__ __forceinline__ float bf2f(unsigned b) { return __uint_as_float(b << 16); }
__device__ __forceinline__ float bflo(unsigned w) { return __uint_as_float(w << 16); }
__device__ __forceinline__ float bfhi(unsigned w) { return __uint_as_float(w & 0xffff0000u); }
__device__ __forceinline__ unsigned f2bf(float f) { unsigned u = __float_as_uint(f); return (u + 0x7fffu + ((u >> 16) & 1u)) >> 16; }
__device__ __forceinline__ unsigned pk2(float lo, float hi) { return f2bf(lo) | (f2bf(hi) << 16); }
__device__ __forceinline__ float sigmoidf_(float x) { return 1.f / (1.f + __expf(-x)); }
__device__ __forceinline__ float siluf_(float x) { return x / (1.f + __expf(-x)); }
__device__ __forceinline__ float wave_sum(float v) {
#pragma unroll
    for (int o = 1; o < 64; o <<= 1) v += __shfl_xor(v, o);
    return v;
}
__device__ __forceinline__ int tid_() { int t = threadIdx.x; asm volatile("" : "+v"(t)); return t; }
__device__ __forceinline__ int bid_() { int b = blockIdx.x; asm volatile("" : "+s"(b)); return b; }
__device__ __forceinline__ int grid_() { int g = gridDim.x; asm volatile("" : "+s"(g)); return g; }
#define XB_TMO      128
#define XB_XCNT(j)  (256  + 64 * (j))
#define XB_XSUB(j)  (1280 + 64 * (j))
#define XB_XGEN(j)  (2304 + 64 * (j))
#define XB_TOP      3328
#define XB_TOPGEN   3392
#define XCD_BAR_WORDS 3456
#define XB_SPIN_CAP (1u << 24)

__device__ __forceinline__ unsigned xb_ld(unsigned* p)              { return __hip_atomic_load(p, __ATOMIC_RELAXED, __HIP_MEMORY_SCOPE_AGENT); }
__device__ __forceinline__ unsigned xb_add(unsigned* p, unsigned v) { return __hip_atomic_fetch_add(p, v, __ATOMIC_RELAXED, __HIP_MEMORY_SCOPE_AGENT); }
__device__ __forceinline__ unsigned xb_xcc_id() { return (unsigned)__builtin_amdgcn_s_getreg((3 << 11) | 20) & 0xFu; }
#define XB_SPIN(cond, bar) do { unsigned _sp = 0; while (cond) { __builtin_amdgcn_s_sleep(1); \
    if ((++_sp & 255u) == 0u) { if (xb_ld(&(bar)[XB_TMO])) break; if (_sp > XB_SPIN_CAP) { atomicAdd(&(bar)[XB_TMO], 1u); break; } } } } while (0)

struct XcdBarrier {
    unsigned* bar; unsigned x;
    volatile LAS unsigned* st;
};

__device__ __forceinline__ XcdBarrier xcd_barrier_post(unsigned* bar, volatile LAS unsigned* st) {
    XcdBarrier b; b.bar = bar; b.x = xb_xcc_id(); b.st = st;
    if (threadIdx.x == 0) (void)xb_add(&bar[XB_XCNT(b.x)], 1u);
    return b;
}
__device__ __forceinline__ void xcd_barrier_complete(unsigned* bar, unsigned x, unsigned& nloc, unsigned& nx) {
    const unsigned G = gridDim.x * gridDim.y * gridDim.z;
    unsigned sum, cnt, mine, sp = 0u;
    for (;;) {
        sum = 0u; cnt = 0u; mine = 0u;
#pragma unroll
        for (unsigned j = 0; j < 16; ++j) { const unsigned c = xb_ld(&bar[XB_XCNT(j)]); sum += c; cnt += (c > 0u) ? 1u : 0u; mine = (j == x) ? c : mine; }
        if (sum == G) break;
        __builtin_amdgcn_s_sleep(1);
        if ((++sp & 255u) == 0u) { if (xb_ld(&bar[XB_TMO])) break; if (sp > XB_SPIN_CAP) { atomicAdd(&bar[XB_TMO], 1u); break; } }
    }
    nloc = mine > 0u ? mine : 1u; nx = cnt > 0u ? cnt : 1u;
}

__device__ __forceinline__ void xcd_barrier(const XcdBarrier& b) {
    asm volatile("s_waitcnt vmcnt(0)" ::: "memory");
    __syncthreads();
    if (threadIdx.x == 0) {
        unsigned* bar = b.bar;
        __builtin_amdgcn_s_waitcnt(0);
        unsigned nloc = b.st[0], nx = b.st[1];
        if (nloc == 0u) { xcd_barrier_complete(bar, b.x, nloc, nx); b.st[0] = nloc; b.st[1] = nx; }
        const unsigned old = xb_add(&bar[XB_XSUB(b.x)], 1u);
        const unsigned gen = old / nloc;
        if (old + 1u == (gen + 1u) * nloc) {
            __builtin_amdgcn_fence(__ATOMIC_RELEASE, "agent");
            asm volatile("s_waitcnt vmcnt(0)" ::: "memory");
            const unsigned og = xb_add(&bar[XB_TOP], 1u);
            const unsigned tg = og / nx;
            if (og + 1u == (tg + 1u) * nx) xb_add(&bar[XB_TOPGEN], 1u);
            else XB_SPIN(xb_ld(&bar[XB_TOPGEN]) == tg, bar);
            __builtin_amdgcn_fence(__ATOMIC_ACQUIRE, "agent");
            xb_add(&bar[XB_XGEN(b.x)], 1u);
            asm volatile("s_waitcnt vmcnt(0)" ::: "memory");
        } else {
            XB_SPIN(xb_ld(&bar[XB_XGEN(b.x)]) == gen, bar);
            __builtin_amdgcn_fence(__ATOMIC_ACQUIRE, "agent");
            asm volatile("s_waitcnt vmcnt(0)" ::: "memory");
        }
    }
    __syncthreads();
}
enum { I_XP = 0, I_XS, I_SRW, I_CCKV, I_CKR, I_SLRU, I_C, I_CCTX, I_WMOD, I_BMOD, I_WIN, I_W0, I_W1, I_W2, I_A0, I_A1, I_A2, I_KK, I_KA, I_RK,
       I_LNXG, I_LNXB, I_QNORM, I_WUQ, I_KVNORM, I_WUKV, I_CONVW, I_CONVB, I_WA, I_BA, I_WX, I_BX, I_LAMBDA, I_WOUT, I_LNG, I_LNB, N_IN };
struct Args { const float* in[N_IN]; float* out; unsigned char* ws; int ph_lo, ph_hi; };
typedef const Args __attribute__((address_space(4)))* ArgsP;
constexpr int NTHREADS = 512;
constexpr int LDS_MISC = 139264;
constexpr int LDS_BYTES = 147456;

struct Tok { int n, b, t, L, lat, modrow, tok0, kidx; };
__device__ __forceinline__ Tok tok_of(int n) {
    Tok k; k.n = n;
    if (n < T_CTX) { k.lat = 0; k.b = n >> 8; k.t = n & 255; k.L = L_CTX; k.modrow = 0; k.tok0 = k.b * 256; k.kidx = n; }
    else { const int m = n - T_CTX; k.lat = 1; k.b = m >> 11; k.t = m & 2047; k.L = L_LAT; k.modrow = 1 + k.b; k.tok0 = T_CTX + k.b * 2048; k.kidx = T_CTX + k.b * LK_LAT + PAST + k.t; }
    return k;
}
__device__ __forceinline__ const float* xrow_src(ArgsP a, int layer, int n) {
    if (layer == 0) return n < T_CTX ? a->in[I_XP] + (size_t)n * D : a->in[I_XS] + (size_t)(n - T_CTX) * D;
    return a->out + (size_t)n * D;
}
__device__ __forceinline__ float dot8(v4u a, v4u b, float acc) {
    acc = fmaf(bflo(a.x), bflo(b.x), acc); acc = fmaf(bfhi(a.x), bfhi(b.x), acc);
    acc = fmaf(bflo(a.y), bflo(b.y), acc); acc = fmaf(bfhi(a.y), bfhi(b.y), acc);
    acc = fmaf(bflo(a.z), bflo(b.z), acc); acc = fmaf(bfhi(a.z), bfhi(b.z), acc);
    acc = fmaf(bflo(a.w), bflo(b.w), acc); acc = fmaf(bfhi(a.w), bfhi(b.w), acc);
    return acc;
}

__device__ __forceinline__ void tr_item(const float* src, int ld, int col0, int k0, bf16* WT, int K, int row0, float scale, LAS float* scr, int lane) {
#pragma unroll 8
    for (int i = 0; i < 32; ++i) { const int kk = 2 * i + (lane >> 5); scr[kk * 33 + (lane & 31)] = src ? src[(size_t)(k0 + kk) * ld + col0 + (lane & 31)] * scale : 0.f; }
    asm volatile("s_waitcnt lgkmcnt(0)" ::: "memory");
    const int c = lane & 7;
#pragma unroll
    for (int j = 0; j < 4; ++j) { const int n = (lane >> 3) + 8 * j; const LAS float* s = scr + (8 * c) * 33 + n;
        v4u o; o.x = pk2(s[0 * 33], s[1 * 33]); o.y = pk2(s[2 * 33], s[3 * 33]); o.z = pk2(s[4 * 33], s[5 * 33]); o.w = pk2(s[6 * 33], s[7 * 33]);
        *(v4u*)(WT + (size_t)(row0 + n) * K + k0 + 8 * c) = o; }
    asm volatile("s_waitcnt lgkmcnt(0)" ::: "memory");
}
__device__ __forceinline__ void rope_angle(int t, int i, float& c, float& s) {
    const int row = t >> 6, col = t & 63; const int ii = i & 7;
    const float inv = exp2f(-(float)ii * (13.287712379549449f / 8.f));
    const float ang = (float)(i < 8 ? row : col) * inv;
    c = cosf(ang); s = sinf(ang);
}
__device__ __forceinline__ void phase_p0(ArgsP a, LAS unsigned char* lds) {
    const int tid = tid_(), lane = tid & 63, wave = tid >> 6, G = grid_();
    unsigned char* ws = a->ws;
    LAS float* scr = (LAS float*)(lds + wave * 8704);
    const int gw = bid_() * 8 + wave, NGW = G * 8;
    constexpr int N_WIN = 2 * 16 * 88, N_WOUT = 2 * 16 * 32, N_WUQ = 2 * 4 * 24, N_WUKV = 2 * 2 * 32;
    for (int it = gw; it < N_WIN + N_WOUT + N_WUQ + N_WUKV; it += NGW) {
        int r = it;
        if (r < N_WIN) {
            const int l = r / (16 * 88), kb = (r / 88) % 16, nb = r % 88, j0 = nb * 32;
            const float* src; int ld, col0;
            const float* win = a->in[I_WIN] + (size_t)l * 1024 * 2464;
            if (j0 < 1024) { src = win; ld = 2464; col0 = j0; }
            else if (j0 < 1536) { src = win; ld = 2464; col0 = 1440 + (j0 - 1024); }
            else if (j0 < 1792) { src = win; ld = 2464; col0 = 1952 + (j0 - 1536); }
            else if (j0 < 2048) { src = win; ld = 2464; col0 = 2208 + (j0 - 1792); }
            else if (j0 < 2304) { const int q = (j0 - 2048) >> 6; src = (q < 2 ? a->in[I_W1] : a->in[I_A1]) + (size_t)(l * 2 + (q & 1)) * 1024 * 64; ld = 64; col0 = (j0 - 2048) & 63; }
            else if (j0 < 2560) { src = win; ld = 2464; col0 = 1024 + (j0 - 2304); }
            else if (j0 < 2688) { src = win; ld = 2464; col0 = 1280 + (j0 - 2560); }
            else if (j0 < 2720) { src = win; ld = 2464; col0 = 1408 + (j0 - 2688); }
            else { src = nullptr; ld = 0; col0 = 0; }
            tr_item(src, ld, col0, kb * 64, (bf16*)(ws + WS_WIN) + (size_t)l * NIN * 1024, 1024, j0, 1.f, scr, lane);
            continue;
        }
        r -= N_WIN;
        if (r < N_WOUT) { const int l = r / (16 * 32), kb = (r / 32) % 16, nb = r % 32;
            tr_item(a->in[I_WOUT] + (size_t)l * 1024 * 1024, 1024, nb * 32, kb * 64, (bf16*)(ws + WS_WOUT) + (size_t)l * 1024 * 1024, 1024, nb * 32, 1.f, scr, lane); continue; }
        r -= N_WOUT;
        if (r < N_WUQ) { const int l = r / (4 * 24), kb = (r / 24) % 4, nb = r % 24;
            tr_item(a->in[I_WUQ] + (size_t)l * 256 * 768, 768, nb * 32, kb * 64, (bf16*)(ws + WS_WUQ) + (size_t)l * 768 * 256, 256, nb * 32, QSCALE, scr, lane); continue; }
        r -= N_WUQ;
        { const int l = r / (2 * 32), kb = (r / 32) % 2, nb = r % 32;
            tr_item(a->in[I_WUKV] + (size_t)l * 128 * 1024, 1024, nb * 32, kb * 64, (bf16*)(ws + WS_WUKV) + (size_t)l * 1024 * 128, 128, nb * 32, 1.f, scr, lane); }
    }
    { float* ROPE = (float*)(ws + WS_ROPE);
      for (int i = bid_() * NTHREADS + tid; i < 2048 * 16; i += G * NTHREADS) { float c, s; rope_angle(i >> 4, i & 15, c, s); ROPE[i * 2] = c; ROPE[i * 2 + 1] = s; } }
    float* MOD = (float*)(ws + WS_MOD);
    for (int it = bid_(); it < 2 * 6 * 32; it += G) {
        const int l = it / 192, nb = (it / 32) % 6, kq = it % 32, col = nb * 512 + tid;
        float acc[9];
#pragma unroll
        for (int j = 0; j < 9; ++j) acc[j] = 0.f;
        for (int kk = 0; kk < 32; ++kk) { const int k = kq * 32 + kk;
            const float w = a->in[I_WMOD][((size_t)l * 1024 + k) * 3072 + col];
#pragma unroll
            for (int j = 0; j < 9; ++j) { const float cj = (j == 0) ? a->in[I_CCTX][k] : a->in[I_C][(j - 1) * 1024 + k]; acc[j] = fmaf(siluf_(cj), w, acc[j]); } }
        const float bias = (kq == 0) ? a->in[I_BMOD][l * 3072 + col] : 0.f;
#pragma unroll
        for (int j = 0; j < 9; ++j) atomicAdd(&MOD[(l * 9 + j) * 3072 + col], acc[j] + bias);
    }
}

__device__ __forceinline__ void phase_a0(ArgsP a, int layer) {
    const int tid = tid_(), lane = tid & 63, wave = tid >> 6, G = grid_();
    const float* MOD = (const float*)(a->ws + WS_MOD);
    bf16* U = (bf16*)(a->ws + WS_U);
    for (int n = bid_() * 8 + wave; n < T; n += G * 8) {
        const Tok tk = tok_of(n);
        const float* xr = xrow_src(a, layer, n);
        f32x4 v[4]; float s = 0.f;
#pragma unroll
        for (int j = 0; j < 4; ++j) { v[j] = *(const f32x4*)(xr + lane * 4 + 256 * j); s += (v[j].x + v[j].y) + (v[j].z + v[j].w); }
        float mean = wave_sum(s) * (1.f / D), s2 = 0.f;
#pragma unroll
        for (int j = 0; j < 4; ++j) { v[j] = v[j] - mean; s2 += (v[j].x * v[j].x + v[j].y * v[j].y) + (v[j].z * v[j].z + v[j].w * v[j].w); }
        float rstd = rsqrtf(wave_sum(s2) * (1.f / D) + LN_EPS);
        if (layer == 1) {
            s = 0.f;
#pragma unroll
            for (int j = 0; j < 4; ++j) { const f32x4 g = *(const f32x4*)(a->in[I_LNG] + lane * 4 + 256 * j), b = *(const f32x4*)(a->in[I_LNB] + lane * 4 + 256 * j);
                v[j] = v[j] * rstd * g + b; *(f32x4*)(a->out + (size_t)n * D + lane * 4 + 256 * j) = v[j]; s += (v[j].x + v[j].y) + (v[j].z + v[j].w); }
            mean = wave_sum(s) * (1.f / D); s2 = 0.f;
#pragma unroll
            for (int j = 0; j < 4; ++j) { v[j] = v[j] - mean; s2 += (v[j].x * v[j].x + v[j].y * v[j].y) + (v[j].z * v[j].z + v[j].w * v[j].w); }
            rstd = rsqrtf(wave_sum(s2) * (1.f / D) + LN_EPS);
        }
        const float* m = MOD + (size_t)(layer * 9 + tk.modrow) * 3072;
#pragma unroll
        for (int j = 0; j < 4; ++j) { const int c = lane * 4 + 256 * j; const f32x4 sh = *(const f32x4*)(m + c), sc = *(const f32x4*)(m + 1024 + c);
            const f32x4 o = v[j] * rstd * (sc + 1.f) + sh;
            v2u p; p.x = pk2(o.x, o.y); p.y = pk2(o.z, o.w); *(v2u*)(U + (size_t)n * D + c) = p; }
    }
}
__device__ __forceinline__ void phase_final(ArgsP a) {
    const int tid = tid_(), lane = tid & 63, wave = tid >> 6, G = grid_();
    for (int n = bid_() * 8 + wave; n < T; n += G * 8) {
        float* xr = a->out + (size_t)n * D;
        f32x4 v[4]; float s = 0.f;
#pragma unroll
        for (int j = 0; j < 4; ++j) { v[j] = *(const f32x4*)(xr + lane * 4 + 256 * j); s += (v[j].x + v[j].y) + (v[j].z + v[j].w); }
        const float mean = wave_sum(s) * (1.f / D); float s2 = 0.f;
#pragma unroll
        for (int j = 0; j < 4; ++j) { v[j] = v[j] - mean; s2 += (v[j].x * v[j].x + v[j].y * v[j].y) + (v[j].z * v[j].z + v[j].w * v[j].w); }
        const float rstd = rsqrtf(wave_sum(s2) * (1.f / D) + LN_EPS);
#pragma unroll
        for (int j = 0; j < 4; ++j) { const f32x4 g = *(const f32x4*)(a->in[I_LNG] + 1024 + lane * 4 + 256 * j), b = *(const f32x4*)(a->in[I_LNB] + 1024 + lane * 4 + 256 * j);
            *(f32x4*)(xr + lane * 4 + 256 * j) = v[j] * rstd * g + b; }
    }
}

__device__ __forceinline__ void phase_a1_naive(ArgsP a, int layer) {
    const bf16* U = (const bf16*)(a->ws + WS_U); const bf16* W = (const bf16*)(a->ws + WS_WIN) + (size_t)layer * NIN * 1024;
    bf16* G1 = (bf16*)(a->ws + WS_G1); bf16* G2 = (bf16*)(a->ws + WS_G2);
    const size_t total = (size_t)T * (NIN / 8), stride = (size_t)grid_() * NTHREADS;
    for (size_t idx = (size_t)bid_() * NTHREADS + tid_(); idx < total; idx += stride) {
        const int row = (int)(idx / (NIN / 8)), c0 = (int)(idx % (NIN / 8)) * 8;
        float acc[8];
#pragma unroll
        for (int c = 0; c < 8; ++c) acc[c] = 0.f;
        const v4u* ap = (const v4u*)(U + (size_t)row * 1024); const v4u* bp = (const v4u*)(W + (size_t)c0 * 1024);
        for (int kc = 0; kc < 128; ++kc) { const v4u av = ap[kc];
#pragma unroll
            for (int c = 0; c < 8; ++c) acc[c] = dot8(av, bp[c * 128 + kc], acc[c]); }
        v4u o; o.x = pk2(acc[0], acc[1]); o.y = pk2(acc[2], acc[3]); o.z = pk2(acc[4], acc[5]); o.w = pk2(acc[6], acc[7]);
        if (c0 < G1W) *(v4u*)(G1 + (size_t)row * G1W + c0) = o; else *(v4u*)(G2 + (size_t)row * G2W + (c0 - G1W)) = o;
    }
}
__device__ __forceinline__ void phase_c2_naive(ArgsP a, int layer) {
    const bf16* Y = (const bf16*)(a->ws + WS_YMIX); const bf16* W = (const bf16*)(a->ws + WS_WOUT) + (size_t)layer * 1024 * 1024;
    const float* MOD = (const float*)(a->ws + WS_MOD);
    const size_t total = (size_t)T * 256, stride = (size_t)grid_() * NTHREADS;
    for (size_t idx = (size_t)bid_() * NTHREADS + tid_(); idx < total; idx += stride) {
        const int row = (int)(idx >> 8), c0 = (int)(idx & 255) * 4;
        float acc[4] = {0.f, 0.f, 0.f, 0.f};
        const v4u* ap = (const v4u*)(Y + (size_t)row * 1024); const v4u* bp = (const v4u*)(W + (size_t)c0 * 1024);
        for (int kc = 0; kc < 128; ++kc) { const v4u av = ap[kc];
#pragma unroll
            for (int c = 0; c < 4; ++c) acc[c] = dot8(av, bp[c * 128 + kc], acc[c]); }
        const Tok tk = tok_of(row);
        const f32x4 gate = *(const f32x4*)(MOD + (size_t)(layer * 9 + tk.modrow) * 3072 + 2048 + c0);
        const f32x4 x = *(const f32x4*)(xrow_src(a, layer, row) + c0);
        f32x4 z; z.x = ALPHA * x.x + gate.x * acc[0]; z.y = ALPHA * x.y + gate.y * acc[1]; z.z = ALPHA * x.z + gate.z * acc[2]; z.w = ALPHA * x.w + gate.w * acc[3];
        *(f32x4*)(a->out + (size_t)row * D + c0) = z;
    }
}

__device__ __forceinline__ void phase_a2_naive(ArgsP a, LAS unsigned char* lds, int layer) {
    const int tid = tid_(), lane = tid & 63, wave = tid >> 6, G = grid_();
    LAS float* AQ = (LAS float*)lds;
    LAS float* AKV = (LAS float*)(lds + 16384);
    LAS float* OT = (LAS float*)(lds + 24576);
    const bf16* G2 = (const bf16*)(a->ws + WS_G2);
    bf16* Q = (bf16*)(a->ws + WS_Q); bf16* KN = (bf16*)(a->ws + WS_KN); bf16* KR = (bf16*)(a->ws + WS_KR); bf16* VT = (bf16*)(a->ws + WS_VT);
    const bf16* WUQ = (const bf16*)(a->ws + WS_WUQ) + (size_t)layer * 768 * 256;
    const bf16* WUKV = (const bf16*)(a->ws + WS_WUKV) + (size_t)layer * 1024 * 128;
    constexpr int NT_TOK = T / 16, NT_CACHE = 8 * 256 / 16;
    for (int tile = bid_(); tile < NT_TOK + NT_CACHE; tile += G) {
        const bool is_tok = tile < NT_TOK;
        for (int rr = 0; rr < 2; ++rr) {
            const int r = wave * 2 + rr;
            if (is_tok) {
                const int n = tile * 16 + r; const Tok tk = tok_of(n);
                const v2u cqv = *(const v2u*)(G2 + (size_t)n * G2W + lane * 4);
                const float c0 = bflo(cqv.x), c1 = bfhi(cqv.x), c2 = bflo(cqv.y), c3 = bfhi(cqv.y);
                const float rq = rsqrtf(wave_sum(c0 * c0 + c1 * c1 + c2 * c2 + c3 * c3) * (1.f / 256.f) + 1e-6f);
                const f32x4 qn = *(const f32x4*)(a->in[I_QNORM] + layer * 256 + lane * 4);
                AQ[r * 256 + lane * 4 + 0] = bf2f(f2bf(c0 * rq * qn.x)); AQ[r * 256 + lane * 4 + 1] = bf2f(f2bf(c1 * rq * qn.y));
                AQ[r * 256 + lane * 4 + 2] = bf2f(f2bf(c2 * rq * qn.z)); AQ[r * 256 + lane * 4 + 3] = bf2f(f2bf(c3 * rq * qn.w));
                float k0 = 0.f, k1 = 0.f, k2 = 0.f, k3 = 0.f;
                if (lane < 32) { const v2u kv = *(const v2u*)(G2 + (size_t)n * G2W + 256 + lane * 4); k0 = bflo(kv.x); k1 = bfhi(kv.x); k2 = bflo(kv.y); k3 = bfhi(kv.y); }
                const float rk = rsqrtf(wave_sum(k0 * k0 + k1 * k1 + k2 * k2 + k3 * k3) * (1.f / 128.f) + 1e-6f);
                if (lane < 32) {
                    const f32x4 kn = *(const f32x4*)(a->in[I_KVNORM] + layer * 128 + lane * 4);
                    f32x4 o; o.x = k0 * rk * kn.x; o.y = k1 * rk * kn.y; o.z = k2 * rk * kn.z; o.w = k3 * rk * kn.w;
                    if (!tk.lat) *(f32x4*)(a->out + O_CKV + ((size_t)(tk.b * 2 + layer) * 256 + tk.t) * 128 + lane * 4) = o;
                    AKV[r * 128 + lane * 4 + 0] = bf2f(f2bf(o.x)); AKV[r * 128 + lane * 4 + 1] = bf2f(f2bf(o.y));
                    AKV[r * 128 + lane * 4 + 2] = bf2f(f2bf(o.z)); AKV[r * 128 + lane * 4 + 3] = bf2f(f2bf(o.w));
                }
                float krv = (lane < 32) ? bf2f(G2[(size_t)n * G2W + 384 + lane]) : 0.f;
                const float other = __shfl_xor(krv, 1);
                if (lane < 32) {
                    if (!tk.lat) a->out[O_KR + ((size_t)(tk.b * 2 + layer) * 256 + tk.t) * 32 + lane] = krv;
                    else { float c, s; rope_angle(tk.t, lane >> 1, c, s); krv = (lane & 1) ? (other * s + krv * c) : (krv * c - other * s); }
                    KR[(size_t)tk.kidx * 32 + lane] = (bf16)f2bf(krv);
                }
            } else {
                const int cr = (tile - NT_TOK) * 16 + r, b = cr >> 8, j = cr & 255;
                const size_t src = ((size_t)(b * 2 + layer) * 256 + j);
                if (lane < 32) { const f32x4 v = *(const f32x4*)(a->in[I_CCKV] + src * 128 + lane * 4);
                    AKV[r * 128 + lane * 4 + 0] = bf2f(f2bf(v.x)); AKV[r * 128 + lane * 4 + 1] = bf2f(f2bf(v.y)); AKV[r * 128 + lane * 4 + 2] = bf2f(f2bf(v.z)); AKV[r * 128 + lane * 4 + 3] = bf2f(f2bf(v.w));
                    KR[(size_t)(T_CTX + b * LK_LAT + j) * 32 + lane] = (bf16)f2bf(a->in[I_CKR][src * 32 + lane]); }
            }
        }
        __syncthreads();
        if (is_tok) {
            for (int col = tid; col < 768; col += NTHREADS) {
                float acc[16];
#pragma unroll
                for (int r = 0; r < 16; ++r) acc[r] = 0.f;
                const v4u* wp = (const v4u*)(WUQ + (size_t)col * 256);
                for (int kc = 0; kc < 32; ++kc) { const v4u w = wp[kc];
                    const float w0 = bflo(w.x), w1 = bfhi(w.x), w2 = bflo(w.y), w3 = bfhi(w.y), w4 = bflo(w.z), w5 = bfhi(w.z), w6 = bflo(w.w), w7 = bfhi(w.w);
#pragma unroll
                    for (int r = 0; r < 16; ++r) { const f32x4 x0 = *(const LAS f32x4*)(AQ + r * 256 + kc * 8), x1 = *(const LAS f32x4*)(AQ + r * 256 + kc * 8 + 4);
                        acc[r] += x0.x * w0 + x0.y * w1 + x0.z * w2 + x0.w * w3 + x1.x * w4 + x1.y * w5 + x1.z * w6 + x1.w * w7; } }
#pragma unroll
                for (int r = 0; r < 16; ++r) OT[r * 1024 + col] = acc[r];
            }
            __syncthreads();
            for (int idx = tid; idx < 16 * 384; idx += NTHREADS) {
                const int r = idx / 384, col = (idx % 384) * 2, d = col % 96; const int n = tile * 16 + r; const Tok tk = tok_of(n);
                float v0 = OT[r * 1024 + col], v1 = OT[r * 1024 + col + 1];
                if (tk.lat && d >= 64) { float c, s; rope_angle(tk.t, (d - 64) >> 1, c, s); const float y0 = v0 * c - v1 * s, y1 = v0 * s + v1 * c; v0 = y0; v1 = y1; }
                *(unsigned*)(Q + (size_t)n * 768 + col) = pk2(v0, v1);
            }
            __syncthreads();
        }
        for (int col = tid; col < 1024; col += NTHREADS) {
            float acc[16];
#pragma unroll
            for (int r = 0; r < 16; ++r) acc[r] = 0.f;
            const v4u* wp = (const v4u*)(WUKV + (size_t)col * 128);
            for (int kc = 0; kc < 16; ++kc) { const v4u w = wp[kc];
                const float w0 = bflo(w.x), w1 = bfhi(w.x), w2 = bflo(w.y), w3 = bfhi(w.y), w4 = bflo(w.z), w5 = bfhi(w.z), w6 = bflo(w.w), w7 = bfhi(w.w);
#pragma unroll
                for (int r = 0; r < 16; ++r) { const f32x4 x0 = *(const LAS f32x4*)(AKV + r * 128 + kc * 8), x1 = *(const LAS f32x4*)(AKV + r * 128 + kc * 8 + 4);
                    acc[r] += x0.x * w0 + x0.y * w1 + x0.z * w2 + x0.w * w3 + x1.x * w4 + x1.y * w5 + x1.z * w6 + x1.w * w7; } }
#pragma unroll
            for (int r = 0; r < 16; ++r) OT[r * 1024 + col] = acc[r];
        }
        __syncthreads();
        for (int idx = tid; idx < 16 * 1024; idx += NTHREADS) {
            const int r = idx >> 10, col = idx & 1023, h = col >> 7, f = col & 127;
            int kidx, lat, b, kpos;
            if (is_tok) { const Tok tk = tok_of(tile * 16 + r); kidx = tk.kidx; lat = tk.lat; b = tk.b; kpos = tk.lat ? PAST + tk.t : tk.t; }
            else { const int cr = (tile - NT_TOK) * 16 + r; b = cr >> 8; kpos = cr & 255; lat = 1; kidx = T_CTX + b * LK_LAT + kpos; }
            const bf16 v = (bf16)f2bf(OT[r * 1024 + col]);
            if (f < 64) KN[(size_t)kidx * 512 + h * 64 + f] = v;
            else { const int dv = f - 64; const size_t base = lat ? (size_t)VT_LAT + ((size_t)(b * 8 + h) * 64 + dv) * LK_LAT : ((size_t)(b * 8 + h) * 64 + dv) * 256; VT[base + kpos] = v; }
        }
        __syncthreads();
    }
}

__device__ __forceinline__ void phase_att_naive(ArgsP a) {
    const bf16* KN = (const bf16*)(a->ws + WS_KN); const bf16* KR = (const bf16*)(a->ws + WS_KR); const bf16* VT = (const bf16*)(a->ws + WS_VT);
    bf16* Q = (bf16*)(a->ws + WS_Q); const bf16* G1 = (const bf16*)(a->ws + WS_G1);
    const int total = T * 8, stride = grid_() * NTHREADS;
    for (int idx = bid_() * NTHREADS + tid_(); idx < total; idx += stride) {
        int n, h, Lk, kidx0; size_t vbase;
        if (idx < T_CTX * 8) { const int b = idx >> 11, hh = (idx >> 8) & 7, t = idx & 255; n = b * 256 + t; h = hh; Lk = 256; kidx0 = b * 256; vbase = ((size_t)(b * 8 + h) * 64) * 256; }
        else { const int m = idx - T_CTX * 8, b = m >> 14, hh = (m >> 11) & 7, t = m & 2047; n = T_CTX + b * 2048 + t; h = hh; Lk = LK_LAT; kidx0 = T_CTX + b * LK_LAT; vbase = (size_t)VT_LAT + ((size_t)(b * 8 + h) * 64) * LK_LAT; }
        v4u qp[12];
#pragma unroll
        for (int c = 0; c < 12; ++c) qp[c] = *(const v4u*)(Q + (size_t)n * 768 + h * 96 + c * 8);
        float acc[64];
#pragma unroll
        for (int d = 0; d < 64; ++d) acc[d] = 0.f;
        float m = -1e30f, l = 0.f;
        for (int j0 = 0; j0 < Lk; j0 += 8) {
            float s[8];
#pragma unroll
            for (int j = 0; j < 8; ++j) {
                const v4u* kp = (const v4u*)(KN + (size_t)(kidx0 + j0 + j) * 512 + h * 64); const v4u* rp = (const v4u*)(KR + (size_t)(kidx0 + j0 + j) * 32);
                float sv = 0.f;
#pragma unroll
                for (int c = 0; c < 8; ++c) sv = dot8(qp[c], kp[c], sv);
#pragma unroll
                for (int c = 0; c < 4; ++c) sv = dot8(qp[8 + c], rp[c], sv);
                s[j] = sv;
                __builtin_amdgcn_sched_barrier(0);
            }
            float mx = m;
#pragma unroll
            for (int j = 0; j < 8; ++j) mx = fmaxf(mx, s[j]);
            const float alpha = exp2f(m - mx); m = mx; float ps = 0.f;
#pragma unroll
            for (int j = 0; j < 8; ++j) { s[j] = exp2f(s[j] - mx); ps += s[j]; }
            l = l * alpha + ps;
            unsigned lk = (unsigned)Lk; asm volatile("" : "+v"(lk));
            const bf16* vp = VT + vbase + j0;
#pragma unroll
            for (int dg = 0; dg < 8; ++dg) {
#pragma unroll
                for (int dd = 0; dd < 8; ++dd) { const int d = dg * 8 + dd; const v4u w = *(const v4u*)(vp + (unsigned)d * lk);
                    acc[d] = acc[d] * alpha + s[0] * bflo(w.x) + s[1] * bfhi(w.x) + s[2] * bflo(w.y) + s[3] * bfhi(w.y) + s[4] * bflo(w.z) + s[5] * bfhi(w.z) + s[6] * bflo(w.w) + s[7] * bfhi(w.w); }
                __builtin_amdgcn_sched_barrier(0);
            }
        }
        const float inv = 1.f / l;
#pragma unroll
        for (int c = 0; c < 8; ++c) { const v4u g = *(const v4u*)(G1 + (size_t)n * G1W + C_GM + h * 64 + c * 8);
            v4u o;
            o.x = pk2(acc[c * 8 + 0] * inv * siluf_(bflo(g.x)), acc[c * 8 + 1] * inv * siluf_(bfhi(g.x)));
            o.y = pk2(acc[c * 8 + 2] * inv * siluf_(bflo(g.y)), acc[c * 8 + 3] * inv * siluf_(bfhi(g.y)));
            o.z = pk2(acc[c * 8 + 4] * inv * siluf_(bflo(g.z)), acc[c * 8 + 5] * inv * siluf_(bfhi(g.z)));
            o.w = pk2(acc[c * 8 + 6] * inv * siluf_(bflo(g.w)), acc[c * 8 + 7] * inv * siluf_(bfhi(g.w)));
            *(v4u*)(Q + (size_t)n * 768 + h * 96 + c * 8) = o; }
    }
}
namespace pg8 {
#define PG8_LAS __attribute__((address_space(3)))
typedef unsigned short bf16_t;
typedef short bf16x8 __attribute__((ext_vector_type(8)));
typedef float f32x4 __attribute__((ext_vector_type(4)));
typedef unsigned u32x4 __attribute__((ext_vector_type(4)));
constexpr int BM = 256, BK = 64, HALF = 128, HTB = HALF * BK * 2  , STAGE_BYTES = 8 * HTB, NXCD = 8, WGM = 8;

__host__ __device__ __forceinline__ int lds_byte(int r, int c) { const int st = (r >> 4) * 2 + (c >> 5), rr = r & 15, cc = c & 31, ob = rr * 64 + cc * 2; return st * 1024 + (ob ^ (((ob >> 9) & 1) << 5)); }
__host__ __device__ __forceinline__ void stage_rc(int b, int& R, int& C) { const int st = b / 1024, sb = b % 1024, swz = sb ^ (((sb >> 9) & 1) << 5); R = (st >> 1) * 16 + swz / 64; C = (st & 1) * 32 + (swz % 64) / 2; }
__host__ __device__ __forceinline__ int perm32(int rho) { const int n = rho >> 4, i = rho & 15; return 8 * (i >> 2) + 4 * n + (i & 3); }

struct Unit { int pm, pn; };
struct Gemm { const bf16_t* A; const bf16_t* Bt; int M, N, K; };

struct StaticOrder {
    int nM, nN, nwg, G, c;
    __host__ __device__ void init(int M, int N, int G_, int c_) { nM = M / BM; nN = N / BM; nwg = nM * nN; G = G_; c = c_; }
    __host__ __device__ bool next(int i, Unit& u) const {
        const long L = (long)i * G + c; if (L >= nwg) return false;
        int wgid = (int)L; { const int q = nwg / NXCD, r = nwg % NXCD, xcd = wgid % NXCD, off = wgid / NXCD; wgid = (xcd < r ? xcd * (q + 1) : r * (q + 1) + (xcd - r) * q) + off; }
        const int nig = WGM * nN, gid = wgid / nig, fm = gid * WGM, gsz = (nM - fm) < WGM ? (nM - fm) : WGM;
        u.pm = fm + ((wgid % nig) % gsz); u.pn = (wgid % nig) / gsz; return true;
    }
    __device__ __forceinline__ void a_ready(const Unit&) const {}
    __device__ __forceinline__ void done(const Unit&) const {}
};
__device__ __forceinline__ unsigned cvt_pk_bf16(float lo, float hi) { unsigned r; asm volatile("v_cvt_pk_bf16_f32 %0, %1, %2" : "=v"(r) : "v"(lo), "v"(hi)); return r; }

template <class Epi, class Sched, bool STAMP = false>
__device__ __forceinline__ void gemm_phase(PG8_LAS unsigned char* lds, const Gemm g, const Sched& S, const Epi& E, unsigned long long* stamps) {
    const int tid = tid_(), wid = __builtin_amdgcn_readfirstlane(tid >> 6), lane = tid & 63, wr = wid >> 2, wc = wid & 3, fr = lane & 15, fq = lane >> 4;
    const int K = g.K, nt = K / BK;
    int ts_lo = 0, ts_hi = 0, nts = 0; const unsigned long long rt_entry = STAMP ? (unsigned long long)wall_clock64() : 0ull;
#define PG8_STAMP() do { if (STAMP && wid == 0 && nts < 64) { const unsigned long long _c = (unsigned long long)clock64(); \
        ts_lo = (lane == nts) ? (int)(unsigned)_c : ts_lo; ts_hi = (lane == nts) ? (int)(unsigned)(_c >> 32) : ts_hi; ++nts; } } while (0)
    PG8_STAMP();
    unsigned voffA[2], voffB[2];
#pragma unroll
    for (int i = 0; i < 2; ++i) { int R, C; stage_rc(tid * 16 + i * 8192, R, C); const int Rb = Epi::PERM ? ((R & ~31) + perm32(R & 31)) : R;
        voffA[i] = (unsigned)(R * K + C) * 2u; voffB[i] = (unsigned)(Rb * K + C) * 2u; }
    const size_t kstep = (size_t)(BK * 2);
    const size_t hstep = (size_t)HALF * K * 2;
    const size_t tstep = 2 * hstep;
    const unsigned ldsw = (unsigned)wid * 1024u;
    const int aoff = lds_byte(wr * 64 + fr, fq * 8), boff = lds_byte(wc * 32 + fr, fq * 8);
#define PG8_SA(b, h) (((b) * 2 + (h)) * HTB)
#define PG8_SB(b, h) ((4 + (b) * 2 + (h)) * HTB)
#define PG8_STAGE(bufoff, gbase, voff) do { _Pragma("unroll") for (int _i = 0; _i < 2; ++_i) \
        __builtin_amdgcn_global_load_lds((const unsigned*)((const char*)(gbase) + (voff)[_i]), (PG8_LAS unsigned*)(lds + (bufoff) + ldsw + _i * 8192), 16, 0, 0); } while (0)
#define PG8_LDA(dst, b, h) do { _Pragma("unroll") for (int m = 0; m < 4; ++m) _Pragma("unroll") for (int k = 0; k < 2; ++k) dst[m][k] = *(const PG8_LAS bf16x8*)(lds + PG8_SA(b, h) + aoff + m * 2048 + k * 1024); } while (0)
#define PG8_LDB(dst, b, h) do { _Pragma("unroll") for (int n = 0; n < 2; ++n) _Pragma("unroll") for (int k = 0; k < 2; ++k) dst[n][k] = *(const PG8_LAS bf16x8*)(lds + PG8_SB(b, h) + boff + n * 2048 + k * 1024); } while (0)
#define PG8_MMA(ai, bj, At, Bt) do { __builtin_amdgcn_s_setprio(1); _Pragma("unroll") for (int m = 0; m < 4; ++m) _Pragma("unroll") for (int n = 0; n < 2; ++n) _Pragma("unroll") for (int k = 0; k < 2; ++k) \
        acc[ai][bj][m][n] = __builtin_amdgcn_mfma_f32_16x16x32_bf16(Bt[n][k], At[m][k], acc[ai][bj][m][n], 0, 0, 0); __builtin_amdgcn_s_setprio(0); } while (0)
#define PG8_WAIT_V(n) asm volatile("s_waitcnt vmcnt(" #n ")" ::: "memory")
#define PG8_WAIT_L(n) asm volatile("s_waitcnt lgkmcnt(" #n ")" ::: "memory")
#define PG8_BAR __builtin_amdgcn_s_barrier()
#define PG8_SCHED __builtin_amdgcn_sched_barrier(0)
    Unit cur, nxt; int ui = 0;
    if (!S.next(0, cur)) return;
    f32x4 acc[2][2][4][2];
#pragma unroll
    for (int a = 0; a < 2; ++a)
#pragma unroll
        for (int b = 0; b < 2; ++b)
#pragma unroll
            for (int m = 0; m < 4; ++m)
#pragma unroll
                for (int n = 0; n < 2; ++n) acc[a][b][m][n] = (f32x4){0.f, 0.f, 0.f, 0.f};
    bf16x8 At[4][2], B0[2][2], B1[2][2];
    const char* cA = (const char*)g.A + (size_t)cur.pm * tstep; const char* cB = (const char*)g.Bt + (size_t)cur.pn * tstep;
    S.a_ready(cur);
    PG8_STAGE(PG8_SB(0, 0), cB, voffB); PG8_STAGE(PG8_SA(0, 0), cA, voffA); PG8_STAGE(PG8_SB(0, 1), cB + hstep, voffB); PG8_STAGE(PG8_SA(0, 1), cA + hstep, voffA);
    if (wr == 1) PG8_BAR;
    PG8_WAIT_V(4); PG8_BAR;
    PG8_STAGE(PG8_SB(1, 0), cB + kstep, voffB); PG8_STAGE(PG8_SA(1, 0), cA + kstep, voffA); PG8_STAGE(PG8_SB(1, 1), cB + hstep + kstep, voffB);
    PG8_WAIT_V(6); PG8_BAR;
    PG8_STAMP();
    for (;;) {
        const bool has_next = S.next(ui + 1, nxt);
        const char* nA = has_next ? (const char*)g.A + (size_t)nxt.pm * tstep : cA; const char* nB = has_next ? (const char*)g.Bt + (size_t)nxt.pn * tstep : cB;
        for (int t = 0; t < nt; t += 2) {
            const bool last = (t == nt - 2);
            const char* a1 = cA + (size_t)(t + 1) * kstep;
            const char* a2 = last ? nA : cA + (size_t)(t + 2) * kstep; const char* b2 = last ? nB : cB + (size_t)(t + 2) * kstep;
            const char* a3 = a2 + kstep; const char* b3 = b2 + kstep;
            if (last && has_next) S.a_ready(nxt);
            PG8_LDB(B0, 0, 0); PG8_SCHED; PG8_LDA(At, 0, 0); PG8_STAGE(PG8_SA(1, 1), a1 + hstep, voffA);
            PG8_WAIT_L(8); PG8_BAR; PG8_WAIT_L(0); PG8_MMA(0, 0, At, B0); PG8_BAR; PG8_SCHED;
            PG8_LDB(B1, 0, 1); PG8_STAGE(PG8_SB(0, 0), b2, voffB);
            PG8_BAR; PG8_WAIT_L(0); PG8_MMA(0, 1, At, B1); PG8_BAR;
            PG8_LDA(At, 0, 1); PG8_STAGE(PG8_SA(0, 0), a2, voffA);
            PG8_BAR; PG8_WAIT_L(0); PG8_MMA(1, 0, At, B0); PG8_BAR; PG8_SCHED;
            PG8_STAGE(PG8_SB(0, 1), b2 + hstep, voffB);
            PG8_WAIT_V(6); PG8_BAR; PG8_MMA(1, 1, At, B1); PG8_BAR;
            PG8_LDB(B0, 1, 0); PG8_SCHED; PG8_LDA(At, 1, 0); PG8_STAGE(PG8_SA(0, 1), a2 + hstep, voffA);
            PG8_WAIT_L(8); PG8_BAR; PG8_WAIT_L(0); PG8_MMA(0, 0, At, B0); PG8_BAR; PG8_SCHED;
            PG8_LDB(B1, 1, 1); PG8_STAGE(PG8_SB(1, 0), b3, voffB);
            PG8_BAR; PG8_WAIT_L(0); PG8_MMA(0, 1, At, B1); PG8_BAR;
            PG8_LDA(At, 1, 1); PG8_STAGE(PG8_SA(1, 0), a3, voffA);
            PG8_BAR; PG8_WAIT_L(0); PG8_MMA(1, 0, At, B0); PG8_BAR; PG8_SCHED;
            PG8_STAGE(PG8_SB(1, 1), b3 + hstep, voffB);
            PG8_WAIT_V(6); PG8_BAR; PG8_MMA(1, 1, At, B1); PG8_BAR;
        }
        PG8_STAMP();
        if constexpr (!Epi::AFTER_DRAIN) { E(acc, cur, wr, wc, fr, fq); S.done(cur); }
        PG8_STAMP();
        if (!has_next) break;
#pragma unroll
        for (int a = 0; a < 2; ++a)
#pragma unroll
            for (int b = 0; b < 2; ++b)
#pragma unroll
                for (int m = 0; m < 4; ++m)
#pragma unroll
                    for (int n = 0; n < 2; ++n) acc[a][b][m][n] = (f32x4){0.f, 0.f, 0.f, 0.f};
        cur = nxt; cA = nA; cB = nB; ++ui;
    }
    PG8_WAIT_V(0);
    if (wr == 0) PG8_BAR;
    PG8_BAR;
    if constexpr (Epi::AFTER_DRAIN) { E.fused(acc, cur, wr, wc, fr, fq, lds, wid, lane); S.done(cur); }
    PG8_STAMP();
    if (STAMP && wid == 0) { stamps[lane] = lane < nts ? (((unsigned long long)(unsigned)ts_hi << 32) | (unsigned)ts_lo) : 0ull;
        if (lane == 62) stamps[62] = rt_entry; if (lane == 63) stamps[63] = (unsigned long long)wall_clock64(); }
#undef PG8_STAMP
#undef PG8_SA
#undef PG8_SB
#undef PG8_STAGE
#undef PG8_LDA
#undef PG8_LDB
#undef PG8_MMA
#undef PG8_WAIT_V
#undef PG8_WAIT_L
#undef PG8_BAR
#undef PG8_SCHED
}
}
namespace pg8 {
struct EpiIn {
    static constexpr bool PERM = true, AFTER_DRAIN = false;
    bf16_t* G1; bf16_t* G2;
    __device__ __forceinline__ void operator()(const f32x4 (&acc)[2][2][4][2], const Unit& u, int wr, int wc, int fr, int fq) const {
        const int row0 = u.pm * BM + wr * 64 + fr;
        bf16_t* base; int ldc, colt;
        if (u.pn < 9) { base = G1; ldc = 2304; colt = u.pn * 256; } else { base = G2; ldc = 512; colt = (u.pn - 9) * 256; }
        const int col0 = colt + wc * 32 + 8 * fq;
#pragma unroll
        for (int ai = 0; ai < 2; ++ai)
#pragma unroll
            for (int m = 0; m < 4; ++m) { bf16_t* rowp = base + (size_t)(row0 + ai * HALF + m * 16) * ldc + col0;
#pragma unroll
                for (int bj = 0; bj < 2; ++bj) { const f32x4 v0 = acc[ai][bj][m][0], v1 = acc[ai][bj][m][1];
                    u32x4 w; w.x = cvt_pk_bf16(v0[0], v0[1]); w.y = cvt_pk_bf16(v0[2], v0[3]); w.z = cvt_pk_bf16(v1[0], v1[1]); w.w = cvt_pk_bf16(v1[2], v1[3]);
                    *(u32x4*)(rowp + bj * HALF) = w; } }
    }
};
struct EpiOut {
    static constexpr bool PERM = false, AFTER_DRAIN = false;
    const float* xp; const float* xs; const float* xo; float* out; const float* mod; int layer;
    __device__ __forceinline__ void operator()(const f32x4 (&acc)[2][2][4][2], const Unit& u, int wr, int wc, int fr, int fq) const {
        const int row0 = u.pm * BM + wr * 64 + fr, col0 = u.pn * BM + wc * 32 + 4 * fq;
        const int rt = u.pm * BM; const int modrow = rt < 8192 ? 0 : 1 + ((rt - 8192) >> 11);
        const float* gp = mod + (size_t)modrow * 3072 + 2048 + col0;
        f32x4 gv[2][2];
#pragma unroll
        for (int bj = 0; bj < 2; ++bj)
#pragma unroll
            for (int n = 0; n < 2; ++n) gv[bj][n] = *(const f32x4*)(gp + bj * HALF + n * 16);
#pragma unroll
        for (int ai = 0; ai < 2; ++ai)
#pragma unroll
            for (int m = 0; m < 4; ++m) { const int row = row0 + ai * HALF + m * 16;
                const float* xr = (layer == 0 ? (row < 8192 ? xp + (size_t)row * 1024 : xs + (size_t)(row - 8192) * 1024) : xo + (size_t)row * 1024) + col0;
                float* orow = out + (size_t)row * 1024 + col0;
#pragma unroll
                for (int bj = 0; bj < 2; ++bj)
#pragma unroll
                    for (int n = 0; n < 2; ++n) { const f32x4 x = *(const f32x4*)(xr + bj * HALF + n * 16);
                        *(f32x4*)(orow + bj * HALF + n * 16) = x * 1.4142135623730951f + gv[bj][n] * acc[ai][bj][m][n]; } }
    }
};
}

__device__ __forceinline__ void phase_a1_pg8(ArgsP a, LAS unsigned char* lds, int layer) {
    pg8::Gemm g{(const bf16*)(a->ws + WS_U), (const bf16*)(a->ws + WS_WIN) + (size_t)layer * NIN * 1024, T, NIN, 1024};
    pg8::StaticOrder S; S.init(T, NIN, grid_(), bid_());
    pg8::EpiIn E{(bf16*)(a->ws + WS_G1), (bf16*)(a->ws + WS_G2)};
    pg8::gemm_phase<pg8::EpiIn, pg8::StaticOrder, false>(lds, g, S, E, nullptr);
}
__device__ __forceinline__ void phase_c2_pg8(ArgsP a, LAS unsigned char* lds, int layer) {
    pg8::Gemm g{(const bf16*)(a->ws + WS_YMIX), (const bf16*)(a->ws + WS_WOUT) + (size_t)layer * 1024 * 1024, T, 1024, 1024};
    pg8::StaticOrder S; S.init(T, 1024, grid_(), bid_());
    pg8::EpiOut E{a->in[I_XP], a->in[I_XS], a->out, a->out, (const float*)(a->ws + WS_MOD) + (size_t)layer * 9 * 3072, layer};
    pg8::gemm_phase<pg8::EpiOut, pg8::StaticOrder, false>(lds, g, S, E, nullptr);
}
__device__ __forceinline__ void rwkv_unit_seq(ArgsP a, LAS unsigned char* lds, int layer, int u) {
    const int tid = tid_();
    LAS float* W2s = (LAS float*)lds;
    LAS float* A2s = W2s + 4096;
    LAS float* TH = A2s + 4096;
    LAS float* HA = TH + 2048;
    LAS float* Wd = HA + 2048;
    LAS float* KT = Wd + 2048; LAS float* KK = KT + 2048; LAS float* BB = KK + 2048; LAS float* RR = BB + 2048; LAS float* VV = RR + 2048; LAS float* YO = VV + 2048;
    const int lat = u < 64, uu = lat ? u : u - 64, b = uu >> 3, e = (uu >> 2) & 1, hh = uu & 3;
    const int L = lat ? L_LAT : L_CTX, tok0 = lat ? T_CTX + b * L_LAT : b * L_CTX;
    const bf16* G1 = (const bf16*)(a->ws + WS_G1);
    bf16* YS = (bf16*)(a->ws + WS_G2);
    for (int i = tid; i < 4096; i += NTHREADS) { const int j = i >> 6, c = i & 63;
        W2s[i] = a->in[I_W2][((size_t)(layer * 2 + e) * 64 + j) * 256 + hh * 64 + c];
        A2s[i] = a->in[I_A2][((size_t)(layer * 2 + e) * 64 + j) * 256 + hh * 64 + c]; }
    const int r = tid >> 3, ks = tid & 7;
    float S[8];
#pragma unroll
    for (int j = 0; j < 8; ++j) S[j] = lat ? a->in[I_SRW][(((size_t)((b * 2 + layer) * 2 + e) * 4 + hh) * 64 + r) * 64 + ks * 8 + j] : 0.f;
    const int tt = tid >> 4, q4 = (tid & 15) * 4;
    float w0v[4], a0v[4], kkw[4], kav[4];
#pragma unroll
    for (int i = 0; i < 4; ++i) { const int ch = hh * 64 + q4 + i;
        w0v[i] = a->in[I_W0][(layer * 2 + e) * 256 + ch]; a0v[i] = a->in[I_A0][(layer * 2 + e) * 256 + ch]; kkw[i] = a->in[I_KK][layer * 256 + ch]; kav[i] = a->in[I_KA][layer * 256 + ch]; }
    __syncthreads();
    for (int c = 0; c < L / 32; ++c) {
        const int step = c * 32 + tt, t = e ? L - 1 - step : step, n = tok0 + t;
        const bf16* g = G1 + (size_t)n * G1W;
        { const v2u hw = *(const v2u*)(g + C_LORA + e * 64 + q4), ha = *(const v2u*)(g + C_LORA + 128 + e * 64 + q4);
          TH[tt * 64 + q4 + 0] = tanhf(bflo(hw.x)); TH[tt * 64 + q4 + 1] = tanhf(bfhi(hw.x)); TH[tt * 64 + q4 + 2] = tanhf(bflo(hw.y)); TH[tt * 64 + q4 + 3] = tanhf(bfhi(hw.y));
          HA[tt * 64 + q4 + 0] = bflo(ha.x); HA[tt * 64 + q4 + 1] = bfhi(ha.x); HA[tt * 64 + q4 + 2] = bflo(ha.y); HA[tt * 64 + q4 + 3] = bfhi(ha.y); }
        __syncthreads();
        {
            float wl[4], al[4];
#pragma unroll
            for (int i = 0; i < 4; ++i) { wl[i] = w0v[i]; al[i] = a0v[i]; }
            for (int j = 0; j < 64; ++j) { const float th = TH[tt * 64 + j], hv = HA[tt * 64 + j];
                const f32x4 w2 = *(const LAS f32x4*)(W2s + j * 64 + q4), a2 = *(const LAS f32x4*)(A2s + j * 64 + q4);
                wl[0] = fmaf(th, w2.x, wl[0]); wl[1] = fmaf(th, w2.y, wl[1]); wl[2] = fmaf(th, w2.z, wl[2]); wl[3] = fmaf(th, w2.w, wl[3]);
                al[0] = fmaf(hv, a2.x, al[0]); al[1] = fmaf(hv, a2.y, al[1]); al[2] = fmaf(hv, a2.z, al[2]); al[3] = fmaf(hv, a2.w, al[3]); }
            const v2u kv = *(const v2u*)(g + C_K + hh * 64 + q4), rv = *(const v2u*)(g + C_R + hh * 64 + q4), vv = *(const v2u*)(g + C_V + hh * 64 + q4);
            const float kx[4] = {bflo(kv.x), bfhi(kv.x), bflo(kv.y), bfhi(kv.y)}, rx[4] = {bflo(rv.x), bfhi(rv.x), bflo(rv.y), bfhi(rv.y)}, vx[4] = {bflo(vv.x), bfhi(vv.x), bflo(vv.y), bfhi(vv.y)};
            float kkr[4], ss = 0.f;
#pragma unroll
            for (int i = 0; i < 4; ++i) { kkr[i] = kx[i] * kkw[i]; ss += kkr[i] * kkr[i]; }
            ss += __shfl_xor(ss, 1); ss += __shfl_xor(ss, 2); ss += __shfl_xor(ss, 4); ss += __shfl_xor(ss, 8);
            const float inrm = 1.f / fmaxf(sqrtf(ss), 1e-12f);
#pragma unroll
            for (int i = 0; i < 4; ++i) {
                const float dec = __expf(-0.6065306597126334f * sigmoidf_(wl[i])), av = sigmoidf_(al[i]), kk = kkr[i] * inrm;
                const int o = tt * 64 + q4 + i;
                Wd[o] = dec; KT[o] = kx[i] * (1.f + (av - 1.f) * kav[i]); KK[o] = kk; BB[o] = kk * av; RR[o] = rx[i]; VV[o] = vx[i]; }
        }
        __syncthreads();
        for (int s = 0; s < 32; ++s) {
            const int o = s * 64 + ks * 8;
            const f32x4 k0 = *(const LAS f32x4*)(KK + o), k1 = *(const LAS f32x4*)(KK + o + 4);
            float p = S[0] * k0.x + S[1] * k0.y + S[2] * k0.z + S[3] * k0.w + S[4] * k1.x + S[5] * k1.y + S[6] * k1.z + S[7] * k1.w;
            p += __shfl_xor(p, 1); p += __shfl_xor(p, 2); p += __shfl_xor(p, 4);
            const float sa = -p, vv = VV[s * 64 + r];
            const f32x4 w0 = *(const LAS f32x4*)(Wd + o), w1 = *(const LAS f32x4*)(Wd + o + 4), b0 = *(const LAS f32x4*)(BB + o), b1 = *(const LAS f32x4*)(BB + o + 4);
            const f32x4 t0 = *(const LAS f32x4*)(KT + o), t1 = *(const LAS f32x4*)(KT + o + 4), r0 = *(const LAS f32x4*)(RR + o), r1 = *(const LAS f32x4*)(RR + o + 4);
            S[0] = S[0] * w0.x + sa * b0.x + vv * t0.x; S[1] = S[1] * w0.y + sa * b0.y + vv * t0.y; S[2] = S[2] * w0.z + sa * b0.z + vv * t0.z; S[3] = S[3] * w0.w + sa * b0.w + vv * t0.w;
            S[4] = S[4] * w1.x + sa * b1.x + vv * t1.x; S[5] = S[5] * w1.y + sa * b1.y + vv * t1.y; S[6] = S[6] * w1.z + sa * b1.z + vv * t1.z; S[7] = S[7] * w1.w + sa * b1.w + vv * t1.w;
            float y = S[0] * r0.x + S[1] * r0.y + S[2] * r0.z + S[3] * r0.w + S[4] * r1.x + S[5] * r1.y + S[6] * r1.z + S[7] * r1.w;
            y += __shfl_xor(y, 1); y += __shfl_xor(y, 2); y += __shfl_xor(y, 4);
            if (ks == 0) YO[s * 64 + r] = y;
        }
        __syncthreads();
        { v2u o; o.x = pk2(YO[tt * 64 + q4], YO[tt * 64 + q4 + 1]); o.y = pk2(YO[tt * 64 + q4 + 2], YO[tt * 64 + q4 + 3]);
          *(v2u*)(YS + ((size_t)e * T + n) * 256 + hh * 64 + q4) = o; }
        __syncthreads();
    }
    if (!lat) {
        float* dst = a->out + O_RW + (((size_t)((b * 2 + layer) * 2 + e) * 4 + hh) * 64 + r) * 64 + ks * 8;
        *(f32x4*)dst = (f32x4){S[0], S[1], S[2], S[3]}; *(f32x4*)(dst + 4) = (f32x4){S[4], S[5], S[6], S[7]};
    }
}

__device__ __forceinline__ void lru_unit_seq(ArgsP a, LAS unsigned char* lds, int layer, int u) {
    const int tid = tid_();
    LAS float* WA = (LAS float*)lds;
    LAS float* WX = WA + 4096;
    LAS float* XC = WX + 4096;
    LAS float* AA = XC + 4096; LAS float* BV = AA + 4096; LAS float* HH = BV + 4096;
    const int lat = u < 32, uu = lat ? u : u - 32, b = uu >> 2, g = uu & 3;
    const int L = lat ? L_LAT : L_CTX, tok0 = lat ? T_CTX + b * L_LAT : b * L_CTX;
    const bf16* G1 = (const bf16*)(a->ws + WS_G1);
    bf16* HF = (bf16*)(a->ws + WS_HF);
    const int tt = tid >> 3, q8 = (tid & 7) * 8;
    float cw[4][8], cb[8];
#pragma unroll
    for (int i = 0; i < 8; ++i) { const int ch = g * 64 + q8 + i; cb[i] = a->in[I_CONVB][layer * 256 + ch];
#pragma unroll
        for (int j = 0; j < 4; ++j) cw[j][i] = a->in[I_CONVW][(layer * 4 + j) * 256 + ch]; }
    for (int e = 0; e < 2; ++e) {
        __syncthreads();
        for (int i = tid; i < 4096; i += NTHREADS) { const size_t src = ((size_t)((layer * 2 + e) * 4 + g)) * 4096 + i; WA[i] = a->in[I_WA][src]; WX[i] = a->in[I_WX][src]; }
        float bav[8], bxv[8], spl[8];
#pragma unroll
        for (int i = 0; i < 8; ++i) { const int ch = (layer * 2 + e) * 256 + g * 64 + q8 + i; bav[i] = a->in[I_BA][ch]; bxv[i] = a->in[I_BX][ch]; spl[i] = log1pf(__expf(-a->in[I_LAMBDA][ch])); }
        float h = 0.f;
        if (tid < 64 && lat) h = a->in[I_SLRU][((size_t)(b * 2 + layer) * 2 + e) * 256 + g * 64 + tid];
        __syncthreads();
        for (int cc = 0; cc < L / 64; ++cc) {
            const int c = e ? L / 64 - 1 - cc : cc, t = c * 64 + tt, n = tok0 + t;
            {
                float xc[8];
#pragma unroll
                for (int i = 0; i < 8; ++i) xc[i] = cb[i];
#pragma unroll
                for (int j = 0; j < 4; ++j) { const int ts = t + j - 2;
                    if (ts >= 0 && ts < L) { const v4u x = *(const v4u*)(G1 + (size_t)(tok0 + ts) * G1W + C_XL + g * 64 + q8);
                        xc[0] += cw[j][0] * bflo(x.x); xc[1] += cw[j][1] * bfhi(x.x); xc[2] += cw[j][2] * bflo(x.y); xc[3] += cw[j][3] * bfhi(x.y);
                        xc[4] += cw[j][4] * bflo(x.z); xc[5] += cw[j][5] * bfhi(x.z); xc[6] += cw[j][6] * bflo(x.w); xc[7] += cw[j][7] * bfhi(x.w); } }
#pragma unroll
                for (int i = 0; i < 8; ++i) XC[tt * 64 + q8 + i] = xc[i];
            }
            __syncthreads();
            {
                float gr[8], gi[8];
#pragma unroll
                for (int i = 0; i < 8; ++i) { gr[i] = bav[i]; gi[i] = bxv[i]; }
                for (int i = 0; i < 64; ++i) { const float x = XC[tt * 64 + i];
                    const f32x4 a0 = *(const LAS f32x4*)(WA + i * 64 + q8), a1 = *(const LAS f32x4*)(WA + i * 64 + q8 + 4), x0 = *(const LAS f32x4*)(WX + i * 64 + q8), x1 = *(const LAS f32x4*)(WX + i * 64 + q8 + 4);
                    gr[0] = fmaf(x, a0.x, gr[0]); gr[1] = fmaf(x, a0.y, gr[1]); gr[2] = fmaf(x, a0.z, gr[2]); gr[3] = fmaf(x, a0.w, gr[3]);
                    gr[4] = fmaf(x, a1.x, gr[4]); gr[5] = fmaf(x, a1.y, gr[5]); gr[6] = fmaf(x, a1.z, gr[6]); gr[7] = fmaf(x, a1.w, gr[7]);
                    gi[0] = fmaf(x, x0.x, gi[0]); gi[1] = fmaf(x, x0.y, gi[1]); gi[2] = fmaf(x, x0.z, gi[2]); gi[3] = fmaf(x, x0.w, gi[3]);
                    gi[4] = fmaf(x, x1.x, gi[4]); gi[5] = fmaf(x, x1.y, gi[5]); gi[6] = fmaf(x, x1.z, gi[6]); gi[7] = fmaf(x, x1.w, gi[7]); }
#pragma unroll
                for (int i = 0; i < 8; ++i) { const float la = -8.f * sigmoidf_(gr[i]) * spl[i];
                    AA[tt * 64 + q8 + i] = __expf(la);
                    BV[tt * 64 + q8 + i] = sqrtf(-expm1f(2.f * la)) * sigmoidf_(gi[i]) * XC[tt * 64 + q8 + i]; }
            }
            __syncthreads();
            if (tid < 64) { for (int s = 0; s < 64; ++s) { const int st = e ? 63 - s : s; h = fmaf(AA[st * 64 + tid], h, BV[st * 64 + tid]); HH[st * 64 + tid] = h; } }
            __syncthreads();
            {
                bf16* dst = HF + (size_t)n * 256 + g * 64 + q8;
                float o[8];
#pragma unroll
                for (int i = 0; i < 8; ++i) o[i] = HH[tt * 64 + q8 + i];
                if (e) { const v4u hf = *(const v4u*)dst, gl = *(const v4u*)(G1 + (size_t)n * G1W + C_GL + g * 64 + q8);
                    o[0] = (o[0] + bflo(hf.x)) * siluf_(bflo(gl.x)); o[1] = (o[1] + bfhi(hf.x)) * siluf_(bfhi(gl.x)); o[2] = (o[2] + bflo(hf.y)) * siluf_(bflo(gl.y)); o[3] = (o[3] + bfhi(hf.y)) * siluf_(bfhi(gl.y));
                    o[4] = (o[4] + bflo(hf.z)) * siluf_(bflo(gl.z)); o[5] = (o[5] + bfhi(hf.z)) * siluf_(bfhi(gl.z)); o[6] = (o[6] + bflo(hf.w)) * siluf_(bflo(gl.w)); o[7] = (o[7] + bfhi(hf.w)) * siluf_(bfhi(gl.w)); }
                v4u ov; ov.x = pk2(o[0], o[1]); ov.y = pk2(o[2], o[3]); ov.z = pk2(o[4], o[5]); ov.w = pk2(o[6], o[7]);
                *(v4u*)dst = ov;
            }
            __syncthreads();
        }
        if (tid < 64 && !lat) a->out[O_LRU + ((size_t)(b * 2 + layer) * 2 + e) * 256 + g * 64 + tid] = h;
    }
}

__device__ __forceinline__ void phase_c1(ArgsP a, int layer) {
    const int tid = tid_(), lane = tid & 63, wave = tid >> 6, G = grid_();
    const bf16* G1 = (const bf16*)(a->ws + WS_G1); const bf16* YS = (const bf16*)(a->ws + WS_G2); const bf16* Q = (const bf16*)(a->ws + WS_Q); const bf16* HF = (const bf16*)(a->ws + WS_HF);
    bf16* Y = (bf16*)(a->ws + WS_YMIX);
    const int ch = lane * 4;
    const f32x4 rk = *(const f32x4*)(a->in[I_RK] + layer * 256 + ch), lg = *(const f32x4*)(a->in[I_LNXG] + layer * 256 + ch), lb = *(const f32x4*)(a->in[I_LNXB] + layer * 256 + ch);
    for (int n = bid_() * 8 + wave; n < T; n += G * 8) {
        const bf16* g = G1 + (size_t)n * G1W;
        const v2u y0 = *(const v2u*)(YS + (size_t)n * 256 + ch), y1 = *(const v2u*)(YS + ((size_t)T + n) * 256 + ch);
        float y[4] = {bflo(y0.x) + bflo(y1.x), bfhi(y0.x) + bfhi(y1.x), bflo(y0.y) + bflo(y1.y), bfhi(y0.y) + bfhi(y1.y)};
        const v2u rv = *(const v2u*)(g + C_R + ch), kv = *(const v2u*)(g + C_K + ch), vv = *(const v2u*)(g + C_V + ch), gv = *(const v2u*)(g + C_G + ch);
        float s = (y[0] + y[1]) + (y[2] + y[3]);
        float bon = bflo(rv.x) * bflo(kv.x) * rk.x + bfhi(rv.x) * bfhi(kv.x) * rk.y + bflo(rv.y) * bflo(kv.y) * rk.z + bfhi(rv.y) * bfhi(kv.y) * rk.w;
#pragma unroll
        for (int o = 1; o < 16; o <<= 1) { s += __shfl_xor(s, o); bon += __shfl_xor(bon, o); }
        const float mu = s * (1.f / 64.f);
        float s2 = (y[0] - mu) * (y[0] - mu) + (y[1] - mu) * (y[1] - mu) + (y[2] - mu) * (y[2] - mu) + (y[3] - mu) * (y[3] - mu);
#pragma unroll
        for (int o = 1; o < 16; o <<= 1) s2 += __shfl_xor(s2, o);
        const float rstd = rsqrtf(s2 * (1.f / 64.f) + GN_EPS);
        const float o0 = ((y[0] - mu) * rstd * lg.x + lb.x + bon * bflo(vv.x)) * siluf_(bflo(gv.x));
        const float o1 = ((y[1] - mu) * rstd * lg.y + lb.y + bon * bfhi(vv.x)) * siluf_(bfhi(gv.x));
        const float o2 = ((y[2] - mu) * rstd * lg.z + lb.z + bon * bflo(vv.y)) * siluf_(bflo(gv.y));
        const float o3 = ((y[3] - mu) * rstd * lg.w + lb.w + bon * bfhi(vv.y)) * siluf_(bfhi(gv.y));
        v2u ov; ov.x = pk2(o0, o1); ov.y = pk2(o2, o3);
        bf16* yr = Y + (size_t)n * 1024;
        *(v2u*)(yr + ch) = ov;
        *(v4u*)(yr + 256 + (lane >> 3) * 64 + (lane & 7) * 8) = *(const v4u*)(Q + (size_t)n * 768 + (lane >> 3) * 96 + (lane & 7) * 8);
        *(v2u*)(yr + 768 + ch) = *(const v2u*)(HF + (size_t)n * 256 + ch);
    }
}
typedef float f32x16 __attribute__((ext_vector_type(16)));
typedef float f32x2_t __attribute__((ext_vector_type(2)));
typedef __bf16 bf16x2_t __attribute__((ext_vector_type(2)));
__device__ __forceinline__ unsigned cvtpk(float lo, float hi) { const f32x2_t v = {lo, hi}; return __builtin_bit_cast(unsigned, __builtin_convertvector(v, bf16x2_t)); }
#define MFMA32(a, b, c) __builtin_amdgcn_mfma_f32_32x32x16_bf16((a), (b), (c), 0, 0, 0)
#define MFMA16(a, b, c) __builtin_amdgcn_mfma_f32_16x16x32_bf16((a), (b), (c), 0, 0, 0)

constexpr int ATT_KSTR = 208, ATT_VSTR = 136, ATT_VOFF = 64 * ATT_KSTR, ATT_STAGE = 64 * ATT_KSTR + 64 * ATT_VSTR;
__device__ __forceinline__ void att_unit(ArgsP a, LAS unsigned char* lds, int u) {
    const int tid = tid_(), lane = tid & 63, wave = tid >> 6, r = lane & 31, hq = lane >> 5;
    const bf16* KN = (const bf16*)(a->ws + WS_KN); const bf16* KR = (const bf16*)(a->ws + WS_KR); const bf16* VT = (const bf16*)(a->ws + WS_VT);
    bf16* Q = (bf16*)(a->ws + WS_Q); const bf16* G1 = (const bf16*)(a->ws + WS_G1);
    int b, h, n0, Lk, kidx0; size_t vbase;
    if (u < 512) { b = u >> 6; h = (u >> 3) & 7; n0 = T_CTX + b * 2048 + (u & 7) * 256; Lk = LK_LAT; kidx0 = T_CTX + b * LK_LAT; vbase = (size_t)VT_LAT + (size_t)(b * 8 + h) * 64 * LK_LAT; }
    else { const int uu = u - 512; b = uu >> 3; h = uu & 7; n0 = b * 256; Lk = 256; kidx0 = b * 256; vbase = (size_t)(b * 8 + h) * 64 * 256; }
    const int ntiles = Lk >> 6;
    const int n = n0 + wave * 32 + r;
    bf16x8 qf[6];
#pragma unroll
    for (int ks = 0; ks < 6; ++ks) qf[ks] = *(const bf16x8*)(Q + (size_t)n * 768 + h * 96 + ks * 16 + 8 * hq);
    const int key_k = tid >> 3, ck = tid & 7, key_r = (tid >> 2) & 63, cr = tid & 3;
    const bf16* gk = KN + (size_t)(kidx0 + key_k) * 512 + h * 64 + ck * 8;
    const bf16* gr = KR + (size_t)(kidx0 + key_r) * 32 + cr * 8;
    const bf16* gv = VT + vbase + (size_t)key_k * Lk + ck * 8;
    const unsigned sk = key_k * ATT_KSTR + ck * 16, sr = key_r * ATT_KSTR + 128 + cr * 16, sv = ATT_VOFF + key_k * ATT_VSTR + ck * 16;
    v4u rk, rr, rv;
    rk = *(const v4u*)gk; rr = (tid < 256) ? *(const v4u*)gr : (v4u){0u, 0u, 0u, 0u}; rv = *(const v4u*)gv;
    __syncthreads();
    *(LAS v4u*)(lds + sk) = rk; if (tid < 256) *(LAS v4u*)(lds + sr) = rr;
    *(LAS v2u*)(lds + sv) = (v2u){rv.x, rv.y}; *(LAS v2u*)(lds + sv + 8) = (v2u){rv.z, rv.w};
    __syncthreads();
    f32x16 o0, o1;
#pragma unroll
    for (int i = 0; i < 16; ++i) { o0[i] = 0.f; o1[i] = 0.f; }
    float m = -1e30f, l = 0.f;
    for (int j = 0; j < ntiles; ++j) {
        const int buf = j & 1;
        if (j + 1 < ntiles) { rk = *(const v4u*)(gk + (size_t)(j + 1) * 64 * 512); if (tid < 256) rr = *(const v4u*)(gr + (size_t)(j + 1) * 64 * 32); rv = *(const v4u*)(gv + (j + 1) * 64); }
        const LAS unsigned char* Kb = lds + buf * ATT_STAGE;
        f32x16 s0, s1;
#pragma unroll
        for (int i = 0; i < 16; ++i) { s0[i] = 0.f; s1[i] = 0.f; }
#pragma unroll
        for (int ks = 0; ks < 6; ++ks) {
            const bf16x8 a0 = *(const LAS bf16x8*)(Kb + r * ATT_KSTR + ks * 32 + hq * 16), a1 = *(const LAS bf16x8*)(Kb + (32 + r) * ATT_KSTR + ks * 32 + hq * 16);
            s0 = MFMA32(a0, qf[ks], s0); s1 = MFMA32(a1, qf[ks], s1);
        }
        float mx = s0[0];
#pragma unroll
        for (int i = 1; i < 16; ++i) mx = fmaxf(mx, s0[i]);
#pragma unroll
        for (int i = 0; i < 16; ++i) mx = fmaxf(mx, s1[i]);
        mx = fmaxf(mx, __shfl_xor(mx, 32));
        const float mn = fmaxf(m, mx), alpha = __builtin_amdgcn_exp2f(m - mn); m = mn;
        float ps = 0.f;
#pragma unroll
        for (int i = 0; i < 16; ++i) { s0[i] = __builtin_amdgcn_exp2f(s0[i] - mn); s1[i] = __builtin_amdgcn_exp2f(s1[i] - mn); ps += s0[i] + s1[i]; }
        l = l * alpha + ps;
#pragma unroll
        for (int i = 0; i < 16; ++i) { o0[i] *= alpha; o1[i] *= alpha; }
        const LAS unsigned char* Vb = Kb + ATT_VOFF;
#pragma unroll
        for (int ks = 0; ks < 4; ++ks) {
            v4u pw;
            if (ks == 0) { pw.x = cvtpk(s0[0], s0[1]); pw.y = cvtpk(s0[2], s0[3]); pw.z = cvtpk(s0[4], s0[5]); pw.w = cvtpk(s0[6], s0[7]); }
            else if (ks == 1) { pw.x = cvtpk(s0[8], s0[9]); pw.y = cvtpk(s0[10], s0[11]); pw.z = cvtpk(s0[12], s0[13]); pw.w = cvtpk(s0[14], s0[15]); }
            else if (ks == 2) { pw.x = cvtpk(s1[0], s1[1]); pw.y = cvtpk(s1[2], s1[3]); pw.z = cvtpk(s1[4], s1[5]); pw.w = cvtpk(s1[6], s1[7]); }
            else { pw.x = cvtpk(s1[8], s1[9]); pw.y = cvtpk(s1[10], s1[11]); pw.z = cvtpk(s1[12], s1[13]); pw.w = cvtpk(s1[14], s1[15]); }
            const bf16x8 pf = __builtin_bit_cast(bf16x8, pw);
            const v2u va0 = *(const LAS v2u*)(Vb + r * ATT_VSTR + ks * 32 + hq * 8), va1 = *(const LAS v2u*)(Vb + r * ATT_VSTR + ks * 32 + 16 + hq * 8);
            const v2u vb0 = *(const LAS v2u*)(Vb + (32 + r) * ATT_VSTR + ks * 32 + hq * 8), vb1 = *(const LAS v2u*)(Vb + (32 + r) * ATT_VSTR + ks * 32 + 16 + hq * 8);
            const v4u vwa = {va0.x, va0.y, va1.x, va1.y}, vwb = {vb0.x, vb0.y, vb1.x, vb1.y};
            o0 = MFMA32(__builtin_bit_cast(bf16x8, vwa), pf, o0); o1 = MFMA32(__builtin_bit_cast(bf16x8, vwb), pf, o1);
        }
        if (j + 1 < ntiles) {
            LAS unsigned char* Nb = lds + (buf ^ 1) * ATT_STAGE;
            *(LAS v4u*)(Nb + sk) = rk; if (tid < 256) *(LAS v4u*)(Nb + sr) = rr;
            *(LAS v2u*)(Nb + sv) = (v2u){rv.x, rv.y}; *(LAS v2u*)(Nb + sv + 8) = (v2u){rv.z, rv.w};
        }
        __syncthreads();
    }
    l += __shfl_xor(l, 32);
    const float inv = 1.f / l;
#pragma unroll
    for (int mt = 0; mt < 2; ++mt)
#pragma unroll
        for (int g = 0; g < 4; ++g) {
            const int dv0 = 32 * mt + 8 * g + 4 * hq;
            const v2u gm = *(const v2u*)(G1 + (size_t)n * G1W + C_GM + h * 64 + dv0);
            const float x0 = (mt ? o1[4 * g + 0] : o0[4 * g + 0]) * inv, x1 = (mt ? o1[4 * g + 1] : o0[4 * g + 1]) * inv, x2 = (mt ? o1[4 * g + 2] : o0[4 * g + 2]) * inv, x3 = (mt ? o1[4 * g + 3] : o0[4 * g + 3]) * inv;
            v2u ov; ov.x = cvtpk(x0 * siluf_(bflo(gm.x)), x1 * siluf_(bfhi(gm.x))); ov.y = cvtpk(x2 * siluf_(bflo(gm.y)), x3 * siluf_(bfhi(gm.y)));
            *(v2u*)(Q + (size_t)n * 768 + h * 96 + dv0) = ov;
        }
}

constexpr int A2_QSTR = 528, A2_KVSTR = 272, A2_KVOFF = 64 * A2_QSTR;
__device__ __forceinline__ void a2_unit(ArgsP a, LAS unsigned char* lds, int layer, int unit) {
    const int tid = tid_(), lane = tid & 63, wave = tid >> 6, tn = lane & 15, g = lane >> 4;
    constexpr int NU_TOK = T / 64;
    const bool is_tok = unit < NU_TOK;
    const bf16* G2 = (const bf16*)(a->ws + WS_G2);
    bf16* Q = (bf16*)(a->ws + WS_Q); bf16* KN = (bf16*)(a->ws + WS_KN); bf16* KR = (bf16*)(a->ws + WS_KR); bf16* VT = (bf16*)(a->ws + WS_VT);
    const bf16* WUQ = (const bf16*)(a->ws + WS_WUQ) + (size_t)layer * 768 * 256;
    const bf16* WUKV = (const bf16*)(a->ws + WS_WUKV) + (size_t)layer * 1024 * 128;
    const float* ROPE1 = (const float*)(a->ws + WS_ROPE);
    __syncthreads();
    for (int rr = 0; rr < 8; ++rr) {
        const int r = wave * 8 + rr;
        if (is_tok) {
            const int n = unit * 64 + r; const Tok tk = tok_of(n);
            const v2u cqv = *(const v2u*)(G2 + (size_t)n * G2W + lane * 4);
            const float c0 = bflo(cqv.x), c1 = bfhi(cqv.x), c2 = bflo(cqv.y), c3 = bfhi(cqv.y);
            const float rq = rsqrtf(wave_sum(c0 * c0 + c1 * c1 + c2 * c2 + c3 * c3) * (1.f / 256.f) + 1e-6f);
            const f32x4 qn = *(const f32x4*)(a->in[I_QNORM] + layer * 256 + lane * 4);
            *(LAS v2u*)(lds + r * A2_QSTR + lane * 8) = (v2u){cvtpk(c0 * rq * qn.x, c1 * rq * qn.y), cvtpk(c2 * rq * qn.z, c3 * rq * qn.w)};
            float k0 = 0.f, k1 = 0.f, k2 = 0.f, k3 = 0.f;
            if (lane < 32) { const v2u kv = *(const v2u*)(G2 + (size_t)n * G2W + 256 + lane * 4); k0 = bflo(kv.x); k1 = bfhi(kv.x); k2 = bflo(kv.y); k3 = bfhi(kv.y); }
            const float rk = rsqrtf(wave_sum(k0 * k0 + k1 * k1 + k2 * k2 + k3 * k3) * (1.f / 128.f) + 1e-6f);
            if (lane < 32) {
                const f32x4 kn = *(const f32x4*)(a->in[I_KVNORM] + layer * 128 + lane * 4);
                f32x4 o; o.x = k0 * rk * kn.x; o.y = k1 * rk * kn.y; o.z = k2 * rk * kn.z; o.w = k3 * rk * kn.w;
                if (!tk.lat) *(f32x4*)(a->out + O_CKV + ((size_t)(tk.b * 2 + layer) * 256 + tk.t) * 128 + lane * 4) = o;
                *(LAS v2u*)(lds + A2_KVOFF + r * A2_KVSTR + lane * 8) = (v2u){cvtpk(o.x, o.y), cvtpk(o.z, o.w)};
            }
            float krv = (lane < 32) ? bf2f(G2[(size_t)n * G2W + 384 + lane]) : 0.f;
            const float other = __shfl_xor(krv, 1);
            if (lane < 32) {
                if (!tk.lat) a->out[O_KR + ((size_t)(tk.b * 2 + layer) * 256 + tk.t) * 32 + lane] = krv;
                else { const float c = ROPE1[((size_t)tk.t * 16 + (lane >> 1)) * 2], s = ROPE1[((size_t)tk.t * 16 + (lane >> 1)) * 2 + 1]; krv = (lane & 1) ? (other * s + krv * c) : (krv * c - other * s); }
                KR[(size_t)tk.kidx * 32 + lane] = (bf16)f2bf(krv);
            }
        } else {
            const int cr = (unit - NU_TOK) * 64 + r, b = cr >> 8, j = cr & 255;
            const size_t src = ((size_t)(b * 2 + layer) * 256 + j);
            if (lane < 32) { const f32x4 v = *(const f32x4*)(a->in[I_CCKV] + src * 128 + lane * 4);
                *(LAS v2u*)(lds + A2_KVOFF + r * A2_KVSTR + lane * 8) = (v2u){cvtpk(v.x, v.y), cvtpk(v.z, v.w)};
                KR[(size_t)(T_CTX + b * LK_LAT + j) * 32 + lane] = (bf16)f2bf(a->in[I_CKR][src * 32 + lane]); }
        }
    }
    __syncthreads();
    if (is_tok) {
      const float* ROPE = (const float*)(a->ws + WS_ROPE);
      for (int qh = 0; qh < 2; ++qh) {
        f32x4 acc[3][4];
#pragma unroll
        for (int f = 0; f < 3; ++f)
#pragma unroll
            for (int t = 0; t < 4; ++t) acc[f][t] = (f32x4){0.f, 0.f, 0.f, 0.f};
#pragma unroll 2
        for (int ks = 0; ks < 8; ++ks) {
            bf16x8 bfr[4];
#pragma unroll
            for (int t = 0; t < 4; ++t) bfr[t] = *(const LAS bf16x8*)(lds + (t * 16 + tn) * A2_QSTR + ks * 64 + g * 16);
#pragma unroll
            for (int f = 0; f < 3; ++f) { const bf16x8 af = *(const bf16x8*)(WUQ + (size_t)((wave * 6 + qh * 3 + f) * 16 + tn) * 256 + ks * 32 + g * 8);
#pragma unroll
                for (int t = 0; t < 4; ++t) acc[f][t] = MFMA16(af, bfr[t], acc[f][t]); }
        }
#pragma unroll
        for (int f = 0; f < 3; ++f) { const int f0 = (wave * 6 + qh * 3 + f) * 16 + 4 * g, d = f0 % 96;
#pragma unroll
            for (int t = 0; t < 4; ++t) { const int n = unit * 64 + t * 16 + tn;
                float v0 = acc[f][t][0], v1 = acc[f][t][1], v2 = acc[f][t][2], v3 = acc[f][t][3];
                if (n >= T_CTX && d >= 64) { const int tt = (n - T_CTX) & 2047; const f32x4 cs = *(const f32x4*)(ROPE + ((size_t)tt * 16 + ((d - 64) >> 1)) * 2);
                    const float y0 = v0 * cs.x - v1 * cs.y, y1 = v0 * cs.y + v1 * cs.x, y2 = v2 * cs.z - v3 * cs.w, y3 = v2 * cs.w + v3 * cs.z; v0 = y0; v1 = y1; v2 = y2; v3 = y3; }
                *(v2u*)(Q + (size_t)n * 768 + f0) = (v2u){cvtpk(v0, v1), cvtpk(v2, v3)}; } }
      }
    }
    for (int half = 0; half < 2; ++half) {
        f32x4 acc[4][4];
#pragma unroll
        for (int f = 0; f < 4; ++f)
#pragma unroll
            for (int t = 0; t < 4; ++t) acc[f][t] = (f32x4){0.f, 0.f, 0.f, 0.f};
#pragma unroll 2
        for (int ks = 0; ks < 4; ++ks) {
            bf16x8 bfr[4];
#pragma unroll
            for (int t = 0; t < 4; ++t) bfr[t] = *(const LAS bf16x8*)(lds + A2_KVOFF + (t * 16 + tn) * A2_KVSTR + ks * 64 + g * 16);
#pragma unroll
            for (int f = 0; f < 4; ++f) { const bf16x8 af = *(const bf16x8*)(WUKV + (size_t)((wave * 8 + half * 4 + f) * 16 + tn) * 128 + ks * 32 + g * 8);
#pragma unroll
                for (int t = 0; t < 4; ++t) acc[f][t] = MFMA16(af, bfr[t], acc[f][t]); }
        }
#pragma unroll
        for (int f = 0; f < 4; ++f) { const int f0 = (wave * 8 + half * 4 + f) * 16 + 4 * g, h = f0 >> 7, x = f0 & 127;
#pragma unroll
            for (int t = 0; t < 4; ++t) { const int r = t * 16 + tn;
                int kidx, lat, b, kpos;
                if (is_tok) { const Tok tk = tok_of(unit * 64 + r); kidx = tk.kidx; lat = tk.lat; b = tk.b; kpos = tk.lat ? PAST + tk.t : tk.t; }
                else { const int cr = (unit - NU_TOK) * 64 + r; b = cr >> 8; kpos = cr & 255; lat = 1; kidx = T_CTX + b * LK_LAT + kpos; }
                if (x < 64) *(v2u*)(KN + (size_t)kidx * 512 + h * 64 + x) = (v2u){cvtpk(acc[f][t][0], acc[f][t][1]), cvtpk(acc[f][t][2], acc[f][t][3])};
                else {
                    const size_t base = lat ? (size_t)VT_LAT + ((size_t)(b * 8 + h) * 64 + (x - 64)) * LK_LAT + kpos : ((size_t)(b * 8 + h) * 64 + (x - 64)) * 256 + kpos;
                    const int Lk = lat ? LK_LAT : 256;
                    VT[base] = (bf16)f2bf(acc[f][t][0]); VT[base + Lk] = (bf16)f2bf(acc[f][t][1]); VT[base + 2 * Lk] = (bf16)f2bf(acc[f][t][2]); VT[base + 3 * Lk] = (bf16)f2bf(acc[f][t][3]);
                } } }
    }
}
constexpr int N_PHASES = 14;
#ifndef MK_PER_PHASE
#define MK_PER_PHASE 0
#endif
#ifndef VAR_GEMM
#define VAR_GEMM 1
#endif
#ifndef VAR_A2
#define VAR_A2 1
#endif
#ifndef VAR_ATT
#define VAR_ATT 1
#endif
#ifndef VAR_RWKV
#define VAR_RWKV 1
#endif
#ifndef VAR_LRU
#define VAR_LRU 1
#endif

__device__ __forceinline__ void phase_b(ArgsP a, LAS unsigned char* lds, int layer) {
    const int G = grid_();
    for (int u = bid_(); u < 320; u += G) { __syncthreads(); rwkv_unit_seq(a, lds, layer, u); }
    for (int u = G - 1 - bid_(); u < 160; u += G) { __syncthreads(); lru_unit_seq(a, lds, layer, u); }
    for (int u = bid_(); u < 768; u += G) att_unit(a, lds, u);
}

#if MK_PER_PHASE
template <int SUB> __global__ void __launch_bounds__(NTHREADS, 2) mk_phase(Args args, int layer) {
    extern __shared__ __attribute__((aligned(16))) unsigned char lds_raw[];
    LAS unsigned char* lds = (LAS unsigned char*)lds_raw;
    ArgsP a = (ArgsP)__builtin_amdgcn_kernarg_segment_ptr();
    if (SUB == 0) phase_p0(a, lds);
    if (SUB == 1) phase_a0(a, layer);
    if (SUB == 2) { if (VAR_GEMM) phase_a1_pg8(a, lds, layer); else phase_a1_naive(a, layer); }
    if (SUB == 3) { if (VAR_A2) { for (int u = blockIdx.x; u < T / 64 + 32; u += gridDim.x) a2_unit(a, lds, layer, u); } else phase_a2_naive(a, lds, layer); }
    if (SUB == 4) { if (VAR_ATT) { for (int u = blockIdx.x; u < 768; u += gridDim.x) att_unit(a, lds, u); } else phase_att_naive(a); }
    if (SUB == 5) { for (int u = blockIdx.x; u < 320; u += gridDim.x) { __syncthreads(); rwkv_unit_seq(a, lds, layer, u); } }
    if (SUB == 6) { for (int u = blockIdx.x; u < 160; u += gridDim.x) { __syncthreads(); lru_unit_seq(a, lds, layer, u); } }
    if (SUB == 7) phase_c1(a, layer);
    if (SUB == 8) { if (VAR_GEMM) phase_c2_pg8(a, lds, layer); else phase_c2_naive(a, layer); }
    if (SUB == 9) phase_final(a);
}
#else
#define ARGS_VIEW() ({ ArgsP p_ = (ArgsP)__builtin_amdgcn_kernarg_segment_ptr(); asm volatile("" : "+s"(p_)); p_; })
__global__ void __launch_bounds__(NTHREADS, 2) mk_fwd(Args args) {
    extern __shared__ __attribute__((aligned(16))) unsigned char lds_raw[];
    LAS unsigned char* lds = (LAS unsigned char*)lds_raw;
    volatile LAS unsigned* MISC = (volatile LAS unsigned*)(lds + LDS_MISC);
    for (int u = threadIdx.x; u < 64; u += NTHREADS) MISC[u] = 0u;
    __syncthreads();
    XcdBarrier bar;
    { ArgsP a = ARGS_VIEW(); bar = xcd_barrier_post((unsigned*)(a->ws + WS_CTL) + CW_BAR, MISC + 8); }
    int lo, hi; { ArgsP a = ARGS_VIEW(); lo = a->ph_lo; hi = a->ph_hi; }
#define IN(k) (lo <= (k) && (k) < hi)
#define SEAM(k) do { if (IN(k) && IN((k) + 1)) xcd_barrier(bar); } while (0)
#ifndef NO_P0
    if (IN(0)) { ArgsP a = ARGS_VIEW(); phase_p0(a, lds); }
#endif
    SEAM(0);
    for (int layer = 0; layer < 2; ++layer) {
        const int p = 1 + 6 * layer;
#ifndef NO_A0
        if (IN(p + 0)) { ArgsP a = ARGS_VIEW(); phase_a0(a, layer); }
#endif
        SEAM(p + 0);
#ifndef NO_A1
        if (IN(p + 1)) { ArgsP a = ARGS_VIEW(); phase_a1_pg8(a, lds, layer); }
#endif
        SEAM(p + 1);
#ifndef NO_A2
        if (IN(p + 2)) { ArgsP a = ARGS_VIEW(); for (int u = bid_(); u < T / 64 + 32; u += grid_()) a2_unit(a, lds, layer, u); }
#endif
        SEAM(p + 2);
#ifndef NO_B
        if (IN(p + 3)) { ArgsP a = ARGS_VIEW(); phase_b(a, lds, layer); }
#endif
        SEAM(p + 3);
#ifndef NO_C1
        if (IN(p + 4)) { ArgsP a = ARGS_VIEW(); phase_c1(a, layer); }
#endif
        SEAM(p + 4);
#ifndef NO_C2
        if (IN(p + 5)) { ArgsP a = ARGS_VIEW(); phase_c2_pg8(a, lds, layer); }
#endif
        SEAM(p + 5);
    }
    if (IN(N_PHASES - 1)) { ArgsP a = ARGS_VIEW(); phase_final(a); }
#undef IN
#undef SEAM
}

#endif

extern "C" void kernel_launch(void* const* d_in, const int* in_sizes, int n_in, void* d_out, int out_size, void* d_ws, size_t ws_size, hipStream_t stream) {
    static int grid = 0;
    if (grid == 0) {
        if (n_in != N_IN || ws_size < WS_END) { fprintf(stderr, "kernel_launch: unexpected n_in %d / ws_size %zu\n", n_in, ws_size); grid = -1; return; }
        int dev = 0, cus = 0;
        if (hipGetDevice(&dev) != hipSuccess || hipDeviceGetAttribute(&cus, hipDeviceAttributeMultiprocessorCount, dev) != hipSuccess) { grid = -1; return; }
#if MK_PER_PHASE
#define SA(SUB) if (hipFuncSetAttribute((const void*)mk_phase<SUB>, hipFuncAttributeMaxDynamicSharedMemorySize, LDS_BYTES) != hipSuccess) { fprintf(stderr, "kernel_launch: hipFuncSetAttribute failed\n"); grid = -1; return; }
        SA(0) SA(1) SA(2) SA(3) SA(4) SA(5) SA(6) SA(7) SA(8) SA(9)
#undef SA
#else
        if (hipFuncSetAttribute((const void*)mk_fwd, hipFuncAttributeMaxDynamicSharedMemorySize, LDS_BYTES) != hipSuccess) { fprintf(stderr, "kernel_launch: hipFuncSetAttribute failed\n"); grid = -1; return; }
        int per_cu = 0;
        if (hipOccupancyMaxActiveBlocksPerMultiprocessor(&per_cu, (const void*)mk_fwd, NTHREADS, LDS_BYTES) != hipSuccess || per_cu < 1) fprintf(stderr, "kernel_launch: occupancy query reports %d\n", per_cu);
        (void)hipGetLastError();
#endif
        grid = cus;
    }
    if (grid < 0) return;
    if (hipMemsetAsync((char*)d_ws + WS_CTL, 0, CTL_ZERO_BYTES, stream) != hipSuccess) return;
    Args a{};
    for (int i = 0; i < N_IN; ++i) a.in[i] = (const float*)d_in[i];
    a.out = (float*)d_out; a.ws = (unsigned char*)d_ws;
#if MK_PER_PHASE
#define LP(SUB, layer) hipLaunchKernelGGL(mk_phase<SUB>, dim3(grid), dim3(NTHREADS), LDS_BYTES, stream, a, layer)
    LP(0, 0);
    for (int layer = 0; layer < 2; ++layer) { LP(1, layer); LP(2, layer); LP(3, layer); LP(4, layer); LP(5, layer); LP(6, layer); LP(7, layer); LP(8, layer); }
    LP(9, 0);
#undef LP
#else
    a.ph_lo = 0; a.ph_hi = N_PHASES;
    hipLaunchKernelGGL(mk_fwd, dim3(grid), dim3(NTHREADS), LDS_BYTES, stream, a);
#endif
}
```

```cpp
#define MK_PER_PHASE 0
#include <hip/hip_runtime.h>
#include <cstdio>
#include <cstdint>

#define GAS __attribute__((address_space(1)))
#define LAS __attribute__((address_space(3)))
typedef unsigned short bf16;
typedef unsigned v4u __attribute__((ext_vector_type(4)));
typedef unsigned v2u __attribute__((ext_vector_type(2)));
typedef float f32x4 __attribute__((ext_vector_type(4)));
typedef short bf16x8 __attribute__((ext_vector_type(8)));

constexpr int D = 1024, T_CTX = 8192, T_LAT = 16384, T = 24576, L_CTX = 256, L_LAT = 2048, PAST = 256;
constexpr int NIN = 2816, G1W = 2304, G2W = 512;
constexpr int C_R = 0, C_K = 256, C_V = 512, C_G = 768, C_GM = 1024, C_XL = 1536, C_GL = 1792, C_LORA = 2048;
constexpr int LK_LAT = PAST + L_LAT;
constexpr int TK = T_CTX + 8 * LK_LAT;
constexpr int VT_LAT = 32 * 8 * 64 * 256;
constexpr float LN_EPS = 1e-5f, GN_EPS = 64e-5f;
constexpr float ALPHA = 1.4142135623730951f;
constexpr float QSCALE = 0.10206207261596575f * 1.4426950408889634f;
constexpr size_t O_Y = 0, O_RW = 25165824, O_CKV = 27262976, O_KR = 29360128, O_LRU = 29884416;
constexpr size_t MiB = 1u << 20;
constexpr size_t WS_CTL = 0, CTL_ZERO_BYTES = 1 * MiB;
constexpr size_t WS_MOD = 256 * 1024;
constexpr size_t WS_ROPE = 1 * MiB;
constexpr size_t WS_WUQ = 2 * MiB;
constexpr size_t WS_WUKV = 3 * MiB;
constexpr size_t WS_WIN = 4 * MiB;
constexpr size_t WS_WOUT = 16 * MiB;
constexpr size_t WS_G1 = 20 * MiB;
constexpr size_t WS_G2 = 128 * MiB;
constexpr size_t WS_Q = 152 * MiB;
constexpr size_t WS_U = 152 * MiB;
constexpr size_t WS_KN = 188 * MiB;
constexpr size_t WS_KR = 214 * MiB;
constexpr size_t WS_VT = 216 * MiB;
constexpr size_t WS_YMIX = 188 * MiB;
constexpr size_t WS_HF = 242 * MiB;
constexpr size_t WS_END = 254 * MiB;
constexpr int CW_BAR = 4096;
constexpr int CW_Q = 16384;

__device__ __forceinline__ float bf2f(unsigned b) { return __uint_as_float(b << 16); }
__device__ __forceinline__ float bflo(unsigned w) { return __uint_as_float(w << 16); }
__device__ __forceinline__ float bfhi(unsigned w) { return __uint_as_float(w & 0xffff0000u); }
__device__ __forceinline__ unsigned f2bf(float f) { unsigned u = __float_as_uint(f); return (u + 0x7fffu + ((u >> 16) & 1u)) >> 16; }
__device__ __forceinline__ unsigned pk2(float lo, float hi) { return f2bf(lo) | (f2bf(hi) << 16); }
__device__ __forceinline__ float sigmoidf_(float x) { return 1.f / (1.f + __expf(-x)); }
__device__ __forceinline__ float siluf_(float x) { return x / (1.f + __expf(-x)); }
__device__ __forceinline__ float wave_sum(float v) {
#pragma unroll
    for (int o = 1; o < 64; o <<= 1) v += __shfl_xor(v, o);
    return v;
}
__device__ __forceinline__ int tid_() { int t = threadIdx.x; asm volatile("" : "+v"(t)); return t; }
__device__ __forceinline__ int bid_() { int b = blockIdx.x; asm volatile("" : "+s"(b)); return b; }
__device__ __forceinline__ int grid_() { int g = gridDim.x; asm volatile("" : "+s"(g)); return g; }
#define XB_TMO      128
#define XB_XCNT(j)  (256  + 64 * (j))
#define XB_XSUB(j)  (1280 + 64 * (j))
#define XB_XGEN(j)  (2304 + 64 * (j))
#define XB_TOP      3328
#define XB_TOPGEN   3392
#define XCD_BAR_WORDS 3456
#define XB_SPIN_CAP (1u << 24)

__device__ __forceinline__ unsigned xb_ld(unsigned* p)              { return __hip_atomic_load(p, __ATOMIC_RELAXED, __HIP_MEMORY_SCOPE_AGENT); }
__device__ __forceinline__ unsigned xb_add(unsigned* p, unsigned v) { return __hip_atomic_fetch_add(p, v, __ATOMIC_RELAXED, __HIP_MEMORY_SCOPE_AGENT); }
__device__ __forceinline__ unsigned xb_xcc_id() { return (unsigned)__builtin_amdgcn_s_getreg((3 << 11) | 20) & 0xFu; }
#define XB_SPIN(cond, bar) do { unsigned _sp = 0; while (cond) { __builtin_amdgcn_s_sleep(1); \
    if ((++_sp & 255u) == 0u) { if (xb_ld(&(bar)[XB_TMO])) break; if (_sp > XB_SPIN_CAP) { atomicAdd(&(bar)[XB_TMO], 1u); break; } } } } while (0)

struct XcdBarrier {
    unsigned* bar; unsigned x;
    volatile LAS unsigned* st;
};

__device__ __forceinline__ XcdBarrier xcd_barrier_post(unsigned* bar, volatile LAS unsigned* st) {
    XcdBarrier b; b.bar = bar; b.x = xb_xcc_id(); b.st = st;
    if (threadIdx.x == 0) (void)xb_add(&bar[XB_XCNT(b.x)], 1u);
    return b;
}
__device__ __forceinline__ void xcd_barrier_complete(unsigned* bar, unsigned x, unsigned& nloc, unsigned& nx) {
    const unsigned G = gridDim.x * gridDim.y * gridDim.z;
    unsigned sum, cnt, mine, sp = 0u;
    for (;;) {
        sum = 0u; cnt = 0u; mine = 0u;
#pragma unroll
        for (unsigned j = 0; j < 16; ++j) { const unsigned c = xb_ld(&bar[XB_XCNT(j)]); sum += c; cnt += (c > 0u) ? 1u : 0u; mine = (j == x) ? c : mine; }
        if (sum == G) break;
        __builtin_amdgcn_s_sleep(1);
        if ((++sp & 255u) == 0u) { if (xb_ld(&bar[XB_TMO])) break; if (sp > XB_SPIN_CAP) { atomicAdd(&bar[XB_TMO], 1u); break; } }
    }
    nloc = mine > 0u ? mine : 1u; nx = cnt > 0u ? cnt : 1u;
}

__device__ __forceinline__ void xcd_barrier(const XcdBarrier& b) {
    asm volatile("s_waitcnt vmcnt(0)" ::: "memory");
    __syncthreads();
    if (threadIdx.x == 0) {
        unsigned* bar = b.bar;
        __builtin_amdgcn_s_waitcnt(0);
        unsigned nloc = b.st[0], nx = b.st[1];
        if (nloc == 0u) { xcd_barrier_complete(bar, b.x, nloc, nx); b.st[0] = nloc; b.st[1] = nx; }
        const unsigned old = xb_add(&bar[XB_XSUB(b.x)], 1u);
        const unsigned gen = old / nloc;
        if (old + 1u == (gen + 1u) * nloc) {
            __builtin_amdgcn_fence(__ATOMIC_RELEASE, "agent");
            asm volatile("s_waitcnt vmcnt(0)" ::: "memory");
            const unsigned og = xb_add(&bar[XB_TOP], 1u);
            const unsigned tg = og / nx;
            if (og + 1u == (tg + 1u) * nx) xb_add(&bar[XB_TOPGEN], 1u);
            else XB_SPIN(xb_ld(&bar[XB_TOPGEN]) == tg, bar);
            __builtin_amdgcn_fence(__ATOMIC_ACQUIRE, "agent");
            xb_add(&bar[XB_XGEN(b.x)], 1u);
            asm volatile("s_waitcnt vmcnt(0)" ::: "memory");
        } else {
            XB_SPIN(xb_ld(&bar[XB_XGEN(b.x)]) == gen, bar);
            __builtin_amdgcn_fence(__ATOMIC_ACQUIRE, "agent");
            asm volatile("s_waitcnt vmcnt(0)" ::: "memory");
        }
    }
    __syncthreads();
}
enum { I_XP = 0, I_XS, I_SRW, I_CCKV, I_CKR, I_SLRU, I_C, I_CCTX, I_WMOD, I_BMOD, I_WIN, I_W0, I_W1, I_W2, I_A0, I_A1, I_A2, I_KK, I_KA, I_RK,
       I_LNXG, I_LNXB, I_QNORM, I_WUQ, I_KVNORM, I_WUKV, I_CONVW, I_CONVB, I_WA, I_BA, I_WX, I_BX, I_LAMBDA, I_WOUT, I_LNG, I_LNB, N_IN };
struct Args { const float* in[N_IN]; float* out; unsigned char* ws; int ph_lo, ph_hi; };
typedef const Args __attribute__((address_space(4)))* ArgsP;
constexpr int NTHREADS = 512;
constexpr int LDS_MISC = 139264;
constexpr int LDS_BYTES = 147456;

struct Tok { int n, b, t, L, lat, modrow, tok0, kidx; };
__device__ __forceinline__ Tok tok_of(int n) {
    Tok k; k.n = n;
    if (n < T_CTX) { k.lat = 0; k.b = n >> 8; k.t = n & 255; k.L = L_CTX; k.modrow = 0; k.tok0 = k.b * 256; k.kidx = n; }
    else { const int m = n - T_CTX; k.lat = 1; k.b = m >> 11; k.t = m & 2047; k.L = L_LAT; k.modrow = 1 + k.b; k.tok0 = T_CTX + k.b * 2048; k.kidx = T_CTX + k.b * LK_LAT + PAST + k.t; }
    return k;
}
__device__ __forceinline__ const float* xrow_src(ArgsP a, int layer, int n) {
    if (layer == 0) return n < T_CTX ? a->in[I_XP] + (size_t)n * D : a->in[I_XS] + (size_t)(n - T_CTX) * D;
    return a->out + (size_t)n * D;
}
__device__ __forceinline__ float dot8(v4u a, v4u b, float acc) {
    acc = fmaf(bflo(a.x), bflo(b.x), acc); acc = fmaf(bfhi(a.x), bfhi(b.x), acc);
    acc = fmaf(bflo(a.y), bflo(b.y), acc); acc = fmaf(bfhi(a.y), bfhi(b.y), acc);
    acc = fmaf(bflo(a.z), bflo(b.z), acc); acc = fmaf(bfhi(a.z), bfhi(b.z), acc);
    acc = fmaf(bflo(a.w), bflo(b.w), acc); acc = fmaf(bfhi(a.w), bfhi(b.w), acc);
    return acc;
}

__device__ __forceinline__ void tr_item(const float* src, int ld, int col0, int k0, bf16* WT, int K, int row0, float scale, LAS float* scr, int lane) {
#pragma unroll 8
    for (int i = 0; i < 32; ++i) { const int kk = 2 * i + (lane >> 5); scr[kk * 33 + (lane & 31)] = src ? src[(size_t)(k0 + kk) * ld + col0 + (lane & 31)] * scale : 0.f; }
    asm volatile("s_waitcnt lgkmcnt(0)" ::: "memory");
    const int c = lane & 7;
#pragma unroll
    for (int j = 0; j < 4; ++j) { const int n = (lane >> 3) + 8 * j; const LAS float* s = scr + (8 * c) * 33 + n;
        v4u o; o.x = pk2(s[0 * 33], s[1 * 33]); o.y = pk2(s[2 * 33], s[3 * 33]); o.z = pk2(s[4 * 33], s[5 * 33]); o.w = pk2(s[6 * 33], s[7 * 33]);
        *(v4u*)(WT + (size_t)(row0 + n) * K + k0 + 8 * c) = o; }
    asm volatile("s_waitcnt lgkmcnt(0)" ::: "memory");
}
__device__ __forceinline__ void rope_angle(int t, int i, float& c, float& s) {
    const int row = t >> 6, col = t & 63; const int ii = i & 7;
    const float inv = exp2f(-(float)ii * (13.287712379549449f / 8.f));
    const float ang = (float)(i < 8 ? row : col) * inv;
    c = cosf(ang); s = sinf(ang);
}
__device__ __forceinline__ void phase_p0(ArgsP a, LAS unsigned char* lds) {
    const int tid = tid_(), lane = tid & 63, wave = tid >> 6, G = grid_();
    unsigned char* ws = a->ws;
    LAS float* scr = (LAS float*)(lds + wave * 8704);
    const int gw = bid_() * 8 + wave, NGW = G * 8;
    constexpr int N_WIN = 2 * 16 * 88, N_WOUT = 2 * 16 * 32, N_WUQ = 2 * 4 * 24, N_WUKV = 2 * 2 * 32;
    for (int it = gw; it < N_WIN + N_WOUT + N_WUQ + N_WUKV; it += NGW) {
        int r = it;
        if (r < N_WIN) {
            const int l = r / (16 * 88), kb = (r / 88) % 16, nb = r % 88, j0 = nb * 32;
            const float* src; int ld, col0;
            const float* win = a->in[I_WIN] + (size_t)l * 1024 * 2464;
            if (j0 < 1024) { src = win; ld = 2464; col0 = j0; }
            else if (j0 < 1536) { src = win; ld = 2464; col0 = 1440 + (j0 - 1024); }
            else if (j0 < 1792) { src = win; ld = 2464; col0 = 1952 + (j0 - 1536); }
            else if (j0 < 2048) { src = win; ld = 2464; col0 = 2208 + (j0 - 1792); }
            else if (j0 < 2304) { const int q = (j0 - 2048) >> 6; src = (q < 2 ? a->in[I_W1] : a->in[I_A1]) + (size_t)(l * 2 + (q & 1)) * 1024 * 64; ld = 64; col0 = (j0 - 2048) & 63; }
            else if (j0 < 2560) { src = win; ld = 2464; col0 = 1024 + (j0 - 2304); }
            else if (j0 < 2688) { src = win; ld = 2464; col0 = 1280 + (j0 - 2560); }
            else if (j0 < 2720) { src = win; ld = 2464; col0 = 1408 + (j0 - 2688); }
            else { src = nullptr; ld = 0; col0 = 0; }
            tr_item(src, ld, col0, kb * 64, (bf16*)(ws + WS_WIN) + (size_t)l * NIN * 1024, 1024, j0, 1.f, scr, lane);
            continue;
        }
        r -= N_WIN;
        if (r < N_WOUT) { const int l = r / (16 * 32), kb = (r / 32) % 16, nb = r % 32;
            tr_item(a->in[I_WOUT] + (size_t)l * 1024 * 1024, 1024, nb * 32, kb * 64, (bf16*)(ws + WS_WOUT) + (size_t)l * 1024 * 1024, 1024, nb * 32, 1.f, scr, lane); continue; }
        r -= N_WOUT;
        if (r < N_WUQ) { const int l = r / (4 * 24), kb = (r / 24) % 4, nb = r % 24;
            tr_item(a->in[I_WUQ] + (size_t)l * 256 * 768, 768, nb * 32, kb * 64, (bf16*)(ws + WS_WUQ) + (size_t)l * 768 * 256, 256, nb * 32, QSCALE, scr, lane); continue; }
        r -= N_WUQ;
        { const int l = r / (2 * 32), kb = (r / 32) % 2, nb = r % 32;
            tr_item(a->in[I_WUKV] + (size_t)l * 128 * 1024, 1024, nb * 32, kb * 64, (bf16*)(ws + WS_WUKV) + (size_t)l * 1024 * 128, 128, nb * 32, 1.f, scr, lane); }
    }
    { float* ROPE = (float*)(ws + WS_ROPE);
      for (int i = bid_() * NTHREADS + tid; i < 2048 * 16; i += G * NTHREADS) { float c, s; rope_angle(i >> 4, i & 15, c, s); ROPE[i * 2] = c; ROPE[i * 2 + 1] = s; } }
    float* MOD = (float*)(ws + WS_MOD);
    for (int it = bid_(); it < 2 * 6 * 32; it += G) {
        const int l = it / 192, nb = (it / 32) % 6, kq = it % 32, col = nb * 512 + tid;
        float acc[9];
#pragma unroll
        for (int j = 0; j < 9; ++j) acc[j] = 0.f;
        for (int kk = 0; kk < 32; ++kk) { const int k = kq * 32 + kk;
            const float w = a->in[I_WMOD][((size_t)l * 1024 + k) * 3072 + col];
#pragma unroll
            for (int j = 0; j < 9; ++j) { const float cj = (j == 0) ? a->in[I_CCTX][k] : a->in[I_C][(j - 1) * 1024 + k]; acc[j] = fmaf(siluf_(cj), w, acc[j]); } }
        const float bias = (kq == 0) ? a->in[I_BMOD][l * 3072 + col] : 0.f;
#pragma unroll
        for (int j = 0; j < 9; ++j) atomicAdd(&MOD[(l * 9 + j) * 3072 + col], acc[j] + bias);
    }
}

__device__ __forceinline__ void phase_a0(ArgsP a, int layer) {
    const int tid = tid_(), lane = tid & 63, wave = tid >> 6, G = grid_();
    const float* MOD = (const float*)(a->ws + WS_MOD);
    bf16* U = (bf16*)(a->ws + WS_U);
    for (int n = bid_() * 8 + wave; n < T; n += G * 8) {
        const Tok tk = tok_of(n);
        const float* xr = xrow_src(a, layer, n);
        f32x4 v[4]; float s = 0.f;
#pragma unroll
        for (int j = 0; j < 4; ++j) { v[j] = *(const f32x4*)(xr + lane * 4 + 256 * j); s += (v[j].x + v[j].y) + (v[j].z + v[j].w); }
        float mean = wave_sum(s) * (1.f / D), s2 = 0.f;
#pragma unroll
        for (int j = 0; j < 4; ++j) { v[j] = v[j] - mean; s2 += (v[j].x * v[j].x + v[j].y * v[j].y) + (v[j].z * v[j].z + v[j].w * v[j].w); }
        float rstd = rsqrtf(wave_sum(s2) * (1.f / D) + LN_EPS);
        if (layer == 1) {
            s = 0.f;
#pragma unroll
            for (int j = 0; j < 4; ++j) { const f32x4 g = *(const f32x4*)(a->in[I_LNG] + lane * 4 + 256 * j), b = *(const f32x4*)(a->in[I_LNB] + lane * 4 + 256 * j);
                v[j] = v[j] * rstd * g + b; *(f32x4*)(a->out + (size_t)n * D + lane * 4 + 256 * j) = v[j]; s += (v[j].x + v[j].y) + (v[j].z + v[j].w); }
            mean = wave_sum(s) * (1.f / D); s2 = 0.f;
#pragma unroll
            for (int j = 0; j < 4; ++j) { v[j] = v[j] - mean; s2 += (v[j].x * v[j].x + v[j].y * v[j].y) + (v[j].z * v[j].z + v[j].w * v[j].w); }
            rstd = rsqrtf(wave_sum(s2) * (1.f / D) + LN_EPS);
        }
        const float* m = MOD + (size_t)(layer * 9 + tk.modrow) * 3072;
#pragma unroll
        for (int j = 0; j < 4; ++j) { const int c = lane * 4 + 256 * j; const f32x4 sh = *(const f32x4*)(m + c), sc = *(const f32x4*)(m + 1024 + c);
            const f32x4 o = v[j] * rstd * (sc + 1.f) + sh;
            v2u p; p.x = pk2(o.x, o.y); p.y = pk2(o.z, o.w); *(v2u*)(U + (size_t)n * D + c) = p; }
    }
}
__device__ __forceinline__ void phase_final(ArgsP a) {
    const int tid = tid_(), lane = tid & 63, wave = tid >> 6, G = grid_();
    for (int n = bid_() * 8 + wave; n < T; n += G * 8) {
        float* xr = a->out + (size_t)n * D;
        f32x4 v[4]; float s = 0.f;
#pragma unroll
        for (int j = 0; j < 4; ++j) { v[j] = *(const f32x4*)(xr + lane * 4 + 256 * j); s += (v[j].x + v[j].y) + (v[j].z + v[j].w); }
        const float mean = wave_sum(s) * (1.f / D); float s2 = 0.f;
#pragma unroll
        for (int j = 0; j < 4; ++j) { v[j] = v[j] - mean; s2 += (v[j].x * v[j].x + v[j].y * v[j].y) + (v[j].z * v[j].z + v[j].w * v[j].w); }
        const float rstd = rsqrtf(wave_sum(s2) * (1.f / D) + LN_EPS);
#pragma unroll
        for (int j = 0; j < 4; ++j) { const f32x4 g = *(const f32x4*)(a->in[I_LNG] + 1024 + lane * 4 + 256 * j), b = *(const f32x4*)(a->in[I_LNB] + 1024 + lane * 4 + 256 * j);
            *(f32x4*)(xr + lane * 4 + 256 * j) = v[j] * rstd * g + b; }
    }
}

__device__ __forceinline__ void phase_a1_naive(ArgsP a, int layer) {
    const bf16* U = (const bf16*)(a->ws + WS_U); const bf16* W = (const bf16*)(a->ws + WS_WIN) + (size_t)layer * NIN * 1024;
    bf16* G1 = (bf16*)(a->ws + WS_G1); bf16* G2 = (bf16*)(a->ws + WS_G2);
    const size_t total = (size_t)T * (NIN / 8), stride = (size_t)grid_() * NTHREADS;
    for (size_t idx = (size_t)bid_() * NTHREADS + tid_(); idx < total; idx += stride) {
        const int row = (int)(idx / (NIN / 8)), c0 = (int)(idx % (NIN / 8)) * 8;
        float acc[8];
#pragma unroll
        for (int c = 0; c < 8; ++c) acc[c] = 0.f;
        const v4u* ap = (const v4u*)(U + (size_t)row * 1024); const v4u* bp = (const v4u*)(W + (size_t)c0 * 1024);
        for (int kc = 0; kc < 128; ++kc) { const v4u av = ap[kc];
#pragma unroll
            for (int c = 0; c < 8; ++c) acc[c] = dot8(av, bp[c * 128 + kc], acc[c]); }
        v4u o; o.x = pk2(acc[0], acc[1]); o.y = pk2(acc[2], acc[3]); o.z = pk2(acc[4], acc[5]); o.w = pk2(acc[6], acc[7]);
        if (c0 < G1W) *(v4u*)(G1 + (size_t)row * G1W + c0) = o; else *(v4u*)(G2 + (size_t)row * G2W + (c0 - G1W)) = o;
    }
}
__device__ __forceinline__ void phase_c2_naive(ArgsP a, int layer) {
    const bf16* Y = (const bf16*)(a->ws + WS_YMIX); const bf16* W = (const bf16*)(a->ws + WS_WOUT) + (size_t)layer * 1024 * 1024;
    const float* MOD = (const float*)(a->ws + WS_MOD);
    const size_t total = (size_t)T * 256, stride = (size_t)grid_() * NTHREADS;
    for (size_t idx = (size_t)bid_() * NTHREADS + tid_(); idx < total; idx += stride) {
        const int row = (int)(idx >> 8), c0 = (int)(idx & 255) * 4;
        float acc[4] = {0.f, 0.f, 0.f, 0.f};
        const v4u* ap = (const v4u*)(Y + (size_t)row * 1024); const v4u* bp = (const v4u*)(W + (size_t)c0 * 1024);
        for (int kc = 0; kc < 128; ++kc) { const v4u av = ap[kc];
#pragma unroll
            for (int c = 0; c < 4; ++c) acc[c] = dot8(av, bp[c * 128 + kc], acc[c]); }
        const Tok tk = tok_of(row);
        const f32x4 gate = *(const f32x4*)(MOD + (size_t)(layer * 9 + tk.modrow) * 3072 + 2048 + c0);
        const f32x4 x = *(const f32x4*)(xrow_src(a, layer, row) + c0);
        f32x4 z; z.x = ALPHA * x.x + gate.x * acc[0]; z.y = ALPHA * x.y + gate.y * acc[1]; z.z = ALPHA * x.z + gate.z * acc[2]; z.w = ALPHA * x.w + gate.w * acc[3];
        *(f32x4*)(a->out + (size_t)row * D + c0) = z;
    }
}

__device__ __forceinline__ void phase_a2_naive(ArgsP a, LAS unsigned char* lds, int layer) {
    const int tid = tid_(), lane = tid & 63, wave = tid >> 6, G = grid_();
    LAS float* AQ = (LAS float*)lds;
    LAS float* AKV = (LAS float*)(lds + 16384);
    LAS float* OT = (LAS float*)(lds + 24576);
    const bf16* G2 = (const bf16*)(a->ws + WS_G2);
    bf16* Q = (bf16*)(a->ws + WS_Q); bf16* KN = (bf16*)(a->ws + WS_KN); bf16* KR = (bf16*)(a->ws + WS_KR); bf16* VT = (bf16*)(a->ws + WS_VT);
    const bf16* WUQ = (const bf16*)(a->ws + WS_WUQ) + (size_t)layer * 768 * 256;
    const bf16* WUKV = (const bf16*)(a->ws + WS_WUKV) + (size_t)layer * 1024 * 128;
    constexpr int NT_TOK = T / 16, NT_CACHE = 8 * 256 / 16;
    for (int tile = bid_(); tile < NT_TOK + NT_CACHE; tile += G) {
        const bool is_tok = tile < NT_TOK;
        for (int rr = 0; rr < 2; ++rr) {
            const int r = wave * 2 + rr;
            if (is_tok) {
                const int n = tile * 16 + r; const Tok tk = tok_of(n);
                const v2u cqv = *(const v2u*)(G2 + (size_t)n * G2W + lane * 4);
                const float c0 = bflo(cqv.x), c1 = bfhi(cqv.x), c2 = bflo(cqv.y), c3 = bfhi(cqv.y);
                const float rq = rsqrtf(wave_sum(c0 * c0 + c1 * c1 + c2 * c2 + c3 * c3) * (1.f / 256.f) + 1e-6f);
                const f32x4 qn = *(const f32x4*)(a->in[I_QNORM] + layer * 256 + lane * 4);
                AQ[r * 256 + lane * 4 + 0] = bf2f(f2bf(c0 * rq * qn.x)); AQ[r * 256 + lane * 4 + 1] = bf2f(f2bf(c1 * rq * qn.y));
                AQ[r * 256 + lane * 4 + 2] = bf2f(f2bf(c2 * rq * qn.z)); AQ[r * 256 + lane * 4 + 3] = bf2f(f2bf(c3 * rq * qn.w));
                float k0 = 0.f, k1 = 0.f, k2 = 0.f, k3 = 0.f;
                if (lane < 32) { const v2u kv = *(const v2u*)(G2 + (size_t)n * G2W + 256 + lane * 4); k0 = bflo(kv.x); k1 = bfhi(kv.x); k2 = bflo(kv.y); k3 = bfhi(kv.y); }
                const float rk = rsqrtf(wave_sum(k0 * k0 + k1 * k1 + k2 * k2 + k3 * k3) * (1.f / 128.f) + 1e-6f);
                if (lane < 32) {
                    const f32x4 kn = *(const f32x4*)(a->in[I_KVNORM] + layer * 128 + lane * 4);
                    f32x4 o; o.x = k0 * rk * kn.x; o.y = k1 * rk * kn.y; o.z = k2 * rk * kn.z; o.w = k3 * rk * kn.w;
                    if (!tk.lat) *(f32x4*)(a->out + O_CKV + ((size_t)(tk.b * 2 + layer) * 256 + tk.t) * 128 + lane * 4) = o;
                    AKV[r * 128 + lane * 4 + 0] = bf2f(f2bf(o.x)); AKV[r * 128 + lane * 4 + 1] = bf2f(f2bf(o.y));
                    AKV[r * 128 + lane * 4 + 2] = bf2f(f2bf(o.z)); AKV[r * 128 + lane * 4 + 3] = bf2f(f2bf(o.w));
                }
                float krv = (lane < 32) ? bf2f(G2[(size_t)n * G2W + 384 + lane]) : 0.f;
                const float other = __shfl_xor(krv, 1);
                if (lane < 32) {
                    if (!tk.lat) a->out[O_KR + ((size_t)(tk.b * 2 + layer) * 256 + tk.t) * 32 + lane] = krv;
                    else { float c, s; rope_angle(tk.t, lane >> 1, c, s); krv = (lane & 1) ? (other * s + krv * c) : (krv * c - other * s); }
                    KR[(size_t)tk.kidx * 32 + lane] = (bf16)f2bf(krv);
                }
            } else {
                const int cr = (tile - NT_TOK) * 16 + r, b = cr >> 8, j = cr & 255;
                const size_t src = ((size_t)(b * 2 + layer) * 256 + j);
                if (lane < 32) { const f32x4 v = *(const f32x4*)(a->in[I_CCKV] + src * 128 + lane * 4);
                    AKV[r * 128 + lane * 4 + 0] = bf2f(f2bf(v.x)); AKV[r * 128 + lane * 4 + 1] = bf2f(f2bf(v.y)); AKV[r * 128 + lane * 4 + 2] = bf2f(f2bf(v.z)); AKV[r * 128 + lane * 4 + 3] = bf2f(f2bf(v.w));
                    KR[(size_t)(T_CTX + b * LK_LAT + j) * 32 + lane] = (bf16)f2bf(a->in[I_CKR][src * 32 + lane]); }
            }
        }
        __syncthreads();
        if (is_tok) {
            for (int col = tid; col < 768; col += NTHREADS) {
                float acc[16];
#pragma unroll
                for (int r = 0; r < 16; ++r) acc[r] = 0.f;
                const v4u* wp = (const v4u*)(WUQ + (size_t)col * 256);
                for (int kc = 0; kc < 32; ++kc) { const v4u w = wp[kc];
                    const float w0 = bflo(w.x), w1 = bfhi(w.x), w2 = bflo(w.y), w3 = bfhi(w.y), w4 = bflo(w.z), w5 = bfhi(w.z), w6 = bflo(w.w), w7 = bfhi(w.w);
#pragma unroll
                    for (int r = 0; r < 16; ++r) { const f32x4 x0 = *(const LAS f32x4*)(AQ + r * 256 + kc * 8), x1 = *(const LAS f32x4*)(AQ + r * 256 + kc * 8 + 4);
                        acc[r] += x0.x * w0 + x0.y * w1 + x0.z * w2 + x0.w * w3 + x1.x * w4 + x1.y * w5 + x1.z * w6 + x1.w * w7; } }
#pragma unroll
                for (int r = 0; r < 16; ++r) OT[r * 1024 + col] = acc[r];
            }
            __syncthreads();
            for (int idx = tid; idx < 16 * 384; idx += NTHREADS) {
                const int r = idx / 384, col = (idx % 384) * 2, d = col % 96; const int n = tile * 16 + r; const Tok tk = tok_of(n);
                float v0 = OT[r * 1024 + col], v1 = OT[r * 1024 + col + 1];
                if (tk.lat && d >= 64) { float c, s; rope_angle(tk.t, (d - 64) >> 1, c, s); const float y0 = v0 * c - v1 * s, y1 = v0 * s + v1 * c; v0 = y0; v1 = y1; }
                *(unsigned*)(Q + (size_t)n * 768 + col) = pk2(v0, v1);
            }
            __syncthreads();
        }
        for (int col = tid; col < 1024; col += NTHREADS) {
            float acc[16];
#pragma unroll
            for (int r = 0; r < 16; ++r) acc[r] = 0.f;
            const v4u* wp = (const v4u*)(WUKV + (size_t)col * 128);
            for (int kc = 0; kc < 16; ++kc) { const v4u w = wp[kc];
                const float w0 = bflo(w.x), w1 = bfhi(w.x), w2 = bflo(w.y), w3 = bfhi(w.y), w4 = bflo(w.z), w5 = bfhi(w.z), w6 = bflo(w.w), w7 = bfhi(w.w);
#pragma unroll
                for (int r = 0; r < 16; ++r) { const f32x4 x0 = *(const LAS f32x4*)(AKV + r * 128 + kc * 8), x1 = *(const LAS f32x4*)(AKV + r * 128 + kc * 8 + 4);
                    acc[r] += x0.x * w0 + x0.y * w1 + x0.z * w2 + x0.w * w3 + x1.x * w4 + x1.y * w5 + x1.z * w6 + x1.w * w7; } }
#pragma unroll
            for (int r = 0; r < 16; ++r) OT[r * 1024 + col] = acc[r];
        }
        __syncthreads();
        for (int idx = tid; idx < 16 * 1024; idx += NTHREADS) {
            const int r = idx >> 10, col = idx & 1023, h = col >> 7, f = col & 127;
            int kidx, lat, b, kpos;
            if (is_tok) { const Tok tk = tok_of(tile * 16 + r); kidx = tk.kidx; lat = tk.lat; b = tk.b; kpos = tk.lat ? PAST + tk.t : tk.t; }
            else { const int cr = (tile - NT_TOK) * 16 + r; b = cr >> 8; kpos = cr & 255; lat = 1; kidx = T_CTX + b * LK_LAT + kpos; }
            const bf16 v = (bf16)f2bf(OT[r * 1024 + col]);
            if (f < 64) KN[(size_t)kidx * 512 + h * 64 + f] = v;
            else { const int dv = f - 64; const size_t base = lat ? (size_t)VT_LAT + ((size_t)(b * 8 + h) * 64 + dv) * LK_LAT : ((size_t)(b * 8 + h) * 64 + dv) * 256; VT[base + kpos] = v; }
        }
        __syncthreads();
    }
}

__device__ __forceinline__ void phase_att_naive(ArgsP a) {
    const bf16* KN = (const bf16*)(a->ws + WS_KN); const bf16* KR = (const bf16*)(a->ws + WS_KR); const bf16* VT = (const bf16*)(a->ws + WS_VT);
    bf16* Q = (bf16*)(a->ws + WS_Q); const bf16* G1 = (const bf16*)(a->ws + WS_G1);
    const int total = T * 8, stride = grid_() * NTHREADS;
    for (int idx = bid_() * NTHREADS + tid_(); idx < total; idx += stride) {
        int n, h, Lk, kidx0; size_t vbase;
        if (idx < T_CTX * 8) { const int b = idx >> 11, hh = (idx >> 8) & 7, t = idx & 255; n = b * 256 + t; h = hh; Lk = 256; kidx0 = b * 256; vbase = ((size_t)(b * 8 + h) * 64) * 256; }
        else { const int m = idx - T_CTX * 8, b = m >> 14, hh = (m >> 11) & 7, t = m & 2047; n = T_CTX + b * 2048 + t; h = hh; Lk = LK_LAT; kidx0 = T_CTX + b * LK_LAT; vbase = (size_t)VT_LAT + ((size_t)(b * 8 + h) * 64) * LK_LAT; }
        v4u qp[12];
#pragma unroll
        for (int c = 0; c < 12; ++c) qp[c] = *(const v4u*)(Q + (size_t)n * 768 + h * 96 + c * 8);
        float acc[64];
#pragma unroll
        for (int d = 0; d < 64; ++d) acc[d] = 0.f;
        float m = -1e30f, l = 0.f;
        for (int j0 = 0; j0 < Lk; j0 += 8) {
            float s[8];
#pragma unroll
            for (int j = 0; j < 8; ++j) {
                const v4u* kp = (const v4u*)(KN + (size_t)(kidx0 + j0 + j) * 512 + h * 64); const v4u* rp = (const v4u*)(KR + (size_t)(kidx0 + j0 + j) * 32);
                float sv = 0.f;
#pragma unroll
                for (int c = 0; c < 8; ++c) sv = dot8(qp[c], kp[c], sv);
#pragma unroll
                for (int c = 0; c < 4; ++c) sv = dot8(qp[8 + c], rp[c], sv);
                s[j] = sv;
                __builtin_amdgcn_sched_barrier(0);
            }
            float mx = m;
#pragma unroll
            for (int j = 0; j < 8; ++j) mx = fmaxf(mx, s[j]);
            const float alpha = exp2f(m - mx); m = mx; float ps = 0.f;
#pragma unroll
            for (int j = 0; j < 8; ++j) { s[j] = exp2f(s[j] - mx); ps += s[j]; }
            l = l * alpha + ps;
            unsigned lk = (unsigned)Lk; asm volatile("" : "+v"(lk));
            const bf16* vp = VT + vbase + j0;
#pragma unroll
            for (int dg = 0; dg < 8; ++dg) {
#pragma unroll
                for (int dd = 0; dd < 8; ++dd) { const int d = dg * 8 + dd; const v4u w = *(const v4u*)(vp + (unsigned)d * lk);
                    acc[d] = acc[d] * alpha + s[0] * bflo(w.x) + s[1] * bfhi(w.x) + s[2] * bflo(w.y) + s[3] * bfhi(w.y) + s[4] * bflo(w.z) + s[5] * bfhi(w.z) + s[6] * bflo(w.w) + s[7] * bfhi(w.w); }
                __builtin_amdgcn_sched_barrier(0);
            }
        }
        const float inv = 1.f / l;
#pragma unroll
        for (int c = 0; c < 8; ++c) { const v4u g = *(const v4u*)(G1 + (size_t)n * G1W + C_GM + h * 64 + c * 8);
            v4u o;
            o.x = pk2(acc[c * 8 + 0] * inv * siluf_(bflo(g.x)), acc[c * 8 + 1] * inv * siluf_(bfhi(g.x)));
            o.y = pk2(acc[c * 8 + 2] * inv * siluf_(bflo(g.y)), acc[c * 8 + 3] * inv * siluf_(bfhi(g.y)));
            o.z = pk2(acc[c * 8 + 4] * inv * siluf_(bflo(g.z)), acc[c * 8 + 5] * inv * siluf_(bfhi(g.z)));
            o.w = pk2(acc[c * 8 + 6] * inv * siluf_(bflo(g.w)), acc[c * 8 + 7] * inv * siluf_(bfhi(g.w)));
            *(v4u*)(Q + (size_t)n * 768 + h * 96 + c * 8) = o; }
    }
}
namespace pg8 {
#define PG8_LAS __attribute__((address_space(3)))
typedef unsigned short bf16_t;
typedef short bf16x8 __attribute__((ext_vector_type(8)));
typedef float f32x4 __attribute__((ext_vector_type(4)));
typedef unsigned u32x4 __attribute__((ext_vector_type(4)));
constexpr int BM = 256, BK = 64, HALF = 128, HTB = HALF * BK * 2  , STAGE_BYTES = 8 * HTB, NXCD = 8, WGM = 8;

__host__ __device__ __forceinline__ int lds_byte(int r, int c) { const int st = (r >> 4) * 2 + (c >> 5), rr = r & 15, cc = c & 31, ob = rr * 64 + cc * 2; return st * 1024 + (ob ^ (((ob >> 9) & 1) << 5)); }
__host__ __device__ __forceinline__ void stage_rc(int b, int& R, int& C) { const int st = b / 1024, sb = b % 1024, swz = sb ^ (((sb >> 9) & 1) << 5); R = (st >> 1) * 16 + swz / 64; C = (st & 1) * 32 + (swz % 64) / 2; }
__host__ __device__ __forceinline__ int perm32(int rho) { const int n = rho >> 4, i = rho & 15; return 8 * (i >> 2) + 4 * n + (i & 3); }

struct Unit { int pm, pn; };
struct Gemm { const bf16_t* A; const bf16_t* Bt; int M, N, K; };

struct StaticOrder {
    int nM, nN, nwg, G, c;
    __host__ __device__ void init(int M, int N, int G_, int c_) { nM = M / BM; nN = N / BM; nwg = nM * nN; G = G_; c = c_; }
    __host__ __device__ bool next(int i, Unit& u) const {
        const long L = (long)i * G + c; if (L >= nwg) return false;
        int wgid = (int)L; { const int q = nwg / NXCD, r = nwg % NXCD, xcd = wgid % NXCD, off = wgid / NXCD; wgid = (xcd < r ? xcd * (q + 1) : r * (q + 1) + (xcd - r) * q) + off; }
        const int nig = WGM * nN, gid = wgid / nig, fm = gid * WGM, gsz = (nM - fm) < WGM ? (nM - fm) : WGM;
        u.pm = fm + ((wgid % nig) % gsz); u.pn = (wgid % nig) / gsz; return true;
    }
    __device__ __forceinline__ void a_ready(const Unit&) const {}
    __device__ __forceinline__ void done(const Unit&) const {}
};
__device__ __forceinline__ unsigned cvt_pk_bf16(float lo, float hi) { unsigned r; asm volatile("v_cvt_pk_bf16_f32 %0, %1, %2" : "=v"(r) : "v"(lo), "v"(hi)); return r; }

template <class Epi, class Sched, bool STAMP = false>
__device__ __forceinline__ void gemm_phase(PG8_LAS unsigned char* lds, const Gemm g, const Sched& S, const Epi& E, unsigned long long* stamps) {
    const int tid = tid_(), wid = __builtin_amdgcn_readfirstlane(tid >> 6), lane = tid & 63, wr = wid >> 2, wc = wid & 3, fr = lane & 15, fq = lane >> 4;
    const int K = g.K, nt = K / BK;
    int ts_lo = 0, ts_hi = 0, nts = 0; const unsigned long long rt_entry = STAMP ? (unsigned long long)wall_clock64() : 0ull;
#define PG8_STAMP() do { if (STAMP && wid == 0 && nts < 64) { const unsigned long long _c = (unsigned long long)clock64(); \
        ts_lo = (lane == nts) ? (int)(unsigned)_c : ts_lo; ts_hi = (lane == nts) ? (int)(unsigned)(_c >> 32) : ts_hi; ++nts; } } while (0)
    PG8_STAMP();
    unsigned voffA[2], voffB[2];
#pragma unroll
    for (int i = 0; i < 2; ++i) { int R, C; stage_rc(tid * 16 + i * 8192, R, C); const int Rb = Epi::PERM ? ((R & ~31) + perm32(R & 31)) : R;
        voffA[i] = (unsigned)(R * K + C) * 2u; voffB[i] = (unsigned)(Rb * K + C) * 2u; }
    const size_t kstep = (size_t)(BK * 2);
    const size_t hstep = (size_t)HALF * K * 2;
    const size_t tstep = 2 * hstep;
    const unsigned ldsw = (unsigned)wid * 1024u;
    const int aoff = lds_byte(wr * 64 + fr, fq * 8), boff = lds_byte(wc * 32 + fr, fq * 8);
#define PG8_SA(b, h) (((b) * 2 + (h)) * HTB)
#define PG8_SB(b, h) ((4 + (b) * 2 + (h)) * HTB)
#define PG8_STAGE(bufoff, gbase, voff) do { _Pragma("unroll") for (int _i = 0; _i < 2; ++_i) \
        __builtin_amdgcn_global_load_lds((const unsigned*)((const char*)(gbase) + (voff)[_i]), (PG8_LAS unsigned*)(lds + (bufoff) + ldsw + _i * 8192), 16, 0, 0); } while (0)
#define PG8_LDA(dst, b, h) do { _Pragma("unroll") for (int m = 0; m < 4; ++m) _Pragma("unroll") for (int k = 0; k < 2; ++k) dst[m][k] = *(const PG8_LAS bf16x8*)(lds + PG8_SA(b, h) + aoff + m * 2048 + k * 1024); } while (0)
#define PG8_LDB(dst, b, h) do { _Pragma("unroll") for (int n = 0; n < 2; ++n) _Pragma("unroll") for (int k = 0; k < 2; ++k) dst[n][k] = *(const PG8_LAS bf16x8*)(lds + PG8_SB(b, h) + boff + n * 2048 + k * 1024); } while (0)
#define PG8_MMA(ai, bj, At, Bt) do { __builtin_amdgcn_s_setprio(1); _Pragma("unroll") for (int m = 0; m < 4; ++m) _Pragma("unroll") for (int n = 0; n < 2; ++n) _Pragma("unroll") for (int k = 0; k < 2; ++k) \
        acc[ai][bj][m][n] = __builtin_amdgcn_mfma_f32_16x16x32_bf16(Bt[n][k], At[m][k], acc[ai][bj][m][n], 0, 0, 0); __builtin_amdgcn_s_setprio(0); } while (0)
#define PG8_WAIT_V(n) asm volatile("s_waitcnt vmcnt(" #n ")" ::: "memory")
#define PG8_WAIT_L(n) asm volatile("s_waitcnt lgkmcnt(" #n ")" ::: "memory")
#define PG8_BAR __builtin_amdgcn_s_barrier()
#define PG8_SCHED __builtin_amdgcn_sched_barrier(0)
    Unit cur, nxt; int ui = 0;
    if (!S.next(0, cur)) return;
    f32x4 acc[2][2][4][2];
#pragma unroll
    for (int a = 0; a < 2; ++a)
#pragma unroll
        for (int b = 0; b < 2; ++b)
#pragma unroll
            for (int m = 0; m < 4; ++m)
#pragma unroll
                for (int n = 0; n < 2; ++n) acc[a][b][m][n] = (f32x4){0.f, 0.f, 0.f, 0.f};
    bf16x8 At[4][2], B0[2][2], B1[2][2];
    const char* cA = (const char*)g.A + (size_t)cur.pm * tstep; const char* cB = (const char*)g.Bt + (size_t)cur.pn * tstep;
    S.a_ready(cur);
    PG8_STAGE(PG8_SB(0, 0), cB, voffB); PG8_STAGE(PG8_SA(0, 0), cA, voffA); PG8_STAGE(PG8_SB(0, 1), cB + hstep, voffB); PG8_STAGE(PG8_SA(0, 1), cA + hstep, voffA);
    if (wr == 1) PG8_BAR;
    PG8_WAIT_V(4); PG8_BAR;
    PG8_STAGE(PG8_SB(1, 0), cB + kstep, voffB); PG8_STAGE(PG8_SA(1, 0), cA + kstep, voffA); PG8_STAGE(PG8_SB(1, 1), cB + hstep + kstep, voffB);
    PG8_WAIT_V(6); PG8_BAR;
    PG8_STAMP();
    for (;;) {
        const bool has_next = S.next(ui + 1, nxt);
        const char* nA = has_next ? (const char*)g.A + (size_t)nxt.pm * tstep : cA; const char* nB = has_next ? (const char*)g.Bt + (size_t)nxt.pn * tstep : cB;
        for (int t = 0; t < nt; t += 2) {
            const bool last = (t == nt - 2);
            const char* a1 = cA + (size_t)(t + 1) * kstep;
            const char* a2 = last ? nA : cA + (size_t)(t + 2) * kstep; const char* b2 = last ? nB : cB + (size_t)(t + 2) * kstep;
            const char* a3 = a2 + kstep; const char* b3 = b2 + kstep;
            if (last && has_next) S.a_ready(nxt);
            PG8_LDB(B0, 0, 0); PG8_SCHED; PG8_LDA(At, 0, 0); PG8_STAGE(PG8_SA(1, 1), a1 + hstep, voffA);
            PG8_WAIT_L(8); PG8_BAR; PG8_WAIT_L(0); PG8_MMA(0, 0, At, B0); PG8_BAR; PG8_SCHED;
            PG8_LDB(B1, 0, 1); PG8_STAGE(PG8_SB(0, 0), b2, voffB);
            PG8_BAR; PG8_WAIT_L(0); PG8_MMA(0, 1, At, B1); PG8_BAR;
            PG8_LDA(At, 0, 1); PG8_STAGE(PG8_SA(0, 0), a2, voffA);
            PG8_BAR; PG8_WAIT_L(0); PG8_MMA(1, 0, At, B0); PG8_BAR; PG8_SCHED;
            PG8_STAGE(PG8_SB(0, 1), b2 + hstep, voffB);
            PG8_WAIT_V(6); PG8_BAR; PG8_MMA(1, 1, At, B1); PG8_BAR;
            PG8_LDB(B0, 1, 0); PG8_SCHED; PG8_LDA(At, 1, 0); PG8_STAGE(PG8_SA(0, 1), a2 + hstep, voffA);
            PG8_WAIT_L(8); PG8_BAR; PG8_WAIT_L(0); PG8_MMA(0, 0, At, B0); PG8_BAR; PG8_SCHED;
            PG8_LDB(B1, 1, 1); PG8_STAGE(PG8_SB(1, 0), b3, voffB);
            PG8_BAR; PG8_WAIT_L(0); PG8_MMA(0, 1, At, B1); PG8_BAR;
            PG8_LDA(At, 1, 1); PG8_STAGE(PG8_SA(1, 0), a3, voffA);
            PG8_BAR; PG8_WAIT_L(0); PG8_MMA(1, 0, At, B0); PG8_BAR; PG8_SCHED;
            PG8_STAGE(PG8_SB(1, 1), b3 + hstep, voffB);
            PG8_WAIT_V(6); PG8_BAR; PG8_MMA(1, 1, At, B1); PG8_BAR;
        }
        PG8_STAMP();
        if constexpr (!Epi::AFTER_DRAIN) { E(acc, cur, wr, wc, fr, fq); S.done(cur); }
        PG8_STAMP();
        if (!has_next) break;
#pragma unroll
        for (int a = 0; a < 2; ++a)
#pragma unroll
            for (int b = 0; b < 2; ++b)
#pragma unroll
                for (int m = 0; m < 4; ++m)
#pragma unroll
                    for (int n = 0; n < 2; ++n) acc[a][b][m][n] = (f32x4){0.f, 0.f, 0.f, 0.f};
        cur = nxt; cA = nA; cB = nB; ++ui;
    }
    PG8_WAIT_V(0);
    if (wr == 0) PG8_BAR;
    PG8_BAR;
    if constexpr (Epi::AFTER_DRAIN) { E.fused(acc, cur, wr, wc, fr, fq, lds, wid, lane); S.done(cur); }
    PG8_STAMP();
    if (STAMP && wid == 0) { stamps[lane] = lane < nts ? (((unsigned long long)(unsigned)ts_hi << 32) | (unsigned)ts_lo) : 0ull;
        if (lane == 62) stamps[62] = rt_entry; if (lane == 63) stamps[63] = (unsigned long long)wall_clock64(); }
#undef PG8_STAMP
#undef PG8_SA
#undef PG8_SB
#undef PG8_STAGE
#undef PG8_LDA
#undef PG8_LDB
#undef PG8_MMA
#undef PG8_WAIT_V
#undef PG8_WAIT_L
#undef PG8_BAR
#undef PG8_SCHED
}
}
namespace pg8 {
struct EpiIn {
    static constexpr bool PERM = true, AFTER_DRAIN = false;
    bf16_t* G1; bf16_t* G2;
    __device__ __forceinline__ void operator()(const f32x4 (&acc)[2][2][4][2], const Unit& u, int wr, int wc, int fr, int fq) const {
        const int row0 = u.pm * BM + wr * 64 + fr;
        bf16_t* base; int ldc, colt;
        if (u.pn < 9) { base = G1; ldc = 2304; colt = u.pn * 256; } else { base = G2; ldc = 512; colt = (u.pn - 9) * 256; }
        const int col0 = colt + wc * 32 + 8 * fq;
#pragma unroll
        for (int ai = 0; ai < 2; ++ai)
#pragma unroll
            for (int m = 0; m < 4; ++m) { bf16_t* rowp = base + (size_t)(row0 + ai * HALF + m * 16) * ldc + col0;
#pragma unroll
                for (int bj = 0; bj < 2; ++bj) { const f32x4 v0 = acc[ai][bj][m][0], v1 = acc[ai][bj][m][1];
                    u32x4 w; w.x = cvt_pk_bf16(v0[0], v0[1]); w.y = cvt_pk_bf16(v0[2], v0[3]); w.z = cvt_pk_bf16(v1[0], v1[1]); w.w = cvt_pk_bf16(v1[2], v1[3]);
                    *(u32x4*)(rowp + bj * HALF) = w; } }
    }
};
struct EpiOut {
    static constexpr bool PERM = false, AFTER_DRAIN = false;
    const float* xp; const float* xs; const float* xo; float* out; const float* mod; int layer;
    __device__ __forceinline__ void operator()(const f32x4 (&acc)[2][2][4][2], const Unit& u, int wr, int wc, int fr, int fq) const {
        const int row0 = u.pm * BM + wr * 64 + fr, col0 = u.pn * BM + wc * 32 + 4 * fq;
        const int rt = u.pm * BM; const int modrow = rt < 8192 ? 0 : 1 + ((rt - 8192) >> 11);
        const float* gp = mod + (size_t)modrow * 3072 + 2048 + col0;
        f32x4 gv[2][2];
#pragma unroll
        for (int bj = 0; bj < 2; ++bj)
#pragma unroll
            for (int n = 0; n < 2; ++n) gv[bj][n] = *(const f32x4*)(gp + bj * HALF + n * 16);
#pragma unroll
        for (int ai = 0; ai < 2; ++ai)
#pragma unroll
            for (int m = 0; m < 4; ++m) { const int row = row0 + ai * HALF + m * 16;
                const float* xr = (layer == 0 ? (row < 8192 ? xp + (size_t)row * 1024 : xs + (size_t)(row - 8192) * 1024) : xo + (size_t)row * 1024) + col0;
                float* orow = out + (size_t)row * 1024 + col0;
#pragma unroll
                for (int bj = 0; bj < 2; ++bj)
#pragma unroll
                    for (int n = 0; n < 2; ++n) { const f32x4 x = *(const f32x4*)(xr + bj * HALF + n * 16);
                        *(f32x4*)(orow + bj * HALF + n * 16) = x * 1.4142135623730951f + gv[bj][n] * acc[ai][bj][m][n]; } }
    }
};
}

__device__ __forceinline__ void phase_a1_pg8(ArgsP a, LAS unsigned char* lds, int layer) {
    pg8::Gemm g{(const bf16*)(a->ws + WS_U), (const bf16*)(a->ws + WS_WIN) + (size_t)layer * NIN * 1024, T, NIN, 1024};
    pg8::StaticOrder S; S.init(T, NIN, grid_(), bid_());
    pg8::EpiIn E{(bf16*)(a->ws + WS_G1), (bf16*)(a->ws + WS_G2)};
    pg8::gemm_phase<pg8::EpiIn, pg8::StaticOrder, false>(lds, g, S, E, nullptr);
}
__device__ __forceinline__ void phase_c2_pg8(ArgsP a, LAS unsigned char* lds, int layer) {
    pg8::Gemm g{(const bf16*)(a->ws + WS_YMIX), (const bf16*)(a->ws + WS_WOUT) + (size_t)layer * 1024 * 1024, T, 1024, 1024};
    pg8::StaticOrder S; S.init(T, 1024, grid_(), bid_());
    pg8::EpiOut E{a->in[I_XP], a->in[I_XS], a->out, a->out, (const float*)(a->ws + WS_MOD) + (size_t)layer * 9 * 3072, layer};
    pg8::gemm_phase<pg8::EpiOut, pg8::StaticOrder, false>(lds, g, S, E, nullptr);
}
__device__ __forceinline__ void rwkv_unit_seq(ArgsP a, LAS unsigned char* lds, int layer, int u) {
    const int tid = tid_();
    LAS float* W2s = (LAS float*)lds;
    LAS float* A2s = W2s + 4096;
    LAS float* TH = A2s + 4096;
    LAS float* HA = TH + 2048;
    LAS float* Wd = HA + 2048;
    LAS float* KT = Wd + 2048; LAS float* KK = KT + 2048; LAS float* BB = KK + 2048; LAS float* RR = BB + 2048; LAS float* VV = RR + 2048; LAS float* YO = VV + 2048;
    const int lat = u < 64, uu = lat ? u : u - 64, b = uu >> 3, e = (uu >> 2) & 1, hh = uu & 3;
    const int L = lat ? L_LAT : L_CTX, tok0 = lat ? T_CTX + b * L_LAT : b * L_CTX;
    const bf16* G1 = (const bf16*)(a->ws + WS_G1);
    bf16* YS = (bf16*)(a->ws + WS_G2);
    for (int i = tid; i < 4096; i += NTHREADS) { const int j = i >> 6, c = i & 63;
        W2s[i] = a->in[I_W2][((size_t)(layer * 2 + e) * 64 + j) * 256 + hh * 64 + c];
        A2s[i] = a->in[I_A2][((size_t)(layer * 2 + e) * 64 + j) * 256 + hh * 64 + c]; }
    const int r = tid >> 3, ks = tid & 7;
    float S[8];
#pragma unroll
    for (int j = 0; j < 8; ++j) S[j] = lat ? a->in[I_SRW][(((size_t)((b * 2 + layer) * 2 + e) * 4 + hh) * 64 + r) * 64 + ks * 8 + j] : 0.f;
    const int tt = tid >> 4, q4 = (tid & 15) * 4;
    float w0v[4], a0v[4], kkw[4], kav[4];
#pragma unroll
    for (int i = 0; i < 4; ++i) { const int ch = hh * 64 + q4 + i;
        w0v[i] = a->in[I_W0][(layer * 2 + e) * 256 + ch]; a0v[i] = a->in[I_A0][(layer * 2 + e) * 256 + ch]; kkw[i] = a->in[I_KK][layer * 256 + ch]; kav[i] = a->in[I_KA][layer * 256 + ch]; }
    __syncthreads();
    for (int c = 0; c < L / 32; ++c) {
        const int step = c * 32 + tt, t = e ? L - 1 - step : step, n = tok0 + t;
        const bf16* g = G1 + (size_t)n * G1W;
        { const v2u hw = *(const v2u*)(g + C_LORA + e * 64 + q4), ha = *(const v2u*)(g + C_LORA + 128 + e * 64 + q4);
          TH[tt * 64 + q4 + 0] = tanhf(bflo(hw.x)); TH[tt * 64 + q4 + 1] = tanhf(bfhi(hw.x)); TH[tt * 64 + q4 + 2] = tanhf(bflo(hw.y)); TH[tt * 64 + q4 + 3] = tanhf(bfhi(hw.y));
          HA[tt * 64 + q4 + 0] = bflo(ha.x); HA[tt * 64 + q4 + 1] = bfhi(ha.x); HA[tt * 64 + q4 + 2] = bflo(ha.y); HA[tt * 64 + q4 + 3] = bfhi(ha.y); }
        __syncthreads();
        {
            float wl[4], al[4];
#pragma unroll
            for (int i = 0; i < 4; ++i) { wl[i] = w0v[i]; al[i] = a0v[i]; }
            for (int j = 0; j < 64; ++j) { const float th = TH[tt * 64 + j], hv = HA[tt * 64 + j];
                const f32x4 w2 = *(const LAS f32x4*)(W2s + j * 64 + q4), a2 = *(const LAS f32x4*)(A2s + j * 64 + q4);
                wl[0] = fmaf(th, w2.x, wl[0]); wl[1] = fmaf(th, w2.y, wl[1]); wl[2] = fmaf(th, w2.z, wl[2]); wl[3] = fmaf(th, w2.w, wl[3]);
                al[0] = fmaf(hv, a2.x, al[0]); al[1] = fmaf(hv, a2.y, al[1]); al[2] = fmaf(hv, a2.z, al[2]); al[3] = fmaf(hv, a2.w, al[3]); }
            const v2u kv = *(const v2u*)(g + C_K + hh * 64 + q4), rv = *(const v2u*)(g + C_R + hh * 64 + q4), vv = *(const v2u*)(g + C_V + hh * 64 + q4);
            const float kx[4] = {bflo(kv.x), bfhi(kv.x), bflo(kv.y), bfhi(kv.y)}, rx[4] = {bflo(rv.x), bfhi(rv.x), bflo(rv.y), bfhi(rv.y)}, vx[4] = {bflo(vv.x), bfhi(vv.x), bflo(vv.y), bfhi(vv.y)};
            float kkr[4], ss = 0.f;
#pragma unroll
            for (int i = 0; i < 4; ++i) { kkr[i] = kx[i] * kkw[i]; ss += kkr[i] * kkr[i]; }
            ss += __shfl_xor(ss, 1); ss += __shfl_xor(ss, 2); ss += __shfl_xor(ss, 4); ss += __shfl_xor(ss, 8);
            const float inrm = 1.f / fmaxf(sqrtf(ss), 1e-12f);
#pragma unroll
            for (int i = 0; i < 4; ++i) {
                const float dec = __expf(-0.6065306597126334f * sigmoidf_(wl[i])), av = sigmoidf_(al[i]), kk = kkr[i] * inrm;
                const int o = tt * 64 + q4 + i;
                Wd[o] = dec; KT[o] = kx[i] * (1.f + (av - 1.f) * kav[i]); KK[o] = kk; BB[o] = kk * av; RR[o] = rx[i]; VV[o] = vx[i]; }
        }
        __syncthreads();
        for (int s = 0; s < 32; ++s) {
            const int o = s * 64 + ks * 8;
            const f32x4 k0 = *(const LAS f32x4*)(KK + o), k1 = *(const LAS f32x4*)(KK + o + 4);
            float p = S[0] * k0.x + S[1] * k0.y + S[2] * k0.z + S[3] * k0.w + S[4] * k1.x + S[5] * k1.y + S[6] * k1.z + S[7] * k1.w;
            p += __shfl_xor(p, 1); p += __shfl_xor(p, 2); p += __shfl_xor(p, 4);
            const float sa = -p, vv = VV[s * 64 + r];
            const f32x4 w0 = *(const LAS f32x4*)(Wd + o), w1 = *(const LAS f32x4*)(Wd + o + 4), b0 = *(const LAS f32x4*)(BB + o), b1 = *(const LAS f32x4*)(BB + o + 4);
            const f32x4 t0 = *(const LAS f32x4*)(KT + o), t1 = *(const LAS f32x4*)(KT + o + 4), r0 = *(const LAS f32x4*)(RR + o), r1 = *(const LAS f32x4*)(RR + o + 4);
            S[0] = S[0] * w0.x + sa * b0.x + vv * t0.x; S[1] = S[1] * w0.y + sa * b0.y + vv * t0.y; S[2] = S[2] * w0.z + sa * b0.z + vv * t0.z; S[3] = S[3] * w0.w + sa * b0.w + vv * t0.w;
            S[4] = S[4] * w1.x + sa * b1.x + vv * t1.x; S[5] = S[5] * w1.y + sa * b1.y + vv * t1.y; S[6] = S[6] * w1.z + sa * b1.z + vv * t1.z; S[7] = S[7] * w1.w + sa * b1.w + vv * t1.w;
            float y = S[0] * r0.x + S[1] * r0.y + S[2] * r0.z + S[3] * r0.w + S[4] * r1.x + S[5] * r1.y + S[6] * r1.z + S[7] * r1.w;
            y += __shfl_xor(y, 1); y += __shfl_xor(y, 2); y += __shfl_xor(y, 4);
            if (ks == 0) YO[s * 64 + r] = y;
        }
        __syncthreads();
        { v2u o; o.x = pk2(YO[tt * 64 + q4], YO[tt * 64 + q4 + 1]); o.y = pk2(YO[tt * 64 + q4 + 2], YO[tt * 64 + q4 + 3]);
          *(v2u*)(YS + ((size_t)e * T + n) * 256 + hh * 64 + q4) = o; }
        __syncthreads();
    }
    if (!lat) {
        float* dst = a->out + O_RW + (((size_t)((b * 2 + layer) * 2 + e) * 4 + hh) * 64 + r) * 64 + ks * 8;
        *(f32x4*)dst = (f32x4){S[0], S[1], S[2], S[3]}; *(f32x4*)(dst + 4) = (f32x4){S[4], S[5], S[6], S[7]};
    }
}

__device__ __forceinline__ void lru_unit_seq(ArgsP a, LAS unsigned char* lds, int layer, int u) {
    const int tid = tid_();
    LAS float* WA = (LAS float*)lds;
    LAS float* WX = WA + 4096;
    LAS float* XC = WX + 4096;
    LAS float* AA = XC + 4096; LAS float* BV = AA + 4096; LAS float* HH = BV + 4096;
    const int lat = u < 32, uu = lat ? u : u - 32, b = uu >> 2, g = uu & 3;
    const int L = lat ? L_LAT : L_CTX, tok0 = lat ? T_CTX + b * L_LAT : b * L_CTX;
    const bf16* G1 = (const bf16*)(a->ws + WS_G1);
    bf16* HF = (bf16*)(a->ws + WS_HF);
    const int tt = tid >> 3, q8 = (tid & 7) * 8;
    float cw[4][8], cb[8];
#pragma unroll
    for (int i = 0; i < 8; ++i) { const int ch = g * 64 + q8 + i; cb[i] = a->in[I_CONVB][layer * 256 + ch];
#pragma unroll
        for (int j = 0; j < 4; ++j) cw[j][i] = a->in[I_CONVW][(layer * 4 + j) * 256 + ch]; }
    for (int e = 0; e < 2; ++e) {
        __syncthreads();
        for (int i = tid; i < 4096; i += NTHREADS) { const size_t src = ((size_t)((layer * 2 + e) * 4 + g)) * 4096 + i; WA[i] = a->in[I_WA][src]; WX[i] = a->in[I_WX][src]; }
        float bav[8], bxv[8], spl[8];
#pragma unroll
        for (int i = 0; i < 8; ++i) { const int ch = (layer * 2 + e) * 256 + g * 64 + q8 + i; bav[i] = a->in[I_BA][ch]; bxv[i] = a->in[I_BX][ch]; spl[i] = log1pf(__expf(-a->in[I_LAMBDA][ch])); }
        float h = 0.f;
        if (tid < 64 && lat) h = a->in[I_SLRU][((size_t)(b * 2 + layer) * 2 + e) * 256 + g * 64 + tid];
        __syncthreads();
        for (int cc = 0; cc < L / 64; ++cc) {
            const int c = e ? L / 64 - 1 - cc : cc, t = c * 64 + tt, n = tok0 + t;
            {
                float xc[8];
#pragma unroll
                for (int i = 0; i < 8; ++i) xc[i] = cb[i];
#pragma unroll
                for (int j = 0; j < 4; ++j) { const int ts = t + j - 2;
                    if (ts >= 0 && ts < L) { const v4u x = *(const v4u*)(G1 + (size_t)(tok0 + ts) * G1W + C_XL + g * 64 + q8);
                        xc[0] += cw[j][0] * bflo(x.x); xc[1] += cw[j][1] * bfhi(x.x); xc[2] += cw[j][2] * bflo(x.y); xc[3] += cw[j][3] * bfhi(x.y);
                        xc[4] += cw[j][4] * bflo(x.z); xc[5] += cw[j][5] * bfhi(x.z); xc[6] += cw[j][6] * bflo(x.w); xc[7] += cw[j][7] * bfhi(x.w); } }
#pragma unroll
                for (int i = 0; i < 8; ++i) XC[tt * 64 + q8 + i] = xc[i];
            }
            __syncthreads();
            {
                float gr[8], gi[8];
#pragma unroll
                for (int i = 0; i < 8; ++i) { gr[i] = bav[i]; gi[i] = bxv[i]; }
                for (int i = 0; i < 64; ++i) { const float x = XC[tt * 64 + i];
                    const f32x4 a0 = *(const LAS f32x4*)(WA + i * 64 + q8), a1 = *(const LAS f32x4*)(WA + i * 64 + q8 + 4), x0 = *(const LAS f32x4*)(WX + i * 64 + q8), x1 = *(const LAS f32x4*)(WX + i * 64 + q8 + 4);
                    gr[0] = fmaf(x, a0.x, gr[0]); gr[1] = fmaf(x, a0.y, gr[1]); gr[2] = fmaf(x, a0.z, gr[2]); gr[3] = fmaf(x, a0.w, gr[3]);
                    gr[4] = fmaf(x, a1.x, gr[4]); gr[5] = fmaf(x, a1.y, gr[5]); gr[6] = fmaf(x, a1.z, gr[6]); gr[7] = fmaf(x, a1.w, gr[7]);
                    gi[0] = fmaf(x, x0.x, gi[0]); gi[1] = fmaf(x, x0.y, gi[1]); gi[2] = fmaf(x, x0.z, gi[2]); gi[3] = fmaf(x, x0.w, gi[3]);
                    gi[4] = fmaf(x, x1.x, gi[4]); gi[5] = fmaf(x, x1.y, gi[5]); gi[6] = fmaf(x, x1.z, gi[6]); gi[7] = fmaf(x, x1.w, gi[7]); }
#pragma unroll
                for (int i = 0; i < 8; ++i) { const float la = -8.f * sigmoidf_(gr[i]) * spl[i];
                    AA[tt * 64 + q8 + i] = __expf(la);
                    BV[tt * 64 + q8 + i] = sqrtf(-expm1f(2.f * la)) * sigmoidf_(gi[i]) * XC[tt * 64 + q8 + i]; }
            }
            __syncthreads();
            if (tid < 64) { for (int s = 0; s < 64; ++s) { const int st = e ? 63 - s : s; h = fmaf(AA[st * 64 + tid], h, BV[st * 64 + tid]); HH[st * 64 + tid] = h; } }
            __syncthreads();
            {
                bf16* dst = HF + (size_t)n * 256 + g * 64 + q8;
                float o[8];
#pragma unroll
                for (int i = 0; i < 8; ++i) o[i] = HH[tt * 64 + q8 + i];
                if (e) { const v4u hf = *(const v4u*)dst, gl = *(const v4u*)(G1 + (size_t)n * G1W + C_GL + g * 64 + q8);
                    o[0] = (o[0] + bflo(hf.x)) * siluf_(bflo(gl.x)); o[1] = (o[1] + bfhi(hf.x)) * siluf_(bfhi(gl.x)); o[2] = (o[2] + bflo(hf.y)) * siluf_(bflo(gl.y)); o[3] = (o[3] + bfhi(hf.y)) * siluf_(bfhi(gl.y));
                    o[4] = (o[4] + bflo(hf.z)) * siluf_(bflo(gl.z)); o[5] = (o[5] + bfhi(hf.z)) * siluf_(bfhi(gl.z)); o[6] = (o[6] + bflo(hf.w)) * siluf_(bflo(gl.w)); o[7] = (o[7] + bfhi(hf.w)) * siluf_(bfhi(gl.w)); }
                v4u ov; ov.x = pk2(o[0], o[1]); ov.y = pk2(o[2], o[3]); ov.z = pk2(o[4], o[5]); ov.w = pk2(o[6], o[7]);
                *(v4u*)dst = ov;
            }
            __syncthreads();
        }
        if (tid < 64 && !lat) a->out[O_LRU + ((size_t)(b * 2 + layer) * 2 + e) * 256 + g * 64 + tid] = h;
    }
}

__device__ __forceinline__ void phase_c1(ArgsP a, int layer) {
    const int tid = tid_(), lane = tid & 63, wave = tid >> 6, G = grid_();
    const bf16* G1 = (const bf16*)(a->ws + WS_G1); const bf16* YS = (const bf16*)(a->ws + WS_G2); const bf16* Q = (const bf16*)(a->ws + WS_Q); const bf16* HF = (const bf16*)(a->ws + WS_HF);
    bf16* Y = (bf16*)(a->ws + WS_YMIX);
    const int ch = lane * 4;
    const f32x4 rk = *(const f32x4*)(a->in[I_RK] + layer * 256 + ch), lg = *(const f32x4*)(a->in[I_LNXG] + layer * 256 + ch), lb = *(const f32x4*)(a->in[I_LNXB] + layer * 256 + ch);
    for (int n = bid_() * 8 + wave; n < T; n += G * 8) {
        const bf16* g = G1 + (size_t)n * G1W;
        const v2u y0 = *(const v2u*)(YS + (size_t)n * 256 + ch), y1 = *(const v2u*)(YS + ((size_t)T + n) * 256 + ch);
        float y[4] = {bflo(y0.x) + bflo(y1.x), bfhi(y0.x) + bfhi(y1.x), bflo(y0.y) + bflo(y1.y), bfhi(y0.y) + bfhi(y1.y)};
        const v2u rv = *(const v2u*)(g + C_R + ch), kv = *(const v2u*)(g + C_K + ch), vv = *(const v2u*)(g + C_V + ch), gv = *(const v2u*)(g + C_G + ch);
        float s = (y[0] + y[1]) + (y[2] + y[3]);
        float bon = bflo(rv.x) * bflo(kv.x) * rk.x + bfhi(rv.x) * bfhi(kv.x) * rk.y + bflo(rv.y) * bflo(kv.y) * rk.z + bfhi(rv.y) * bfhi(kv.y) * rk.w;
#pragma unroll
        for (int o = 1; o < 16; o <<= 1) { s += __shfl_xor(s, o); bon += __shfl_xor(bon, o); }
        const float mu = s * (1.f / 64.f);
        float s2 = (y[0] - mu) * (y[0] - mu) + (y[1] - mu) * (y[1] - mu) + (y[2] - mu) * (y[2] - mu) + (y[3] - mu) * (y[3] - mu);
#pragma unroll
        for (int o = 1; o < 16; o <<= 1) s2 += __shfl_xor(s2, o);
        const float rstd = rsqrtf(s2 * (1.f / 64.f) + GN_EPS);
        const float o0 = ((y[0] - mu) * rstd * lg.x + lb.x + bon * bflo(vv.x)) * siluf_(bflo(gv.x));
        const float o1 = ((y[1] - mu) * rstd * lg.y + lb.y + bon * bfhi(vv.x)) * siluf_(bfhi(gv.x));
        const float o2 = ((y[2] - mu) * rstd * lg.z + lb.z + bon * bflo(vv.y)) * siluf_(bflo(gv.y));
        const float o3 = ((y[3] - mu) * rstd * lg.w + lb.w + bon * bfhi(vv.y)) * siluf_(bfhi(gv.y));
        v2u ov; ov.x = pk2(o0, o1); ov.y = pk2(o2, o3);
        bf16* yr = Y + (size_t)n * 1024;
        *(v2u*)(yr + ch) = ov;
        *(v4u*)(yr + 256 + (lane >> 3) * 64 + (lane & 7) * 8) = *(const v4u*)(Q + (size_t)n * 768 + (lane >> 3) * 96 + (lane & 7) * 8);
        *(v2u*)(yr + 768 + ch) = *(const v2u*)(HF + (size_t)n * 256 + ch);
    }
}
typedef float f32x16 __attribute__((ext_vector_type(16)));
typedef float f32x2_t __attribute__((ext_vector_type(2)));
typedef __bf16 bf16x2_t __attribute__((ext_vector_type(2)));
__device__ __forceinline__ unsigned cvtpk(float lo, float hi) { const f32x2_t v = {lo, hi}; return __builtin_bit_cast(unsigned, __builtin_convertvector(v, bf16x2_t)); }
#define MFMA32(a, b, c) __builtin_amdgcn_mfma_f32_32x32x16_bf16((a), (b), (c), 0, 0, 0)
#define MFMA16(a, b, c) __builtin_amdgcn_mfma_f32_16x16x32_bf16((a), (b), (c), 0, 0, 0)

constexpr int ATT_KSTR = 208, ATT_VSTR = 136, ATT_VOFF = 64 * ATT_KSTR, ATT_STAGE = 64 * ATT_KSTR + 64 * ATT_VSTR;
__device__ __forceinline__ void att_unit(ArgsP a, LAS unsigned char* lds, int u) {
    const int tid = tid_(), lane = tid & 63, wave = tid >> 6, r = lane & 31, hq = lane >> 5;
    const bf16* KN = (const bf16*)(a->ws + WS_KN); const bf16* KR = (const bf16*)(a->ws + WS_KR); const bf16* VT = (const bf16*)(a->ws + WS_VT);
    bf16* Q = (bf16*)(a->ws + WS_Q); const bf16* G1 = (const bf16*)(a->ws + WS_G1);
    int b, h, n0, Lk, kidx0; size_t vbase;
    if (u < 512) { b = u >> 6; h = (u >> 3) & 7; n0 = T_CTX + b * 2048 + (u & 7) * 256; Lk = LK_LAT; kidx0 = T_CTX + b * LK_LAT; vbase = (size_t)VT_LAT + (size_t)(b * 8 + h) * 64 * LK_LAT; }
    else { const int uu = u - 512; b = uu >> 3; h = uu & 7; n0 = b * 256; Lk = 256; kidx0 = b * 256; vbase = (size_t)(b * 8 + h) * 64 * 256; }
    const int ntiles = Lk >> 6;
    const int n = n0 + wave * 32 + r;
    bf16x8 qf[6];
#pragma unroll
    for (int ks = 0; ks < 6; ++ks) qf[ks] = *(const bf16x8*)(Q + (size_t)n * 768 + h * 96 + ks * 16 + 8 * hq);
    const int key_k = tid >> 3, ck = tid & 7, key_r = (tid >> 2) & 63, cr = tid & 3;
    const bf16* gk = KN + (size_t)(kidx0 + key_k) * 512 + h * 64 + ck * 8;
    const bf16* gr = KR + (size_t)(kidx0 + key_r) * 32 + cr * 8;
    const bf16* gv = VT + vbase + (size_t)key_k * Lk + ck * 8;
    const unsigned sk = key_k * ATT_KSTR + ck * 16, sr = key_r * ATT_KSTR + 128 + cr * 16, sv = ATT_VOFF + key_k * ATT_VSTR + ck * 16;
    v4u rk, rr, rv;
    rk = *(const v4u*)gk; rr = (tid < 256) ? *(const v4u*)gr : (v4u){0u, 0u, 0u, 0u}; rv = *(const v4u*)gv;
    __syncthreads();
    *(LAS v4u*)(lds + sk) = rk; if (tid < 256) *(LAS v4u*)(lds + sr) = rr;
    *(LAS v2u*)(lds + sv) = (v2u){rv.x, rv.y}; *(LAS v2u*)(lds + sv + 8) = (v2u){rv.z, rv.w};
    __syncthreads();
    f32x16 o0, o1;
#pragma unroll
    for (int i = 0; i < 16; ++i) { o0[i] = 0.f; o1[i] = 0.f; }
    float m = -1e30f, l = 0.f;
    for (int j = 0; j < ntiles; ++j) {
        const int buf = j & 1;
        if (j + 1 < ntiles) { rk = *(const v4u*)(gk + (size_t)(j + 1) * 64 * 512); if (tid < 256) rr = *(const v4u*)(gr + (size_t)(j + 1) * 64 * 32); rv = *(const v4u*)(gv + (j + 1) * 64); }
        const LAS unsigned char* Kb = lds + buf * ATT_STAGE;
        f32x16 s0, s1;
#pragma unroll
        for (int i = 0; i < 16; ++i) { s0[i] = 0.f; s1[i] = 0.f; }
#pragma unroll
        for (int ks = 0; ks < 6; ++ks) {
            const bf16x8 a0 = *(const LAS bf16x8*)(Kb + r * ATT_KSTR + ks * 32 + hq * 16), a1 = *(const LAS bf16x8*)(Kb + (32 + r) * ATT_KSTR + ks * 32 + hq * 16);
            s0 = MFMA32(a0, qf[ks], s0); s1 = MFMA32(a1, qf[ks], s1);
        }
        float mx = s0[0];
#pragma unroll
        for (int i = 1; i < 16; ++i) mx = fmaxf(mx, s0[i]);
#pragma unroll
        for (int i = 0; i < 16; ++i) mx = fmaxf(mx, s1[i]);
        mx = fmaxf(mx, __shfl_xor(mx, 32));
        const float mn = fmaxf(m, mx), alpha = __builtin_amdgcn_exp2f(m - mn); m = mn;
        float ps = 0.f;
#pragma unroll
        for (int i = 0; i < 16; ++i) { s0[i] = __builtin_amdgcn_exp2f(s0[i] - mn); s1[i] = __builtin_amdgcn_exp2f(s1[i] - mn); ps += s0[i] + s1[i]; }
        l = l * alpha + ps;
#pragma unroll
        for (int i = 0; i < 16; ++i) { o0[i] *= alpha; o1[i] *= alpha; }
        const LAS unsigned char* Vb = Kb + ATT_VOFF;
#pragma unroll
        for (int ks = 0; ks < 4; ++ks) {
            v4u pw;
            if (ks == 0) { pw.x = cvtpk(s0[0], s0[1]); pw.y = cvtpk(s0[2], s0[3]); pw.z = cvtpk(s0[4], s0[5]); pw.w = cvtpk(s0[6], s0[7]); }
            else if (ks == 1) { pw.x = cvtpk(s0[8], s0[9]); pw.y = cvtpk(s0[10], s0[11]); pw.z = cvtpk(s0[12], s0[13]); pw.w = cvtpk(s0[14], s0[15]); }
            else if (ks == 2) { pw.x = cvtpk(s1[0], s1[1]); pw.y = cvtpk(s1[2], s1[3]); pw.z = cvtpk(s1[4], s1[5]); pw.w = cvtpk(s1[6], s1[7]); }
            else { pw.x = cvtpk(s1[8], s1[9]); pw.y = cvtpk(s1[10], s1[11]); pw.z = cvtpk(s1[12], s1[13]); pw.w = cvtpk(s1[14], s1[15]); }
            const bf16x8 pf = __builtin_bit_cast(bf16x8, pw);
            const v2u va0 = *(const LAS v2u*)(Vb + r * ATT_VSTR + ks * 32 + hq * 8), va1 = *(const LAS v2u*)(Vb + r * ATT_VSTR + ks * 32 + 16 + hq * 8);
            const v2u vb0 = *(const LAS v2u*)(Vb + (32 + r) * ATT_VSTR + ks * 32 + hq * 8), vb1 = *(const LAS v2u*)(Vb + (32 + r) * ATT_VSTR + ks * 32 + 16 + hq * 8);
            const v4u vwa = {va0.x, va0.y, va1.x, va1.y}, vwb = {vb0.x, vb0.y, vb1.x, vb1.y};
            o0 = MFMA32(__builtin_bit_cast(bf16x8, vwa), pf, o0); o1 = MFMA32(__builtin_bit_cast(bf16x8, vwb), pf, o1);
        }
        if (j + 1 < ntiles) {
            LAS unsigned char* Nb = lds + (buf ^ 1) * ATT_STAGE;
            *(LAS v4u*)(Nb + sk) = rk; if (tid < 256) *(LAS v4u*)(Nb + sr) = rr;
            *(LAS v2u*)(Nb + sv) = (v2u){rv.x, rv.y}; *(LAS v2u*)(Nb + sv + 8) = (v2u){rv.z, rv.w};
        }
        __syncthreads();
    }
    l += __shfl_xor(l, 32);
    const float inv = 1.f / l;
#pragma unroll
    for (int mt = 0; mt < 2; ++mt)
#pragma unroll
        for (int g = 0; g < 4; ++g) {
            const int dv0 = 32 * mt + 8 * g + 4 * hq;
            const v2u gm = *(const v2u*)(G1 + (size_t)n * G1W + C_GM + h * 64 + dv0);
            const float x0 = (mt ? o1[4 * g + 0] : o0[4 * g + 0]) * inv, x1 = (mt ? o1[4 * g + 1] : o0[4 * g + 1]) * inv, x2 = (mt ? o1[4 * g + 2] : o0[4 * g + 2]) * inv, x3 = (mt ? o1[4 * g + 3] : o0[4 * g + 3]) * inv;
            v2u ov; ov.x = cvtpk(x0 * siluf_(bflo(gm.x)), x1 * siluf_(bfhi(gm.x))); ov.y = cvtpk(x2 * siluf_(bflo(gm.y)), x3 * siluf_(bfhi(gm.y)));
            *(v2u*)(Q + (size_t)n * 768 + h * 96 + dv0) = ov;
        }
}

constexpr int A2_QSTR = 528, A2_KVSTR = 272, A2_KVOFF = 64 * A2_QSTR;
__device__ __forceinline__ void a2_unit(ArgsP a, LAS unsigned char* lds, int layer, int unit) {
    const int tid = tid_(), lane = tid & 63, wave = tid >> 6, tn = lane & 15, g = lane >> 4;
    constexpr int NU_TOK = T / 64;
    const bool is_tok = unit < NU_TOK;
    const bf16* G2 = (const bf16*)(a->ws + WS_G2);
    bf16* Q = (bf16*)(a->ws + WS_Q); bf16* KN = (bf16*)(a->ws + WS_KN); bf16* KR = (bf16*)(a->ws + WS_KR); bf16* VT = (bf16*)(a->ws + WS_VT);
    const bf16* WUQ = (const bf16*)(a->ws + WS_WUQ) + (size_t)layer * 768 * 256;
    const bf16* WUKV = (const bf16*)(a->ws + WS_WUKV) + (size_t)layer * 1024 * 128;
    const float* ROPE1 = (const float*)(a->ws + WS_ROPE);
    __syncthreads();
    for (int rr = 0; rr < 8; ++rr) {
        const int r = wave * 8 + rr;
        if (is_tok) {
            const int n = unit * 64 + r; const Tok tk = tok_of(n);
            const v2u cqv = *(const v2u*)(G2 + (size_t)n * G2W + lane * 4);
            const float c0 = bflo(cqv.x), c1 = bfhi(cqv.x), c2 = bflo(cqv.y), c3 = bfhi(cqv.y);
            const float rq = rsqrtf(wave_sum(c0 * c0 + c1 * c1 + c2 * c2 + c3 * c3) * (1.f / 256.f) + 1e-6f);
            const f32x4 qn = *(const f32x4*)(a->in[I_QNORM] + layer * 256 + lane * 4);
            *(LAS v2u*)(lds + r * A2_QSTR + lane * 8) = (v2u){cvtpk(c0 * rq * qn.x, c1 * rq * qn.y), cvtpk(c2 * rq * qn.z, c3 * rq * qn.w)};
            float k0 = 0.f, k1 = 0.f, k2 = 0.f, k3 = 0.f;
            if (lane < 32) { const v2u kv = *(const v2u*)(G2 + (size_t)n * G2W + 256 + lane * 4); k0 = bflo(kv.x); k1 = bfhi(kv.x); k2 = bflo(kv.y); k3 = bfhi(kv.y); }
            const float rk = rsqrtf(wave_sum(k0 * k0 + k1 * k1 + k2 * k2 + k3 * k3) * (1.f / 128.f) + 1e-6f);
            if (lane < 32) {
                const f32x4 kn = *(const f32x4*)(a->in[I_KVNORM] + layer * 128 + lane * 4);
                f32x4 o; o.x = k0 * rk * kn.x; o.y = k1 * rk * kn.y; o.z = k2 * rk * kn.z; o.w = k3 * rk * kn.w;
                if (!tk.lat) *(f32x4*)(a->out + O_CKV + ((size_t)(tk.b * 2 + layer) * 256 + tk.t) * 128 + lane * 4) = o;
                *(LAS v2u*)(lds + A2_KVOFF + r * A2_KVSTR + lane * 8) = (v2u){cvtpk(o.x, o.y), cvtpk(o.z, o.w)};
            }
            float krv = (lane < 32) ? bf2f(G2[(size_t)n * G2W + 384 + lane]) : 0.f;
            const float other = __shfl_xor(krv, 1);
            if (lane < 32) {
                if (!tk.lat) a->out[O_KR + ((size_t)(tk.b * 2 + layer) * 256 + tk.t) * 32 + lane] = krv;
                else { const float c = ROPE1[((size_t)tk.t * 16 + (lane >> 1)) * 2], s = ROPE1[((size_t)tk.t * 16 + (lane >> 1)) * 2 + 1]; krv = (lane & 1) ? (other * s + krv * c) : (krv * c - other * s); }
                KR[(size_t)tk.kidx * 32 + lane] = (bf16)f2bf(krv);
            }
        } else {
            const int cr = (unit - NU_TOK) * 64 + r, b = cr >> 8, j = cr & 255;
            const size_t src = ((size_t)(b * 2 + layer) * 256 + j);
            if (lane < 32) { const f32x4 v = *(const f32x4*)(a->in[I_CCKV] + src * 128 + lane * 4);
                *(LAS v2u*)(lds + A2_KVOFF + r * A2_KVSTR + lane * 8) = (v2u){cvtpk(v.x, v.y), cvtpk(v.z, v.w)};
                KR[(size_t)(T_CTX + b * LK_LAT + j) * 32 + lane] = (bf16)f2bf(a->in[I_CKR][src * 32 + lane]); }
        }
    }
    __syncthreads();
    if (is_tok) {
      const float* ROPE = (const float*)(a->ws + WS_ROPE);
      for (int qh = 0; qh < 2; ++qh) {
        f32x4 acc[3][4];
#pragma unroll
        for (int f = 0; f < 3; ++f)
#pragma unroll
            for (int t = 0; t < 4; ++t) acc[f][t] = (f32x4){0.f, 0.f, 0.f, 0.f};
#pragma unroll 2
        for (int ks = 0; ks < 8; ++ks) {
            bf16x8 bfr[4];
#pragma unroll
            for (int t = 0; t < 4; ++t) bfr[t] = *(const LAS bf16x8*)(lds + (t * 16 + tn) * A2_QSTR + ks * 64 + g * 16);
#pragma unroll
            for (int f = 0; f < 3; ++f) { const bf16x8 af = *(const bf16x8*)(WUQ + (size_t)((wave * 6 + qh * 3 + f) * 16 + tn) * 256 + ks * 32 + g * 8);
#pragma unroll
                for (int t = 0; t < 4; ++t) acc[f][t] = MFMA16(af, bfr[t], acc[f][t]); }
        }
#pragma unroll
        for (int f = 0; f < 3; ++f) { const int f0 = (wave * 6 + qh * 3 + f) * 16 + 4 * g, d = f0 % 96;
#pragma unroll
            for (int t = 0; t < 4; ++t) { const int n = unit * 64 + t * 16 + tn;
                float v0 = acc[f][t][0], v1 = acc[f][t][1], v2 = acc[f][t][2], v3 = acc[f][t][3];
                if (n >= T_CTX && d >= 64) { const int tt = (n - T_CTX) & 2047; const f32x4 cs = *(const f32x4*)(ROPE + ((size_t)tt * 16 + ((d - 64) >> 1)) * 2);
                    const float y0 = v0 * cs.x - v1 * cs.y, y1 = v0 * cs.y + v1 * cs.x, y2 = v2 * cs.z - v3 * cs.w, y3 = v2 * cs.w + v3 * cs.z; v0 = y0; v1 = y1; v2 = y2; v3 = y3; }
                *(v2u*)(Q + (size_t)n * 768 + f0) = (v2u){cvtpk(v0, v1), cvtpk(v2, v3)}; } }
      }
    }
    for (int half = 0; half < 2; ++half) {
        f32x4 acc[4][4];
#pragma unroll
        for (int f = 0; f < 4; ++f)
#pragma unroll
            for (int t = 0; t < 4; ++t) acc[f][t] = (f32x4){0.f, 0.f, 0.f, 0.f};
#pragma unroll 2
        for (int ks = 0; ks < 4; ++ks) {
            bf16x8 bfr[4];
#pragma unroll
            for (int t = 0; t < 4; ++t) bfr[t] = *(const LAS bf16x8*)(lds + A2_KVOFF + (t * 16 + tn) * A2_KVSTR + ks * 64 + g * 16);
#pragma unroll
            for (int f = 0; f < 4; ++f) { const bf16x8 af = *(const bf16x8*)(WUKV + (size_t)((wave * 8 + half * 4 + f) * 16 + tn) * 128 + ks * 32 + g * 8);
#pragma unroll
                for (int t = 0; t < 4; ++t) acc[f][t] = MFMA16(af, bfr[t], acc[f][t]); }
        }
#pragma unroll
        for (int f = 0; f < 4; ++f) { const int f0 = (wave * 8 + half * 4 + f) * 16 + 4 * g, h = f0 >> 7, x = f0 & 127;
#pragma unroll
            for (int t = 0; t < 4; ++t) { const int r = t * 16 + tn;
                int kidx, lat, b, kpos;
                if (is_tok) { const Tok tk = tok_of(unit * 64 + r); kidx = tk.kidx; lat = tk.lat; b = tk.b; kpos = tk.lat ? PAST + tk.t : tk.t; }
                else { const int cr = (unit - NU_TOK) * 64 + r; b = cr >> 8; kpos = cr & 255; lat = 1; kidx = T_CTX + b * LK_LAT + kpos; }
                if (x < 64) *(v2u*)(KN + (size_t)kidx * 512 + h * 64 + x) = (v2u){cvtpk(acc[f][t][0], acc[f][t][1]), cvtpk(acc[f][t][2], acc[f][t][3])};
                else {
                    const size_t base = lat ? (size_t)VT_LAT + ((size_t)(b * 8 + h) * 64 + (x - 64)) * LK_LAT + kpos : ((size_t)(b * 8 + h) * 64 + (x - 64)) * 256 + kpos;
                    const int Lk = lat ? LK_LAT : 256;
                    VT[base] = (bf16)f2bf(acc[f][t][0]); VT[base + Lk] = (bf16)f2bf(acc[f][t][1]); VT[base + 2 * Lk] = (bf16)f2bf(acc[f][t][2]); VT[base + 3 * Lk] = (bf16)f2bf(acc[f][t][3]);
                } } }
    }
}

constexpr int RW_W2T = 0, RW_A2T = 9216, RW_TH = 18432, RW_HA = 27648, RW_CH0 = 36864, RW_CHB = 20992;
constexpr int RC_KP = 0, RC_RP = 2304, RC_BP = 4608, RC_KT = 6912, RC_KTT = 9216, RC_NBPT = 11776, RC_VTT = 14336, RC_LK = 16896, RC_TM = 17536, RC_ARK = 18176, RC_NARB = 18816, RC_G15 = 19456, RC_LBF = 19712, RC_SSQ = 20736;
__device__ __forceinline__ void rwkv_unit_mfma(ArgsP a, LAS unsigned char* lds, int layer, int u) {
    const int tid = tid_(), lane = tid & 63, wave = tid >> 6, i16 = lane & 15, g = lane >> 4;
    const int lat = u < 64, uu = lat ? u : u - 64, b = uu >> 3, e = (uu >> 2) & 1, hh = uu & 3;
    const int L = lat ? L_LAT : L_CTX, tok0 = lat ? T_CTX + b * L_LAT : b * L_CTX;
    const bf16* G1 = (const bf16*)(a->ws + WS_G1);
    bf16* YS = (bf16*)(a->ws + WS_G2);
    __syncthreads();
    for (int i = tid; i < 4096; i += NTHREADS) { const int j = i >> 6, c = i & 63;
        *(LAS bf16*)(lds + RW_W2T + (c * 72 + j) * 2) = (bf16)f2bf(a->in[I_W2][((size_t)(layer * 2 + e) * 64 + j) * 256 + hh * 64 + c]);
        *(LAS bf16*)(lds + RW_A2T + (c * 72 + j) * 2) = (bf16)f2bf(a->in[I_A2][((size_t)(layer * 2 + e) * 64 + j) * 256 + hh * 64 + c]); }
    const int st_tok = tid >> 3, st_c8 = (tid & 7) * 8;
#define RW_STAGE(sc) do { const int step_ = (sc) * 64 + st_tok, t_ = e ? L - 1 - step_ : step_; const bf16* gp_ = G1 + (size_t)(tok0 + t_) * G1W + C_LORA + e * 64 + st_c8; \
        const v4u hw_ = *(const v4u*)gp_, ha_ = *(const v4u*)(gp_ + 128); v4u th_; \
        th_.x = cvtpk(tanhf(bflo(hw_.x)), tanhf(bfhi(hw_.x))); th_.y = cvtpk(tanhf(bflo(hw_.y)), tanhf(bfhi(hw_.y))); th_.z = cvtpk(tanhf(bflo(hw_.z)), tanhf(bfhi(hw_.z))); th_.w = cvtpk(tanhf(bflo(hw_.w)), tanhf(bfhi(hw_.w))); \
        *(LAS v4u*)(lds + RW_TH + st_tok * 144 + st_c8 * 2) = th_; *(LAS v4u*)(lds + RW_HA + st_tok * 144 + st_c8 * 2) = ha_; } while (0)
    RW_STAGE(0);
    f32x4 ST[4];
    {
        const int v = 16 * (wave & 3) + i16;
#pragma unroll
        for (int kt = 0; kt < 4; ++kt) ST[kt] = lat ? *(const f32x4*)(a->in[I_SRW] + (((size_t)((b * 2 + layer) * 2 + e) * 4 + hh) * 64 + v) * 64 + 16 * kt + 4 * g) : (f32x4){0.f, 0.f, 0.f, 0.f};
    }
    const int pc = wave & 3, ph = wave >> 2;
    LAS unsigned char* CH = lds + RW_CH0 + pc * RW_CHB;
    __syncthreads();
    const int nsc = L >> 6;
    for (int sc = 0; sc < nsc; ++sc) {
        const int pstep = sc * 64 + pc * 16 + i16, pt = e ? L - 1 - pstep : pstep, pn = tok0 + pt;
        const bf16* gp = G1 + (size_t)pn * G1W;
        float dec[8], av[8], kx[8], rx[8], kk[8];
        {
            f32x4 aw[2], aa[2];
#pragma unroll
            for (int c2 = 0; c2 < 2; ++c2) { aw[c2] = (f32x4){0.f, 0.f, 0.f, 0.f}; aa[c2] = (f32x4){0.f, 0.f, 0.f, 0.f}; }
#pragma unroll
            for (int ks = 0; ks < 2; ++ks) {
                const bf16x8 bth = *(const LAS bf16x8*)(lds + RW_TH + (pc * 16 + i16) * 144 + ks * 64 + g * 16), bha = *(const LAS bf16x8*)(lds + RW_HA + (pc * 16 + i16) * 144 + ks * 64 + g * 16);
#pragma unroll
                for (int c2 = 0; c2 < 2; ++c2) { const int row = (2 * ph + c2) * 16 + i16;
                    const bf16x8 w2f = *(const LAS bf16x8*)(lds + RW_W2T + row * 144 + ks * 64 + g * 16), a2f = *(const LAS bf16x8*)(lds + RW_A2T + row * 144 + ks * 64 + g * 16);
                    aw[c2] = MFMA16(w2f, bth, aw[c2]); aa[c2] = MFMA16(a2f, bha, aa[c2]); }
            }
            float ss = 0.f;
#pragma unroll
            for (int c2 = 0; c2 < 2; ++c2) { const int ch = (2 * ph + c2) * 16 + 4 * g, gch = hh * 64 + ch;
                const f32x4 w0 = *(const f32x4*)(a->in[I_W0] + (layer * 2 + e) * 256 + gch), a0 = *(const f32x4*)(a->in[I_A0] + (layer * 2 + e) * 256 + gch), kw = *(const f32x4*)(a->in[I_KK] + layer * 256 + gch);
                const v2u kv = *(const v2u*)(gp + C_K + gch), rv = *(const v2u*)(gp + C_R + gch);
                const float kq[4] = {bflo(kv.x), bfhi(kv.x), bflo(kv.y), bfhi(kv.y)}, rq[4] = {bflo(rv.x), bfhi(rv.x), bflo(rv.y), bfhi(rv.y)};
#pragma unroll
                for (int q = 0; q < 4; ++q) { const int o = c2 * 4 + q;
                    dec[o] = __expf(-0.6065306597126334f * sigmoidf_(aw[c2][q] + w0[q])); av[o] = sigmoidf_(aa[c2][q] + a0[q]);
                    kx[o] = kq[q]; rx[o] = rq[q]; kk[o] = kq[q] * kw[q]; ss += kk[o] * kk[o]; }
            }
            ss += __shfl_xor(ss, 16); ss += __shfl_xor(ss, 32);
            if (g == 0) *(LAS float*)(CH + RC_SSQ + (i16 * 2 + ph) * 4) = ss;
        }
        __syncthreads();
        {
            const float tot = *(const LAS float*)(CH + RC_SSQ + (i16 * 2) * 4) + *(const LAS float*)(CH + RC_SSQ + (i16 * 2 + 1) * 4);
            const float inrm = 1.f / fmaxf(sqrtf(tot), 1e-12f);
#pragma unroll
            for (int c2 = 0; c2 < 2; ++c2) { const int ch = (2 * ph + c2) * 16 + 4 * g, gch = hh * 64 + ch;
                const f32x4 ka = *(const f32x4*)(a->in[I_KA] + layer * 256 + gch);
                float kp[4], bp[4], kt[4], rp[4];
#pragma unroll
                for (int q = 0; q < 4; ++q) { const int o = c2 * 4 + q;
                    float G = dec[o];
#pragma unroll
                    for (int d = 1; d < 16; d <<= 1) { const float t = __shfl_up(G, d, 16); if (i16 >= d) G *= t; }
                    float Gex = __shfl_up(G, 1, 16); if (i16 == 0) Gex = 1.f;
                    const float kkn = kk[o] * inrm, iG = 1.f / G;
                    kp[q] = Gex * kkn; bp[q] = kkn * av[o] * iG; kt[q] = kx[o] * (1.f + (av[o] - 1.f) * ka[q]) * iG; rp[q] = G * rx[o];
                    if (i16 == 15) *(LAS float*)(CH + RC_G15 + (ch + q) * 4) = G;
                    *(LAS bf16*)(CH + RC_KTT + (ch + q) * 40 + i16 * 2) = (bf16)f2bf(kt[q]); *(LAS bf16*)(CH + RC_NBPT + (ch + q) * 40 + i16 * 2) = (bf16)f2bf(-bp[q]); }
                *(LAS v2u*)(CH + RC_KP + i16 * 144 + ch * 2) = (v2u){cvtpk(kp[0], kp[1]), cvtpk(kp[2], kp[3])};
                *(LAS v2u*)(CH + RC_BP + i16 * 144 + ch * 2) = (v2u){cvtpk(bp[0], bp[1]), cvtpk(bp[2], bp[3])};
                *(LAS v2u*)(CH + RC_KT + i16 * 144 + ch * 2) = (v2u){cvtpk(kt[0], kt[1]), cvtpk(kt[2], kt[3])};
                *(LAS v2u*)(CH + RC_RP + i16 * 144 + ch * 2) = (v2u){cvtpk(rp[0], rp[1]), cvtpk(rp[2], rp[3])};
                const v2u vv = *(const v2u*)(gp + C_V + gch);
                *(LAS bf16*)(CH + RC_VTT + (ch + 0) * 40 + i16 * 2) = (bf16)(vv.x & 0xffffu); *(LAS bf16*)(CH + RC_VTT + (ch + 1) * 40 + i16 * 2) = (bf16)(vv.x >> 16);
                *(LAS bf16*)(CH + RC_VTT + (ch + 2) * 40 + i16 * 2) = (bf16)(vv.y & 0xffffu); *(LAS bf16*)(CH + RC_VTT + (ch + 3) * 40 + i16 * 2) = (bf16)(vv.y >> 16);
            }
        }
        __syncthreads();
        {
            f32x4 d0 = (f32x4){0.f, 0.f, 0.f, 0.f}, d1 = (f32x4){0.f, 0.f, 0.f, 0.f};
            const int xoff = ph ? RC_RP : RC_KP, y0off = ph ? RC_KT : RC_BP, y1off = ph ? RC_BP : RC_KT;
#pragma unroll
            for (int ks = 0; ks < 2; ++ks) {
                const bf16x8 xf = *(const LAS bf16x8*)(CH + xoff + i16 * 144 + ks * 64 + g * 16);
                const bf16x8 y0 = *(const LAS bf16x8*)(CH + y0off + i16 * 144 + ks * 64 + g * 16), y1 = *(const LAS bf16x8*)(CH + y1off + i16 * 144 + ks * 64 + g * 16);
                d0 = MFMA16(xf, y0, d0); d1 = MFMA16(xf, y1, d1);
            }
#pragma unroll
            for (int q = 0; q < 4; ++q) { const int i = 4 * g + q, j = i16;
                if (ph == 0) { *(LAS float*)(CH + RC_LBF + (i * 16 + j) * 4) = (j < i) ? d0[q] : 0.f; *(LAS bf16*)(CH + RC_LK + i * 40 + j * 2) = (bf16)f2bf((j < i) ? d1[q] : 0.f); }
                else { *(LAS bf16*)(CH + RC_ARK + i * 40 + j * 2) = (bf16)f2bf((j <= i) ? d0[q] : 0.f); *(LAS bf16*)(CH + RC_NARB + i * 40 + j * 2) = (bf16)f2bf((j <= i) ? -d1[q] : 0.f); }
            }
            if (ph == 0) {
                float x[16];
#pragma unroll
                for (int i = 0; i < 16; ++i) { float s = (i == i16) ? 1.f : 0.f;
#pragma unroll
                    for (int j4 = 0; j4 < (i + 3) / 4; ++j4) { const f32x4 lr = *(const LAS f32x4*)(CH + RC_LBF + (i * 16 + j4 * 4) * 4);
#pragma unroll
                        for (int jj = 0; jj < 4; ++jj) { const int j = j4 * 4 + jj; if (j < i) s -= lr[jj] * x[j]; } }
                    x[i] = s; }
                if (g == 0) {
#pragma unroll
                    for (int i = 0; i < 16; ++i) *(LAS bf16*)(CH + RC_TM + i * 40 + i16 * 2) = (bf16)f2bf(x[i]); }
            }
        }
        __syncthreads();
        if (wave < 4) {
            const int vt = wave;
#pragma unroll 1
            for (int c = 0; c < 4; ++c) {
                const LAS unsigned char* C = lds + RW_CH0 + c * RW_CHB;
                v4u sb01, sb23;
                sb01.x = cvtpk(ST[0][0], ST[0][1]); sb01.y = cvtpk(ST[0][2], ST[0][3]); sb01.z = cvtpk(ST[1][0], ST[1][1]); sb01.w = cvtpk(ST[1][2], ST[1][3]);
                sb23.x = cvtpk(ST[2][0], ST[2][1]); sb23.y = cvtpk(ST[2][2], ST[2][3]); sb23.z = cvtpk(ST[3][0], ST[3][1]); sb23.w = cvtpk(ST[3][2], ST[3][3]);
                const bf16x8 s01 = __builtin_bit_cast(bf16x8, sb01), s23 = __builtin_bit_cast(bf16x8, sb23);
                const v2u kp0a = *(const LAS v2u*)(C + RC_KP + i16 * 144 + (4 * g) * 2), kp0b = *(const LAS v2u*)(C + RC_KP + i16 * 144 + (16 + 4 * g) * 2);
                const v2u kp1a = *(const LAS v2u*)(C + RC_KP + i16 * 144 + (32 + 4 * g) * 2), kp1b = *(const LAS v2u*)(C + RC_KP + i16 * 144 + (48 + 4 * g) * 2);
                const v2u rp0a = *(const LAS v2u*)(C + RC_RP + i16 * 144 + (4 * g) * 2), rp0b = *(const LAS v2u*)(C + RC_RP + i16 * 144 + (16 + 4 * g) * 2);
                const v2u rp1a = *(const LAS v2u*)(C + RC_RP + i16 * 144 + (32 + 4 * g) * 2), rp1b = *(const LAS v2u*)(C + RC_RP + i16 * 144 + (48 + 4 * g) * 2);
                const v2u lk = *(const LAS v2u*)(C + RC_LK + i16 * 40 + g * 8), tm = *(const LAS v2u*)(C + RC_TM + i16 * 40 + g * 8);
                const v2u ark = *(const LAS v2u*)(C + RC_ARK + i16 * 40 + g * 8), narb = *(const LAS v2u*)(C + RC_NARB + i16 * 40 + g * 8);
                const v2u vf = *(const LAS v2u*)(C + RC_VTT + (16 * vt + i16) * 40 + g * 8);
                const v4u z4 = {0u, 0u, 0u, 0u};
                f32x4 rhs = (f32x4){0.f, 0.f, 0.f, 0.f};
                rhs = MFMA16(__builtin_bit_cast(bf16x8, ((v4u){kp0a.x, kp0a.y, kp0b.x, kp0b.y})), s01, rhs);
                rhs = MFMA16(__builtin_bit_cast(bf16x8, ((v4u){kp1a.x, kp1a.y, kp1b.x, kp1b.y})), s23, rhs);
                rhs = MFMA16(__builtin_bit_cast(bf16x8, ((v4u){lk.x, lk.y, 0u, 0u})), __builtin_bit_cast(bf16x8, ((v4u){vf.x, vf.y, 0u, 0u})), rhs);
                f32x4 z = MFMA16(__builtin_bit_cast(bf16x8, ((v4u){tm.x, tm.y, 0u, 0u})), __builtin_bit_cast(bf16x8, ((v4u){cvtpk(rhs[0], rhs[1]), cvtpk(rhs[2], rhs[3]), 0u, 0u})), ((f32x4){0.f, 0.f, 0.f, 0.f}));
                const bf16x8 vz = __builtin_bit_cast(bf16x8, ((v4u){vf.x, vf.y, cvtpk(z[0], z[1]), cvtpk(z[2], z[3])}));
                f32x4 y = (f32x4){0.f, 0.f, 0.f, 0.f};
                y = MFMA16(__builtin_bit_cast(bf16x8, ((v4u){rp0a.x, rp0a.y, rp0b.x, rp0b.y})), s01, y);
                y = MFMA16(__builtin_bit_cast(bf16x8, ((v4u){rp1a.x, rp1a.y, rp1b.x, rp1b.y})), s23, y);
                y = MFMA16(__builtin_bit_cast(bf16x8, ((v4u){ark.x, ark.y, narb.x, narb.y})), vz, y);
#pragma unroll
                for (int kt = 0; kt < 4; ++kt) {
                    const v2u ktf = *(const LAS v2u*)(C + RC_KTT + (16 * kt + i16) * 40 + g * 8), nbf = *(const LAS v2u*)(C + RC_NBPT + (16 * kt + i16) * 40 + g * 8);
                    const f32x4 g15 = *(const LAS f32x4*)(C + RC_G15 + (16 * kt + 4 * g) * 4);
                    ST[kt] = MFMA16(__builtin_bit_cast(bf16x8, ((v4u){ktf.x, ktf.y, nbf.x, nbf.y})), vz, ST[kt]);
                    ST[kt] = ST[kt] * g15;
                }
#pragma unroll
                for (int q = 0; q < 4; ++q) { const int step = sc * 64 + c * 16 + 4 * g + q, t = e ? L - 1 - step : step;
                    YS[((size_t)e * T + tok0 + t) * 256 + hh * 64 + 16 * vt + i16] = (bf16)f2bf(y[q]); }
                (void)z4;
            }
        } else if (sc + 1 < nsc) {
            const int r0 = (tid - 256) >> 3;
#pragma unroll
            for (int hrow = 0; hrow < 2; ++hrow) { const int tokr = r0 + 32 * hrow, step_ = (sc + 1) * 64 + tokr, t_ = e ? L - 1 - step_ : step_;
                const bf16* gp_ = G1 + (size_t)(tok0 + t_) * G1W + C_LORA + e * 64 + st_c8;
                const v4u hw_ = *(const v4u*)gp_, ha_ = *(const v4u*)(gp_ + 128); v4u th_;
                th_.x = cvtpk(tanhf(bflo(hw_.x)), tanhf(bfhi(hw_.x))); th_.y = cvtpk(tanhf(bflo(hw_.y)), tanhf(bfhi(hw_.y))); th_.z = cvtpk(tanhf(bflo(hw_.z)), tanhf(bfhi(hw_.z))); th_.w = cvtpk(tanhf(bflo(hw_.w)), tanhf(bfhi(hw_.w)));
                *(LAS v4u*)(lds + RW_TH + tokr * 144 + st_c8 * 2) = th_; *(LAS v4u*)(lds + RW_HA + tokr * 144 + st_c8 * 2) = ha_; }
        }
        __syncthreads();
    }
#undef RW_STAGE
    if (!lat && wave < 4) {
        const int v = 16 * wave + i16;
#pragma unroll
        for (int kt = 0; kt < 4; ++kt) *(f32x4*)(a->out + O_RW + (((size_t)((b * 2 + layer) * 2 + e) * 4 + hh) * 64 + v) * 64 + 16 * kt + 4 * g) = ST[kt];
    }
}

constexpr int LR_WAT = 0, LR_XCB = 18432, LR_XCF = 27648, LR_AA = 44032, LR_BV = 60416, LR_HH = 76800, LR_SP = 93184, LR_SH = 95232, LR_HC = 97280;
__device__ __forceinline__ void lru_unit_mfma(ArgsP a, LAS unsigned char* lds, int layer, int u) {
    const int tid = tid_(), lane = tid & 63, wave = tid >> 6, i16 = lane & 15, g4 = lane >> 4;
    const int lat = u < 32, uu = lat ? u : u - 32, b = uu >> 2, g = uu & 3;
    const int L = lat ? L_LAT : L_CTX, tok0 = lat ? T_CTX + b * L_LAT : b * L_CTX;
    const bf16* G1 = (const bf16*)(a->ws + WS_G1);
    bf16* HF = (bf16*)(a->ws + WS_HF);
    LAS float* XCF = (LAS float*)(lds + LR_XCF); LAS float* AA = (LAS float*)(lds + LR_AA); LAS float* BV = (LAS float*)(lds + LR_BV); LAS float* HH = (LAS float*)(lds + LR_HH);
    LAS float* SP = (LAS float*)(lds + LR_SP); LAS float* SH = (LAS float*)(lds + LR_SH); LAS float* HC = (LAS float*)(lds + LR_HC);
    const int tt = tid >> 3, q8 = (tid & 7) * 8;
    float cw[4][8], cb[8];
#pragma unroll
    for (int i = 0; i < 8; ++i) { const int ch = g * 64 + q8 + i; cb[i] = a->in[I_CONVB][layer * 256 + ch];
#pragma unroll
        for (int j = 0; j < 4; ++j) cw[j][i] = a->in[I_CONVW][(layer * 4 + j) * 256 + ch]; }
    const int ot = wave & 3, tp = wave >> 2;
    const int sch = tid & 63, seg = tid >> 6;
    for (int e = 0; e < 2; ++e) {
        __syncthreads();
        for (int i = tid; i < 4096; i += NTHREADS) { const size_t src = ((size_t)((layer * 2 + e) * 4 + g)) * 4096 + i; const int ii = i >> 6, oo = i & 63;
            *(LAS bf16*)(lds + LR_WAT + (oo * 72 + ii) * 2) = (bf16)f2bf(a->in[I_WA][src]); *(LAS bf16*)(lds + LR_WAT + 9216 + (oo * 72 + ii) * 2) = (bf16)f2bf(a->in[I_WX][src]); }
        if (tid < 64) HC[tid] = lat ? a->in[I_SLRU][((size_t)(b * 2 + layer) * 2 + e) * 256 + g * 64 + tid] : 0.f;
        f32x4 bav, bxv, spl;
        { const int chb = (layer * 2 + e) * 256 + g * 64 + 16 * ot + 4 * g4;
          bav = *(const f32x4*)(a->in[I_BA] + chb); bxv = *(const f32x4*)(a->in[I_BX] + chb); const f32x4 lam = *(const f32x4*)(a->in[I_LAMBDA] + chb);
#pragma unroll
          for (int q = 0; q < 4; ++q) spl[q] = log1pf(__expf(-lam[q])); }
        __syncthreads();
        for (int cc = 0; cc < L / 64; ++cc) {
            const int c = e ? L / 64 - 1 - cc : cc, t = c * 64 + tt, n = tok0 + t;
            {
                float xc[8];
#pragma unroll
                for (int i = 0; i < 8; ++i) xc[i] = cb[i];
#pragma unroll
                for (int j = 0; j < 4; ++j) { const int ts = t + j - 2;
                    if (ts >= 0 && ts < L) { const v4u x = *(const v4u*)(G1 + (size_t)(tok0 + ts) * G1W + C_XL + g * 64 + q8);
                        xc[0] += cw[j][0] * bflo(x.x); xc[1] += cw[j][1] * bfhi(x.x); xc[2] += cw[j][2] * bflo(x.y); xc[3] += cw[j][3] * bfhi(x.y);
                        xc[4] += cw[j][4] * bflo(x.z); xc[5] += cw[j][5] * bfhi(x.z); xc[6] += cw[j][6] * bflo(x.w); xc[7] += cw[j][7] * bfhi(x.w); } }
                *(LAS f32x4*)(XCF + tt * 64 + q8) = (f32x4){xc[0], xc[1], xc[2], xc[3]}; *(LAS f32x4*)(XCF + tt * 64 + q8 + 4) = (f32x4){xc[4], xc[5], xc[6], xc[7]};
                *(LAS v4u*)(lds + LR_XCB + tt * 144 + q8 * 2) = (v4u){cvtpk(xc[0], xc[1]), cvtpk(xc[2], xc[3]), cvtpk(xc[4], xc[5]), cvtpk(xc[6], xc[7])};
            }
            __syncthreads();
            {
#pragma unroll
                for (int t2 = 0; t2 < 2; ++t2) { const int tk = (2 * tp + t2) * 16 + i16;
                    f32x4 ga = (f32x4){0.f, 0.f, 0.f, 0.f}, gx = (f32x4){0.f, 0.f, 0.f, 0.f};
#pragma unroll
                    for (int ks = 0; ks < 2; ++ks) { const bf16x8 xf = *(const LAS bf16x8*)(lds + LR_XCB + tk * 144 + ks * 64 + g4 * 16);
                        const bf16x8 wa = *(const LAS bf16x8*)(lds + LR_WAT + (16 * ot + i16) * 144 + ks * 64 + g4 * 16), wx = *(const LAS bf16x8*)(lds + LR_WAT + 9216 + (16 * ot + i16) * 144 + ks * 64 + g4 * 16);
                        ga = MFMA16(wa, xf, ga); gx = MFMA16(wx, xf, gx); }
                    const f32x4 xcv = *(const LAS f32x4*)(XCF + tk * 64 + 16 * ot + 4 * g4);
                    f32x4 av, bv;
#pragma unroll
                    for (int q = 0; q < 4; ++q) { const float la = -8.f * sigmoidf_(ga[q] + bav[q]) * spl[q]; av[q] = __expf(la); bv[q] = sqrtf(-expm1f(2.f * la)) * sigmoidf_(gx[q] + bxv[q]) * xcv[q]; }
                    *(LAS f32x4*)(AA + tk * 64 + 16 * ot + 4 * g4) = av; *(LAS f32x4*)(BV + tk * 64 + 16 * ot + 4 * g4) = bv; }
            }
            __syncthreads();
            float av8[8], bv8[8];
            {
                float P = 1.f, H = 0.f;
#pragma unroll
                for (int s = 0; s < 8; ++s) { const int p = seg * 8 + s, st = e ? 63 - p : p; av8[s] = AA[st * 64 + sch]; bv8[s] = BV[st * 64 + sch]; H = fmaf(av8[s], H, bv8[s]); P *= av8[s]; }
                SP[seg * 64 + sch] = P; SH[seg * 64 + sch] = H;
            }
            __syncthreads();
            {
                float h = HC[sch];
                for (int s2 = 0; s2 < seg; ++s2) h = fmaf(SP[s2 * 64 + sch], h, SH[s2 * 64 + sch]);
#pragma unroll
                for (int s = 0; s < 8; ++s) { const int p = seg * 8 + s, st = e ? 63 - p : p; h = fmaf(av8[s], h, bv8[s]); HH[st * 64 + sch] = h; }
                __syncthreads();
                if (seg == 7) HC[sch] = h;
            }
            __syncthreads();
            {
                bf16* dst = HF + (size_t)n * 256 + g * 64 + q8;
                float o[8];
#pragma unroll
                for (int i = 0; i < 8; ++i) o[i] = HH[tt * 64 + q8 + i];
                if (e) { const v4u hf = *(const v4u*)dst, gl = *(const v4u*)(G1 + (size_t)n * G1W + C_GL + g * 64 + q8);
                    o[0] = (o[0] + bflo(hf.x)) * siluf_(bflo(gl.x)); o[1] = (o[1] + bfhi(hf.x)) * siluf_(bfhi(gl.x)); o[2] = (o[2] + bflo(hf.y)) * siluf_(bflo(gl.y)); o[3] = (o[3] + bfhi(hf.y)) * siluf_(bfhi(gl.y));
                    o[4] = (o[4] + bflo(hf.z)) * siluf_(bflo(gl.z)); o[5] = (o[5] + bfhi(hf.z)) * siluf_(bfhi(gl.z)); o[6] = (o[6] + bflo(hf.w)) * siluf_(bflo(gl.w)); o[7] = (o[7] + bfhi(hf.w)) * siluf_(bfhi(gl.w)); }
                *(v4u*)dst = (v4u){cvtpk(o[0], o[1]), cvtpk(o[2], o[3]), cvtpk(o[4], o[5]), cvtpk(o[6], o[7])};
            }
        }
        __syncthreads();
        if (tid < 64 && !lat) a->out[O_LRU + ((size_t)(b * 2 + layer) * 2 + e) * 256 + g * 64 + tid] = HC[tid];
    }
}
constexpr int N_PHASES = 14;
#ifndef MK_PER_PHASE
#define MK_PER_PHASE 0
#endif
#ifndef VAR_GEMM
#define VAR_GEMM 1
#endif
#ifndef VAR_A2
#define VAR_A2 1
#endif
#ifndef VAR_ATT
#define VAR_ATT 1
#endif
#ifndef VAR_RWKV
#define VAR_RWKV 1
#endif
#ifndef VAR_LRU
#define VAR_LRU 1
#endif

__device__ __forceinline__ void phase_b(ArgsP a, LAS unsigned char* lds, int layer) {
    volatile LAS unsigned* MISC = (volatile LAS unsigned*)(lds + LDS_MISC);
    unsigned* head = (unsigned*)(a->ws + WS_CTL) + CW_Q + layer * 64;
    for (;;) {
        __syncthreads();
        if (tid_() == 0) MISC[16] = atomicAdd(head, 1u);
        __syncthreads();
        const int idx = (int)MISC[16];
        if (idx >= 1248) break;
        if (idx < 32) { if (VAR_LRU) lru_unit_mfma(a, lds, layer, idx); else lru_unit_seq(a, lds, layer, idx); }
        else if (idx < 96) { if (VAR_RWKV) rwkv_unit_mfma(a, lds, layer, idx - 32); else rwkv_unit_seq(a, lds, layer, idx - 32); }
        else if (idx < 608) att_unit(a, lds, idx - 96);
        else if (idx < 864) { if (VAR_RWKV) rwkv_unit_mfma(a, lds, layer, 64 + idx - 608); else rwkv_unit_seq(a, lds, layer, 64 + idx - 608); }
        else if (idx < 992) { if (VAR_LRU) lru_unit_mfma(a, lds, layer, 32 + idx - 864); else lru_unit_seq(a, lds, layer, 32 + idx - 864); }
        else att_unit(a, lds, 512 + idx - 992);
    }
}

#if MK_PER_PHASE
template <int SUB> __global__ void __launch_bounds__(NTHREADS, 2) mk_phase(Args args, int layer) {
    extern __shared__ __attribute__((aligned(16))) unsigned char lds_raw[];
    LAS unsigned char* lds = (LAS unsigned char*)lds_raw;
    ArgsP a = (ArgsP)__builtin_amdgcn_kernarg_segment_ptr();
    if (SUB == 0) phase_p0(a, lds);
    if (SUB == 1) phase_a0(a, layer);
    if (SUB == 2) { if (VAR_GEMM) phase_a1_pg8(a, lds, layer); else phase_a1_naive(a, layer); }
    if (SUB == 3) { if (VAR_A2) { for (int u = blockIdx.x; u < T / 64 + 32; u += gridDim.x) a2_unit(a, lds, layer, u); } else phase_a2_naive(a, lds, layer); }
    if (SUB == 4) { if (VAR_ATT) { for (int u = blockIdx.x; u < 768; u += gridDim.x) att_unit(a, lds, u); } else phase_att_naive(a); }
    if (SUB == 5) { for (int u = blockIdx.x; u < 320; u += gridDim.x) { __syncthreads(); if (VAR_RWKV) rwkv_unit_mfma(a, lds, layer, u); else rwkv_unit_seq(a, lds, layer, u); } }
    if (SUB == 6) { for (int u = blockIdx.x; u < 160; u += gridDim.x) { __syncthreads(); if (VAR_LRU) lru_unit_mfma(a, lds, layer, u); else lru_unit_seq(a, lds, layer, u); } }
    if (SUB == 7) phase_c1(a, layer);
    if (SUB == 8) { if (VAR_GEMM) phase_c2_pg8(a, lds, layer); else phase_c2_naive(a, layer); }
    if (SUB == 9) phase_final(a);
}
#else
#define ARGS_VIEW() ({ ArgsP p_ = (ArgsP)__builtin_amdgcn_kernarg_segment_ptr(); asm volatile("" : "+s"(p_)); p_; })
__global__ void __launch_bounds__(NTHREADS, 2) mk_fwd(Args args) {
    extern __shared__ __attribute__((aligned(16))) unsigned char lds_raw[];
    LAS unsigned char* lds = (LAS unsigned char*)lds_raw;
    volatile LAS unsigned* MISC = (volatile LAS unsigned*)(lds + LDS_MISC);
    for (int u = threadIdx.x; u < 64; u += NTHREADS) MISC[u] = 0u;
    __syncthreads();
    XcdBarrier bar;
    { ArgsP a = ARGS_VIEW(); bar = xcd_barrier_post((unsigned*)(a->ws + WS_CTL) + CW_BAR, MISC + 8); }
    int lo, hi; { ArgsP a = ARGS_VIEW(); lo = a->ph_lo; hi = a->ph_hi; }
#define IN(k) (lo <= (k) && (k) < hi)
#define SEAM(k) do { if (IN(k) && IN((k) + 1)) xcd_barrier(bar); } while (0)
#ifndef NO_P0
    if (IN(0)) { ArgsP a = ARGS_VIEW(); phase_p0(a, lds); }
#endif
    SEAM(0);
    for (int layer = 0; layer < 2; ++layer) {
        const int p = 1 + 6 * layer;
#ifndef NO_A0
        if (IN(p + 0)) { ArgsP a = ARGS_VIEW(); phase_a0(a, layer); }
#endif
        SEAM(p + 0);
#ifndef NO_A1
        if (IN(p + 1)) { ArgsP a = ARGS_VIEW(); phase_a1_pg8(a, lds, layer); }
#endif
        SEAM(p + 1);
#ifndef NO_A2
        if (IN(p + 2)) { ArgsP a = ARGS_VIEW(); for (int u = bid_(); u < T / 64 + 32; u += grid_()) a2_unit(a, lds, layer, u); }
#endif
        SEAM(p + 2);
#ifndef NO_B
        if (IN(p + 3)) { ArgsP a = ARGS_VIEW(); phase_b(a, lds, layer); }
#endif
        SEAM(p + 3);
#ifndef NO_C1
        if (IN(p + 4)) { ArgsP a = ARGS_VIEW(); phase_c1(a, layer); }
#endif
        SEAM(p + 4);
#ifndef NO_C2
        if (IN(p + 5)) { ArgsP a = ARGS_VIEW(); phase_c2_pg8(a, lds, layer); }
#endif
        SEAM(p + 5);
    }
    if (IN(N_PHASES - 1)) { ArgsP a = ARGS_VIEW(); phase_final(a); }
#undef IN
#undef SEAM
}

#endif

extern "C" void kernel_launch(void* const* d_in, const int* in_sizes, int n_in, void* d_out, int out_size, void* d_ws, size_t ws_size, hipStream_t stream) {
    static int grid = 0;
    if (grid == 0) {
        if (n_in != N_IN || ws_size < WS_END) { fprintf(stderr, "kernel_launch: unexpected n_in %d / ws_size %zu\n", n_in, ws_size); grid = -1; return; }
        int dev = 0, cus = 0;
        if (hipGetDevice(&dev) != hipSuccess || hipDeviceGetAttribute(&cus, hipDeviceAttributeMultiprocessorCount, dev) != hipSuccess) { grid = -1; return; }
#if MK_PER_PHASE
#define SA(SUB) if (hipFuncSetAttribute((const void*)mk_phase<SUB>, hipFuncAttributeMaxDynamicSharedMemorySize, LDS_BYTES) != hipSuccess) { fprintf(stderr, "kernel_launch: hipFuncSetAttribute failed\n"); grid = -1; return; }
        SA(0) SA(1) SA(2) SA(3) SA(4) SA(5) SA(6) SA(7) SA(8) SA(9)
#undef SA
#else
        if (hipFuncSetAttribute((const void*)mk_fwd, hipFuncAttributeMaxDynamicSharedMemorySize, LDS_BYTES) != hipSuccess) { fprintf(stderr, "kernel_launch: hipFuncSetAttribute failed\n"); grid = -1; return; }
        int per_cu = 0;
        if (hipOccupancyMaxActiveBlocksPerMultiprocessor(&per_cu, (const void*)mk_fwd, NTHREADS, LDS_BYTES) != hipSuccess || per_cu < 1) fprintf(stderr, "kernel_launch: occupancy query reports %d\n", per_cu);
        (void)hipGetLastError();
#endif
        grid = cus;
    }
    if (grid < 0) return;
    if (hipMemsetAsync((char*)d_ws + WS_CTL, 0, CTL_ZERO_BYTES, stream) != hipSuccess) return;
    Args a{};
    for (int i = 0; i < N_IN; ++i) a.in[i] = (const float*)d_in[i];
    a.out = (float*)d_out; a.ws = (unsigned char*)d_ws;
#if MK_PER_PHASE
#define LP(SUB, layer) hipLaunchKernelGGL(mk_phase<SUB>, dim3(grid), dim3(NTHREADS), LDS_BYTES, stream, a, layer)
    LP(0, 0);
    for (int layer = 0; layer < 2; ++layer) { LP(1, layer); LP(2, layer); LP(3, layer); LP(4, layer); LP(5, layer); LP(6, layer); LP(7, layer); LP(8, layer); }
    LP(9, 0);
#undef LP
#else
    a.ph_lo = 0; a.ph_hi = N_PHASES;
    hipLaunchKernelGGL(mk_fwd, dim3(grid), dim3(NTHREADS), LDS_BYTES, stream, a);
#endif
}
```

```cpp
#define MK_PER_PHASE 0
#include <hip/hip_runtime.h>
#include <cstdio>
#include <cstdint>

#define GAS __attribute__((address_space(1)))
#define LAS __attribute__((address_space(3)))
typedef unsigned short bf16;
typedef unsigned v4u __attribute__((ext_vector_type(4)));
typedef unsigned v2u __attribute__((ext_vector_type(2)));
typedef float f32x4 __attribute__((ext_vector_type(4)));
typedef short bf16x8 __attribute__((ext_vector_type(8)));

constexpr int D = 1024, T_CTX = 8192, T_LAT = 16384, T = 24576, L_CTX = 256, L_LAT = 2048, PAST = 256;
constexpr int NIN = 2816, G1W = 2304, G2W = 512;
constexpr int C_R = 0, C_K = 256, C_V = 512, C_G = 768, C_GM = 1024, C_XL = 1536, C_GL = 1792, C_LORA = 2048;
constexpr int LK_LAT = PAST + L_LAT;
constexpr int TK = T_CTX + 8 * LK_LAT;
constexpr int VT_LAT = 32 * 8 * 64 * 256;
constexpr float LN_EPS = 1e-5f, GN_EPS = 64e-5f;
constexpr float ALPHA = 1.4142135623730951f;
constexpr float QSCALE = 0.10206207261596575f * 1.4426950408889634f;
constexpr size_t O_Y = 0, O_RW = 25165824, O_CKV = 27262976, O_KR = 29360128, O_LRU = 29884416;
constexpr size_t MiB = 1u << 20;
constexpr size_t WS_CTL = 0, CTL_ZERO_BYTES = 1 * MiB;
constexpr size_t WS_MOD = 256 * 1024;
constexpr size_t WS_ROPE = 1 * MiB;
constexpr size_t WS_WUQ = 2 * MiB;
constexpr size_t WS_WUKV = 3 * MiB;
constexpr size_t WS_WIN = 4 * MiB;
constexpr size_t WS_WOUT = 16 * MiB;
constexpr size_t WS_G1 = 20 * MiB;
constexpr size_t WS_G2 = 128 * MiB;
constexpr size_t WS_Q = 152 * MiB;
constexpr size_t WS_U = 152 * MiB;
constexpr size_t WS_KN = 188 * MiB;
constexpr size_t WS_KR = 214 * MiB;
constexpr size_t WS_VT = 216 * MiB;
constexpr size_t WS_YMIX = 188 * MiB;
constexpr size_t WS_HF = 242 * MiB;
constexpr size_t WS_END = 254 * MiB;
constexpr int CW_BAR = 4096;
constexpr int CW_Q = 16384;

__device__ __forceinline__ float bf2f(unsigned b) { return __uint_as_float(b << 16); }
__device__ __forceinline__ float bflo(unsigned w) { return __uint_as_float(w << 16); }
__device__ __forceinline__ float bfhi(unsigned w) { return __uint_as_float(w & 0xffff0000u); }
__device__ __forceinline__ unsigned f2bf(float f) { unsigned u = __float_as_uint(f); return (u + 0x7fffu + ((u >> 16) & 1u)) >> 16; }
__device__ __forceinline__ unsigned pk2(float lo, float hi) { return f2bf(lo) | (f2bf(hi) << 16); }
__device__ __forceinline__ float rcp_(float x) { return __builtin_amdgcn_rcpf(x); }
__device__ __forceinline__ float exp_(float x) { return __builtin_amdgcn_exp2f(x * 1.4426950408889634f); }
__device__ __forceinline__ float sqrt_(float x) { return __builtin_amdgcn_sqrtf(x); }
__device__ __forceinline__ float rsqrt_(float x) { return __builtin_amdgcn_rsqf(x); }
__device__ __forceinline__ float sigmoidf_(float x) { return rcp_(1.f + exp_(-x)); }
__device__ __forceinline__ float siluf_(float x) { return x * rcp_(1.f + exp_(-x)); }
template <int CTRL> __device__ __forceinline__ float dpp_f(float old, float x) { return __builtin_bit_cast(float, __builtin_amdgcn_update_dpp(__builtin_bit_cast(int, old), __builtin_bit_cast(int, x), CTRL, 0xf, 0xf, false)); }
__device__ __forceinline__ float row16_sum(float x) { x += dpp_f<0x128>(0.f, x); x += dpp_f<0x124>(0.f, x); x += dpp_f<0x122>(0.f, x); x += dpp_f<0x121>(0.f, x); return x; }
__device__ __forceinline__ float wave_sum_fast(float x) { x = row16_sum(x); x += __shfl_xor(x, 16); x += __shfl_xor(x, 32); return x; }
__device__ __forceinline__ float row16_prefix_prod(float x) { x *= dpp_f<0x111>(1.f, x); x *= dpp_f<0x112>(1.f, x); x *= dpp_f<0x114>(1.f, x); x *= dpp_f<0x118>(1.f, x); return x; }
__device__ __forceinline__ float wave_sum(float v) { return wave_sum_fast(v); }
__device__ __forceinline__ int tid_() { int t = threadIdx.x; asm volatile("" : "+v"(t)); return t; }
__device__ __forceinline__ int bid_() { int b = blockIdx.x; asm volatile("" : "+s"(b)); return b; }
__device__ __forceinline__ int grid_() { int g = gridDim.x; asm volatile("" : "+s"(g)); return g; }
#define XB_TMO      128
#define XB_XCNT(j)  (256  + 64 * (j))
#define XB_XSUB(j)  (1280 + 64 * (j))
#define XB_XGEN(j)  (2304 + 64 * (j))
#define XB_TOP      3328
#define XB_TOPGEN   3392
#define XCD_BAR_WORDS 3456
#define XB_SPIN_CAP (1u << 24)

__device__ __forceinline__ unsigned xb_ld(unsigned* p)              { return __hip_atomic_load(p, __ATOMIC_RELAXED, __HIP_MEMORY_SCOPE_AGENT); }
__device__ __forceinline__ unsigned xb_add(unsigned* p, unsigned v) { return __hip_atomic_fetch_add(p, v, __ATOMIC_RELAXED, __HIP_MEMORY_SCOPE_AGENT); }
__device__ __forceinline__ unsigned xb_xcc_id() { return (unsigned)__builtin_amdgcn_s_getreg((3 << 11) | 20) & 0xFu; }
#define XB_SPIN(cond, bar) do { unsigned _sp = 0; while (cond) { __builtin_amdgcn_s_sleep(1); \
    if ((++_sp & 255u) == 0u) { if (xb_ld(&(bar)[XB_TMO])) break; if (_sp > XB_SPIN_CAP) { atomicAdd(&(bar)[XB_TMO], 1u); break; } } } } while (0)

struct XcdBarrier {
    unsigned* bar; unsigned x;
    volatile LAS unsigned* st;
};

__device__ __forceinline__ XcdBarrier xcd_barrier_post(unsigned* bar, volatile LAS unsigned* st) {
    XcdBarrier b; b.bar = bar; b.x = xb_xcc_id(); b.st = st;
    if (threadIdx.x == 0) (void)xb_add(&bar[XB_XCNT(b.x)], 1u);
    return b;
}
__device__ __forceinline__ void xcd_barrier_complete(unsigned* bar, unsigned x, unsigned& nloc, unsigned& nx) {
    const unsigned G = gridDim.x * gridDim.y * gridDim.z;
    unsigned sum, cnt, mine, sp = 0u;
    for (;;) {
        sum = 0u; cnt = 0u; mine = 0u;
#pragma unroll
        for (unsigned j = 0; j < 16; ++j) { const unsigned c = xb_ld(&bar[XB_XCNT(j)]); sum += c; cnt += (c > 0u) ? 1u : 0u; mine = (j == x) ? c : mine; }
        if (sum == G) break;
        __builtin_amdgcn_s_sleep(1);
        if ((++sp & 255u) == 0u) { if (xb_ld(&bar[XB_TMO])) break; if (sp > XB_SPIN_CAP) { atomicAdd(&bar[XB_TMO], 1u); break; } }
    }
    nloc = mine > 0u ? mine : 1u; nx = cnt > 0u ? cnt : 1u;
}

__device__ __forceinline__ void xcd_barrier(const XcdBarrier& b) {
    asm volatile("s_waitcnt vmcnt(0)" ::: "memory");
    __syncthreads();
    if (threadIdx.x == 0) {
        unsigned* bar = b.bar;
        __builtin_amdgcn_s_waitcnt(0);
        unsigned nloc = b.st[0], nx = b.st[1];
        if (nloc == 0u) { xcd_barrier_complete(bar, b.x, nloc, nx); b.st[0] = nloc; b.st[1] = nx; }
        const unsigned old = xb_add(&bar[XB_XSUB(b.x)], 1u);
        const unsigned gen = old / nloc;
        if (old + 1u == (gen + 1u) * nloc) {
            __builtin_amdgcn_fence(__ATOMIC_RELEASE, "agent");
            asm volatile("s_waitcnt vmcnt(0)" ::: "memory");
            const unsigned og = xb_add(&bar[XB_TOP], 1u);
            const unsigned tg = og / nx;
            if (og + 1u == (tg + 1u) * nx) xb_add(&bar[XB_TOPGEN], 1u);
            else XB_SPIN(xb_ld(&bar[XB_TOPGEN]) == tg, bar);
            __builtin_amdgcn_fence(__ATOMIC_ACQUIRE, "agent");
            xb_add(&bar[XB_XGEN(b.x)], 1u);
            asm volatile("s_waitcnt vmcnt(0)" ::: "memory");
        } else {
            XB_SPIN(xb_ld(&bar[XB_XGEN(b.x)]) == gen, bar);
            __builtin_amdgcn_fence(__ATOMIC_ACQUIRE, "agent");
            asm volatile("s_waitcnt vmcnt(0)" ::: "memory");
        }
    }
    __syncthreads();
}
enum { I_XP = 0, I_XS, I_SRW, I_CCKV, I_CKR, I_SLRU, I_C, I_CCTX, I_WMOD, I_BMOD, I_WIN, I_W0, I_W1, I_W2, I_A0, I_A1, I_A2, I_KK, I_KA, I_RK,
       I_LNXG, I_LNXB, I_QNORM, I_WUQ, I_KVNORM, I_WUKV, I_CONVW, I_CONVB, I_WA, I_BA, I_WX, I_BX, I_LAMBDA, I_WOUT, I_LNG, I_LNB, N_IN };
struct Args { const float* in[N_IN]; float* out; unsigned char* ws; int ph_lo, ph_hi; };
typedef const Args __attribute__((address_space(4)))* ArgsP;
constexpr int NTHREADS = 512;
constexpr int LDS_MISC = 139264;
constexpr int LDS_BYTES = 147456;

struct Tok { int n, b, t, L, lat, modrow, tok0, kidx; };
__device__ __forceinline__ Tok tok_of(int n) {
    Tok k; k.n = n;
    if (n < T_CTX) { k.lat = 0; k.b = n >> 8; k.t = n & 255; k.L = L_CTX; k.modrow = 0; k.tok0 = k.b * 256; k.kidx = n; }
    else { const int m = n - T_CTX; k.lat = 1; k.b = m >> 11; k.t = m & 2047; k.L = L_LAT; k.modrow = 1 + k.b; k.tok0 = T_CTX + k.b * 2048; k.kidx = T_CTX + k.b * LK_LAT + PAST + k.t; }
    return k;
}
__device__ __forceinline__ const float* xrow_src(ArgsP a, int layer, int n) {
    if (layer == 0) return n < T_CTX ? a->in[I_XP] + (size_t)n * D : a->in[I_XS] + (size_t)(n - T_CTX) * D;
    return a->out + (size_t)n * D;
}
__device__ __forceinline__ float dot8(v4u a, v4u b, float acc) {
    acc = fmaf(bflo(a.x), bflo(b.x), acc); acc = fmaf(bfhi(a.x), bfhi(b.x), acc);
    acc = fmaf(bflo(a.y), bflo(b.y), acc); acc = fmaf(bfhi(a.y), bfhi(b.y), acc);
    acc = fmaf(bflo(a.z), bflo(b.z), acc); acc = fmaf(bfhi(a.z), bfhi(b.z), acc);
    acc = fmaf(bflo(a.w), bflo(b.w), acc); acc = fmaf(bfhi(a.w), bfhi(b.w), acc);
    return acc;
}

__device__ __forceinline__ void tr_item(const float* src, int ld, int col0, int k0, bf16* WT, int K, int row0, float scale, LAS float* scr, int lane) {
#pragma unroll 8
    for (int i = 0; i < 32; ++i) { const int kk = 2 * i + (lane >> 5); scr[kk * 33 + (lane & 31)] = src ? src[(size_t)(k0 + kk) * ld + col0 + (lane & 31)] * scale : 0.f; }
    asm volatile("s_waitcnt lgkmcnt(0)" ::: "memory");
    const int c = lane & 7;
#pragma unroll
    for (int j = 0; j < 4; ++j) { const int n = (lane >> 3) + 8 * j; const LAS float* s = scr + (8 * c) * 33 + n;
        v4u o; o.x = pk2(s[0 * 33], s[1 * 33]); o.y = pk2(s[2 * 33], s[3 * 33]); o.z = pk2(s[4 * 33], s[5 * 33]); o.w = pk2(s[6 * 33], s[7 * 33]);
        *(v4u*)(WT + (size_t)(row0 + n) * K + k0 + 8 * c) = o; }
    asm volatile("s_waitcnt lgkmcnt(0)" ::: "memory");
}
__device__ __forceinline__ void rope_angle(int t, int i, float& c, float& s) {
    const int row = t >> 6, col = t & 63; const int ii = i & 7;
    const float inv = exp2f(-(float)ii * (13.287712379549449f / 8.f));
    const float ang = (float)(i < 8 ? row : col) * inv;
    c = cosf(ang); s = sinf(ang);
}
__device__ __forceinline__ void phase_p0(ArgsP a, LAS unsigned char* lds) {
    const int tid = tid_(), lane = tid & 63, wave = tid >> 6, G = grid_();
    unsigned char* ws = a->ws;
    LAS float* scr = (LAS float*)(lds + wave * 8704);
    const int gw = bid_() * 8 + wave, NGW = G * 8;
    constexpr int N_WIN = 2 * 16 * 88, N_WOUT = 2 * 16 * 32, N_WUQ = 2 * 4 * 24, N_WUKV = 2 * 2 * 32;
    for (int it = gw; it < N_WIN + N_WOUT + N_WUQ + N_WUKV; it += NGW) {
        int r = it;
        if (r < N_WIN) {
            const int l = r / (16 * 88), kb = (r / 88) % 16, nb = r % 88, j0 = nb * 32;
            const float* src; int ld, col0;
            const float* win = a->in[I_WIN] + (size_t)l * 1024 * 2464;
            if (j0 < 1024) { src = win; ld = 2464; col0 = j0; }
            else if (j0 < 1536) { src = win; ld = 2464; col0 = 1440 + (j0 - 1024); }
            else if (j0 < 1792) { src = win; ld = 2464; col0 = 1952 + (j0 - 1536); }
            else if (j0 < 2048) { src = win; ld = 2464; col0 = 2208 + (j0 - 1792); }
            else if (j0 < 2304) { const int q = (j0 - 2048) >> 6; src = (q < 2 ? a->in[I_W1] : a->in[I_A1]) + (size_t)(l * 2 + (q & 1)) * 1024 * 64; ld = 64; col0 = (j0 - 2048) & 63; }
            else if (j0 < 2560) { src = win; ld = 2464; col0 = 1024 + (j0 - 2304); }
            else if (j0 < 2688) { src = win; ld = 2464; col0 = 1280 + (j0 - 2560); }
            else if (j0 < 2720) { src = win; ld = 2464; col0 = 1408 + (j0 - 2688); }
            else { src = nullptr; ld = 0; col0 = 0; }
            tr_item(src, ld, col0, kb * 64, (bf16*)(ws + WS_WIN) + (size_t)l * NIN * 1024, 1024, j0, 1.f, scr, lane);
            continue;
        }
        r -= N_WIN;
        if (r < N_WOUT) { const int l = r / (16 * 32), kb = (r / 32) % 16, nb = r % 32;
            tr_item(a->in[I_WOUT] + (size_t)l * 1024 * 1024, 1024, nb * 32, kb * 64, (bf16*)(ws + WS_WOUT) + (size_t)l * 1024 * 1024, 1024, nb * 32, 1.f, scr, lane); continue; }
        r -= N_WOUT;
        if (r < N_WUQ) { const int l = r / (4 * 24), kb = (r / 24) % 4, nb = r % 24;
            tr_item(a->in[I_WUQ] + (size_t)l * 256 * 768, 768, nb * 32, kb * 64, (bf16*)(ws + WS_WUQ) + (size_t)l * 768 * 256, 256, nb * 32, QSCALE, scr, lane); continue; }
        r -= N_WUQ;
        { const int l = r / (2 * 32), kb = (r / 32) % 2, nb = r % 32;
            tr_item(a->in[I_WUKV] + (size_t)l * 128 * 1024, 1024, nb * 32, kb * 64, (bf16*)(ws + WS_WUKV) + (size_t)l * 1024 * 128, 128, nb * 32, 1.f, scr, lane); }
    }
    { float* ROPE = (float*)(ws + WS_ROPE);
      for (int i = bid_() * NTHREADS + tid; i < 2048 * 16; i += G * NTHREADS) { float c, s; rope_angle(i >> 4, i & 15, c, s); ROPE[i * 2] = c; ROPE[i * 2 + 1] = s; } }
    float* MOD = (float*)(ws + WS_MOD);
    for (int it = bid_(); it < 2 * 6 * 32; it += G) {
        const int l = it / 192, nb = (it / 32) % 6, kq = it % 32, col = nb * 512 + tid;
        float acc[9];
#pragma unroll
        for (int j = 0; j < 9; ++j) acc[j] = 0.f;
        for (int kk = 0; kk < 32; ++kk) { const int k = kq * 32 + kk;
            const float w = a->in[I_WMOD][((size_t)l * 1024 + k) * 3072 + col];
#pragma unroll
            for (int j = 0; j < 9; ++j) { const float cj = (j == 0) ? a->in[I_CCTX][k] : a->in[I_C][(j - 1) * 1024 + k]; acc[j] = fmaf(siluf_(cj), w, acc[j]); } }
        const float bias = (kq == 0) ? a->in[I_BMOD][l * 3072 + col] : 0.f;
#pragma unroll
        for (int j = 0; j < 9; ++j) atomicAdd(&MOD[(l * 9 + j) * 3072 + col], acc[j] + bias);
    }
}

__device__ __forceinline__ void phase_a0(ArgsP a, int layer) {
    const int tid = tid_(), lane = tid & 63, wave = tid >> 6, G = grid_();
    const float* MOD = (const float*)(a->ws + WS_MOD);
    bf16* U = (bf16*)(a->ws + WS_U);
    f32x4 nx[4];
    { const int n0 = bid_() * 8 + wave; if (n0 < T) { const float* xr0 = xrow_src(a, layer, n0);
#pragma unroll
        for (int j = 0; j < 4; ++j) nx[j] = *(const f32x4*)(xr0 + lane * 4 + 256 * j); } }
    for (int n = bid_() * 8 + wave; n < T; n += G * 8) {
        const Tok tk = tok_of(n);
        f32x4 v[4]; float s = 0.f;
#pragma unroll
        for (int j = 0; j < 4; ++j) { v[j] = nx[j]; s += (v[j].x + v[j].y) + (v[j].z + v[j].w); }
        if (n + G * 8 < T) { const float* xr1 = xrow_src(a, layer, n + G * 8);
#pragma unroll
            for (int j = 0; j < 4; ++j) nx[j] = *(const f32x4*)(xr1 + lane * 4 + 256 * j); }
        float mean = wave_sum(s) * (1.f / D), s2 = 0.f;
#pragma unroll
        for (int j = 0; j < 4; ++j) { v[j] = v[j] - mean; s2 += (v[j].x * v[j].x + v[j].y * v[j].y) + (v[j].z * v[j].z + v[j].w * v[j].w); }
        float rstd = rsqrt_(wave_sum(s2) * (1.f / D) + LN_EPS);
        if (layer == 1) {
            s = 0.f;
#pragma unroll
            for (int j = 0; j < 4; ++j) { const f32x4 g = *(const f32x4*)(a->in[I_LNG] + lane * 4 + 256 * j), b = *(const f32x4*)(a->in[I_LNB] + lane * 4 + 256 * j);
                v[j] = v[j] * rstd * g + b; *(f32x4*)(a->out + (size_t)n * D + lane * 4 + 256 * j) = v[j]; s += (v[j].x + v[j].y) + (v[j].z + v[j].w); }
            mean = wave_sum(s) * (1.f / D); s2 = 0.f;
#pragma unroll
            for (int j = 0; j < 4; ++j) { v[j] = v[j] - mean; s2 += (v[j].x * v[j].x + v[j].y * v[j].y) + (v[j].z * v[j].z + v[j].w * v[j].w); }
            rstd = rsqrt_(wave_sum(s2) * (1.f / D) + LN_EPS);
        }
        const float* m = MOD + (size_t)(layer * 9 + tk.modrow) * 3072;
#pragma unroll
        for (int j = 0; j < 4; ++j) { const int c = lane * 4 + 256 * j; const f32x4 sh = *(const f32x4*)(m + c), sc = *(const f32x4*)(m + 1024 + c);
            const f32x4 o = v[j] * rstd * (sc + 1.f) + sh;
            v2u p; p.x = pk2(o.x, o.y); p.y = pk2(o.z, o.w); *(v2u*)(U + (size_t)n * D + c) = p; }
    }
}
__device__ __forceinline__ void phase_final(ArgsP a) {
    const int tid = tid_(), lane = tid & 63, wave = tid >> 6, G = grid_();
    f32x4 nx[4];
    { const int n0 = bid_() * 8 + wave; if (n0 < T) {
#pragma unroll
        for (int j = 0; j < 4; ++j) nx[j] = *(const f32x4*)(a->out + (size_t)n0 * D + lane * 4 + 256 * j); } }
    for (int n = bid_() * 8 + wave; n < T; n += G * 8) {
        float* xr = a->out + (size_t)n * D;
        f32x4 v[4]; float s = 0.f;
#pragma unroll
        for (int j = 0; j < 4; ++j) { v[j] = nx[j]; s += (v[j].x + v[j].y) + (v[j].z + v[j].w); }
        if (n + G * 8 < T) {
#pragma unroll
            for (int j = 0; j < 4; ++j) nx[j] = *(const f32x4*)(a->out + (size_t)(n + G * 8) * D + lane * 4 + 256 * j); }
        const float mean = wave_sum(s) * (1.f / D); float s2 = 0.f;
#pragma unroll
        for (int j = 0; j < 4; ++j) { v[j] = v[j] - mean; s2 += (v[j].x * v[j].x + v[j].y * v[j].y) + (v[j].z * v[j].z + v[j].w * v[j].w); }
        const float rstd = rsqrt_(wave_sum(s2) * (1.f / D) + LN_EPS);
#pragma unroll
        for (int j = 0; j < 4; ++j) { const f32x4 g = *(const f32x4*)(a->in[I_LNG] + 1024 + lane * 4 + 256 * j), b = *(const f32x4*)(a->in[I_LNB] + 1024 + lane * 4 + 256 * j);
            *(f32x4*)(xr + lane * 4 + 256 * j) = v[j] * rstd * g + b; }
    }
}

__device__ __forceinline__ void phase_a1_naive(ArgsP a, int layer) {
    const bf16* U = (const bf16*)(a->ws + WS_U); const bf16* W = (const bf16*)(a->ws + WS_WIN) + (size_t)layer * NIN * 1024;
    bf16* G1 = (bf16*)(a->ws + WS_G1); bf16* G2 = (bf16*)(a->ws + WS_G2);
    const size_t total = (size_t)T * (NIN / 8), stride = (size_t)grid_() * NTHREADS;
    for (size_t idx = (size_t)bid_() * NTHREADS + tid_(); idx < total; idx += stride) {
        const int row = (int)(idx / (NIN / 8)), c0 = (int)(idx % (NIN / 8)) * 8;
        float acc[8];
#pragma unroll
        for (int c = 0; c < 8; ++c) acc[c] = 0.f;
        const v4u* ap = (const v4u*)(U + (size_t)row * 1024); const v4u* bp = (const v4u*)(W + (size_t)c0 * 1024);
        for (int kc = 0; kc < 128; ++kc) { const v4u av = ap[kc];
#pragma unroll
            for (int c = 0; c < 8; ++c) acc[c] = dot8(av, bp[c * 128 + kc], acc[c]); }
        v4u o; o.x = pk2(acc[0], acc[1]); o.y = pk2(acc[2], acc[3]); o.z = pk2(acc[4], acc[5]); o.w = pk2(acc[6], acc[7]);
        if (c0 < G1W) *(v4u*)(G1 + (size_t)row * G1W + c0) = o; else *(v4u*)(G2 + (size_t)row * G2W + (c0 - G1W)) = o;
    }
}
__device__ __forceinline__ void phase_c2_naive(ArgsP a, int layer) {
    const bf16* Y = (const bf16*)(a->ws + WS_YMIX); const bf16* W = (const bf16*)(a->ws + WS_WOUT) + (size_t)layer * 1024 * 1024;
    const float* MOD = (const float*)(a->ws + WS_MOD);
    const size_t total = (size_t)T * 256, stride = (size_t)grid_() * NTHREADS;
    for (size_t idx = (size_t)bid_() * NTHREADS + tid_(); idx < total; idx += stride) {
        const int row = (int)(idx >> 8), c0 = (int)(idx & 255) * 4;
        float acc[4] = {0.f, 0.f, 0.f, 0.f};
        const v4u* ap = (const v4u*)(Y + (size_t)row * 1024); const v4u* bp = (const v4u*)(W + (size_t)c0 * 1024);
        for (int kc = 0; kc < 128; ++kc) { const v4u av = ap[kc];
#pragma unroll
            for (int c = 0; c < 4; ++c) acc[c] = dot8(av, bp[c * 128 + kc], acc[c]); }
        const Tok tk = tok_of(row);
        const f32x4 gate = *(const f32x4*)(MOD + (size_t)(layer * 9 + tk.modrow) * 3072 + 2048 + c0);
        const f32x4 x = *(const f32x4*)(xrow_src(a, layer, row) + c0);
        f32x4 z; z.x = ALPHA * x.x + gate.x * acc[0]; z.y = ALPHA * x.y + gate.y * acc[1]; z.z = ALPHA * x.z + gate.z * acc[2]; z.w = ALPHA * x.w + gate.w * acc[3];
        *(f32x4*)(a->out + (size_t)row * D + c0) = z;
    }
}

__device__ __forceinline__ void phase_a2_naive(ArgsP a, LAS unsigned char* lds, int layer) {
    const int tid = tid_(), lane = tid & 63, wave = tid >> 6, G = grid_();
    LAS float* AQ = (LAS float*)lds;
    LAS float* AKV = (LAS float*)(lds + 16384);
    LAS float* OT = (LAS float*)(lds + 24576);
    const bf16* G2 = (const bf16*)(a->ws + WS_G2);
    bf16* Q = (bf16*)(a->ws + WS_Q); bf16* KN = (bf16*)(a->ws + WS_KN); bf16* KR = (bf16*)(a->ws + WS_KR); bf16* VT = (bf16*)(a->ws + WS_VT);
    const bf16* WUQ = (const bf16*)(a->ws + WS_WUQ) + (size_t)layer * 768 * 256;
    const bf16* WUKV = (const bf16*)(a->ws + WS_WUKV) + (size_t)layer * 1024 * 128;
    constexpr int NT_TOK = T / 16, NT_CACHE = 8 * 256 / 16;
    for (int tile = bid_(); tile < NT_TOK + NT_CACHE; tile += G) {
        const bool is_tok = tile < NT_TOK;
        for (int rr = 0; rr < 2; ++rr) {
            const int r = wave * 2 + rr;
            if (is_tok) {
                const int n = tile * 16 + r; const Tok tk = tok_of(n);
                const v2u cqv = *(const v2u*)(G2 + (size_t)n * G2W + lane * 4);
                const float c0 = bflo(cqv.x), c1 = bfhi(cqv.x), c2 = bflo(cqv.y), c3 = bfhi(cqv.y);
                const float rq = rsqrt_(wave_sum(c0 * c0 + c1 * c1 + c2 * c2 + c3 * c3) * (1.f / 256.f) + 1e-6f);
                const f32x4 qn = *(const f32x4*)(a->in[I_QNORM] + layer * 256 + lane * 4);
                AQ[r * 256 + lane * 4 + 0] = bf2f(f2bf(c0 * rq * qn.x)); AQ[r * 256 + lane * 4 + 1] = bf2f(f2bf(c1 * rq * qn.y));
                AQ[r * 256 + lane * 4 + 2] = bf2f(f2bf(c2 * rq * qn.z)); AQ[r * 256 + lane * 4 + 3] = bf2f(f2bf(c3 * rq * qn.w));
                float k0 = 0.f, k1 = 0.f, k2 = 0.f, k3 = 0.f;
                if (lane < 32) { const v2u kv = *(const v2u*)(G2 + (size_t)n * G2W + 256 + lane * 4); k0 = bflo(kv.x); k1 = bfhi(kv.x); k2 = bflo(kv.y); k3 = bfhi(kv.y); }
                const float rk = rsqrt_(wave_sum(k0 * k0 + k1 * k1 + k2 * k2 + k3 * k3) * (1.f / 128.f) + 1e-6f);
                if (lane < 32) {
                    const f32x4 kn = *(const f32x4*)(a->in[I_KVNORM] + layer * 128 + lane * 4);
                    f32x4 o; o.x = k0 * rk * kn.x; o.y = k1 * rk * kn.y; o.z = k2 * rk * kn.z; o.w = k3 * rk * kn.w;
                    if (!tk.lat) *(f32x4*)(a->out + O_CKV + ((size_t)(tk.b * 2 + layer) * 256 + tk.t) * 128 + lane * 4) = o;
                    AKV[r * 128 + lane * 4 + 0] = bf2f(f2bf(o.x)); AKV[r * 128 + lane * 4 + 1] = bf2f(f2bf(o.y));
                    AKV[r * 128 + lane * 4 + 2] = bf2f(f2bf(o.z)); AKV[r * 128 + lane * 4 + 3] = bf2f(f2bf(o.w));
                }
                float krv = (lane < 32) ? bf2f(G2[(size_t)n * G2W + 384 + lane]) : 0.f;
                const float other = __shfl_xor(krv, 1);
                if (lane < 32) {
                    if (!tk.lat) a->out[O_KR + ((size_t)(tk.b * 2 + layer) * 256 + tk.t) * 32 + lane] = krv;
                    else { float c, s; rope_angle(tk.t, lane >> 1, c, s); krv = (lane & 1) ? (other * s + krv * c) : (krv * c - other * s); }
                    KR[(size_t)tk.kidx * 32 + lane] = (bf16)f2bf(krv);
                }
            } else {
                const int cr = (tile - NT_TOK) * 16 + r, b = cr >> 8, j = cr & 255;
                const size_t src = ((size_t)(b * 2 + layer) * 256 + j);
                if (lane < 32) { const f32x4 v = *(const f32x4*)(a->in[I_CCKV] + src * 128 + lane * 4);
                    AKV[r * 128 + lane * 4 + 0] = bf2f(f2bf(v.x)); AKV[r * 128 + lane * 4 + 1] = bf2f(f2bf(v.y)); AKV[r * 128 + lane * 4 + 2] = bf2f(f2bf(v.z)); AKV[r * 128 + lane * 4 + 3] = bf2f(f2bf(v.w));
                    KR[(size_t)(T_CTX + b * LK_LAT + j) * 32 + lane] = (bf16)f2bf(a->in[I_CKR][src * 32 + lane]); }
            }
        }
        __syncthreads();
        if (is_tok) {
            for (int col = tid; col < 768; col += NTHREADS) {
                float acc[16];
#pragma unroll
                for (int r = 0; r < 16; ++r) acc[r] = 0.f;
                const v4u* wp = (const v4u*)(WUQ + (size_t)col * 256);
                for (int kc = 0; kc < 32; ++kc) { const v4u w = wp[kc];
                    const float w0 = bflo(w.x), w1 = bfhi(w.x), w2 = bflo(w.y), w3 = bfhi(w.y), w4 = bflo(w.z), w5 = bfhi(w.z), w6 = bflo(w.w), w7 = bfhi(w.w);
#pragma unroll
                    for (int r = 0; r < 16; ++r) { const f32x4 x0 = *(const LAS f32x4*)(AQ + r * 256 + kc * 8), x1 = *(const LAS f32x4*)(AQ + r * 256 + kc * 8 + 4);
                        acc[r] += x0.x * w0 + x0.y * w1 + x0.z * w2 + x0.w * w3 + x1.x * w4 + x1.y * w5 + x1.z * w6 + x1.w * w7; } }
#pragma unroll
                for (int r = 0; r < 16; ++r) OT[r * 1024 + col] = acc[r];
            }
            __syncthreads();
            for (int idx = tid; idx < 16 * 384; idx += NTHREADS) {
                const int r = idx / 384, col = (idx % 384) * 2, d = col % 96; const int n = tile * 16 + r; const Tok tk = tok_of(n);
                float v0 = OT[r * 1024 + col], v1 = OT[r * 1024 + col + 1];
                if (tk.lat && d >= 64) { float c, s; rope_angle(tk.t, (d - 64) >> 1, c, s); const float y0 = v0 * c - v1 * s, y1 = v0 * s + v1 * c; v0 = y0; v1 = y1; }
                *(unsigned*)(Q + (size_t)n * 768 + col) = pk2(v0, v1);
            }
            __syncthreads();
        }
        for (int col = tid; col < 1024; col += NTHREADS) {
            float acc[16];
#pragma unroll
            for (int r = 0; r < 16; ++r) acc[r] = 0.f;
            const v4u* wp = (const v4u*)(WUKV + (size_t)col * 128);
            for (int kc = 0; kc < 16; ++kc) { const v4u w = wp[kc];
                const float w0 = bflo(w.x), w1 = bfhi(w.x), w2 = bflo(w.y), w3 = bfhi(w.y), w4 = bflo(w.z), w5 = bfhi(w.z), w6 = bflo(w.w), w7 = bfhi(w.w);
#pragma unroll
                for (int r = 0; r < 16; ++r) { const f32x4 x0 = *(const LAS f32x4*)(AKV + r * 128 + kc * 8), x1 = *(const LAS f32x4*)(AKV + r * 128 + kc * 8 + 4);
                    acc[r] += x0.x * w0 + x0.y * w1 + x0.z * w2 + x0.w * w3 + x1.x * w4 + x1.y * w5 + x1.z * w6 + x1.w * w7; } }
#pragma unroll
            for (int r = 0; r < 16; ++r) OT[r * 1024 + col] = acc[r];
        }
        __syncthreads();
        for (int idx = tid; idx < 16 * 1024; idx += NTHREADS) {
            const int r = idx >> 10, col = idx & 1023, h = col >> 7, f = col & 127;
            int kidx, lat, b, kpos;
            if (is_tok) { const Tok tk = tok_of(tile * 16 + r); kidx = tk.kidx; lat = tk.lat; b = tk.b; kpos = tk.lat ? PAST + tk.t : tk.t; }
            else { const int cr = (tile - NT_TOK) * 16 + r; b = cr >> 8; kpos = cr & 255; lat = 1; kidx = T_CTX + b * LK_LAT + kpos; }
            const bf16 v = (bf16)f2bf(OT[r * 1024 + col]);
            if (f < 64) KN[(size_t)kidx * 512 + h * 64 + f] = v;
            else { const int dv = f - 64; const size_t base = lat ? (size_t)VT_LAT + ((size_t)(b * 8 + h) * 64 + dv) * LK_LAT : ((size_t)(b * 8 + h) * 64 + dv) * 256; VT[base + kpos] = v; }
        }
        __syncthreads();
    }
}

__device__ __forceinline__ void phase_att_naive(ArgsP a) {
    const bf16* KN = (const bf16*)(a->ws + WS_KN); const bf16* KR = (const bf16*)(a->ws + WS_KR); const bf16* VT = (const bf16*)(a->ws + WS_VT);
    bf16* Q = (bf16*)(a->ws + WS_Q); const bf16* G1 = (const bf16*)(a->ws + WS_G1);
    const int total = T * 8, stride = grid_() * NTHREADS;
    for (int idx = bid_() * NTHREADS + tid_(); idx < total; idx += stride) {
        int n, h, Lk, kidx0; size_t vbase;
        if (idx < T_CTX * 8) { const int b = idx >> 11, hh = (idx >> 8) & 7, t = idx & 255; n = b * 256 + t; h = hh; Lk = 256; kidx0 = b * 256; vbase = ((size_t)(b * 8 + h) * 64) * 256; }
        else { const int m = idx - T_CTX * 8, b = m >> 14, hh = (m >> 11) & 7, t = m & 2047; n = T_CTX + b * 2048 + t; h = hh; Lk = LK_LAT; kidx0 = T_CTX + b * LK_LAT; vbase = (size_t)VT_LAT + ((size_t)(b * 8 + h) * 64) * LK_LAT; }
        v4u qp[12];
#pragma unroll
        for (int c = 0; c < 12; ++c) qp[c] = *(const v4u*)(Q + (size_t)n * 768 + h * 96 + c * 8);
        float acc[64];
#pragma unroll
        for (int d = 0; d < 64; ++d) acc[d] = 0.f;
        float m = -1e30f, l = 0.f;
        for (int j0 = 0; j0 < Lk; j0 += 8) {
            float s[8];
#pragma unroll
            for (int j = 0; j < 8; ++j) {
                const v4u* kp = (const v4u*)(KN + (size_t)(kidx0 + j0 + j) * 512 + h * 64); const v4u* rp = (const v4u*)(KR + (size_t)(kidx0 + j0 + j) * 32);
                float sv = 0.f;
#pragma unroll
                for (int c = 0; c < 8; ++c) sv = dot8(qp[c], kp[c], sv);
#pragma unroll
                for (int c = 0; c < 4; ++c) sv = dot8(qp[8 + c], rp[c], sv);
                s[j] = sv;
                __builtin_amdgcn_sched_barrier(0);
            }
            float mx = m;
#pragma unroll
            for (int j = 0; j < 8; ++j) mx = fmaxf(mx, s[j]);
            const float alpha = exp2f(m - mx); m = mx; float ps = 0.f;
#pragma unroll
            for (int j = 0; j < 8; ++j) { s[j] = exp2f(s[j] - mx); ps += s[j]; }
            l = l * alpha + ps;
            unsigned lk = (unsigned)Lk; asm volatile("" : "+v"(lk));
            const bf16* vp = VT + vbase + j0;
#pragma unroll
            for (int dg = 0; dg < 8; ++dg) {
#pragma unroll
                for (int dd = 0; dd < 8; ++dd) { const int d = dg * 8 + dd; const v4u w = *(const v4u*)(vp + (unsigned)d * lk);
                    acc[d] = acc[d] * alpha + s[0] * bflo(w.x) + s[1] * bfhi(w.x) + s[2] * bflo(w.y) + s[3] * bfhi(w.y) + s[4] * bflo(w.z) + s[5] * bfhi(w.z) + s[6] * bflo(w.w) + s[7] * bfhi(w.w); }
                __builtin_amdgcn_sched_barrier(0);
            }
        }
        const float inv = rcp_(l);
#pragma unroll
        for (int c = 0; c < 8; ++c) { const v4u g = *(const v4u*)(G1 + (size_t)n * G1W + C_GM + h * 64 + c * 8);
            v4u o;
            o.x = pk2(acc[c * 8 + 0] * inv * siluf_(bflo(g.x)), acc[c * 8 + 1] * inv * siluf_(bfhi(g.x)));
            o.y = pk2(acc[c * 8 + 2] * inv * siluf_(bflo(g.y)), acc[c * 8 + 3] * inv * siluf_(bfhi(g.y)));
            o.z = pk2(acc[c * 8 + 4] * inv * siluf_(bflo(g.z)), acc[c * 8 + 5] * inv * siluf_(bfhi(g.z)));
            o.w = pk2(acc[c * 8 + 6] * inv * siluf_(bflo(g.w)), acc[c * 8 + 7] * inv * siluf_(bfhi(g.w)));
            *(v4u*)(Q + (size_t)n * 768 + h * 96 + c * 8) = o; }
    }
}
namespace pg8 {
#define PG8_LAS __attribute__((address_space(3)))
typedef unsigned short bf16_t;
typedef short bf16x8 __attribute__((ext_vector_type(8)));
typedef float f32x4 __attribute__((ext_vector_type(4)));
typedef unsigned u32x4 __attribute__((ext_vector_type(4)));
constexpr int BM = 256, BK = 64, HALF = 128, HTB = HALF * BK * 2  , STAGE_BYTES = 8 * HTB, NXCD = 8, WGM = 8;

__host__ __device__ __forceinline__ int lds_byte(int r, int c) { const int st = (r >> 4) * 2 + (c >> 5), rr = r & 15, cc = c & 31, ob = rr * 64 + cc * 2; return st * 1024 + (ob ^ (((ob >> 9) & 1) << 5)); }
__host__ __device__ __forceinline__ void stage_rc(int b, int& R, int& C) { const int st = b / 1024, sb = b % 1024, swz = sb ^ (((sb >> 9) & 1) << 5); R = (st >> 1) * 16 + swz / 64; C = (st & 1) * 32 + (swz % 64) / 2; }
__host__ __device__ __forceinline__ int perm32(int rho) { const int n = rho >> 4, i = rho & 15; return 8 * (i >> 2) + 4 * n + (i & 3); }

struct Unit { int pm, pn; };
struct Gemm { const bf16_t* A; const bf16_t* Bt; int M, N, K; };

struct StaticOrder {
    int nM, nN, nwg, G, c;
    __host__ __device__ void init(int M, int N, int G_, int c_) { nM = M / BM; nN = N / BM; nwg = nM * nN; G = G_; c = c_; }
    __host__ __device__ bool next(int i, Unit& u) const {
        const long L = (long)i * G + c; if (L >= nwg) return false;
        int wgid = (int)L; { const int q = nwg / NXCD, r = nwg % NXCD, xcd = wgid % NXCD, off = wgid / NXCD; wgid = (xcd < r ? xcd * (q + 1) : r * (q + 1) + (xcd - r) * q) + off; }
        const int nig = WGM * nN, gid = wgid / nig, fm = gid * WGM, gsz = (nM - fm) < WGM ? (nM - fm) : WGM;
        u.pm = fm + ((wgid % nig) % gsz); u.pn = (wgid % nig) / gsz; return true;
    }
    __device__ __forceinline__ void a_ready(const Unit&) const {}
    __device__ __forceinline__ void done(const Unit&) const {}
};
__device__ __forceinline__ unsigned cvt_pk_bf16(float lo, float hi) { unsigned r; asm volatile("v_cvt_pk_bf16_f32 %0, %1, %2" : "=v"(r) : "v"(lo), "v"(hi)); return r; }

template <class Epi, class Sched, bool STAMP = false>
__device__ __forceinline__ void gemm_phase(PG8_LAS unsigned char* lds, const Gemm g, const Sched& S, const Epi& E, unsigned long long* stamps) {
    const int tid = tid_(), wid = __builtin_amdgcn_readfirstlane(tid >> 6), lane = tid & 63, wr = wid >> 2, wc = wid & 3, fr = lane & 15, fq = lane >> 4;
    const int K = g.K, nt = K / BK;
    int ts_lo = 0, ts_hi = 0, nts = 0; const unsigned long long rt_entry = STAMP ? (unsigned long long)wall_clock64() : 0ull;
#define PG8_STAMP() do { if (STAMP && wid == 0 && nts < 64) { const unsigned long long _c = (unsigned long long)clock64(); \
        ts_lo = (lane == nts) ? (int)(unsigned)_c : ts_lo; ts_hi = (lane == nts) ? (int)(unsigned)(_c >> 32) : ts_hi; ++nts; } } while (0)
    PG8_STAMP();
    unsigned voffA[2], voffB[2];
#pragma unroll
    for (int i = 0; i < 2; ++i) { int R, C; stage_rc(tid * 16 + i * 8192, R, C); const int Rb = Epi::PERM ? ((R & ~31) + perm32(R & 31)) : R;
        voffA[i] = (unsigned)(R * K + C) * 2u; voffB[i] = (unsigned)(Rb * K + C) * 2u; }
    const size_t kstep = (size_t)(BK * 2);
    const size_t hstep = (size_t)HALF * K * 2;
    const size_t tstep = 2 * hstep;
    const unsigned ldsw = (unsigned)wid * 1024u;
    const int aoff = lds_byte(wr * 64 + fr, fq * 8), boff = lds_byte(wc * 32 + fr, fq * 8);
#define PG8_SA(b, h) (((b) * 2 + (h)) * HTB)
#define PG8_SB(b, h) ((4 + (b) * 2 + (h)) * HTB)
#define PG8_STAGE(bufoff, gbase, voff) do { _Pragma("unroll") for (int _i = 0; _i < 2; ++_i) \
        __builtin_amdgcn_global_load_lds((const unsigned*)((const char*)(gbase) + (voff)[_i]), (PG8_LAS unsigned*)(lds + (bufoff) + ldsw + _i * 8192), 16, 0, 0); } while (0)
#define PG8_LDA(dst, b, h) do { _Pragma("unroll") for (int m = 0; m < 4; ++m) _Pragma("unroll") for (int k = 0; k < 2; ++k) dst[m][k] = *(const PG8_LAS bf16x8*)(lds + PG8_SA(b, h) + aoff + m * 2048 + k * 1024); } while (0)
#define PG8_LDB(dst, b, h) do { _Pragma("unroll") for (int n = 0; n < 2; ++n) _Pragma("unroll") for (int k = 0; k < 2; ++k) dst[n][k] = *(const PG8_LAS bf16x8*)(lds + PG8_SB(b, h) + boff + n * 2048 + k * 1024); } while (0)
#define PG8_MMA(ai, bj, At, Bt) do { __builtin_amdgcn_s_setprio(1); _Pragma("unroll") for (int m = 0; m < 4; ++m) _Pragma("unroll") for (int n = 0; n < 2; ++n) _Pragma("unroll") for (int k = 0; k < 2; ++k) \
        acc[ai][bj][m][n] = __builtin_amdgcn_mfma_f32_16x16x32_bf16(Bt[n][k], At[m][k], acc[ai][bj][m][n], 0, 0, 0); __builtin_amdgcn_s_setprio(0); } while (0)
#define PG8_WAIT_V(n) asm volatile("s_waitcnt vmcnt(" #n ")" ::: "memory")
#define PG8_WAIT_L(n) asm volatile("s_waitcnt lgkmcnt(" #n ")" ::: "memory")
#define PG8_BAR __builtin_amdgcn_s_barrier()
#define PG8_SCHED __builtin_amdgcn_sched_barrier(0)
    Unit cur, nxt; int ui = 0;
    if (!S.next(0, cur)) return;
    f32x4 acc[2][2][4][2];
#pragma unroll
    for (int a = 0; a < 2; ++a)
#pragma unroll
        for (int b = 0; b < 2; ++b)
#pragma unroll
            for (int m = 0; m < 4; ++m)
#pragma unroll
                for (int n = 0; n < 2; ++n) acc[a][b][m][n] = (f32x4){0.f, 0.f, 0.f, 0.f};
    bf16x8 At[4][2], B0[2][2], B1[2][2];
    const char* cA = (const char*)g.A + (size_t)cur.pm * tstep; const char* cB = (const char*)g.Bt + (size_t)cur.pn * tstep;
    S.a_ready(cur);
    PG8_STAGE(PG8_SB(0, 0), cB, voffB); PG8_STAGE(PG8_SA(0, 0), cA, voffA); PG8_STAGE(PG8_SB(0, 1), cB + hstep, voffB); PG8_STAGE(PG8_SA(0, 1), cA + hstep, voffA);
    if (wr == 1) PG8_BAR;
    PG8_WAIT_V(4); PG8_BAR;
    PG8_STAGE(PG8_SB(1, 0), cB + kstep, voffB); PG8_STAGE(PG8_SA(1, 0), cA + kstep, voffA); PG8_STAGE(PG8_SB(1, 1), cB + hstep + kstep, voffB);
    PG8_WAIT_V(6); PG8_BAR;
    PG8_STAMP();
    for (;;) {
        const bool has_next = S.next(ui + 1, nxt);
        const char* nA = has_next ? (const char*)g.A + (size_t)nxt.pm * tstep : cA; const char* nB = has_next ? (const char*)g.Bt + (size_t)nxt.pn * tstep : cB;
        for (int t = 0; t < nt; t += 2) {
            const bool last = (t == nt - 2);
            const char* a1 = cA + (size_t)(t + 1) * kstep;
            const char* a2 = last ? nA : cA + (size_t)(t + 2) * kstep; const char* b2 = last ? nB : cB + (size_t)(t + 2) * kstep;
            const char* a3 = a2 + kstep; const char* b3 = b2 + kstep;
            if (last && has_next) S.a_ready(nxt);
            PG8_LDB(B0, 0, 0); PG8_SCHED; PG8_LDA(At, 0, 0); PG8_STAGE(PG8_SA(1, 1), a1 + hstep, voffA);
            PG8_WAIT_L(8); PG8_BAR; PG8_WAIT_L(0); PG8_MMA(0, 0, At, B0); PG8_BAR; PG8_SCHED;
            PG8_LDB(B1, 0, 1); PG8_STAGE(PG8_SB(0, 0), b2, voffB);
            PG8_BAR; PG8_WAIT_L(0); PG8_MMA(0, 1, At, B1); PG8_BAR;
            PG8_LDA(At, 0, 1); PG8_STAGE(PG8_SA(0, 0), a2, voffA);
            PG8_BAR; PG8_WAIT_L(0); PG8_MMA(1, 0, At, B0); PG8_BAR; PG8_SCHED;
            PG8_STAGE(PG8_SB(0, 1), b2 + hstep, voffB);
            PG8_WAIT_V(6); PG8_BAR; PG8_MMA(1, 1, At, B1); PG8_BAR;
            PG8_LDB(B0, 1, 0); PG8_SCHED; PG8_LDA(At, 1, 0); PG8_STAGE(PG8_SA(0, 1), a2 + hstep, voffA);
            PG8_WAIT_L(8); PG8_BAR; PG8_WAIT_L(0); PG8_MMA(0, 0, At, B0); PG8_BAR; PG8_SCHED;
            PG8_LDB(B1, 1, 1); PG8_STAGE(PG8_SB(1, 0), b3, voffB);
            PG8_BAR; PG8_WAIT_L(0); PG8_MMA(0, 1, At, B1); PG8_BAR;
            PG8_LDA(At, 1, 1); PG8_STAGE(PG8_SA(1, 0), a3, voffA);
            PG8_BAR; PG8_WAIT_L(0); PG8_MMA(1, 0, At, B0); PG8_BAR; PG8_SCHED;
            PG8_STAGE(PG8_SB(1, 1), b3 + hstep, voffB);
            PG8_WAIT_V(6); PG8_BAR; PG8_MMA(1, 1, At, B1); PG8_BAR;
        }
        PG8_STAMP();
        if constexpr (!Epi::AFTER_DRAIN) { E(acc, cur, wr, wc, fr, fq); S.done(cur); }
        PG8_STAMP();
        if (!has_next) break;
#pragma unroll
        for (int a = 0; a < 2; ++a)
#pragma unroll
            for (int b = 0; b < 2; ++b)
#pragma unroll
                for (int m = 0; m < 4; ++m)
#pragma unroll
                    for (int n = 0; n < 2; ++n) acc[a][b][m][n] = (f32x4){0.f, 0.f, 0.f, 0.f};
        cur = nxt; cA = nA; cB = nB; ++ui;
    }
    PG8_WAIT_V(0);
    if (wr == 0) PG8_BAR;
    PG8_BAR;
    if constexpr (Epi::AFTER_DRAIN) { E.fused(acc, cur, wr, wc, fr, fq, lds, wid, lane); S.done(cur); }
    PG8_STAMP();
    if (STAMP && wid == 0) { stamps[lane] = lane < nts ? (((unsigned long long)(unsigned)ts_hi << 32) | (unsigned)ts_lo) : 0ull;
        if (lane == 62) stamps[62] = rt_entry; if (lane == 63) stamps[63] = (unsigned long long)wall_clock64(); }
#undef PG8_STAMP
#undef PG8_SA
#undef PG8_SB
#undef PG8_STAGE
#undef PG8_LDA
#undef PG8_LDB
#undef PG8_MMA
#undef PG8_WAIT_V
#undef PG8_WAIT_L
#undef PG8_BAR
#undef PG8_SCHED
}
}
namespace pg8 {
struct EpiIn {
    static constexpr bool PERM = true, AFTER_DRAIN = false;
    bf16_t* G1; bf16_t* G2;
    __device__ __forceinline__ void operator()(const f32x4 (&acc)[2][2][4][2], const Unit& u, int wr, int wc, int fr, int fq) const {
        const int row0 = u.pm * BM + wr * 64 + fr;
        bf16_t* base; int ldc, colt;
        if (u.pn < 9) { base = G1; ldc = 2304; colt = u.pn * 256; } else { base = G2; ldc = 512; colt = (u.pn - 9) * 256; }
        const int col0 = colt + wc * 32 + 8 * fq;
#pragma unroll
        for (int ai = 0; ai < 2; ++ai)
#pragma unroll
            for (int m = 0; m < 4; ++m) { bf16_t* rowp = base + (size_t)(row0 + ai * HALF + m * 16) * ldc + col0;
#pragma unroll
                for (int bj = 0; bj < 2; ++bj) { const f32x4 v0 = acc[ai][bj][m][0], v1 = acc[ai][bj][m][1];
                    u32x4 w; w.x = cvt_pk_bf16(v0[0], v0[1]); w.y = cvt_pk_bf16(v0[2], v0[3]); w.z = cvt_pk_bf16(v1[0], v1[1]); w.w = cvt_pk_bf16(v1[2], v1[3]);
                    *(u32x4*)(rowp + bj * HALF) = w; } }
    }
};
struct EpiOut {
    static constexpr bool PERM = false, AFTER_DRAIN = false;
    const float* xp; const float* xs; const float* xo; float* out; const float* mod; int layer;
    __device__ __forceinline__ void operator()(const f32x4 (&acc)[2][2][4][2], const Unit& u, int wr, int wc, int fr, int fq) const {
        const int row0 = u.pm * BM + wr * 64 + fr, col0 = u.pn * BM + wc * 32 + 4 * fq;
        const int rt = u.pm * BM; const int modrow = rt < 8192 ? 0 : 1 + ((rt - 8192) >> 11);
        const float* gp = mod + (size_t)modrow * 3072 + 2048 + col0;
        f32x4 gv[2][2];
#pragma unroll
        for (int bj = 0; bj < 2; ++bj)
#pragma unroll
            for (int n = 0; n < 2; ++n) gv[bj][n] = *(const f32x4*)(gp + bj * HALF + n * 16);
#pragma unroll
        for (int ai = 0; ai < 2; ++ai)
#pragma unroll
            for (int m = 0; m < 4; ++m) { const int row = row0 + ai * HALF + m * 16;
                const float* xr = (layer == 0 ? (row < 8192 ? xp + (size_t)row * 1024 : xs + (size_t)(row - 8192) * 1024) : xo + (size_t)row * 1024) + col0;
                float* orow = out + (size_t)row * 1024 + col0;
#pragma unroll
                for (int bj = 0; bj < 2; ++bj)
#pragma unroll
                    for (int n = 0; n < 2; ++n) { const f32x4 x = *(const f32x4*)(xr + bj * HALF + n * 16);
                        *(f32x4*)(orow + bj * HALF + n * 16) = x * 1.4142135623730951f + gv[bj][n] * acc[ai][bj][m][n]; } }
    }
};
}

__device__ __forceinline__ void phase_a1_pg8(ArgsP a, LAS unsigned char* lds, int layer) {
    pg8::Gemm g{(const bf16*)(a->ws + WS_U), (const bf16*)(a->ws + WS_WIN) + (size_t)layer * NIN * 1024, T, NIN, 1024};
    pg8::StaticOrder S; S.init(T, NIN, grid_(), bid_());
    pg8::EpiIn E{(bf16*)(a->ws + WS_G1), (bf16*)(a->ws + WS_G2)};
    pg8::gemm_phase<pg8::EpiIn, pg8::StaticOrder, false>(lds, g, S, E, nullptr);
}
__device__ __forceinline__ void phase_c2_pg8(ArgsP a, LAS unsigned char* lds, int layer) {
    pg8::Gemm g{(const bf16*)(a->ws + WS_YMIX), (const bf16*)(a->ws + WS_WOUT) + (size_t)layer * 1024 * 1024, T, 1024, 1024};
    pg8::StaticOrder S; S.init(T, 1024, grid_(), bid_());
    pg8::EpiOut E{a->in[I_XP], a->in[I_XS], a->out, a->out, (const float*)(a->ws + WS_MOD) + (size_t)layer * 9 * 3072, layer};
    pg8::gemm_phase<pg8::EpiOut, pg8::StaticOrder, false>(lds, g, S, E, nullptr);
}
__device__ __forceinline__ void rwkv_unit_seq(ArgsP a, LAS unsigned char* lds, int layer, int u) {
    const int tid = tid_();
    LAS float* W2s = (LAS float*)lds;
    LAS float* A2s = W2s + 4096;
    LAS float* TH = A2s + 4096;
    LAS float* HA = TH + 2048;
    LAS float* Wd = HA + 2048;
    LAS float* KT = Wd + 2048; LAS float* KK = KT + 2048; LAS float* BB = KK + 2048; LAS float* RR = BB + 2048; LAS float* VV = RR + 2048; LAS float* YO = VV + 2048;
    const int lat = u < 64, uu = lat ? u : u - 64, b = uu >> 3, e = (uu >> 2) & 1, hh = uu & 3;
    const int L = lat ? L_LAT : L_CTX, tok0 = lat ? T_CTX + b * L_LAT : b * L_CTX;
    const bf16* G1 = (const bf16*)(a->ws + WS_G1);
    bf16* YS = (bf16*)(a->ws + WS_G2);
    for (int i = tid; i < 4096; i += NTHREADS) { const int j = i >> 6, c = i & 63;
        W2s[i] = a->in[I_W2][((size_t)(layer * 2 + e) * 64 + j) * 256 + hh * 64 + c];
        A2s[i] = a->in[I_A2][((size_t)(layer * 2 + e) * 64 + j) * 256 + hh * 64 + c]; }
    const int r = tid >> 3, ks = tid & 7;
    float S[8];
#pragma unroll
    for (int j = 0; j < 8; ++j) S[j] = lat ? a->in[I_SRW][(((size_t)((b * 2 + layer) * 2 + e) * 4 + hh) * 64 + r) * 64 + ks * 8 + j] : 0.f;
    const int tt = tid >> 4, q4 = (tid & 15) * 4;
    float w0v[4], a0v[4], kkw[4], kav[4];
#pragma unroll
    for (int i = 0; i < 4; ++i) { const int ch = hh * 64 + q4 + i;
        w0v[i] = a->in[I_W0][(layer * 2 + e) * 256 + ch]; a0v[i] = a->in[I_A0][(layer * 2 + e) * 256 + ch]; kkw[i] = a->in[I_KK][layer * 256 + ch]; kav[i] = a->in[I_KA][layer * 256 + ch]; }
    __syncthreads();
    for (int c = 0; c < L / 32; ++c) {
        const int step = c * 32 + tt, t = e ? L - 1 - step : step, n = tok0 + t;
        const bf16* g = G1 + (size_t)n * G1W;
        { const v2u hw = *(const v2u*)(g + C_LORA + e * 64 + q4), ha = *(const v2u*)(g + C_LORA + 128 + e * 64 + q4);
          TH[tt * 64 + q4 + 0] = tanhf(bflo(hw.x)); TH[tt * 64 + q4 + 1] = tanhf(bfhi(hw.x)); TH[tt * 64 + q4 + 2] = tanhf(bflo(hw.y)); TH[tt * 64 + q4 + 3] = tanhf(bfhi(hw.y));
          HA[tt * 64 + q4 + 0] = bflo(ha.x); HA[tt * 64 + q4 + 1] = bfhi(ha.x); HA[tt * 64 + q4 + 2] = bflo(ha.y); HA[tt * 64 + q4 + 3] = bfhi(ha.y); }
        __syncthreads();
        {
            float wl[4], al[4];
#pragma unroll
            for (int i = 0; i < 4; ++i) { wl[i] = w0v[i]; al[i] = a0v[i]; }
            for (int j = 0; j < 64; ++j) { const float th = TH[tt * 64 + j], hv = HA[tt * 64 + j];
                const f32x4 w2 = *(const LAS f32x4*)(W2s + j * 64 + q4), a2 = *(const LAS f32x4*)(A2s + j * 64 + q4);
                wl[0] = fmaf(th, w2.x, wl[0]); wl[1] = fmaf(th, w2.y, wl[1]); wl[2] = fmaf(th, w2.z, wl[2]); wl[3] = fmaf(th, w2.w, wl[3]);
                al[0] = fmaf(hv, a2.x, al[0]); al[1] = fmaf(hv, a2.y, al[1]); al[2] = fmaf(hv, a2.z, al[2]); al[3] = fmaf(hv, a2.w, al[3]); }
            const v2u kv = *(const v2u*)(g + C_K + hh * 64 + q4), rv = *(const v2u*)(g + C_R + hh * 64 + q4), vv = *(const v2u*)(g + C_V + hh * 64 + q4);
            const float kx[4] = {bflo(kv.x), bfhi(kv.x), bflo(kv.y), bfhi(kv.y)}, rx[4] = {bflo(rv.x), bfhi(rv.x), bflo(rv.y), bfhi(rv.y)}, vx[4] = {bflo(vv.x), bfhi(vv.x), bflo(vv.y), bfhi(vv.y)};
            float kkr[4], ss = 0.f;
#pragma unroll
            for (int i = 0; i < 4; ++i) { kkr[i] = kx[i] * kkw[i]; ss += kkr[i] * kkr[i]; }
            ss += __shfl_xor(ss, 1); ss += __shfl_xor(ss, 2); ss += __shfl_xor(ss, 4); ss += __shfl_xor(ss, 8);
            const float inrm = rcp_(fmaxf(sqrt_(ss), 1e-12f));
#pragma unroll
            for (int i = 0; i < 4; ++i) {
                const float dec = exp_(-0.6065306597126334f * sigmoidf_(wl[i])), av = sigmoidf_(al[i]), kk = kkr[i] * inrm;
                const int o = tt * 64 + q4 + i;
                Wd[o] = dec; KT[o] = kx[i] * (1.f + (av - 1.f) * kav[i]); KK[o] = kk; BB[o] = kk * av; RR[o] = rx[i]; VV[o] = vx[i]; }
        }
        __syncthreads();
        for (int s = 0; s < 32; ++s) {
            const int o = s * 64 + ks * 8;
            const f32x4 k0 = *(const LAS f32x4*)(KK + o), k1 = *(const LAS f32x4*)(KK + o + 4);
            float p = S[0] * k0.x + S[1] * k0.y + S[2] * k0.z + S[3] * k0.w + S[4] * k1.x + S[5] * k1.y + S[6] * k1.z + S[7] * k1.w;
            p += __shfl_xor(p, 1); p += __shfl_xor(p, 2); p += __shfl_xor(p, 4);
            const float sa = -p, vv = VV[s * 64 + r];
            const f32x4 w0 = *(const LAS f32x4*)(Wd + o), w1 = *(const LAS f32x4*)(Wd + o + 4), b0 = *(const LAS f32x4*)(BB + o), b1 = *(const LAS f32x4*)(BB + o + 4);
            const f32x4 t0 = *(const LAS f32x4*)(KT + o), t1 = *(const LAS f32x4*)(KT + o + 4), r0 = *(const LAS f32x4*)(RR + o), r1 = *(const LAS f32x4*)(RR + o + 4);
            S[0] = S[0] * w0.x + sa * b0.x + vv * t0.x; S[1] = S[1] * w0.y + sa * b0.y + vv * t0.y; S[2] = S[2] * w0.z + sa * b0.z + vv * t0.z; S[3] = S[3] * w0.w + sa * b0.w + vv * t0.w;
            S[4] = S[4] * w1.x + sa * b1.x + vv * t1.x; S[5] = S[5] * w1.y + sa * b1.y + vv * t1.y; S[6] = S[6] * w1.z + sa * b1.z + vv * t1.z; S[7] = S[7] * w1.w + sa * b1.w + vv * t1.w;
            float y = S[0] * r0.x + S[1] * r0.y + S[2] * r0.z + S[3] * r0.w + S[4] * r1.x + S[5] * r1.y + S[6] * r1.z + S[7] * r1.w;
            y += __shfl_xor(y, 1); y += __shfl_xor(y, 2); y += __shfl_xor(y, 4);
            if (ks == 0) YO[s * 64 + r] = y;
        }
        __syncthreads();
        { v2u o; o.x = pk2(YO[tt * 64 + q4], YO[tt * 64 + q4 + 1]); o.y = pk2(YO[tt * 64 + q4 + 2], YO[tt * 64 + q4 + 3]);
          *(v2u*)(YS + ((size_t)e * T + n) * 256 + hh * 64 + q4) = o; }
        __syncthreads();
    }
    if (!lat) {
        float* dst = a->out + O_RW + (((size_t)((b * 2 + layer) * 2 + e) * 4 + hh) * 64 + r) * 64 + ks * 8;
        *(f32x4*)dst = (f32x4){S[0], S[1], S[2], S[3]}; *(f32x4*)(dst + 4) = (f32x4){S[4], S[5], S[6], S[7]};
    }
}

__device__ __forceinline__ void lru_unit_seq(ArgsP a, LAS unsigned char* lds, int layer, int u) {
    const int tid = tid_();
    LAS float* WA = (LAS float*)lds;
    LAS float* WX = WA + 4096;
    LAS float* XC = WX + 4096;
    LAS float* AA = XC + 4096; LAS float* BV = AA + 4096; LAS float* HH = BV + 4096;
    const int lat = u < 32, uu = lat ? u : u - 32, b = uu >> 2, g = uu & 3;
    const int L = lat ? L_LAT : L_CTX, tok0 = lat ? T_CTX + b * L_LAT : b * L_CTX;
    const bf16* G1 = (const bf16*)(a->ws + WS_G1);
    bf16* HF = (bf16*)(a->ws + WS_HF);
    const int tt = tid >> 3, q8 = (tid & 7) * 8;
    float cw[4][8], cb[8];
#pragma unroll
    for (int i = 0; i < 8; ++i) { const int ch = g * 64 + q8 + i; cb[i] = a->in[I_CONVB][layer * 256 + ch];
#pragma unroll
        for (int j = 0; j < 4; ++j) cw[j][i] = a->in[I_CONVW][(layer * 4 + j) * 256 + ch]; }
    for (int e = 0; e < 2; ++e) {
        __syncthreads();
        for (int i = tid; i < 4096; i += NTHREADS) { const size_t src = ((size_t)((layer * 2 + e) * 4 + g)) * 4096 + i; WA[i] = a->in[I_WA][src]; WX[i] = a->in[I_WX][src]; }
        float bav[8], bxv[8], spl[8];
#pragma unroll
        for (int i = 0; i < 8; ++i) { const int ch = (layer * 2 + e) * 256 + g * 64 + q8 + i; bav[i] = a->in[I_BA][ch]; bxv[i] = a->in[I_BX][ch]; spl[i] = log1pf(exp_(-a->in[I_LAMBDA][ch])); }
        float h = 0.f;
        if (tid < 64 && lat) h = a->in[I_SLRU][((size_t)(b * 2 + layer) * 2 + e) * 256 + g * 64 + tid];
        __syncthreads();
        for (int cc = 0; cc < L / 64; ++cc) {
            const int c = e ? L / 64 - 1 - cc : cc, t = c * 64 + tt, n = tok0 + t;
            {
                float xc[8];
#pragma unroll
                for (int i = 0; i < 8; ++i) xc[i] = cb[i];
#pragma unroll
                for (int j = 0; j < 4; ++j) { const int ts = t + j - 2;
                    if (ts >= 0 && ts < L) { const v4u x = *(const v4u*)(G1 + (size_t)(tok0 + ts) * G1W + C_XL + g * 64 + q8);
                        xc[0] += cw[j][0] * bflo(x.x); xc[1] += cw[j][1] * bfhi(x.x); xc[2] += cw[j][2] * bflo(x.y); xc[3] += cw[j][3] * bfhi(x.y);
                        xc[4] += cw[j][4] * bflo(x.z); xc[5] += cw[j][5] * bfhi(x.z); xc[6] += cw[j][6] * bflo(x.w); xc[7] += cw[j][7] * bfhi(x.w); } }
#pragma unroll
                for (int i = 0; i < 8; ++i) XC[tt * 64 + q8 + i] = xc[i];
            }
            __syncthreads();
            {
                float gr[8], gi[8];
#pragma unroll
                for (int i = 0; i < 8; ++i) { gr[i] = bav[i]; gi[i] = bxv[i]; }
                for (int i = 0; i < 64; ++i) { const float x = XC[tt * 64 + i];
                    const f32x4 a0 = *(const LAS f32x4*)(WA + i * 64 + q8), a1 = *(const LAS f32x4*)(WA + i * 64 + q8 + 4), x0 = *(const LAS f32x4*)(WX + i * 64 + q8), x1 = *(const LAS f32x4*)(WX + i * 64 + q8 + 4);
                    gr[0] = fmaf(x, a0.x, gr[0]); gr[1] = fmaf(x, a0.y, gr[1]); gr[2] = fmaf(x, a0.z, gr[2]); gr[3] = fmaf(x, a0.w, gr[3]);
                    gr[4] = fmaf(x, a1.x, gr[4]); gr[5] = fmaf(x, a1.y, gr[5]); gr[6] = fmaf(x, a1.z, gr[6]); gr[7] = fmaf(x, a1.w, gr[7]);
                    gi[0] = fmaf(x, x0.x, gi[0]); gi[1] = fmaf(x, x0.y, gi[1]); gi[2] = fmaf(x, x0.z, gi[2]); gi[3] = fmaf(x, x0.w, gi[3]);
                    gi[4] = fmaf(x, x1.x, gi[4]); gi[5] = fmaf(x, x1.y, gi[5]); gi[6] = fmaf(x, x1.z, gi[6]); gi[7] = fmaf(x, x1.w, gi[7]); }
#pragma unroll
                for (int i = 0; i < 8; ++i) { const float la = -8.f * sigmoidf_(gr[i]) * spl[i];
                    AA[tt * 64 + q8 + i] = exp_(la);
                    BV[tt * 64 + q8 + i] = sqrt_(-expm1f(2.f * la)) * sigmoidf_(gi[i]) * XC[tt * 64 + q8 + i]; }
            }
            __syncthreads();
            if (tid < 64) { for (int s = 0; s < 64; ++s) { const int st = e ? 63 - s : s; h = fmaf(AA[st * 64 + tid], h, BV[st * 64 + tid]); HH[st * 64 + tid] = h; } }
            __syncthreads();
            {
                bf16* dst = HF + (size_t)n * 256 + g * 64 + q8;
                float o[8];
#pragma unroll
                for (int i = 0; i < 8; ++i) o[i] = HH[tt * 64 + q8 + i];
                if (e) { const v4u hf = *(const v4u*)dst, gl = *(const v4u*)(G1 + (size_t)n * G1W + C_GL + g * 64 + q8);
                    o[0] = (o[0] + bflo(hf.x)) * siluf_(bflo(gl.x)); o[1] = (o[1] + bfhi(hf.x)) * siluf_(bfhi(gl.x)); o[2] = (o[2] + bflo(hf.y)) * siluf_(bflo(gl.y)); o[3] = (o[3] + bfhi(hf.y)) * siluf_(bfhi(gl.y));
                    o[4] = (o[4] + bflo(hf.z)) * siluf_(bflo(gl.z)); o[5] = (o[5] + bfhi(hf.z)) * siluf_(bfhi(gl.z)); o[6] = (o[6] + bflo(hf.w)) * siluf_(bflo(gl.w)); o[7] = (o[7] + bfhi(hf.w)) * siluf_(bfhi(gl.w)); }
                v4u ov; ov.x = pk2(o[0], o[1]); ov.y = pk2(o[2], o[3]); ov.z = pk2(o[4], o[5]); ov.w = pk2(o[6], o[7]);
                *(v4u*)dst = ov;
            }
            __syncthreads();
        }
        if (tid < 64 && !lat) a->out[O_LRU + ((size_t)(b * 2 + layer) * 2 + e) * 256 + g * 64 + tid] = h;
    }
}

__device__ __forceinline__ void phase_c1(ArgsP a, int layer) {
    const int tid = tid_(), lane = tid & 63, wave = tid >> 6, G = grid_();
    const bf16* G1 = (const bf16*)(a->ws + WS_G1); const bf16* YS = (const bf16*)(a->ws + WS_G2); const bf16* Q = (const bf16*)(a->ws + WS_Q); const bf16* HF = (const bf16*)(a->ws + WS_HF);
    bf16* Y = (bf16*)(a->ws + WS_YMIX);
    const int ch = lane * 4;
    const f32x4 rk = *(const f32x4*)(a->in[I_RK] + layer * 256 + ch), lg = *(const f32x4*)(a->in[I_LNXG] + layer * 256 + ch), lb = *(const f32x4*)(a->in[I_LNXB] + layer * 256 + ch);
    v2u p_y0, p_y1, p_r, p_k, p_v, p_g, p_h; v4u p_q;
#define C1_LOAD(nn) do { const bf16* g_ = G1 + (size_t)(nn) * G1W; p_y0 = *(const v2u*)(YS + (size_t)(nn) * 256 + ch); p_y1 = *(const v2u*)(YS + ((size_t)T + (nn)) * 256 + ch); \
        p_r = *(const v2u*)(g_ + C_R + ch); p_k = *(const v2u*)(g_ + C_K + ch); p_v = *(const v2u*)(g_ + C_V + ch); p_g = *(const v2u*)(g_ + C_G + ch); \
        p_q = *(const v4u*)(Q + (size_t)(nn) * 768 + (lane >> 3) * 96 + (lane & 7) * 8); p_h = *(const v2u*)(HF + (size_t)(nn) * 256 + ch); } while (0)
    { const int n0 = bid_() * 8 + wave; if (n0 < T) C1_LOAD(n0); }
    for (int n = bid_() * 8 + wave; n < T; n += G * 8) {
        const v2u y0 = p_y0, y1 = p_y1, rv = p_r, kv = p_k, vv = p_v, gv = p_g, hq = p_h; const v4u qq = p_q;
        if (n + G * 8 < T) C1_LOAD(n + G * 8);
        float y[4] = {bflo(y0.x) + bflo(y1.x), bfhi(y0.x) + bfhi(y1.x), bflo(y0.y) + bflo(y1.y), bfhi(y0.y) + bfhi(y1.y)};
        float s = (y[0] + y[1]) + (y[2] + y[3]);
        float bon = bflo(rv.x) * bflo(kv.x) * rk.x + bfhi(rv.x) * bfhi(kv.x) * rk.y + bflo(rv.y) * bflo(kv.y) * rk.z + bfhi(rv.y) * bfhi(kv.y) * rk.w;
#pragma unroll
        for (int o = 1; o < 16; o <<= 1) { s += __shfl_xor(s, o); bon += __shfl_xor(bon, o); }
        const float mu = s * (1.f / 64.f);
        float s2 = (y[0] - mu) * (y[0] - mu) + (y[1] - mu) * (y[1] - mu) + (y[2] - mu) * (y[2] - mu) + (y[3] - mu) * (y[3] - mu);
#pragma unroll
        for (int o = 1; o < 16; o <<= 1) s2 += __shfl_xor(s2, o);
        const float rstd = rsqrt_(s2 * (1.f / 64.f) + GN_EPS);
        const float o0 = ((y[0] - mu) * rstd * lg.x + lb.x + bon * bflo(vv.x)) * siluf_(bflo(gv.x));
        const float o1 = ((y[1] - mu) * rstd * lg.y + lb.y + bon * bfhi(vv.x)) * siluf_(bfhi(gv.x));
        const float o2 = ((y[2] - mu) * rstd * lg.z + lb.z + bon * bflo(vv.y)) * siluf_(bflo(gv.y));
        const float o3 = ((y[3] - mu) * rstd * lg.w + lb.w + bon * bfhi(vv.y)) * siluf_(bfhi(gv.y));
        v2u ov; ov.x = pk2(o0, o1); ov.y = pk2(o2, o3);
        bf16* yr = Y + (size_t)n * 1024;
        *(v2u*)(yr + ch) = ov;
        *(v4u*)(yr + 256 + (lane >> 3) * 64 + (lane & 7) * 8) = qq;
        *(v2u*)(yr + 768 + ch) = hq;
    }
#undef C1_LOAD
}
typedef float f32x16 __attribute__((ext_vector_type(16)));
typedef float f32x2_t __attribute__((ext_vector_type(2)));
typedef __bf16 bf16x2_t __attribute__((ext_vector_type(2)));
__device__ __forceinline__ unsigned cvtpk(float lo, float hi) { const f32x2_t v = {lo, hi}; return __builtin_bit_cast(unsigned, __builtin_convertvector(v, bf16x2_t)); }
#define MFMA32(a, b, c) __builtin_amdgcn_mfma_f32_32x32x16_bf16((a), (b), (c), 0, 0, 0)
#define MFMA16(a, b, c) __builtin_amdgcn_mfma_f32_16x16x32_bf16((a), (b), (c), 0, 0, 0)

__device__ __forceinline__ float tanh_fast(float x) { return 1.f - 2.f * rcp_(1.f + exp_(2.f * x)); }

constexpr int ATT_KSTR = 208, ATT_VSTR = 136, ATT_VOFF = 64 * ATT_KSTR, ATT_STAGE = 64 * ATT_KSTR + 64 * ATT_VSTR;
__device__ __forceinline__ void att_unit(ArgsP a, LAS unsigned char* lds, int u) {
    const int tid = tid_(), lane = tid & 63, wave = tid >> 6, r = lane & 31, hq = lane >> 5;
    const bf16* KN = (const bf16*)(a->ws + WS_KN); const bf16* KR = (const bf16*)(a->ws + WS_KR); const bf16* VT = (const bf16*)(a->ws + WS_VT);
    bf16* Q = (bf16*)(a->ws + WS_Q); const bf16* G1 = (const bf16*)(a->ws + WS_G1);
    int b, h, n0, Lk, kidx0; size_t vbase;
    if (u < 512) { b = u >> 6; h = (u >> 3) & 7; n0 = T_CTX + b * 2048 + (u & 7) * 256; Lk = LK_LAT; kidx0 = T_CTX + b * LK_LAT; vbase = (size_t)VT_LAT + (size_t)(b * 8 + h) * 64 * LK_LAT; }
    else { const int uu = u - 512; b = uu >> 3; h = uu & 7; n0 = b * 256; Lk = 256; kidx0 = b * 256; vbase = (size_t)(b * 8 + h) * 64 * 256; }
    const int ntiles = Lk >> 6;
    const int n = n0 + wave * 32 + r;
    bf16x8 qf[6];
#pragma unroll
    for (int ks = 0; ks < 6; ++ks) qf[ks] = *(const bf16x8*)(Q + (size_t)n * 768 + h * 96 + ks * 16 + 8 * hq);
    const int key_k = tid >> 3, ck = tid & 7, key_r = (tid >> 2) & 63, cr = tid & 3;
    const bf16* gk = KN + (size_t)(kidx0 + key_k) * 512 + h * 64 + ck * 8;
    const bf16* gr = KR + (size_t)(kidx0 + key_r) * 32 + cr * 8;
    const bf16* gv = VT + vbase + (size_t)key_k * Lk + ck * 8;
    const unsigned sk = key_k * ATT_KSTR + ck * 16, sr = key_r * ATT_KSTR + 128 + cr * 16, sv = ATT_VOFF + key_k * ATT_VSTR + ck * 16;
    v4u rk, rr, rv;
    rk = *(const v4u*)gk; rr = (tid < 256) ? *(const v4u*)gr : (v4u){0u, 0u, 0u, 0u}; rv = *(const v4u*)gv;
    __syncthreads();
    *(LAS v4u*)(lds + sk) = rk; if (tid < 256) *(LAS v4u*)(lds + sr) = rr;
    *(LAS v2u*)(lds + sv) = (v2u){rv.x, rv.y}; *(LAS v2u*)(lds + sv + 8) = (v2u){rv.z, rv.w};
    __syncthreads();
    f32x16 o0, o1;
#pragma unroll
    for (int i = 0; i < 16; ++i) { o0[i] = 0.f; o1[i] = 0.f; }
    float m = -1e30f, l = 0.f;
    for (int j = 0; j < ntiles; ++j) {
        const int buf = j & 1;
        if (j + 1 < ntiles) { rk = *(const v4u*)(gk + (size_t)(j + 1) * 64 * 512); if (tid < 256) rr = *(const v4u*)(gr + (size_t)(j + 1) * 64 * 32); rv = *(const v4u*)(gv + (j + 1) * 64); }
        const LAS unsigned char* Kb = lds + buf * ATT_STAGE;
        f32x16 s0, s1;
#pragma unroll
        for (int i = 0; i < 16; ++i) { s0[i] = 0.f; s1[i] = 0.f; }
#pragma unroll
        for (int ks = 0; ks < 6; ++ks) {
            const bf16x8 a0 = *(const LAS bf16x8*)(Kb + r * ATT_KSTR + ks * 32 + hq * 16), a1 = *(const LAS bf16x8*)(Kb + (32 + r) * ATT_KSTR + ks * 32 + hq * 16);
            s0 = MFMA32(a0, qf[ks], s0); s1 = MFMA32(a1, qf[ks], s1);
        }
        float mx = s0[0];
#pragma unroll
        for (int i = 1; i < 16; ++i) mx = fmaxf(mx, s0[i]);
#pragma unroll
        for (int i = 0; i < 16; ++i) mx = fmaxf(mx, s1[i]);
        mx = fmaxf(mx, __shfl_xor(mx, 32));
        const float mn = fmaxf(m, mx), alpha = __builtin_amdgcn_exp2f(m - mn); m = mn;
        float ps = 0.f;
#pragma unroll
        for (int i = 0; i < 16; ++i) { s0[i] = __builtin_amdgcn_exp2f(s0[i] - mn); s1[i] = __builtin_amdgcn_exp2f(s1[i] - mn); ps += s0[i] + s1[i]; }
        l = l * alpha + ps;
#pragma unroll
        for (int i = 0; i < 16; ++i) { o0[i] *= alpha; o1[i] *= alpha; }
        const LAS unsigned char* Vb = Kb + ATT_VOFF;
#pragma unroll
        for (int ks = 0; ks < 4; ++ks) {
            v4u pw;
            if (ks == 0) { pw.x = cvtpk(s0[0], s0[1]); pw.y = cvtpk(s0[2], s0[3]); pw.z = cvtpk(s0[4], s0[5]); pw.w = cvtpk(s0[6], s0[7]); }
            else if (ks == 1) { pw.x = cvtpk(s0[8], s0[9]); pw.y = cvtpk(s0[10], s0[11]); pw.z = cvtpk(s0[12], s0[13]); pw.w = cvtpk(s0[14], s0[15]); }
            else if (ks == 2) { pw.x = cvtpk(s1[0], s1[1]); pw.y = cvtpk(s1[2], s1[3]); pw.z = cvtpk(s1[4], s1[5]); pw.w = cvtpk(s1[6], s1[7]); }
            else { pw.x = cvtpk(s1[8], s1[9]); pw.y = cvtpk(s1[10], s1[11]); pw.z = cvtpk(s1[12], s1[13]); pw.w = cvtpk(s1[14], s1[15]); }
            const bf16x8 pf = __builtin_bit_cast(bf16x8, pw);
            const v2u va0 = *(const LAS v2u*)(Vb + r * ATT_VSTR + ks * 32 + hq * 8), va1 = *(const LAS v2u*)(Vb + r * ATT_VSTR + ks * 32 + 16 + hq * 8);
            const v2u vb0 = *(const LAS v2u*)(Vb + (32 + r) * ATT_VSTR + ks * 32 + hq * 8), vb1 = *(const LAS v2u*)(Vb + (32 + r) * ATT_VSTR + ks * 32 + 16 + hq * 8);
            const v4u vwa = {va0.x, va0.y, va1.x, va1.y}, vwb = {vb0.x, vb0.y, vb1.x, vb1.y};
            o0 = MFMA32(__builtin_bit_cast(bf16x8, vwa), pf, o0); o1 = MFMA32(__builtin_bit_cast(bf16x8, vwb), pf, o1);
        }
        if (j + 1 < ntiles) {
            LAS unsigned char* Nb = lds + (buf ^ 1) * ATT_STAGE;
            *(LAS v4u*)(Nb + sk) = rk; if (tid < 256) *(LAS v4u*)(Nb + sr) = rr;
            *(LAS v2u*)(Nb + sv) = (v2u){rv.x, rv.y}; *(LAS v2u*)(Nb + sv + 8) = (v2u){rv.z, rv.w};
        }
        __syncthreads();
    }
    l += __shfl_xor(l, 32);
    const float inv = rcp_(l);
#pragma unroll
    for (int mt = 0; mt < 2; ++mt)
#pragma unroll
        for (int g = 0; g < 4; ++g) {
            const int dv0 = 32 * mt + 8 * g + 4 * hq;
            const v2u gm = *(const v2u*)(G1 + (size_t)n * G1W + C_GM + h * 64 + dv0);
            const float x0 = (mt ? o1[4 * g + 0] : o0[4 * g + 0]) * inv, x1 = (mt ? o1[4 * g + 1] : o0[4 * g + 1]) * inv, x2 = (mt ? o1[4 * g + 2] : o0[4 * g + 2]) * inv, x3 = (mt ? o1[4 * g + 3] : o0[4 * g + 3]) * inv;
            v2u ov; ov.x = cvtpk(x0 * siluf_(bflo(gm.x)), x1 * siluf_(bfhi(gm.x))); ov.y = cvtpk(x2 * siluf_(bflo(gm.y)), x3 * siluf_(bfhi(gm.y)));
            *(v2u*)(Q + (size_t)n * 768 + h * 96 + dv0) = ov;
        }
}

constexpr int A2_QSTR = 528, A2_KVSTR = 272, A2_KVOFF = 64 * A2_QSTR;
__device__ __forceinline__ void a2_unit(ArgsP a, LAS unsigned char* lds, int layer, int unit) {
    const int tid = tid_(), lane = tid & 63, wave = tid >> 6, tn = lane & 15, g = lane >> 4;
    constexpr int NU_TOK = T / 64;
    const bool is_tok = unit < NU_TOK;
    const bf16* G2 = (const bf16*)(a->ws + WS_G2);
    bf16* Q = (bf16*)(a->ws + WS_Q); bf16* KN = (bf16*)(a->ws + WS_KN); bf16* KR = (bf16*)(a->ws + WS_KR); bf16* VT = (bf16*)(a->ws + WS_VT);
    const bf16* WUQ = (const bf16*)(a->ws + WS_WUQ) + (size_t)layer * 768 * 256;
    const bf16* WUKV = (const bf16*)(a->ws + WS_WUKV) + (size_t)layer * 1024 * 128;
    const float* ROPE1 = (const float*)(a->ws + WS_ROPE);
    __syncthreads();
    v2u cq8[8], kv8[8]; unsigned kr8[8];
    if (is_tok) {
#pragma unroll
        for (int rr = 0; rr < 8; ++rr) { const size_t n_ = (size_t)(unit * 64 + wave * 8 + rr);
            cq8[rr] = *(const v2u*)(G2 + n_ * G2W + lane * 4); kv8[rr] = *(const v2u*)(G2 + n_ * G2W + 256 + (lane & 31) * 4); kr8[rr] = G2[n_ * G2W + 384 + (lane & 31)]; }
    }
#pragma unroll
    for (int rr = 0; rr < 8; ++rr) {
        const int r = wave * 8 + rr;
        if (is_tok) {
            const int n = unit * 64 + r; const Tok tk = tok_of(n);
            const v2u cqv = cq8[rr];
            const float c0 = bflo(cqv.x), c1 = bfhi(cqv.x), c2 = bflo(cqv.y), c3 = bfhi(cqv.y);
            const float rq = rsqrt_(wave_sum(c0 * c0 + c1 * c1 + c2 * c2 + c3 * c3) * (1.f / 256.f) + 1e-6f);
            const f32x4 qn = *(const f32x4*)(a->in[I_QNORM] + layer * 256 + lane * 4);
            *(LAS v2u*)(lds + r * A2_QSTR + lane * 8) = (v2u){cvtpk(c0 * rq * qn.x, c1 * rq * qn.y), cvtpk(c2 * rq * qn.z, c3 * rq * qn.w)};
            float k0 = 0.f, k1 = 0.f, k2 = 0.f, k3 = 0.f;
            if (lane < 32) { const v2u kv = kv8[rr]; k0 = bflo(kv.x); k1 = bfhi(kv.x); k2 = bflo(kv.y); k3 = bfhi(kv.y); }
            const float rk = rsqrt_(wave_sum(k0 * k0 + k1 * k1 + k2 * k2 + k3 * k3) * (1.f / 128.f) + 1e-6f);
            if (lane < 32) {
                const f32x4 kn = *(const f32x4*)(a->in[I_KVNORM] + layer * 128 + lane * 4);
                f32x4 o; o.x = k0 * rk * kn.x; o.y = k1 * rk * kn.y; o.z = k2 * rk * kn.z; o.w = k3 * rk * kn.w;
                if (!tk.lat) *(f32x4*)(a->out + O_CKV + ((size_t)(tk.b * 2 + layer) * 256 + tk.t) * 128 + lane * 4) = o;
                *(LAS v2u*)(lds + A2_KVOFF + r * A2_KVSTR + lane * 8) = (v2u){cvtpk(o.x, o.y), cvtpk(o.z, o.w)};
            }
            float krv = (lane < 32) ? bf2f(kr8[rr]) : 0.f;
            const float other = __shfl_xor(krv, 1);
            if (lane < 32) {
                if (!tk.lat) a->out[O_KR + ((size_t)(tk.b * 2 + layer) * 256 + tk.t) * 32 + lane] = krv;
                else { const float c = ROPE1[((size_t)tk.t * 16 + (lane >> 1)) * 2], s = ROPE1[((size_t)tk.t * 16 + (lane >> 1)) * 2 + 1]; krv = (lane & 1) ? (other * s + krv * c) : (krv * c - other * s); }
                KR[(size_t)tk.kidx * 32 + lane] = (bf16)f2bf(krv);
            }
        } else {
            const int cr = (unit - NU_TOK) * 64 + r, b = cr >> 8, j = cr & 255;
            const size_t src = ((size_t)(b * 2 + layer) * 256 + j);
            if (lane < 32) { const f32x4 v = *(const f32x4*)(a->in[I_CCKV] + src * 128 + lane * 4);
                *(LAS v2u*)(lds + A2_KVOFF + r * A2_KVSTR + lane * 8) = (v2u){cvtpk(v.x, v.y), cvtpk(v.z, v.w)};
                KR[(size_t)(T_CTX + b * LK_LAT + j) * 32 + lane] = (bf16)f2bf(a->in[I_CKR][src * 32 + lane]); }
        }
    }
    __syncthreads();
    constexpr int A2_STG = 52224, A2_SQSTR = 784, A2_SKSTR = 1040, A2_SVSTR = 144;
    const int n0 = is_tok ? unit * 64 : 0;
    if (is_tok) {
      const float* ROPE = (const float*)(a->ws + WS_ROPE);
      for (int qh = 0; qh < 2; ++qh) {
        f32x4 acc[3][4];
#pragma unroll
        for (int f = 0; f < 3; ++f)
#pragma unroll
            for (int t = 0; t < 4; ++t) acc[f][t] = (f32x4){0.f, 0.f, 0.f, 0.f};
        bf16x8 afq[3][8];
        const bf16* wq = WUQ + (size_t)((qh * 24 + wave * 3) * 16 + tn) * 256 + g * 8;
#pragma unroll
        for (int f = 0; f < 3; ++f)
#pragma unroll
            for (int ks = 0; ks < 8; ++ks) afq[f][ks] = *(const bf16x8*)(wq + f * 16 * 256 + ks * 32);
#pragma unroll
        for (int ks = 0; ks < 8; ++ks) {
            bf16x8 bfr[4];
#pragma unroll
            for (int t = 0; t < 4; ++t) bfr[t] = *(const LAS bf16x8*)(lds + (t * 16 + tn) * A2_QSTR + ks * 64 + g * 16);
#pragma unroll
            for (int f = 0; f < 3; ++f)
#pragma unroll
                for (int t = 0; t < 4; ++t) acc[f][t] = MFMA16(afq[f][ks], bfr[t], acc[f][t]);
        }
#pragma unroll
        for (int f = 0; f < 3; ++f) { const int fl = (wave * 3 + f) * 16 + 4 * g, f0 = qh * 384 + fl, d = f0 % 96;
#pragma unroll
            for (int t = 0; t < 4; ++t) { const int r = t * 16 + tn, n = n0 + r;
                float v0 = acc[f][t][0], v1 = acc[f][t][1], v2 = acc[f][t][2], v3 = acc[f][t][3];
                if (n >= T_CTX && d >= 64) { const int tt = (n - T_CTX) & 2047; const f32x4 cs = *(const f32x4*)(ROPE + ((size_t)tt * 16 + ((d - 64) >> 1)) * 2);
                    const float y0 = v0 * cs.x - v1 * cs.y, y1 = v0 * cs.y + v1 * cs.x, y2 = v2 * cs.z - v3 * cs.w, y3 = v2 * cs.w + v3 * cs.z; v0 = y0; v1 = y1; v2 = y2; v3 = y3; }
                *(LAS v2u*)(lds + A2_STG + r * A2_SQSTR + fl * 2) = (v2u){cvtpk(v0, v1), cvtpk(v2, v3)}; } }
        __syncthreads();
#pragma unroll
        for (int i = 0; i < 6; ++i) { const int c = tid + 512 * i, row = c / 48, c16 = c % 48;
            *(v4u*)(Q + (size_t)(n0 + row) * 768 + qh * 384 + c16 * 8) = *(const LAS v4u*)(lds + A2_STG + row * A2_SQSTR + c16 * 16); }
        __syncthreads();
      }
    }
    int kidx0, latu, bu, kpos0;
    if (is_tok) { const Tok tk = tok_of(n0); kidx0 = tk.kidx; latu = tk.lat; bu = tk.b; kpos0 = tk.lat ? PAST + tk.t : tk.t; }
    else { const int cr = (unit - NU_TOK) * 64; bu = cr >> 8; kpos0 = cr & 255; latu = 1; kidx0 = T_CTX + bu * LK_LAT + kpos0; }
    for (int half = 0; half < 2; ++half) {
        f32x4 acc[4][4];
#pragma unroll
        for (int f = 0; f < 4; ++f)
#pragma unroll
            for (int t = 0; t < 4; ++t) acc[f][t] = (f32x4){0.f, 0.f, 0.f, 0.f};
        bf16x8 afk[4][4];
        const bf16* wk = WUKV + (size_t)(wave * 128 + half * 64 + tn) * 128 + g * 8;
#pragma unroll
        for (int f = 0; f < 4; ++f)
#pragma unroll
            for (int ks = 0; ks < 4; ++ks) afk[f][ks] = *(const bf16x8*)(wk + f * 16 * 128 + ks * 32);
#pragma unroll
        for (int ks = 0; ks < 4; ++ks) {
            bf16x8 bfr[4];
#pragma unroll
            for (int t = 0; t < 4; ++t) bfr[t] = *(const LAS bf16x8*)(lds + A2_KVOFF + (t * 16 + tn) * A2_KVSTR + ks * 64 + g * 16);
#pragma unroll
            for (int f = 0; f < 4; ++f)
#pragma unroll
                for (int t = 0; t < 4; ++t) acc[f][t] = MFMA16(afk[f][ks], bfr[t], acc[f][t]);
        }
#pragma unroll
        for (int f = 0; f < 4; ++f) { const int x = wave * 64 + f * 16 + 4 * g;
#pragma unroll
            for (int t = 0; t < 4; ++t) { const int r = t * 16 + tn;
                if (half == 0) *(LAS v2u*)(lds + A2_STG + r * A2_SKSTR + x * 2) = (v2u){cvtpk(acc[f][t][0], acc[f][t][1]), cvtpk(acc[f][t][2], acc[f][t][3])};
                else { const unsigned p01 = cvtpk(acc[f][t][0], acc[f][t][1]), p23 = cvtpk(acc[f][t][2], acc[f][t][3]);
                    *(LAS bf16*)(lds + A2_STG + (x + 0) * A2_SVSTR + r * 2) = (bf16)(p01 & 0xffffu); *(LAS bf16*)(lds + A2_STG + (x + 1) * A2_SVSTR + r * 2) = (bf16)(p01 >> 16);
                    *(LAS bf16*)(lds + A2_STG + (x + 2) * A2_SVSTR + r * 2) = (bf16)(p23 & 0xffffu); *(LAS bf16*)(lds + A2_STG + (x + 3) * A2_SVSTR + r * 2) = (bf16)(p23 >> 16); } } }
        __syncthreads();
        if (half == 0) {
#pragma unroll
            for (int i = 0; i < 8; ++i) { const int c = tid + 512 * i, row = c >> 6, c16 = c & 63;
                *(v4u*)(KN + (size_t)(kidx0 + row) * 512 + c16 * 8) = *(const LAS v4u*)(lds + A2_STG + row * A2_SKSTR + c16 * 16); }
        } else {
            const int Lk = latu ? LK_LAT : 256;
#pragma unroll
            for (int i = 0; i < 8; ++i) { const int c = tid + 512 * i, row = c >> 3, part = c & 7, h = row >> 6, dv = row & 63;
                const size_t base = latu ? (size_t)VT_LAT + ((size_t)(bu * 8 + h) * 64 + dv) * LK_LAT : ((size_t)(bu * 8 + h) * 64 + dv) * 256;
                *(v4u*)(VT + base + kpos0 + part * 8) = *(const LAS v4u*)(lds + A2_STG + row * A2_SVSTR + part * 16); }
            (void)Lk;
        }
        __syncthreads();
    }
}

constexpr int RW_W2T = 0, RW_A2T = 9216, RW_TH = 18432, RW_HA = 27648, RW_CH0 = 36864, RW_CHB = 20992, RW_YB = 120832;
constexpr int RC_KP = 0, RC_RP = 2304, RC_BP = 4608, RC_KT = 6912, RC_KTT = 9216, RC_NBPT = 11776, RC_VTT = 14336, RC_LK = 16896, RC_TM = 17536, RC_ARK = 18176, RC_NARB = 18816, RC_G15 = 19456, RC_LBF = 19712, RC_SSQ = 20736;
__device__ __forceinline__ void rwkv_unit_mfma(ArgsP a, LAS unsigned char* lds, int layer, int u) {
    const int tid = tid_(), lane = tid & 63, wave = tid >> 6, i16 = lane & 15, g = lane >> 4;
    const int lat = u < 64, uu = lat ? u : u - 64, b = uu >> 3, e = (uu >> 2) & 1, hh = uu & 3;
    const int L = lat ? L_LAT : L_CTX, tok0 = lat ? T_CTX + b * L_LAT : b * L_CTX;
    const bf16* G1 = (const bf16*)(a->ws + WS_G1);
    bf16* YS = (bf16*)(a->ws + WS_G2);
    __syncthreads();
    for (int i = tid; i < 4096; i += NTHREADS) { const int j = i >> 6, c = i & 63;
        *(LAS bf16*)(lds + RW_W2T + (c * 72 + j) * 2) = (bf16)f2bf(a->in[I_W2][((size_t)(layer * 2 + e) * 64 + j) * 256 + hh * 64 + c]);
        *(LAS bf16*)(lds + RW_A2T + (c * 72 + j) * 2) = (bf16)f2bf(a->in[I_A2][((size_t)(layer * 2 + e) * 64 + j) * 256 + hh * 64 + c]); }
    const int st_tok = tid >> 3, st_c8 = (tid & 7) * 8;
#define RW_STAGE(sc) do { const int step_ = (sc) * 64 + st_tok, t_ = e ? L - 1 - step_ : step_; const bf16* gp_ = G1 + (size_t)(tok0 + t_) * G1W + C_LORA + e * 64 + st_c8; \
        const v4u hw_ = *(const v4u*)gp_, ha_ = *(const v4u*)(gp_ + 128); v4u th_; \
        th_.x = cvtpk(tanh_fast(bflo(hw_.x)), tanh_fast(bfhi(hw_.x))); th_.y = cvtpk(tanh_fast(bflo(hw_.y)), tanh_fast(bfhi(hw_.y))); th_.z = cvtpk(tanh_fast(bflo(hw_.z)), tanh_fast(bfhi(hw_.z))); th_.w = cvtpk(tanh_fast(bflo(hw_.w)), tanh_fast(bfhi(hw_.w))); \
        *(LAS v4u*)(lds + RW_TH + st_tok * 144 + st_c8 * 2) = th_; *(LAS v4u*)(lds + RW_HA + st_tok * 144 + st_c8 * 2) = ha_; } while (0)
    RW_STAGE(0);
    f32x4 ST[4];
    {
        const int v = 16 * (wave & 3) + i16;
#pragma unroll
        for (int kt = 0; kt < 4; ++kt) ST[kt] = lat ? *(const f32x4*)(a->in[I_SRW] + (((size_t)((b * 2 + layer) * 2 + e) * 4 + hh) * 64 + v) * 64 + 16 * kt + 4 * g) : (f32x4){0.f, 0.f, 0.f, 0.f};
    }
    const int pc = wave & 3, ph = wave >> 2;
    LAS unsigned char* CH = lds + RW_CH0 + pc * RW_CHB;
    __syncthreads();
    const int nsc = L >> 6;
    v2u pk[2], pr[2], pv[2];
#define RW_PREFETCH(sc) do { const int ps_ = (sc) * 64 + pc * 16 + i16, pt_ = e ? L - 1 - ps_ : ps_; const bf16* gq_ = G1 + (size_t)(tok0 + pt_) * G1W + hh * 64 + (2 * ph) * 16 + 4 * g; \
        pk[0] = *(const v2u*)(gq_ + C_K); pk[1] = *(const v2u*)(gq_ + C_K + 16); pr[0] = *(const v2u*)(gq_ + C_R); pr[1] = *(const v2u*)(gq_ + C_R + 16); pv[0] = *(const v2u*)(gq_ + C_V); pv[1] = *(const v2u*)(gq_ + C_V + 16); } while (0)
    RW_PREFETCH(0);
    for (int sc = 0; sc < nsc; ++sc) {
        const v2u ck[2] = {pk[0], pk[1]}, cr[2] = {pr[0], pr[1]}, cv[2] = {pv[0], pv[1]};
        if (sc + 1 < nsc) RW_PREFETCH(sc + 1);
        float dec[8], av[8], kx[8], rx[8], kk[8];
        {
            f32x4 aw[2], aa[2];
#pragma unroll
            for (int c2 = 0; c2 < 2; ++c2) { aw[c2] = (f32x4){0.f, 0.f, 0.f, 0.f}; aa[c2] = (f32x4){0.f, 0.f, 0.f, 0.f}; }
#pragma unroll
            for (int ks = 0; ks < 2; ++ks) {
                const bf16x8 bth = *(const LAS bf16x8*)(lds + RW_TH + (pc * 16 + i16) * 144 + ks * 64 + g * 16), bha = *(const LAS bf16x8*)(lds + RW_HA + (pc * 16 + i16) * 144 + ks * 64 + g * 16);
#pragma unroll
                for (int c2 = 0; c2 < 2; ++c2) { const int row = (2 * ph + c2) * 16 + i16;
                    const bf16x8 w2f = *(const LAS bf16x8*)(lds + RW_W2T + row * 144 + ks * 64 + g * 16), a2f = *(const LAS bf16x8*)(lds + RW_A2T + row * 144 + ks * 64 + g * 16);
                    aw[c2] = MFMA16(w2f, bth, aw[c2]); aa[c2] = MFMA16(a2f, bha, aa[c2]); }
            }
            float ss = 0.f;
#pragma unroll
            for (int c2 = 0; c2 < 2; ++c2) { const int ch = (2 * ph + c2) * 16 + 4 * g, gch = hh * 64 + ch;
                const f32x4 w0 = *(const f32x4*)(a->in[I_W0] + (layer * 2 + e) * 256 + gch), a0 = *(const f32x4*)(a->in[I_A0] + (layer * 2 + e) * 256 + gch), kw = *(const f32x4*)(a->in[I_KK] + layer * 256 + gch);
                const v2u kv = ck[c2], rv = cr[c2];
                const float kq[4] = {bflo(kv.x), bfhi(kv.x), bflo(kv.y), bfhi(kv.y)}, rq[4] = {bflo(rv.x), bfhi(rv.x), bflo(rv.y), bfhi(rv.y)};
#pragma unroll
                for (int q = 0; q < 4; ++q) { const int o = c2 * 4 + q;
                    dec[o] = exp_(-0.6065306597126334f * sigmoidf_(aw[c2][q] + w0[q])); av[o] = sigmoidf_(aa[c2][q] + a0[q]);
                    kx[o] = kq[q]; rx[o] = rq[q]; kk[o] = kq[q] * kw[q]; ss += kk[o] * kk[o]; }
            }
            ss += __shfl_xor(ss, 16); ss += __shfl_xor(ss, 32);
            if (g == 0) *(LAS float*)(CH + RC_SSQ + (i16 * 2 + ph) * 4) = ss;
        }
        __syncthreads();
        {
            const float tot = *(const LAS float*)(CH + RC_SSQ + (i16 * 2) * 4) + *(const LAS float*)(CH + RC_SSQ + (i16 * 2 + 1) * 4);
            const float inrm = rcp_(fmaxf(sqrt_(tot), 1e-12f));
#pragma unroll
            for (int c2 = 0; c2 < 2; ++c2) { const int ch = (2 * ph + c2) * 16 + 4 * g, gch = hh * 64 + ch;
                const f32x4 ka = *(const f32x4*)(a->in[I_KA] + layer * 256 + gch);
                float kp[4], bp[4], kt[4], rp[4];
#pragma unroll
                for (int q = 0; q < 4; ++q) { const int o = c2 * 4 + q;
                    const float G = row16_prefix_prod(dec[o]);
                    const float Gex = dpp_f<0x111>(1.f, G);
                    const float kkn = kk[o] * inrm, iG = rcp_(G);
                    kp[q] = Gex * kkn; bp[q] = kkn * av[o] * iG; kt[q] = kx[o] * (1.f + (av[o] - 1.f) * ka[q]) * iG; rp[q] = G * rx[o];
                    if (i16 == 15) *(LAS float*)(CH + RC_G15 + (ch + q) * 4) = G;
                    *(LAS bf16*)(CH + RC_KTT + (ch + q) * 40 + i16 * 2) = (bf16)f2bf(kt[q]); *(LAS bf16*)(CH + RC_NBPT + (ch + q) * 40 + i16 * 2) = (bf16)f2bf(-bp[q]); }
                *(LAS v2u*)(CH + RC_KP + i16 * 144 + ch * 2) = (v2u){cvtpk(kp[0], kp[1]), cvtpk(kp[2], kp[3])};
                *(LAS v2u*)(CH + RC_BP + i16 * 144 + ch * 2) = (v2u){cvtpk(bp[0], bp[1]), cvtpk(bp[2], bp[3])};
                *(LAS v2u*)(CH + RC_KT + i16 * 144 + ch * 2) = (v2u){cvtpk(kt[0], kt[1]), cvtpk(kt[2], kt[3])};
                *(LAS v2u*)(CH + RC_RP + i16 * 144 + ch * 2) = (v2u){cvtpk(rp[0], rp[1]), cvtpk(rp[2], rp[3])};
                const v2u vv = cv[c2];
                *(LAS bf16*)(CH + RC_VTT + (ch + 0) * 40 + i16 * 2) = (bf16)(vv.x & 0xffffu); *(LAS bf16*)(CH + RC_VTT + (ch + 1) * 40 + i16 * 2) = (bf16)(vv.x >> 16);
                *(LAS bf16*)(CH + RC_VTT + (ch + 2) * 40 + i16 * 2) = (bf16)(vv.y & 0xffffu); *(LAS bf16*)(CH + RC_VTT + (ch + 3) * 40 + i16 * 2) = (bf16)(vv.y >> 16);
            }
        }
        __syncthreads();
        {
            f32x4 d0 = (f32x4){0.f, 0.f, 0.f, 0.f}, d1 = (f32x4){0.f, 0.f, 0.f, 0.f};
            const int xoff = ph ? RC_RP : RC_KP, y0off = ph ? RC_KT : RC_BP, y1off = ph ? RC_BP : RC_KT;
#pragma unroll
            for (int ks = 0; ks < 2; ++ks) {
                const bf16x8 xf = *(const LAS bf16x8*)(CH + xoff + i16 * 144 + ks * 64 + g * 16);
                const bf16x8 y0 = *(const LAS bf16x8*)(CH + y0off + i16 * 144 + ks * 64 + g * 16), y1 = *(const LAS bf16x8*)(CH + y1off + i16 * 144 + ks * 64 + g * 16);
                d0 = MFMA16(xf, y0, d0); d1 = MFMA16(xf, y1, d1);
            }
#pragma unroll
            for (int q = 0; q < 4; ++q) { const int i = 4 * g + q, j = i16;
                if (ph == 0) { *(LAS float*)(CH + RC_LBF + (i * 16 + j) * 4) = (j < i) ? d0[q] : 0.f; *(LAS bf16*)(CH + RC_LK + i * 40 + j * 2) = (bf16)f2bf((j < i) ? d1[q] : 0.f); }
                else { *(LAS bf16*)(CH + RC_ARK + i * 40 + j * 2) = (bf16)f2bf((j <= i) ? d0[q] : 0.f); *(LAS bf16*)(CH + RC_NARB + i * 40 + j * 2) = (bf16)f2bf((j <= i) ? -d1[q] : 0.f); }
            }
            if (ph == 0) {
                float x[16];
#pragma unroll
                for (int i = 0; i < 16; ++i) { float s = (i == i16) ? 1.f : 0.f;
#pragma unroll
                    for (int j4 = 0; j4 < (i + 3) / 4; ++j4) { const f32x4 lr = *(const LAS f32x4*)(CH + RC_LBF + (i * 16 + j4 * 4) * 4);
#pragma unroll
                        for (int jj = 0; jj < 4; ++jj) { const int j = j4 * 4 + jj; if (j < i) s -= lr[jj] * x[j]; } }
                    x[i] = s; }
                if (g == 0) {
#pragma unroll
                    for (int i = 0; i < 16; ++i) *(LAS bf16*)(CH + RC_TM + i * 40 + i16 * 2) = (bf16)f2bf(x[i]); }
            }
        }
        __syncthreads();
        if (wave < 4) {
            const int vt = wave;
#pragma unroll 1
            for (int c = 0; c < 4; ++c) {
                const LAS unsigned char* C = lds + RW_CH0 + c * RW_CHB;
                v4u sb01, sb23;
                sb01.x = cvtpk(ST[0][0], ST[0][1]); sb01.y = cvtpk(ST[0][2], ST[0][3]); sb01.z = cvtpk(ST[1][0], ST[1][1]); sb01.w = cvtpk(ST[1][2], ST[1][3]);
                sb23.x = cvtpk(ST[2][0], ST[2][1]); sb23.y = cvtpk(ST[2][2], ST[2][3]); sb23.z = cvtpk(ST[3][0], ST[3][1]); sb23.w = cvtpk(ST[3][2], ST[3][3]);
                const bf16x8 s01 = __builtin_bit_cast(bf16x8, sb01), s23 = __builtin_bit_cast(bf16x8, sb23);
                const v2u kp0a = *(const LAS v2u*)(C + RC_KP + i16 * 144 + (4 * g) * 2), kp0b = *(const LAS v2u*)(C + RC_KP + i16 * 144 + (16 + 4 * g) * 2);
                const v2u kp1a = *(const LAS v2u*)(C + RC_KP + i16 * 144 + (32 + 4 * g) * 2), kp1b = *(const LAS v2u*)(C + RC_KP + i16 * 144 + (48 + 4 * g) * 2);
                const v2u rp0a = *(const LAS v2u*)(C + RC_RP + i16 * 144 + (4 * g) * 2), rp0b = *(const LAS v2u*)(C + RC_RP + i16 * 144 + (16 + 4 * g) * 2);
                const v2u rp1a = *(const LAS v2u*)(C + RC_RP + i16 * 144 + (32 + 4 * g) * 2), rp1b = *(const LAS v2u*)(C + RC_RP + i16 * 144 + (48 + 4 * g) * 2);
                const v2u lk = *(const LAS v2u*)(C + RC_LK + i16 * 40 + g * 8), tm = *(const LAS v2u*)(C + RC_TM + i16 * 40 + g * 8);
                const v2u ark = *(const LAS v2u*)(C + RC_ARK + i16 * 40 + g * 8), narb = *(const LAS v2u*)(C + RC_NARB + i16 * 40 + g * 8);
                const v2u vf = *(const LAS v2u*)(C + RC_VTT + (16 * vt + i16) * 40 + g * 8);
                const v4u z4 = {0u, 0u, 0u, 0u};
                f32x4 rhs = (f32x4){0.f, 0.f, 0.f, 0.f};
                rhs = MFMA16(__builtin_bit_cast(bf16x8, ((v4u){kp0a.x, kp0a.y, kp0b.x, kp0b.y})), s01, rhs);
                rhs = MFMA16(__builtin_bit_cast(bf16x8, ((v4u){kp1a.x, kp1a.y, kp1b.x, kp1b.y})), s23, rhs);
                rhs = MFMA16(__builtin_bit_cast(bf16x8, ((v4u){lk.x, lk.y, 0u, 0u})), __builtin_bit_cast(bf16x8, ((v4u){vf.x, vf.y, 0u, 0u})), rhs);
                f32x4 z = MFMA16(__builtin_bit_cast(bf16x8, ((v4u){tm.x, tm.y, 0u, 0u})), __builtin_bit_cast(bf16x8, ((v4u){cvtpk(rhs[0], rhs[1]), cvtpk(rhs[2], rhs[3]), 0u, 0u})), ((f32x4){0.f, 0.f, 0.f, 0.f}));
                const bf16x8 vz = __builtin_bit_cast(bf16x8, ((v4u){vf.x, vf.y, cvtpk(z[0], z[1]), cvtpk(z[2], z[3])}));
                f32x4 y = (f32x4){0.f, 0.f, 0.f, 0.f};
                y = MFMA16(__builtin_bit_cast(bf16x8, ((v4u){rp0a.x, rp0a.y, rp0b.x, rp0b.y})), s01, y);
                y = MFMA16(__builtin_bit_cast(bf16x8, ((v4u){rp1a.x, rp1a.y, rp1b.x, rp1b.y})), s23, y);
                y = MFMA16(__builtin_bit_cast(bf16x8, ((v4u){ark.x, ark.y, narb.x, narb.y})), vz, y);
#pragma unroll
                for (int kt = 0; kt < 4; ++kt) {
                    const v2u ktf = *(const LAS v2u*)(C + RC_KTT + (16 * kt + i16) * 40 + g * 8), nbf = *(const LAS v2u*)(C + RC_NBPT + (16 * kt + i16) * 40 + g * 8);
                    const f32x4 g15 = *(const LAS f32x4*)(C + RC_G15 + (16 * kt + 4 * g) * 4);
                    ST[kt] = MFMA16(__builtin_bit_cast(bf16x8, ((v4u){ktf.x, ktf.y, nbf.x, nbf.y})), vz, ST[kt]);
                    ST[kt] = ST[kt] * g15;
                }
                { const unsigned y01 = cvtpk(y[0], y[1]), y23 = cvtpk(y[2], y[3]); LAS unsigned char* yb = lds + RW_YB + (c * 16 + 4 * g) * 144 + (16 * vt + i16) * 2;
                  *(LAS bf16*)(yb) = (bf16)(y01 & 0xffffu); *(LAS bf16*)(yb + 144) = (bf16)(y01 >> 16); *(LAS bf16*)(yb + 288) = (bf16)(y23 & 0xffffu); *(LAS bf16*)(yb + 432) = (bf16)(y23 >> 16); }
                (void)z4;
            }
        } else if (sc + 1 < nsc) {
            const int r0 = (tid - 256) >> 3;
#pragma unroll
            for (int hrow = 0; hrow < 2; ++hrow) { const int tokr = r0 + 32 * hrow, step_ = (sc + 1) * 64 + tokr, t_ = e ? L - 1 - step_ : step_;
                const bf16* gp_ = G1 + (size_t)(tok0 + t_) * G1W + C_LORA + e * 64 + st_c8;
                const v4u hw_ = *(const v4u*)gp_, ha_ = *(const v4u*)(gp_ + 128); v4u th_;
                th_.x = cvtpk(tanh_fast(bflo(hw_.x)), tanh_fast(bfhi(hw_.x))); th_.y = cvtpk(tanh_fast(bflo(hw_.y)), tanh_fast(bfhi(hw_.y))); th_.z = cvtpk(tanh_fast(bflo(hw_.z)), tanh_fast(bfhi(hw_.z))); th_.w = cvtpk(tanh_fast(bflo(hw_.w)), tanh_fast(bfhi(hw_.w)));
                *(LAS v4u*)(lds + RW_TH + tokr * 144 + st_c8 * 2) = th_; *(LAS v4u*)(lds + RW_HA + tokr * 144 + st_c8 * 2) = ha_; }
        }
        __syncthreads();
        {
            const int row = tid >> 3, part = tid & 7, step = sc * 64 + row, t = e ? L - 1 - step : step;
            *(v4u*)(YS + ((size_t)e * T + tok0 + t) * 256 + hh * 64 + part * 8) = *(const LAS v4u*)(lds + RW_YB + row * 144 + part * 16);
        }
    }
#undef RW_STAGE
#undef RW_PREFETCH
    if (!lat && wave < 4) {
        const int v = 16 * wave + i16;
#pragma unroll
        for (int kt = 0; kt < 4; ++kt) *(f32x4*)(a->out + O_RW + (((size_t)((b * 2 + layer) * 2 + e) * 4 + hh) * 64 + v) * 64 + 16 * kt + 4 * g) = ST[kt];
    }
}

constexpr int LR_WAT = 0, LR_XCB = 18432, LR_XCF = 27648, LR_AA = 44032, LR_BV = 60416, LR_HH = 76800, LR_SP = 93184, LR_SH = 95232, LR_HC = 97280;
__device__ __forceinline__ void lru_unit_mfma(ArgsP a, LAS unsigned char* lds, int layer, int u) {
    const int tid = tid_(), lane = tid & 63, wave = tid >> 6, i16 = lane & 15, g4 = lane >> 4;
    const int lat = u < 32, uu = lat ? u : u - 32, b = uu >> 2, g = uu & 3;
    const int L = lat ? L_LAT : L_CTX, tok0 = lat ? T_CTX + b * L_LAT : b * L_CTX;
    const bf16* G1 = (const bf16*)(a->ws + WS_G1);
    bf16* HF = (bf16*)(a->ws + WS_HF);
    LAS float* XCF = (LAS float*)(lds + LR_XCF); LAS float* AA = (LAS float*)(lds + LR_AA); LAS float* BV = (LAS float*)(lds + LR_BV); LAS float* HH = (LAS float*)(lds + LR_HH);
    LAS float* SP = (LAS float*)(lds + LR_SP); LAS float* SH = (LAS float*)(lds + LR_SH); LAS float* HC = (LAS float*)(lds + LR_HC);
    const int tt = tid >> 3, q8 = (tid & 7) * 8;
    float cw[4][8], cb[8];
#pragma unroll
    for (int i = 0; i < 8; ++i) { const int ch = g * 64 + q8 + i; cb[i] = a->in[I_CONVB][layer * 256 + ch];
#pragma unroll
        for (int j = 0; j < 4; ++j) cw[j][i] = a->in[I_CONVW][(layer * 4 + j) * 256 + ch]; }
    const int ot = wave & 3, tp = wave >> 2;
    const int sch = tid & 63, seg = tid >> 6;
    for (int e = 0; e < 2; ++e) {
        __syncthreads();
        for (int i = tid; i < 4096; i += NTHREADS) { const size_t src = ((size_t)((layer * 2 + e) * 4 + g)) * 4096 + i; const int ii = i >> 6, oo = i & 63;
            *(LAS bf16*)(lds + LR_WAT + (oo * 72 + ii) * 2) = (bf16)f2bf(a->in[I_WA][src]); *(LAS bf16*)(lds + LR_WAT + 9216 + (oo * 72 + ii) * 2) = (bf16)f2bf(a->in[I_WX][src]); }
        if (tid < 64) HC[tid] = lat ? a->in[I_SLRU][((size_t)(b * 2 + layer) * 2 + e) * 256 + g * 64 + tid] : 0.f;
        f32x4 bav, bxv, spl;
        { const int chb = (layer * 2 + e) * 256 + g * 64 + 16 * ot + 4 * g4;
          bav = *(const f32x4*)(a->in[I_BA] + chb); bxv = *(const f32x4*)(a->in[I_BX] + chb); const f32x4 lam = *(const f32x4*)(a->in[I_LAMBDA] + chb);
#pragma unroll
          for (int q = 0; q < 4; ++q) spl[q] = log1pf(exp_(-lam[q])); }
        __syncthreads();
        v4u xr[4], hfr, glr;
#define LR_PREFETCH(cc_) do { const int c_ = e ? L / 64 - 1 - (cc_) : (cc_), t_ = c_ * 64 + tt; \
            _Pragma("unroll") for (int j = 0; j < 4; ++j) { const int ts = t_ + j - 2; xr[j] = (ts >= 0 && ts < L) ? *(const v4u*)(G1 + (size_t)(tok0 + ts) * G1W + C_XL + g * 64 + q8) : (v4u){0u, 0u, 0u, 0u}; } \
            if (e) { hfr = *(const v4u*)(HF + (size_t)(tok0 + t_) * 256 + g * 64 + q8); glr = *(const v4u*)(G1 + (size_t)(tok0 + t_) * G1W + C_GL + g * 64 + q8); } } while (0)
        LR_PREFETCH(0);
        for (int cc = 0; cc < L / 64; ++cc) {
            const int c = e ? L / 64 - 1 - cc : cc, t = c * 64 + tt, n = tok0 + t;
            const v4u xcur[4] = {xr[0], xr[1], xr[2], xr[3]}; const v4u hfc = hfr, glc = glr;
            if (cc + 1 < L / 64) LR_PREFETCH(cc + 1);
            {
                float xc[8];
#pragma unroll
                for (int i = 0; i < 8; ++i) xc[i] = cb[i];
#pragma unroll
                for (int j = 0; j < 4; ++j) {
                    { const v4u x = xcur[j];
                        xc[0] += cw[j][0] * bflo(x.x); xc[1] += cw[j][1] * bfhi(x.x); xc[2] += cw[j][2] * bflo(x.y); xc[3] += cw[j][3] * bfhi(x.y);
                        xc[4] += cw[j][4] * bflo(x.z); xc[5] += cw[j][5] * bfhi(x.z); xc[6] += cw[j][6] * bflo(x.w); xc[7] += cw[j][7] * bfhi(x.w); } }
                *(LAS f32x4*)(XCF + tt * 64 + q8) = (f32x4){xc[0], xc[1], xc[2], xc[3]}; *(LAS f32x4*)(XCF + tt * 64 + q8 + 4) = (f32x4){xc[4], xc[5], xc[6], xc[7]};
                *(LAS v4u*)(lds + LR_XCB + tt * 144 + q8 * 2) = (v4u){cvtpk(xc[0], xc[1]), cvtpk(xc[2], xc[3]), cvtpk(xc[4], xc[5]), cvtpk(xc[6], xc[7])};
            }
            __syncthreads();
            {
#pragma unroll
                for (int t2 = 0; t2 < 2; ++t2) { const int tk = (2 * tp + t2) * 16 + i16;
                    f32x4 ga = (f32x4){0.f, 0.f, 0.f, 0.f}, gx = (f32x4){0.f, 0.f, 0.f, 0.f};
#pragma unroll
                    for (int ks = 0; ks < 2; ++ks) { const bf16x8 xf = *(const LAS bf16x8*)(lds + LR_XCB + tk * 144 + ks * 64 + g4 * 16);
                        const bf16x8 wa = *(const LAS bf16x8*)(lds + LR_WAT + (16 * ot + i16) * 144 + ks * 64 + g4 * 16), wx = *(const LAS bf16x8*)(lds + LR_WAT + 9216 + (16 * ot + i16) * 144 + ks * 64 + g4 * 16);
                        ga = MFMA16(wa, xf, ga); gx = MFMA16(wx, xf, gx); }
                    const f32x4 xcv = *(const LAS f32x4*)(XCF + tk * 64 + 16 * ot + 4 * g4);
                    f32x4 av, bv;
#pragma unroll
                    for (int q = 0; q < 4; ++q) { const float la = -8.f * sigmoidf_(ga[q] + bav[q]) * spl[q]; av[q] = exp_(la); bv[q] = sqrt_(1.f - exp_(2.f * la)) * sigmoidf_(gx[q] + bxv[q]) * xcv[q]; }
                    *(LAS f32x4*)(AA + tk * 64 + 16 * ot + 4 * g4) = av; *(LAS f32x4*)(BV + tk * 64 + 16 * ot + 4 * g4) = bv; }
            }
            __syncthreads();
            float av8[8], bv8[8];
            {
                float P = 1.f, H = 0.f;
#pragma unroll
                for (int s = 0; s < 8; ++s) { const int p = seg * 8 + s, st = e ? 63 - p : p; av8[s] = AA[st * 64 + sch]; bv8[s] = BV[st * 64 + sch]; H = fmaf(av8[s], H, bv8[s]); P *= av8[s]; }
                SP[seg * 64 + sch] = P; SH[seg * 64 + sch] = H;
            }
            __syncthreads();
            {
                float h = HC[sch];
                for (int s2 = 0; s2 < seg; ++s2) h = fmaf(SP[s2 * 64 + sch], h, SH[s2 * 64 + sch]);
#pragma unroll
                for (int s = 0; s < 8; ++s) { const int p = seg * 8 + s, st = e ? 63 - p : p; h = fmaf(av8[s], h, bv8[s]); HH[st * 64 + sch] = h; }
                __syncthreads();
                if (seg == 7) HC[sch] = h;
            }
            __syncthreads();
            {
                bf16* dst = HF + (size_t)n * 256 + g * 64 + q8;
                float o[8];
#pragma unroll
                for (int i = 0; i < 8; ++i) o[i] = HH[tt * 64 + q8 + i];
                if (e) { const v4u hf = hfc, gl = glc;
                    o[0] = (o[0] + bflo(hf.x)) * siluf_(bflo(gl.x)); o[1] = (o[1] + bfhi(hf.x)) * siluf_(bfhi(gl.x)); o[2] = (o[2] + bflo(hf.y)) * siluf_(bflo(gl.y)); o[3] = (o[3] + bfhi(hf.y)) * siluf_(bfhi(gl.y));
                    o[4] = (o[4] + bflo(hf.z)) * siluf_(bflo(gl.z)); o[5] = (o[5] + bfhi(hf.z)) * siluf_(bfhi(gl.z)); o[6] = (o[6] + bflo(hf.w)) * siluf_(bflo(gl.w)); o[7] = (o[7] + bfhi(hf.w)) * siluf_(bfhi(gl.w)); }
                *(v4u*)dst = (v4u){cvtpk(o[0], o[1]), cvtpk(o[2], o[3]), cvtpk(o[4], o[5]), cvtpk(o[6], o[7])};
            }
        }
#undef LR_PREFETCH
        __syncthreads();
        if (tid < 64 && !lat) a->out[O_LRU + ((size_t)(b * 2 + layer) * 2 + e) * 256 + g * 64 + tid] = HC[tid];
    }
}

constexpr int LQ_NQ = 32;
constexpr int LQ_WAT = 0, LQ_XCB = 2 * LQ_NQ * 144, LQ_XCQ = LQ_XCB + 9216, LQ_AA = LQ_XCQ + 64 * LQ_NQ * 4, LQ_BV = LQ_AA + 64 * LQ_NQ * 4, LQ_HH = LQ_BV + 64 * LQ_NQ * 4,
              LQ_SP = LQ_HH + 64 * LQ_NQ * 4, LQ_SH = LQ_SP + 8 * LQ_NQ * 4, LQ_HC = LQ_SH + 8 * LQ_NQ * 4;
__device__ __forceinline__ void lru_unit_q(ArgsP a, LAS unsigned char* lds, int layer, int u) {
    const int tid = tid_(), lane = tid & 63, wave = tid >> 6, i16 = lane & 15, g4 = lane >> 4;
    const int lat = u < 64, uu = lat ? u : u - 64, b = uu >> 3, g = (uu >> 1) & 3, oq = uu & 1;
    const int L = lat ? L_LAT : L_CTX, tok0 = lat ? T_CTX + b * L_LAT : b * L_CTX;
    const bf16* G1 = (const bf16*)(a->ws + WS_G1);
    bf16* HF = (bf16*)(a->ws + WS_HF);
    LAS float* XCQ = (LAS float*)(lds + LQ_XCQ);
    LAS float* AA = (LAS float*)(lds + LQ_AA); LAS float* BV = (LAS float*)(lds + LQ_BV); LAS float* HH = (LAS float*)(lds + LQ_HH);
    LAS float* SP = (LAS float*)(lds + LQ_SP); LAS float* SH = (LAS float*)(lds + LQ_SH); LAS float* HC = (LAS float*)(lds + LQ_HC);
    const int tt = tid >> 3, q8 = (tid & 7) * 8;
    float cw[4][8], cb[8];
#pragma unroll
    for (int i = 0; i < 8; ++i) { const int ch = g * 64 + q8 + i; cb[i] = a->in[I_CONVB][layer * 256 + ch];
#pragma unroll
        for (int j = 0; j < 4; ++j) cw[j][i] = a->in[I_CONVW][(layer * 4 + j) * 256 + ch]; }
    const int gt = wave & 3, got = wave >> 2;
    const int sch = tid & (LQ_NQ - 1), seg = (tid >> 5) & 7;
    const int otok = tid >> 3, oc4 = (tid & 7) * 4;
    const int chq = g * 64 + oq * LQ_NQ;
    for (int e = 0; e < 2; ++e) {
        __syncthreads();
        for (int i = tid; i < 64 * LQ_NQ; i += NTHREADS) { const int ii = i / LQ_NQ, oo = i % LQ_NQ; const size_t src = ((size_t)((layer * 2 + e) * 4 + g)) * 4096 + ii * 64 + oq * LQ_NQ + oo;
            *(LAS bf16*)(lds + LQ_WAT + (oo * 72 + ii) * 2) = (bf16)f2bf(a->in[I_WA][src]); *(LAS bf16*)(lds + LQ_WAT + LQ_NQ * 144 + (oo * 72 + ii) * 2) = (bf16)f2bf(a->in[I_WX][src]); }
        if (tid < LQ_NQ) HC[tid] = lat ? a->in[I_SLRU][((size_t)(b * 2 + layer) * 2 + e) * 256 + chq + tid] : 0.f;
        f32x4 bav, bxv, spl;
        { const int chb = (layer * 2 + e) * 256 + chq + 16 * got + 4 * g4;
          bav = *(const f32x4*)(a->in[I_BA] + chb); bxv = *(const f32x4*)(a->in[I_BX] + chb); const f32x4 lam = *(const f32x4*)(a->in[I_LAMBDA] + chb);
#pragma unroll
          for (int q = 0; q < 4; ++q) spl[q] = log1pf(exp_(-lam[q])); }
        v4u xr[4]; v2u hfr, glr;
#define LQ_PREFETCH(cc_) do { const int c_ = e ? L / 64 - 1 - (cc_) : (cc_), t_ = c_ * 64 + tt; \
            _Pragma("unroll") for (int j = 0; j < 4; ++j) { const int ts = t_ + j - 2; xr[j] = (ts >= 0 && ts < L) ? *(const v4u*)(G1 + (size_t)(tok0 + ts) * G1W + C_XL + g * 64 + q8) : (v4u){0u, 0u, 0u, 0u}; } \
            if (e) { const int to_ = c_ * 64 + otok; hfr = *(const v2u*)(HF + (size_t)(tok0 + to_) * 256 + chq + oc4); glr = *(const v2u*)(G1 + (size_t)(tok0 + to_) * G1W + C_GL + chq + oc4); } } while (0)
        LQ_PREFETCH(0);
        __syncthreads();
        for (int cc = 0; cc < L / 64; ++cc) {
            const int c = e ? L / 64 - 1 - cc : cc;
            const v4u xcur[4] = {xr[0], xr[1], xr[2], xr[3]}; const v2u hfc = hfr, glc = glr;
            if (cc + 1 < L / 64) LQ_PREFETCH(cc + 1);
            {
                float xc[8];
#pragma unroll
                for (int i = 0; i < 8; ++i) xc[i] = cb[i];
#pragma unroll
                for (int j = 0; j < 4; ++j) { const v4u x = xcur[j];
                    xc[0] += cw[j][0] * bflo(x.x); xc[1] += cw[j][1] * bfhi(x.x); xc[2] += cw[j][2] * bflo(x.y); xc[3] += cw[j][3] * bfhi(x.y);
                    xc[4] += cw[j][4] * bflo(x.z); xc[5] += cw[j][5] * bfhi(x.z); xc[6] += cw[j][6] * bflo(x.w); xc[7] += cw[j][7] * bfhi(x.w); }
                *(LAS v4u*)(lds + LQ_XCB + tt * 144 + q8 * 2) = (v4u){cvtpk(xc[0], xc[1]), cvtpk(xc[2], xc[3]), cvtpk(xc[4], xc[5]), cvtpk(xc[6], xc[7])};
                if ((q8 / LQ_NQ) == oq) { *(LAS f32x4*)(XCQ + tt * LQ_NQ + (q8 % LQ_NQ)) = (f32x4){xc[0], xc[1], xc[2], xc[3]}; *(LAS f32x4*)(XCQ + tt * LQ_NQ + (q8 % LQ_NQ) + 4) = (f32x4){xc[4], xc[5], xc[6], xc[7]}; }
            }
            __syncthreads();
            {
                const int tk = gt * 16 + i16;
                f32x4 ga = (f32x4){0.f, 0.f, 0.f, 0.f}, gx = (f32x4){0.f, 0.f, 0.f, 0.f};
#pragma unroll
                for (int ks = 0; ks < 2; ++ks) { const bf16x8 xf = *(const LAS bf16x8*)(lds + LQ_XCB + tk * 144 + ks * 64 + g4 * 16);
                    const bf16x8 wa = *(const LAS bf16x8*)(lds + LQ_WAT + (16 * got + i16) * 144 + ks * 64 + g4 * 16), wx = *(const LAS bf16x8*)(lds + LQ_WAT + LQ_NQ * 144 + (16 * got + i16) * 144 + ks * 64 + g4 * 16);
                    ga = MFMA16(wa, xf, ga); gx = MFMA16(wx, xf, gx); }
                const f32x4 xcv = *(const LAS f32x4*)(XCQ + tk * LQ_NQ + 16 * got + 4 * g4);
                f32x4 av, bv;
#pragma unroll
                for (int q = 0; q < 4; ++q) { const float la = -8.f * sigmoidf_(ga[q] + bav[q]) * spl[q], aq = exp_(la); av[q] = aq; bv[q] = sqrt_((1.f - aq) * (1.f + aq)) * sigmoidf_(gx[q] + bxv[q]) * xcv[q]; }
                *(LAS f32x4*)(AA + tk * LQ_NQ + 16 * got + 4 * g4) = av; *(LAS f32x4*)(BV + tk * LQ_NQ + 16 * got + 4 * g4) = bv;
            }
            __syncthreads();
            float av8[8], bv8[8];
            if (tid < 8 * LQ_NQ) {
                float P = 1.f, H = 0.f;
#pragma unroll
                for (int s = 0; s < 8; ++s) { const int p = seg * 8 + s, st = e ? 63 - p : p; av8[s] = AA[st * LQ_NQ + sch]; bv8[s] = BV[st * LQ_NQ + sch]; H = fmaf(av8[s], H, bv8[s]); P *= av8[s]; }
                SP[seg * LQ_NQ + sch] = P; SH[seg * LQ_NQ + sch] = H;
            }
            __syncthreads();
            if (tid < 8 * LQ_NQ) {
                float h = HC[(cc & 1) * LQ_NQ + sch];
                for (int s2 = 0; s2 < seg; ++s2) h = fmaf(SP[s2 * LQ_NQ + sch], h, SH[s2 * LQ_NQ + sch]);
#pragma unroll
                for (int s = 0; s < 8; ++s) { const int p = seg * 8 + s, st = e ? 63 - p : p; h = fmaf(av8[s], h, bv8[s]); HH[st * LQ_NQ + sch] = h; }
                if (seg == 7) HC[((cc + 1) & 1) * LQ_NQ + sch] = h;
            }
            __syncthreads();
            {
                const int n = tok0 + c * 64 + otok;
                const f32x4 hv = *(const LAS f32x4*)(HH + otok * LQ_NQ + oc4);
                float o0 = hv[0], o1 = hv[1], o2 = hv[2], o3 = hv[3];
                if (e) { o0 = (o0 + bflo(hfc.x)) * siluf_(bflo(glc.x)); o1 = (o1 + bfhi(hfc.x)) * siluf_(bfhi(glc.x)); o2 = (o2 + bflo(hfc.y)) * siluf_(bflo(glc.y)); o3 = (o3 + bfhi(hfc.y)) * siluf_(bfhi(glc.y)); }
                *(v2u*)(HF + (size_t)n * 256 + chq + oc4) = (v2u){cvtpk(o0, o1), cvtpk(o2, o3)};
            }
        }
#undef LQ_PREFETCH
        __syncthreads();
        if (tid < LQ_NQ && !lat) a->out[O_LRU + ((size_t)(b * 2 + layer) * 2 + e) * 256 + chq + tid] = HC[((L / 64) & 1) * LQ_NQ + tid];
    }
}
constexpr int N_PHASES = 14;
#ifndef MK_PER_PHASE
#define MK_PER_PHASE 0
#endif
#ifndef VAR_GEMM
#define VAR_GEMM 1
#endif
#ifndef VAR_A2
#define VAR_A2 1
#endif
#ifndef VAR_ATT
#define VAR_ATT 1
#endif
#ifndef VAR_RWKV
#define VAR_RWKV 1
#endif
#ifndef VAR_LRU
#define VAR_LRU 1
#endif

__device__ __forceinline__ void phase_b(ArgsP a, LAS unsigned char* lds, int layer) {
    volatile LAS unsigned* MISC = (volatile LAS unsigned*)(lds + LDS_MISC);
    unsigned* head = (unsigned*)(a->ws + WS_CTL) + CW_Q + layer * 64;
    for (;;) {
        __syncthreads();
        if (tid_() == 0) MISC[16] = atomicAdd(head, 1u);
        __syncthreads();
        const int idx = (int)MISC[16];
        if (idx >= 1408) break;
#ifdef PROBE_UNIT1
        const unsigned long long pt0_ = __builtin_amdgcn_s_memrealtime();
#endif
        if (idx < 64) rwkv_unit_mfma(a, lds, layer, idx);
        else if (idx < 128) lru_unit_q(a, lds, layer, idx - 64);
        else if (idx < 640) att_unit(a, lds, idx - 128);
        else if (idx < 896) rwkv_unit_mfma(a, lds, layer, 64 + idx - 640);
        else if (idx < 1152) lru_unit_q(a, lds, layer, 64 + idx - 896);
        else att_unit(a, lds, 512 + idx - 1152);
#ifdef PROBE_UNIT1
        if (tid_() == 0 && layer == 0) { const unsigned d_ = (unsigned)(__builtin_amdgcn_s_memrealtime() - pt0_);
            const int ty_ = idx < 64 ? 0 : idx < 128 ? 1 : idx < 640 ? 2 : idx < 896 ? 3 : idx < 1152 ? 4 : 5;
            atomicMax((unsigned*)(a->ws + WS_CTL) + CW_Q + 1024 + ty_ * 64, d_); }
#endif
    }
}

#if MK_PER_PHASE
template <int SUB> __global__ void __launch_bounds__(NTHREADS, 2) mk_phase(Args args, int layer) {
    extern __shared__ __attribute__((aligned(16))) unsigned char lds_raw[];
    LAS unsigned char* lds = (LAS unsigned char*)lds_raw;
    ArgsP a = (ArgsP)__builtin_amdgcn_kernarg_segment_ptr();
    if (SUB == 0) phase_p0(a, lds);
    if (SUB == 1) phase_a0(a, layer);
    if (SUB == 2) { if (VAR_GEMM) phase_a1_pg8(a, lds, layer); else phase_a1_naive(a, layer); }
    if (SUB == 3) { if (VAR_A2) { for (int u = blockIdx.x; u < T / 64 + 32; u += gridDim.x) a2_unit(a, lds, layer, u); } else phase_a2_naive(a, lds, layer); }
    if (SUB == 4) { if (VAR_ATT) { for (int u = blockIdx.x; u < 768; u += gridDim.x) att_unit(a, lds, u); } else phase_att_naive(a); }
    if (SUB == 5) { for (int u = blockIdx.x; u < 320; u += gridDim.x) { __syncthreads(); if (VAR_RWKV) rwkv_unit_mfma(a, lds, layer, u); else rwkv_unit_seq(a, lds, layer, u); } }
    if (SUB == 6) { for (int u = blockIdx.x; u < 160; u += gridDim.x) { __syncthreads(); if (VAR_LRU) lru_unit_mfma(a, lds, layer, u); else lru_unit_seq(a, lds, layer, u); } }
    if (SUB == 7) phase_c1(a, layer);
    if (SUB == 8) { if (VAR_GEMM) phase_c2_pg8(a, lds, layer); else phase_c2_naive(a, layer); }
    if (SUB == 9) phase_final(a);
}
#else
#define ARGS_VIEW() ({ ArgsP p_ = (ArgsP)__builtin_amdgcn_kernarg_segment_ptr(); asm volatile("" : "+s"(p_)); p_; })
__global__ void __launch_bounds__(NTHREADS, 2) mk_fwd(Args args) {
    extern __shared__ __attribute__((aligned(16))) unsigned char lds_raw[];
    LAS unsigned char* lds = (LAS unsigned char*)lds_raw;
    volatile LAS unsigned* MISC = (volatile LAS unsigned*)(lds + LDS_MISC);
    for (int u = threadIdx.x; u < 64; u += NTHREADS) MISC[u] = 0u;
    __syncthreads();
    XcdBarrier bar;
    { ArgsP a = ARGS_VIEW(); bar = xcd_barrier_post((unsigned*)(a->ws + WS_CTL) + CW_BAR, MISC + 8); }
    int lo, hi; { ArgsP a = ARGS_VIEW(); lo = a->ph_lo; hi = a->ph_hi; }
#define IN(k) (lo <= (k) && (k) < hi)
#ifdef PROBE_MASK1
#define STAMP(k) do { if (bid_() == 0 && tid_() == 0) { const unsigned long long t_ = __builtin_amdgcn_s_memrealtime(); MISC[32 + 2 * (k)] = (unsigned)t_; MISC[33 + 2 * (k)] = (unsigned)(t_ >> 32); } } while (0)
#else
#define STAMP(k) do { } while (0)
#endif
#define SEAM(k) do { if (IN(k) && IN((k) + 1)) xcd_barrier(bar); STAMP((k) + 1); } while (0)
#ifndef NO_P0
    STAMP(0);
    if (IN(0)) { ArgsP a = ARGS_VIEW(); phase_p0(a, lds); }
#endif
    SEAM(0);
    for (int layer = 0; layer < 2; ++layer) {
        const int p = 1 + 6 * layer;
#ifndef NO_A0
        if (IN(p + 0)) { ArgsP a = ARGS_VIEW(); phase_a0(a, layer); }
#endif
        SEAM(p + 0);
#ifndef NO_A1
        if (IN(p + 1)) { ArgsP a = ARGS_VIEW(); phase_a1_pg8(a, lds, layer); }
#endif
        SEAM(p + 1);
#ifndef NO_A2
        if (IN(p + 2)) { ArgsP a = ARGS_VIEW(); for (int u = bid_(); u < T / 64 + 32; u += grid_()) {
#ifdef PROBE_UNIT1
            const unsigned long long pt0_ = __builtin_amdgcn_s_memrealtime();
#endif
            a2_unit(a, lds, layer, u);
#ifdef PROBE_A2_TWICE
            a2_unit(a, lds, layer, u);
#endif
#ifdef PROBE_UNIT1
            __syncthreads();
            if (tid_() == 0 && layer == 0) atomicMax((unsigned*)(a->ws + WS_CTL) + CW_Q + 1024 + (u < 256 ? 6 : 7) * 64, (unsigned)(__builtin_amdgcn_s_memrealtime() - pt0_));
#endif
        } }
#endif
        SEAM(p + 2);
#ifndef NO_B
        if (IN(p + 3)) { ArgsP a = ARGS_VIEW(); phase_b(a, lds, layer); }
#endif
        SEAM(p + 3);
#ifndef NO_C1
        if (IN(p + 4)) { ArgsP a = ARGS_VIEW(); phase_c1(a, layer); }
#endif
        SEAM(p + 4);
#ifndef NO_C2
        if (IN(p + 5)) { ArgsP a = ARGS_VIEW(); phase_c2_pg8(a, lds, layer); }
#endif
        SEAM(p + 5);
    }
    if (IN(N_PHASES - 1)) { ArgsP a = ARGS_VIEW(); phase_final(a); }
#ifdef PROBE_MASK1
    STAMP(14);
    __syncthreads();
    if (bid_() == 0) {
        ArgsP a = ARGS_VIEW();
        float t1 = 0.f, t2 = 0.f;
        for (int k = 0; k < 14; ++k) { const unsigned long long s0 = ((unsigned long long)MISC[33 + 2 * k] << 32) | MISC[32 + 2 * k], s1 = ((unsigned long long)MISC[35 + 2 * k] << 32) | MISC[34 + 2 * k];
            const float us = (float)(s1 - s0) * 0.01f; if ((PROBE_MASK1 >> k) & 1) t1 += us; if ((PROBE_MASK2 >> k) & 1) t2 += us; }
#ifdef PROBE_UNIT1
        t1 = (float)((unsigned*)(a->ws + WS_CTL))[CW_Q + 1024 + PROBE_UNIT1 * 64] * 0.01f; t2 = (float)((unsigned*)(a->ws + WS_CTL))[CW_Q + 1024 + PROBE_UNIT2 * 64] * 0.01f;
#endif
        for (int i = tid_(); i < 32768; i += NTHREADS) a->out[O_LRU + i] *= (1.f + t2 * (1.f / 2000.f));
        if (tid_() == 0) a->out[0] += 2.f + t1 * 0.01f;
    }
#endif
#undef IN
#undef SEAM
}

#endif

extern "C" void kernel_launch(void* const* d_in, const int* in_sizes, int n_in, void* d_out, int out_size, void* d_ws, size_t ws_size, hipStream_t stream) {
    static int grid = 0;
    if (grid == 0) {
        if (n_in != N_IN || ws_size < WS_END) { fprintf(stderr, "kernel_launch: unexpected n_in %d / ws_size %zu\n", n_in, ws_size); grid = -1; return; }
        int dev = 0, cus = 0;
        if (hipGetDevice(&dev) != hipSuccess || hipDeviceGetAttribute(&cus, hipDeviceAttributeMultiprocessorCount, dev) != hipSuccess) { grid = -1; return; }
#if MK_PER_PHASE
#define SA(SUB) if (hipFuncSetAttribute((const void*)mk_phase<SUB>, hipFuncAttributeMaxDynamicSharedMemorySize, LDS_BYTES) != hipSuccess) { fprintf(stderr, "kernel_launch: hipFuncSetAttribute failed\n"); grid = -1; return; }
        SA(0) SA(1) SA(2) SA(3) SA(4) SA(5) SA(6) SA(7) SA(8) SA(9)
#undef SA
#else
        if (hipFuncSetAttribute((const void*)mk_fwd, hipFuncAttributeMaxDynamicSharedMemorySize, LDS_BYTES) != hipSuccess) { fprintf(stderr, "kernel_launch: hipFuncSetAttribute failed\n"); grid = -1; return; }
        int per_cu = 0;
        if (hipOccupancyMaxActiveBlocksPerMultiprocessor(&per_cu, (const void*)mk_fwd, NTHREADS, LDS_BYTES) != hipSuccess || per_cu < 1) fprintf(stderr, "kernel_launch: occupancy query reports %d\n", per_cu);
        (void)hipGetLastError();
#endif
        grid = cus;
    }
    if (grid < 0) return;
    if (hipMemsetAsync((char*)d_ws + WS_CTL, 0, CTL_ZERO_BYTES, stream) != hipSuccess) return;
    Args a{};
    for (int i = 0; i < N_IN; ++i) a.in[i] = (const float*)d_in[i];
    a.out = (float*)d_out; a.ws = (unsigned char*)d_ws;
#if MK_PER_PHASE
#define LP(SUB, layer) hipLaunchKernelGGL(mk_phase<SUB>, dim3(grid), dim3(NTHREADS), LDS_BYTES, stream, a, layer)
    LP(0, 0);
    for (int layer = 0; layer < 2; ++layer) { LP(1, layer); LP(2, layer); LP(3, layer); LP(4, layer); LP(5, layer); LP(6, layer); LP(7, layer); LP(8, layer); }
    LP(9, 0);
#undef LP
#else
    a.ph_lo = 0; a.ph_hi = N_PHASES;
    hipLaunchKernelGGL(mk_fwd, dim3(grid), dim3(NTHREADS), LDS_BYTES, stream, a);
#endif
}
```

```cpp
#define MK_PER_PHASE 0
#include <hip/hip_runtime.h>
#include <cstdio>
#include <cstdint>

#define GAS __attribute__((address_space(1)))
#define LAS __attribute__((address_space(3)))
typedef unsigned short bf16;
typedef unsigned v4u __attribute__((ext_vector_type(4)));
typedef unsigned v2u __attribute__((ext_vector_type(2)));
typedef float f32x4 __attribute__((ext_vector_type(4)));
typedef short bf16x8 __attribute__((ext_vector_type(8)));

constexpr int D = 1024, T_CTX = 8192, T_LAT = 16384, T = 24576, L_CTX = 256, L_LAT = 2048, PAST = 256;
constexpr int NIN = 2816, G1W = 2304, G2W = 512;
constexpr int C_R = 0, C_K = 256, C_V = 512, C_G = 768, C_GM = 1024, C_XL = 1536, C_GL = 1792, C_LORA = 2048;
constexpr int LK_LAT = PAST + L_LAT;
constexpr int TK = T_CTX + 8 * LK_LAT;
constexpr int VT_LAT = 32 * 8 * 64 * 256;
constexpr float LN_EPS = 1e-5f, GN_EPS = 64e-5f;
constexpr float ALPHA = 1.4142135623730951f;
constexpr float QSCALE = 0.10206207261596575f * 1.4426950408889634f;
constexpr size_t O_Y = 0, O_RW = 25165824, O_CKV = 27262976, O_KR = 29360128, O_LRU = 29884416;
constexpr size_t MiB = 1u << 20;
constexpr size_t WS_CTL = 0, CTL_ZERO_BYTES = 1 * MiB;
constexpr size_t WS_MOD = 256 * 1024;
constexpr size_t WS_ROPE = 1 * MiB;
constexpr size_t WS_STATS = 1536 * 1024;
constexpr size_t WS_WUQ = 2 * MiB;
constexpr size_t WS_WUKV = 3 * MiB;
constexpr size_t WS_WIN = 4 * MiB;
constexpr size_t WS_WOUT = 16 * MiB;
constexpr size_t WS_G1 = 20 * MiB;
constexpr size_t WS_G2 = 128 * MiB;
constexpr size_t WS_Q = 152 * MiB;
constexpr size_t WS_U = 152 * MiB;
constexpr size_t WS_KN = 188 * MiB;
constexpr size_t WS_KR = 214 * MiB;
constexpr size_t WS_VT = 216 * MiB;
constexpr size_t WS_YMIX = 188 * MiB;
constexpr size_t WS_HF = 242 * MiB;
constexpr size_t WS_END = 254 * MiB;
constexpr int CW_BAR = 4096;
constexpr int CW_Q = 16384;

__device__ __forceinline__ float bf2f(unsigned b) { return __uint_as_float(b << 16); }
__device__ __forceinline__ float bflo(unsigned w) { return __uint_as_float(w << 16); }
__device__ __forceinline__ float bfhi(unsigned w) { return __uint_as_float(w & 0xffff0000u); }
__device__ __forceinline__ unsigned f2bf(float f) { unsigned u = __float_as_uint(f); return (u + 0x7fffu + ((u >> 16) & 1u)) >> 16; }
__device__ __forceinline__ unsigned pk2(float lo, float hi) { return f2bf(lo) | (f2bf(hi) << 16); }
__device__ __forceinline__ float rcp_(float x) { return __builtin_amdgcn_rcpf(x); }
__device__ __forceinline__ float exp_(float x) { return __builtin_amdgcn_exp2f(x * 1.4426950408889634f); }
__device__ __forceinline__ float sqrt_(float x) { return __builtin_amdgcn_sqrtf(x); }
__device__ __forceinline__ float rsqrt_(float x) { return __builtin_amdgcn_rsqf(x); }
__device__ __forceinline__ float sigmoidf_(float x) { return rcp_(1.f + exp_(-x)); }
__device__ __forceinline__ float siluf_(float x) { return x * rcp_(1.f + exp_(-x)); }
template <int CTRL> __device__ __forceinline__ float dpp_f(float old, float x) { return __builtin_bit_cast(float, __builtin_amdgcn_update_dpp(__builtin_bit_cast(int, old), __builtin_bit_cast(int, x), CTRL, 0xf, 0xf, false)); }
__device__ __forceinline__ float row16_sum(float x) { x += dpp_f<0x128>(0.f, x); x += dpp_f<0x124>(0.f, x); x += dpp_f<0x122>(0.f, x); x += dpp_f<0x121>(0.f, x); return x; }
__device__ __forceinline__ float wave_sum_fast(float x) { x = row16_sum(x); x += __shfl_xor(x, 16); x += __shfl_xor(x, 32); return x; }
__device__ __forceinline__ float row16_prefix_prod(float x) { x *= dpp_f<0x111>(1.f, x); x *= dpp_f<0x112>(1.f, x); x *= dpp_f<0x114>(1.f, x); x *= dpp_f<0x118>(1.f, x); return x; }
__device__ __forceinline__ float wave_sum(float v) { return wave_sum_fast(v); }
__device__ __forceinline__ int tid_() { int t = threadIdx.x; asm volatile("" : "+v"(t)); return t; }
__device__ __forceinline__ int bid_() { int b = blockIdx.x; asm volatile("" : "+s"(b)); return b; }
__device__ __forceinline__ int grid_() { int g = gridDim.x; asm volatile("" : "+s"(g)); return g; }
typedef float f32x16 __attribute__((ext_vector_type(16)));
typedef float f32x2_t __attribute__((ext_vector_type(2)));
typedef __bf16 bf16x2_t __attribute__((ext_vector_type(2)));
__device__ __forceinline__ unsigned cvtpk(float lo, float hi) { const f32x2_t v = {lo, hi}; return __builtin_bit_cast(unsigned, __builtin_convertvector(v, bf16x2_t)); }
#define XB_TMO      128
#define XB_XCNT(j)  (256  + 64 * (j))
#define XB_XSUB(j)  (1280 + 64 * (j))
#define XB_XGEN(j)  (2304 + 64 * (j))
#define XB_TOP      3328
#define XB_TOPGEN   3392
#define XCD_BAR_WORDS 3456
#define XB_SPIN_CAP (1u << 24)

__device__ __forceinline__ unsigned xb_ld(unsigned* p)              { return __hip_atomic_load(p, __ATOMIC_RELAXED, __HIP_MEMORY_SCOPE_AGENT); }
__device__ __forceinline__ unsigned xb_add(unsigned* p, unsigned v) { return __hip_atomic_fetch_add(p, v, __ATOMIC_RELAXED, __HIP_MEMORY_SCOPE_AGENT); }
__device__ __forceinline__ unsigned xb_xcc_id() { return (unsigned)__builtin_amdgcn_s_getreg((3 << 11) | 20) & 0xFu; }
#define XB_SPIN(cond, bar) do { unsigned _sp = 0; while (cond) { __builtin_amdgcn_s_sleep(1); \
    if ((++_sp & 255u) == 0u) { if (xb_ld(&(bar)[XB_TMO])) break; if (_sp > XB_SPIN_CAP) { atomicAdd(&(bar)[XB_TMO], 1u); break; } } } } while (0)

struct XcdBarrier {
    unsigned* bar; unsigned x;
    volatile LAS unsigned* st;
};

__device__ __forceinline__ XcdBarrier xcd_barrier_post(unsigned* bar, volatile LAS unsigned* st) {
    XcdBarrier b; b.bar = bar; b.x = xb_xcc_id(); b.st = st;
    if (threadIdx.x == 0) (void)xb_add(&bar[XB_XCNT(b.x)], 1u);
    return b;
}
__device__ __forceinline__ void xcd_barrier_complete(unsigned* bar, unsigned x, unsigned& nloc, unsigned& nx) {
    const unsigned G = gridDim.x * gridDim.y * gridDim.z;
    unsigned sum, cnt, mine, sp = 0u;
    for (;;) {
        sum = 0u; cnt = 0u; mine = 0u;
#pragma unroll
        for (unsigned j = 0; j < 16; ++j) { const unsigned c = xb_ld(&bar[XB_XCNT(j)]); sum += c; cnt += (c > 0u) ? 1u : 0u; mine = (j == x) ? c : mine; }
        if (sum == G) break;
        __builtin_amdgcn_s_sleep(1);
        if ((++sp & 255u) == 0u) { if (xb_ld(&bar[XB_TMO])) break; if (sp > XB_SPIN_CAP) { atomicAdd(&bar[XB_TMO], 1u); break; } }
    }
    nloc = mine > 0u ? mine : 1u; nx = cnt > 0u ? cnt : 1u;
}

__device__ __forceinline__ void xcd_barrier(const XcdBarrier& b) {
    asm volatile("s_waitcnt vmcnt(0)" ::: "memory");
    __syncthreads();
    if (threadIdx.x == 0) {
        unsigned* bar = b.bar;
        __builtin_amdgcn_s_waitcnt(0);
        unsigned nloc = b.st[0], nx = b.st[1];
        if (nloc == 0u) { xcd_barrier_complete(bar, b.x, nloc, nx); b.st[0] = nloc; b.st[1] = nx; }
        const unsigned old = xb_add(&bar[XB_XSUB(b.x)], 1u);
        const unsigned gen = old / nloc;
        if (old + 1u == (gen + 1u) * nloc) {
            __builtin_amdgcn_fence(__ATOMIC_RELEASE, "agent");
            asm volatile("s_waitcnt vmcnt(0)" ::: "memory");
            const unsigned og = xb_add(&bar[XB_TOP], 1u);
            const unsigned tg = og / nx;
            if (og + 1u == (tg + 1u) * nx) xb_add(&bar[XB_TOPGEN], 1u);
            else XB_SPIN(xb_ld(&bar[XB_TOPGEN]) == tg, bar);
            __builtin_amdgcn_fence(__ATOMIC_ACQUIRE, "agent");
            xb_add(&bar[XB_XGEN(b.x)], 1u);
            asm volatile("s_waitcnt vmcnt(0)" ::: "memory");
        } else {
            XB_SPIN(xb_ld(&bar[XB_XGEN(b.x)]) == gen, bar);
            __builtin_amdgcn_fence(__ATOMIC_ACQUIRE, "agent");
            asm volatile("s_waitcnt vmcnt(0)" ::: "memory");
        }
    }
    __syncthreads();
}
enum { I_XP = 0, I_XS, I_SRW, I_CCKV, I_CKR, I_SLRU, I_C, I_CCTX, I_WMOD, I_BMOD, I_WIN, I_W0, I_W1, I_W2, I_A0, I_A1, I_A2, I_KK, I_KA, I_RK,
       I_LNXG, I_LNXB, I_QNORM, I_WUQ, I_KVNORM, I_WUKV, I_CONVW, I_CONVB, I_WA, I_BA, I_WX, I_BX, I_LAMBDA, I_WOUT, I_LNG, I_LNB, N_IN };
struct Args { const float* in[N_IN]; float* out; unsigned char* ws; int ph_lo, ph_hi; };
typedef const Args __attribute__((address_space(4)))* ArgsP;
constexpr int NTHREADS = 512;
constexpr int LDS_MISC = 139264;
constexpr int LDS_BYTES = 147456;

struct Tok { int n, b, t, L, lat, modrow, tok0, kidx; };
__device__ __forceinline__ Tok tok_of(int n) {
    Tok k; k.n = n;
    if (n < T_CTX) { k.lat = 0; k.b = n >> 8; k.t = n & 255; k.L = L_CTX; k.modrow = 0; k.tok0 = k.b * 256; k.kidx = n; }
    else { const int m = n - T_CTX; k.lat = 1; k.b = m >> 11; k.t = m & 2047; k.L = L_LAT; k.modrow = 1 + k.b; k.tok0 = T_CTX + k.b * 2048; k.kidx = T_CTX + k.b * LK_LAT + PAST + k.t; }
    return k;
}
__device__ __forceinline__ const float* xrow_src(ArgsP a, int layer, int n) {
    if (layer == 0) return n < T_CTX ? a->in[I_XP] + (size_t)n * D : a->in[I_XS] + (size_t)(n - T_CTX) * D;
    return a->out + (size_t)n * D;
}
__device__ __forceinline__ float dot8(v4u a, v4u b, float acc) {
    acc = fmaf(bflo(a.x), bflo(b.x), acc); acc = fmaf(bfhi(a.x), bfhi(b.x), acc);
    acc = fmaf(bflo(a.y), bflo(b.y), acc); acc = fmaf(bfhi(a.y), bfhi(b.y), acc);
    acc = fmaf(bflo(a.z), bflo(b.z), acc); acc = fmaf(bfhi(a.z), bfhi(b.z), acc);
    acc = fmaf(bflo(a.w), bflo(b.w), acc); acc = fmaf(bfhi(a.w), bfhi(b.w), acc);
    return acc;
}

__device__ __forceinline__ void tr_item(const float* src, int ld, int col0, int k0, bf16* WT, int K, int row0, float scale, LAS float* scr, int lane) {
    {
        const int kr = lane >> 3, n4 = (lane & 7) * 4;
        f32x4 v[8];
#pragma unroll
        for (int i = 0; i < 8; ++i) v[i] = src ? *(const f32x4*)(src + (size_t)(k0 + i * 8 + kr) * ld + col0 + n4) : (f32x4){0.f, 0.f, 0.f, 0.f};
#pragma unroll
        for (int i = 0; i < 8; ++i) { LAS float* d = scr + (i * 8 + kr) * 33 + n4; d[0] = v[i].x * scale; d[1] = v[i].y * scale; d[2] = v[i].z * scale; d[3] = v[i].w * scale; }
    }
    asm volatile("s_waitcnt lgkmcnt(0)" ::: "memory");
    const int c = lane & 7;
#pragma unroll
    for (int j = 0; j < 4; ++j) { const int n = (lane >> 3) + 8 * j; const LAS float* s = scr + (8 * c) * 33 + n;
        v4u o; o.x = pk2(s[0 * 33], s[1 * 33]); o.y = pk2(s[2 * 33], s[3 * 33]); o.z = pk2(s[4 * 33], s[5 * 33]); o.w = pk2(s[6 * 33], s[7 * 33]);
        *(v4u*)(WT + (size_t)(row0 + n) * K + k0 + 8 * c) = o; }
    asm volatile("s_waitcnt lgkmcnt(0)" ::: "memory");
}
__device__ __forceinline__ void rope_angle(int t, int i, float& c, float& s) {
    const int row = t >> 6, col = t & 63; const int ii = i & 7;
    const float inv = exp2f(-(float)ii * (13.287712379549449f / 8.f));
    const float ang = (float)(i < 8 ? row : col) * inv;
    c = cosf(ang); s = sinf(ang);
}
__device__ __forceinline__ void phase_p0_weights(ArgsP a, LAS unsigned char* lds) {
    const int tid = tid_(), lane = tid & 63, wave = tid >> 6, G = grid_();
    unsigned char* ws = a->ws;
    LAS float* scr = (LAS float*)(lds + wave * 8704);
    const int gw = bid_() * 8 + wave, NGW = G * 8;
    constexpr int N_WIN = 2 * 16 * 88, N_WOUT = 2 * 16 * 32, N_WUQ = 2 * 4 * 24, N_WUKV = 2 * 4 * 32;
    for (int it = gw; it < N_WIN + N_WOUT + N_WUQ + N_WUKV; it += NGW) {
        int r = it;
        if (r < N_WIN) {
            const int l = r / (16 * 88), kb = (r / 88) % 16, nb = r % 88, j0 = nb * 32;
            const float* src; int ld, col0;
            const float* win = a->in[I_WIN] + (size_t)l * 1024 * 2464;
            if (j0 < 1024) { src = win; ld = 2464; col0 = j0; }
            else if (j0 < 1536) { src = win; ld = 2464; col0 = 1440 + (j0 - 1024); }
            else if (j0 < 1792) { src = win; ld = 2464; col0 = 1952 + (j0 - 1536); }
            else if (j0 < 2048) { src = win; ld = 2464; col0 = 2208 + (j0 - 1792); }
            else if (j0 < 2304) { const int q = (j0 - 2048) >> 6; src = (q < 2 ? a->in[I_W1] : a->in[I_A1]) + (size_t)(l * 2 + (q & 1)) * 1024 * 64; ld = 64; col0 = (j0 - 2048) & 63; }
            else if (j0 < 2560) { src = win; ld = 2464; col0 = 1024 + (j0 - 2304); }
            else if (j0 < 2688) { src = win; ld = 2464; col0 = 1280 + (j0 - 2560); }
            else if (j0 < 2720) { src = win; ld = 2464; col0 = 1408 + (j0 - 2688); }
            else { src = nullptr; ld = 0; col0 = 0; }
            tr_item(src, ld, col0, kb * 64, (bf16*)(ws + WS_WIN) + (size_t)l * NIN * 1024, 1024, j0, 1.f, scr, lane);
            continue;
        }
        r -= N_WIN;
        if (r < N_WOUT) { const int l = r / (16 * 32), kb = (r / 32) % 16, nb = r % 32;
            tr_item(a->in[I_WOUT] + (size_t)l * 1024 * 1024, 1024, nb * 32, kb * 64, (bf16*)(ws + WS_WOUT) + (size_t)l * 1024 * 1024, 1024, nb * 32, 1.f, scr, lane); continue; }
        r -= N_WOUT;
        if (r < N_WUQ) { const int l = r / (4 * 24), kb = (r / 24) % 4, nb = r % 24;
            tr_item(a->in[I_WUQ] + (size_t)l * 256 * 768, 768, nb * 32, kb * 64, (bf16*)(ws + WS_WUQ) + (size_t)l * 768 * 256, 256, nb * 32, QSCALE, scr, lane); continue; }
        r -= N_WUQ;
        { const int l = r / (4 * 32), kb = (r / 32) % 4, nb = r % 32;
            tr_item(kb < 2 ? a->in[I_WUKV] + (size_t)l * 128 * 1024 : nullptr, 1024, nb * 32, kb * 64, (bf16*)(ws + WS_WUKV) + (size_t)l * 1024 * 256, 256, nb * 32, 1.f, scr, lane); }
    }
}
__device__ __forceinline__ void phase_p0(ArgsP a, LAS unsigned char* lds) {
    const int tid = tid_(), G = grid_();
    unsigned char* ws = a->ws;
    { float* ROPE = (float*)(ws + WS_ROPE);
      for (int i = bid_() * NTHREADS + tid; i < 2048 * 16; i += G * NTHREADS) { float c, s; rope_angle(i >> 4, i & 15, c, s); ROPE[i * 2] = c; ROPE[i * 2 + 1] = s; } }
    float* MOD = (float*)(ws + WS_MOD);
    LAS float* SIL = (LAS float*)lds;
    for (int it = bid_(); it < 2 * 6 * 32; it += G) {
        const int l = it / 192, nb = (it / 32) % 6, kq = it % 32, col = nb * 512 + tid;
        __syncthreads();
        if (tid < 288) { const int j = tid >> 5, k = kq * 32 + (tid & 31); const float cj = (j == 0) ? a->in[I_CCTX][k] : a->in[I_C][(j - 1) * 1024 + k]; SIL[tid] = siluf_(cj); }
        float w[32];
#pragma unroll
        for (int kk = 0; kk < 32; ++kk) w[kk] = a->in[I_WMOD][((size_t)l * 1024 + kq * 32 + kk) * 3072 + col];
        __syncthreads();
        const float bias = (kq == 0) ? a->in[I_BMOD][l * 3072 + col] : 0.f;
#pragma unroll
        for (int j = 0; j < 9; ++j) { float acc = bias;
#pragma unroll
            for (int k4 = 0; k4 < 8; ++k4) { const f32x4 sv = *(const LAS f32x4*)(SIL + j * 32 + k4 * 4); acc = fmaf(sv.x, w[k4 * 4], acc); acc = fmaf(sv.y, w[k4 * 4 + 1], acc); acc = fmaf(sv.z, w[k4 * 4 + 2], acc); acc = fmaf(sv.w, w[k4 * 4 + 3], acc); }
            atomicAdd(&MOD[(l * 9 + j) * 3072 + col], acc); }
    }
}

__device__ __forceinline__ void phase_a0(ArgsP a, int layer) {
    const int tid = tid_(), lane = tid & 63, wave = tid >> 6, G = grid_();
    const float* MOD = (const float*)(a->ws + WS_MOD);
    bf16* U = (bf16*)(a->ws + WS_U);
    f32x4 nx[4];
    { const int n0 = bid_() * 8 + wave; if (n0 < T) { const float* xr0 = xrow_src(a, layer, n0);
#pragma unroll
        for (int j = 0; j < 4; ++j) nx[j] = *(const f32x4*)(xr0 + lane * 4 + 256 * j); } }
    for (int n = bid_() * 8 + wave; n < T; n += G * 8) {
        const Tok tk = tok_of(n);
        f32x4 v[4]; float s = 0.f;
#pragma unroll
        for (int j = 0; j < 4; ++j) { v[j] = nx[j]; s += (v[j].x + v[j].y) + (v[j].z + v[j].w); }
        if (n + G * 8 < T) { const float* xr1 = xrow_src(a, layer, n + G * 8);
#pragma unroll
            for (int j = 0; j < 4; ++j) nx[j] = *(const f32x4*)(xr1 + lane * 4 + 256 * j); }
        float mean = wave_sum(s) * (1.f / D), s2 = 0.f;
#pragma unroll
        for (int j = 0; j < 4; ++j) { v[j] = v[j] - mean; s2 += (v[j].x * v[j].x + v[j].y * v[j].y) + (v[j].z * v[j].z + v[j].w * v[j].w); }
        float rstd = rsqrt_(wave_sum(s2) * (1.f / D) + LN_EPS);
        if (layer == 1) {
            s = 0.f;
#pragma unroll
            for (int j = 0; j < 4; ++j) { const f32x4 g = *(const f32x4*)(a->in[I_LNG] + lane * 4 + 256 * j), b = *(const f32x4*)(a->in[I_LNB] + lane * 4 + 256 * j);
                v[j] = v[j] * rstd * g + b; s += (v[j].x + v[j].y) + (v[j].z + v[j].w); }
            if (lane == 0) { float* st = (float*)(a->ws + WS_STATS) + (size_t)n * 2; st[0] = mean; st[1] = rstd; }
            mean = wave_sum(s) * (1.f / D); s2 = 0.f;
#pragma unroll
            for (int j = 0; j < 4; ++j) { v[j] = v[j] - mean; s2 += (v[j].x * v[j].x + v[j].y * v[j].y) + (v[j].z * v[j].z + v[j].w * v[j].w); }
            rstd = rsqrt_(wave_sum(s2) * (1.f / D) + LN_EPS);
        }
        const float* m = MOD + (size_t)(layer * 9 + tk.modrow) * 3072;
#pragma unroll
        for (int j = 0; j < 4; ++j) { const int c = lane * 4 + 256 * j; const f32x4 sh = *(const f32x4*)(m + c), sc = *(const f32x4*)(m + 1024 + c);
            const f32x4 o = v[j] * rstd * (sc + 1.f) + sh;
            v2u p; p.x = pk2(o.x, o.y); p.y = pk2(o.z, o.w); *(v2u*)(U + (size_t)n * D + c) = p; }
    }
}
__device__ __forceinline__ void phase_final(ArgsP a) {
    const int tid = tid_(), lane = tid & 63, wave = tid >> 6, G = grid_();
    f32x4 nx[4];
    { const int n0 = bid_() * 8 + wave; if (n0 < T) {
#pragma unroll
        for (int j = 0; j < 4; ++j) nx[j] = *(const f32x4*)(a->out + (size_t)n0 * D + lane * 4 + 256 * j); } }
    for (int n = bid_() * 8 + wave; n < T; n += G * 8) {
        float* xr = a->out + (size_t)n * D;
        f32x4 v[4]; float s = 0.f;
#pragma unroll
        for (int j = 0; j < 4; ++j) { v[j] = nx[j]; s += (v[j].x + v[j].y) + (v[j].z + v[j].w); }
        if (n + G * 8 < T) {
#pragma unroll
            for (int j = 0; j < 4; ++j) nx[j] = *(const f32x4*)(a->out + (size_t)(n + G * 8) * D + lane * 4 + 256 * j); }
        const float mean = wave_sum(s) * (1.f / D); float s2 = 0.f;
#pragma unroll
        for (int j = 0; j < 4; ++j) { v[j] = v[j] - mean; s2 += (v[j].x * v[j].x + v[j].y * v[j].y) + (v[j].z * v[j].z + v[j].w * v[j].w); }
        const float rstd = rsqrt_(wave_sum(s2) * (1.f / D) + LN_EPS);
#pragma unroll
        for (int j = 0; j < 4; ++j) { const f32x4 g = *(const f32x4*)(a->in[I_LNG] + 1024 + lane * 4 + 256 * j), b = *(const f32x4*)(a->in[I_LNB] + 1024 + lane * 4 + 256 * j);
            *(f32x4*)(xr + lane * 4 + 256 * j) = v[j] * rstd * g + b; }
    }
}

__device__ __forceinline__ void phase_a1_naive(ArgsP a, int layer) {
    const bf16* U = (const bf16*)(a->ws + WS_U); const bf16* W = (const bf16*)(a->ws + WS_WIN) + (size_t)layer * NIN * 1024;
    bf16* G1 = (bf16*)(a->ws + WS_G1); bf16* G2 = (bf16*)(a->ws + WS_G2);
    const size_t total = (size_t)T * (NIN / 8), stride = (size_t)grid_() * NTHREADS;
    for (size_t idx = (size_t)bid_() * NTHREADS + tid_(); idx < total; idx += stride) {
        const int row = (int)(idx / (NIN / 8)), c0 = (int)(idx % (NIN / 8)) * 8;
        float acc[8];
#pragma unroll
        for (int c = 0; c < 8; ++c) acc[c] = 0.f;
        const v4u* ap = (const v4u*)(U + (size_t)row * 1024); const v4u* bp = (const v4u*)(W + (size_t)c0 * 1024);
        for (int kc = 0; kc < 128; ++kc) { const v4u av = ap[kc];
#pragma unroll
            for (int c = 0; c < 8; ++c) acc[c] = dot8(av, bp[c * 128 + kc], acc[c]); }
        v4u o; o.x = pk2(acc[0], acc[1]); o.y = pk2(acc[2], acc[3]); o.z = pk2(acc[4], acc[5]); o.w = pk2(acc[6], acc[7]);
        if (c0 < G1W) *(v4u*)(G1 + (size_t)row * G1W + c0) = o; else *(v4u*)(G2 + (size_t)row * G2W + (c0 - G1W)) = o;
    }
}
__device__ __forceinline__ void phase_c2_naive(ArgsP a, int layer) {
    const bf16* Y = (const bf16*)(a->ws + WS_YMIX); const bf16* W = (const bf16*)(a->ws + WS_WOUT) + (size_t)layer * 1024 * 1024;
    const float* MOD = (const float*)(a->ws + WS_MOD);
    const size_t total = (size_t)T * 256, stride = (size_t)grid_() * NTHREADS;
    for (size_t idx = (size_t)bid_() * NTHREADS + tid_(); idx < total; idx += stride) {
        const int row = (int)(idx >> 8), c0 = (int)(idx & 255) * 4;
        float acc[4] = {0.f, 0.f, 0.f, 0.f};
        const v4u* ap = (const v4u*)(Y + (size_t)row * 1024); const v4u* bp = (const v4u*)(W + (size_t)c0 * 1024);
        for (int kc = 0; kc < 128; ++kc) { const v4u av = ap[kc];
#pragma unroll
            for (int c = 0; c < 4; ++c) acc[c] = dot8(av, bp[c * 128 + kc], acc[c]); }
        const Tok tk = tok_of(row);
        const f32x4 gate = *(const f32x4*)(MOD + (size_t)(layer * 9 + tk.modrow) * 3072 + 2048 + c0);
        const f32x4 x = *(const f32x4*)(xrow_src(a, layer, row) + c0);
        f32x4 z; z.x = ALPHA * x.x + gate.x * acc[0]; z.y = ALPHA * x.y + gate.y * acc[1]; z.z = ALPHA * x.z + gate.z * acc[2]; z.w = ALPHA * x.w + gate.w * acc[3];
        *(f32x4*)(a->out + (size_t)row * D + c0) = z;
    }
}

__device__ __forceinline__ void phase_a2_naive(ArgsP a, LAS unsigned char* lds, int layer) {
    const int tid = tid_(), lane = tid & 63, wave = tid >> 6, G = grid_();
    LAS float* AQ = (LAS float*)lds;
    LAS float* AKV = (LAS float*)(lds + 16384);
    LAS float* OT = (LAS float*)(lds + 24576);
    const bf16* G2 = (const bf16*)(a->ws + WS_G2);
    bf16* Q = (bf16*)(a->ws + WS_Q); bf16* KN = (bf16*)(a->ws + WS_KN); bf16* KR = (bf16*)(a->ws + WS_KR); bf16* VT = (bf16*)(a->ws + WS_VT);
    const bf16* WUQ = (const bf16*)(a->ws + WS_WUQ) + (size_t)layer * 768 * 256;
    const bf16* WUKV = (const bf16*)(a->ws + WS_WUKV) + (size_t)layer * 1024 * 128;
    constexpr int NT_TOK = T / 16, NT_CACHE = 8 * 256 / 16;
    for (int tile = bid_(); tile < NT_TOK + NT_CACHE; tile += G) {
        const bool is_tok = tile < NT_TOK;
        for (int rr = 0; rr < 2; ++rr) {
            const int r = wave * 2 + rr;
            if (is_tok) {
                const int n = tile * 16 + r; const Tok tk = tok_of(n);
                const v2u cqv = *(const v2u*)(G2 + (size_t)n * G2W + lane * 4);
                const float c0 = bflo(cqv.x), c1 = bfhi(cqv.x), c2 = bflo(cqv.y), c3 = bfhi(cqv.y);
                const float rq = rsqrt_(wave_sum(c0 * c0 + c1 * c1 + c2 * c2 + c3 * c3) * (1.f / 256.f) + 1e-6f);
                const f32x4 qn = *(const f32x4*)(a->in[I_QNORM] + layer * 256 + lane * 4);
                AQ[r * 256 + lane * 4 + 0] = bf2f(f2bf(c0 * rq * qn.x)); AQ[r * 256 + lane * 4 + 1] = bf2f(f2bf(c1 * rq * qn.y));
                AQ[r * 256 + lane * 4 + 2] = bf2f(f2bf(c2 * rq * qn.z)); AQ[r * 256 + lane * 4 + 3] = bf2f(f2bf(c3 * rq * qn.w));
                float k0 = 0.f, k1 = 0.f, k2 = 0.f, k3 = 0.f;
                if (lane < 32) { const v2u kv = *(const v2u*)(G2 + (size_t)n * G2W + 256 + lane * 4); k0 = bflo(kv.x); k1 = bfhi(kv.x); k2 = bflo(kv.y); k3 = bfhi(kv.y); }
                const float rk = rsqrt_(wave_sum(k0 * k0 + k1 * k1 + k2 * k2 + k3 * k3) * (1.f / 128.f) + 1e-6f);
                if (lane < 32) {
                    const f32x4 kn = *(const f32x4*)(a->in[I_KVNORM] + layer * 128 + lane * 4);
                    f32x4 o; o.x = k0 * rk * kn.x; o.y = k1 * rk * kn.y; o.z = k2 * rk * kn.z; o.w = k3 * rk * kn.w;
                    if (!tk.lat) *(f32x4*)(a->out + O_CKV + ((size_t)(tk.b * 2 + layer) * 256 + tk.t) * 128 + lane * 4) = o;
                    AKV[r * 128 + lane * 4 + 0] = bf2f(f2bf(o.x)); AKV[r * 128 + lane * 4 + 1] = bf2f(f2bf(o.y));
                    AKV[r * 128 + lane * 4 + 2] = bf2f(f2bf(o.z)); AKV[r * 128 + lane * 4 + 3] = bf2f(f2bf(o.w));
                }
                float krv = (lane < 32) ? bf2f(G2[(size_t)n * G2W + 384 + lane]) : 0.f;
                const float other = __shfl_xor(krv, 1);
                if (lane < 32) {
                    if (!tk.lat) a->out[O_KR + ((size_t)(tk.b * 2 + layer) * 256 + tk.t) * 32 + lane] = krv;
                    else { float c, s; rope_angle(tk.t, lane >> 1, c, s); krv = (lane & 1) ? (other * s + krv * c) : (krv * c - other * s); }
                    KR[(size_t)tk.kidx * 32 + lane] = (bf16)f2bf(krv);
                }
            } else {
                const int cr = (tile - NT_TOK) * 16 + r, b = cr >> 8, j = cr & 255;
                const size_t src = ((size_t)(b * 2 + layer) * 256 + j);
                if (lane < 32) { const f32x4 v = *(const f32x4*)(a->in[I_CCKV] + src * 128 + lane * 4);
                    AKV[r * 128 + lane * 4 + 0] = bf2f(f2bf(v.x)); AKV[r * 128 + lane * 4 + 1] = bf2f(f2bf(v.y)); AKV[r * 128 + lane * 4 + 2] = bf2f(f2bf(v.z)); AKV[r * 128 + lane * 4 + 3] = bf2f(f2bf(v.w));
                    KR[(size_t)(T_CTX + b * LK_LAT + j) * 32 + lane] = (bf16)f2bf(a->in[I_CKR][src * 32 + lane]); }
            }
        }
        __syncthreads();
        if (is_tok) {
            for (int col = tid; col < 768; col += NTHREADS) {
                float acc[16];
#pragma unroll
                for (int r = 0; r < 16; ++r) acc[r] = 0.f;
                const v4u* wp = (const v4u*)(WUQ + (size_t)col * 256);
                for (int kc = 0; kc < 32; ++kc) { const v4u w = wp[kc];
                    const float w0 = bflo(w.x), w1 = bfhi(w.x), w2 = bflo(w.y), w3 = bfhi(w.y), w4 = bflo(w.z), w5 = bfhi(w.z), w6 = bflo(w.w), w7 = bfhi(w.w);
#pragma unroll
                    for (int r = 0; r < 16; ++r) { const f32x4 x0 = *(const LAS f32x4*)(AQ + r * 256 + kc * 8), x1 = *(const LAS f32x4*)(AQ + r * 256 + kc * 8 + 4);
                        acc[r] += x0.x * w0 + x0.y * w1 + x0.z * w2 + x0.w * w3 + x1.x * w4 + x1.y * w5 + x1.z * w6 + x1.w * w7; } }
#pragma unroll
                for (int r = 0; r < 16; ++r) OT[r * 1024 + col] = acc[r];
            }
            __syncthreads();
            for (int idx = tid; idx < 16 * 384; idx += NTHREADS) {
                const int r = idx / 384, col = (idx % 384) * 2, d = col % 96; const int n = tile * 16 + r; const Tok tk = tok_of(n);
                float v0 = OT[r * 1024 + col], v1 = OT[r * 1024 + col + 1];
                if (tk.lat && d >= 64) { float c, s; rope_angle(tk.t, (d - 64) >> 1, c, s); const float y0 = v0 * c - v1 * s, y1 = v0 * s + v1 * c; v0 = y0; v1 = y1; }
                *(unsigned*)(Q + (size_t)n * 768 + col) = pk2(v0, v1);
            }
            __syncthreads();
        }
        for (int col = tid; col < 1024; col += NTHREADS) {
            float acc[16];
#pragma unroll
            for (int r = 0; r < 16; ++r) acc[r] = 0.f;
            const v4u* wp = (const v4u*)(WUKV + (size_t)col * 128);
            for (int kc = 0; kc < 16; ++kc) { const v4u w = wp[kc];
                const float w0 = bflo(w.x), w1 = bfhi(w.x), w2 = bflo(w.y), w3 = bfhi(w.y), w4 = bflo(w.z), w5 = bfhi(w.z), w6 = bflo(w.w), w7 = bfhi(w.w);
#pragma unroll
                for (int r = 0; r < 16; ++r) { const f32x4 x0 = *(const LAS f32x4*)(AKV + r * 128 + kc * 8), x1 = *(const LAS f32x4*)(AKV + r * 128 + kc * 8 + 4);
                    acc[r] += x0.x * w0 + x0.y * w1 + x0.z * w2 + x0.w * w3 + x1.x * w4 + x1.y * w5 + x1.z * w6 + x1.w * w7; } }
#pragma unroll
            for (int r = 0; r < 16; ++r) OT[r * 1024 + col] = acc[r];
        }
        __syncthreads();
        for (int idx = tid; idx < 16 * 1024; idx += NTHREADS) {
            const int r = idx >> 10, col = idx & 1023, h = col >> 7, f = col & 127;
            int kidx, lat, b, kpos;
            if (is_tok) { const Tok tk = tok_of(tile * 16 + r); kidx = tk.kidx; lat = tk.lat; b = tk.b; kpos = tk.lat ? PAST + tk.t : tk.t; }
            else { const int cr = (tile - NT_TOK) * 16 + r; b = cr >> 8; kpos = cr & 255; lat = 1; kidx = T_CTX + b * LK_LAT + kpos; }
            const bf16 v = (bf16)f2bf(OT[r * 1024 + col]);
            if (f < 64) KN[(size_t)kidx * 512 + h * 64 + f] = v;
            else { const int dv = f - 64; const size_t base = lat ? (size_t)VT_LAT + ((size_t)(b * 8 + h) * 64 + dv) * LK_LAT : ((size_t)(b * 8 + h) * 64 + dv) * 256; VT[base + kpos] = v; }
        }
        __syncthreads();
    }
}

__device__ __forceinline__ void phase_att_naive(ArgsP a) {
    const bf16* KN = (const bf16*)(a->ws + WS_KN); const bf16* KR = (const bf16*)(a->ws + WS_KR); const bf16* VT = (const bf16*)(a->ws + WS_VT);
    bf16* Q = (bf16*)(a->ws + WS_Q); const bf16* G1 = (const bf16*)(a->ws + WS_G1);
    const int total = T * 8, stride = grid_() * NTHREADS;
    for (int idx = bid_() * NTHREADS + tid_(); idx < total; idx += stride) {
        int n, h, Lk, kidx0; size_t vbase;
        if (idx < T_CTX * 8) { const int b = idx >> 11, hh = (idx >> 8) & 7, t = idx & 255; n = b * 256 + t; h = hh; Lk = 256; kidx0 = b * 256; vbase = ((size_t)(b * 8 + h) * 64) * 256; }
        else { const int m = idx - T_CTX * 8, b = m >> 14, hh = (m >> 11) & 7, t = m & 2047; n = T_CTX + b * 2048 + t; h = hh; Lk = LK_LAT; kidx0 = T_CTX + b * LK_LAT; vbase = (size_t)VT_LAT + ((size_t)(b * 8 + h) * 64) * LK_LAT; }
        v4u qp[12];
#pragma unroll
        for (int c = 0; c < 12; ++c) qp[c] = *(const v4u*)(Q + (size_t)n * 768 + h * 96 + c * 8);
        float acc[64];
#pragma unroll
        for (int d = 0; d < 64; ++d) acc[d] = 0.f;
        float m = -1e30f, l = 0.f;
        for (int j0 = 0; j0 < Lk; j0 += 8) {
            float s[8];
#pragma unroll
            for (int j = 0; j < 8; ++j) {
                const v4u* kp = (const v4u*)(KN + (size_t)(kidx0 + j0 + j) * 512 + h * 64); const v4u* rp = (const v4u*)(KR + (size_t)(kidx0 + j0 + j) * 32);
                float sv = 0.f;
#pragma unroll
                for (int c = 0; c < 8; ++c) sv = dot8(qp[c], kp[c], sv);
#pragma unroll
                for (int c = 0; c < 4; ++c) sv = dot8(qp[8 + c], rp[c], sv);
                s[j] = sv;
                __builtin_amdgcn_sched_barrier(0);
            }
            float mx = m;
#pragma unroll
            for (int j = 0; j < 8; ++j) mx = fmaxf(mx, s[j]);
            const float alpha = exp2f(m - mx); m = mx; float ps = 0.f;
#pragma unroll
            for (int j = 0; j < 8; ++j) { s[j] = exp2f(s[j] - mx); ps += s[j]; }
            l = l * alpha + ps;
            unsigned lk = (unsigned)Lk; asm volatile("" : "+v"(lk));
            const bf16* vp = VT + vbase + j0;
#pragma unroll
            for (int dg = 0; dg < 8; ++dg) {
#pragma unroll
                for (int dd = 0; dd < 8; ++dd) { const int d = dg * 8 + dd; const v4u w = *(const v4u*)(vp + (unsigned)d * lk);
                    acc[d] = acc[d] * alpha + s[0] * bflo(w.x) + s[1] * bfhi(w.x) + s[2] * bflo(w.y) + s[3] * bfhi(w.y) + s[4] * bflo(w.z) + s[5] * bfhi(w.z) + s[6] * bflo(w.w) + s[7] * bfhi(w.w); }
                __builtin_amdgcn_sched_barrier(0);
            }
        }
        const float inv = rcp_(l);
#pragma unroll
        for (int c = 0; c < 8; ++c) { const v4u g = *(const v4u*)(G1 + (size_t)n * G1W + C_GM + h * 64 + c * 8);
            v4u o;
            o.x = pk2(acc[c * 8 + 0] * inv * siluf_(bflo(g.x)), acc[c * 8 + 1] * inv * siluf_(bfhi(g.x)));
            o.y = pk2(acc[c * 8 + 2] * inv * siluf_(bflo(g.y)), acc[c * 8 + 3] * inv * siluf_(bfhi(g.y)));
            o.z = pk2(acc[c * 8 + 4] * inv * siluf_(bflo(g.z)), acc[c * 8 + 5] * inv * siluf_(bfhi(g.z)));
            o.w = pk2(acc[c * 8 + 6] * inv * siluf_(bflo(g.w)), acc[c * 8 + 7] * inv * siluf_(bfhi(g.w)));
            *(v4u*)(Q + (size_t)n * 768 + h * 96 + c * 8) = o; }
    }
}
namespace pg8 {
#define PG8_LAS __attribute__((address_space(3)))
typedef unsigned short bf16_t;
typedef short bf16x8 __attribute__((ext_vector_type(8)));
typedef float f32x4 __attribute__((ext_vector_type(4)));
typedef unsigned u32x4 __attribute__((ext_vector_type(4)));
constexpr int BM = 256, BK = 64, HALF = 128, HTB = HALF * BK * 2  , STAGE_BYTES = 8 * HTB, NXCD = 8, WGM = 8;

__host__ __device__ __forceinline__ int lds_byte(int r, int c) { const int st = (r >> 4) * 2 + (c >> 5), rr = r & 15, cc = c & 31, ob = rr * 64 + cc * 2; return st * 1024 + (ob ^ (((ob >> 9) & 1) << 5)); }
__host__ __device__ __forceinline__ void stage_rc(int b, int& R, int& C) { const int st = b / 1024, sb = b % 1024, swz = sb ^ (((sb >> 9) & 1) << 5); R = (st >> 1) * 16 + swz / 64; C = (st & 1) * 32 + (swz % 64) / 2; }
__host__ __device__ __forceinline__ int perm32(int rho) { const int n = rho >> 4, i = rho & 15; return 8 * (i >> 2) + 4 * n + (i & 3); }

struct Unit { int pm, pn, gid; };
struct Gemm { const bf16_t* A; const bf16_t* Bt; int M, N, K, lda, ldb; };

struct StaticOrder {
    int nM, nN, nwg, G, c;
    __host__ __device__ void init(int M, int N, int G_, int c_) { nM = M / BM; nN = N / BM; nwg = nM * nN; G = G_; c = c_; }
    __host__ __device__ bool next(int i, Unit& u) const {
        const long L = (long)i * G + c; if (L >= nwg) return false;
        int wgid = (int)L; { const int q = nwg / NXCD, r = nwg % NXCD, xcd = wgid % NXCD, off = wgid / NXCD; wgid = (xcd < r ? xcd * (q + 1) : r * (q + 1) + (xcd - r) * q) + off; }
        const int nig = WGM * nN, gid = wgid / nig, fm = gid * WGM, gsz = (nM - fm) < WGM ? (nM - fm) : WGM;
        u.pm = fm + ((wgid % nig) % gsz); u.pn = (wgid % nig) / gsz; u.gid = 0; return true;
    }
    __device__ __forceinline__ const char* abase(const Gemm& g, const Unit& u) const { return (const char*)g.A + (size_t)u.pm * BM * g.lda * 2; }
    __device__ __forceinline__ const char* bbase(const Gemm& g, const Unit& u) const { return (const char*)g.Bt + (size_t)u.pn * BM * g.ldb * 2; }
    __device__ __forceinline__ void a_ready(const Unit&) const {}
    __device__ __forceinline__ void done(const Unit&) const {}
};
__device__ __forceinline__ unsigned cvt_pk_bf16(float lo, float hi) { unsigned r; asm volatile("v_cvt_pk_bf16_f32 %0, %1, %2" : "=v"(r) : "v"(lo), "v"(hi)); return r; }

template <class Epi, class Sched, bool STAMP = false>
__device__ __forceinline__ void gemm_phase(PG8_LAS unsigned char* lds, const Gemm g, const Sched& S, const Epi& E, unsigned long long* stamps) {
    const int tid = tid_(), wid = __builtin_amdgcn_readfirstlane(tid >> 6), lane = tid & 63, wr = wid >> 2, wc = wid & 3, fr = lane & 15, fq = lane >> 4;
    const int K = g.K, nt = K / BK;
    int ts_lo = 0, ts_hi = 0, nts = 0; const unsigned long long rt_entry = STAMP ? (unsigned long long)wall_clock64() : 0ull;
#define PG8_STAMP() do { if (STAMP && wid == 0 && nts < 64) { const unsigned long long _c = (unsigned long long)clock64(); \
        ts_lo = (lane == nts) ? (int)(unsigned)_c : ts_lo; ts_hi = (lane == nts) ? (int)(unsigned)(_c >> 32) : ts_hi; ++nts; } } while (0)
    PG8_STAMP();
    unsigned voffA[2], voffB[2];
#pragma unroll
    for (int i = 0; i < 2; ++i) { int R, C; stage_rc(tid * 16 + i * 8192, R, C); const int Rb = Epi::PERM ? ((R & ~31) + perm32(R & 31)) : R;
        voffA[i] = (unsigned)(R * g.lda + C) * 2u; voffB[i] = (unsigned)(Rb * g.ldb + C) * 2u; }
    const size_t kstep = (size_t)(BK * 2);
    const size_t hstepA = (size_t)HALF * g.lda * 2, hstepB = (size_t)HALF * g.ldb * 2;
    const unsigned ldsw = (unsigned)wid * 1024u;
    const int aoff = lds_byte(wr * 64 + fr, fq * 8), boff = lds_byte(wc * 32 + fr, fq * 8);
#define PG8_SA(b, h) (((b) * 2 + (h)) * HTB)
#define PG8_SB(b, h) ((4 + (b) * 2 + (h)) * HTB)
#define PG8_STAGE(bufoff, gbase, voff) do { _Pragma("unroll") for (int _i = 0; _i < 2; ++_i) \
        __builtin_amdgcn_global_load_lds((const unsigned*)((const char*)(gbase) + (voff)[_i]), (PG8_LAS unsigned*)(lds + (bufoff) + ldsw + _i * 8192), 16, 0, 0); } while (0)
#define PG8_LDA(dst, b, h) do { _Pragma("unroll") for (int m = 0; m < 4; ++m) _Pragma("unroll") for (int k = 0; k < 2; ++k) dst[m][k] = *(const PG8_LAS bf16x8*)(lds + PG8_SA(b, h) + aoff + m * 2048 + k * 1024); } while (0)
#define PG8_LDB(dst, b, h) do { _Pragma("unroll") for (int n = 0; n < 2; ++n) _Pragma("unroll") for (int k = 0; k < 2; ++k) dst[n][k] = *(const PG8_LAS bf16x8*)(lds + PG8_SB(b, h) + boff + n * 2048 + k * 1024); } while (0)
#define PG8_MMA(ai, bj, At, Bt) do { __builtin_amdgcn_s_setprio(1); _Pragma("unroll") for (int m = 0; m < 4; ++m) _Pragma("unroll") for (int n = 0; n < 2; ++n) _Pragma("unroll") for (int k = 0; k < 2; ++k) \
        acc[ai][bj][m][n] = __builtin_amdgcn_mfma_f32_16x16x32_bf16(Bt[n][k], At[m][k], acc[ai][bj][m][n], 0, 0, 0); __builtin_amdgcn_s_setprio(0); } while (0)
#define PG8_WAIT_V(n) asm volatile("s_waitcnt vmcnt(" #n ")" ::: "memory")
#define PG8_WAIT_L(n) asm volatile("s_waitcnt lgkmcnt(" #n ")" ::: "memory")
#define PG8_BAR __builtin_amdgcn_s_barrier()
#define PG8_SCHED __builtin_amdgcn_sched_barrier(0)
    Unit cur, nxt; int ui = 0;
    if (!S.next(0, cur)) return;
    f32x4 acc[2][2][4][2];
#pragma unroll
    for (int a = 0; a < 2; ++a)
#pragma unroll
        for (int b = 0; b < 2; ++b)
#pragma unroll
            for (int m = 0; m < 4; ++m)
#pragma unroll
                for (int n = 0; n < 2; ++n) acc[a][b][m][n] = (f32x4){0.f, 0.f, 0.f, 0.f};
    bf16x8 At[4][2], B0[2][2], B1[2][2];
    const char* cA = S.abase(g, cur); const char* cB = S.bbase(g, cur);
    S.a_ready(cur);
    PG8_STAGE(PG8_SB(0, 0), cB, voffB); PG8_STAGE(PG8_SA(0, 0), cA, voffA); PG8_STAGE(PG8_SB(0, 1), cB + hstepB, voffB); PG8_STAGE(PG8_SA(0, 1), cA + hstepA, voffA);
    if (wr == 1) PG8_BAR;
    PG8_WAIT_V(4); PG8_BAR;
    PG8_STAGE(PG8_SB(1, 0), cB + kstep, voffB); PG8_STAGE(PG8_SA(1, 0), cA + kstep, voffA); PG8_STAGE(PG8_SB(1, 1), cB + hstepB + kstep, voffB);
    PG8_WAIT_V(6); PG8_BAR;
    PG8_STAMP();
    for (;;) {
        const bool has_next = S.next(ui + 1, nxt);
        const char* nA = has_next ? S.abase(g, nxt) : cA; const char* nB = has_next ? S.bbase(g, nxt) : cB;
        for (int t = 0; t < nt; t += 2) {
            const bool last = (t == nt - 2);
            const char* a1 = cA + (size_t)(t + 1) * kstep;
            const char* a2 = last ? nA : cA + (size_t)(t + 2) * kstep; const char* b2 = last ? nB : cB + (size_t)(t + 2) * kstep;
            const char* a3 = a2 + kstep; const char* b3 = b2 + kstep;
            if (last && has_next) S.a_ready(nxt);
            PG8_LDB(B0, 0, 0); PG8_SCHED; PG8_LDA(At, 0, 0); PG8_STAGE(PG8_SA(1, 1), a1 + hstepA, voffA);
            PG8_WAIT_L(8); PG8_BAR; PG8_WAIT_L(0); PG8_MMA(0, 0, At, B0); PG8_BAR; PG8_SCHED;
            PG8_LDB(B1, 0, 1); PG8_STAGE(PG8_SB(0, 0), b2, voffB);
            PG8_BAR; PG8_WAIT_L(0); PG8_MMA(0, 1, At, B1); PG8_BAR;
            PG8_LDA(At, 0, 1); PG8_STAGE(PG8_SA(0, 0), a2, voffA);
            PG8_BAR; PG8_WAIT_L(0); PG8_MMA(1, 0, At, B0); PG8_BAR; PG8_SCHED;
            PG8_STAGE(PG8_SB(0, 1), b2 + hstepB, voffB);
            PG8_WAIT_V(6); PG8_BAR; PG8_MMA(1, 1, At, B1); PG8_BAR;
            PG8_LDB(B0, 1, 0); PG8_SCHED; PG8_LDA(At, 1, 0); PG8_STAGE(PG8_SA(0, 1), a2 + hstepA, voffA);
            PG8_WAIT_L(8); PG8_BAR; PG8_WAIT_L(0); PG8_MMA(0, 0, At, B0); PG8_BAR; PG8_SCHED;
            PG8_LDB(B1, 1, 1); PG8_STAGE(PG8_SB(1, 0), b3, voffB);
            PG8_BAR; PG8_WAIT_L(0); PG8_MMA(0, 1, At, B1); PG8_BAR;
            PG8_LDA(At, 1, 1); PG8_STAGE(PG8_SA(1, 0), a3, voffA);
            PG8_BAR; PG8_WAIT_L(0); PG8_MMA(1, 0, At, B0); PG8_BAR; PG8_SCHED;
            PG8_STAGE(PG8_SB(1, 1), b3 + hstepB, voffB);
            PG8_WAIT_V(6); PG8_BAR; PG8_MMA(1, 1, At, B1); PG8_BAR;
        }
        PG8_STAMP();
        if constexpr (!Epi::AFTER_DRAIN) { E(acc, cur, wr, wc, fr, fq); S.done(cur); }
        PG8_STAMP();
        if (!has_next) break;
#pragma unroll
        for (int a = 0; a < 2; ++a)
#pragma unroll
            for (int b = 0; b < 2; ++b)
#pragma unroll
                for (int m = 0; m < 4; ++m)
#pragma unroll
                    for (int n = 0; n < 2; ++n) acc[a][b][m][n] = (f32x4){0.f, 0.f, 0.f, 0.f};
        cur = nxt; cA = nA; cB = nB; ++ui;
    }
    PG8_WAIT_V(0);
    if (wr == 0) PG8_BAR;
    PG8_BAR;
    if constexpr (Epi::AFTER_DRAIN) { E.fused(acc, cur, wr, wc, fr, fq, lds, wid, lane); S.done(cur); }
    PG8_STAMP();
    if (STAMP && wid == 0) { stamps[lane] = lane < nts ? (((unsigned long long)(unsigned)ts_hi << 32) | (unsigned)ts_lo) : 0ull;
        if (lane == 62) stamps[62] = rt_entry; if (lane == 63) stamps[63] = (unsigned long long)wall_clock64(); }
#undef PG8_STAMP
#undef PG8_SA
#undef PG8_SB
#undef PG8_STAGE
#undef PG8_LDA
#undef PG8_LDB
#undef PG8_MMA
#undef PG8_WAIT_V
#undef PG8_WAIT_L
#undef PG8_BAR
#undef PG8_SCHED
}
}
namespace pg8 {
struct EpiIn {
    static constexpr bool PERM = true, AFTER_DRAIN = false;
    bf16_t* G1; bf16_t* G2;
    __device__ __forceinline__ void operator()(const f32x4 (&acc)[2][2][4][2], const Unit& u, int wr, int wc, int fr, int fq) const {
        const int row0 = u.pm * BM + wr * 64 + fr;
        bf16_t* base; int ldc, colt;
        if (u.pn < 9) { base = G1; ldc = 2304; colt = u.pn * 256; } else { base = G2; ldc = 512; colt = (u.pn - 9) * 256; }
        const int col0 = colt + wc * 32 + 8 * fq;
#pragma unroll
        for (int ai = 0; ai < 2; ++ai)
#pragma unroll
            for (int m = 0; m < 4; ++m) { bf16_t* rowp = base + (size_t)(row0 + ai * HALF + m * 16) * ldc + col0;
#pragma unroll
                for (int bj = 0; bj < 2; ++bj) { const f32x4 v0 = acc[ai][bj][m][0], v1 = acc[ai][bj][m][1];
                    u32x4 w; w.x = cvt_pk_bf16(v0[0], v0[1]); w.y = cvt_pk_bf16(v0[2], v0[3]); w.z = cvt_pk_bf16(v1[0], v1[1]); w.w = cvt_pk_bf16(v1[2], v1[3]);
                    *(u32x4*)(rowp + bj * HALF) = w; } }
    }
};
struct EpiOut {
    static constexpr bool PERM = false, AFTER_DRAIN = false;
    const float* xp; const float* xs; const float* xo; float* out; const float* mod; int layer;
    const float* stats; const float* lng; const float* lnb;
    __device__ __forceinline__ void operator()(const f32x4 (&acc)[2][2][4][2], const Unit& u, int wr, int wc, int fr, int fq) const {
        const int row0 = u.pm * BM + wr * 64 + fr, col0 = u.pn * BM + wc * 32 + 4 * fq;
        const int rt = u.pm * BM; const int modrow = rt < 8192 ? 0 : 1 + ((rt - 8192) >> 11);
        const float* gp = mod + (size_t)modrow * 3072 + 2048 + col0;
        f32x4 gv[2][2];
#pragma unroll
        for (int bj = 0; bj < 2; ++bj)
#pragma unroll
            for (int n = 0; n < 2; ++n) gv[bj][n] = *(const f32x4*)(gp + bj * HALF + n * 16);
#pragma unroll
        for (int ai = 0; ai < 2; ++ai)
#pragma unroll
            for (int m = 0; m < 4; ++m) { const int row = row0 + ai * HALF + m * 16;
                const float* xr = (layer == 0 ? (row < 8192 ? xp + (size_t)row * 1024 : xs + (size_t)(row - 8192) * 1024) : xo + (size_t)row * 1024) + col0;
                float* orow = out + (size_t)row * 1024 + col0;
                float mean = 0.f, rstd = 1.f; if (layer) { mean = stats[(size_t)row * 2]; rstd = stats[(size_t)row * 2 + 1]; }
#pragma unroll
                for (int bj = 0; bj < 2; ++bj)
#pragma unroll
                    for (int n = 0; n < 2; ++n) { f32x4 x = *(const f32x4*)(xr + bj * HALF + n * 16);
                        if (layer) x = (x - mean) * rstd * *(const f32x4*)(lng + col0 + bj * HALF + n * 16) + *(const f32x4*)(lnb + col0 + bj * HALF + n * 16);
                        *(f32x4*)(orow + bj * HALF + n * 16) = x * 1.4142135623730951f + gv[bj][n] * acc[ai][bj][m][n]; } }
    }
};
}

__device__ __forceinline__ void phase_a1_pg8(ArgsP a, LAS unsigned char* lds, int layer) {
    pg8::Gemm g{(const bf16*)(a->ws + WS_U), (const bf16*)(a->ws + WS_WIN) + (size_t)layer * NIN * 1024, T, NIN, 1024, 1024, 1024};
    pg8::StaticOrder S; S.init(T, NIN, grid_(), bid_());
    pg8::EpiIn E{(bf16*)(a->ws + WS_G1), (bf16*)(a->ws + WS_G2)};
    pg8::gemm_phase<pg8::EpiIn, pg8::StaticOrder, false>(lds, g, S, E, nullptr);
}
__device__ __forceinline__ void phase_c2_pg8(ArgsP a, LAS unsigned char* lds, int layer) {
    pg8::Gemm g{(const bf16*)(a->ws + WS_YMIX), (const bf16*)(a->ws + WS_WOUT) + (size_t)layer * 1024 * 1024, T, 1024, 1024, 1024, 1024};
    pg8::StaticOrder S; S.init(T, 1024, grid_(), bid_());
    pg8::EpiOut E{a->in[I_XP], a->in[I_XS], a->out, a->out, (const float*)(a->ws + WS_MOD) + (size_t)layer * 9 * 3072, layer, (const float*)(a->ws + WS_STATS), a->in[I_LNG], a->in[I_LNB]};
    pg8::gemm_phase<pg8::EpiOut, pg8::StaticOrder, false>(lds, g, S, E, nullptr);
}

__device__ __forceinline__ void phase_a2a(ArgsP a, int layer) {
    const int tid = tid_(), lane = tid & 63, wave = tid >> 6, G = grid_();
    bf16* G2 = (bf16*)(a->ws + WS_G2); bf16* KR = (bf16*)(a->ws + WS_KR); bf16* CK = (bf16*)(a->ws + WS_HF);
    const float* ROPE = (const float*)(a->ws + WS_ROPE);
    f32x4 nw0 = {0.f, 0.f, 0.f, 0.f}, nw1 = {0.f, 0.f, 0.f, 0.f};
    if (lane < 32) { nw0 = *(const f32x4*)(a->in[I_QNORM] + layer * 256 + lane * 8); nw1 = *(const f32x4*)(a->in[I_QNORM] + layer * 256 + lane * 8 + 4); }
    else if (lane < 48) { nw0 = *(const f32x4*)(a->in[I_KVNORM] + layer * 128 + (lane - 32) * 8); nw1 = *(const f32x4*)(a->in[I_KVNORM] + layer * 128 + (lane - 32) * 8 + 4); }
    v4u nx = {0u, 0u, 0u, 0u};
    { const int n0 = bid_() * 8 + wave; if (n0 < T) nx = *(const v4u*)(G2 + (size_t)n0 * G2W + lane * 8); }
    for (int n = bid_() * 8 + wave; n < T; n += G * 8) {
        const v4u w = nx;
        if (n + G * 8 < T) nx = *(const v4u*)(G2 + (size_t)(n + G * 8) * G2W + lane * 8);
        const Tok tk = tok_of(n);
        float x[8] = {bflo(w.x), bfhi(w.x), bflo(w.y), bfhi(w.y), bflo(w.z), bfhi(w.z), bflo(w.w), bfhi(w.w)};
        const float ss = (x[0] * x[0] + x[1] * x[1]) + (x[2] * x[2] + x[3] * x[3]) + (x[4] * x[4] + x[5] * x[5]) + (x[6] * x[6] + x[7] * x[7]);
        const float sq = wave_sum(lane < 32 ? ss : 0.f), sk = wave_sum((lane >= 32 && lane < 48) ? ss : 0.f);
        const float rs = lane < 32 ? rsqrt_(sq * (1.f / 256.f) + 1e-6f) : rsqrt_(sk * (1.f / 128.f) + 1e-6f);
        if (lane < 48) {
            const float y0 = x[0] * rs * nw0.x, y1 = x[1] * rs * nw0.y, y2 = x[2] * rs * nw0.z, y3 = x[3] * rs * nw0.w, y4 = x[4] * rs * nw1.x, y5 = x[5] * rs * nw1.y, y6 = x[6] * rs * nw1.z, y7 = x[7] * rs * nw1.w;
            *(v4u*)(G2 + (size_t)n * G2W + lane * 8) = (v4u){cvtpk(y0, y1), cvtpk(y2, y3), cvtpk(y4, y5), cvtpk(y6, y7)};
            if (lane >= 32 && !tk.lat) { float* op = a->out + O_CKV + ((size_t)(tk.b * 2 + layer) * 256 + tk.t) * 128 + (lane - 32) * 8;
                *(f32x4*)op = (f32x4){y0, y1, y2, y3}; *(f32x4*)(op + 4) = (f32x4){y4, y5, y6, y7}; }
        } else if (lane < 52) {
            const int d0 = (lane - 48) * 8;
            if (!tk.lat) { float* op = a->out + O_KR + ((size_t)(tk.b * 2 + layer) * 256 + tk.t) * 32 + d0;
                *(f32x4*)op = (f32x4){x[0], x[1], x[2], x[3]}; *(f32x4*)(op + 4) = (f32x4){x[4], x[5], x[6], x[7]};
                *(v4u*)(KR + (size_t)tk.kidx * 32 + d0) = w; }
            else { const f32x4 c0 = *(const f32x4*)(ROPE + ((size_t)tk.t * 16 + (d0 >> 1)) * 2), c1 = *(const f32x4*)(ROPE + ((size_t)tk.t * 16 + (d0 >> 1) + 2) * 2);
                const float y0 = x[0] * c0.x - x[1] * c0.y, y1 = x[0] * c0.y + x[1] * c0.x, y2 = x[2] * c0.z - x[3] * c0.w, y3 = x[2] * c0.w + x[3] * c0.z;
                const float y4 = x[4] * c1.x - x[5] * c1.y, y5 = x[4] * c1.y + x[5] * c1.x, y6 = x[6] * c1.z - x[7] * c1.w, y7 = x[6] * c1.w + x[7] * c1.z;
                *(v4u*)(KR + (size_t)tk.kidx * 32 + d0) = (v4u){cvtpk(y0, y1), cvtpk(y2, y3), cvtpk(y4, y5), cvtpk(y6, y7)}; }
        }
    }
    for (int r = bid_() * 8 + wave; r < 2048; r += G * 8) {
        const int b = r >> 8, j = r & 255; const size_t src = (size_t)(b * 2 + layer) * 256 + j;
        if (lane < 16) { const f32x4 v0 = *(const f32x4*)(a->in[I_CCKV] + src * 128 + lane * 8), v1 = *(const f32x4*)(a->in[I_CCKV] + src * 128 + lane * 8 + 4);
            *(v4u*)(CK + (size_t)r * 512 + lane * 8) = (v4u){cvtpk(v0.x, v0.y), cvtpk(v0.z, v0.w), cvtpk(v1.x, v1.y), cvtpk(v1.z, v1.w)}; }
        else if (lane < 32) *(v4u*)(CK + (size_t)r * 512 + lane * 8) = (v4u){0u, 0u, 0u, 0u};
        else if (lane < 36) { const f32x4 v0 = *(const f32x4*)(a->in[I_CKR] + src * 32 + (lane - 32) * 8), v1 = *(const f32x4*)(a->in[I_CKR] + src * 32 + (lane - 32) * 8 + 4);
            *(v4u*)(KR + (size_t)(T_CTX + b * LK_LAT + j) * 32 + (lane - 32) * 8) = (v4u){cvtpk(v0.x, v0.y), cvtpk(v0.z, v0.w), cvtpk(v1.x, v1.y), cvtpk(v1.z, v1.w)}; }
    }
}
namespace pg8 {
struct A2OrderQ {
    const char* g2; const char* wuq; int G, c;
    __device__ __forceinline__ bool next(int i, Unit& u) const { const int L = i * G + c; if (L >= 288) return false; u.gid = 0; u.pm = L / 3; u.pn = L % 3; return true; }
    __device__ __forceinline__ const char* abase(const Gemm&, const Unit& u) const { return g2 + (size_t)u.pm * 256 * 512 * 2; }
    __device__ __forceinline__ const char* bbase(const Gemm&, const Unit& u) const { return wuq + (size_t)u.pn * 256 * 256 * 2; }
    __device__ __forceinline__ void a_ready(const Unit&) const {}
    __device__ __forceinline__ void done(const Unit&) const {}
};
struct A2OrderKV {
    const char* g2; const char* ck; const char* wukv; int G, c;
    __device__ __forceinline__ bool next(int i, Unit& u) const { const int L = i * G + c; if (L >= 416) return false; u.gid = L < 384 ? 1 : 2; const int li = L < 384 ? L : L - 384; u.pm = li >> 2; u.pn = li & 3; return true; }
    __device__ __forceinline__ const char* abase(const Gemm&, const Unit& u) const { return (u.gid == 2 ? ck : g2 + 512) + (size_t)u.pm * 256 * 512 * 2; }
    __device__ __forceinline__ const char* bbase(const Gemm&, const Unit& u) const { return wukv + (size_t)u.pn * 256 * 256 * 2; }
    __device__ __forceinline__ void a_ready(const Unit&) const {}
    __device__ __forceinline__ void done(const Unit&) const {}
};
template <int WHICH> struct EpiA2 {
    static constexpr bool PERM = true, AFTER_DRAIN = false;
    bf16_t* Q; bf16_t* KN; bf16_t* VR; const float* rope;
    __device__ __forceinline__ void operator()(const f32x4 (&acc)[2][2][4][2], const Unit& u, int wr, int wc, int fr, int fq) const {
        const int row0 = u.pm * BM + wr * 64 + fr;
        if (WHICH == 0) {
            const int fb = u.pn * 256 + wc * 32 + 8 * fq;
#pragma unroll
            for (int ai = 0; ai < 2; ++ai)
#pragma unroll
                for (int m = 0; m < 4; ++m) { const int row = row0 + ai * HALF + m * 16;
                    const float* rp = rope + (unsigned)(((row - 8192) & 2047) * 32);
#pragma unroll
                    for (int bj = 0; bj < 2; ++bj) {
                        f32x4 v0 = acc[ai][bj][m][0], v1 = acc[ai][bj][m][1];
                        const int f0 = fb + bj * HALF, d = f0 % 96;
                        if (row >= 8192 && d >= 64) { const f32x4 c0 = *(const f32x4*)(rp + (d - 64)), c1 = *(const f32x4*)(rp + (d - 64) + 4);
                            const f32x4 a0 = v0, a1 = v1;
                            v0[0] = a0[0] * c0[0] - a0[1] * c0[1]; v0[1] = a0[0] * c0[1] + a0[1] * c0[0]; v0[2] = a0[2] * c0[2] - a0[3] * c0[3]; v0[3] = a0[2] * c0[3] + a0[3] * c0[2];
                            v1[0] = a1[0] * c1[0] - a1[1] * c1[1]; v1[1] = a1[0] * c1[1] + a1[1] * c1[0]; v1[2] = a1[2] * c1[2] - a1[3] * c1[3]; v1[3] = a1[2] * c1[3] + a1[3] * c1[2]; }
                        u32x4 w; w.x = cvt_pk_bf16(v0[0], v0[1]); w.y = cvt_pk_bf16(v0[2], v0[3]); w.z = cvt_pk_bf16(v1[0], v1[1]); w.w = cvt_pk_bf16(v1[2], v1[3]);
                        *(u32x4*)(Q + (unsigned)(row * 768 + f0)) = w; } }
        } else {
            const int x = wc * 32 + 8 * fq;
            bf16_t* base = (wc < 2 ? KN : VR);
            const unsigned xo = (unsigned)(x & 63);
#pragma unroll
            for (int ai = 0; ai < 2; ++ai)
#pragma unroll
                for (int m = 0; m < 4; ++m) { const int row = row0 + ai * HALF + m * 16;
                    int kidx;
                    if (u.gid == 2) kidx = 8192 + (row >> 8) * 2304 + (row & 255);
                    else if (row < 8192) kidx = row;
                    else { const int mrow = row - 8192; kidx = 8192 + (mrow >> 11) * 2304 + 256 + (mrow & 2047); }
#pragma unroll
                    for (int bj = 0; bj < 2; ++bj) { const f32x4 v0 = acc[ai][bj][m][0], v1 = acc[ai][bj][m][1];
                        u32x4 w; w.x = cvt_pk_bf16(v0[0], v0[1]); w.y = cvt_pk_bf16(v0[2], v0[3]); w.z = cvt_pk_bf16(v1[0], v1[1]); w.w = cvt_pk_bf16(v1[2], v1[3]);
                        *(u32x4*)(base + (unsigned)(kidx * 512 + (u.pn * 2 + bj) * 64) + xo) = w; } }
        }
    }
};
}
__device__ __forceinline__ void phase_a2b(ArgsP a, LAS unsigned char* lds, int layer) {
    int kk = 256; asm volatile("" : "+s"(kk));
    pg8::Gemm g{nullptr, nullptr, T, 1024, kk, 512, 256};
    {
        pg8::A2OrderQ S{(const char*)(a->ws + WS_G2), (const char*)((const bf16*)(a->ws + WS_WUQ) + (size_t)layer * 768 * 256), grid_(), bid_()};
        pg8::EpiA2<0> E{(bf16*)(a->ws + WS_Q), nullptr, nullptr, (const float*)(a->ws + WS_ROPE)};
        pg8::gemm_phase<pg8::EpiA2<0>, pg8::A2OrderQ, false>(lds, g, S, E, nullptr);
    }
    {
        pg8::A2OrderKV S{(const char*)(a->ws + WS_G2), (const char*)(a->ws + WS_HF), (const char*)((const bf16*)(a->ws + WS_WUKV) + (size_t)layer * 1024 * 256), grid_(), bid_()};
        pg8::EpiA2<1> E{nullptr, (bf16*)(a->ws + WS_KN), (bf16*)(a->ws + WS_VT), nullptr};
        pg8::gemm_phase<pg8::EpiA2<1>, pg8::A2OrderKV, false>(lds, g, S, E, nullptr);
    }
}
__device__ __forceinline__ void rwkv_unit_seq(ArgsP a, LAS unsigned char* lds, int layer, int u) {
    const int tid = tid_();
    LAS float* W2s = (LAS float*)lds;
    LAS float* A2s = W2s + 4096;
    LAS float* TH = A2s + 4096;
    LAS float* HA = TH + 2048;
    LAS float* Wd = HA + 2048;
    LAS float* KT = Wd + 2048; LAS float* KK = KT + 2048; LAS float* BB = KK + 2048; LAS float* RR = BB + 2048; LAS float* VV = RR + 2048; LAS float* YO = VV + 2048;
    const int lat = u < 64, uu = lat ? u : u - 64, b = uu >> 3, e = (uu >> 2) & 1, hh = uu & 3;
    const int L = lat ? L_LAT : L_CTX, tok0 = lat ? T_CTX + b * L_LAT : b * L_CTX;
    const bf16* G1 = (const bf16*)(a->ws + WS_G1);
    bf16* YS = (bf16*)(a->ws + WS_G2);
    for (int i = tid; i < 4096; i += NTHREADS) { const int j = i >> 6, c = i & 63;
        W2s[i] = a->in[I_W2][((size_t)(layer * 2 + e) * 64 + j) * 256 + hh * 64 + c];
        A2s[i] = a->in[I_A2][((size_t)(layer * 2 + e) * 64 + j) * 256 + hh * 64 + c]; }
    const int r = tid >> 3, ks = tid & 7;
    float S[8];
#pragma unroll
    for (int j = 0; j < 8; ++j) S[j] = lat ? a->in[I_SRW][(((size_t)((b * 2 + layer) * 2 + e) * 4 + hh) * 64 + r) * 64 + ks * 8 + j] : 0.f;
    const int tt = tid >> 4, q4 = (tid & 15) * 4;
    float w0v[4], a0v[4], kkw[4], kav[4];
#pragma unroll
    for (int i = 0; i < 4; ++i) { const int ch = hh * 64 + q4 + i;
        w0v[i] = a->in[I_W0][(layer * 2 + e) * 256 + ch]; a0v[i] = a->in[I_A0][(layer * 2 + e) * 256 + ch]; kkw[i] = a->in[I_KK][layer * 256 + ch]; kav[i] = a->in[I_KA][layer * 256 + ch]; }
    __syncthreads();
    for (int c = 0; c < L / 32; ++c) {
        const int step = c * 32 + tt, t = e ? L - 1 - step : step, n = tok0 + t;
        const bf16* g = G1 + (size_t)n * G1W;
        { const v2u hw = *(const v2u*)(g + C_LORA + e * 64 + q4), ha = *(const v2u*)(g + C_LORA + 128 + e * 64 + q4);
          TH[tt * 64 + q4 + 0] = tanhf(bflo(hw.x)); TH[tt * 64 + q4 + 1] = tanhf(bfhi(hw.x)); TH[tt * 64 + q4 + 2] = tanhf(bflo(hw.y)); TH[tt * 64 + q4 + 3] = tanhf(bfhi(hw.y));
          HA[tt * 64 + q4 + 0] = bflo(ha.x); HA[tt * 64 + q4 + 1] = bfhi(ha.x); HA[tt * 64 + q4 + 2] = bflo(ha.y); HA[tt * 64 + q4 + 3] = bfhi(ha.y); }
        __syncthreads();
        {
            float wl[4], al[4];
#pragma unroll
            for (int i = 0; i < 4; ++i) { wl[i] = w0v[i]; al[i] = a0v[i]; }
            for (int j = 0; j < 64; ++j) { const float th = TH[tt * 64 + j], hv = HA[tt * 64 + j];
                const f32x4 w2 = *(const LAS f32x4*)(W2s + j * 64 + q4), a2 = *(const LAS f32x4*)(A2s + j * 64 + q4);
                wl[0] = fmaf(th, w2.x, wl[0]); wl[1] = fmaf(th, w2.y, wl[1]); wl[2] = fmaf(th, w2.z, wl[2]); wl[3] = fmaf(th, w2.w, wl[3]);
                al[0] = fmaf(hv, a2.x, al[0]); al[1] = fmaf(hv, a2.y, al[1]); al[2] = fmaf(hv, a2.z, al[2]); al[3] = fmaf(hv, a2.w, al[3]); }
            const v2u kv = *(const v2u*)(g + C_K + hh * 64 + q4), rv = *(const v2u*)(g + C_R + hh * 64 + q4), vv = *(const v2u*)(g + C_V + hh * 64 + q4);
            const float kx[4] = {bflo(kv.x), bfhi(kv.x), bflo(kv.y), bfhi(kv.y)}, rx[4] = {bflo(rv.x), bfhi(rv.x), bflo(rv.y), bfhi(rv.y)}, vx[4] = {bflo(vv.x), bfhi(vv.x), bflo(vv.y), bfhi(vv.y)};
            float kkr[4], ss = 0.f;
#pragma unroll
            for (int i = 0; i < 4; ++i) { kkr[i] = kx[i] * kkw[i]; ss += kkr[i] * kkr[i]; }
            ss += __shfl_xor(ss, 1); ss += __shfl_xor(ss, 2); ss += __shfl_xor(ss, 4); ss += __shfl_xor(ss, 8);
            const float inrm = rcp_(fmaxf(sqrt_(ss), 1e-12f));
#pragma unroll
            for (int i = 0; i < 4; ++i) {
                const float dec = exp_(-0.6065306597126334f * sigmoidf_(wl[i])), av = sigmoidf_(al[i]), kk = kkr[i] * inrm;
                const int o = tt * 64 + q4 + i;
                Wd[o] = dec; KT[o] = kx[i] * (1.f + (av - 1.f) * kav[i]); KK[o] = kk; BB[o] = kk * av; RR[o] = rx[i]; VV[o] = vx[i]; }
        }
        __syncthreads();
        for (int s = 0; s < 32; ++s) {
            const int o = s * 64 + ks * 8;
            const f32x4 k0 = *(const LAS f32x4*)(KK + o), k1 = *(const LAS f32x4*)(KK + o + 4);
            float p = S[0] * k0.x + S[1] * k0.y + S[2] * k0.z + S[3] * k0.w + S[4] * k1.x + S[5] * k1.y + S[6] * k1.z + S[7] * k1.w;
            p += __shfl_xor(p, 1); p += __shfl_xor(p, 2); p += __shfl_xor(p, 4);
            const float sa = -p, vv = VV[s * 64 + r];
            const f32x4 w0 = *(const LAS f32x4*)(Wd + o), w1 = *(const LAS f32x4*)(Wd + o + 4), b0 = *(const LAS f32x4*)(BB + o), b1 = *(const LAS f32x4*)(BB + o + 4);
            const f32x4 t0 = *(const LAS f32x4*)(KT + o), t1 = *(const LAS f32x4*)(KT + o + 4), r0 = *(const LAS f32x4*)(RR + o), r1 = *(const LAS f32x4*)(RR + o + 4);
            S[0] = S[0] * w0.x + sa * b0.x + vv * t0.x; S[1] = S[1] * w0.y + sa * b0.y + vv * t0.y; S[2] = S[2] * w0.z + sa * b0.z + vv * t0.z; S[3] = S[3] * w0.w + sa * b0.w + vv * t0.w;
            S[4] = S[4] * w1.x + sa * b1.x + vv * t1.x; S[5] = S[5] * w1.y + sa * b1.y + vv * t1.y; S[6] = S[6] * w1.z + sa * b1.z + vv * t1.z; S[7] = S[7] * w1.w + sa * b1.w + vv * t1.w;
            float y = S[0] * r0.x + S[1] * r0.y + S[2] * r0.z + S[3] * r0.w + S[4] * r1.x + S[5] * r1.y + S[6] * r1.z + S[7] * r1.w;
            y += __shfl_xor(y, 1); y += __shfl_xor(y, 2); y += __shfl_xor(y, 4);
            if (ks == 0) YO[s * 64 + r] = y;
        }
        __syncthreads();
        { v2u o; o.x = pk2(YO[tt * 64 + q4], YO[tt * 64 + q4 + 1]); o.y = pk2(YO[tt * 64 + q4 + 2], YO[tt * 64 + q4 + 3]);
          *(v2u*)(YS + ((size_t)e * T + n) * 256 + hh * 64 + q4) = o; }
        __syncthreads();
    }
    if (!lat) {
        float* dst = a->out + O_RW + (((size_t)((b * 2 + layer) * 2 + e) * 4 + hh) * 64 + r) * 64 + ks * 8;
        *(f32x4*)dst = (f32x4){S[0], S[1], S[2], S[3]}; *(f32x4*)(dst + 4) = (f32x4){S[4], S[5], S[6], S[7]};
    }
}

__device__ __forceinline__ void lru_unit_seq(ArgsP a, LAS unsigned char* lds, int layer, int u) {
    const int tid = tid_();
    LAS float* WA = (LAS float*)lds;
    LAS float* WX = WA + 4096;
    LAS float* XC = WX + 4096;
    LAS float* AA = XC + 4096; LAS float* BV = AA + 4096; LAS float* HH = BV + 4096;
    const int lat = u < 32, uu = lat ? u : u - 32, b = uu >> 2, g = uu & 3;
    const int L = lat ? L_LAT : L_CTX, tok0 = lat ? T_CTX + b * L_LAT : b * L_CTX;
    const bf16* G1 = (const bf16*)(a->ws + WS_G1);
    bf16* HF = (bf16*)(a->ws + WS_HF);
    const int tt = tid >> 3, q8 = (tid & 7) * 8;
    float cw[4][8], cb[8];
#pragma unroll
    for (int i = 0; i < 8; ++i) { const int ch = g * 64 + q8 + i; cb[i] = a->in[I_CONVB][layer * 256 + ch];
#pragma unroll
        for (int j = 0; j < 4; ++j) cw[j][i] = a->in[I_CONVW][(layer * 4 + j) * 256 + ch]; }
    for (int e = 0; e < 2; ++e) {
        __syncthreads();
        for (int i = tid; i < 4096; i += NTHREADS) { const size_t src = ((size_t)((layer * 2 + e) * 4 + g)) * 4096 + i; WA[i] = a->in[I_WA][src]; WX[i] = a->in[I_WX][src]; }
        float bav[8], bxv[8], spl[8];
#pragma unroll
        for (int i = 0; i < 8; ++i) { const int ch = (layer * 2 + e) * 256 + g * 64 + q8 + i; bav[i] = a->in[I_BA][ch]; bxv[i] = a->in[I_BX][ch]; spl[i] = log1pf(exp_(-a->in[I_LAMBDA][ch])); }
        float h = 0.f;
        if (tid < 64 && lat) h = a->in[I_SLRU][((size_t)(b * 2 + layer) * 2 + e) * 256 + g * 64 + tid];
        __syncthreads();
        for (int cc = 0; cc < L / 64; ++cc) {
            const int c = e ? L / 64 - 1 - cc : cc, t = c * 64 + tt, n = tok0 + t;
            {
                float xc[8];
#pragma unroll
                for (int i = 0; i < 8; ++i) xc[i] = cb[i];
#pragma unroll
                for (int j = 0; j < 4; ++j) { const int ts = t + j - 2;
                    if (ts >= 0 && ts < L) { const v4u x = *(const v4u*)(G1 + (size_t)(tok0 + ts) * G1W + C_XL + g * 64 + q8);
                        xc[0] += cw[j][0] * bflo(x.x); xc[1] += cw[j][1] * bfhi(x.x); xc[2] += cw[j][2] * bflo(x.y); xc[3] += cw[j][3] * bfhi(x.y);
                        xc[4] += cw[j][4] * bflo(x.z); xc[5] += cw[j][5] * bfhi(x.z); xc[6] += cw[j][6] * bflo(x.w); xc[7] += cw[j][7] * bfhi(x.w); } }
#pragma unroll
                for (int i = 0; i < 8; ++i) XC[tt * 64 + q8 + i] = xc[i];
            }
            __syncthreads();
            {
                float gr[8], gi[8];
#pragma unroll
                for (int i = 0; i < 8; ++i) { gr[i] = bav[i]; gi[i] = bxv[i]; }
                for (int i = 0; i < 64; ++i) { const float x = XC[tt * 64 + i];
                    const f32x4 a0 = *(const LAS f32x4*)(WA + i * 64 + q8), a1 = *(const LAS f32x4*)(WA + i * 64 + q8 + 4), x0 = *(const LAS f32x4*)(WX + i * 64 + q8), x1 = *(const LAS f32x4*)(WX + i * 64 + q8 + 4);
                    gr[0] = fmaf(x, a0.x, gr[0]); gr[1] = fmaf(x, a0.y, gr[1]); gr[2] = fmaf(x, a0.z, gr[2]); gr[3] = fmaf(x, a0.w, gr[3]);
                    gr[4] = fmaf(x, a1.x, gr[4]); gr[5] = fmaf(x, a1.y, gr[5]); gr[6] = fmaf(x, a1.z, gr[6]); gr[7] = fmaf(x, a1.w, gr[7]);
                    gi[0] = fmaf(x, x0.x, gi[0]); gi[1] = fmaf(x, x0.y, gi[1]); gi[2] = fmaf(x, x0.z, gi[2]); gi[3] = fmaf(x, x0.w, gi[3]);
                    gi[4] = fmaf(x, x1.x, gi[4]); gi[5] = fmaf(x, x1.y, gi[5]); gi[6] = fmaf(x, x1.z, gi[6]); gi[7] = fmaf(x, x1.w, gi[7]); }
#pragma unroll
                for (int i = 0; i < 8; ++i) { const float la = -8.f * sigmoidf_(gr[i]) * spl[i];
                    AA[tt * 64 + q8 + i] = exp_(la);
                    BV[tt * 64 + q8 + i] = sqrt_(-expm1f(2.f * la)) * sigmoidf_(gi[i]) * XC[tt * 64 + q8 + i]; }
            }
            __syncthreads();
            if (tid < 64) { for (int s = 0; s < 64; ++s) { const int st = e ? 63 - s : s; h = fmaf(AA[st * 64 + tid], h, BV[st * 64 + tid]); HH[st * 64 + tid] = h; } }
            __syncthreads();
            {
                bf16* dst = HF + (size_t)n * 256 + g * 64 + q8;
                float o[8];
#pragma unroll
                for (int i = 0; i < 8; ++i) o[i] = HH[tt * 64 + q8 + i];
                if (e) { const v4u hf = *(const v4u*)dst, gl = *(const v4u*)(G1 + (size_t)n * G1W + C_GL + g * 64 + q8);
                    o[0] = (o[0] + bflo(hf.x)) * siluf_(bflo(gl.x)); o[1] = (o[1] + bfhi(hf.x)) * siluf_(bfhi(gl.x)); o[2] = (o[2] + bflo(hf.y)) * siluf_(bflo(gl.y)); o[3] = (o[3] + bfhi(hf.y)) * siluf_(bfhi(gl.y));
                    o[4] = (o[4] + bflo(hf.z)) * siluf_(bflo(gl.z)); o[5] = (o[5] + bfhi(hf.z)) * siluf_(bfhi(gl.z)); o[6] = (o[6] + bflo(hf.w)) * siluf_(bflo(gl.w)); o[7] = (o[7] + bfhi(hf.w)) * siluf_(bfhi(gl.w)); }
                v4u ov; ov.x = pk2(o[0], o[1]); ov.y = pk2(o[2], o[3]); ov.z = pk2(o[4], o[5]); ov.w = pk2(o[6], o[7]);
                *(v4u*)dst = ov;
            }
            __syncthreads();
        }
        if (tid < 64 && !lat) a->out[O_LRU + ((size_t)(b * 2 + layer) * 2 + e) * 256 + g * 64 + tid] = h;
    }
}

__device__ __forceinline__ void phase_c1(ArgsP a, int layer) {
    const int tid = tid_(), lane = tid & 63, wave = tid >> 6, G = grid_();
    const bf16* G1 = (const bf16*)(a->ws + WS_G1); const bf16* YS = (const bf16*)(a->ws + WS_G2); const bf16* Q = (const bf16*)(a->ws + WS_Q); const bf16* HF = (const bf16*)(a->ws + WS_HF);
    bf16* Y = (bf16*)(a->ws + WS_YMIX);
    const int ch = lane * 4;
    const f32x4 rk = *(const f32x4*)(a->in[I_RK] + layer * 256 + ch), lg = *(const f32x4*)(a->in[I_LNXG] + layer * 256 + ch), lb = *(const f32x4*)(a->in[I_LNXB] + layer * 256 + ch);
    v2u p_y0, p_y1, p_r, p_k, p_v, p_g, p_h; v4u p_q;
#define C1_LOAD(nn) do { const bf16* g_ = G1 + (size_t)(nn) * G1W; p_y0 = *(const v2u*)(YS + (size_t)(nn) * 256 + ch); p_y1 = *(const v2u*)(YS + ((size_t)T + (nn)) * 256 + ch); \
        p_r = *(const v2u*)(g_ + C_R + ch); p_k = *(const v2u*)(g_ + C_K + ch); p_v = *(const v2u*)(g_ + C_V + ch); p_g = *(const v2u*)(g_ + C_G + ch); \
        p_q = *(const v4u*)(Q + (size_t)(nn) * 768 + (lane >> 3) * 96 + (lane & 7) * 8); p_h = *(const v2u*)(HF + (size_t)(nn) * 256 + ch); } while (0)
    { const int n0 = bid_() * 8 + wave; if (n0 < T) C1_LOAD(n0); }
    for (int n = bid_() * 8 + wave; n < T; n += G * 8) {
        const v2u y0 = p_y0, y1 = p_y1, rv = p_r, kv = p_k, vv = p_v, gv = p_g, hq = p_h; const v4u qq = p_q;
        if (n + G * 8 < T) C1_LOAD(n + G * 8);
        float y[4] = {bflo(y0.x) + bflo(y1.x), bfhi(y0.x) + bfhi(y1.x), bflo(y0.y) + bflo(y1.y), bfhi(y0.y) + bfhi(y1.y)};
        float s = (y[0] + y[1]) + (y[2] + y[3]);
        float bon = bflo(rv.x) * bflo(kv.x) * rk.x + bfhi(rv.x) * bfhi(kv.x) * rk.y + bflo(rv.y) * bflo(kv.y) * rk.z + bfhi(rv.y) * bfhi(kv.y) * rk.w;
#pragma unroll
        for (int o = 1; o < 16; o <<= 1) { s += __shfl_xor(s, o); bon += __shfl_xor(bon, o); }
        const float mu = s * (1.f / 64.f);
        float s2 = (y[0] - mu) * (y[0] - mu) + (y[1] - mu) * (y[1] - mu) + (y[2] - mu) * (y[2] - mu) + (y[3] - mu) * (y[3] - mu);
#pragma unroll
        for (int o = 1; o < 16; o <<= 1) s2 += __shfl_xor(s2, o);
        const float rstd = rsqrt_(s2 * (1.f / 64.f) + GN_EPS);
        const float o0 = ((y[0] - mu) * rstd * lg.x + lb.x + bon * bflo(vv.x)) * siluf_(bflo(gv.x));
        const float o1 = ((y[1] - mu) * rstd * lg.y + lb.y + bon * bfhi(vv.x)) * siluf_(bfhi(gv.x));
        const float o2 = ((y[2] - mu) * rstd * lg.z + lb.z + bon * bflo(vv.y)) * siluf_(bflo(gv.y));
        const float o3 = ((y[3] - mu) * rstd * lg.w + lb.w + bon * bfhi(vv.y)) * siluf_(bfhi(gv.y));
        v2u ov; ov.x = pk2(o0, o1); ov.y = pk2(o2, o3);
        bf16* yr = Y + (size_t)n * 1024;
        *(v2u*)(yr + ch) = ov;
        *(v4u*)(yr + 256 + (lane >> 3) * 64 + (lane & 7) * 8) = qq;
        *(v2u*)(yr + 768 + ch) = hq;
    }
#undef C1_LOAD
}
#define MFMA32(a, b, c) __builtin_amdgcn_mfma_f32_32x32x16_bf16((a), (b), (c), 0, 0, 0)
#define MFMA16(a, b, c) __builtin_amdgcn_mfma_f32_16x16x32_bf16((a), (b), (c), 0, 0, 0)

__device__ __forceinline__ float tanh_fast(float x) { return 1.f - 2.f * rcp_(1.f + exp_(2.f * x)); }

constexpr int ATT_KSTR = 208, ATT_VSTR = 136, ATT_VOFF = 64 * ATT_KSTR, ATT_STAGE = 64 * ATT_KSTR + 64 * ATT_VSTR;
__device__ __forceinline__ void att_unit(ArgsP a, LAS unsigned char* lds, int u) {
    const int tid = tid_(), lane = tid & 63, wave = tid >> 6, r = lane & 31, hq = lane >> 5;
    const bf16* KN = (const bf16*)(a->ws + WS_KN); const bf16* KR = (const bf16*)(a->ws + WS_KR); const bf16* VT = (const bf16*)(a->ws + WS_VT);
    bf16* Q = (bf16*)(a->ws + WS_Q); const bf16* G1 = (const bf16*)(a->ws + WS_G1);
    int b, h, n0, Lk, kidx0; size_t vbase;
    if (u < 512) { b = u >> 6; h = (u >> 3) & 7; n0 = T_CTX + b * 2048 + (u & 7) * 256; Lk = LK_LAT; kidx0 = T_CTX + b * LK_LAT; vbase = (size_t)VT_LAT + (size_t)(b * 8 + h) * 64 * LK_LAT; }
    else { const int uu = u - 512; b = uu >> 3; h = uu & 7; n0 = b * 256; Lk = 256; kidx0 = b * 256; vbase = (size_t)(b * 8 + h) * 64 * 256; }
    const int ntiles = Lk >> 6;
    const int n = n0 + wave * 32 + r;
    bf16x8 qf[6];
#pragma unroll
    for (int ks = 0; ks < 6; ++ks) qf[ks] = *(const bf16x8*)(Q + (size_t)n * 768 + h * 96 + ks * 16 + 8 * hq);
    const int key_k = tid >> 3, ck = tid & 7, key_r = (tid >> 2) & 63, cr = tid & 3;
    const bf16* gk = KN + (size_t)(kidx0 + key_k) * 512 + h * 64 + ck * 8;
    const bf16* gr = KR + (size_t)(kidx0 + key_r) * 32 + cr * 8;
    const bf16* gv = VT + vbase + (size_t)key_k * Lk + ck * 8;
    const unsigned sk = key_k * ATT_KSTR + ck * 16, sr = key_r * ATT_KSTR + 128 + cr * 16, sv = ATT_VOFF + key_k * ATT_VSTR + ck * 16;
    v4u rk, rr, rv;
    rk = *(const v4u*)gk; rr = (tid < 256) ? *(const v4u*)gr : (v4u){0u, 0u, 0u, 0u}; rv = *(const v4u*)gv;
    __syncthreads();
    *(LAS v4u*)(lds + sk) = rk; if (tid < 256) *(LAS v4u*)(lds + sr) = rr;
    *(LAS v2u*)(lds + sv) = (v2u){rv.x, rv.y}; *(LAS v2u*)(lds + sv + 8) = (v2u){rv.z, rv.w};
    __syncthreads();
    f32x16 o0, o1;
#pragma unroll
    for (int i = 0; i < 16; ++i) { o0[i] = 0.f; o1[i] = 0.f; }
    float m = -1e30f, l = 0.f;
    for (int j = 0; j < ntiles; ++j) {
        const int buf = j & 1;
        if (j + 1 < ntiles) { rk = *(const v4u*)(gk + (size_t)(j + 1) * 64 * 512); if (tid < 256) rr = *(const v4u*)(gr + (size_t)(j + 1) * 64 * 32); rv = *(const v4u*)(gv + (j + 1) * 64); }
        const LAS unsigned char* Kb = lds + buf * ATT_STAGE;
        f32x16 s0, s1;
#pragma unroll
        for (int i = 0; i < 16; ++i) { s0[i] = 0.f; s1[i] = 0.f; }
#pragma unroll
        for (int ks = 0; ks < 6; ++ks) {
            const bf16x8 a0 = *(const LAS bf16x8*)(Kb + r * ATT_KSTR + ks * 32 + hq * 16), a1 = *(const LAS bf16x8*)(Kb + (32 + r) * ATT_KSTR + ks * 32 + hq * 16);
            s0 = MFMA32(a0, qf[ks], s0); s1 = MFMA32(a1, qf[ks], s1);
        }
        float mx = s0[0];
#pragma unroll
        for (int i = 1; i < 16; ++i) mx = fmaxf(mx, s0[i]);
#pragma unroll
        for (int i = 0; i < 16; ++i) mx = fmaxf(mx, s1[i]);
        mx = fmaxf(mx, __shfl_xor(mx, 32));
        const float mn = fmaxf(m, mx), alpha = __builtin_amdgcn_exp2f(m - mn); m = mn;
        float ps = 0.f;
#pragma unroll
        for (int i = 0; i < 16; ++i) { s0[i] = __builtin_amdgcn_exp2f(s0[i] - mn); s1[i] = __builtin_amdgcn_exp2f(s1[i] - mn); ps += s0[i] + s1[i]; }
        l = l * alpha + ps;
#pragma unroll
        for (int i = 0; i < 16; ++i) { o0[i] *= alpha; o1[i] *= alpha; }
        const LAS unsigned char* Vb = Kb + ATT_VOFF;
#pragma unroll
        for (int ks = 0; ks < 4; ++ks) {
            v4u pw;
            if (ks == 0) { pw.x = cvtpk(s0[0], s0[1]); pw.y = cvtpk(s0[2], s0[3]); pw.z = cvtpk(s0[4], s0[5]); pw.w = cvtpk(s0[6], s0[7]); }
            else if (ks == 1) { pw.x = cvtpk(s0[8], s0[9]); pw.y = cvtpk(s0[10], s0[11]); pw.z = cvtpk(s0[12], s0[13]); pw.w = cvtpk(s0[14], s0[15]); }
            else if (ks == 2) { pw.x = cvtpk(s1[0], s1[1]); pw.y = cvtpk(s1[2], s1[3]); pw.z = cvtpk(s1[4], s1[5]); pw.w = cvtpk(s1[6], s1[7]); }
            else { pw.x = cvtpk(s1[8], s1[9]); pw.y = cvtpk(s1[10], s1[11]); pw.z = cvtpk(s1[12], s1[13]); pw.w = cvtpk(s1[14], s1[15]); }
            const bf16x8 pf = __builtin_bit_cast(bf16x8, pw);
            const v2u va0 = *(const LAS v2u*)(Vb + r * ATT_VSTR + ks * 32 + hq * 8), va1 = *(const LAS v2u*)(Vb + r * ATT_VSTR + ks * 32 + 16 + hq * 8);
            const v2u vb0 = *(const LAS v2u*)(Vb + (32 + r) * ATT_VSTR + ks * 32 + hq * 8), vb1 = *(const LAS v2u*)(Vb + (32 + r) * ATT_VSTR + ks * 32 + 16 + hq * 8);
            const v4u vwa = {va0.x, va0.y, va1.x, va1.y}, vwb = {vb0.x, vb0.y, vb1.x, vb1.y};
            o0 = MFMA32(__builtin_bit_cast(bf16x8, vwa), pf, o0); o1 = MFMA32(__builtin_bit_cast(bf16x8, vwb), pf, o1);
        }
        if (j + 1 < ntiles) {
            LAS unsigned char* Nb = lds + (buf ^ 1) * ATT_STAGE;
            *(LAS v4u*)(Nb + sk) = rk; if (tid < 256) *(LAS v4u*)(Nb + sr) = rr;
            *(LAS v2u*)(Nb + sv) = (v2u){rv.x, rv.y}; *(LAS v2u*)(Nb + sv + 8) = (v2u){rv.z, rv.w};
        }
        __syncthreads();
    }
    l += __shfl_xor(l, 32);
    const float inv = rcp_(l);
#pragma unroll
    for (int mt = 0; mt < 2; ++mt)
#pragma unroll
        for (int g = 0; g < 4; ++g) {
            const int dv0 = 32 * mt + 8 * g + 4 * hq;
            const v2u gm = *(const v2u*)(G1 + (size_t)n * G1W + C_GM + h * 64 + dv0);
            const float x0 = (mt ? o1[4 * g + 0] : o0[4 * g + 0]) * inv, x1 = (mt ? o1[4 * g + 1] : o0[4 * g + 1]) * inv, x2 = (mt ? o1[4 * g + 2] : o0[4 * g + 2]) * inv, x3 = (mt ? o1[4 * g + 3] : o0[4 * g + 3]) * inv;
            v2u ov; ov.x = cvtpk(x0 * siluf_(bflo(gm.x)), x1 * siluf_(bfhi(gm.x))); ov.y = cvtpk(x2 * siluf_(bflo(gm.y)), x3 * siluf_(bfhi(gm.y)));
            *(v2u*)(Q + (size_t)n * 768 + h * 96 + dv0) = ov;
        }
}

constexpr int A2_QSTR = 528, A2_KVSTR = 272, A2_KVOFF = 64 * A2_QSTR;
__device__ __forceinline__ void a2_unit(ArgsP a, LAS unsigned char* lds, int layer, int unit) {
    const int tid = tid_(), lane = tid & 63, wave = tid >> 6, tn = lane & 15, g = lane >> 4;
    constexpr int NU_TOK = T / 64;
    const bool is_tok = unit < NU_TOK;
    const bf16* G2 = (const bf16*)(a->ws + WS_G2);
    bf16* Q = (bf16*)(a->ws + WS_Q); bf16* KN = (bf16*)(a->ws + WS_KN); bf16* KR = (bf16*)(a->ws + WS_KR); bf16* VT = (bf16*)(a->ws + WS_VT);
    const bf16* WUQ = (const bf16*)(a->ws + WS_WUQ) + (size_t)layer * 768 * 256;
    const bf16* WUKV = (const bf16*)(a->ws + WS_WUKV) + (size_t)layer * 1024 * 128;
    const float* ROPE1 = (const float*)(a->ws + WS_ROPE);
    __syncthreads();
    v2u cq8[8], kv8[8]; unsigned kr8[8];
    if (is_tok) {
#pragma unroll
        for (int rr = 0; rr < 8; ++rr) { const size_t n_ = (size_t)(unit * 64 + wave * 8 + rr);
            cq8[rr] = *(const v2u*)(G2 + n_ * G2W + lane * 4); kv8[rr] = *(const v2u*)(G2 + n_ * G2W + 256 + (lane & 31) * 4); kr8[rr] = G2[n_ * G2W + 384 + (lane & 31)]; }
    }
#pragma unroll
    for (int rr = 0; rr < 8; ++rr) {
        const int r = wave * 8 + rr;
        if (is_tok) {
            const int n = unit * 64 + r; const Tok tk = tok_of(n);
            const v2u cqv = cq8[rr];
            const float c0 = bflo(cqv.x), c1 = bfhi(cqv.x), c2 = bflo(cqv.y), c3 = bfhi(cqv.y);
            const float rq = rsqrt_(wave_sum(c0 * c0 + c1 * c1 + c2 * c2 + c3 * c3) * (1.f / 256.f) + 1e-6f);
            const f32x4 qn = *(const f32x4*)(a->in[I_QNORM] + layer * 256 + lane * 4);
            *(LAS v2u*)(lds + r * A2_QSTR + lane * 8) = (v2u){cvtpk(c0 * rq * qn.x, c1 * rq * qn.y), cvtpk(c2 * rq * qn.z, c3 * rq * qn.w)};
            float k0 = 0.f, k1 = 0.f, k2 = 0.f, k3 = 0.f;
            if (lane < 32) { const v2u kv = kv8[rr]; k0 = bflo(kv.x); k1 = bfhi(kv.x); k2 = bflo(kv.y); k3 = bfhi(kv.y); }
            const float rk = rsqrt_(wave_sum(k0 * k0 + k1 * k1 + k2 * k2 + k3 * k3) * (1.f / 128.f) + 1e-6f);
            if (lane < 32) {
                const f32x4 kn = *(const f32x4*)(a->in[I_KVNORM] + layer * 128 + lane * 4);
                f32x4 o; o.x = k0 * rk * kn.x; o.y = k1 * rk * kn.y; o.z = k2 * rk * kn.z; o.w = k3 * rk * kn.w;
                if (!tk.lat) *(f32x4*)(a->out + O_CKV + ((size_t)(tk.b * 2 + layer) * 256 + tk.t) * 128 + lane * 4) = o;
                *(LAS v2u*)(lds + A2_KVOFF + r * A2_KVSTR + lane * 8) = (v2u){cvtpk(o.x, o.y), cvtpk(o.z, o.w)};
            }
            float krv = (lane < 32) ? bf2f(kr8[rr]) : 0.f;
            const float other = __shfl_xor(krv, 1);
            if (lane < 32) {
                if (!tk.lat) a->out[O_KR + ((size_t)(tk.b * 2 + layer) * 256 + tk.t) * 32 + lane] = krv;
                else { const float c = ROPE1[((size_t)tk.t * 16 + (lane >> 1)) * 2], s = ROPE1[((size_t)tk.t * 16 + (lane >> 1)) * 2 + 1]; krv = (lane & 1) ? (other * s + krv * c) : (krv * c - other * s); }
                KR[(size_t)tk.kidx * 32 + lane] = (bf16)f2bf(krv);
            }
        } else {
            const int cr = (unit - NU_TOK) * 64 + r, b = cr >> 8, j = cr & 255;
            const size_t src = ((size_t)(b * 2 + layer) * 256 + j);
            if (lane < 32) { const f32x4 v = *(const f32x4*)(a->in[I_CCKV] + src * 128 + lane * 4);
                *(LAS v2u*)(lds + A2_KVOFF + r * A2_KVSTR + lane * 8) = (v2u){cvtpk(v.x, v.y), cvtpk(v.z, v.w)};
                KR[(size_t)(T_CTX + b * LK_LAT + j) * 32 + lane] = (bf16)f2bf(a->in[I_CKR][src * 32 + lane]); }
        }
    }
    __syncthreads();
    constexpr int A2_STG = 52224, A2_SQSTR = 784, A2_SKSTR = 1040, A2_SVSTR = 144;
    const int n0 = is_tok ? unit * 64 : 0;
    if (is_tok) {
      const float* ROPE = (const float*)(a->ws + WS_ROPE);
      for (int qh = 0; qh < 2; ++qh) {
        f32x4 acc[3][4];
#pragma unroll
        for (int f = 0; f < 3; ++f)
#pragma unroll
            for (int t = 0; t < 4; ++t) acc[f][t] = (f32x4){0.f, 0.f, 0.f, 0.f};
        bf16x8 afq[3][8];
        const bf16* wq = WUQ + (size_t)((qh * 24 + wave * 3) * 16 + tn) * 256 + g * 8;
#pragma unroll
        for (int f = 0; f < 3; ++f)
#pragma unroll
            for (int ks = 0; ks < 8; ++ks) afq[f][ks] = *(const bf16x8*)(wq + f * 16 * 256 + ks * 32);
#pragma unroll
        for (int ks = 0; ks < 8; ++ks) {
            bf16x8 bfr[4];
#pragma unroll
            for (int t = 0; t < 4; ++t) bfr[t] = *(const LAS bf16x8*)(lds + (t * 16 + tn) * A2_QSTR + ks * 64 + g * 16);
#pragma unroll
            for (int f = 0; f < 3; ++f)
#pragma unroll
                for (int t = 0; t < 4; ++t) acc[f][t] = MFMA16(afq[f][ks], bfr[t], acc[f][t]);
        }
#pragma unroll
        for (int f = 0; f < 3; ++f) { const int fl = (wave * 3 + f) * 16 + 4 * g, f0 = qh * 384 + fl, d = f0 % 96;
#pragma unroll
            for (int t = 0; t < 4; ++t) { const int r = t * 16 + tn, n = n0 + r;
                float v0 = acc[f][t][0], v1 = acc[f][t][1], v2 = acc[f][t][2], v3 = acc[f][t][3];
                if (n >= T_CTX && d >= 64) { const int tt = (n - T_CTX) & 2047; const f32x4 cs = *(const f32x4*)(ROPE + ((size_t)tt * 16 + ((d - 64) >> 1)) * 2);
                    const float y0 = v0 * cs.x - v1 * cs.y, y1 = v0 * cs.y + v1 * cs.x, y2 = v2 * cs.z - v3 * cs.w, y3 = v2 * cs.w + v3 * cs.z; v0 = y0; v1 = y1; v2 = y2; v3 = y3; }
                *(LAS v2u*)(lds + A2_STG + r * A2_SQSTR + fl * 2) = (v2u){cvtpk(v0, v1), cvtpk(v2, v3)}; } }
        __syncthreads();
#pragma unroll
        for (int i = 0; i < 6; ++i) { const int c = tid + 512 * i, row = c / 48, c16 = c % 48;
            *(v4u*)(Q + (size_t)(n0 + row) * 768 + qh * 384 + c16 * 8) = *(const LAS v4u*)(lds + A2_STG + row * A2_SQSTR + c16 * 16); }
        __syncthreads();
      }
    }
    int kidx0, latu, bu, kpos0;
    if (is_tok) { const Tok tk = tok_of(n0); kidx0 = tk.kidx; latu = tk.lat; bu = tk.b; kpos0 = tk.lat ? PAST + tk.t : tk.t; }
    else { const int cr = (unit - NU_TOK) * 64; bu = cr >> 8; kpos0 = cr & 255; latu = 1; kidx0 = T_CTX + bu * LK_LAT + kpos0; }
    for (int half = 0; half < 2; ++half) {
        f32x4 acc[4][4];
#pragma unroll
        for (int f = 0; f < 4; ++f)
#pragma unroll
            for (int t = 0; t < 4; ++t) acc[f][t] = (f32x4){0.f, 0.f, 0.f, 0.f};
        bf16x8 afk[4][4];
        const bf16* wk = WUKV + (size_t)(wave * 128 + half * 64 + tn) * 128 + g * 8;
#pragma unroll
        for (int f = 0; f < 4; ++f)
#pragma unroll
            for (int ks = 0; ks < 4; ++ks) afk[f][ks] = *(const bf16x8*)(wk + f * 16 * 128 + ks * 32);
#pragma unroll
        for (int ks = 0; ks < 4; ++ks) {
            bf16x8 bfr[4];
#pragma unroll
            for (int t = 0; t < 4; ++t) bfr[t] = *(const LAS bf16x8*)(lds + A2_KVOFF + (t * 16 + tn) * A2_KVSTR + ks * 64 + g * 16);
#pragma unroll
            for (int f = 0; f < 4; ++f)
#pragma unroll
                for (int t = 0; t < 4; ++t) acc[f][t] = MFMA16(afk[f][ks], bfr[t], acc[f][t]);
        }
#pragma unroll
        for (int f = 0; f < 4; ++f) { const int x = wave * 64 + f * 16 + 4 * g;
#pragma unroll
            for (int t = 0; t < 4; ++t) { const int r = t * 16 + tn;
                if (half == 0) *(LAS v2u*)(lds + A2_STG + r * A2_SKSTR + x * 2) = (v2u){cvtpk(acc[f][t][0], acc[f][t][1]), cvtpk(acc[f][t][2], acc[f][t][3])};
                else { const unsigned p01 = cvtpk(acc[f][t][0], acc[f][t][1]), p23 = cvtpk(acc[f][t][2], acc[f][t][3]);
                    *(LAS bf16*)(lds + A2_STG + (x + 0) * A2_SVSTR + r * 2) = (bf16)(p01 & 0xffffu); *(LAS bf16*)(lds + A2_STG + (x + 1) * A2_SVSTR + r * 2) = (bf16)(p01 >> 16);
                    *(LAS bf16*)(lds + A2_STG + (x + 2) * A2_SVSTR + r * 2) = (bf16)(p23 & 0xffffu); *(LAS bf16*)(lds + A2_STG + (x + 3) * A2_SVSTR + r * 2) = (bf16)(p23 >> 16); } } }
        __syncthreads();
        if (half == 0) {
#pragma unroll
            for (int i = 0; i < 8; ++i) { const int c = tid + 512 * i, row = c >> 6, c16 = c & 63;
                *(v4u*)(KN + (size_t)(kidx0 + row) * 512 + c16 * 8) = *(const LAS v4u*)(lds + A2_STG + row * A2_SKSTR + c16 * 16); }
        } else {
            const int Lk = latu ? LK_LAT : 256;
#pragma unroll
            for (int i = 0; i < 8; ++i) { const int c = tid + 512 * i, row = c >> 3, part = c & 7, h = row >> 6, dv = row & 63;
                const size_t base = latu ? (size_t)VT_LAT + ((size_t)(bu * 8 + h) * 64 + dv) * LK_LAT : ((size_t)(bu * 8 + h) * 64 + dv) * 256;
                *(v4u*)(VT + base + kpos0 + part * 8) = *(const LAS v4u*)(lds + A2_STG + row * A2_SVSTR + part * 16); }
            (void)Lk;
        }
        __syncthreads();
    }
}

constexpr int RW_W2T = 0, RW_A2T = 9216, RW_TH = 18432, RW_HA = 27648, RW_CH0 = 36864, RW_CHB = 20992, RW_YB = 120832;
constexpr int RC_KP = 0, RC_RP = 2304, RC_BP = 4608, RC_KT = 6912, RC_KTT = 9216, RC_NBPT = 11776, RC_VTT = 14336, RC_LK = 16896, RC_TM = 17536, RC_ARK = 18176, RC_NARB = 18816, RC_G15 = 19456, RC_LBF = 19712, RC_SSQ = 20736;
__device__ __forceinline__ void rwkv_unit_mfma(ArgsP a, LAS unsigned char* lds, int layer, int u) {
    const int tid = tid_(), lane = tid & 63, wave = tid >> 6, i16 = lane & 15, g = lane >> 4;
    const int lat = u < 64, uu = lat ? u : u - 64, b = uu >> 3, e = (uu >> 2) & 1, hh = uu & 3;
    const int L = lat ? L_LAT : L_CTX, tok0 = lat ? T_CTX + b * L_LAT : b * L_CTX;
    const bf16* G1 = (const bf16*)(a->ws + WS_G1);
    bf16* YS = (bf16*)(a->ws + WS_G2);
    __syncthreads();
    for (int i = tid; i < 4096; i += NTHREADS) { const int j = i >> 6, c = i & 63;
        *(LAS bf16*)(lds + RW_W2T + (c * 72 + j) * 2) = (bf16)f2bf(a->in[I_W2][((size_t)(layer * 2 + e) * 64 + j) * 256 + hh * 64 + c]);
        *(LAS bf16*)(lds + RW_A2T + (c * 72 + j) * 2) = (bf16)f2bf(a->in[I_A2][((size_t)(layer * 2 + e) * 64 + j) * 256 + hh * 64 + c]); }
    const int st_tok = tid >> 3, st_c8 = (tid & 7) * 8;
#define RW_STAGE(sc) do { const int step_ = (sc) * 64 + st_tok, t_ = e ? L - 1 - step_ : step_; const bf16* gp_ = G1 + (size_t)(tok0 + t_) * G1W + C_LORA + e * 64 + st_c8; \
        const v4u hw_ = *(const v4u*)gp_, ha_ = *(const v4u*)(gp_ + 128); v4u th_; \
        th_.x = cvtpk(tanh_fast(bflo(hw_.x)), tanh_fast(bfhi(hw_.x))); th_.y = cvtpk(tanh_fast(bflo(hw_.y)), tanh_fast(bfhi(hw_.y))); th_.z = cvtpk(tanh_fast(bflo(hw_.z)), tanh_fast(bfhi(hw_.z))); th_.w = cvtpk(tanh_fast(bflo(hw_.w)), tanh_fast(bfhi(hw_.w))); \
        *(LAS v4u*)(lds + RW_TH + st_tok * 144 + st_c8 * 2) = th_; *(LAS v4u*)(lds + RW_HA + st_tok * 144 + st_c8 * 2) = ha_; } while (0)
    RW_STAGE(0);
    f32x4 ST[4];
    {
        const int v = 16 * (wave & 3) + i16;
#pragma unroll
        for (int kt = 0; kt < 4; ++kt) ST[kt] = lat ? *(const f32x4*)(a->in[I_SRW] + (((size_t)((b * 2 + layer) * 2 + e) * 4 + hh) * 64 + v) * 64 + 16 * kt + 4 * g) : (f32x4){0.f, 0.f, 0.f, 0.f};
    }
    const int pc = wave & 3, ph = wave >> 2;
    LAS unsigned char* CH = lds + RW_CH0 + pc * RW_CHB;
    __syncthreads();
    const int nsc = L >> 6;
    v2u pk[2], pr[2], pv[2];
#define RW_PREFETCH(sc) do { const int ps_ = (sc) * 64 + pc * 16 + i16, pt_ = e ? L - 1 - ps_ : ps_; const bf16* gq_ = G1 + (size_t)(tok0 + pt_) * G1W + hh * 64 + (2 * ph) * 16 + 4 * g; \
        pk[0] = *(const v2u*)(gq_ + C_K); pk[1] = *(const v2u*)(gq_ + C_K + 16); pr[0] = *(const v2u*)(gq_ + C_R); pr[1] = *(const v2u*)(gq_ + C_R + 16); pv[0] = *(const v2u*)(gq_ + C_V); pv[1] = *(const v2u*)(gq_ + C_V + 16); } while (0)
    RW_PREFETCH(0);
    for (int sc = 0; sc < nsc; ++sc) {
        const v2u ck[2] = {pk[0], pk[1]}, cr[2] = {pr[0], pr[1]}, cv[2] = {pv[0], pv[1]};
        if (sc + 1 < nsc) RW_PREFETCH(sc + 1);
        float dec[8], av[8], kx[8], rx[8], kk[8];
        {
            f32x4 aw[2], aa[2];
#pragma unroll
            for (int c2 = 0; c2 < 2; ++c2) { aw[c2] = (f32x4){0.f, 0.f, 0.f, 0.f}; aa[c2] = (f32x4){0.f, 0.f, 0.f, 0.f}; }
#pragma unroll
            for (int ks = 0; ks < 2; ++ks) {
                const bf16x8 bth = *(const LAS bf16x8*)(lds + RW_TH + (pc * 16 + i16) * 144 + ks * 64 + g * 16), bha = *(const LAS bf16x8*)(lds + RW_HA + (pc * 16 + i16) * 144 + ks * 64 + g * 16);
#pragma unroll
                for (int c2 = 0; c2 < 2; ++c2) { const int row = (2 * ph + c2) * 16 + i16;
                    const bf16x8 w2f = *(const LAS bf16x8*)(lds + RW_W2T + row * 144 + ks * 64 + g * 16), a2f = *(const LAS bf16x8*)(lds + RW_A2T + row * 144 + ks * 64 + g * 16);
                    aw[c2] = MFMA16(w2f, bth, aw[c2]); aa[c2] = MFMA16(a2f, bha, aa[c2]); }
            }
            float ss = 0.f;
#pragma unroll
            for (int c2 = 0; c2 < 2; ++c2) { const int ch = (2 * ph + c2) * 16 + 4 * g, gch = hh * 64 + ch;
                const f32x4 w0 = *(const f32x4*)(a->in[I_W0] + (layer * 2 + e) * 256 + gch), a0 = *(const f32x4*)(a->in[I_A0] + (layer * 2 + e) * 256 + gch), kw = *(const f32x4*)(a->in[I_KK] + layer * 256 + gch);
                const v2u kv = ck[c2], rv = cr[c2];
                const float kq[4] = {bflo(kv.x), bfhi(kv.x), bflo(kv.y), bfhi(kv.y)}, rq[4] = {bflo(rv.x), bfhi(rv.x), bflo(rv.y), bfhi(rv.y)};
#pragma unroll
                for (int q = 0; q < 4; ++q) { const int o = c2 * 4 + q;
                    dec[o] = exp_(-0.6065306597126334f * sigmoidf_(aw[c2][q] + w0[q])); av[o] = sigmoidf_(aa[c2][q] + a0[q]);
                    kx[o] = kq[q]; rx[o] = rq[q]; kk[o] = kq[q] * kw[q]; ss += kk[o] * kk[o]; }
            }
            ss += __shfl_xor(ss, 16); ss += __shfl_xor(ss, 32);
            if (g == 0) *(LAS float*)(CH + RC_SSQ + (i16 * 2 + ph) * 4) = ss;
        }
        __syncthreads();
        {
            const float tot = *(const LAS float*)(CH + RC_SSQ + (i16 * 2) * 4) + *(const LAS float*)(CH + RC_SSQ + (i16 * 2 + 1) * 4);
            const float inrm = rcp_(fmaxf(sqrt_(tot), 1e-12f));
#pragma unroll
            for (int c2 = 0; c2 < 2; ++c2) { const int ch = (2 * ph + c2) * 16 + 4 * g, gch = hh * 64 + ch;
                const f32x4 ka = *(const f32x4*)(a->in[I_KA] + layer * 256 + gch);
                float kp[4], bp[4], kt[4], rp[4];
#pragma unroll
                for (int q = 0; q < 4; ++q) { const int o = c2 * 4 + q;
                    const float G = row16_prefix_prod(dec[o]);
                    const float Gex = dpp_f<0x111>(1.f, G);
                    const float kkn = kk[o] * inrm, iG = rcp_(G);
                    kp[q] = Gex * kkn; bp[q] = kkn * av[o] * iG; kt[q] = kx[o] * (1.f + (av[o] - 1.f) * ka[q]) * iG; rp[q] = G * rx[o];
                    if (i16 == 15) *(LAS float*)(CH + RC_G15 + (ch + q) * 4) = G;
                    { const unsigned pk_ = cvtpk(kt[q], -bp[q]); *(LAS bf16*)(CH + RC_KTT + (ch + q) * 40 + i16 * 2) = (bf16)(pk_ & 0xffffu); *(LAS bf16*)(CH + RC_NBPT + (ch + q) * 40 + i16 * 2) = (bf16)(pk_ >> 16); } }
                *(LAS v2u*)(CH + RC_KP + i16 * 144 + ch * 2) = (v2u){cvtpk(kp[0], kp[1]), cvtpk(kp[2], kp[3])};
                *(LAS v2u*)(CH + RC_BP + i16 * 144 + ch * 2) = (v2u){cvtpk(bp[0], bp[1]), cvtpk(bp[2], bp[3])};
                *(LAS v2u*)(CH + RC_KT + i16 * 144 + ch * 2) = (v2u){cvtpk(kt[0], kt[1]), cvtpk(kt[2], kt[3])};
                *(LAS v2u*)(CH + RC_RP + i16 * 144 + ch * 2) = (v2u){cvtpk(rp[0], rp[1]), cvtpk(rp[2], rp[3])};
                const v2u vv = cv[c2];
                *(LAS bf16*)(CH + RC_VTT + (ch + 0) * 40 + i16 * 2) = (bf16)(vv.x & 0xffffu); *(LAS bf16*)(CH + RC_VTT + (ch + 1) * 40 + i16 * 2) = (bf16)(vv.x >> 16);
                *(LAS bf16*)(CH + RC_VTT + (ch + 2) * 40 + i16 * 2) = (bf16)(vv.y & 0xffffu); *(LAS bf16*)(CH + RC_VTT + (ch + 3) * 40 + i16 * 2) = (bf16)(vv.y >> 16);
            }
        }
        __syncthreads();
        {
            f32x4 d0 = (f32x4){0.f, 0.f, 0.f, 0.f}, d1 = (f32x4){0.f, 0.f, 0.f, 0.f};
            const int xoff = ph ? RC_KP : RC_RP, y0off = ph ? RC_BP : RC_KT, y1off = ph ? RC_KT : RC_BP;
#pragma unroll
            for (int ks = 0; ks < 2; ++ks) {
                const bf16x8 xf = *(const LAS bf16x8*)(CH + xoff + i16 * 144 + ks * 64 + g * 16);
                const bf16x8 y0 = *(const LAS bf16x8*)(CH + y0off + i16 * 144 + ks * 64 + g * 16), y1 = *(const LAS bf16x8*)(CH + y1off + i16 * 144 + ks * 64 + g * 16);
                d0 = MFMA16(xf, y0, d0); d1 = MFMA16(xf, y1, d1);
            }
#pragma unroll
            for (int q = 0; q < 4; ++q) { const int i = 4 * g + q, j = i16;
                if (ph) { *(LAS float*)(CH + RC_LBF + (i * 16 + j) * 4) = (j < i) ? d0[q] : 0.f; *(LAS bf16*)(CH + RC_LK + i * 40 + j * 2) = (bf16)(cvtpk((j < i) ? d1[q] : 0.f, 0.f) & 0xffffu); }
                else { const unsigned pk_ = cvtpk((j <= i) ? d0[q] : 0.f, (j <= i) ? -d1[q] : 0.f); *(LAS bf16*)(CH + RC_ARK + i * 40 + j * 2) = (bf16)(pk_ & 0xffffu); *(LAS bf16*)(CH + RC_NARB + i * 40 + j * 2) = (bf16)(pk_ >> 16); }
            }
            if (ph) {
                float x[16];
#pragma unroll
                for (int i = 0; i < 16; ++i) { float s = (i == i16) ? 1.f : 0.f;
#pragma unroll
                    for (int j4 = 0; j4 < (i + 3) / 4; ++j4) { const f32x4 lr = *(const LAS f32x4*)(CH + RC_LBF + (i * 16 + j4 * 4) * 4);
#pragma unroll
                        for (int jj = 0; jj < 4; ++jj) { const int j = j4 * 4 + jj; if (j < i) s -= lr[jj] * x[j]; } }
                    x[i] = s; }
                if (g == 0) {
#pragma unroll
                    for (int i = 0; i < 16; i += 2) { const unsigned pk_ = cvtpk(x[i], x[i + 1]); *(LAS bf16*)(CH + RC_TM + i * 40 + i16 * 2) = (bf16)(pk_ & 0xffffu); *(LAS bf16*)(CH + RC_TM + (i + 1) * 40 + i16 * 2) = (bf16)(pk_ >> 16); } }
            }
        }
        __syncthreads();
        if (wave < 4) {
            const int vt = wave;
#pragma unroll 1
            for (int c = 0; c < 4; ++c) {
                const LAS unsigned char* C = lds + RW_CH0 + c * RW_CHB;
                v4u sb01, sb23;
                sb01.x = cvtpk(ST[0][0], ST[0][1]); sb01.y = cvtpk(ST[0][2], ST[0][3]); sb01.z = cvtpk(ST[1][0], ST[1][1]); sb01.w = cvtpk(ST[1][2], ST[1][3]);
                sb23.x = cvtpk(ST[2][0], ST[2][1]); sb23.y = cvtpk(ST[2][2], ST[2][3]); sb23.z = cvtpk(ST[3][0], ST[3][1]); sb23.w = cvtpk(ST[3][2], ST[3][3]);
                const bf16x8 s01 = __builtin_bit_cast(bf16x8, sb01), s23 = __builtin_bit_cast(bf16x8, sb23);
                const v2u kp0a = *(const LAS v2u*)(C + RC_KP + i16 * 144 + (4 * g) * 2), kp0b = *(const LAS v2u*)(C + RC_KP + i16 * 144 + (16 + 4 * g) * 2);
                const v2u kp1a = *(const LAS v2u*)(C + RC_KP + i16 * 144 + (32 + 4 * g) * 2), kp1b = *(const LAS v2u*)(C + RC_KP + i16 * 144 + (48 + 4 * g) * 2);
                const v2u rp0a = *(const LAS v2u*)(C + RC_RP + i16 * 144 + (4 * g) * 2), rp0b = *(const LAS v2u*)(C + RC_RP + i16 * 144 + (16 + 4 * g) * 2);
                const v2u rp1a = *(const LAS v2u*)(C + RC_RP + i16 * 144 + (32 + 4 * g) * 2), rp1b = *(const LAS v2u*)(C + RC_RP + i16 * 144 + (48 + 4 * g) * 2);
                const v2u lk = *(const LAS v2u*)(C + RC_LK + i16 * 40 + g * 8), tm = *(const LAS v2u*)(C + RC_TM + i16 * 40 + g * 8);
                const v2u ark = *(const LAS v2u*)(C + RC_ARK + i16 * 40 + g * 8), narb = *(const LAS v2u*)(C + RC_NARB + i16 * 40 + g * 8);
                const v2u vf = *(const LAS v2u*)(C + RC_VTT + (16 * vt + i16) * 40 + g * 8);
                const v4u z4 = {0u, 0u, 0u, 0u};
                f32x4 rhs = (f32x4){0.f, 0.f, 0.f, 0.f};
                rhs = MFMA16(__builtin_bit_cast(bf16x8, ((v4u){kp0a.x, kp0a.y, kp0b.x, kp0b.y})), s01, rhs);
                rhs = MFMA16(__builtin_bit_cast(bf16x8, ((v4u){kp1a.x, kp1a.y, kp1b.x, kp1b.y})), s23, rhs);
                rhs = MFMA16(__builtin_bit_cast(bf16x8, ((v4u){lk.x, lk.y, 0u, 0u})), __builtin_bit_cast(bf16x8, ((v4u){vf.x, vf.y, 0u, 0u})), rhs);
                f32x4 z = MFMA16(__builtin_bit_cast(bf16x8, ((v4u){tm.x, tm.y, 0u, 0u})), __builtin_bit_cast(bf16x8, ((v4u){cvtpk(rhs[0], rhs[1]), cvtpk(rhs[2], rhs[3]), 0u, 0u})), ((f32x4){0.f, 0.f, 0.f, 0.f}));
                const bf16x8 vz = __builtin_bit_cast(bf16x8, ((v4u){vf.x, vf.y, cvtpk(z[0], z[1]), cvtpk(z[2], z[3])}));
                f32x4 y = (f32x4){0.f, 0.f, 0.f, 0.f};
                y = MFMA16(__builtin_bit_cast(bf16x8, ((v4u){rp0a.x, rp0a.y, rp0b.x, rp0b.y})), s01, y);
                y = MFMA16(__builtin_bit_cast(bf16x8, ((v4u){rp1a.x, rp1a.y, rp1b.x, rp1b.y})), s23, y);
                y = MFMA16(__builtin_bit_cast(bf16x8, ((v4u){ark.x, ark.y, narb.x, narb.y})), vz, y);
#pragma unroll
                for (int kt = 0; kt < 4; ++kt) {
                    const v2u ktf = *(const LAS v2u*)(C + RC_KTT + (16 * kt + i16) * 40 + g * 8), nbf = *(const LAS v2u*)(C + RC_NBPT + (16 * kt + i16) * 40 + g * 8);
                    const f32x4 g15 = *(const LAS f32x4*)(C + RC_G15 + (16 * kt + 4 * g) * 4);
                    ST[kt] = MFMA16(__builtin_bit_cast(bf16x8, ((v4u){ktf.x, ktf.y, nbf.x, nbf.y})), vz, ST[kt]);
                    ST[kt] = ST[kt] * g15;
                }
                { const unsigned y01 = cvtpk(y[0], y[1]), y23 = cvtpk(y[2], y[3]); LAS unsigned char* yb = lds + RW_YB + (c * 16 + 4 * g) * 144 + (16 * vt + i16) * 2;
                  *(LAS bf16*)(yb) = (bf16)(y01 & 0xffffu); *(LAS bf16*)(yb + 144) = (bf16)(y01 >> 16); *(LAS bf16*)(yb + 288) = (bf16)(y23 & 0xffffu); *(LAS bf16*)(yb + 432) = (bf16)(y23 >> 16); }
                (void)z4;
            }
        } else if (sc + 1 < nsc) {
            const int r0 = (tid - 256) >> 3;
#pragma unroll
            for (int hrow = 0; hrow < 2; ++hrow) { const int tokr = r0 + 32 * hrow, step_ = (sc + 1) * 64 + tokr, t_ = e ? L - 1 - step_ : step_;
                const bf16* gp_ = G1 + (size_t)(tok0 + t_) * G1W + C_LORA + e * 64 + st_c8;
                const v4u hw_ = *(const v4u*)gp_, ha_ = *(const v4u*)(gp_ + 128); v4u th_;
                th_.x = cvtpk(tanh_fast(bflo(hw_.x)), tanh_fast(bfhi(hw_.x))); th_.y = cvtpk(tanh_fast(bflo(hw_.y)), tanh_fast(bfhi(hw_.y))); th_.z = cvtpk(tanh_fast(bflo(hw_.z)), tanh_fast(bfhi(hw_.z))); th_.w = cvtpk(tanh_fast(bflo(hw_.w)), tanh_fast(bfhi(hw_.w)));
                *(LAS v4u*)(lds + RW_TH + tokr * 144 + st_c8 * 2) = th_; *(LAS v4u*)(lds + RW_HA + tokr * 144 + st_c8 * 2) = ha_; }
        }
        __syncthreads();
        {
            const int row = tid >> 3, part = tid & 7, step = sc * 64 + row, t = e ? L - 1 - step : step;
            *(v4u*)(YS + ((size_t)e * T + tok0 + t) * 256 + hh * 64 + part * 8) = *(const LAS v4u*)(lds + RW_YB + row * 144 + part * 16);
        }
    }
#undef RW_STAGE
#undef RW_PREFETCH
    if (!lat && wave < 4) {
        const int v = 16 * wave + i16;
#pragma unroll
        for (int kt = 0; kt < 4; ++kt) *(f32x4*)(a->out + O_RW + (((size_t)((b * 2 + layer) * 2 + e) * 4 + hh) * 64 + v) * 64 + 16 * kt + 4 * g) = ST[kt];
    }
}

constexpr int LR_WAT = 0, LR_XCB = 18432, LR_XCF = 27648, LR_AA = 44032, LR_BV = 60416, LR_HH = 76800, LR_SP = 93184, LR_SH = 95232, LR_HC = 97280;
__device__ __forceinline__ void lru_unit_mfma(ArgsP a, LAS unsigned char* lds, int layer, int u) {
    const int tid = tid_(), lane = tid & 63, wave = tid >> 6, i16 = lane & 15, g4 = lane >> 4;
    const int lat = u < 32, uu = lat ? u : u - 32, b = uu >> 2, g = uu & 3;
    const int L = lat ? L_LAT : L_CTX, tok0 = lat ? T_CTX + b * L_LAT : b * L_CTX;
    const bf16* G1 = (const bf16*)(a->ws + WS_G1);
    bf16* HF = (bf16*)(a->ws + WS_HF);
    LAS float* XCF = (LAS float*)(lds + LR_XCF); LAS float* AA = (LAS float*)(lds + LR_AA); LAS float* BV = (LAS float*)(lds + LR_BV); LAS float* HH = (LAS float*)(lds + LR_HH);
    LAS float* SP = (LAS float*)(lds + LR_SP); LAS float* SH = (LAS float*)(lds + LR_SH); LAS float* HC = (LAS float*)(lds + LR_HC);
    const int tt = tid >> 3, q8 = (tid & 7) * 8;
    float cw[4][8], cb[8];
#pragma unroll
    for (int i = 0; i < 8; ++i) { const int ch = g * 64 + q8 + i; cb[i] = a->in[I_CONVB][layer * 256 + ch];
#pragma unroll
        for (int j = 0; j < 4; ++j) cw[j][i] = a->in[I_CONVW][(layer * 4 + j) * 256 + ch]; }
    const int ot = wave & 3, tp = wave >> 2;
    const int sch = tid & 63, seg = tid >> 6;
    for (int e = 0; e < 2; ++e) {
        __syncthreads();
        for (int i = tid; i < 4096; i += NTHREADS) { const size_t src = ((size_t)((layer * 2 + e) * 4 + g)) * 4096 + i; const int ii = i >> 6, oo = i & 63;
            *(LAS bf16*)(lds + LR_WAT + (oo * 72 + ii) * 2) = (bf16)f2bf(a->in[I_WA][src]); *(LAS bf16*)(lds + LR_WAT + 9216 + (oo * 72 + ii) * 2) = (bf16)f2bf(a->in[I_WX][src]); }
        if (tid < 64) HC[tid] = lat ? a->in[I_SLRU][((size_t)(b * 2 + layer) * 2 + e) * 256 + g * 64 + tid] : 0.f;
        f32x4 bav, bxv, spl;
        { const int chb = (layer * 2 + e) * 256 + g * 64 + 16 * ot + 4 * g4;
          bav = *(const f32x4*)(a->in[I_BA] + chb); bxv = *(const f32x4*)(a->in[I_BX] + chb); const f32x4 lam = *(const f32x4*)(a->in[I_LAMBDA] + chb);
#pragma unroll
          for (int q = 0; q < 4; ++q) spl[q] = log1pf(exp_(-lam[q])); }
        __syncthreads();
        v4u xr[4], hfr, glr;
#define LR_PREFETCH(cc_) do { const int c_ = e ? L / 64 - 1 - (cc_) : (cc_), t_ = c_ * 64 + tt; \
            _Pragma("unroll") for (int j = 0; j < 4; ++j) { const int ts = t_ + j - 2; xr[j] = (ts >= 0 && ts < L) ? *(const v4u*)(G1 + (size_t)(tok0 + ts) * G1W + C_XL + g * 64 + q8) : (v4u){0u, 0u, 0u, 0u}; } \
            if (e) { hfr = *(const v4u*)(HF + (size_t)(tok0 + t_) * 256 + g * 64 + q8); glr = *(const v4u*)(G1 + (size_t)(tok0 + t_) * G1W + C_GL + g * 64 + q8); } } while (0)
        LR_PREFETCH(0);
        for (int cc = 0; cc < L / 64; ++cc) {
            const int c = e ? L / 64 - 1 - cc : cc, t = c * 64 + tt, n = tok0 + t;
            const v4u xcur[4] = {xr[0], xr[1], xr[2], xr[3]}; const v4u hfc = hfr, glc = glr;
            if (cc + 1 < L / 64) LR_PREFETCH(cc + 1);
            {
                float xc[8];
#pragma unroll
                for (int i = 0; i < 8; ++i) xc[i] = cb[i];
#pragma unroll
                for (int j = 0; j < 4; ++j) {
                    { const v4u x = xcur[j];
                        xc[0] += cw[j][0] * bflo(x.x); xc[1] += cw[j][1] * bfhi(x.x); xc[2] += cw[j][2] * bflo(x.y); xc[3] += cw[j][3] * bfhi(x.y);
                        xc[4] += cw[j][4] * bflo(x.z); xc[5] += cw[j][5] * bfhi(x.z); xc[6] += cw[j][6] * bflo(x.w); xc[7] += cw[j][7] * bfhi(x.w); } }
                *(LAS f32x4*)(XCF + tt * 64 + q8) = (f32x4){xc[0], xc[1], xc[2], xc[3]}; *(LAS f32x4*)(XCF + tt * 64 + q8 + 4) = (f32x4){xc[4], xc[5], xc[6], xc[7]};
                *(LAS v4u*)(lds + LR_XCB + tt * 144 + q8 * 2) = (v4u){cvtpk(xc[0], xc[1]), cvtpk(xc[2], xc[3]), cvtpk(xc[4], xc[5]), cvtpk(xc[6], xc[7])};
            }
            __syncthreads();
            {
#pragma unroll
                for (int t2 = 0; t2 < 2; ++t2) { const int tk = (2 * tp + t2) * 16 + i16;
                    f32x4 ga = (f32x4){0.f, 0.f, 0.f, 0.f}, gx = (f32x4){0.f, 0.f, 0.f, 0.f};
#pragma unroll
                    for (int ks = 0; ks < 2; ++ks) { const bf16x8 xf = *(const LAS bf16x8*)(lds + LR_XCB + tk * 144 + ks * 64 + g4 * 16);
                        const bf16x8 wa = *(const LAS bf16x8*)(lds + LR_WAT + (16 * ot + i16) * 144 + ks * 64 + g4 * 16), wx = *(const LAS bf16x8*)(lds + LR_WAT + 9216 + (16 * ot + i16) * 144 + ks * 64 + g4 * 16);
                        ga = MFMA16(wa, xf, ga); gx = MFMA16(wx, xf, gx); }
                    const f32x4 xcv = *(const LAS f32x4*)(XCF + tk * 64 + 16 * ot + 4 * g4);
                    f32x4 av, bv;
#pragma unroll
                    for (int q = 0; q < 4; ++q) { const float la = -8.f * sigmoidf_(ga[q] + bav[q]) * spl[q]; av[q] = exp_(la); bv[q] = sqrt_(1.f - exp_(2.f * la)) * sigmoidf_(gx[q] + bxv[q]) * xcv[q]; }
                    *(LAS f32x4*)(AA + tk * 64 + 16 * ot + 4 * g4) = av; *(LAS f32x4*)(BV + tk * 64 + 16 * ot + 4 * g4) = bv; }
            }
            __syncthreads();
            float av8[8], bv8[8];
            {
                float P = 1.f, H = 0.f;
#pragma unroll
                for (int s = 0; s < 8; ++s) { const int p = seg * 8 + s, st = e ? 63 - p : p; av8[s] = AA[st * 64 + sch]; bv8[s] = BV[st * 64 + sch]; H = fmaf(av8[s], H, bv8[s]); P *= av8[s]; }
                SP[seg * 64 + sch] = P; SH[seg * 64 + sch] = H;
            }
            __syncthreads();
            {
                float h = HC[sch];
                for (int s2 = 0; s2 < seg; ++s2) h = fmaf(SP[s2 * 64 + sch], h, SH[s2 * 64 + sch]);
#pragma unroll
                for (int s = 0; s < 8; ++s) { const int p = seg * 8 + s, st = e ? 63 - p : p; h = fmaf(av8[s], h, bv8[s]); HH[st * 64 + sch] = h; }
                __syncthreads();
                if (seg == 7) HC[sch] = h;
            }
            __syncthreads();
            {
                bf16* dst = HF + (size_t)n * 256 + g * 64 + q8;
                float o[8];
#pragma unroll
                for (int i = 0; i < 8; ++i) o[i] = HH[tt * 64 + q8 + i];
                if (e) { const v4u hf = hfc, gl = glc;
                    o[0] = (o[0] + bflo(hf.x)) * siluf_(bflo(gl.x)); o[1] = (o[1] + bfhi(hf.x)) * siluf_(bfhi(gl.x)); o[2] = (o[2] + bflo(hf.y)) * siluf_(bflo(gl.y)); o[3] = (o[3] + bfhi(hf.y)) * siluf_(bfhi(gl.y));
                    o[4] = (o[4] + bflo(hf.z)) * siluf_(bflo(gl.z)); o[5] = (o[5] + bfhi(hf.z)) * siluf_(bfhi(gl.z)); o[6] = (o[6] + bflo(hf.w)) * siluf_(bflo(gl.w)); o[7] = (o[7] + bfhi(hf.w)) * siluf_(bfhi(gl.w)); }
                *(v4u*)dst = (v4u){cvtpk(o[0], o[1]), cvtpk(o[2], o[3]), cvtpk(o[4], o[5]), cvtpk(o[6], o[7])};
            }
        }
#undef LR_PREFETCH
        __syncthreads();
        if (tid < 64 && !lat) a->out[O_LRU + ((size_t)(b * 2 + layer) * 2 + e) * 256 + g * 64 + tid] = HC[tid];
    }
}

constexpr int LQ_NQ = 32;
constexpr int LQ_WAT = 0, LQ_XCB = 2 * LQ_NQ * 144, LQ_XCQ = LQ_XCB + 9216, LQ_AA = LQ_XCQ + 64 * LQ_NQ * 4, LQ_BV = LQ_AA + 64 * LQ_NQ * 4, LQ_HH = LQ_BV + 64 * LQ_NQ * 4,
              LQ_SP = LQ_HH + 64 * LQ_NQ * 4, LQ_SH = LQ_SP + 8 * LQ_NQ * 4, LQ_HC = LQ_SH + 8 * LQ_NQ * 4;
__device__ __forceinline__ void lru_unit_q(ArgsP a, LAS unsigned char* lds, int layer, int u) {
    const int tid = tid_(), lane = tid & 63, wave = tid >> 6, i16 = lane & 15, g4 = lane >> 4;
    const int lat = u < 64, uu = lat ? u : u - 64, b = uu >> 3, g = (uu >> 1) & 3, oq = uu & 1;
    const int L = lat ? L_LAT : L_CTX, tok0 = lat ? T_CTX + b * L_LAT : b * L_CTX;
    const bf16* G1 = (const bf16*)(a->ws + WS_G1);
    bf16* HF = (bf16*)(a->ws + WS_HF);
    LAS float* XCQ = (LAS float*)(lds + LQ_XCQ);
    LAS float* AA = (LAS float*)(lds + LQ_AA); LAS float* BV = (LAS float*)(lds + LQ_BV); LAS float* HH = (LAS float*)(lds + LQ_HH);
    LAS float* SP = (LAS float*)(lds + LQ_SP); LAS float* SH = (LAS float*)(lds + LQ_SH); LAS float* HC = (LAS float*)(lds + LQ_HC);
    const int tt = tid >> 3, q8 = (tid & 7) * 8;
    float cw[4][8], cb[8];
#pragma unroll
    for (int i = 0; i < 8; ++i) { const int ch = g * 64 + q8 + i; cb[i] = a->in[I_CONVB][layer * 256 + ch];
#pragma unroll
        for (int j = 0; j < 4; ++j) cw[j][i] = a->in[I_CONVW][(layer * 4 + j) * 256 + ch]; }
    const int gt = wave & 3, got = wave >> 2;
    const int sch = tid & (LQ_NQ - 1), seg = (tid >> 5) & 7;
    const int otok = tid >> 3, oc4 = (tid & 7) * 4;
    const int chq = g * 64 + oq * LQ_NQ;
    for (int e = 0; e < 2; ++e) {
        __syncthreads();
        for (int i = tid; i < 64 * LQ_NQ; i += NTHREADS) { const int ii = i / LQ_NQ, oo = i % LQ_NQ; const size_t src = ((size_t)((layer * 2 + e) * 4 + g)) * 4096 + ii * 64 + oq * LQ_NQ + oo;
            *(LAS bf16*)(lds + LQ_WAT + (oo * 72 + ii) * 2) = (bf16)f2bf(a->in[I_WA][src]); *(LAS bf16*)(lds + LQ_WAT + LQ_NQ * 144 + (oo * 72 + ii) * 2) = (bf16)f2bf(a->in[I_WX][src]); }
        if (tid < LQ_NQ) HC[tid] = lat ? a->in[I_SLRU][((size_t)(b * 2 + layer) * 2 + e) * 256 + chq + tid] : 0.f;
        f32x4 bav, bxv, spl;
        { const int chb = (layer * 2 + e) * 256 + chq + 16 * got + 4 * g4;
          bav = *(const f32x4*)(a->in[I_BA] + chb); bxv = *(const f32x4*)(a->in[I_BX] + chb); const f32x4 lam = *(const f32x4*)(a->in[I_LAMBDA] + chb);
#pragma unroll
          for (int q = 0; q < 4; ++q) spl[q] = log1pf(exp_(-lam[q])); }
        v4u xr[4]; v2u hfr, glr;
#define LQ_PREFETCH(cc_) do { const int c_ = e ? L / 64 - 1 - (cc_) : (cc_), t_ = c_ * 64 + tt; \
            _Pragma("unroll") for (int j = 0; j < 4; ++j) { const int ts = t_ + j - 2; xr[j] = (ts >= 0 && ts < L) ? *(const v4u*)(G1 + (size_t)(tok0 + ts) * G1W + C_XL + g * 64 + q8) : (v4u){0u, 0u, 0u, 0u}; } \
            if (e) { const int to_ = c_ * 64 + otok; hfr = *(const v2u*)(HF + (size_t)(tok0 + to_) * 256 + chq + oc4); glr = *(const v2u*)(G1 + (size_t)(tok0 + to_) * G1W + C_GL + chq + oc4); } } while (0)
        LQ_PREFETCH(0);
        __syncthreads();
        for (int cc = 0; cc < L / 64; ++cc) {
            const int c = e ? L / 64 - 1 - cc : cc;
            const v4u xcur[4] = {xr[0], xr[1], xr[2], xr[3]}; const v2u hfc = hfr, glc = glr;
            if (cc + 1 < L / 64) LQ_PREFETCH(cc + 1);
            {
                float xc[8];
#pragma unroll
                for (int i = 0; i < 8; ++i) xc[i] = cb[i];
#pragma unroll
                for (int j = 0; j < 4; ++j) { const v4u x = xcur[j];
                    xc[0] += cw[j][0] * bflo(x.x); xc[1] += cw[j][1] * bfhi(x.x); xc[2] += cw[j][2] * bflo(x.y); xc[3] += cw[j][3] * bfhi(x.y);
                    xc[4] += cw[j][4] * bflo(x.z); xc[5] += cw[j][5] * bfhi(x.z); xc[6] += cw[j][6] * bflo(x.w); xc[7] += cw[j][7] * bfhi(x.w); }
                *(LAS v4u*)(lds + LQ_XCB + tt * 144 + q8 * 2) = (v4u){cvtpk(xc[0], xc[1]), cvtpk(xc[2], xc[3]), cvtpk(xc[4], xc[5]), cvtpk(xc[6], xc[7])};
                if ((q8 / LQ_NQ) == oq) { *(LAS f32x4*)(XCQ + tt * LQ_NQ + (q8 % LQ_NQ)) = (f32x4){xc[0], xc[1], xc[2], xc[3]}; *(LAS f32x4*)(XCQ + tt * LQ_NQ + (q8 % LQ_NQ) + 4) = (f32x4){xc[4], xc[5], xc[6], xc[7]}; }
            }
            __syncthreads();
            {
                const int tk = gt * 16 + i16;
                f32x4 ga = (f32x4){0.f, 0.f, 0.f, 0.f}, gx = (f32x4){0.f, 0.f, 0.f, 0.f};
#pragma unroll
                for (int ks = 0; ks < 2; ++ks) { const bf16x8 xf = *(const LAS bf16x8*)(lds + LQ_XCB + tk * 144 + ks * 64 + g4 * 16);
                    const bf16x8 wa = *(const LAS bf16x8*)(lds + LQ_WAT + (16 * got + i16) * 144 + ks * 64 + g4 * 16), wx = *(const LAS bf16x8*)(lds + LQ_WAT + LQ_NQ * 144 + (16 * got + i16) * 144 + ks * 64 + g4 * 16);
                    ga = MFMA16(wa, xf, ga); gx = MFMA16(wx, xf, gx); }
                const f32x4 xcv = *(const LAS f32x4*)(XCQ + tk * LQ_NQ + 16 * got + 4 * g4);
                f32x4 av, bv;
#pragma unroll
                for (int q = 0; q < 4; ++q) { const float la = -8.f * sigmoidf_(ga[q] + bav[q]) * spl[q], aq = exp_(la); av[q] = aq; bv[q] = sqrt_((1.f - aq) * (1.f + aq)) * sigmoidf_(gx[q] + bxv[q]) * xcv[q]; }
                *(LAS f32x4*)(AA + tk * LQ_NQ + 16 * got + 4 * g4) = av; *(LAS f32x4*)(BV + tk * LQ_NQ + 16 * got + 4 * g4) = bv;
            }
            __syncthreads();
            float av8[8], bv8[8];
            if (tid < 8 * LQ_NQ) {
                float P = 1.f, H = 0.f;
#pragma unroll
                for (int s = 0; s < 8; ++s) { const int p = seg * 8 + s, st = e ? 63 - p : p; av8[s] = AA[st * LQ_NQ + sch]; bv8[s] = BV[st * LQ_NQ + sch]; H = fmaf(av8[s], H, bv8[s]); P *= av8[s]; }
                SP[seg * LQ_NQ + sch] = P; SH[seg * LQ_NQ + sch] = H;
            }
            __syncthreads();
            if (tid < 8 * LQ_NQ) {
                float h = HC[(cc & 1) * LQ_NQ + sch];
                for (int s2 = 0; s2 < seg; ++s2) h = fmaf(SP[s2 * LQ_NQ + sch], h, SH[s2 * LQ_NQ + sch]);
#pragma unroll
                for (int s = 0; s < 8; ++s) { const int p = seg * 8 + s, st = e ? 63 - p : p; h = fmaf(av8[s], h, bv8[s]); HH[st * LQ_NQ + sch] = h; }
                if (seg == 7) HC[((cc + 1) & 1) * LQ_NQ + sch] = h;
            }
            __syncthreads();
            {
                const int n = tok0 + c * 64 + otok;
                const f32x4 hv = *(const LAS f32x4*)(HH + otok * LQ_NQ + oc4);
                float o0 = hv[0], o1 = hv[1], o2 = hv[2], o3 = hv[3];
                if (e) { o0 = (o0 + bflo(hfc.x)) * siluf_(bflo(glc.x)); o1 = (o1 + bfhi(hfc.x)) * siluf_(bfhi(glc.x)); o2 = (o2 + bflo(hfc.y)) * siluf_(bflo(glc.y)); o3 = (o3 + bfhi(hfc.y)) * siluf_(bfhi(glc.y)); }
                *(v2u*)(HF + (size_t)n * 256 + chq + oc4) = (v2u){cvtpk(o0, o1), cvtpk(o2, o3)};
            }
        }
#undef LQ_PREFETCH
        __syncthreads();
        if (tid < LQ_NQ && !lat) a->out[O_LRU + ((size_t)(b * 2 + layer) * 2 + e) * 256 + chq + tid] = HC[((L / 64) & 1) * LQ_NQ + tid];
    }
}

#define ATT_QK(S0_, S1_, KB_) do { \
        _Pragma("unroll") for (int i_ = 0; i_ < 16; ++i_) { S0_[i_] = 0.f; S1_[i_] = 0.f; } \
        _Pragma("unroll") for (int ks_ = 0; ks_ < 6; ++ks_) { \
            const bf16x8 a0_ = *(const LAS bf16x8*)((KB_) + r * ATT_KSTR + ks_ * 32 + hq * 16), a1_ = *(const LAS bf16x8*)((KB_) + (32 + r) * ATT_KSTR + ks_ * 32 + hq * 16); \
            S0_ = MFMA32(a0_, qf[ks_], S0_); S1_ = MFMA32(a1_, qf[ks_], S1_); } } while (0)
#define ATT_SOFTMAX_PV(S0_, S1_, VB_) do { \
        float mx_ = S0_[0]; \
        _Pragma("unroll") for (int i_ = 1; i_ < 16; ++i_) mx_ = fmaxf(mx_, S0_[i_]); \
        _Pragma("unroll") for (int i_ = 0; i_ < 16; ++i_) mx_ = fmaxf(mx_, S1_[i_]); \
        mx_ = fmaxf(mx_, __shfl_xor(mx_, 32)); \
        if (!__all(mx_ - m <= 8.f)) { const float mn_ = fmaxf(m, mx_), al_ = __builtin_amdgcn_exp2f(m - mn_); m = mn_; l *= al_; \
            _Pragma("unroll") for (int i_ = 0; i_ < 16; ++i_) { o0[i_] *= al_; o1[i_] *= al_; } } \
        float ps_ = 0.f; \
        _Pragma("unroll") for (int i_ = 0; i_ < 16; ++i_) { S0_[i_] = __builtin_amdgcn_exp2f(S0_[i_] - m); S1_[i_] = __builtin_amdgcn_exp2f(S1_[i_] - m); ps_ += S0_[i_] + S1_[i_]; } \
        l += ps_; \
        _Pragma("unroll") for (int ks_ = 0; ks_ < 4; ++ks_) { \
            v4u pw_; \
            if (ks_ == 0) { pw_.x = cvtpk(S0_[0], S0_[1]); pw_.y = cvtpk(S0_[2], S0_[3]); pw_.z = cvtpk(S0_[4], S0_[5]); pw_.w = cvtpk(S0_[6], S0_[7]); } \
            else if (ks_ == 1) { pw_.x = cvtpk(S0_[8], S0_[9]); pw_.y = cvtpk(S0_[10], S0_[11]); pw_.z = cvtpk(S0_[12], S0_[13]); pw_.w = cvtpk(S0_[14], S0_[15]); } \
            else if (ks_ == 2) { pw_.x = cvtpk(S1_[0], S1_[1]); pw_.y = cvtpk(S1_[2], S1_[3]); pw_.z = cvtpk(S1_[4], S1_[5]); pw_.w = cvtpk(S1_[6], S1_[7]); } \
            else { pw_.x = cvtpk(S1_[8], S1_[9]); pw_.y = cvtpk(S1_[10], S1_[11]); pw_.z = cvtpk(S1_[12], S1_[13]); pw_.w = cvtpk(S1_[14], S1_[15]); } \
            const bf16x8 pf_ = __builtin_bit_cast(bf16x8, pw_); \
            const v2u va0_ = *(const LAS v2u*)((VB_) + r * ATT_VSTR + ks_ * 32 + hq * 8), va1_ = *(const LAS v2u*)((VB_) + r * ATT_VSTR + ks_ * 32 + 16 + hq * 8); \
            const v2u vb0_ = *(const LAS v2u*)((VB_) + (32 + r) * ATT_VSTR + ks_ * 32 + hq * 8), vb1_ = *(const LAS v2u*)((VB_) + (32 + r) * ATT_VSTR + ks_ * 32 + 16 + hq * 8); \
            const v4u vwa_ = {va0_.x, va0_.y, va1_.x, va1_.y}, vwb_ = {vb0_.x, vb0_.y, vb1_.x, vb1_.y}; \
            o0 = MFMA32(__builtin_bit_cast(bf16x8, vwa_), pf_, o0); o1 = MFMA32(__builtin_bit_cast(bf16x8, vwb_), pf_, o1); } } while (0)
__device__ __forceinline__ void att_unit2(ArgsP a, LAS unsigned char* lds, int u) {
    const int tid = tid_(), lane = tid & 63, wave = tid >> 6, r = lane & 31, hq = lane >> 5;
    const bf16* KN = (const bf16*)(a->ws + WS_KN); const bf16* KR = (const bf16*)(a->ws + WS_KR); const bf16* VT = (const bf16*)(a->ws + WS_VT);
    bf16* Q = (bf16*)(a->ws + WS_Q); const bf16* G1 = (const bf16*)(a->ws + WS_G1);
    int b, h, n0, Lk, kidx0; size_t vbase;
    if (u < 512) { b = u >> 6; h = (u >> 3) & 7; n0 = T_CTX + b * 2048 + (u & 7) * 256; Lk = LK_LAT; kidx0 = T_CTX + b * LK_LAT; vbase = (size_t)VT_LAT + (size_t)(b * 8 + h) * 64 * LK_LAT; }
    else { const int uu = u - 512; b = uu >> 3; h = uu & 7; n0 = b * 256; Lk = 256; kidx0 = b * 256; vbase = (size_t)(b * 8 + h) * 64 * 256; }
    const int ntiles = Lk >> 6;
    const int n = n0 + wave * 32 + r;
    bf16x8 qf[6];
#pragma unroll
    for (int ks = 0; ks < 6; ++ks) qf[ks] = *(const bf16x8*)(Q + (size_t)n * 768 + h * 96 + ks * 16 + 8 * hq);
    const int key_k = tid >> 3, ck = tid & 7, key_r = (tid >> 2) & 63, cr = tid & 3;
    const bf16* gk = KN + (size_t)(kidx0 + key_k) * 512 + h * 64 + ck * 8;
    const bf16* gr = KR + (size_t)(kidx0 + key_r) * 32 + cr * 8;
    const bf16* gv = VT + (size_t)(kidx0 + key_k) * 512 + h * 64 + ck * 8;
    const unsigned sk = key_k * ATT_KSTR + ck * 16, sr = key_r * ATT_KSTR + 128 + cr * 16, sv = ATT_VOFF + (ck * 8) * ATT_VSTR + key_k * 2;
    v4u rk, rr = {0u, 0u, 0u, 0u}, rv;
#define ATT_LOAD(j_) do { rk = *(const v4u*)(gk + (size_t)(j_) * 64 * 512); if (tid < 256) rr = *(const v4u*)(gr + (size_t)(j_) * 64 * 32); rv = *(const v4u*)(gv + (size_t)(j_) * 64 * 512); } while (0)
#define ATT_STORE(B_) do { LAS unsigned char* nb_ = lds + (B_) * ATT_STAGE; *(LAS v4u*)(nb_ + sk) = rk; if (tid < 256) *(LAS v4u*)(nb_ + sr) = rr; \
        LAS unsigned char* vp_ = nb_ + sv; \
        *(LAS bf16*)(vp_) = (bf16)(rv.x & 0xffffu); *(LAS bf16*)(vp_ + ATT_VSTR) = (bf16)(rv.x >> 16); *(LAS bf16*)(vp_ + 2 * ATT_VSTR) = (bf16)(rv.y & 0xffffu); *(LAS bf16*)(vp_ + 3 * ATT_VSTR) = (bf16)(rv.y >> 16); \
        *(LAS bf16*)(vp_ + 4 * ATT_VSTR) = (bf16)(rv.z & 0xffffu); *(LAS bf16*)(vp_ + 5 * ATT_VSTR) = (bf16)(rv.z >> 16); *(LAS bf16*)(vp_ + 6 * ATT_VSTR) = (bf16)(rv.w & 0xffffu); *(LAS bf16*)(vp_ + 7 * ATT_VSTR) = (bf16)(rv.w >> 16); } while (0)
    ATT_LOAD(0);
    __syncthreads();
    ATT_STORE(0);
    ATT_LOAD(1);
    ATT_STORE(1);
    __syncthreads();
    f32x16 o0, o1, sa0, sa1, sb0, sb1;
#pragma unroll
    for (int i = 0; i < 16; ++i) { o0[i] = 0.f; o1[i] = 0.f; }
    float m = -1e30f, l = 0.f;
    ATT_QK(sa0, sa1, lds);
    int bcur = 0;
    for (int j = 0; j < ntiles; j += 2) {
        {
            const int b1 = bcur == 2 ? 0 : bcur + 1, b2 = b1 == 2 ? 0 : b1 + 1;
            if (j + 2 < ntiles) ATT_LOAD(j + 2);
            ATT_QK(sb0, sb1, lds + b1 * ATT_STAGE);
            ATT_SOFTMAX_PV(sa0, sa1, lds + bcur * ATT_STAGE + ATT_VOFF);
            if (j + 2 < ntiles) ATT_STORE(b2);
            __syncthreads();
            bcur = b1;
        }
        {
            const int b1 = bcur == 2 ? 0 : bcur + 1, b2 = b1 == 2 ? 0 : b1 + 1;
            if (j + 3 < ntiles) ATT_LOAD(j + 3);
            if (j + 2 < ntiles) ATT_QK(sa0, sa1, lds + b1 * ATT_STAGE);
            ATT_SOFTMAX_PV(sb0, sb1, lds + bcur * ATT_STAGE + ATT_VOFF);
            if (j + 3 < ntiles) ATT_STORE(b2);
            __syncthreads();
            bcur = b1;
        }
    }
#undef ATT_LOAD
#undef ATT_STORE
    l += __shfl_xor(l, 32);
    const float inv = rcp_(l);
#pragma unroll
    for (int mt = 0; mt < 2; ++mt)
#pragma unroll
        for (int g = 0; g < 4; ++g) {
            const int dv0 = 32 * mt + 8 * g + 4 * hq;
            const v2u gm = *(const v2u*)(G1 + (size_t)n * G1W + C_GM + h * 64 + dv0);
            const float x0 = (mt ? o1[4 * g + 0] : o0[4 * g + 0]) * inv, x1 = (mt ? o1[4 * g + 1] : o0[4 * g + 1]) * inv, x2 = (mt ? o1[4 * g + 2] : o0[4 * g + 2]) * inv, x3 = (mt ? o1[4 * g + 3] : o0[4 * g + 3]) * inv;
            v2u ov; ov.x = cvtpk(x0 * siluf_(bflo(gm.x)), x1 * siluf_(bfhi(gm.x))); ov.y = cvtpk(x2 * siluf_(bflo(gm.y)), x3 * siluf_(bfhi(gm.y)));
            *(v2u*)(Q + (size_t)n * 768 + h * 96 + dv0) = ov;
        }
}
constexpr int N_PHASES = 14;
#ifndef MK_PER_PHASE
#define MK_PER_PHASE 0
#endif
#ifndef VAR_GEMM
#define VAR_GEMM 1
#endif
#ifndef VAR_A2
#define VAR_A2 1
#endif
#ifndef VAR_ATT
#define VAR_ATT 1
#endif
#ifndef VAR_RWKV
#define VAR_RWKV 1
#endif
#ifndef VAR_LRU
#define VAR_LRU 1
#endif

__device__ __forceinline__ void phase_b(ArgsP a, LAS unsigned char* lds, int layer) {
    volatile LAS unsigned* MISC = (volatile LAS unsigned*)(lds + LDS_MISC);
    unsigned* head = (unsigned*)(a->ws + WS_CTL) + CW_Q + layer * 64;
    for (;;) {
        __syncthreads();
        if (tid_() == 0) MISC[16] = atomicAdd(head, 1u);
        __syncthreads();
        const int idx = (int)MISC[16];
        if (idx >= 1408) break;
#ifdef PROBE_UNIT1
        const unsigned long long pt0_ = __builtin_amdgcn_s_memrealtime();
#endif
        if (idx < 64) rwkv_unit_mfma(a, lds, layer, idx);
        else if (idx < 128) lru_unit_q(a, lds, layer, idx - 64);
        else if (idx < 640) att_unit2(a, lds, idx - 128);
        else if (idx < 896) rwkv_unit_mfma(a, lds, layer, 64 + idx - 640);
        else if (idx < 1152) lru_unit_q(a, lds, layer, 64 + idx - 896);
        else att_unit2(a, lds, 512 + idx - 1152);
#ifdef PROBE_UNIT1
        if (tid_() == 0 && layer == 0) { const unsigned d_ = (unsigned)(__builtin_amdgcn_s_memrealtime() - pt0_);
            const int ty_ = idx < 64 ? 0 : idx < 128 ? 1 : idx < 640 ? 2 : idx < 896 ? 3 : idx < 1152 ? 4 : 5;
            atomicMax((unsigned*)(a->ws + WS_CTL) + CW_Q + 1024 + ty_ * 64, d_); }
#endif
    }
}

#if MK_PER_PHASE
template <int SUB> __global__ void __launch_bounds__(NTHREADS, 2) mk_phase(Args args, int layer) {
    extern __shared__ __attribute__((aligned(16))) unsigned char lds_raw[];
    LAS unsigned char* lds = (LAS unsigned char*)lds_raw;
    ArgsP a = (ArgsP)__builtin_amdgcn_kernarg_segment_ptr();
    if (SUB == 0) phase_p0(a, lds);
    if (SUB == 1) phase_a0(a, layer);
    if (SUB == 2) { if (VAR_GEMM) phase_a1_pg8(a, lds, layer); else phase_a1_naive(a, layer); }
    if (SUB == 3) { if (VAR_A2) { for (int u = blockIdx.x; u < T / 64 + 32; u += gridDim.x) a2_unit(a, lds, layer, u); } else phase_a2_naive(a, lds, layer); }
    if (SUB == 4) { if (VAR_ATT) { for (int u = blockIdx.x; u < 768; u += gridDim.x) att_unit(a, lds, u); } else phase_att_naive(a); }
    if (SUB == 5) { for (int u = blockIdx.x; u < 320; u += gridDim.x) { __syncthreads(); if (VAR_RWKV) rwkv_unit_mfma(a, lds, layer, u); else rwkv_unit_seq(a, lds, layer, u); } }
    if (SUB == 6) { for (int u = blockIdx.x; u < 160; u += gridDim.x) { __syncthreads(); if (VAR_LRU) lru_unit_mfma(a, lds, layer, u); else lru_unit_seq(a, lds, layer, u); } }
    if (SUB == 7) phase_c1(a, layer);
    if (SUB == 8) { if (VAR_GEMM) phase_c2_pg8(a, lds, layer); else phase_c2_naive(a, layer); }
    if (SUB == 9) phase_final(a);
}
#else
#define ARGS_VIEW() ({ ArgsP p_ = (ArgsP)__builtin_amdgcn_kernarg_segment_ptr(); asm volatile("" : "+s"(p_)); p_; })
__global__ void __launch_bounds__(NTHREADS, 2) mk_fwd(Args args) {
    extern __shared__ __attribute__((aligned(16))) unsigned char lds_raw[];
    LAS unsigned char* lds = (LAS unsigned char*)lds_raw;
    volatile LAS unsigned* MISC = (volatile LAS unsigned*)(lds + LDS_MISC);
    for (int u = threadIdx.x; u < 64; u += NTHREADS) MISC[u] = 0u;
    __syncthreads();
    XcdBarrier bar;
    { ArgsP a = ARGS_VIEW(); bar = xcd_barrier_post((unsigned*)(a->ws + WS_CTL) + CW_BAR, MISC + 8); }
    int lo, hi; { ArgsP a = ARGS_VIEW(); lo = a->ph_lo; hi = a->ph_hi; }
#define IN(k) (lo <= (k) && (k) < hi)
#ifdef PROBE_MASK1
#define STAMP(k) do { if (bid_() == 0 && tid_() == 0) { const unsigned long long t_ = __builtin_amdgcn_s_memrealtime(); MISC[32 + 2 * (k)] = (unsigned)t_; MISC[33 + 2 * (k)] = (unsigned)(t_ >> 32); } } while (0)
#else
#define STAMP(k) do { } while (0)
#endif
#define SEAM(k) do { if (IN(k) && IN((k) + 1)) xcd_barrier(bar); STAMP((k) + 1); } while (0)
#ifndef NO_P0
    STAMP(0);
    if (IN(0)) { ArgsP a = ARGS_VIEW(); phase_p0(a, lds); }
#endif
    SEAM(0);
    for (int layer = 0; layer < 2; ++layer) {
        const int p = 1 + 6 * layer;
#ifndef NO_A0
        if (IN(p + 0)) { { ArgsP a = ARGS_VIEW(); phase_a0(a, layer); } if (layer == 0) { ArgsP a = ARGS_VIEW(); phase_p0_weights(a, lds); } }
#endif
        SEAM(p + 0);
#ifndef NO_A1
        if (IN(p + 1)) { ArgsP a = ARGS_VIEW(); phase_a1_pg8(a, lds, layer); }
#endif
        SEAM(p + 1);
#ifndef NO_A2
        if (IN(p + 2)) { { ArgsP a = ARGS_VIEW(); phase_a2a(a, layer); } xcd_barrier(bar); { ArgsP a = ARGS_VIEW(); phase_a2b(a, lds, layer); } }
        if (0) { ArgsP a = ARGS_VIEW(); for (int u = bid_(); u < T / 64 + 32; u += grid_()) {
#ifdef PROBE_UNIT1
            const unsigned long long pt0_ = __builtin_amdgcn_s_memrealtime();
#endif
            a2_unit(a, lds, layer, u);
#ifdef PROBE_A2_TWICE
            a2_unit(a, lds, layer, u);
#endif
#ifdef PROBE_UNIT1
            __syncthreads();
            if (tid_() == 0 && layer == 0) atomicMax((unsigned*)(a->ws + WS_CTL) + CW_Q + 1024 + (u < 256 ? 6 : 7) * 64, (unsigned)(__builtin_amdgcn_s_memrealtime() - pt0_));
#endif
        } }
#endif
        SEAM(p + 2);
#ifndef NO_B
        if (IN(p + 3)) { ArgsP a = ARGS_VIEW(); phase_b(a, lds, layer); }
#endif
        SEAM(p + 3);
#ifndef NO_C1
        if (IN(p + 4)) { ArgsP a = ARGS_VIEW(); phase_c1(a, layer); }
#endif
        SEAM(p + 4);
#ifndef NO_C2
        if (IN(p + 5)) { ArgsP a = ARGS_VIEW(); phase_c2_pg8(a, lds, layer); }
#endif
        SEAM(p + 5);
    }
    if (IN(N_PHASES - 1)) { ArgsP a = ARGS_VIEW(); phase_final(a); }
#ifdef PROBE_MASK1
    STAMP(14);
    __syncthreads();
    if (bid_() == 0) {
        ArgsP a = ARGS_VIEW();
        float t1 = 0.f, t2 = 0.f;
        for (int k = 0; k < 14; ++k) { const unsigned long long s0 = ((unsigned long long)MISC[33 + 2 * k] << 32) | MISC[32 + 2 * k], s1 = ((unsigned long long)MISC[35 + 2 * k] << 32) | MISC[34 + 2 * k];
            const float us = (float)(s1 - s0) * 0.01f; if ((PROBE_MASK1 >> k) & 1) t1 += us; if ((PROBE_MASK2 >> k) & 1) t2 += us; }
#ifdef PROBE_UNIT1
        t1 = (float)((unsigned*)(a->ws + WS_CTL))[CW_Q + 1024 + PROBE_UNIT1 * 64] * 0.01f; t2 = (float)((unsigned*)(a->ws + WS_CTL))[CW_Q + 1024 + PROBE_UNIT2 * 64] * 0.01f;
#endif
        for (int i = tid_(); i < 32768; i += NTHREADS) a->out[O_LRU + i] *= (1.f + t2 * (1.f / 2000.f));
        if (tid_() == 0) a->out[0] += 2.f + t1 * 0.01f;
    }
#endif
#undef IN
#undef SEAM
}

#endif

extern "C" void kernel_launch(void* const* d_in, const int* in_sizes, int n_in, void* d_out, int out_size, void* d_ws, size_t ws_size, hipStream_t stream) {
    static int grid = 0;
    if (grid == 0) {
        if (n_in != N_IN || ws_size < WS_END) { fprintf(stderr, "kernel_launch: unexpected n_in %d / ws_size %zu\n", n_in, ws_size); grid = -1; return; }
        int dev = 0, cus = 0;
        if (hipGetDevice(&dev) != hipSuccess || hipDeviceGetAttribute(&cus, hipDeviceAttributeMultiprocessorCount, dev) != hipSuccess) { grid = -1; return; }
#if MK_PER_PHASE
#define SA(SUB) if (hipFuncSetAttribute((const void*)mk_phase<SUB>, hipFuncAttributeMaxDynamicSharedMemorySize, LDS_BYTES) != hipSuccess) { fprintf(stderr, "kernel_launch: hipFuncSetAttribute failed\n"); grid = -1; return; }
        SA(0) SA(1) SA(2) SA(3) SA(4) SA(5) SA(6) SA(7) SA(8) SA(9)
#undef SA
#else
        if (hipFuncSetAttribute((const void*)mk_fwd, hipFuncAttributeMaxDynamicSharedMemorySize, LDS_BYTES) != hipSuccess) { fprintf(stderr, "kernel_launch: hipFuncSetAttribute failed\n"); grid = -1; return; }
        int per_cu = 0;
        if (hipOccupancyMaxActiveBlocksPerMultiprocessor(&per_cu, (const void*)mk_fwd, NTHREADS, LDS_BYTES) != hipSuccess || per_cu < 1) fprintf(stderr, "kernel_launch: occupancy query reports %d\n", per_cu);
        (void)hipGetLastError();
#endif
        grid = cus;
    }
    if (grid < 0) return;
    if (hipMemsetAsync((char*)d_ws + WS_CTL, 0, CTL_ZERO_BYTES, stream) != hipSuccess) return;
    Args a{};
    for (int i = 0; i < N_IN; ++i) a.in[i] = (const float*)d_in[i];
    a.out = (float*)d_out; a.ws = (unsigned char*)d_ws;
#if MK_PER_PHASE
#define LP(SUB, layer) hipLaunchKernelGGL(mk_phase<SUB>, dim3(grid), dim3(NTHREADS), LDS_BYTES, stream, a, layer)
    LP(0, 0);
    for (int layer = 0; layer < 2; ++layer) { LP(1, layer); LP(2, layer); LP(3, layer); LP(4, layer); LP(5, layer); LP(6, layer); LP(7, layer); LP(8, layer); }
    LP(9, 0);
#undef LP
#else
    a.ph_lo = 0; a.ph_hi = N_PHASES;
    hipLaunchKernelGGL(mk_fwd, dim3(grid), dim3(NTHREADS), LDS_BYTES, stream, a);
#endif
}
```

```cpp
#define MK_PER_PHASE 0
#include <hip/hip_runtime.h>
#include <cstdio>
#include <cstdint>

#define GAS __attribute__((address_space(1)))
#define LAS __attribute__((address_space(3)))
typedef unsigned short bf16;
typedef unsigned v4u __attribute__((ext_vector_type(4)));
typedef unsigned v2u __attribute__((ext_vector_type(2)));
typedef float f32x4 __attribute__((ext_vector_type(4)));
typedef short bf16x8 __attribute__((ext_vector_type(8)));

constexpr int D = 1024, T_CTX = 8192, T_LAT = 16384, T = 24576, L_CTX = 256, L_LAT = 2048, PAST = 256;
constexpr int NIN = 2816, G1W = 2304, G2W = 512;
constexpr int C_R = 0, C_K = 256, C_V = 512, C_G = 768, C_GM = 1024, C_XL = 1536, C_GL = 1792, C_LORA = 2048;
constexpr int LK_LAT = PAST + L_LAT;
constexpr int TK = T_CTX + 8 * LK_LAT;
constexpr int VT_LAT = 32 * 8 * 64 * 256;
constexpr float LN_EPS = 1e-5f, GN_EPS = 64e-5f;
constexpr float ALPHA = 1.4142135623730951f;
constexpr float QSCALE = 0.10206207261596575f * 1.4426950408889634f;
constexpr size_t O_Y = 0, O_RW = 25165824, O_CKV = 27262976, O_KR = 29360128, O_LRU = 29884416;
constexpr size_t MiB = 1u << 20;
constexpr size_t WS_CTL = 0, CTL_ZERO_BYTES = 1 * MiB;
constexpr size_t WS_MOD = 256 * 1024;
constexpr size_t WS_ROPE = 1 * MiB;
constexpr size_t WS_STATS = 1536 * 1024;
constexpr size_t WS_WUQ = 2 * MiB;
constexpr size_t WS_WUKV = 3 * MiB;
constexpr size_t WS_WIN = 4 * MiB;
constexpr size_t WS_WOUT = 16 * MiB;
constexpr size_t WS_G1 = 20 * MiB;
constexpr size_t WS_G2 = 128 * MiB;
constexpr size_t WS_Q = 152 * MiB;
constexpr size_t WS_U = 152 * MiB;
constexpr size_t WS_KN = 188 * MiB;
constexpr size_t WS_KR = 214 * MiB;
constexpr size_t WS_VT = 216 * MiB;
constexpr size_t WS_YMIX = 188 * MiB;
constexpr size_t WS_HF = 242 * MiB;
constexpr size_t WS_END = 254 * MiB;
constexpr int CW_BAR = 4096;
constexpr int CW_Q = 16384;

__device__ __forceinline__ float bf2f(unsigned b) { return __uint_as_float(b << 16); }
__device__ __forceinline__ float bflo(unsigned w) { return __uint_as_float(w << 16); }
__device__ __forceinline__ float bfhi(unsigned w) { return __uint_as_float(w & 0xffff0000u); }
__device__ __forceinline__ unsigned f2bf(float f) { unsigned u = __float_as_uint(f); return (u + 0x7fffu + ((u >> 16) & 1u)) >> 16; }
__device__ __forceinline__ unsigned pk2(float lo, float hi) { return f2bf(lo) | (f2bf(hi) << 16); }
__device__ __forceinline__ float rcp_(float x) { return __builtin_amdgcn_rcpf(x); }
__device__ __forceinline__ float exp_(float x) { return __builtin_amdgcn_exp2f(x * 1.4426950408889634f); }
__device__ __forceinline__ float sqrt_(float x) { return __builtin_amdgcn_sqrtf(x); }
__device__ __forceinline__ float rsqrt_(float x) { return __builtin_amdgcn_rsqf(x); }
__device__ __forceinline__ float sigmoidf_(float x) { return rcp_(1.f + exp_(-x)); }
__device__ __forceinline__ float siluf_(float x) { return x * rcp_(1.f + exp_(-x)); }
template <int CTRL> __device__ __forceinline__ float dpp_f(float old, float x) { return __builtin_bit_cast(float, __builtin_amdgcn_update_dpp(__builtin_bit_cast(int, old), __builtin_bit_cast(int, x), CTRL, 0xf, 0xf, false)); }
__device__ __forceinline__ float row16_sum(float x) { x += dpp_f<0x128>(0.f, x); x += dpp_f<0x124>(0.f, x); x += dpp_f<0x122>(0.f, x); x += dpp_f<0x121>(0.f, x); return x; }
__device__ __forceinline__ float wave_sum_fast(float x) { x = row16_sum(x); x += __shfl_xor(x, 16); x += __shfl_xor(x, 32); return x; }
__device__ __forceinline__ float row16_prefix_prod(float x) { x *= dpp_f<0x111>(1.f, x); x *= dpp_f<0x112>(1.f, x); x *= dpp_f<0x114>(1.f, x); x *= dpp_f<0x118>(1.f, x); return x; }
__device__ __forceinline__ float wave_sum(float v) { return wave_sum_fast(v); }
__device__ __forceinline__ int tid_() { int t = threadIdx.x; asm volatile("" : "+v"(t)); return t; }
__device__ __forceinline__ int bid_() { int b = blockIdx.x; asm volatile("" : "+s"(b)); return b; }
__device__ __forceinline__ int grid_() { int g = gridDim.x; asm volatile("" : "+s"(g)); return g; }
typedef float f32x16 __attribute__((ext_vector_type(16)));
typedef float f32x2_t __attribute__((ext_vector_type(2)));
typedef __bf16 bf16x2_t __attribute__((ext_vector_type(2)));
__device__ __forceinline__ unsigned cvtpk(float lo, float hi) { const f32x2_t v = {lo, hi}; return __builtin_bit_cast(unsigned, __builtin_convertvector(v, bf16x2_t)); }
#define XB_TMO      128
#define XB_XCNT(j)  (256  + 64 * (j))
#define XB_XSUB(j)  (1280 + 64 * (j))
#define XB_XGEN(j)  (2304 + 64 * (j))
#define XB_TOP      3328
#define XB_TOPGEN   3392
#define XCD_BAR_WORDS 3456
#define XB_SPIN_CAP (1u << 24)

__device__ __forceinline__ unsigned xb_ld(unsigned* p)              { return __hip_atomic_load(p, __ATOMIC_RELAXED, __HIP_MEMORY_SCOPE_AGENT); }
__device__ __forceinline__ unsigned xb_add(unsigned* p, unsigned v) { return __hip_atomic_fetch_add(p, v, __ATOMIC_RELAXED, __HIP_MEMORY_SCOPE_AGENT); }
__device__ __forceinline__ unsigned xb_xcc_id() { return (unsigned)__builtin_amdgcn_s_getreg((3 << 11) | 20) & 0xFu; }
#define XB_SPIN(cond, bar) do { unsigned _sp = 0; while (cond) { __builtin_amdgcn_s_sleep(1); \
    if ((++_sp & 255u) == 0u) { if (xb_ld(&(bar)[XB_TMO])) break; if (_sp > XB_SPIN_CAP) { atomicAdd(&(bar)[XB_TMO], 1u); break; } } } } while (0)

struct XcdBarrier {
    unsigned* bar; unsigned x;
    volatile LAS unsigned* st;
};

__device__ __forceinline__ XcdBarrier xcd_barrier_post(unsigned* bar, volatile LAS unsigned* st) {
    XcdBarrier b; b.bar = bar; b.x = xb_xcc_id(); b.st = st;
    if (threadIdx.x == 0) (void)xb_add(&bar[XB_XCNT(b.x)], 1u);
    return b;
}
__device__ __forceinline__ void xcd_barrier_complete(unsigned* bar, unsigned x, unsigned& nloc, unsigned& nx) {
    const unsigned G = gridDim.x * gridDim.y * gridDim.z;
    unsigned sum, cnt, mine, sp = 0u;
    for (;;) {
        sum = 0u; cnt = 0u; mine = 0u;
#pragma unroll
        for (unsigned j = 0; j < 16; ++j) { const unsigned c = xb_ld(&bar[XB_XCNT(j)]); sum += c; cnt += (c > 0u) ? 1u : 0u; mine = (j == x) ? c : mine; }
        if (sum == G) break;
        __builtin_amdgcn_s_sleep(1);
        if ((++sp & 255u) == 0u) { if (xb_ld(&bar[XB_TMO])) break; if (sp > XB_SPIN_CAP) { atomicAdd(&bar[XB_TMO], 1u); break; } }
    }
    nloc = mine > 0u ? mine : 1u; nx = cnt > 0u ? cnt : 1u;
}

__device__ __forceinline__ void xcd_barrier(const XcdBarrier& b) {
    asm volatile("s_waitcnt vmcnt(0)" ::: "memory");
    __syncthreads();
    if (threadIdx.x == 0) {
        unsigned* bar = b.bar;
        __builtin_amdgcn_s_waitcnt(0);
        unsigned nloc = b.st[0], nx = b.st[1];
        if (nloc == 0u) { xcd_barrier_complete(bar, b.x, nloc, nx); b.st[0] = nloc; b.st[1] = nx; }
        const unsigned old = xb_add(&bar[XB_XSUB(b.x)], 1u);
        const unsigned gen = old / nloc;
        if (old + 1u == (gen + 1u) * nloc) {
            __builtin_amdgcn_fence(__ATOMIC_RELEASE, "agent");
            asm volatile("s_waitcnt vmcnt(0)" ::: "memory");
            const unsigned og = xb_add(&bar[XB_TOP], 1u);
            const unsigned tg = og / nx;
            if (og + 1u == (tg + 1u) * nx) xb_add(&bar[XB_TOPGEN], 1u);
            else XB_SPIN(xb_ld(&bar[XB_TOPGEN]) == tg, bar);
            __builtin_amdgcn_fence(__ATOMIC_ACQUIRE, "agent");
            xb_add(&bar[XB_XGEN(b.x)], 1u);
            asm volatile("s_waitcnt vmcnt(0)" ::: "memory");
        } else {
            XB_SPIN(xb_ld(&bar[XB_XGEN(b.x)]) == gen, bar);
            __builtin_amdgcn_fence(__ATOMIC_ACQUIRE, "agent");
            asm volatile("s_waitcnt vmcnt(0)" ::: "memory");
        }
    }
    __syncthreads();
}
enum { I_XP = 0, I_XS, I_SRW, I_CCKV, I_CKR, I_SLRU, I_C, I_CCTX, I_WMOD, I_BMOD, I_WIN, I_W0, I_W1, I_W2, I_A0, I_A1, I_A2, I_KK, I_KA, I_RK,
       I_LNXG, I_LNXB, I_QNORM, I_WUQ, I_KVNORM, I_WUKV, I_CONVW, I_CONVB, I_WA, I_BA, I_WX, I_BX, I_LAMBDA, I_WOUT, I_LNG, I_LNB, N_IN };
struct Args { const float* in[N_IN]; float* out; unsigned char* ws; int ph_lo, ph_hi; };
typedef const Args __attribute__((address_space(4)))* ArgsP;
constexpr int NTHREADS = 512;
constexpr int LDS_MISC = 139264;
constexpr int LDS_BYTES = 147456;

struct Tok { int n, b, t, L, lat, modrow, tok0, kidx; };
__device__ __forceinline__ Tok tok_of(int n) {
    Tok k; k.n = n;
    if (n < T_CTX) { k.lat = 0; k.b = n >> 8; k.t = n & 255; k.L = L_CTX; k.modrow = 0; k.tok0 = k.b * 256; k.kidx = n; }
    else { const int m = n - T_CTX; k.lat = 1; k.b = m >> 11; k.t = m & 2047; k.L = L_LAT; k.modrow = 1 + k.b; k.tok0 = T_CTX + k.b * 2048; k.kidx = T_CTX + k.b * LK_LAT + PAST + k.t; }
    return k;
}
__device__ __forceinline__ const float* xrow_src(ArgsP a, int layer, int n) {
    if (layer == 0) return n < T_CTX ? a->in[I_XP] + (size_t)n * D : a->in[I_XS] + (size_t)(n - T_CTX) * D;
    return a->out + (size_t)n * D;
}
__device__ __forceinline__ float dot8(v4u a, v4u b, float acc) {
    acc = fmaf(bflo(a.x), bflo(b.x), acc); acc = fmaf(bfhi(a.x), bfhi(b.x), acc);
    acc = fmaf(bflo(a.y), bflo(b.y), acc); acc = fmaf(bfhi(a.y), bfhi(b.y), acc);
    acc = fmaf(bflo(a.z), bflo(b.z), acc); acc = fmaf(bfhi(a.z), bfhi(b.z), acc);
    acc = fmaf(bflo(a.w), bflo(b.w), acc); acc = fmaf(bfhi(a.w), bfhi(b.w), acc);
    return acc;
}

__device__ __forceinline__ void tr_item(const float* src, int ld, int col0, int k0, bf16* WT, int K, int row0, float scale, LAS float* scr, int lane) {
    {
        const int kr = lane >> 3, n4 = (lane & 7) * 4;
        f32x4 v[8];
#pragma unroll
        for (int i = 0; i < 8; ++i) v[i] = src ? *(const f32x4*)(src + (size_t)(k0 + i * 8 + kr) * ld + col0 + n4) : (f32x4){0.f, 0.f, 0.f, 0.f};
#pragma unroll
        for (int i = 0; i < 8; ++i) { LAS float* d = scr + (i * 8 + kr) * 33 + n4; d[0] = v[i].x * scale; d[1] = v[i].y * scale; d[2] = v[i].z * scale; d[3] = v[i].w * scale; }
    }
    asm volatile("s_waitcnt lgkmcnt(0)" ::: "memory");
    const int c = lane & 7;
#pragma unroll
    for (int j = 0; j < 4; ++j) { const int n = (lane >> 3) + 8 * j; const LAS float* s = scr + (8 * c) * 33 + n;
        v4u o; o.x = pk2(s[0 * 33], s[1 * 33]); o.y = pk2(s[2 * 33], s[3 * 33]); o.z = pk2(s[4 * 33], s[5 * 33]); o.w = pk2(s[6 * 33], s[7 * 33]);
        *(v4u*)(WT + (size_t)(row0 + n) * K + k0 + 8 * c) = o; }
    asm volatile("s_waitcnt lgkmcnt(0)" ::: "memory");
}
__device__ __forceinline__ void rope_angle(int t, int i, float& c, float& s) {
    const int row = t >> 6, col = t & 63; const int ii = i & 7;
    const float inv = exp2f(-(float)ii * (13.287712379549449f / 8.f));
    const float ang = (float)(i < 8 ? row : col) * inv;
    c = cosf(ang); s = sinf(ang);
}
__device__ __forceinline__ void phase_p0_weights(ArgsP a, LAS unsigned char* lds) {
    const int tid = tid_(), lane = tid & 63, wave = tid >> 6, G = grid_();
    unsigned char* ws = a->ws;
    LAS float* scr = (LAS float*)(lds + wave * 8704);
    const int gw = bid_() * 8 + wave, NGW = G * 8;
    constexpr int N_WIN = 2 * 16 * 88, N_WOUT = 2 * 16 * 32, N_WUQ = 2 * 4 * 24, N_WUKV = 2 * 4 * 32;
    for (int it = gw; it < N_WIN + N_WOUT + N_WUQ + N_WUKV; it += NGW) {
        int r = it;
        if (r < N_WIN) {
            const int l = r / (16 * 88), kb = (r / 88) % 16, nb = r % 88, j0 = nb * 32;
            const float* src; int ld, col0;
            const float* win = a->in[I_WIN] + (size_t)l * 1024 * 2464;
            if (j0 < 1024) { src = win; ld = 2464; col0 = j0; }
            else if (j0 < 1536) { src = win; ld = 2464; col0 = 1440 + (j0 - 1024); }
            else if (j0 < 1792) { src = win; ld = 2464; col0 = 1952 + (j0 - 1536); }
            else if (j0 < 2048) { src = win; ld = 2464; col0 = 2208 + (j0 - 1792); }
            else if (j0 < 2304) { const int q = (j0 - 2048) >> 6; src = (q < 2 ? a->in[I_W1] : a->in[I_A1]) + (size_t)(l * 2 + (q & 1)) * 1024 * 64; ld = 64; col0 = (j0 - 2048) & 63; }
            else if (j0 < 2560) { src = win; ld = 2464; col0 = 1024 + (j0 - 2304); }
            else if (j0 < 2688) { src = win; ld = 2464; col0 = 1280 + (j0 - 2560); }
            else if (j0 < 2720) { src = win; ld = 2464; col0 = 1408 + (j0 - 2688); }
            else { src = nullptr; ld = 0; col0 = 0; }
            tr_item(src, ld, col0, kb * 64, (bf16*)(ws + WS_WIN) + (size_t)l * NIN * 1024, 1024, j0, 1.f, scr, lane);
            continue;
        }
        r -= N_WIN;
        if (r < N_WOUT) { const int l = r / (16 * 32), kb = (r / 32) % 16, nb = r % 32;
            tr_item(a->in[I_WOUT] + (size_t)l * 1024 * 1024, 1024, nb * 32, kb * 64, (bf16*)(ws + WS_WOUT) + (size_t)l * 1024 * 1024, 1024, nb * 32, 1.f, scr, lane); continue; }
        r -= N_WOUT;
        if (r < N_WUQ) { const int l = r / (4 * 24), kb = (r / 24) % 4, nb = r % 24;
            tr_item(a->in[I_WUQ] + (size_t)l * 256 * 768, 768, nb * 32, kb * 64, (bf16*)(ws + WS_WUQ) + (size_t)l * 768 * 256, 256, nb * 32, QSCALE, scr, lane); continue; }
        r -= N_WUQ;
        { const int l = r / (4 * 32), kb = (r / 32) % 4, nb = r % 32;
            tr_item(kb < 2 ? a->in[I_WUKV] + (size_t)l * 128 * 1024 : nullptr, 1024, nb * 32, kb * 64, (bf16*)(ws + WS_WUKV) + (size_t)l * 1024 * 256, 256, nb * 32, 1.f, scr, lane); }
    }
}
__device__ __forceinline__ void phase_p0(ArgsP a, LAS unsigned char* lds) {
    const int tid = tid_(), G = grid_();
    unsigned char* ws = a->ws;
    { float* ROPE = (float*)(ws + WS_ROPE);
      for (int i = bid_() * NTHREADS + tid; i < 2048 * 16; i += G * NTHREADS) { float c, s; rope_angle(i >> 4, i & 15, c, s); ROPE[i * 2] = c; ROPE[i * 2 + 1] = s; } }
    float* MOD = (float*)(ws + WS_MOD);
    LAS float* SIL = (LAS float*)lds;
    for (int it = bid_(); it < 2 * 6 * 32; it += G) {
        const int l = it / 192, nb = (it / 32) % 6, kq = it % 32, col = nb * 512 + tid;
        __syncthreads();
        if (tid < 288) { const int j = tid >> 5, k = kq * 32 + (tid & 31); const float cj = (j == 0) ? a->in[I_CCTX][k] : a->in[I_C][(j - 1) * 1024 + k]; SIL[tid] = siluf_(cj); }
        float w[32];
#pragma unroll
        for (int kk = 0; kk < 32; ++kk) w[kk] = a->in[I_WMOD][((size_t)l * 1024 + kq * 32 + kk) * 3072 + col];
        __syncthreads();
        const float bias = (kq == 0) ? a->in[I_BMOD][l * 3072 + col] : 0.f;
#pragma unroll
        for (int j = 0; j < 9; ++j) { float acc = bias;
#pragma unroll
            for (int k4 = 0; k4 < 8; ++k4) { const f32x4 sv = *(const LAS f32x4*)(SIL + j * 32 + k4 * 4); acc = fmaf(sv.x, w[k4 * 4], acc); acc = fmaf(sv.y, w[k4 * 4 + 1], acc); acc = fmaf(sv.z, w[k4 * 4 + 2], acc); acc = fmaf(sv.w, w[k4 * 4 + 3], acc); }
            atomicAdd(&MOD[(l * 9 + j) * 3072 + col], acc); }
    }
}

__device__ __forceinline__ void phase_a0(ArgsP a, int layer) {
    const int tid = tid_(), lane = tid & 63, wave = tid >> 6, G = grid_();
    const float* MOD = (const float*)(a->ws + WS_MOD);
    bf16* U = (bf16*)(a->ws + WS_U);
    f32x4 nx[4];
#define A0_LOAD(nn_) do { if (layer == 0) { const float* xr_ = xrow_src(a, 0, (nn_)); \
            _Pragma("unroll") for (int j = 0; j < 4; ++j) nx[j] = *(const f32x4*)(xr_ + lane * 4 + 256 * j); } \
        else { const bf16* zr_ = (const bf16*)a->out + (size_t)(nn_) * 2048; \
            _Pragma("unroll") for (int j = 0; j < 4; ++j) { const v2u w_ = *(const v2u*)(zr_ + lane * 4 + 256 * j); nx[j] = (f32x4){bflo(w_.x), bfhi(w_.x), bflo(w_.y), bfhi(w_.y)}; } } } while (0)
    { const int n0 = bid_() * 8 + wave; if (n0 < T) A0_LOAD(n0); }
    for (int n = bid_() * 8 + wave; n < T; n += G * 8) {
        const Tok tk = tok_of(n);
        f32x4 v[4]; float s = 0.f;
#pragma unroll
        for (int j = 0; j < 4; ++j) { v[j] = nx[j]; s += (v[j].x + v[j].y) + (v[j].z + v[j].w); }
        if (n + G * 8 < T) A0_LOAD(n + G * 8);
        float mean = wave_sum(s) * (1.f / D), s2 = 0.f;
#pragma unroll
        for (int j = 0; j < 4; ++j) { v[j] = v[j] - mean; s2 += (v[j].x * v[j].x + v[j].y * v[j].y) + (v[j].z * v[j].z + v[j].w * v[j].w); }
        float rstd = rsqrt_(wave_sum(s2) * (1.f / D) + LN_EPS);
        if (layer == 1) {
            s = 0.f;
#pragma unroll
            for (int j = 0; j < 4; ++j) { const f32x4 g = *(const f32x4*)(a->in[I_LNG] + lane * 4 + 256 * j), b = *(const f32x4*)(a->in[I_LNB] + lane * 4 + 256 * j);
                v[j] = v[j] * rstd * g + b; s += (v[j].x + v[j].y) + (v[j].z + v[j].w); }
            if (lane == 0) { float* st = (float*)(a->ws + WS_STATS) + (size_t)n * 2; st[0] = mean; st[1] = rstd; }
            mean = wave_sum(s) * (1.f / D); s2 = 0.f;
#pragma unroll
            for (int j = 0; j < 4; ++j) { v[j] = v[j] - mean; s2 += (v[j].x * v[j].x + v[j].y * v[j].y) + (v[j].z * v[j].z + v[j].w * v[j].w); }
            rstd = rsqrt_(wave_sum(s2) * (1.f / D) + LN_EPS);
        }
        const float* m = MOD + (size_t)(layer * 9 + tk.modrow) * 3072;
#pragma unroll
        for (int j = 0; j < 4; ++j) { const int c = lane * 4 + 256 * j; const f32x4 sh = *(const f32x4*)(m + c), sc = *(const f32x4*)(m + 1024 + c);
            const f32x4 o = v[j] * rstd * (sc + 1.f) + sh;
            v2u p; p.x = pk2(o.x, o.y); p.y = pk2(o.z, o.w); *(v2u*)(U + (size_t)n * D + c) = p; }
    }
}
__device__ __forceinline__ void phase_final(ArgsP a) {
    const int tid = tid_(), lane = tid & 63, wave = tid >> 6, G = grid_();
    f32x4 nx[4];
#define FN_LOAD(nn_) do { const bf16* zr_ = (const bf16*)a->out + (size_t)(nn_) * 2048; \
        _Pragma("unroll") for (int j = 0; j < 4; ++j) { const v2u w_ = *(const v2u*)(zr_ + lane * 4 + 256 * j); nx[j] = (f32x4){bflo(w_.x), bfhi(w_.x), bflo(w_.y), bfhi(w_.y)}; } } while (0)
    { const int n0 = bid_() * 8 + wave; if (n0 < T) FN_LOAD(n0); }
    for (int n = bid_() * 8 + wave; n < T; n += G * 8) {
        float* xr = a->out + (size_t)n * D;
        f32x4 v[4]; float s = 0.f;
#pragma unroll
        for (int j = 0; j < 4; ++j) { v[j] = nx[j]; s += (v[j].x + v[j].y) + (v[j].z + v[j].w); }
        if (n + G * 8 < T) FN_LOAD(n + G * 8);
        const float mean = wave_sum(s) * (1.f / D); float s2 = 0.f;
#pragma unroll
        for (int j = 0; j < 4; ++j) { v[j] = v[j] - mean; s2 += (v[j].x * v[j].x + v[j].y * v[j].y) + (v[j].z * v[j].z + v[j].w * v[j].w); }
        const float rstd = rsqrt_(wave_sum(s2) * (1.f / D) + LN_EPS);
#pragma unroll
        for (int j = 0; j < 4; ++j) { const f32x4 g = *(const f32x4*)(a->in[I_LNG] + 1024 + lane * 4 + 256 * j), b = *(const f32x4*)(a->in[I_LNB] + 1024 + lane * 4 + 256 * j);
            *(f32x4*)(xr + lane * 4 + 256 * j) = v[j] * rstd * g + b; }
    }
}

__device__ __forceinline__ void phase_a1_naive(ArgsP a, int layer) {
    const bf16* U = (const bf16*)(a->ws + WS_U); const bf16* W = (const bf16*)(a->ws + WS_WIN) + (size_t)layer * NIN * 1024;
    bf16* G1 = (bf16*)(a->ws + WS_G1); bf16* G2 = (bf16*)(a->ws + WS_G2);
    const size_t total = (size_t)T * (NIN / 8), stride = (size_t)grid_() * NTHREADS;
    for (size_t idx = (size_t)bid_() * NTHREADS + tid_(); idx < total; idx += stride) {
        const int row = (int)(idx / (NIN / 8)), c0 = (int)(idx % (NIN / 8)) * 8;
        float acc[8];
#pragma unroll
        for (int c = 0; c < 8; ++c) acc[c] = 0.f;
        const v4u* ap = (const v4u*)(U + (size_t)row * 1024); const v4u* bp = (const v4u*)(W + (size_t)c0 * 1024);
        for (int kc = 0; kc < 128; ++kc) { const v4u av = ap[kc];
#pragma unroll
            for (int c = 0; c < 8; ++c) acc[c] = dot8(av, bp[c * 128 + kc], acc[c]); }
        v4u o; o.x = pk2(acc[0], acc[1]); o.y = pk2(acc[2], acc[3]); o.z = pk2(acc[4], acc[5]); o.w = pk2(acc[6], acc[7]);
        if (c0 < G1W) *(v4u*)(G1 + (size_t)row * G1W + c0) = o; else *(v4u*)(G2 + (size_t)row * G2W + (c0 - G1W)) = o;
    }
}
__device__ __forceinline__ void phase_c2_naive(ArgsP a, int layer) {
    const bf16* Y = (const bf16*)(a->ws + WS_YMIX); const bf16* W = (const bf16*)(a->ws + WS_WOUT) + (size_t)layer * 1024 * 1024;
    const float* MOD = (const float*)(a->ws + WS_MOD);
    const size_t total = (size_t)T * 256, stride = (size_t)grid_() * NTHREADS;
    for (size_t idx = (size_t)bid_() * NTHREADS + tid_(); idx < total; idx += stride) {
        const int row = (int)(idx >> 8), c0 = (int)(idx & 255) * 4;
        float acc[4] = {0.f, 0.f, 0.f, 0.f};
        const v4u* ap = (const v4u*)(Y + (size_t)row * 1024); const v4u* bp = (const v4u*)(W + (size_t)c0 * 1024);
        for (int kc = 0; kc < 128; ++kc) { const v4u av = ap[kc];
#pragma unroll
            for (int c = 0; c < 4; ++c) acc[c] = dot8(av, bp[c * 128 + kc], acc[c]); }
        const Tok tk = tok_of(row);
        const f32x4 gate = *(const f32x4*)(MOD + (size_t)(layer * 9 + tk.modrow) * 3072 + 2048 + c0);
        const f32x4 x = *(const f32x4*)(xrow_src(a, layer, row) + c0);
        f32x4 z; z.x = ALPHA * x.x + gate.x * acc[0]; z.y = ALPHA * x.y + gate.y * acc[1]; z.z = ALPHA * x.z + gate.z * acc[2]; z.w = ALPHA * x.w + gate.w * acc[3];
        *(f32x4*)(a->out + (size_t)row * D + c0) = z;
    }
}

__device__ __forceinline__ void phase_a2_naive(ArgsP a, LAS unsigned char* lds, int layer) {
    const int tid = tid_(), lane = tid & 63, wave = tid >> 6, G = grid_();
    LAS float* AQ = (LAS float*)lds;
    LAS float* AKV = (LAS float*)(lds + 16384);
    LAS float* OT = (LAS float*)(lds + 24576);
    const bf16* G2 = (const bf16*)(a->ws + WS_G2);
    bf16* Q = (bf16*)(a->ws + WS_Q); bf16* KN = (bf16*)(a->ws + WS_KN); bf16* KR = (bf16*)(a->ws + WS_KR); bf16* VT = (bf16*)(a->ws + WS_VT);
    const bf16* WUQ = (const bf16*)(a->ws + WS_WUQ) + (size_t)layer * 768 * 256;
    const bf16* WUKV = (const bf16*)(a->ws + WS_WUKV) + (size_t)layer * 1024 * 128;
    constexpr int NT_TOK = T / 16, NT_CACHE = 8 * 256 / 16;
    for (int tile = bid_(); tile < NT_TOK + NT_CACHE; tile += G) {
        const bool is_tok = tile < NT_TOK;
        for (int rr = 0; rr < 2; ++rr) {
            const int r = wave * 2 + rr;
            if (is_tok) {
                const int n = tile * 16 + r; const Tok tk = tok_of(n);
                const v2u cqv = *(const v2u*)(G2 + (size_t)n * G2W + lane * 4);
                const float c0 = bflo(cqv.x), c1 = bfhi(cqv.x), c2 = bflo(cqv.y), c3 = bfhi(cqv.y);
                const float rq = rsqrt_(wave_sum(c0 * c0 + c1 * c1 + c2 * c2 + c3 * c3) * (1.f / 256.f) + 1e-6f);
                const f32x4 qn = *(const f32x4*)(a->in[I_QNORM] + layer * 256 + lane * 4);
                AQ[r * 256 + lane * 4 + 0] = bf2f(f2bf(c0 * rq * qn.x)); AQ[r * 256 + lane * 4 + 1] = bf2f(f2bf(c1 * rq * qn.y));
                AQ[r * 256 + lane * 4 + 2] = bf2f(f2bf(c2 * rq * qn.z)); AQ[r * 256 + lane * 4 + 3] = bf2f(f2bf(c3 * rq * qn.w));
                float k0 = 0.f, k1 = 0.f, k2 = 0.f, k3 = 0.f;
                if (lane < 32) { const v2u kv = *(const v2u*)(G2 + (size_t)n * G2W + 256 + lane * 4); k0 = bflo(kv.x); k1 = bfhi(kv.x); k2 = bflo(kv.y); k3 = bfhi(kv.y); }
                const float rk = rsqrt_(wave_sum(k0 * k0 + k1 * k1 + k2 * k2 + k3 * k3) * (1.f / 128.f) + 1e-6f);
                if (lane < 32) {
                    const f32x4 kn = *(const f32x4*)(a->in[I_KVNORM] + layer * 128 + lane * 4);
                    f32x4 o; o.x = k0 * rk * kn.x; o.y = k1 * rk * kn.y; o.z = k2 * rk * kn.z; o.w = k3 * rk * kn.w;
                    if (!tk.lat) *(f32x4*)(a->out + O_CKV + ((size_t)(tk.b * 2 + layer) * 256 + tk.t) * 128 + lane * 4) = o;
                    AKV[r * 128 + lane * 4 + 0] = bf2f(f2bf(o.x)); AKV[r * 128 + lane * 4 + 1] = bf2f(f2bf(o.y));
                    AKV[r * 128 + lane * 4 + 2] = bf2f(f2bf(o.z)); AKV[r * 128 + lane * 4 + 3] = bf2f(f2bf(o.w));
                }
                float krv = (lane < 32) ? bf2f(G2[(size_t)n * G2W + 384 + lane]) : 0.f;
                const float other = __shfl_xor(krv, 1);
                if (lane < 32) {
                    if (!tk.lat) a->out[O_KR + ((size_t)(tk.b * 2 + layer) * 256 + tk.t) * 32 + lane] = krv;
                    else { float c, s; rope_angle(tk.t, lane >> 1, c, s); krv = (lane & 1) ? (other * s + krv * c) : (krv * c - other * s); }
                    KR[(size_t)tk.kidx * 32 + lane] = (bf16)f2bf(krv);
                }
            } else {
                const int cr = (tile - NT_TOK) * 16 + r, b = cr >> 8, j = cr & 255;
                const size_t src = ((size_t)(b * 2 + layer) * 256 + j);
                if (lane < 32) { const f32x4 v = *(const f32x4*)(a->in[I_CCKV] + src * 128 + lane * 4);
                    AKV[r * 128 + lane * 4 + 0] = bf2f(f2bf(v.x)); AKV[r * 128 + lane * 4 + 1] = bf2f(f2bf(v.y)); AKV[r * 128 + lane * 4 + 2] = bf2f(f2bf(v.z)); AKV[r * 128 + lane * 4 + 3] = bf2f(f2bf(v.w));
                    KR[(size_t)(T_CTX + b * LK_LAT + j) * 32 + lane] = (bf16)f2bf(a->in[I_CKR][src * 32 + lane]); }
            }
        }
        __syncthreads();
        if (is_tok) {
            for (int col = tid; col < 768; col += NTHREADS) {
                float acc[16];
#pragma unroll
                for (int r = 0; r < 16; ++r) acc[r] = 0.f;
                const v4u* wp = (const v4u*)(WUQ + (size_t)col * 256);
                for (int kc = 0; kc < 32; ++kc) { const v4u w = wp[kc];
                    const float w0 = bflo(w.x), w1 = bfhi(w.x), w2 = bflo(w.y), w3 = bfhi(w.y), w4 = bflo(w.z), w5 = bfhi(w.z), w6 = bflo(w.w), w7 = bfhi(w.w);
#pragma unroll
                    for (int r = 0; r < 16; ++r) { const f32x4 x0 = *(const LAS f32x4*)(AQ + r * 256 + kc * 8), x1 = *(const LAS f32x4*)(AQ + r * 256 + kc * 8 + 4);
                        acc[r] += x0.x * w0 + x0.y * w1 + x0.z * w2 + x0.w * w3 + x1.x * w4 + x1.y * w5 + x1.z * w6 + x1.w * w7; } }
#pragma unroll
                for (int r = 0; r < 16; ++r) OT[r * 1024 + col] = acc[r];
            }
            __syncthreads();
            for (int idx = tid; idx < 16 * 384; idx += NTHREADS) {
                const int r = idx / 384, col = (idx % 384) * 2, d = col % 96; const int n = tile * 16 + r; const Tok tk = tok_of(n);
                float v0 = OT[r * 1024 + col], v1 = OT[r * 1024 + col + 1];
                if (tk.lat && d >= 64) { float c, s; rope_angle(tk.t, (d - 64) >> 1, c, s); const float y0 = v0 * c - v1 * s, y1 = v0 * s + v1 * c; v0 = y0; v1 = y1; }
                *(unsigned*)(Q + (size_t)n * 768 + col) = pk2(v0, v1);
            }
            __syncthreads();
        }
        for (int col = tid; col < 1024; col += NTHREADS) {
            float acc[16];
#pragma unroll
            for (int r = 0; r < 16; ++r) acc[r] = 0.f;
            const v4u* wp = (const v4u*)(WUKV + (size_t)col * 128);
            for (int kc = 0; kc < 16; ++kc) { const v4u w = wp[kc];
                const float w0 = bflo(w.x), w1 = bfhi(w.x), w2 = bflo(w.y), w3 = bfhi(w.y), w4 = bflo(w.z), w5 = bfhi(w.z), w6 = bflo(w.w), w7 = bfhi(w.w);
#pragma unroll
                for (int r = 0; r < 16; ++r) { const f32x4 x0 = *(const LAS f32x4*)(AKV + r * 128 + kc * 8), x1 = *(const LAS f32x4*)(AKV + r * 128 + kc * 8 + 4);
                    acc[r] += x0.x * w0 + x0.y * w1 + x0.z * w2 + x0.w * w3 + x1.x * w4 + x1.y * w5 + x1.z * w6 + x1.w * w7; } }
#pragma unroll
            for (int r = 0; r < 16; ++r) OT[r * 1024 + col] = acc[r];
        }
        __syncthreads();
        for (int idx = tid; idx < 16 * 1024; idx += NTHREADS) {
            const int r = idx >> 10, col = idx & 1023, h = col >> 7, f = col & 127;
            int kidx, lat, b, kpos;
            if (is_tok) { const Tok tk = tok_of(tile * 16 + r); kidx = tk.kidx; lat = tk.lat; b = tk.b; kpos = tk.lat ? PAST + tk.t : tk.t; }
            else { const int cr = (tile - NT_TOK) * 16 + r; b = cr >> 8; kpos = cr & 255; lat = 1; kidx = T_CTX + b * LK_LAT + kpos; }
            const bf16 v = (bf16)f2bf(OT[r * 1024 + col]);
            if (f < 64) KN[(size_t)kidx * 512 + h * 64 + f] = v;
            else { const int dv = f - 64; const size_t base = lat ? (size_t)VT_LAT + ((size_t)(b * 8 + h) * 64 + dv) * LK_LAT : ((size_t)(b * 8 + h) * 64 + dv) * 256; VT[base + kpos] = v; }
        }
        __syncthreads();
    }
}

__device__ __forceinline__ void phase_att_naive(ArgsP a) {
    const bf16* KN = (const bf16*)(a->ws + WS_KN); const bf16* KR = (const bf16*)(a->ws + WS_KR); const bf16* VT = (const bf16*)(a->ws + WS_VT);
    bf16* Q = (bf16*)(a->ws + WS_Q); const bf16* G1 = (const bf16*)(a->ws + WS_G1);
    const int total = T * 8, stride = grid_() * NTHREADS;
    for (int idx = bid_() * NTHREADS + tid_(); idx < total; idx += stride) {
        int n, h, Lk, kidx0; size_t vbase;
        if (idx < T_CTX * 8) { const int b = idx >> 11, hh = (idx >> 8) & 7, t = idx & 255; n = b * 256 + t; h = hh; Lk = 256; kidx0 = b * 256; vbase = ((size_t)(b * 8 + h) * 64) * 256; }
        else { const int m = idx - T_CTX * 8, b = m >> 14, hh = (m >> 11) & 7, t = m & 2047; n = T_CTX + b * 2048 + t; h = hh; Lk = LK_LAT; kidx0 = T_CTX + b * LK_LAT; vbase = (size_t)VT_LAT + ((size_t)(b * 8 + h) * 64) * LK_LAT; }
        v4u qp[12];
#pragma unroll
        for (int c = 0; c < 12; ++c) qp[c] = *(const v4u*)(Q + (size_t)n * 768 + h * 96 + c * 8);
        float acc[64];
#pragma unroll
        for (int d = 0; d < 64; ++d) acc[d] = 0.f;
        float m = -1e30f, l = 0.f;
        for (int j0 = 0; j0 < Lk; j0 += 8) {
            float s[8];
#pragma unroll
            for (int j = 0; j < 8; ++j) {
                const v4u* kp = (const v4u*)(KN + (size_t)(kidx0 + j0 + j) * 512 + h * 64); const v4u* rp = (const v4u*)(KR + (size_t)(kidx0 + j0 + j) * 32);
                float sv = 0.f;
#pragma unroll
                for (int c = 0; c < 8; ++c) sv = dot8(qp[c], kp[c], sv);
#pragma unroll
                for (int c = 0; c < 4; ++c) sv = dot8(qp[8 + c], rp[c], sv);
                s[j] = sv;
                __builtin_amdgcn_sched_barrier(0);
            }
            float mx = m;
#pragma unroll
            for (int j = 0; j < 8; ++j) mx = fmaxf(mx, s[j]);
            const float alpha = exp2f(m - mx); m = mx; float ps = 0.f;
#pragma unroll
            for (int j = 0; j < 8; ++j) { s[j] = exp2f(s[j] - mx); ps += s[j]; }
            l = l * alpha + ps;
            unsigned lk = (unsigned)Lk; asm volatile("" : "+v"(lk));
            const bf16* vp = VT + vbase + j0;
#pragma unroll
            for (int dg = 0; dg < 8; ++dg) {
#pragma unroll
                for (int dd = 0; dd < 8; ++dd) { const int d = dg * 8 + dd; const v4u w = *(const v4u*)(vp + (unsigned)d * lk);
                    acc[d] = acc[d] * alpha + s[0] * bflo(w.x) + s[1] * bfhi(w.x) + s[2] * bflo(w.y) + s[3] * bfhi(w.y) + s[4] * bflo(w.z) + s[5] * bfhi(w.z) + s[6] * bflo(w.w) + s[7] * bfhi(w.w); }
                __builtin_amdgcn_sched_barrier(0);
            }
        }
        const float inv = rcp_(l);
#pragma unroll
        for (int c = 0; c < 8; ++c) { const v4u g = *(const v4u*)(G1 + (size_t)n * G1W + C_GM + h * 64 + c * 8);
            v4u o;
            o.x = pk2(acc[c * 8 + 0] * inv * siluf_(bflo(g.x)), acc[c * 8 + 1] * inv * siluf_(bfhi(g.x)));
            o.y = pk2(acc[c * 8 + 2] * inv * siluf_(bflo(g.y)), acc[c * 8 + 3] * inv * siluf_(bfhi(g.y)));
            o.z = pk2(acc[c * 8 + 4] * inv * siluf_(bflo(g.z)), acc[c * 8 + 5] * inv * siluf_(bfhi(g.z)));
            o.w = pk2(acc[c * 8 + 6] * inv * siluf_(bflo(g.w)), acc[c * 8 + 7] * inv * siluf_(bfhi(g.w)));
            *(v4u*)(Q + (size_t)n * 768 + h * 96 + c * 8) = o; }
    }
}
namespace pg8 {
#define PG8_LAS __attribute__((address_space(3)))
typedef unsigned short bf16_t;
typedef short bf16x8 __attribute__((ext_vector_type(8)));
typedef float f32x4 __attribute__((ext_vector_type(4)));
typedef unsigned u32x4 __attribute__((ext_vector_type(4)));
constexpr int BM = 256, BK = 64, HALF = 128, HTB = HALF * BK * 2  , STAGE_BYTES = 8 * HTB, NXCD = 8, WGM = 8;

__host__ __device__ __forceinline__ int lds_byte(int r, int c) { const int st = (r >> 4) * 2 + (c >> 5), rr = r & 15, cc = c & 31, ob = rr * 64 + cc * 2; return st * 1024 + (ob ^ (((ob >> 9) & 1) << 5)); }
__host__ __device__ __forceinline__ void stage_rc(int b, int& R, int& C) { const int st = b / 1024, sb = b % 1024, swz = sb ^ (((sb >> 9) & 1) << 5); R = (st >> 1) * 16 + swz / 64; C = (st & 1) * 32 + (swz % 64) / 2; }
__host__ __device__ __forceinline__ int perm32(int rho) { const int n = rho >> 4, i = rho & 15; return 8 * (i >> 2) + 4 * n + (i & 3); }

struct Unit { int pm, pn, gid; };
struct Gemm { const bf16_t* A; const bf16_t* Bt; int M, N, K, lda, ldb; };

struct StaticOrder {
    int nM, nN, nwg, G, c;
    __host__ __device__ void init(int M, int N, int G_, int c_) { nM = M / BM; nN = N / BM; nwg = nM * nN; G = G_; c = c_; }
    __host__ __device__ bool next(int i, Unit& u) const {
        const long L = (long)i * G + c; if (L >= nwg) return false;
        int wgid = (int)L; { const int q = nwg / NXCD, r = nwg % NXCD, xcd = wgid % NXCD, off = wgid / NXCD; wgid = (xcd < r ? xcd * (q + 1) : r * (q + 1) + (xcd - r) * q) + off; }
        const int nig = WGM * nN, gid = wgid / nig, fm = gid * WGM, gsz = (nM - fm) < WGM ? (nM - fm) : WGM;
        u.pm = fm + ((wgid % nig) % gsz); u.pn = (wgid % nig) / gsz; u.gid = 0; return true;
    }
    __device__ __forceinline__ const char* abase(const Gemm& g, const Unit& u) const { return (const char*)g.A + (size_t)u.pm * BM * g.lda * 2; }
    __device__ __forceinline__ const char* bbase(const Gemm& g, const Unit& u) const { return (const char*)g.Bt + (size_t)u.pn * BM * g.ldb * 2; }
    __device__ __forceinline__ void a_ready(const Unit&) const {}
    __device__ __forceinline__ void done(const Unit&) const {}
};
__device__ __forceinline__ unsigned cvt_pk_bf16(float lo, float hi) { unsigned r; asm volatile("v_cvt_pk_bf16_f32 %0, %1, %2" : "=v"(r) : "v"(lo), "v"(hi)); return r; }

template <class Epi, class Sched, bool STAMP = false>
__device__ __forceinline__ void gemm_phase(PG8_LAS unsigned char* lds, const Gemm g, const Sched& S, const Epi& E, unsigned long long* stamps) {
    const int tid = tid_(), wid = __builtin_amdgcn_readfirstlane(tid >> 6), lane = tid & 63, wr = wid >> 2, wc = wid & 3, fr = lane & 15, fq = lane >> 4;
    const int K = g.K, nt = K / BK;
    int ts_lo = 0, ts_hi = 0, nts = 0; const unsigned long long rt_entry = STAMP ? (unsigned long long)wall_clock64() : 0ull;
#define PG8_STAMP() do { if (STAMP && wid == 0 && nts < 64) { const unsigned long long _c = (unsigned long long)clock64(); \
        ts_lo = (lane == nts) ? (int)(unsigned)_c : ts_lo; ts_hi = (lane == nts) ? (int)(unsigned)(_c >> 32) : ts_hi; ++nts; } } while (0)
    PG8_STAMP();
    unsigned voffA[2], voffB[2];
#pragma unroll
    for (int i = 0; i < 2; ++i) { int R, C; stage_rc(tid * 16 + i * 8192, R, C); const int Rb = Epi::PERM ? ((R & ~31) + perm32(R & 31)) : R;
        voffA[i] = (unsigned)(R * g.lda + C) * 2u; voffB[i] = (unsigned)(Rb * g.ldb + C) * 2u; }
    const size_t kstep = (size_t)(BK * 2);
    const size_t hstepA = (size_t)HALF * g.lda * 2, hstepB = (size_t)HALF * g.ldb * 2;
    const unsigned ldsw = (unsigned)wid * 1024u;
    const int aoff = lds_byte(wr * 64 + fr, fq * 8), boff = lds_byte(wc * 32 + fr, fq * 8);
#define PG8_SA(b, h) (((b) * 2 + (h)) * HTB)
#define PG8_SB(b, h) ((4 + (b) * 2 + (h)) * HTB)
#define PG8_STAGE(bufoff, gbase, voff) do { _Pragma("unroll") for (int _i = 0; _i < 2; ++_i) \
        __builtin_amdgcn_global_load_lds((const unsigned*)((const char*)(gbase) + (voff)[_i]), (PG8_LAS unsigned*)(lds + (bufoff) + ldsw + _i * 8192), 16, 0, 0); } while (0)
#define PG8_LDA(dst, b, h) do { _Pragma("unroll") for (int m = 0; m < 4; ++m) _Pragma("unroll") for (int k = 0; k < 2; ++k) dst[m][k] = *(const PG8_LAS bf16x8*)(lds + PG8_SA(b, h) + aoff + m * 2048 + k * 1024); } while (0)
#define PG8_LDB(dst, b, h) do { _Pragma("unroll") for (int n = 0; n < 2; ++n) _Pragma("unroll") for (int k = 0; k < 2; ++k) dst[n][k] = *(const PG8_LAS bf16x8*)(lds + PG8_SB(b, h) + boff + n * 2048 + k * 1024); } while (0)
#define PG8_MMA(ai, bj, At, Bt) do { __builtin_amdgcn_s_setprio(1); _Pragma("unroll") for (int m = 0; m < 4; ++m) _Pragma("unroll") for (int n = 0; n < 2; ++n) _Pragma("unroll") for (int k = 0; k < 2; ++k) \
        acc[ai][bj][m][n] = __builtin_amdgcn_mfma_f32_16x16x32_bf16(Bt[n][k], At[m][k], acc[ai][bj][m][n], 0, 0, 0); __builtin_amdgcn_s_setprio(0); } while (0)
#define PG8_WAIT_V(n) asm volatile("s_waitcnt vmcnt(" #n ")" ::: "memory")
#define PG8_WAIT_L(n) asm volatile("s_waitcnt lgkmcnt(" #n ")" ::: "memory")
#define PG8_BAR __builtin_amdgcn_s_barrier()
#define PG8_SCHED __builtin_amdgcn_sched_barrier(0)
    Unit cur, nxt; int ui = 0;
    if (!S.next(0, cur)) return;
    f32x4 acc[2][2][4][2];
#pragma unroll
    for (int a = 0; a < 2; ++a)
#pragma unroll
        for (int b = 0; b < 2; ++b)
#pragma unroll
            for (int m = 0; m < 4; ++m)
#pragma unroll
                for (int n = 0; n < 2; ++n) acc[a][b][m][n] = (f32x4){0.f, 0.f, 0.f, 0.f};
    bf16x8 At[4][2], B0[2][2], B1[2][2];
    const char* cA = S.abase(g, cur); const char* cB = S.bbase(g, cur);
    S.a_ready(cur);
    PG8_STAGE(PG8_SB(0, 0), cB, voffB); PG8_STAGE(PG8_SA(0, 0), cA, voffA); PG8_STAGE(PG8_SB(0, 1), cB + hstepB, voffB); PG8_STAGE(PG8_SA(0, 1), cA + hstepA, voffA);
    if (wr == 1) PG8_BAR;
    PG8_WAIT_V(4); PG8_BAR;
    PG8_STAGE(PG8_SB(1, 0), cB + kstep, voffB); PG8_STAGE(PG8_SA(1, 0), cA + kstep, voffA); PG8_STAGE(PG8_SB(1, 1), cB + hstepB + kstep, voffB);
    PG8_WAIT_V(6); PG8_BAR;
    PG8_STAMP();
    for (;;) {
        const bool has_next = S.next(ui + 1, nxt);
        const char* nA = has_next ? S.abase(g, nxt) : cA; const char* nB = has_next ? S.bbase(g, nxt) : cB;
        for (int t = 0; t < nt; t += 2) {
            const bool last = (t == nt - 2);
            const char* a1 = cA + (size_t)(t + 1) * kstep;
            const char* a2 = last ? nA : cA + (size_t)(t + 2) * kstep; const char* b2 = last ? nB : cB + (size_t)(t + 2) * kstep;
            const char* a3 = a2 + kstep; const char* b3 = b2 + kstep;
            if (last && has_next) S.a_ready(nxt);
            PG8_LDB(B0, 0, 0); PG8_SCHED; PG8_LDA(At, 0, 0); PG8_STAGE(PG8_SA(1, 1), a1 + hstepA, voffA);
            PG8_WAIT_L(8); PG8_BAR; PG8_WAIT_L(0); PG8_MMA(0, 0, At, B0); PG8_BAR; PG8_SCHED;
            PG8_LDB(B1, 0, 1); PG8_STAGE(PG8_SB(0, 0), b2, voffB);
            PG8_BAR; PG8_WAIT_L(0); PG8_MMA(0, 1, At, B1); PG8_BAR;
            PG8_LDA(At, 0, 1); PG8_STAGE(PG8_SA(0, 0), a2, voffA);
            PG8_BAR; PG8_WAIT_L(0); PG8_MMA(1, 0, At, B0); PG8_BAR; PG8_SCHED;
            PG8_STAGE(PG8_SB(0, 1), b2 + hstepB, voffB);
            PG8_WAIT_V(6); PG8_BAR; PG8_MMA(1, 1, At, B1); PG8_BAR;
            PG8_LDB(B0, 1, 0); PG8_SCHED; PG8_LDA(At, 1, 0); PG8_STAGE(PG8_SA(0, 1), a2 + hstepA, voffA);
            PG8_WAIT_L(8); PG8_BAR; PG8_WAIT_L(0); PG8_MMA(0, 0, At, B0); PG8_BAR; PG8_SCHED;
            PG8_LDB(B1, 1, 1); PG8_STAGE(PG8_SB(1, 0), b3, voffB);
            PG8_BAR; PG8_WAIT_L(0); PG8_MMA(0, 1, At, B1); PG8_BAR;
            PG8_LDA(At, 1, 1); PG8_STAGE(PG8_SA(1, 0), a3, voffA);
            PG8_BAR; PG8_WAIT_L(0); PG8_MMA(1, 0, At, B0); PG8_BAR; PG8_SCHED;
            PG8_STAGE(PG8_SB(1, 1), b3 + hstepB, voffB);
            PG8_WAIT_V(6); PG8_BAR; PG8_MMA(1, 1, At, B1); PG8_BAR;
        }
        PG8_STAMP();
        if constexpr (!Epi::AFTER_DRAIN) { E(acc, cur, wr, wc, fr, fq); S.done(cur); }
        PG8_STAMP();
        if (!has_next) break;
#pragma unroll
        for (int a = 0; a < 2; ++a)
#pragma unroll
            for (int b = 0; b < 2; ++b)
#pragma unroll
                for (int m = 0; m < 4; ++m)
#pragma unroll
                    for (int n = 0; n < 2; ++n) acc[a][b][m][n] = (f32x4){0.f, 0.f, 0.f, 0.f};
        cur = nxt; cA = nA; cB = nB; ++ui;
    }
    PG8_WAIT_V(0);
    if (wr == 0) PG8_BAR;
    PG8_BAR;
    if constexpr (Epi::AFTER_DRAIN) { E.fused(acc, cur, wr, wc, fr, fq, lds, wid, lane); S.done(cur); }
    PG8_STAMP();
    if (STAMP && wid == 0) { stamps[lane] = lane < nts ? (((unsigned long long)(unsigned)ts_hi << 32) | (unsigned)ts_lo) : 0ull;
        if (lane == 62) stamps[62] = rt_entry; if (lane == 63) stamps[63] = (unsigned long long)wall_clock64(); }
#undef PG8_STAMP
#undef PG8_SA
#undef PG8_SB
#undef PG8_STAGE
#undef PG8_LDA
#undef PG8_LDB
#undef PG8_MMA
#undef PG8_WAIT_V
#undef PG8_WAIT_L
#undef PG8_BAR
#undef PG8_SCHED
}
}
namespace pg8 {
struct EpiIn {
    static constexpr bool PERM = true, AFTER_DRAIN = false;
    bf16_t* G1; bf16_t* G2;
    __device__ __forceinline__ void operator()(const f32x4 (&acc)[2][2][4][2], const Unit& u, int wr, int wc, int fr, int fq) const {
        const int row0 = u.pm * BM + wr * 64 + fr;
        bf16_t* base; int ldc, colt;
        if (u.pn < 9) { base = G1; ldc = 2304; colt = u.pn * 256; } else { base = G2; ldc = 512; colt = (u.pn - 9) * 256; }
        const int col0 = colt + wc * 32 + 8 * fq;
#pragma unroll
        for (int ai = 0; ai < 2; ++ai)
#pragma unroll
            for (int m = 0; m < 4; ++m) { bf16_t* rowp = base + (size_t)(row0 + ai * HALF + m * 16) * ldc + col0;
#pragma unroll
                for (int bj = 0; bj < 2; ++bj) { const f32x4 v0 = acc[ai][bj][m][0], v1 = acc[ai][bj][m][1];
                    u32x4 w; w.x = cvt_pk_bf16(v0[0], v0[1]); w.y = cvt_pk_bf16(v0[2], v0[3]); w.z = cvt_pk_bf16(v1[0], v1[1]); w.w = cvt_pk_bf16(v1[2], v1[3]);
                    *(u32x4*)(rowp + bj * HALF) = w; } }
    }
};
struct EpiOut {
    static constexpr bool PERM = true, AFTER_DRAIN = false;
    const float* xp; const float* xs; float* out; const float* mod; int layer;
    const float* stats; const float* lng; const float* lnb;
    __device__ __forceinline__ void operator()(const f32x4 (&acc)[2][2][4][2], const Unit& u, int wr, int wc, int fr, int fq) const {
        const int row0 = u.pm * BM + wr * 64 + fr, col0 = u.pn * BM + wc * 32 + 8 * fq;
        const int rt = u.pm * BM; const int modrow = rt < 8192 ? 0 : 1 + ((rt - 8192) >> 11);
        const float* gp = mod + (size_t)modrow * 3072 + 2048 + col0;
        f32x4 gv[2][2];
#pragma unroll
        for (int bj = 0; bj < 2; ++bj)
#pragma unroll
            for (int n = 0; n < 2; ++n) gv[bj][n] = *(const f32x4*)(gp + bj * HALF + n * 4);
        f32x4 lg[2][2], lb[2][2];
        if (layer) {
#pragma unroll
            for (int bj = 0; bj < 2; ++bj)
#pragma unroll
                for (int n = 0; n < 2; ++n) { lg[bj][n] = *(const f32x4*)(lng + col0 + bj * HALF + n * 4); lb[bj][n] = *(const f32x4*)(lnb + col0 + bj * HALF + n * 4); }
        }
        f32x4 xn[2][2]; float mean_n = 0.f, rstd_n = 1.f;
#define EO_LOAD(am_) do { const int row_ = row0 + ((am_) >> 2) * HALF + ((am_) & 3) * 16; \
            if (layer == 0) { const float* xr_ = (row_ < 8192 ? xp + (size_t)row_ * 1024 : xs + (size_t)(row_ - 8192) * 1024) + col0; \
                xn[0][0] = *(const f32x4*)(xr_); xn[0][1] = *(const f32x4*)(xr_ + 4); xn[1][0] = *(const f32x4*)(xr_ + HALF); xn[1][1] = *(const f32x4*)(xr_ + HALF + 4); } \
            else { const bf16_t* zr_ = (const bf16_t*)out + (size_t)row_ * 2048 + col0; const u32x4 z0_ = *(const u32x4*)zr_, z1_ = *(const u32x4*)(zr_ + HALF); \
                xn[0][0] = (f32x4){__uint_as_float(z0_.x << 16), __uint_as_float(z0_.x & 0xffff0000u), __uint_as_float(z0_.y << 16), __uint_as_float(z0_.y & 0xffff0000u)}; \
                xn[0][1] = (f32x4){__uint_as_float(z0_.z << 16), __uint_as_float(z0_.z & 0xffff0000u), __uint_as_float(z0_.w << 16), __uint_as_float(z0_.w & 0xffff0000u)}; \
                xn[1][0] = (f32x4){__uint_as_float(z1_.x << 16), __uint_as_float(z1_.x & 0xffff0000u), __uint_as_float(z1_.y << 16), __uint_as_float(z1_.y & 0xffff0000u)}; \
                xn[1][1] = (f32x4){__uint_as_float(z1_.z << 16), __uint_as_float(z1_.z & 0xffff0000u), __uint_as_float(z1_.w << 16), __uint_as_float(z1_.w & 0xffff0000u)}; \
                mean_n = stats[(size_t)row_ * 2]; rstd_n = stats[(size_t)row_ * 2 + 1]; } } while (0)
        EO_LOAD(0);
#pragma unroll
        for (int am = 0; am < 8; ++am) { const int ai = am >> 2, m = am & 3, row = row0 + ai * HALF + m * 16;
            const f32x4 xc[2][2] = {{xn[0][0], xn[0][1]}, {xn[1][0], xn[1][1]}}; const float mean = mean_n, rstd = rstd_n;
            if (am + 1 < 8) EO_LOAD(am + 1);
            bf16_t* orow = (bf16_t*)out + (size_t)row * 2048 + col0;
#pragma unroll
            for (int bj = 0; bj < 2; ++bj) { f32x4 z[2];
#pragma unroll
                for (int n = 0; n < 2; ++n) { f32x4 x = xc[bj][n];
                    if (layer) x = (x - mean) * rstd * lg[bj][n] + lb[bj][n];
                    z[n] = x * 1.4142135623730951f + gv[bj][n] * acc[ai][bj][m][n]; }
                u32x4 w; w.x = cvt_pk_bf16(z[0][0], z[0][1]); w.y = cvt_pk_bf16(z[0][2], z[0][3]); w.z = cvt_pk_bf16(z[1][0], z[1][1]); w.w = cvt_pk_bf16(z[1][2], z[1][3]);
                *(u32x4*)(orow + bj * HALF) = w; } }
#undef EO_LOAD
    }
};
}

__device__ __forceinline__ void phase_a1_pg8(ArgsP a, LAS unsigned char* lds, int layer) {
    pg8::Gemm g{(const bf16*)(a->ws + WS_U), (const bf16*)(a->ws + WS_WIN) + (size_t)layer * NIN * 1024, T, NIN, 1024, 1024, 1024};
    pg8::StaticOrder S; S.init(T, NIN, grid_(), bid_());
    pg8::EpiIn E{(bf16*)(a->ws + WS_G1), (bf16*)(a->ws + WS_G2)};
    pg8::gemm_phase<pg8::EpiIn, pg8::StaticOrder, false>(lds, g, S, E, nullptr);
}
__device__ __forceinline__ void phase_c2_pg8(ArgsP a, LAS unsigned char* lds, int layer) {
    pg8::Gemm g{(const bf16*)(a->ws + WS_YMIX), (const bf16*)(a->ws + WS_WOUT) + (size_t)layer * 1024 * 1024, T, 1024, 1024, 1024, 1024};
    pg8::StaticOrder S; S.init(T, 1024, grid_(), bid_());
    pg8::EpiOut E{a->in[I_XP], a->in[I_XS], a->out, (const float*)(a->ws + WS_MOD) + (size_t)layer * 9 * 3072, layer, (const float*)(a->ws + WS_STATS), a->in[I_LNG], a->in[I_LNB]};
    pg8::gemm_phase<pg8::EpiOut, pg8::StaticOrder, false>(lds, g, S, E, nullptr);
}

__device__ __forceinline__ void phase_a2a(ArgsP a, int layer) {
    const int tid = tid_(), lane = tid & 63, wave = tid >> 6, G = grid_();
    bf16* G2 = (bf16*)(a->ws + WS_G2); bf16* KR = (bf16*)(a->ws + WS_KR); bf16* CK = (bf16*)(a->ws + WS_HF);
    const float* ROPE = (const float*)(a->ws + WS_ROPE);
    f32x4 nw0 = {0.f, 0.f, 0.f, 0.f}, nw1 = {0.f, 0.f, 0.f, 0.f};
    if (lane < 32) { nw0 = *(const f32x4*)(a->in[I_QNORM] + layer * 256 + lane * 8); nw1 = *(const f32x4*)(a->in[I_QNORM] + layer * 256 + lane * 8 + 4); }
    else if (lane < 48) { nw0 = *(const f32x4*)(a->in[I_KVNORM] + layer * 128 + (lane - 32) * 8); nw1 = *(const f32x4*)(a->in[I_KVNORM] + layer * 128 + (lane - 32) * 8 + 4); }
    v4u nx = {0u, 0u, 0u, 0u};
    { const int n0 = bid_() * 8 + wave; if (n0 < T) nx = *(const v4u*)(G2 + (size_t)n0 * G2W + lane * 8); }
    for (int n = bid_() * 8 + wave; n < T; n += G * 8) {
        const v4u w = nx;
        if (n + G * 8 < T) nx = *(const v4u*)(G2 + (size_t)(n + G * 8) * G2W + lane * 8);
        const Tok tk = tok_of(n);
        float x[8] = {bflo(w.x), bfhi(w.x), bflo(w.y), bfhi(w.y), bflo(w.z), bfhi(w.z), bflo(w.w), bfhi(w.w)};
        const float ss = (x[0] * x[0] + x[1] * x[1]) + (x[2] * x[2] + x[3] * x[3]) + (x[4] * x[4] + x[5] * x[5]) + (x[6] * x[6] + x[7] * x[7]);
        const float sq = wave_sum(lane < 32 ? ss : 0.f), sk = wave_sum((lane >= 32 && lane < 48) ? ss : 0.f);
        const float rs = lane < 32 ? rsqrt_(sq * (1.f / 256.f) + 1e-6f) : rsqrt_(sk * (1.f / 128.f) + 1e-6f);
        if (lane < 48) {
            const float y0 = x[0] * rs * nw0.x, y1 = x[1] * rs * nw0.y, y2 = x[2] * rs * nw0.z, y3 = x[3] * rs * nw0.w, y4 = x[4] * rs * nw1.x, y5 = x[5] * rs * nw1.y, y6 = x[6] * rs * nw1.z, y7 = x[7] * rs * nw1.w;
            *(v4u*)(G2 + (size_t)n * G2W + lane * 8) = (v4u){cvtpk(y0, y1), cvtpk(y2, y3), cvtpk(y4, y5), cvtpk(y6, y7)};
            if (lane >= 32 && !tk.lat) { float* op = a->out + O_CKV + ((size_t)(tk.b * 2 + layer) * 256 + tk.t) * 128 + (lane - 32) * 8;
                *(f32x4*)op = (f32x4){y0, y1, y2, y3}; *(f32x4*)(op + 4) = (f32x4){y4, y5, y6, y7}; }
        } else if (lane < 52) {
            const int d0 = (lane - 48) * 8;
            if (!tk.lat) { float* op = a->out + O_KR + ((size_t)(tk.b * 2 + layer) * 256 + tk.t) * 32 + d0;
                *(f32x4*)op = (f32x4){x[0], x[1], x[2], x[3]}; *(f32x4*)(op + 4) = (f32x4){x[4], x[5], x[6], x[7]};
                *(v4u*)(KR + (size_t)tk.kidx * 32 + d0) = w; }
            else { const f32x4 c0 = *(const f32x4*)(ROPE + ((size_t)tk.t * 16 + (d0 >> 1)) * 2), c1 = *(const f32x4*)(ROPE + ((size_t)tk.t * 16 + (d0 >> 1) + 2) * 2);
                const float y0 = x[0] * c0.x - x[1] * c0.y, y1 = x[0] * c0.y + x[1] * c0.x, y2 = x[2] * c0.z - x[3] * c0.w, y3 = x[2] * c0.w + x[3] * c0.z;
                const float y4 = x[4] * c1.x - x[5] * c1.y, y5 = x[4] * c1.y + x[5] * c1.x, y6 = x[6] * c1.z - x[7] * c1.w, y7 = x[6] * c1.w + x[7] * c1.z;
                *(v4u*)(KR + (size_t)tk.kidx * 32 + d0) = (v4u){cvtpk(y0, y1), cvtpk(y2, y3), cvtpk(y4, y5), cvtpk(y6, y7)}; }
        }
    }
    for (int r = bid_() * 8 + wave; r < 2048; r += G * 8) {
        const int b = r >> 8, j = r & 255; const size_t src = (size_t)(b * 2 + layer) * 256 + j;
        if (lane < 16) { const f32x4 v0 = *(const f32x4*)(a->in[I_CCKV] + src * 128 + lane * 8), v1 = *(const f32x4*)(a->in[I_CCKV] + src * 128 + lane * 8 + 4);
            *(v4u*)(CK + (size_t)r * 512 + lane * 8) = (v4u){cvtpk(v0.x, v0.y), cvtpk(v0.z, v0.w), cvtpk(v1.x, v1.y), cvtpk(v1.z, v1.w)}; }
        else if (lane < 32) *(v4u*)(CK + (size_t)r * 512 + lane * 8) = (v4u){0u, 0u, 0u, 0u};
        else if (lane < 36) { const f32x4 v0 = *(const f32x4*)(a->in[I_CKR] + src * 32 + (lane - 32) * 8), v1 = *(const f32x4*)(a->in[I_CKR] + src * 32 + (lane - 32) * 8 + 4);
            *(v4u*)(KR + (size_t)(T_CTX + b * LK_LAT + j) * 32 + (lane - 32) * 8) = (v4u){cvtpk(v0.x, v0.y), cvtpk(v0.z, v0.w), cvtpk(v1.x, v1.y), cvtpk(v1.z, v1.w)}; }
    }
}
namespace pg8 {
struct A2OrderQ {
    const char* g2; const char* wuq; int G, c;
    __device__ __forceinline__ bool next(int i, Unit& u) const { const int L = i * G + c; if (L >= 288) return false; u.gid = 0; u.pm = L / 3; u.pn = L % 3; return true; }
    __device__ __forceinline__ const char* abase(const Gemm&, const Unit& u) const { return g2 + (size_t)u.pm * 256 * 512 * 2; }
    __device__ __forceinline__ const char* bbase(const Gemm&, const Unit& u) const { return wuq + (size_t)u.pn * 256 * 256 * 2; }
    __device__ __forceinline__ void a_ready(const Unit&) const {}
    __device__ __forceinline__ void done(const Unit&) const {}
};
struct A2OrderKV {
    const char* g2; const char* ck; const char* wukv; int G, c;
    __device__ __forceinline__ bool next(int i, Unit& u) const { const int L = i * G + c; if (L >= 416) return false; u.gid = L < 384 ? 1 : 2; const int li = L < 384 ? L : L - 384; u.pm = li >> 2; u.pn = li & 3; return true; }
    __device__ __forceinline__ const char* abase(const Gemm&, const Unit& u) const { return (u.gid == 2 ? ck : g2 + 512) + (size_t)u.pm * 256 * 512 * 2; }
    __device__ __forceinline__ const char* bbase(const Gemm&, const Unit& u) const { return wukv + (size_t)u.pn * 256 * 256 * 2; }
    __device__ __forceinline__ void a_ready(const Unit&) const {}
    __device__ __forceinline__ void done(const Unit&) const {}
};
template <int WHICH> struct EpiA2 {
    static constexpr bool PERM = true, AFTER_DRAIN = false;
    bf16_t* Q; bf16_t* KN; bf16_t* VR; const float* rope;
    __device__ __forceinline__ void operator()(const f32x4 (&acc)[2][2][4][2], const Unit& u, int wr, int wc, int fr, int fq) const {
        const int row0 = u.pm * BM + wr * 64 + fr;
        if (WHICH == 0) {
            const int fb = u.pn * 256 + wc * 32 + 8 * fq;
#pragma unroll
            for (int ai = 0; ai < 2; ++ai)
#pragma unroll
                for (int m = 0; m < 4; ++m) { const int row = row0 + ai * HALF + m * 16;
                    const float* rp = rope + (unsigned)(((row - 8192) & 2047) * 32);
#pragma unroll
                    for (int bj = 0; bj < 2; ++bj) {
                        f32x4 v0 = acc[ai][bj][m][0], v1 = acc[ai][bj][m][1];
                        const int f0 = fb + bj * HALF, d = f0 % 96;
                        if (row >= 8192 && d >= 64) { const f32x4 c0 = *(const f32x4*)(rp + (d - 64)), c1 = *(const f32x4*)(rp + (d - 64) + 4);
                            const f32x4 a0 = v0, a1 = v1;
                            v0[0] = a0[0] * c0[0] - a0[1] * c0[1]; v0[1] = a0[0] * c0[1] + a0[1] * c0[0]; v0[2] = a0[2] * c0[2] - a0[3] * c0[3]; v0[3] = a0[2] * c0[3] + a0[3] * c0[2];
                            v1[0] = a1[0] * c1[0] - a1[1] * c1[1]; v1[1] = a1[0] * c1[1] + a1[1] * c1[0]; v1[2] = a1[2] * c1[2] - a1[3] * c1[3]; v1[3] = a1[2] * c1[3] + a1[3] * c1[2]; }
                        u32x4 w; w.x = cvt_pk_bf16(v0[0], v0[1]); w.y = cvt_pk_bf16(v0[2], v0[3]); w.z = cvt_pk_bf16(v1[0], v1[1]); w.w = cvt_pk_bf16(v1[2], v1[3]);
                        *(u32x4*)(Q + (unsigned)(row * 768 + f0)) = w; } }
        } else {
            const int x = wc * 32 + 8 * fq;
            bf16_t* base = (wc < 2 ? KN : VR);
            const unsigned xo = (unsigned)(x & 63);
#pragma unroll
            for (int ai = 0; ai < 2; ++ai)
#pragma unroll
                for (int m = 0; m < 4; ++m) { const int row = row0 + ai * HALF + m * 16;
                    int kidx;
                    if (u.gid == 2) kidx = 8192 + (row >> 8) * 2304 + (row & 255);
                    else if (row < 8192) kidx = row;
                    else { const int mrow = row - 8192; kidx = 8192 + (mrow >> 11) * 2304 + 256 + (mrow & 2047); }
#pragma unroll
                    for (int bj = 0; bj < 2; ++bj) { const f32x4 v0 = acc[ai][bj][m][0], v1 = acc[ai][bj][m][1];
                        u32x4 w; w.x = cvt_pk_bf16(v0[0], v0[1]); w.y = cvt_pk_bf16(v0[2], v0[3]); w.z = cvt_pk_bf16(v1[0], v1[1]); w.w = cvt_pk_bf16(v1[2], v1[3]);
                        *(u32x4*)(base + (unsigned)(kidx * 512 + (u.pn * 2 + bj) * 64) + xo) = w; } }
        }
    }
};
}
__device__ __forceinline__ void phase_a2b(ArgsP a, LAS unsigned char* lds, int layer) {
    int kk = 256; asm volatile("" : "+s"(kk));
    pg8::Gemm g{nullptr, nullptr, T, 1024, kk, 512, 256};
    {
        pg8::A2OrderQ S{(const char*)(a->ws + WS_G2), (const char*)((const bf16*)(a->ws + WS_WUQ) + (size_t)layer * 768 * 256), grid_(), bid_()};
        pg8::EpiA2<0> E{(bf16*)(a->ws + WS_Q), nullptr, nullptr, (const float*)(a->ws + WS_ROPE)};
        pg8::gemm_phase<pg8::EpiA2<0>, pg8::A2OrderQ, false>(lds, g, S, E, nullptr);
    }
    {
        pg8::A2OrderKV S{(const char*)(a->ws + WS_G2), (const char*)(a->ws + WS_HF), (const char*)((const bf16*)(a->ws + WS_WUKV) + (size_t)layer * 1024 * 256), grid_(), bid_()};
        pg8::EpiA2<1> E{nullptr, (bf16*)(a->ws + WS_KN), (bf16*)(a->ws + WS_VT), nullptr};
        pg8::gemm_phase<pg8::EpiA2<1>, pg8::A2OrderKV, false>(lds, g, S, E, nullptr);
    }
}
__device__ __forceinline__ void rwkv_unit_seq(ArgsP a, LAS unsigned char* lds, int layer, int u) {
    const int tid = tid_();
    LAS float* W2s = (LAS float*)lds;
    LAS float* A2s = W2s + 4096;
    LAS float* TH = A2s + 4096;
    LAS float* HA = TH + 2048;
    LAS float* Wd = HA + 2048;
    LAS float* KT = Wd + 2048; LAS float* KK = KT + 2048; LAS float* BB = KK + 2048; LAS float* RR = BB + 2048; LAS float* VV = RR + 2048; LAS float* YO = VV + 2048;
    const int lat = u < 64, uu = lat ? u : u - 64, b = uu >> 3, e = (uu >> 2) & 1, hh = uu & 3;
    const int L = lat ? L_LAT : L_CTX, tok0 = lat ? T_CTX + b * L_LAT : b * L_CTX;
    const bf16* G1 = (const bf16*)(a->ws + WS_G1);
    bf16* YS = (bf16*)(a->ws + WS_G2);
    for (int i = tid; i < 4096; i += NTHREADS) { const int j = i >> 6, c = i & 63;
        W2s[i] = a->in[I_W2][((size_t)(layer * 2 + e) * 64 + j) * 256 + hh * 64 + c];
        A2s[i] = a->in[I_A2][((size_t)(layer * 2 + e) * 64 + j) * 256 + hh * 64 + c]; }
    const int r = tid >> 3, ks = tid & 7;
    float S[8];
#pragma unroll
    for (int j = 0; j < 8; ++j) S[j] = lat ? a->in[I_SRW][(((size_t)((b * 2 + layer) * 2 + e) * 4 + hh) * 64 + r) * 64 + ks * 8 + j] : 0.f;
    const int tt = tid >> 4, q4 = (tid & 15) * 4;
    float w0v[4], a0v[4], kkw[4], kav[4];
#pragma unroll
    for (int i = 0; i < 4; ++i) { const int ch = hh * 64 + q4 + i;
        w0v[i] = a->in[I_W0][(layer * 2 + e) * 256 + ch]; a0v[i] = a->in[I_A0][(layer * 2 + e) * 256 + ch]; kkw[i] = a->in[I_KK][layer * 256 + ch]; kav[i] = a->in[I_KA][layer * 256 + ch]; }
    __syncthreads();
    for (int c = 0; c < L / 32; ++c) {
        const int step = c * 32 + tt, t = e ? L - 1 - step : step, n = tok0 + t;
        const bf16* g = G1 + (size_t)n * G1W;
        { const v2u hw = *(const v2u*)(g + C_LORA + e * 64 + q4), ha = *(const v2u*)(g + C_LORA + 128 + e * 64 + q4);
          TH[tt * 64 + q4 + 0] = tanhf(bflo(hw.x)); TH[tt * 64 + q4 + 1] = tanhf(bfhi(hw.x)); TH[tt * 64 + q4 + 2] = tanhf(bflo(hw.y)); TH[tt * 64 + q4 + 3] = tanhf(bfhi(hw.y));
          HA[tt * 64 + q4 + 0] = bflo(ha.x); HA[tt * 64 + q4 + 1] = bfhi(ha.x); HA[tt * 64 + q4 + 2] = bflo(ha.y); HA[tt * 64 + q4 + 3] = bfhi(ha.y); }
        __syncthreads();
        {
            float wl[4], al[4];
#pragma unroll
            for (int i = 0; i < 4; ++i) { wl[i] = w0v[i]; al[i] = a0v[i]; }
            for (int j = 0; j < 64; ++j) { const float th = TH[tt * 64 + j], hv = HA[tt * 64 + j];
                const f32x4 w2 = *(const LAS f32x4*)(W2s + j * 64 + q4), a2 = *(const LAS f32x4*)(A2s + j * 64 + q4);
                wl[0] = fmaf(th, w2.x, wl[0]); wl[1] = fmaf(th, w2.y, wl[1]); wl[2] = fmaf(th, w2.z, wl[2]); wl[3] = fmaf(th, w2.w, wl[3]);
                al[0] = fmaf(hv, a2.x, al[0]); al[1] = fmaf(hv, a2.y, al[1]); al[2] = fmaf(hv, a2.z, al[2]); al[3] = fmaf(hv, a2.w, al[3]); }
            const v2u kv = *(const v2u*)(g + C_K + hh * 64 + q4), rv = *(const v2u*)(g + C_R + hh * 64 + q4), vv = *(const v2u*)(g + C_V + hh * 64 + q4);
            const float kx[4] = {bflo(kv.x), bfhi(kv.x), bflo(kv.y), bfhi(kv.y)}, rx[4] = {bflo(rv.x), bfhi(rv.x), bflo(rv.y), bfhi(rv.y)}, vx[4] = {bflo(vv.x), bfhi(vv.x), bflo(vv.y), bfhi(vv.y)};
            float kkr[4], ss = 0.f;
#pragma unroll
            for (int i = 0; i < 4; ++i) { kkr[i] = kx[i] * kkw[i]; ss += kkr[i] * kkr[i]; }
            ss += __shfl_xor(ss, 1); ss += __shfl_xor(ss, 2); ss += __shfl_xor(ss, 4); ss += __shfl_xor(ss, 8);
            const float inrm = rcp_(fmaxf(sqrt_(ss), 1e-12f));
#pragma unroll
            for (int i = 0; i < 4; ++i) {
                const float dec = exp_(-0.6065306597126334f * sigmoidf_(wl[i])), av = sigmoidf_(al[i]), kk = kkr[i] * inrm;
                const int o = tt * 64 + q4 + i;
                Wd[o] = dec; KT[o] = kx[i] * (1.f + (av - 1.f) * kav[i]); KK[o] = kk; BB[o] = kk * av; RR[o] = rx[i]; VV[o] = vx[i]; }
        }
        __syncthreads();
        for (int s = 0; s < 32; ++s) {
            const int o = s * 64 + ks * 8;
            const f32x4 k0 = *(const LAS f32x4*)(KK + o), k1 = *(const LAS f32x4*)(KK + o + 4);
            float p = S[0] * k0.x + S[1] * k0.y + S[2] * k0.z + S[3] * k0.w + S[4] * k1.x + S[5] * k1.y + S[6] * k1.z + S[7] * k1.w;
            p += __shfl_xor(p, 1); p += __shfl_xor(p, 2); p += __shfl_xor(p, 4);
            const float sa = -p, vv = VV[s * 64 + r];
            const f32x4 w0 = *(const LAS f32x4*)(Wd + o), w1 = *(const LAS f32x4*)(Wd + o + 4), b0 = *(const LAS f32x4*)(BB + o), b1 = *(const LAS f32x4*)(BB + o + 4);
            const f32x4 t0 = *(const LAS f32x4*)(KT + o), t1 = *(const LAS f32x4*)(KT + o + 4), r0 = *(const LAS f32x4*)(RR + o), r1 = *(const LAS f32x4*)(RR + o + 4);
            S[0] = S[0] * w0.x + sa * b0.x + vv * t0.x; S[1] = S[1] * w0.y + sa * b0.y + vv * t0.y; S[2] = S[2] * w0.z + sa * b0.z + vv * t0.z; S[3] = S[3] * w0.w + sa * b0.w + vv * t0.w;
            S[4] = S[4] * w1.x + sa * b1.x + vv * t1.x; S[5] = S[5] * w1.y + sa * b1.y + vv * t1.y; S[6] = S[6] * w1.z + sa * b1.z + vv * t1.z; S[7] = S[7] * w1.w + sa * b1.w + vv * t1.w;
            float y = S[0] * r0.x + S[1] * r0.y + S[2] * r0.z + S[3] * r0.w + S[4] * r1.x + S[5] * r1.y + S[6] * r1.z + S[7] * r1.w;
            y += __shfl_xor(y, 1); y += __shfl_xor(y, 2); y += __shfl_xor(y, 4);
            if (ks == 0) YO[s * 64 + r] = y;
        }
        __syncthreads();
        { v2u o; o.x = pk2(YO[tt * 64 + q4], YO[tt * 64 + q4 + 1]); o.y = pk2(YO[tt * 64 + q4 + 2], YO[tt * 64 + q4 + 3]);
          *(v2u*)(YS + ((size_t)e * T + n) * 256 + hh * 64 + q4) = o; }
        __syncthreads();
    }
    if (!lat) {
        float* dst = a->out + O_RW + (((size_t)((b * 2 + layer) * 2 + e) * 4 + hh) * 64 + r) * 64 + ks * 8;
        *(f32x4*)dst = (f32x4){S[0], S[1], S[2], S[3]}; *(f32x4*)(dst + 4) = (f32x4){S[4], S[5], S[6], S[7]};
    }
}

__device__ __forceinline__ void lru_unit_seq(ArgsP a, LAS unsigned char* lds, int layer, int u) {
    const int tid = tid_();
    LAS float* WA = (LAS float*)lds;
    LAS float* WX = WA + 4096;
    LAS float* XC = WX + 4096;
    LAS float* AA = XC + 4096; LAS float* BV = AA + 4096; LAS float* HH = BV + 4096;
    const int lat = u < 32, uu = lat ? u : u - 32, b = uu >> 2, g = uu & 3;
    const int L = lat ? L_LAT : L_CTX, tok0 = lat ? T_CTX + b * L_LAT : b * L_CTX;
    const bf16* G1 = (const bf16*)(a->ws + WS_G1);
    bf16* HF = (bf16*)(a->ws + WS_HF);
    const int tt = tid >> 3, q8 = (tid & 7) * 8;
    float cw[4][8], cb[8];
#pragma unroll
    for (int i = 0; i < 8; ++i) { const int ch = g * 64 + q8 + i; cb[i] = a->in[I_CONVB][layer * 256 + ch];
#pragma unroll
        for (int j = 0; j < 4; ++j) cw[j][i] = a->in[I_CONVW][(layer * 4 + j) * 256 + ch]; }
    for (int e = 0; e < 2; ++e) {
        __syncthreads();
        for (int i = tid; i < 4096; i += NTHREADS) { const size_t src = ((size_t)((layer * 2 + e) * 4 + g)) * 4096 + i; WA[i] = a->in[I_WA][src]; WX[i] = a->in[I_WX][src]; }
        float bav[8], bxv[8], spl[8];
#pragma unroll
        for (int i = 0; i < 8; ++i) { const int ch = (layer * 2 + e) * 256 + g * 64 + q8 + i; bav[i] = a->in[I_BA][ch]; bxv[i] = a->in[I_BX][ch]; spl[i] = log1pf(exp_(-a->in[I_LAMBDA][ch])); }
        float h = 0.f;
        if (tid < 64 && lat) h = a->in[I_SLRU][((size_t)(b * 2 + layer) * 2 + e) * 256 + g * 64 + tid];
        __syncthreads();
        for (int cc = 0; cc < L / 64; ++cc) {
            const int c = e ? L / 64 - 1 - cc : cc, t = c * 64 + tt, n = tok0 + t;
            {
                float xc[8];
#pragma unroll
                for (int i = 0; i < 8; ++i) xc[i] = cb[i];
#pragma unroll
                for (int j = 0; j < 4; ++j) { const int ts = t + j - 2;
                    if (ts >= 0 && ts < L) { const v4u x = *(const v4u*)(G1 + (size_t)(tok0 + ts) * G1W + C_XL + g * 64 + q8);
                        xc[0] += cw[j][0] * bflo(x.x); xc[1] += cw[j][1] * bfhi(x.x); xc[2] += cw[j][2] * bflo(x.y); xc[3] += cw[j][3] * bfhi(x.y);
                        xc[4] += cw[j][4] * bflo(x.z); xc[5] += cw[j][5] * bfhi(x.z); xc[6] += cw[j][6] * bflo(x.w); xc[7] += cw[j][7] * bfhi(x.w); } }
#pragma unroll
                for (int i = 0; i < 8; ++i) XC[tt * 64 + q8 + i] = xc[i];
            }
            __syncthreads();
            {
                float gr[8], gi[8];
#pragma unroll
                for (int i = 0; i < 8; ++i) { gr[i] = bav[i]; gi[i] = bxv[i]; }
                for (int i = 0; i < 64; ++i) { const float x = XC[tt * 64 + i];
                    const f32x4 a0 = *(const LAS f32x4*)(WA + i * 64 + q8), a1 = *(const LAS f32x4*)(WA + i * 64 + q8 + 4), x0 = *(const LAS f32x4*)(WX + i * 64 + q8), x1 = *(const LAS f32x4*)(WX + i * 64 + q8 + 4);
                    gr[0] = fmaf(x, a0.x, gr[0]); gr[1] = fmaf(x, a0.y, gr[1]); gr[2] = fmaf(x, a0.z, gr[2]); gr[3] = fmaf(x, a0.w, gr[3]);
                    gr[4] = fmaf(x, a1.x, gr[4]); gr[5] = fmaf(x, a1.y, gr[5]); gr[6] = fmaf(x, a1.z, gr[6]); gr[7] = fmaf(x, a1.w, gr[7]);
                    gi[0] = fmaf(x, x0.x, gi[0]); gi[1] = fmaf(x, x0.y, gi[1]); gi[2] = fmaf(x, x0.z, gi[2]); gi[3] = fmaf(x, x0.w, gi[3]);
                    gi[4] = fmaf(x, x1.x, gi[4]); gi[5] = fmaf(x, x1.y, gi[5]); gi[6] = fmaf(x, x1.z, gi[6]); gi[7] = fmaf(x, x1.w, gi[7]); }
#pragma unroll
                for (int i = 0; i < 8; ++i) { const float la = -8.f * sigmoidf_(gr[i]) * spl[i];
                    AA[tt * 64 + q8 + i] = exp_(la);
                    BV[tt * 64 + q8 + i] = sqrt_(-expm1f(2.f * la)) * sigmoidf_(gi[i]) * XC[tt * 64 + q8 + i]; }
            }
            __syncthreads();
            if (tid < 64) { for (int s = 0; s < 64; ++s) { const int st = e ? 63 - s : s; h = fmaf(AA[st * 64 + tid], h, BV[st * 64 + tid]); HH[st * 64 + tid] = h; } }
            __syncthreads();
            {
                bf16* dst = HF + (size_t)n * 256 + g * 64 + q8;
                float o[8];
#pragma unroll
                for (int i = 0; i < 8; ++i) o[i] = HH[tt * 64 + q8 + i];
                if (e) { const v4u hf = *(const v4u*)dst, gl = *(const v4u*)(G1 + (size_t)n * G1W + C_GL + g * 64 + q8);
                    o[0] = (o[0] + bflo(hf.x)) * siluf_(bflo(gl.x)); o[1] = (o[1] + bfhi(hf.x)) * siluf_(bfhi(gl.x)); o[2] = (o[2] + bflo(hf.y)) * siluf_(bflo(gl.y)); o[3] = (o[3] + bfhi(hf.y)) * siluf_(bfhi(gl.y));
                    o[4] = (o[4] + bflo(hf.z)) * siluf_(bflo(gl.z)); o[5] = (o[5] + bfhi(hf.z)) * siluf_(bfhi(gl.z)); o[6] = (o[6] + bflo(hf.w)) * siluf_(bflo(gl.w)); o[7] = (o[7] + bfhi(hf.w)) * siluf_(bfhi(gl.w)); }
                v4u ov; ov.x = pk2(o[0], o[1]); ov.y = pk2(o[2], o[3]); ov.z = pk2(o[4], o[5]); ov.w = pk2(o[6], o[7]);
                *(v4u*)dst = ov;
            }
            __syncthreads();
        }
        if (tid < 64 && !lat) a->out[O_LRU + ((size_t)(b * 2 + layer) * 2 + e) * 256 + g * 64 + tid] = h;
    }
}

__device__ __forceinline__ void phase_c1(ArgsP a, int layer) {
    const int tid = tid_(), lane = tid & 63, wave = tid >> 6, G = grid_();
    const bf16* G1 = (const bf16*)(a->ws + WS_G1); const bf16* YS = (const bf16*)(a->ws + WS_G2); const bf16* Q = (const bf16*)(a->ws + WS_Q); const bf16* HF = (const bf16*)(a->ws + WS_HF);
    bf16* Y = (bf16*)(a->ws + WS_YMIX);
    const int ch = lane * 4;
    const f32x4 rk = *(const f32x4*)(a->in[I_RK] + layer * 256 + ch), lg = *(const f32x4*)(a->in[I_LNXG] + layer * 256 + ch), lb = *(const f32x4*)(a->in[I_LNXB] + layer * 256 + ch);
    v2u p_y0, p_y1, p_r, p_k, p_v, p_g, p_h; v4u p_q;
#define C1_LOAD(nn) do { const bf16* g_ = G1 + (size_t)(nn) * G1W; p_y0 = *(const v2u*)(YS + (size_t)(nn) * 256 + ch); p_y1 = *(const v2u*)(YS + ((size_t)T + (nn)) * 256 + ch); \
        p_r = *(const v2u*)(g_ + C_R + ch); p_k = *(const v2u*)(g_ + C_K + ch); p_v = *(const v2u*)(g_ + C_V + ch); p_g = *(const v2u*)(g_ + C_G + ch); \
        p_q = *(const v4u*)(Q + (size_t)(nn) * 768 + (lane >> 3) * 96 + (lane & 7) * 8); p_h = *(const v2u*)(HF + (size_t)(nn) * 256 + ch); } while (0)
    { const int n0 = bid_() * 8 + wave; if (n0 < T) C1_LOAD(n0); }
    for (int n = bid_() * 8 + wave; n < T; n += G * 8) {
        const v2u y0 = p_y0, y1 = p_y1, rv = p_r, kv = p_k, vv = p_v, gv = p_g, hq = p_h; const v4u qq = p_q;
        if (n + G * 8 < T) C1_LOAD(n + G * 8);
        float y[4] = {bflo(y0.x) + bflo(y1.x), bfhi(y0.x) + bfhi(y1.x), bflo(y0.y) + bflo(y1.y), bfhi(y0.y) + bfhi(y1.y)};
        float s = (y[0] + y[1]) + (y[2] + y[3]);
        float bon = bflo(rv.x) * bflo(kv.x) * rk.x + bfhi(rv.x) * bfhi(kv.x) * rk.y + bflo(rv.y) * bflo(kv.y) * rk.z + bfhi(rv.y) * bfhi(kv.y) * rk.w;
#pragma unroll
        for (int o = 1; o < 16; o <<= 1) { s += __shfl_xor(s, o); bon += __shfl_xor(bon, o); }
        const float mu = s * (1.f / 64.f);
        float s2 = (y[0] - mu) * (y[0] - mu) + (y[1] - mu) * (y[1] - mu) + (y[2] - mu) * (y[2] - mu) + (y[3] - mu) * (y[3] - mu);
#pragma unroll
        for (int o = 1; o < 16; o <<= 1) s2 += __shfl_xor(s2, o);
        const float rstd = rsqrt_(s2 * (1.f / 64.f) + GN_EPS);
        const float o0 = ((y[0] - mu) * rstd * lg.x + lb.x + bon * bflo(vv.x)) * siluf_(bflo(gv.x));
        const float o1 = ((y[1] - mu) * rstd * lg.y + lb.y + bon * bfhi(vv.x)) * siluf_(bfhi(gv.x));
        const float o2 = ((y[2] - mu) * rstd * lg.z + lb.z + bon * bflo(vv.y)) * siluf_(bflo(gv.y));
        const float o3 = ((y[3] - mu) * rstd * lg.w + lb.w + bon * bfhi(vv.y)) * siluf_(bfhi(gv.y));
        v2u ov; ov.x = pk2(o0, o1); ov.y = pk2(o2, o3);
        bf16* yr = Y + (size_t)n * 1024;
        *(v2u*)(yr + ch) = ov;
        *(v4u*)(yr + 256 + (lane >> 3) * 64 + (lane & 7) * 8) = qq;
        *(v2u*)(yr + 768 + ch) = hq;
    }
#undef C1_LOAD
}
#define MFMA32(a, b, c) __builtin_amdgcn_mfma_f32_32x32x16_bf16((a), (b), (c), 0, 0, 0)
#define MFMA16(a, b, c) __builtin_amdgcn_mfma_f32_16x16x32_bf16((a), (b), (c), 0, 0, 0)

__device__ __forceinline__ float tanh_fast(float x) { return 1.f - 2.f * rcp_(1.f + exp_(2.f * x)); }

constexpr int ATT_KSTR = 208, ATT_VSTR = 136, ATT_VOFF = 64 * ATT_KSTR, ATT_STAGE = 64 * ATT_KSTR + 64 * ATT_VSTR;
__device__ __forceinline__ void att_unit(ArgsP a, LAS unsigned char* lds, int u) {
    const int tid = tid_(), lane = tid & 63, wave = tid >> 6, r = lane & 31, hq = lane >> 5;
    const bf16* KN = (const bf16*)(a->ws + WS_KN); const bf16* KR = (const bf16*)(a->ws + WS_KR); const bf16* VT = (const bf16*)(a->ws + WS_VT);
    bf16* Q = (bf16*)(a->ws + WS_Q); const bf16* G1 = (const bf16*)(a->ws + WS_G1);
    int b, h, n0, Lk, kidx0; size_t vbase;
    if (u < 512) { b = u >> 6; h = (u >> 3) & 7; n0 = T_CTX + b * 2048 + (u & 7) * 256; Lk = LK_LAT; kidx0 = T_CTX + b * LK_LAT; vbase = (size_t)VT_LAT + (size_t)(b * 8 + h) * 64 * LK_LAT; }
    else { const int uu = u - 512; b = uu >> 3; h = uu & 7; n0 = b * 256; Lk = 256; kidx0 = b * 256; vbase = (size_t)(b * 8 + h) * 64 * 256; }
    const int ntiles = Lk >> 6;
    const int n = n0 + wave * 32 + r;
    bf16x8 qf[6];
#pragma unroll
    for (int ks = 0; ks < 6; ++ks) qf[ks] = *(const bf16x8*)(Q + (size_t)n * 768 + h * 96 + ks * 16 + 8 * hq);
    const int key_k = tid >> 3, ck = tid & 7, key_r = (tid >> 2) & 63, cr = tid & 3;
    const bf16* gk = KN + (size_t)(kidx0 + key_k) * 512 + h * 64 + ck * 8;
    const bf16* gr = KR + (size_t)(kidx0 + key_r) * 32 + cr * 8;
    const bf16* gv = VT + vbase + (size_t)key_k * Lk + ck * 8;
    const unsigned sk = key_k * ATT_KSTR + ck * 16, sr = key_r * ATT_KSTR + 128 + cr * 16, sv = ATT_VOFF + key_k * ATT_VSTR + ck * 16;
    v4u rk, rr, rv;
    rk = *(const v4u*)gk; rr = (tid < 256) ? *(const v4u*)gr : (v4u){0u, 0u, 0u, 0u}; rv = *(const v4u*)gv;
    __syncthreads();
    *(LAS v4u*)(lds + sk) = rk; if (tid < 256) *(LAS v4u*)(lds + sr) = rr;
    *(LAS v2u*)(lds + sv) = (v2u){rv.x, rv.y}; *(LAS v2u*)(lds + sv + 8) = (v2u){rv.z, rv.w};
    __syncthreads();
    f32x16 o0, o1;
#pragma unroll
    for (int i = 0; i < 16; ++i) { o0[i] = 0.f; o1[i] = 0.f; }
    float m = -1e30f, l = 0.f;
    for (int j = 0; j < ntiles; ++j) {
        const int buf = j & 1;
        if (j + 1 < ntiles) { rk = *(const v4u*)(gk + (size_t)(j + 1) * 64 * 512); if (tid < 256) rr = *(const v4u*)(gr + (size_t)(j + 1) * 64 * 32); rv = *(const v4u*)(gv + (j + 1) * 64); }
        const LAS unsigned char* Kb = lds + buf * ATT_STAGE;
        f32x16 s0, s1;
#pragma unroll
        for (int i = 0; i < 16; ++i) { s0[i] = 0.f; s1[i] = 0.f; }
#pragma unroll
        for (int ks = 0; ks < 6; ++ks) {
            const bf16x8 a0 = *(const LAS bf16x8*)(Kb + r * ATT_KSTR + ks * 32 + hq * 16), a1 = *(const LAS bf16x8*)(Kb + (32 + r) * ATT_KSTR + ks * 32 + hq * 16);
            s0 = MFMA32(a0, qf[ks], s0); s1 = MFMA32(a1, qf[ks], s1);
        }
        float mx = s0[0];
#pragma unroll
        for (int i = 1; i < 16; ++i) mx = fmaxf(mx, s0[i]);
#pragma unroll
        for (int i = 0; i < 16; ++i) mx = fmaxf(mx, s1[i]);
        mx = fmaxf(mx, __shfl_xor(mx, 32));
        const float mn = fmaxf(m, mx), alpha = __builtin_amdgcn_exp2f(m - mn); m = mn;
        float ps = 0.f;
#pragma unroll
        for (int i = 0; i < 16; ++i) { s0[i] = __builtin_amdgcn_exp2f(s0[i] - mn); s1[i] = __builtin_amdgcn_exp2f(s1[i] - mn); ps += s0[i] + s1[i]; }
        l = l * alpha + ps;
#pragma unroll
        for (int i = 0; i < 16; ++i) { o0[i] *= alpha; o1[i] *= alpha; }
        const LAS unsigned char* Vb = Kb + ATT_VOFF;
#pragma unroll
        for (int ks = 0; ks < 4; ++ks) {
            v4u pw;
            if (ks == 0) { pw.x = cvtpk(s0[0], s0[1]); pw.y = cvtpk(s0[2], s0[3]); pw.z = cvtpk(s0[4], s0[5]); pw.w = cvtpk(s0[6], s0[7]); }
            else if (ks == 1) { pw.x = cvtpk(s0[8], s0[9]); pw.y = cvtpk(s0[10], s0[11]); pw.z = cvtpk(s0[12], s0[13]); pw.w = cvtpk(s0[14], s0[15]); }
            else if (ks == 2) { pw.x = cvtpk(s1[0], s1[1]); pw.y = cvtpk(s1[2], s1[3]); pw.z = cvtpk(s1[4], s1[5]); pw.w = cvtpk(s1[6], s1[7]); }
            else { pw.x = cvtpk(s1[8], s1[9]); pw.y = cvtpk(s1[10], s1[11]); pw.z = cvtpk(s1[12], s1[13]); pw.w = cvtpk(s1[14], s1[15]); }
            const bf16x8 pf = __builtin_bit_cast(bf16x8, pw);
            const v2u va0 = *(const LAS v2u*)(Vb + r * ATT_VSTR + ks * 32 + hq * 8), va1 = *(const LAS v2u*)(Vb + r * ATT_VSTR + ks * 32 + 16 + hq * 8);
            const v2u vb0 = *(const LAS v2u*)(Vb + (32 + r) * ATT_VSTR + ks * 32 + hq * 8), vb1 = *(const LAS v2u*)(Vb + (32 + r) * ATT_VSTR + ks * 32 + 16 + hq * 8);
            const v4u vwa = {va0.x, va0.y, va1.x, va1.y}, vwb = {vb0.x, vb0.y, vb1.x, vb1.y};
            o0 = MFMA32(__builtin_bit_cast(bf16x8, vwa), pf, o0); o1 = MFMA32(__builtin_bit_cast(bf16x8, vwb), pf, o1);
        }
        if (j + 1 < ntiles) {
            LAS unsigned char* Nb = lds + (buf ^ 1) * ATT_STAGE;
            *(LAS v4u*)(Nb + sk) = rk; if (tid < 256) *(LAS v4u*)(Nb + sr) = rr;
            *(LAS v2u*)(Nb + sv) = (v2u){rv.x, rv.y}; *(LAS v2u*)(Nb + sv + 8) = (v2u){rv.z, rv.w};
        }
        __syncthreads();
    }
    l += __shfl_xor(l, 32);
    const float inv = rcp_(l);
#pragma unroll
    for (int mt = 0; mt < 2; ++mt)
#pragma unroll
        for (int g = 0; g < 4; ++g) {
            const int dv0 = 32 * mt + 8 * g + 4 * hq;
            const v2u gm = *(const v2u*)(G1 + (size_t)n * G1W + C_GM + h * 64 + dv0);
            const float x0 = (mt ? o1[4 * g + 0] : o0[4 * g + 0]) * inv, x1 = (mt ? o1[4 * g + 1] : o0[4 * g + 1]) * inv, x2 = (mt ? o1[4 * g + 2] : o0[4 * g + 2]) * inv, x3 = (mt ? o1[4 * g + 3] : o0[4 * g + 3]) * inv;
            v2u ov; ov.x = cvtpk(x0 * siluf_(bflo(gm.x)), x1 * siluf_(bfhi(gm.x))); ov.y = cvtpk(x2 * siluf_(bflo(gm.y)), x3 * siluf_(bfhi(gm.y)));
            *(v2u*)(Q + (size_t)n * 768 + h * 96 + dv0) = ov;
        }
}

constexpr int A2_QSTR = 528, A2_KVSTR = 272, A2_KVOFF = 64 * A2_QSTR;
__device__ __forceinline__ void a2_unit(ArgsP a, LAS unsigned char* lds, int layer, int unit) {
    const int tid = tid_(), lane = tid & 63, wave = tid >> 6, tn = lane & 15, g = lane >> 4;
    constexpr int NU_TOK = T / 64;
    const bool is_tok = unit < NU_TOK;
    const bf16* G2 = (const bf16*)(a->ws + WS_G2);
    bf16* Q = (bf16*)(a->ws + WS_Q); bf16* KN = (bf16*)(a->ws + WS_KN); bf16* KR = (bf16*)(a->ws + WS_KR); bf16* VT = (bf16*)(a->ws + WS_VT);
    const bf16* WUQ = (const bf16*)(a->ws + WS_WUQ) + (size_t)layer * 768 * 256;
    const bf16* WUKV = (const bf16*)(a->ws + WS_WUKV) + (size_t)layer * 1024 * 128;
    const float* ROPE1 = (const float*)(a->ws + WS_ROPE);
    __syncthreads();
    v2u cq8[8], kv8[8]; unsigned kr8[8];
    if (is_tok) {
#pragma unroll
        for (int rr = 0; rr < 8; ++rr) { const size_t n_ = (size_t)(unit * 64 + wave * 8 + rr);
            cq8[rr] = *(const v2u*)(G2 + n_ * G2W + lane * 4); kv8[rr] = *(const v2u*)(G2 + n_ * G2W + 256 + (lane & 31) * 4); kr8[rr] = G2[n_ * G2W + 384 + (lane & 31)]; }
    }
#pragma unroll
    for (int rr = 0; rr < 8; ++rr) {
        const int r = wave * 8 + rr;
        if (is_tok) {
            const int n = unit * 64 + r; const Tok tk = tok_of(n);
            const v2u cqv = cq8[rr];
            const float c0 = bflo(cqv.x), c1 = bfhi(cqv.x), c2 = bflo(cqv.y), c3 = bfhi(cqv.y);
            const float rq = rsqrt_(wave_sum(c0 * c0 + c1 * c1 + c2 * c2 + c3 * c3) * (1.f / 256.f) + 1e-6f);
            const f32x4 qn = *(const f32x4*)(a->in[I_QNORM] + layer * 256 + lane * 4);
            *(LAS v2u*)(lds + r * A2_QSTR + lane * 8) = (v2u){cvtpk(c0 * rq * qn.x, c1 * rq * qn.y), cvtpk(c2 * rq * qn.z, c3 * rq * qn.w)};
            float k0 = 0.f, k1 = 0.f, k2 = 0.f, k3 = 0.f;
            if (lane < 32) { const v2u kv = kv8[rr]; k0 = bflo(kv.x); k1 = bfhi(kv.x); k2 = bflo(kv.y); k3 = bfhi(kv.y); }
            const float rk = rsqrt_(wave_sum(k0 * k0 + k1 * k1 + k2 * k2 + k3 * k3) * (1.f / 128.f) + 1e-6f);
            if (lane < 32) {
                const f32x4 kn = *(const f32x4*)(a->in[I_KVNORM] + layer * 128 + lane * 4);
                f32x4 o; o.x = k0 * rk * kn.x; o.y = k1 * rk * kn.y; o.z = k2 * rk * kn.z; o.w = k3 * rk * kn.w;
                if (!tk.lat) *(f32x4*)(a->out + O_CKV + ((size_t)(tk.b * 2 + layer) * 256 + tk.t) * 128 + lane * 4) = o;
                *(LAS v2u*)(lds + A2_KVOFF + r * A2_KVSTR + lane * 8) = (v2u){cvtpk(o.x, o.y), cvtpk(o.z, o.w)};
            }
            float krv = (lane < 32) ? bf2f(kr8[rr]) : 0.f;
            const float other = __shfl_xor(krv, 1);
            if (lane < 32) {
                if (!tk.lat) a->out[O_KR + ((size_t)(tk.b * 2 + layer) * 256 + tk.t) * 32 + lane] = krv;
                else { const float c = ROPE1[((size_t)tk.t * 16 + (lane >> 1)) * 2], s = ROPE1[((size_t)tk.t * 16 + (lane >> 1)) * 2 + 1]; krv = (lane & 1) ? (other * s + krv * c) : (krv * c - other * s); }
                KR[(size_t)tk.kidx * 32 + lane] = (bf16)f2bf(krv);
            }
        } else {
            const int cr = (unit - NU_TOK) * 64 + r, b = cr >> 8, j = cr & 255;
            const size_t src = ((size_t)(b * 2 + layer) * 256 + j);
            if (lane < 32) { const f32x4 v = *(const f32x4*)(a->in[I_CCKV] + src * 128 + lane * 4);
                *(LAS v2u*)(lds + A2_KVOFF + r * A2_KVSTR + lane * 8) = (v2u){cvtpk(v.x, v.y), cvtpk(v.z, v.w)};
                KR[(size_t)(T_CTX + b * LK_LAT + j) * 32 + lane] = (bf16)f2bf(a->in[I_CKR][src * 32 + lane]); }
        }
    }
    __syncthreads();
    constexpr int A2_STG = 52224, A2_SQSTR = 784, A2_SKSTR = 1040, A2_SVSTR = 144;
    const int n0 = is_tok ? unit * 64 : 0;
    if (is_tok) {
      const float* ROPE = (const float*)(a->ws + WS_ROPE);
      for (int qh = 0; qh < 2; ++qh) {
        f32x4 acc[3][4];
#pragma unroll
        for (int f = 0; f < 3; ++f)
#pragma unroll
            for (int t = 0; t < 4; ++t) acc[f][t] = (f32x4){0.f, 0.f, 0.f, 0.f};
        bf16x8 afq[3][8];
        const bf16* wq = WUQ + (size_t)((qh * 24 + wave * 3) * 16 + tn) * 256 + g * 8;
#pragma unroll
        for (int f = 0; f < 3; ++f)
#pragma unroll
            for (int ks = 0; ks < 8; ++ks) afq[f][ks] = *(const bf16x8*)(wq + f * 16 * 256 + ks * 32);
#pragma unroll
        for (int ks = 0; ks < 8; ++ks) {
            bf16x8 bfr[4];
#pragma unroll
            for (int t = 0; t < 4; ++t) bfr[t] = *(const LAS bf16x8*)(lds + (t * 16 + tn) * A2_QSTR + ks * 64 + g * 16);
#pragma unroll
            for (int f = 0; f < 3; ++f)
#pragma unroll
                for (int t = 0; t < 4; ++t) acc[f][t] = MFMA16(afq[f][ks], bfr[t], acc[f][t]);
        }
#pragma unroll
        for (int f = 0; f < 3; ++f) { const int fl = (wave * 3 + f) * 16 + 4 * g, f0 = qh * 384 + fl, d = f0 % 96;
#pragma unroll
            for (int t = 0; t < 4; ++t) { const int r = t * 16 + tn, n = n0 + r;
                float v0 = acc[f][t][0], v1 = acc[f][t][1], v2 = acc[f][t][2], v3 = acc[f][t][3];
                if (n >= T_CTX && d >= 64) { const int tt = (n - T_CTX) & 2047; const f32x4 cs = *(const f32x4*)(ROPE + ((size_t)tt * 16 + ((d - 64) >> 1)) * 2);
                    const float y0 = v0 * cs.x - v1 * cs.y, y1 = v0 * cs.y + v1 * cs.x, y2 = v2 * cs.z - v3 * cs.w, y3 = v2 * cs.w + v3 * cs.z; v0 = y0; v1 = y1; v2 = y2; v3 = y3; }
                *(LAS v2u*)(lds + A2_STG + r * A2_SQSTR + fl * 2) = (v2u){cvtpk(v0, v1), cvtpk(v2, v3)}; } }
        __syncthreads();
#pragma unroll
        for (int i = 0; i < 6; ++i) { const int c = tid + 512 * i, row = c / 48, c16 = c % 48;
            *(v4u*)(Q + (size_t)(n0 + row) * 768 + qh * 384 + c16 * 8) = *(const LAS v4u*)(lds + A2_STG + row * A2_SQSTR + c16 * 16); }
        __syncthreads();
      }
    }
    int kidx0, latu, bu, kpos0;
    if (is_tok) { const Tok tk = tok_of(n0); kidx0 = tk.kidx; latu = tk.lat; bu = tk.b; kpos0 = tk.lat ? PAST + tk.t : tk.t; }
    else { const int cr = (unit - NU_TOK) * 64; bu = cr >> 8; kpos0 = cr & 255; latu = 1; kidx0 = T_CTX + bu * LK_LAT + kpos0; }
    for (int half = 0; half < 2; ++half) {
        f32x4 acc[4][4];
#pragma unroll
        for (int f = 0; f < 4; ++f)
#pragma unroll
            for (int t = 0; t < 4; ++t) acc[f][t] = (f32x4){0.f, 0.f, 0.f, 0.f};
        bf16x8 afk[4][4];
        const bf16* wk = WUKV + (size_t)(wave * 128 + half * 64 + tn) * 128 + g * 8;
#pragma unroll
        for (int f = 0; f < 4; ++f)
#pragma unroll
            for (int ks = 0; ks < 4; ++ks) afk[f][ks] = *(const bf16x8*)(wk + f * 16 * 128 + ks * 32);
#pragma unroll
        for (int ks = 0; ks < 4; ++ks) {
            bf16x8 bfr[4];
#pragma unroll
            for (int t = 0; t < 4; ++t) bfr[t] = *(const LAS bf16x8*)(lds + A2_KVOFF + (t * 16 + tn) * A2_KVSTR + ks * 64 + g * 16);
#pragma unroll
            for (int f = 0; f < 4; ++f)
#pragma unroll
                for (int t = 0; t < 4; ++t) acc[f][t] = MFMA16(afk[f][ks], bfr[t], acc[f][t]);
        }
#pragma unroll
        for (int f = 0; f < 4; ++f) { const int x = wave * 64 + f * 16 + 4 * g;
#pragma unroll
            for (int t = 0; t < 4; ++t) { const int r = t * 16 + tn;
                if (half == 0) *(LAS v2u*)(lds + A2_STG + r * A2_SKSTR + x * 2) = (v2u){cvtpk(acc[f][t][0], acc[f][t][1]), cvtpk(acc[f][t][2], acc[f][t][3])};
                else { const unsigned p01 = cvtpk(acc[f][t][0], acc[f][t][1]), p23 = cvtpk(acc[f][t][2], acc[f][t][3]);
                    *(LAS bf16*)(lds + A2_STG + (x + 0) * A2_SVSTR + r * 2) = (bf16)(p01 & 0xffffu); *(LAS bf16*)(lds + A2_STG + (x + 1) * A2_SVSTR + r * 2) = (bf16)(p01 >> 16);
                    *(LAS bf16*)(lds + A2_STG + (x + 2) * A2_SVSTR + r * 2) = (bf16)(p23 & 0xffffu); *(LAS bf16*)(lds + A2_STG + (x + 3) * A2_SVSTR + r * 2) = (bf16)(p23 >> 16); } } }
        __syncthreads();
        if (half == 0) {
#pragma unroll
            for (int i = 0; i < 8; ++i) { const int c = tid + 512 * i, row = c >> 6, c16 = c & 63;
                *(v4u*)(KN + (size_t)(kidx0 + row) * 512 + c16 * 8) = *(const LAS v4u*)(lds + A2_STG + row * A2_SKSTR + c16 * 16); }
        } else {
            const int Lk = latu ? LK_LAT : 256;
#pragma unroll
            for (int i = 0; i < 8; ++i) { const int c = tid + 512 * i, row = c >> 3, part = c & 7, h = row >> 6, dv = row & 63;
                const size_t base = latu ? (size_t)VT_LAT + ((size_t)(bu * 8 + h) * 64 + dv) * LK_LAT : ((size_t)(bu * 8 + h) * 64 + dv) * 256;
                *(v4u*)(VT + base + kpos0 + part * 8) = *(const LAS v4u*)(lds + A2_STG + row * A2_SVSTR + part * 16); }
            (void)Lk;
        }
        __syncthreads();
    }
}

constexpr int RW_W2T = 0, RW_A2T = 9216, RW_TH = 18432, RW_HA = 27648, RW_CH0 = 36864, RW_CHB = 20992, RW_YB = 120832;
constexpr int RC_KP = 0, RC_RP = 2304, RC_BP = 4608, RC_KT = 6912, RC_KTT = 9216, RC_NBPT = 11776, RC_VTT = 14336, RC_LK = 16896, RC_TM = 17536, RC_ARK = 18176, RC_NARB = 18816, RC_G15 = 19456, RC_LBF = 19712, RC_SSQ = 20736;
__device__ __forceinline__ void rwkv_unit_mfma(ArgsP a, LAS unsigned char* lds, int layer, int u) {
    const int tid = tid_(), lane = tid & 63, wave = tid >> 6, i16 = lane & 15, g = lane >> 4;
    const int lat = u < 64, uu = lat ? u : u - 64, b = uu >> 3, e = (uu >> 2) & 1, hh = uu & 3;
    const int L = lat ? L_LAT : L_CTX, tok0 = lat ? T_CTX + b * L_LAT : b * L_CTX;
    const bf16* G1 = (const bf16*)(a->ws + WS_G1);
    bf16* YS = (bf16*)(a->ws + WS_G2);
    __syncthreads();
    for (int i = tid; i < 4096; i += NTHREADS) { const int j = i >> 6, c = i & 63;
        *(LAS bf16*)(lds + RW_W2T + (c * 72 + j) * 2) = (bf16)f2bf(a->in[I_W2][((size_t)(layer * 2 + e) * 64 + j) * 256 + hh * 64 + c]);
        *(LAS bf16*)(lds + RW_A2T + (c * 72 + j) * 2) = (bf16)f2bf(a->in[I_A2][((size_t)(layer * 2 + e) * 64 + j) * 256 + hh * 64 + c]); }
    const int st_tok = tid >> 3, st_c8 = (tid & 7) * 8;
#define RW_STAGE(sc) do { const int step_ = (sc) * 64 + st_tok, t_ = e ? L - 1 - step_ : step_; const bf16* gp_ = G1 + (size_t)(tok0 + t_) * G1W + C_LORA + e * 64 + st_c8; \
        const v4u hw_ = *(const v4u*)gp_, ha_ = *(const v4u*)(gp_ + 128); v4u th_; \
        th_.x = cvtpk(tanh_fast(bflo(hw_.x)), tanh_fast(bfhi(hw_.x))); th_.y = cvtpk(tanh_fast(bflo(hw_.y)), tanh_fast(bfhi(hw_.y))); th_.z = cvtpk(tanh_fast(bflo(hw_.z)), tanh_fast(bfhi(hw_.z))); th_.w = cvtpk(tanh_fast(bflo(hw_.w)), tanh_fast(bfhi(hw_.w))); \
        *(LAS v4u*)(lds + RW_TH + st_tok * 144 + st_c8 * 2) = th_; *(LAS v4u*)(lds + RW_HA + st_tok * 144 + st_c8 * 2) = ha_; } while (0)
    RW_STAGE(0);
    f32x4 ST[4];
    {
        const int v = 16 * (wave & 3) + i16;
#pragma unroll
        for (int kt = 0; kt < 4; ++kt) ST[kt] = lat ? *(const f32x4*)(a->in[I_SRW] + (((size_t)((b * 2 + layer) * 2 + e) * 4 + hh) * 64 + v) * 64 + 16 * kt + 4 * g) : (f32x4){0.f, 0.f, 0.f, 0.f};
    }
    const int pc = wave & 3, ph = wave >> 2;
    LAS unsigned char* CH = lds + RW_CH0 + pc * RW_CHB;
    __syncthreads();
    const int nsc = L >> 6;
    v2u pk[2], pr[2], pv[2];
#define RW_PREFETCH(sc) do { const int ps_ = (sc) * 64 + pc * 16 + i16, pt_ = e ? L - 1 - ps_ : ps_; const bf16* gq_ = G1 + (size_t)(tok0 + pt_) * G1W + hh * 64 + (2 * ph) * 16 + 4 * g; \
        pk[0] = *(const v2u*)(gq_ + C_K); pk[1] = *(const v2u*)(gq_ + C_K + 16); pr[0] = *(const v2u*)(gq_ + C_R); pr[1] = *(const v2u*)(gq_ + C_R + 16); pv[0] = *(const v2u*)(gq_ + C_V); pv[1] = *(const v2u*)(gq_ + C_V + 16); } while (0)
    RW_PREFETCH(0);
    for (int sc = 0; sc < nsc; ++sc) {
        const v2u ck[2] = {pk[0], pk[1]}, cr[2] = {pr[0], pr[1]}, cv[2] = {pv[0], pv[1]};
        if (sc + 1 < nsc) RW_PREFETCH(sc + 1);
        float dec[8], av[8], kx[8], rx[8], kk[8];
        {
            f32x4 aw[2], aa[2];
#pragma unroll
            for (int c2 = 0; c2 < 2; ++c2) { aw[c2] = (f32x4){0.f, 0.f, 0.f, 0.f}; aa[c2] = (f32x4){0.f, 0.f, 0.f, 0.f}; }
#pragma unroll
            for (int ks = 0; ks < 2; ++ks) {
                const bf16x8 bth = *(const LAS bf16x8*)(lds + RW_TH + (pc * 16 + i16) * 144 + ks * 64 + g * 16), bha = *(const LAS bf16x8*)(lds + RW_HA + (pc * 16 + i16) * 144 + ks * 64 + g * 16);
#pragma unroll
                for (int c2 = 0; c2 < 2; ++c2) { const int row = (2 * ph + c2) * 16 + i16;
                    const bf16x8 w2f = *(const LAS bf16x8*)(lds + RW_W2T + row * 144 + ks * 64 + g * 16), a2f = *(const LAS bf16x8*)(lds + RW_A2T + row * 144 + ks * 64 + g * 16);
                    aw[c2] = MFMA16(w2f, bth, aw[c2]); aa[c2] = MFMA16(a2f, bha, aa[c2]); }
            }
            float ss = 0.f;
#pragma unroll
            for (int c2 = 0; c2 < 2; ++c2) { const int ch = (2 * ph + c2) * 16 + 4 * g, gch = hh * 64 + ch;
                const f32x4 w0 = *(const f32x4*)(a->in[I_W0] + (layer * 2 + e) * 256 + gch), a0 = *(const f32x4*)(a->in[I_A0] + (layer * 2 + e) * 256 + gch), kw = *(const f32x4*)(a->in[I_KK] + layer * 256 + gch);
                const v2u kv = ck[c2], rv = cr[c2];
                const float kq[4] = {bflo(kv.x), bfhi(kv.x), bflo(kv.y), bfhi(kv.y)}, rq[4] = {bflo(rv.x), bfhi(rv.x), bflo(rv.y), bfhi(rv.y)};
#pragma unroll
                for (int q = 0; q < 4; ++q) { const int o = c2 * 4 + q;
                    dec[o] = exp_(-0.6065306597126334f * sigmoidf_(aw[c2][q] + w0[q])); av[o] = sigmoidf_(aa[c2][q] + a0[q]);
                    kx[o] = kq[q]; rx[o] = rq[q]; kk[o] = kq[q] * kw[q]; ss += kk[o] * kk[o]; }
            }
            ss += __shfl_xor(ss, 16); ss += __shfl_xor(ss, 32);
            if (g == 0) *(LAS float*)(CH + RC_SSQ + (i16 * 2 + ph) * 4) = ss;
        }
        __syncthreads();
        {
            const float tot = *(const LAS float*)(CH + RC_SSQ + (i16 * 2) * 4) + *(const LAS float*)(CH + RC_SSQ + (i16 * 2 + 1) * 4);
            const float inrm = rcp_(fmaxf(sqrt_(tot), 1e-12f));
            float G8[8], Gx8[8];
#pragma unroll
            for (int o8 = 0; o8 < 8; ++o8) G8[o8] = dec[o8];
#pragma unroll
            for (int o8 = 0; o8 < 8; ++o8) G8[o8] *= dpp_f<0x111>(1.f, G8[o8]);
#pragma unroll
            for (int o8 = 0; o8 < 8; ++o8) G8[o8] *= dpp_f<0x112>(1.f, G8[o8]);
#pragma unroll
            for (int o8 = 0; o8 < 8; ++o8) G8[o8] *= dpp_f<0x114>(1.f, G8[o8]);
#pragma unroll
            for (int o8 = 0; o8 < 8; ++o8) G8[o8] *= dpp_f<0x118>(1.f, G8[o8]);
#pragma unroll
            for (int o8 = 0; o8 < 8; ++o8) Gx8[o8] = dpp_f<0x111>(1.f, G8[o8]);
#pragma unroll
            for (int c2 = 0; c2 < 2; ++c2) { const int ch = (2 * ph + c2) * 16 + 4 * g, gch = hh * 64 + ch;
                const f32x4 ka = *(const f32x4*)(a->in[I_KA] + layer * 256 + gch);
                float kp[4], bp[4], kt[4], rp[4];
#pragma unroll
                for (int q = 0; q < 4; ++q) { const int o = c2 * 4 + q;
                    const float G = G8[o], Gex = Gx8[o];
                    const float kkn = kk[o] * inrm, iG = rcp_(G);
                    kp[q] = Gex * kkn; bp[q] = kkn * av[o] * iG; kt[q] = kx[o] * (1.f + (av[o] - 1.f) * ka[q]) * iG; rp[q] = G * rx[o];
                    if (i16 == 15) *(LAS float*)(CH + RC_G15 + (ch + q) * 4) = G;
                    { const unsigned pk_ = cvtpk(kt[q], -bp[q]); *(LAS bf16*)(CH + RC_KTT + (ch + q) * 40 + i16 * 2) = (bf16)(pk_ & 0xffffu); *(LAS bf16*)(CH + RC_NBPT + (ch + q) * 40 + i16 * 2) = (bf16)(pk_ >> 16); } }
                *(LAS v2u*)(CH + RC_KP + i16 * 144 + ch * 2) = (v2u){cvtpk(kp[0], kp[1]), cvtpk(kp[2], kp[3])};
                *(LAS v2u*)(CH + RC_BP + i16 * 144 + ch * 2) = (v2u){cvtpk(bp[0], bp[1]), cvtpk(bp[2], bp[3])};
                *(LAS v2u*)(CH + RC_KT + i16 * 144 + ch * 2) = (v2u){cvtpk(kt[0], kt[1]), cvtpk(kt[2], kt[3])};
                *(LAS v2u*)(CH + RC_RP + i16 * 144 + ch * 2) = (v2u){cvtpk(rp[0], rp[1]), cvtpk(rp[2], rp[3])};
                const v2u vv = cv[c2];
                *(LAS bf16*)(CH + RC_VTT + (ch + 0) * 40 + i16 * 2) = (bf16)(vv.x & 0xffffu); *(LAS bf16*)(CH + RC_VTT + (ch + 1) * 40 + i16 * 2) = (bf16)(vv.x >> 16);
                *(LAS bf16*)(CH + RC_VTT + (ch + 2) * 40 + i16 * 2) = (bf16)(vv.y & 0xffffu); *(LAS bf16*)(CH + RC_VTT + (ch + 3) * 40 + i16 * 2) = (bf16)(vv.y >> 16);
            }
        }
        __syncthreads();
        {
            f32x4 d0 = (f32x4){0.f, 0.f, 0.f, 0.f}, d1 = (f32x4){0.f, 0.f, 0.f, 0.f};
            const int xoff = ph ? RC_KP : RC_RP, y0off = ph ? RC_BP : RC_KT, y1off = ph ? RC_KT : RC_BP;
#pragma unroll
            for (int ks = 0; ks < 2; ++ks) {
                const bf16x8 xf = *(const LAS bf16x8*)(CH + xoff + i16 * 144 + ks * 64 + g * 16);
                const bf16x8 y0 = *(const LAS bf16x8*)(CH + y0off + i16 * 144 + ks * 64 + g * 16), y1 = *(const LAS bf16x8*)(CH + y1off + i16 * 144 + ks * 64 + g * 16);
                d0 = MFMA16(xf, y0, d0); d1 = MFMA16(xf, y1, d1);
            }
#pragma unroll
            for (int q = 0; q < 4; ++q) { const int i = 4 * g + q, j = i16;
                if (ph) { *(LAS float*)(CH + RC_LBF + (i * 16 + j) * 4) = (j < i) ? d0[q] : 0.f; *(LAS bf16*)(CH + RC_LK + i * 40 + j * 2) = (bf16)(cvtpk((j < i) ? d1[q] : 0.f, 0.f) & 0xffffu); }
                else { const unsigned pk_ = cvtpk((j <= i) ? d0[q] : 0.f, (j <= i) ? -d1[q] : 0.f); *(LAS bf16*)(CH + RC_ARK + i * 40 + j * 2) = (bf16)(pk_ & 0xffffu); *(LAS bf16*)(CH + RC_NARB + i * 40 + j * 2) = (bf16)(pk_ >> 16); }
            }
            if (ph) {
                float x[16];
#pragma unroll
                for (int i = 0; i < 16; ++i) { float s = (i == i16) ? 1.f : 0.f;
#pragma unroll
                    for (int j4 = 0; j4 < (i + 3) / 4; ++j4) { const f32x4 lr = *(const LAS f32x4*)(CH + RC_LBF + (i * 16 + j4 * 4) * 4);
#pragma unroll
                        for (int jj = 0; jj < 4; ++jj) { const int j = j4 * 4 + jj; if (j < i) s -= lr[jj] * x[j]; } }
                    x[i] = s; }
                if (g == 0) {
#pragma unroll
                    for (int i = 0; i < 16; i += 2) { const unsigned pk_ = cvtpk(x[i], x[i + 1]); *(LAS bf16*)(CH + RC_TM + i * 40 + i16 * 2) = (bf16)(pk_ & 0xffffu); *(LAS bf16*)(CH + RC_TM + (i + 1) * 40 + i16 * 2) = (bf16)(pk_ >> 16); } }
            }
        }
        __syncthreads();
        if (wave < 4) {
            const int vt = wave;
#pragma unroll 1
            for (int c = 0; c < 4; ++c) {
                const LAS unsigned char* C = lds + RW_CH0 + c * RW_CHB;
                v4u sb01, sb23;
                sb01.x = cvtpk(ST[0][0], ST[0][1]); sb01.y = cvtpk(ST[0][2], ST[0][3]); sb01.z = cvtpk(ST[1][0], ST[1][1]); sb01.w = cvtpk(ST[1][2], ST[1][3]);
                sb23.x = cvtpk(ST[2][0], ST[2][1]); sb23.y = cvtpk(ST[2][2], ST[2][3]); sb23.z = cvtpk(ST[3][0], ST[3][1]); sb23.w = cvtpk(ST[3][2], ST[3][3]);
                const bf16x8 s01 = __builtin_bit_cast(bf16x8, sb01), s23 = __builtin_bit_cast(bf16x8, sb23);
                const v2u kp0a = *(const LAS v2u*)(C + RC_KP + i16 * 144 + (4 * g) * 2), kp0b = *(const LAS v2u*)(C + RC_KP + i16 * 144 + (16 + 4 * g) * 2);
                const v2u kp1a = *(const LAS v2u*)(C + RC_KP + i16 * 144 + (32 + 4 * g) * 2), kp1b = *(const LAS v2u*)(C + RC_KP + i16 * 144 + (48 + 4 * g) * 2);
                const v2u rp0a = *(const LAS v2u*)(C + RC_RP + i16 * 144 + (4 * g) * 2), rp0b = *(const LAS v2u*)(C + RC_RP + i16 * 144 + (16 + 4 * g) * 2);
                const v2u rp1a = *(const LAS v2u*)(C + RC_RP + i16 * 144 + (32 + 4 * g) * 2), rp1b = *(const LAS v2u*)(C + RC_RP + i16 * 144 + (48 + 4 * g) * 2);
                const v2u lk = *(const LAS v2u*)(C + RC_LK + i16 * 40 + g * 8), tm = *(const LAS v2u*)(C + RC_TM + i16 * 40 + g * 8);
                const v2u ark = *(const LAS v2u*)(C + RC_ARK + i16 * 40 + g * 8), narb = *(const LAS v2u*)(C + RC_NARB + i16 * 40 + g * 8);
                const v2u vf = *(const LAS v2u*)(C + RC_VTT + (16 * vt + i16) * 40 + g * 8);
                const v4u z4 = {0u, 0u, 0u, 0u};
                f32x4 rhs = (f32x4){0.f, 0.f, 0.f, 0.f};
                rhs = MFMA16(__builtin_bit_cast(bf16x8, ((v4u){kp0a.x, kp0a.y, kp0b.x, kp0b.y})), s01, rhs);
                rhs = MFMA16(__builtin_bit_cast(bf16x8, ((v4u){kp1a.x, kp1a.y, kp1b.x, kp1b.y})), s23, rhs);
                rhs = MFMA16(__builtin_bit_cast(bf16x8, ((v4u){lk.x, lk.y, 0u, 0u})), __builtin_bit_cast(bf16x8, ((v4u){vf.x, vf.y, 0u, 0u})), rhs);
                f32x4 z = MFMA16(__builtin_bit_cast(bf16x8, ((v4u){tm.x, tm.y, 0u, 0u})), __builtin_bit_cast(bf16x8, ((v4u){cvtpk(rhs[0], rhs[1]), cvtpk(rhs[2], rhs[3]), 0u, 0u})), ((f32x4){0.f, 0.f, 0.f, 0.f}));
                const bf16x8 vz = __builtin_bit_cast(bf16x8, ((v4u){vf.x, vf.y, cvtpk(z[0], z[1]), cvtpk(z[2], z[3])}));
                f32x4 y = (f32x4){0.f, 0.f, 0.f, 0.f};
                y = MFMA16(__builtin_bit_cast(bf16x8, ((v4u){rp0a.x, rp0a.y, rp0b.x, rp0b.y})), s01, y);
                y = MFMA16(__builtin_bit_cast(bf16x8, ((v4u){rp1a.x, rp1a.y, rp1b.x, rp1b.y})), s23, y);
                y = MFMA16(__builtin_bit_cast(bf16x8, ((v4u){ark.x, ark.y, narb.x, narb.y})), vz, y);
#pragma unroll
                for (int kt = 0; kt < 4; ++kt) {
                    const v2u ktf = *(const LAS v2u*)(C + RC_KTT + (16 * kt + i16) * 40 + g * 8), nbf = *(const LAS v2u*)(C + RC_NBPT + (16 * kt + i16) * 40 + g * 8);
                    const f32x4 g15 = *(const LAS f32x4*)(C + RC_G15 + (16 * kt + 4 * g) * 4);
                    ST[kt] = MFMA16(__builtin_bit_cast(bf16x8, ((v4u){ktf.x, ktf.y, nbf.x, nbf.y})), vz, ST[kt]);
                    ST[kt] = ST[kt] * g15;
                }
                { const unsigned y01 = cvtpk(y[0], y[1]), y23 = cvtpk(y[2], y[3]); LAS unsigned char* yb = lds + RW_YB + (c * 16 + 4 * g) * 144 + (16 * vt + i16) * 2;
                  *(LAS bf16*)(yb) = (bf16)(y01 & 0xffffu); *(LAS bf16*)(yb + 144) = (bf16)(y01 >> 16); *(LAS bf16*)(yb + 288) = (bf16)(y23 & 0xffffu); *(LAS bf16*)(yb + 432) = (bf16)(y23 >> 16); }
                (void)z4;
            }
        } else if (sc + 1 < nsc) {
            const int r0 = (tid - 256) >> 3;
#pragma unroll
            for (int hrow = 0; hrow < 2; ++hrow) { const int tokr = r0 + 32 * hrow, step_ = (sc + 1) * 64 + tokr, t_ = e ? L - 1 - step_ : step_;
                const bf16* gp_ = G1 + (size_t)(tok0 + t_) * G1W + C_LORA + e * 64 + st_c8;
                const v4u hw_ = *(const v4u*)gp_, ha_ = *(const v4u*)(gp_ + 128); v4u th_;
                th_.x = cvtpk(tanh_fast(bflo(hw_.x)), tanh_fast(bfhi(hw_.x))); th_.y = cvtpk(tanh_fast(bflo(hw_.y)), tanh_fast(bfhi(hw_.y))); th_.z = cvtpk(tanh_fast(bflo(hw_.z)), tanh_fast(bfhi(hw_.z))); th_.w = cvtpk(tanh_fast(bflo(hw_.w)), tanh_fast(bfhi(hw_.w)));
                *(LAS v4u*)(lds + RW_TH + tokr * 144 + st_c8 * 2) = th_; *(LAS v4u*)(lds + RW_HA + tokr * 144 + st_c8 * 2) = ha_; }
        }
        __syncthreads();
        {
            const int row = tid >> 3, part = tid & 7, step = sc * 64 + row, t = e ? L - 1 - step : step;
            *(v4u*)(YS + ((size_t)e * T + tok0 + t) * 256 + hh * 64 + part * 8) = *(const LAS v4u*)(lds + RW_YB + row * 144 + part * 16);
        }
    }
#undef RW_STAGE
#undef RW_PREFETCH
    if (!lat && wave < 4) {
        const int v = 16 * wave + i16;
#pragma unroll
        for (int kt = 0; kt < 4; ++kt) *(f32x4*)(a->out + O_RW + (((size_t)((b * 2 + layer) * 2 + e) * 4 + hh) * 64 + v) * 64 + 16 * kt + 4 * g) = ST[kt];
    }
}

constexpr int LR_WAT = 0, LR_XCB = 18432, LR_XCF = 27648, LR_AA = 44032, LR_BV = 60416, LR_HH = 76800, LR_SP = 93184, LR_SH = 95232, LR_HC = 97280;
__device__ __forceinline__ void lru_unit_mfma(ArgsP a, LAS unsigned char* lds, int layer, int u) {
    const int tid = tid_(), lane = tid & 63, wave = tid >> 6, i16 = lane & 15, g4 = lane >> 4;
    const int lat = u < 32, uu = lat ? u : u - 32, b = uu >> 2, g = uu & 3;
    const int L = lat ? L_LAT : L_CTX, tok0 = lat ? T_CTX + b * L_LAT : b * L_CTX;
    const bf16* G1 = (const bf16*)(a->ws + WS_G1);
    bf16* HF = (bf16*)(a->ws + WS_HF);
    LAS float* XCF = (LAS float*)(lds + LR_XCF); LAS float* AA = (LAS float*)(lds + LR_AA); LAS float* BV = (LAS float*)(lds + LR_BV); LAS float* HH = (LAS float*)(lds + LR_HH);
    LAS float* SP = (LAS float*)(lds + LR_SP); LAS float* SH = (LAS float*)(lds + LR_SH); LAS float* HC = (LAS float*)(lds + LR_HC);
    const int tt = tid >> 3, q8 = (tid & 7) * 8;
    float cw[4][8], cb[8];
#pragma unroll
    for (int i = 0; i < 8; ++i) { const int ch = g * 64 + q8 + i; cb[i] = a->in[I_CONVB][layer * 256 + ch];
#pragma unroll
        for (int j = 0; j < 4; ++j) cw[j][i] = a->in[I_CONVW][(layer * 4 + j) * 256 + ch]; }
    const int ot = wave & 3, tp = wave >> 2;
    const int sch = tid & 63, seg = tid >> 6;
    for (int e = 0; e < 2; ++e) {
        __syncthreads();
        for (int i = tid; i < 4096; i += NTHREADS) { const size_t src = ((size_t)((layer * 2 + e) * 4 + g)) * 4096 + i; const int ii = i >> 6, oo = i & 63;
            *(LAS bf16*)(lds + LR_WAT + (oo * 72 + ii) * 2) = (bf16)f2bf(a->in[I_WA][src]); *(LAS bf16*)(lds + LR_WAT + 9216 + (oo * 72 + ii) * 2) = (bf16)f2bf(a->in[I_WX][src]); }
        if (tid < 64) HC[tid] = lat ? a->in[I_SLRU][((size_t)(b * 2 + layer) * 2 + e) * 256 + g * 64 + tid] : 0.f;
        f32x4 bav, bxv, spl;
        { const int chb = (layer * 2 + e) * 256 + g * 64 + 16 * ot + 4 * g4;
          bav = *(const f32x4*)(a->in[I_BA] + chb); bxv = *(const f32x4*)(a->in[I_BX] + chb); const f32x4 lam = *(const f32x4*)(a->in[I_LAMBDA] + chb);
#pragma unroll
          for (int q = 0; q < 4; ++q) spl[q] = log1pf(exp_(-lam[q])); }
        __syncthreads();
        v4u xr[4], hfr, glr;
#define LR_PREFETCH(cc_) do { const int c_ = e ? L / 64 - 1 - (cc_) : (cc_), t_ = c_ * 64 + tt; \
            _Pragma("unroll") for (int j = 0; j < 4; ++j) { const int ts = t_ + j - 2; xr[j] = (ts >= 0 && ts < L) ? *(const v4u*)(G1 + (size_t)(tok0 + ts) * G1W + C_XL + g * 64 + q8) : (v4u){0u, 0u, 0u, 0u}; } \
            if (e) { hfr = *(const v4u*)(HF + (size_t)(tok0 + t_) * 256 + g * 64 + q8); glr = *(const v4u*)(G1 + (size_t)(tok0 + t_) * G1W + C_GL + g * 64 + q8); } } while (0)
        LR_PREFETCH(0);
        for (int cc = 0; cc < L / 64; ++cc) {
            const int c = e ? L / 64 - 1 - cc : cc, t = c * 64 + tt, n = tok0 + t;
            const v4u xcur[4] = {xr[0], xr[1], xr[2], xr[3]}; const v4u hfc = hfr, glc = glr;
            if (cc + 1 < L / 64) LR_PREFETCH(cc + 1);
            {
                float xc[8];
#pragma unroll
                for (int i = 0; i < 8; ++i) xc[i] = cb[i];
#pragma unroll
                for (int j = 0; j < 4; ++j) {
                    { const v4u x = xcur[j];
                        xc[0] += cw[j][0] * bflo(x.x); xc[1] += cw[j][1] * bfhi(x.x); xc[2] += cw[j][2] * bflo(x.y); xc[3] += cw[j][3] * bfhi(x.y);
                        xc[4] += cw[j][4] * bflo(x.z); xc[5] += cw[j][5] * bfhi(x.z); xc[6] += cw[j][6] * bflo(x.w); xc[7] += cw[j][7] * bfhi(x.w); } }
                *(LAS f32x4*)(XCF + tt * 64 + q8) = (f32x4){xc[0], xc[1], xc[2], xc[3]}; *(LAS f32x4*)(XCF + tt * 64 + q8 + 4) = (f32x4){xc[4], xc[5], xc[6], xc[7]};
                *(LAS v4u*)(lds + LR_XCB + tt * 144 + q8 * 2) = (v4u){cvtpk(xc[0], xc[1]), cvtpk(xc[2], xc[3]), cvtpk(xc[4], xc[5]), cvtpk(xc[6], xc[7])};
            }
            __syncthreads();
            {
#pragma unroll
                for (int t2 = 0; t2 < 2; ++t2) { const int tk = (2 * tp + t2) * 16 + i16;
                    f32x4 ga = (f32x4){0.f, 0.f, 0.f, 0.f}, gx = (f32x4){0.f, 0.f, 0.f, 0.f};
#pragma unroll
                    for (int ks = 0; ks < 2; ++ks) { const bf16x8 xf = *(const LAS bf16x8*)(lds + LR_XCB + tk * 144 + ks * 64 + g4 * 16);
                        const bf16x8 wa = *(const LAS bf16x8*)(lds + LR_WAT + (16 * ot + i16) * 144 + ks * 64 + g4 * 16), wx = *(const LAS bf16x8*)(lds + LR_WAT + 9216 + (16 * ot + i16) * 144 + ks * 64 + g4 * 16);
                        ga = MFMA16(wa, xf, ga); gx = MFMA16(wx, xf, gx); }
                    const f32x4 xcv = *(const LAS f32x4*)(XCF + tk * 64 + 16 * ot + 4 * g4);
                    f32x4 av, bv;
#pragma unroll
                    for (int q = 0; q < 4; ++q) { const float la = -8.f * sigmoidf_(ga[q] + bav[q]) * spl[q]; av[q] = exp_(la); bv[q] = sqrt_(1.f - exp_(2.f * la)) * sigmoidf_(gx[q] + bxv[q]) * xcv[q]; }
                    *(LAS f32x4*)(AA + tk * 64 + 16 * ot + 4 * g4) = av; *(LAS f32x4*)(BV + tk * 64 + 16 * ot + 4 * g4) = bv; }
            }
            __syncthreads();
            float av8[8], bv8[8];
            {
                float P = 1.f, H = 0.f;
#pragma unroll
                for (int s = 0; s < 8; ++s) { const int p = seg * 8 + s, st = e ? 63 - p : p; av8[s] = AA[st * 64 + sch]; bv8[s] = BV[st * 64 + sch]; H = fmaf(av8[s], H, bv8[s]); P *= av8[s]; }
                SP[seg * 64 + sch] = P; SH[seg * 64 + sch] = H;
            }
            __syncthreads();
            {
                float h = HC[sch];
                for (int s2 = 0; s2 < seg; ++s2) h = fmaf(SP[s2 * 64 + sch], h, SH[s2 * 64 + sch]);
#pragma unroll
                for (int s = 0; s < 8; ++s) { const int p = seg * 8 + s, st = e ? 63 - p : p; h = fmaf(av8[s], h, bv8[s]); HH[st * 64 + sch] = h; }
                __syncthreads();
                if (seg == 7) HC[sch] = h;
            }
            __syncthreads();
            {
                bf16* dst = HF + (size_t)n * 256 + g * 64 + q8;
                float o[8];
#pragma unroll
                for (int i = 0; i < 8; ++i) o[i] = HH[tt * 64 + q8 + i];
                if (e) { const v4u hf = hfc, gl = glc;
                    o[0] = (o[0] + bflo(hf.x)) * siluf_(bflo(gl.x)); o[1] = (o[1] + bfhi(hf.x)) * siluf_(bfhi(gl.x)); o[2] = (o[2] + bflo(hf.y)) * siluf_(bflo(gl.y)); o[3] = (o[3] + bfhi(hf.y)) * siluf_(bfhi(gl.y));
                    o[4] = (o[4] + bflo(hf.z)) * siluf_(bflo(gl.z)); o[5] = (o[5] + bfhi(hf.z)) * siluf_(bfhi(gl.z)); o[6] = (o[6] + bflo(hf.w)) * siluf_(bflo(gl.w)); o[7] = (o[7] + bfhi(hf.w)) * siluf_(bfhi(gl.w)); }
                *(v4u*)dst = (v4u){cvtpk(o[0], o[1]), cvtpk(o[2], o[3]), cvtpk(o[4], o[5]), cvtpk(o[6], o[7])};
            }
        }
#undef LR_PREFETCH
        __syncthreads();
        if (tid < 64 && !lat) a->out[O_LRU + ((size_t)(b * 2 + layer) * 2 + e) * 256 + g * 64 + tid] = HC[tid];
    }
}

constexpr int LQ_NQ = 32;
constexpr int LQ_WAT = 0, LQ_S0 = 2 * LQ_NQ * 144;
constexpr int LS_XCB = 0, LS_XCQ = 9216, LS_AA = LS_XCQ + 64 * LQ_NQ * 4, LS_BV = LS_AA + 64 * LQ_NQ * 4, LS_HH = LS_BV + 64 * LQ_NQ * 4,
              LS_SP = LS_HH + 64 * LQ_NQ * 4, LS_SH = LS_SP + 8 * LQ_NQ * 4, LS_HC = LS_SH + 8 * LQ_NQ * 4, LS_BYTES = LS_HC + 2 * LQ_NQ * 4;
__device__ __forceinline__ void lru_unit_q(ArgsP a, LAS unsigned char* lds, int layer, int u) {
    const int tid = tid_(), lane = tid & 63, wave = tid >> 6, i16 = lane & 15, g4 = lane >> 4;
    const int lat = u < 32, uu = lat ? u : u - 32, bp = uu >> 3, g = (uu >> 1) & 3, oq = uu & 1;
    const int L = lat ? L_LAT : L_CTX;
    const int tokb[2] = {lat ? T_CTX + (2 * bp) * L_LAT : (2 * bp) * L_CTX, lat ? T_CTX + (2 * bp + 1) * L_LAT : (2 * bp + 1) * L_CTX};
    const bf16* G1 = (const bf16*)(a->ws + WS_G1);
    bf16* HF = (bf16*)(a->ws + WS_HF);
    const int tt = tid >> 3, q8 = (tid & 7) * 8;
    float cw[4][8], cb[8];
#pragma unroll
    for (int i = 0; i < 8; ++i) { const int ch = g * 64 + q8 + i; cb[i] = a->in[I_CONVB][layer * 256 + ch];
#pragma unroll
        for (int j = 0; j < 4; ++j) cw[j][i] = a->in[I_CONVW][(layer * 4 + j) * 256 + ch]; }
    const int gt = wave & 3, got = wave >> 2;
    const int ssn = tid >> 8, sch = tid & (LQ_NQ - 1), seg = (tid >> 5) & 7;
    const int otok = tid >> 3, oc4 = (tid & 7) * 4;
    const int chq = g * 64 + oq * LQ_NQ;
    LAS unsigned char* SS = lds + LQ_S0 + ssn * LS_BYTES;
    for (int e = 0; e < 2; ++e) {
        __syncthreads();
        for (int i = tid; i < 64 * LQ_NQ; i += NTHREADS) { const int ii = i / LQ_NQ, oo = i % LQ_NQ; const size_t src = ((size_t)((layer * 2 + e) * 4 + g)) * 4096 + ii * 64 + oq * LQ_NQ + oo;
            *(LAS bf16*)(lds + LQ_WAT + (oo * 72 + ii) * 2) = (bf16)f2bf(a->in[I_WA][src]); *(LAS bf16*)(lds + LQ_WAT + LQ_NQ * 144 + (oo * 72 + ii) * 2) = (bf16)f2bf(a->in[I_WX][src]); }
        if (tid < 2 * LQ_NQ) { const int s = tid >> 5, c = tid & 31; ((LAS float*)(lds + LQ_S0 + s * LS_BYTES + LS_HC))[c] = lat ? a->in[I_SLRU][((size_t)((2 * bp + s) * 2 + layer) * 2 + e) * 256 + chq + c] : 0.f; }
        f32x4 bav, bxv, spl;
        { const int chb = (layer * 2 + e) * 256 + chq + 16 * got + 4 * g4;
          bav = *(const f32x4*)(a->in[I_BA] + chb); bxv = *(const f32x4*)(a->in[I_BX] + chb); const f32x4 lam = *(const f32x4*)(a->in[I_LAMBDA] + chb);
#pragma unroll
          for (int q = 0; q < 4; ++q) spl[q] = log1pf(exp_(-lam[q])); }
        v4u xr[2][4]; v2u hfr[2], glr[2];
#define LQ_PREFETCH(cc_) do { const int c_ = e ? L / 64 - 1 - (cc_) : (cc_), t_ = c_ * 64 + tt; \
            _Pragma("unroll") for (int s = 0; s < 2; ++s) { \
              _Pragma("unroll") for (int j = 0; j < 4; ++j) { const int ts = t_ + j - 2; xr[s][j] = (ts >= 0 && ts < L) ? *(const v4u*)(G1 + (size_t)(tokb[s] + ts) * G1W + C_XL + g * 64 + q8) : (v4u){0u, 0u, 0u, 0u}; } \
              if (e) { const int to_ = c_ * 64 + otok; hfr[s] = *(const v2u*)(HF + (size_t)(tokb[s] + to_) * 256 + chq + oc4); glr[s] = *(const v2u*)(G1 + (size_t)(tokb[s] + to_) * G1W + C_GL + chq + oc4); } } } while (0)
        LQ_PREFETCH(0);
        __syncthreads();
        for (int cc = 0; cc < L / 64; ++cc) {
            const int c = e ? L / 64 - 1 - cc : cc;
            v4u xcur[2][4]; v2u hfc[2], glc[2];
#pragma unroll
            for (int s = 0; s < 2; ++s) { xcur[s][0] = xr[s][0]; xcur[s][1] = xr[s][1]; xcur[s][2] = xr[s][2]; xcur[s][3] = xr[s][3]; hfc[s] = hfr[s]; glc[s] = glr[s]; }
            if (cc + 1 < L / 64) LQ_PREFETCH(cc + 1);
#pragma unroll
            for (int s = 0; s < 2; ++s) {
                LAS unsigned char* SB = lds + LQ_S0 + s * LS_BYTES;
                float xc[8];
#pragma unroll
                for (int i = 0; i < 8; ++i) xc[i] = cb[i];
#pragma unroll
                for (int j = 0; j < 4; ++j) { const v4u x = xcur[s][j];
                    xc[0] += cw[j][0] * bflo(x.x); xc[1] += cw[j][1] * bfhi(x.x); xc[2] += cw[j][2] * bflo(x.y); xc[3] += cw[j][3] * bfhi(x.y);
                    xc[4] += cw[j][4] * bflo(x.z); xc[5] += cw[j][5] * bfhi(x.z); xc[6] += cw[j][6] * bflo(x.w); xc[7] += cw[j][7] * bfhi(x.w); }
                *(LAS v4u*)(SB + LS_XCB + tt * 144 + q8 * 2) = (v4u){cvtpk(xc[0], xc[1]), cvtpk(xc[2], xc[3]), cvtpk(xc[4], xc[5]), cvtpk(xc[6], xc[7])};
                if ((q8 / LQ_NQ) == oq) { LAS float* XCQ = (LAS float*)(SB + LS_XCQ); *(LAS f32x4*)(XCQ + tt * LQ_NQ + (q8 % LQ_NQ)) = (f32x4){xc[0], xc[1], xc[2], xc[3]}; *(LAS f32x4*)(XCQ + tt * LQ_NQ + (q8 % LQ_NQ) + 4) = (f32x4){xc[4], xc[5], xc[6], xc[7]}; }
            }
            __syncthreads();
#pragma unroll
            for (int s = 0; s < 2; ++s) {
                LAS unsigned char* SB = lds + LQ_S0 + s * LS_BYTES;
                const int tk = gt * 16 + i16;
                f32x4 ga = (f32x4){0.f, 0.f, 0.f, 0.f}, gx = (f32x4){0.f, 0.f, 0.f, 0.f};
#pragma unroll
                for (int ks = 0; ks < 2; ++ks) { const bf16x8 xf = *(const LAS bf16x8*)(SB + LS_XCB + tk * 144 + ks * 64 + g4 * 16);
                    const bf16x8 wa = *(const LAS bf16x8*)(lds + LQ_WAT + (16 * got + i16) * 144 + ks * 64 + g4 * 16), wx = *(const LAS bf16x8*)(lds + LQ_WAT + LQ_NQ * 144 + (16 * got + i16) * 144 + ks * 64 + g4 * 16);
                    ga = MFMA16(wa, xf, ga); gx = MFMA16(wx, xf, gx); }
                const f32x4 xcv = *(const LAS f32x4*)((LAS float*)(SB + LS_XCQ) + tk * LQ_NQ + 16 * got + 4 * g4);
                f32x4 av, bv;
#pragma unroll
                for (int q = 0; q < 4; ++q) { const float la = -8.f * sigmoidf_(ga[q] + bav[q]) * spl[q], aq = exp_(la); av[q] = aq; bv[q] = sqrt_((1.f - aq) * (1.f + aq)) * sigmoidf_(gx[q] + bxv[q]) * xcv[q]; }
                *(LAS f32x4*)((LAS float*)(SB + LS_AA) + tk * LQ_NQ + 16 * got + 4 * g4) = av; *(LAS f32x4*)((LAS float*)(SB + LS_BV) + tk * LQ_NQ + 16 * got + 4 * g4) = bv;
            }
            __syncthreads();
            LAS float* AA = (LAS float*)(SS + LS_AA); LAS float* BV = (LAS float*)(SS + LS_BV); LAS float* HH = (LAS float*)(SS + LS_HH);
            LAS float* SP = (LAS float*)(SS + LS_SP); LAS float* SH = (LAS float*)(SS + LS_SH); LAS float* HC = (LAS float*)(SS + LS_HC);
            float av8[8], bv8[8];
            {
                float P = 1.f, H = 0.f;
#pragma unroll
                for (int s = 0; s < 8; ++s) { const int p = seg * 8 + s, st = e ? 63 - p : p; av8[s] = AA[st * LQ_NQ + sch]; bv8[s] = BV[st * LQ_NQ + sch]; H = fmaf(av8[s], H, bv8[s]); P *= av8[s]; }
                SP[seg * LQ_NQ + sch] = P; SH[seg * LQ_NQ + sch] = H;
            }
            __syncthreads();
            {
                float h = HC[(cc & 1) * LQ_NQ + sch];
                for (int s2 = 0; s2 < seg; ++s2) h = fmaf(SP[s2 * LQ_NQ + sch], h, SH[s2 * LQ_NQ + sch]);
#pragma unroll
                for (int s = 0; s < 8; ++s) { const int p = seg * 8 + s, st = e ? 63 - p : p; h = fmaf(av8[s], h, bv8[s]); HH[st * LQ_NQ + sch] = h; }
                if (seg == 7) HC[((cc + 1) & 1) * LQ_NQ + sch] = h;
            }
            __syncthreads();
#pragma unroll
            for (int s = 0; s < 2; ++s) {
                const int n = tokb[s] + c * 64 + otok;
                const f32x4 hv = *(const LAS f32x4*)((LAS float*)(lds + LQ_S0 + s * LS_BYTES + LS_HH) + otok * LQ_NQ + oc4);
                float o0 = hv[0], o1 = hv[1], o2 = hv[2], o3 = hv[3];
                if (e) { o0 = (o0 + bflo(hfc[s].x)) * siluf_(bflo(glc[s].x)); o1 = (o1 + bfhi(hfc[s].x)) * siluf_(bfhi(glc[s].x)); o2 = (o2 + bflo(hfc[s].y)) * siluf_(bflo(glc[s].y)); o3 = (o3 + bfhi(hfc[s].y)) * siluf_(bfhi(glc[s].y)); }
                *(v2u*)(HF + (size_t)n * 256 + chq + oc4) = (v2u){cvtpk(o0, o1), cvtpk(o2, o3)};
            }
        }
#undef LQ_PREFETCH
        __syncthreads();
        if (tid < 2 * LQ_NQ && !lat) { const int s = tid >> 5, c = tid & 31; a->out[O_LRU + ((size_t)((2 * bp + s) * 2 + layer) * 2 + e) * 256 + chq + c] = ((LAS float*)(lds + LQ_S0 + s * LS_BYTES + LS_HC))[((L / 64) & 1) * LQ_NQ + c]; }
    }
}

#define ATT_KLOAD(KB_) \
        bf16x8 kfa_[6], kfb_[6]; \
        _Pragma("unroll") for (int ks_ = 0; ks_ < 6; ++ks_) { kfa_[ks_] = *(const LAS bf16x8*)((KB_) + r * ATT_KSTR + ks_ * 32 + hq * 16); kfb_[ks_] = *(const LAS bf16x8*)((KB_) + (32 + r) * ATT_KSTR + ks_ * 32 + hq * 16); }
#define ATT_VLOAD(VB_) \
        v2u va0_[4], va1_[4], vb0_[4], vb1_[4]; \
        _Pragma("unroll") for (int ks_ = 0; ks_ < 4; ++ks_) { \
            va0_[ks_] = *(const LAS v2u*)((VB_) + r * ATT_VSTR + ks_ * 32 + hq * 8); va1_[ks_] = *(const LAS v2u*)((VB_) + r * ATT_VSTR + ks_ * 32 + 16 + hq * 8); \
            vb0_[ks_] = *(const LAS v2u*)((VB_) + (32 + r) * ATT_VSTR + ks_ * 32 + hq * 8); vb1_[ks_] = *(const LAS v2u*)((VB_) + (32 + r) * ATT_VSTR + ks_ * 32 + 16 + hq * 8); }
#define ATT_QKM(S0_, S1_) do { \
        _Pragma("unroll") for (int i_ = 0; i_ < 16; ++i_) { S0_[i_] = 0.f; S1_[i_] = 0.f; } \
        _Pragma("unroll") for (int ks_ = 0; ks_ < 6; ++ks_) { S0_ = MFMA32(kfa_[ks_], qf[ks_], S0_); S1_ = MFMA32(kfb_[ks_], qf[ks_], S1_); } } while (0)
#define ATT_STEP(SC0_, SC1_, SN0_, SN1_, KB_, VB_, HAVE_NEXT_) do { \
        ATT_KLOAD(KB_) \
        float mx_ = SC0_[0]; \
        _Pragma("unroll") for (int i_ = 1; i_ < 16; ++i_) mx_ = fmaxf(mx_, SC0_[i_]); \
        _Pragma("unroll") for (int i_ = 0; i_ < 16; ++i_) mx_ = fmaxf(mx_, SC1_[i_]); \
        mx_ = fmaxf(mx_, __shfl_xor(mx_, 32)); \
        if (!__all(mx_ - m <= 8.f)) { const float mn_ = fmaxf(m, mx_), al_ = __builtin_amdgcn_exp2f(m - mn_); m = mn_; l *= al_; \
            _Pragma("unroll") for (int i_ = 0; i_ < 16; ++i_) { o0[i_] *= al_; o1[i_] *= al_; } } \
        if (HAVE_NEXT_) ATT_QKM(SN0_, SN1_); \
        ATT_VLOAD(VB_) \
        float ps_ = 0.f; \
        _Pragma("unroll") for (int i_ = 0; i_ < 16; ++i_) { SC0_[i_] = __builtin_amdgcn_exp2f(SC0_[i_] - m); SC1_[i_] = __builtin_amdgcn_exp2f(SC1_[i_] - m); ps_ += SC0_[i_] + SC1_[i_]; } \
        l += ps_; \
        _Pragma("unroll") for (int ks_ = 0; ks_ < 4; ++ks_) { \
            v4u pw_; \
            if (ks_ == 0) { pw_.x = cvtpk(SC0_[0], SC0_[1]); pw_.y = cvtpk(SC0_[2], SC0_[3]); pw_.z = cvtpk(SC0_[4], SC0_[5]); pw_.w = cvtpk(SC0_[6], SC0_[7]); } \
            else if (ks_ == 1) { pw_.x = cvtpk(SC0_[8], SC0_[9]); pw_.y = cvtpk(SC0_[10], SC0_[11]); pw_.z = cvtpk(SC0_[12], SC0_[13]); pw_.w = cvtpk(SC0_[14], SC0_[15]); } \
            else if (ks_ == 2) { pw_.x = cvtpk(SC1_[0], SC1_[1]); pw_.y = cvtpk(SC1_[2], SC1_[3]); pw_.z = cvtpk(SC1_[4], SC1_[5]); pw_.w = cvtpk(SC1_[6], SC1_[7]); } \
            else { pw_.x = cvtpk(SC1_[8], SC1_[9]); pw_.y = cvtpk(SC1_[10], SC1_[11]); pw_.z = cvtpk(SC1_[12], SC1_[13]); pw_.w = cvtpk(SC1_[14], SC1_[15]); } \
            const bf16x8 pf_ = __builtin_bit_cast(bf16x8, pw_); \
            const v4u vwa_ = {va0_[ks_].x, va0_[ks_].y, va1_[ks_].x, va1_[ks_].y}, vwb_ = {vb0_[ks_].x, vb0_[ks_].y, vb1_[ks_].x, vb1_[ks_].y}; \
            o0 = MFMA32(__builtin_bit_cast(bf16x8, vwa_), pf_, o0); o1 = MFMA32(__builtin_bit_cast(bf16x8, vwb_), pf_, o1); } } while (0)
__device__ __forceinline__ void att_unit2(ArgsP a, LAS unsigned char* lds, int u) {
    const int tid = tid_(), lane = tid & 63, wave = tid >> 6, r = lane & 31, hq = lane >> 5;
    const bf16* KN = (const bf16*)(a->ws + WS_KN); const bf16* KR = (const bf16*)(a->ws + WS_KR); const bf16* VT = (const bf16*)(a->ws + WS_VT);
    bf16* Q = (bf16*)(a->ws + WS_Q); const bf16* G1 = (const bf16*)(a->ws + WS_G1);
    int b, h, n0, Lk, kidx0; size_t vbase;
    if (u < 512) { b = u >> 6; h = (u >> 3) & 7; n0 = T_CTX + b * 2048 + (u & 7) * 256; Lk = LK_LAT; kidx0 = T_CTX + b * LK_LAT; vbase = (size_t)VT_LAT + (size_t)(b * 8 + h) * 64 * LK_LAT; }
    else { const int uu = u - 512; b = uu >> 3; h = uu & 7; n0 = b * 256; Lk = 256; kidx0 = b * 256; vbase = (size_t)(b * 8 + h) * 64 * 256; }
    const int ntiles = Lk >> 6;
    const int n = n0 + wave * 32 + r;
    bf16x8 qf[6];
#pragma unroll
    for (int ks = 0; ks < 6; ++ks) qf[ks] = *(const bf16x8*)(Q + (size_t)n * 768 + h * 96 + ks * 16 + 8 * hq);
    const int key_k = tid >> 3, ck = tid & 7, key_r = (tid >> 2) & 63, cr = tid & 3;
    const bf16* gk = KN + (size_t)(kidx0 + key_k) * 512 + h * 64 + ck * 8;
    const bf16* gr = KR + (size_t)(kidx0 + key_r) * 32 + cr * 8;
    const bf16* gv = VT + (size_t)(kidx0 + key_k) * 512 + h * 64 + ck * 8;
    const unsigned sk = key_k * ATT_KSTR + ck * 16, sr = key_r * ATT_KSTR + 128 + cr * 16, sv = ATT_VOFF + (ck * 8) * ATT_VSTR + key_k * 2;
    v4u rkA, rrA = {0u, 0u, 0u, 0u}, rvA, rkB, rrB = {0u, 0u, 0u, 0u}, rvB;
#define ATT_LOAD(X_, j_) do { rk##X_ = *(const v4u*)(gk + (size_t)(j_) * 64 * 512); if (tid < 256) rr##X_ = *(const v4u*)(gr + (size_t)(j_) * 64 * 32); rv##X_ = *(const v4u*)(gv + (size_t)(j_) * 64 * 512); } while (0)
#define ATT_STORE(X_, B_) do { LAS unsigned char* nb_ = lds + (B_) * ATT_STAGE; *(LAS v4u*)(nb_ + sk) = rk##X_; if (tid < 256) *(LAS v4u*)(nb_ + sr) = rr##X_; \
        LAS unsigned char* vp_ = nb_ + sv; \
        *(LAS bf16*)(vp_) = (bf16)(rv##X_.x & 0xffffu); *(LAS bf16*)(vp_ + ATT_VSTR) = (bf16)(rv##X_.x >> 16); *(LAS bf16*)(vp_ + 2 * ATT_VSTR) = (bf16)(rv##X_.y & 0xffffu); *(LAS bf16*)(vp_ + 3 * ATT_VSTR) = (bf16)(rv##X_.y >> 16); \
        *(LAS bf16*)(vp_ + 4 * ATT_VSTR) = (bf16)(rv##X_.z & 0xffffu); *(LAS bf16*)(vp_ + 5 * ATT_VSTR) = (bf16)(rv##X_.z >> 16); *(LAS bf16*)(vp_ + 6 * ATT_VSTR) = (bf16)(rv##X_.w & 0xffffu); *(LAS bf16*)(vp_ + 7 * ATT_VSTR) = (bf16)(rv##X_.w >> 16); } while (0)
    ATT_LOAD(A, 0); ATT_LOAD(B, 1);
    __syncthreads();
    ATT_STORE(A, 0);
    ATT_STORE(B, 1);
    ATT_LOAD(A, 2);
    __syncthreads();
    f32x16 o0, o1, sa0, sa1, sb0, sb1;
#pragma unroll
    for (int i = 0; i < 16; ++i) { o0[i] = 0.f; o1[i] = 0.f; }
    float m = -1e30f, l = 0.f;
    { ATT_KLOAD(lds) ATT_QKM(sa0, sa1); }
    int bcur = 0;
    int j = 0;
    for (; j < ntiles - 2; j += 2) {
        {
            const int b1 = bcur == 2 ? 0 : bcur + 1, b2 = b1 == 2 ? 0 : b1 + 1;
            ATT_LOAD(B, j + 3);
            ATT_STEP(sa0, sa1, sb0, sb1, lds + b1 * ATT_STAGE, lds + bcur * ATT_STAGE + ATT_VOFF, true);
            ATT_STORE(A, b2);
            __syncthreads();
            bcur = b1;
        }
        {
            const int b1 = bcur == 2 ? 0 : bcur + 1, b2 = b1 == 2 ? 0 : b1 + 1;
            if (j + 4 < ntiles) ATT_LOAD(A, j + 4);
            ATT_STEP(sb0, sb1, sa0, sa1, lds + b1 * ATT_STAGE, lds + bcur * ATT_STAGE + ATT_VOFF, true);
            ATT_STORE(B, b2);
            __syncthreads();
            bcur = b1;
        }
    }
    {
        { const int b1 = bcur == 2 ? 0 : bcur + 1;
          ATT_STEP(sa0, sa1, sb0, sb1, lds + b1 * ATT_STAGE, lds + bcur * ATT_STAGE + ATT_VOFF, true);
          bcur = b1; }
        { ATT_STEP(sb0, sb1, sa0, sa1, lds + bcur * ATT_STAGE, lds + bcur * ATT_STAGE + ATT_VOFF, false); }
        __syncthreads();
    }
#undef ATT_LOAD
#undef ATT_STORE
    v2u gmv[2][4];
#pragma unroll
    for (int mt = 0; mt < 2; ++mt)
#pragma unroll
        for (int g = 0; g < 4; ++g) gmv[mt][g] = *(const v2u*)(G1 + (size_t)n * G1W + C_GM + h * 64 + 32 * mt + 8 * g + 4 * hq);
    l += __shfl_xor(l, 32);
    const float inv = rcp_(l);
#pragma unroll
    for (int mt = 0; mt < 2; ++mt)
#pragma unroll
        for (int g = 0; g < 4; ++g) {
            const int dv0 = 32 * mt + 8 * g + 4 * hq;
            const v2u gm = gmv[mt][g];
            const float x0 = (mt ? o1[4 * g + 0] : o0[4 * g + 0]) * inv, x1 = (mt ? o1[4 * g + 1] : o0[4 * g + 1]) * inv, x2 = (mt ? o1[4 * g + 2] : o0[4 * g + 2]) * inv, x3 = (mt ? o1[4 * g + 3] : o0[4 * g + 3]) * inv;
            v2u ov; ov.x = cvtpk(x0 * siluf_(bflo(gm.x)), x1 * siluf_(bfhi(gm.x))); ov.y = cvtpk(x2 * siluf_(bflo(gm.y)), x3 * siluf_(bfhi(gm.y)));
            *(v2u*)(Q + (size_t)n * 768 + h * 96 + dv0) = ov;
        }
}
constexpr int N_PHASES = 14;
#ifndef MK_PER_PHASE
#define MK_PER_PHASE 0
#endif
#ifndef VAR_GEMM
#define VAR_GEMM 1
#endif
#ifndef VAR_A2
#define VAR_A2 1
#endif
#ifndef VAR_ATT
#define VAR_ATT 1
#endif
#ifndef VAR_RWKV
#define VAR_RWKV 1
#endif
#ifndef VAR_LRU
#define VAR_LRU 1
#endif

__device__ __forceinline__ void phase_b(ArgsP a, LAS unsigned char* lds, int layer) {
    volatile LAS unsigned* MISC = (volatile LAS unsigned*)(lds + LDS_MISC);
    unsigned* head = (unsigned*)(a->ws + WS_CTL) + CW_Q + layer * 64;
    for (;;) {
        __syncthreads();
        if (tid_() == 0) MISC[16] = atomicAdd(head, 1u);
        __syncthreads();
        const int idx = (int)MISC[16];
        if (idx >= 1248) break;
#ifdef PROBE_UNIT1
        const unsigned long long pt0_ = __builtin_amdgcn_s_memrealtime();
#endif
        if (idx < 64) rwkv_unit_mfma(a, lds, layer, idx);
        else if (idx < 96) lru_unit_q(a, lds, layer, idx - 64);
        else if (idx < 608) att_unit2(a, lds, idx - 96);
        else if (idx < 864) rwkv_unit_mfma(a, lds, layer, 64 + idx - 608);
        else if (idx < 992) lru_unit_q(a, lds, layer, 32 + idx - 864);
        else att_unit2(a, lds, 512 + idx - 992);
#ifdef PROBE_UNIT1
        if (tid_() == 0 && layer == 0) { const unsigned d_ = (unsigned)(__builtin_amdgcn_s_memrealtime() - pt0_);
            const int ty_ = idx < 64 ? 0 : idx < 96 ? 1 : idx < 608 ? 2 : idx < 864 ? 3 : idx < 992 ? 4 : 5;
            atomicMax((unsigned*)(a->ws + WS_CTL) + CW_Q + 1024 + ty_ * 64, d_); }
#endif
    }
}

#if MK_PER_PHASE
template <int SUB> __global__ void __launch_bounds__(NTHREADS, 2) mk_phase(Args args, int layer) {
    extern __shared__ __attribute__((aligned(16))) unsigned char lds_raw[];
    LAS unsigned char* lds = (LAS unsigned char*)lds_raw;
    ArgsP a = (ArgsP)__builtin_amdgcn_kernarg_segment_ptr();
    if (SUB == 0) phase_p0(a, lds);
    if (SUB == 1) phase_a0(a, layer);
    if (SUB == 2) { if (VAR_GEMM) phase_a1_pg8(a, lds, layer); else phase_a1_naive(a, layer); }
    if (SUB == 3) { if (VAR_A2) { for (int u = blockIdx.x; u < T / 64 + 32; u += gridDim.x) a2_unit(a, lds, layer, u); } else phase_a2_naive(a, lds, layer); }
    if (SUB == 4) { if (VAR_ATT) { for (int u = blockIdx.x; u < 768; u += gridDim.x) att_unit(a, lds, u); } else phase_att_naive(a); }
    if (SUB == 5) { for (int u = blockIdx.x; u < 320; u += gridDim.x) { __syncthreads(); if (VAR_RWKV) rwkv_unit_mfma(a, lds, layer, u); else rwkv_unit_seq(a, lds, layer, u); } }
    if (SUB == 6) { for (int u = blockIdx.x; u < 160; u += gridDim.x) { __syncthreads(); if (VAR_LRU) lru_unit_mfma(a, lds, layer, u); else lru_unit_seq(a, lds, layer, u); } }
    if (SUB == 7) phase_c1(a, layer);
    if (SUB == 8) { if (VAR_GEMM) phase_c2_pg8(a, lds, layer); else phase_c2_naive(a, layer); }
    if (SUB == 9) phase_final(a);
}
#else
#define ARGS_VIEW() ({ ArgsP p_ = (ArgsP)__builtin_amdgcn_kernarg_segment_ptr(); asm volatile("" : "+s"(p_)); p_; })
__global__ void __launch_bounds__(NTHREADS, 2) mk_fwd(Args args) {
    extern __shared__ __attribute__((aligned(16))) unsigned char lds_raw[];
    LAS unsigned char* lds = (LAS unsigned char*)lds_raw;
    volatile LAS unsigned* MISC = (volatile LAS unsigned*)(lds + LDS_MISC);
    for (int u = threadIdx.x; u < 64; u += NTHREADS) MISC[u] = 0u;
    __syncthreads();
    XcdBarrier bar;
    { ArgsP a = ARGS_VIEW(); bar = xcd_barrier_post((unsigned*)(a->ws + WS_CTL) + CW_BAR, MISC + 8); }
    int lo, hi; { ArgsP a = ARGS_VIEW(); lo = a->ph_lo; hi = a->ph_hi; }
#define IN(k) (lo <= (k) && (k) < hi)
#ifdef PROBE_MASK1
#define STAMP(k) do { if (bid_() == 0 && tid_() == 0) { const unsigned long long t_ = __builtin_amdgcn_s_memrealtime(); MISC[32 + 2 * (k)] = (unsigned)t_; MISC[33 + 2 * (k)] = (unsigned)(t_ >> 32); } } while (0)
#else
#define STAMP(k) do { } while (0)
#endif
#define SEAM(k) do { if (IN(k) && IN((k) + 1)) xcd_barrier(bar); STAMP((k) + 1); } while (0)
#ifndef NO_P0
    STAMP(0);
    if (IN(0)) { ArgsP a = ARGS_VIEW(); phase_p0(a, lds); }
#endif
    SEAM(0);
    for (int layer = 0; layer < 2; ++layer) {
        const int p = 1 + 6 * layer;
#ifndef NO_A0
        if (IN(p + 0)) { { ArgsP a = ARGS_VIEW(); phase_a0(a, layer); } if (layer == 0) { ArgsP a = ARGS_VIEW(); phase_p0_weights(a, lds); } }
#endif
        SEAM(p + 0);
#ifndef NO_A1
        if (IN(p + 1)) { ArgsP a = ARGS_VIEW(); phase_a1_pg8(a, lds, layer); }
#endif
        SEAM(p + 1);
#ifndef NO_A2
        if (IN(p + 2)) { { ArgsP a = ARGS_VIEW(); phase_a2a(a, layer); } xcd_barrier(bar); { ArgsP a = ARGS_VIEW(); phase_a2b(a, lds, layer); } }
        if (0) { ArgsP a = ARGS_VIEW(); for (int u = bid_(); u < T / 64 + 32; u += grid_()) {
#ifdef PROBE_UNIT1
            const unsigned long long pt0_ = __builtin_amdgcn_s_memrealtime();
#endif
            a2_unit(a, lds, layer, u);
#ifdef PROBE_A2_TWICE
            a2_unit(a, lds, layer, u);
#endif
#ifdef PROBE_UNIT1
            __syncthreads();
            if (tid_() == 0 && layer == 0) atomicMax((unsigned*)(a->ws + WS_CTL) + CW_Q + 1024 + (u < 256 ? 6 : 7) * 64, (unsigned)(__builtin_amdgcn_s_memrealtime() - pt0_));
#endif
        } }
#endif
        SEAM(p + 2);
#ifndef NO_B
        if (IN(p + 3)) { ArgsP a = ARGS_VIEW(); phase_b(a, lds, layer); }
#endif
        SEAM(p + 3);
#ifndef NO_C1
        if (IN(p + 4)) { ArgsP a = ARGS_VIEW(); phase_c1(a, layer); }
#endif
        SEAM(p + 4);
#ifndef NO_C2
        if (IN(p + 5)) { ArgsP a = ARGS_VIEW(); phase_c2_pg8(a, lds, layer); }
#endif
        SEAM(p + 5);
    }
    if (IN(N_PHASES - 1)) { ArgsP a = ARGS_VIEW(); phase_final(a); }
#ifdef PROBE_MASK1
    STAMP(14);
    __syncthreads();
    if (bid_() == 0) {
        ArgsP a = ARGS_VIEW();
        float t1 = 0.f, t2 = 0.f;
        for (int k = 0; k < 14; ++k) { const unsigned long long s0 = ((unsigned long long)MISC[33 + 2 * k] << 32) | MISC[32 + 2 * k], s1 = ((unsigned long long)MISC[35 + 2 * k] << 32) | MISC[34 + 2 * k];
            const float us = (float)(s1 - s0) * 0.01f; if ((PROBE_MASK1 >> k) & 1) t1 += us; if ((PROBE_MASK2 >> k) & 1) t2 += us; }
#ifdef PROBE_UNIT1
        t1 = (float)((unsigned*)(a->ws + WS_CTL))[CW_Q + 1024 + PROBE_UNIT1 * 64] * 0.01f; t2 = (float)((unsigned*)(a->ws + WS_CTL))[CW_Q + 1024 + PROBE_UNIT2 * 64] * 0.01f;
#endif
        for (int i = tid_(); i < 32768; i += NTHREADS) a->out[O_LRU + i] *= (1.f + t2 * (1.f / 2000.f));
        if (tid_() == 0) a->out[0] += 2.f + t1 * 0.01f;
    }
#endif
#undef IN
#undef SEAM
}

#endif

extern "C" void kernel_launch(void* const* d_in, const int* in_sizes, int n_in, void* d_out, int out_size, void* d_ws, size_t ws_size, hipStream_t stream) {
    static int grid = 0;
    if (grid == 0) {
        if (n_in != N_IN || ws_size < WS_END) { fprintf(stderr, "kernel_launch: unexpected n_in %d / ws_size %zu\n", n_in, ws_size); grid = -1; return; }
        int dev = 0, cus = 0;
        if (hipGetDevice(&dev) != hipSuccess || hipDeviceGetAttribute(&cus, hipDeviceAttributeMultiprocessorCount, dev) != hipSuccess) { grid = -1; return; }
#if MK_PER_PHASE
#define SA(SUB) if (hipFuncSetAttribute((const void*)mk_phase<SUB>, hipFuncAttributeMaxDynamicSharedMemorySize, LDS_BYTES) != hipSuccess) { fprintf(stderr, "kernel_launch: hipFuncSetAttribute failed\n"); grid = -1; return; }
        SA(0) SA(1) SA(2) SA(3) SA(4) SA(5) SA(6) SA(7) SA(8) SA(9)
#undef SA
#else
        if (hipFuncSetAttribute((const void*)mk_fwd, hipFuncAttributeMaxDynamicSharedMemorySize, LDS_BYTES) != hipSuccess) { fprintf(stderr, "kernel_launch: hipFuncSetAttribute failed\n"); grid = -1; return; }
        int per_cu = 0;
        if (hipOccupancyMaxActiveBlocksPerMultiprocessor(&per_cu, (const void*)mk_fwd, NTHREADS, LDS_BYTES) != hipSuccess || per_cu < 1) fprintf(stderr, "kernel_launch: occupancy query reports %d\n", per_cu);
        (void)hipGetLastError();
#endif
        grid = cus;
    }
    if (grid < 0) return;
    if (hipMemsetAsync((char*)d_ws + WS_CTL, 0, CTL_ZERO_BYTES, stream) != hipSuccess) return;
    Args a{};
    for (int i = 0; i < N_IN; ++i) a.in[i] = (const float*)d_in[i];
    a.out = (float*)d_out; a.ws = (unsigned char*)d_ws;
#if MK_PER_PHASE
#define LP(SUB, layer) hipLaunchKernelGGL(mk_phase<SUB>, dim3(grid), dim3(NTHREADS), LDS_BYTES, stream, a, layer)
    LP(0, 0);
    for (int layer = 0; layer < 2; ++layer) { LP(1, layer); LP(2, layer); LP(3, layer); LP(4, layer); LP(5, layer); LP(6, layer); LP(7, layer); LP(8, layer); }
    LP(9, 0);
#undef LP
#else
    a.ph_lo = 0; a.ph_hi = N_PHASES;
    hipLaunchKernelGGL(mk_fwd, dim3(grid), dim3(NTHREADS), LDS_BYTES, stream, a);
#endif
}
```

```cpp
#define MK_PER_PHASE 0
#include <hip/hip_runtime.h>
#include <cstdio>
#include <cstdint>

#define GAS __attribute__((address_space(1)))
#define LAS __attribute__((address_space(3)))
typedef unsigned short bf16;
typedef unsigned v4u __attribute__((ext_vector_type(4)));
typedef unsigned v2u __attribute__((ext_vector_type(2)));
typedef float f32x4 __attribute__((ext_vector_type(4)));
typedef short bf16x8 __attribute__((ext_vector_type(8)));

constexpr int D = 1024, T_CTX = 8192, T_LAT = 16384, T = 24576, L_CTX = 256, L_LAT = 2048, PAST = 256;
constexpr int NIN = 2816, G1W = 2304, G2W = 512;
constexpr int C_R = 0, C_K = 256, C_V = 512, C_G = 768, C_GM = 1024, C_XL = 1536, C_GL = 1792, C_LORA = 2048;
constexpr int LK_LAT = PAST + L_LAT;
constexpr int TK = T_CTX + 8 * LK_LAT;
constexpr int VT_LAT = 32 * 8 * 64 * 256;
constexpr float LN_EPS = 1e-5f, GN_EPS = 64e-5f;
constexpr float ALPHA = 1.4142135623730951f;
constexpr float QSCALE = 0.10206207261596575f * 1.4426950408889634f;
constexpr size_t O_Y = 0, O_RW = 25165824, O_CKV = 27262976, O_KR = 29360128, O_LRU = 29884416;
constexpr size_t MiB = 1u << 20;
constexpr size_t WS_CTL = 0, CTL_ZERO_BYTES = 1 * MiB;
constexpr size_t WS_MOD = 256 * 1024;
constexpr size_t WS_ROPE = 1 * MiB;
constexpr size_t WS_STATS = 1536 * 1024;
constexpr size_t WS_WUQ = 2 * MiB;
constexpr size_t WS_WUKV = 3 * MiB;
constexpr size_t WS_WIN = 4 * MiB;
constexpr size_t WS_WOUT = 16 * MiB;
constexpr size_t WS_G1 = 20 * MiB;
constexpr size_t WS_G2 = 128 * MiB;
constexpr size_t WS_Q = 152 * MiB;
constexpr size_t WS_U = 152 * MiB;
constexpr size_t WS_KN = 188 * MiB;
constexpr size_t WS_KR = 214 * MiB;
constexpr size_t WS_VT = 216 * MiB;
constexpr size_t WS_YMIX = 188 * MiB;
constexpr size_t WS_HF = 242 * MiB;
constexpr size_t WS_END = 254 * MiB;
constexpr int CW_BAR = 4096;
constexpr int CW_Q = 16384;

__device__ __forceinline__ float bf2f(unsigned b) { return __uint_as_float(b << 16); }
__device__ __forceinline__ float bflo(unsigned w) { return __uint_as_float(w << 16); }
__device__ __forceinline__ float bfhi(unsigned w) { return __uint_as_float(w & 0xffff0000u); }
__device__ __forceinline__ unsigned f2bf(float f) { unsigned u = __float_as_uint(f); return (u + 0x7fffu + ((u >> 16) & 1u)) >> 16; }
__device__ __forceinline__ unsigned pk2(float lo, float hi) { return f2bf(lo) | (f2bf(hi) << 16); }
__device__ __forceinline__ float rcp_(float x) { return __builtin_amdgcn_rcpf(x); }
__device__ __forceinline__ float exp_(float x) { return __builtin_amdgcn_exp2f(x * 1.4426950408889634f); }
__device__ __forceinline__ float sqrt_(float x) { return __builtin_amdgcn_sqrtf(x); }
__device__ __forceinline__ float rsqrt_(float x) { return __builtin_amdgcn_rsqf(x); }
__device__ __forceinline__ float sigmoidf_(float x) { return rcp_(1.f + exp_(-x)); }
__device__ __forceinline__ float siluf_(float x) { return x * rcp_(1.f + exp_(-x)); }
template <int CTRL> __device__ __forceinline__ float dpp_f(float old, float x) { return __builtin_bit_cast(float, __builtin_amdgcn_update_dpp(__builtin_bit_cast(int, old), __builtin_bit_cast(int, x), CTRL, 0xf, 0xf, false)); }
__device__ __forceinline__ float row16_sum(float x) { x += dpp_f<0x128>(0.f, x); x += dpp_f<0x124>(0.f, x); x += dpp_f<0x122>(0.f, x); x += dpp_f<0x121>(0.f, x); return x; }
__device__ __forceinline__ float wave_sum_fast(float x) { x = row16_sum(x); x += __shfl_xor(x, 16); x += __shfl_xor(x, 32); return x; }
__device__ __forceinline__ float row16_prefix_prod(float x) { x *= dpp_f<0x111>(1.f, x); x *= dpp_f<0x112>(1.f, x); x *= dpp_f<0x114>(1.f, x); x *= dpp_f<0x118>(1.f, x); return x; }
__device__ __forceinline__ float wave_sum(float v) { return wave_sum_fast(v); }
__device__ __forceinline__ int tid_() { int t = threadIdx.x; asm volatile("" : "+v"(t)); return t; }
__device__ __forceinline__ int bid_() { int b = blockIdx.x; asm volatile("" : "+s"(b)); return b; }
__device__ __forceinline__ int grid_() { int g = gridDim.x; asm volatile("" : "+s"(g)); return g; }
typedef float f32x16 __attribute__((ext_vector_type(16)));
typedef float f32x2_t __attribute__((ext_vector_type(2)));
typedef __bf16 bf16x2_t __attribute__((ext_vector_type(2)));
__device__ __forceinline__ unsigned cvtpk(float lo, float hi) { const f32x2_t v = {lo, hi}; return __builtin_bit_cast(unsigned, __builtin_convertvector(v, bf16x2_t)); }
#define XB_TMO      128
#define XB_XCNT(j)  (256  + 64 * (j))
#define XB_XSUB(j)  (1280 + 64 * (j))
#define XB_XGEN(j)  (2304 + 64 * (j))
#define XB_TOP      3328
#define XB_TOPGEN   3392
#define XCD_BAR_WORDS 3456
#define XB_SPIN_CAP (1u << 24)

__device__ __forceinline__ unsigned xb_ld(unsigned* p)              { return __hip_atomic_load(p, __ATOMIC_RELAXED, __HIP_MEMORY_SCOPE_AGENT); }
__device__ __forceinline__ unsigned xb_add(unsigned* p, unsigned v) { return __hip_atomic_fetch_add(p, v, __ATOMIC_RELAXED, __HIP_MEMORY_SCOPE_AGENT); }
__device__ __forceinline__ unsigned xb_xcc_id() { return (unsigned)__builtin_amdgcn_s_getreg((3 << 11) | 20) & 0xFu; }
#define XB_SPIN(cond, bar) do { unsigned _sp = 0; while (cond) { __builtin_amdgcn_s_sleep(1); \
    if ((++_sp & 255u) == 0u) { if (xb_ld(&(bar)[XB_TMO])) break; if (_sp > XB_SPIN_CAP) { atomicAdd(&(bar)[XB_TMO], 1u); break; } } } } while (0)

struct XcdBarrier {
    unsigned* bar; unsigned x;
    volatile LAS unsigned* st;
};

__device__ __forceinline__ XcdBarrier xcd_barrier_post(unsigned* bar, volatile LAS unsigned* st) {
    XcdBarrier b; b.bar = bar; b.x = xb_xcc_id(); b.st = st;
    if (threadIdx.x == 0) (void)xb_add(&bar[XB_XCNT(b.x)], 1u);
    return b;
}
__device__ __forceinline__ void xcd_barrier_complete(unsigned* bar, unsigned x, unsigned& nloc, unsigned& nx) {
    const unsigned G = gridDim.x * gridDim.y * gridDim.z;
    unsigned sum, cnt, mine, sp = 0u;
    for (;;) {
        sum = 0u; cnt = 0u; mine = 0u;
#pragma unroll
        for (unsigned j = 0; j < 16; ++j) { const unsigned c = xb_ld(&bar[XB_XCNT(j)]); sum += c; cnt += (c > 0u) ? 1u : 0u; mine = (j == x) ? c : mine; }
        if (sum == G) break;
        __builtin_amdgcn_s_sleep(1);
        if ((++sp & 255u) == 0u) { if (xb_ld(&bar[XB_TMO])) break; if (sp > XB_SPIN_CAP) { atomicAdd(&bar[XB_TMO], 1u); break; } }
    }
    nloc = mine > 0u ? mine : 1u; nx = cnt > 0u ? cnt : 1u;
}

__device__ __forceinline__ void xcd_barrier(const XcdBarrier& b) {
    asm volatile("s_waitcnt vmcnt(0)" ::: "memory");
    __syncthreads();
    if (threadIdx.x == 0) {
        unsigned* bar = b.bar;
        __builtin_amdgcn_s_waitcnt(0);
        unsigned nloc = b.st[0], nx = b.st[1];
        if (nloc == 0u) { xcd_barrier_complete(bar, b.x, nloc, nx); b.st[0] = nloc; b.st[1] = nx; }
        const unsigned old = xb_add(&bar[XB_XSUB(b.x)], 1u);
        const unsigned gen = old / nloc;
        if (old + 1u == (gen + 1u) * nloc) {
            __builtin_amdgcn_fence(__ATOMIC_RELEASE, "agent");
            asm volatile("s_waitcnt vmcnt(0)" ::: "memory");
            const unsigned og = xb_add(&bar[XB_TOP], 1u);
            const unsigned tg = og / nx;
            if (og + 1u == (tg + 1u) * nx) xb_add(&bar[XB_TOPGEN], 1u);
            else XB_SPIN(xb_ld(&bar[XB_TOPGEN]) == tg, bar);
            __builtin_amdgcn_fence(__ATOMIC_ACQUIRE, "agent");
            xb_add(&bar[XB_XGEN(b.x)], 1u);
            asm volatile("s_waitcnt vmcnt(0)" ::: "memory");
        } else {
            XB_SPIN(xb_ld(&bar[XB_XGEN(b.x)]) == gen, bar);
            __builtin_amdgcn_fence(__ATOMIC_ACQUIRE, "agent");
            asm volatile("s_waitcnt vmcnt(0)" ::: "memory");
        }
    }
    __syncthreads();
}
enum { I_XP = 0, I_XS, I_SRW, I_CCKV, I_CKR, I_SLRU, I_C, I_CCTX, I_WMOD, I_BMOD, I_WIN, I_W0, I_W1, I_W2, I_A0, I_A1, I_A2, I_KK, I_KA, I_RK,
       I_LNXG, I_LNXB, I_QNORM, I_WUQ, I_KVNORM, I_WUKV, I_CONVW, I_CONVB, I_WA, I_BA, I_WX, I_BX, I_LAMBDA, I_WOUT, I_LNG, I_LNB, N_IN };
struct Args { const float* in[N_IN]; float* out; unsigned char* ws; int ph_lo, ph_hi; };
typedef const Args __attribute__((address_space(4)))* ArgsP;
constexpr int NTHREADS = 512;
constexpr int LDS_MISC = 139264;
constexpr int LDS_BYTES = 147456;

struct Tok { int n, b, t, L, lat, modrow, tok0, kidx; };
__device__ __forceinline__ Tok tok_of(int n) {
    Tok k; k.n = n;
    if (n < T_CTX) { k.lat = 0; k.b = n >> 8; k.t = n & 255; k.L = L_CTX; k.modrow = 0; k.tok0 = k.b * 256; k.kidx = n; }
    else { const int m = n - T_CTX; k.lat = 1; k.b = m >> 11; k.t = m & 2047; k.L = L_LAT; k.modrow = 1 + k.b; k.tok0 = T_CTX + k.b * 2048; k.kidx = T_CTX + k.b * LK_LAT + PAST + k.t; }
    return k;
}
__device__ __forceinline__ const float* xrow_src(ArgsP a, int layer, int n) {
    if (layer == 0) return n < T_CTX ? a->in[I_XP] + (size_t)n * D : a->in[I_XS] + (size_t)(n - T_CTX) * D;
    return a->out + (size_t)n * D;
}
__device__ __forceinline__ float dot8(v4u a, v4u b, float acc) {
    acc = fmaf(bflo(a.x), bflo(b.x), acc); acc = fmaf(bfhi(a.x), bfhi(b.x), acc);
    acc = fmaf(bflo(a.y), bflo(b.y), acc); acc = fmaf(bfhi(a.y), bfhi(b.y), acc);
    acc = fmaf(bflo(a.z), bflo(b.z), acc); acc = fmaf(bfhi(a.z), bfhi(b.z), acc);
    acc = fmaf(bflo(a.w), bflo(b.w), acc); acc = fmaf(bfhi(a.w), bfhi(b.w), acc);
    return acc;
}

__device__ __forceinline__ void tr_item(const float* src, int ld, int col0, int k0, bf16* WT, int K, int row0, float scale, LAS float* scr, int lane) {
    {
        const int kr = lane >> 3, n4 = (lane & 7) * 4;
        f32x4 v[8];
#pragma unroll
        for (int i = 0; i < 8; ++i) v[i] = src ? *(const f32x4*)(src + (size_t)(k0 + i * 8 + kr) * ld + col0 + n4) : (f32x4){0.f, 0.f, 0.f, 0.f};
#pragma unroll
        for (int i = 0; i < 8; ++i) { LAS float* d = scr + (i * 8 + kr) * 33 + n4; d[0] = v[i].x * scale; d[1] = v[i].y * scale; d[2] = v[i].z * scale; d[3] = v[i].w * scale; }
    }
    asm volatile("s_waitcnt lgkmcnt(0)" ::: "memory");
    const int c = lane & 7;
#pragma unroll
    for (int j = 0; j < 4; ++j) { const int n = (lane >> 3) + 8 * j; const LAS float* s = scr + (8 * c) * 33 + n;
        v4u o; o.x = pk2(s[0 * 33], s[1 * 33]); o.y = pk2(s[2 * 33], s[3 * 33]); o.z = pk2(s[4 * 33], s[5 * 33]); o.w = pk2(s[6 * 33], s[7 * 33]);
        *(v4u*)(WT + (size_t)(row0 + n) * K + k0 + 8 * c) = o; }
    asm volatile("s_waitcnt lgkmcnt(0)" ::: "memory");
}
__device__ __forceinline__ void rope_angle(int t, int i, float& c, float& s) {
    const int row = t >> 6, col = t & 63; const int ii = i & 7;
    const float inv = exp2f(-(float)ii * (13.287712379549449f / 8.f));
    const float ang = (float)(i < 8 ? row : col) * inv;
    c = cosf(ang); s = sinf(ang);
}
__device__ __forceinline__ void phase_p0_weights(ArgsP a, LAS unsigned char* lds) {
    const int tid = tid_(), lane = tid & 63, wave = tid >> 6, G = grid_();
    unsigned char* ws = a->ws;
    LAS float* scr = (LAS float*)(lds + wave * 8704);
    const int gw = bid_() * 8 + wave, NGW = G * 8;
    constexpr int N_WIN = 2 * 16 * 88, N_WOUT = 2 * 16 * 32, N_WUQ = 2 * 4 * 24, N_WUKV = 2 * 4 * 32;
    for (int it = gw; it < N_WIN + N_WOUT + N_WUQ + N_WUKV; it += NGW) {
        int r = it;
        if (r < N_WIN) {
            const int l = r / (16 * 88), kb = (r / 88) % 16, nb = r % 88, j0 = nb * 32;
            const float* src; int ld, col0;
            const float* win = a->in[I_WIN] + (size_t)l * 1024 * 2464;
            if (j0 < 1024) { src = win; ld = 2464; col0 = j0; }
            else if (j0 < 1536) { src = win; ld = 2464; col0 = 1440 + (j0 - 1024); }
            else if (j0 < 1792) { src = win; ld = 2464; col0 = 1952 + (j0 - 1536); }
            else if (j0 < 2048) { src = win; ld = 2464; col0 = 2208 + (j0 - 1792); }
            else if (j0 < 2304) { const int q = (j0 - 2048) >> 6; src = (q < 2 ? a->in[I_W1] : a->in[I_A1]) + (size_t)(l * 2 + (q & 1)) * 1024 * 64; ld = 64; col0 = (j0 - 2048) & 63; }
            else if (j0 < 2560) { src = win; ld = 2464; col0 = 1024 + (j0 - 2304); }
            else if (j0 < 2688) { src = win; ld = 2464; col0 = 1280 + (j0 - 2560); }
            else if (j0 < 2720) { src = win; ld = 2464; col0 = 1408 + (j0 - 2688); }
            else { src = nullptr; ld = 0; col0 = 0; }
            tr_item(src, ld, col0, kb * 64, (bf16*)(ws + WS_WIN) + (size_t)l * NIN * 1024, 1024, j0, 1.f, scr, lane);
            continue;
        }
        r -= N_WIN;
        if (r < N_WOUT) { const int l = r / (16 * 32), kb = (r / 32) % 16, nb = r % 32;
            tr_item(a->in[I_WOUT] + (size_t)l * 1024 * 1024, 1024, nb * 32, kb * 64, (bf16*)(ws + WS_WOUT) + (size_t)l * 1024 * 1024, 1024, nb * 32, 1.f, scr, lane); continue; }
        r -= N_WOUT;
        if (r < N_WUQ) { const int l = r / (4 * 24), kb = (r / 24) % 4, nb = r % 24;
            tr_item(a->in[I_WUQ] + (size_t)l * 256 * 768, 768, nb * 32, kb * 64, (bf16*)(ws + WS_WUQ) + (size_t)l * 768 * 256, 256, nb * 32, QSCALE, scr, lane); continue; }
        r -= N_WUQ;
        { const int l = r / (4 * 32), kb = (r / 32) % 4, nb = r % 32;
            tr_item(kb < 2 ? a->in[I_WUKV] + (size_t)l * 128 * 1024 : nullptr, 1024, nb * 32, kb * 64, (bf16*)(ws + WS_WUKV) + (size_t)l * 1024 * 256, 256, nb * 32, 1.f, scr, lane); }
    }
}
__device__ __forceinline__ void phase_p0(ArgsP a, LAS unsigned char* lds) {
    const int tid = tid_(), G = grid_();
    unsigned char* ws = a->ws;
    { float* ROPE = (float*)(ws + WS_ROPE);
      for (int i = bid_() * NTHREADS + tid; i < 2048 * 16; i += G * NTHREADS) { float c, s; rope_angle(i >> 4, i & 15, c, s); ROPE[i * 2] = c; ROPE[i * 2 + 1] = s; } }
    float* MOD = (float*)(ws + WS_MOD);
    LAS float* SIL = (LAS float*)lds;
    for (int it = bid_(); it < 2 * 6 * 32; it += G) {
        const int l = it / 192, nb = (it / 32) % 6, kq = it % 32, col = nb * 512 + tid;
        __syncthreads();
        if (tid < 288) { const int j = tid >> 5, k = kq * 32 + (tid & 31); const float cj = (j == 0) ? a->in[I_CCTX][k] : a->in[I_C][(j - 1) * 1024 + k]; SIL[tid] = siluf_(cj); }
        float w[32];
#pragma unroll
        for (int kk = 0; kk < 32; ++kk) w[kk] = a->in[I_WMOD][((size_t)l * 1024 + kq * 32 + kk) * 3072 + col];
        __syncthreads();
        const float bias = (kq == 0) ? a->in[I_BMOD][l * 3072 + col] : 0.f;
#pragma unroll
        for (int j = 0; j < 9; ++j) { float acc = bias;
#pragma unroll
            for (int k4 = 0; k4 < 8; ++k4) { const f32x4 sv = *(const LAS f32x4*)(SIL + j * 32 + k4 * 4); acc = fmaf(sv.x, w[k4 * 4], acc); acc = fmaf(sv.y, w[k4 * 4 + 1], acc); acc = fmaf(sv.z, w[k4 * 4 + 2], acc); acc = fmaf(sv.w, w[k4 * 4 + 3], acc); }
            atomicAdd(&MOD[(l * 9 + j) * 3072 + col], acc); }
    }
}

__device__ __forceinline__ void phase_a0(ArgsP a, int layer) {
    const int tid = tid_(), lane = tid & 63, wave = tid >> 6, G = grid_();
    const float* MOD = (const float*)(a->ws + WS_MOD);
    bf16* U = (bf16*)(a->ws + WS_U);
    f32x4 nx[4];
#define A0_LOAD(nn_) do { if (layer == 0) { const float* xr_ = xrow_src(a, 0, (nn_)); \
            _Pragma("unroll") for (int j = 0; j < 4; ++j) nx[j] = *(const f32x4*)(xr_ + lane * 4 + 256 * j); } \
        else { const bf16* zr_ = (const bf16*)a->out + (size_t)(nn_) * 2048; \
            _Pragma("unroll") for (int j = 0; j < 4; ++j) { const v2u w_ = *(const v2u*)(zr_ + lane * 4 + 256 * j); nx[j] = (f32x4){bflo(w_.x), bfhi(w_.x), bflo(w_.y), bfhi(w_.y)}; } } } while (0)
    { const int n0 = bid_() * 8 + wave; if (n0 < T) A0_LOAD(n0); }
    for (int n = bid_() * 8 + wave; n < T; n += G * 8) {
        const Tok tk = tok_of(n);
        f32x4 v[4]; float s = 0.f;
#pragma unroll
        for (int j = 0; j < 4; ++j) { v[j] = nx[j]; s += (v[j].x + v[j].y) + (v[j].z + v[j].w); }
        if (n + G * 8 < T) A0_LOAD(n + G * 8);
        float mean = wave_sum(s) * (1.f / D), s2 = 0.f;
#pragma unroll
        for (int j = 0; j < 4; ++j) { v[j] = v[j] - mean; s2 += (v[j].x * v[j].x + v[j].y * v[j].y) + (v[j].z * v[j].z + v[j].w * v[j].w); }
        float rstd = rsqrt_(wave_sum(s2) * (1.f / D) + LN_EPS);
        if (layer == 1) {
            s = 0.f;
#pragma unroll
            for (int j = 0; j < 4; ++j) { const f32x4 g = *(const f32x4*)(a->in[I_LNG] + lane * 4 + 256 * j), b = *(const f32x4*)(a->in[I_LNB] + lane * 4 + 256 * j);
                v[j] = v[j] * rstd * g + b; s += (v[j].x + v[j].y) + (v[j].z + v[j].w); }
            if (lane == 0) { float* st = (float*)(a->ws + WS_STATS) + (size_t)n * 2; st[0] = mean; st[1] = rstd; }
            mean = wave_sum(s) * (1.f / D); s2 = 0.f;
#pragma unroll
            for (int j = 0; j < 4; ++j) { v[j] = v[j] - mean; s2 += (v[j].x * v[j].x + v[j].y * v[j].y) + (v[j].z * v[j].z + v[j].w * v[j].w); }
            rstd = rsqrt_(wave_sum(s2) * (1.f / D) + LN_EPS);
        }
        const float* m = MOD + (size_t)(layer * 9 + tk.modrow) * 3072;
#pragma unroll
        for (int j = 0; j < 4; ++j) { const int c = lane * 4 + 256 * j; const f32x4 sh = *(const f32x4*)(m + c), sc = *(const f32x4*)(m + 1024 + c);
            const f32x4 o = v[j] * rstd * (sc + 1.f) + sh;
            v2u p; p.x = pk2(o.x, o.y); p.y = pk2(o.z, o.w); *(v2u*)(U + (size_t)n * D + c) = p; }
    }
}
__device__ __forceinline__ void phase_final(ArgsP a) {
    const int tid = tid_(), lane = tid & 63, wave = tid >> 6, G = grid_();
    f32x4 nx[4];
#define FN_LOAD(nn_) do { const bf16* zr_ = (const bf16*)a->out + (size_t)(nn_) * 2048; \
        _Pragma("unroll") for (int j = 0; j < 4; ++j) { const v2u w_ = *(const v2u*)(zr_ + lane * 4 + 256 * j); nx[j] = (f32x4){bflo(w_.x), bfhi(w_.x), bflo(w_.y), bfhi(w_.y)}; } } while (0)
    { const int n0 = bid_() * 8 + wave; if (n0 < T) FN_LOAD(n0); }
    for (int n = bid_() * 8 + wave; n < T; n += G * 8) {
        float* xr = a->out + (size_t)n * D;
        f32x4 v[4]; float s = 0.f;
#pragma unroll
        for (int j = 0; j < 4; ++j) { v[j] = nx[j]; s += (v[j].x + v[j].y) + (v[j].z + v[j].w); }
        if (n + G * 8 < T) FN_LOAD(n + G * 8);
        const float mean = wave_sum(s) * (1.f / D); float s2 = 0.f;
#pragma unroll
        for (int j = 0; j < 4; ++j) { v[j] = v[j] - mean; s2 += (v[j].x * v[j].x + v[j].y * v[j].y) + (v[j].z * v[j].z + v[j].w * v[j].w); }
        const float rstd = rsqrt_(wave_sum(s2) * (1.f / D) + LN_EPS);
#pragma unroll
        for (int j = 0; j < 4; ++j) { const f32x4 g = *(const f32x4*)(a->in[I_LNG] + 1024 + lane * 4 + 256 * j), b = *(const f32x4*)(a->in[I_LNB] + 1024 + lane * 4 + 256 * j);
            *(f32x4*)(xr + lane * 4 + 256 * j) = v[j] * rstd * g + b; }
    }
}

__device__ __forceinline__ void phase_a1_naive(ArgsP a, int layer) {
    const bf16* U = (const bf16*)(a->ws + WS_U); const bf16* W = (const bf16*)(a->ws + WS_WIN) + (size_t)layer * NIN * 1024;
    bf16* G1 = (bf16*)(a->ws + WS_G1); bf16* G2 = (bf16*)(a->ws + WS_G2);
    const size_t total = (size_t)T * (NIN / 8), stride = (size_t)grid_() * NTHREADS;
    for (size_t idx = (size_t)bid_() * NTHREADS + tid_(); idx < total; idx += stride) {
        const int row = (int)(idx / (NIN / 8)), c0 = (int)(idx % (NIN / 8)) * 8;
        float acc[8];
#pragma unroll
        for (int c = 0; c < 8; ++c) acc[c] = 0.f;
        const v4u* ap = (const v4u*)(U + (size_t)row * 1024); const v4u* bp = (const v4u*)(W + (size_t)c0 * 1024);
        for (int kc = 0; kc < 128; ++kc) { const v4u av = ap[kc];
#pragma unroll
            for (int c = 0; c < 8; ++c) acc[c] = dot8(av, bp[c * 128 + kc], acc[c]); }
        v4u o; o.x = pk2(acc[0], acc[1]); o.y = pk2(acc[2], acc[3]); o.z = pk2(acc[4], acc[5]); o.w = pk2(acc[6], acc[7]);
        if (c0 < G1W) *(v4u*)(G1 + (size_t)row * G1W + c0) = o; else *(v4u*)(G2 + (size_t)row * G2W + (c0 - G1W)) = o;
    }
}
__device__ __forceinline__ void phase_c2_naive(ArgsP a, int layer) {
    const bf16* Y = (const bf16*)(a->ws + WS_YMIX); const bf16* W = (const bf16*)(a->ws + WS_WOUT) + (size_t)layer * 1024 * 1024;
    const float* MOD = (const float*)(a->ws + WS_MOD);
    const size_t total = (size_t)T * 256, stride = (size_t)grid_() * NTHREADS;
    for (size_t idx = (size_t)bid_() * NTHREADS + tid_(); idx < total; idx += stride) {
        const int row = (int)(idx >> 8), c0 = (int)(idx & 255) * 4;
        float acc[4] = {0.f, 0.f, 0.f, 0.f};
        const v4u* ap = (const v4u*)(Y + (size_t)row * 1024); const v4u* bp = (const v4u*)(W + (size_t)c0 * 1024);
        for (int kc = 0; kc < 128; ++kc) { const v4u av = ap[kc];
#pragma unroll
            for (int c = 0; c < 4; ++c) acc[c] = dot8(av, bp[c * 128 + kc], acc[c]); }
        const Tok tk = tok_of(row);
        const f32x4 gate = *(const f32x4*)(MOD + (size_t)(layer * 9 + tk.modrow) * 3072 + 2048 + c0);
        const f32x4 x = *(const f32x4*)(xrow_src(a, layer, row) + c0);
        f32x4 z; z.x = ALPHA * x.x + gate.x * acc[0]; z.y = ALPHA * x.y + gate.y * acc[1]; z.z = ALPHA * x.z + gate.z * acc[2]; z.w = ALPHA * x.w + gate.w * acc[3];
        *(f32x4*)(a->out + (size_t)row * D + c0) = z;
    }
}

__device__ __forceinline__ void phase_a2_naive(ArgsP a, LAS unsigned char* lds, int layer) {
    const int tid = tid_(), lane = tid & 63, wave = tid >> 6, G = grid_();
    LAS float* AQ = (LAS float*)lds;
    LAS float* AKV = (LAS float*)(lds + 16384);
    LAS float* OT = (LAS float*)(lds + 24576);
    const bf16* G2 = (const bf16*)(a->ws + WS_G2);
    bf16* Q = (bf16*)(a->ws + WS_Q); bf16* KN = (bf16*)(a->ws + WS_KN); bf16* KR = (bf16*)(a->ws + WS_KR); bf16* VT = (bf16*)(a->ws + WS_VT);
    const bf16* WUQ = (const bf16*)(a->ws + WS_WUQ) + (size_t)layer * 768 * 256;
    const bf16* WUKV = (const bf16*)(a->ws + WS_WUKV) + (size_t)layer * 1024 * 128;
    constexpr int NT_TOK = T / 16, NT_CACHE = 8 * 256 / 16;
    for (int tile = bid_(); tile < NT_TOK + NT_CACHE; tile += G) {
        const bool is_tok = tile < NT_TOK;
        for (int rr = 0; rr < 2; ++rr) {
            const int r = wave * 2 + rr;
            if (is_tok) {
                const int n = tile * 16 + r; const Tok tk = tok_of(n);
                const v2u cqv = *(const v2u*)(G2 + (size_t)n * G2W + lane * 4);
                const float c0 = bflo(cqv.x), c1 = bfhi(cqv.x), c2 = bflo(cqv.y), c3 = bfhi(cqv.y);
                const float rq = rsqrt_(wave_sum(c0 * c0 + c1 * c1 + c2 * c2 + c3 * c3) * (1.f / 256.f) + 1e-6f);
                const f32x4 qn = *(const f32x4*)(a->in[I_QNORM] + layer * 256 + lane * 4);
                AQ[r * 256 + lane * 4 + 0] = bf2f(f2bf(c0 * rq * qn.x)); AQ[r * 256 + lane * 4 + 1] = bf2f(f2bf(c1 * rq * qn.y));
                AQ[r * 256 + lane * 4 + 2] = bf2f(f2bf(c2 * rq * qn.z)); AQ[r * 256 + lane * 4 + 3] = bf2f(f2bf(c3 * rq * qn.w));
                float k0 = 0.f, k1 = 0.f, k2 = 0.f, k3 = 0.f;
                if (lane < 32) { const v2u kv = *(const v2u*)(G2 + (size_t)n * G2W + 256 + lane * 4); k0 = bflo(kv.x); k1 = bfhi(kv.x); k2 = bflo(kv.y); k3 = bfhi(kv.y); }
                const float rk = rsqrt_(wave_sum(k0 * k0 + k1 * k1 + k2 * k2 + k3 * k3) * (1.f / 128.f) + 1e-6f);
                if (lane < 32) {
                    const f32x4 kn = *(const f32x4*)(a->in[I_KVNORM] + layer * 128 + lane * 4);
                    f32x4 o; o.x = k0 * rk * kn.x; o.y = k1 * rk * kn.y; o.z = k2 * rk * kn.z; o.w = k3 * rk * kn.w;
                    if (!tk.lat) *(f32x4*)(a->out + O_CKV + ((size_t)(tk.b * 2 + layer) * 256 + tk.t) * 128 + lane * 4) = o;
                    AKV[r * 128 + lane * 4 + 0] = bf2f(f2bf(o.x)); AKV[r * 128 + lane * 4 + 1] = bf2f(f2bf(o.y));
                    AKV[r * 128 + lane * 4 + 2] = bf2f(f2bf(o.z)); AKV[r * 128 + lane * 4 + 3] = bf2f(f2bf(o.w));
                }
                float krv = (lane < 32) ? bf2f(G2[(size_t)n * G2W + 384 + lane]) : 0.f;
                const float other = __shfl_xor(krv, 1);
                if (lane < 32) {
                    if (!tk.lat) a->out[O_KR + ((size_t)(tk.b * 2 + layer) * 256 + tk.t) * 32 + lane] = krv;
                    else { float c, s; rope_angle(tk.t, lane >> 1, c, s); krv = (lane & 1) ? (other * s + krv * c) : (krv * c - other * s); }
                    KR[(size_t)tk.kidx * 32 + lane] = (bf16)f2bf(krv);
                }
            } else {
                const int cr = (tile - NT_TOK) * 16 + r, b = cr >> 8, j = cr & 255;
                const size_t src = ((size_t)(b * 2 + layer) * 256 + j);
                if (lane < 32) { const f32x4 v = *(const f32x4*)(a->in[I_CCKV] + src * 128 + lane * 4);
                    AKV[r * 128 + lane * 4 + 0] = bf2f(f2bf(v.x)); AKV[r * 128 + lane * 4 + 1] = bf2f(f2bf(v.y)); AKV[r * 128 + lane * 4 + 2] = bf2f(f2bf(v.z)); AKV[r * 128 + lane * 4 + 3] = bf2f(f2bf(v.w));
                    KR[(size_t)(T_CTX + b * LK_LAT + j) * 32 + lane] = (bf16)f2bf(a->in[I_CKR][src * 32 + lane]); }
            }
        }
        __syncthreads();
        if (is_tok) {
            for (int col = tid; col < 768; col += NTHREADS) {
                float acc[16];
#pragma unroll
                for (int r = 0; r < 16; ++r) acc[r] = 0.f;
                const v4u* wp = (const v4u*)(WUQ + (size_t)col * 256);
                for (int kc = 0; kc < 32; ++kc) { const v4u w = wp[kc];
                    const float w0 = bflo(w.x), w1 = bfhi(w.x), w2 = bflo(w.y), w3 = bfhi(w.y), w4 = bflo(w.z), w5 = bfhi(w.z), w6 = bflo(w.w), w7 = bfhi(w.w);
#pragma unroll
                    for (int r = 0; r < 16; ++r) { const f32x4 x0 = *(const LAS f32x4*)(AQ + r * 256 + kc * 8), x1 = *(const LAS f32x4*)(AQ + r * 256 + kc * 8 + 4);
                        acc[r] += x0.x * w0 + x0.y * w1 + x0.z * w2 + x0.w * w3 + x1.x * w4 + x1.y * w5 + x1.z * w6 + x1.w * w7; } }
#pragma unroll
                for (int r = 0; r < 16; ++r) OT[r * 1024 + col] = acc[r];
            }
            __syncthreads();
            for (int idx = tid; idx < 16 * 384; idx += NTHREADS) {
                const int r = idx / 384, col = (idx % 384) * 2, d = col % 96; const int n = tile * 16 + r; const Tok tk = tok_of(n);
                float v0 = OT[r * 1024 + col], v1 = OT[r * 1024 + col + 1];
                if (tk.lat && d >= 64) { float c, s; rope_angle(tk.t, (d - 64) >> 1, c, s); const float y0 = v0 * c - v1 * s, y1 = v0 * s + v1 * c; v0 = y0; v1 = y1; }
                *(unsigned*)(Q + (size_t)n * 768 + col) = pk2(v0, v1);
            }
            __syncthreads();
        }
        for (int col = tid; col < 1024; col += NTHREADS) {
            float acc[16];
#pragma unroll
            for (int r = 0; r < 16; ++r) acc[r] = 0.f;
            const v4u* wp = (const v4u*)(WUKV + (size_t)col * 128);
            for (int kc = 0; kc < 16; ++kc) { const v4u w = wp[kc];
                const float w0 = bflo(w.x), w1 = bfhi(w.x), w2 = bflo(w.y), w3 = bfhi(w.y), w4 = bflo(w.z), w5 = bfhi(w.z), w6 = bflo(w.w), w7 = bfhi(w.w);
#pragma unroll
                for (int r = 0; r < 16; ++r) { const f32x4 x0 = *(const LAS f32x4*)(AKV + r * 128 + kc * 8), x1 = *(const LAS f32x4*)(AKV + r * 128 + kc * 8 + 4);
                    acc[r] += x0.x * w0 + x0.y * w1 + x0.z * w2 + x0.w * w3 + x1.x * w4 + x1.y * w5 + x1.z * w6 + x1.w * w7; } }
#pragma unroll
            for (int r = 0; r < 16; ++r) OT[r * 1024 + col] = acc[r];
        }
        __syncthreads();
        for (int idx = tid; idx < 16 * 1024; idx += NTHREADS) {
            const int r = idx >> 10, col = idx & 1023, h = col >> 7, f = col & 127;
            int kidx, lat, b, kpos;
            if (is_tok) { const Tok tk = tok_of(tile * 16 + r); kidx = tk.kidx; lat = tk.lat; b = tk.b; kpos = tk.lat ? PAST + tk.t : tk.t; }
            else { const int cr = (tile - NT_TOK) * 16 + r; b = cr >> 8; kpos = cr & 255; lat = 1; kidx = T_CTX + b * LK_LAT + kpos; }
            const bf16 v = (bf16)f2bf(OT[r * 1024 + col]);
            if (f < 64) KN[(size_t)kidx * 512 + h * 64 + f] = v;
            else { const int dv = f - 64; const size_t base = lat ? (size_t)VT_LAT + ((size_t)(b * 8 + h) * 64 + dv) * LK_LAT : ((size_t)(b * 8 + h) * 64 + dv) * 256; VT[base + kpos] = v; }
        }
        __syncthreads();
    }
}

__device__ __forceinline__ void phase_att_naive(ArgsP a) {
    const bf16* KN = (const bf16*)(a->ws + WS_KN); const bf16* KR = (const bf16*)(a->ws + WS_KR); const bf16* VT = (const bf16*)(a->ws + WS_VT);
    bf16* Q = (bf16*)(a->ws + WS_Q); const bf16* G1 = (const bf16*)(a->ws + WS_G1);
    const int total = T * 8, stride = grid_() * NTHREADS;
    for (int idx = bid_() * NTHREADS + tid_(); idx < total; idx += stride) {
        int n, h, Lk, kidx0; size_t vbase;
        if (idx < T_CTX * 8) { const int b = idx >> 11, hh = (idx >> 8) & 7, t = idx & 255; n = b * 256 + t; h = hh; Lk = 256; kidx0 = b * 256; vbase = ((size_t)(b * 8 + h) * 64) * 256; }
        else { const int m = idx - T_CTX * 8, b = m >> 14, hh = (m >> 11) & 7, t = m & 2047; n = T_CTX + b * 2048 + t; h = hh; Lk = LK_LAT; kidx0 = T_CTX + b * LK_LAT; vbase = (size_t)VT_LAT + ((size_t)(b * 8 + h) * 64) * LK_LAT; }
        v4u qp[12];
#pragma unroll
        for (int c = 0; c < 12; ++c) qp[c] = *(const v4u*)(Q + (size_t)n * 768 + h * 96 + c * 8);
        float acc[64];
#pragma unroll
        for (int d = 0; d < 64; ++d) acc[d] = 0.f;
        float m = -1e30f, l = 0.f;
        for (int j0 = 0; j0 < Lk; j0 += 8) {
            float s[8];
#pragma unroll
            for (int j = 0; j < 8; ++j) {
                const v4u* kp = (const v4u*)(KN + (size_t)(kidx0 + j0 + j) * 512 + h * 64); const v4u* rp = (const v4u*)(KR + (size_t)(kidx0 + j0 + j) * 32);
                float sv = 0.f;
#pragma unroll
                for (int c = 0; c < 8; ++c) sv = dot8(qp[c], kp[c], sv);
#pragma unroll
                for (int c = 0; c < 4; ++c) sv = dot8(qp[8 + c], rp[c], sv);
                s[j] = sv;
                __builtin_amdgcn_sched_barrier(0);
            }
            float mx = m;
#pragma unroll
            for (int j = 0; j < 8; ++j) mx = fmaxf(mx, s[j]);
            const float alpha = exp2f(m - mx); m = mx; float ps = 0.f;
#pragma unroll
            for (int j = 0; j < 8; ++j) { s[j] = exp2f(s[j] - mx); ps += s[j]; }
            l = l * alpha + ps;
            unsigned lk = (unsigned)Lk; asm volatile("" : "+v"(lk));
            const bf16* vp = VT + vbase + j0;
#pragma unroll
            for (int dg = 0; dg < 8; ++dg) {
#pragma unroll
                for (int dd = 0; dd < 8; ++dd) { const int d = dg * 8 + dd; const v4u w = *(const v4u*)(vp + (unsigned)d * lk);
                    acc[d] = acc[d] * alpha + s[0] * bflo(w.x) + s[1] * bfhi(w.x) + s[2] * bflo(w.y) + s[3] * bfhi(w.y) + s[4] * bflo(w.z) + s[5] * bfhi(w.z) + s[6] * bflo(w.w) + s[7] * bfhi(w.w); }
                __builtin_amdgcn_sched_barrier(0);
            }
        }
        const float inv = rcp_(l);
#pragma unroll
        for (int c = 0; c < 8; ++c) { const v4u g = *(const v4u*)(G1 + (size_t)n * G1W + C_GM + h * 64 + c * 8);
            v4u o;
            o.x = pk2(acc[c * 8 + 0] * inv * siluf_(bflo(g.x)), acc[c * 8 + 1] * inv * siluf_(bfhi(g.x)));
            o.y = pk2(acc[c * 8 + 2] * inv * siluf_(bflo(g.y)), acc[c * 8 + 3] * inv * siluf_(bfhi(g.y)));
            o.z = pk2(acc[c * 8 + 4] * inv * siluf_(bflo(g.z)), acc[c * 8 + 5] * inv * siluf_(bfhi(g.z)));
            o.w = pk2(acc[c * 8 + 6] * inv * siluf_(bflo(g.w)), acc[c * 8 + 7] * inv * siluf_(bfhi(g.w)));
            *(v4u*)(Q + (size_t)n * 768 + h * 96 + c * 8) = o; }
    }
}
namespace pg8 {
#define PG8_LAS __attribute__((address_space(3)))
typedef unsigned short bf16_t;
typedef short bf16x8 __attribute__((ext_vector_type(8)));
typedef float f32x4 __attribute__((ext_vector_type(4)));
typedef unsigned u32x4 __attribute__((ext_vector_type(4)));
constexpr int BM = 256, BK = 64, HALF = 128, HTB = HALF * BK * 2  , STAGE_BYTES = 8 * HTB, NXCD = 8, WGM = 8;

__host__ __device__ __forceinline__ int lds_byte(int r, int c) { const int st = (r >> 4) * 2 + (c >> 5), rr = r & 15, cc = c & 31, ob = rr * 64 + cc * 2; return st * 1024 + (ob ^ (((ob >> 9) & 1) << 5)); }
__host__ __device__ __forceinline__ void stage_rc(int b, int& R, int& C) { const int st = b / 1024, sb = b % 1024, swz = sb ^ (((sb >> 9) & 1) << 5); R = (st >> 1) * 16 + swz / 64; C = (st & 1) * 32 + (swz % 64) / 2; }
__host__ __device__ __forceinline__ int perm32(int rho) { const int n = rho >> 4, i = rho & 15; return 8 * (i >> 2) + 4 * n + (i & 3); }

struct Unit { int pm, pn, gid; };
struct Gemm { const bf16_t* A; const bf16_t* Bt; int M, N, K, lda, ldb; };

struct StaticOrder {
    int nM, nN, nwg, G, c;
    __host__ __device__ void init(int M, int N, int G_, int c_) { nM = M / BM; nN = N / BM; nwg = nM * nN; G = G_; c = c_; }
    __host__ __device__ bool next(int i, Unit& u) const {
        const long L = (long)i * G + c; if (L >= nwg) return false;
        int wgid = (int)L; { const int q = nwg / NXCD, r = nwg % NXCD, xcd = wgid % NXCD, off = wgid / NXCD; wgid = (xcd < r ? xcd * (q + 1) : r * (q + 1) + (xcd - r) * q) + off; }
        const int nig = WGM * nN, gid = wgid / nig, fm = gid * WGM, gsz = (nM - fm) < WGM ? (nM - fm) : WGM;
        u.pm = fm + ((wgid % nig) % gsz); u.pn = (wgid % nig) / gsz; u.gid = 0; return true;
    }
    __device__ __forceinline__ const char* abase(const Gemm& g, const Unit& u) const { return (const char*)g.A + (size_t)u.pm * BM * g.lda * 2; }
    __device__ __forceinline__ const char* bbase(const Gemm& g, const Unit& u) const { return (const char*)g.Bt + (size_t)u.pn * BM * g.ldb * 2; }
    __device__ __forceinline__ void a_ready(const Unit&) const {}
    __device__ __forceinline__ void done(const Unit&) const {}
};
__device__ __forceinline__ unsigned cvt_pk_bf16(float lo, float hi) { unsigned r; asm volatile("v_cvt_pk_bf16_f32 %0, %1, %2" : "=v"(r) : "v"(lo), "v"(hi)); return r; }

template <class Epi, class Sched, bool STAMP = false>
__device__ __forceinline__ void gemm_phase(PG8_LAS unsigned char* lds, const Gemm g, const Sched& S, const Epi& E, unsigned long long* stamps) {
    const int tid = tid_(), wid = __builtin_amdgcn_readfirstlane(tid >> 6), lane = tid & 63, wr = wid >> 2, wc = wid & 3, fr = lane & 15, fq = lane >> 4;
    const int K = g.K, nt = K / BK;
    int ts_lo = 0, ts_hi = 0, nts = 0; const unsigned long long rt_entry = STAMP ? (unsigned long long)wall_clock64() : 0ull;
#define PG8_STAMP() do { if (STAMP && wid == 0 && nts < 64) { const unsigned long long _c = (unsigned long long)clock64(); \
        ts_lo = (lane == nts) ? (int)(unsigned)_c : ts_lo; ts_hi = (lane == nts) ? (int)(unsigned)(_c >> 32) : ts_hi; ++nts; } } while (0)
    PG8_STAMP();
    unsigned voffA[2], voffB[2];
#pragma unroll
    for (int i = 0; i < 2; ++i) { int R, C; stage_rc(tid * 16 + i * 8192, R, C); const int Rb = Epi::PERM ? ((R & ~31) + perm32(R & 31)) : R;
        voffA[i] = (unsigned)(R * g.lda + C) * 2u; voffB[i] = (unsigned)(Rb * g.ldb + C) * 2u; }
    const size_t kstep = (size_t)(BK * 2);
    const size_t hstepA = (size_t)HALF * g.lda * 2, hstepB = (size_t)HALF * g.ldb * 2;
    const unsigned ldsw = (unsigned)wid * 1024u;
    const int aoff = lds_byte(wr * 64 + fr, fq * 8), boff = lds_byte(wc * 32 + fr, fq * 8);
#define PG8_SA(b, h) (((b) * 2 + (h)) * HTB)
#define PG8_SB(b, h) ((4 + (b) * 2 + (h)) * HTB)
#define PG8_STAGE(bufoff, gbase, voff) do { _Pragma("unroll") for (int _i = 0; _i < 2; ++_i) \
        __builtin_amdgcn_global_load_lds((const unsigned*)((const char*)(gbase) + (voff)[_i]), (PG8_LAS unsigned*)(lds + (bufoff) + ldsw + _i * 8192), 16, 0, 0); } while (0)
#define PG8_LDA(dst, b, h) do { _Pragma("unroll") for (int m = 0; m < 4; ++m) _Pragma("unroll") for (int k = 0; k < 2; ++k) dst[m][k] = *(const PG8_LAS bf16x8*)(lds + PG8_SA(b, h) + aoff + m * 2048 + k * 1024); } while (0)
#define PG8_LDB(dst, b, h) do { _Pragma("unroll") for (int n = 0; n < 2; ++n) _Pragma("unroll") for (int k = 0; k < 2; ++k) dst[n][k] = *(const PG8_LAS bf16x8*)(lds + PG8_SB(b, h) + boff + n * 2048 + k * 1024); } while (0)
#define PG8_MMA(ai, bj, At, Bt) do { __builtin_amdgcn_s_setprio(1); _Pragma("unroll") for (int m = 0; m < 4; ++m) _Pragma("unroll") for (int n = 0; n < 2; ++n) _Pragma("unroll") for (int k = 0; k < 2; ++k) \
        acc[ai][bj][m][n] = __builtin_amdgcn_mfma_f32_16x16x32_bf16(Bt[n][k], At[m][k], acc[ai][bj][m][n], 0, 0, 0); __builtin_amdgcn_s_setprio(0); } while (0)
#define PG8_WAIT_V(n) asm volatile("s_waitcnt vmcnt(" #n ")" ::: "memory")
#define PG8_WAIT_L(n) asm volatile("s_waitcnt lgkmcnt(" #n ")" ::: "memory")
#define PG8_BAR __builtin_amdgcn_s_barrier()
#define PG8_SCHED __builtin_amdgcn_sched_barrier(0)
    Unit cur, nxt; int ui = 0;
    if (!S.next(0, cur)) return;
    f32x4 acc[2][2][4][2];
#pragma unroll
    for (int a = 0; a < 2; ++a)
#pragma unroll
        for (int b = 0; b < 2; ++b)
#pragma unroll
            for (int m = 0; m < 4; ++m)
#pragma unroll
                for (int n = 0; n < 2; ++n) acc[a][b][m][n] = (f32x4){0.f, 0.f, 0.f, 0.f};
    bf16x8 At[4][2], B0[2][2], B1[2][2];
    const char* cA = S.abase(g, cur); const char* cB = S.bbase(g, cur);
    S.a_ready(cur);
    PG8_STAGE(PG8_SB(0, 0), cB, voffB); PG8_STAGE(PG8_SA(0, 0), cA, voffA); PG8_STAGE(PG8_SB(0, 1), cB + hstepB, voffB); PG8_STAGE(PG8_SA(0, 1), cA + hstepA, voffA);
    if (wr == 1) PG8_BAR;
    PG8_WAIT_V(4); PG8_BAR;
    PG8_STAGE(PG8_SB(1, 0), cB + kstep, voffB); PG8_STAGE(PG8_SA(1, 0), cA + kstep, voffA); PG8_STAGE(PG8_SB(1, 1), cB + hstepB + kstep, voffB);
    PG8_WAIT_V(6); PG8_BAR;
    PG8_STAMP();
    for (;;) {
        const bool has_next = S.next(ui + 1, nxt);
        const char* nA = has_next ? S.abase(g, nxt) : cA; const char* nB = has_next ? S.bbase(g, nxt) : cB;
        for (int t = 0; t < nt; t += 2) {
            const bool last = (t == nt - 2);
            const char* a1 = cA + (size_t)(t + 1) * kstep;
            const char* a2 = last ? nA : cA + (size_t)(t + 2) * kstep; const char* b2 = last ? nB : cB + (size_t)(t + 2) * kstep;
            const char* a3 = a2 + kstep; const char* b3 = b2 + kstep;
            if (last && has_next) S.a_ready(nxt);
            PG8_LDB(B0, 0, 0); PG8_SCHED; PG8_LDA(At, 0, 0); PG8_STAGE(PG8_SA(1, 1), a1 + hstepA, voffA);
            PG8_WAIT_L(8); PG8_BAR; PG8_WAIT_L(0); PG8_MMA(0, 0, At, B0); PG8_BAR; PG8_SCHED;
            PG8_LDB(B1, 0, 1); PG8_STAGE(PG8_SB(0, 0), b2, voffB);
            PG8_BAR; PG8_WAIT_L(0); PG8_MMA(0, 1, At, B1); PG8_BAR;
            PG8_LDA(At, 0, 1); PG8_STAGE(PG8_SA(0, 0), a2, voffA);
            PG8_BAR; PG8_WAIT_L(0); PG8_MMA(1, 0, At, B0); PG8_BAR; PG8_SCHED;
            PG8_STAGE(PG8_SB(0, 1), b2 + hstepB, voffB);
            PG8_WAIT_V(6); PG8_BAR; PG8_MMA(1, 1, At, B1); PG8_BAR;
            PG8_LDB(B0, 1, 0); PG8_SCHED; PG8_LDA(At, 1, 0); PG8_STAGE(PG8_SA(0, 1), a2 + hstepA, voffA);
            PG8_WAIT_L(8); PG8_BAR; PG8_WAIT_L(0); PG8_MMA(0, 0, At, B0); PG8_BAR; PG8_SCHED;
            PG8_LDB(B1, 1, 1); PG8_STAGE(PG8_SB(1, 0), b3, voffB);
            PG8_BAR; PG8_WAIT_L(0); PG8_MMA(0, 1, At, B1); PG8_BAR;
            PG8_LDA(At, 1, 1); PG8_STAGE(PG8_SA(1, 0), a3, voffA);
            PG8_BAR; PG8_WAIT_L(0); PG8_MMA(1, 0, At, B0); PG8_BAR; PG8_SCHED;
            PG8_STAGE(PG8_SB(1, 1), b3 + hstepB, voffB);
            PG8_WAIT_V(6); PG8_BAR; PG8_MMA(1, 1, At, B1); PG8_BAR;
        }
        PG8_STAMP();
        if constexpr (!Epi::AFTER_DRAIN) { E(acc, cur, wr, wc, fr, fq); S.done(cur); }
        PG8_STAMP();
        if (!has_next) break;
#pragma unroll
        for (int a = 0; a < 2; ++a)
#pragma unroll
            for (int b = 0; b < 2; ++b)
#pragma unroll
                for (int m = 0; m < 4; ++m)
#pragma unroll
                    for (int n = 0; n < 2; ++n) acc[a][b][m][n] = (f32x4){0.f, 0.f, 0.f, 0.f};
        cur = nxt; cA = nA; cB = nB; ++ui;
    }
    PG8_WAIT_V(0);
    if (wr == 0) PG8_BAR;
    PG8_BAR;
    if constexpr (Epi::AFTER_DRAIN) { E.fused(acc, cur, wr, wc, fr, fq, lds, wid, lane); S.done(cur); }
    PG8_STAMP();
    if (STAMP && wid == 0) { stamps[lane] = lane < nts ? (((unsigned long long)(unsigned)ts_hi << 32) | (unsigned)ts_lo) : 0ull;
        if (lane == 62) stamps[62] = rt_entry; if (lane == 63) stamps[63] = (unsigned long long)wall_clock64(); }
#undef PG8_STAMP
#undef PG8_SA
#undef PG8_SB
#undef PG8_STAGE
#undef PG8_LDA
#undef PG8_LDB
#undef PG8_MMA
#undef PG8_WAIT_V
#undef PG8_WAIT_L
#undef PG8_BAR
#undef PG8_SCHED
}
}
namespace pg8 {
struct EpiIn {
    static constexpr bool PERM = true, AFTER_DRAIN = false;
    bf16_t* G1; bf16_t* G2;
    __device__ __forceinline__ void operator()(const f32x4 (&acc)[2][2][4][2], const Unit& u, int wr, int wc, int fr, int fq) const {
        const int row0 = u.pm * BM + wr * 64 + fr;
        bf16_t* base; int ldc, colt;
        if (u.pn < 9) { base = G1; ldc = 2304; colt = u.pn * 256; } else { base = G2; ldc = 512; colt = (u.pn - 9) * 256; }
        const int col0 = colt + wc * 32 + 8 * fq;
#pragma unroll
        for (int ai = 0; ai < 2; ++ai)
#pragma unroll
            for (int m = 0; m < 4; ++m) { bf16_t* rowp = base + (size_t)(row0 + ai * HALF + m * 16) * ldc + col0;
#pragma unroll
                for (int bj = 0; bj < 2; ++bj) { const f32x4 v0 = acc[ai][bj][m][0], v1 = acc[ai][bj][m][1];
                    u32x4 w; w.x = cvt_pk_bf16(v0[0], v0[1]); w.y = cvt_pk_bf16(v0[2], v0[3]); w.z = cvt_pk_bf16(v1[0], v1[1]); w.w = cvt_pk_bf16(v1[2], v1[3]);
                    *(u32x4*)(rowp + bj * HALF) = w; } }
    }
};
struct EpiOut {
    static constexpr bool PERM = true, AFTER_DRAIN = false;
    const float* xp; const float* xs; float* out; const float* mod; int layer;
    const float* stats; const float* lng; const float* lnb;
    __device__ __forceinline__ void operator()(const f32x4 (&acc)[2][2][4][2], const Unit& u, int wr, int wc, int fr, int fq) const {
        const int row0 = u.pm * BM + wr * 64 + fr, col0 = u.pn * BM + wc * 32 + 8 * fq;
        const int rt = u.pm * BM; const int modrow = rt < 8192 ? 0 : 1 + ((rt - 8192) >> 11);
        const float* gp = mod + (size_t)modrow * 3072 + 2048 + col0;
        f32x4 gv[2][2];
#pragma unroll
        for (int bj = 0; bj < 2; ++bj)
#pragma unroll
            for (int n = 0; n < 2; ++n) gv[bj][n] = *(const f32x4*)(gp + bj * HALF + n * 4);
        f32x4 lg[2][2], lb[2][2];
        if (layer) {
#pragma unroll
            for (int bj = 0; bj < 2; ++bj)
#pragma unroll
                for (int n = 0; n < 2; ++n) { lg[bj][n] = *(const f32x4*)(lng + col0 + bj * HALF + n * 4); lb[bj][n] = *(const f32x4*)(lnb + col0 + bj * HALF + n * 4); }
        }
        f32x4 xn[2][2]; float mean_n = 0.f, rstd_n = 1.f;
#define EO_LOAD(am_) do { const int row_ = row0 + ((am_) >> 2) * HALF + ((am_) & 3) * 16; \
            if (layer == 0) { const float* xr_ = (row_ < 8192 ? xp + (size_t)row_ * 1024 : xs + (size_t)(row_ - 8192) * 1024) + col0; \
                xn[0][0] = *(const f32x4*)(xr_); xn[0][1] = *(const f32x4*)(xr_ + 4); xn[1][0] = *(const f32x4*)(xr_ + HALF); xn[1][1] = *(const f32x4*)(xr_ + HALF + 4); } \
            else { const bf16_t* zr_ = (const bf16_t*)out + (size_t)row_ * 2048 + col0; const u32x4 z0_ = *(const u32x4*)zr_, z1_ = *(const u32x4*)(zr_ + HALF); \
                xn[0][0] = (f32x4){__uint_as_float(z0_.x << 16), __uint_as_float(z0_.x & 0xffff0000u), __uint_as_float(z0_.y << 16), __uint_as_float(z0_.y & 0xffff0000u)}; \
                xn[0][1] = (f32x4){__uint_as_float(z0_.z << 16), __uint_as_float(z0_.z & 0xffff0000u), __uint_as_float(z0_.w << 16), __uint_as_float(z0_.w & 0xffff0000u)}; \
                xn[1][0] = (f32x4){__uint_as_float(z1_.x << 16), __uint_as_float(z1_.x & 0xffff0000u), __uint_as_float(z1_.y << 16), __uint_as_float(z1_.y & 0xffff0000u)}; \
                xn[1][1] = (f32x4){__uint_as_float(z1_.z << 16), __uint_as_float(z1_.z & 0xffff0000u), __uint_as_float(z1_.w << 16), __uint_as_float(z1_.w & 0xffff0000u)}; \
                mean_n = stats[(size_t)row_ * 2]; rstd_n = stats[(size_t)row_ * 2 + 1]; } } while (0)
        EO_LOAD(0);
#pragma unroll
        for (int am = 0; am < 8; ++am) { const int ai = am >> 2, m = am & 3, row = row0 + ai * HALF + m * 16;
            const f32x4 xc[2][2] = {{xn[0][0], xn[0][1]}, {xn[1][0], xn[1][1]}}; const float mean = mean_n, rstd = rstd_n;
            if (am + 1 < 8) EO_LOAD(am + 1);
            bf16_t* orow = (bf16_t*)out + (size_t)row * 2048 + col0;
#pragma unroll
            for (int bj = 0; bj < 2; ++bj) { f32x4 z[2];
#pragma unroll
                for (int n = 0; n < 2; ++n) { f32x4 x = xc[bj][n];
                    if (layer) x = (x - mean) * rstd * lg[bj][n] + lb[bj][n];
                    z[n] = x * 1.4142135623730951f + gv[bj][n] * acc[ai][bj][m][n]; }
                u32x4 w; w.x = cvt_pk_bf16(z[0][0], z[0][1]); w.y = cvt_pk_bf16(z[0][2], z[0][3]); w.z = cvt_pk_bf16(z[1][0], z[1][1]); w.w = cvt_pk_bf16(z[1][2], z[1][3]);
                *(u32x4*)(orow + bj * HALF) = w; } }
#undef EO_LOAD
    }
};
}

__device__ __forceinline__ void phase_a1_pg8(ArgsP a, LAS unsigned char* lds, int layer) {
    pg8::Gemm g{(const bf16*)(a->ws + WS_U), (const bf16*)(a->ws + WS_WIN) + (size_t)layer * NIN * 1024, T, NIN, 1024, 1024, 1024};
    pg8::StaticOrder S; S.init(T, NIN, grid_(), bid_());
    pg8::EpiIn E{(bf16*)(a->ws + WS_G1), (bf16*)(a->ws + WS_G2)};
    pg8::gemm_phase<pg8::EpiIn, pg8::StaticOrder, false>(lds, g, S, E, nullptr);
}
__device__ __forceinline__ void phase_c2_pg8(ArgsP a, LAS unsigned char* lds, int layer) {
    pg8::Gemm g{(const bf16*)(a->ws + WS_YMIX), (const bf16*)(a->ws + WS_WOUT) + (size_t)layer * 1024 * 1024, T, 1024, 1024, 1024, 1024};
    pg8::StaticOrder S; S.init(T, 1024, grid_(), bid_());
    pg8::EpiOut E{a->in[I_XP], a->in[I_XS], a->out, (const float*)(a->ws + WS_MOD) + (size_t)layer * 9 * 3072, layer, (const float*)(a->ws + WS_STATS), a->in[I_LNG], a->in[I_LNB]};
    pg8::gemm_phase<pg8::EpiOut, pg8::StaticOrder, false>(lds, g, S, E, nullptr);
}

__device__ __forceinline__ void phase_a2a(ArgsP a, int layer) {
    const int tid = tid_(), lane = tid & 63, wave = tid >> 6, G = grid_();
    bf16* G2 = (bf16*)(a->ws + WS_G2); bf16* KR = (bf16*)(a->ws + WS_KR); bf16* CK = (bf16*)(a->ws + WS_HF);
    const float* ROPE = (const float*)(a->ws + WS_ROPE);
    f32x4 nw0 = {0.f, 0.f, 0.f, 0.f}, nw1 = {0.f, 0.f, 0.f, 0.f};
    if (lane < 32) { nw0 = *(const f32x4*)(a->in[I_QNORM] + layer * 256 + lane * 8); nw1 = *(const f32x4*)(a->in[I_QNORM] + layer * 256 + lane * 8 + 4); }
    else if (lane < 48) { nw0 = *(const f32x4*)(a->in[I_KVNORM] + layer * 128 + (lane - 32) * 8); nw1 = *(const f32x4*)(a->in[I_KVNORM] + layer * 128 + (lane - 32) * 8 + 4); }
    v4u nx = {0u, 0u, 0u, 0u};
    { const int n0 = bid_() * 8 + wave; if (n0 < T) nx = *(const v4u*)(G2 + (size_t)n0 * G2W + lane * 8); }
    for (int n = bid_() * 8 + wave; n < T; n += G * 8) {
        const v4u w = nx;
        if (n + G * 8 < T) nx = *(const v4u*)(G2 + (size_t)(n + G * 8) * G2W + lane * 8);
        const Tok tk = tok_of(n);
        float x[8] = {bflo(w.x), bfhi(w.x), bflo(w.y), bfhi(w.y), bflo(w.z), bfhi(w.z), bflo(w.w), bfhi(w.w)};
        const float ss = (x[0] * x[0] + x[1] * x[1]) + (x[2] * x[2] + x[3] * x[3]) + (x[4] * x[4] + x[5] * x[5]) + (x[6] * x[6] + x[7] * x[7]);
        const float sq = wave_sum(lane < 32 ? ss : 0.f), sk = wave_sum((lane >= 32 && lane < 48) ? ss : 0.f);
        const float rs = lane < 32 ? rsqrt_(sq * (1.f / 256.f) + 1e-6f) : rsqrt_(sk * (1.f / 128.f) + 1e-6f);
        if (lane < 48) {
            const float y0 = x[0] * rs * nw0.x, y1 = x[1] * rs * nw0.y, y2 = x[2] * rs * nw0.z, y3 = x[3] * rs * nw0.w, y4 = x[4] * rs * nw1.x, y5 = x[5] * rs * nw1.y, y6 = x[6] * rs * nw1.z, y7 = x[7] * rs * nw1.w;
            *(v4u*)(G2 + (size_t)n * G2W + lane * 8) = (v4u){cvtpk(y0, y1), cvtpk(y2, y3), cvtpk(y4, y5), cvtpk(y6, y7)};
            if (lane >= 32 && !tk.lat) { float* op = a->out + O_CKV + ((size_t)(tk.b * 2 + layer) * 256 + tk.t) * 128 + (lane - 32) * 8;
                *(f32x4*)op = (f32x4){y0, y1, y2, y3}; *(f32x4*)(op + 4) = (f32x4){y4, y5, y6, y7}; }
        } else if (lane < 52) {
            const int d0 = (lane - 48) * 8;
            if (!tk.lat) { float* op = a->out + O_KR + ((size_t)(tk.b * 2 + layer) * 256 + tk.t) * 32 + d0;
                *(f32x4*)op = (f32x4){x[0], x[1], x[2], x[3]}; *(f32x4*)(op + 4) = (f32x4){x[4], x[5], x[6], x[7]};
                *(v4u*)(KR + (size_t)tk.kidx * 32 + d0) = w; }
            else { const f32x4 c0 = *(const f32x4*)(ROPE + ((size_t)tk.t * 16 + (d0 >> 1)) * 2), c1 = *(const f32x4*)(ROPE + ((size_t)tk.t * 16 + (d0 >> 1) + 2) * 2);
                const float y0 = x[0] * c0.x - x[1] * c0.y, y1 = x[0] * c0.y + x[1] * c0.x, y2 = x[2] * c0.z - x[3] * c0.w, y3 = x[2] * c0.w + x[3] * c0.z;
                const float y4 = x[4] * c1.x - x[5] * c1.y, y5 = x[4] * c1.y + x[5] * c1.x, y6 = x[6] * c1.z - x[7] * c1.w, y7 = x[6] * c1.w + x[7] * c1.z;
                *(v4u*)(KR + (size_t)tk.kidx * 32 + d0) = (v4u){cvtpk(y0, y1), cvtpk(y2, y3), cvtpk(y4, y5), cvtpk(y6, y7)}; }
        }
    }
    for (int r = bid_() * 8 + wave; r < 2048; r += G * 8) {
        const int b = r >> 8, j = r & 255; const size_t src = (size_t)(b * 2 + layer) * 256 + j;
        if (lane < 16) { const f32x4 v0 = *(const f32x4*)(a->in[I_CCKV] + src * 128 + lane * 8), v1 = *(const f32x4*)(a->in[I_CCKV] + src * 128 + lane * 8 + 4);
            *(v4u*)(CK + (size_t)r * 512 + lane * 8) = (v4u){cvtpk(v0.x, v0.y), cvtpk(v0.z, v0.w), cvtpk(v1.x, v1.y), cvtpk(v1.z, v1.w)}; }
        else if (lane < 32) *(v4u*)(CK + (size_t)r * 512 + lane * 8) = (v4u){0u, 0u, 0u, 0u};
        else if (lane < 36) { const f32x4 v0 = *(const f32x4*)(a->in[I_CKR] + src * 32 + (lane - 32) * 8), v1 = *(const f32x4*)(a->in[I_CKR] + src * 32 + (lane - 32) * 8 + 4);
            *(v4u*)(KR + (size_t)(T_CTX + b * LK_LAT + j) * 32 + (lane - 32) * 8) = (v4u){cvtpk(v0.x, v0.y), cvtpk(v0.z, v0.w), cvtpk(v1.x, v1.y), cvtpk(v1.z, v1.w)}; }
    }
}
namespace pg8 {
struct A2Order {
    const char* ws; unsigned oq, okv; int G, c;
    __device__ __forceinline__ bool next(int i, Unit& u) const {
        const int L = i * G + c; if (L >= 704) return false;
        if (L < 288) { u.gid = 0; u.pm = L / 3; u.pn = L % 3; } else if (L < 672) { u.gid = 1; u.pm = (L - 288) >> 2; u.pn = (L - 288) & 3; } else { u.gid = 2; u.pm = (L - 672) >> 2; u.pn = (L - 672) & 3; }
        return true;
    }
    __device__ __forceinline__ const char* abase(const Gemm&, const Unit& u) const { const unsigned off = u.gid == 0 ? (unsigned)WS_G2 : (u.gid == 1 ? (unsigned)WS_G2 + 512u : (unsigned)WS_HF); return ws + off + (size_t)u.pm * 256 * 512 * 2; }
    __device__ __forceinline__ const char* bbase(const Gemm&, const Unit& u) const { const unsigned off = u.gid == 0 ? oq : okv; return ws + off + (size_t)u.pn * 256 * 256 * 2; }
    __device__ __forceinline__ void a_ready(const Unit&) const {}
    __device__ __forceinline__ void done(const Unit&) const {}
};
struct EpiA2 {
    static constexpr bool PERM = true, AFTER_DRAIN = false;
    bf16_t* Q; bf16_t* KN; bf16_t* VR; const float* rope;
    __device__ __forceinline__ void operator()(const f32x4 (&acc)[2][2][4][2], const Unit& u, int wr, int wc, int fr, int fq) const {
        const int row0 = u.pm * BM + wr * 64 + fr;
        if (u.gid == 0) {
            const int fb = u.pn * 256 + wc * 32 + 8 * fq;
#pragma unroll
            for (int ai = 0; ai < 2; ++ai)
#pragma unroll
                for (int m = 0; m < 4; ++m) { const int row = row0 + ai * HALF + m * 16;
                    const float* rp = rope + (unsigned)(((row - 8192) & 2047) * 32);
#pragma unroll
                    for (int bj = 0; bj < 2; ++bj) {
                        f32x4 v0 = acc[ai][bj][m][0], v1 = acc[ai][bj][m][1];
                        const int f0 = fb + bj * HALF, d = f0 % 96;
                        if (row >= 8192 && d >= 64) { const f32x4 c0 = *(const f32x4*)(rp + (d - 64)), c1 = *(const f32x4*)(rp + (d - 64) + 4);
                            const f32x4 a0 = v0, a1 = v1;
                            v0[0] = a0[0] * c0[0] - a0[1] * c0[1]; v0[1] = a0[0] * c0[1] + a0[1] * c0[0]; v0[2] = a0[2] * c0[2] - a0[3] * c0[3]; v0[3] = a0[2] * c0[3] + a0[3] * c0[2];
                            v1[0] = a1[0] * c1[0] - a1[1] * c1[1]; v1[1] = a1[0] * c1[1] + a1[1] * c1[0]; v1[2] = a1[2] * c1[2] - a1[3] * c1[3]; v1[3] = a1[2] * c1[3] + a1[3] * c1[2]; }
                        u32x4 w; w.x = cvt_pk_bf16(v0[0], v0[1]); w.y = cvt_pk_bf16(v0[2], v0[3]); w.z = cvt_pk_bf16(v1[0], v1[1]); w.w = cvt_pk_bf16(v1[2], v1[3]);
                        *(u32x4*)(Q + (unsigned)(row * 768 + f0)) = w; } }
        } else {
            const int x = wc * 32 + 8 * fq;
            bf16_t* base = (wc < 2 ? KN : VR);
            const unsigned xo = (unsigned)(x & 63);
#pragma unroll
            for (int ai = 0; ai < 2; ++ai)
#pragma unroll
                for (int m = 0; m < 4; ++m) { const int row = row0 + ai * HALF + m * 16;
                    int kidx;
                    if (u.gid == 2) kidx = 8192 + (row >> 8) * 2304 + (row & 255);
                    else if (row < 8192) kidx = row;
                    else { const int mrow = row - 8192; kidx = 8192 + (mrow >> 11) * 2304 + 256 + (mrow & 2047); }
#pragma unroll
                    for (int bj = 0; bj < 2; ++bj) { const f32x4 v0 = acc[ai][bj][m][0], v1 = acc[ai][bj][m][1];
                        u32x4 w; w.x = cvt_pk_bf16(v0[0], v0[1]); w.y = cvt_pk_bf16(v0[2], v0[3]); w.z = cvt_pk_bf16(v1[0], v1[1]); w.w = cvt_pk_bf16(v1[2], v1[3]);
                        *(u32x4*)(base + (unsigned)(kidx * 512 + (u.pn * 2 + bj) * 64) + xo) = w; } }
        }
    }
};
}
__device__ __forceinline__ void phase_a2b(ArgsP a, LAS unsigned char* lds, int layer) {
    int kk = 256; asm volatile("" : "+s"(kk));
    pg8::Gemm g{nullptr, nullptr, T, 1024, kk, 512, 256};
    pg8::A2Order S{(const char*)a->ws, (unsigned)(WS_WUQ + (size_t)layer * 768 * 256 * 2), (unsigned)(WS_WUKV + (size_t)layer * 1024 * 256 * 2), grid_(), bid_()};
    pg8::EpiA2 E{(bf16*)(a->ws + WS_Q), (bf16*)(a->ws + WS_KN), (bf16*)(a->ws + WS_VT), (const float*)(a->ws + WS_ROPE)};
    pg8::gemm_phase<pg8::EpiA2, pg8::A2Order, false>(lds, g, S, E, nullptr);
}
__device__ __forceinline__ void rwkv_unit_seq(ArgsP a, LAS unsigned char* lds, int layer, int u) {
    const int tid = tid_();
    LAS float* W2s = (LAS float*)lds;
    LAS float* A2s = W2s + 4096;
    LAS float* TH = A2s + 4096;
    LAS float* HA = TH + 2048;
    LAS float* Wd = HA + 2048;
    LAS float* KT = Wd + 2048; LAS float* KK = KT + 2048; LAS float* BB = KK + 2048; LAS float* RR = BB + 2048; LAS float* VV = RR + 2048; LAS float* YO = VV + 2048;
    const int lat = u < 64, uu = lat ? u : u - 64, b = uu >> 3, e = (uu >> 2) & 1, hh = uu & 3;
    const int L = lat ? L_LAT : L_CTX, tok0 = lat ? T_CTX + b * L_LAT : b * L_CTX;
    const bf16* G1 = (const bf16*)(a->ws + WS_G1);
    bf16* YS = (bf16*)(a->ws + WS_G2);
    for (int i = tid; i < 4096; i += NTHREADS) { const int j = i >> 6, c = i & 63;
        W2s[i] = a->in[I_W2][((size_t)(layer * 2 + e) * 64 + j) * 256 + hh * 64 + c];
        A2s[i] = a->in[I_A2][((size_t)(layer * 2 + e) * 64 + j) * 256 + hh * 64 + c]; }
    const int r = tid >> 3, ks = tid & 7;
    float S[8];
#pragma unroll
    for (int j = 0; j < 8; ++j) S[j] = lat ? a->in[I_SRW][(((size_t)((b * 2 + layer) * 2 + e) * 4 + hh) * 64 + r) * 64 + ks * 8 + j] : 0.f;
    const int tt = tid >> 4, q4 = (tid & 15) * 4;
    float w0v[4], a0v[4], kkw[4], kav[4];
#pragma unroll
    for (int i = 0; i < 4; ++i) { const int ch = hh * 64 + q4 + i;
        w0v[i] = a->in[I_W0][(layer * 2 + e) * 256 + ch]; a0v[i] = a->in[I_A0][(layer * 2 + e) * 256 + ch]; kkw[i] = a->in[I_KK][layer * 256 + ch]; kav[i] = a->in[I_KA][layer * 256 + ch]; }
    __syncthreads();
    for (int c = 0; c < L / 32; ++c) {
        const int step = c * 32 + tt, t = e ? L - 1 - step : step, n = tok0 + t;
        const bf16* g = G1 + (size_t)n * G1W;
        { const v2u hw = *(const v2u*)(g + C_LORA + e * 64 + q4), ha = *(const v2u*)(g + C_LORA + 128 + e * 64 + q4);
          TH[tt * 64 + q4 + 0] = tanhf(bflo(hw.x)); TH[tt * 64 + q4 + 1] = tanhf(bfhi(hw.x)); TH[tt * 64 + q4 + 2] = tanhf(bflo(hw.y)); TH[tt * 64 + q4 + 3] = tanhf(bfhi(hw.y));
          HA[tt * 64 + q4 + 0] = bflo(ha.x); HA[tt * 64 + q4 + 1] = bfhi(ha.x); HA[tt * 64 + q4 + 2] = bflo(ha.y); HA[tt * 64 + q4 + 3] = bfhi(ha.y); }
        __syncthreads();
        {
            float wl[4], al[4];
#pragma unroll
            for (int i = 0; i < 4; ++i) { wl[i] = w0v[i]; al[i] = a0v[i]; }
            for (int j = 0; j < 64; ++j) { const float th = TH[tt * 64 + j], hv = HA[tt * 64 + j];
                const f32x4 w2 = *(const LAS f32x4*)(W2s + j * 64 + q4), a2 = *(const LAS f32x4*)(A2s + j * 64 + q4);
                wl[0] = fmaf(th, w2.x, wl[0]); wl[1] = fmaf(th, w2.y, wl[1]); wl[2] = fmaf(th, w2.z, wl[2]); wl[3] = fmaf(th, w2.w, wl[3]);
                al[0] = fmaf(hv, a2.x, al[0]); al[1] = fmaf(hv, a2.y, al[1]); al[2] = fmaf(hv, a2.z, al[2]); al[3] = fmaf(hv, a2.w, al[3]); }
            const v2u kv = *(const v2u*)(g + C_K + hh * 64 + q4), rv = *(const v2u*)(g + C_R + hh * 64 + q4), vv = *(const v2u*)(g + C_V + hh * 64 + q4);
            const float kx[4] = {bflo(kv.x), bfhi(kv.x), bflo(kv.y), bfhi(kv.y)}, rx[4] = {bflo(rv.x), bfhi(rv.x), bflo(rv.y), bfhi(rv.y)}, vx[4] = {bflo(vv.x), bfhi(vv.x), bflo(vv.y), bfhi(vv.y)};
            float kkr[4], ss = 0.f;
#pragma unroll
            for (int i = 0; i < 4; ++i) { kkr[i] = kx[i] * kkw[i]; ss += kkr[i] * kkr[i]; }
            ss += __shfl_xor(ss, 1); ss += __shfl_xor(ss, 2); ss += __shfl_xor(ss, 4); ss += __shfl_xor(ss, 8);
            const float inrm = rcp_(fmaxf(sqrt_(ss), 1e-12f));
#pragma unroll
            for (int i = 0; i < 4; ++i) {
                const float dec = exp_(-0.6065306597126334f * sigmoidf_(wl[i])), av = sigmoidf_(al[i]), kk = kkr[i] * inrm;
                const int o = tt * 64 + q4 + i;
                Wd[o] = dec; KT[o] = kx[i] * (1.f + (av - 1.f) * kav[i]); KK[o] = kk; BB[o] = kk * av; RR[o] = rx[i]; VV[o] = vx[i]; }
        }
        __syncthreads();
        for (int s = 0; s < 32; ++s) {
            const int o = s * 64 + ks * 8;
            const f32x4 k0 = *(const LAS f32x4*)(KK + o), k1 = *(const LAS f32x4*)(KK + o + 4);
            float p = S[0] * k0.x + S[1] * k0.y + S[2] * k0.z + S[3] * k0.w + S[4] * k1.x + S[5] * k1.y + S[6] * k1.z + S[7] * k1.w;
            p += __shfl_xor(p, 1); p += __shfl_xor(p, 2); p += __shfl_xor(p, 4);
            const float sa = -p, vv = VV[s * 64 + r];
            const f32x4 w0 = *(const LAS f32x4*)(Wd + o), w1 = *(const LAS f32x4*)(Wd + o + 4), b0 = *(const LAS f32x4*)(BB + o), b1 = *(const LAS f32x4*)(BB + o + 4);
            const f32x4 t0 = *(const LAS f32x4*)(KT + o), t1 = *(const LAS f32x4*)(KT + o + 4), r0 = *(const LAS f32x4*)(RR + o), r1 = *(const LAS f32x4*)(RR + o + 4);
            S[0] = S[0] * w0.x + sa * b0.x + vv * t0.x; S[1] = S[1] * w0.y + sa * b0.y + vv * t0.y; S[2] = S[2] * w0.z + sa * b0.z + vv * t0.z; S[3] = S[3] * w0.w + sa * b0.w + vv * t0.w;
            S[4] = S[4] * w1.x + sa * b1.x + vv * t1.x; S[5] = S[5] * w1.y + sa * b1.y + vv * t1.y; S[6] = S[6] * w1.z + sa * b1.z + vv * t1.z; S[7] = S[7] * w1.w + sa * b1.w + vv * t1.w;
            float y = S[0] * r0.x + S[1] * r0.y + S[2] * r0.z + S[3] * r0.w + S[4] * r1.x + S[5] * r1.y + S[6] * r1.z + S[7] * r1.w;
            y += __shfl_xor(y, 1); y += __shfl_xor(y, 2); y += __shfl_xor(y, 4);
            if (ks == 0) YO[s * 64 + r] = y;
        }
        __syncthreads();
        { v2u o; o.x = pk2(YO[tt * 64 + q4], YO[tt * 64 + q4 + 1]); o.y = pk2(YO[tt * 64 + q4 + 2], YO[tt * 64 + q4 + 3]);
          *(v2u*)(YS + ((size_t)e * T + n) * 256 + hh * 64 + q4) = o; }
        __syncthreads();
    }
    if (!lat) {
        float* dst = a->out + O_RW + (((size_t)((b * 2 + layer) * 2 + e) * 4 + hh) * 64 + r) * 64 + ks * 8;
        *(f32x4*)dst = (f32x4){S[0], S[1], S[2], S[3]}; *(f32x4*)(dst + 4) = (f32x4){S[4], S[5], S[6], S[7]};
    }
}

__device__ __forceinline__ void lru_unit_seq(ArgsP a, LAS unsigned char* lds, int layer, int u) {
    const int tid = tid_();
    LAS float* WA = (LAS float*)lds;
    LAS float* WX = WA + 4096;
    LAS float* XC = WX + 4096;
    LAS float* AA = XC + 4096; LAS float* BV = AA + 4096; LAS float* HH = BV + 4096;
    const int lat = u < 32, uu = lat ? u : u - 32, b = uu >> 2, g = uu & 3;
    const int L = lat ? L_LAT : L_CTX, tok0 = lat ? T_CTX + b * L_LAT : b * L_CTX;
    const bf16* G1 = (const bf16*)(a->ws + WS_G1);
    bf16* HF = (bf16*)(a->ws + WS_HF);
    const int tt = tid >> 3, q8 = (tid & 7) * 8;
    float cw[4][8], cb[8];
#pragma unroll
    for (int i = 0; i < 8; ++i) { const int ch = g * 64 + q8 + i; cb[i] = a->in[I_CONVB][layer * 256 + ch];
#pragma unroll
        for (int j = 0; j < 4; ++j) cw[j][i] = a->in[I_CONVW][(layer * 4 + j) * 256 + ch]; }
    for (int e = 0; e < 2; ++e) {
        __syncthreads();
        for (int i = tid; i < 4096; i += NTHREADS) { const size_t src = ((size_t)((layer * 2 + e) * 4 + g)) * 4096 + i; WA[i] = a->in[I_WA][src]; WX[i] = a->in[I_WX][src]; }
        float bav[8], bxv[8], spl[8];
#pragma unroll
        for (int i = 0; i < 8; ++i) { const int ch = (layer * 2 + e) * 256 + g * 64 + q8 + i; bav[i] = a->in[I_BA][ch]; bxv[i] = a->in[I_BX][ch]; spl[i] = log1pf(exp_(-a->in[I_LAMBDA][ch])); }
        float h = 0.f;
        if (tid < 64 && lat) h = a->in[I_SLRU][((size_t)(b * 2 + layer) * 2 + e) * 256 + g * 64 + tid];
        __syncthreads();
        for (int cc = 0; cc < L / 64; ++cc) {
            const int c = e ? L / 64 - 1 - cc : cc, t = c * 64 + tt, n = tok0 + t;
            {
                float xc[8];
#pragma unroll
                for (int i = 0; i < 8; ++i) xc[i] = cb[i];
#pragma unroll
                for (int j = 0; j < 4; ++j) { const int ts = t + j - 2;
                    if (ts >= 0 && ts < L) { const v4u x = *(const v4u*)(G1 + (size_t)(tok0 + ts) * G1W + C_XL + g * 64 + q8);
                        xc[0] += cw[j][0] * bflo(x.x); xc[1] += cw[j][1] * bfhi(x.x); xc[2] += cw[j][2] * bflo(x.y); xc[3] += cw[j][3] * bfhi(x.y);
                        xc[4] += cw[j][4] * bflo(x.z); xc[5] += cw[j][5] * bfhi(x.z); xc[6] += cw[j][6] * bflo(x.w); xc[7] += cw[j][7] * bfhi(x.w); } }
#pragma unroll
                for (int i = 0; i < 8; ++i) XC[tt * 64 + q8 + i] = xc[i];
            }
            __syncthreads();
            {
                float gr[8], gi[8];
#pragma unroll
                for (int i = 0; i < 8; ++i) { gr[i] = bav[i]; gi[i] = bxv[i]; }
                for (int i = 0; i < 64; ++i) { const float x = XC[tt * 64 + i];
                    const f32x4 a0 = *(const LAS f32x4*)(WA + i * 64 + q8), a1 = *(const LAS f32x4*)(WA + i * 64 + q8 + 4), x0 = *(const LAS f32x4*)(WX + i * 64 + q8), x1 = *(const LAS f32x4*)(WX + i * 64 + q8 + 4);
                    gr[0] = fmaf(x, a0.x, gr[0]); gr[1] = fmaf(x, a0.y, gr[1]); gr[2] = fmaf(x, a0.z, gr[2]); gr[3] = fmaf(x, a0.w, gr[3]);
                    gr[4] = fmaf(x, a1.x, gr[4]); gr[5] = fmaf(x, a1.y, gr[5]); gr[6] = fmaf(x, a1.z, gr[6]); gr[7] = fmaf(x, a1.w, gr[7]);
                    gi[0] = fmaf(x, x0.x, gi[0]); gi[1] = fmaf(x, x0.y, gi[1]); gi[2] = fmaf(x, x0.z, gi[2]); gi[3] = fmaf(x, x0.w, gi[3]);
                    gi[4] = fmaf(x, x1.x, gi[4]); gi[5] = fmaf(x, x1.y, gi[5]); gi[6] = fmaf(x, x1.z, gi[6]); gi[7] = fmaf(x, x1.w, gi[7]); }
#pragma unroll
                for (int i = 0; i < 8; ++i) { const float la = -8.f * sigmoidf_(gr[i]) * spl[i];
                    AA[tt * 64 + q8 + i] = exp_(la);
                    BV[tt * 64 + q8 + i] = sqrt_(-expm1f(2.f * la)) * sigmoidf_(gi[i]) * XC[tt * 64 + q8 + i]; }
            }
            __syncthreads();
            if (tid < 64) { for (int s = 0; s < 64; ++s) { const int st = e ? 63 - s : s; h = fmaf(AA[st * 64 + tid], h, BV[st * 64 + tid]); HH[st * 64 + tid] = h; } }
            __syncthreads();
            {
                bf16* dst = HF + (size_t)n * 256 + g * 64 + q8;
                float o[8];
#pragma unroll
                for (int i = 0; i < 8; ++i) o[i] = HH[tt * 64 + q8 + i];
                if (e) { const v4u hf = *(const v4u*)dst, gl = *(const v4u*)(G1 + (size_t)n * G1W + C_GL + g * 64 + q8);
                    o[0] = (o[0] + bflo(hf.x)) * siluf_(bflo(gl.x)); o[1] = (o[1] + bfhi(hf.x)) * siluf_(bfhi(gl.x)); o[2] = (o[2] + bflo(hf.y)) * siluf_(bflo(gl.y)); o[3] = (o[3] + bfhi(hf.y)) * siluf_(bfhi(gl.y));
                    o[4] = (o[4] + bflo(hf.z)) * siluf_(bflo(gl.z)); o[5] = (o[5] + bfhi(hf.z)) * siluf_(bfhi(gl.z)); o[6] = (o[6] + bflo(hf.w)) * siluf_(bflo(gl.w)); o[7] = (o[7] + bfhi(hf.w)) * siluf_(bfhi(gl.w)); }
                v4u ov; ov.x = pk2(o[0], o[1]); ov.y = pk2(o[2], o[3]); ov.z = pk2(o[4], o[5]); ov.w = pk2(o[6], o[7]);
                *(v4u*)dst = ov;
            }
            __syncthreads();
        }
        if (tid < 64 && !lat) a->out[O_LRU + ((size_t)(b * 2 + layer) * 2 + e) * 256 + g * 64 + tid] = h;
    }
}

__device__ __forceinline__ void phase_c1(ArgsP a, int layer) {
    const int tid = tid_(), lane = tid & 63, wave = tid >> 6, G = grid_();
    const bf16* G1 = (const bf16*)(a->ws + WS_G1); const bf16* YS = (const bf16*)(a->ws + WS_G2); const bf16* Q = (const bf16*)(a->ws + WS_Q); const bf16* HF = (const bf16*)(a->ws + WS_HF);
    bf16* Y = (bf16*)(a->ws + WS_YMIX);
    const int ch = lane * 4;
    const f32x4 rk = *(const f32x4*)(a->in[I_RK] + layer * 256 + ch), lg = *(const f32x4*)(a->in[I_LNXG] + layer * 256 + ch), lb = *(const f32x4*)(a->in[I_LNXB] + layer * 256 + ch);
    v2u p_y0, p_y1, p_r, p_k, p_v, p_g, p_h; v4u p_q;
#define C1_LOAD(nn) do { const bf16* g_ = G1 + (size_t)(nn) * G1W; p_y0 = *(const v2u*)(YS + (size_t)(nn) * 256 + ch); p_y1 = *(const v2u*)(YS + ((size_t)T + (nn)) * 256 + ch); \
        p_r = *(const v2u*)(g_ + C_R + ch); p_k = *(const v2u*)(g_ + C_K + ch); p_v = *(const v2u*)(g_ + C_V + ch); p_g = *(const v2u*)(g_ + C_G + ch); \
        p_q = *(const v4u*)(Q + (size_t)(nn) * 768 + (lane >> 3) * 96 + (lane & 7) * 8); p_h = *(const v2u*)(HF + (size_t)(nn) * 256 + ch); } while (0)
    { const int n0 = bid_() * 8 + wave; if (n0 < T) C1_LOAD(n0); }
    for (int n = bid_() * 8 + wave; n < T; n += G * 8) {
        const v2u y0 = p_y0, y1 = p_y1, rv = p_r, kv = p_k, vv = p_v, gv = p_g, hq = p_h; const v4u qq = p_q;
        if (n + G * 8 < T) C1_LOAD(n + G * 8);
        float y[4] = {bflo(y0.x) + bflo(y1.x), bfhi(y0.x) + bfhi(y1.x), bflo(y0.y) + bflo(y1.y), bfhi(y0.y) + bfhi(y1.y)};
        float s = (y[0] + y[1]) + (y[2] + y[3]);
        float bon = bflo(rv.x) * bflo(kv.x) * rk.x + bfhi(rv.x) * bfhi(kv.x) * rk.y + bflo(rv.y) * bflo(kv.y) * rk.z + bfhi(rv.y) * bfhi(kv.y) * rk.w;
#pragma unroll
        for (int o = 1; o < 16; o <<= 1) { s += __shfl_xor(s, o); bon += __shfl_xor(bon, o); }
        const float mu = s * (1.f / 64.f);
        float s2 = (y[0] - mu) * (y[0] - mu) + (y[1] - mu) * (y[1] - mu) + (y[2] - mu) * (y[2] - mu) + (y[3] - mu) * (y[3] - mu);
#pragma unroll
        for (int o = 1; o < 16; o <<= 1) s2 += __shfl_xor(s2, o);
        const float rstd = rsqrt_(s2 * (1.f / 64.f) + GN_EPS);
        const float o0 = ((y[0] - mu) * rstd * lg.x + lb.x + bon * bflo(vv.x)) * siluf_(bflo(gv.x));
        const float o1 = ((y[1] - mu) * rstd * lg.y + lb.y + bon * bfhi(vv.x)) * siluf_(bfhi(gv.x));
        const float o2 = ((y[2] - mu) * rstd * lg.z + lb.z + bon * bflo(vv.y)) * siluf_(bflo(gv.y));
        const float o3 = ((y[3] - mu) * rstd * lg.w + lb.w + bon * bfhi(vv.y)) * siluf_(bfhi(gv.y));
        v2u ov; ov.x = pk2(o0, o1); ov.y = pk2(o2, o3);
        bf16* yr = Y + (size_t)n * 1024;
        *(v2u*)(yr + ch) = ov;
        *(v4u*)(yr + 256 + (lane >> 3) * 64 + (lane & 7) * 8) = qq;
        *(v2u*)(yr + 768 + ch) = hq;
    }
#undef C1_LOAD
}
#define MFMA32(a, b, c) __builtin_amdgcn_mfma_f32_32x32x16_bf16((a), (b), (c), 0, 0, 0)
#define MFMA16(a, b, c) __builtin_amdgcn_mfma_f32_16x16x32_bf16((a), (b), (c), 0, 0, 0)

__device__ __forceinline__ float tanh_fast(float x) { return 1.f - 2.f * rcp_(1.f + exp_(2.f * x)); }

constexpr int ATT_KSTR = 208, ATT_VSTR = 136, ATT_VOFF = 64 * ATT_KSTR, ATT_STAGE = 64 * ATT_KSTR + 64 * ATT_VSTR;
__device__ __forceinline__ void att_unit(ArgsP a, LAS unsigned char* lds, int u) {
    const int tid = tid_(), lane = tid & 63, wave = tid >> 6, r = lane & 31, hq = lane >> 5;
    const bf16* KN = (const bf16*)(a->ws + WS_KN); const bf16* KR = (const bf16*)(a->ws + WS_KR); const bf16* VT = (const bf16*)(a->ws + WS_VT);
    bf16* Q = (bf16*)(a->ws + WS_Q); const bf16* G1 = (const bf16*)(a->ws + WS_G1);
    int b, h, n0, Lk, kidx0; size_t vbase;
    if (u < 512) { b = u >> 6; h = (u >> 3) & 7; n0 = T_CTX + b * 2048 + (u & 7) * 256; Lk = LK_LAT; kidx0 = T_CTX + b * LK_LAT; vbase = (size_t)VT_LAT + (size_t)(b * 8 + h) * 64 * LK_LAT; }
    else { const int uu = u - 512; b = uu >> 3; h = uu & 7; n0 = b * 256; Lk = 256; kidx0 = b * 256; vbase = (size_t)(b * 8 + h) * 64 * 256; }
    const int ntiles = Lk >> 6;
    const int n = n0 + wave * 32 + r;
    bf16x8 qf[6];
#pragma unroll
    for (int ks = 0; ks < 6; ++ks) qf[ks] = *(const bf16x8*)(Q + (size_t)n * 768 + h * 96 + ks * 16 + 8 * hq);
    const int key_k = tid >> 3, ck = tid & 7, key_r = (tid >> 2) & 63, cr = tid & 3;
    const bf16* gk = KN + (size_t)(kidx0 + key_k) * 512 + h * 64 + ck * 8;
    const bf16* gr = KR + (size_t)(kidx0 + key_r) * 32 + cr * 8;
    const bf16* gv = VT + vbase + (size_t)key_k * Lk + ck * 8;
    const unsigned sk = key_k * ATT_KSTR + ck * 16, sr = key_r * ATT_KSTR + 128 + cr * 16, sv = ATT_VOFF + key_k * ATT_VSTR + ck * 16;
    v4u rk, rr, rv;
    rk = *(const v4u*)gk; rr = (tid < 256) ? *(const v4u*)gr : (v4u){0u, 0u, 0u, 0u}; rv = *(const v4u*)gv;
    __syncthreads();
    *(LAS v4u*)(lds + sk) = rk; if (tid < 256) *(LAS v4u*)(lds + sr) = rr;
    *(LAS v2u*)(lds + sv) = (v2u){rv.x, rv.y}; *(LAS v2u*)(lds + sv + 8) = (v2u){rv.z, rv.w};
    __syncthreads();
    f32x16 o0, o1;
#pragma unroll
    for (int i = 0; i < 16; ++i) { o0[i] = 0.f; o1[i] = 0.f; }
    float m = -1e30f, l = 0.f;
    for (int j = 0; j < ntiles; ++j) {
        const int buf = j & 1;
        if (j + 1 < ntiles) { rk = *(const v4u*)(gk + (size_t)(j + 1) * 64 * 512); if (tid < 256) rr = *(const v4u*)(gr + (size_t)(j + 1) * 64 * 32); rv = *(const v4u*)(gv + (j + 1) * 64); }
        const LAS unsigned char* Kb = lds + buf * ATT_STAGE;
        f32x16 s0, s1;
#pragma unroll
        for (int i = 0; i < 16; ++i) { s0[i] = 0.f; s1[i] = 0.f; }
#pragma unroll
        for (int ks = 0; ks < 6; ++ks) {
            const bf16x8 a0 = *(const LAS bf16x8*)(Kb + r * ATT_KSTR + ks * 32 + hq * 16), a1 = *(const LAS bf16x8*)(Kb + (32 + r) * ATT_KSTR + ks * 32 + hq * 16);
            s0 = MFMA32(a0, qf[ks], s0); s1 = MFMA32(a1, qf[ks], s1);
        }
        float mx = s0[0];
#pragma unroll
        for (int i = 1; i < 16; ++i) mx = fmaxf(mx, s0[i]);
#pragma unroll
        for (int i = 0; i < 16; ++i) mx = fmaxf(mx, s1[i]);
        mx = fmaxf(mx, __shfl_xor(mx, 32));
        const float mn = fmaxf(m, mx), alpha = __builtin_amdgcn_exp2f(m - mn); m = mn;
        float ps = 0.f;
#pragma unroll
        for (int i = 0; i < 16; ++i) { s0[i] = __builtin_amdgcn_exp2f(s0[i] - mn); s1[i] = __builtin_amdgcn_exp2f(s1[i] - mn); ps += s0[i] + s1[i]; }
        l = l * alpha + ps;
#pragma unroll
        for (int i = 0; i < 16; ++i) { o0[i] *= alpha; o1[i] *= alpha; }
        const LAS unsigned char* Vb = Kb + ATT_VOFF;
#pragma unroll
        for (int ks = 0; ks < 4; ++ks) {
            v4u pw;
            if (ks == 0) { pw.x = cvtpk(s0[0], s0[1]); pw.y = cvtpk(s0[2], s0[3]); pw.z = cvtpk(s0[4], s0[5]); pw.w = cvtpk(s0[6], s0[7]); }
            else if (ks == 1) { pw.x = cvtpk(s0[8], s0[9]); pw.y = cvtpk(s0[10], s0[11]); pw.z = cvtpk(s0[12], s0[13]); pw.w = cvtpk(s0[14], s0[15]); }
            else if (ks == 2) { pw.x = cvtpk(s1[0], s1[1]); pw.y = cvtpk(s1[2], s1[3]); pw.z = cvtpk(s1[4], s1[5]); pw.w = cvtpk(s1[6], s1[7]); }
            else { pw.x = cvtpk(s1[8], s1[9]); pw.y = cvtpk(s1[10], s1[11]); pw.z = cvtpk(s1[12], s1[13]); pw.w = cvtpk(s1[14], s1[15]); }
            const bf16x8 pf = __builtin_bit_cast(bf16x8, pw);
            const v2u va0 = *(const LAS v2u*)(Vb + r * ATT_VSTR + ks * 32 + hq * 8), va1 = *(const LAS v2u*)(Vb + r * ATT_VSTR + ks * 32 + 16 + hq * 8);
            const v2u vb0 = *(const LAS v2u*)(Vb + (32 + r) * ATT_VSTR + ks * 32 + hq * 8), vb1 = *(const LAS v2u*)(Vb + (32 + r) * ATT_VSTR + ks * 32 + 16 + hq * 8);
            const v4u vwa = {va0.x, va0.y, va1.x, va1.y}, vwb = {vb0.x, vb0.y, vb1.x, vb1.y};
            o0 = MFMA32(__builtin_bit_cast(bf16x8, vwa), pf, o0); o1 = MFMA32(__builtin_bit_cast(bf16x8, vwb), pf, o1);
        }
        if (j + 1 < ntiles) {
            LAS unsigned char* Nb = lds + (buf ^ 1) * ATT_STAGE;
            *(LAS v4u*)(Nb + sk) = rk; if (tid < 256) *(LAS v4u*)(Nb + sr) = rr;
            *(LAS v2u*)(Nb + sv) = (v2u){rv.x, rv.y}; *(LAS v2u*)(Nb + sv + 8) = (v2u){rv.z, rv.w};
        }
        __syncthreads();
    }
    l += __shfl_xor(l, 32);
    const float inv = rcp_(l);
#pragma unroll
    for (int mt = 0; mt < 2; ++mt)
#pragma unroll
        for (int g = 0; g < 4; ++g) {
            const int dv0 = 32 * mt + 8 * g + 4 * hq;
            const v2u gm = *(const v2u*)(G1 + (size_t)n * G1W + C_GM + h * 64 + dv0);
            const float x0 = (mt ? o1[4 * g + 0] : o0[4 * g + 0]) * inv, x1 = (mt ? o1[4 * g + 1] : o0[4 * g + 1]) * inv, x2 = (mt ? o1[4 * g + 2] : o0[4 * g + 2]) * inv, x3 = (mt ? o1[4 * g + 3] : o0[4 * g + 3]) * inv;
            v2u ov; ov.x = cvtpk(x0 * siluf_(bflo(gm.x)), x1 * siluf_(bfhi(gm.x))); ov.y = cvtpk(x2 * siluf_(bflo(gm.y)), x3 * siluf_(bfhi(gm.y)));
            *(v2u*)(Q + (size_t)n * 768 + h * 96 + dv0) = ov;
        }
}

constexpr int A2_QSTR = 528, A2_KVSTR = 272, A2_KVOFF = 64 * A2_QSTR;
__device__ __forceinline__ void a2_unit(ArgsP a, LAS unsigned char* lds, int layer, int unit) {
    const int tid = tid_(), lane = tid & 63, wave = tid >> 6, tn = lane & 15, g = lane >> 4;
    constexpr int NU_TOK = T / 64;
    const bool is_tok = unit < NU_TOK;
    const bf16* G2 = (const bf16*)(a->ws + WS_G2);
    bf16* Q = (bf16*)(a->ws + WS_Q); bf16* KN = (bf16*)(a->ws + WS_KN); bf16* KR = (bf16*)(a->ws + WS_KR); bf16* VT = (bf16*)(a->ws + WS_VT);
    const bf16* WUQ = (const bf16*)(a->ws + WS_WUQ) + (size_t)layer * 768 * 256;
    const bf16* WUKV = (const bf16*)(a->ws + WS_WUKV) + (size_t)layer * 1024 * 128;
    const float* ROPE1 = (const float*)(a->ws + WS_ROPE);
    __syncthreads();
    v2u cq8[8], kv8[8]; unsigned kr8[8];
    if (is_tok) {
#pragma unroll
        for (int rr = 0; rr < 8; ++rr) { const size_t n_ = (size_t)(unit * 64 + wave * 8 + rr);
            cq8[rr] = *(const v2u*)(G2 + n_ * G2W + lane * 4); kv8[rr] = *(const v2u*)(G2 + n_ * G2W + 256 + (lane & 31) * 4); kr8[rr] = G2[n_ * G2W + 384 + (lane & 31)]; }
    }
#pragma unroll
    for (int rr = 0; rr < 8; ++rr) {
        const int r = wave * 8 + rr;
        if (is_tok) {
            const int n = unit * 64 + r; const Tok tk = tok_of(n);
            const v2u cqv = cq8[rr];
            const float c0 = bflo(cqv.x), c1 = bfhi(cqv.x), c2 = bflo(cqv.y), c3 = bfhi(cqv.y);
            const float rq = rsqrt_(wave_sum(c0 * c0 + c1 * c1 + c2 * c2 + c3 * c3) * (1.f / 256.f) + 1e-6f);
            const f32x4 qn = *(const f32x4*)(a->in[I_QNORM] + layer * 256 + lane * 4);
            *(LAS v2u*)(lds + r * A2_QSTR + lane * 8) = (v2u){cvtpk(c0 * rq * qn.x, c1 * rq * qn.y), cvtpk(c2 * rq * qn.z, c3 * rq * qn.w)};
            float k0 = 0.f, k1 = 0.f, k2 = 0.f, k3 = 0.f;
            if (lane < 32) { const v2u kv = kv8[rr]; k0 = bflo(kv.x); k1 = bfhi(kv.x); k2 = bflo(kv.y); k3 = bfhi(kv.y); }
            const float rk = rsqrt_(wave_sum(k0 * k0 + k1 * k1 + k2 * k2 + k3 * k3) * (1.f / 128.f) + 1e-6f);
            if (lane < 32) {
                const f32x4 kn = *(const f32x4*)(a->in[I_KVNORM] + layer * 128 + lane * 4);
                f32x4 o; o.x = k0 * rk * kn.x; o.y = k1 * rk * kn.y; o.z = k2 * rk * kn.z; o.w = k3 * rk * kn.w;
                if (!tk.lat) *(f32x4*)(a->out + O_CKV + ((size_t)(tk.b * 2 + layer) * 256 + tk.t) * 128 + lane * 4) = o;
                *(LAS v2u*)(lds + A2_KVOFF + r * A2_KVSTR + lane * 8) = (v2u){cvtpk(o.x, o.y), cvtpk(o.z, o.w)};
            }
            float krv = (lane < 32) ? bf2f(kr8[rr]) : 0.f;
            const float other = __shfl_xor(krv, 1);
            if (lane < 32) {
                if (!tk.lat) a->out[O_KR + ((size_t)(tk.b * 2 + layer) * 256 + tk.t) * 32 + lane] = krv;
                else { const float c = ROPE1[((size_t)tk.t * 16 + (lane >> 1)) * 2], s = ROPE1[((size_t)tk.t * 16 + (lane >> 1)) * 2 + 1]; krv = (lane & 1) ? (other * s + krv * c) : (krv * c - other * s); }
                KR[(size_t)tk.kidx * 32 + lane] = (bf16)f2bf(krv);
            }
        } else {
            const int cr = (unit - NU_TOK) * 64 + r, b = cr >> 8, j = cr & 255;
            const size_t src = ((size_t)(b * 2 + layer) * 256 + j);
            if (lane < 32) { const f32x4 v = *(const f32x4*)(a->in[I_CCKV] + src * 128 + lane * 4);
                *(LAS v2u*)(lds + A2_KVOFF + r * A2_KVSTR + lane * 8) = (v2u){cvtpk(v.x, v.y), cvtpk(v.z, v.w)};
                KR[(size_t)(T_CTX + b * LK_LAT + j) * 32 + lane] = (bf16)f2bf(a->in[I_CKR][src * 32 + lane]); }
        }
    }
    __syncthreads();
    constexpr int A2_STG = 52224, A2_SQSTR = 784, A2_SKSTR = 1040, A2_SVSTR = 144;
    const int n0 = is_tok ? unit * 64 : 0;
    if (is_tok) {
      const float* ROPE = (const float*)(a->ws + WS_ROPE);
      for (int qh = 0; qh < 2; ++qh) {
        f32x4 acc[3][4];
#pragma unroll
        for (int f = 0; f < 3; ++f)
#pragma unroll
            for (int t = 0; t < 4; ++t) acc[f][t] = (f32x4){0.f, 0.f, 0.f, 0.f};
        bf16x8 afq[3][8];
        const bf16* wq = WUQ + (size_t)((qh * 24 + wave * 3) * 16 + tn) * 256 + g * 8;
#pragma unroll
        for (int f = 0; f < 3; ++f)
#pragma unroll
            for (int ks = 0; ks < 8; ++ks) afq[f][ks] = *(const bf16x8*)(wq + f * 16 * 256 + ks * 32);
#pragma unroll
        for (int ks = 0; ks < 8; ++ks) {
            bf16x8 bfr[4];
#pragma unroll
            for (int t = 0; t < 4; ++t) bfr[t] = *(const LAS bf16x8*)(lds + (t * 16 + tn) * A2_QSTR + ks * 64 + g * 16);
#pragma unroll
            for (int f = 0; f < 3; ++f)
#pragma unroll
                for (int t = 0; t < 4; ++t) acc[f][t] = MFMA16(afq[f][ks], bfr[t], acc[f][t]);
        }
#pragma unroll
        for (int f = 0; f < 3; ++f) { const int fl = (wave * 3 + f) * 16 + 4 * g, f0 = qh * 384 + fl, d = f0 % 96;
#pragma unroll
            for (int t = 0; t < 4; ++t) { const int r = t * 16 + tn, n = n0 + r;
                float v0 = acc[f][t][0], v1 = acc[f][t][1], v2 = acc[f][t][2], v3 = acc[f][t][3];
                if (n >= T_CTX && d >= 64) { const int tt = (n - T_CTX) & 2047; const f32x4 cs = *(const f32x4*)(ROPE + ((size_t)tt * 16 + ((d - 64) >> 1)) * 2);
                    const float y0 = v0 * cs.x - v1 * cs.y, y1 = v0 * cs.y + v1 * cs.x, y2 = v2 * cs.z - v3 * cs.w, y3 = v2 * cs.w + v3 * cs.z; v0 = y0; v1 = y1; v2 = y2; v3 = y3; }
                *(LAS v2u*)(lds + A2_STG + r * A2_SQSTR + fl * 2) = (v2u){cvtpk(v0, v1), cvtpk(v2, v3)}; } }
        __syncthreads();
#pragma unroll
        for (int i = 0; i < 6; ++i) { const int c = tid + 512 * i, row = c / 48, c16 = c % 48;
            *(v4u*)(Q + (size_t)(n0 + row) * 768 + qh * 384 + c16 * 8) = *(const LAS v4u*)(lds + A2_STG + row * A2_SQSTR + c16 * 16); }
        __syncthreads();
      }
    }
    int kidx0, latu, bu, kpos0;
    if (is_tok) { const Tok tk = tok_of(n0); kidx0 = tk.kidx; latu = tk.lat; bu = tk.b; kpos0 = tk.lat ? PAST + tk.t : tk.t; }
    else { const int cr = (unit - NU_TOK) * 64; bu = cr >> 8; kpos0 = cr & 255; latu = 1; kidx0 = T_CTX + bu * LK_LAT + kpos0; }
    for (int half = 0; half < 2; ++half) {
        f32x4 acc[4][4];
#pragma unroll
        for (int f = 0; f < 4; ++f)
#pragma unroll
            for (int t = 0; t < 4; ++t) acc[f][t] = (f32x4){0.f, 0.f, 0.f, 0.f};
        bf16x8 afk[4][4];
        const bf16* wk = WUKV + (size_t)(wave * 128 + half * 64 + tn) * 128 + g * 8;
#pragma unroll
        for (int f = 0; f < 4; ++f)
#pragma unroll
            for (int ks = 0; ks < 4; ++ks) afk[f][ks] = *(const bf16x8*)(wk + f * 16 * 128 + ks * 32);
#pragma unroll
        for (int ks = 0; ks < 4; ++ks) {
            bf16x8 bfr[4];
#pragma unroll
            for (int t = 0; t < 4; ++t) bfr[t] = *(const LAS bf16x8*)(lds + A2_KVOFF + (t * 16 + tn) * A2_KVSTR + ks * 64 + g * 16);
#pragma unroll
            for (int f = 0; f < 4; ++f)
#pragma unroll
                for (int t = 0; t < 4; ++t) acc[f][t] = MFMA16(afk[f][ks], bfr[t], acc[f][t]);
        }
#pragma unroll
        for (int f = 0; f < 4; ++f) { const int x = wave * 64 + f * 16 + 4 * g;
#pragma unroll
            for (int t = 0; t < 4; ++t) { const int r = t * 16 + tn;
                if (half == 0) *(LAS v2u*)(lds + A2_STG + r * A2_SKSTR + x * 2) = (v2u){cvtpk(acc[f][t][0], acc[f][t][1]), cvtpk(acc[f][t][2], acc[f][t][3])};
                else { const unsigned p01 = cvtpk(acc[f][t][0], acc[f][t][1]), p23 = cvtpk(acc[f][t][2], acc[f][t][3]);
                    *(LAS bf16*)(lds + A2_STG + (x + 0) * A2_SVSTR + r * 2) = (bf16)(p01 & 0xffffu); *(LAS bf16*)(lds + A2_STG + (x + 1) * A2_SVSTR + r * 2) = (bf16)(p01 >> 16);
                    *(LAS bf16*)(lds + A2_STG + (x + 2) * A2_SVSTR + r * 2) = (bf16)(p23 & 0xffffu); *(LAS bf16*)(lds + A2_STG + (x + 3) * A2_SVSTR + r * 2) = (bf16)(p23 >> 16); } } }
        __syncthreads();
        if (half == 0) {
#pragma unroll
            for (int i = 0; i < 8; ++i) { const int c = tid + 512 * i, row = c >> 6, c16 = c & 63;
                *(v4u*)(KN + (size_t)(kidx0 + row) * 512 + c16 * 8) = *(const LAS v4u*)(lds + A2_STG + row * A2_SKSTR + c16 * 16); }
        } else {
            const int Lk = latu ? LK_LAT : 256;
#pragma unroll
            for (int i = 0; i < 8; ++i) { const int c = tid + 512 * i, row = c >> 3, part = c & 7, h = row >> 6, dv = row & 63;
                const size_t base = latu ? (size_t)VT_LAT + ((size_t)(bu * 8 + h) * 64 + dv) * LK_LAT : ((size_t)(bu * 8 + h) * 64 + dv) * 256;
                *(v4u*)(VT + base + kpos0 + part * 8) = *(const LAS v4u*)(lds + A2_STG + row * A2_SVSTR + part * 16); }
            (void)Lk;
        }
        __syncthreads();
    }
}

constexpr int RW_W2T = 0, RW_A2T = 9216, RW_TH = 18432, RW_HA = 27648, RW_CH0 = 36864, RW_CHB = 20992, RW_YB = 120832;
constexpr int RC_KP = 0, RC_RP = 2304, RC_BP = 4608, RC_KT = 6912, RC_KTT = 9216, RC_NBPT = 11776, RC_VTT = 14336, RC_LK = 16896, RC_TM = 17536, RC_ARK = 18176, RC_NARB = 18816, RC_G15 = 19456, RC_LBF = 19712, RC_SSQ = 20736;
__device__ __forceinline__ void rwkv_unit_mfma(ArgsP a, LAS unsigned char* lds, int layer, int u) {
    const int tid = tid_(), lane = tid & 63, wave = tid >> 6, i16 = lane & 15, g = lane >> 4;
    const int lat = u < 64, uu = lat ? u : u - 64, b = uu >> 3, e = (uu >> 2) & 1, hh = uu & 3;
    const int L = lat ? L_LAT : L_CTX, tok0 = lat ? T_CTX + b * L_LAT : b * L_CTX;
    const bf16* G1 = (const bf16*)(a->ws + WS_G1);
    bf16* YS = (bf16*)(a->ws + WS_G2);
    __syncthreads();
    for (int i = tid; i < 4096; i += NTHREADS) { const int j = i >> 6, c = i & 63;
        *(LAS bf16*)(lds + RW_W2T + (c * 72 + j) * 2) = (bf16)f2bf(a->in[I_W2][((size_t)(layer * 2 + e) * 64 + j) * 256 + hh * 64 + c]);
        *(LAS bf16*)(lds + RW_A2T + (c * 72 + j) * 2) = (bf16)f2bf(a->in[I_A2][((size_t)(layer * 2 + e) * 64 + j) * 256 + hh * 64 + c]); }
    const int st_tok = tid >> 3, st_c8 = (tid & 7) * 8;
#define RW_STAGE(sc) do { const int step_ = (sc) * 64 + st_tok, t_ = e ? L - 1 - step_ : step_; const bf16* gp_ = G1 + (size_t)(tok0 + t_) * G1W + C_LORA + e * 64 + st_c8; \
        const v4u hw_ = *(const v4u*)gp_, ha_ = *(const v4u*)(gp_ + 128); v4u th_; \
        th_.x = cvtpk(tanh_fast(bflo(hw_.x)), tanh_fast(bfhi(hw_.x))); th_.y = cvtpk(tanh_fast(bflo(hw_.y)), tanh_fast(bfhi(hw_.y))); th_.z = cvtpk(tanh_fast(bflo(hw_.z)), tanh_fast(bfhi(hw_.z))); th_.w = cvtpk(tanh_fast(bflo(hw_.w)), tanh_fast(bfhi(hw_.w))); \
        *(LAS v4u*)(lds + RW_TH + st_tok * 144 + st_c8 * 2) = th_; *(LAS v4u*)(lds + RW_HA + st_tok * 144 + st_c8 * 2) = ha_; } while (0)
    RW_STAGE(0);
    f32x4 ST[4];
    {
        const int v = 16 * (wave & 3) + i16;
#pragma unroll
        for (int kt = 0; kt < 4; ++kt) ST[kt] = lat ? *(const f32x4*)(a->in[I_SRW] + (((size_t)((b * 2 + layer) * 2 + e) * 4 + hh) * 64 + v) * 64 + 16 * kt + 4 * g) : (f32x4){0.f, 0.f, 0.f, 0.f};
    }
    const int pc = wave & 3, ph = wave >> 2;
    LAS unsigned char* CH = lds + RW_CH0 + pc * RW_CHB;
    __syncthreads();
    const int nsc = L >> 6;
    v2u pk[2], pr[2], pv[2];
#define RW_PREFETCH(sc) do { const int ps_ = (sc) * 64 + pc * 16 + i16, pt_ = e ? L - 1 - ps_ : ps_; const bf16* gq_ = G1 + (size_t)(tok0 + pt_) * G1W + hh * 64 + (2 * ph) * 16 + 4 * g; \
        pk[0] = *(const v2u*)(gq_ + C_K); pk[1] = *(const v2u*)(gq_ + C_K + 16); pr[0] = *(const v2u*)(gq_ + C_R); pr[1] = *(const v2u*)(gq_ + C_R + 16); pv[0] = *(const v2u*)(gq_ + C_V); pv[1] = *(const v2u*)(gq_ + C_V + 16); } while (0)
    RW_PREFETCH(0);
    for (int sc = 0; sc < nsc; ++sc) {
        const v2u ck[2] = {pk[0], pk[1]}, cr[2] = {pr[0], pr[1]}, cv[2] = {pv[0], pv[1]};
        if (sc + 1 < nsc) RW_PREFETCH(sc + 1);
        float dec[8], av[8], kx[8], rx[8], kk[8];
        {
            f32x4 aw[2], aa[2];
#pragma unroll
            for (int c2 = 0; c2 < 2; ++c2) { aw[c2] = (f32x4){0.f, 0.f, 0.f, 0.f}; aa[c2] = (f32x4){0.f, 0.f, 0.f, 0.f}; }
#pragma unroll
            for (int ks = 0; ks < 2; ++ks) {
                const bf16x8 bth = *(const LAS bf16x8*)(lds + RW_TH + (pc * 16 + i16) * 144 + ks * 64 + g * 16), bha = *(const LAS bf16x8*)(lds + RW_HA + (pc * 16 + i16) * 144 + ks * 64 + g * 16);
#pragma unroll
                for (int c2 = 0; c2 < 2; ++c2) { const int row = (2 * ph + c2) * 16 + i16;
                    const bf16x8 w2f = *(const LAS bf16x8*)(lds + RW_W2T + row * 144 + ks * 64 + g * 16), a2f = *(const LAS bf16x8*)(lds + RW_A2T + row * 144 + ks * 64 + g * 16);
                    aw[c2] = MFMA16(w2f, bth, aw[c2]); aa[c2] = MFMA16(a2f, bha, aa[c2]); }
            }
            float ss = 0.f;
#pragma unroll
            for (int c2 = 0; c2 < 2; ++c2) { const int ch = (2 * ph + c2) * 16 + 4 * g, gch = hh * 64 + ch;
                const f32x4 w0 = *(const f32x4*)(a->in[I_W0] + (layer * 2 + e) * 256 + gch), a0 = *(const f32x4*)(a->in[I_A0] + (layer * 2 + e) * 256 + gch), kw = *(const f32x4*)(a->in[I_KK] + layer * 256 + gch);
                const v2u kv = ck[c2], rv = cr[c2];
                const float kq[4] = {bflo(kv.x), bfhi(kv.x), bflo(kv.y), bfhi(kv.y)}, rq[4] = {bflo(rv.x), bfhi(rv.x), bflo(rv.y), bfhi(rv.y)};
#pragma unroll
                for (int q = 0; q < 4; ++q) { const int o = c2 * 4 + q;
                    dec[o] = exp_(-0.6065306597126334f * sigmoidf_(aw[c2][q] + w0[q])); av[o] = sigmoidf_(aa[c2][q] + a0[q]);
                    kx[o] = kq[q]; rx[o] = rq[q]; kk[o] = kq[q] * kw[q]; ss += kk[o] * kk[o]; }
            }
            ss += __shfl_xor(ss, 16); ss += __shfl_xor(ss, 32);
            if (g == 0) *(LAS float*)(CH + RC_SSQ + (i16 * 2 + ph) * 4) = ss;
        }
        __syncthreads();
        {
            const float tot = *(const LAS float*)(CH + RC_SSQ + (i16 * 2) * 4) + *(const LAS float*)(CH + RC_SSQ + (i16 * 2 + 1) * 4);
            const float inrm = rcp_(fmaxf(sqrt_(tot), 1e-12f));
            float G8[8], Gx8[8];
#pragma unroll
            for (int o8 = 0; o8 < 8; ++o8) G8[o8] = dec[o8];
#pragma unroll
            for (int o8 = 0; o8 < 8; ++o8) G8[o8] *= dpp_f<0x111>(1.f, G8[o8]);
#pragma unroll
            for (int o8 = 0; o8 < 8; ++o8) G8[o8] *= dpp_f<0x112>(1.f, G8[o8]);
#pragma unroll
            for (int o8 = 0; o8 < 8; ++o8) G8[o8] *= dpp_f<0x114>(1.f, G8[o8]);
#pragma unroll
            for (int o8 = 0; o8 < 8; ++o8) G8[o8] *= dpp_f<0x118>(1.f, G8[o8]);
#pragma unroll
            for (int o8 = 0; o8 < 8; ++o8) Gx8[o8] = dpp_f<0x111>(1.f, G8[o8]);
#pragma unroll
            for (int c2 = 0; c2 < 2; ++c2) { const int ch = (2 * ph + c2) * 16 + 4 * g, gch = hh * 64 + ch;
                const f32x4 ka = *(const f32x4*)(a->in[I_KA] + layer * 256 + gch);
                float kp[4], bp[4], kt[4], rp[4];
#pragma unroll
                for (int q = 0; q < 4; ++q) { const int o = c2 * 4 + q;
                    const float G = G8[o], Gex = Gx8[o];
                    const float kkn = kk[o] * inrm, iG = rcp_(G);
                    kp[q] = Gex * kkn; bp[q] = kkn * av[o] * iG; kt[q] = kx[o] * (1.f + (av[o] - 1.f) * ka[q]) * iG; rp[q] = G * rx[o];
                    if (i16 == 15) *(LAS float*)(CH + RC_G15 + (ch + q) * 4) = G;
                    { const unsigned pk_ = cvtpk(kt[q], -bp[q]); *(LAS bf16*)(CH + RC_KTT + (ch + q) * 40 + i16 * 2) = (bf16)(pk_ & 0xffffu); *(LAS bf16*)(CH + RC_NBPT + (ch + q) * 40 + i16 * 2) = (bf16)(pk_ >> 16); } }
                *(LAS v2u*)(CH + RC_KP + i16 * 144 + ch * 2) = (v2u){cvtpk(kp[0], kp[1]), cvtpk(kp[2], kp[3])};
                *(LAS v2u*)(CH + RC_BP + i16 * 144 + ch * 2) = (v2u){cvtpk(bp[0], bp[1]), cvtpk(bp[2], bp[3])};
                *(LAS v2u*)(CH + RC_KT + i16 * 144 + ch * 2) = (v2u){cvtpk(kt[0], kt[1]), cvtpk(kt[2], kt[3])};
                *(LAS v2u*)(CH + RC_RP + i16 * 144 + ch * 2) = (v2u){cvtpk(rp[0], rp[1]), cvtpk(rp[2], rp[3])};
                const v2u vv = cv[c2];
                *(LAS bf16*)(CH + RC_VTT + (ch + 0) * 40 + i16 * 2) = (bf16)(vv.x & 0xffffu); *(LAS bf16*)(CH + RC_VTT + (ch + 1) * 40 + i16 * 2) = (bf16)(vv.x >> 16);
                *(LAS bf16*)(CH + RC_VTT + (ch + 2) * 40 + i16 * 2) = (bf16)(vv.y & 0xffffu); *(LAS bf16*)(CH + RC_VTT + (ch + 3) * 40 + i16 * 2) = (bf16)(vv.y >> 16);
            }
        }
        __syncthreads();
        {
            f32x4 d0 = (f32x4){0.f, 0.f, 0.f, 0.f}, d1 = (f32x4){0.f, 0.f, 0.f, 0.f};
            const int xoff = ph ? RC_KP : RC_RP, y0off = ph ? RC_BP : RC_KT, y1off = ph ? RC_KT : RC_BP;
#pragma unroll
            for (int ks = 0; ks < 2; ++ks) {
                const bf16x8 xf = *(const LAS bf16x8*)(CH + xoff + i16 * 144 + ks * 64 + g * 16);
                const bf16x8 y0 = *(const LAS bf16x8*)(CH + y0off + i16 * 144 + ks * 64 + g * 16), y1 = *(const LAS bf16x8*)(CH + y1off + i16 * 144 + ks * 64 + g * 16);
                d0 = MFMA16(xf, y0, d0); d1 = MFMA16(xf, y1, d1);
            }
#pragma unroll
            for (int q = 0; q < 4; ++q) { const int i = 4 * g + q, j = i16;
                if (ph) { *(LAS float*)(CH + RC_LBF + (i * 16 + j) * 4) = (j < i) ? d0[q] : 0.f; *(LAS bf16*)(CH + RC_LK + i * 40 + j * 2) = (bf16)(cvtpk((j < i) ? d1[q] : 0.f, 0.f) & 0xffffu); }
                else { const unsigned pk_ = cvtpk((j <= i) ? d0[q] : 0.f, (j <= i) ? -d1[q] : 0.f); *(LAS bf16*)(CH + RC_ARK + i * 40 + j * 2) = (bf16)(pk_ & 0xffffu); *(LAS bf16*)(CH + RC_NARB + i * 40 + j * 2) = (bf16)(pk_ >> 16); }
            }
            if (ph) {
                float x[16];
#pragma unroll
                for (int i = 0; i < 16; ++i) { float s = (i == i16) ? 1.f : 0.f;
#pragma unroll
                    for (int j4 = 0; j4 < (i + 3) / 4; ++j4) { const f32x4 lr = *(const LAS f32x4*)(CH + RC_LBF + (i * 16 + j4 * 4) * 4);
#pragma unroll
                        for (int jj = 0; jj < 4; ++jj) { const int j = j4 * 4 + jj; if (j < i) s -= lr[jj] * x[j]; } }
                    x[i] = s; }
                if (g == 0) {
#pragma unroll
                    for (int i = 0; i < 16; i += 2) { const unsigned pk_ = cvtpk(x[i], x[i + 1]); *(LAS bf16*)(CH + RC_TM + i * 40 + i16 * 2) = (bf16)(pk_ & 0xffffu); *(LAS bf16*)(CH + RC_TM + (i + 1) * 40 + i16 * 2) = (bf16)(pk_ >> 16); } }
            }
        }
        __syncthreads();
        if (wave < 4) {
            const int vt = wave;
#pragma unroll 1
            for (int c = 0; c < 4; ++c) {
                const LAS unsigned char* C = lds + RW_CH0 + c * RW_CHB;
                v4u sb01, sb23;
                sb01.x = cvtpk(ST[0][0], ST[0][1]); sb01.y = cvtpk(ST[0][2], ST[0][3]); sb01.z = cvtpk(ST[1][0], ST[1][1]); sb01.w = cvtpk(ST[1][2], ST[1][3]);
                sb23.x = cvtpk(ST[2][0], ST[2][1]); sb23.y = cvtpk(ST[2][2], ST[2][3]); sb23.z = cvtpk(ST[3][0], ST[3][1]); sb23.w = cvtpk(ST[3][2], ST[3][3]);
                const bf16x8 s01 = __builtin_bit_cast(bf16x8, sb01), s23 = __builtin_bit_cast(bf16x8, sb23);
                const v2u kp0a = *(const LAS v2u*)(C + RC_KP + i16 * 144 + (4 * g) * 2), kp0b = *(const LAS v2u*)(C + RC_KP + i16 * 144 + (16 + 4 * g) * 2);
                const v2u kp1a = *(const LAS v2u*)(C + RC_KP + i16 * 144 + (32 + 4 * g) * 2), kp1b = *(const LAS v2u*)(C + RC_KP + i16 * 144 + (48 + 4 * g) * 2);
                const v2u rp0a = *(const LAS v2u*)(C + RC_RP + i16 * 144 + (4 * g) * 2), rp0b = *(const LAS v2u*)(C + RC_RP + i16 * 144 + (16 + 4 * g) * 2);
                const v2u rp1a = *(const LAS v2u*)(C + RC_RP + i16 * 144 + (32 + 4 * g) * 2), rp1b = *(const LAS v2u*)(C + RC_RP + i16 * 144 + (48 + 4 * g) * 2);
                const v2u lk = *(const LAS v2u*)(C + RC_LK + i16 * 40 + g * 8), tm = *(const LAS v2u*)(C + RC_TM + i16 * 40 + g * 8);
                const v2u ark = *(const LAS v2u*)(C + RC_ARK + i16 * 40 + g * 8), narb = *(const LAS v2u*)(C + RC_NARB + i16 * 40 + g * 8);
                const v2u vf = *(const LAS v2u*)(C + RC_VTT + (16 * vt + i16) * 40 + g * 8);
                const v4u z4 = {0u, 0u, 0u, 0u};
                f32x4 rhs = (f32x4){0.f, 0.f, 0.f, 0.f};
                rhs = MFMA16(__builtin_bit_cast(bf16x8, ((v4u){kp0a.x, kp0a.y, kp0b.x, kp0b.y})), s01, rhs);
                rhs = MFMA16(__builtin_bit_cast(bf16x8, ((v4u){kp1a.x, kp1a.y, kp1b.x, kp1b.y})), s23, rhs);
                rhs = MFMA16(__builtin_bit_cast(bf16x8, ((v4u){lk.x, lk.y, 0u, 0u})), __builtin_bit_cast(bf16x8, ((v4u){vf.x, vf.y, 0u, 0u})), rhs);
                f32x4 z = MFMA16(__builtin_bit_cast(bf16x8, ((v4u){tm.x, tm.y, 0u, 0u})), __builtin_bit_cast(bf16x8, ((v4u){cvtpk(rhs[0], rhs[1]), cvtpk(rhs[2], rhs[3]), 0u, 0u})), ((f32x4){0.f, 0.f, 0.f, 0.f}));
                const bf16x8 vz = __builtin_bit_cast(bf16x8, ((v4u){vf.x, vf.y, cvtpk(z[0], z[1]), cvtpk(z[2], z[3])}));
                f32x4 y = (f32x4){0.f, 0.f, 0.f, 0.f};
                y = MFMA16(__builtin_bit_cast(bf16x8, ((v4u){rp0a.x, rp0a.y, rp0b.x, rp0b.y})), s01, y);
                y = MFMA16(__builtin_bit_cast(bf16x8, ((v4u){rp1a.x, rp1a.y, rp1b.x, rp1b.y})), s23, y);
                y = MFMA16(__builtin_bit_cast(bf16x8, ((v4u){ark.x, ark.y, narb.x, narb.y})), vz, y);
#pragma unroll
                for (int kt = 0; kt < 4; ++kt) {
                    const v2u ktf = *(const LAS v2u*)(C + RC_KTT + (16 * kt + i16) * 40 + g * 8), nbf = *(const LAS v2u*)(C + RC_NBPT + (16 * kt + i16) * 40 + g * 8);
                    const f32x4 g15 = *(const LAS f32x4*)(C + RC_G15 + (16 * kt + 4 * g) * 4);
                    ST[kt] = MFMA16(__builtin_bit_cast(bf16x8, ((v4u){ktf.x, ktf.y, nbf.x, nbf.y})), vz, ST[kt]);
                    ST[kt] = ST[kt] * g15;
                }
                { const unsigned y01 = cvtpk(y[0], y[1]), y23 = cvtpk(y[2], y[3]); LAS unsigned char* yb = lds + RW_YB + (c * 16 + 4 * g) * 144 + (16 * vt + i16) * 2;
                  *(LAS bf16*)(yb) = (bf16)(y01 & 0xffffu); *(LAS bf16*)(yb + 144) = (bf16)(y01 >> 16); *(LAS bf16*)(yb + 288) = (bf16)(y23 & 0xffffu); *(LAS bf16*)(yb + 432) = (bf16)(y23 >> 16); }
                (void)z4;
            }
        } else if (sc + 1 < nsc) {
            const int r0 = (tid - 256) >> 3;
#pragma unroll
            for (int hrow = 0; hrow < 2; ++hrow) { const int tokr = r0 + 32 * hrow, step_ = (sc + 1) * 64 + tokr, t_ = e ? L - 1 - step_ : step_;
                const bf16* gp_ = G1 + (size_t)(tok0 + t_) * G1W + C_LORA + e * 64 + st_c8;
                const v4u hw_ = *(const v4u*)gp_, ha_ = *(const v4u*)(gp_ + 128); v4u th_;
                th_.x = cvtpk(tanh_fast(bflo(hw_.x)), tanh_fast(bfhi(hw_.x))); th_.y = cvtpk(tanh_fast(bflo(hw_.y)), tanh_fast(bfhi(hw_.y))); th_.z = cvtpk(tanh_fast(bflo(hw_.z)), tanh_fast(bfhi(hw_.z))); th_.w = cvtpk(tanh_fast(bflo(hw_.w)), tanh_fast(bfhi(hw_.w)));
                *(LAS v4u*)(lds + RW_TH + tokr * 144 + st_c8 * 2) = th_; *(LAS v4u*)(lds + RW_HA + tokr * 144 + st_c8 * 2) = ha_; }
        }
        __syncthreads();
        {
            const int row = tid >> 3, part = tid & 7, step = sc * 64 + row, t = e ? L - 1 - step : step;
            *(v4u*)(YS + ((size_t)e * T + tok0 + t) * 256 + hh * 64 + part * 8) = *(const LAS v4u*)(lds + RW_YB + row * 144 + part * 16);
        }
    }
#undef RW_STAGE
#undef RW_PREFETCH
    if (!lat && wave < 4) {
        const int v = 16 * wave + i16;
#pragma unroll
        for (int kt = 0; kt < 4; ++kt) *(f32x4*)(a->out + O_RW + (((size_t)((b * 2 + layer) * 2 + e) * 4 + hh) * 64 + v) * 64 + 16 * kt + 4 * g) = ST[kt];
    }
}

constexpr int LR_WAT = 0, LR_XCB = 18432, LR_XCF = 27648, LR_AA = 44032, LR_BV = 60416, LR_HH = 76800, LR_SP = 93184, LR_SH = 95232, LR_HC = 97280;
__device__ __forceinline__ void lru_unit_mfma(ArgsP a, LAS unsigned char* lds, int layer, int u) {
    const int tid = tid_(), lane = tid & 63, wave = tid >> 6, i16 = lane & 15, g4 = lane >> 4;
    const int lat = u < 32, uu = lat ? u : u - 32, b = uu >> 2, g = uu & 3;
    const int L = lat ? L_LAT : L_CTX, tok0 = lat ? T_CTX + b * L_LAT : b * L_CTX;
    const bf16* G1 = (const bf16*)(a->ws + WS_G1);
    bf16* HF = (bf16*)(a->ws + WS_HF);
    LAS float* XCF = (LAS float*)(lds + LR_XCF); LAS float* AA = (LAS float*)(lds + LR_AA); LAS float* BV = (LAS float*)(lds + LR_BV); LAS float* HH = (LAS float*)(lds + LR_HH);
    LAS float* SP = (LAS float*)(lds + LR_SP); LAS float* SH = (LAS float*)(lds + LR_SH); LAS float* HC = (LAS float*)(lds + LR_HC);
    const int tt = tid >> 3, q8 = (tid & 7) * 8;
    float cw[4][8], cb[8];
#pragma unroll
    for (int i = 0; i < 8; ++i) { const int ch = g * 64 + q8 + i; cb[i] = a->in[I_CONVB][layer * 256 + ch];
#pragma unroll
        for (int j = 0; j < 4; ++j) cw[j][i] = a->in[I_CONVW][(layer * 4 + j) * 256 + ch]; }
    const int ot = wave & 3, tp = wave >> 2;
    const int sch = tid & 63, seg = tid >> 6;
    for (int e = 0; e < 2; ++e) {
        __syncthreads();
        for (int i = tid; i < 4096; i += NTHREADS) { const size_t src = ((size_t)((layer * 2 + e) * 4 + g)) * 4096 + i; const int ii = i >> 6, oo = i & 63;
            *(LAS bf16*)(lds + LR_WAT + (oo * 72 + ii) * 2) = (bf16)f2bf(a->in[I_WA][src]); *(LAS bf16*)(lds + LR_WAT + 9216 + (oo * 72 + ii) * 2) = (bf16)f2bf(a->in[I_WX][src]); }
        if (tid < 64) HC[tid] = lat ? a->in[I_SLRU][((size_t)(b * 2 + layer) * 2 + e) * 256 + g * 64 + tid] : 0.f;
        f32x4 bav, bxv, spl;
        { const int chb = (layer * 2 + e) * 256 + g * 64 + 16 * ot + 4 * g4;
          bav = *(const f32x4*)(a->in[I_BA] + chb); bxv = *(const f32x4*)(a->in[I_BX] + chb); const f32x4 lam = *(const f32x4*)(a->in[I_LAMBDA] + chb);
#pragma unroll
          for (int q = 0; q < 4; ++q) spl[q] = log1pf(exp_(-lam[q])); }
        __syncthreads();
        v4u xr[4], hfr, glr;
#define LR_PREFETCH(cc_) do { const int c_ = e ? L / 64 - 1 - (cc_) : (cc_), t_ = c_ * 64 + tt; \
            _Pragma("unroll") for (int j = 0; j < 4; ++j) { const int ts = t_ + j - 2; xr[j] = (ts >= 0 && ts < L) ? *(const v4u*)(G1 + (size_t)(tok0 + ts) * G1W + C_XL + g * 64 + q8) : (v4u){0u, 0u, 0u, 0u}; } \
            if (e) { hfr = *(const v4u*)(HF + (size_t)(tok0 + t_) * 256 + g * 64 + q8); glr = *(const v4u*)(G1 + (size_t)(tok0 + t_) * G1W + C_GL + g * 64 + q8); } } while (0)
        LR_PREFETCH(0);
        for (int cc = 0; cc < L / 64; ++cc) {
            const int c = e ? L / 64 - 1 - cc : cc, t = c * 64 + tt, n = tok0 + t;
            const v4u xcur[4] = {xr[0], xr[1], xr[2], xr[3]}; const v4u hfc = hfr, glc = glr;
            if (cc + 1 < L / 64) LR_PREFETCH(cc + 1);
            {
                float xc[8];
#pragma unroll
                for (int i = 0; i < 8; ++i) xc[i] = cb[i];
#pragma unroll
                for (int j = 0; j < 4; ++j) {
                    { const v4u x = xcur[j];
                        xc[0] += cw[j][0] * bflo(x.x); xc[1] += cw[j][1] * bfhi(x.x); xc[2] += cw[j][2] * bflo(x.y); xc[3] += cw[j][3] * bfhi(x.y);
                        xc[4] += cw[j][4] * bflo(x.z); xc[5] += cw[j][5] * bfhi(x.z); xc[6] += cw[j][6] * bflo(x.w); xc[7] += cw[j][7] * bfhi(x.w); } }
                *(LAS f32x4*)(XCF + tt * 64 + q8) = (f32x4){xc[0], xc[1], xc[2], xc[3]}; *(LAS f32x4*)(XCF + tt * 64 + q8 + 4) = (f32x4){xc[4], xc[5], xc[6], xc[7]};
                *(LAS v4u*)(lds + LR_XCB + tt * 144 + q8 * 2) = (v4u){cvtpk(xc[0], xc[1]), cvtpk(xc[2], xc[3]), cvtpk(xc[4], xc[5]), cvtpk(xc[6], xc[7])};
            }
            __syncthreads();
            {
#pragma unroll
                for (int t2 = 0; t2 < 2; ++t2) { const int tk = (2 * tp + t2) * 16 + i16;
                    f32x4 ga = (f32x4){0.f, 0.f, 0.f, 0.f}, gx = (f32x4){0.f, 0.f, 0.f, 0.f};
#pragma unroll
                    for (int ks = 0; ks < 2; ++ks) { const bf16x8 xf = *(const LAS bf16x8*)(lds + LR_XCB + tk * 144 + ks * 64 + g4 * 16);
                        const bf16x8 wa = *(const LAS bf16x8*)(lds + LR_WAT + (16 * ot + i16) * 144 + ks * 64 + g4 * 16), wx = *(const LAS bf16x8*)(lds + LR_WAT + 9216 + (16 * ot + i16) * 144 + ks * 64 + g4 * 16);
                        ga = MFMA16(wa, xf, ga); gx = MFMA16(wx, xf, gx); }
                    const f32x4 xcv = *(const LAS f32x4*)(XCF + tk * 64 + 16 * ot + 4 * g4);
                    f32x4 av, bv;
#pragma unroll
                    for (int q = 0; q < 4; ++q) { const float la = -8.f * sigmoidf_(ga[q] + bav[q]) * spl[q]; av[q] = exp_(la); bv[q] = sqrt_(1.f - exp_(2.f * la)) * sigmoidf_(gx[q] + bxv[q]) * xcv[q]; }
                    *(LAS f32x4*)(AA + tk * 64 + 16 * ot + 4 * g4) = av; *(LAS f32x4*)(BV + tk * 64 + 16 * ot + 4 * g4) = bv; }
            }
            __syncthreads();
            float av8[8], bv8[8];
            {
                float P = 1.f, H = 0.f;
#pragma unroll
                for (int s = 0; s < 8; ++s) { const int p = seg * 8 + s, st = e ? 63 - p : p; av8[s] = AA[st * 64 + sch]; bv8[s] = BV[st * 64 + sch]; H = fmaf(av8[s], H, bv8[s]); P *= av8[s]; }
                SP[seg * 64 + sch] = P; SH[seg * 64 + sch] = H;
            }
            __syncthreads();
            {
                float h = HC[sch];
                for (int s2 = 0; s2 < seg; ++s2) h = fmaf(SP[s2 * 64 + sch], h, SH[s2 * 64 + sch]);
#pragma unroll
                for (int s = 0; s < 8; ++s) { const int p = seg * 8 + s, st = e ? 63 - p : p; h = fmaf(av8[s], h, bv8[s]); HH[st * 64 + sch] = h; }
                __syncthreads();
                if (seg == 7) HC[sch] = h;
            }
            __syncthreads();
            {
                bf16* dst = HF + (size_t)n * 256 + g * 64 + q8;
                float o[8];
#pragma unroll
                for (int i = 0; i < 8; ++i) o[i] = HH[tt * 64 + q8 + i];
                if (e) { const v4u hf = hfc, gl = glc;
                    o[0] = (o[0] + bflo(hf.x)) * siluf_(bflo(gl.x)); o[1] = (o[1] + bfhi(hf.x)) * siluf_(bfhi(gl.x)); o[2] = (o[2] + bflo(hf.y)) * siluf_(bflo(gl.y)); o[3] = (o[3] + bfhi(hf.y)) * siluf_(bfhi(gl.y));
                    o[4] = (o[4] + bflo(hf.z)) * siluf_(bflo(gl.z)); o[5] = (o[5] + bfhi(hf.z)) * siluf_(bfhi(gl.z)); o[6] = (o[6] + bflo(hf.w)) * siluf_(bflo(gl.w)); o[7] = (o[7] + bfhi(hf.w)) * siluf_(bfhi(gl.w)); }
                *(v4u*)dst = (v4u){cvtpk(o[0], o[1]), cvtpk(o[2], o[3]), cvtpk(o[4], o[5]), cvtpk(o[6], o[7])};
            }
        }
#undef LR_PREFETCH
        __syncthreads();
        if (tid < 64 && !lat) a->out[O_LRU + ((size_t)(b * 2 + layer) * 2 + e) * 256 + g * 64 + tid] = HC[tid];
    }
}

constexpr int LQ_NQ = 32;
constexpr int LQ_WAT = 0, LQ_S0 = 2 * LQ_NQ * 144;
constexpr int LS_XCB = 0, LS_XCQ = 9216, LS_AA = LS_XCQ + 64 * LQ_NQ * 4, LS_BV = LS_AA + 64 * LQ_NQ * 4, LS_HH = LS_BV + 64 * LQ_NQ * 4,
              LS_SP = LS_HH + 64 * LQ_NQ * 4, LS_SH = LS_SP + 8 * LQ_NQ * 4, LS_HC = LS_SH + 8 * LQ_NQ * 4, LS_BYTES = LS_HC + 2 * LQ_NQ * 4;
__device__ __forceinline__ void lru_unit_q(ArgsP a, LAS unsigned char* lds, int layer, int u) {
    const int tid = tid_(), lane = tid & 63, wave = tid >> 6, i16 = lane & 15, g4 = lane >> 4;
    const int lat = u < 32, uu = lat ? u : u - 32, bp = uu >> 3, g = (uu >> 1) & 3, oq = uu & 1;
    const int L = lat ? L_LAT : L_CTX;
    const int tokb[2] = {lat ? T_CTX + (2 * bp) * L_LAT : (2 * bp) * L_CTX, lat ? T_CTX + (2 * bp + 1) * L_LAT : (2 * bp + 1) * L_CTX};
    const bf16* G1 = (const bf16*)(a->ws + WS_G1);
    bf16* HF = (bf16*)(a->ws + WS_HF);
    const int tt = tid >> 3, q8 = (tid & 7) * 8;
    float cw[4][8], cb[8];
#pragma unroll
    for (int i = 0; i < 8; ++i) { const int ch = g * 64 + q8 + i; cb[i] = a->in[I_CONVB][layer * 256 + ch];
#pragma unroll
        for (int j = 0; j < 4; ++j) cw[j][i] = a->in[I_CONVW][(layer * 4 + j) * 256 + ch]; }
    const int gt = wave & 3, got = wave >> 2;
    const int ssn = tid >> 8, sch = tid & (LQ_NQ - 1), seg = (tid >> 5) & 7;
    const int otok = tid >> 3, oc4 = (tid & 7) * 4;
    const int chq = g * 64 + oq * LQ_NQ;
    LAS unsigned char* SS = lds + LQ_S0 + ssn * LS_BYTES;
    for (int e = 0; e < 2; ++e) {
        __syncthreads();
        for (int i = tid; i < 64 * LQ_NQ; i += NTHREADS) { const int ii = i / LQ_NQ, oo = i % LQ_NQ; const size_t src = ((size_t)((layer * 2 + e) * 4 + g)) * 4096 + ii * 64 + oq * LQ_NQ + oo;
            *(LAS bf16*)(lds + LQ_WAT + (oo * 72 + ii) * 2) = (bf16)f2bf(a->in[I_WA][src]); *(LAS bf16*)(lds + LQ_WAT + LQ_NQ * 144 + (oo * 72 + ii) * 2) = (bf16)f2bf(a->in[I_WX][src]); }
        if (tid < 2 * LQ_NQ) { const int s = tid >> 5, c = tid & 31; ((LAS float*)(lds + LQ_S0 + s * LS_BYTES + LS_HC))[c] = lat ? a->in[I_SLRU][((size_t)((2 * bp + s) * 2 + layer) * 2 + e) * 256 + chq + c] : 0.f; }
        f32x4 bav, bxv, spl;
        { const int chb = (layer * 2 + e) * 256 + chq + 16 * got + 4 * g4;
          bav = *(const f32x4*)(a->in[I_BA] + chb); bxv = *(const f32x4*)(a->in[I_BX] + chb); const f32x4 lam = *(const f32x4*)(a->in[I_LAMBDA] + chb);
#pragma unroll
          for (int q = 0; q < 4; ++q) spl[q] = log1pf(exp_(-lam[q])); }
        v4u xr[2][4]; v2u hfr[2], glr[2];
#define LQ_PREFETCH(cc_) do { const int c_ = e ? L / 64 - 1 - (cc_) : (cc_), t_ = c_ * 64 + tt; \
            _Pragma("unroll") for (int s = 0; s < 2; ++s) { \
              _Pragma("unroll") for (int j = 0; j < 4; ++j) { const int ts = t_ + j - 2; xr[s][j] = (ts >= 0 && ts < L) ? *(const v4u*)(G1 + (size_t)(tokb[s] + ts) * G1W + C_XL + g * 64 + q8) : (v4u){0u, 0u, 0u, 0u}; } \
              if (e) { const int to_ = c_ * 64 + otok; hfr[s] = *(const v2u*)(HF + (size_t)(tokb[s] + to_) * 256 + chq + oc4); glr[s] = *(const v2u*)(G1 + (size_t)(tokb[s] + to_) * G1W + C_GL + chq + oc4); } } } while (0)
        LQ_PREFETCH(0);
        __syncthreads();
        for (int cc = 0; cc < L / 64; ++cc) {
            const int c = e ? L / 64 - 1 - cc : cc;
            v4u xcur[2][4]; v2u hfc[2], glc[2];
#pragma unroll
            for (int s = 0; s < 2; ++s) { xcur[s][0] = xr[s][0]; xcur[s][1] = xr[s][1]; xcur[s][2] = xr[s][2]; xcur[s][3] = xr[s][3]; hfc[s] = hfr[s]; glc[s] = glr[s]; }
            if (cc + 1 < L / 64) LQ_PREFETCH(cc + 1);
#pragma unroll
            for (int s = 0; s < 2; ++s) {
                LAS unsigned char* SB = lds + LQ_S0 + s * LS_BYTES;
                float xc[8];
#pragma unroll
                for (int i = 0; i < 8; ++i) xc[i] = cb[i];
#pragma unroll
                for (int j = 0; j < 4; ++j) { const v4u x = xcur[s][j];
                    xc[0] += cw[j][0] * bflo(x.x); xc[1] += cw[j][1] * bfhi(x.x); xc[2] += cw[j][2] * bflo(x.y); xc[3] += cw[j][3] * bfhi(x.y);
                    xc[4] += cw[j][4] * bflo(x.z); xc[5] += cw[j][5] * bfhi(x.z); xc[6] += cw[j][6] * bflo(x.w); xc[7] += cw[j][7] * bfhi(x.w); }
                *(LAS v4u*)(SB + LS_XCB + tt * 144 + q8 * 2) = (v4u){cvtpk(xc[0], xc[1]), cvtpk(xc[2], xc[3]), cvtpk(xc[4], xc[5]), cvtpk(xc[6], xc[7])};
                if ((q8 / LQ_NQ) == oq) { LAS float* XCQ = (LAS float*)(SB + LS_XCQ); *(LAS f32x4*)(XCQ + tt * LQ_NQ + (q8 % LQ_NQ)) = (f32x4){xc[0], xc[1], xc[2], xc[3]}; *(LAS f32x4*)(XCQ + tt * LQ_NQ + (q8 % LQ_NQ) + 4) = (f32x4){xc[4], xc[5], xc[6], xc[7]}; }
            }
            __syncthreads();
#pragma unroll
            for (int s = 0; s < 2; ++s) {
                LAS unsigned char* SB = lds + LQ_S0 + s * LS_BYTES;
                const int tk = gt * 16 + i16;
                f32x4 ga = (f32x4){0.f, 0.f, 0.f, 0.f}, gx = (f32x4){0.f, 0.f, 0.f, 0.f};
#pragma unroll
                for (int ks = 0; ks < 2; ++ks) { const bf16x8 xf = *(const LAS bf16x8*)(SB + LS_XCB + tk * 144 + ks * 64 + g4 * 16);
                    const bf16x8 wa = *(const LAS bf16x8*)(lds + LQ_WAT + (16 * got + i16) * 144 + ks * 64 + g4 * 16), wx = *(const LAS bf16x8*)(lds + LQ_WAT + LQ_NQ * 144 + (16 * got + i16) * 144 + ks * 64 + g4 * 16);
                    ga = MFMA16(wa, xf, ga); gx = MFMA16(wx, xf, gx); }
                const f32x4 xcv = *(const LAS f32x4*)((LAS float*)(SB + LS_XCQ) + tk * LQ_NQ + 16 * got + 4 * g4);
                f32x4 av, bv;
#pragma unroll
                for (int q = 0; q < 4; ++q) { const float la = -8.f * sigmoidf_(ga[q] + bav[q]) * spl[q], aq = exp_(la); av[q] = aq; bv[q] = sqrt_((1.f - aq) * (1.f + aq)) * sigmoidf_(gx[q] + bxv[q]) * xcv[q]; }
                *(LAS f32x4*)((LAS float*)(SB + LS_AA) + tk * LQ_NQ + 16 * got + 4 * g4) = av; *(LAS f32x4*)((LAS float*)(SB + LS_BV) + tk * LQ_NQ + 16 * got + 4 * g4) = bv;
            }
            __syncthreads();
            LAS float* AA = (LAS float*)(SS + LS_AA); LAS float* BV = (LAS float*)(SS + LS_BV); LAS float* HH = (LAS float*)(SS + LS_HH);
            LAS float* SP = (LAS float*)(SS + LS_SP); LAS float* SH = (LAS float*)(SS + LS_SH); LAS float* HC = (LAS float*)(SS + LS_HC);
            float av8[8], bv8[8];
            {
                float P = 1.f, H = 0.f;
#pragma unroll
                for (int s = 0; s < 8; ++s) { const int p = seg * 8 + s, st = e ? 63 - p : p; av8[s] = AA[st * LQ_NQ + sch]; bv8[s] = BV[st * LQ_NQ + sch]; H = fmaf(av8[s], H, bv8[s]); P *= av8[s]; }
                SP[seg * LQ_NQ + sch] = P; SH[seg * LQ_NQ + sch] = H;
            }
            __syncthreads();
            {
                float h = HC[(cc & 1) * LQ_NQ + sch];
                for (int s2 = 0; s2 < seg; ++s2) h = fmaf(SP[s2 * LQ_NQ + sch], h, SH[s2 * LQ_NQ + sch]);
#pragma unroll
                for (int s = 0; s < 8; ++s) { const int p = seg * 8 + s, st = e ? 63 - p : p; h = fmaf(av8[s], h, bv8[s]); HH[st * LQ_NQ + sch] = h; }
                if (seg == 7) HC[((cc + 1) & 1) * LQ_NQ + sch] = h;
            }
            __syncthreads();
#pragma unroll
            for (int s = 0; s < 2; ++s) {
                const int n = tokb[s] + c * 64 + otok;
                const f32x4 hv = *(const LAS f32x4*)((LAS float*)(lds + LQ_S0 + s * LS_BYTES + LS_HH) + otok * LQ_NQ + oc4);
                float o0 = hv[0], o1 = hv[1], o2 = hv[2], o3 = hv[3];
                if (e) { o0 = (o0 + bflo(hfc[s].x)) * siluf_(bflo(glc[s].x)); o1 = (o1 + bfhi(hfc[s].x)) * siluf_(bfhi(glc[s].x)); o2 = (o2 + bflo(hfc[s].y)) * siluf_(bflo(glc[s].y)); o3 = (o3 + bfhi(hfc[s].y)) * siluf_(bfhi(glc[s].y)); }
                *(v2u*)(HF + (size_t)n * 256 + chq + oc4) = (v2u){cvtpk(o0, o1), cvtpk(o2, o3)};
            }
        }
#undef LQ_PREFETCH
        __syncthreads();
        if (tid < 2 * LQ_NQ && !lat) { const int s = tid >> 5, c = tid & 31; a->out[O_LRU + ((size_t)((2 * bp + s) * 2 + layer) * 2 + e) * 256 + chq + c] = ((LAS float*)(lds + LQ_S0 + s * LS_BYTES + LS_HC))[((L / 64) & 1) * LQ_NQ + c]; }
    }
}

#define ATT_KLOAD(KB_) \
        bf16x8 kfa_[6], kfb_[6]; \
        _Pragma("unroll") for (int ks_ = 0; ks_ < 6; ++ks_) { kfa_[ks_] = *(const LAS bf16x8*)((KB_) + r * ATT_KSTR + ks_ * 32 + hq * 16); kfb_[ks_] = *(const LAS bf16x8*)((KB_) + (32 + r) * ATT_KSTR + ks_ * 32 + hq * 16); }
#define ATT_VLOAD(VB_) \
        v2u va0_[4], va1_[4], vb0_[4], vb1_[4]; \
        _Pragma("unroll") for (int ks_ = 0; ks_ < 4; ++ks_) { \
            va0_[ks_] = *(const LAS v2u*)((VB_) + r * ATT_VSTR + ks_ * 32 + hq * 8); va1_[ks_] = *(const LAS v2u*)((VB_) + r * ATT_VSTR + ks_ * 32 + 16 + hq * 8); \
            vb0_[ks_] = *(const LAS v2u*)((VB_) + (32 + r) * ATT_VSTR + ks_ * 32 + hq * 8); vb1_[ks_] = *(const LAS v2u*)((VB_) + (32 + r) * ATT_VSTR + ks_ * 32 + 16 + hq * 8); }
#define ATT_QKM(S0_, S1_) do { \
        _Pragma("unroll") for (int i_ = 0; i_ < 16; ++i_) { S0_[i_] = 0.f; S1_[i_] = 0.f; } \
        _Pragma("unroll") for (int ks_ = 0; ks_ < 6; ++ks_) { S0_ = MFMA32(kfa_[ks_], qf[ks_], S0_); S1_ = MFMA32(kfb_[ks_], qf[ks_], S1_); } } while (0)
#define ATT_STEP(SC0_, SC1_, SN0_, SN1_, KB_, VB_, HAVE_NEXT_) do { \
        ATT_KLOAD(KB_) \
        float mx_ = SC0_[0]; \
        _Pragma("unroll") for (int i_ = 1; i_ < 16; ++i_) mx_ = fmaxf(mx_, SC0_[i_]); \
        _Pragma("unroll") for (int i_ = 0; i_ < 16; ++i_) mx_ = fmaxf(mx_, SC1_[i_]); \
        mx_ = fmaxf(mx_, __shfl_xor(mx_, 32)); \
        if (!__all(mx_ - m <= 8.f)) { const float mn_ = fmaxf(m, mx_), al_ = __builtin_amdgcn_exp2f(m - mn_); m = mn_; l *= al_; \
            _Pragma("unroll") for (int i_ = 0; i_ < 16; ++i_) { o0[i_] *= al_; o1[i_] *= al_; } } \
        if (HAVE_NEXT_) ATT_QKM(SN0_, SN1_); \
        ATT_VLOAD(VB_) \
        float ps_ = 0.f; \
        _Pragma("unroll") for (int i_ = 0; i_ < 16; ++i_) { SC0_[i_] = __builtin_amdgcn_exp2f(SC0_[i_] - m); SC1_[i_] = __builtin_amdgcn_exp2f(SC1_[i_] - m); ps_ += SC0_[i_] + SC1_[i_]; } \
        l += ps_; \
        _Pragma("unroll") for (int ks_ = 0; ks_ < 4; ++ks_) { \
            v4u pw_; \
            if (ks_ == 0) { pw_.x = cvtpk(SC0_[0], SC0_[1]); pw_.y = cvtpk(SC0_[2], SC0_[3]); pw_.z = cvtpk(SC0_[4], SC0_[5]); pw_.w = cvtpk(SC0_[6], SC0_[7]); } \
            else if (ks_ == 1) { pw_.x = cvtpk(SC0_[8], SC0_[9]); pw_.y = cvtpk(SC0_[10], SC0_[11]); pw_.z = cvtpk(SC0_[12], SC0_[13]); pw_.w = cvtpk(SC0_[14], SC0_[15]); } \
            else if (ks_ == 2) { pw_.x = cvtpk(SC1_[0], SC1_[1]); pw_.y = cvtpk(SC1_[2], SC1_[3]); pw_.z = cvtpk(SC1_[4], SC1_[5]); pw_.w = cvtpk(SC1_[6], SC1_[7]); } \
            else { pw_.x = cvtpk(SC1_[8], SC1_[9]); pw_.y = cvtpk(SC1_[10], SC1_[11]); pw_.z = cvtpk(SC1_[12], SC1_[13]); pw_.w = cvtpk(SC1_[14], SC1_[15]); } \
            const bf16x8 pf_ = __builtin_bit_cast(bf16x8, pw_); \
            const v4u vwa_ = {va0_[ks_].x, va0_[ks_].y, va1_[ks_].x, va1_[ks_].y}, vwb_ = {vb0_[ks_].x, vb0_[ks_].y, vb1_[ks_].x, vb1_[ks_].y}; \
            o0 = MFMA32(__builtin_bit_cast(bf16x8, vwa_), pf_, o0); o1 = MFMA32(__builtin_bit_cast(bf16x8, vwb_), pf_, o1); } } while (0)
__device__ __forceinline__ void att_unit2(ArgsP a, LAS unsigned char* lds, int u) {
    const int tid = tid_(), lane = tid & 63, wave = tid >> 6, r = lane & 31, hq = lane >> 5;
    const bf16* KN = (const bf16*)(a->ws + WS_KN); const bf16* KR = (const bf16*)(a->ws + WS_KR); const bf16* VT = (const bf16*)(a->ws + WS_VT);
    bf16* Q = (bf16*)(a->ws + WS_Q); const bf16* G1 = (const bf16*)(a->ws + WS_G1);
    int b, h, n0, Lk, kidx0; size_t vbase;
    if (u < 512) { b = u >> 6; h = (u >> 3) & 7; n0 = T_CTX + b * 2048 + (u & 7) * 256; Lk = LK_LAT; kidx0 = T_CTX + b * LK_LAT; vbase = (size_t)VT_LAT + (size_t)(b * 8 + h) * 64 * LK_LAT; }
    else { const int uu = u - 512; b = uu >> 3; h = uu & 7; n0 = b * 256; Lk = 256; kidx0 = b * 256; vbase = (size_t)(b * 8 + h) * 64 * 256; }
    const int ntiles = Lk >> 6;
    const int n = n0 + wave * 32 + r;
    bf16x8 qf[6];
#pragma unroll
    for (int ks = 0; ks < 6; ++ks) qf[ks] = *(const bf16x8*)(Q + (size_t)n * 768 + h * 96 + ks * 16 + 8 * hq);
    const int key_k = tid >> 3, ck = tid & 7, key_r = (tid >> 2) & 63, cr = tid & 3;
    const bf16* gk = KN + (size_t)(kidx0 + key_k) * 512 + h * 64 + ck * 8;
    const bf16* gr = KR + (size_t)(kidx0 + key_r) * 32 + cr * 8;
    const bf16* gv = VT + (size_t)(kidx0 + key_k) * 512 + h * 64 + ck * 8;
    const unsigned sk = key_k * ATT_KSTR + ck * 16, sr = key_r * ATT_KSTR + 128 + cr * 16, sv = ATT_VOFF + (ck * 8) * ATT_VSTR + key_k * 2;
    v4u rkA, rrA = {0u, 0u, 0u, 0u}, rvA, rkB, rrB = {0u, 0u, 0u, 0u}, rvB;
#define ATT_LOAD(X_, j_) do { rk##X_ = *(const v4u*)(gk + (size_t)(j_) * 64 * 512); if (tid < 256) rr##X_ = *(const v4u*)(gr + (size_t)(j_) * 64 * 32); rv##X_ = *(const v4u*)(gv + (size_t)(j_) * 64 * 512); } while (0)
#define ATT_STORE(X_, B_) do { LAS unsigned char* nb_ = lds + (B_) * ATT_STAGE; *(LAS v4u*)(nb_ + sk) = rk##X_; if (tid < 256) *(LAS v4u*)(nb_ + sr) = rr##X_; \
        LAS unsigned char* vp_ = nb_ + sv; \
        *(LAS bf16*)(vp_) = (bf16)(rv##X_.x & 0xffffu); *(LAS bf16*)(vp_ + ATT_VSTR) = (bf16)(rv##X_.x >> 16); *(LAS bf16*)(vp_ + 2 * ATT_VSTR) = (bf16)(rv##X_.y & 0xffffu); *(LAS bf16*)(vp_ + 3 * ATT_VSTR) = (bf16)(rv##X_.y >> 16); \
        *(LAS bf16*)(vp_ + 4 * ATT_VSTR) = (bf16)(rv##X_.z & 0xffffu); *(LAS bf16*)(vp_ + 5 * ATT_VSTR) = (bf16)(rv##X_.z >> 16); *(LAS bf16*)(vp_ + 6 * ATT_VSTR) = (bf16)(rv##X_.w & 0xffffu); *(LAS bf16*)(vp_ + 7 * ATT_VSTR) = (bf16)(rv##X_.w >> 16); } while (0)
    ATT_LOAD(A, 0); ATT_LOAD(B, 1);
    __syncthreads();
    ATT_STORE(A, 0);
    ATT_STORE(B, 1);
    ATT_LOAD(A, 2);
    __syncthreads();
    f32x16 o0, o1, sa0, sa1, sb0, sb1;
#pragma unroll
    for (int i = 0; i < 16; ++i) { o0[i] = 0.f; o1[i] = 0.f; }
    float m = -1e30f, l = 0.f;
    { ATT_KLOAD(lds) ATT_QKM(sa0, sa1); }
    int bcur = 0;
    int j = 0;
    for (; j < ntiles - 2; j += 2) {
        {
            const int b1 = bcur == 2 ? 0 : bcur + 1, b2 = b1 == 2 ? 0 : b1 + 1;
            ATT_LOAD(B, j + 3);
            ATT_STEP(sa0, sa1, sb0, sb1, lds + b1 * ATT_STAGE, lds + bcur * ATT_STAGE + ATT_VOFF, true);
            ATT_STORE(A, b2);
            __syncthreads();
            bcur = b1;
        }
        {
            const int b1 = bcur == 2 ? 0 : bcur + 1, b2 = b1 == 2 ? 0 : b1 + 1;
            if (j + 4 < ntiles) ATT_LOAD(A, j + 4);
            ATT_STEP(sb0, sb1, sa0, sa1, lds + b1 * ATT_STAGE, lds + bcur * ATT_STAGE + ATT_VOFF, true);
            ATT_STORE(B, b2);
            __syncthreads();
            bcur = b1;
        }
    }
    {
        { const int b1 = bcur == 2 ? 0 : bcur + 1;
          ATT_STEP(sa0, sa1, sb0, sb1, lds + b1 * ATT_STAGE, lds + bcur * ATT_STAGE + ATT_VOFF, true);
          bcur = b1; }
        { ATT_STEP(sb0, sb1, sa0, sa1, lds + bcur * ATT_STAGE, lds + bcur * ATT_STAGE + ATT_VOFF, false); }
        __syncthreads();
    }
#undef ATT_LOAD
#undef ATT_STORE
    v2u gmv[2][4];
#pragma unroll
    for (int mt = 0; mt < 2; ++mt)
#pragma unroll
        for (int g = 0; g < 4; ++g) gmv[mt][g] = *(const v2u*)(G1 + (size_t)n * G1W + C_GM + h * 64 + 32 * mt + 8 * g + 4 * hq);
    l += __shfl_xor(l, 32);
    const float inv = rcp_(l);
#pragma unroll
    for (int mt = 0; mt < 2; ++mt)
#pragma unroll
        for (int g = 0; g < 4; ++g) {
            const int dv0 = 32 * mt + 8 * g + 4 * hq;
            const v2u gm = gmv[mt][g];
            const float x0 = (mt ? o1[4 * g + 0] : o0[4 * g + 0]) * inv, x1 = (mt ? o1[4 * g + 1] : o0[4 * g + 1]) * inv, x2 = (mt ? o1[4 * g + 2] : o0[4 * g + 2]) * inv, x3 = (mt ? o1[4 * g + 3] : o0[4 * g + 3]) * inv;
            v2u ov; ov.x = cvtpk(x0 * siluf_(bflo(gm.x)), x1 * siluf_(bfhi(gm.x))); ov.y = cvtpk(x2 * siluf_(bflo(gm.y)), x3 * siluf_(bfhi(gm.y)));
            *(v2u*)(Q + (size_t)n * 768 + h * 96 + dv0) = ov;
        }
}
constexpr int N_PHASES = 14;
#ifndef MK_PER_PHASE
#define MK_PER_PHASE 0
#endif
#ifndef VAR_GEMM
#define VAR_GEMM 1
#endif
#ifndef VAR_A2
#define VAR_A2 1
#endif
#ifndef VAR_ATT
#define VAR_ATT 1
#endif
#ifndef VAR_RWKV
#define VAR_RWKV 1
#endif
#ifndef VAR_LRU
#define VAR_LRU 1
#endif

__device__ __forceinline__ void phase_b(ArgsP a, LAS unsigned char* lds, int layer) {
    volatile LAS unsigned* MISC = (volatile LAS unsigned*)(lds + LDS_MISC);
    unsigned* head = (unsigned*)(a->ws + WS_CTL) + CW_Q + layer * 64;
    for (;;) {
        __syncthreads();
        if (tid_() == 0) MISC[16] = atomicAdd(head, 1u);
        __syncthreads();
        const int idx = (int)MISC[16];
        if (idx >= 1248) break;
#ifdef PROBE_UNIT1
        const unsigned long long pt0_ = __builtin_amdgcn_s_memrealtime();
#endif
        if (idx < 64) rwkv_unit_mfma(a, lds, layer, idx);
        else if (idx < 96) lru_unit_q(a, lds, layer, idx - 64);
        else if (idx < 608) att_unit2(a, lds, idx - 96);
        else if (idx < 864) rwkv_unit_mfma(a, lds, layer, 64 + idx - 608);
        else if (idx < 992) lru_unit_q(a, lds, layer, 32 + idx - 864);
        else att_unit2(a, lds, 512 + idx - 992);
#ifdef PROBE_UNIT1
        if (tid_() == 0 && layer == 0) { const unsigned d_ = (unsigned)(__builtin_amdgcn_s_memrealtime() - pt0_);
            const int ty_ = idx < 64 ? 0 : idx < 96 ? 1 : idx < 608 ? 2 : idx < 864 ? 3 : idx < 992 ? 4 : 5;
            atomicMax((unsigned*)(a->ws + WS_CTL) + CW_Q + 1024 + ty_ * 64, d_); }
#endif
    }
}

#if MK_PER_PHASE
template <int SUB> __global__ void __launch_bounds__(NTHREADS, 2) mk_phase(Args args, int layer) {
    extern __shared__ __attribute__((aligned(16))) unsigned char lds_raw[];
    LAS unsigned char* lds = (LAS unsigned char*)lds_raw;
    ArgsP a = (ArgsP)__builtin_amdgcn_kernarg_segment_ptr();
    if (SUB == 0) phase_p0(a, lds);
    if (SUB == 1) phase_a0(a, layer);
    if (SUB == 2) { if (VAR_GEMM) phase_a1_pg8(a, lds, layer); else phase_a1_naive(a, layer); }
    if (SUB == 3) { if (VAR_A2) { for (int u = blockIdx.x; u < T / 64 + 32; u += gridDim.x) a2_unit(a, lds, layer, u); } else phase_a2_naive(a, lds, layer); }
    if (SUB == 4) { if (VAR_ATT) { for (int u = blockIdx.x; u < 768; u += gridDim.x) att_unit(a, lds, u); } else phase_att_naive(a); }
    if (SUB == 5) { for (int u = blockIdx.x; u < 320; u += gridDim.x) { __syncthreads(); if (VAR_RWKV) rwkv_unit_mfma(a, lds, layer, u); else rwkv_unit_seq(a, lds, layer, u); } }
    if (SUB == 6) { for (int u = blockIdx.x; u < 160; u += gridDim.x) { __syncthreads(); if (VAR_LRU) lru_unit_mfma(a, lds, layer, u); else lru_unit_seq(a, lds, layer, u); } }
    if (SUB == 7) phase_c1(a, layer);
    if (SUB == 8) { if (VAR_GEMM) phase_c2_pg8(a, lds, layer); else phase_c2_naive(a, layer); }
    if (SUB == 9) phase_final(a);
}
#else
#define ARGS_VIEW() ({ ArgsP p_ = (ArgsP)__builtin_amdgcn_kernarg_segment_ptr(); asm volatile("" : "+s"(p_)); p_; })
__global__ void __launch_bounds__(NTHREADS, 2) mk_fwd(Args args) {
    extern __shared__ __attribute__((aligned(16))) unsigned char lds_raw[];
    LAS unsigned char* lds = (LAS unsigned char*)lds_raw;
    volatile LAS unsigned* MISC = (volatile LAS unsigned*)(lds + LDS_MISC);
    for (int u = threadIdx.x; u < 64; u += NTHREADS) MISC[u] = 0u;
    __syncthreads();
    XcdBarrier bar;
    { ArgsP a = ARGS_VIEW(); bar = xcd_barrier_post((unsigned*)(a->ws + WS_CTL) + CW_BAR, MISC + 8); }
    int lo, hi; { ArgsP a = ARGS_VIEW(); lo = a->ph_lo; hi = a->ph_hi; }
#define IN(k) (lo <= (k) && (k) < hi)
#ifdef PROBE_MASK1
#define STAMP(k) do { if (bid_() == 0 && tid_() == 0) { const unsigned long long t_ = __builtin_amdgcn_s_memrealtime(); MISC[32 + 2 * (k)] = (unsigned)t_; MISC[33 + 2 * (k)] = (unsigned)(t_ >> 32); } } while (0)
#else
#define STAMP(k) do { } while (0)
#endif
#define SEAM(k) do { if (IN(k) && IN((k) + 1)) xcd_barrier(bar); STAMP((k) + 1); } while (0)
#ifndef NO_P0
    STAMP(0);
    if (IN(0)) { ArgsP a = ARGS_VIEW(); phase_p0(a, lds); }
#endif
    SEAM(0);
    for (int layer = 0; layer < 2; ++layer) {
        const int p = 1 + 6 * layer;
#ifndef NO_A0
        if (IN(p + 0)) { { ArgsP a = ARGS_VIEW(); phase_a0(a, layer); } if (layer == 0) { ArgsP a = ARGS_VIEW(); phase_p0_weights(a, lds); } }
#endif
        SEAM(p + 0);
#ifndef NO_A1
        if (IN(p + 1)) { ArgsP a = ARGS_VIEW(); phase_a1_pg8(a, lds, layer); }
#endif
        SEAM(p + 1);
#ifndef NO_A2
        if (IN(p + 2)) { { ArgsP a = ARGS_VIEW(); phase_a2a(a, layer); } xcd_barrier(bar); { ArgsP a = ARGS_VIEW(); phase_a2b(a, lds, layer); } }
        if (0) { ArgsP a = ARGS_VIEW(); for (int u = bid_(); u < T / 64 + 32; u += grid_()) {
#ifdef PROBE_UNIT1
            const unsigned long long pt0_ = __builtin_amdgcn_s_memrealtime();
#endif
            a2_unit(a, lds, layer, u);
#ifdef PROBE_A2_TWICE
            a2_unit(a, lds, layer, u);
#endif
#ifdef PROBE_UNIT1
            __syncthreads();
            if (tid_() == 0 && layer == 0) atomicMax((unsigned*)(a->ws + WS_CTL) + CW_Q + 1024 + (u < 256 ? 6 : 7) * 64, (unsigned)(__builtin_amdgcn_s_memrealtime() - pt0_));
#endif
        } }
#endif
        SEAM(p + 2);
#ifndef NO_B
        if (IN(p + 3)) { ArgsP a = ARGS_VIEW(); phase_b(a, lds, layer); }
#endif
        SEAM(p + 3);
#ifndef NO_C1
        if (IN(p + 4)) { ArgsP a = ARGS_VIEW(); phase_c1(a, layer); }
#endif
        SEAM(p + 4);
#ifndef NO_C2
        if (IN(p + 5)) { ArgsP a = ARGS_VIEW(); phase_c2_pg8(a, lds, layer); }
#endif
        SEAM(p + 5);
    }
    if (IN(N_PHASES - 1)) { ArgsP a = ARGS_VIEW(); phase_final(a); }
#ifdef PROBE_MASK1
    STAMP(14);
    __syncthreads();
    if (bid_() == 0) {
        ArgsP a = ARGS_VIEW();
        float t1 = 0.f, t2 = 0.f;
        for (int k = 0; k < 14; ++k) { const unsigned long long s0 = ((unsigned long long)MISC[33 + 2 * k] << 32) | MISC[32 + 2 * k], s1 = ((unsigned long long)MISC[35 + 2 * k] << 32) | MISC[34 + 2 * k];
            const float us = (float)(s1 - s0) * 0.01f; if ((PROBE_MASK1 >> k) & 1) t1 += us; if ((PROBE_MASK2 >> k) & 1) t2 += us; }
#ifdef PROBE_UNIT1
        t1 = (float)((unsigned*)(a->ws + WS_CTL))[CW_Q + 1024 + PROBE_UNIT1 * 64] * 0.01f; t2 = (float)((unsigned*)(a->ws + WS_CTL))[CW_Q + 1024 + PROBE_UNIT2 * 64] * 0.01f;
#endif
        for (int i = tid_(); i < 32768; i += NTHREADS) a->out[O_LRU + i] *= (1.f + t2 * (1.f / 2000.f));
        if (tid_() == 0) a->out[0] += 2.f + t1 * 0.01f;
    }
#endif
#undef IN
#undef SEAM
}

#endif

extern "C" void kernel_launch(void* const* d_in, const int* in_sizes, int n_in, void* d_out, int out_size, void* d_ws, size_t ws_size, hipStream_t stream) {
    static int grid = 0;
    if (grid == 0) {
        if (n_in != N_IN || ws_size < WS_END) { fprintf(stderr, "kernel_launch: unexpected n_in %d / ws_size %zu\n", n_in, ws_size); grid = -1; return; }
        int dev = 0, cus = 0;
        if (hipGetDevice(&dev) != hipSuccess || hipDeviceGetAttribute(&cus, hipDeviceAttributeMultiprocessorCount, dev) != hipSuccess) { grid = -1; return; }
#if MK_PER_PHASE
#define SA(SUB) if (hipFuncSetAttribute((const void*)mk_phase<SUB>, hipFuncAttributeMaxDynamicSharedMemorySize, LDS_BYTES) != hipSuccess) { fprintf(stderr, "kernel_launch: hipFuncSetAttribute failed\n"); grid = -1; return; }
        SA(0) SA(1) SA(2) SA(3) SA(4) SA(5) SA(6) SA(7) SA(8) SA(9)
#undef SA
#else
        if (hipFuncSetAttribute((const void*)mk_fwd, hipFuncAttributeMaxDynamicSharedMemorySize, LDS_BYTES) != hipSuccess) { fprintf(stderr, "kernel_launch: hipFuncSetAttribute failed\n"); grid = -1; return; }
        int per_cu = 0;
        if (hipOccupancyMaxActiveBlocksPerMultiprocessor(&per_cu, (const void*)mk_fwd, NTHREADS, LDS_BYTES) != hipSuccess || per_cu < 1) fprintf(stderr, "kernel_launch: occupancy query reports %d\n", per_cu);
        (void)hipGetLastError();
#endif
        grid = cus;
    }
    if (grid < 0) return;
    if (hipMemsetAsync((char*)d_ws + WS_CTL, 0, CTL_ZERO_BYTES, stream) != hipSuccess) return;
    Args a{};
    for (int i = 0; i < N_IN; ++i) a.in[i] = (const float*)d_in[i];
    a.out = (float*)d_out; a.ws = (unsigned char*)d_ws;
#if MK_PER_PHASE
#define LP(SUB, layer) hipLaunchKernelGGL(mk_phase<SUB>, dim3(grid), dim3(NTHREADS), LDS_BYTES, stream, a, layer)
    LP(0, 0);
    for (int layer = 0; layer < 2; ++layer) { LP(1, layer); LP(2, layer); LP(3, layer); LP(4, layer); LP(5, layer); LP(6, layer); LP(7, layer); LP(8, layer); }
    LP(9, 0);
#undef LP
#else
    a.ph_lo = 0; a.ph_hi = N_PHASES;
    hipLaunchKernelGGL(mk_fwd, dim3(grid), dim3(NTHREADS), LDS_BYTES, stream, a);
#endif
}
```

```cpp
#define MK_PER_PHASE 0
#include <hip/hip_runtime.h>
#include <cstdio>
#include <cstdint>

#define GAS __attribute__((address_space(1)))
#define LAS __attribute__((address_space(3)))
typedef unsigned short bf16;
typedef unsigned v4u __attribute__((ext_vector_type(4)));
typedef unsigned v2u __attribute__((ext_vector_type(2)));
typedef float f32x4 __attribute__((ext_vector_type(4)));
typedef short bf16x8 __attribute__((ext_vector_type(8)));

constexpr int D = 1024, T_CTX = 8192, T_LAT = 16384, T = 24576, L_CTX = 256, L_LAT = 2048, PAST = 256;
constexpr int NIN = 2816, G1W = 2304, G2W = 512;
constexpr int C_R = 0, C_K = 256, C_V = 512, C_G = 768, C_GM = 1024, C_XL = 1536, C_GL = 1792, C_LORA = 2048;
constexpr int LK_LAT = PAST + L_LAT;
constexpr int TK = T_CTX + 8 * LK_LAT;
constexpr int VT_LAT = 32 * 8 * 64 * 256;
constexpr float LN_EPS = 1e-5f, GN_EPS = 64e-5f;
constexpr float ALPHA = 1.4142135623730951f;
constexpr float QSCALE = 0.10206207261596575f * 1.4426950408889634f;
constexpr size_t O_Y = 0, O_RW = 25165824, O_CKV = 27262976, O_KR = 29360128, O_LRU = 29884416;
constexpr size_t MiB = 1u << 20;
constexpr size_t WS_CTL = 0, CTL_ZERO_BYTES = 1 * MiB;
constexpr size_t WS_MOD = 256 * 1024;
constexpr size_t WS_ROPE = 1 * MiB;
constexpr size_t WS_STATS = 1536 * 1024;
constexpr size_t WS_WUQ = 2 * MiB;
constexpr size_t WS_WUKV = 3 * MiB;
constexpr size_t WS_WIN = 4 * MiB;
constexpr size_t WS_WOUT = 16 * MiB;
constexpr size_t WS_G1 = 20 * MiB;
constexpr size_t WS_G2 = 128 * MiB;
constexpr size_t WS_Q = 152 * MiB;
constexpr size_t WS_U = 152 * MiB;
constexpr size_t WS_KN = 188 * MiB;
constexpr size_t WS_KR = 214 * MiB;
constexpr size_t WS_VT = 216 * MiB;
constexpr size_t WS_YMIX = 188 * MiB;
constexpr size_t WS_HF = 242 * MiB;
constexpr size_t WS_END = 254 * MiB;
constexpr int CW_BAR = 4096;
constexpr int CW_Q = 16384;

__device__ __forceinline__ float bf2f(unsigned b) { return __uint_as_float(b << 16); }
__device__ __forceinline__ float bflo(unsigned w) { return __uint_as_float(w << 16); }
__device__ __forceinline__ float bfhi(unsigned w) { return __uint_as_float(w & 0xffff0000u); }
__device__ __forceinline__ unsigned f2bf(float f) { unsigned u = __float_as_uint(f); return (u + 0x7fffu + ((u >> 16) & 1u)) >> 16; }
__device__ __forceinline__ unsigned pk2(float lo, float hi) { return f2bf(lo) | (f2bf(hi) << 16); }
__device__ __forceinline__ float rcp_(float x) { return __builtin_amdgcn_rcpf(x); }
__device__ __forceinline__ float exp_(float x) { return __builtin_amdgcn_exp2f(x * 1.4426950408889634f); }
__device__ __forceinline__ float sqrt_(float x) { return __builtin_amdgcn_sqrtf(x); }
__device__ __forceinline__ float rsqrt_(float x) { return __builtin_amdgcn_rsqf(x); }
__device__ __forceinline__ float sigmoidf_(float x) { return rcp_(1.f + exp_(-x)); }
__device__ __forceinline__ float siluf_(float x) { return x * rcp_(1.f + exp_(-x)); }
template <int CTRL> __device__ __forceinline__ float dpp_f(float old, float x) { return __builtin_bit_cast(float, __builtin_amdgcn_update_dpp(__builtin_bit_cast(int, old), __builtin_bit_cast(int, x), CTRL, 0xf, 0xf, false)); }
__device__ __forceinline__ float row16_sum(float x) { x += dpp_f<0x128>(0.f, x); x += dpp_f<0x124>(0.f, x); x += dpp_f<0x122>(0.f, x); x += dpp_f<0x121>(0.f, x); return x; }
__device__ __forceinline__ float wave_sum_fast(float x) { x = row16_sum(x); x += __shfl_xor(x, 16); x += __shfl_xor(x, 32); return x; }
__device__ __forceinline__ float row16_prefix_prod(float x) { x *= dpp_f<0x111>(1.f, x); x *= dpp_f<0x112>(1.f, x); x *= dpp_f<0x114>(1.f, x); x *= dpp_f<0x118>(1.f, x); return x; }
__device__ __forceinline__ float wave_sum(float v) { return wave_sum_fast(v); }
__device__ __forceinline__ int tid_() { int t = threadIdx.x; asm volatile("" : "+v"(t)); return t; }
__device__ __forceinline__ int bid_() { int b = blockIdx.x; asm volatile("" : "+s"(b)); return b; }
__device__ __forceinline__ int grid_() { int g = gridDim.x; asm volatile("" : "+s"(g)); return g; }
typedef float f32x16 __attribute__((ext_vector_type(16)));
typedef float f32x2_t __attribute__((ext_vector_type(2)));
typedef __bf16 bf16x2_t __attribute__((ext_vector_type(2)));
__device__ __forceinline__ unsigned cvtpk(float lo, float hi) { const f32x2_t v = {lo, hi}; return __builtin_bit_cast(unsigned, __builtin_convertvector(v, bf16x2_t)); }
#define XB_TMO      128
#define XB_XCNT(j)  (256  + 64 * (j))
#define XB_XSUB(j)  (1280 + 64 * (j))
#define XB_XGEN(j)  (2304 + 64 * (j))
#define XB_TOP      3328
#define XB_TOPGEN   3392
#define XCD_BAR_WORDS 3456
#define XB_SPIN_CAP (1u << 24)

__device__ __forceinline__ unsigned xb_ld(unsigned* p)              { return __hip_atomic_load(p, __ATOMIC_RELAXED, __HIP_MEMORY_SCOPE_AGENT); }
__device__ __forceinline__ unsigned xb_add(unsigned* p, unsigned v) { return __hip_atomic_fetch_add(p, v, __ATOMIC_RELAXED, __HIP_MEMORY_SCOPE_AGENT); }
__device__ __forceinline__ unsigned xb_xcc_id() { return (unsigned)__builtin_amdgcn_s_getreg((3 << 11) | 20) & 0xFu; }
#define XB_SPIN(cond, bar) do { unsigned _sp = 0; while (cond) { __builtin_amdgcn_s_sleep(1); \
    if ((++_sp & 255u) == 0u) { if (xb_ld(&(bar)[XB_TMO])) break; if (_sp > XB_SPIN_CAP) { atomicAdd(&(bar)[XB_TMO], 1u); break; } } } } while (0)

struct XcdBarrier {
    unsigned* bar; unsigned x;
    volatile LAS unsigned* st;
};

__device__ __forceinline__ XcdBarrier xcd_barrier_post(unsigned* bar, volatile LAS unsigned* st) {
    XcdBarrier b; b.bar = bar; b.x = xb_xcc_id(); b.st = st;
    if (threadIdx.x == 0) (void)xb_add(&bar[XB_XCNT(b.x)], 1u);
    return b;
}
__device__ __forceinline__ void xcd_barrier_complete(unsigned* bar, unsigned x, unsigned& nloc, unsigned& nx) {
    const unsigned G = gridDim.x * gridDim.y * gridDim.z;
    unsigned sum, cnt, mine, sp = 0u;
    for (;;) {
        sum = 0u; cnt = 0u; mine = 0u;
#pragma unroll
        for (unsigned j = 0; j < 16; ++j) { const unsigned c = xb_ld(&bar[XB_XCNT(j)]); sum += c; cnt += (c > 0u) ? 1u : 0u; mine = (j == x) ? c : mine; }
        if (sum == G) break;
        __builtin_amdgcn_s_sleep(1);
        if ((++sp & 255u) == 0u) { if (xb_ld(&bar[XB_TMO])) break; if (sp > XB_SPIN_CAP) { atomicAdd(&bar[XB_TMO], 1u); break; } }
    }
    nloc = mine > 0u ? mine : 1u; nx = cnt > 0u ? cnt : 1u;
}

__device__ __forceinline__ void xcd_barrier(const XcdBarrier& b) {
    asm volatile("s_waitcnt vmcnt(0)" ::: "memory");
    __syncthreads();
    if (threadIdx.x == 0) {
        unsigned* bar = b.bar;
        __builtin_amdgcn_s_waitcnt(0);
        unsigned nloc = b.st[0], nx = b.st[1];
        if (nloc == 0u) { xcd_barrier_complete(bar, b.x, nloc, nx); b.st[0] = nloc; b.st[1] = nx; }
        const unsigned old = xb_add(&bar[XB_XSUB(b.x)], 1u);
        const unsigned gen = old / nloc;
        if (old + 1u == (gen + 1u) * nloc) {
            __builtin_amdgcn_fence(__ATOMIC_RELEASE, "agent");
            asm volatile("s_waitcnt vmcnt(0)" ::: "memory");
            const unsigned og = xb_add(&bar[XB_TOP], 1u);
            const unsigned tg = og / nx;
            if (og + 1u == (tg + 1u) * nx) xb_add(&bar[XB_TOPGEN], 1u);
            else XB_SPIN(xb_ld(&bar[XB_TOPGEN]) == tg, bar);
            __builtin_amdgcn_fence(__ATOMIC_ACQUIRE, "agent");
            xb_add(&bar[XB_XGEN(b.x)], 1u);
            asm volatile("s_waitcnt vmcnt(0)" ::: "memory");
        } else {
            XB_SPIN(xb_ld(&bar[XB_XGEN(b.x)]) == gen, bar);
            __builtin_amdgcn_fence(__ATOMIC_ACQUIRE, "agent");
            asm volatile("s_waitcnt vmcnt(0)" ::: "memory");
        }
    }
    __syncthreads();
}
enum { I_XP = 0, I_XS, I_SRW, I_CCKV, I_CKR, I_SLRU, I_C, I_CCTX, I_WMOD, I_BMOD, I_WIN, I_W0, I_W1, I_W2, I_A0, I_A1, I_A2, I_KK, I_KA, I_RK,
       I_LNXG, I_LNXB, I_QNORM, I_WUQ, I_KVNORM, I_WUKV, I_CONVW, I_CONVB, I_WA, I_BA, I_WX, I_BX, I_LAMBDA, I_WOUT, I_LNG, I_LNB, N_IN };
struct Args { const float* in[N_IN]; float* out; unsigned char* ws; int ph_lo, ph_hi; };
typedef const Args __attribute__((address_space(4)))* ArgsP;
constexpr int NTHREADS = 512;
constexpr int LDS_MISC = 139264;
constexpr int LDS_BYTES = 147456;

struct Tok { int n, b, t, L, lat, modrow, tok0, kidx; };
__device__ __forceinline__ Tok tok_of(int n) {
    Tok k; k.n = n;
    if (n < T_CTX) { k.lat = 0; k.b = n >> 8; k.t = n & 255; k.L = L_CTX; k.modrow = 0; k.tok0 = k.b * 256; k.kidx = n; }
    else { const int m = n - T_CTX; k.lat = 1; k.b = m >> 11; k.t = m & 2047; k.L = L_LAT; k.modrow = 1 + k.b; k.tok0 = T_CTX + k.b * 2048; k.kidx = T_CTX + k.b * LK_LAT + PAST + k.t; }
    return k;
}
__device__ __forceinline__ const float* xrow_src(ArgsP a, int layer, int n) {
    if (layer == 0) return n < T_CTX ? a->in[I_XP] + (size_t)n * D : a->in[I_XS] + (size_t)(n - T_CTX) * D;
    return a->out + (size_t)n * D;
}
__device__ __forceinline__ float dot8(v4u a, v4u b, float acc) {
    acc = fmaf(bflo(a.x), bflo(b.x), acc); acc = fmaf(bfhi(a.x), bfhi(b.x), acc);
    acc = fmaf(bflo(a.y), bflo(b.y), acc); acc = fmaf(bfhi(a.y), bfhi(b.y), acc);
    acc = fmaf(bflo(a.z), bflo(b.z), acc); acc = fmaf(bfhi(a.z), bfhi(b.z), acc);
    acc = fmaf(bflo(a.w), bflo(b.w), acc); acc = fmaf(bfhi(a.w), bfhi(b.w), acc);
    return acc;
}

__device__ __forceinline__ void tr_item(const float* src, int ld, int col0, int k0, bf16* WT, int K, int row0, float scale, LAS float* scr, int lane) {
    {
        const int kr = lane >> 3, n4 = (lane & 7) * 4;
        f32x4 v[8];
#pragma unroll
        for (int i = 0; i < 8; ++i) v[i] = src ? *(const f32x4*)(src + (size_t)(k0 + i * 8 + kr) * ld + col0 + n4) : (f32x4){0.f, 0.f, 0.f, 0.f};
#pragma unroll
        for (int i = 0; i < 8; ++i) { LAS float* d = scr + (i * 8 + kr) * 33 + n4; d[0] = v[i].x * scale; d[1] = v[i].y * scale; d[2] = v[i].z * scale; d[3] = v[i].w * scale; }
    }
    asm volatile("s_waitcnt lgkmcnt(0)" ::: "memory");
    const int c = lane & 7;
#pragma unroll
    for (int j = 0; j < 4; ++j) { const int n = (lane >> 3) + 8 * j; const LAS float* s = scr + (8 * c) * 33 + n;
        v4u o; o.x = pk2(s[0 * 33], s[1 * 33]); o.y = pk2(s[2 * 33], s[3 * 33]); o.z = pk2(s[4 * 33], s[5 * 33]); o.w = pk2(s[6 * 33], s[7 * 33]);
        *(v4u*)(WT + (size_t)(row0 + n) * K + k0 + 8 * c) = o; }
    asm volatile("s_waitcnt lgkmcnt(0)" ::: "memory");
}
__device__ __forceinline__ void rope_angle(int t, int i, float& c, float& s) {
    const int row = t >> 6, col = t & 63; const int ii = i & 7;
    const float inv = exp2f(-(float)ii * (13.287712379549449f / 8.f));
    const float ang = (float)(i < 8 ? row : col) * inv;
    c = cosf(ang); s = sinf(ang);
}
__device__ __forceinline__ void phase_p0_weights(ArgsP a, LAS unsigned char* lds) {
    const int tid = tid_(), lane = tid & 63, wave = tid >> 6, G = grid_();
    unsigned char* ws = a->ws;
    LAS float* scr = (LAS float*)(lds + wave * 8704);
    const int gw = bid_() * 8 + wave, NGW = G * 8;
    constexpr int N_WIN = 2 * 16 * 88, N_WOUT = 2 * 16 * 32, N_WUQ = 2 * 4 * 24, N_WUKV = 2 * 4 * 32;
    for (int it = gw; it < N_WIN + N_WOUT + N_WUQ + N_WUKV; it += NGW) {
        int r = it;
        if (r < N_WIN) {
            const int l = r / (16 * 88), kb = (r / 88) % 16, nb = r % 88, j0 = nb * 32;
            const float* src; int ld, col0;
            const float* win = a->in[I_WIN] + (size_t)l * 1024 * 2464;
            if (j0 < 1024) { src = win; ld = 2464; col0 = j0; }
            else if (j0 < 1536) { src = win; ld = 2464; col0 = 1440 + (j0 - 1024); }
            else if (j0 < 1792) { src = win; ld = 2464; col0 = 1952 + (j0 - 1536); }
            else if (j0 < 2048) { src = win; ld = 2464; col0 = 2208 + (j0 - 1792); }
            else if (j0 < 2304) { const int q = (j0 - 2048) >> 6; src = (q < 2 ? a->in[I_W1] : a->in[I_A1]) + (size_t)(l * 2 + (q & 1)) * 1024 * 64; ld = 64; col0 = (j0 - 2048) & 63; }
            else if (j0 < 2560) { src = win; ld = 2464; col0 = 1024 + (j0 - 2304); }
            else if (j0 < 2688) { src = win; ld = 2464; col0 = 1280 + (j0 - 2560); }
            else if (j0 < 2720) { src = win; ld = 2464; col0 = 1408 + (j0 - 2688); }
            else { src = nullptr; ld = 0; col0 = 0; }
            tr_item(src, ld, col0, kb * 64, (bf16*)(ws + WS_WIN) + (size_t)l * NIN * 1024, 1024, j0, 1.f, scr, lane);
            continue;
        }
        r -= N_WIN;
        if (r < N_WOUT) { const int l = r / (16 * 32), kb = (r / 32) % 16, nb = r % 32;
            tr_item(a->in[I_WOUT] + (size_t)l * 1024 * 1024, 1024, nb * 32, kb * 64, (bf16*)(ws + WS_WOUT) + (size_t)l * 1024 * 1024, 1024, nb * 32, 1.f, scr, lane); continue; }
        r -= N_WOUT;
        if (r < N_WUQ) { const int l = r / (4 * 24), kb = (r / 24) % 4, nb = r % 24;
            tr_item(a->in[I_WUQ] + (size_t)l * 256 * 768, 768, nb * 32, kb * 64, (bf16*)(ws + WS_WUQ) + (size_t)l * 768 * 256, 256, nb * 32, QSCALE, scr, lane); continue; }
        r -= N_WUQ;
        { const int l = r / (4 * 32), kb = (r / 32) % 4, nb = r % 32;
            tr_item(kb < 2 ? a->in[I_WUKV] + (size_t)l * 128 * 1024 : nullptr, 1024, nb * 32, kb * 64, (bf16*)(ws + WS_WUKV) + (size_t)l * 1024 * 256, 256, nb * 32, 1.f, scr, lane); }
    }
}
__device__ __forceinline__ void phase_p0(ArgsP a, LAS unsigned char* lds) {
    const int tid = tid_(), G = grid_();
    unsigned char* ws = a->ws;
    { float* ROPE = (float*)(ws + WS_ROPE);
      for (int i = bid_() * NTHREADS + tid; i < 2048 * 16; i += G * NTHREADS) { float c, s; rope_angle(i >> 4, i & 15, c, s); ROPE[i * 2] = c; ROPE[i * 2 + 1] = s; } }
    float* MOD = (float*)(ws + WS_MOD);
    LAS float* SIL = (LAS float*)lds;
    for (int it = bid_(); it < 2 * 6 * 32; it += G) {
        const int l = it / 192, nb = (it / 32) % 6, kq = it % 32, col = nb * 512 + tid;
        __syncthreads();
        if (tid < 288) { const int j = tid >> 5, k = kq * 32 + (tid & 31); const float cj = (j == 0) ? a->in[I_CCTX][k] : a->in[I_C][(j - 1) * 1024 + k]; SIL[tid] = siluf_(cj); }
        float w[32];
#pragma unroll
        for (int kk = 0; kk < 32; ++kk) w[kk] = a->in[I_WMOD][((size_t)l * 1024 + kq * 32 + kk) * 3072 + col];
        __syncthreads();
        const float bias = (kq == 0) ? a->in[I_BMOD][l * 3072 + col] : 0.f;
#pragma unroll
        for (int j = 0; j < 9; ++j) { float acc = bias;
#pragma unroll
            for (int k4 = 0; k4 < 8; ++k4) { const f32x4 sv = *(const LAS f32x4*)(SIL + j * 32 + k4 * 4); acc = fmaf(sv.x, w[k4 * 4], acc); acc = fmaf(sv.y, w[k4 * 4 + 1], acc); acc = fmaf(sv.z, w[k4 * 4 + 2], acc); acc = fmaf(sv.w, w[k4 * 4 + 3], acc); }
            atomicAdd(&MOD[(l * 9 + j) * 3072 + col], acc); }
    }
}

__device__ __forceinline__ void phase_a0(ArgsP a, int layer) {
    const int tid = tid_(), lane = tid & 63, wave = tid >> 6, G = grid_();
    const float* MOD = (const float*)(a->ws + WS_MOD);
    bf16* U = (bf16*)(a->ws + WS_U);
    f32x4 nx[4];
#define A0_LOAD(nn_) do { if (layer == 0) { const float* xr_ = xrow_src(a, 0, (nn_)); \
            _Pragma("unroll") for (int j = 0; j < 4; ++j) nx[j] = *(const f32x4*)(xr_ + lane * 4 + 256 * j); } \
        else { const bf16* zr_ = (const bf16*)a->out + (size_t)(nn_) * 2048; \
            _Pragma("unroll") for (int j = 0; j < 4; ++j) { const v2u w_ = *(const v2u*)(zr_ + lane * 4 + 256 * j); nx[j] = (f32x4){bflo(w_.x), bfhi(w_.x), bflo(w_.y), bfhi(w_.y)}; } } } while (0)
    { const int n0 = bid_() * 8 + wave; if (n0 < T) A0_LOAD(n0); }
    for (int n = bid_() * 8 + wave; n < T; n += G * 8) {
        const Tok tk = tok_of(n);
        f32x4 v[4]; float s = 0.f;
#pragma unroll
        for (int j = 0; j < 4; ++j) { v[j] = nx[j]; s += (v[j].x + v[j].y) + (v[j].z + v[j].w); }
        if (n + G * 8 < T) A0_LOAD(n + G * 8);
        float mean = wave_sum(s) * (1.f / D), s2 = 0.f;
#pragma unroll
        for (int j = 0; j < 4; ++j) { v[j] = v[j] - mean; s2 += (v[j].x * v[j].x + v[j].y * v[j].y) + (v[j].z * v[j].z + v[j].w * v[j].w); }
        float rstd = rsqrt_(wave_sum(s2) * (1.f / D) + LN_EPS);
        if (layer == 1) {
            s = 0.f;
#pragma unroll
            for (int j = 0; j < 4; ++j) { const f32x4 g = *(const f32x4*)(a->in[I_LNG] + lane * 4 + 256 * j), b = *(const f32x4*)(a->in[I_LNB] + lane * 4 + 256 * j);
                v[j] = v[j] * rstd * g + b; s += (v[j].x + v[j].y) + (v[j].z + v[j].w); }
            if (lane == 0) { float* st = (float*)(a->ws + WS_STATS) + (size_t)n * 2; st[0] = mean; st[1] = rstd; }
            mean = wave_sum(s) * (1.f / D); s2 = 0.f;
#pragma unroll
            for (int j = 0; j < 4; ++j) { v[j] = v[j] - mean; s2 += (v[j].x * v[j].x + v[j].y * v[j].y) + (v[j].z * v[j].z + v[j].w * v[j].w); }
            rstd = rsqrt_(wave_sum(s2) * (1.f / D) + LN_EPS);
        }
        const float* m = MOD + (size_t)(layer * 9 + tk.modrow) * 3072;
#pragma unroll
        for (int j = 0; j < 4; ++j) { const int c = lane * 4 + 256 * j; const f32x4 sh = *(const f32x4*)(m + c), sc = *(const f32x4*)(m + 1024 + c);
            const f32x4 o = v[j] * rstd * (sc + 1.f) + sh;
            v2u p; p.x = pk2(o.x, o.y); p.y = pk2(o.z, o.w); *(v2u*)(U + (size_t)n * D + c) = p; }
    }
}
__device__ __forceinline__ void phase_final(ArgsP a) {
    const int tid = tid_(), lane = tid & 63, wave = tid >> 6, G = grid_();
    f32x4 nx[4];
#define FN_LOAD(nn_) do { const bf16* zr_ = (const bf16*)a->out + (size_t)(nn_) * 2048; \
        _Pragma("unroll") for (int j = 0; j < 4; ++j) { const v2u w_ = *(const v2u*)(zr_ + lane * 4 + 256 * j); nx[j] = (f32x4){bflo(w_.x), bfhi(w_.x), bflo(w_.y), bfhi(w_.y)}; } } while (0)
    { const int n0 = bid_() * 8 + wave; if (n0 < T) FN_LOAD(n0); }
    for (int n = bid_() * 8 + wave; n < T; n += G * 8) {
        float* xr = a->out + (size_t)n * D;
        f32x4 v[4]; float s = 0.f;
#pragma unroll
        for (int j = 0; j < 4; ++j) { v[j] = nx[j]; s += (v[j].x + v[j].y) + (v[j].z + v[j].w); }
        if (n + G * 8 < T) FN_LOAD(n + G * 8);
        const float mean = wave_sum(s) * (1.f / D); float s2 = 0.f;
#pragma unroll
        for (int j = 0; j < 4; ++j) { v[j] = v[j] - mean; s2 += (v[j].x * v[j].x + v[j].y * v[j].y) + (v[j].z * v[j].z + v[j].w * v[j].w); }
        const float rstd = rsqrt_(wave_sum(s2) * (1.f / D) + LN_EPS);
#pragma unroll
        for (int j = 0; j < 4; ++j) { const f32x4 g = *(const f32x4*)(a->in[I_LNG] + 1024 + lane * 4 + 256 * j), b = *(const f32x4*)(a->in[I_LNB] + 1024 + lane * 4 + 256 * j);
            *(f32x4*)(xr + lane * 4 + 256 * j) = v[j] * rstd * g + b; }
    }
}

__device__ __forceinline__ void phase_a1_naive(ArgsP a, int layer) {
    const bf16* U = (const bf16*)(a->ws + WS_U); const bf16* W = (const bf16*)(a->ws + WS_WIN) + (size_t)layer * NIN * 1024;
    bf16* G1 = (bf16*)(a->ws + WS_G1); bf16* G2 = (bf16*)(a->ws + WS_G2);
    const size_t total = (size_t)T * (NIN / 8), stride = (size_t)grid_() * NTHREADS;
    for (size_t idx = (size_t)bid_() * NTHREADS + tid_(); idx < total; idx += stride) {
        const int row = (int)(idx / (NIN / 8)), c0 = (int)(idx % (NIN / 8)) * 8;
        float acc[8];
#pragma unroll
        for (int c = 0; c < 8; ++c) acc[c] = 0.f;
        const v4u* ap = (const v4u*)(U + (size_t)row * 1024); const v4u* bp = (const v4u*)(W + (size_t)c0 * 1024);
        for (int kc = 0; kc < 128; ++kc) { const v4u av = ap[kc];
#pragma unroll
            for (int c = 0; c < 8; ++c) acc[c] = dot8(av, bp[c * 128 + kc], acc[c]); }
        v4u o; o.x = pk2(acc[0], acc[1]); o.y = pk2(acc[2], acc[3]); o.z = pk2(acc[4], acc[5]); o.w = pk2(acc[6], acc[7]);
        if (c0 < G1W) *(v4u*)(G1 + (size_t)row * G1W + c0) = o; else *(v4u*)(G2 + (size_t)row * G2W + (c0 - G1W)) = o;
    }
}
__device__ __forceinline__ void phase_c2_naive(ArgsP a, int layer) {
    const bf16* Y = (const bf16*)(a->ws + WS_YMIX); const bf16* W = (const bf16*)(a->ws + WS_WOUT) + (size_t)layer * 1024 * 1024;
    const float* MOD = (const float*)(a->ws + WS_MOD);
    const size_t total = (size_t)T * 256, stride = (size_t)grid_() * NTHREADS;
    for (size_t idx = (size_t)bid_() * NTHREADS + tid_(); idx < total; idx += stride) {
        const int row = (int)(idx >> 8), c0 = (int)(idx & 255) * 4;
        float acc[4] = {0.f, 0.f, 0.f, 0.f};
        const v4u* ap = (const v4u*)(Y + (size_t)row * 1024); const v4u* bp = (const v4u*)(W + (size_t)c0 * 1024);
        for (int kc = 0; kc < 128; ++kc) { const v4u av = ap[kc];
#pragma unroll
            for (int c = 0; c < 4; ++c) acc[c] = dot8(av, bp[c * 128 + kc], acc[c]); }
        const Tok tk = tok_of(row);
        const f32x4 gate = *(const f32x4*)(MOD + (size_t)(layer * 9 + tk.modrow) * 3072 + 2048 + c0);
        const f32x4 x = *(const f32x4*)(xrow_src(a, layer, row) + c0);
        f32x4 z; z.x = ALPHA * x.x + gate.x * acc[0]; z.y = ALPHA * x.y + gate.y * acc[1]; z.z = ALPHA * x.z + gate.z * acc[2]; z.w = ALPHA * x.w + gate.w * acc[3];
        *(f32x4*)(a->out + (size_t)row * D + c0) = z;
    }
}

__device__ __forceinline__ void phase_a2_naive(ArgsP a, LAS unsigned char* lds, int layer) {
    const int tid = tid_(), lane = tid & 63, wave = tid >> 6, G = grid_();
    LAS float* AQ = (LAS float*)lds;
    LAS float* AKV = (LAS float*)(lds + 16384);
    LAS float* OT = (LAS float*)(lds + 24576);
    const bf16* G2 = (const bf16*)(a->ws + WS_G2);
    bf16* Q = (bf16*)(a->ws + WS_Q); bf16* KN = (bf16*)(a->ws + WS_KN); bf16* KR = (bf16*)(a->ws + WS_KR); bf16* VT = (bf16*)(a->ws + WS_VT);
    const bf16* WUQ = (const bf16*)(a->ws + WS_WUQ) + (size_t)layer * 768 * 256;
    const bf16* WUKV = (const bf16*)(a->ws + WS_WUKV) + (size_t)layer * 1024 * 128;
    constexpr int NT_TOK = T / 16, NT_CACHE = 8 * 256 / 16;
    for (int tile = bid_(); tile < NT_TOK + NT_CACHE; tile += G) {
        const bool is_tok = tile < NT_TOK;
        for (int rr = 0; rr < 2; ++rr) {
            const int r = wave * 2 + rr;
            if (is_tok) {
                const int n = tile * 16 + r; const Tok tk = tok_of(n);
                const v2u cqv = *(const v2u*)(G2 + (size_t)n * G2W + lane * 4);
                const float c0 = bflo(cqv.x), c1 = bfhi(cqv.x), c2 = bflo(cqv.y), c3 = bfhi(cqv.y);
                const float rq = rsqrt_(wave_sum(c0 * c0 + c1 * c1 + c2 * c2 + c3 * c3) * (1.f / 256.f) + 1e-6f);
                const f32x4 qn = *(const f32x4*)(a->in[I_QNORM] + layer * 256 + lane * 4);
                AQ[r * 256 + lane * 4 + 0] = bf2f(f2bf(c0 * rq * qn.x)); AQ[r * 256 + lane * 4 + 1] = bf2f(f2bf(c1 * rq * qn.y));
                AQ[r * 256 + lane * 4 + 2] = bf2f(f2bf(c2 * rq * qn.z)); AQ[r * 256 + lane * 4 + 3] = bf2f(f2bf(c3 * rq * qn.w));
                float k0 = 0.f, k1 = 0.f, k2 = 0.f, k3 = 0.f;
                if (lane < 32) { const v2u kv = *(const v2u*)(G2 + (size_t)n * G2W + 256 + lane * 4); k0 = bflo(kv.x); k1 = bfhi(kv.x); k2 = bflo(kv.y); k3 = bfhi(kv.y); }
                const float rk = rsqrt_(wave_sum(k0 * k0 + k1 * k1 + k2 * k2 + k3 * k3) * (1.f / 128.f) + 1e-6f);
                if (lane < 32) {
                    const f32x4 kn = *(const f32x4*)(a->in[I_KVNORM] + layer * 128 + lane * 4);
                    f32x4 o; o.x = k0 * rk * kn.x; o.y = k1 * rk * kn.y; o.z = k2 * rk * kn.z; o.w = k3 * rk * kn.w;
                    if (!tk.lat) *(f32x4*)(a->out + O_CKV + ((size_t)(tk.b * 2 + layer) * 256 + tk.t) * 128 + lane * 4) = o;
                    AKV[r * 128 + lane * 4 + 0] = bf2f(f2bf(o.x)); AKV[r * 128 + lane * 4 + 1] = bf2f(f2bf(o.y));
                    AKV[r * 128 + lane * 4 + 2] = bf2f(f2bf(o.z)); AKV[r * 128 + lane * 4 + 3] = bf2f(f2bf(o.w));
                }
                float krv = (lane < 32) ? bf2f(G2[(size_t)n * G2W + 384 + lane]) : 0.f;
                const float other = __shfl_xor(krv, 1);
                if (lane < 32) {
                    if (!tk.lat) a->out[O_KR + ((size_t)(tk.b * 2 + layer) * 256 + tk.t) * 32 + lane] = krv;
                    else { float c, s; rope_angle(tk.t, lane >> 1, c, s); krv = (lane & 1) ? (other * s + krv * c) : (krv * c - other * s); }
                    KR[(size_t)tk.kidx * 32 + lane] = (bf16)f2bf(krv);
                }
            } else {
                const int cr = (tile - NT_TOK) * 16 + r, b = cr >> 8, j = cr & 255;
                const size_t src = ((size_t)(b * 2 + layer) * 256 + j);
                if (lane < 32) { const f32x4 v = *(const f32x4*)(a->in[I_CCKV] + src * 128 + lane * 4);
                    AKV[r * 128 + lane * 4 + 0] = bf2f(f2bf(v.x)); AKV[r * 128 + lane * 4 + 1] = bf2f(f2bf(v.y)); AKV[r * 128 + lane * 4 + 2] = bf2f(f2bf(v.z)); AKV[r * 128 + lane * 4 + 3] = bf2f(f2bf(v.w));
                    KR[(size_t)(T_CTX + b * LK_LAT + j) * 32 + lane] = (bf16)f2bf(a->in[I_CKR][src * 32 + lane]); }
            }
        }
        __syncthreads();
        if (is_tok) {
            for (int col = tid; col < 768; col += NTHREADS) {
                float acc[16];
#pragma unroll
                for (int r = 0; r < 16; ++r) acc[r] = 0.f;
                const v4u* wp = (const v4u*)(WUQ + (size_t)col * 256);
                for (int kc = 0; kc < 32; ++kc) { const v4u w = wp[kc];
                    const float w0 = bflo(w.x), w1 = bfhi(w.x), w2 = bflo(w.y), w3 = bfhi(w.y), w4 = bflo(w.z), w5 = bfhi(w.z), w6 = bflo(w.w), w7 = bfhi(w.w);
#pragma unroll
                    for (int r = 0; r < 16; ++r) { const f32x4 x0 = *(const LAS f32x4*)(AQ + r * 256 + kc * 8), x1 = *(const LAS f32x4*)(AQ + r * 256 + kc * 8 + 4);
                        acc[r] += x0.x * w0 + x0.y * w1 + x0.z * w2 + x0.w * w3 + x1.x * w4 + x1.y * w5 + x1.z * w6 + x1.w * w7; } }
#pragma unroll
                for (int r = 0; r < 16; ++r) OT[r * 1024 + col] = acc[r];
            }
            __syncthreads();
            for (int idx = tid; idx < 16 * 384; idx += NTHREADS) {
                const int r = idx / 384, col = (idx % 384) * 2, d = col % 96; const int n = tile * 16 + r; const Tok tk = tok_of(n);
                float v0 = OT[r * 1024 + col], v1 = OT[r * 1024 + col + 1];
                if (tk.lat && d >= 64) { float c, s; rope_angle(tk.t, (d - 64) >> 1, c, s); const float y0 = v0 * c - v1 * s, y1 = v0 * s + v1 * c; v0 = y0; v1 = y1; }
                *(unsigned*)(Q + (size_t)n * 768 + col) = pk2(v0, v1);
            }
            __syncthreads();
        }
        for (int col = tid; col < 1024; col += NTHREADS) {
            float acc[16];
#pragma unroll
            for (int r = 0; r < 16; ++r) acc[r] = 0.f;
            const v4u* wp = (const v4u*)(WUKV + (size_t)col * 128);
            for (int kc = 0; kc < 16; ++kc) { const v4u w = wp[kc];
                const float w0 = bflo(w.x), w1 = bfhi(w.x), w2 = bflo(w.y), w3 = bfhi(w.y), w4 = bflo(w.z), w5 = bfhi(w.z), w6 = bflo(w.w), w7 = bfhi(w.w);
#pragma unroll
                for (int r = 0; r < 16; ++r) { const f32x4 x0 = *(const LAS f32x4*)(AKV + r * 128 + kc * 8), x1 = *(const LAS f32x4*)(AKV + r * 128 + kc * 8 + 4);
                    acc[r] += x0.x * w0 + x0.y * w1 + x0.z * w2 + x0.w * w3 + x1.x * w4 + x1.y * w5 + x1.z * w6 + x1.w * w7; } }
#pragma unroll
            for (int r = 0; r < 16; ++r) OT[r * 1024 + col] = acc[r];
        }
        __syncthreads();
        for (int idx = tid; idx < 16 * 1024; idx += NTHREADS) {
            const int r = idx >> 10, col = idx & 1023, h = col >> 7, f = col & 127;
            int kidx, lat, b, kpos;
            if (is_tok) { const Tok tk = tok_of(tile * 16 + r); kidx = tk.kidx; lat = tk.lat; b = tk.b; kpos = tk.lat ? PAST + tk.t : tk.t; }
            else { const int cr = (tile - NT_TOK) * 16 + r; b = cr >> 8; kpos = cr & 255; lat = 1; kidx = T_CTX + b * LK_LAT + kpos; }
            const bf16 v = (bf16)f2bf(OT[r * 1024 + col]);
            if (f < 64) KN[(size_t)kidx * 512 + h * 64 + f] = v;
            else { const int dv = f - 64; const size_t base = lat ? (size_t)VT_LAT + ((size_t)(b * 8 + h) * 64 + dv) * LK_LAT : ((size_t)(b * 8 + h) * 64 + dv) * 256; VT[base + kpos] = v; }
        }
        __syncthreads();
    }
}

__device__ __forceinline__ void phase_att_naive(ArgsP a) {
    const bf16* KN = (const bf16*)(a->ws + WS_KN); const bf16* KR = (const bf16*)(a->ws + WS_KR); const bf16* VT = (const bf16*)(a->ws + WS_VT);
    bf16* Q = (bf16*)(a->ws + WS_Q); const bf16* G1 = (const bf16*)(a->ws + WS_G1);
    const int total = T * 8, stride = grid_() * NTHREADS;
    for (int idx = bid_() * NTHREADS + tid_(); idx < total; idx += stride) {
        int n, h, Lk, kidx0; size_t vbase;
        if (idx < T_CTX * 8) { const int b = idx >> 11, hh = (idx >> 8) & 7, t = idx & 255; n = b * 256 + t; h = hh; Lk = 256; kidx0 = b * 256; vbase = ((size_t)(b * 8 + h) * 64) * 256; }
        else { const int m = idx - T_CTX * 8, b = m >> 14, hh = (m >> 11) & 7, t = m & 2047; n = T_CTX + b * 2048 + t; h = hh; Lk = LK_LAT; kidx0 = T_CTX + b * LK_LAT; vbase = (size_t)VT_LAT + ((size_t)(b * 8 + h) * 64) * LK_LAT; }
        v4u qp[12];
#pragma unroll
        for (int c = 0; c < 12; ++c) qp[c] = *(const v4u*)(Q + (size_t)n * 768 + h * 96 + c * 8);
        float acc[64];
#pragma unroll
        for (int d = 0; d < 64; ++d) acc[d] = 0.f;
        float m = -1e30f, l = 0.f;
        for (int j0 = 0; j0 < Lk; j0 += 8) {
            float s[8];
#pragma unroll
            for (int j = 0; j < 8; ++j) {
                const v4u* kp = (const v4u*)(KN + (size_t)(kidx0 + j0 + j) * 512 + h * 64); const v4u* rp = (const v4u*)(KR + (size_t)(kidx0 + j0 + j) * 32);
                float sv = 0.f;
#pragma unroll
                for (int c = 0; c < 8; ++c) sv = dot8(qp[c], kp[c], sv);
#pragma unroll
                for (int c = 0; c < 4; ++c) sv = dot8(qp[8 + c], rp[c], sv);
                s[j] = sv;
                __builtin_amdgcn_sched_barrier(0);
            }
            float mx = m;
#pragma unroll
            for (int j = 0; j < 8; ++j) mx = fmaxf(mx, s[j]);
            const float alpha = exp2f(m - mx); m = mx; float ps = 0.f;
#pragma unroll
            for (int j = 0; j < 8; ++j) { s[j] = exp2f(s[j] - mx); ps += s[j]; }
            l = l * alpha + ps;
            unsigned lk = (unsigned)Lk; asm volatile("" : "+v"(lk));
            const bf16* vp = VT + vbase + j0;
#pragma unroll
            for (int dg = 0; dg < 8; ++dg) {
#pragma unroll
                for (int dd = 0; dd < 8; ++dd) { const int d = dg * 8 + dd; const v4u w = *(const v4u*)(vp + (unsigned)d * lk);
                    acc[d] = acc[d] * alpha + s[0] * bflo(w.x) + s[1] * bfhi(w.x) + s[2] * bflo(w.y) + s[3] * bfhi(w.y) + s[4] * bflo(w.z) + s[5] * bfhi(w.z) + s[6] * bflo(w.w) + s[7] * bfhi(w.w); }
                __builtin_amdgcn_sched_barrier(0);
            }
        }
        const float inv = rcp_(l);
#pragma unroll
        for (int c = 0; c < 8; ++c) { const v4u g = *(const v4u*)(G1 + (size_t)n * G1W + C_GM + h * 64 + c * 8);
            v4u o;
            o.x = pk2(acc[c * 8 + 0] * inv * siluf_(bflo(g.x)), acc[c * 8 + 1] * inv * siluf_(bfhi(g.x)));
            o.y = pk2(acc[c * 8 + 2] * inv * siluf_(bflo(g.y)), acc[c * 8 + 3] * inv * siluf_(bfhi(g.y)));
            o.z = pk2(acc[c * 8 + 4] * inv * siluf_(bflo(g.z)), acc[c * 8 + 5] * inv * siluf_(bfhi(g.z)));
            o.w = pk2(acc[c * 8 + 6] * inv * siluf_(bflo(g.w)), acc[c * 8 + 7] * inv * siluf_(bfhi(g.w)));
            *(v4u*)(Q + (size_t)n * 768 + h * 96 + c * 8) = o; }
    }
}
namespace pg8 {
#define PG8_LAS __attribute__((address_space(3)))
typedef unsigned short bf16_t;
typedef short bf16x8 __attribute__((ext_vector_type(8)));
typedef float f32x4 __attribute__((ext_vector_type(4)));
typedef unsigned u32x4 __attribute__((ext_vector_type(4)));
constexpr int BM = 256, BK = 64, HALF = 128, HTB = HALF * BK * 2  , STAGE_BYTES = 8 * HTB, NXCD = 8, WGM = 8;

__host__ __device__ __forceinline__ int lds_byte(int r, int c) { const int st = (r >> 4) * 2 + (c >> 5), rr = r & 15, cc = c & 31, ob = rr * 64 + cc * 2; return st * 1024 + (ob ^ (((ob >> 9) & 1) << 5)); }
__host__ __device__ __forceinline__ void stage_rc(int b, int& R, int& C) { const int st = b / 1024, sb = b % 1024, swz = sb ^ (((sb >> 9) & 1) << 5); R = (st >> 1) * 16 + swz / 64; C = (st & 1) * 32 + (swz % 64) / 2; }
__host__ __device__ __forceinline__ int perm32(int rho) { const int n = rho >> 4, i = rho & 15; return 8 * (i >> 2) + 4 * n + (i & 3); }

struct Unit { int pm, pn, gid; };
struct Gemm { const bf16_t* A; const bf16_t* Bt; int M, N, K, lda, ldb; };

struct StaticOrder {
    int nM, nN, nwg, G, c;
    __host__ __device__ void init(int M, int N, int G_, int c_) { nM = M / BM; nN = N / BM; nwg = nM * nN; G = G_; c = c_; }
    __host__ __device__ bool next(int i, Unit& u) const {
        const long L = (long)i * G + c; if (L >= nwg) return false;
        int wgid = (int)L; { const int q = nwg / NXCD, r = nwg % NXCD, xcd = wgid % NXCD, off = wgid / NXCD; wgid = (xcd < r ? xcd * (q + 1) : r * (q + 1) + (xcd - r) * q) + off; }
        const int nig = WGM * nN, gid = wgid / nig, fm = gid * WGM, gsz = (nM - fm) < WGM ? (nM - fm) : WGM;
        u.pm = fm + ((wgid % nig) % gsz); u.pn = (wgid % nig) / gsz; u.gid = 0; return true;
    }
    __device__ __forceinline__ const char* abase(const Gemm& g, const Unit& u) const { return (const char*)g.A + (size_t)u.pm * BM * g.lda * 2; }
    __device__ __forceinline__ const char* bbase(const Gemm& g, const Unit& u) const { return (const char*)g.Bt + (size_t)u.pn * BM * g.ldb * 2; }
    __device__ __forceinline__ void a_ready(const Unit&) const {}
    __device__ __forceinline__ void done(const Unit&) const {}
};
__device__ __forceinline__ unsigned cvt_pk_bf16(float lo, float hi) { unsigned r; asm volatile("v_cvt_pk_bf16_f32 %0, %1, %2" : "=v"(r) : "v"(lo), "v"(hi)); return r; }

template <class Epi, class Sched, bool STAMP = false>
__device__ __forceinline__ void gemm_phase(PG8_LAS unsigned char* lds, const Gemm g, const Sched& S, const Epi& E, unsigned long long* stamps) {
    const int tid = tid_(), wid = __builtin_amdgcn_readfirstlane(tid >> 6), lane = tid & 63, wr = wid >> 2, wc = wid & 3, fr = lane & 15, fq = lane >> 4;
    const int K = g.K, nt = K / BK;
    int ts_lo = 0, ts_hi = 0, nts = 0; const unsigned long long rt_entry = STAMP ? (unsigned long long)wall_clock64() : 0ull;
#define PG8_STAMP() do { if (STAMP && wid == 0 && nts < 64) { const unsigned long long _c = (unsigned long long)clock64(); \
        ts_lo = (lane == nts) ? (int)(unsigned)_c : ts_lo; ts_hi = (lane == nts) ? (int)(unsigned)(_c >> 32) : ts_hi; ++nts; } } while (0)
    PG8_STAMP();
    unsigned voffA[2], voffB[2];
#pragma unroll
    for (int i = 0; i < 2; ++i) { int R, C; stage_rc(tid * 16 + i * 8192, R, C); const int Rb = Epi::PERM ? ((R & ~31) + perm32(R & 31)) : R;
        voffA[i] = (unsigned)(R * g.lda + C) * 2u; voffB[i] = (unsigned)(Rb * g.ldb + C) * 2u; }
    const size_t kstep = (size_t)(BK * 2);
    const size_t hstepA = (size_t)HALF * g.lda * 2, hstepB = (size_t)HALF * g.ldb * 2;
    const unsigned ldsw = (unsigned)wid * 1024u;
    const int aoff = lds_byte(wr * 64 + fr, fq * 8), boff = lds_byte(wc * 32 + fr, fq * 8);
#define PG8_SA(b, h) (((b) * 2 + (h)) * HTB)
#define PG8_SB(b, h) ((4 + (b) * 2 + (h)) * HTB)
#define PG8_STAGE(bufoff, gbase, voff) do { _Pragma("unroll") for (int _i = 0; _i < 2; ++_i) \
        __builtin_amdgcn_global_load_lds((const unsigned*)((const char*)(gbase) + (voff)[_i]), (PG8_LAS unsigned*)(lds + (bufoff) + ldsw + _i * 8192), 16, 0, 0); } while (0)
#define PG8_LDA(dst, b, h) do { _Pragma("unroll") for (int m = 0; m < 4; ++m) _Pragma("unroll") for (int k = 0; k < 2; ++k) dst[m][k] = *(const PG8_LAS bf16x8*)(lds + PG8_SA(b, h) + aoff + m * 2048 + k * 1024); } while (0)
#define PG8_LDB(dst, b, h) do { _Pragma("unroll") for (int n = 0; n < 2; ++n) _Pragma("unroll") for (int k = 0; k < 2; ++k) dst[n][k] = *(const PG8_LAS bf16x8*)(lds + PG8_SB(b, h) + boff + n * 2048 + k * 1024); } while (0)
#define PG8_MMA(ai, bj, At, Bt) do { __builtin_amdgcn_s_setprio(1); _Pragma("unroll") for (int m = 0; m < 4; ++m) _Pragma("unroll") for (int n = 0; n < 2; ++n) _Pragma("unroll") for (int k = 0; k < 2; ++k) \
        acc[ai][bj][m][n] = __builtin_amdgcn_mfma_f32_16x16x32_bf16(Bt[n][k], At[m][k], acc[ai][bj][m][n], 0, 0, 0); __builtin_amdgcn_s_setprio(0); } while (0)
#define PG8_WAIT_V(n) asm volatile("s_waitcnt vmcnt(" #n ")" ::: "memory")
#define PG8_WAIT_L(n) asm volatile("s_waitcnt lgkmcnt(" #n ")" ::: "memory")
#define PG8_BAR __builtin_amdgcn_s_barrier()
#define PG8_SCHED __builtin_amdgcn_sched_barrier(0)
    Unit cur, nxt; int ui = 0;
    if (!S.next(0, cur)) return;
    f32x4 acc[2][2][4][2];
#pragma unroll
    for (int a = 0; a < 2; ++a)
#pragma unroll
        for (int b = 0; b < 2; ++b)
#pragma unroll
            for (int m = 0; m < 4; ++m)
#pragma unroll
                for (int n = 0; n < 2; ++n) acc[a][b][m][n] = (f32x4){0.f, 0.f, 0.f, 0.f};
    bf16x8 At[4][2], B0[2][2], B1[2][2];
    const char* cA = S.abase(g, cur); const char* cB = S.bbase(g, cur);
    S.a_ready(cur);
    PG8_STAGE(PG8_SB(0, 0), cB, voffB); PG8_STAGE(PG8_SA(0, 0), cA, voffA); PG8_STAGE(PG8_SB(0, 1), cB + hstepB, voffB); PG8_STAGE(PG8_SA(0, 1), cA + hstepA, voffA);
    if (wr == 1) PG8_BAR;
    PG8_WAIT_V(4); PG8_BAR;
    PG8_STAGE(PG8_SB(1, 0), cB + kstep, voffB); PG8_STAGE(PG8_SA(1, 0), cA + kstep, voffA); PG8_STAGE(PG8_SB(1, 1), cB + hstepB + kstep, voffB);
    PG8_WAIT_V(6); PG8_BAR;
    PG8_STAMP();
    for (;;) {
        const bool has_next = S.next(ui + 1, nxt);
        const char* nA = has_next ? S.abase(g, nxt) : cA; const char* nB = has_next ? S.bbase(g, nxt) : cB;
        for (int t = 0; t < nt; t += 2) {
            const bool last = (t == nt - 2);
            const char* a1 = cA + (size_t)(t + 1) * kstep;
            const char* a2 = last ? nA : cA + (size_t)(t + 2) * kstep; const char* b2 = last ? nB : cB + (size_t)(t + 2) * kstep;
            const char* a3 = a2 + kstep; const char* b3 = b2 + kstep;
            if (last && has_next) S.a_ready(nxt);
            PG8_LDB(B0, 0, 0); PG8_SCHED; PG8_LDA(At, 0, 0); PG8_STAGE(PG8_SA(1, 1), a1 + hstepA, voffA);
            PG8_WAIT_L(8); PG8_BAR; PG8_WAIT_L(0); PG8_MMA(0, 0, At, B0); PG8_BAR; PG8_SCHED;
            PG8_LDB(B1, 0, 1); PG8_STAGE(PG8_SB(0, 0), b2, voffB);
            PG8_BAR; PG8_WAIT_L(0); PG8_MMA(0, 1, At, B1); PG8_BAR;
            PG8_LDA(At, 0, 1); PG8_STAGE(PG8_SA(0, 0), a2, voffA);
            PG8_BAR; PG8_WAIT_L(0); PG8_MMA(1, 0, At, B0); PG8_BAR; PG8_SCHED;
            PG8_STAGE(PG8_SB(0, 1), b2 + hstepB, voffB);
            PG8_WAIT_V(6); PG8_BAR; PG8_MMA(1, 1, At, B1); PG8_BAR;
            PG8_LDB(B0, 1, 0); PG8_SCHED; PG8_LDA(At, 1, 0); PG8_STAGE(PG8_SA(0, 1), a2 + hstepA, voffA);
            PG8_WAIT_L(8); PG8_BAR; PG8_WAIT_L(0); PG8_MMA(0, 0, At, B0); PG8_BAR; PG8_SCHED;
            PG8_LDB(B1, 1, 1); PG8_STAGE(PG8_SB(1, 0), b3, voffB);
            PG8_BAR; PG8_WAIT_L(0); PG8_MMA(0, 1, At, B1); PG8_BAR;
            PG8_LDA(At, 1, 1); PG8_STAGE(PG8_SA(1, 0), a3, voffA);
            PG8_BAR; PG8_WAIT_L(0); PG8_MMA(1, 0, At, B0); PG8_BAR; PG8_SCHED;
            PG8_STAGE(PG8_SB(1, 1), b3 + hstepB, voffB);
            PG8_WAIT_V(6); PG8_BAR; PG8_MMA(1, 1, At, B1); PG8_BAR;
        }
        PG8_STAMP();
        if constexpr (!Epi::AFTER_DRAIN) { E(acc, cur, wr, wc, fr, fq); S.done(cur); }
        PG8_STAMP();
        if (!has_next) break;
#pragma unroll
        for (int a = 0; a < 2; ++a)
#pragma unroll
            for (int b = 0; b < 2; ++b)
#pragma unroll
                for (int m = 0; m < 4; ++m)
#pragma unroll
                    for (int n = 0; n < 2; ++n) acc[a][b][m][n] = (f32x4){0.f, 0.f, 0.f, 0.f};
        cur = nxt; cA = nA; cB = nB; ++ui;
    }
    PG8_WAIT_V(0);
    if (wr == 0) PG8_BAR;
    PG8_BAR;
    if constexpr (Epi::AFTER_DRAIN) { E.fused(acc, cur, wr, wc, fr, fq, lds, wid, lane); S.done(cur); }
    PG8_STAMP();
    if (STAMP && wid == 0) { stamps[lane] = lane < nts ? (((unsigned long long)(unsigned)ts_hi << 32) | (unsigned)ts_lo) : 0ull;
        if (lane == 62) stamps[62] = rt_entry; if (lane == 63) stamps[63] = (unsigned long long)wall_clock64(); }
#undef PG8_STAMP
#undef PG8_SA
#undef PG8_SB
#undef PG8_STAGE
#undef PG8_LDA
#undef PG8_LDB
#undef PG8_MMA
#undef PG8_WAIT_V
#undef PG8_WAIT_L
#undef PG8_BAR
#undef PG8_SCHED
}
}
namespace pg8 {
struct EpiIn {
    static constexpr bool PERM = true, AFTER_DRAIN = false;
    bf16_t* G1; bf16_t* G2;
    __device__ __forceinline__ void operator()(const f32x4 (&acc)[2][2][4][2], const Unit& u, int wr, int wc, int fr, int fq) const {
        const int row0 = u.pm * BM + wr * 64 + fr;
        bf16_t* base; int ldc, colt;
        if (u.pn < 9) { base = G1; ldc = 2304; colt = u.pn * 256; } else { base = G2; ldc = 512; colt = (u.pn - 9) * 256; }
        const int col0 = colt + wc * 32 + 8 * fq;
#pragma unroll
        for (int ai = 0; ai < 2; ++ai)
#pragma unroll
            for (int m = 0; m < 4; ++m) { bf16_t* rowp = base + (size_t)(row0 + ai * HALF + m * 16) * ldc + col0;
#pragma unroll
                for (int bj = 0; bj < 2; ++bj) { const f32x4 v0 = acc[ai][bj][m][0], v1 = acc[ai][bj][m][1];
                    u32x4 w; w.x = cvt_pk_bf16(v0[0], v0[1]); w.y = cvt_pk_bf16(v0[2], v0[3]); w.z = cvt_pk_bf16(v1[0], v1[1]); w.w = cvt_pk_bf16(v1[2], v1[3]);
                    *(u32x4*)(rowp + bj * HALF) = w; } }
    }
};
struct EpiOut {
    static constexpr bool PERM = true, AFTER_DRAIN = false;
    const float* xp; const float* xs; float* out; const float* mod; int layer;
    const float* stats; const float* lng; const float* lnb;
    __device__ __forceinline__ void operator()(const f32x4 (&acc)[2][2][4][2], const Unit& u, int wr, int wc, int fr, int fq) const {
        const int row0 = u.pm * BM + wr * 64 + fr, col0 = u.pn * BM + wc * 32 + 8 * fq;
        const int rt = u.pm * BM; const int modrow = rt < 8192 ? 0 : 1 + ((rt - 8192) >> 11);
        const float* gp = mod + (size_t)modrow * 3072 + 2048 + col0;
        f32x4 gv[2][2];
#pragma unroll
        for (int bj = 0; bj < 2; ++bj)
#pragma unroll
            for (int n = 0; n < 2; ++n) gv[bj][n] = *(const f32x4*)(gp + bj * HALF + n * 4);
        f32x4 lg[2][2], lb[2][2];
        if (layer) {
#pragma unroll
            for (int bj = 0; bj < 2; ++bj)
#pragma unroll
                for (int n = 0; n < 2; ++n) { lg[bj][n] = *(const f32x4*)(lng + col0 + bj * HALF + n * 4); lb[bj][n] = *(const f32x4*)(lnb + col0 + bj * HALF + n * 4); }
        }
        f32x4 xn[2][2]; float mean_n = 0.f, rstd_n = 1.f;
#define EO_LOAD(am_) do { const int row_ = row0 + ((am_) >> 2) * HALF + ((am_) & 3) * 16; \
            if (layer == 0) { const float* xr_ = (row_ < 8192 ? xp + (size_t)row_ * 1024 : xs + (size_t)(row_ - 8192) * 1024) + col0; \
                xn[0][0] = *(const f32x4*)(xr_); xn[0][1] = *(const f32x4*)(xr_ + 4); xn[1][0] = *(const f32x4*)(xr_ + HALF); xn[1][1] = *(const f32x4*)(xr_ + HALF + 4); } \
            else { const bf16_t* zr_ = (const bf16_t*)out + (size_t)row_ * 2048 + col0; const u32x4 z0_ = *(const u32x4*)zr_, z1_ = *(const u32x4*)(zr_ + HALF); \
                xn[0][0] = (f32x4){__uint_as_float(z0_.x << 16), __uint_as_float(z0_.x & 0xffff0000u), __uint_as_float(z0_.y << 16), __uint_as_float(z0_.y & 0xffff0000u)}; \
                xn[0][1] = (f32x4){__uint_as_float(z0_.z << 16), __uint_as_float(z0_.z & 0xffff0000u), __uint_as_float(z0_.w << 16), __uint_as_float(z0_.w & 0xffff0000u)}; \
                xn[1][0] = (f32x4){__uint_as_float(z1_.x << 16), __uint_as_float(z1_.x & 0xffff0000u), __uint_as_float(z1_.y << 16), __uint_as_float(z1_.y & 0xffff0000u)}; \
                xn[1][1] = (f32x4){__uint_as_float(z1_.z << 16), __uint_as_float(z1_.z & 0xffff0000u), __uint_as_float(z1_.w << 16), __uint_as_float(z1_.w & 0xffff0000u)}; \
                mean_n = stats[(size_t)row_ * 2]; rstd_n = stats[(size_t)row_ * 2 + 1]; } } while (0)
        EO_LOAD(0);
#pragma unroll
        for (int am = 0; am < 8; ++am) { const int ai = am >> 2, m = am & 3, row = row0 + ai * HALF + m * 16;
            const f32x4 xc[2][2] = {{xn[0][0], xn[0][1]}, {xn[1][0], xn[1][1]}}; const float mean = mean_n, rstd = rstd_n;
            if (am + 1 < 8) EO_LOAD(am + 1);
            bf16_t* orow = (bf16_t*)out + (size_t)row * 2048 + col0;
#pragma unroll
            for (int bj = 0; bj < 2; ++bj) { f32x4 z[2];
#pragma unroll
                for (int n = 0; n < 2; ++n) { f32x4 x = xc[bj][n];
                    if (layer) x = (x - mean) * rstd * lg[bj][n] + lb[bj][n];
                    z[n] = x * 1.4142135623730951f + gv[bj][n] * acc[ai][bj][m][n]; }
                u32x4 w; w.x = cvt_pk_bf16(z[0][0], z[0][1]); w.y = cvt_pk_bf16(z[0][2], z[0][3]); w.z = cvt_pk_bf16(z[1][0], z[1][1]); w.w = cvt_pk_bf16(z[1][2], z[1][3]);
                *(u32x4*)(orow + bj * HALF) = w; } }
#undef EO_LOAD
    }
};
}

__device__ __forceinline__ void phase_a1_pg8(ArgsP a, LAS unsigned char* lds, int layer) {
    pg8::Gemm g{(const bf16*)(a->ws + WS_U), (const bf16*)(a->ws + WS_WIN) + (size_t)layer * NIN * 1024, T, NIN, 1024, 1024, 1024};
    pg8::StaticOrder S; S.init(T, NIN, grid_(), bid_());
    pg8::EpiIn E{(bf16*)(a->ws + WS_G1), (bf16*)(a->ws + WS_G2)};
    pg8::gemm_phase<pg8::EpiIn, pg8::StaticOrder, false>(lds, g, S, E, nullptr);
}
__device__ __forceinline__ void phase_c2_pg8(ArgsP a, LAS unsigned char* lds, int layer) {
    pg8::Gemm g{(const bf16*)(a->ws + WS_YMIX), (const bf16*)(a->ws + WS_WOUT) + (size_t)layer * 1024 * 1024, T, 1024, 1024, 1024, 1024};
    pg8::StaticOrder S; S.init(T, 1024, grid_(), bid_());
    pg8::EpiOut E{a->in[I_XP], a->in[I_XS], a->out, (const float*)(a->ws + WS_MOD) + (size_t)layer * 9 * 3072, layer, (const float*)(a->ws + WS_STATS), a->in[I_LNG], a->in[I_LNB]};
    pg8::gemm_phase<pg8::EpiOut, pg8::StaticOrder, false>(lds, g, S, E, nullptr);
}

__device__ __forceinline__ void phase_a2a(ArgsP a, int layer) {
    const int tid = tid_(), lane = tid & 63, wave = tid >> 6, G = grid_();
    bf16* G2 = (bf16*)(a->ws + WS_G2); bf16* KR = (bf16*)(a->ws + WS_KR); bf16* CK = (bf16*)(a->ws + WS_HF);
    const float* ROPE = (const float*)(a->ws + WS_ROPE);
    f32x4 nw0 = {0.f, 0.f, 0.f, 0.f}, nw1 = {0.f, 0.f, 0.f, 0.f};
    if (lane < 32) { nw0 = *(const f32x4*)(a->in[I_QNORM] + layer * 256 + lane * 8); nw1 = *(const f32x4*)(a->in[I_QNORM] + layer * 256 + lane * 8 + 4); }
    else if (lane < 48) { nw0 = *(const f32x4*)(a->in[I_KVNORM] + layer * 128 + (lane - 32) * 8); nw1 = *(const f32x4*)(a->in[I_KVNORM] + layer * 128 + (lane - 32) * 8 + 4); }
    v4u nx = {0u, 0u, 0u, 0u};
    { const int n0 = bid_() * 8 + wave; if (n0 < T) nx = *(const v4u*)(G2 + (size_t)n0 * G2W + lane * 8); }
    for (int n = bid_() * 8 + wave; n < T; n += G * 8) {
        const v4u w = nx;
        if (n + G * 8 < T) nx = *(const v4u*)(G2 + (size_t)(n + G * 8) * G2W + lane * 8);
        const Tok tk = tok_of(n);
        float x[8] = {bflo(w.x), bfhi(w.x), bflo(w.y), bfhi(w.y), bflo(w.z), bfhi(w.z), bflo(w.w), bfhi(w.w)};
        const float ss = (x[0] * x[0] + x[1] * x[1]) + (x[2] * x[2] + x[3] * x[3]) + (x[4] * x[4] + x[5] * x[5]) + (x[6] * x[6] + x[7] * x[7]);
        const float sq = wave_sum(lane < 32 ? ss : 0.f), sk = wave_sum((lane >= 32 && lane < 48) ? ss : 0.f);
        const float rs = lane < 32 ? rsqrt_(sq * (1.f / 256.f) + 1e-6f) : rsqrt_(sk * (1.f / 128.f) + 1e-6f);
        if (lane < 48) {
            const float y0 = x[0] * rs * nw0.x, y1 = x[1] * rs * nw0.y, y2 = x[2] * rs * nw0.z, y3 = x[3] * rs * nw0.w, y4 = x[4] * rs * nw1.x, y5 = x[5] * rs * nw1.y, y6 = x[6] * rs * nw1.z, y7 = x[7] * rs * nw1.w;
            *(v4u*)(G2 + (size_t)n * G2W + lane * 8) = (v4u){cvtpk(y0, y1), cvtpk(y2, y3), cvtpk(y4, y5), cvtpk(y6, y7)};
            if (lane >= 32 && !tk.lat) { float* op = a->out + O_CKV + ((size_t)(tk.b * 2 + layer) * 256 + tk.t) * 128 + (lane - 32) * 8;
                *(f32x4*)op = (f32x4){y0, y1, y2, y3}; *(f32x4*)(op + 4) = (f32x4){y4, y5, y6, y7}; }
        } else if (lane < 52) {
            const int d0 = (lane - 48) * 8;
            if (!tk.lat) { float* op = a->out + O_KR + ((size_t)(tk.b * 2 + layer) * 256 + tk.t) * 32 + d0;
                *(f32x4*)op = (f32x4){x[0], x[1], x[2], x[3]}; *(f32x4*)(op + 4) = (f32x4){x[4], x[5], x[6], x[7]};
                *(v4u*)(KR + (size_t)tk.kidx * 32 + d0) = w; }
            else { const f32x4 c0 = *(const f32x4*)(ROPE + ((size_t)tk.t * 16 + (d0 >> 1)) * 2), c1 = *(const f32x4*)(ROPE + ((size_t)tk.t * 16 + (d0 >> 1) + 2) * 2);
                const float y0 = x[0] * c0.x - x[1] * c0.y, y1 = x[0] * c0.y + x[1] * c0.x, y2 = x[2] * c0.z - x[3] * c0.w, y3 = x[2] * c0.w + x[3] * c0.z;
                const float y4 = x[4] * c1.x - x[5] * c1.y, y5 = x[4] * c1.y + x[5] * c1.x, y6 = x[6] * c1.z - x[7] * c1.w, y7 = x[6] * c1.w + x[7] * c1.z;
                *(v4u*)(KR + (size_t)tk.kidx * 32 + d0) = (v4u){cvtpk(y0, y1), cvtpk(y2, y3), cvtpk(y4, y5), cvtpk(y6, y7)}; }
        }
    }
    for (int r = bid_() * 8 + wave; r < 2048; r += G * 8) {
        const int b = r >> 8, j = r & 255; const size_t src = (size_t)(b * 2 + layer) * 256 + j;
        if (lane < 16) { const f32x4 v0 = *(const f32x4*)(a->in[I_CCKV] + src * 128 + lane * 8), v1 = *(const f32x4*)(a->in[I_CCKV] + src * 128 + lane * 8 + 4);
            *(v4u*)(CK + (size_t)r * 512 + lane * 8) = (v4u){cvtpk(v0.x, v0.y), cvtpk(v0.z, v0.w), cvtpk(v1.x, v1.y), cvtpk(v1.z, v1.w)}; }
        else if (lane < 32) *(v4u*)(CK + (size_t)r * 512 + lane * 8) = (v4u){0u, 0u, 0u, 0u};
        else if (lane < 36) { const f32x4 v0 = *(const f32x4*)(a->in[I_CKR] + src * 32 + (lane - 32) * 8), v1 = *(const f32x4*)(a->in[I_CKR] + src * 32 + (lane - 32) * 8 + 4);
            *(v4u*)(KR + (size_t)(T_CTX + b * LK_LAT + j) * 32 + (lane - 32) * 8) = (v4u){cvtpk(v0.x, v0.y), cvtpk(v0.z, v0.w), cvtpk(v1.x, v1.y), cvtpk(v1.z, v1.w)}; }
    }
}
namespace pg8 {
struct A2Order {
    const char* ws; unsigned oq, okv; int G, c;
    __device__ __forceinline__ bool next(int i, Unit& u) const {
        const int L = i * G + c; if (L >= 704) return false;
        if (L < 288) { u.gid = 0; u.pm = L / 3; u.pn = L % 3; } else if (L < 672) { u.gid = 1; u.pm = (L - 288) >> 2; u.pn = (L - 288) & 3; } else { u.gid = 2; u.pm = (L - 672) >> 2; u.pn = (L - 672) & 3; }
        return true;
    }
    __device__ __forceinline__ const char* abase(const Gemm&, const Unit& u) const { const unsigned off = u.gid == 0 ? (unsigned)WS_G2 : (u.gid == 1 ? (unsigned)WS_G2 + 512u : (unsigned)WS_HF); return ws + off + (size_t)u.pm * 256 * 512 * 2; }
    __device__ __forceinline__ const char* bbase(const Gemm&, const Unit& u) const { const unsigned off = u.gid == 0 ? oq : okv; return ws + off + (size_t)u.pn * 256 * 256 * 2; }
    __device__ __forceinline__ void a_ready(const Unit&) const {}
    __device__ __forceinline__ void done(const Unit&) const {}
};
struct EpiA2 {
    static constexpr bool PERM = true, AFTER_DRAIN = false;
    bf16_t* Q; bf16_t* KN; bf16_t* VR; const float* rope;
    __device__ __forceinline__ void operator()(const f32x4 (&acc)[2][2][4][2], const Unit& u, int wr, int wc, int fr, int fq) const {
        const int row0 = u.pm * BM + wr * 64 + fr;
        if (u.gid == 0) {
            const int fb = u.pn * 256 + wc * 32 + 8 * fq;
#pragma unroll
            for (int ai = 0; ai < 2; ++ai)
#pragma unroll
                for (int m = 0; m < 4; ++m) { const int row = row0 + ai * HALF + m * 16;
                    const float* rp = rope + (unsigned)(((row - 8192) & 2047) * 32);
#pragma unroll
                    for (int bj = 0; bj < 2; ++bj) {
                        f32x4 v0 = acc[ai][bj][m][0], v1 = acc[ai][bj][m][1];
                        const int f0 = fb + bj * HALF, d = f0 % 96;
                        if (row >= 8192 && d >= 64) { const f32x4 c0 = *(const f32x4*)(rp + (d - 64)), c1 = *(const f32x4*)(rp + (d - 64) + 4);
                            const f32x4 a0 = v0, a1 = v1;
                            v0[0] = a0[0] * c0[0] - a0[1] * c0[1]; v0[1] = a0[0] * c0[1] + a0[1] * c0[0]; v0[2] = a0[2] * c0[2] - a0[3] * c0[3]; v0[3] = a0[2] * c0[3] + a0[3] * c0[2];
                            v1[0] = a1[0] * c1[0] - a1[1] * c1[1]; v1[1] = a1[0] * c1[1] + a1[1] * c1[0]; v1[2] = a1[2] * c1[2] - a1[3] * c1[3]; v1[3] = a1[2] * c1[3] + a1[3] * c1[2]; }
                        u32x4 w; w.x = cvt_pk_bf16(v0[0], v0[1]); w.y = cvt_pk_bf16(v0[2], v0[3]); w.z = cvt_pk_bf16(v1[0], v1[1]); w.w = cvt_pk_bf16(v1[2], v1[3]);
                        *(u32x4*)(Q + (unsigned)(row * 768 + f0)) = w; } }
        } else {
            const int x = wc * 32 + 8 * fq;
            bf16_t* base = (wc < 2 ? KN : VR);
            const unsigned xo = (unsigned)(x & 63);
#pragma unroll
            for (int ai = 0; ai < 2; ++ai)
#pragma unroll
                for (int m = 0; m < 4; ++m) { const int row = row0 + ai * HALF + m * 16;
                    int kidx;
                    if (u.gid == 2) kidx = 8192 + (row >> 8) * 2304 + (row & 255);
                    else if (row < 8192) kidx = row;
                    else { const int mrow = row - 8192; kidx = 8192 + (mrow >> 11) * 2304 + 256 + (mrow & 2047); }
#pragma unroll
                    for (int bj = 0; bj < 2; ++bj) { const f32x4 v0 = acc[ai][bj][m][0], v1 = acc[ai][bj][m][1];
                        u32x4 w; w.x = cvt_pk_bf16(v0[0], v0[1]); w.y = cvt_pk_bf16(v0[2], v0[3]); w.z = cvt_pk_bf16(v1[0], v1[1]); w.w = cvt_pk_bf16(v1[2], v1[3]);
                        *(u32x4*)(base + (unsigned)(kidx * 512 + (u.pn * 2 + bj) * 64) + xo) = w; } }
        }
    }
};
}
__device__ __forceinline__ void phase_a2b(ArgsP a, LAS unsigned char* lds, int layer) {
    int kk = 256; asm volatile("" : "+s"(kk));
    pg8::Gemm g{nullptr, nullptr, T, 1024, kk, 512, 256};
    pg8::A2Order S{(const char*)a->ws, (unsigned)(WS_WUQ + (size_t)layer * 768 * 256 * 2), (unsigned)(WS_WUKV + (size_t)layer * 1024 * 256 * 2), grid_(), bid_()};
    pg8::EpiA2 E{(bf16*)(a->ws + WS_Q), (bf16*)(a->ws + WS_KN), (bf16*)(a->ws + WS_VT), (const float*)(a->ws + WS_ROPE)};
    pg8::gemm_phase<pg8::EpiA2, pg8::A2Order, false>(lds, g, S, E, nullptr);
}
__device__ __forceinline__ void rwkv_unit_seq(ArgsP a, LAS unsigned char* lds, int layer, int u) {
    const int tid = tid_();
    LAS float* W2s = (LAS float*)lds;
    LAS float* A2s = W2s + 4096;
    LAS float* TH = A2s + 4096;
    LAS float* HA = TH + 2048;
    LAS float* Wd = HA + 2048;
    LAS float* KT = Wd + 2048; LAS float* KK = KT + 2048; LAS float* BB = KK + 2048; LAS float* RR = BB + 2048; LAS float* VV = RR + 2048; LAS float* YO = VV + 2048;
    const int lat = u < 64, uu = lat ? u : u - 64, b = uu >> 3, e = (uu >> 2) & 1, hh = uu & 3;
    const int L = lat ? L_LAT : L_CTX, tok0 = lat ? T_CTX + b * L_LAT : b * L_CTX;
    const bf16* G1 = (const bf16*)(a->ws + WS_G1);
    bf16* YS = (bf16*)(a->ws + WS_G2);
    for (int i = tid; i < 4096; i += NTHREADS) { const int j = i >> 6, c = i & 63;
        W2s[i] = a->in[I_W2][((size_t)(layer * 2 + e) * 64 + j) * 256 + hh * 64 + c];
        A2s[i] = a->in[I_A2][((size_t)(layer * 2 + e) * 64 + j) * 256 + hh * 64 + c]; }
    const int r = tid >> 3, ks = tid & 7;
    float S[8];
#pragma unroll
    for (int j = 0; j < 8; ++j) S[j] = lat ? a->in[I_SRW][(((size_t)((b * 2 + layer) * 2 + e) * 4 + hh) * 64 + r) * 64 + ks * 8 + j] : 0.f;
    const int tt = tid >> 4, q4 = (tid & 15) * 4;
    float w0v[4], a0v[4], kkw[4], kav[4];
#pragma unroll
    for (int i = 0; i < 4; ++i) { const int ch = hh * 64 + q4 + i;
        w0v[i] = a->in[I_W0][(layer * 2 + e) * 256 + ch]; a0v[i] = a->in[I_A0][(layer * 2 + e) * 256 + ch]; kkw[i] = a->in[I_KK][layer * 256 + ch]; kav[i] = a->in[I_KA][layer * 256 + ch]; }
    __syncthreads();
    for (int c = 0; c < L / 32; ++c) {
        const int step = c * 32 + tt, t = e ? L - 1 - step : step, n = tok0 + t;
        const bf16* g = G1 + (size_t)n * G1W;
        { const v2u hw = *(const v2u*)(g + C_LORA + e * 64 + q4), ha = *(const v2u*)(g + C_LORA + 128 + e * 64 + q4);
          TH[tt * 64 + q4 + 0] = tanhf(bflo(hw.x)); TH[tt * 64 + q4 + 1] = tanhf(bfhi(hw.x)); TH[tt * 64 + q4 + 2] = tanhf(bflo(hw.y)); TH[tt * 64 + q4 + 3] = tanhf(bfhi(hw.y));
          HA[tt * 64 + q4 + 0] = bflo(ha.x); HA[tt * 64 + q4 + 1] = bfhi(ha.x); HA[tt * 64 + q4 + 2] = bflo(ha.y); HA[tt * 64 + q4 + 3] = bfhi(ha.y); }
        __syncthreads();
        {
            float wl[4], al[4];
#pragma unroll
            for (int i = 0; i < 4; ++i) { wl[i] = w0v[i]; al[i] = a0v[i]; }
            for (int j = 0; j < 64; ++j) { const float th = TH[tt * 64 + j], hv = HA[tt * 64 + j];
                const f32x4 w2 = *(const LAS f32x4*)(W2s + j * 64 + q4), a2 = *(const LAS f32x4*)(A2s + j * 64 + q4);
                wl[0] = fmaf(th, w2.x, wl[0]); wl[1] = fmaf(th, w2.y, wl[1]); wl[2] = fmaf(th, w2.z, wl[2]); wl[3] = fmaf(th, w2.w, wl[3]);
                al[0] = fmaf(hv, a2.x, al[0]); al[1] = fmaf(hv, a2.y, al[1]); al[2] = fmaf(hv, a2.z, al[2]); al[3] = fmaf(hv, a2.w, al[3]); }
            const v2u kv = *(const v2u*)(g + C_K + hh * 64 + q4), rv = *(const v2u*)(g + C_R + hh * 64 + q4), vv = *(const v2u*)(g + C_V + hh * 64 + q4);
            const float kx[4] = {bflo(kv.x), bfhi(kv.x), bflo(kv.y), bfhi(kv.y)}, rx[4] = {bflo(rv.x), bfhi(rv.x), bflo(rv.y), bfhi(rv.y)}, vx[4] = {bflo(vv.x), bfhi(vv.x), bflo(vv.y), bfhi(vv.y)};
            float kkr[4], ss = 0.f;
#pragma unroll
            for (int i = 0; i < 4; ++i) { kkr[i] = kx[i] * kkw[i]; ss += kkr[i] * kkr[i]; }
            ss += __shfl_xor(ss, 1); ss += __shfl_xor(ss, 2); ss += __shfl_xor(ss, 4); ss += __shfl_xor(ss, 8);
            const float inrm = rcp_(fmaxf(sqrt_(ss), 1e-12f));
#pragma unroll
            for (int i = 0; i < 4; ++i) {
                const float dec = exp_(-0.6065306597126334f * sigmoidf_(wl[i])), av = sigmoidf_(al[i]), kk = kkr[i] * inrm;
                const int o = tt * 64 + q4 + i;
                Wd[o] = dec; KT[o] = kx[i] * (1.f + (av - 1.f) * kav[i]); KK[o] = kk; BB[o] = kk * av; RR[o] = rx[i]; VV[o] = vx[i]; }
        }
        __syncthreads();
        for (int s = 0; s < 32; ++s) {
            const int o = s * 64 + ks * 8;
            const f32x4 k0 = *(const LAS f32x4*)(KK + o), k1 = *(const LAS f32x4*)(KK + o + 4);
            float p = S[0] * k0.x + S[1] * k0.y + S[2] * k0.z + S[3] * k0.w + S[4] * k1.x + S[5] * k1.y + S[6] * k1.z + S[7] * k1.w;
            p += __shfl_xor(p, 1); p += __shfl_xor(p, 2); p += __shfl_xor(p, 4);
            const float sa = -p, vv = VV[s * 64 + r];
            const f32x4 w0 = *(const LAS f32x4*)(Wd + o), w1 = *(const LAS f32x4*)(Wd + o + 4), b0 = *(const LAS f32x4*)(BB + o), b1 = *(const LAS f32x4*)(BB + o + 4);
            const f32x4 t0 = *(const LAS f32x4*)(KT + o), t1 = *(const LAS f32x4*)(KT + o + 4), r0 = *(const LAS f32x4*)(RR + o), r1 = *(const LAS f32x4*)(RR + o + 4);
            S[0] = S[0] * w0.x + sa * b0.x + vv * t0.x; S[1] = S[1] * w0.y + sa * b0.y + vv * t0.y; S[2] = S[2] * w0.z + sa * b0.z + vv * t0.z; S[3] = S[3] * w0.w + sa * b0.w + vv * t0.w;
            S[4] = S[4] * w1.x + sa * b1.x + vv * t1.x; S[5] = S[5] * w1.y + sa * b1.y + vv * t1.y; S[6] = S[6] * w1.z + sa * b1.z + vv * t1.z; S[7] = S[7] * w1.w + sa * b1.w + vv * t1.w;
            float y = S[0] * r0.x + S[1] * r0.y + S[2] * r0.z + S[3] * r0.w + S[4] * r1.x + S[5] * r1.y + S[6] * r1.z + S[7] * r1.w;
            y += __shfl_xor(y, 1); y += __shfl_xor(y, 2); y += __shfl_xor(y, 4);
            if (ks == 0) YO[s * 64 + r] = y;
        }
        __syncthreads();
        { v2u o; o.x = pk2(YO[tt * 64 + q4], YO[tt * 64 + q4 + 1]); o.y = pk2(YO[tt * 64 + q4 + 2], YO[tt * 64 + q4 + 3]);
          *(v2u*)(YS + ((size_t)e * T + n) * 256 + hh * 64 + q4) = o; }
        __syncthreads();
    }
    if (!lat) {
        float* dst = a->out + O_RW + (((size_t)((b * 2 + layer) * 2 + e) * 4 + hh) * 64 + r) * 64 + ks * 8;
        *(f32x4*)dst = (f32x4){S[0], S[1], S[2], S[3]}; *(f32x4*)(dst + 4) = (f32x4){S[4], S[5], S[6], S[7]};
    }
}

__device__ __forceinline__ void lru_unit_seq(ArgsP a, LAS unsigned char* lds, int layer, int u) {
    const int tid = tid_();
    LAS float* WA = (LAS float*)lds;
    LAS float* WX = WA + 4096;
    LAS float* XC = WX + 4096;
    LAS float* AA = XC + 4096; LAS float* BV = AA + 4096; LAS float* HH = BV + 4096;
    const int lat = u < 32, uu = lat ? u : u - 32, b = uu >> 2, g = uu & 3;
    const int L = lat ? L_LAT : L_CTX, tok0 = lat ? T_CTX + b * L_LAT : b * L_CTX;
    const bf16* G1 = (const bf16*)(a->ws + WS_G1);
    bf16* HF = (bf16*)(a->ws + WS_HF);
    const int tt = tid >> 3, q8 = (tid & 7) * 8;
    float cw[4][8], cb[8];
#pragma unroll
    for (int i = 0; i < 8; ++i) { const int ch = g * 64 + q8 + i; cb[i] = a->in[I_CONVB][layer * 256 + ch];
#pragma unroll
        for (int j = 0; j < 4; ++j) cw[j][i] = a->in[I_CONVW][(layer * 4 + j) * 256 + ch]; }
    for (int e = 0; e < 2; ++e) {
        __syncthreads();
        for (int i = tid; i < 4096; i += NTHREADS) { const size_t src = ((size_t)((layer * 2 + e) * 4 + g)) * 4096 + i; WA[i] = a->in[I_WA][src]; WX[i] = a->in[I_WX][src]; }
        float bav[8], bxv[8], spl[8];
#pragma unroll
        for (int i = 0; i < 8; ++i) { const int ch = (layer * 2 + e) * 256 + g * 64 + q8 + i; bav[i] = a->in[I_BA][ch]; bxv[i] = a->in[I_BX][ch]; spl[i] = log1pf(exp_(-a->in[I_LAMBDA][ch])); }
        float h = 0.f;
        if (tid < 64 && lat) h = a->in[I_SLRU][((size_t)(b * 2 + layer) * 2 + e) * 256 + g * 64 + tid];
        __syncthreads();
        for (int cc = 0; cc < L / 64; ++cc) {
            const int c = e ? L / 64 - 1 - cc : cc, t = c * 64 + tt, n = tok0 + t;
            {
                float xc[8];
#pragma unroll
                for (int i = 0; i < 8; ++i) xc[i] = cb[i];
#pragma unroll
                for (int j = 0; j < 4; ++j) { const int ts = t + j - 2;
                    if (ts >= 0 && ts < L) { const v4u x = *(const v4u*)(G1 + (size_t)(tok0 + ts) * G1W + C_XL + g * 64 + q8);
                        xc[0] += cw[j][0] * bflo(x.x); xc[1] += cw[j][1] * bfhi(x.x); xc[2] += cw[j][2] * bflo(x.y); xc[3] += cw[j][3] * bfhi(x.y);
                        xc[4] += cw[j][4] * bflo(x.z); xc[5] += cw[j][5] * bfhi(x.z); xc[6] += cw[j][6] * bflo(x.w); xc[7] += cw[j][7] * bfhi(x.w); } }
#pragma unroll
                for (int i = 0; i < 8; ++i) XC[tt * 64 + q8 + i] = xc[i];
            }
            __syncthreads();
            {
                float gr[8], gi[8];
#pragma unroll
                for (int i = 0; i < 8; ++i) { gr[i] = bav[i]; gi[i] = bxv[i]; }
                for (int i = 0; i < 64; ++i) { const float x = XC[tt * 64 + i];
                    const f32x4 a0 = *(const LAS f32x4*)(WA + i * 64 + q8), a1 = *(const LAS f32x4*)(WA + i * 64 + q8 + 4), x0 = *(const LAS f32x4*)(WX + i * 64 + q8), x1 = *(const LAS f32x4*)(WX + i * 64 + q8 + 4);
                    gr[0] = fmaf(x, a0.x, gr[0]); gr[1] = fmaf(x, a0.y, gr[1]); gr[2] = fmaf(x, a0.z, gr[2]); gr[3] = fmaf(x, a0.w, gr[3]);
                    gr[4] = fmaf(x, a1.x, gr[4]); gr[5] = fmaf(x, a1.y, gr[5]); gr[6] = fmaf(x, a1.z, gr[6]); gr[7] = fmaf(x, a1.w, gr[7]);
                    gi[0] = fmaf(x, x0.x, gi[0]); gi[1] = fmaf(x, x0.y, gi[1]); gi[2] = fmaf(x, x0.z, gi[2]); gi[3] = fmaf(x, x0.w, gi[3]);
                    gi[4] = fmaf(x, x1.x, gi[4]); gi[5] = fmaf(x, x1.y, gi[5]); gi[6] = fmaf(x, x1.z, gi[6]); gi[7] = fmaf(x, x1.w, gi[7]); }
#pragma unroll
                for (int i = 0; i < 8; ++i) { const float la = -8.f * sigmoidf_(gr[i]) * spl[i];
                    AA[tt * 64 + q8 + i] = exp_(la);
                    BV[tt * 64 + q8 + i] = sqrt_(-expm1f(2.f * la)) * sigmoidf_(gi[i]) * XC[tt * 64 + q8 + i]; }
            }
            __syncthreads();
            if (tid < 64) { for (int s = 0; s < 64; ++s) { const int st = e ? 63 - s : s; h = fmaf(AA[st * 64 + tid], h, BV[st * 64 + tid]); HH[st * 64 + tid] = h; } }
            __syncthreads();
            {
                bf16* dst = HF + (size_t)n * 256 + g * 64 + q8;
                float o[8];
#pragma unroll
                for (int i = 0; i < 8; ++i) o[i] = HH[tt * 64 + q8 + i];
                if (e) { const v4u hf = *(const v4u*)dst, gl = *(const v4u*)(G1 + (size_t)n * G1W + C_GL + g * 64 + q8);
                    o[0] = (o[0] + bflo(hf.x)) * siluf_(bflo(gl.x)); o[1] = (o[1] + bfhi(hf.x)) * siluf_(bfhi(gl.x)); o[2] = (o[2] + bflo(hf.y)) * siluf_(bflo(gl.y)); o[3] = (o[3] + bfhi(hf.y)) * siluf_(bfhi(gl.y));
                    o[4] = (o[4] + bflo(hf.z)) * siluf_(bflo(gl.z)); o[5] = (o[5] + bfhi(hf.z)) * siluf_(bfhi(gl.z)); o[6] = (o[6] + bflo(hf.w)) * siluf_(bflo(gl.w)); o[7] = (o[7] + bfhi(hf.w)) * siluf_(bfhi(gl.w)); }
                v4u ov; ov.x = pk2(o[0], o[1]); ov.y = pk2(o[2], o[3]); ov.z = pk2(o[4], o[5]); ov.w = pk2(o[6], o[7]);
                *(v4u*)dst = ov;
            }
            __syncthreads();
        }
        if (tid < 64 && !lat) a->out[O_LRU + ((size_t)(b * 2 + layer) * 2 + e) * 256 + g * 64 + tid] = h;
    }
}

__device__ __forceinline__ void phase_c1(ArgsP a, int layer) {
    const int tid = tid_(), lane = tid & 63, wave = tid >> 6, G = grid_();
    const bf16* G1 = (const bf16*)(a->ws + WS_G1); const bf16* YS = (const bf16*)(a->ws + WS_G2); const bf16* Q = (const bf16*)(a->ws + WS_Q); const bf16* HF = (const bf16*)(a->ws + WS_HF);
    bf16* Y = (bf16*)(a->ws + WS_YMIX);
    const int ch = lane * 4;
    const f32x4 rk = *(const f32x4*)(a->in[I_RK] + layer * 256 + ch), lg = *(const f32x4*)(a->in[I_LNXG] + layer * 256 + ch), lb = *(const f32x4*)(a->in[I_LNXB] + layer * 256 + ch);
    v2u p_y0, p_y1, p_r, p_k, p_v, p_g, p_h; v4u p_q;
#define C1_LOAD(nn) do { const bf16* g_ = G1 + (size_t)(nn) * G1W; p_y0 = *(const v2u*)(YS + (size_t)(nn) * 256 + ch); p_y1 = *(const v2u*)(YS + ((size_t)T + (nn)) * 256 + ch); \
        p_r = *(const v2u*)(g_ + C_R + ch); p_k = *(const v2u*)(g_ + C_K + ch); p_v = *(const v2u*)(g_ + C_V + ch); p_g = *(const v2u*)(g_ + C_G + ch); \
        p_q = *(const v4u*)(Q + (size_t)(nn) * 768 + (lane >> 3) * 96 + (lane & 7) * 8); p_h = *(const v2u*)(HF + (size_t)(nn) * 256 + ch); } while (0)
    { const int n0 = bid_() * 8 + wave; if (n0 < T) C1_LOAD(n0); }
    for (int n = bid_() * 8 + wave; n < T; n += G * 8) {
        const v2u y0 = p_y0, y1 = p_y1, rv = p_r, kv = p_k, vv = p_v, gv = p_g, hq = p_h; const v4u qq = p_q;
        if (n + G * 8 < T) C1_LOAD(n + G * 8);
        float y[4] = {bflo(y0.x) + bflo(y1.x), bfhi(y0.x) + bfhi(y1.x), bflo(y0.y) + bflo(y1.y), bfhi(y0.y) + bfhi(y1.y)};
        float s = (y[0] + y[1]) + (y[2] + y[3]);
        float bon = bflo(rv.x) * bflo(kv.x) * rk.x + bfhi(rv.x) * bfhi(kv.x) * rk.y + bflo(rv.y) * bflo(kv.y) * rk.z + bfhi(rv.y) * bfhi(kv.y) * rk.w;
#pragma unroll
        for (int o = 1; o < 16; o <<= 1) { s += __shfl_xor(s, o); bon += __shfl_xor(bon, o); }
        const float mu = s * (1.f / 64.f);
        float s2 = (y[0] - mu) * (y[0] - mu) + (y[1] - mu) * (y[1] - mu) + (y[2] - mu) * (y[2] - mu) + (y[3] - mu) * (y[3] - mu);
#pragma unroll
        for (int o = 1; o < 16; o <<= 1) s2 += __shfl_xor(s2, o);
        const float rstd = rsqrt_(s2 * (1.f / 64.f) + GN_EPS);
        const float o0 = ((y[0] - mu) * rstd * lg.x + lb.x + bon * bflo(vv.x)) * siluf_(bflo(gv.x));
        const float o1 = ((y[1] - mu) * rstd * lg.y + lb.y + bon * bfhi(vv.x)) * siluf_(bfhi(gv.x));
        const float o2 = ((y[2] - mu) * rstd * lg.z + lb.z + bon * bflo(vv.y)) * siluf_(bflo(gv.y));
        const float o3 = ((y[3] - mu) * rstd * lg.w + lb.w + bon * bfhi(vv.y)) * siluf_(bfhi(gv.y));
        v2u ov; ov.x = pk2(o0, o1); ov.y = pk2(o2, o3);
        bf16* yr = Y + (size_t)n * 1024;
        *(v2u*)(yr + ch) = ov;
        *(v4u*)(yr + 256 + (lane >> 3) * 64 + (lane & 7) * 8) = qq;
        *(v2u*)(yr + 768 + ch) = hq;
    }
#undef C1_LOAD
}
#define MFMA32(a, b, c) __builtin_amdgcn_mfma_f32_32x32x16_bf16((a), (b), (c), 0, 0, 0)
#define MFMA16(a, b, c) __builtin_amdgcn_mfma_f32_16x16x32_bf16((a), (b), (c), 0, 0, 0)
typedef short s16x4_t __attribute__((ext_vector_type(4)));

__device__ __forceinline__ float tanh_fast(float x) { return 1.f - 2.f * rcp_(1.f + exp_(2.f * x)); }

constexpr int ATT_KSTR = 208, ATT_VSTR = 136, ATT_VOFF = 64 * ATT_KSTR, ATT_STAGE = 64 * ATT_KSTR + 64 * ATT_VSTR;
__device__ __forceinline__ void att_unit(ArgsP a, LAS unsigned char* lds, int u) {
    const int tid = tid_(), lane = tid & 63, wave = tid >> 6, r = lane & 31, hq = lane >> 5;
    const bf16* KN = (const bf16*)(a->ws + WS_KN); const bf16* KR = (const bf16*)(a->ws + WS_KR); const bf16* VT = (const bf16*)(a->ws + WS_VT);
    bf16* Q = (bf16*)(a->ws + WS_Q); const bf16* G1 = (const bf16*)(a->ws + WS_G1);
    int b, h, n0, Lk, kidx0; size_t vbase;
    if (u < 512) { b = u >> 6; h = (u >> 3) & 7; n0 = T_CTX + b * 2048 + (u & 7) * 256; Lk = LK_LAT; kidx0 = T_CTX + b * LK_LAT; vbase = (size_t)VT_LAT + (size_t)(b * 8 + h) * 64 * LK_LAT; }
    else { const int uu = u - 512; b = uu >> 3; h = uu & 7; n0 = b * 256; Lk = 256; kidx0 = b * 256; vbase = (size_t)(b * 8 + h) * 64 * 256; }
    const int ntiles = Lk >> 6;
    const int n = n0 + wave * 32 + r;
    bf16x8 qf[6];
#pragma unroll
    for (int ks = 0; ks < 6; ++ks) qf[ks] = *(const bf16x8*)(Q + (size_t)n * 768 + h * 96 + ks * 16 + 8 * hq);
    const int key_k = tid >> 3, ck = tid & 7, key_r = (tid >> 2) & 63, cr = tid & 3;
    const bf16* gk = KN + (size_t)(kidx0 + key_k) * 512 + h * 64 + ck * 8;
    const bf16* gr = KR + (size_t)(kidx0 + key_r) * 32 + cr * 8;
    const bf16* gv = VT + vbase + (size_t)key_k * Lk + ck * 8;
    const unsigned sk = key_k * ATT_KSTR + ck * 16, sr = key_r * ATT_KSTR + 128 + cr * 16, sv = ATT_VOFF + key_k * ATT_VSTR + ck * 16;
    v4u rk, rr, rv;
    rk = *(const v4u*)gk; rr = (tid < 256) ? *(const v4u*)gr : (v4u){0u, 0u, 0u, 0u}; rv = *(const v4u*)gv;
    __syncthreads();
    *(LAS v4u*)(lds + sk) = rk; if (tid < 256) *(LAS v4u*)(lds + sr) = rr;
    *(LAS v2u*)(lds + sv) = (v2u){rv.x, rv.y}; *(LAS v2u*)(lds + sv + 8) = (v2u){rv.z, rv.w};
    __syncthreads();
    f32x16 o0, o1;
#pragma unroll
    for (int i = 0; i < 16; ++i) { o0[i] = 0.f; o1[i] = 0.f; }
    float m = -1e30f, l = 0.f;
    for (int j = 0; j < ntiles; ++j) {
        const int buf = j & 1;
        if (j + 1 < ntiles) { rk = *(const v4u*)(gk + (size_t)(j + 1) * 64 * 512); if (tid < 256) rr = *(const v4u*)(gr + (size_t)(j + 1) * 64 * 32); rv = *(const v4u*)(gv + (j + 1) * 64); }
        const LAS unsigned char* Kb = lds + buf * ATT_STAGE;
        f32x16 s0, s1;
#pragma unroll
        for (int i = 0; i < 16; ++i) { s0[i] = 0.f; s1[i] = 0.f; }
#pragma unroll
        for (int ks = 0; ks < 6; ++ks) {
            const bf16x8 a0 = *(const LAS bf16x8*)(Kb + r * ATT_KSTR + ks * 32 + hq * 16), a1 = *(const LAS bf16x8*)(Kb + (32 + r) * ATT_KSTR + ks * 32 + hq * 16);
            s0 = MFMA32(a0, qf[ks], s0); s1 = MFMA32(a1, qf[ks], s1);
        }
        float mx = s0[0];
#pragma unroll
        for (int i = 1; i < 16; ++i) mx = fmaxf(mx, s0[i]);
#pragma unroll
        for (int i = 0; i < 16; ++i) mx = fmaxf(mx, s1[i]);
        mx = fmaxf(mx, __shfl_xor(mx, 32));
        const float mn = fmaxf(m, mx), alpha = __builtin_amdgcn_exp2f(m - mn); m = mn;
        float ps = 0.f;
#pragma unroll
        for (int i = 0; i < 16; ++i) { s0[i] = __builtin_amdgcn_exp2f(s0[i] - mn); s1[i] = __builtin_amdgcn_exp2f(s1[i] - mn); ps += s0[i] + s1[i]; }
        l = l * alpha + ps;
#pragma unroll
        for (int i = 0; i < 16; ++i) { o0[i] *= alpha; o1[i] *= alpha; }
        const LAS unsigned char* Vb = Kb + ATT_VOFF;
#pragma unroll
        for (int ks = 0; ks < 4; ++ks) {
            v4u pw;
            if (ks == 0) { pw.x = cvtpk(s0[0], s0[1]); pw.y = cvtpk(s0[2], s0[3]); pw.z = cvtpk(s0[4], s0[5]); pw.w = cvtpk(s0[6], s0[7]); }
            else if (ks == 1) { pw.x = cvtpk(s0[8], s0[9]); pw.y = cvtpk(s0[10], s0[11]); pw.z = cvtpk(s0[12], s0[13]); pw.w = cvtpk(s0[14], s0[15]); }
            else if (ks == 2) { pw.x = cvtpk(s1[0], s1[1]); pw.y = cvtpk(s1[2], s1[3]); pw.z = cvtpk(s1[4], s1[5]); pw.w = cvtpk(s1[6], s1[7]); }
            else { pw.x = cvtpk(s1[8], s1[9]); pw.y = cvtpk(s1[10], s1[11]); pw.z = cvtpk(s1[12], s1[13]); pw.w = cvtpk(s1[14], s1[15]); }
            const bf16x8 pf = __builtin_bit_cast(bf16x8, pw);
            const v2u va0 = *(const LAS v2u*)(Vb + r * ATT_VSTR + ks * 32 + hq * 8), va1 = *(const LAS v2u*)(Vb + r * ATT_VSTR + ks * 32 + 16 + hq * 8);
            const v2u vb0 = *(const LAS v2u*)(Vb + (32 + r) * ATT_VSTR + ks * 32 + hq * 8), vb1 = *(const LAS v2u*)(Vb + (32 + r) * ATT_VSTR + ks * 32 + 16 + hq * 8);
            const v4u vwa = {va0.x, va0.y, va1.x, va1.y}, vwb = {vb0.x, vb0.y, vb1.x, vb1.y};
            o0 = MFMA32(__builtin_bit_cast(bf16x8, vwa), pf, o0); o1 = MFMA32(__builtin_bit_cast(bf16x8, vwb), pf, o1);
        }
        if (j + 1 < ntiles) {
            LAS unsigned char* Nb = lds + (buf ^ 1) * ATT_STAGE;
            *(LAS v4u*)(Nb + sk) = rk; if (tid < 256) *(LAS v4u*)(Nb + sr) = rr;
            *(LAS v2u*)(Nb + sv) = (v2u){rv.x, rv.y}; *(LAS v2u*)(Nb + sv + 8) = (v2u){rv.z, rv.w};
        }
        __syncthreads();
    }
    l += __shfl_xor(l, 32);
    const float inv = rcp_(l);
#pragma unroll
    for (int mt = 0; mt < 2; ++mt)
#pragma unroll
        for (int g = 0; g < 4; ++g) {
            const int dv0 = 32 * mt + 8 * g + 4 * hq;
            const v2u gm = *(const v2u*)(G1 + (size_t)n * G1W + C_GM + h * 64 + dv0);
            const float x0 = (mt ? o1[4 * g + 0] : o0[4 * g + 0]) * inv, x1 = (mt ? o1[4 * g + 1] : o0[4 * g + 1]) * inv, x2 = (mt ? o1[4 * g + 2] : o0[4 * g + 2]) * inv, x3 = (mt ? o1[4 * g + 3] : o0[4 * g + 3]) * inv;
            v2u ov; ov.x = cvtpk(x0 * siluf_(bflo(gm.x)), x1 * siluf_(bfhi(gm.x))); ov.y = cvtpk(x2 * siluf_(bflo(gm.y)), x3 * siluf_(bfhi(gm.y)));
            *(v2u*)(Q + (size_t)n * 768 + h * 96 + dv0) = ov;
        }
}

constexpr int A2_QSTR = 528, A2_KVSTR = 272, A2_KVOFF = 64 * A2_QSTR;
__device__ __forceinline__ void a2_unit(ArgsP a, LAS unsigned char* lds, int layer, int unit) {
    const int tid = tid_(), lane = tid & 63, wave = tid >> 6, tn = lane & 15, g = lane >> 4;
    constexpr int NU_TOK = T / 64;
    const bool is_tok = unit < NU_TOK;
    const bf16* G2 = (const bf16*)(a->ws + WS_G2);
    bf16* Q = (bf16*)(a->ws + WS_Q); bf16* KN = (bf16*)(a->ws + WS_KN); bf16* KR = (bf16*)(a->ws + WS_KR); bf16* VT = (bf16*)(a->ws + WS_VT);
    const bf16* WUQ = (const bf16*)(a->ws + WS_WUQ) + (size_t)layer * 768 * 256;
    const bf16* WUKV = (const bf16*)(a->ws + WS_WUKV) + (size_t)layer * 1024 * 128;
    const float* ROPE1 = (const float*)(a->ws + WS_ROPE);
    __syncthreads();
    v2u cq8[8], kv8[8]; unsigned kr8[8];
    if (is_tok) {
#pragma unroll
        for (int rr = 0; rr < 8; ++rr) { const size_t n_ = (size_t)(unit * 64 + wave * 8 + rr);
            cq8[rr] = *(const v2u*)(G2 + n_ * G2W + lane * 4); kv8[rr] = *(const v2u*)(G2 + n_ * G2W + 256 + (lane & 31) * 4); kr8[rr] = G2[n_ * G2W + 384 + (lane & 31)]; }
    }
#pragma unroll
    for (int rr = 0; rr < 8; ++rr) {
        const int r = wave * 8 + rr;
        if (is_tok) {
            const int n = unit * 64 + r; const Tok tk = tok_of(n);
            const v2u cqv = cq8[rr];
            const float c0 = bflo(cqv.x), c1 = bfhi(cqv.x), c2 = bflo(cqv.y), c3 = bfhi(cqv.y);
            const float rq = rsqrt_(wave_sum(c0 * c0 + c1 * c1 + c2 * c2 + c3 * c3) * (1.f / 256.f) + 1e-6f);
            const f32x4 qn = *(const f32x4*)(a->in[I_QNORM] + layer * 256 + lane * 4);
            *(LAS v2u*)(lds + r * A2_QSTR + lane * 8) = (v2u){cvtpk(c0 * rq * qn.x, c1 * rq * qn.y), cvtpk(c2 * rq * qn.z, c3 * rq * qn.w)};
            float k0 = 0.f, k1 = 0.f, k2 = 0.f, k3 = 0.f;
            if (lane < 32) { const v2u kv = kv8[rr]; k0 = bflo(kv.x); k1 = bfhi(kv.x); k2 = bflo(kv.y); k3 = bfhi(kv.y); }
            const float rk = rsqrt_(wave_sum(k0 * k0 + k1 * k1 + k2 * k2 + k3 * k3) * (1.f / 128.f) + 1e-6f);
            if (lane < 32) {
                const f32x4 kn = *(const f32x4*)(a->in[I_KVNORM] + layer * 128 + lane * 4);
                f32x4 o; o.x = k0 * rk * kn.x; o.y = k1 * rk * kn.y; o.z = k2 * rk * kn.z; o.w = k3 * rk * kn.w;
                if (!tk.lat) *(f32x4*)(a->out + O_CKV + ((size_t)(tk.b * 2 + layer) * 256 + tk.t) * 128 + lane * 4) = o;
                *(LAS v2u*)(lds + A2_KVOFF + r * A2_KVSTR + lane * 8) = (v2u){cvtpk(o.x, o.y), cvtpk(o.z, o.w)};
            }
            float krv = (lane < 32) ? bf2f(kr8[rr]) : 0.f;
            const float other = __shfl_xor(krv, 1);
            if (lane < 32) {
                if (!tk.lat) a->out[O_KR + ((size_t)(tk.b * 2 + layer) * 256 + tk.t) * 32 + lane] = krv;
                else { const float c = ROPE1[((size_t)tk.t * 16 + (lane >> 1)) * 2], s = ROPE1[((size_t)tk.t * 16 + (lane >> 1)) * 2 + 1]; krv = (lane & 1) ? (other * s + krv * c) : (krv * c - other * s); }
                KR[(size_t)tk.kidx * 32 + lane] = (bf16)f2bf(krv);
            }
        } else {
            const int cr = (unit - NU_TOK) * 64 + r, b = cr >> 8, j = cr & 255;
            const size_t src = ((size_t)(b * 2 + layer) * 256 + j);
            if (lane < 32) { const f32x4 v = *(const f32x4*)(a->in[I_CCKV] + src * 128 + lane * 4);
                *(LAS v2u*)(lds + A2_KVOFF + r * A2_KVSTR + lane * 8) = (v2u){cvtpk(v.x, v.y), cvtpk(v.z, v.w)};
                KR[(size_t)(T_CTX + b * LK_LAT + j) * 32 + lane] = (bf16)f2bf(a->in[I_CKR][src * 32 + lane]); }
        }
    }
    __syncthreads();
    constexpr int A2_STG = 52224, A2_SQSTR = 784, A2_SKSTR = 1040, A2_SVSTR = 144;
    const int n0 = is_tok ? unit * 64 : 0;
    if (is_tok) {
      const float* ROPE = (const float*)(a->ws + WS_ROPE);
      for (int qh = 0; qh < 2; ++qh) {
        f32x4 acc[3][4];
#pragma unroll
        for (int f = 0; f < 3; ++f)
#pragma unroll
            for (int t = 0; t < 4; ++t) acc[f][t] = (f32x4){0.f, 0.f, 0.f, 0.f};
        bf16x8 afq[3][8];
        const bf16* wq = WUQ + (size_t)((qh * 24 + wave * 3) * 16 + tn) * 256 + g * 8;
#pragma unroll
        for (int f = 0; f < 3; ++f)
#pragma unroll
            for (int ks = 0; ks < 8; ++ks) afq[f][ks] = *(const bf16x8*)(wq + f * 16 * 256 + ks * 32);
#pragma unroll
        for (int ks = 0; ks < 8; ++ks) {
            bf16x8 bfr[4];
#pragma unroll
            for (int t = 0; t < 4; ++t) bfr[t] = *(const LAS bf16x8*)(lds + (t * 16 + tn) * A2_QSTR + ks * 64 + g * 16);
#pragma unroll
            for (int f = 0; f < 3; ++f)
#pragma unroll
                for (int t = 0; t < 4; ++t) acc[f][t] = MFMA16(afq[f][ks], bfr[t], acc[f][t]);
        }
#pragma unroll
        for (int f = 0; f < 3; ++f) { const int fl = (wave * 3 + f) * 16 + 4 * g, f0 = qh * 384 + fl, d = f0 % 96;
#pragma unroll
            for (int t = 0; t < 4; ++t) { const int r = t * 16 + tn, n = n0 + r;
                float v0 = acc[f][t][0], v1 = acc[f][t][1], v2 = acc[f][t][2], v3 = acc[f][t][3];
                if (n >= T_CTX && d >= 64) { const int tt = (n - T_CTX) & 2047; const f32x4 cs = *(const f32x4*)(ROPE + ((size_t)tt * 16 + ((d - 64) >> 1)) * 2);
                    const float y0 = v0 * cs.x - v1 * cs.y, y1 = v0 * cs.y + v1 * cs.x, y2 = v2 * cs.z - v3 * cs.w, y3 = v2 * cs.w + v3 * cs.z; v0 = y0; v1 = y1; v2 = y2; v3 = y3; }
                *(LAS v2u*)(lds + A2_STG + r * A2_SQSTR + fl * 2) = (v2u){cvtpk(v0, v1), cvtpk(v2, v3)}; } }
        __syncthreads();
#pragma unroll
        for (int i = 0; i < 6; ++i) { const int c = tid + 512 * i, row = c / 48, c16 = c % 48;
            *(v4u*)(Q + (size_t)(n0 + row) * 768 + qh * 384 + c16 * 8) = *(const LAS v4u*)(lds + A2_STG + row * A2_SQSTR + c16 * 16); }
        __syncthreads();
      }
    }
    int kidx0, latu, bu, kpos0;
    if (is_tok) { const Tok tk = tok_of(n0); kidx0 = tk.kidx; latu = tk.lat; bu = tk.b; kpos0 = tk.lat ? PAST + tk.t : tk.t; }
    else { const int cr = (unit - NU_TOK) * 64; bu = cr >> 8; kpos0 = cr & 255; latu = 1; kidx0 = T_CTX + bu * LK_LAT + kpos0; }
    for (int half = 0; half < 2; ++half) {
        f32x4 acc[4][4];
#pragma unroll
        for (int f = 0; f < 4; ++f)
#pragma unroll
            for (int t = 0; t < 4; ++t) acc[f][t] = (f32x4){0.f, 0.f, 0.f, 0.f};
        bf16x8 afk[4][4];
        const bf16* wk = WUKV + (size_t)(wave * 128 + half * 64 + tn) * 128 + g * 8;
#pragma unroll
        for (int f = 0; f < 4; ++f)
#pragma unroll
            for (int ks = 0; ks < 4; ++ks) afk[f][ks] = *(const bf16x8*)(wk + f * 16 * 128 + ks * 32);
#pragma unroll
        for (int ks = 0; ks < 4; ++ks) {
            bf16x8 bfr[4];
#pragma unroll
            for (int t = 0; t < 4; ++t) bfr[t] = *(const LAS bf16x8*)(lds + A2_KVOFF + (t * 16 + tn) * A2_KVSTR + ks * 64 + g * 16);
#pragma unroll
            for (int f = 0; f < 4; ++f)
#pragma unroll
                for (int t = 0; t < 4; ++t) acc[f][t] = MFMA16(afk[f][ks], bfr[t], acc[f][t]);
        }
#pragma unroll
        for (int f = 0; f < 4; ++f) { const int x = wave * 64 + f * 16 + 4 * g;
#pragma unroll
            for (int t = 0; t < 4; ++t) { const int r = t * 16 + tn;
                if (half == 0) *(LAS v2u*)(lds + A2_STG + r * A2_SKSTR + x * 2) = (v2u){cvtpk(acc[f][t][0], acc[f][t][1]), cvtpk(acc[f][t][2], acc[f][t][3])};
                else { const unsigned p01 = cvtpk(acc[f][t][0], acc[f][t][1]), p23 = cvtpk(acc[f][t][2], acc[f][t][3]);
                    *(LAS bf16*)(lds + A2_STG + (x + 0) * A2_SVSTR + r * 2) = (bf16)(p01 & 0xffffu); *(LAS bf16*)(lds + A2_STG + (x + 1) * A2_SVSTR + r * 2) = (bf16)(p01 >> 16);
                    *(LAS bf16*)(lds + A2_STG + (x + 2) * A2_SVSTR + r * 2) = (bf16)(p23 & 0xffffu); *(LAS bf16*)(lds + A2_STG + (x + 3) * A2_SVSTR + r * 2) = (bf16)(p23 >> 16); } } }
        __syncthreads();
        if (half == 0) {
#pragma unroll
            for (int i = 0; i < 8; ++i) { const int c = tid + 512 * i, row = c >> 6, c16 = c & 63;
                *(v4u*)(KN + (size_t)(kidx0 + row) * 512 + c16 * 8) = *(const LAS v4u*)(lds + A2_STG + row * A2_SKSTR + c16 * 16); }
        } else {
            const int Lk = latu ? LK_LAT : 256;
#pragma unroll
            for (int i = 0; i < 8; ++i) { const int c = tid + 512 * i, row = c >> 3, part = c & 7, h = row >> 6, dv = row & 63;
                const size_t base = latu ? (size_t)VT_LAT + ((size_t)(bu * 8 + h) * 64 + dv) * LK_LAT : ((size_t)(bu * 8 + h) * 64 + dv) * 256;
                *(v4u*)(VT + base + kpos0 + part * 8) = *(const LAS v4u*)(lds + A2_STG + row * A2_SVSTR + part * 16); }
            (void)Lk;
        }
        __syncthreads();
    }
}

constexpr int RW_W2T = 0, RW_A2T = 9216, RW_TH = 18432, RW_HA = 27648, RW_CH0 = 36864, RW_CHB = 20992, RW_YB = 120832;
constexpr int RC_KP = 0, RC_RP = 2304, RC_BP = 4608  , RC_KT = 6912, RC_VR = 9216  , RC_LK = 16896, RC_TM = 17536, RC_ARK = 18176, RC_NARB = 18816, RC_G15 = 19456, RC_LBF = 19712, RC_SSQ = 20736;
__device__ __forceinline__ void rwkv_unit_mfma(ArgsP a, LAS unsigned char* lds, int layer, int u) {
    const int tid = tid_(), lane = tid & 63, wave = tid >> 6, i16 = lane & 15, g = lane >> 4;
    const int lat = u < 64, uu = lat ? u : u - 64, b = uu >> 3, e = (uu >> 2) & 1, hh = uu & 3;
    const int L = lat ? L_LAT : L_CTX, tok0 = lat ? T_CTX + b * L_LAT : b * L_CTX;
    const bf16* G1 = (const bf16*)(a->ws + WS_G1);
    bf16* YS = (bf16*)(a->ws + WS_G2);
    __syncthreads();
    for (int i = tid; i < 4096; i += NTHREADS) { const int j = i >> 6, c = i & 63;
        *(LAS bf16*)(lds + RW_W2T + (c * 72 + j) * 2) = (bf16)f2bf(a->in[I_W2][((size_t)(layer * 2 + e) * 64 + j) * 256 + hh * 64 + c]);
        *(LAS bf16*)(lds + RW_A2T + (c * 72 + j) * 2) = (bf16)f2bf(a->in[I_A2][((size_t)(layer * 2 + e) * 64 + j) * 256 + hh * 64 + c]); }
    const int st_tok = tid >> 3, st_c8 = (tid & 7) * 8;
#define RW_STAGE(sc) do { const int step_ = (sc) * 64 + st_tok, t_ = e ? L - 1 - step_ : step_; const bf16* gp_ = G1 + (size_t)(tok0 + t_) * G1W + C_LORA + e * 64 + st_c8; \
        const v4u hw_ = *(const v4u*)gp_, ha_ = *(const v4u*)(gp_ + 128); v4u th_; \
        th_.x = cvtpk(tanh_fast(bflo(hw_.x)), tanh_fast(bfhi(hw_.x))); th_.y = cvtpk(tanh_fast(bflo(hw_.y)), tanh_fast(bfhi(hw_.y))); th_.z = cvtpk(tanh_fast(bflo(hw_.z)), tanh_fast(bfhi(hw_.z))); th_.w = cvtpk(tanh_fast(bflo(hw_.w)), tanh_fast(bfhi(hw_.w))); \
        *(LAS v4u*)(lds + RW_TH + st_tok * 144 + st_c8 * 2) = th_; *(LAS v4u*)(lds + RW_HA + st_tok * 144 + st_c8 * 2) = ha_; } while (0)
    RW_STAGE(0);
    f32x4 ST[4];
    {
        const int v = 16 * (wave & 3) + i16;
#pragma unroll
        for (int kt = 0; kt < 4; ++kt) ST[kt] = lat ? *(const f32x4*)(a->in[I_SRW] + (((size_t)((b * 2 + layer) * 2 + e) * 4 + hh) * 64 + v) * 64 + 16 * kt + 4 * g) : (f32x4){0.f, 0.f, 0.f, 0.f};
    }
    const int pc = wave & 3, ph = wave >> 2;
    LAS unsigned char* CH = lds + RW_CH0 + pc * RW_CHB;
    __syncthreads();
    const int nsc = L >> 6;
    v2u pk[2], pr[2], pv[2];
#define RW_PREFETCH(sc) do { const int ps_ = (sc) * 64 + pc * 16 + i16, pt_ = e ? L - 1 - ps_ : ps_; const bf16* gq_ = G1 + (size_t)(tok0 + pt_) * G1W + hh * 64 + (2 * ph) * 16 + 4 * g; \
        pk[0] = *(const v2u*)(gq_ + C_K); pk[1] = *(const v2u*)(gq_ + C_K + 16); pr[0] = *(const v2u*)(gq_ + C_R); pr[1] = *(const v2u*)(gq_ + C_R + 16); pv[0] = *(const v2u*)(gq_ + C_V); pv[1] = *(const v2u*)(gq_ + C_V + 16); } while (0)
    RW_PREFETCH(0);
    for (int sc = 0; sc < nsc; ++sc) {
        const v2u ck[2] = {pk[0], pk[1]}, cr[2] = {pr[0], pr[1]}, cv[2] = {pv[0], pv[1]};
        if (sc + 1 < nsc) RW_PREFETCH(sc + 1);
        float dec[8], av[8], kx[8], rx[8], kk[8];
        {
            f32x4 aw[2], aa[2];
#pragma unroll
            for (int c2 = 0; c2 < 2; ++c2) { aw[c2] = (f32x4){0.f, 0.f, 0.f, 0.f}; aa[c2] = (f32x4){0.f, 0.f, 0.f, 0.f}; }
#pragma unroll
            for (int ks = 0; ks < 2; ++ks) {
                const bf16x8 bth = *(const LAS bf16x8*)(lds + RW_TH + (pc * 16 + i16) * 144 + ks * 64 + g * 16), bha = *(const LAS bf16x8*)(lds + RW_HA + (pc * 16 + i16) * 144 + ks * 64 + g * 16);
#pragma unroll
                for (int c2 = 0; c2 < 2; ++c2) { const int row = (2 * ph + c2) * 16 + i16;
                    const bf16x8 w2f = *(const LAS bf16x8*)(lds + RW_W2T + row * 144 + ks * 64 + g * 16), a2f = *(const LAS bf16x8*)(lds + RW_A2T + row * 144 + ks * 64 + g * 16);
                    aw[c2] = MFMA16(w2f, bth, aw[c2]); aa[c2] = MFMA16(a2f, bha, aa[c2]); }
            }
            float ss = 0.f;
#pragma unroll
            for (int c2 = 0; c2 < 2; ++c2) { const int ch = (2 * ph + c2) * 16 + 4 * g, gch = hh * 64 + ch;
                const f32x4 w0 = *(const f32x4*)(a->in[I_W0] + (layer * 2 + e) * 256 + gch), a0 = *(const f32x4*)(a->in[I_A0] + (layer * 2 + e) * 256 + gch), kw = *(const f32x4*)(a->in[I_KK] + layer * 256 + gch);
                const v2u kv = ck[c2], rv = cr[c2];
                const float kq[4] = {bflo(kv.x), bfhi(kv.x), bflo(kv.y), bfhi(kv.y)}, rq[4] = {bflo(rv.x), bfhi(rv.x), bflo(rv.y), bfhi(rv.y)};
#pragma unroll
                for (int q = 0; q < 4; ++q) { const int o = c2 * 4 + q;
                    dec[o] = exp_(-0.6065306597126334f * sigmoidf_(aw[c2][q] + w0[q])); av[o] = sigmoidf_(aa[c2][q] + a0[q]);
                    kx[o] = kq[q]; rx[o] = rq[q]; kk[o] = kq[q] * kw[q]; ss += kk[o] * kk[o]; }
            }
            ss += __shfl_xor(ss, 16); ss += __shfl_xor(ss, 32);
            if (g == 0) *(LAS float*)(CH + RC_SSQ + (i16 * 2 + ph) * 4) = ss;
        }
        __syncthreads();
        {
            const float tot = *(const LAS float*)(CH + RC_SSQ + (i16 * 2) * 4) + *(const LAS float*)(CH + RC_SSQ + (i16 * 2 + 1) * 4);
            const float inrm = rcp_(fmaxf(sqrt_(tot), 1e-12f));
            float G8[8], Gx8[8];
#pragma unroll
            for (int o8 = 0; o8 < 8; ++o8) G8[o8] = dec[o8];
#pragma unroll
            for (int o8 = 0; o8 < 8; ++o8) G8[o8] *= dpp_f<0x111>(1.f, G8[o8]);
#pragma unroll
            for (int o8 = 0; o8 < 8; ++o8) G8[o8] *= dpp_f<0x112>(1.f, G8[o8]);
#pragma unroll
            for (int o8 = 0; o8 < 8; ++o8) G8[o8] *= dpp_f<0x114>(1.f, G8[o8]);
#pragma unroll
            for (int o8 = 0; o8 < 8; ++o8) G8[o8] *= dpp_f<0x118>(1.f, G8[o8]);
#pragma unroll
            for (int o8 = 0; o8 < 8; ++o8) Gx8[o8] = dpp_f<0x111>(1.f, G8[o8]);
#pragma unroll
            for (int c2 = 0; c2 < 2; ++c2) { const int ch = (2 * ph + c2) * 16 + 4 * g, gch = hh * 64 + ch;
                const f32x4 ka = *(const f32x4*)(a->in[I_KA] + layer * 256 + gch);
                float kp[4], bp[4], kt[4], rp[4];
#pragma unroll
                for (int q = 0; q < 4; ++q) { const int o = c2 * 4 + q;
                    const float G = G8[o], Gex = Gx8[o];
                    const float kkn = kk[o] * inrm, iG = rcp_(G);
                    kp[q] = Gex * kkn; bp[q] = kkn * av[o] * iG; kt[q] = kx[o] * (1.f + (av[o] - 1.f) * ka[q]) * iG; rp[q] = G * rx[o];
                    if (i16 == 15) *(LAS float*)(CH + RC_G15 + (ch + q) * 4) = G;
                }
                *(LAS v2u*)(CH + RC_KP + i16 * 144 + ch * 2) = (v2u){cvtpk(kp[0], kp[1]), cvtpk(kp[2], kp[3])};
                *(LAS v2u*)(CH + RC_BP + i16 * 144 + ch * 2) = (v2u){cvtpk(-bp[0], -bp[1]), cvtpk(-bp[2], -bp[3])};
                *(LAS v2u*)(CH + RC_KT + i16 * 144 + ch * 2) = (v2u){cvtpk(kt[0], kt[1]), cvtpk(kt[2], kt[3])};
                *(LAS v2u*)(CH + RC_RP + i16 * 144 + ch * 2) = (v2u){cvtpk(rp[0], rp[1]), cvtpk(rp[2], rp[3])};
                *(LAS v2u*)(CH + RC_VR + i16 * 144 + ch * 2) = cv[c2];
            }
        }
        __syncthreads();
        {
            f32x4 d0 = (f32x4){0.f, 0.f, 0.f, 0.f}, d1 = (f32x4){0.f, 0.f, 0.f, 0.f};
            const int xoff = ph ? RC_KP : RC_RP, y0off = ph ? RC_BP : RC_KT, y1off = ph ? RC_KT : RC_BP;
#pragma unroll
            for (int ks = 0; ks < 2; ++ks) {
                const bf16x8 xf = *(const LAS bf16x8*)(CH + xoff + i16 * 144 + ks * 64 + g * 16);
                const bf16x8 y0 = *(const LAS bf16x8*)(CH + y0off + i16 * 144 + ks * 64 + g * 16), y1 = *(const LAS bf16x8*)(CH + y1off + i16 * 144 + ks * 64 + g * 16);
                d0 = MFMA16(xf, y0, d0); d1 = MFMA16(xf, y1, d1);
            }
#pragma unroll
            for (int q = 0; q < 4; ++q) { const int i = 4 * g + q, j = i16;
                if (ph) { *(LAS float*)(CH + RC_LBF + (i * 16 + j) * 4) = (j < i) ? -d0[q] : 0.f; *(LAS bf16*)(CH + RC_LK + i * 40 + j * 2) = (bf16)(cvtpk((j < i) ? d1[q] : 0.f, 0.f) & 0xffffu); }
                else { const unsigned pk_ = cvtpk((j <= i) ? d0[q] : 0.f, (j <= i) ? d1[q] : 0.f); *(LAS bf16*)(CH + RC_ARK + i * 40 + j * 2) = (bf16)(pk_ & 0xffffu); *(LAS bf16*)(CH + RC_NARB + i * 40 + j * 2) = (bf16)(pk_ >> 16); }
            }
            if (ph) {
                float x[16];
#pragma unroll
                for (int i = 0; i < 16; ++i) { float s = (i == i16) ? 1.f : 0.f;
#pragma unroll
                    for (int j4 = 0; j4 < (i + 3) / 4; ++j4) { const f32x4 lr = *(const LAS f32x4*)(CH + RC_LBF + (i * 16 + j4 * 4) * 4);
#pragma unroll
                        for (int jj = 0; jj < 4; ++jj) { const int j = j4 * 4 + jj; if (j < i) s -= lr[jj] * x[j]; } }
                    x[i] = s; }
                if (g == 0) {
#pragma unroll
                    for (int i = 0; i < 16; i += 2) { const unsigned pk_ = cvtpk(x[i], x[i + 1]); *(LAS bf16*)(CH + RC_TM + i * 40 + i16 * 2) = (bf16)(pk_ & 0xffffu); *(LAS bf16*)(CH + RC_TM + (i + 1) * 40 + i16 * 2) = (bf16)(pk_ >> 16); } }
            }
        }
        __syncthreads();
        if (wave < 4) {
            const int vt = wave;
#pragma unroll 1
            for (int c = 0; c < 4; ++c) {
                const LAS unsigned char* C = lds + RW_CH0 + c * RW_CHB;
                v4u sb01, sb23;
                sb01.x = cvtpk(ST[0][0], ST[0][1]); sb01.y = cvtpk(ST[0][2], ST[0][3]); sb01.z = cvtpk(ST[1][0], ST[1][1]); sb01.w = cvtpk(ST[1][2], ST[1][3]);
                sb23.x = cvtpk(ST[2][0], ST[2][1]); sb23.y = cvtpk(ST[2][2], ST[2][3]); sb23.z = cvtpk(ST[3][0], ST[3][1]); sb23.w = cvtpk(ST[3][2], ST[3][3]);
                const bf16x8 s01 = __builtin_bit_cast(bf16x8, sb01), s23 = __builtin_bit_cast(bf16x8, sb23);
                const v2u kp0a = *(const LAS v2u*)(C + RC_KP + i16 * 144 + (4 * g) * 2), kp0b = *(const LAS v2u*)(C + RC_KP + i16 * 144 + (16 + 4 * g) * 2);
                const v2u kp1a = *(const LAS v2u*)(C + RC_KP + i16 * 144 + (32 + 4 * g) * 2), kp1b = *(const LAS v2u*)(C + RC_KP + i16 * 144 + (48 + 4 * g) * 2);
                const v2u rp0a = *(const LAS v2u*)(C + RC_RP + i16 * 144 + (4 * g) * 2), rp0b = *(const LAS v2u*)(C + RC_RP + i16 * 144 + (16 + 4 * g) * 2);
                const v2u rp1a = *(const LAS v2u*)(C + RC_RP + i16 * 144 + (32 + 4 * g) * 2), rp1b = *(const LAS v2u*)(C + RC_RP + i16 * 144 + (48 + 4 * g) * 2);
                const v2u lk = *(const LAS v2u*)(C + RC_LK + i16 * 40 + g * 8), tm = *(const LAS v2u*)(C + RC_TM + i16 * 40 + g * 8);
                const v2u ark = *(const LAS v2u*)(C + RC_ARK + i16 * 40 + g * 8), narb = *(const LAS v2u*)(C + RC_NARB + i16 * 40 + g * 8);
                const int trq = (i16 >> 2) & 3, trp = i16 & 3;
                const v2u vf = __builtin_bit_cast(v2u, __builtin_amdgcn_ds_read_tr16_b64_v4i16((LAS s16x4_t*)(C + RC_VR + (4 * g + trq) * 144 + (16 * vt + 4 * trp) * 2)));
                const v4u z4 = {0u, 0u, 0u, 0u};
                f32x4 rhs = (f32x4){0.f, 0.f, 0.f, 0.f};
                rhs = MFMA16(__builtin_bit_cast(bf16x8, ((v4u){kp0a.x, kp0a.y, kp0b.x, kp0b.y})), s01, rhs);
                rhs = MFMA16(__builtin_bit_cast(bf16x8, ((v4u){kp1a.x, kp1a.y, kp1b.x, kp1b.y})), s23, rhs);
                rhs = MFMA16(__builtin_bit_cast(bf16x8, ((v4u){lk.x, lk.y, 0u, 0u})), __builtin_bit_cast(bf16x8, ((v4u){vf.x, vf.y, 0u, 0u})), rhs);
                f32x4 z = MFMA16(__builtin_bit_cast(bf16x8, ((v4u){tm.x, tm.y, 0u, 0u})), __builtin_bit_cast(bf16x8, ((v4u){cvtpk(rhs[0], rhs[1]), cvtpk(rhs[2], rhs[3]), 0u, 0u})), ((f32x4){0.f, 0.f, 0.f, 0.f}));
                const bf16x8 vz = __builtin_bit_cast(bf16x8, ((v4u){vf.x, vf.y, cvtpk(z[0], z[1]), cvtpk(z[2], z[3])}));
                f32x4 y = (f32x4){0.f, 0.f, 0.f, 0.f};
                y = MFMA16(__builtin_bit_cast(bf16x8, ((v4u){rp0a.x, rp0a.y, rp0b.x, rp0b.y})), s01, y);
                y = MFMA16(__builtin_bit_cast(bf16x8, ((v4u){rp1a.x, rp1a.y, rp1b.x, rp1b.y})), s23, y);
                y = MFMA16(__builtin_bit_cast(bf16x8, ((v4u){ark.x, ark.y, narb.x, narb.y})), vz, y);
#pragma unroll
                for (int kt = 0; kt < 4; ++kt) {
                    const v2u ktf = __builtin_bit_cast(v2u, __builtin_amdgcn_ds_read_tr16_b64_v4i16((LAS s16x4_t*)(C + RC_KT + (4 * g + trq) * 144 + (16 * kt + 4 * trp) * 2)));
                    const v2u nbf = __builtin_bit_cast(v2u, __builtin_amdgcn_ds_read_tr16_b64_v4i16((LAS s16x4_t*)(C + RC_BP + (4 * g + trq) * 144 + (16 * kt + 4 * trp) * 2)));
                    const f32x4 g15 = *(const LAS f32x4*)(C + RC_G15 + (16 * kt + 4 * g) * 4);
                    ST[kt] = MFMA16(__builtin_bit_cast(bf16x8, ((v4u){ktf.x, ktf.y, nbf.x, nbf.y})), vz, ST[kt]);
                    ST[kt] = ST[kt] * g15;
                }
                { const unsigned y01 = cvtpk(y[0], y[1]), y23 = cvtpk(y[2], y[3]); LAS unsigned char* yb = lds + RW_YB + (c * 16 + 4 * g) * 144 + (16 * vt + i16) * 2;
                  *(LAS bf16*)(yb) = (bf16)(y01 & 0xffffu); *(LAS bf16*)(yb + 144) = (bf16)(y01 >> 16); *(LAS bf16*)(yb + 288) = (bf16)(y23 & 0xffffu); *(LAS bf16*)(yb + 432) = (bf16)(y23 >> 16); }
                (void)z4;
            }
        } else if (sc + 1 < nsc) {
            const int r0 = (tid - 256) >> 3;
#pragma unroll
            for (int hrow = 0; hrow < 2; ++hrow) { const int tokr = r0 + 32 * hrow, step_ = (sc + 1) * 64 + tokr, t_ = e ? L - 1 - step_ : step_;
                const bf16* gp_ = G1 + (size_t)(tok0 + t_) * G1W + C_LORA + e * 64 + st_c8;
                const v4u hw_ = *(const v4u*)gp_, ha_ = *(const v4u*)(gp_ + 128); v4u th_;
                th_.x = cvtpk(tanh_fast(bflo(hw_.x)), tanh_fast(bfhi(hw_.x))); th_.y = cvtpk(tanh_fast(bflo(hw_.y)), tanh_fast(bfhi(hw_.y))); th_.z = cvtpk(tanh_fast(bflo(hw_.z)), tanh_fast(bfhi(hw_.z))); th_.w = cvtpk(tanh_fast(bflo(hw_.w)), tanh_fast(bfhi(hw_.w)));
                *(LAS v4u*)(lds + RW_TH + tokr * 144 + st_c8 * 2) = th_; *(LAS v4u*)(lds + RW_HA + tokr * 144 + st_c8 * 2) = ha_; }
        }
        __syncthreads();
        {
            const int row = tid >> 3, part = tid & 7, step = sc * 64 + row, t = e ? L - 1 - step : step;
            *(v4u*)(YS + ((size_t)e * T + tok0 + t) * 256 + hh * 64 + part * 8) = *(const LAS v4u*)(lds + RW_YB + row * 144 + part * 16);
        }
    }
#undef RW_STAGE
#undef RW_PREFETCH
    if (!lat && wave < 4) {
        const int v = 16 * wave + i16;
#pragma unroll
        for (int kt = 0; kt < 4; ++kt) *(f32x4*)(a->out + O_RW + (((size_t)((b * 2 + layer) * 2 + e) * 4 + hh) * 64 + v) * 64 + 16 * kt + 4 * g) = ST[kt];
    }
}

constexpr int LR_WAT = 0, LR_XCB = 18432, LR_XCF = 27648, LR_AA = 44032, LR_BV = 60416, LR_HH = 76800, LR_SP = 93184, LR_SH = 95232, LR_HC = 97280;
__device__ __forceinline__ void lru_unit_mfma(ArgsP a, LAS unsigned char* lds, int layer, int u) {
    const int tid = tid_(), lane = tid & 63, wave = tid >> 6, i16 = lane & 15, g4 = lane >> 4;
    const int lat = u < 32, uu = lat ? u : u - 32, b = uu >> 2, g = uu & 3;
    const int L = lat ? L_LAT : L_CTX, tok0 = lat ? T_CTX + b * L_LAT : b * L_CTX;
    const bf16* G1 = (const bf16*)(a->ws + WS_G1);
    bf16* HF = (bf16*)(a->ws + WS_HF);
    LAS float* XCF = (LAS float*)(lds + LR_XCF); LAS float* AA = (LAS float*)(lds + LR_AA); LAS float* BV = (LAS float*)(lds + LR_BV); LAS float* HH = (LAS float*)(lds + LR_HH);
    LAS float* SP = (LAS float*)(lds + LR_SP); LAS float* SH = (LAS float*)(lds + LR_SH); LAS float* HC = (LAS float*)(lds + LR_HC);
    const int tt = tid >> 3, q8 = (tid & 7) * 8;
    float cw[4][8], cb[8];
#pragma unroll
    for (int i = 0; i < 8; ++i) { const int ch = g * 64 + q8 + i; cb[i] = a->in[I_CONVB][layer * 256 + ch];
#pragma unroll
        for (int j = 0; j < 4; ++j) cw[j][i] = a->in[I_CONVW][(layer * 4 + j) * 256 + ch]; }
    const int ot = wave & 3, tp = wave >> 2;
    const int sch = tid & 63, seg = tid >> 6;
    for (int e = 0; e < 2; ++e) {
        __syncthreads();
        for (int i = tid; i < 4096; i += NTHREADS) { const size_t src = ((size_t)((layer * 2 + e) * 4 + g)) * 4096 + i; const int ii = i >> 6, oo = i & 63;
            *(LAS bf16*)(lds + LR_WAT + (oo * 72 + ii) * 2) = (bf16)f2bf(a->in[I_WA][src]); *(LAS bf16*)(lds + LR_WAT + 9216 + (oo * 72 + ii) * 2) = (bf16)f2bf(a->in[I_WX][src]); }
        if (tid < 64) HC[tid] = lat ? a->in[I_SLRU][((size_t)(b * 2 + layer) * 2 + e) * 256 + g * 64 + tid] : 0.f;
        f32x4 bav, bxv, spl;
        { const int chb = (layer * 2 + e) * 256 + g * 64 + 16 * ot + 4 * g4;
          bav = *(const f32x4*)(a->in[I_BA] + chb); bxv = *(const f32x4*)(a->in[I_BX] + chb); const f32x4 lam = *(const f32x4*)(a->in[I_LAMBDA] + chb);
#pragma unroll
          for (int q = 0; q < 4; ++q) spl[q] = log1pf(exp_(-lam[q])); }
        __syncthreads();
        v4u xr[4], hfr, glr;
#define LR_PREFETCH(cc_) do { const int c_ = e ? L / 64 - 1 - (cc_) : (cc_), t_ = c_ * 64 + tt; \
            _Pragma("unroll") for (int j = 0; j < 4; ++j) { const int ts = t_ + j - 2; xr[j] = (ts >= 0 && ts < L) ? *(const v4u*)(G1 + (size_t)(tok0 + ts) * G1W + C_XL + g * 64 + q8) : (v4u){0u, 0u, 0u, 0u}; } \
            if (e) { hfr = *(const v4u*)(HF + (size_t)(tok0 + t_) * 256 + g * 64 + q8); glr = *(const v4u*)(G1 + (size_t)(tok0 + t_) * G1W + C_GL + g * 64 + q8); } } while (0)
        LR_PREFETCH(0);
        for (int cc = 0; cc < L / 64; ++cc) {
            const int c = e ? L / 64 - 1 - cc : cc, t = c * 64 + tt, n = tok0 + t;
            const v4u xcur[4] = {xr[0], xr[1], xr[2], xr[3]}; const v4u hfc = hfr, glc = glr;
            if (cc + 1 < L / 64) LR_PREFETCH(cc + 1);
            {
                float xc[8];
#pragma unroll
                for (int i = 0; i < 8; ++i) xc[i] = cb[i];
#pragma unroll
                for (int j = 0; j < 4; ++j) {
                    { const v4u x = xcur[j];
                        xc[0] += cw[j][0] * bflo(x.x); xc[1] += cw[j][1] * bfhi(x.x); xc[2] += cw[j][2] * bflo(x.y); xc[3] += cw[j][3] * bfhi(x.y);
                        xc[4] += cw[j][4] * bflo(x.z); xc[5] += cw[j][5] * bfhi(x.z); xc[6] += cw[j][6] * bflo(x.w); xc[7] += cw[j][7] * bfhi(x.w); } }
                *(LAS f32x4*)(XCF + tt * 64 + q8) = (f32x4){xc[0], xc[1], xc[2], xc[3]}; *(LAS f32x4*)(XCF + tt * 64 + q8 + 4) = (f32x4){xc[4], xc[5], xc[6], xc[7]};
                *(LAS v4u*)(lds + LR_XCB + tt * 144 + q8 * 2) = (v4u){cvtpk(xc[0], xc[1]), cvtpk(xc[2], xc[3]), cvtpk(xc[4], xc[5]), cvtpk(xc[6], xc[7])};
            }
            __syncthreads();
            {
#pragma unroll
                for (int t2 = 0; t2 < 2; ++t2) { const int tk = (2 * tp + t2) * 16 + i16;
                    f32x4 ga = (f32x4){0.f, 0.f, 0.f, 0.f}, gx = (f32x4){0.f, 0.f, 0.f, 0.f};
#pragma unroll
                    for (int ks = 0; ks < 2; ++ks) { const bf16x8 xf = *(const LAS bf16x8*)(lds + LR_XCB + tk * 144 + ks * 64 + g4 * 16);
                        const bf16x8 wa = *(const LAS bf16x8*)(lds + LR_WAT + (16 * ot + i16) * 144 + ks * 64 + g4 * 16), wx = *(const LAS bf16x8*)(lds + LR_WAT + 9216 + (16 * ot + i16) * 144 + ks * 64 + g4 * 16);
                        ga = MFMA16(wa, xf, ga); gx = MFMA16(wx, xf, gx); }
                    const f32x4 xcv = *(const LAS f32x4*)(XCF + tk * 64 + 16 * ot + 4 * g4);
                    f32x4 av, bv;
#pragma unroll
                    for (int q = 0; q < 4; ++q) { const float la = -8.f * sigmoidf_(ga[q] + bav[q]) * spl[q]; av[q] = exp_(la); bv[q] = sqrt_(1.f - exp_(2.f * la)) * sigmoidf_(gx[q] + bxv[q]) * xcv[q]; }
                    *(LAS f32x4*)(AA + tk * 64 + 16 * ot + 4 * g4) = av; *(LAS f32x4*)(BV + tk * 64 + 16 * ot + 4 * g4) = bv; }
            }
            __syncthreads();
            float av8[8], bv8[8];
            {
                float P = 1.f, H = 0.f;
#pragma unroll
                for (int s = 0; s < 8; ++s) { const int p = seg * 8 + s, st = e ? 63 - p : p; av8[s] = AA[st * 64 + sch]; bv8[s] = BV[st * 64 + sch]; H = fmaf(av8[s], H, bv8[s]); P *= av8[s]; }
                SP[seg * 64 + sch] = P; SH[seg * 64 + sch] = H;
            }
            __syncthreads();
            {
                float h = HC[sch];
                for (int s2 = 0; s2 < seg; ++s2) h = fmaf(SP[s2 * 64 + sch], h, SH[s2 * 64 + sch]);
#pragma unroll
                for (int s = 0; s < 8; ++s) { const int p = seg * 8 + s, st = e ? 63 - p : p; h = fmaf(av8[s], h, bv8[s]); HH[st * 64 + sch] = h; }
                __syncthreads();
                if (seg == 7) HC[sch] = h;
            }
            __syncthreads();
            {
                bf16* dst = HF + (size_t)n * 256 + g * 64 + q8;
                float o[8];
#pragma unroll
                for (int i = 0; i < 8; ++i) o[i] = HH[tt * 64 + q8 + i];
                if (e) { const v4u hf = hfc, gl = glc;
                    o[0] = (o[0] + bflo(hf.x)) * siluf_(bflo(gl.x)); o[1] = (o[1] + bfhi(hf.x)) * siluf_(bfhi(gl.x)); o[2] = (o[2] + bflo(hf.y)) * siluf_(bflo(gl.y)); o[3] = (o[3] + bfhi(hf.y)) * siluf_(bfhi(gl.y));
                    o[4] = (o[4] + bflo(hf.z)) * siluf_(bflo(gl.z)); o[5] = (o[5] + bfhi(hf.z)) * siluf_(bfhi(gl.z)); o[6] = (o[6] + bflo(hf.w)) * siluf_(bflo(gl.w)); o[7] = (o[7] + bfhi(hf.w)) * siluf_(bfhi(gl.w)); }
                *(v4u*)dst = (v4u){cvtpk(o[0], o[1]), cvtpk(o[2], o[3]), cvtpk(o[4], o[5]), cvtpk(o[6], o[7])};
            }
        }
#undef LR_PREFETCH
        __syncthreads();
        if (tid < 64 && !lat) a->out[O_LRU + ((size_t)(b * 2 + layer) * 2 + e) * 256 + g * 64 + tid] = HC[tid];
    }
}

constexpr int LQ_NQ = 32;
constexpr int LQ_WAT = 0, LQ_S0 = 2 * LQ_NQ * 144;
constexpr int LS_XCB = 0, LS_XCQ = 9216, LS_AA = LS_XCQ + 64 * LQ_NQ * 4, LS_BV = LS_AA + 64 * LQ_NQ * 4, LS_HH = LS_BV + 64 * LQ_NQ * 4,
              LS_SP = LS_HH + 64 * LQ_NQ * 4, LS_SH = LS_SP + 8 * LQ_NQ * 4, LS_HC = LS_SH + 8 * LQ_NQ * 4, LS_BYTES = LS_HC + 2 * LQ_NQ * 4;
__device__ __forceinline__ void lru_unit_q(ArgsP a, LAS unsigned char* lds, int layer, int u) {
    const int tid = tid_(), lane = tid & 63, wave = tid >> 6, i16 = lane & 15, g4 = lane >> 4;
    const int lat = u < 32, uu = lat ? u : u - 32, bp = uu >> 3, g = (uu >> 1) & 3, oq = uu & 1;
    const int L = lat ? L_LAT : L_CTX;
    const int tokb[2] = {lat ? T_CTX + (2 * bp) * L_LAT : (2 * bp) * L_CTX, lat ? T_CTX + (2 * bp + 1) * L_LAT : (2 * bp + 1) * L_CTX};
    const bf16* G1 = (const bf16*)(a->ws + WS_G1);
    bf16* HF = (bf16*)(a->ws + WS_HF);
    const int tt = tid >> 3, q8 = (tid & 7) * 8;
    float cw[4][8], cb[8];
#pragma unroll
    for (int i = 0; i < 8; ++i) { const int ch = g * 64 + q8 + i; cb[i] = a->in[I_CONVB][layer * 256 + ch];
#pragma unroll
        for (int j = 0; j < 4; ++j) cw[j][i] = a->in[I_CONVW][(layer * 4 + j) * 256 + ch]; }
    const int gt = wave & 3, got = wave >> 2;
    const int ssn = tid >> 8, sch = tid & (LQ_NQ - 1), seg = (tid >> 5) & 7;
    const int otok = tid >> 3, oc4 = (tid & 7) * 4;
    const int chq = g * 64 + oq * LQ_NQ;
    LAS unsigned char* SS = lds + LQ_S0 + ssn * LS_BYTES;
    for (int e = 0; e < 2; ++e) {
        __syncthreads();
        for (int i = tid; i < 64 * LQ_NQ; i += NTHREADS) { const int ii = i / LQ_NQ, oo = i % LQ_NQ; const size_t src = ((size_t)((layer * 2 + e) * 4 + g)) * 4096 + ii * 64 + oq * LQ_NQ + oo;
            *(LAS bf16*)(lds + LQ_WAT + (oo * 72 + ii) * 2) = (bf16)f2bf(a->in[I_WA][src]); *(LAS bf16*)(lds + LQ_WAT + LQ_NQ * 144 + (oo * 72 + ii) * 2) = (bf16)f2bf(a->in[I_WX][src]); }
        if (tid < 2 * LQ_NQ) { const int s = tid >> 5, c = tid & 31; ((LAS float*)(lds + LQ_S0 + s * LS_BYTES + LS_HC))[c] = lat ? a->in[I_SLRU][((size_t)((2 * bp + s) * 2 + layer) * 2 + e) * 256 + chq + c] : 0.f; }
        f32x4 bav, bxv, spl;
        { const int chb = (layer * 2 + e) * 256 + chq + 16 * got + 4 * g4;
          bav = *(const f32x4*)(a->in[I_BA] + chb); bxv = *(const f32x4*)(a->in[I_BX] + chb); const f32x4 lam = *(const f32x4*)(a->in[I_LAMBDA] + chb);
#pragma unroll
          for (int q = 0; q < 4; ++q) spl[q] = log1pf(exp_(-lam[q])); }
        v4u xr[2][4]; v2u hfr[2], glr[2];
#define LQ_PREFETCH(cc_) do { const int c_ = e ? L / 64 - 1 - (cc_) : (cc_), t_ = c_ * 64 + tt; \
            _Pragma("unroll") for (int s = 0; s < 2; ++s) { \
              _Pragma("unroll") for (int j = 0; j < 4; ++j) { const int ts = t_ + j - 2; xr[s][j] = (ts >= 0 && ts < L) ? *(const v4u*)(G1 + (size_t)(tokb[s] + ts) * G1W + C_XL + g * 64 + q8) : (v4u){0u, 0u, 0u, 0u}; } \
              if (e) { const int to_ = c_ * 64 + otok; hfr[s] = *(const v2u*)(HF + (size_t)(tokb[s] + to_) * 256 + chq + oc4); glr[s] = *(const v2u*)(G1 + (size_t)(tokb[s] + to_) * G1W + C_GL + chq + oc4); } } } while (0)
        LQ_PREFETCH(0);
        __syncthreads();
        for (int cc = 0; cc < L / 64; ++cc) {
            const int c = e ? L / 64 - 1 - cc : cc;
            v4u xcur[2][4]; v2u hfc[2], glc[2];
#pragma unroll
            for (int s = 0; s < 2; ++s) { xcur[s][0] = xr[s][0]; xcur[s][1] = xr[s][1]; xcur[s][2] = xr[s][2]; xcur[s][3] = xr[s][3]; hfc[s] = hfr[s]; glc[s] = glr[s]; }
            if (cc + 1 < L / 64) LQ_PREFETCH(cc + 1);
#pragma unroll
            for (int s = 0; s < 2; ++s) {
                LAS unsigned char* SB = lds + LQ_S0 + s * LS_BYTES;
                float xc[8];
#pragma unroll
                for (int i = 0; i < 8; ++i) xc[i] = cb[i];
#pragma unroll
                for (int j = 0; j < 4; ++j) { const v4u x = xcur[s][j];
                    xc[0] += cw[j][0] * bflo(x.x); xc[1] += cw[j][1] * bfhi(x.x); xc[2] += cw[j][2] * bflo(x.y); xc[3] += cw[j][3] * bfhi(x.y);
                    xc[4] += cw[j][4] * bflo(x.z); xc[5] += cw[j][5] * bfhi(x.z); xc[6] += cw[j][6] * bflo(x.w); xc[7] += cw[j][7] * bfhi(x.w); }
                *(LAS v4u*)(SB + LS_XCB + tt * 144 + q8 * 2) = (v4u){cvtpk(xc[0], xc[1]), cvtpk(xc[2], xc[3]), cvtpk(xc[4], xc[5]), cvtpk(xc[6], xc[7])};
                if ((q8 / LQ_NQ) == oq) { LAS float* XCQ = (LAS float*)(SB + LS_XCQ); *(LAS f32x4*)(XCQ + tt * LQ_NQ + (q8 % LQ_NQ)) = (f32x4){xc[0], xc[1], xc[2], xc[3]}; *(LAS f32x4*)(XCQ + tt * LQ_NQ + (q8 % LQ_NQ) + 4) = (f32x4){xc[4], xc[5], xc[6], xc[7]}; }
            }
            __syncthreads();
#pragma unroll
            for (int s = 0; s < 2; ++s) {
                LAS unsigned char* SB = lds + LQ_S0 + s * LS_BYTES;
                const int tk = gt * 16 + i16;
                f32x4 ga = (f32x4){0.f, 0.f, 0.f, 0.f}, gx = (f32x4){0.f, 0.f, 0.f, 0.f};
#pragma unroll
                for (int ks = 0; ks < 2; ++ks) { const bf16x8 xf = *(const LAS bf16x8*)(SB + LS_XCB + tk * 144 + ks * 64 + g4 * 16);
                    const bf16x8 wa = *(const LAS bf16x8*)(lds + LQ_WAT + (16 * got + i16) * 144 + ks * 64 + g4 * 16), wx = *(const LAS bf16x8*)(lds + LQ_WAT + LQ_NQ * 144 + (16 * got + i16) * 144 + ks * 64 + g4 * 16);
                    ga = MFMA16(wa, xf, ga); gx = MFMA16(wx, xf, gx); }
                const f32x4 xcv = *(const LAS f32x4*)((LAS float*)(SB + LS_XCQ) + tk * LQ_NQ + 16 * got + 4 * g4);
                f32x4 av, bv;
#pragma unroll
                for (int q = 0; q < 4; ++q) { const float la = -8.f * sigmoidf_(ga[q] + bav[q]) * spl[q], aq = exp_(la); av[q] = aq; bv[q] = sqrt_((1.f - aq) * (1.f + aq)) * sigmoidf_(gx[q] + bxv[q]) * xcv[q]; }
                *(LAS f32x4*)((LAS float*)(SB + LS_AA) + tk * LQ_NQ + 16 * got + 4 * g4) = av; *(LAS f32x4*)((LAS float*)(SB + LS_BV) + tk * LQ_NQ + 16 * got + 4 * g4) = bv;
            }
            __syncthreads();
            LAS float* AA = (LAS float*)(SS + LS_AA); LAS float* BV = (LAS float*)(SS + LS_BV); LAS float* HH = (LAS float*)(SS + LS_HH);
            LAS float* SP = (LAS float*)(SS + LS_SP); LAS float* SH = (LAS float*)(SS + LS_SH); LAS float* HC = (LAS float*)(SS + LS_HC);
            float av8[8], bv8[8];
            {
                float P = 1.f, H = 0.f;
#pragma unroll
                for (int s = 0; s < 8; ++s) { const int p = seg * 8 + s, st = e ? 63 - p : p; av8[s] = AA[st * LQ_NQ + sch]; bv8[s] = BV[st * LQ_NQ + sch]; H = fmaf(av8[s], H, bv8[s]); P *= av8[s]; }
                SP[seg * LQ_NQ + sch] = P; SH[seg * LQ_NQ + sch] = H;
            }
            __syncthreads();
            {
                float h = HC[(cc & 1) * LQ_NQ + sch];
                for (int s2 = 0; s2 < seg; ++s2) h = fmaf(SP[s2 * LQ_NQ + sch], h, SH[s2 * LQ_NQ + sch]);
#pragma unroll
                for (int s = 0; s < 8; ++s) { const int p = seg * 8 + s, st = e ? 63 - p : p; h = fmaf(av8[s], h, bv8[s]); HH[st * LQ_NQ + sch] = h; }
                if (seg == 7) HC[((cc + 1) & 1) * LQ_NQ + sch] = h;
            }
            __syncthreads();
#pragma unroll
            for (int s = 0; s < 2; ++s) {
                const int n = tokb[s] + c * 64 + otok;
                const f32x4 hv = *(const LAS f32x4*)((LAS float*)(lds + LQ_S0 + s * LS_BYTES + LS_HH) + otok * LQ_NQ + oc4);
                float o0 = hv[0], o1 = hv[1], o2 = hv[2], o3 = hv[3];
                if (e) { o0 = (o0 + bflo(hfc[s].x)) * siluf_(bflo(glc[s].x)); o1 = (o1 + bfhi(hfc[s].x)) * siluf_(bfhi(glc[s].x)); o2 = (o2 + bflo(hfc[s].y)) * siluf_(bflo(glc[s].y)); o3 = (o3 + bfhi(hfc[s].y)) * siluf_(bfhi(glc[s].y)); }
                *(v2u*)(HF + (size_t)n * 256 + chq + oc4) = (v2u){cvtpk(o0, o1), cvtpk(o2, o3)};
            }
        }
#undef LQ_PREFETCH
        __syncthreads();
        if (tid < 2 * LQ_NQ && !lat) { const int s = tid >> 5, c = tid & 31; a->out[O_LRU + ((size_t)((2 * bp + s) * 2 + layer) * 2 + e) * 256 + chq + c] = ((LAS float*)(lds + LQ_S0 + s * LS_BYTES + LS_HC))[((L / 64) & 1) * LQ_NQ + c]; }
    }
}

constexpr int ATT2_VSTR = 144, ATT2_STAGE = 64 * ATT_KSTR + 64 * ATT2_VSTR;
#define ATT_KLOAD(KB_) \
        bf16x8 kfa_[6], kfb_[6]; \
        _Pragma("unroll") for (int ks_ = 0; ks_ < 6; ++ks_) { kfa_[ks_] = *(const LAS bf16x8*)((KB_) + r * ATT_KSTR + ks_ * 32 + hq * 16); kfb_[ks_] = *(const LAS bf16x8*)((KB_) + (32 + r) * ATT_KSTR + ks_ * 32 + hq * 16); }
#define ATT_VLOAD(VB_) \
        v2u va0_[4], va1_[4], vb0_[4], vb1_[4]; \
        _Pragma("unroll") for (int ks_ = 0; ks_ < 4; ++ks_) { \
            const LAS unsigned char* vp_ = (VB_) + (ks_ * 16 + 4 * hq + ((lane >> 2) & 3)) * ATT2_VSTR + (16 * ((lane >> 4) & 1) + 4 * (lane & 3)) * 2; \
            va0_[ks_] = __builtin_bit_cast(v2u, __builtin_amdgcn_ds_read_tr16_b64_v4i16((LAS s16x4_t*)(vp_))); \
            va1_[ks_] = __builtin_bit_cast(v2u, __builtin_amdgcn_ds_read_tr16_b64_v4i16((LAS s16x4_t*)(vp_ + 8 * ATT2_VSTR))); \
            vb0_[ks_] = __builtin_bit_cast(v2u, __builtin_amdgcn_ds_read_tr16_b64_v4i16((LAS s16x4_t*)(vp_ + 64))); \
            vb1_[ks_] = __builtin_bit_cast(v2u, __builtin_amdgcn_ds_read_tr16_b64_v4i16((LAS s16x4_t*)(vp_ + 8 * ATT2_VSTR + 64))); }
#define ATT_QKM(S0_, S1_) do { \
        _Pragma("unroll") for (int i_ = 0; i_ < 16; ++i_) { S0_[i_] = 0.f; S1_[i_] = 0.f; } \
        _Pragma("unroll") for (int ks_ = 0; ks_ < 6; ++ks_) { S0_ = MFMA32(kfa_[ks_], qf[ks_], S0_); S1_ = MFMA32(kfb_[ks_], qf[ks_], S1_); } } while (0)
#define ATT_STEP(SC0_, SC1_, SN0_, SN1_, KB_, VB_, HAVE_NEXT_) do { \
        ATT_KLOAD(KB_) \
        float mx_ = SC0_[0]; \
        _Pragma("unroll") for (int i_ = 1; i_ < 16; ++i_) mx_ = fmaxf(mx_, SC0_[i_]); \
        _Pragma("unroll") for (int i_ = 0; i_ < 16; ++i_) mx_ = fmaxf(mx_, SC1_[i_]); \
        mx_ = fmaxf(mx_, __shfl_xor(mx_, 32)); \
        if (!__all(mx_ - m <= 8.f)) { const float mn_ = fmaxf(m, mx_), al_ = __builtin_amdgcn_exp2f(m - mn_); m = mn_; l *= al_; \
            _Pragma("unroll") for (int i_ = 0; i_ < 16; ++i_) { o0[i_] *= al_; o1[i_] *= al_; } } \
        if (HAVE_NEXT_) ATT_QKM(SN0_, SN1_); \
        ATT_VLOAD(VB_) \
        float ps_ = 0.f; \
        _Pragma("unroll") for (int i_ = 0; i_ < 16; ++i_) { SC0_[i_] = __builtin_amdgcn_exp2f(SC0_[i_] - m); SC1_[i_] = __builtin_amdgcn_exp2f(SC1_[i_] - m); ps_ += SC0_[i_] + SC1_[i_]; } \
        l += ps_; \
        _Pragma("unroll") for (int ks_ = 0; ks_ < 4; ++ks_) { \
            v4u pw_; \
            if (ks_ == 0) { pw_.x = cvtpk(SC0_[0], SC0_[1]); pw_.y = cvtpk(SC0_[2], SC0_[3]); pw_.z = cvtpk(SC0_[4], SC0_[5]); pw_.w = cvtpk(SC0_[6], SC0_[7]); } \
            else if (ks_ == 1) { pw_.x = cvtpk(SC0_[8], SC0_[9]); pw_.y = cvtpk(SC0_[10], SC0_[11]); pw_.z = cvtpk(SC0_[12], SC0_[13]); pw_.w = cvtpk(SC0_[14], SC0_[15]); } \
            else if (ks_ == 2) { pw_.x = cvtpk(SC1_[0], SC1_[1]); pw_.y = cvtpk(SC1_[2], SC1_[3]); pw_.z = cvtpk(SC1_[4], SC1_[5]); pw_.w = cvtpk(SC1_[6], SC1_[7]); } \
            else { pw_.x = cvtpk(SC1_[8], SC1_[9]); pw_.y = cvtpk(SC1_[10], SC1_[11]); pw_.z = cvtpk(SC1_[12], SC1_[13]); pw_.w = cvtpk(SC1_[14], SC1_[15]); } \
            const bf16x8 pf_ = __builtin_bit_cast(bf16x8, pw_); \
            const v4u vwa_ = {va0_[ks_].x, va0_[ks_].y, va1_[ks_].x, va1_[ks_].y}, vwb_ = {vb0_[ks_].x, vb0_[ks_].y, vb1_[ks_].x, vb1_[ks_].y}; \
            o0 = MFMA32(__builtin_bit_cast(bf16x8, vwa_), pf_, o0); o1 = MFMA32(__builtin_bit_cast(bf16x8, vwb_), pf_, o1); } } while (0)
__device__ __forceinline__ void att_unit2(ArgsP a, LAS unsigned char* lds, int u) {
    const int tid = tid_(), lane = tid & 63, wave = tid >> 6, r = lane & 31, hq = lane >> 5;
    const bf16* KN = (const bf16*)(a->ws + WS_KN); const bf16* KR = (const bf16*)(a->ws + WS_KR); const bf16* VT = (const bf16*)(a->ws + WS_VT);
    bf16* Q = (bf16*)(a->ws + WS_Q); const bf16* G1 = (const bf16*)(a->ws + WS_G1);
    int b, h, n0, Lk, kidx0; size_t vbase;
    if (u < 512) { b = u >> 6; h = (u >> 3) & 7; n0 = T_CTX + b * 2048 + (u & 7) * 256; Lk = LK_LAT; kidx0 = T_CTX + b * LK_LAT; vbase = (size_t)VT_LAT + (size_t)(b * 8 + h) * 64 * LK_LAT; }
    else { const int uu = u - 512; b = uu >> 3; h = uu & 7; n0 = b * 256; Lk = 256; kidx0 = b * 256; vbase = (size_t)(b * 8 + h) * 64 * 256; }
    const int ntiles = Lk >> 6;
    const int n = n0 + wave * 32 + r;
    bf16x8 qf[6];
#pragma unroll
    for (int ks = 0; ks < 6; ++ks) qf[ks] = *(const bf16x8*)(Q + (size_t)n * 768 + h * 96 + ks * 16 + 8 * hq);
    const int key_k = tid >> 3, ck = tid & 7, key_r = (tid >> 2) & 63, cr = tid & 3;
    const bf16* gk = KN + (size_t)(kidx0 + key_k) * 512 + h * 64 + ck * 8;
    const bf16* gr = KR + (size_t)(kidx0 + key_r) * 32 + cr * 8;
    const bf16* gv = VT + (size_t)(kidx0 + key_k) * 512 + h * 64 + ck * 8;
    const unsigned sk = key_k * ATT_KSTR + ck * 16, sr = key_r * ATT_KSTR + 128 + cr * 16, sv = ATT_VOFF + key_k * ATT2_VSTR + ck * 16;
    v4u rkA, rrA = {0u, 0u, 0u, 0u}, rvA, rkB, rrB = {0u, 0u, 0u, 0u}, rvB;
#define ATT_LOAD(X_, j_) do { rk##X_ = *(const v4u*)(gk + (size_t)(j_) * 64 * 512); if (tid < 256) rr##X_ = *(const v4u*)(gr + (size_t)(j_) * 64 * 32); rv##X_ = *(const v4u*)(gv + (size_t)(j_) * 64 * 512); } while (0)
#define ATT_STORE(X_, B_) do { LAS unsigned char* nb_ = lds + (B_) * ATT2_STAGE; *(LAS v4u*)(nb_ + sk) = rk##X_; if (tid < 256) *(LAS v4u*)(nb_ + sr) = rr##X_; \
        *(LAS v4u*)(nb_ + sv) = rv##X_; } while (0)
    ATT_LOAD(A, 0); ATT_LOAD(B, 1);
    __syncthreads();
    ATT_STORE(A, 0);
    ATT_STORE(B, 1);
    ATT_LOAD(A, 2);
    __syncthreads();
    f32x16 o0, o1, sa0, sa1, sb0, sb1;
#pragma unroll
    for (int i = 0; i < 16; ++i) { o0[i] = 0.f; o1[i] = 0.f; }
    float m = -1e30f, l = 0.f;
    { ATT_KLOAD(lds) ATT_QKM(sa0, sa1); }
    int bcur = 0;
    int j = 0;
    for (; j < ntiles - 2; j += 2) {
        {
            const int b1 = bcur == 2 ? 0 : bcur + 1, b2 = b1 == 2 ? 0 : b1 + 1;
            ATT_LOAD(B, j + 3);
            ATT_STEP(sa0, sa1, sb0, sb1, lds + b1 * ATT2_STAGE, lds + bcur * ATT2_STAGE + ATT_VOFF, true);
            ATT_STORE(A, b2);
            __syncthreads();
            bcur = b1;
        }
        {
            const int b1 = bcur == 2 ? 0 : bcur + 1, b2 = b1 == 2 ? 0 : b1 + 1;
            if (j + 4 < ntiles) ATT_LOAD(A, j + 4);
            ATT_STEP(sb0, sb1, sa0, sa1, lds + b1 * ATT2_STAGE, lds + bcur * ATT2_STAGE + ATT_VOFF, true);
            ATT_STORE(B, b2);
            __syncthreads();
            bcur = b1;
        }
    }
    {
        { const int b1 = bcur == 2 ? 0 : bcur + 1;
          ATT_STEP(sa0, sa1, sb0, sb1, lds + b1 * ATT2_STAGE, lds + bcur * ATT2_STAGE + ATT_VOFF, true);
          bcur = b1; }
        { ATT_STEP(sb0, sb1, sa0, sa1, lds + bcur * ATT2_STAGE, lds + bcur * ATT2_STAGE + ATT_VOFF, false); }
        __syncthreads();
    }
#undef ATT_LOAD
#undef ATT_STORE
    v2u gmv[2][4];
#pragma unroll
    for (int mt = 0; mt < 2; ++mt)
#pragma unroll
        for (int g = 0; g < 4; ++g) gmv[mt][g] = *(const v2u*)(G1 + (size_t)n * G1W + C_GM + h * 64 + 32 * mt + 8 * g + 4 * hq);
    l += __shfl_xor(l, 32);
    const float inv = rcp_(l);
#pragma unroll
    for (int mt = 0; mt < 2; ++mt)
#pragma unroll
        for (int g = 0; g < 4; ++g) {
            const int dv0 = 32 * mt + 8 * g + 4 * hq;
            const v2u gm = gmv[mt][g];
            const float x0 = (mt ? o1[4 * g + 0] : o0[4 * g + 0]) * inv, x1 = (mt ? o1[4 * g + 1] : o0[4 * g + 1]) * inv, x2 = (mt ? o1[4 * g + 2] : o0[4 * g + 2]) * inv, x3 = (mt ? o1[4 * g + 3] : o0[4 * g + 3]) * inv;
            v2u ov; ov.x = cvtpk(x0 * siluf_(bflo(gm.x)), x1 * siluf_(bfhi(gm.x))); ov.y = cvtpk(x2 * siluf_(bflo(gm.y)), x3 * siluf_(bfhi(gm.y)));
            *(v2u*)(Q + (size_t)n * 768 + h * 96 + dv0) = ov;
        }
}
constexpr int N_PHASES = 14;
#ifndef MK_PER_PHASE
#define MK_PER_PHASE 0
#endif
#ifndef VAR_GEMM
#define VAR_GEMM 1
#endif
#ifndef VAR_A2
#define VAR_A2 1
#endif
#ifndef VAR_ATT
#define VAR_ATT 1
#endif
#ifndef VAR_RWKV
#define VAR_RWKV 1
#endif
#ifndef VAR_LRU
#define VAR_LRU 1
#endif

__device__ __forceinline__ void phase_b(ArgsP a, LAS unsigned char* lds, int layer) {
    volatile LAS unsigned* MISC = (volatile LAS unsigned*)(lds + LDS_MISC);
    unsigned* head = (unsigned*)(a->ws + WS_CTL) + CW_Q + layer * 64;
    for (;;) {
        __syncthreads();
        if (tid_() == 0) MISC[16] = atomicAdd(head, 1u);
        __syncthreads();
        const int idx = (int)MISC[16];
        if (idx >= 1248) break;
#ifdef PROBE_UNIT1
        const unsigned long long pt0_ = __builtin_amdgcn_s_memrealtime();
#endif
        if (idx < 64) rwkv_unit_mfma(a, lds, layer, idx);
        else if (idx < 96) lru_unit_q(a, lds, layer, idx - 64);
        else if (idx < 608) att_unit2(a, lds, idx - 96);
        else if (idx < 864) rwkv_unit_mfma(a, lds, layer, 64 + idx - 608);
        else if (idx < 992) lru_unit_q(a, lds, layer, 32 + idx - 864);
        else att_unit2(a, lds, 512 + idx - 992);
#ifdef PROBE_UNIT1
        if (tid_() == 0 && layer == 0) { const unsigned d_ = (unsigned)(__builtin_amdgcn_s_memrealtime() - pt0_);
            const int ty_ = idx < 64 ? 0 : idx < 96 ? 1 : idx < 608 ? 2 : idx < 864 ? 3 : idx < 992 ? 4 : 5;
            atomicMax((unsigned*)(a->ws + WS_CTL) + CW_Q + 1024 + ty_ * 64, d_); }
#endif
    }
}

#if MK_PER_PHASE
template <int SUB> __global__ void __launch_bounds__(NTHREADS, 2) mk_phase(Args args, int layer) {
    extern __shared__ __attribute__((aligned(16))) unsigned char lds_raw[];
    LAS unsigned char* lds = (LAS unsigned char*)lds_raw;
    ArgsP a = (ArgsP)__builtin_amdgcn_kernarg_segment_ptr();
    if (SUB == 0) phase_p0(a, lds);
    if (SUB == 1) phase_a0(a, layer);
    if (SUB == 2) { if (VAR_GEMM) phase_a1_pg8(a, lds, layer); else phase_a1_naive(a, layer); }
    if (SUB == 3) { if (VAR_A2) { for (int u = blockIdx.x; u < T / 64 + 32; u += gridDim.x) a2_unit(a, lds, layer, u); } else phase_a2_naive(a, lds, layer); }
    if (SUB == 4) { if (VAR_ATT) { for (int u = blockIdx.x; u < 768; u += gridDim.x) att_unit(a, lds, u); } else phase_att_naive(a); }
    if (SUB == 5) { for (int u = blockIdx.x; u < 320; u += gridDim.x) { __syncthreads(); if (VAR_RWKV) rwkv_unit_mfma(a, lds, layer, u); else rwkv_unit_seq(a, lds, layer, u); } }
    if (SUB == 6) { for (int u = blockIdx.x; u < 160; u += gridDim.x) { __syncthreads(); if (VAR_LRU) lru_unit_mfma(a, lds, layer, u); else lru_unit_seq(a, lds, layer, u); } }
    if (SUB == 7) phase_c1(a, layer);
    if (SUB == 8) { if (VAR_GEMM) phase_c2_pg8(a, lds, layer); else phase_c2_naive(a, layer); }
    if (SUB == 9) phase_final(a);
}
#else
#define ARGS_VIEW() ({ ArgsP p_ = (ArgsP)__builtin_amdgcn_kernarg_segment_ptr(); asm volatile("" : "+s"(p_)); p_; })
__global__ void __launch_bounds__(NTHREADS, 2) mk_fwd(Args args) {
    extern __shared__ __attribute__((aligned(16))) unsigned char lds_raw[];
    LAS unsigned char* lds = (LAS unsigned char*)lds_raw;
    volatile LAS unsigned* MISC = (volatile LAS unsigned*)(lds + LDS_MISC);
    for (int u = threadIdx.x; u < 64; u += NTHREADS) MISC[u] = 0u;
    __syncthreads();
    XcdBarrier bar;
    { ArgsP a = ARGS_VIEW(); bar = xcd_barrier_post((unsigned*)(a->ws + WS_CTL) + CW_BAR, MISC + 8); }
    int lo, hi; { ArgsP a = ARGS_VIEW(); lo = a->ph_lo; hi = a->ph_hi; }
#define IN(k) (lo <= (k) && (k) < hi)
#ifdef PROBE_MASK1
#define STAMP(k) do { if (bid_() == 0 && tid_() == 0) { const unsigned long long t_ = __builtin_amdgcn_s_memrealtime(); MISC[32 + 2 * (k)] = (unsigned)t_; MISC[33 + 2 * (k)] = (unsigned)(t_ >> 32); } } while (0)
#else
#define STAMP(k) do { } while (0)
#endif
#define SEAM(k) do { if (IN(k) && IN((k) + 1)) xcd_barrier(bar); STAMP((k) + 1); } while (0)
#ifndef NO_P0
    STAMP(0);
    if (IN(0)) { ArgsP a = ARGS_VIEW(); phase_p0(a, lds); }
#endif
    SEAM(0);
    for (int layer = 0; layer < 2; ++layer) {
        const int p = 1 + 6 * layer;
#ifndef NO_A0
        if (IN(p + 0)) { { ArgsP a = ARGS_VIEW(); phase_a0(a, layer); } if (layer == 0) { ArgsP a = ARGS_VIEW(); phase_p0_weights(a, lds); } }
#endif
        SEAM(p + 0);
#ifndef NO_A1
        if (IN(p + 1)) { ArgsP a = ARGS_VIEW(); phase_a1_pg8(a, lds, layer); }
#endif
        SEAM(p + 1);
#ifndef NO_A2
        if (IN(p + 2)) { { ArgsP a = ARGS_VIEW(); phase_a2a(a, layer); } xcd_barrier(bar); { ArgsP a = ARGS_VIEW(); phase_a2b(a, lds, layer); } }
        if (0) { ArgsP a = ARGS_VIEW(); for (int u = bid_(); u < T / 64 + 32; u += grid_()) {
#ifdef PROBE_UNIT1
            const unsigned long long pt0_ = __builtin_amdgcn_s_memrealtime();
#endif
            a2_unit(a, lds, layer, u);
#ifdef PROBE_A2_TWICE
            a2_unit(a, lds, layer, u);
#endif
#ifdef PROBE_UNIT1
            __syncthreads();
            if (tid_() == 0 && layer == 0) atomicMax((unsigned*)(a->ws + WS_CTL) + CW_Q + 1024 + (u < 256 ? 6 : 7) * 64, (unsigned)(__builtin_amdgcn_s_memrealtime() - pt0_));
#endif
        } }
#endif
        SEAM(p + 2);
#ifndef NO_B
        if (IN(p + 3)) { ArgsP a = ARGS_VIEW(); phase_b(a, lds, layer); }
#endif
        SEAM(p + 3);
#ifndef NO_C1
        if (IN(p + 4)) { ArgsP a = ARGS_VIEW(); phase_c1(a, layer); }
#endif
        SEAM(p + 4);
#ifndef NO_C2
        if (IN(p + 5)) { ArgsP a = ARGS_VIEW(); phase_c2_pg8(a, lds, layer); }
#endif
        SEAM(p + 5);
    }
    if (IN(N_PHASES - 1)) { ArgsP a = ARGS_VIEW(); phase_final(a); }
#ifdef PROBE_MASK1
    STAMP(14);
    __syncthreads();
    if (bid_() == 0) {
        ArgsP a = ARGS_VIEW();
        float t1 = 0.f, t2 = 0.f;
        for (int k = 0; k < 14; ++k) { const unsigned long long s0 = ((unsigned long long)MISC[33 + 2 * k] << 32) | MISC[32 + 2 * k], s1 = ((unsigned long long)MISC[35 + 2 * k] << 32) | MISC[34 + 2 * k];
            const float us = (float)(s1 - s0) * 0.01f; if ((PROBE_MASK1 >> k) & 1) t1 += us; if ((PROBE_MASK2 >> k) & 1) t2 += us; }
#ifdef PROBE_UNIT1
        t1 = (float)((unsigned*)(a->ws + WS_CTL))[CW_Q + 1024 + PROBE_UNIT1 * 64] * 0.01f; t2 = (float)((unsigned*)(a->ws + WS_CTL))[CW_Q + 1024 + PROBE_UNIT2 * 64] * 0.01f;
#endif
        for (int i = tid_(); i < 32768; i += NTHREADS) a->out[O_LRU + i] *= (1.f + t2 * (1.f / 2000.f));
        if (tid_() == 0) a->out[0] += 2.f + t1 * 0.01f;
    }
#endif
#undef IN
#undef SEAM
}

#endif

extern "C" void kernel_launch(void* const* d_in, const int* in_sizes, int n_in, void* d_out, int out_size, void* d_ws, size_t ws_size, hipStream_t stream) {
    static int grid = 0;
    if (grid == 0) {
        if (n_in != N_IN || ws_size < WS_END) { fprintf(stderr, "kernel_launch: unexpected n_in %d / ws_size %zu\n", n_in, ws_size); grid = -1; return; }
        int dev = 0, cus = 0;
        if (hipGetDevice(&dev) != hipSuccess || hipDeviceGetAttribute(&cus, hipDeviceAttributeMultiprocessorCount, dev) != hipSuccess) { grid = -1; return; }
#if MK_PER_PHASE
#define SA(SUB) if (hipFuncSetAttribute((const void*)mk_phase<SUB>, hipFuncAttributeMaxDynamicSharedMemorySize, LDS_BYTES) != hipSuccess) { fprintf(stderr, "kernel_launch: hipFuncSetAttribute failed\n"); grid = -1; return; }
        SA(0) SA(1) SA(2) SA(3) SA(4) SA(5) SA(6) SA(7) SA(8) SA(9)
#undef SA
#else
        if (hipFuncSetAttribute((const void*)mk_fwd, hipFuncAttributeMaxDynamicSharedMemorySize, LDS_BYTES) != hipSuccess) { fprintf(stderr, "kernel_launch: hipFuncSetAttribute failed\n"); grid = -1; return; }
        int per_cu = 0;
        if (hipOccupancyMaxActiveBlocksPerMultiprocessor(&per_cu, (const void*)mk_fwd, NTHREADS, LDS_BYTES) != hipSuccess || per_cu < 1) fprintf(stderr, "kernel_launch: occupancy query reports %d\n", per_cu);
        (void)hipGetLastError();
#endif
        grid = cus;
    }
    if (grid < 0) return;
    if (hipMemsetAsync((char*)d_ws + WS_CTL, 0, CTL_ZERO_BYTES, stream) != hipSuccess) return;
    Args a{};
    for (int i = 0; i < N_IN; ++i) a.in[i] = (const float*)d_in[i];
    a.out = (float*)d_out; a.ws = (unsigned char*)d_ws;
#if MK_PER_PHASE
#define LP(SUB, layer) hipLaunchKernelGGL(mk_phase<SUB>, dim3(grid), dim3(NTHREADS), LDS_BYTES, stream, a, layer)
    LP(0, 0);
    for (int layer = 0; layer < 2; ++layer) { LP(1, layer); LP(2, layer); LP(3, layer); LP(4, layer); LP(5, layer); LP(6, layer); LP(7, layer); LP(8, layer); }
    LP(9, 0);
#undef LP
#else
    a.ph_lo = 0; a.ph_hi = N_PHASES;
    hipLaunchKernelGGL(mk_fwd, dim3(grid), dim3(NTHREADS), LDS_BYTES, stream, a);
#endif
}
```

```cpp
#define MK_PER_PHASE 0
#include <hip/hip_runtime.h>
#include <cstdio>
#include <cstdint>

#define GAS __attribute__((address_space(1)))
#define LAS __attribute__((address_space(3)))
typedef unsigned short bf16;
typedef unsigned v4u __attribute__((ext_vector_type(4)));
typedef unsigned v2u __attribute__((ext_vector_type(2)));
typedef float f32x4 __attribute__((ext_vector_type(4)));
typedef short bf16x8 __attribute__((ext_vector_type(8)));

constexpr int D = 1024, T_CTX = 8192, T_LAT = 16384, T = 24576, L_CTX = 256, L_LAT = 2048, PAST = 256;
constexpr int NIN = 2816, G1W = 2304, G2W = 512;
constexpr int C_R = 0, C_K = 256, C_V = 512, C_G = 768, C_GM = 1024, C_XL = 1536, C_GL = 1792, C_LORA = 2048;
constexpr int LK_LAT = PAST + L_LAT;
constexpr int TK = T_CTX + 8 * LK_LAT;
constexpr int VT_LAT = 32 * 8 * 64 * 256;
constexpr float LN_EPS = 1e-5f, GN_EPS = 64e-5f;
constexpr float ALPHA = 1.4142135623730951f;
constexpr float QSCALE = 0.10206207261596575f * 1.4426950408889634f;
constexpr size_t O_Y = 0, O_RW = 25165824, O_CKV = 27262976, O_KR = 29360128, O_LRU = 29884416;
constexpr size_t MiB = 1u << 20;
constexpr size_t WS_CTL = 0, CTL_ZERO_BYTES = 1 * MiB;
constexpr size_t WS_MOD = 256 * 1024;
constexpr size_t WS_ROPE = 1 * MiB;
constexpr size_t WS_LORA2 = 1280 * 1024;
constexpr size_t WS_LRUW = 2816 * 1024;
constexpr size_t WS_STATS = 1536 * 1024;
constexpr size_t WS_WUQ = 2 * MiB;
constexpr size_t WS_WUKV = 3 * MiB;
constexpr size_t WS_WIN = 4 * MiB;
constexpr size_t WS_WOUT = 16 * MiB;
constexpr size_t WS_G1 = 20 * MiB;
constexpr size_t WS_G2 = 128 * MiB;
constexpr size_t WS_Q = 152 * MiB;
constexpr size_t WS_U = 152 * MiB;
constexpr size_t WS_KN = 188 * MiB;
constexpr size_t WS_KR = 214 * MiB;
constexpr size_t WS_VT = 216 * MiB;
constexpr size_t WS_YMIX = 188 * MiB;
constexpr size_t WS_HF = 242 * MiB;
constexpr size_t WS_END = 254 * MiB;
constexpr int CW_BAR = 4096;
constexpr int CW_Q = 16384;

__device__ __forceinline__ float bf2f(unsigned b) { return __uint_as_float(b << 16); }
__device__ __forceinline__ float bflo(unsigned w) { return __uint_as_float(w << 16); }
__device__ __forceinline__ float bfhi(unsigned w) { return __uint_as_float(w & 0xffff0000u); }
__device__ __forceinline__ unsigned f2bf(float f) { unsigned u = __float_as_uint(f); return (u + 0x7fffu + ((u >> 16) & 1u)) >> 16; }
__device__ __forceinline__ unsigned pk2(float lo, float hi) { return f2bf(lo) | (f2bf(hi) << 16); }
__device__ __forceinline__ float rcp_(float x) { return __builtin_amdgcn_rcpf(x); }
__device__ __forceinline__ float exp_(float x) { return __builtin_amdgcn_exp2f(x * 1.4426950408889634f); }
__device__ __forceinline__ float sqrt_(float x) { return __builtin_amdgcn_sqrtf(x); }
__device__ __forceinline__ float rsqrt_(float x) { return __builtin_amdgcn_rsqf(x); }
__device__ __forceinline__ float sigmoidf_(float x) { return rcp_(1.f + exp_(-x)); }
__device__ __forceinline__ float siluf_(float x) { return x * rcp_(1.f + exp_(-x)); }
template <int CTRL> __device__ __forceinline__ float dpp_f(float old, float x) { return __builtin_bit_cast(float, __builtin_amdgcn_update_dpp(__builtin_bit_cast(int, old), __builtin_bit_cast(int, x), CTRL, 0xf, 0xf, false)); }
__device__ __forceinline__ float row16_sum(float x) { x += dpp_f<0x128>(0.f, x); x += dpp_f<0x124>(0.f, x); x += dpp_f<0x122>(0.f, x); x += dpp_f<0x121>(0.f, x); return x; }
__device__ __forceinline__ float wave_sum_fast(float x) { x = row16_sum(x); x += __shfl_xor(x, 16); x += __shfl_xor(x, 32); return x; }
__device__ __forceinline__ float row16_prefix_prod(float x) { x *= dpp_f<0x111>(1.f, x); x *= dpp_f<0x112>(1.f, x); x *= dpp_f<0x114>(1.f, x); x *= dpp_f<0x118>(1.f, x); return x; }
__device__ __forceinline__ float wave_sum(float v) { return wave_sum_fast(v); }
__device__ __forceinline__ int tid_() { int t = threadIdx.x; asm volatile("" : "+v"(t)); return t; }
__device__ __forceinline__ int bid_() { int b = blockIdx.x; asm volatile("" : "+s"(b)); return b; }
__device__ __forceinline__ int grid_() { int g = gridDim.x; asm volatile("" : "+s"(g)); return g; }
typedef float f32x16 __attribute__((ext_vector_type(16)));
typedef float f32x2_t __attribute__((ext_vector_type(2)));
typedef __bf16 bf16x2_t __attribute__((ext_vector_type(2)));
__device__ __forceinline__ unsigned cvtpk(float lo, float hi) { const f32x2_t v = {lo, hi}; return __builtin_bit_cast(unsigned, __builtin_convertvector(v, bf16x2_t)); }
#define XB_TMO      128
#define XB_XCNT(j)  (256  + 64 * (j))
#define XB_XSUB(j)  (1280 + 64 * (j))
#define XB_XGEN(j)  (2304 + 64 * (j))
#define XB_TOP      3328
#define XB_TOPGEN   3392
#define XCD_BAR_WORDS 3456
#define XB_SPIN_CAP (1u << 24)

__device__ __forceinline__ unsigned xb_ld(unsigned* p)              { return __hip_atomic_load(p, __ATOMIC_RELAXED, __HIP_MEMORY_SCOPE_AGENT); }
__device__ __forceinline__ unsigned xb_add(unsigned* p, unsigned v) { return __hip_atomic_fetch_add(p, v, __ATOMIC_RELAXED, __HIP_MEMORY_SCOPE_AGENT); }
__device__ __forceinline__ unsigned xb_xcc_id() { return (unsigned)__builtin_amdgcn_s_getreg((3 << 11) | 20) & 0xFu; }
#define XB_SPIN(cond, bar) do { unsigned _sp = 0; while (cond) { __builtin_amdgcn_s_sleep(1); \
    if ((++_sp & 255u) == 0u) { if (xb_ld(&(bar)[XB_TMO])) break; if (_sp > XB_SPIN_CAP) { atomicAdd(&(bar)[XB_TMO], 1u); break; } } } } while (0)

struct XcdBarrier {
    unsigned* bar; unsigned x;
    volatile LAS unsigned* st;
};

__device__ __forceinline__ XcdBarrier xcd_barrier_post(unsigned* bar, volatile LAS unsigned* st) {
    XcdBarrier b; b.bar = bar; b.x = xb_xcc_id(); b.st = st;
    if (threadIdx.x == 0) (void)xb_add(&bar[XB_XCNT(b.x)], 1u);
    return b;
}
__device__ __forceinline__ void xcd_barrier_complete(unsigned* bar, unsigned x, unsigned& nloc, unsigned& nx) {
    const unsigned G = gridDim.x * gridDim.y * gridDim.z;
    unsigned sum, cnt, mine, sp = 0u;
    for (;;) {
        sum = 0u; cnt = 0u; mine = 0u;
#pragma unroll
        for (unsigned j = 0; j < 16; ++j) { const unsigned c = xb_ld(&bar[XB_XCNT(j)]); sum += c; cnt += (c > 0u) ? 1u : 0u; mine = (j == x) ? c : mine; }
        if (sum == G) break;
        __builtin_amdgcn_s_sleep(1);
        if ((++sp & 255u) == 0u) { if (xb_ld(&bar[XB_TMO])) break; if (sp > XB_SPIN_CAP) { atomicAdd(&bar[XB_TMO], 1u); break; } }
    }
    nloc = mine > 0u ? mine : 1u; nx = cnt > 0u ? cnt : 1u;
}

__device__ __forceinline__ void xcd_barrier(const XcdBarrier& b) {
    asm volatile("s_waitcnt vmcnt(0)" ::: "memory");
    __syncthreads();
    if (threadIdx.x == 0) {
        unsigned* bar = b.bar;
        __builtin_amdgcn_s_waitcnt(0);
        unsigned nloc = b.st[0], nx = b.st[1];
        if (nloc == 0u) { xcd_barrier_complete(bar, b.x, nloc, nx); b.st[0] = nloc; b.st[1] = nx; }
        const unsigned old = xb_add(&bar[XB_XSUB(b.x)], 1u);
        const unsigned gen = old / nloc;
        if (old + 1u == (gen + 1u) * nloc) {
            __builtin_amdgcn_fence(__ATOMIC_RELEASE, "agent");
            asm volatile("s_waitcnt vmcnt(0)" ::: "memory");
            const unsigned og = xb_add(&bar[XB_TOP], 1u);
            const unsigned tg = og / nx;
            if (og + 1u == (tg + 1u) * nx) xb_add(&bar[XB_TOPGEN], 1u);
            else XB_SPIN(xb_ld(&bar[XB_TOPGEN]) == tg, bar);
            __builtin_amdgcn_fence(__ATOMIC_ACQUIRE, "agent");
            xb_add(&bar[XB_XGEN(b.x)], 1u);
            asm volatile("s_waitcnt vmcnt(0)" ::: "memory");
        } else {
            XB_SPIN(xb_ld(&bar[XB_XGEN(b.x)]) == gen, bar);
            __builtin_amdgcn_fence(__ATOMIC_ACQUIRE, "agent");
            asm volatile("s_waitcnt vmcnt(0)" ::: "memory");
        }
    }
    __syncthreads();
}
enum { I_XP = 0, I_XS, I_SRW, I_CCKV, I_CKR, I_SLRU, I_C, I_CCTX, I_WMOD, I_BMOD, I_WIN, I_W0, I_W1, I_W2, I_A0, I_A1, I_A2, I_KK, I_KA, I_RK,
       I_LNXG, I_LNXB, I_QNORM, I_WUQ, I_KVNORM, I_WUKV, I_CONVW, I_CONVB, I_WA, I_BA, I_WX, I_BX, I_LAMBDA, I_WOUT, I_LNG, I_LNB, N_IN };
struct Args { const float* in[N_IN]; float* out; unsigned char* ws; int ph_lo, ph_hi; };
typedef const Args __attribute__((address_space(4)))* ArgsP;
constexpr int NTHREADS = 512;
constexpr int LDS_MISC = 139264;
constexpr int LDS_BYTES = 147456;

struct Tok { int n, b, t, L, lat, modrow, tok0, kidx; };
__device__ __forceinline__ Tok tok_of(int n) {
    Tok k; k.n = n;
    if (n < T_CTX) { k.lat = 0; k.b = n >> 8; k.t = n & 255; k.L = L_CTX; k.modrow = 0; k.tok0 = k.b * 256; k.kidx = n; }
    else { const int m = n - T_CTX; k.lat = 1; k.b = m >> 11; k.t = m & 2047; k.L = L_LAT; k.modrow = 1 + k.b; k.tok0 = T_CTX + k.b * 2048; k.kidx = T_CTX + k.b * LK_LAT + PAST + k.t; }
    return k;
}
__device__ __forceinline__ const float* xrow_src(ArgsP a, int layer, int n) {
    if (layer == 0) return n < T_CTX ? a->in[I_XP] + (size_t)n * D : a->in[I_XS] + (size_t)(n - T_CTX) * D;
    return a->out + (size_t)n * D;
}
__device__ __forceinline__ float dot8(v4u a, v4u b, float acc) {
    acc = fmaf(bflo(a.x), bflo(b.x), acc); acc = fmaf(bfhi(a.x), bfhi(b.x), acc);
    acc = fmaf(bflo(a.y), bflo(b.y), acc); acc = fmaf(bfhi(a.y), bfhi(b.y), acc);
    acc = fmaf(bflo(a.z), bflo(b.z), acc); acc = fmaf(bfhi(a.z), bfhi(b.z), acc);
    acc = fmaf(bflo(a.w), bflo(b.w), acc); acc = fmaf(bfhi(a.w), bfhi(b.w), acc);
    return acc;
}

__device__ __forceinline__ void tr_item(const float* src, int ld, int col0, int k0, bf16* WT, int K, int row0, float scale, LAS float* scr, int lane) {
    {
        const int kr = lane >> 3, n4 = (lane & 7) * 4;
        f32x4 v[8];
#pragma unroll
        for (int i = 0; i < 8; ++i) v[i] = src ? *(const f32x4*)(src + (size_t)(k0 + i * 8 + kr) * ld + col0 + n4) : (f32x4){0.f, 0.f, 0.f, 0.f};
#pragma unroll
        for (int i = 0; i < 8; ++i) { LAS float* d = scr + (i * 8 + kr) * 33 + n4; d[0] = v[i].x * scale; d[1] = v[i].y * scale; d[2] = v[i].z * scale; d[3] = v[i].w * scale; }
    }
    asm volatile("s_waitcnt lgkmcnt(0)" ::: "memory");
    const int c = lane & 7;
#pragma unroll
    for (int j = 0; j < 4; ++j) { const int n = (lane >> 3) + 8 * j; const LAS float* s = scr + (8 * c) * 33 + n;
        v4u o; o.x = pk2(s[0 * 33], s[1 * 33]); o.y = pk2(s[2 * 33], s[3 * 33]); o.z = pk2(s[4 * 33], s[5 * 33]); o.w = pk2(s[6 * 33], s[7 * 33]);
        *(v4u*)(WT + (size_t)(row0 + n) * K + k0 + 8 * c) = o; }
    asm volatile("s_waitcnt lgkmcnt(0)" ::: "memory");
}
__device__ __forceinline__ void rope_angle(int t, int i, float& c, float& s) {
    const int row = t >> 6, col = t & 63; const int ii = i & 7;
    const float inv = exp2f(-(float)ii * (13.287712379549449f / 8.f));
    const float ang = (float)(i < 8 ? row : col) * inv;
    c = cosf(ang); s = sinf(ang);
}
__device__ __forceinline__ void phase_p0_weights(ArgsP a, LAS unsigned char* lds) {
    const int tid = tid_(), lane = tid & 63, wave = tid >> 6, G = grid_();
    unsigned char* ws = a->ws;
    LAS float* scr = (LAS float*)(lds + wave * 8704);
    const int gw = bid_() * 8 + wave, NGW = G * 8;
    constexpr int N_WIN = 2 * 16 * 88, N_WOUT = 2 * 16 * 32, N_WUQ = 2 * 4 * 24, N_WUKV = 2 * 4 * 32, N_LORA = 2 * 2 * 2 * 8, N_LRUW = 2 * 2 * 2 * 4 * 2;
    for (int it = gw; it < N_WIN + N_WOUT + N_WUQ + N_WUKV + N_LORA + N_LRUW; it += NGW) {
        int r = it;
        if (r < N_WIN) {
            const int l = r / (16 * 88), kb = (r / 88) % 16, nb = r % 88, j0 = nb * 32;
            const float* src; int ld, col0;
            const float* win = a->in[I_WIN] + (size_t)l * 1024 * 2464;
            if (j0 < 1024) { src = win; ld = 2464; col0 = j0; }
            else if (j0 < 1536) { src = win; ld = 2464; col0 = 1440 + (j0 - 1024); }
            else if (j0 < 1792) { src = win; ld = 2464; col0 = 1952 + (j0 - 1536); }
            else if (j0 < 2048) { src = win; ld = 2464; col0 = 2208 + (j0 - 1792); }
            else if (j0 < 2304) { const int q = (j0 - 2048) >> 6; src = (q < 2 ? a->in[I_W1] : a->in[I_A1]) + (size_t)(l * 2 + (q & 1)) * 1024 * 64; ld = 64; col0 = (j0 - 2048) & 63; }
            else if (j0 < 2560) { src = win; ld = 2464; col0 = 1024 + (j0 - 2304); }
            else if (j0 < 2688) { src = win; ld = 2464; col0 = 1280 + (j0 - 2560); }
            else if (j0 < 2720) { src = win; ld = 2464; col0 = 1408 + (j0 - 2688); }
            else { src = nullptr; ld = 0; col0 = 0; }
            tr_item(src, ld, col0, kb * 64, (bf16*)(ws + WS_WIN) + (size_t)l * NIN * 1024, 1024, j0, 1.f, scr, lane);
            continue;
        }
        r -= N_WIN;
        if (r < N_WOUT) { const int l = r / (16 * 32), kb = (r / 32) % 16, nb = r % 32;
            tr_item(a->in[I_WOUT] + (size_t)l * 1024 * 1024, 1024, nb * 32, kb * 64, (bf16*)(ws + WS_WOUT) + (size_t)l * 1024 * 1024, 1024, nb * 32, 1.f, scr, lane); continue; }
        r -= N_WOUT;
        if (r < N_WUQ) { const int l = r / (4 * 24), kb = (r / 24) % 4, nb = r % 24;
            tr_item(a->in[I_WUQ] + (size_t)l * 256 * 768, 768, nb * 32, kb * 64, (bf16*)(ws + WS_WUQ) + (size_t)l * 768 * 256, 256, nb * 32, QSCALE, scr, lane); continue; }
        r -= N_WUQ;
        if (r >= N_WUKV) { r -= N_WUKV;
            if (r < N_LORA) { const int le = r >> 4, m = (r >> 3) & 1, nb = r & 7;
                tr_item((m ? a->in[I_A2] : a->in[I_W2]) + (size_t)le * 64 * 256, 256, nb * 32, 0, (bf16*)(ws + WS_LORA2) + (size_t)(le * 2 + m) * 256 * 64, 64, nb * 32, 1.f, scr, lane); }
            else { r -= N_LORA; const int le = r >> 4, m = (r >> 3) & 1, g = (r >> 1) & 3, nb = r & 1;
                tr_item((m ? a->in[I_WX] : a->in[I_WA]) + (size_t)(le * 4 + g) * 4096, 64, nb * 32, 0, (bf16*)(ws + WS_LRUW) + (size_t)((le * 2 + m) * 4 + g) * 4096, 64, nb * 32, 1.f, scr, lane); }
            continue; }
        { const int l = r / (4 * 32), kb = (r / 32) % 4, nb = r % 32;
            tr_item(kb < 2 ? a->in[I_WUKV] + (size_t)l * 128 * 1024 : nullptr, 1024, nb * 32, kb * 64, (bf16*)(ws + WS_WUKV) + (size_t)l * 1024 * 256, 256, nb * 32, 1.f, scr, lane); }
    }
}
__device__ __forceinline__ void phase_p0(ArgsP a, LAS unsigned char* lds) {
    const int tid = tid_(), G = grid_();
    unsigned char* ws = a->ws;
    { float* ROPE = (float*)(ws + WS_ROPE);
      for (int i = bid_() * NTHREADS + tid; i < 2048 * 16; i += G * NTHREADS) { float c, s; rope_angle(i >> 4, i & 15, c, s); ROPE[i * 2] = c; ROPE[i * 2 + 1] = s; } }
    float* MOD = (float*)(ws + WS_MOD);
    LAS float* SIL = (LAS float*)lds;
    for (int it = bid_(); it < 2 * 6 * 32; it += G) {
        const int l = it / 192, nb = (it / 32) % 6, kq = it % 32, col = nb * 512 + tid;
        __syncthreads();
        if (tid < 288) { const int j = tid >> 5, k = kq * 32 + (tid & 31); const float cj = (j == 0) ? a->in[I_CCTX][k] : a->in[I_C][(j - 1) * 1024 + k]; SIL[tid] = siluf_(cj); }
        float w[32];
#pragma unroll
        for (int kk = 0; kk < 32; ++kk) w[kk] = a->in[I_WMOD][((size_t)l * 1024 + kq * 32 + kk) * 3072 + col];
        __syncthreads();
        const float bias = (kq == 0) ? a->in[I_BMOD][l * 3072 + col] : 0.f;
#pragma unroll
        for (int j = 0; j < 9; ++j) { float acc = bias;
#pragma unroll
            for (int k4 = 0; k4 < 8; ++k4) { const f32x4 sv = *(const LAS f32x4*)(SIL + j * 32 + k4 * 4); acc = fmaf(sv.x, w[k4 * 4], acc); acc = fmaf(sv.y, w[k4 * 4 + 1], acc); acc = fmaf(sv.z, w[k4 * 4 + 2], acc); acc = fmaf(sv.w, w[k4 * 4 + 3], acc); }
            atomicAdd(&MOD[(l * 9 + j) * 3072 + col], acc); }
    }
}

__device__ __forceinline__ void phase_a0(ArgsP a, int layer) {
    const int tid = tid_(), lane = tid & 63, wave = tid >> 6, G = grid_();
    const float* MOD = (const float*)(a->ws + WS_MOD);
    bf16* U = (bf16*)(a->ws + WS_U);
    f32x4 nx[4];
#define A0_LOAD(nn_) do { if (layer == 0) { const float* xr_ = xrow_src(a, 0, (nn_)); \
            _Pragma("unroll") for (int j = 0; j < 4; ++j) nx[j] = *(const f32x4*)(xr_ + lane * 4 + 256 * j); } \
        else { const bf16* zr_ = (const bf16*)a->out + (size_t)(nn_) * 2048; \
            _Pragma("unroll") for (int j = 0; j < 4; ++j) { const v2u w_ = *(const v2u*)(zr_ + lane * 4 + 256 * j); nx[j] = (f32x4){bflo(w_.x), bfhi(w_.x), bflo(w_.y), bfhi(w_.y)}; } } } while (0)
    { const int n0 = bid_() * 8 + wave; if (n0 < T) A0_LOAD(n0); }
    for (int n = bid_() * 8 + wave; n < T; n += G * 8) {
        const Tok tk = tok_of(n);
        f32x4 v[4]; float s = 0.f;
#pragma unroll
        for (int j = 0; j < 4; ++j) { v[j] = nx[j]; s += (v[j].x + v[j].y) + (v[j].z + v[j].w); }
        if (n + G * 8 < T) A0_LOAD(n + G * 8);
        float mean = wave_sum(s) * (1.f / D), s2 = 0.f;
#pragma unroll
        for (int j = 0; j < 4; ++j) { v[j] = v[j] - mean; s2 += (v[j].x * v[j].x + v[j].y * v[j].y) + (v[j].z * v[j].z + v[j].w * v[j].w); }
        float rstd = rsqrt_(wave_sum(s2) * (1.f / D) + LN_EPS);
        if (layer == 1) {
            s = 0.f;
#pragma unroll
            for (int j = 0; j < 4; ++j) { const f32x4 g = *(const f32x4*)(a->in[I_LNG] + lane * 4 + 256 * j), b = *(const f32x4*)(a->in[I_LNB] + lane * 4 + 256 * j);
                v[j] = v[j] * rstd * g + b; s += (v[j].x + v[j].y) + (v[j].z + v[j].w); }
            if (lane == 0) { float* st = (float*)(a->ws + WS_STATS) + (size_t)n * 2; st[0] = mean; st[1] = rstd; }
            mean = wave_sum(s) * (1.f / D); s2 = 0.f;
#pragma unroll
            for (int j = 0; j < 4; ++j) { v[j] = v[j] - mean; s2 += (v[j].x * v[j].x + v[j].y * v[j].y) + (v[j].z * v[j].z + v[j].w * v[j].w); }
            rstd = rsqrt_(wave_sum(s2) * (1.f / D) + LN_EPS);
        }
        const float* m = MOD + (size_t)(layer * 9 + tk.modrow) * 3072;
#pragma unroll
        for (int j = 0; j < 4; ++j) { const int c = lane * 4 + 256 * j; const f32x4 sh = *(const f32x4*)(m + c), sc = *(const f32x4*)(m + 1024 + c);
            const f32x4 o = v[j] * rstd * (sc + 1.f) + sh;
            v2u p; p.x = pk2(o.x, o.y); p.y = pk2(o.z, o.w); *(v2u*)(U + (size_t)n * D + c) = p; }
    }
}
__device__ __forceinline__ void phase_final(ArgsP a) {
    const int tid = tid_(), lane = tid & 63, wave = tid >> 6, G = grid_();
    f32x4 nx[4];
#define FN_LOAD(nn_) do { const bf16* zr_ = (const bf16*)a->out + (size_t)(nn_) * 2048; \
        _Pragma("unroll") for (int j = 0; j < 4; ++j) { const v2u w_ = *(const v2u*)(zr_ + lane * 4 + 256 * j); nx[j] = (f32x4){bflo(w_.x), bfhi(w_.x), bflo(w_.y), bfhi(w_.y)}; } } while (0)
    { const int n0 = bid_() * 8 + wave; if (n0 < T) FN_LOAD(n0); }
    for (int n = bid_() * 8 + wave; n < T; n += G * 8) {
        float* xr = a->out + (size_t)n * D;
        f32x4 v[4]; float s = 0.f;
#pragma unroll
        for (int j = 0; j < 4; ++j) { v[j] = nx[j]; s += (v[j].x + v[j].y) + (v[j].z + v[j].w); }
        if (n + G * 8 < T) FN_LOAD(n + G * 8);
        const float mean = wave_sum(s) * (1.f / D); float s2 = 0.f;
#pragma unroll
        for (int j = 0; j < 4; ++j) { v[j] = v[j] - mean; s2 += (v[j].x * v[j].x + v[j].y * v[j].y) + (v[j].z * v[j].z + v[j].w * v[j].w); }
        const float rstd = rsqrt_(wave_sum(s2) * (1.f / D) + LN_EPS);
#pragma unroll
        for (int j = 0; j < 4; ++j) { const f32x4 g = *(const f32x4*)(a->in[I_LNG] + 1024 + lane * 4 + 256 * j), b = *(const f32x4*)(a->in[I_LNB] + 1024 + lane * 4 + 256 * j);
            *(f32x4*)(xr + lane * 4 + 256 * j) = v[j] * rstd * g + b; }
    }
}

__device__ __forceinline__ void phase_a1_naive(ArgsP a, int layer) {
    const bf16* U = (const bf16*)(a->ws + WS_U); const bf16* W = (const bf16*)(a->ws + WS_WIN) + (size_t)layer * NIN * 1024;
    bf16* G1 = (bf16*)(a->ws + WS_G1); bf16* G2 = (bf16*)(a->ws + WS_G2);
    const size_t total = (size_t)T * (NIN / 8), stride = (size_t)grid_() * NTHREADS;
    for (size_t idx = (size_t)bid_() * NTHREADS + tid_(); idx < total; idx += stride) {
        const int row = (int)(idx / (NIN / 8)), c0 = (int)(idx % (NIN / 8)) * 8;
        float acc[8];
#pragma unroll
        for (int c = 0; c < 8; ++c) acc[c] = 0.f;
        const v4u* ap = (const v4u*)(U + (size_t)row * 1024); const v4u* bp = (const v4u*)(W + (size_t)c0 * 1024);
        for (int kc = 0; kc < 128; ++kc) { const v4u av = ap[kc];
#pragma unroll
            for (int c = 0; c < 8; ++c) acc[c] = dot8(av, bp[c * 128 + kc], acc[c]); }
        v4u o; o.x = pk2(acc[0], acc[1]); o.y = pk2(acc[2], acc[3]); o.z = pk2(acc[4], acc[5]); o.w = pk2(acc[6], acc[7]);
        if (c0 < G1W) *(v4u*)(G1 + (size_t)row * G1W + c0) = o; else *(v4u*)(G2 + (size_t)row * G2W + (c0 - G1W)) = o;
    }
}
__device__ __forceinline__ void phase_c2_naive(ArgsP a, int layer) {
    const bf16* Y = (const bf16*)(a->ws + WS_YMIX); const bf16* W = (const bf16*)(a->ws + WS_WOUT) + (size_t)layer * 1024 * 1024;
    const float* MOD = (const float*)(a->ws + WS_MOD);
    const size_t total = (size_t)T * 256, stride = (size_t)grid_() * NTHREADS;
    for (size_t idx = (size_t)bid_() * NTHREADS + tid_(); idx < total; idx += stride) {
        const int row = (int)(idx >> 8), c0 = (int)(idx & 255) * 4;
        float acc[4] = {0.f, 0.f, 0.f, 0.f};
        const v4u* ap = (const v4u*)(Y + (size_t)row * 1024); const v4u* bp = (const v4u*)(W + (size_t)c0 * 1024);
        for (int kc = 0; kc < 128; ++kc) { const v4u av = ap[kc];
#pragma unroll
            for (int c = 0; c < 4; ++c) acc[c] = dot8(av, bp[c * 128 + kc], acc[c]); }
        const Tok tk = tok_of(row);
        const f32x4 gate = *(const f32x4*)(MOD + (size_t)(layer * 9 + tk.modrow) * 3072 + 2048 + c0);
        const f32x4 x = *(const f32x4*)(xrow_src(a, layer, row) + c0);
        f32x4 z; z.x = ALPHA * x.x + gate.x * acc[0]; z.y = ALPHA * x.y + gate.y * acc[1]; z.z = ALPHA * x.z + gate.z * acc[2]; z.w = ALPHA * x.w + gate.w * acc[3];
        *(f32x4*)(a->out + (size_t)row * D + c0) = z;
    }
}

__device__ __forceinline__ void phase_a2_naive(ArgsP a, LAS unsigned char* lds, int layer) {
    const int tid = tid_(), lane = tid & 63, wave = tid >> 6, G = grid_();
    LAS float* AQ = (LAS float*)lds;
    LAS float* AKV = (LAS float*)(lds + 16384);
    LAS float* OT = (LAS float*)(lds + 24576);
    const bf16* G2 = (const bf16*)(a->ws + WS_G2);
    bf16* Q = (bf16*)(a->ws + WS_Q); bf16* KN = (bf16*)(a->ws + WS_KN); bf16* KR = (bf16*)(a->ws + WS_KR); bf16* VT = (bf16*)(a->ws + WS_VT);
    const bf16* WUQ = (const bf16*)(a->ws + WS_WUQ) + (size_t)layer * 768 * 256;
    const bf16* WUKV = (const bf16*)(a->ws + WS_WUKV) + (size_t)layer * 1024 * 128;
    constexpr int NT_TOK = T / 16, NT_CACHE = 8 * 256 / 16;
    for (int tile = bid_(); tile < NT_TOK + NT_CACHE; tile += G) {
        const bool is_tok = tile < NT_TOK;
        for (int rr = 0; rr < 2; ++rr) {
            const int r = wave * 2 + rr;
            if (is_tok) {
                const int n = tile * 16 + r; const Tok tk = tok_of(n);
                const v2u cqv = *(const v2u*)(G2 + (size_t)n * G2W + lane * 4);
                const float c0 = bflo(cqv.x), c1 = bfhi(cqv.x), c2 = bflo(cqv.y), c3 = bfhi(cqv.y);
                const float rq = rsqrt_(wave_sum(c0 * c0 + c1 * c1 + c2 * c2 + c3 * c3) * (1.f / 256.f) + 1e-6f);
                const f32x4 qn = *(const f32x4*)(a->in[I_QNORM] + layer * 256 + lane * 4);
                AQ[r * 256 + lane * 4 + 0] = bf2f(f2bf(c0 * rq * qn.x)); AQ[r * 256 + lane * 4 + 1] = bf2f(f2bf(c1 * rq * qn.y));
                AQ[r * 256 + lane * 4 + 2] = bf2f(f2bf(c2 * rq * qn.z)); AQ[r * 256 + lane * 4 + 3] = bf2f(f2bf(c3 * rq * qn.w));
                float k0 = 0.f, k1 = 0.f, k2 = 0.f, k3 = 0.f;
                if (lane < 32) { const v2u kv = *(const v2u*)(G2 + (size_t)n * G2W + 256 + lane * 4); k0 = bflo(kv.x); k1 = bfhi(kv.x); k2 = bflo(kv.y); k3 = bfhi(kv.y); }
                const float rk = rsqrt_(wave_sum(k0 * k0 + k1 * k1 + k2 * k2 + k3 * k3) * (1.f / 128.f) + 1e-6f);
                if (lane < 32) {
                    const f32x4 kn = *(const f32x4*)(a->in[I_KVNORM] + layer * 128 + lane * 4);
                    f32x4 o; o.x = k0 * rk * kn.x; o.y = k1 * rk * kn.y; o.z = k2 * rk * kn.z; o.w = k3 * rk * kn.w;
                    if (!tk.lat) *(f32x4*)(a->out + O_CKV + ((size_t)(tk.b * 2 + layer) * 256 + tk.t) * 128 + lane * 4) = o;
                    AKV[r * 128 + lane * 4 + 0] = bf2f(f2bf(o.x)); AKV[r * 128 + lane * 4 + 1] = bf2f(f2bf(o.y));
                    AKV[r * 128 + lane * 4 + 2] = bf2f(f2bf(o.z)); AKV[r * 128 + lane * 4 + 3] = bf2f(f2bf(o.w));
                }
                float krv = (lane < 32) ? bf2f(G2[(size_t)n * G2W + 384 + lane]) : 0.f;
                const float other = __shfl_xor(krv, 1);
                if (lane < 32) {
                    if (!tk.lat) a->out[O_KR + ((size_t)(tk.b * 2 + layer) * 256 + tk.t) * 32 + lane] = krv;
                    else { float c, s; rope_angle(tk.t, lane >> 1, c, s); krv = (lane & 1) ? (other * s + krv * c) : (krv * c - other * s); }
                    KR[(size_t)tk.kidx * 32 + lane] = (bf16)f2bf(krv);
                }
            } else {
                const int cr = (tile - NT_TOK) * 16 + r, b = cr >> 8, j = cr & 255;
                const size_t src = ((size_t)(b * 2 + layer) * 256 + j);
                if (lane < 32) { const f32x4 v = *(const f32x4*)(a->in[I_CCKV] + src * 128 + lane * 4);
                    AKV[r * 128 + lane * 4 + 0] = bf2f(f2bf(v.x)); AKV[r * 128 + lane * 4 + 1] = bf2f(f2bf(v.y)); AKV[r * 128 + lane * 4 + 2] = bf2f(f2bf(v.z)); AKV[r * 128 + lane * 4 + 3] = bf2f(f2bf(v.w));
                    KR[(size_t)(T_CTX + b * LK_LAT + j) * 32 + lane] = (bf16)f2bf(a->in[I_CKR][src * 32 + lane]); }
            }
        }
        __syncthreads();
        if (is_tok) {
            for (int col = tid; col < 768; col += NTHREADS) {
                float acc[16];
#pragma unroll
                for (int r = 0; r < 16; ++r) acc[r] = 0.f;
                const v4u* wp = (const v4u*)(WUQ + (size_t)col * 256);
                for (int kc = 0; kc < 32; ++kc) { const v4u w = wp[kc];
                    const float w0 = bflo(w.x), w1 = bfhi(w.x), w2 = bflo(w.y), w3 = bfhi(w.y), w4 = bflo(w.z), w5 = bfhi(w.z), w6 = bflo(w.w), w7 = bfhi(w.w);
#pragma unroll
                    for (int r = 0; r < 16; ++r) { const f32x4 x0 = *(const LAS f32x4*)(AQ + r * 256 + kc * 8), x1 = *(const LAS f32x4*)(AQ + r * 256 + kc * 8 + 4);
                        acc[r] += x0.x * w0 + x0.y * w1 + x0.z * w2 + x0.w * w3 + x1.x * w4 + x1.y * w5 + x1.z * w6 + x1.w * w7; } }
#pragma unroll
                for (int r = 0; r < 16; ++r) OT[r * 1024 + col] = acc[r];
            }
            __syncthreads();
            for (int idx = tid; idx < 16 * 384; idx += NTHREADS) {
                const int r = idx / 384, col = (idx % 384) * 2, d = col % 96; const int n = tile * 16 + r; const Tok tk = tok_of(n);
                float v0 = OT[r * 1024 + col], v1 = OT[r * 1024 + col + 1];
                if (tk.lat && d >= 64) { float c, s; rope_angle(tk.t, (d - 64) >> 1, c, s); const float y0 = v0 * c - v1 * s, y1 = v0 * s + v1 * c; v0 = y0; v1 = y1; }
                *(unsigned*)(Q + (size_t)n * 768 + col) = pk2(v0, v1);
            }
            __syncthreads();
        }
        for (int col = tid; col < 1024; col += NTHREADS) {
            float acc[16];
#pragma unroll
            for (int r = 0; r < 16; ++r) acc[r] = 0.f;
            const v4u* wp = (const v4u*)(WUKV + (size_t)col * 128);
            for (int kc = 0; kc < 16; ++kc) { const v4u w = wp[kc];
                const float w0 = bflo(w.x), w1 = bfhi(w.x), w2 = bflo(w.y), w3 = bfhi(w.y), w4 = bflo(w.z), w5 = bfhi(w.z), w6 = bflo(w.w), w7 = bfhi(w.w);
#pragma unroll
                for (int r = 0; r < 16; ++r) { const f32x4 x0 = *(const LAS f32x4*)(AKV + r * 128 + kc * 8), x1 = *(const LAS f32x4*)(AKV + r * 128 + kc * 8 + 4);
                    acc[r] += x0.x * w0 + x0.y * w1 + x0.z * w2 + x0.w * w3 + x1.x * w4 + x1.y * w5 + x1.z * w6 + x1.w * w7; } }
#pragma unroll
            for (int r = 0; r < 16; ++r) OT[r * 1024 + col] = acc[r];
        }
        __syncthreads();
        for (int idx = tid; idx < 16 * 1024; idx += NTHREADS) {
            const int r = idx >> 10, col = idx & 1023, h = col >> 7, f = col & 127;
            int kidx, lat, b, kpos;
            if (is_tok) { const Tok tk = tok_of(tile * 16 + r); kidx = tk.kidx; lat = tk.lat; b = tk.b; kpos = tk.lat ? PAST + tk.t : tk.t; }
            else { const int cr = (tile - NT_TOK) * 16 + r; b = cr >> 8; kpos = cr & 255; lat = 1; kidx = T_CTX + b * LK_LAT + kpos; }
            const bf16 v = (bf16)f2bf(OT[r * 1024 + col]);
            if (f < 64) KN[(size_t)kidx * 512 + h * 64 + f] = v;
            else { const int dv = f - 64; const size_t base = lat ? (size_t)VT_LAT + ((size_t)(b * 8 + h) * 64 + dv) * LK_LAT : ((size_t)(b * 8 + h) * 64 + dv) * 256; VT[base + kpos] = v; }
        }
        __syncthreads();
    }
}

__device__ __forceinline__ void phase_att_naive(ArgsP a) {
    const bf16* KN = (const bf16*)(a->ws + WS_KN); const bf16* KR = (const bf16*)(a->ws + WS_KR); const bf16* VT = (const bf16*)(a->ws + WS_VT);
    bf16* Q = (bf16*)(a->ws + WS_Q); const bf16* G1 = (const bf16*)(a->ws + WS_G1);
    const int total = T * 8, stride = grid_() * NTHREADS;
    for (int idx = bid_() * NTHREADS + tid_(); idx < total; idx += stride) {
        int n, h, Lk, kidx0; size_t vbase;
        if (idx < T_CTX * 8) { const int b = idx >> 11, hh = (idx >> 8) & 7, t = idx & 255; n = b * 256 + t; h = hh; Lk = 256; kidx0 = b * 256; vbase = ((size_t)(b * 8 + h) * 64) * 256; }
        else { const int m = idx - T_CTX * 8, b = m >> 14, hh = (m >> 11) & 7, t = m & 2047; n = T_CTX + b * 2048 + t; h = hh; Lk = LK_LAT; kidx0 = T_CTX + b * LK_LAT; vbase = (size_t)VT_LAT + ((size_t)(b * 8 + h) * 64) * LK_LAT; }
        v4u qp[12];
#pragma unroll
        for (int c = 0; c < 12; ++c) qp[c] = *(const v4u*)(Q + (size_t)n * 768 + h * 96 + c * 8);
        float acc[64];
#pragma unroll
        for (int d = 0; d < 64; ++d) acc[d] = 0.f;
        float m = -1e30f, l = 0.f;
        for (int j0 = 0; j0 < Lk; j0 += 8) {
            float s[8];
#pragma unroll
            for (int j = 0; j < 8; ++j) {
                const v4u* kp = (const v4u*)(KN + (size_t)(kidx0 + j0 + j) * 512 + h * 64); const v4u* rp = (const v4u*)(KR + (size_t)(kidx0 + j0 + j) * 32);
                float sv = 0.f;
#pragma unroll
                for (int c = 0; c < 8; ++c) sv = dot8(qp[c], kp[c], sv);
#pragma unroll
                for (int c = 0; c < 4; ++c) sv = dot8(qp[8 + c], rp[c], sv);
                s[j] = sv;
                __builtin_amdgcn_sched_barrier(0);
            }
            float mx = m;
#pragma unroll
            for (int j = 0; j < 8; ++j) mx = fmaxf(mx, s[j]);
            const float alpha = exp2f(m - mx); m = mx; float ps = 0.f;
#pragma unroll
            for (int j = 0; j < 8; ++j) { s[j] = exp2f(s[j] - mx); ps += s[j]; }
            l = l * alpha + ps;
            unsigned lk = (unsigned)Lk; asm volatile("" : "+v"(lk));
            const bf16* vp = VT + vbase + j0;
#pragma unroll
            for (int dg = 0; dg < 8; ++dg) {
#pragma unroll
                for (int dd = 0; dd < 8; ++dd) { const int d = dg * 8 + dd; const v4u w = *(const v4u*)(vp + (unsigned)d * lk);
                    acc[d] = acc[d] * alpha + s[0] * bflo(w.x) + s[1] * bfhi(w.x) + s[2] * bflo(w.y) + s[3] * bfhi(w.y) + s[4] * bflo(w.z) + s[5] * bfhi(w.z) + s[6] * bflo(w.w) + s[7] * bfhi(w.w); }
                __builtin_amdgcn_sched_barrier(0);
            }
        }
        const float inv = rcp_(l);
#pragma unroll
        for (int c = 0; c < 8; ++c) { const v4u g = *(const v4u*)(G1 + (size_t)n * G1W + C_GM + h * 64 + c * 8);
            v4u o;
            o.x = pk2(acc[c * 8 + 0] * inv * siluf_(bflo(g.x)), acc[c * 8 + 1] * inv * siluf_(bfhi(g.x)));
            o.y = pk2(acc[c * 8 + 2] * inv * siluf_(bflo(g.y)), acc[c * 8 + 3] * inv * siluf_(bfhi(g.y)));
            o.z = pk2(acc[c * 8 + 4] * inv * siluf_(bflo(g.z)), acc[c * 8 + 5] * inv * siluf_(bfhi(g.z)));
            o.w = pk2(acc[c * 8 + 6] * inv * siluf_(bflo(g.w)), acc[c * 8 + 7] * inv * siluf_(bfhi(g.w)));
            *(v4u*)(Q + (size_t)n * 768 + h * 96 + c * 8) = o; }
    }
}
namespace pg8 {
#define PG8_LAS __attribute__((address_space(3)))
typedef unsigned short bf16_t;
typedef short bf16x8 __attribute__((ext_vector_type(8)));
typedef float f32x4 __attribute__((ext_vector_type(4)));
typedef unsigned u32x4 __attribute__((ext_vector_type(4)));
constexpr int BM = 256, BK = 64, HALF = 128, HTB = HALF * BK * 2  , STAGE_BYTES = 8 * HTB, NXCD = 8, WGM = 8;

__host__ __device__ __forceinline__ int lds_byte(int r, int c) { const int st = (r >> 4) * 2 + (c >> 5), rr = r & 15, cc = c & 31, ob = rr * 64 + cc * 2; return st * 1024 + (ob ^ (((ob >> 9) & 1) << 5)); }
__host__ __device__ __forceinline__ void stage_rc(int b, int& R, int& C) { const int st = b / 1024, sb = b % 1024, swz = sb ^ (((sb >> 9) & 1) << 5); R = (st >> 1) * 16 + swz / 64; C = (st & 1) * 32 + (swz % 64) / 2; }
__host__ __device__ __forceinline__ int perm32(int rho) { const int n = rho >> 4, i = rho & 15; return 8 * (i >> 2) + 4 * n + (i & 3); }

struct Unit { int pm, pn, gid; };
struct Gemm { const bf16_t* A; const bf16_t* Bt; int M, N, K, lda, ldb; };

struct StaticOrder {
    int nM, nN, nwg, G, c;
    __host__ __device__ void init(int M, int N, int G_, int c_) { nM = M / BM; nN = N / BM; nwg = nM * nN; G = G_; c = c_; }
    __host__ __device__ bool next(int i, Unit& u) const {
        const long L = (long)i * G + c; if (L >= nwg) return false;
        int wgid = (int)L; { const int q = nwg / NXCD, r = nwg % NXCD, xcd = wgid % NXCD, off = wgid / NXCD; wgid = (xcd < r ? xcd * (q + 1) : r * (q + 1) + (xcd - r) * q) + off; }
        const int nig = WGM * nN, gid = wgid / nig, fm = gid * WGM, gsz = (nM - fm) < WGM ? (nM - fm) : WGM;
        u.pm = fm + ((wgid % nig) % gsz); u.pn = (wgid % nig) / gsz; u.gid = 0; return true;
    }
    __device__ __forceinline__ const char* abase(const Gemm& g, const Unit& u) const { return (const char*)g.A + (size_t)u.pm * BM * g.lda * 2; }
    __device__ __forceinline__ const char* bbase(const Gemm& g, const Unit& u) const { return (const char*)g.Bt + (size_t)u.pn * BM * g.ldb * 2; }
    __device__ __forceinline__ void a_ready(const Unit&) const {}
    __device__ __forceinline__ void done(const Unit&) const {}
};
__device__ __forceinline__ unsigned cvt_pk_bf16(float lo, float hi) { unsigned r; asm volatile("v_cvt_pk_bf16_f32 %0, %1, %2" : "=v"(r) : "v"(lo), "v"(hi)); return r; }

template <class Epi, class Sched, bool STAMP = false>
__device__ __forceinline__ void gemm_phase(PG8_LAS unsigned char* lds, const Gemm g, const Sched& S, const Epi& E, unsigned long long* stamps) {
    const int tid = tid_(), wid = __builtin_amdgcn_readfirstlane(tid >> 6), lane = tid & 63, wr = wid >> 2, wc = wid & 3, fr = lane & 15, fq = lane >> 4;
    const int K = g.K, nt = K / BK;
    int ts_lo = 0, ts_hi = 0, nts = 0; const unsigned long long rt_entry = STAMP ? (unsigned long long)wall_clock64() : 0ull;
#define PG8_STAMP() do { if (STAMP && wid == 0 && nts < 64) { const unsigned long long _c = (unsigned long long)clock64(); \
        ts_lo = (lane == nts) ? (int)(unsigned)_c : ts_lo; ts_hi = (lane == nts) ? (int)(unsigned)(_c >> 32) : ts_hi; ++nts; } } while (0)
    PG8_STAMP();
    unsigned voffA[2], voffB[2];
#pragma unroll
    for (int i = 0; i < 2; ++i) { int R, C; stage_rc(tid * 16 + i * 8192, R, C); const int Rb = Epi::PERM ? ((R & ~31) + perm32(R & 31)) : R;
        voffA[i] = (unsigned)(R * g.lda + C) * 2u; voffB[i] = (unsigned)(Rb * g.ldb + C) * 2u; }
    const size_t kstep = (size_t)(BK * 2);
    const size_t hstepA = (size_t)HALF * g.lda * 2, hstepB = (size_t)HALF * g.ldb * 2;
    const unsigned ldsw = (unsigned)wid * 1024u;
    const int aoff = lds_byte(wr * 64 + fr, fq * 8), boff = lds_byte(wc * 32 + fr, fq * 8);
#define PG8_SA(b, h) (((b) * 2 + (h)) * HTB)
#define PG8_SB(b, h) ((4 + (b) * 2 + (h)) * HTB)
#define PG8_STAGE(bufoff, gbase, voff) do { _Pragma("unroll") for (int _i = 0; _i < 2; ++_i) \
        __builtin_amdgcn_global_load_lds((const unsigned*)((const char*)(gbase) + (voff)[_i]), (PG8_LAS unsigned*)(lds + (bufoff) + ldsw + _i * 8192), 16, 0, 0); } while (0)
#define PG8_LDA(dst, b, h) do { _Pragma("unroll") for (int m = 0; m < 4; ++m) _Pragma("unroll") for (int k = 0; k < 2; ++k) dst[m][k] = *(const PG8_LAS bf16x8*)(lds + PG8_SA(b, h) + aoff + m * 2048 + k * 1024); } while (0)
#define PG8_LDB(dst, b, h) do { _Pragma("unroll") for (int n = 0; n < 2; ++n) _Pragma("unroll") for (int k = 0; k < 2; ++k) dst[n][k] = *(const PG8_LAS bf16x8*)(lds + PG8_SB(b, h) + boff + n * 2048 + k * 1024); } while (0)
#define PG8_MMA(ai, bj, At, Bt) do { __builtin_amdgcn_s_setprio(1); _Pragma("unroll") for (int m = 0; m < 4; ++m) _Pragma("unroll") for (int n = 0; n < 2; ++n) _Pragma("unroll") for (int k = 0; k < 2; ++k) \
        acc[ai][bj][m][n] = __builtin_amdgcn_mfma_f32_16x16x32_bf16(Bt[n][k], At[m][k], acc[ai][bj][m][n], 0, 0, 0); __builtin_amdgcn_s_setprio(0); } while (0)
#define PG8_WAIT_V(n) asm volatile("s_waitcnt vmcnt(" #n ")" ::: "memory")
#define PG8_WAIT_L(n) asm volatile("s_waitcnt lgkmcnt(" #n ")" ::: "memory")
#define PG8_BAR __builtin_amdgcn_s_barrier()
#define PG8_SCHED __builtin_amdgcn_sched_barrier(0)
    Unit cur, nxt; int ui = 0;
    if (!S.next(0, cur)) return;
    f32x4 acc[2][2][4][2];
#pragma unroll
    for (int a = 0; a < 2; ++a)
#pragma unroll
        for (int b = 0; b < 2; ++b)
#pragma unroll
            for (int m = 0; m < 4; ++m)
#pragma unroll
                for (int n = 0; n < 2; ++n) acc[a][b][m][n] = (f32x4){0.f, 0.f, 0.f, 0.f};
    bf16x8 At[4][2], B0[2][2], B1[2][2];
    const char* cA = S.abase(g, cur); const char* cB = S.bbase(g, cur);
    S.a_ready(cur);
    PG8_STAGE(PG8_SB(0, 0), cB, voffB); PG8_STAGE(PG8_SA(0, 0), cA, voffA); PG8_STAGE(PG8_SB(0, 1), cB + hstepB, voffB); PG8_STAGE(PG8_SA(0, 1), cA + hstepA, voffA);
    if (wr == 1) PG8_BAR;
    PG8_WAIT_V(4); PG8_BAR;
    PG8_STAGE(PG8_SB(1, 0), cB + kstep, voffB); PG8_STAGE(PG8_SA(1, 0), cA + kstep, voffA); PG8_STAGE(PG8_SB(1, 1), cB + hstepB + kstep, voffB);
    PG8_WAIT_V(6); PG8_BAR;
    PG8_STAMP();
    for (;;) {
        const bool has_next = S.next(ui + 1, nxt);
        const char* nA = has_next ? S.abase(g, nxt) : cA; const char* nB = has_next ? S.bbase(g, nxt) : cB;
        for (int t = 0; t < nt; t += 2) {
            const bool last = (t == nt - 2);
            const char* a1 = cA + (size_t)(t + 1) * kstep;
            const char* a2 = last ? nA : cA + (size_t)(t + 2) * kstep; const char* b2 = last ? nB : cB + (size_t)(t + 2) * kstep;
            const char* a3 = a2 + kstep; const char* b3 = b2 + kstep;
            if (last && has_next) S.a_ready(nxt);
            PG8_LDB(B0, 0, 0); PG8_SCHED; PG8_LDA(At, 0, 0); PG8_STAGE(PG8_SA(1, 1), a1 + hstepA, voffA);
            PG8_WAIT_L(8); PG8_BAR; PG8_WAIT_L(0); PG8_MMA(0, 0, At, B0); PG8_BAR; PG8_SCHED;
            PG8_LDB(B1, 0, 1); PG8_STAGE(PG8_SB(0, 0), b2, voffB);
            PG8_BAR; PG8_WAIT_L(0); PG8_MMA(0, 1, At, B1); PG8_BAR;
            PG8_LDA(At, 0, 1); PG8_STAGE(PG8_SA(0, 0), a2, voffA);
            PG8_BAR; PG8_WAIT_L(0); PG8_MMA(1, 0, At, B0); PG8_BAR; PG8_SCHED;
            PG8_STAGE(PG8_SB(0, 1), b2 + hstepB, voffB);
            PG8_WAIT_V(6); PG8_BAR; PG8_MMA(1, 1, At, B1); PG8_BAR;
            PG8_LDB(B0, 1, 0); PG8_SCHED; PG8_LDA(At, 1, 0); PG8_STAGE(PG8_SA(0, 1), a2 + hstepA, voffA);
            PG8_WAIT_L(8); PG8_BAR; PG8_WAIT_L(0); PG8_MMA(0, 0, At, B0); PG8_BAR; PG8_SCHED;
            PG8_LDB(B1, 1, 1); PG8_STAGE(PG8_SB(1, 0), b3, voffB);
            PG8_BAR; PG8_WAIT_L(0); PG8_MMA(0, 1, At, B1); PG8_BAR;
            PG8_LDA(At, 1, 1); PG8_STAGE(PG8_SA(1, 0), a3, voffA);
            PG8_BAR; PG8_WAIT_L(0); PG8_MMA(1, 0, At, B0); PG8_BAR; PG8_SCHED;
            PG8_STAGE(PG8_SB(1, 1), b3 + hstepB, voffB);
            PG8_WAIT_V(6); PG8_BAR; PG8_MMA(1, 1, At, B1); PG8_BAR;
        }
        PG8_STAMP();
        if constexpr (!Epi::AFTER_DRAIN) { E(acc, cur, wr, wc, fr, fq); S.done(cur); }
        PG8_STAMP();
        if (!has_next) break;
#pragma unroll
        for (int a = 0; a < 2; ++a)
#pragma unroll
            for (int b = 0; b < 2; ++b)
#pragma unroll
                for (int m = 0; m < 4; ++m)
#pragma unroll
                    for (int n = 0; n < 2; ++n) acc[a][b][m][n] = (f32x4){0.f, 0.f, 0.f, 0.f};
        cur = nxt; cA = nA; cB = nB; ++ui;
    }
    PG8_WAIT_V(0);
    if (wr == 0) PG8_BAR;
    PG8_BAR;
    if constexpr (Epi::AFTER_DRAIN) { E.fused(acc, cur, wr, wc, fr, fq, lds, wid, lane); S.done(cur); }
    PG8_STAMP();
    if (STAMP && wid == 0) { stamps[lane] = lane < nts ? (((unsigned long long)(unsigned)ts_hi << 32) | (unsigned)ts_lo) : 0ull;
        if (lane == 62) stamps[62] = rt_entry; if (lane == 63) stamps[63] = (unsigned long long)wall_clock64(); }
#undef PG8_STAMP
#undef PG8_SA
#undef PG8_SB
#undef PG8_STAGE
#undef PG8_LDA
#undef PG8_LDB
#undef PG8_MMA
#undef PG8_WAIT_V
#undef PG8_WAIT_L
#undef PG8_BAR
#undef PG8_SCHED
}
}
namespace pg8 {
struct EpiIn {
    static constexpr bool PERM = true, AFTER_DRAIN = false;
    bf16_t* G1; bf16_t* G2;
    __device__ __forceinline__ void operator()(const f32x4 (&acc)[2][2][4][2], const Unit& u, int wr, int wc, int fr, int fq) const {
        const int row0 = u.pm * BM + wr * 64 + fr;
        bf16_t* base; int ldc, colt;
        if (u.pn < 9) { base = G1; ldc = 2304; colt = u.pn * 256; } else { base = G2; ldc = 512; colt = (u.pn - 9) * 256; }
        const int col0 = colt + wc * 32 + 8 * fq;
#pragma unroll
        for (int ai = 0; ai < 2; ++ai)
#pragma unroll
            for (int m = 0; m < 4; ++m) { bf16_t* rowp = base + (size_t)(row0 + ai * HALF + m * 16) * ldc + col0;
#pragma unroll
                for (int bj = 0; bj < 2; ++bj) { const f32x4 v0 = acc[ai][bj][m][0], v1 = acc[ai][bj][m][1];
                    u32x4 w; w.x = cvt_pk_bf16(v0[0], v0[1]); w.y = cvt_pk_bf16(v0[2], v0[3]); w.z = cvt_pk_bf16(v1[0], v1[1]); w.w = cvt_pk_bf16(v1[2], v1[3]);
                    *(u32x4*)(rowp + bj * HALF) = w; } }
    }
};
struct EpiOut {
    static constexpr bool PERM = true, AFTER_DRAIN = false;
    const float* xp; const float* xs; float* out; const float* mod; int layer;
    const float* stats; const float* lng; const float* lnb;
    __device__ __forceinline__ void operator()(const f32x4 (&acc)[2][2][4][2], const Unit& u, int wr, int wc, int fr, int fq) const {
        const int row0 = u.pm * BM + wr * 64 + fr, col0 = u.pn * BM + wc * 32 + 8 * fq;
        const int rt = u.pm * BM; const int modrow = rt < 8192 ? 0 : 1 + ((rt - 8192) >> 11);
        const float* gp = mod + (size_t)modrow * 3072 + 2048 + col0;
        f32x4 gv[2][2];
#pragma unroll
        for (int bj = 0; bj < 2; ++bj)
#pragma unroll
            for (int n = 0; n < 2; ++n) gv[bj][n] = *(const f32x4*)(gp + bj * HALF + n * 4);
        f32x4 lg[2][2], lb[2][2];
        if (layer) {
#pragma unroll
            for (int bj = 0; bj < 2; ++bj)
#pragma unroll
                for (int n = 0; n < 2; ++n) { lg[bj][n] = *(const f32x4*)(lng + col0 + bj * HALF + n * 4); lb[bj][n] = *(const f32x4*)(lnb + col0 + bj * HALF + n * 4); }
        }
        f32x4 xn[2][2]; float mean_n = 0.f, rstd_n = 1.f;
#define EO_LOAD(am_) do { const int row_ = row0 + ((am_) >> 2) * HALF + ((am_) & 3) * 16; \
            if (layer == 0) { const float* xr_ = (row_ < 8192 ? xp + (size_t)row_ * 1024 : xs + (size_t)(row_ - 8192) * 1024) + col0; \
                xn[0][0] = *(const f32x4*)(xr_); xn[0][1] = *(const f32x4*)(xr_ + 4); xn[1][0] = *(const f32x4*)(xr_ + HALF); xn[1][1] = *(const f32x4*)(xr_ + HALF + 4); } \
            else { const bf16_t* zr_ = (const bf16_t*)out + (size_t)row_ * 2048 + col0; const u32x4 z0_ = *(const u32x4*)zr_, z1_ = *(const u32x4*)(zr_ + HALF); \
                xn[0][0] = (f32x4){__uint_as_float(z0_.x << 16), __uint_as_float(z0_.x & 0xffff0000u), __uint_as_float(z0_.y << 16), __uint_as_float(z0_.y & 0xffff0000u)}; \
                xn[0][1] = (f32x4){__uint_as_float(z0_.z << 16), __uint_as_float(z0_.z & 0xffff0000u), __uint_as_float(z0_.w << 16), __uint_as_float(z0_.w & 0xffff0000u)}; \
                xn[1][0] = (f32x4){__uint_as_float(z1_.x << 16), __uint_as_float(z1_.x & 0xffff0000u), __uint_as_float(z1_.y << 16), __uint_as_float(z1_.y & 0xffff0000u)}; \
                xn[1][1] = (f32x4){__uint_as_float(z1_.z << 16), __uint_as_float(z1_.z & 0xffff0000u), __uint_as_float(z1_.w << 16), __uint_as_float(z1_.w & 0xffff0000u)}; \
                mean_n = stats[(size_t)row_ * 2]; rstd_n = stats[(size_t)row_ * 2 + 1]; } } while (0)
        EO_LOAD(0);
#pragma unroll
        for (int am = 0; am < 8; ++am) { const int ai = am >> 2, m = am & 3, row = row0 + ai * HALF + m * 16;
            const f32x4 xc[2][2] = {{xn[0][0], xn[0][1]}, {xn[1][0], xn[1][1]}}; const float mean = mean_n, rstd = rstd_n;
            if (am + 1 < 8) EO_LOAD(am + 1);
            bf16_t* orow = (bf16_t*)out + (size_t)row * 2048 + col0;
#pragma unroll
            for (int bj = 0; bj < 2; ++bj) { f32x4 z[2];
#pragma unroll
                for (int n = 0; n < 2; ++n) { f32x4 x = xc[bj][n];
                    if (layer) x = (x - mean) * rstd * lg[bj][n] + lb[bj][n];
                    z[n] = x * 1.4142135623730951f + gv[bj][n] * acc[ai][bj][m][n]; }
                u32x4 w; w.x = cvt_pk_bf16(z[0][0], z[0][1]); w.y = cvt_pk_bf16(z[0][2], z[0][3]); w.z = cvt_pk_bf16(z[1][0], z[1][1]); w.w = cvt_pk_bf16(z[1][2], z[1][3]);
                *(u32x4*)(orow + bj * HALF) = w; } }
#undef EO_LOAD
    }
};
}

__device__ __forceinline__ void phase_a1_pg8(ArgsP a, LAS unsigned char* lds, int layer) {
    pg8::Gemm g{(const bf16*)(a->ws + WS_U), (const bf16*)(a->ws + WS_WIN) + (size_t)layer * NIN * 1024, T, NIN, 1024, 1024, 1024};
    pg8::StaticOrder S; S.init(T, NIN, grid_(), bid_());
    pg8::EpiIn E{(bf16*)(a->ws + WS_G1), (bf16*)(a->ws + WS_G2)};
    pg8::gemm_phase<pg8::EpiIn, pg8::StaticOrder, false>(lds, g, S, E, nullptr);
}
__device__ __forceinline__ void phase_c2_pg8(ArgsP a, LAS unsigned char* lds, int layer) {
    pg8::Gemm g{(const bf16*)(a->ws + WS_YMIX), (const bf16*)(a->ws + WS_WOUT) + (size_t)layer * 1024 * 1024, T, 1024, 1024, 1024, 1024};
    pg8::StaticOrder S; S.init(T, 1024, grid_(), bid_());
    pg8::EpiOut E{a->in[I_XP], a->in[I_XS], a->out, (const float*)(a->ws + WS_MOD) + (size_t)layer * 9 * 3072, layer, (const float*)(a->ws + WS_STATS), a->in[I_LNG], a->in[I_LNB]};
    pg8::gemm_phase<pg8::EpiOut, pg8::StaticOrder, false>(lds, g, S, E, nullptr);
}

__device__ __forceinline__ void phase_a2a(ArgsP a, int layer) {
    const int tid = tid_(), lane = tid & 63, wave = tid >> 6, G = grid_();
    bf16* G2 = (bf16*)(a->ws + WS_G2); bf16* KR = (bf16*)(a->ws + WS_KR); bf16* CK = (bf16*)(a->ws + WS_HF);
    const float* ROPE = (const float*)(a->ws + WS_ROPE);
    f32x4 nw0 = {0.f, 0.f, 0.f, 0.f}, nw1 = {0.f, 0.f, 0.f, 0.f};
    if (lane < 32) { nw0 = *(const f32x4*)(a->in[I_QNORM] + layer * 256 + lane * 8); nw1 = *(const f32x4*)(a->in[I_QNORM] + layer * 256 + lane * 8 + 4); }
    else if (lane < 48) { nw0 = *(const f32x4*)(a->in[I_KVNORM] + layer * 128 + (lane - 32) * 8); nw1 = *(const f32x4*)(a->in[I_KVNORM] + layer * 128 + (lane - 32) * 8 + 4); }
    v4u nx = {0u, 0u, 0u, 0u};
    { const int n0 = bid_() * 8 + wave; if (n0 < T) nx = *(const v4u*)(G2 + (size_t)n0 * G2W + lane * 8); }
    for (int n = bid_() * 8 + wave; n < T; n += G * 8) {
        const v4u w = nx;
        if (n + G * 8 < T) nx = *(const v4u*)(G2 + (size_t)(n + G * 8) * G2W + lane * 8);
        const Tok tk = tok_of(n);
        float x[8] = {bflo(w.x), bfhi(w.x), bflo(w.y), bfhi(w.y), bflo(w.z), bfhi(w.z), bflo(w.w), bfhi(w.w)};
        const float ss = (x[0] * x[0] + x[1] * x[1]) + (x[2] * x[2] + x[3] * x[3]) + (x[4] * x[4] + x[5] * x[5]) + (x[6] * x[6] + x[7] * x[7]);
        const float sq = wave_sum(lane < 32 ? ss : 0.f), sk = wave_sum((lane >= 32 && lane < 48) ? ss : 0.f);
        const float rs = lane < 32 ? rsqrt_(sq * (1.f / 256.f) + 1e-6f) : rsqrt_(sk * (1.f / 128.f) + 1e-6f);
        if (lane < 48) {
            const float y0 = x[0] * rs * nw0.x, y1 = x[1] * rs * nw0.y, y2 = x[2] * rs * nw0.z, y3 = x[3] * rs * nw0.w, y4 = x[4] * rs * nw1.x, y5 = x[5] * rs * nw1.y, y6 = x[6] * rs * nw1.z, y7 = x[7] * rs * nw1.w;
            *(v4u*)(G2 + (size_t)n * G2W + lane * 8) = (v4u){cvtpk(y0, y1), cvtpk(y2, y3), cvtpk(y4, y5), cvtpk(y6, y7)};
            if (lane >= 32 && !tk.lat) { float* op = a->out + O_CKV + ((size_t)(tk.b * 2 + layer) * 256 + tk.t) * 128 + (lane - 32) * 8;
                *(f32x4*)op = (f32x4){y0, y1, y2, y3}; *(f32x4*)(op + 4) = (f32x4){y4, y5, y6, y7}; }
        } else if (lane < 52) {
            const int d0 = (lane - 48) * 8;
            if (!tk.lat) { float* op = a->out + O_KR + ((size_t)(tk.b * 2 + layer) * 256 + tk.t) * 32 + d0;
                *(f32x4*)op = (f32x4){x[0], x[1], x[2], x[3]}; *(f32x4*)(op + 4) = (f32x4){x[4], x[5], x[6], x[7]};
                *(v4u*)(KR + (size_t)tk.kidx * 32 + d0) = w; }
            else { const f32x4 c0 = *(const f32x4*)(ROPE + ((size_t)tk.t * 16 + (d0 >> 1)) * 2), c1 = *(const f32x4*)(ROPE + ((size_t)tk.t * 16 + (d0 >> 1) + 2) * 2);
                const float y0 = x[0] * c0.x - x[1] * c0.y, y1 = x[0] * c0.y + x[1] * c0.x, y2 = x[2] * c0.z - x[3] * c0.w, y3 = x[2] * c0.w + x[3] * c0.z;
                const float y4 = x[4] * c1.x - x[5] * c1.y, y5 = x[4] * c1.y + x[5] * c1.x, y6 = x[6] * c1.z - x[7] * c1.w, y7 = x[6] * c1.w + x[7] * c1.z;
                *(v4u*)(KR + (size_t)tk.kidx * 32 + d0) = (v4u){cvtpk(y0, y1), cvtpk(y2, y3), cvtpk(y4, y5), cvtpk(y6, y7)}; }
        }
    }
    for (int r = bid_() * 8 + wave; r < 2048; r += G * 8) {
        const int b = r >> 8, j = r & 255; const size_t src = (size_t)(b * 2 + layer) * 256 + j;
        if (lane < 16) { const f32x4 v0 = *(const f32x4*)(a->in[I_CCKV] + src * 128 + lane * 8), v1 = *(const f32x4*)(a->in[I_CCKV] + src * 128 + lane * 8 + 4);
            *(v4u*)(CK + (size_t)r * 512 + lane * 8) = (v4u){cvtpk(v0.x, v0.y), cvtpk(v0.z, v0.w), cvtpk(v1.x, v1.y), cvtpk(v1.z, v1.w)}; }
        else if (lane < 32) *(v4u*)(CK + (size_t)r * 512 + lane * 8) = (v4u){0u, 0u, 0u, 0u};
        else if (lane < 36) { const f32x4 v0 = *(const f32x4*)(a->in[I_CKR] + src * 32 + (lane - 32) * 8), v1 = *(const f32x4*)(a->in[I_CKR] + src * 32 + (lane - 32) * 8 + 4);
            *(v4u*)(KR + (size_t)(T_CTX + b * LK_LAT + j) * 32 + (lane - 32) * 8) = (v4u){cvtpk(v0.x, v0.y), cvtpk(v0.z, v0.w), cvtpk(v1.x, v1.y), cvtpk(v1.z, v1.w)}; }
    }
}
namespace pg8 {
struct A2Order {
    const char* ws; unsigned oq, okv; int G, c;
    __device__ __forceinline__ bool next(int i, Unit& u) const {
        const int L = i * G + c; if (L >= 704) return false;
        if (L < 288) { u.gid = 0; u.pm = L / 3; u.pn = L % 3; } else if (L < 672) { u.gid = 1; u.pm = (L - 288) >> 2; u.pn = (L - 288) & 3; } else { u.gid = 2; u.pm = (L - 672) >> 2; u.pn = (L - 672) & 3; }
        return true;
    }
    __device__ __forceinline__ const char* abase(const Gemm&, const Unit& u) const { const unsigned off = u.gid == 0 ? (unsigned)WS_G2 : (u.gid == 1 ? (unsigned)WS_G2 + 512u : (unsigned)WS_HF); return ws + off + (size_t)u.pm * 256 * 512 * 2; }
    __device__ __forceinline__ const char* bbase(const Gemm&, const Unit& u) const { const unsigned off = u.gid == 0 ? oq : okv; return ws + off + (size_t)u.pn * 256 * 256 * 2; }
    __device__ __forceinline__ void a_ready(const Unit&) const {}
    __device__ __forceinline__ void done(const Unit&) const {}
};
struct EpiA2 {
    static constexpr bool PERM = true, AFTER_DRAIN = false;
    bf16_t* Q; bf16_t* KN; bf16_t* VR; const float* rope;
    __device__ __forceinline__ void operator()(const f32x4 (&acc)[2][2][4][2], const Unit& u, int wr, int wc, int fr, int fq) const {
        const int row0 = u.pm * BM + wr * 64 + fr;
        if (u.gid == 0) {
            const int fb = u.pn * 256 + wc * 32 + 8 * fq;
#pragma unroll
            for (int ai = 0; ai < 2; ++ai)
#pragma unroll
                for (int m = 0; m < 4; ++m) { const int row = row0 + ai * HALF + m * 16;
                    const float* rp = rope + (unsigned)(((row - 8192) & 2047) * 32);
#pragma unroll
                    for (int bj = 0; bj < 2; ++bj) {
                        f32x4 v0 = acc[ai][bj][m][0], v1 = acc[ai][bj][m][1];
                        const int f0 = fb + bj * HALF, d = f0 % 96;
                        if (row >= 8192 && d >= 64) { const f32x4 c0 = *(const f32x4*)(rp + (d - 64)), c1 = *(const f32x4*)(rp + (d - 64) + 4);
                            const f32x4 a0 = v0, a1 = v1;
                            v0[0] = a0[0] * c0[0] - a0[1] * c0[1]; v0[1] = a0[0] * c0[1] + a0[1] * c0[0]; v0[2] = a0[2] * c0[2] - a0[3] * c0[3]; v0[3] = a0[2] * c0[3] + a0[3] * c0[2];
                            v1[0] = a1[0] * c1[0] - a1[1] * c1[1]; v1[1] = a1[0] * c1[1] + a1[1] * c1[0]; v1[2] = a1[2] * c1[2] - a1[3] * c1[3]; v1[3] = a1[2] * c1[3] + a1[3] * c1[2]; }
                        u32x4 w; w.x = cvt_pk_bf16(v0[0], v0[1]); w.y = cvt_pk_bf16(v0[2], v0[3]); w.z = cvt_pk_bf16(v1[0], v1[1]); w.w = cvt_pk_bf16(v1[2], v1[3]);
                        *(u32x4*)(Q + (unsigned)(row * 768 + f0)) = w; } }
        } else {
            const int x = wc * 32 + 8 * fq;
            bf16_t* base = (wc < 2 ? KN : VR);
            const unsigned xo = (unsigned)(x & 63);
#pragma unroll
            for (int ai = 0; ai < 2; ++ai)
#pragma unroll
                for (int m = 0; m < 4; ++m) { const int row = row0 + ai * HALF + m * 16;
                    int kidx;
                    if (u.gid == 2) kidx = 8192 + (row >> 8) * 2304 + (row & 255);
                    else if (row < 8192) kidx = row;
                    else { const int mrow = row - 8192; kidx = 8192 + (mrow >> 11) * 2304 + 256 + (mrow & 2047); }
#pragma unroll
                    for (int bj = 0; bj < 2; ++bj) { const f32x4 v0 = acc[ai][bj][m][0], v1 = acc[ai][bj][m][1];
                        u32x4 w; w.x = cvt_pk_bf16(v0[0], v0[1]); w.y = cvt_pk_bf16(v0[2], v0[3]); w.z = cvt_pk_bf16(v1[0], v1[1]); w.w = cvt_pk_bf16(v1[2], v1[3]);
                        *(u32x4*)(base + (unsigned)(kidx * 512 + (u.pn * 2 + bj) * 64) + xo) = w; } }
        }
    }
};
}
__device__ __forceinline__ void phase_a2b(ArgsP a, LAS unsigned char* lds, int layer) {
    int kk = 256; asm volatile("" : "+s"(kk));
    pg8::Gemm g{nullptr, nullptr, T, 1024, kk, 512, 256};
    pg8::A2Order S{(const char*)a->ws, (unsigned)(WS_WUQ + (size_t)layer * 768 * 256 * 2), (unsigned)(WS_WUKV + (size_t)layer * 1024 * 256 * 2), grid_(), bid_()};
    pg8::EpiA2 E{(bf16*)(a->ws + WS_Q), (bf16*)(a->ws + WS_KN), (bf16*)(a->ws + WS_VT), (const float*)(a->ws + WS_ROPE)};
    pg8::gemm_phase<pg8::EpiA2, pg8::A2Order, false>(lds, g, S, E, nullptr);
}
__device__ __forceinline__ void rwkv_unit_seq(ArgsP a, LAS unsigned char* lds, int layer, int u) {
    const int tid = tid_();
    LAS float* W2s = (LAS float*)lds;
    LAS float* A2s = W2s + 4096;
    LAS float* TH = A2s + 4096;
    LAS float* HA = TH + 2048;
    LAS float* Wd = HA + 2048;
    LAS float* KT = Wd + 2048; LAS float* KK = KT + 2048; LAS float* BB = KK + 2048; LAS float* RR = BB + 2048; LAS float* VV = RR + 2048; LAS float* YO = VV + 2048;
    const int lat = u < 64, uu = lat ? u : u - 64, b = uu >> 3, e = (uu >> 2) & 1, hh = uu & 3;
    const int L = lat ? L_LAT : L_CTX, tok0 = lat ? T_CTX + b * L_LAT : b * L_CTX;
    const bf16* G1 = (const bf16*)(a->ws + WS_G1);
    bf16* YS = (bf16*)(a->ws + WS_G2);
    for (int i = tid; i < 4096; i += NTHREADS) { const int j = i >> 6, c = i & 63;
        W2s[i] = a->in[I_W2][((size_t)(layer * 2 + e) * 64 + j) * 256 + hh * 64 + c];
        A2s[i] = a->in[I_A2][((size_t)(layer * 2 + e) * 64 + j) * 256 + hh * 64 + c]; }
    const int r = tid >> 3, ks = tid & 7;
    float S[8];
#pragma unroll
    for (int j = 0; j < 8; ++j) S[j] = lat ? a->in[I_SRW][(((size_t)((b * 2 + layer) * 2 + e) * 4 + hh) * 64 + r) * 64 + ks * 8 + j] : 0.f;
    const int tt = tid >> 4, q4 = (tid & 15) * 4;
    float w0v[4], a0v[4], kkw[4], kav[4];
#pragma unroll
    for (int i = 0; i < 4; ++i) { const int ch = hh * 64 + q4 + i;
        w0v[i] = a->in[I_W0][(layer * 2 + e) * 256 + ch]; a0v[i] = a->in[I_A0][(layer * 2 + e) * 256 + ch]; kkw[i] = a->in[I_KK][layer * 256 + ch]; kav[i] = a->in[I_KA][layer * 256 + ch]; }
    __syncthreads();
    for (int c = 0; c < L / 32; ++c) {
        const int step = c * 32 + tt, t = e ? L - 1 - step : step, n = tok0 + t;
        const bf16* g = G1 + (size_t)n * G1W;
        { const v2u hw = *(const v2u*)(g + C_LORA + e * 64 + q4), ha = *(const v2u*)(g + C_LORA + 128 + e * 64 + q4);
          TH[tt * 64 + q4 + 0] = tanhf(bflo(hw.x)); TH[tt * 64 + q4 + 1] = tanhf(bfhi(hw.x)); TH[tt * 64 + q4 + 2] = tanhf(bflo(hw.y)); TH[tt * 64 + q4 + 3] = tanhf(bfhi(hw.y));
          HA[tt * 64 + q4 + 0] = bflo(ha.x); HA[tt * 64 + q4 + 1] = bfhi(ha.x); HA[tt * 64 + q4 + 2] = bflo(ha.y); HA[tt * 64 + q4 + 3] = bfhi(ha.y); }
        __syncthreads();
        {
            float wl[4], al[4];
#pragma unroll
            for (int i = 0; i < 4; ++i) { wl[i] = w0v[i]; al[i] = a0v[i]; }
            for (int j = 0; j < 64; ++j) { const float th = TH[tt * 64 + j], hv = HA[tt * 64 + j];
                const f32x4 w2 = *(const LAS f32x4*)(W2s + j * 64 + q4), a2 = *(const LAS f32x4*)(A2s + j * 64 + q4);
                wl[0] = fmaf(th, w2.x, wl[0]); wl[1] = fmaf(th, w2.y, wl[1]); wl[2] = fmaf(th, w2.z, wl[2]); wl[3] = fmaf(th, w2.w, wl[3]);
                al[0] = fmaf(hv, a2.x, al[0]); al[1] = fmaf(hv, a2.y, al[1]); al[2] = fmaf(hv, a2.z, al[2]); al[3] = fmaf(hv, a2.w, al[3]); }
            const v2u kv = *(const v2u*)(g + C_K + hh * 64 + q4), rv = *(const v2u*)(g + C_R + hh * 64 + q4), vv = *(const v2u*)(g + C_V + hh * 64 + q4);
            const float kx[4] = {bflo(kv.x), bfhi(kv.x), bflo(kv.y), bfhi(kv.y)}, rx[4] = {bflo(rv.x), bfhi(rv.x), bflo(rv.y), bfhi(rv.y)}, vx[4] = {bflo(vv.x), bfhi(vv.x), bflo(vv.y), bfhi(vv.y)};
            float kkr[4], ss = 0.f;
#pragma unroll
            for (int i = 0; i < 4; ++i) { kkr[i] = kx[i] * kkw[i]; ss += kkr[i] * kkr[i]; }
            ss += __shfl_xor(ss, 1); ss += __shfl_xor(ss, 2); ss += __shfl_xor(ss, 4); ss += __shfl_xor(ss, 8);
            const float inrm = rcp_(fmaxf(sqrt_(ss), 1e-12f));
#pragma unroll
            for (int i = 0; i < 4; ++i) {
                const float dec = exp_(-0.6065306597126334f * sigmoidf_(wl[i])), av = sigmoidf_(al[i]), kk = kkr[i] * inrm;
                const int o = tt * 64 + q4 + i;
                Wd[o] = dec; KT[o] = kx[i] * (1.f + (av - 1.f) * kav[i]); KK[o] = kk; BB[o] = kk * av; RR[o] = rx[i]; VV[o] = vx[i]; }
        }
        __syncthreads();
        for (int s = 0; s < 32; ++s) {
            const int o = s * 64 + ks * 8;
            const f32x4 k0 = *(const LAS f32x4*)(KK + o), k1 = *(const LAS f32x4*)(KK + o + 4);
            float p = S[0] * k0.x + S[1] * k0.y + S[2] * k0.z + S[3] * k0.w + S[4] * k1.x + S[5] * k1.y + S[6] * k1.z + S[7] * k1.w;
            p += __shfl_xor(p, 1); p += __shfl_xor(p, 2); p += __shfl_xor(p, 4);
            const float sa = -p, vv = VV[s * 64 + r];
            const f32x4 w0 = *(const LAS f32x4*)(Wd + o), w1 = *(const LAS f32x4*)(Wd + o + 4), b0 = *(const LAS f32x4*)(BB + o), b1 = *(const LAS f32x4*)(BB + o + 4);
            const f32x4 t0 = *(const LAS f32x4*)(KT + o), t1 = *(const LAS f32x4*)(KT + o + 4), r0 = *(const LAS f32x4*)(RR + o), r1 = *(const LAS f32x4*)(RR + o + 4);
            S[0] = S[0] * w0.x + sa * b0.x + vv * t0.x; S[1] = S[1] * w0.y + sa * b0.y + vv * t0.y; S[2] = S[2] * w0.z + sa * b0.z + vv * t0.z; S[3] = S[3] * w0.w + sa * b0.w + vv * t0.w;
            S[4] = S[4] * w1.x + sa * b1.x + vv * t1.x; S[5] = S[5] * w1.y + sa * b1.y + vv * t1.y; S[6] = S[6] * w1.z + sa * b1.z + vv * t1.z; S[7] = S[7] * w1.w + sa * b1.w + vv * t1.w;
            float y = S[0] * r0.x + S[1] * r0.y + S[2] * r0.z + S[3] * r0.w + S[4] * r1.x + S[5] * r1.y + S[6] * r1.z + S[7] * r1.w;
            y += __shfl_xor(y, 1); y += __shfl_xor(y, 2); y += __shfl_xor(y, 4);
            if (ks == 0) YO[s * 64 + r] = y;
        }
        __syncthreads();
        { v2u o; o.x = pk2(YO[tt * 64 + q4], YO[tt * 64 + q4 + 1]); o.y = pk2(YO[tt * 64 + q4 + 2], YO[tt * 64 + q4 + 3]);
          *(v2u*)(YS + ((size_t)e * T + n) * 256 + hh * 64 + q4) = o; }
        __syncthreads();
    }
    if (!lat) {
        float* dst = a->out + O_RW + (((size_t)((b * 2 + layer) * 2 + e) * 4 + hh) * 64 + r) * 64 + ks * 8;
        *(f32x4*)dst = (f32x4){S[0], S[1], S[2], S[3]}; *(f32x4*)(dst + 4) = (f32x4){S[4], S[5], S[6], S[7]};
    }
}

__device__ __forceinline__ void lru_unit_seq(ArgsP a, LAS unsigned char* lds, int layer, int u) {
    const int tid = tid_();
    LAS float* WA = (LAS float*)lds;
    LAS float* WX = WA + 4096;
    LAS float* XC = WX + 4096;
    LAS float* AA = XC + 4096; LAS float* BV = AA + 4096; LAS float* HH = BV + 4096;
    const int lat = u < 32, uu = lat ? u : u - 32, b = uu >> 2, g = uu & 3;
    const int L = lat ? L_LAT : L_CTX, tok0 = lat ? T_CTX + b * L_LAT : b * L_CTX;
    const bf16* G1 = (const bf16*)(a->ws + WS_G1);
    bf16* HF = (bf16*)(a->ws + WS_HF);
    const int tt = tid >> 3, q8 = (tid & 7) * 8;
    float cw[4][8], cb[8];
#pragma unroll
    for (int i = 0; i < 8; ++i) { const int ch = g * 64 + q8 + i; cb[i] = a->in[I_CONVB][layer * 256 + ch];
#pragma unroll
        for (int j = 0; j < 4; ++j) cw[j][i] = a->in[I_CONVW][(layer * 4 + j) * 256 + ch]; }
    for (int e = 0; e < 2; ++e) {
        __syncthreads();
        for (int i = tid; i < 4096; i += NTHREADS) { const size_t src = ((size_t)((layer * 2 + e) * 4 + g)) * 4096 + i; WA[i] = a->in[I_WA][src]; WX[i] = a->in[I_WX][src]; }
        float bav[8], bxv[8], spl[8];
#pragma unroll
        for (int i = 0; i < 8; ++i) { const int ch = (layer * 2 + e) * 256 + g * 64 + q8 + i; bav[i] = a->in[I_BA][ch]; bxv[i] = a->in[I_BX][ch]; spl[i] = log1pf(exp_(-a->in[I_LAMBDA][ch])); }
        float h = 0.f;
        if (tid < 64 && lat) h = a->in[I_SLRU][((size_t)(b * 2 + layer) * 2 + e) * 256 + g * 64 + tid];
        __syncthreads();
        for (int cc = 0; cc < L / 64; ++cc) {
            const int c = e ? L / 64 - 1 - cc : cc, t = c * 64 + tt, n = tok0 + t;
            {
                float xc[8];
#pragma unroll
                for (int i = 0; i < 8; ++i) xc[i] = cb[i];
#pragma unroll
                for (int j = 0; j < 4; ++j) { const int ts = t + j - 2;
                    if (ts >= 0 && ts < L) { const v4u x = *(const v4u*)(G1 + (size_t)(tok0 + ts) * G1W + C_XL + g * 64 + q8);
                        xc[0] += cw[j][0] * bflo(x.x); xc[1] += cw[j][1] * bfhi(x.x); xc[2] += cw[j][2] * bflo(x.y); xc[3] += cw[j][3] * bfhi(x.y);
                        xc[4] += cw[j][4] * bflo(x.z); xc[5] += cw[j][5] * bfhi(x.z); xc[6] += cw[j][6] * bflo(x.w); xc[7] += cw[j][7] * bfhi(x.w); } }
#pragma unroll
                for (int i = 0; i < 8; ++i) XC[tt * 64 + q8 + i] = xc[i];
            }
            __syncthreads();
            {
                float gr[8], gi[8];
#pragma unroll
                for (int i = 0; i < 8; ++i) { gr[i] = bav[i]; gi[i] = bxv[i]; }
                for (int i = 0; i < 64; ++i) { const float x = XC[tt * 64 + i];
                    const f32x4 a0 = *(const LAS f32x4*)(WA + i * 64 + q8), a1 = *(const LAS f32x4*)(WA + i * 64 + q8 + 4), x0 = *(const LAS f32x4*)(WX + i * 64 + q8), x1 = *(const LAS f32x4*)(WX + i * 64 + q8 + 4);
                    gr[0] = fmaf(x, a0.x, gr[0]); gr[1] = fmaf(x, a0.y, gr[1]); gr[2] = fmaf(x, a0.z, gr[2]); gr[3] = fmaf(x, a0.w, gr[3]);
                    gr[4] = fmaf(x, a1.x, gr[4]); gr[5] = fmaf(x, a1.y, gr[5]); gr[6] = fmaf(x, a1.z, gr[6]); gr[7] = fmaf(x, a1.w, gr[7]);
                    gi[0] = fmaf(x, x0.x, gi[0]); gi[1] = fmaf(x, x0.y, gi[1]); gi[2] = fmaf(x, x0.z, gi[2]); gi[3] = fmaf(x, x0.w, gi[3]);
                    gi[4] = fmaf(x, x1.x, gi[4]); gi[5] = fmaf(x, x1.y, gi[5]); gi[6] = fmaf(x, x1.z, gi[6]); gi[7] = fmaf(x, x1.w, gi[7]); }
#pragma unroll
                for (int i = 0; i < 8; ++i) { const float la = -8.f * sigmoidf_(gr[i]) * spl[i];
                    AA[tt * 64 + q8 + i] = exp_(la);
                    BV[tt * 64 + q8 + i] = sqrt_(-expm1f(2.f * la)) * sigmoidf_(gi[i]) * XC[tt * 64 + q8 + i]; }
            }
            __syncthreads();
            if (tid < 64) { for (int s = 0; s < 64; ++s) { const int st = e ? 63 - s : s; h = fmaf(AA[st * 64 + tid], h, BV[st * 64 + tid]); HH[st * 64 + tid] = h; } }
            __syncthreads();
            {
                bf16* dst = HF + (size_t)n * 256 + g * 64 + q8;
                float o[8];
#pragma unroll
                for (int i = 0; i < 8; ++i) o[i] = HH[tt * 64 + q8 + i];
                if (e) { const v4u hf = *(const v4u*)dst, gl = *(const v4u*)(G1 + (size_t)n * G1W + C_GL + g * 64 + q8);
                    o[0] = (o[0] + bflo(hf.x)) * siluf_(bflo(gl.x)); o[1] = (o[1] + bfhi(hf.x)) * siluf_(bfhi(gl.x)); o[2] = (o[2] + bflo(hf.y)) * siluf_(bflo(gl.y)); o[3] = (o[3] + bfhi(hf.y)) * siluf_(bfhi(gl.y));
                    o[4] = (o[4] + bflo(hf.z)) * siluf_(bflo(gl.z)); o[5] = (o[5] + bfhi(hf.z)) * siluf_(bfhi(gl.z)); o[6] = (o[6] + bflo(hf.w)) * siluf_(bflo(gl.w)); o[7] = (o[7] + bfhi(hf.w)) * siluf_(bfhi(gl.w)); }
                v4u ov; ov.x = pk2(o[0], o[1]); ov.y = pk2(o[2], o[3]); ov.z = pk2(o[4], o[5]); ov.w = pk2(o[6], o[7]);
                *(v4u*)dst = ov;
            }
            __syncthreads();
        }
        if (tid < 64 && !lat) a->out[O_LRU + ((size_t)(b * 2 + layer) * 2 + e) * 256 + g * 64 + tid] = h;
    }
}

__device__ __forceinline__ void phase_c1(ArgsP a, int layer) {
    const int tid = tid_(), lane = tid & 63, wave = tid >> 6, G = grid_();
    const bf16* G1 = (const bf16*)(a->ws + WS_G1); const bf16* YS = (const bf16*)(a->ws + WS_G2); const bf16* Q = (const bf16*)(a->ws + WS_Q); const bf16* HF = (const bf16*)(a->ws + WS_HF);
    bf16* Y = (bf16*)(a->ws + WS_YMIX);
    const int ch = lane * 4;
    const f32x4 rk = *(const f32x4*)(a->in[I_RK] + layer * 256 + ch), lg = *(const f32x4*)(a->in[I_LNXG] + layer * 256 + ch), lb = *(const f32x4*)(a->in[I_LNXB] + layer * 256 + ch);
    v2u p_y0, p_y1, p_r, p_k, p_v, p_g, p_h; v4u p_q;
#define C1_LOAD(nn) do { const bf16* g_ = G1 + (size_t)(nn) * G1W; p_y0 = *(const v2u*)(YS + (size_t)(nn) * 256 + ch); p_y1 = *(const v2u*)(YS + ((size_t)T + (nn)) * 256 + ch); \
        p_r = *(const v2u*)(g_ + C_R + ch); p_k = *(const v2u*)(g_ + C_K + ch); p_v = *(const v2u*)(g_ + C_V + ch); p_g = *(const v2u*)(g_ + C_G + ch); \
        p_q = *(const v4u*)(Q + (size_t)(nn) * 768 + (lane >> 3) * 96 + (lane & 7) * 8); p_h = *(const v2u*)(HF + (size_t)(nn) * 256 + ch); } while (0)
    { const int n0 = bid_() * 8 + wave; if (n0 < T) C1_LOAD(n0); }
    for (int n = bid_() * 8 + wave; n < T; n += G * 8) {
        const v2u y0 = p_y0, y1 = p_y1, rv = p_r, kv = p_k, vv = p_v, gv = p_g, hq = p_h; const v4u qq = p_q;
        if (n + G * 8 < T) C1_LOAD(n + G * 8);
        float y[4] = {bflo(y0.x) + bflo(y1.x), bfhi(y0.x) + bfhi(y1.x), bflo(y0.y) + bflo(y1.y), bfhi(y0.y) + bfhi(y1.y)};
        float s = (y[0] + y[1]) + (y[2] + y[3]);
        float bon = bflo(rv.x) * bflo(kv.x) * rk.x + bfhi(rv.x) * bfhi(kv.x) * rk.y + bflo(rv.y) * bflo(kv.y) * rk.z + bfhi(rv.y) * bfhi(kv.y) * rk.w;
#pragma unroll
        for (int o = 1; o < 16; o <<= 1) { s += __shfl_xor(s, o); bon += __shfl_xor(bon, o); }
        const float mu = s * (1.f / 64.f);
        float s2 = (y[0] - mu) * (y[0] - mu) + (y[1] - mu) * (y[1] - mu) + (y[2] - mu) * (y[2] - mu) + (y[3] - mu) * (y[3] - mu);
#pragma unroll
        for (int o = 1; o < 16; o <<= 1) s2 += __shfl_xor(s2, o);
        const float rstd = rsqrt_(s2 * (1.f / 64.f) + GN_EPS);
        const float o0 = ((y[0] - mu) * rstd * lg.x + lb.x + bon * bflo(vv.x)) * siluf_(bflo(gv.x));
        const float o1 = ((y[1] - mu) * rstd * lg.y + lb.y + bon * bfhi(vv.x)) * siluf_(bfhi(gv.x));
        const float o2 = ((y[2] - mu) * rstd * lg.z + lb.z + bon * bflo(vv.y)) * siluf_(bflo(gv.y));
        const float o3 = ((y[3] - mu) * rstd * lg.w + lb.w + bon * bfhi(vv.y)) * siluf_(bfhi(gv.y));
        v2u ov; ov.x = pk2(o0, o1); ov.y = pk2(o2, o3);
        bf16* yr = Y + (size_t)n * 1024;
        *(v2u*)(yr + ch) = ov;
        *(v4u*)(yr + 256 + (lane >> 3) * 64 + (lane & 7) * 8) = qq;
        *(v2u*)(yr + 768 + ch) = hq;
    }
#undef C1_LOAD
}
#define MFMA32(a, b, c) __builtin_amdgcn_mfma_f32_32x32x16_bf16((a), (b), (c), 0, 0, 0)
#define MFMA16(a, b, c) __builtin_amdgcn_mfma_f32_16x16x32_bf16((a), (b), (c), 0, 0, 0)
typedef short s16x4_t __attribute__((ext_vector_type(4)));

__device__ __forceinline__ float tanh_fast(float x) { return 1.f - 2.f * rcp_(1.f + exp_(2.f * x)); }

constexpr int ATT_KSTR = 208, ATT_VSTR = 136, ATT_VOFF = 64 * ATT_KSTR, ATT_STAGE = 64 * ATT_KSTR + 64 * ATT_VSTR;
__device__ __forceinline__ void att_unit(ArgsP a, LAS unsigned char* lds, int u) {
    const int tid = tid_(), lane = tid & 63, wave = tid >> 6, r = lane & 31, hq = lane >> 5;
    const bf16* KN = (const bf16*)(a->ws + WS_KN); const bf16* KR = (const bf16*)(a->ws + WS_KR); const bf16* VT = (const bf16*)(a->ws + WS_VT);
    bf16* Q = (bf16*)(a->ws + WS_Q); const bf16* G1 = (const bf16*)(a->ws + WS_G1);
    int b, h, n0, Lk, kidx0; size_t vbase;
    if (u < 512) { b = u >> 6; h = (u >> 3) & 7; n0 = T_CTX + b * 2048 + (u & 7) * 256; Lk = LK_LAT; kidx0 = T_CTX + b * LK_LAT; vbase = (size_t)VT_LAT + (size_t)(b * 8 + h) * 64 * LK_LAT; }
    else { const int uu = u - 512; b = uu >> 3; h = uu & 7; n0 = b * 256; Lk = 256; kidx0 = b * 256; vbase = (size_t)(b * 8 + h) * 64 * 256; }
    const int ntiles = Lk >> 6;
    const int n = n0 + wave * 32 + r;
    bf16x8 qf[6];
#pragma unroll
    for (int ks = 0; ks < 6; ++ks) qf[ks] = *(const bf16x8*)(Q + (size_t)n * 768 + h * 96 + ks * 16 + 8 * hq);
    const int key_k = tid >> 3, ck = tid & 7, key_r = (tid >> 2) & 63, cr = tid & 3;
    const bf16* gk = KN + (size_t)(kidx0 + key_k) * 512 + h * 64 + ck * 8;
    const bf16* gr = KR + (size_t)(kidx0 + key_r) * 32 + cr * 8;
    const bf16* gv = VT + vbase + (size_t)key_k * Lk + ck * 8;
    const unsigned sk = key_k * ATT_KSTR + ck * 16, sr = key_r * ATT_KSTR + 128 + cr * 16, sv = ATT_VOFF + key_k * ATT_VSTR + ck * 16;
    v4u rk, rr, rv;
    rk = *(const v4u*)gk; rr = (tid < 256) ? *(const v4u*)gr : (v4u){0u, 0u, 0u, 0u}; rv = *(const v4u*)gv;
    __syncthreads();
    *(LAS v4u*)(lds + sk) = rk; if (tid < 256) *(LAS v4u*)(lds + sr) = rr;
    *(LAS v2u*)(lds + sv) = (v2u){rv.x, rv.y}; *(LAS v2u*)(lds + sv + 8) = (v2u){rv.z, rv.w};
    __syncthreads();
    f32x16 o0, o1;
#pragma unroll
    for (int i = 0; i < 16; ++i) { o0[i] = 0.f; o1[i] = 0.f; }
    float m = -1e30f, l = 0.f;
    for (int j = 0; j < ntiles; ++j) {
        const int buf = j & 1;
        if (j + 1 < ntiles) { rk = *(const v4u*)(gk + (size_t)(j + 1) * 64 * 512); if (tid < 256) rr = *(const v4u*)(gr + (size_t)(j + 1) * 64 * 32); rv = *(const v4u*)(gv + (j + 1) * 64); }
        const LAS unsigned char* Kb = lds + buf * ATT_STAGE;
        f32x16 s0, s1;
#pragma unroll
        for (int i = 0; i < 16; ++i) { s0[i] = 0.f; s1[i] = 0.f; }
#pragma unroll
        for (int ks = 0; ks < 6; ++ks) {
            const bf16x8 a0 = *(const LAS bf16x8*)(Kb + r * ATT_KSTR + ks * 32 + hq * 16), a1 = *(const LAS bf16x8*)(Kb + (32 + r) * ATT_KSTR + ks * 32 + hq * 16);
            s0 = MFMA32(a0, qf[ks], s0); s1 = MFMA32(a1, qf[ks], s1);
        }
        float mx = s0[0];
#pragma unroll
        for (int i = 1; i < 16; ++i) mx = fmaxf(mx, s0[i]);
#pragma unroll
        for (int i = 0; i < 16; ++i) mx = fmaxf(mx, s1[i]);
        mx = fmaxf(mx, __shfl_xor(mx, 32));
        const float mn = fmaxf(m, mx), alpha = __builtin_amdgcn_exp2f(m - mn); m = mn;
        float ps = 0.f;
#pragma unroll
        for (int i = 0; i < 16; ++i) { s0[i] = __builtin_amdgcn_exp2f(s0[i] - mn); s1[i] = __builtin_amdgcn_exp2f(s1[i] - mn); ps += s0[i] + s1[i]; }
        l = l * alpha + ps;
#pragma unroll
        for (int i = 0; i < 16; ++i) { o0[i] *= alpha; o1[i] *= alpha; }
        const LAS unsigned char* Vb = Kb + ATT_VOFF;
#pragma unroll
        for (int ks = 0; ks < 4; ++ks) {
            v4u pw;
            if (ks == 0) { pw.x = cvtpk(s0[0], s0[1]); pw.y = cvtpk(s0[2], s0[3]); pw.z = cvtpk(s0[4], s0[5]); pw.w = cvtpk(s0[6], s0[7]); }
            else if (ks == 1) { pw.x = cvtpk(s0[8], s0[9]); pw.y = cvtpk(s0[10], s0[11]); pw.z = cvtpk(s0[12], s0[13]); pw.w = cvtpk(s0[14], s0[15]); }
            else if (ks == 2) { pw.x = cvtpk(s1[0], s1[1]); pw.y = cvtpk(s1[2], s1[3]); pw.z = cvtpk(s1[4], s1[5]); pw.w = cvtpk(s1[6], s1[7]); }
            else { pw.x = cvtpk(s1[8], s1[9]); pw.y = cvtpk(s1[10], s1[11]); pw.z = cvtpk(s1[12], s1[13]); pw.w = cvtpk(s1[14], s1[15]); }
            const bf16x8 pf = __builtin_bit_cast(bf16x8, pw);
            const v2u va0 = *(const LAS v2u*)(Vb + r * ATT_VSTR + ks * 32 + hq * 8), va1 = *(const LAS v2u*)(Vb + r * ATT_VSTR + ks * 32 + 16 + hq * 8);
            const v2u vb0 = *(const LAS v2u*)(Vb + (32 + r) * ATT_VSTR + ks * 32 + hq * 8), vb1 = *(const LAS v2u*)(Vb + (32 + r) * ATT_VSTR + ks * 32 + 16 + hq * 8);
            const v4u vwa = {va0.x, va0.y, va1.x, va1.y}, vwb = {vb0.x, vb0.y, vb1.x, vb1.y};
            o0 = MFMA32(__builtin_bit_cast(bf16x8, vwa), pf, o0); o1 = MFMA32(__builtin_bit_cast(bf16x8, vwb), pf, o1);
        }
        if (j + 1 < ntiles) {
            LAS unsigned char* Nb = lds + (buf ^ 1) * ATT_STAGE;
            *(LAS v4u*)(Nb + sk) = rk; if (tid < 256) *(LAS v4u*)(Nb + sr) = rr;
            *(LAS v2u*)(Nb + sv) = (v2u){rv.x, rv.y}; *(LAS v2u*)(Nb + sv + 8) = (v2u){rv.z, rv.w};
        }
        __syncthreads();
    }
    l += __shfl_xor(l, 32);
    const float inv = rcp_(l);
#pragma unroll
    for (int mt = 0; mt < 2; ++mt)
#pragma unroll
        for (int g = 0; g < 4; ++g) {
            const int dv0 = 32 * mt + 8 * g + 4 * hq;
            const v2u gm = *(const v2u*)(G1 + (size_t)n * G1W + C_GM + h * 64 + dv0);
            const float x0 = (mt ? o1[4 * g + 0] : o0[4 * g + 0]) * inv, x1 = (mt ? o1[4 * g + 1] : o0[4 * g + 1]) * inv, x2 = (mt ? o1[4 * g + 2] : o0[4 * g + 2]) * inv, x3 = (mt ? o1[4 * g + 3] : o0[4 * g + 3]) * inv;
            v2u ov; ov.x = cvtpk(x0 * siluf_(bflo(gm.x)), x1 * siluf_(bfhi(gm.x))); ov.y = cvtpk(x2 * siluf_(bflo(gm.y)), x3 * siluf_(bfhi(gm.y)));
            *(v2u*)(Q + (size_t)n * 768 + h * 96 + dv0) = ov;
        }
}

constexpr int A2_QSTR = 528, A2_KVSTR = 272, A2_KVOFF = 64 * A2_QSTR;
__device__ __forceinline__ void a2_unit(ArgsP a, LAS unsigned char* lds, int layer, int unit) {
    const int tid = tid_(), lane = tid & 63, wave = tid >> 6, tn = lane & 15, g = lane >> 4;
    constexpr int NU_TOK = T / 64;
    const bool is_tok = unit < NU_TOK;
    const bf16* G2 = (const bf16*)(a->ws + WS_G2);
    bf16* Q = (bf16*)(a->ws + WS_Q); bf16* KN = (bf16*)(a->ws + WS_KN); bf16* KR = (bf16*)(a->ws + WS_KR); bf16* VT = (bf16*)(a->ws + WS_VT);
    const bf16* WUQ = (const bf16*)(a->ws + WS_WUQ) + (size_t)layer * 768 * 256;
    const bf16* WUKV = (const bf16*)(a->ws + WS_WUKV) + (size_t)layer * 1024 * 128;
    const float* ROPE1 = (const float*)(a->ws + WS_ROPE);
    __syncthreads();
    v2u cq8[8], kv8[8]; unsigned kr8[8];
    if (is_tok) {
#pragma unroll
        for (int rr = 0; rr < 8; ++rr) { const size_t n_ = (size_t)(unit * 64 + wave * 8 + rr);
            cq8[rr] = *(const v2u*)(G2 + n_ * G2W + lane * 4); kv8[rr] = *(const v2u*)(G2 + n_ * G2W + 256 + (lane & 31) * 4); kr8[rr] = G2[n_ * G2W + 384 + (lane & 31)]; }
    }
#pragma unroll
    for (int rr = 0; rr < 8; ++rr) {
        const int r = wave * 8 + rr;
        if (is_tok) {
            const int n = unit * 64 + r; const Tok tk = tok_of(n);
            const v2u cqv = cq8[rr];
            const float c0 = bflo(cqv.x), c1 = bfhi(cqv.x), c2 = bflo(cqv.y), c3 = bfhi(cqv.y);
            const float rq = rsqrt_(wave_sum(c0 * c0 + c1 * c1 + c2 * c2 + c3 * c3) * (1.f / 256.f) + 1e-6f);
            const f32x4 qn = *(const f32x4*)(a->in[I_QNORM] + layer * 256 + lane * 4);
            *(LAS v2u*)(lds + r * A2_QSTR + lane * 8) = (v2u){cvtpk(c0 * rq * qn.x, c1 * rq * qn.y), cvtpk(c2 * rq * qn.z, c3 * rq * qn.w)};
            float k0 = 0.f, k1 = 0.f, k2 = 0.f, k3 = 0.f;
            if (lane < 32) { const v2u kv = kv8[rr]; k0 = bflo(kv.x); k1 = bfhi(kv.x); k2 = bflo(kv.y); k3 = bfhi(kv.y); }
            const float rk = rsqrt_(wave_sum(k0 * k0 + k1 * k1 + k2 * k2 + k3 * k3) * (1.f / 128.f) + 1e-6f);
            if (lane < 32) {
                const f32x4 kn = *(const f32x4*)(a->in[I_KVNORM] + layer * 128 + lane * 4);
                f32x4 o; o.x = k0 * rk * kn.x; o.y = k1 * rk * kn.y; o.z = k2 * rk * kn.z; o.w = k3 * rk * kn.w;
                if (!tk.lat) *(f32x4*)(a->out + O_CKV + ((size_t)(tk.b * 2 + layer) * 256 + tk.t) * 128 + lane * 4) = o;
                *(LAS v2u*)(lds + A2_KVOFF + r * A2_KVSTR + lane * 8) = (v2u){cvtpk(o.x, o.y), cvtpk(o.z, o.w)};
            }
            float krv = (lane < 32) ? bf2f(kr8[rr]) : 0.f;
            const float other = __shfl_xor(krv, 1);
            if (lane < 32) {
                if (!tk.lat) a->out[O_KR + ((size_t)(tk.b * 2 + layer) * 256 + tk.t) * 32 + lane] = krv;
                else { const float c = ROPE1[((size_t)tk.t * 16 + (lane >> 1)) * 2], s = ROPE1[((size_t)tk.t * 16 + (lane >> 1)) * 2 + 1]; krv = (lane & 1) ? (other * s + krv * c) : (krv * c - other * s); }
                KR[(size_t)tk.kidx * 32 + lane] = (bf16)f2bf(krv);
            }
        } else {
            const int cr = (unit - NU_TOK) * 64 + r, b = cr >> 8, j = cr & 255;
            const size_t src = ((size_t)(b * 2 + layer) * 256 + j);
            if (lane < 32) { const f32x4 v = *(const f32x4*)(a->in[I_CCKV] + src * 128 + lane * 4);
                *(LAS v2u*)(lds + A2_KVOFF + r * A2_KVSTR + lane * 8) = (v2u){cvtpk(v.x, v.y), cvtpk(v.z, v.w)};
                KR[(size_t)(T_CTX + b * LK_LAT + j) * 32 + lane] = (bf16)f2bf(a->in[I_CKR][src * 32 + lane]); }
        }
    }
    __syncthreads();
    constexpr int A2_STG = 52224, A2_SQSTR = 784, A2_SKSTR = 1040, A2_SVSTR = 144;
    const int n0 = is_tok ? unit * 64 : 0;
    if (is_tok) {
      const float* ROPE = (const float*)(a->ws + WS_ROPE);
      for (int qh = 0; qh < 2; ++qh) {
        f32x4 acc[3][4];
#pragma unroll
        for (int f = 0; f < 3; ++f)
#pragma unroll
            for (int t = 0; t < 4; ++t) acc[f][t] = (f32x4){0.f, 0.f, 0.f, 0.f};
        bf16x8 afq[3][8];
        const bf16* wq = WUQ + (size_t)((qh * 24 + wave * 3) * 16 + tn) * 256 + g * 8;
#pragma unroll
        for (int f = 0; f < 3; ++f)
#pragma unroll
            for (int ks = 0; ks < 8; ++ks) afq[f][ks] = *(const bf16x8*)(wq + f * 16 * 256 + ks * 32);
#pragma unroll
        for (int ks = 0; ks < 8; ++ks) {
            bf16x8 bfr[4];
#pragma unroll
            for (int t = 0; t < 4; ++t) bfr[t] = *(const LAS bf16x8*)(lds + (t * 16 + tn) * A2_QSTR + ks * 64 + g * 16);
#pragma unroll
            for (int f = 0; f < 3; ++f)
#pragma unroll
                for (int t = 0; t < 4; ++t) acc[f][t] = MFMA16(afq[f][ks], bfr[t], acc[f][t]);
        }
#pragma unroll
        for (int f = 0; f < 3; ++f) { const int fl = (wave * 3 + f) * 16 + 4 * g, f0 = qh * 384 + fl, d = f0 % 96;
#pragma unroll
            for (int t = 0; t < 4; ++t) { const int r = t * 16 + tn, n = n0 + r;
                float v0 = acc[f][t][0], v1 = acc[f][t][1], v2 = acc[f][t][2], v3 = acc[f][t][3];
                if (n >= T_CTX && d >= 64) { const int tt = (n - T_CTX) & 2047; const f32x4 cs = *(const f32x4*)(ROPE + ((size_t)tt * 16 + ((d - 64) >> 1)) * 2);
                    const float y0 = v0 * cs.x - v1 * cs.y, y1 = v0 * cs.y + v1 * cs.x, y2 = v2 * cs.z - v3 * cs.w, y3 = v2 * cs.w + v3 * cs.z; v0 = y0; v1 = y1; v2 = y2; v3 = y3; }
                *(LAS v2u*)(lds + A2_STG + r * A2_SQSTR + fl * 2) = (v2u){cvtpk(v0, v1), cvtpk(v2, v3)}; } }
        __syncthreads();
#pragma unroll
        for (int i = 0; i < 6; ++i) { const int c = tid + 512 * i, row = c / 48, c16 = c % 48;
            *(v4u*)(Q + (size_t)(n0 + row) * 768 + qh * 384 + c16 * 8) = *(const LAS v4u*)(lds + A2_STG + row * A2_SQSTR + c16 * 16); }
        __syncthreads();
      }
    }
    int kidx0, latu, bu, kpos0;
    if (is_tok) { const Tok tk = tok_of(n0); kidx0 = tk.kidx; latu = tk.lat; bu = tk.b; kpos0 = tk.lat ? PAST + tk.t : tk.t; }
    else { const int cr = (unit - NU_TOK) * 64; bu = cr >> 8; kpos0 = cr & 255; latu = 1; kidx0 = T_CTX + bu * LK_LAT + kpos0; }
    for (int half = 0; half < 2; ++half) {
        f32x4 acc[4][4];
#pragma unroll
        for (int f = 0; f < 4; ++f)
#pragma unroll
            for (int t = 0; t < 4; ++t) acc[f][t] = (f32x4){0.f, 0.f, 0.f, 0.f};
        bf16x8 afk[4][4];
        const bf16* wk = WUKV + (size_t)(wave * 128 + half * 64 + tn) * 128 + g * 8;
#pragma unroll
        for (int f = 0; f < 4; ++f)
#pragma unroll
            for (int ks = 0; ks < 4; ++ks) afk[f][ks] = *(const bf16x8*)(wk + f * 16 * 128 + ks * 32);
#pragma unroll
        for (int ks = 0; ks < 4; ++ks) {
            bf16x8 bfr[4];
#pragma unroll
            for (int t = 0; t < 4; ++t) bfr[t] = *(const LAS bf16x8*)(lds + A2_KVOFF + (t * 16 + tn) * A2_KVSTR + ks * 64 + g * 16);
#pragma unroll
            for (int f = 0; f < 4; ++f)
#pragma unroll
                for (int t = 0; t < 4; ++t) acc[f][t] = MFMA16(afk[f][ks], bfr[t], acc[f][t]);
        }
#pragma unroll
        for (int f = 0; f < 4; ++f) { const int x = wave * 64 + f * 16 + 4 * g;
#pragma unroll
            for (int t = 0; t < 4; ++t) { const int r = t * 16 + tn;
                if (half == 0) *(LAS v2u*)(lds + A2_STG + r * A2_SKSTR + x * 2) = (v2u){cvtpk(acc[f][t][0], acc[f][t][1]), cvtpk(acc[f][t][2], acc[f][t][3])};
                else { const unsigned p01 = cvtpk(acc[f][t][0], acc[f][t][1]), p23 = cvtpk(acc[f][t][2], acc[f][t][3]);
                    *(LAS bf16*)(lds + A2_STG + (x + 0) * A2_SVSTR + r * 2) = (bf16)(p01 & 0xffffu); *(LAS bf16*)(lds + A2_STG + (x + 1) * A2_SVSTR + r * 2) = (bf16)(p01 >> 16);
                    *(LAS bf16*)(lds + A2_STG + (x + 2) * A2_SVSTR + r * 2) = (bf16)(p23 & 0xffffu); *(LAS bf16*)(lds + A2_STG + (x + 3) * A2_SVSTR + r * 2) = (bf16)(p23 >> 16); } } }
        __syncthreads();
        if (half == 0) {
#pragma unroll
            for (int i = 0; i < 8; ++i) { const int c = tid + 512 * i, row = c >> 6, c16 = c & 63;
                *(v4u*)(KN + (size_t)(kidx0 + row) * 512 + c16 * 8) = *(const LAS v4u*)(lds + A2_STG + row * A2_SKSTR + c16 * 16); }
        } else {
            const int Lk = latu ? LK_LAT : 256;
#pragma unroll
            for (int i = 0; i < 8; ++i) { const int c = tid + 512 * i, row = c >> 3, part = c & 7, h = row >> 6, dv = row & 63;
                const size_t base = latu ? (size_t)VT_LAT + ((size_t)(bu * 8 + h) * 64 + dv) * LK_LAT : ((size_t)(bu * 8 + h) * 64 + dv) * 256;
                *(v4u*)(VT + base + kpos0 + part * 8) = *(const LAS v4u*)(lds + A2_STG + row * A2_SVSTR + part * 16); }
            (void)Lk;
        }
        __syncthreads();
    }
}

constexpr int RW_W2T = 0, RW_A2T = 9216, RW_TH = 18432, RW_HA = 27648, RW_CH0 = 36864, RW_CHB = 20992, RW_YB = 120832;
constexpr int RC_KP = 0, RC_RP = 2304, RC_BP = 4608  , RC_KT = 6912, RC_VR = 9216  , RC_LK = 16896, RC_TM = 17536, RC_ARK = 18176, RC_NARB = 18816, RC_G15 = 19456, RC_LBF = 19712, RC_SSQ = 20736;
__device__ __forceinline__ void rwkv_unit_mfma(ArgsP a, LAS unsigned char* lds, int layer, int u) {
    const int tid = tid_(), lane = tid & 63, wave = tid >> 6, i16 = lane & 15, g = lane >> 4;
    const int lat = u < 64, uu = lat ? u : u - 64, b = uu >> 3, e = (uu >> 2) & 1, hh = uu & 3;
    const int L = lat ? L_LAT : L_CTX, tok0 = lat ? T_CTX + b * L_LAT : b * L_CTX;
    const bf16* G1 = (const bf16*)(a->ws + WS_G1);
    bf16* YS = (bf16*)(a->ws + WS_G2);
    __syncthreads();
    { const bf16* wsrc = (const bf16*)(a->ws + WS_LORA2) + ((size_t)((layer * 2 + e) * 2) * 256 + hh * 64) * 64; const int row = tid >> 3, c8 = (tid & 7) * 8;
      *(LAS v4u*)(lds + RW_W2T + row * 144 + c8 * 2) = *(const v4u*)(wsrc + row * 64 + c8);
      *(LAS v4u*)(lds + RW_A2T + row * 144 + c8 * 2) = *(const v4u*)(wsrc + 256 * 64 + row * 64 + c8); }
    const int st_tok = tid >> 3, st_c8 = (tid & 7) * 8;
#define RW_STAGE(sc) do { const int step_ = (sc) * 64 + st_tok, t_ = e ? L - 1 - step_ : step_; const bf16* gp_ = G1 + (size_t)(tok0 + t_) * G1W + C_LORA + e * 64 + st_c8; \
        const v4u hw_ = *(const v4u*)gp_, ha_ = *(const v4u*)(gp_ + 128); v4u th_; \
        th_.x = cvtpk(tanh_fast(bflo(hw_.x)), tanh_fast(bfhi(hw_.x))); th_.y = cvtpk(tanh_fast(bflo(hw_.y)), tanh_fast(bfhi(hw_.y))); th_.z = cvtpk(tanh_fast(bflo(hw_.z)), tanh_fast(bfhi(hw_.z))); th_.w = cvtpk(tanh_fast(bflo(hw_.w)), tanh_fast(bfhi(hw_.w))); \
        *(LAS v4u*)(lds + RW_TH + st_tok * 144 + st_c8 * 2) = th_; *(LAS v4u*)(lds + RW_HA + st_tok * 144 + st_c8 * 2) = ha_; } while (0)
    RW_STAGE(0);
    f32x4 ST[4];
    {
        const int v = 16 * (wave & 3) + i16;
#pragma unroll
        for (int kt = 0; kt < 4; ++kt) ST[kt] = lat ? *(const f32x4*)(a->in[I_SRW] + (((size_t)((b * 2 + layer) * 2 + e) * 4 + hh) * 64 + v) * 64 + 16 * kt + 4 * g) : (f32x4){0.f, 0.f, 0.f, 0.f};
    }
    const int pc = wave & 3, ph = wave >> 2;
    LAS unsigned char* CH = lds + RW_CH0 + pc * RW_CHB;
    __syncthreads();
    const int nsc = L >> 6;
    v2u pk[2], pr[2], pv[2];
#define RW_PREFETCH(sc) do { const int ps_ = (sc) * 64 + pc * 16 + i16, pt_ = e ? L - 1 - ps_ : ps_; const bf16* gq_ = G1 + (size_t)(tok0 + pt_) * G1W + hh * 64 + (2 * ph) * 16 + 4 * g; \
        pk[0] = *(const v2u*)(gq_ + C_K); pk[1] = *(const v2u*)(gq_ + C_K + 16); pr[0] = *(const v2u*)(gq_ + C_R); pr[1] = *(const v2u*)(gq_ + C_R + 16); pv[0] = *(const v2u*)(gq_ + C_V); pv[1] = *(const v2u*)(gq_ + C_V + 16); } while (0)
    RW_PREFETCH(0);
    for (int sc = 0; sc < nsc; ++sc) {
        const v2u ck[2] = {pk[0], pk[1]}, cr[2] = {pr[0], pr[1]}, cv[2] = {pv[0], pv[1]};
        if (sc + 1 < nsc) RW_PREFETCH(sc + 1);
        float dec[8], av[8], kx[8], rx[8], kk[8];
        {
            f32x4 aw[2], aa[2];
#pragma unroll
            for (int c2 = 0; c2 < 2; ++c2) { aw[c2] = (f32x4){0.f, 0.f, 0.f, 0.f}; aa[c2] = (f32x4){0.f, 0.f, 0.f, 0.f}; }
#pragma unroll
            for (int ks = 0; ks < 2; ++ks) {
                const bf16x8 bth = *(const LAS bf16x8*)(lds + RW_TH + (pc * 16 + i16) * 144 + ks * 64 + g * 16), bha = *(const LAS bf16x8*)(lds + RW_HA + (pc * 16 + i16) * 144 + ks * 64 + g * 16);
#pragma unroll
                for (int c2 = 0; c2 < 2; ++c2) { const int row = (2 * ph + c2) * 16 + i16;
                    const bf16x8 w2f = *(const LAS bf16x8*)(lds + RW_W2T + row * 144 + ks * 64 + g * 16), a2f = *(const LAS bf16x8*)(lds + RW_A2T + row * 144 + ks * 64 + g * 16);
                    aw[c2] = MFMA16(w2f, bth, aw[c2]); aa[c2] = MFMA16(a2f, bha, aa[c2]); }
            }
            float ss = 0.f;
#pragma unroll
            for (int c2 = 0; c2 < 2; ++c2) { const int ch = (2 * ph + c2) * 16 + 4 * g, gch = hh * 64 + ch;
                const f32x4 w0 = *(const f32x4*)(a->in[I_W0] + (layer * 2 + e) * 256 + gch), a0 = *(const f32x4*)(a->in[I_A0] + (layer * 2 + e) * 256 + gch), kw = *(const f32x4*)(a->in[I_KK] + layer * 256 + gch);
                const v2u kv = ck[c2], rv = cr[c2];
                const float kq[4] = {bflo(kv.x), bfhi(kv.x), bflo(kv.y), bfhi(kv.y)}, rq[4] = {bflo(rv.x), bfhi(rv.x), bflo(rv.y), bfhi(rv.y)};
#pragma unroll
                for (int q = 0; q < 4; ++q) { const int o = c2 * 4 + q;
                    dec[o] = exp_(-0.6065306597126334f * sigmoidf_(aw[c2][q] + w0[q])); av[o] = sigmoidf_(aa[c2][q] + a0[q]);
                    kx[o] = kq[q]; rx[o] = rq[q]; kk[o] = kq[q] * kw[q]; ss += kk[o] * kk[o]; }
            }
            ss += __shfl_xor(ss, 16); ss += __shfl_xor(ss, 32);
            if (g == 0) *(LAS float*)(CH + RC_SSQ + (i16 * 2 + ph) * 4) = ss;
        }
        __syncthreads();
        {
            const float tot = *(const LAS float*)(CH + RC_SSQ + (i16 * 2) * 4) + *(const LAS float*)(CH + RC_SSQ + (i16 * 2 + 1) * 4);
            const float inrm = rcp_(fmaxf(sqrt_(tot), 1e-12f));
            float G8[8], Gx8[8];
#pragma unroll
            for (int o8 = 0; o8 < 8; ++o8) G8[o8] = dec[o8];
#pragma unroll
            for (int o8 = 0; o8 < 8; ++o8) G8[o8] *= dpp_f<0x111>(1.f, G8[o8]);
#pragma unroll
            for (int o8 = 0; o8 < 8; ++o8) G8[o8] *= dpp_f<0x112>(1.f, G8[o8]);
#pragma unroll
            for (int o8 = 0; o8 < 8; ++o8) G8[o8] *= dpp_f<0x114>(1.f, G8[o8]);
#pragma unroll
            for (int o8 = 0; o8 < 8; ++o8) G8[o8] *= dpp_f<0x118>(1.f, G8[o8]);
#pragma unroll
            for (int o8 = 0; o8 < 8; ++o8) Gx8[o8] = dpp_f<0x111>(1.f, G8[o8]);
#pragma unroll
            for (int c2 = 0; c2 < 2; ++c2) { const int ch = (2 * ph + c2) * 16 + 4 * g, gch = hh * 64 + ch;
                const f32x4 ka = *(const f32x4*)(a->in[I_KA] + layer * 256 + gch);
                float kp[4], bp[4], kt[4], rp[4];
#pragma unroll
                for (int q = 0; q < 4; ++q) { const int o = c2 * 4 + q;
                    const float G = G8[o], Gex = Gx8[o];
                    const float kkn = kk[o] * inrm, iG = rcp_(G);
                    kp[q] = Gex * kkn; bp[q] = kkn * av[o] * iG; kt[q] = kx[o] * (1.f + (av[o] - 1.f) * ka[q]) * iG; rp[q] = G * rx[o];
                    if (i16 == 15) *(LAS float*)(CH + RC_G15 + (ch + q) * 4) = G;
                }
                *(LAS v2u*)(CH + RC_KP + i16 * 144 + ch * 2) = (v2u){cvtpk(kp[0], kp[1]), cvtpk(kp[2], kp[3])};
                *(LAS v2u*)(CH + RC_BP + i16 * 144 + ch * 2) = (v2u){cvtpk(-bp[0], -bp[1]), cvtpk(-bp[2], -bp[3])};
                *(LAS v2u*)(CH + RC_KT + i16 * 144 + ch * 2) = (v2u){cvtpk(kt[0], kt[1]), cvtpk(kt[2], kt[3])};
                *(LAS v2u*)(CH + RC_RP + i16 * 144 + ch * 2) = (v2u){cvtpk(rp[0], rp[1]), cvtpk(rp[2], rp[3])};
                *(LAS v2u*)(CH + RC_VR + i16 * 144 + ch * 2) = cv[c2];
            }
        }
        __syncthreads();
        {
            f32x4 d0 = (f32x4){0.f, 0.f, 0.f, 0.f}, d1 = (f32x4){0.f, 0.f, 0.f, 0.f};
            const int xoff = ph ? RC_KP : RC_RP, y0off = ph ? RC_BP : RC_KT, y1off = ph ? RC_KT : RC_BP;
#pragma unroll
            for (int ks = 0; ks < 2; ++ks) {
                const bf16x8 xf = *(const LAS bf16x8*)(CH + xoff + i16 * 144 + ks * 64 + g * 16);
                const bf16x8 y0 = *(const LAS bf16x8*)(CH + y0off + i16 * 144 + ks * 64 + g * 16), y1 = *(const LAS bf16x8*)(CH + y1off + i16 * 144 + ks * 64 + g * 16);
                d0 = MFMA16(xf, y0, d0); d1 = MFMA16(xf, y1, d1);
            }
#pragma unroll
            for (int q = 0; q < 4; ++q) { const int i = 4 * g + q, j = i16;
                if (ph) { *(LAS float*)(CH + RC_LBF + (i * 16 + j) * 4) = (j < i) ? -d0[q] : 0.f; *(LAS bf16*)(CH + RC_LK + i * 40 + j * 2) = (bf16)(cvtpk((j < i) ? d1[q] : 0.f, 0.f) & 0xffffu); }
                else { const unsigned pk_ = cvtpk((j <= i) ? d0[q] : 0.f, (j <= i) ? d1[q] : 0.f); *(LAS bf16*)(CH + RC_ARK + i * 40 + j * 2) = (bf16)(pk_ & 0xffffu); *(LAS bf16*)(CH + RC_NARB + i * 40 + j * 2) = (bf16)(pk_ >> 16); }
            }
            if (ph) {
                float x[16];
#pragma unroll
                for (int i = 0; i < 16; ++i) { float s = (i == i16) ? 1.f : 0.f;
#pragma unroll
                    for (int j4 = 0; j4 < (i + 3) / 4; ++j4) { const f32x4 lr = *(const LAS f32x4*)(CH + RC_LBF + (i * 16 + j4 * 4) * 4);
#pragma unroll
                        for (int jj = 0; jj < 4; ++jj) { const int j = j4 * 4 + jj; if (j < i) s -= lr[jj] * x[j]; } }
                    x[i] = s; }
                if (g == 0) {
#pragma unroll
                    for (int i = 0; i < 16; i += 2) { const unsigned pk_ = cvtpk(x[i], x[i + 1]); *(LAS bf16*)(CH + RC_TM + i * 40 + i16 * 2) = (bf16)(pk_ & 0xffffu); *(LAS bf16*)(CH + RC_TM + (i + 1) * 40 + i16 * 2) = (bf16)(pk_ >> 16); } }
            }
        }
        __syncthreads();
        if (wave < 4) {
            const int vt = wave;
#pragma unroll 1
            for (int c = 0; c < 4; ++c) {
                const LAS unsigned char* C = lds + RW_CH0 + c * RW_CHB;
                v4u sb01, sb23;
                sb01.x = cvtpk(ST[0][0], ST[0][1]); sb01.y = cvtpk(ST[0][2], ST[0][3]); sb01.z = cvtpk(ST[1][0], ST[1][1]); sb01.w = cvtpk(ST[1][2], ST[1][3]);
                sb23.x = cvtpk(ST[2][0], ST[2][1]); sb23.y = cvtpk(ST[2][2], ST[2][3]); sb23.z = cvtpk(ST[3][0], ST[3][1]); sb23.w = cvtpk(ST[3][2], ST[3][3]);
                const bf16x8 s01 = __builtin_bit_cast(bf16x8, sb01), s23 = __builtin_bit_cast(bf16x8, sb23);
                const v2u kp0a = *(const LAS v2u*)(C + RC_KP + i16 * 144 + (4 * g) * 2), kp0b = *(const LAS v2u*)(C + RC_KP + i16 * 144 + (16 + 4 * g) * 2);
                const v2u kp1a = *(const LAS v2u*)(C + RC_KP + i16 * 144 + (32 + 4 * g) * 2), kp1b = *(const LAS v2u*)(C + RC_KP + i16 * 144 + (48 + 4 * g) * 2);
                const v2u rp0a = *(const LAS v2u*)(C + RC_RP + i16 * 144 + (4 * g) * 2), rp0b = *(const LAS v2u*)(C + RC_RP + i16 * 144 + (16 + 4 * g) * 2);
                const v2u rp1a = *(const LAS v2u*)(C + RC_RP + i16 * 144 + (32 + 4 * g) * 2), rp1b = *(const LAS v2u*)(C + RC_RP + i16 * 144 + (48 + 4 * g) * 2);
                const v2u lk = *(const LAS v2u*)(C + RC_LK + i16 * 40 + g * 8), tm = *(const LAS v2u*)(C + RC_TM + i16 * 40 + g * 8);
                const v2u ark = *(const LAS v2u*)(C + RC_ARK + i16 * 40 + g * 8), narb = *(const LAS v2u*)(C + RC_NARB + i16 * 40 + g * 8);
                const int trq = (i16 >> 2) & 3, trp = i16 & 3;
                const v2u vf = __builtin_bit_cast(v2u, __builtin_amdgcn_ds_read_tr16_b64_v4i16((LAS s16x4_t*)(C + RC_VR + (4 * g + trq) * 144 + (16 * vt + 4 * trp) * 2)));
                const v4u z4 = {0u, 0u, 0u, 0u};
                f32x4 rhs = (f32x4){0.f, 0.f, 0.f, 0.f};
                rhs = MFMA16(__builtin_bit_cast(bf16x8, ((v4u){kp0a.x, kp0a.y, kp0b.x, kp0b.y})), s01, rhs);
                rhs = MFMA16(__builtin_bit_cast(bf16x8, ((v4u){kp1a.x, kp1a.y, kp1b.x, kp1b.y})), s23, rhs);
                rhs = MFMA16(__builtin_bit_cast(bf16x8, ((v4u){lk.x, lk.y, 0u, 0u})), __builtin_bit_cast(bf16x8, ((v4u){vf.x, vf.y, 0u, 0u})), rhs);
                f32x4 z = MFMA16(__builtin_bit_cast(bf16x8, ((v4u){tm.x, tm.y, 0u, 0u})), __builtin_bit_cast(bf16x8, ((v4u){cvtpk(rhs[0], rhs[1]), cvtpk(rhs[2], rhs[3]), 0u, 0u})), ((f32x4){0.f, 0.f, 0.f, 0.f}));
                const bf16x8 vz = __builtin_bit_cast(bf16x8, ((v4u){vf.x, vf.y, cvtpk(z[0], z[1]), cvtpk(z[2], z[3])}));
                f32x4 y = (f32x4){0.f, 0.f, 0.f, 0.f};
                y = MFMA16(__builtin_bit_cast(bf16x8, ((v4u){rp0a.x, rp0a.y, rp0b.x, rp0b.y})), s01, y);
                y = MFMA16(__builtin_bit_cast(bf16x8, ((v4u){rp1a.x, rp1a.y, rp1b.x, rp1b.y})), s23, y);
                y = MFMA16(__builtin_bit_cast(bf16x8, ((v4u){ark.x, ark.y, narb.x, narb.y})), vz, y);
#pragma unroll
                for (int kt = 0; kt < 4; ++kt) {
                    const v2u ktf = __builtin_bit_cast(v2u, __builtin_amdgcn_ds_read_tr16_b64_v4i16((LAS s16x4_t*)(C + RC_KT + (4 * g + trq) * 144 + (16 * kt + 4 * trp) * 2)));
                    const v2u nbf = __builtin_bit_cast(v2u, __builtin_amdgcn_ds_read_tr16_b64_v4i16((LAS s16x4_t*)(C + RC_BP + (4 * g + trq) * 144 + (16 * kt + 4 * trp) * 2)));
                    const f32x4 g15 = *(const LAS f32x4*)(C + RC_G15 + (16 * kt + 4 * g) * 4);
                    ST[kt] = MFMA16(__builtin_bit_cast(bf16x8, ((v4u){ktf.x, ktf.y, nbf.x, nbf.y})), vz, ST[kt]);
                    ST[kt] = ST[kt] * g15;
                }
                { const unsigned y01 = cvtpk(y[0], y[1]), y23 = cvtpk(y[2], y[3]); LAS unsigned char* yb = lds + RW_YB + (c * 16 + 4 * g) * 144 + (16 * vt + i16) * 2;
                  *(LAS bf16*)(yb) = (bf16)(y01 & 0xffffu); *(LAS bf16*)(yb + 144) = (bf16)(y01 >> 16); *(LAS bf16*)(yb + 288) = (bf16)(y23 & 0xffffu); *(LAS bf16*)(yb + 432) = (bf16)(y23 >> 16); }
                (void)z4;
            }
        } else if (sc + 1 < nsc) {
            const int r0 = (tid - 256) >> 3;
#pragma unroll
            for (int hrow = 0; hrow < 2; ++hrow) { const int tokr = r0 + 32 * hrow, step_ = (sc + 1) * 64 + tokr, t_ = e ? L - 1 - step_ : step_;
                const bf16* gp_ = G1 + (size_t)(tok0 + t_) * G1W + C_LORA + e * 64 + st_c8;
                const v4u hw_ = *(const v4u*)gp_, ha_ = *(const v4u*)(gp_ + 128); v4u th_;
                th_.x = cvtpk(tanh_fast(bflo(hw_.x)), tanh_fast(bfhi(hw_.x))); th_.y = cvtpk(tanh_fast(bflo(hw_.y)), tanh_fast(bfhi(hw_.y))); th_.z = cvtpk(tanh_fast(bflo(hw_.z)), tanh_fast(bfhi(hw_.z))); th_.w = cvtpk(tanh_fast(bflo(hw_.w)), tanh_fast(bfhi(hw_.w)));
                *(LAS v4u*)(lds + RW_TH + tokr * 144 + st_c8 * 2) = th_; *(LAS v4u*)(lds + RW_HA + tokr * 144 + st_c8 * 2) = ha_; }
        }
        __syncthreads();
        {
            const int row = tid >> 3, part = tid & 7, step = sc * 64 + row, t = e ? L - 1 - step : step;
            *(v4u*)(YS + ((size_t)e * T + tok0 + t) * 256 + hh * 64 + part * 8) = *(const LAS v4u*)(lds + RW_YB + row * 144 + part * 16);
        }
    }
#undef RW_STAGE
#undef RW_PREFETCH
    if (!lat && wave < 4) {
        const int v = 16 * wave + i16;
#pragma unroll
        for (int kt = 0; kt < 4; ++kt) *(f32x4*)(a->out + O_RW + (((size_t)((b * 2 + layer) * 2 + e) * 4 + hh) * 64 + v) * 64 + 16 * kt + 4 * g) = ST[kt];
    }
}

constexpr int LR_WAT = 0, LR_XCB = 18432, LR_XCF = 27648, LR_AA = 44032, LR_BV = 60416, LR_HH = 76800, LR_SP = 93184, LR_SH = 95232, LR_HC = 97280;
__device__ __forceinline__ void lru_unit_mfma(ArgsP a, LAS unsigned char* lds, int layer, int u) {
    const int tid = tid_(), lane = tid & 63, wave = tid >> 6, i16 = lane & 15, g4 = lane >> 4;
    const int lat = u < 32, uu = lat ? u : u - 32, b = uu >> 2, g = uu & 3;
    const int L = lat ? L_LAT : L_CTX, tok0 = lat ? T_CTX + b * L_LAT : b * L_CTX;
    const bf16* G1 = (const bf16*)(a->ws + WS_G1);
    bf16* HF = (bf16*)(a->ws + WS_HF);
    LAS float* XCF = (LAS float*)(lds + LR_XCF); LAS float* AA = (LAS float*)(lds + LR_AA); LAS float* BV = (LAS float*)(lds + LR_BV); LAS float* HH = (LAS float*)(lds + LR_HH);
    LAS float* SP = (LAS float*)(lds + LR_SP); LAS float* SH = (LAS float*)(lds + LR_SH); LAS float* HC = (LAS float*)(lds + LR_HC);
    const int tt = tid >> 3, q8 = (tid & 7) * 8;
    float cw[4][8], cb[8];
#pragma unroll
    for (int i = 0; i < 8; ++i) { const int ch = g * 64 + q8 + i; cb[i] = a->in[I_CONVB][layer * 256 + ch];
#pragma unroll
        for (int j = 0; j < 4; ++j) cw[j][i] = a->in[I_CONVW][(layer * 4 + j) * 256 + ch]; }
    const int ot = wave & 3, tp = wave >> 2;
    const int sch = tid & 63, seg = tid >> 6;
    for (int e = 0; e < 2; ++e) {
        __syncthreads();
        for (int i = tid; i < 4096; i += NTHREADS) { const size_t src = ((size_t)((layer * 2 + e) * 4 + g)) * 4096 + i; const int ii = i >> 6, oo = i & 63;
            *(LAS bf16*)(lds + LR_WAT + (oo * 72 + ii) * 2) = (bf16)f2bf(a->in[I_WA][src]); *(LAS bf16*)(lds + LR_WAT + 9216 + (oo * 72 + ii) * 2) = (bf16)f2bf(a->in[I_WX][src]); }
        if (tid < 64) HC[tid] = lat ? a->in[I_SLRU][((size_t)(b * 2 + layer) * 2 + e) * 256 + g * 64 + tid] : 0.f;
        f32x4 bav, bxv, spl;
        { const int chb = (layer * 2 + e) * 256 + g * 64 + 16 * ot + 4 * g4;
          bav = *(const f32x4*)(a->in[I_BA] + chb); bxv = *(const f32x4*)(a->in[I_BX] + chb); const f32x4 lam = *(const f32x4*)(a->in[I_LAMBDA] + chb);
#pragma unroll
          for (int q = 0; q < 4; ++q) spl[q] = log1pf(exp_(-lam[q])); }
        __syncthreads();
        v4u xr[4], hfr, glr;
#define LR_PREFETCH(cc_) do { const int c_ = e ? L / 64 - 1 - (cc_) : (cc_), t_ = c_ * 64 + tt; \
            _Pragma("unroll") for (int j = 0; j < 4; ++j) { const int ts = t_ + j - 2; xr[j] = (ts >= 0 && ts < L) ? *(const v4u*)(G1 + (size_t)(tok0 + ts) * G1W + C_XL + g * 64 + q8) : (v4u){0u, 0u, 0u, 0u}; } \
            if (e) { hfr = *(const v4u*)(HF + (size_t)(tok0 + t_) * 256 + g * 64 + q8); glr = *(const v4u*)(G1 + (size_t)(tok0 + t_) * G1W + C_GL + g * 64 + q8); } } while (0)
        LR_PREFETCH(0);
        for (int cc = 0; cc < L / 64; ++cc) {
            const int c = e ? L / 64 - 1 - cc : cc, t = c * 64 + tt, n = tok0 + t;
            const v4u xcur[4] = {xr[0], xr[1], xr[2], xr[3]}; const v4u hfc = hfr, glc = glr;
            if (cc + 1 < L / 64) LR_PREFETCH(cc + 1);
            {
                float xc[8];
#pragma unroll
                for (int i = 0; i < 8; ++i) xc[i] = cb[i];
#pragma unroll
                for (int j = 0; j < 4; ++j) {
                    { const v4u x = xcur[j];
                        xc[0] += cw[j][0] * bflo(x.x); xc[1] += cw[j][1] * bfhi(x.x); xc[2] += cw[j][2] * bflo(x.y); xc[3] += cw[j][3] * bfhi(x.y);
                        xc[4] += cw[j][4] * bflo(x.z); xc[5] += cw[j][5] * bfhi(x.z); xc[6] += cw[j][6] * bflo(x.w); xc[7] += cw[j][7] * bfhi(x.w); } }
                *(LAS f32x4*)(XCF + tt * 64 + q8) = (f32x4){xc[0], xc[1], xc[2], xc[3]}; *(LAS f32x4*)(XCF + tt * 64 + q8 + 4) = (f32x4){xc[4], xc[5], xc[6], xc[7]};
                *(LAS v4u*)(lds + LR_XCB + tt * 144 + q8 * 2) = (v4u){cvtpk(xc[0], xc[1]), cvtpk(xc[2], xc[3]), cvtpk(xc[4], xc[5]), cvtpk(xc[6], xc[7])};
            }
            __syncthreads();
            {
#pragma unroll
                for (int t2 = 0; t2 < 2; ++t2) { const int tk = (2 * tp + t2) * 16 + i16;
                    f32x4 ga = (f32x4){0.f, 0.f, 0.f, 0.f}, gx = (f32x4){0.f, 0.f, 0.f, 0.f};
#pragma unroll
                    for (int ks = 0; ks < 2; ++ks) { const bf16x8 xf = *(const LAS bf16x8*)(lds + LR_XCB + tk * 144 + ks * 64 + g4 * 16);
                        const bf16x8 wa = *(const LAS bf16x8*)(lds + LR_WAT + (16 * ot + i16) * 144 + ks * 64 + g4 * 16), wx = *(const LAS bf16x8*)(lds + LR_WAT + 9216 + (16 * ot + i16) * 144 + ks * 64 + g4 * 16);
                        ga = MFMA16(wa, xf, ga); gx = MFMA16(wx, xf, gx); }
                    const f32x4 xcv = *(const LAS f32x4*)(XCF + tk * 64 + 16 * ot + 4 * g4);
                    f32x4 av, bv;
#pragma unroll
                    for (int q = 0; q < 4; ++q) { const float la = -8.f * sigmoidf_(ga[q] + bav[q]) * spl[q]; av[q] = exp_(la); bv[q] = sqrt_(1.f - exp_(2.f * la)) * sigmoidf_(gx[q] + bxv[q]) * xcv[q]; }
                    *(LAS f32x4*)(AA + tk * 64 + 16 * ot + 4 * g4) = av; *(LAS f32x4*)(BV + tk * 64 + 16 * ot + 4 * g4) = bv; }
            }
            __syncthreads();
            float av8[8], bv8[8];
            {
                float P = 1.f, H = 0.f;
#pragma unroll
                for (int s = 0; s < 8; ++s) { const int p = seg * 8 + s, st = e ? 63 - p : p; av8[s] = AA[st * 64 + sch]; bv8[s] = BV[st * 64 + sch]; H = fmaf(av8[s], H, bv8[s]); P *= av8[s]; }
                SP[seg * 64 + sch] = P; SH[seg * 64 + sch] = H;
            }
            __syncthreads();
            {
                float h = HC[sch];
                for (int s2 = 0; s2 < seg; ++s2) h = fmaf(SP[s2 * 64 + sch], h, SH[s2 * 64 + sch]);
#pragma unroll
                for (int s = 0; s < 8; ++s) { const int p = seg * 8 + s, st = e ? 63 - p : p; h = fmaf(av8[s], h, bv8[s]); HH[st * 64 + sch] = h; }
                __syncthreads();
                if (seg == 7) HC[sch] = h;
            }
            __syncthreads();
            {
                bf16* dst = HF + (size_t)n * 256 + g * 64 + q8;
                float o[8];
#pragma unroll
                for (int i = 0; i < 8; ++i) o[i] = HH[tt * 64 + q8 + i];
                if (e) { const v4u hf = hfc, gl = glc;
                    o[0] = (o[0] + bflo(hf.x)) * siluf_(bflo(gl.x)); o[1] = (o[1] + bfhi(hf.x)) * siluf_(bfhi(gl.x)); o[2] = (o[2] + bflo(hf.y)) * siluf_(bflo(gl.y)); o[3] = (o[3] + bfhi(hf.y)) * siluf_(bfhi(gl.y));
                    o[4] = (o[4] + bflo(hf.z)) * siluf_(bflo(gl.z)); o[5] = (o[5] + bfhi(hf.z)) * siluf_(bfhi(gl.z)); o[6] = (o[6] + bflo(hf.w)) * siluf_(bflo(gl.w)); o[7] = (o[7] + bfhi(hf.w)) * siluf_(bfhi(gl.w)); }
                *(v4u*)dst = (v4u){cvtpk(o[0], o[1]), cvtpk(o[2], o[3]), cvtpk(o[4], o[5]), cvtpk(o[6], o[7])};
            }
        }
#undef LR_PREFETCH
        __syncthreads();
        if (tid < 64 && !lat) a->out[O_LRU + ((size_t)(b * 2 + layer) * 2 + e) * 256 + g * 64 + tid] = HC[tid];
    }
}

constexpr int LQ_NQ = 32;
constexpr int LQ_WAT = 0, LQ_S0 = 2 * LQ_NQ * 144;
constexpr int LS_XCB = 0, LS_XCQ = 9216, LS_AA = LS_XCQ + 64 * LQ_NQ * 4, LS_BV = LS_AA + 64 * LQ_NQ * 4, LS_HH = LS_BV + 64 * LQ_NQ * 4,
              LS_SP = LS_HH + 64 * LQ_NQ * 4, LS_SH = LS_SP + 8 * LQ_NQ * 4, LS_HC = LS_SH + 8 * LQ_NQ * 4, LS_BYTES = LS_HC + 2 * LQ_NQ * 4;
__device__ __forceinline__ void lru_unit_q(ArgsP a, LAS unsigned char* lds, int layer, int u) {
    const int tid = tid_(), lane = tid & 63, wave = tid >> 6, i16 = lane & 15, g4 = lane >> 4;
    const int lat = u < 32, uu = lat ? u : u - 32, bp = uu >> 3, g = (uu >> 1) & 3, oq = uu & 1;
    const int L = lat ? L_LAT : L_CTX;
    const int tokb[2] = {lat ? T_CTX + (2 * bp) * L_LAT : (2 * bp) * L_CTX, lat ? T_CTX + (2 * bp + 1) * L_LAT : (2 * bp + 1) * L_CTX};
    const bf16* G1 = (const bf16*)(a->ws + WS_G1);
    bf16* HF = (bf16*)(a->ws + WS_HF);
    const int tt = tid >> 3, q8 = (tid & 7) * 8;
    float cw[4][8], cb[8];
#pragma unroll
    for (int i = 0; i < 8; ++i) { const int ch = g * 64 + q8 + i; cb[i] = a->in[I_CONVB][layer * 256 + ch];
#pragma unroll
        for (int j = 0; j < 4; ++j) cw[j][i] = a->in[I_CONVW][(layer * 4 + j) * 256 + ch]; }
    const int gt = wave & 3, got = wave >> 2;
    const int ssn = tid >> 8, sch = tid & (LQ_NQ - 1), seg = (tid >> 5) & 7;
    const int otok = tid >> 3, oc4 = (tid & 7) * 4;
    const int chq = g * 64 + oq * LQ_NQ;
    LAS unsigned char* SS = lds + LQ_S0 + ssn * LS_BYTES;
    for (int e = 0; e < 2; ++e) {
        __syncthreads();
        { const int m = tid >> 8, row = (tid >> 3) & 31, c8 = (tid & 7) * 8;
          const bf16* wsrc = (const bf16*)(a->ws + WS_LRUW) + ((size_t)(((layer * 2 + e) * 2 + m) * 4 + g) * 64 + oq * LQ_NQ + row) * 64 + c8;
          *(LAS v4u*)(lds + LQ_WAT + m * LQ_NQ * 144 + row * 144 + c8 * 2) = *(const v4u*)wsrc; }
        if (tid < 2 * LQ_NQ) { const int s = tid >> 5, c = tid & 31; ((LAS float*)(lds + LQ_S0 + s * LS_BYTES + LS_HC))[c] = lat ? a->in[I_SLRU][((size_t)((2 * bp + s) * 2 + layer) * 2 + e) * 256 + chq + c] : 0.f; }
        f32x4 bav, bxv, spl;
        { const int chb = (layer * 2 + e) * 256 + chq + 16 * got + 4 * g4;
          bav = *(const f32x4*)(a->in[I_BA] + chb); bxv = *(const f32x4*)(a->in[I_BX] + chb); const f32x4 lam = *(const f32x4*)(a->in[I_LAMBDA] + chb);
#pragma unroll
          for (int q = 0; q < 4; ++q) spl[q] = log1pf(exp_(-lam[q])); }
        v4u xr[2][4]; v2u hfr[2], glr[2];
#define LQ_PREFETCH(cc_) do { const int c_ = e ? L / 64 - 1 - (cc_) : (cc_), t_ = c_ * 64 + tt; \
            _Pragma("unroll") for (int s = 0; s < 2; ++s) { \
              _Pragma("unroll") for (int j = 0; j < 4; ++j) { const int ts = t_ + j - 2; xr[s][j] = (ts >= 0 && ts < L) ? *(const v4u*)(G1 + (size_t)(tokb[s] + ts) * G1W + C_XL + g * 64 + q8) : (v4u){0u, 0u, 0u, 0u}; } \
              if (e) { const int to_ = c_ * 64 + otok; hfr[s] = *(const v2u*)(HF + (size_t)(tokb[s] + to_) * 256 + chq + oc4); glr[s] = *(const v2u*)(G1 + (size_t)(tokb[s] + to_) * G1W + C_GL + chq + oc4); } } } while (0)
        LQ_PREFETCH(0);
        __syncthreads();
        for (int cc = 0; cc < L / 64; ++cc) {
            const int c = e ? L / 64 - 1 - cc : cc;
            v4u xcur[2][4]; v2u hfc[2], glc[2];
#pragma unroll
            for (int s = 0; s < 2; ++s) { xcur[s][0] = xr[s][0]; xcur[s][1] = xr[s][1]; xcur[s][2] = xr[s][2]; xcur[s][3] = xr[s][3]; hfc[s] = hfr[s]; glc[s] = glr[s]; }
            if (cc + 1 < L / 64) LQ_PREFETCH(cc + 1);
#pragma unroll
            for (int s = 0; s < 2; ++s) {
                LAS unsigned char* SB = lds + LQ_S0 + s * LS_BYTES;
                float xc[8];
#pragma unroll
                for (int i = 0; i < 8; ++i) xc[i] = cb[i];
#pragma unroll
                for (int j = 0; j < 4; ++j) { const v4u x = xcur[s][j];
                    xc[0] += cw[j][0] * bflo(x.x); xc[1] += cw[j][1] * bfhi(x.x); xc[2] += cw[j][2] * bflo(x.y); xc[3] += cw[j][3] * bfhi(x.y);
                    xc[4] += cw[j][4] * bflo(x.z); xc[5] += cw[j][5] * bfhi(x.z); xc[6] += cw[j][6] * bflo(x.w); xc[7] += cw[j][7] * bfhi(x.w); }
                *(LAS v4u*)(SB + LS_XCB + tt * 144 + q8 * 2) = (v4u){cvtpk(xc[0], xc[1]), cvtpk(xc[2], xc[3]), cvtpk(xc[4], xc[5]), cvtpk(xc[6], xc[7])};
                if ((q8 / LQ_NQ) == oq) { LAS float* XCQ = (LAS float*)(SB + LS_XCQ); *(LAS f32x4*)(XCQ + tt * LQ_NQ + (q8 % LQ_NQ)) = (f32x4){xc[0], xc[1], xc[2], xc[3]}; *(LAS f32x4*)(XCQ + tt * LQ_NQ + (q8 % LQ_NQ) + 4) = (f32x4){xc[4], xc[5], xc[6], xc[7]}; }
            }
            __syncthreads();
#pragma unroll
            for (int s = 0; s < 2; ++s) {
                LAS unsigned char* SB = lds + LQ_S0 + s * LS_BYTES;
                const int tk = gt * 16 + i16;
                f32x4 ga = (f32x4){0.f, 0.f, 0.f, 0.f}, gx = (f32x4){0.f, 0.f, 0.f, 0.f};
#pragma unroll
                for (int ks = 0; ks < 2; ++ks) { const bf16x8 xf = *(const LAS bf16x8*)(SB + LS_XCB + tk * 144 + ks * 64 + g4 * 16);
                    const bf16x8 wa = *(const LAS bf16x8*)(lds + LQ_WAT + (16 * got + i16) * 144 + ks * 64 + g4 * 16), wx = *(const LAS bf16x8*)(lds + LQ_WAT + LQ_NQ * 144 + (16 * got + i16) * 144 + ks * 64 + g4 * 16);
                    ga = MFMA16(wa, xf, ga); gx = MFMA16(wx, xf, gx); }
                const f32x4 xcv = *(const LAS f32x4*)((LAS float*)(SB + LS_XCQ) + tk * LQ_NQ + 16 * got + 4 * g4);
                f32x4 av, bv;
#pragma unroll
                for (int q = 0; q < 4; ++q) { const float la = -8.f * sigmoidf_(ga[q] + bav[q]) * spl[q], aq = exp_(la); av[q] = aq; bv[q] = sqrt_((1.f - aq) * (1.f + aq)) * sigmoidf_(gx[q] + bxv[q]) * xcv[q]; }
                *(LAS f32x4*)((LAS float*)(SB + LS_AA) + tk * LQ_NQ + 16 * got + 4 * g4) = av; *(LAS f32x4*)((LAS float*)(SB + LS_BV) + tk * LQ_NQ + 16 * got + 4 * g4) = bv;
            }
            __syncthreads();
            LAS float* AA = (LAS float*)(SS + LS_AA); LAS float* BV = (LAS float*)(SS + LS_BV); LAS float* HH = (LAS float*)(SS + LS_HH);
            LAS float* SP = (LAS float*)(SS + LS_SP); LAS float* SH = (LAS float*)(SS + LS_SH); LAS float* HC = (LAS float*)(SS + LS_HC);
            float av8[8], bv8[8];
            {
                float P = 1.f, H = 0.f;
#pragma unroll
                for (int s = 0; s < 8; ++s) { const int p = seg * 8 + s, st = e ? 63 - p : p; av8[s] = AA[st * LQ_NQ + sch]; bv8[s] = BV[st * LQ_NQ + sch]; H = fmaf(av8[s], H, bv8[s]); P *= av8[s]; }
                SP[seg * LQ_NQ + sch] = P; SH[seg * LQ_NQ + sch] = H;
            }
            __syncthreads();
            {
                float h = HC[(cc & 1) * LQ_NQ + sch];
                for (int s2 = 0; s2 < seg; ++s2) h = fmaf(SP[s2 * LQ_NQ + sch], h, SH[s2 * LQ_NQ + sch]);
#pragma unroll
                for (int s = 0; s < 8; ++s) { const int p = seg * 8 + s, st = e ? 63 - p : p; h = fmaf(av8[s], h, bv8[s]); HH[st * LQ_NQ + sch] = h; }
                if (seg == 7) HC[((cc + 1) & 1) * LQ_NQ + sch] = h;
            }
            __syncthreads();
#pragma unroll
            for (int s = 0; s < 2; ++s) {
                const int n = tokb[s] + c * 64 + otok;
                const f32x4 hv = *(const LAS f32x4*)((LAS float*)(lds + LQ_S0 + s * LS_BYTES + LS_HH) + otok * LQ_NQ + oc4);
                float o0 = hv[0], o1 = hv[1], o2 = hv[2], o3 = hv[3];
                if (e) { o0 = (o0 + bflo(hfc[s].x)) * siluf_(bflo(glc[s].x)); o1 = (o1 + bfhi(hfc[s].x)) * siluf_(bfhi(glc[s].x)); o2 = (o2 + bflo(hfc[s].y)) * siluf_(bflo(glc[s].y)); o3 = (o3 + bfhi(hfc[s].y)) * siluf_(bfhi(glc[s].y)); }
                *(v2u*)(HF + (size_t)n * 256 + chq + oc4) = (v2u){cvtpk(o0, o1), cvtpk(o2, o3)};
            }
        }
#undef LQ_PREFETCH
        __syncthreads();
        if (tid < 2 * LQ_NQ && !lat) { const int s = tid >> 5, c = tid & 31; a->out[O_LRU + ((size_t)((2 * bp + s) * 2 + layer) * 2 + e) * 256 + chq + c] = ((LAS float*)(lds + LQ_S0 + s * LS_BYTES + LS_HC))[((L / 64) & 1) * LQ_NQ + c]; }
    }
}

constexpr int ATT2_VSTR = 144, ATT2_STAGE = 64 * ATT_KSTR + 64 * ATT2_VSTR;
#define ATT_KLOAD(KB_) \
        bf16x8 kfa_[6], kfb_[6]; \
        _Pragma("unroll") for (int ks_ = 0; ks_ < 6; ++ks_) { kfa_[ks_] = *(const LAS bf16x8*)((KB_) + r * ATT_KSTR + ks_ * 32 + hq * 16); kfb_[ks_] = *(const LAS bf16x8*)((KB_) + (32 + r) * ATT_KSTR + ks_ * 32 + hq * 16); }
#define ATT_VLOAD(VB_) \
        v2u va0_[4], va1_[4], vb0_[4], vb1_[4]; \
        _Pragma("unroll") for (int ks_ = 0; ks_ < 4; ++ks_) { \
            const LAS unsigned char* vp_ = (VB_) + (ks_ * 16 + 4 * hq + ((lane >> 2) & 3)) * ATT2_VSTR + (16 * ((lane >> 4) & 1) + 4 * (lane & 3)) * 2; \
            va0_[ks_] = __builtin_bit_cast(v2u, __builtin_amdgcn_ds_read_tr16_b64_v4i16((LAS s16x4_t*)(vp_))); \
            va1_[ks_] = __builtin_bit_cast(v2u, __builtin_amdgcn_ds_read_tr16_b64_v4i16((LAS s16x4_t*)(vp_ + 8 * ATT2_VSTR))); \
            vb0_[ks_] = __builtin_bit_cast(v2u, __builtin_amdgcn_ds_read_tr16_b64_v4i16((LAS s16x4_t*)(vp_ + 64))); \
            vb1_[ks_] = __builtin_bit_cast(v2u, __builtin_amdgcn_ds_read_tr16_b64_v4i16((LAS s16x4_t*)(vp_ + 8 * ATT2_VSTR + 64))); }
#define ATT_QKM(S0_, S1_) do { \
        _Pragma("unroll") for (int i_ = 0; i_ < 16; ++i_) { S0_[i_] = 0.f; S1_[i_] = 0.f; } \
        _Pragma("unroll") for (int ks_ = 0; ks_ < 6; ++ks_) { S0_ = MFMA32(kfa_[ks_], qf[ks_], S0_); S1_ = MFMA32(kfb_[ks_], qf[ks_], S1_); } } while (0)
#define ATT_STEP(SC0_, SC1_, SN0_, SN1_, KB_, VB_, HAVE_NEXT_) do { \
        ATT_KLOAD(KB_) \
        float mx_ = SC0_[0]; \
        _Pragma("unroll") for (int i_ = 1; i_ < 16; ++i_) mx_ = fmaxf(mx_, SC0_[i_]); \
        _Pragma("unroll") for (int i_ = 0; i_ < 16; ++i_) mx_ = fmaxf(mx_, SC1_[i_]); \
        mx_ = fmaxf(mx_, __shfl_xor(mx_, 32)); \
        if (!__all(mx_ - m <= 8.f)) { const float mn_ = fmaxf(m, mx_), al_ = __builtin_amdgcn_exp2f(m - mn_); m = mn_; l *= al_; \
            _Pragma("unroll") for (int i_ = 0; i_ < 16; ++i_) { o0[i_] *= al_; o1[i_] *= al_; } } \
        if (HAVE_NEXT_) ATT_QKM(SN0_, SN1_); \
        ATT_VLOAD(VB_) \
        float ps_ = 0.f; \
        _Pragma("unroll") for (int i_ = 0; i_ < 16; ++i_) { SC0_[i_] = __builtin_amdgcn_exp2f(SC0_[i_] - m); SC1_[i_] = __builtin_amdgcn_exp2f(SC1_[i_] - m); ps_ += SC0_[i_] + SC1_[i_]; } \
        l += ps_; \
        _Pragma("unroll") for (int ks_ = 0; ks_ < 4; ++ks_) { \
            v4u pw_; \
            if (ks_ == 0) { pw_.x = cvtpk(SC0_[0], SC0_[1]); pw_.y = cvtpk(SC0_[2], SC0_[3]); pw_.z = cvtpk(SC0_[4], SC0_[5]); pw_.w = cvtpk(SC0_[6], SC0_[7]); } \
            else if (ks_ == 1) { pw_.x = cvtpk(SC0_[8], SC0_[9]); pw_.y = cvtpk(SC0_[10], SC0_[11]); pw_.z = cvtpk(SC0_[12], SC0_[13]); pw_.w = cvtpk(SC0_[14], SC0_[15]); } \
            else if (ks_ == 2) { pw_.x = cvtpk(SC1_[0], SC1_[1]); pw_.y = cvtpk(SC1_[2], SC1_[3]); pw_.z = cvtpk(SC1_[4], SC1_[5]); pw_.w = cvtpk(SC1_[6], SC1_[7]); } \
            else { pw_.x = cvtpk(SC1_[8], SC1_[9]); pw_.y = cvtpk(SC1_[10], SC1_[11]); pw_.z = cvtpk(SC1_[12], SC1_[13]); pw_.w = cvtpk(SC1_[14], SC1_[15]); } \
            const bf16x8 pf_ = __builtin_bit_cast(bf16x8, pw_); \
            const v4u vwa_ = {va0_[ks_].x, va0_[ks_].y, va1_[ks_].x, va1_[ks_].y}, vwb_ = {vb0_[ks_].x, vb0_[ks_].y, vb1_[ks_].x, vb1_[ks_].y}; \
            o0 = MFMA32(__builtin_bit_cast(bf16x8, vwa_), pf_, o0); o1 = MFMA32(__builtin_bit_cast(bf16x8, vwb_), pf_, o1); } } while (0)
__device__ __forceinline__ void att_unit2(ArgsP a, LAS unsigned char* lds, int u) {
    const int tid = tid_(), lane = tid & 63, wave = tid >> 6, r = lane & 31, hq = lane >> 5;
    const bf16* KN = (const bf16*)(a->ws + WS_KN); const bf16* KR = (const bf16*)(a->ws + WS_KR); const bf16* VT = (const bf16*)(a->ws + WS_VT);
    bf16* Q = (bf16*)(a->ws + WS_Q); const bf16* G1 = (const bf16*)(a->ws + WS_G1);
    int b, h, n0, Lk, kidx0; size_t vbase;
    if (u < 512) { b = u >> 6; h = (u >> 3) & 7; n0 = T_CTX + b * 2048 + (u & 7) * 256; Lk = LK_LAT; kidx0 = T_CTX + b * LK_LAT; vbase = (size_t)VT_LAT + (size_t)(b * 8 + h) * 64 * LK_LAT; }
    else { const int uu = u - 512; b = uu >> 3; h = uu & 7; n0 = b * 256; Lk = 256; kidx0 = b * 256; vbase = (size_t)(b * 8 + h) * 64 * 256; }
    const int ntiles = Lk >> 6;
    const int n = n0 + wave * 32 + r;
    bf16x8 qf[6];
#pragma unroll
    for (int ks = 0; ks < 6; ++ks) qf[ks] = *(const bf16x8*)(Q + (size_t)n * 768 + h * 96 + ks * 16 + 8 * hq);
    const int key_k = tid >> 3, ck = tid & 7, key_r = (tid >> 2) & 63, cr = tid & 3;
    const bf16* gk = KN + (size_t)(kidx0 + key_k) * 512 + h * 64 + ck * 8;
    const bf16* gr = KR + (size_t)(kidx0 + key_r) * 32 + cr * 8;
    const bf16* gv = VT + (size_t)(kidx0 + key_k) * 512 + h * 64 + ck * 8;
    const unsigned sk = key_k * ATT_KSTR + ck * 16, sr = key_r * ATT_KSTR + 128 + cr * 16, sv = ATT_VOFF + key_k * ATT2_VSTR + ck * 16;
    v4u rkA, rrA = {0u, 0u, 0u, 0u}, rvA, rkB, rrB = {0u, 0u, 0u, 0u}, rvB;
#define ATT_LOAD(X_, j_) do { rk##X_ = *(const v4u*)(gk + (size_t)(j_) * 64 * 512); if (tid < 256) rr##X_ = *(const v4u*)(gr + (size_t)(j_) * 64 * 32); rv##X_ = *(const v4u*)(gv + (size_t)(j_) * 64 * 512); } while (0)
#define ATT_STORE(X_, B_) do { LAS unsigned char* nb_ = lds + (B_) * ATT2_STAGE; *(LAS v4u*)(nb_ + sk) = rk##X_; if (tid < 256) *(LAS v4u*)(nb_ + sr) = rr##X_; \
        *(LAS v4u*)(nb_ + sv) = rv##X_; } while (0)
    ATT_LOAD(A, 0); ATT_LOAD(B, 1);
    __syncthreads();
    ATT_STORE(A, 0);
    ATT_STORE(B, 1);
    ATT_LOAD(A, 2);
    __syncthreads();
    f32x16 o0, o1, sa0, sa1, sb0, sb1;
#pragma unroll
    for (int i = 0; i < 16; ++i) { o0[i] = 0.f; o1[i] = 0.f; }
    float m = -1e30f, l = 0.f;
    { ATT_KLOAD(lds) ATT_QKM(sa0, sa1); }
    int bcur = 0;
    int j = 0;
    for (; j < ntiles - 2; j += 2) {
        {
            const int b1 = bcur == 2 ? 0 : bcur + 1, b2 = b1 == 2 ? 0 : b1 + 1;
            ATT_LOAD(B, j + 3);
            ATT_STEP(sa0, sa1, sb0, sb1, lds + b1 * ATT2_STAGE, lds + bcur * ATT2_STAGE + ATT_VOFF, true);
            ATT_STORE(A, b2);
            __syncthreads();
            bcur = b1;
        }
        {
            const int b1 = bcur == 2 ? 0 : bcur + 1, b2 = b1 == 2 ? 0 : b1 + 1;
            if (j + 4 < ntiles) ATT_LOAD(A, j + 4);
            ATT_STEP(sb0, sb1, sa0, sa1, lds + b1 * ATT2_STAGE, lds + bcur * ATT2_STAGE + ATT_VOFF, true);
            ATT_STORE(B, b2);
            __syncthreads();
            bcur = b1;
        }
    }
    {
        { const int b1 = bcur == 2 ? 0 : bcur + 1;
          ATT_STEP(sa0, sa1, sb0, sb1, lds + b1 * ATT2_STAGE, lds + bcur * ATT2_STAGE + ATT_VOFF, true);
          bcur = b1; }
        { ATT_STEP(sb0, sb1, sa0, sa1, lds + bcur * ATT2_STAGE, lds + bcur * ATT2_STAGE + ATT_VOFF, false); }
        __syncthreads();
    }
#undef ATT_LOAD
#undef ATT_STORE
    v2u gmv[2][4];
#pragma unroll
    for (int mt = 0; mt < 2; ++mt)
#pragma unroll
        for (int g = 0; g < 4; ++g) gmv[mt][g] = *(const v2u*)(G1 + (size_t)n * G1W + C_GM + h * 64 + 32 * mt + 8 * g + 4 * hq);
    l += __shfl_xor(l, 32);
    const float inv = rcp_(l);
#pragma unroll
    for (int mt = 0; mt < 2; ++mt)
#pragma unroll
        for (int g = 0; g < 4; ++g) {
            const int dv0 = 32 * mt + 8 * g + 4 * hq;
            const v2u gm = gmv[mt][g];
            const float x0 = (mt ? o1[4 * g + 0] : o0[4 * g + 0]) * inv, x1 = (mt ? o1[4 * g + 1] : o0[4 * g + 1]) * inv, x2 = (mt ? o1[4 * g + 2] : o0[4 * g + 2]) * inv, x3 = (mt ? o1[4 * g + 3] : o0[4 * g + 3]) * inv;
            v2u ov; ov.x = cvtpk(x0 * siluf_(bflo(gm.x)), x1 * siluf_(bfhi(gm.x))); ov.y = cvtpk(x2 * siluf_(bflo(gm.y)), x3 * siluf_(bfhi(gm.y)));
            *(v2u*)(Q + (size_t)n * 768 + h * 96 + dv0) = ov;
        }
}
constexpr int N_PHASES = 14;
#ifndef MK_PER_PHASE
#define MK_PER_PHASE 0
#endif
#ifndef VAR_GEMM
#define VAR_GEMM 1
#endif
#ifndef VAR_A2
#define VAR_A2 1
#endif
#ifndef VAR_ATT
#define VAR_ATT 1
#endif
#ifndef VAR_RWKV
#define VAR_RWKV 1
#endif
#ifndef VAR_LRU
#define VAR_LRU 1
#endif

__device__ __forceinline__ void phase_b(ArgsP a, LAS unsigned char* lds, int layer) {
    volatile LAS unsigned* MISC = (volatile LAS unsigned*)(lds + LDS_MISC);
    unsigned* head = (unsigned*)(a->ws + WS_CTL) + CW_Q + layer * 64;
    for (;;) {
        __syncthreads();
        if (tid_() == 0) MISC[16] = atomicAdd(head, 1u);
        __syncthreads();
        const int idx = (int)MISC[16];
        if (idx >= 1248) break;
#ifdef PROBE_UNIT1
        const unsigned long long pt0_ = __builtin_amdgcn_s_memrealtime();
#endif
        if (idx < 64) rwkv_unit_mfma(a, lds, layer, idx);
        else if (idx < 96) lru_unit_q(a, lds, layer, idx - 64);
        else if (idx < 608) att_unit2(a, lds, idx - 96);
        else if (idx < 864) rwkv_unit_mfma(a, lds, layer, 64 + idx - 608);
        else if (idx < 992) lru_unit_q(a, lds, layer, 32 + idx - 864);
        else att_unit2(a, lds, 512 + idx - 992);
#ifdef PROBE_UNIT1
        if (tid_() == 0 && layer == 0) { const unsigned d_ = (unsigned)(__builtin_amdgcn_s_memrealtime() - pt0_);
            const int ty_ = idx < 64 ? 0 : idx < 96 ? 1 : idx < 608 ? 2 : idx < 864 ? 3 : idx < 992 ? 4 : 5;
            atomicMax((unsigned*)(a->ws + WS_CTL) + CW_Q + 1024 + ty_ * 64, d_); }
#endif
    }
}

#if MK_PER_PHASE
template <int SUB> __global__ void __launch_bounds__(NTHREADS, 2) mk_phase(Args args, int layer) {
    extern __shared__ __attribute__((aligned(16))) unsigned char lds_raw[];
    LAS unsigned char* lds = (LAS unsigned char*)lds_raw;
    ArgsP a = (ArgsP)__builtin_amdgcn_kernarg_segment_ptr();
    if (SUB == 0) phase_p0(a, lds);
    if (SUB == 1) phase_a0(a, layer);
    if (SUB == 2) { if (VAR_GEMM) phase_a1_pg8(a, lds, layer); else phase_a1_naive(a, layer); }
    if (SUB == 3) { if (VAR_A2) { for (int u = blockIdx.x; u < T / 64 + 32; u += gridDim.x) a2_unit(a, lds, layer, u); } else phase_a2_naive(a, lds, layer); }
    if (SUB == 4) { if (VAR_ATT) { for (int u = blockIdx.x; u < 768; u += gridDim.x) att_unit(a, lds, u); } else phase_att_naive(a); }
    if (SUB == 5) { for (int u = blockIdx.x; u < 320; u += gridDim.x) { __syncthreads(); if (VAR_RWKV) rwkv_unit_mfma(a, lds, layer, u); else rwkv_unit_seq(a, lds, layer, u); } }
    if (SUB == 6) { for (int u = blockIdx.x; u < 160; u += gridDim.x) { __syncthreads(); if (VAR_LRU) lru_unit_mfma(a, lds, layer, u); else lru_unit_seq(a, lds, layer, u); } }
    if (SUB == 7) phase_c1(a, layer);
    if (SUB == 8) { if (VAR_GEMM) phase_c2_pg8(a, lds, layer); else phase_c2_naive(a, layer); }
    if (SUB == 9) phase_final(a);
}
#else
#define ARGS_VIEW() ({ ArgsP p_ = (ArgsP)__builtin_amdgcn_kernarg_segment_ptr(); asm volatile("" : "+s"(p_)); p_; })
__global__ void __launch_bounds__(NTHREADS, 2) mk_fwd(Args args) {
    extern __shared__ __attribute__((aligned(16))) unsigned char lds_raw[];
    LAS unsigned char* lds = (LAS unsigned char*)lds_raw;
    volatile LAS unsigned* MISC = (volatile LAS unsigned*)(lds + LDS_MISC);
    for (int u = threadIdx.x; u < 64; u += NTHREADS) MISC[u] = 0u;
    __syncthreads();
    XcdBarrier bar;
    { ArgsP a = ARGS_VIEW(); bar = xcd_barrier_post((unsigned*)(a->ws + WS_CTL) + CW_BAR, MISC + 8); }
    int lo, hi; { ArgsP a = ARGS_VIEW(); lo = a->ph_lo; hi = a->ph_hi; }
#define IN(k) (lo <= (k) && (k) < hi)
#ifdef PROBE_MASK1
#define STAMP(k) do { if (bid_() == 0 && tid_() == 0) { const unsigned long long t_ = __builtin_amdgcn_s_memrealtime(); MISC[32 + 2 * (k)] = (unsigned)t_; MISC[33 + 2 * (k)] = (unsigned)(t_ >> 32); } } while (0)
#else
#define STAMP(k) do { } while (0)
#endif
#define SEAM(k) do { if (IN(k) && IN((k) + 1)) xcd_barrier(bar); STAMP((k) + 1); } while (0)
#ifndef NO_P0
    STAMP(0);
    if (IN(0)) { ArgsP a = ARGS_VIEW(); phase_p0(a, lds); }
#endif
    SEAM(0);
    for (int layer = 0; layer < 2; ++layer) {
        const int p = 1 + 6 * layer;
#ifndef NO_A0
        if (IN(p + 0)) { { ArgsP a = ARGS_VIEW(); phase_a0(a, layer); } if (layer == 0) { ArgsP a = ARGS_VIEW(); phase_p0_weights(a, lds); } }
#endif
        SEAM(p + 0);
#ifndef NO_A1
        if (IN(p + 1)) { ArgsP a = ARGS_VIEW(); phase_a1_pg8(a, lds, layer); }
#endif
        SEAM(p + 1);
#ifndef NO_A2
        if (IN(p + 2)) { { ArgsP a = ARGS_VIEW(); phase_a2a(a, layer); } xcd_barrier(bar); { ArgsP a = ARGS_VIEW(); phase_a2b(a, lds, layer); } }
        if (0) { ArgsP a = ARGS_VIEW(); for (int u = bid_(); u < T / 64 + 32; u += grid_()) {
#ifdef PROBE_UNIT1
            const unsigned long long pt0_ = __builtin_amdgcn_s_memrealtime();
#endif
            a2_unit(a, lds, layer, u);
#ifdef PROBE_A2_TWICE
            a2_unit(a, lds, layer, u);
#endif
#ifdef PROBE_UNIT1
            __syncthreads();
            if (tid_() == 0 && layer == 0) atomicMax((unsigned*)(a->ws + WS_CTL) + CW_Q + 1024 + (u < 256 ? 6 : 7) * 64, (unsigned)(__builtin_amdgcn_s_memrealtime() - pt0_));
#endif
        } }
#endif
        SEAM(p + 2);
#ifndef NO_B
        if (IN(p + 3)) { ArgsP a = ARGS_VIEW(); phase_b(a, lds, layer); }
#endif
        SEAM(p + 3);
#ifndef NO_C1
        if (IN(p + 4)) { ArgsP a = ARGS_VIEW(); phase_c1(a, layer); }
#endif
        SEAM(p + 4);
#ifndef NO_C2
        if (IN(p + 5)) { ArgsP a = ARGS_VIEW(); phase_c2_pg8(a, lds, layer); }
#endif
        SEAM(p + 5);
    }
    if (IN(N_PHASES - 1)) { ArgsP a = ARGS_VIEW(); phase_final(a); }
#ifdef PROBE_MASK1
    STAMP(14);
    __syncthreads();
    if (bid_() == 0) {
        ArgsP a = ARGS_VIEW();
        float t1 = 0.f, t2 = 0.f;
        for (int k = 0; k < 14; ++k) { const unsigned long long s0 = ((unsigned long long)MISC[33 + 2 * k] << 32) | MISC[32 + 2 * k], s1 = ((unsigned long long)MISC[35 + 2 * k] << 32) | MISC[34 + 2 * k];
            const float us = (float)(s1 - s0) * 0.01f; if ((PROBE_MASK1 >> k) & 1) t1 += us; if ((PROBE_MASK2 >> k) & 1) t2 += us; }
#ifdef PROBE_UNIT1
        t1 = (float)((unsigned*)(a->ws + WS_CTL))[CW_Q + 1024 + PROBE_UNIT1 * 64] * 0.01f; t2 = (float)((unsigned*)(a->ws + WS_CTL))[CW_Q + 1024 + PROBE_UNIT2 * 64] * 0.01f;
#endif
        for (int i = tid_(); i < 32768; i += NTHREADS) a->out[O_LRU + i] *= (1.f + t2 * (1.f / 2000.f));
        if (tid_() == 0) a->out[0] += 2.f + t1 * 0.01f;
    }
#endif
#undef IN
#undef SEAM
}

#endif

extern "C" void kernel_launch(void* const* d_in, const int* in_sizes, int n_in, void* d_out, int out_size, void* d_ws, size_t ws_size, hipStream_t stream) {
    static int grid = 0;
    if (grid == 0) {
        if (n_in != N_IN || ws_size < WS_END) { fprintf(stderr, "kernel_launch: unexpected n_in %d / ws_size %zu\n", n_in, ws_size); grid = -1; return; }
        int dev = 0, cus = 0;
        if (hipGetDevice(&dev) != hipSuccess || hipDeviceGetAttribute(&cus, hipDeviceAttributeMultiprocessorCount, dev) != hipSuccess) { grid = -1; return; }
#if MK_PER_PHASE
#define SA(SUB) if (hipFuncSetAttribute((const void*)mk_phase<SUB>, hipFuncAttributeMaxDynamicSharedMemorySize, LDS_BYTES) != hipSuccess) { fprintf(stderr, "kernel_launch: hipFuncSetAttribute failed\n"); grid = -1; return; }
        SA(0) SA(1) SA(2) SA(3) SA(4) SA(5) SA(6) SA(7) SA(8) SA(9)
#undef SA
#else
        if (hipFuncSetAttribute((const void*)mk_fwd, hipFuncAttributeMaxDynamicSharedMemorySize, LDS_BYTES) != hipSuccess) { fprintf(stderr, "kernel_launch: hipFuncSetAttribute failed\n"); grid = -1; return; }
        int per_cu = 0;
        if (hipOccupancyMaxActiveBlocksPerMultiprocessor(&per_cu, (const void*)mk_fwd, NTHREADS, LDS_BYTES) != hipSuccess || per_cu < 1) fprintf(stderr, "kernel_launch: occupancy query reports %d\n", per_cu);
        (void)hipGetLastError();
#endif
        grid = cus;
    }
    if (grid < 0) return;
    if (hipMemsetAsync((char*)d_ws + WS_CTL, 0, CTL_ZERO_BYTES, stream) != hipSuccess) return;
    Args a{};
    for (int i = 0; i < N_IN; ++i) a.in[i] = (const float*)d_in[i];
    a.out = (float*)d_out; a.ws = (unsigned char*)d_ws;
#if MK_PER_PHASE
#define LP(SUB, layer) hipLaunchKernelGGL(mk_phase<SUB>, dim3(grid), dim3(NTHREADS), LDS_BYTES, stream, a, layer)
    LP(0, 0);
    for (int layer = 0; layer < 2; ++layer) { LP(1, layer); LP(2, layer); LP(3, layer); LP(4, layer); LP(5, layer); LP(6, layer); LP(7, layer); LP(8, layer); }
    LP(9, 0);
#undef LP
#else
    a.ph_lo = 0; a.ph_hi = N_PHASES;
    hipLaunchKernelGGL(mk_fwd, dim3(grid), dim3(NTHREADS), LDS_BYTES, stream, a);
#endif
}
```

```cpp
#define MK_PER_PHASE 0
#include <hip/hip_runtime.h>
#include <cstdio>
#include <cstdint>

#define GAS __attribute__((address_space(1)))
#define LAS __attribute__((address_space(3)))
typedef unsigned short bf16;
typedef unsigned v4u __attribute__((ext_vector_type(4)));
typedef unsigned v2u __attribute__((ext_vector_type(2)));
typedef float f32x4 __attribute__((ext_vector_type(4)));
typedef short bf16x8 __attribute__((ext_vector_type(8)));

constexpr int D = 1024, T_CTX = 8192, T_LAT = 16384, T = 24576, L_CTX = 256, L_LAT = 2048, PAST = 256;
constexpr int NIN = 2816, G1W = 2304, G2W = 512;
constexpr int C_R = 0, C_K = 256, C_V = 512, C_G = 768, C_GM = 1024, C_XL = 1536, C_GL = 1792, C_LORA = 2048;
constexpr int LK_LAT = PAST + L_LAT;
constexpr int TK = T_CTX + 8 * LK_LAT;
constexpr int VT_LAT = 32 * 8 * 64 * 256;
constexpr float LN_EPS = 1e-5f, GN_EPS = 64e-5f;
constexpr float ALPHA = 1.4142135623730951f;
constexpr float QSCALE = 0.10206207261596575f * 1.4426950408889634f;
constexpr size_t O_Y = 0, O_RW = 25165824, O_CKV = 27262976, O_KR = 29360128, O_LRU = 29884416;
constexpr size_t MiB = 1u << 20;
constexpr size_t WS_CTL = 0, CTL_ZERO_BYTES = 1 * MiB;
constexpr size_t WS_MOD = 256 * 1024;
constexpr size_t WS_ROPE = 1 * MiB;
constexpr size_t WS_LORA2 = 1280 * 1024;
constexpr size_t WS_LRUW = 2816 * 1024;
constexpr size_t WS_STATS = 1536 * 1024;
constexpr size_t WS_WUQ = 2 * MiB;
constexpr size_t WS_WUKV = 3 * MiB;
constexpr size_t WS_WIN = 4 * MiB;
constexpr size_t WS_WOUT = 16 * MiB;
constexpr size_t WS_G1 = 20 * MiB;
constexpr size_t WS_G2 = 128 * MiB;
constexpr size_t WS_Q = 152 * MiB;
constexpr size_t WS_U = 152 * MiB;
constexpr size_t WS_KN = 188 * MiB;
constexpr size_t WS_KR = 214 * MiB;
constexpr size_t WS_VT = 216 * MiB;
constexpr size_t WS_YMIX = 188 * MiB;
constexpr size_t WS_HF = 242 * MiB;
constexpr size_t WS_END = 254 * MiB;
constexpr int CW_BAR = 4096;
constexpr int CW_Q = 16384;

__device__ __forceinline__ float bf2f(unsigned b) { return __uint_as_float(b << 16); }
__device__ __forceinline__ float bflo(unsigned w) { return __uint_as_float(w << 16); }
__device__ __forceinline__ float bfhi(unsigned w) { return __uint_as_float(w & 0xffff0000u); }
__device__ __forceinline__ unsigned f2bf(float f) { unsigned u = __float_as_uint(f); return (u + 0x7fffu + ((u >> 16) & 1u)) >> 16; }
__device__ __forceinline__ unsigned pk2(float lo, float hi) { return f2bf(lo) | (f2bf(hi) << 16); }
__device__ __forceinline__ float rcp_(float x) { return __builtin_amdgcn_rcpf(x); }
__device__ __forceinline__ float exp_(float x) { return __builtin_amdgcn_exp2f(x * 1.4426950408889634f); }
__device__ __forceinline__ float sqrt_(float x) { return __builtin_amdgcn_sqrtf(x); }
__device__ __forceinline__ float rsqrt_(float x) { return __builtin_amdgcn_rsqf(x); }
__device__ __forceinline__ float sigmoidf_(float x) { return rcp_(1.f + exp_(-x)); }
__device__ __forceinline__ float siluf_(float x) { return x * rcp_(1.f + exp_(-x)); }
template <int CTRL> __device__ __forceinline__ float dpp_f(float old, float x) { return __builtin_bit_cast(float, __builtin_amdgcn_update_dpp(__builtin_bit_cast(int, old), __builtin_bit_cast(int, x), CTRL, 0xf, 0xf, false)); }
__device__ __forceinline__ float row16_sum(float x) { x += dpp_f<0x128>(0.f, x); x += dpp_f<0x124>(0.f, x); x += dpp_f<0x122>(0.f, x); x += dpp_f<0x121>(0.f, x); return x; }
__device__ __forceinline__ float wave_sum_fast(float x) { x = row16_sum(x); x += __shfl_xor(x, 16); x += __shfl_xor(x, 32); return x; }
__device__ __forceinline__ float row16_prefix_prod(float x) { x *= dpp_f<0x111>(1.f, x); x *= dpp_f<0x112>(1.f, x); x *= dpp_f<0x114>(1.f, x); x *= dpp_f<0x118>(1.f, x); return x; }
__device__ __forceinline__ float wave_sum(float v) { return wave_sum_fast(v); }
__device__ __forceinline__ int tid_() { int t = threadIdx.x; asm volatile("" : "+v"(t)); return t; }
__device__ __forceinline__ int bid_() { int b = blockIdx.x; asm volatile("" : "+s"(b)); return b; }
__device__ __forceinline__ int grid_() { int g = gridDim.x; asm volatile("" : "+s"(g)); return g; }
typedef float f32x16 __attribute__((ext_vector_type(16)));
typedef float f32x2_t __attribute__((ext_vector_type(2)));
typedef __bf16 bf16x2_t __attribute__((ext_vector_type(2)));
__device__ __forceinline__ unsigned cvtpk(float lo, float hi) { const f32x2_t v = {lo, hi}; return __builtin_bit_cast(unsigned, __builtin_convertvector(v, bf16x2_t)); }
#define XB_TMO      128
#define XB_XCNT(j)  (256  + 64 * (j))
#define XB_XSUB(j)  (1280 + 64 * (j))
#define XB_XGEN(j)  (2304 + 64 * (j))
#define XB_TOP      3328
#define XB_TOPGEN   3392
#define XCD_BAR_WORDS 3456
#define XB_SPIN_CAP (1u << 24)

__device__ __forceinline__ unsigned xb_ld(unsigned* p)              { return __hip_atomic_load(p, __ATOMIC_RELAXED, __HIP_MEMORY_SCOPE_AGENT); }
__device__ __forceinline__ unsigned xb_add(unsigned* p, unsigned v) { return __hip_atomic_fetch_add(p, v, __ATOMIC_RELAXED, __HIP_MEMORY_SCOPE_AGENT); }
__device__ __forceinline__ unsigned xb_xcc_id() { return (unsigned)__builtin_amdgcn_s_getreg((3 << 11) | 20) & 0xFu; }
#define XB_SPIN(cond, bar) do { unsigned _sp = 0; while (cond) { __builtin_amdgcn_s_sleep(1); \
    if ((++_sp & 255u) == 0u) { if (xb_ld(&(bar)[XB_TMO])) break; if (_sp > XB_SPIN_CAP) { atomicAdd(&(bar)[XB_TMO], 1u); break; } } } } while (0)

struct XcdBarrier {
    unsigned* bar; unsigned x;
    volatile LAS unsigned* st;
};

__device__ __forceinline__ XcdBarrier xcd_barrier_post(unsigned* bar, volatile LAS unsigned* st) {
    XcdBarrier b; b.bar = bar; b.x = xb_xcc_id(); b.st = st;
    if (threadIdx.x == 0) (void)xb_add(&bar[XB_XCNT(b.x)], 1u);
    return b;
}
__device__ __forceinline__ void xcd_barrier_complete(unsigned* bar, unsigned x, unsigned& nloc, unsigned& nx) {
    const unsigned G = gridDim.x * gridDim.y * gridDim.z;
    unsigned sum, cnt, mine, sp = 0u;
    for (;;) {
        sum = 0u; cnt = 0u; mine = 0u;
#pragma unroll
        for (unsigned j = 0; j < 16; ++j) { const unsigned c = xb_ld(&bar[XB_XCNT(j)]); sum += c; cnt += (c > 0u) ? 1u : 0u; mine = (j == x) ? c : mine; }
        if (sum == G) break;
        __builtin_amdgcn_s_sleep(1);
        if ((++sp & 255u) == 0u) { if (xb_ld(&bar[XB_TMO])) break; if (sp > XB_SPIN_CAP) { atomicAdd(&bar[XB_TMO], 1u); break; } }
    }
    nloc = mine > 0u ? mine : 1u; nx = cnt > 0u ? cnt : 1u;
}

__device__ __forceinline__ void xcd_barrier(const XcdBarrier& b) {
    asm volatile("s_waitcnt vmcnt(0)" ::: "memory");
    __syncthreads();
    if (threadIdx.x == 0) {
        unsigned* bar = b.bar;
        __builtin_amdgcn_s_waitcnt(0);
        unsigned nloc = b.st[0], nx = b.st[1];
        if (nloc == 0u) { xcd_barrier_complete(bar, b.x, nloc, nx); b.st[0] = nloc; b.st[1] = nx; }
        const unsigned old = xb_add(&bar[XB_XSUB(b.x)], 1u);
        const unsigned gen = old / nloc;
        if (old + 1u == (gen + 1u) * nloc) {
            __builtin_amdgcn_fence(__ATOMIC_RELEASE, "agent");
            asm volatile("s_waitcnt vmcnt(0)" ::: "memory");
            const unsigned og = xb_add(&bar[XB_TOP], 1u);
            const unsigned tg = og / nx;
            if (og + 1u == (tg + 1u) * nx) xb_add(&bar[XB_TOPGEN], 1u);
            else XB_SPIN(xb_ld(&bar[XB_TOPGEN]) == tg, bar);
            __builtin_amdgcn_fence(__ATOMIC_ACQUIRE, "agent");
            xb_add(&bar[XB_XGEN(b.x)], 1u);
            asm volatile("s_waitcnt vmcnt(0)" ::: "memory");
        } else {
            XB_SPIN(xb_ld(&bar[XB_XGEN(b.x)]) == gen, bar);
            __builtin_amdgcn_fence(__ATOMIC_ACQUIRE, "agent");
            asm volatile("s_waitcnt vmcnt(0)" ::: "memory");
        }
    }
    __syncthreads();
}
enum { I_XP = 0, I_XS, I_SRW, I_CCKV, I_CKR, I_SLRU, I_C, I_CCTX, I_WMOD, I_BMOD, I_WIN, I_W0, I_W1, I_W2, I_A0, I_A1, I_A2, I_KK, I_KA, I_RK,
       I_LNXG, I_LNXB, I_QNORM, I_WUQ, I_KVNORM, I_WUKV, I_CONVW, I_CONVB, I_WA, I_BA, I_WX, I_BX, I_LAMBDA, I_WOUT, I_LNG, I_LNB, N_IN };
struct Args { const float* in[N_IN]; float* out; unsigned char* ws; int ph_lo, ph_hi; };
typedef const Args __attribute__((address_space(4)))* ArgsP;
constexpr int NTHREADS = 512;
constexpr int LDS_MISC = 139264;
constexpr int LDS_BYTES = 147456;

struct Tok { int n, b, t, L, lat, modrow, tok0, kidx; };
__device__ __forceinline__ Tok tok_of(int n) {
    Tok k; k.n = n;
    if (n < T_CTX) { k.lat = 0; k.b = n >> 8; k.t = n & 255; k.L = L_CTX; k.modrow = 0; k.tok0 = k.b * 256; k.kidx = n; }
    else { const int m = n - T_CTX; k.lat = 1; k.b = m >> 11; k.t = m & 2047; k.L = L_LAT; k.modrow = 1 + k.b; k.tok0 = T_CTX + k.b * 2048; k.kidx = T_CTX + k.b * LK_LAT + PAST + k.t; }
    return k;
}
__device__ __forceinline__ const float* xrow_src(ArgsP a, int layer, int n) {
    if (layer == 0) return n < T_CTX ? a->in[I_XP] + (size_t)n * D : a->in[I_XS] + (size_t)(n - T_CTX) * D;
    return a->out + (size_t)n * D;
}
__device__ __forceinline__ float dot8(v4u a, v4u b, float acc) {
    acc = fmaf(bflo(a.x), bflo(b.x), acc); acc = fmaf(bfhi(a.x), bfhi(b.x), acc);
    acc = fmaf(bflo(a.y), bflo(b.y), acc); acc = fmaf(bfhi(a.y), bfhi(b.y), acc);
    acc = fmaf(bflo(a.z), bflo(b.z), acc); acc = fmaf(bfhi(a.z), bfhi(b.z), acc);
    acc = fmaf(bflo(a.w), bflo(b.w), acc); acc = fmaf(bfhi(a.w), bfhi(b.w), acc);
    return acc;
}

__device__ __forceinline__ void tr_item(const float* src, int ld, int col0, int k0, bf16* WT, int K, int row0, float scale, LAS float* scr, int lane) {
    {
        const int kr = lane >> 3, n4 = (lane & 7) * 4;
        f32x4 v[8];
#pragma unroll
        for (int i = 0; i < 8; ++i) v[i] = src ? *(const f32x4*)(src + (size_t)(k0 + i * 8 + kr) * ld + col0 + n4) : (f32x4){0.f, 0.f, 0.f, 0.f};
#pragma unroll
        for (int i = 0; i < 8; ++i) { LAS float* d = scr + (i * 8 + kr) * 33 + n4; d[0] = v[i].x * scale; d[1] = v[i].y * scale; d[2] = v[i].z * scale; d[3] = v[i].w * scale; }
    }
    asm volatile("s_waitcnt lgkmcnt(0)" ::: "memory");
    const int c = lane & 7;
#pragma unroll
    for (int j = 0; j < 4; ++j) { const int n = (lane >> 3) + 8 * j; const LAS float* s = scr + (8 * c) * 33 + n;
        v4u o; o.x = pk2(s[0 * 33], s[1 * 33]); o.y = pk2(s[2 * 33], s[3 * 33]); o.z = pk2(s[4 * 33], s[5 * 33]); o.w = pk2(s[6 * 33], s[7 * 33]);
        *(v4u*)(WT + (size_t)(row0 + n) * K + k0 + 8 * c) = o; }
    asm volatile("s_waitcnt lgkmcnt(0)" ::: "memory");
}
__device__ __forceinline__ void rope_angle(int t, int i, float& c, float& s) {
    const int row = t >> 6, col = t & 63; const int ii = i & 7;
    const float inv = exp2f(-(float)ii * (13.287712379549449f / 8.f));
    const float ang = (float)(i < 8 ? row : col) * inv;
    c = cosf(ang); s = sinf(ang);
}
__device__ __forceinline__ void phase_p0_weights(ArgsP a, LAS unsigned char* lds) {
    const int tid = tid_(), lane = tid & 63, wave = tid >> 6, G = grid_();
    unsigned char* ws = a->ws;
    LAS float* scr = (LAS float*)(lds + wave * 8704);
    const int gw = bid_() * 8 + wave, NGW = G * 8;
    constexpr int N_WIN = 2 * 16 * 88, N_WOUT = 2 * 16 * 32, N_WUQ = 2 * 4 * 24, N_WUKV = 2 * 4 * 32, N_LORA = 2 * 2 * 2 * 8, N_LRUW = 2 * 2 * 2 * 4 * 2;
    for (int it = gw; it < N_WIN + N_WOUT + N_WUQ + N_WUKV + N_LORA + N_LRUW; it += NGW) {
        int r = it;
        if (r < N_WIN) {
            const int l = r / (16 * 88), kb = (r / 88) % 16, nb = r % 88, j0 = nb * 32;
            const float* src; int ld, col0;
            const float* win = a->in[I_WIN] + (size_t)l * 1024 * 2464;
            if (j0 < 1024) { src = win; ld = 2464; col0 = j0; }
            else if (j0 < 1536) { src = win; ld = 2464; col0 = 1440 + (j0 - 1024); }
            else if (j0 < 1792) { src = win; ld = 2464; col0 = 1952 + (j0 - 1536); }
            else if (j0 < 2048) { src = win; ld = 2464; col0 = 2208 + (j0 - 1792); }
            else if (j0 < 2304) { const int q = (j0 - 2048) >> 6; src = (q < 2 ? a->in[I_W1] : a->in[I_A1]) + (size_t)(l * 2 + (q & 1)) * 1024 * 64; ld = 64; col0 = (j0 - 2048) & 63; }
            else if (j0 < 2560) { src = win; ld = 2464; col0 = 1024 + (j0 - 2304); }
            else if (j0 < 2688) { src = win; ld = 2464; col0 = 1280 + (j0 - 2560); }
            else if (j0 < 2720) { src = win; ld = 2464; col0 = 1408 + (j0 - 2688); }
            else { src = nullptr; ld = 0; col0 = 0; }
            tr_item(src, ld, col0, kb * 64, (bf16*)(ws + WS_WIN) + (size_t)l * NIN * 1024, 1024, j0, 1.f, scr, lane);
            continue;
        }
        r -= N_WIN;
        if (r < N_WOUT) { const int l = r / (16 * 32), kb = (r / 32) % 16, nb = r % 32;
            tr_item(a->in[I_WOUT] + (size_t)l * 1024 * 1024, 1024, nb * 32, kb * 64, (bf16*)(ws + WS_WOUT) + (size_t)l * 1024 * 1024, 1024, nb * 32, 1.f, scr, lane); continue; }
        r -= N_WOUT;
        if (r < N_WUQ) { const int l = r / (4 * 24), kb = (r / 24) % 4, nb = r % 24;
            tr_item(a->in[I_WUQ] + (size_t)l * 256 * 768, 768, nb * 32, kb * 64, (bf16*)(ws + WS_WUQ) + (size_t)l * 768 * 256, 256, nb * 32, QSCALE, scr, lane); continue; }
        r -= N_WUQ;
        if (r >= N_WUKV) { r -= N_WUKV;
            if (r < N_LORA) { const int le = r >> 4, m = (r >> 3) & 1, nb = r & 7;
                tr_item((m ? a->in[I_A2] : a->in[I_W2]) + (size_t)le * 64 * 256, 256, nb * 32, 0, (bf16*)(ws + WS_LORA2) + (size_t)(le * 2 + m) * 256 * 64, 64, nb * 32, 1.f, scr, lane); }
            else { r -= N_LORA; const int le = r >> 4, m = (r >> 3) & 1, g = (r >> 1) & 3, nb = r & 1;
                tr_item((m ? a->in[I_WX] : a->in[I_WA]) + (size_t)(le * 4 + g) * 4096, 64, nb * 32, 0, (bf16*)(ws + WS_LRUW) + (size_t)((le * 2 + m) * 4 + g) * 4096, 64, nb * 32, 1.f, scr, lane); }
            continue; }
        { const int l = r / (4 * 32), kb = (r / 32) % 4, nb = r % 32;
            tr_item(kb < 2 ? a->in[I_WUKV] + (size_t)l * 128 * 1024 : nullptr, 1024, nb * 32, kb * 64, (bf16*)(ws + WS_WUKV) + (size_t)l * 1024 * 256, 256, nb * 32, 1.f, scr, lane); }
    }
}
__device__ __forceinline__ void phase_p0(ArgsP a, LAS unsigned char* lds) {
    const int tid = tid_(), G = grid_();
    unsigned char* ws = a->ws;
    { float* ROPE = (float*)(ws + WS_ROPE);
      for (int i = bid_() * NTHREADS + tid; i < 2048 * 16; i += G * NTHREADS) { float c, s; rope_angle(i >> 4, i & 15, c, s); ROPE[i * 2] = c; ROPE[i * 2 + 1] = s; } }
    float* MOD = (float*)(ws + WS_MOD);
    LAS float* SIL = (LAS float*)lds;
    for (int it = bid_(); it < 2 * 6 * 32; it += G) {
        const int l = it / 192, nb = (it / 32) % 6, kq = it % 32, col = nb * 512 + tid;
        __syncthreads();
        if (tid < 288) { const int j = tid >> 5, k = kq * 32 + (tid & 31); const float cj = (j == 0) ? a->in[I_CCTX][k] : a->in[I_C][(j - 1) * 1024 + k]; SIL[tid] = siluf_(cj); }
        float w[32];
#pragma unroll
        for (int kk = 0; kk < 32; ++kk) w[kk] = a->in[I_WMOD][((size_t)l * 1024 + kq * 32 + kk) * 3072 + col];
        __syncthreads();
        const float bias = (kq == 0) ? a->in[I_BMOD][l * 3072 + col] : 0.f;
#pragma unroll
        for (int j = 0; j < 9; ++j) { float acc = bias;
#pragma unroll
            for (int k4 = 0; k4 < 8; ++k4) { const f32x4 sv = *(const LAS f32x4*)(SIL + j * 32 + k4 * 4); acc = fmaf(sv.x, w[k4 * 4], acc); acc = fmaf(sv.y, w[k4 * 4 + 1], acc); acc = fmaf(sv.z, w[k4 * 4 + 2], acc); acc = fmaf(sv.w, w[k4 * 4 + 3], acc); }
            atomicAdd(&MOD[(l * 9 + j) * 3072 + col], acc); }
    }
}

__device__ __forceinline__ void phase_a0(ArgsP a, int layer) {
    const int tid = tid_(), lane = tid & 63, wave = tid >> 6, G = grid_();
    const float* MOD = (const float*)(a->ws + WS_MOD);
    bf16* U = (bf16*)(a->ws + WS_U);
    f32x4 nx[4];
#define A0_LOAD(nn_) do { if (layer == 0) { const float* xr_ = xrow_src(a, 0, (nn_)); \
            _Pragma("unroll") for (int j = 0; j < 4; ++j) nx[j] = *(const f32x4*)(xr_ + lane * 4 + 256 * j); } \
        else { const bf16* zr_ = (const bf16*)a->out + (size_t)(nn_) * 2048; \
            _Pragma("unroll") for (int j = 0; j < 4; ++j) { const v2u w_ = *(const v2u*)(zr_ + lane * 4 + 256 * j); nx[j] = (f32x4){bflo(w_.x), bfhi(w_.x), bflo(w_.y), bfhi(w_.y)}; } } } while (0)
    { const int n0 = bid_() * 8 + wave; if (n0 < T) A0_LOAD(n0); }
    for (int n = bid_() * 8 + wave; n < T; n += G * 8) {
        const Tok tk = tok_of(n);
        f32x4 v[4]; float s = 0.f;
#pragma unroll
        for (int j = 0; j < 4; ++j) { v[j] = nx[j]; s += (v[j].x + v[j].y) + (v[j].z + v[j].w); }
        if (n + G * 8 < T) A0_LOAD(n + G * 8);
        float mean = wave_sum(s) * (1.f / D), s2 = 0.f;
#pragma unroll
        for (int j = 0; j < 4; ++j) { v[j] = v[j] - mean; s2 += (v[j].x * v[j].x + v[j].y * v[j].y) + (v[j].z * v[j].z + v[j].w * v[j].w); }
        float rstd = rsqrt_(wave_sum(s2) * (1.f / D) + LN_EPS);
        if (layer == 1) {
            s = 0.f;
#pragma unroll
            for (int j = 0; j < 4; ++j) { const f32x4 g = *(const f32x4*)(a->in[I_LNG] + lane * 4 + 256 * j), b = *(const f32x4*)(a->in[I_LNB] + lane * 4 + 256 * j);
                v[j] = v[j] * rstd * g + b; s += (v[j].x + v[j].y) + (v[j].z + v[j].w); }
            if (lane == 0) { float* st = (float*)(a->ws + WS_STATS) + (size_t)n * 2; st[0] = mean; st[1] = rstd; }
            mean = wave_sum(s) * (1.f / D); s2 = 0.f;
#pragma unroll
            for (int j = 0; j < 4; ++j) { v[j] = v[j] - mean; s2 += (v[j].x * v[j].x + v[j].y * v[j].y) + (v[j].z * v[j].z + v[j].w * v[j].w); }
            rstd = rsqrt_(wave_sum(s2) * (1.f / D) + LN_EPS);
        }
        const float* m = MOD + (size_t)(layer * 9 + tk.modrow) * 3072;
#pragma unroll
        for (int j = 0; j < 4; ++j) { const int c = lane * 4 + 256 * j; const f32x4 sh = *(const f32x4*)(m + c), sc = *(const f32x4*)(m + 1024 + c);
            const f32x4 o = v[j] * rstd * (sc + 1.f) + sh;
            v2u p; p.x = pk2(o.x, o.y); p.y = pk2(o.z, o.w); *(v2u*)(U + (size_t)n * D + c) = p; }
    }
}
__device__ __forceinline__ void phase_final(ArgsP a) {
    const int tid = tid_(), lane = tid & 63, wave = tid >> 6, G = grid_();
    f32x4 nx[4];
#define FN_LOAD(nn_) do { const bf16* zr_ = (const bf16*)a->out + (size_t)(nn_) * 2048; \
        _Pragma("unroll") for (int j = 0; j < 4; ++j) { const v2u w_ = *(const v2u*)(zr_ + lane * 4 + 256 * j); nx[j] = (f32x4){bflo(w_.x), bfhi(w_.x), bflo(w_.y), bfhi(w_.y)}; } } while (0)
    { const int n0 = bid_() * 8 + wave; if (n0 < T) FN_LOAD(n0); }
    for (int n = bid_() * 8 + wave; n < T; n += G * 8) {
        float* xr = a->out + (size_t)n * D;
        f32x4 v[4]; float s = 0.f;
#pragma unroll
        for (int j = 0; j < 4; ++j) { v[j] = nx[j]; s += (v[j].x + v[j].y) + (v[j].z + v[j].w); }
        if (n + G * 8 < T) FN_LOAD(n + G * 8);
        const float mean = wave_sum(s) * (1.f / D); float s2 = 0.f;
#pragma unroll
        for (int j = 0; j < 4; ++j) { v[j] = v[j] - mean; s2 += (v[j].x * v[j].x + v[j].y * v[j].y) + (v[j].z * v[j].z + v[j].w * v[j].w); }
        const float rstd = rsqrt_(wave_sum(s2) * (1.f / D) + LN_EPS);
#pragma unroll
        for (int j = 0; j < 4; ++j) { const f32x4 g = *(const f32x4*)(a->in[I_LNG] + 1024 + lane * 4 + 256 * j), b = *(const f32x4*)(a->in[I_LNB] + 1024 + lane * 4 + 256 * j);
            *(f32x4*)(xr + lane * 4 + 256 * j) = v[j] * rstd * g + b; }
    }
}

__device__ __forceinline__ void phase_a1_naive(ArgsP a, int layer) {
    const bf16* U = (const bf16*)(a->ws + WS_U); const bf16* W = (const bf16*)(a->ws + WS_WIN) + (size_t)layer * NIN * 1024;
    bf16* G1 = (bf16*)(a->ws + WS_G1); bf16* G2 = (bf16*)(a->ws + WS_G2);
    const size_t total = (size_t)T * (NIN / 8), stride = (size_t)grid_() * NTHREADS;
    for (size_t idx = (size_t)bid_() * NTHREADS + tid_(); idx < total; idx += stride) {
        const int row = (int)(idx / (NIN / 8)), c0 = (int)(idx % (NIN / 8)) * 8;
        float acc[8];
#pragma unroll
        for (int c = 0; c < 8; ++c) acc[c] = 0.f;
        const v4u* ap = (const v4u*)(U + (size_t)row * 1024); const v4u* bp = (const v4u*)(W + (size_t)c0 * 1024);
        for (int kc = 0; kc < 128; ++kc) { const v4u av = ap[kc];
#pragma unroll
            for (int c = 0; c < 8; ++c) acc[c] = dot8(av, bp[c * 128 + kc], acc[c]); }
        v4u o; o.x = pk2(acc[0], acc[1]); o.y = pk2(acc[2], acc[3]); o.z = pk2(acc[4], acc[5]); o.w = pk2(acc[6], acc[7]);
        if (c0 < G1W) *(v4u*)(G1 + (size_t)row * G1W + c0) = o; else *(v4u*)(G2 + (size_t)row * G2W + (c0 - G1W)) = o;
    }
}
__device__ __forceinline__ void phase_c2_naive(ArgsP a, int layer) {
    const bf16* Y = (const bf16*)(a->ws + WS_YMIX); const bf16* W = (const bf16*)(a->ws + WS_WOUT) + (size_t)layer * 1024 * 1024;
    const float* MOD = (const float*)(a->ws + WS_MOD);
    const size_t total = (size_t)T * 256, stride = (size_t)grid_() * NTHREADS;
    for (size_t idx = (size_t)bid_() * NTHREADS + tid_(); idx < total; idx += stride) {
        const int row = (int)(idx >> 8), c0 = (int)(idx & 255) * 4;
        float acc[4] = {0.f, 0.f, 0.f, 0.f};
        const v4u* ap = (const v4u*)(Y + (size_t)row * 1024); const v4u* bp = (const v4u*)(W + (size_t)c0 * 1024);
        for (int kc = 0; kc < 128; ++kc) { const v4u av = ap[kc];
#pragma unroll
            for (int c = 0; c < 4; ++c) acc[c] = dot8(av, bp[c * 128 + kc], acc[c]); }
        const Tok tk = tok_of(row);
        const f32x4 gate = *(const f32x4*)(MOD + (size_t)(layer * 9 + tk.modrow) * 3072 + 2048 + c0);
        const f32x4 x = *(const f32x4*)(xrow_src(a, layer, row) + c0);
        f32x4 z; z.x = ALPHA * x.x + gate.x * acc[0]; z.y = ALPHA * x.y + gate.y * acc[1]; z.z = ALPHA * x.z + gate.z * acc[2]; z.w = ALPHA * x.w + gate.w * acc[3];
        *(f32x4*)(a->out + (size_t)row * D + c0) = z;
    }
}

__device__ __forceinline__ void phase_a2_naive(ArgsP a, LAS unsigned char* lds, int layer) {
    const int tid = tid_(), lane = tid & 63, wave = tid >> 6, G = grid_();
    LAS float* AQ = (LAS float*)lds;
    LAS float* AKV = (LAS float*)(lds + 16384);
    LAS float* OT = (LAS float*)(lds + 24576);
    const bf16* G2 = (const bf16*)(a->ws + WS_G2);
    bf16* Q = (bf16*)(a->ws + WS_Q); bf16* KN = (bf16*)(a->ws + WS_KN); bf16* KR = (bf16*)(a->ws + WS_KR); bf16* VT = (bf16*)(a->ws + WS_VT);
    const bf16* WUQ = (const bf16*)(a->ws + WS_WUQ) + (size_t)layer * 768 * 256;
    const bf16* WUKV = (const bf16*)(a->ws + WS_WUKV) + (size_t)layer * 1024 * 128;
    constexpr int NT_TOK = T / 16, NT_CACHE = 8 * 256 / 16;
    for (int tile = bid_(); tile < NT_TOK + NT_CACHE; tile += G) {
        const bool is_tok = tile < NT_TOK;
        for (int rr = 0; rr < 2; ++rr) {
            const int r = wave * 2 + rr;
            if (is_tok) {
                const int n = tile * 16 + r; const Tok tk = tok_of(n);
                const v2u cqv = *(const v2u*)(G2 + (size_t)n * G2W + lane * 4);
                const float c0 = bflo(cqv.x), c1 = bfhi(cqv.x), c2 = bflo(cqv.y), c3 = bfhi(cqv.y);
                const float rq = rsqrt_(wave_sum(c0 * c0 + c1 * c1 + c2 * c2 + c3 * c3) * (1.f / 256.f) + 1e-6f);
                const f32x4 qn = *(const f32x4*)(a->in[I_QNORM] + layer * 256 + lane * 4);
                AQ[r * 256 + lane * 4 + 0] = bf2f(f2bf(c0 * rq * qn.x)); AQ[r * 256 + lane * 4 + 1] = bf2f(f2bf(c1 * rq * qn.y));
                AQ[r * 256 + lane * 4 + 2] = bf2f(f2bf(c2 * rq * qn.z)); AQ[r * 256 + lane * 4 + 3] = bf2f(f2bf(c3 * rq * qn.w));
                float k0 = 0.f, k1 = 0.f, k2 = 0.f, k3 = 0.f;
                if (lane < 32) { const v2u kv = *(const v2u*)(G2 + (size_t)n * G2W + 256 + lane * 4); k0 = bflo(kv.x); k1 = bfhi(kv.x); k2 = bflo(kv.y); k3 = bfhi(kv.y); }
                const float rk = rsqrt_(wave_sum(k0 * k0 + k1 * k1 + k2 * k2 + k3 * k3) * (1.f / 128.f) + 1e-6f);
                if (lane < 32) {
                    const f32x4 kn = *(const f32x4*)(a->in[I_KVNORM] + layer * 128 + lane * 4);
                    f32x4 o; o.x = k0 * rk * kn.x; o.y = k1 * rk * kn.y; o.z = k2 * rk * kn.z; o.w = k3 * rk * kn.w;
                    if (!tk.lat) *(f32x4*)(a->out + O_CKV + ((size_t)(tk.b * 2 + layer) * 256 + tk.t) * 128 + lane * 4) = o;
                    AKV[r * 128 + lane * 4 + 0] = bf2f(f2bf(o.x)); AKV[r * 128 + lane * 4 + 1] = bf2f(f2bf(o.y));
                    AKV[r * 128 + lane * 4 + 2] = bf2f(f2bf(o.z)); AKV[r * 128 + lane * 4 + 3] = bf2f(f2bf(o.w));
                }
                float krv = (lane < 32) ? bf2f(G2[(size_t)n * G2W + 384 + lane]) : 0.f;
                const float other = __shfl_xor(krv, 1);
                if (lane < 32) {
                    if (!tk.lat) a->out[O_KR + ((size_t)(tk.b * 2 + layer) * 256 + tk.t) * 32 + lane] = krv;
                    else { float c, s; rope_angle(tk.t, lane >> 1, c, s); krv = (lane & 1) ? (other * s + krv * c) : (krv * c - other * s); }
                    KR[(size_t)tk.kidx * 32 + lane] = (bf16)f2bf(krv);
                }
            } else {
                const int cr = (tile - NT_TOK) * 16 + r, b = cr >> 8, j = cr & 255;
                const size_t src = ((size_t)(b * 2 + layer) * 256 + j);
                if (lane < 32) { const f32x4 v = *(const f32x4*)(a->in[I_CCKV] + src * 128 + lane * 4);
                    AKV[r * 128 + lane * 4 + 0] = bf2f(f2bf(v.x)); AKV[r * 128 + lane * 4 + 1] = bf2f(f2bf(v.y)); AKV[r * 128 + lane * 4 + 2] = bf2f(f2bf(v.z)); AKV[r * 128 + lane * 4 + 3] = bf2f(f2bf(v.w));
                    KR[(size_t)(T_CTX + b * LK_LAT + j) * 32 + lane] = (bf16)f2bf(a->in[I_CKR][src * 32 + lane]); }
            }
        }
        __syncthreads();
        if (is_tok) {
            for (int col = tid; col < 768; col += NTHREADS) {
                float acc[16];
#pragma unroll
                for (int r = 0; r < 16; ++r) acc[r] = 0.f;
                const v4u* wp = (const v4u*)(WUQ + (size_t)col * 256);
                for (int kc = 0; kc < 32; ++kc) { const v4u w = wp[kc];
                    const float w0 = bflo(w.x), w1 = bfhi(w.x), w2 = bflo(w.y), w3 = bfhi(w.y), w4 = bflo(w.z), w5 = bfhi(w.z), w6 = bflo(w.w), w7 = bfhi(w.w);
#pragma unroll
                    for (int r = 0; r < 16; ++r) { const f32x4 x0 = *(const LAS f32x4*)(AQ + r * 256 + kc * 8), x1 = *(const LAS f32x4*)(AQ + r * 256 + kc * 8 + 4);
                        acc[r] += x0.x * w0 + x0.y * w1 + x0.z * w2 + x0.w * w3 + x1.x * w4 + x1.y * w5 + x1.z * w6 + x1.w * w7; } }
#pragma unroll
                for (int r = 0; r < 16; ++r) OT[r * 1024 + col] = acc[r];
            }
            __syncthreads();
            for (int idx = tid; idx < 16 * 384; idx += NTHREADS) {
                const int r = idx / 384, col = (idx % 384) * 2, d = col % 96; const int n = tile * 16 + r; const Tok tk = tok_of(n);
                float v0 = OT[r * 1024 + col], v1 = OT[r * 1024 + col + 1];
                if (tk.lat && d >= 64) { float c, s; rope_angle(tk.t, (d - 64) >> 1, c, s); const float y0 = v0 * c - v1 * s, y1 = v0 * s + v1 * c; v0 = y0; v1 = y1; }
                *(unsigned*)(Q + (size_t)n * 768 + col) = pk2(v0, v1);
            }
            __syncthreads();
        }
        for (int col = tid; col < 1024; col += NTHREADS) {
            float acc[16];
#pragma unroll
            for (int r = 0; r < 16; ++r) acc[r] = 0.f;
            const v4u* wp = (const v4u*)(WUKV + (size_t)col * 128);
            for (int kc = 0; kc < 16; ++kc) { const v4u w = wp[kc];
                const float w0 = bflo(w.x), w1 = bfhi(w.x), w2 = bflo(w.y), w3 = bfhi(w.y), w4 = bflo(w.z), w5 = bfhi(w.z), w6 = bflo(w.w), w7 = bfhi(w.w);
#pragma unroll
                for (int r = 0; r < 16; ++r) { const f32x4 x0 = *(const LAS f32x4*)(AKV + r * 128 + kc * 8), x1 = *(const LAS f32x4*)(AKV + r * 128 + kc * 8 + 4);
                    acc[r] += x0.x * w0 + x0.y * w1 + x0.z * w2 + x0.w * w3 + x1.x * w4 + x1.y * w5 + x1.z * w6 + x1.w * w7; } }
#pragma unroll
            for (int r = 0; r < 16; ++r) OT[r * 1024 + col] = acc[r];
        }
        __syncthreads();
        for (int idx = tid; idx < 16 * 1024; idx += NTHREADS) {
            const int r = idx >> 10, col = idx & 1023, h = col >> 7, f = col & 127;
            int kidx, lat, b, kpos;
            if (is_tok) { const Tok tk = tok_of(tile * 16 + r); kidx = tk.kidx; lat = tk.lat; b = tk.b; kpos = tk.lat ? PAST + tk.t : tk.t; }
            else { const int cr = (tile - NT_TOK) * 16 + r; b = cr >> 8; kpos = cr & 255; lat = 1; kidx = T_CTX + b * LK_LAT + kpos; }
            const bf16 v = (bf16)f2bf(OT[r * 1024 + col]);
            if (f < 64) KN[(size_t)kidx * 512 + h * 64 + f] = v;
            else { const int dv = f - 64; const size_t base = lat ? (size_t)VT_LAT + ((size_t)(b * 8 + h) * 64 + dv) * LK_LAT : ((size_t)(b * 8 + h) * 64 + dv) * 256; VT[base + kpos] = v; }
        }
        __syncthreads();
    }
}

__device__ __forceinline__ void phase_att_naive(ArgsP a) {
    const bf16* KN = (const bf16*)(a->ws + WS_KN); const bf16* KR = (const bf16*)(a->ws + WS_KR); const bf16* VT = (const bf16*)(a->ws + WS_VT);
    bf16* Q = (bf16*)(a->ws + WS_Q); const bf16* G1 = (const bf16*)(a->ws + WS_G1);
    const int total = T * 8, stride = grid_() * NTHREADS;
    for (int idx = bid_() * NTHREADS + tid_(); idx < total; idx += stride) {
        int n, h, Lk, kidx0; size_t vbase;
        if (idx < T_CTX * 8) { const int b = idx >> 11, hh = (idx >> 8) & 7, t = idx & 255; n = b * 256 + t; h = hh; Lk = 256; kidx0 = b * 256; vbase = ((size_t)(b * 8 + h) * 64) * 256; }
        else { const int m = idx - T_CTX * 8, b = m >> 14, hh = (m >> 11) & 7, t = m & 2047; n = T_CTX + b * 2048 + t; h = hh; Lk = LK_LAT; kidx0 = T_CTX + b * LK_LAT; vbase = (size_t)VT_LAT + ((size_t)(b * 8 + h) * 64) * LK_LAT; }
        v4u qp[12];
#pragma unroll
        for (int c = 0; c < 12; ++c) qp[c] = *(const v4u*)(Q + (size_t)n * 768 + h * 96 + c * 8);
        float acc[64];
#pragma unroll
        for (int d = 0; d < 64; ++d) acc[d] = 0.f;
        float m = -1e30f, l = 0.f;
        for (int j0 = 0; j0 < Lk; j0 += 8) {
            float s[8];
#pragma unroll
            for (int j = 0; j < 8; ++j) {
                const v4u* kp = (const v4u*)(KN + (size_t)(kidx0 + j0 + j) * 512 + h * 64); const v4u* rp = (const v4u*)(KR + (size_t)(kidx0 + j0 + j) * 32);
                float sv = 0.f;
#pragma unroll
                for (int c = 0; c < 8; ++c) sv = dot8(qp[c], kp[c], sv);
#pragma unroll
                for (int c = 0; c < 4; ++c) sv = dot8(qp[8 + c], rp[c], sv);
                s[j] = sv;
                __builtin_amdgcn_sched_barrier(0);
            }
            float mx = m;
#pragma unroll
            for (int j = 0; j < 8; ++j) mx = fmaxf(mx, s[j]);
            const float alpha = exp2f(m - mx); m = mx; float ps = 0.f;
#pragma unroll
            for (int j = 0; j < 8; ++j) { s[j] = exp2f(s[j] - mx); ps += s[j]; }
            l = l * alpha + ps;
            unsigned lk = (unsigned)Lk; asm volatile("" : "+v"(lk));
            const bf16* vp = VT + vbase + j0;
#pragma unroll
            for (int dg = 0; dg < 8; ++dg) {
#pragma unroll
                for (int dd = 0; dd < 8; ++dd) { const int d = dg * 8 + dd; const v4u w = *(const v4u*)(vp + (unsigned)d * lk);
                    acc[d] = acc[d] * alpha + s[0] * bflo(w.x) + s[1] * bfhi(w.x) + s[2] * bflo(w.y) + s[3] * bfhi(w.y) + s[4] * bflo(w.z) + s[5] * bfhi(w.z) + s[6] * bflo(w.w) + s[7] * bfhi(w.w); }
                __builtin_amdgcn_sched_barrier(0);
            }
        }
        const float inv = rcp_(l);
#pragma unroll
        for (int c = 0; c < 8; ++c) { const v4u g = *(const v4u*)(G1 + (size_t)n * G1W + C_GM + h * 64 + c * 8);
            v4u o;
            o.x = pk2(acc[c * 8 + 0] * inv * siluf_(bflo(g.x)), acc[c * 8 + 1] * inv * siluf_(bfhi(g.x)));
            o.y = pk2(acc[c * 8 + 2] * inv * siluf_(bflo(g.y)), acc[c * 8 + 3] * inv * siluf_(bfhi(g.y)));
            o.z = pk2(acc[c * 8 + 4] * inv * siluf_(bflo(g.z)), acc[c * 8 + 5] * inv * siluf_(bfhi(g.z)));
            o.w = pk2(acc[c * 8 + 6] * inv * siluf_(bflo(g.w)), acc[c * 8 + 7] * inv * siluf_(bfhi(g.w)));
            *(v4u*)(Q + (size_t)n * 768 + h * 96 + c * 8) = o; }
    }
}
namespace pg8 {
#define PG8_LAS __attribute__((address_space(3)))
typedef unsigned short bf16_t;
typedef short bf16x8 __attribute__((ext_vector_type(8)));
typedef float f32x4 __attribute__((ext_vector_type(4)));
typedef unsigned u32x4 __attribute__((ext_vector_type(4)));
constexpr int BM = 256, BK = 64, HALF = 128, HTB = HALF * BK * 2  , STAGE_BYTES = 8 * HTB, NXCD = 8, WGM = 8;

__host__ __device__ __forceinline__ int lds_byte(int r, int c) { const int st = (r >> 4) * 2 + (c >> 5), rr = r & 15, cc = c & 31, ob = rr * 64 + cc * 2; return st * 1024 + (ob ^ (((ob >> 9) & 1) << 5)); }
__host__ __device__ __forceinline__ void stage_rc(int b, int& R, int& C) { const int st = b / 1024, sb = b % 1024, swz = sb ^ (((sb >> 9) & 1) << 5); R = (st >> 1) * 16 + swz / 64; C = (st & 1) * 32 + (swz % 64) / 2; }
__host__ __device__ __forceinline__ int perm32(int rho) { const int n = rho >> 4, i = rho & 15; return 8 * (i >> 2) + 4 * n + (i & 3); }

struct Unit { int pm, pn, gid; };
struct Gemm { const bf16_t* A; const bf16_t* Bt; int M, N, K, lda, ldb; };

struct StaticOrder {
    int nM, nN, nwg, G, c;
    __host__ __device__ void init(int M, int N, int G_, int c_) { nM = M / BM; nN = N / BM; nwg = nM * nN; G = G_; c = c_; }
    __host__ __device__ bool next(int i, Unit& u) const {
        const long L = (long)i * G + c; if (L >= nwg) return false;
        int wgid = (int)L; { const int q = nwg / NXCD, r = nwg % NXCD, xcd = wgid % NXCD, off = wgid / NXCD; wgid = (xcd < r ? xcd * (q + 1) : r * (q + 1) + (xcd - r) * q) + off; }
        const int nig = WGM * nN, gid = wgid / nig, fm = gid * WGM, gsz = (nM - fm) < WGM ? (nM - fm) : WGM;
        u.pm = fm + ((wgid % nig) % gsz); u.pn = (wgid % nig) / gsz; u.gid = 0; return true;
    }
    __device__ __forceinline__ const char* abase(const Gemm& g, const Unit& u) const { return (const char*)g.A + (size_t)u.pm * BM * g.lda * 2; }
    __device__ __forceinline__ const char* bbase(const Gemm& g, const Unit& u) const { return (const char*)g.Bt + (size_t)u.pn * BM * g.ldb * 2; }
    __device__ __forceinline__ void a_ready(const Unit&) const {}
    __device__ __forceinline__ void done(const Unit&) const {}
};
__device__ __forceinline__ unsigned cvt_pk_bf16(float lo, float hi) { unsigned r; asm volatile("v_cvt_pk_bf16_f32 %0, %1, %2" : "=v"(r) : "v"(lo), "v"(hi)); return r; }

template <class Epi, class Sched, bool STAMP = false>
__device__ __forceinline__ void gemm_phase(PG8_LAS unsigned char* lds, const Gemm g, const Sched& S, const Epi& E, unsigned long long* stamps) {
    const int tid = tid_(), wid = __builtin_amdgcn_readfirstlane(tid >> 6), lane = tid & 63, wr = wid >> 2, wc = wid & 3, fr = lane & 15, fq = lane >> 4;
    const int K = g.K, nt = K / BK;
    int ts_lo = 0, ts_hi = 0, nts = 0; const unsigned long long rt_entry = STAMP ? (unsigned long long)wall_clock64() : 0ull;
#define PG8_STAMP() do { if (STAMP && wid == 0 && nts < 64) { const unsigned long long _c = (unsigned long long)clock64(); \
        ts_lo = (lane == nts) ? (int)(unsigned)_c : ts_lo; ts_hi = (lane == nts) ? (int)(unsigned)(_c >> 32) : ts_hi; ++nts; } } while (0)
    PG8_STAMP();
    unsigned voffA[2], voffB[2];
#pragma unroll
    for (int i = 0; i < 2; ++i) { int R, C; stage_rc(tid * 16 + i * 8192, R, C); const int Rb = Epi::PERM ? ((R & ~31) + perm32(R & 31)) : R;
        voffA[i] = (unsigned)(R * g.lda + C) * 2u; voffB[i] = (unsigned)(Rb * g.ldb + C) * 2u; }
    const size_t kstep = (size_t)(BK * 2);
    const size_t hstepA = (size_t)HALF * g.lda * 2, hstepB = (size_t)HALF * g.ldb * 2;
    const unsigned ldsw = (unsigned)wid * 1024u;
    const int aoff = lds_byte(wr * 64 + fr, fq * 8), boff = lds_byte(wc * 32 + fr, fq * 8);
#define PG8_SA(b, h) (((b) * 2 + (h)) * HTB)
#define PG8_SB(b, h) ((4 + (b) * 2 + (h)) * HTB)
#define PG8_STAGE(bufoff, gbase, voff) do { _Pragma("unroll") for (int _i = 0; _i < 2; ++_i) \
        __builtin_amdgcn_global_load_lds((const unsigned*)((const char*)(gbase) + (voff)[_i]), (PG8_LAS unsigned*)(lds + (bufoff) + ldsw + _i * 8192), 16, 0, 0); } while (0)
#define PG8_LDA(dst, b, h) do { _Pragma("unroll") for (int m = 0; m < 4; ++m) _Pragma("unroll") for (int k = 0; k < 2; ++k) dst[m][k] = *(const PG8_LAS bf16x8*)(lds + PG8_SA(b, h) + aoff + m * 2048 + k * 1024); } while (0)
#define PG8_LDB(dst, b, h) do { _Pragma("unroll") for (int n = 0; n < 2; ++n) _Pragma("unroll") for (int k = 0; k < 2; ++k) dst[n][k] = *(const PG8_LAS bf16x8*)(lds + PG8_SB(b, h) + boff + n * 2048 + k * 1024); } while (0)
#define PG8_MMA(ai, bj, At, Bt) do { __builtin_amdgcn_s_setprio(1); _Pragma("unroll") for (int m = 0; m < 4; ++m) _Pragma("unroll") for (int n = 0; n < 2; ++n) _Pragma("unroll") for (int k = 0; k < 2; ++k) \
        acc[ai][bj][m][n] = __builtin_amdgcn_mfma_f32_16x16x32_bf16(Bt[n][k], At[m][k], acc[ai][bj][m][n], 0, 0, 0); __builtin_amdgcn_s_setprio(0); } while (0)
#define PG8_WAIT_V(n) asm volatile("s_waitcnt vmcnt(" #n ")" ::: "memory")
#define PG8_WAIT_L(n) asm volatile("s_waitcnt lgkmcnt(" #n ")" ::: "memory")
#define PG8_BAR __builtin_amdgcn_s_barrier()
#define PG8_SCHED __builtin_amdgcn_sched_barrier(0)
    Unit cur, nxt; int ui = 0;
    if (!S.next(0, cur)) return;
    f32x4 acc[2][2][4][2];
#pragma unroll
    for (int a = 0; a < 2; ++a)
#pragma unroll
        for (int b = 0; b < 2; ++b)
#pragma unroll
            for (int m = 0; m < 4; ++m)
#pragma unroll
                for (int n = 0; n < 2; ++n) acc[a][b][m][n] = (f32x4){0.f, 0.f, 0.f, 0.f};
    bf16x8 At[4][2], B0[2][2], B1[2][2];
    const char* cA = S.abase(g, cur); const char* cB = S.bbase(g, cur);
    S.a_ready(cur);
    PG8_STAGE(PG8_SB(0, 0), cB, voffB); PG8_STAGE(PG8_SA(0, 0), cA, voffA); PG8_STAGE(PG8_SB(0, 1), cB + hstepB, voffB); PG8_STAGE(PG8_SA(0, 1), cA + hstepA, voffA);
    if (wr == 1) PG8_BAR;
    PG8_WAIT_V(4); PG8_BAR;
    PG8_STAGE(PG8_SB(1, 0), cB + kstep, voffB); PG8_STAGE(PG8_SA(1, 0), cA + kstep, voffA); PG8_STAGE(PG8_SB(1, 1), cB + hstepB + kstep, voffB);
    PG8_WAIT_V(6); PG8_BAR;
    PG8_STAMP();
    for (;;) {
        const bool has_next = S.next(ui + 1, nxt);
        const char* nA = has_next ? S.abase(g, nxt) : cA; const char* nB = has_next ? S.bbase(g, nxt) : cB;
        for (int t = 0; t < nt; t += 2) {
            const bool last = (t == nt - 2);
            const char* a1 = cA + (size_t)(t + 1) * kstep;
            const char* a2 = last ? nA : cA + (size_t)(t + 2) * kstep; const char* b2 = last ? nB : cB + (size_t)(t + 2) * kstep;
            const char* a3 = a2 + kstep; const char* b3 = b2 + kstep;
            if (last && has_next) S.a_ready(nxt);
            PG8_LDB(B0, 0, 0); PG8_SCHED; PG8_LDA(At, 0, 0); PG8_STAGE(PG8_SA(1, 1), a1 + hstepA, voffA);
            PG8_WAIT_L(8); PG8_BAR; PG8_WAIT_L(0); PG8_MMA(0, 0, At, B0); PG8_BAR; PG8_SCHED;
            PG8_LDB(B1, 0, 1); PG8_STAGE(PG8_SB(0, 0), b2, voffB);
            PG8_BAR; PG8_WAIT_L(0); PG8_MMA(0, 1, At, B1); PG8_BAR;
            PG8_LDA(At, 0, 1); PG8_STAGE(PG8_SA(0, 0), a2, voffA);
            PG8_BAR; PG8_WAIT_L(0); PG8_MMA(1, 0, At, B0); PG8_BAR; PG8_SCHED;
            PG8_STAGE(PG8_SB(0, 1), b2 + hstepB, voffB);
            PG8_WAIT_V(6); PG8_BAR; PG8_MMA(1, 1, At, B1); PG8_BAR;
            PG8_LDB(B0, 1, 0); PG8_SCHED; PG8_LDA(At, 1, 0); PG8_STAGE(PG8_SA(0, 1), a2 + hstepA, voffA);
            PG8_WAIT_L(8); PG8_BAR; PG8_WAIT_L(0); PG8_MMA(0, 0, At, B0); PG8_BAR; PG8_SCHED;
            PG8_LDB(B1, 1, 1); PG8_STAGE(PG8_SB(1, 0), b3, voffB);
            PG8_BAR; PG8_WAIT_L(0); PG8_MMA(0, 1, At, B1); PG8_BAR;
            PG8_LDA(At, 1, 1); PG8_STAGE(PG8_SA(1, 0), a3, voffA);
            PG8_BAR; PG8_WAIT_L(0); PG8_MMA(1, 0, At, B0); PG8_BAR; PG8_SCHED;
            PG8_STAGE(PG8_SB(1, 1), b3 + hstepB, voffB);
            PG8_WAIT_V(6); PG8_BAR; PG8_MMA(1, 1, At, B1); PG8_BAR;
        }
        PG8_STAMP();
        if constexpr (!Epi::AFTER_DRAIN) { E(acc, cur, wr, wc, fr, fq); S.done(cur); }
        PG8_STAMP();
        if (!has_next) break;
#pragma unroll
        for (int a = 0; a < 2; ++a)
#pragma unroll
            for (int b = 0; b < 2; ++b)
#pragma unroll
                for (int m = 0; m < 4; ++m)
#pragma unroll
                    for (int n = 0; n < 2; ++n) acc[a][b][m][n] = (f32x4){0.f, 0.f, 0.f, 0.f};
        cur = nxt; cA = nA; cB = nB; ++ui;
    }
    PG8_WAIT_V(0);
    if (wr == 0) PG8_BAR;
    PG8_BAR;
    if constexpr (Epi::AFTER_DRAIN) { E.fused(acc, cur, wr, wc, fr, fq, lds, wid, lane); S.done(cur); }
    PG8_STAMP();
    if (STAMP && wid == 0) { stamps[lane] = lane < nts ? (((unsigned long long)(unsigned)ts_hi << 32) | (unsigned)ts_lo) : 0ull;
        if (lane == 62) stamps[62] = rt_entry; if (lane == 63) stamps[63] = (unsigned long long)wall_clock64(); }
#undef PG8_STAMP
#undef PG8_SA
#undef PG8_SB
#undef PG8_STAGE
#undef PG8_LDA
#undef PG8_LDB
#undef PG8_MMA
#undef PG8_WAIT_V
#undef PG8_WAIT_L
#undef PG8_BAR
#undef PG8_SCHED
}
}
namespace pg8 {
struct EpiIn {
    static constexpr bool PERM = true, AFTER_DRAIN = false;
    bf16_t* G1; bf16_t* G2;
    __device__ __forceinline__ void operator()(const f32x4 (&acc)[2][2][4][2], const Unit& u, int wr, int wc, int fr, int fq) const {
        const int row0 = u.pm * BM + wr * 64 + fr;
        bf16_t* base; int ldc, colt;
        if (u.pn < 9) { base = G1; ldc = 2304; colt = u.pn * 256; } else { base = G2; ldc = 512; colt = (u.pn - 9) * 256; }
        const int col0 = colt + wc * 32 + 8 * fq;
#pragma unroll
        for (int ai = 0; ai < 2; ++ai)
#pragma unroll
            for (int m = 0; m < 4; ++m) { bf16_t* rowp = base + (size_t)(row0 + ai * HALF + m * 16) * ldc + col0;
#pragma unroll
                for (int bj = 0; bj < 2; ++bj) { const f32x4 v0 = acc[ai][bj][m][0], v1 = acc[ai][bj][m][1];
                    u32x4 w; w.x = cvt_pk_bf16(v0[0], v0[1]); w.y = cvt_pk_bf16(v0[2], v0[3]); w.z = cvt_pk_bf16(v1[0], v1[1]); w.w = cvt_pk_bf16(v1[2], v1[3]);
                    *(u32x4*)(rowp + bj * HALF) = w; } }
    }
};
struct EpiOut {
    static constexpr bool PERM = true, AFTER_DRAIN = false;
    const float* xp; const float* xs; float* out; const float* mod; int layer;
    const float* stats; const float* lng; const float* lnb;
    __device__ __forceinline__ void operator()(const f32x4 (&acc)[2][2][4][2], const Unit& u, int wr, int wc, int fr, int fq) const {
        const int row0 = u.pm * BM + wr * 64 + fr, col0 = u.pn * BM + wc * 32 + 8 * fq;
        const int rt = u.pm * BM; const int modrow = rt < 8192 ? 0 : 1 + ((rt - 8192) >> 11);
        const float* gp = mod + (size_t)modrow * 3072 + 2048 + col0;
        f32x4 gv[2][2];
#pragma unroll
        for (int bj = 0; bj < 2; ++bj)
#pragma unroll
            for (int n = 0; n < 2; ++n) gv[bj][n] = *(const f32x4*)(gp + bj * HALF + n * 4);
        f32x4 lg[2][2], lb[2][2];
        if (layer) {
#pragma unroll
            for (int bj = 0; bj < 2; ++bj)
#pragma unroll
                for (int n = 0; n < 2; ++n) { lg[bj][n] = *(const f32x4*)(lng + col0 + bj * HALF + n * 4); lb[bj][n] = *(const f32x4*)(lnb + col0 + bj * HALF + n * 4); }
        }
        f32x4 xn[2][2]; float mean_n = 0.f, rstd_n = 1.f;
#define EO_LOAD(am_) do { const int row_ = row0 + ((am_) >> 2) * HALF + ((am_) & 3) * 16; \
            if (layer == 0) { const float* xr_ = (row_ < 8192 ? xp + (size_t)row_ * 1024 : xs + (size_t)(row_ - 8192) * 1024) + col0; \
                xn[0][0] = *(const f32x4*)(xr_); xn[0][1] = *(const f32x4*)(xr_ + 4); xn[1][0] = *(const f32x4*)(xr_ + HALF); xn[1][1] = *(const f32x4*)(xr_ + HALF + 4); } \
            else { const bf16_t* zr_ = (const bf16_t*)out + (size_t)row_ * 2048 + col0; const u32x4 z0_ = *(const u32x4*)zr_, z1_ = *(const u32x4*)(zr_ + HALF); \
                xn[0][0] = (f32x4){__uint_as_float(z0_.x << 16), __uint_as_float(z0_.x & 0xffff0000u), __uint_as_float(z0_.y << 16), __uint_as_float(z0_.y & 0xffff0000u)}; \
                xn[0][1] = (f32x4){__uint_as_float(z0_.z << 16), __uint_as_float(z0_.z & 0xffff0000u), __uint_as_float(z0_.w << 16), __uint_as_float(z0_.w & 0xffff0000u)}; \
                xn[1][0] = (f32x4){__uint_as_float(z1_.x << 16), __uint_as_float(z1_.x & 0xffff0000u), __uint_as_float(z1_.y << 16), __uint_as_float(z1_.y & 0xffff0000u)}; \
                xn[1][1] = (f32x4){__uint_as_float(z1_.z << 16), __uint_as_float(z1_.z & 0xffff0000u), __uint_as_float(z1_.w << 16), __uint_as_float(z1_.w & 0xffff0000u)}; \
                mean_n = stats[(size_t)row_ * 2]; rstd_n = stats[(size_t)row_ * 2 + 1]; } } while (0)
        EO_LOAD(0);
#pragma unroll
        for (int am = 0; am < 8; ++am) { const int ai = am >> 2, m = am & 3, row = row0 + ai * HALF + m * 16;
            const f32x4 xc[2][2] = {{xn[0][0], xn[0][1]}, {xn[1][0], xn[1][1]}}; const float mean = mean_n, rstd = rstd_n;
            if (am + 1 < 8) EO_LOAD(am + 1);
            bf16_t* orow = (bf16_t*)out + (size_t)row * 2048 + col0;
#pragma unroll
            for (int bj = 0; bj < 2; ++bj) { f32x4 z[2];
#pragma unroll
                for (int n = 0; n < 2; ++n) { f32x4 x = xc[bj][n];
                    if (layer) x = (x - mean) * rstd * lg[bj][n] + lb[bj][n];
                    z[n] = x * 1.4142135623730951f + gv[bj][n] * acc[ai][bj][m][n]; }
                u32x4 w; w.x = cvt_pk_bf16(z[0][0], z[0][1]); w.y = cvt_pk_bf16(z[0][2], z[0][3]); w.z = cvt_pk_bf16(z[1][0], z[1][1]); w.w = cvt_pk_bf16(z[1][2], z[1][3]);
                *(u32x4*)(orow + bj * HALF) = w; } }
#undef EO_LOAD
    }
};
}

__device__ __forceinline__ void phase_a1_pg8(ArgsP a, LAS unsigned char* lds, int layer) {
    pg8::Gemm g{(const bf16*)(a->ws + WS_U), (const bf16*)(a->ws + WS_WIN) + (size_t)layer * NIN * 1024, T, NIN, 1024, 1024, 1024};
    pg8::StaticOrder S; S.init(T, NIN, grid_(), bid_());
    pg8::EpiIn E{(bf16*)(a->ws + WS_G1), (bf16*)(a->ws + WS_G2)};
    pg8::gemm_phase<pg8::EpiIn, pg8::StaticOrder, false>(lds, g, S, E, nullptr);
}
__device__ __forceinline__ void phase_c2_pg8(ArgsP a, LAS unsigned char* lds, int layer) {
    pg8::Gemm g{(const bf16*)(a->ws + WS_YMIX), (const bf16*)(a->ws + WS_WOUT) + (size_t)layer * 1024 * 1024, T, 1024, 1024, 1024, 1024};
    pg8::StaticOrder S; S.init(T, 1024, grid_(), bid_());
    pg8::EpiOut E{a->in[I_XP], a->in[I_XS], a->out, (const float*)(a->ws + WS_MOD) + (size_t)layer * 9 * 3072, layer, (const float*)(a->ws + WS_STATS), a->in[I_LNG], a->in[I_LNB]};
    pg8::gemm_phase<pg8::EpiOut, pg8::StaticOrder, false>(lds, g, S, E, nullptr);
}

__device__ __forceinline__ void phase_a2a(ArgsP a, int layer) {
    const int tid = tid_(), lane = tid & 63, wave = tid >> 6, G = grid_();
    bf16* G2 = (bf16*)(a->ws + WS_G2); bf16* KR = (bf16*)(a->ws + WS_KR); bf16* CK = (bf16*)(a->ws + WS_HF);
    const float* ROPE = (const float*)(a->ws + WS_ROPE);
    f32x4 nw0 = {0.f, 0.f, 0.f, 0.f}, nw1 = {0.f, 0.f, 0.f, 0.f};
    if (lane < 32) { nw0 = *(const f32x4*)(a->in[I_QNORM] + layer * 256 + lane * 8); nw1 = *(const f32x4*)(a->in[I_QNORM] + layer * 256 + lane * 8 + 4); }
    else if (lane < 48) { nw0 = *(const f32x4*)(a->in[I_KVNORM] + layer * 128 + (lane - 32) * 8); nw1 = *(const f32x4*)(a->in[I_KVNORM] + layer * 128 + (lane - 32) * 8 + 4); }
    v4u nx = {0u, 0u, 0u, 0u};
    { const int n0 = bid_() * 8 + wave; if (n0 < T) nx = *(const v4u*)(G2 + (size_t)n0 * G2W + lane * 8); }
    for (int n = bid_() * 8 + wave; n < T; n += G * 8) {
        const v4u w = nx;
        if (n + G * 8 < T) nx = *(const v4u*)(G2 + (size_t)(n + G * 8) * G2W + lane * 8);
        const Tok tk = tok_of(n);
        float x[8] = {bflo(w.x), bfhi(w.x), bflo(w.y), bfhi(w.y), bflo(w.z), bfhi(w.z), bflo(w.w), bfhi(w.w)};
        const float ss = (x[0] * x[0] + x[1] * x[1]) + (x[2] * x[2] + x[3] * x[3]) + (x[4] * x[4] + x[5] * x[5]) + (x[6] * x[6] + x[7] * x[7]);
        const float sq = wave_sum(lane < 32 ? ss : 0.f), sk = wave_sum((lane >= 32 && lane < 48) ? ss : 0.f);
        const float rs = lane < 32 ? rsqrt_(sq * (1.f / 256.f) + 1e-6f) : rsqrt_(sk * (1.f / 128.f) + 1e-6f);
        if (lane < 48) {
            const float y0 = x[0] * rs * nw0.x, y1 = x[1] * rs * nw0.y, y2 = x[2] * rs * nw0.z, y3 = x[3] * rs * nw0.w, y4 = x[4] * rs * nw1.x, y5 = x[5] * rs * nw1.y, y6 = x[6] * rs * nw1.z, y7 = x[7] * rs * nw1.w;
            *(v4u*)(G2 + (size_t)n * G2W + lane * 8) = (v4u){cvtpk(y0, y1), cvtpk(y2, y3), cvtpk(y4, y5), cvtpk(y6, y7)};
            if (lane >= 32 && !tk.lat) { float* op = a->out + O_CKV + ((size_t)(tk.b * 2 + layer) * 256 + tk.t) * 128 + (lane - 32) * 8;
                *(f32x4*)op = (f32x4){y0, y1, y2, y3}; *(f32x4*)(op + 4) = (f32x4){y4, y5, y6, y7}; }
        } else if (lane < 52) {
            const int d0 = (lane - 48) * 8;
            if (!tk.lat) { float* op = a->out + O_KR + ((size_t)(tk.b * 2 + layer) * 256 + tk.t) * 32 + d0;
                *(f32x4*)op = (f32x4){x[0], x[1], x[2], x[3]}; *(f32x4*)(op + 4) = (f32x4){x[4], x[5], x[6], x[7]};
                *(v4u*)(KR + (size_t)tk.kidx * 32 + d0) = w; }
            else { const f32x4 c0 = *(const f32x4*)(ROPE + ((size_t)tk.t * 16 + (d0 >> 1)) * 2), c1 = *(const f32x4*)(ROPE + ((size_t)tk.t * 16 + (d0 >> 1) + 2) * 2);
                const float y0 = x[0] * c0.x - x[1] * c0.y, y1 = x[0] * c0.y + x[1] * c0.x, y2 = x[2] * c0.z - x[3] * c0.w, y3 = x[2] * c0.w + x[3] * c0.z;
                const float y4 = x[4] * c1.x - x[5] * c1.y, y5 = x[4] * c1.y + x[5] * c1.x, y6 = x[6] * c1.z - x[7] * c1.w, y7 = x[6] * c1.w + x[7] * c1.z;
                *(v4u*)(KR + (size_t)tk.kidx * 32 + d0) = (v4u){cvtpk(y0, y1), cvtpk(y2, y3), cvtpk(y4, y5), cvtpk(y6, y7)}; }
        }
    }
    for (int r = bid_() * 8 + wave; r < 2048; r += G * 8) {
        const int b = r >> 8, j = r & 255; const size_t src = (size_t)(b * 2 + layer) * 256 + j;
        if (lane < 16) { const f32x4 v0 = *(const f32x4*)(a->in[I_CCKV] + src * 128 + lane * 8), v1 = *(const f32x4*)(a->in[I_CCKV] + src * 128 + lane * 8 + 4);
            *(v4u*)(CK + (size_t)r * 512 + lane * 8) = (v4u){cvtpk(v0.x, v0.y), cvtpk(v0.z, v0.w), cvtpk(v1.x, v1.y), cvtpk(v1.z, v1.w)}; }
        else if (lane < 32) *(v4u*)(CK + (size_t)r * 512 + lane * 8) = (v4u){0u, 0u, 0u, 0u};
        else if (lane < 36) { const f32x4 v0 = *(const f32x4*)(a->in[I_CKR] + src * 32 + (lane - 32) * 8), v1 = *(const f32x4*)(a->in[I_CKR] + src * 32 + (lane - 32) * 8 + 4);
            *(v4u*)(KR + (size_t)(T_CTX + b * LK_LAT + j) * 32 + (lane - 32) * 8) = (v4u){cvtpk(v0.x, v0.y), cvtpk(v0.z, v0.w), cvtpk(v1.x, v1.y), cvtpk(v1.z, v1.w)}; }
    }
}
namespace pg8 {
struct A2Order {
    const char* ws; unsigned oq, okv; int G, c;
    __device__ __forceinline__ bool next(int i, Unit& u) const {
        const int L = i * G + c; if (L >= 704) return false;
        if (L < 288) { u.gid = 0; u.pm = L / 3; u.pn = L % 3; } else if (L < 672) { u.gid = 1; u.pm = (L - 288) >> 2; u.pn = (L - 288) & 3; } else { u.gid = 2; u.pm = (L - 672) >> 2; u.pn = (L - 672) & 3; }
        return true;
    }
    __device__ __forceinline__ const char* abase(const Gemm&, const Unit& u) const { const unsigned off = u.gid == 0 ? (unsigned)WS_G2 : (u.gid == 1 ? (unsigned)WS_G2 + 512u : (unsigned)WS_HF); return ws + off + (size_t)u.pm * 256 * 512 * 2; }
    __device__ __forceinline__ const char* bbase(const Gemm&, const Unit& u) const { const unsigned off = u.gid == 0 ? oq : okv; return ws + off + (size_t)u.pn * 256 * 256 * 2; }
    __device__ __forceinline__ void a_ready(const Unit&) const {}
    __device__ __forceinline__ void done(const Unit&) const {}
};
struct EpiA2 {
    static constexpr bool PERM = true, AFTER_DRAIN = false;
    bf16_t* Q; bf16_t* KN; bf16_t* VR; const float* rope;
    __device__ __forceinline__ void operator()(const f32x4 (&acc)[2][2][4][2], const Unit& u, int wr, int wc, int fr, int fq) const {
        const int row0 = u.pm * BM + wr * 64 + fr;
        if (u.gid == 0) {
            const int fb = u.pn * 256 + wc * 32 + 8 * fq;
#pragma unroll
            for (int ai = 0; ai < 2; ++ai)
#pragma unroll
                for (int m = 0; m < 4; ++m) { const int row = row0 + ai * HALF + m * 16;
                    const float* rp = rope + (unsigned)(((row - 8192) & 2047) * 32);
#pragma unroll
                    for (int bj = 0; bj < 2; ++bj) {
                        f32x4 v0 = acc[ai][bj][m][0], v1 = acc[ai][bj][m][1];
                        const int f0 = fb + bj * HALF, d = f0 % 96;
                        if (row >= 8192 && d >= 64) { const f32x4 c0 = *(const f32x4*)(rp + (d - 64)), c1 = *(const f32x4*)(rp + (d - 64) + 4);
                            const f32x4 a0 = v0, a1 = v1;
                            v0[0] = a0[0] * c0[0] - a0[1] * c0[1]; v0[1] = a0[0] * c0[1] + a0[1] * c0[0]; v0[2] = a0[2] * c0[2] - a0[3] * c0[3]; v0[3] = a0[2] * c0[3] + a0[3] * c0[2];
                            v1[0] = a1[0] * c1[0] - a1[1] * c1[1]; v1[1] = a1[0] * c1[1] + a1[1] * c1[0]; v1[2] = a1[2] * c1[2] - a1[3] * c1[3]; v1[3] = a1[2] * c1[3] + a1[3] * c1[2]; }
                        u32x4 w; w.x = cvt_pk_bf16(v0[0], v0[1]); w.y = cvt_pk_bf16(v0[2], v0[3]); w.z = cvt_pk_bf16(v1[0], v1[1]); w.w = cvt_pk_bf16(v1[2], v1[3]);
                        *(u32x4*)(Q + (unsigned)(row * 768 + f0)) = w; } }
        } else {
            const int x = wc * 32 + 8 * fq;
            bf16_t* base = (wc < 2 ? KN : VR);
            const unsigned xo = (unsigned)(x & 63);
#pragma unroll
            for (int ai = 0; ai < 2; ++ai)
#pragma unroll
                for (int m = 0; m < 4; ++m) { const int row = row0 + ai * HALF + m * 16;
                    int kidx;
                    if (u.gid == 2) kidx = 8192 + (row >> 8) * 2304 + (row & 255);
                    else if (row < 8192) kidx = row;
                    else { const int mrow = row - 8192; kidx = 8192 + (mrow >> 11) * 2304 + 256 + (mrow & 2047); }
#pragma unroll
                    for (int bj = 0; bj < 2; ++bj) { const f32x4 v0 = acc[ai][bj][m][0], v1 = acc[ai][bj][m][1];
                        u32x4 w; w.x = cvt_pk_bf16(v0[0], v0[1]); w.y = cvt_pk_bf16(v0[2], v0[3]); w.z = cvt_pk_bf16(v1[0], v1[1]); w.w = cvt_pk_bf16(v1[2], v1[3]);
                        *(u32x4*)(base + (unsigned)(kidx * 512 + (u.pn * 2 + bj) * 64) + xo) = w; } }
        }
    }
};
}
__device__ __forceinline__ void phase_a2b(ArgsP a, LAS unsigned char* lds, int layer) {
    int kk = 256; asm volatile("" : "+s"(kk));
    pg8::Gemm g{nullptr, nullptr, T, 1024, kk, 512, 256};
    pg8::A2Order S{(const char*)a->ws, (unsigned)(WS_WUQ + (size_t)layer * 768 * 256 * 2), (unsigned)(WS_WUKV + (size_t)layer * 1024 * 256 * 2), grid_(), bid_()};
    pg8::EpiA2 E{(bf16*)(a->ws + WS_Q), (bf16*)(a->ws + WS_KN), (bf16*)(a->ws + WS_VT), (const float*)(a->ws + WS_ROPE)};
    pg8::gemm_phase<pg8::EpiA2, pg8::A2Order, false>(lds, g, S, E, nullptr);
}
__device__ __forceinline__ void rwkv_unit_seq(ArgsP a, LAS unsigned char* lds, int layer, int u) {
    const int tid = tid_();
    LAS float* W2s = (LAS float*)lds;
    LAS float* A2s = W2s + 4096;
    LAS float* TH = A2s + 4096;
    LAS float* HA = TH + 2048;
    LAS float* Wd = HA + 2048;
    LAS float* KT = Wd + 2048; LAS float* KK = KT + 2048; LAS float* BB = KK + 2048; LAS float* RR = BB + 2048; LAS float* VV = RR + 2048; LAS float* YO = VV + 2048;
    const int lat = u < 64, uu = lat ? u : u - 64, b = uu >> 3, e = (uu >> 2) & 1, hh = uu & 3;
    const int L = lat ? L_LAT : L_CTX, tok0 = lat ? T_CTX + b * L_LAT : b * L_CTX;
    const bf16* G1 = (const bf16*)(a->ws + WS_G1);
    bf16* YS = (bf16*)(a->ws + WS_G2);
    for (int i = tid; i < 4096; i += NTHREADS) { const int j = i >> 6, c = i & 63;
        W2s[i] = a->in[I_W2][((size_t)(layer * 2 + e) * 64 + j) * 256 + hh * 64 + c];
        A2s[i] = a->in[I_A2][((size_t)(layer * 2 + e) * 64 + j) * 256 + hh * 64 + c]; }
    const int r = tid >> 3, ks = tid & 7;
    float S[8];
#pragma unroll
    for (int j = 0; j < 8; ++j) S[j] = lat ? a->in[I_SRW][(((size_t)((b * 2 + layer) * 2 + e) * 4 + hh) * 64 + r) * 64 + ks * 8 + j] : 0.f;
    const int tt = tid >> 4, q4 = (tid & 15) * 4;
    float w0v[4], a0v[4], kkw[4], kav[4];
#pragma unroll
    for (int i = 0; i < 4; ++i) { const int ch = hh * 64 + q4 + i;
        w0v[i] = a->in[I_W0][(layer * 2 + e) * 256 + ch]; a0v[i] = a->in[I_A0][(layer * 2 + e) * 256 + ch]; kkw[i] = a->in[I_KK][layer * 256 + ch]; kav[i] = a->in[I_KA][layer * 256 + ch]; }
    __syncthreads();
    for (int c = 0; c < L / 32; ++c) {
        const int step = c * 32 + tt, t = e ? L - 1 - step : step, n = tok0 + t;
        const bf16* g = G1 + (size_t)n * G1W;
        { const v2u hw = *(const v2u*)(g + C_LORA + e * 64 + q4), ha = *(const v2u*)(g + C_LORA + 128 + e * 64 + q4);
          TH[tt * 64 + q4 + 0] = tanhf(bflo(hw.x)); TH[tt * 64 + q4 + 1] = tanhf(bfhi(hw.x)); TH[tt * 64 + q4 + 2] = tanhf(bflo(hw.y)); TH[tt * 64 + q4 + 3] = tanhf(bfhi(hw.y));
          HA[tt * 64 + q4 + 0] = bflo(ha.x); HA[tt * 64 + q4 + 1] = bfhi(ha.x); HA[tt * 64 + q4 + 2] = bflo(ha.y); HA[tt * 64 + q4 + 3] = bfhi(ha.y); }
        __syncthreads();
        {
            float wl[4], al[4];
#pragma unroll
            for (int i = 0; i < 4; ++i) { wl[i] = w0v[i]; al[i] = a0v[i]; }
            for (int j = 0; j < 64; ++j) { const float th = TH[tt * 64 + j], hv = HA[tt * 64 + j];
                const f32x4 w2 = *(const LAS f32x4*)(W2s + j * 64 + q4), a2 = *(const LAS f32x4*)(A2s + j * 64 + q4);
                wl[0] = fmaf(th, w2.x, wl[0]); wl[1] = fmaf(th, w2.y, wl[1]); wl[2] = fmaf(th, w2.z, wl[2]); wl[3] = fmaf(th, w2.w, wl[3]);
                al[0] = fmaf(hv, a2.x, al[0]); al[1] = fmaf(hv, a2.y, al[1]); al[2] = fmaf(hv, a2.z, al[2]); al[3] = fmaf(hv, a2.w, al[3]); }
            const v2u kv = *(const v2u*)(g + C_K + hh * 64 + q4), rv = *(const v2u*)(g + C_R + hh * 64 + q4), vv = *(const v2u*)(g + C_V + hh * 64 + q4);
            const float kx[4] = {bflo(kv.x), bfhi(kv.x), bflo(kv.y), bfhi(kv.y)}, rx[4] = {bflo(rv.x), bfhi(rv.x), bflo(rv.y), bfhi(rv.y)}, vx[4] = {bflo(vv.x), bfhi(vv.x), bflo(vv.y), bfhi(vv.y)};
            float kkr[4], ss = 0.f;
#pragma unroll
            for (int i = 0; i < 4; ++i) { kkr[i] = kx[i] * kkw[i]; ss += kkr[i] * kkr[i]; }
            ss += __shfl_xor(ss, 1); ss += __shfl_xor(ss, 2); ss += __shfl_xor(ss, 4); ss += __shfl_xor(ss, 8);
            const float inrm = rcp_(fmaxf(sqrt_(ss), 1e-12f));
#pragma unroll
            for (int i = 0; i < 4; ++i) {
                const float dec = exp_(-0.6065306597126334f * sigmoidf_(wl[i])), av = sigmoidf_(al[i]), kk = kkr[i] * inrm;
                const int o = tt * 64 + q4 + i;
                Wd[o] = dec; KT[o] = kx[i] * (1.f + (av - 1.f) * kav[i]); KK[o] = kk; BB[o] = kk * av; RR[o] = rx[i]; VV[o] = vx[i]; }
        }
        __syncthreads();
        for (int s = 0; s < 32; ++s) {
            const int o = s * 64 + ks * 8;
            const f32x4 k0 = *(const LAS f32x4*)(KK + o), k1 = *(const LAS f32x4*)(KK + o + 4);
            float p = S[0] * k0.x + S[1] * k0.y + S[2] * k0.z + S[3] * k0.w + S[4] * k1.x + S[5] * k1.y + S[6] * k1.z + S[7] * k1.w;
            p += __shfl_xor(p, 1); p += __shfl_xor(p, 2); p += __shfl_xor(p, 4);
            const float sa = -p, vv = VV[s * 64 + r];
            const f32x4 w0 = *(const LAS f32x4*)(Wd + o), w1 = *(const LAS f32x4*)(Wd + o + 4), b0 = *(const LAS f32x4*)(BB + o), b1 = *(const LAS f32x4*)(BB + o + 4);
            const f32x4 t0 = *(const LAS f32x4*)(KT + o), t1 = *(const LAS f32x4*)(KT + o + 4), r0 = *(const LAS f32x4*)(RR + o), r1 = *(const LAS f32x4*)(RR + o + 4);
            S[0] = S[0] * w0.x + sa * b0.x + vv * t0.x; S[1] = S[1] * w0.y + sa * b0.y + vv * t0.y; S[2] = S[2] * w0.z + sa * b0.z + vv * t0.z; S[3] = S[3] * w0.w + sa * b0.w + vv * t0.w;
            S[4] = S[4] * w1.x + sa * b1.x + vv * t1.x; S[5] = S[5] * w1.y + sa * b1.y + vv * t1.y; S[6] = S[6] * w1.z + sa * b1.z + vv * t1.z; S[7] = S[7] * w1.w + sa * b1.w + vv * t1.w;
            float y = S[0] * r0.x + S[1] * r0.y + S[2] * r0.z + S[3] * r0.w + S[4] * r1.x + S[5] * r1.y + S[6] * r1.z + S[7] * r1.w;
            y += __shfl_xor(y, 1); y += __shfl_xor(y, 2); y += __shfl_xor(y, 4);
            if (ks == 0) YO[s * 64 + r] = y;
        }
        __syncthreads();
        { v2u o; o.x = pk2(YO[tt * 64 + q4], YO[tt * 64 + q4 + 1]); o.y = pk2(YO[tt * 64 + q4 + 2], YO[tt * 64 + q4 + 3]);
          *(v2u*)(YS + ((size_t)e * T + n) * 256 + hh * 64 + q4) = o; }
        __syncthreads();
    }
    if (!lat) {
        float* dst = a->out + O_RW + (((size_t)((b * 2 + layer) * 2 + e) * 4 + hh) * 64 + r) * 64 + ks * 8;
        *(f32x4*)dst = (f32x4){S[0], S[1], S[2], S[3]}; *(f32x4*)(dst + 4) = (f32x4){S[4], S[5], S[6], S[7]};
    }
}

__device__ __forceinline__ void lru_unit_seq(ArgsP a, LAS unsigned char* lds, int layer, int u) {
    const int tid = tid_();
    LAS float* WA = (LAS float*)lds;
    LAS float* WX = WA + 4096;
    LAS float* XC = WX + 4096;
    LAS float* AA = XC + 4096; LAS float* BV = AA + 4096; LAS float* HH = BV + 4096;
    const int lat = u < 32, uu = lat ? u : u - 32, b = uu >> 2, g = uu & 3;
    const int L = lat ? L_LAT : L_CTX, tok0 = lat ? T_CTX + b * L_LAT : b * L_CTX;
    const bf16* G1 = (const bf16*)(a->ws + WS_G1);
    bf16* HF = (bf16*)(a->ws + WS_HF);
    const int tt = tid >> 3, q8 = (tid & 7) * 8;
    float cw[4][8], cb[8];
#pragma unroll
    for (int i = 0; i < 8; ++i) { const int ch = g * 64 + q8 + i; cb[i] = a->in[I_CONVB][layer * 256 + ch];
#pragma unroll
        for (int j = 0; j < 4; ++j) cw[j][i] = a->in[I_CONVW][(layer * 4 + j) * 256 + ch]; }
    for (int e = 0; e < 2; ++e) {
        __syncthreads();
        for (int i = tid; i < 4096; i += NTHREADS) { const size_t src = ((size_t)((layer * 2 + e) * 4 + g)) * 4096 + i; WA[i] = a->in[I_WA][src]; WX[i] = a->in[I_WX][src]; }
        float bav[8], bxv[8], spl[8];
#pragma unroll
        for (int i = 0; i < 8; ++i) { const int ch = (layer * 2 + e) * 256 + g * 64 + q8 + i; bav[i] = a->in[I_BA][ch]; bxv[i] = a->in[I_BX][ch]; spl[i] = log1pf(exp_(-a->in[I_LAMBDA][ch])); }
        float h = 0.f;
        if (tid < 64 && lat) h = a->in[I_SLRU][((size_t)(b * 2 + layer) * 2 + e) * 256 + g * 64 + tid];
        __syncthreads();
        for (int cc = 0; cc < L / 64; ++cc) {
            const int c = e ? L / 64 - 1 - cc : cc, t = c * 64 + tt, n = tok0 + t;
            {
                float xc[8];
#pragma unroll
                for (int i = 0; i < 8; ++i) xc[i] = cb[i];
#pragma unroll
                for (int j = 0; j < 4; ++j) { const int ts = t + j - 2;
                    if (ts >= 0 && ts < L) { const v4u x = *(const v4u*)(G1 + (size_t)(tok0 + ts) * G1W + C_XL + g * 64 + q8);
                        xc[0] += cw[j][0] * bflo(x.x); xc[1] += cw[j][1] * bfhi(x.x); xc[2] += cw[j][2] * bflo(x.y); xc[3] += cw[j][3] * bfhi(x.y);
                        xc[4] += cw[j][4] * bflo(x.z); xc[5] += cw[j][5] * bfhi(x.z); xc[6] += cw[j][6] * bflo(x.w); xc[7] += cw[j][7] * bfhi(x.w); } }
#pragma unroll
                for (int i = 0; i < 8; ++i) XC[tt * 64 + q8 + i] = xc[i];
            }
            __syncthreads();
            {
                float gr[8], gi[8];
#pragma unroll
                for (int i = 0; i < 8; ++i) { gr[i] = bav[i]; gi[i] = bxv[i]; }
                for (int i = 0; i < 64; ++i) { const float x = XC[tt * 64 + i];
                    const f32x4 a0 = *(const LAS f32x4*)(WA + i * 64 + q8), a1 = *(const LAS f32x4*)(WA + i * 64 + q8 + 4), x0 = *(const LAS f32x4*)(WX + i * 64 + q8), x1 = *(const LAS f32x4*)(WX + i * 64 + q8 + 4);
                    gr[0] = fmaf(x, a0.x, gr[0]); gr[1] = fmaf(x, a0.y, gr[1]); gr[2] = fmaf(x, a0.z, gr[2]); gr[3] = fmaf(x, a0.w, gr[3]);
                    gr[4] = fmaf(x, a1.x, gr[4]); gr[5] = fmaf(x, a1.y, gr[5]); gr[6] = fmaf(x, a1.z, gr[6]); gr[7] = fmaf(x, a1.w, gr[7]);
                    gi[0] = fmaf(x, x0.x, gi[0]); gi[1] = fmaf(x, x0.y, gi[1]); gi[2] = fmaf(x, x0.z, gi[2]); gi[3] = fmaf(x, x0.w, gi[3]);
                    gi[4] = fmaf(x, x1.x, gi[4]); gi[5] = fmaf(x, x1.y, gi[5]); gi[6] = fmaf(x, x1.z, gi[6]); gi[7] = fmaf(x, x1.w, gi[7]); }
#pragma unroll
                for (int i = 0; i < 8; ++i) { const float la = -8.f * sigmoidf_(gr[i]) * spl[i];
                    AA[tt * 64 + q8 + i] = exp_(la);
                    BV[tt * 64 + q8 + i] = sqrt_(-expm1f(2.f * la)) * sigmoidf_(gi[i]) * XC[tt * 64 + q8 + i]; }
            }
            __syncthreads();
            if (tid < 64) { for (int s = 0; s < 64; ++s) { const int st = e ? 63 - s : s; h = fmaf(AA[st * 64 + tid], h, BV[st * 64 + tid]); HH[st * 64 + tid] = h; } }
            __syncthreads();
            {
                bf16* dst = HF + (size_t)n * 256 + g * 64 + q8;
                float o[8];
#pragma unroll
                for (int i = 0; i < 8; ++i) o[i] = HH[tt * 64 + q8 + i];
                if (e) { const v4u hf = *(const v4u*)dst, gl = *(const v4u*)(G1 + (size_t)n * G1W + C_GL + g * 64 + q8);
                    o[0] = (o[0] + bflo(hf.x)) * siluf_(bflo(gl.x)); o[1] = (o[1] + bfhi(hf.x)) * siluf_(bfhi(gl.x)); o[2] = (o[2] + bflo(hf.y)) * siluf_(bflo(gl.y)); o[3] = (o[3] + bfhi(hf.y)) * siluf_(bfhi(gl.y));
                    o[4] = (o[4] + bflo(hf.z)) * siluf_(bflo(gl.z)); o[5] = (o[5] + bfhi(hf.z)) * siluf_(bfhi(gl.z)); o[6] = (o[6] + bflo(hf.w)) * siluf_(bflo(gl.w)); o[7] = (o[7] + bfhi(hf.w)) * siluf_(bfhi(gl.w)); }
                v4u ov; ov.x = pk2(o[0], o[1]); ov.y = pk2(o[2], o[3]); ov.z = pk2(o[4], o[5]); ov.w = pk2(o[6], o[7]);
                *(v4u*)dst = ov;
            }
            __syncthreads();
        }
        if (tid < 64 && !lat) a->out[O_LRU + ((size_t)(b * 2 + layer) * 2 + e) * 256 + g * 64 + tid] = h;
    }
}

__device__ __forceinline__ void phase_c1(ArgsP a, int layer) {
    const int tid = tid_(), lane = tid & 63, wave = tid >> 6, G = grid_();
    const bf16* G1 = (const bf16*)(a->ws + WS_G1); const bf16* YS = (const bf16*)(a->ws + WS_G2); const bf16* Q = (const bf16*)(a->ws + WS_Q); const bf16* HF = (const bf16*)(a->ws + WS_HF);
    bf16* Y = (bf16*)(a->ws + WS_YMIX);
    const int ch = lane * 4;
    const f32x4 rk = *(const f32x4*)(a->in[I_RK] + layer * 256 + ch), lg = *(const f32x4*)(a->in[I_LNXG] + layer * 256 + ch), lb = *(const f32x4*)(a->in[I_LNXB] + layer * 256 + ch);
    v2u p_y0, p_y1, p_r, p_k, p_v, p_g, p_h; v4u p_q;
#define C1_LOAD(nn) do { const bf16* g_ = G1 + (size_t)(nn) * G1W; p_y0 = *(const v2u*)(YS + (size_t)(nn) * 256 + ch); p_y1 = *(const v2u*)(YS + ((size_t)T + (nn)) * 256 + ch); \
        p_r = *(const v2u*)(g_ + C_R + ch); p_k = *(const v2u*)(g_ + C_K + ch); p_v = *(const v2u*)(g_ + C_V + ch); p_g = *(const v2u*)(g_ + C_G + ch); \
        p_q = *(const v4u*)(Q + (size_t)(nn) * 768 + (lane >> 3) * 96 + (lane & 7) * 8); p_h = *(const v2u*)(HF + (size_t)(nn) * 256 + ch); } while (0)
    { const int n0 = bid_() * 8 + wave; if (n0 < T) C1_LOAD(n0); }
    for (int n = bid_() * 8 + wave; n < T; n += G * 8) {
        const v2u y0 = p_y0, y1 = p_y1, rv = p_r, kv = p_k, vv = p_v, gv = p_g, hq = p_h; const v4u qq = p_q;
        if (n + G * 8 < T) C1_LOAD(n + G * 8);
        float y[4] = {bflo(y0.x) + bflo(y1.x), bfhi(y0.x) + bfhi(y1.x), bflo(y0.y) + bflo(y1.y), bfhi(y0.y) + bfhi(y1.y)};
        float s = (y[0] + y[1]) + (y[2] + y[3]);
        float bon = bflo(rv.x) * bflo(kv.x) * rk.x + bfhi(rv.x) * bfhi(kv.x) * rk.y + bflo(rv.y) * bflo(kv.y) * rk.z + bfhi(rv.y) * bfhi(kv.y) * rk.w;
#pragma unroll
        for (int o = 1; o < 16; o <<= 1) { s += __shfl_xor(s, o); bon += __shfl_xor(bon, o); }
        const float mu = s * (1.f / 64.f);
        float s2 = (y[0] - mu) * (y[0] - mu) + (y[1] - mu) * (y[1] - mu) + (y[2] - mu) * (y[2] - mu) + (y[3] - mu) * (y[3] - mu);
#pragma unroll
        for (int o = 1; o < 16; o <<= 1) s2 += __shfl_xor(s2, o);
        const float rstd = rsqrt_(s2 * (1.f / 64.f) + GN_EPS);
        const float o0 = ((y[0] - mu) * rstd * lg.x + lb.x + bon * bflo(vv.x)) * siluf_(bflo(gv.x));
        const float o1 = ((y[1] - mu) * rstd * lg.y + lb.y + bon * bfhi(vv.x)) * siluf_(bfhi(gv.x));
        const float o2 = ((y[2] - mu) * rstd * lg.z + lb.z + bon * bflo(vv.y)) * siluf_(bflo(gv.y));
        const float o3 = ((y[3] - mu) * rstd * lg.w + lb.w + bon * bfhi(vv.y)) * siluf_(bfhi(gv.y));
        v2u ov; ov.x = pk2(o0, o1); ov.y = pk2(o2, o3);
        bf16* yr = Y + (size_t)n * 1024;
        *(v2u*)(yr + ch) = ov;
        *(v4u*)(yr + 256 + (lane >> 3) * 64 + (lane & 7) * 8) = qq;
        *(v2u*)(yr + 768 + ch) = hq;
    }
#undef C1_LOAD
}
#define MFMA32(a, b, c) __builtin_amdgcn_mfma_f32_32x32x16_bf16((a), (b), (c), 0, 0, 0)
#define MFMA16(a, b, c) __builtin_amdgcn_mfma_f32_16x16x32_bf16((a), (b), (c), 0, 0, 0)
typedef short s16x4_t __attribute__((ext_vector_type(4)));

__device__ __forceinline__ float tanh_fast(float x) { return 1.f - 2.f * rcp_(1.f + exp_(2.f * x)); }

constexpr int ATT_KSTR = 208, ATT_VSTR = 136, ATT_VOFF = 64 * ATT_KSTR, ATT_STAGE = 64 * ATT_KSTR + 64 * ATT_VSTR;
__device__ __forceinline__ void att_unit(ArgsP a, LAS unsigned char* lds, int u) {
    const int tid = tid_(), lane = tid & 63, wave = tid >> 6, r = lane & 31, hq = lane >> 5;
    const bf16* KN = (const bf16*)(a->ws + WS_KN); const bf16* KR = (const bf16*)(a->ws + WS_KR); const bf16* VT = (const bf16*)(a->ws + WS_VT);
    bf16* Q = (bf16*)(a->ws + WS_Q); const bf16* G1 = (const bf16*)(a->ws + WS_G1);
    int b, h, n0, Lk, kidx0; size_t vbase;
    if (u < 512) { b = u >> 6; h = (u >> 3) & 7; n0 = T_CTX + b * 2048 + (u & 7) * 256; Lk = LK_LAT; kidx0 = T_CTX + b * LK_LAT; vbase = (size_t)VT_LAT + (size_t)(b * 8 + h) * 64 * LK_LAT; }
    else { const int uu = u - 512; b = uu >> 3; h = uu & 7; n0 = b * 256; Lk = 256; kidx0 = b * 256; vbase = (size_t)(b * 8 + h) * 64 * 256; }
    const int ntiles = Lk >> 6;
    const int n = n0 + wave * 32 + r;
    bf16x8 qf[6];
#pragma unroll
    for (int ks = 0; ks < 6; ++ks) qf[ks] = *(const bf16x8*)(Q + (size_t)n * 768 + h * 96 + ks * 16 + 8 * hq);
    const int key_k = tid >> 3, ck = tid & 7, key_r = (tid >> 2) & 63, cr = tid & 3;
    const bf16* gk = KN + (size_t)(kidx0 + key_k) * 512 + h * 64 + ck * 8;
    const bf16* gr = KR + (size_t)(kidx0 + key_r) * 32 + cr * 8;
    const bf16* gv = VT + vbase + (size_t)key_k * Lk + ck * 8;
    const unsigned sk = key_k * ATT_KSTR + ck * 16, sr = key_r * ATT_KSTR + 128 + cr * 16, sv = ATT_VOFF + key_k * ATT_VSTR + ck * 16;
    v4u rk, rr, rv;
    rk = *(const v4u*)gk; rr = (tid < 256) ? *(const v4u*)gr : (v4u){0u, 0u, 0u, 0u}; rv = *(const v4u*)gv;
    __syncthreads();
    *(LAS v4u*)(lds + sk) = rk; if (tid < 256) *(LAS v4u*)(lds + sr) = rr;
    *(LAS v2u*)(lds + sv) = (v2u){rv.x, rv.y}; *(LAS v2u*)(lds + sv + 8) = (v2u){rv.z, rv.w};
    __syncthreads();
    f32x16 o0, o1;
#pragma unroll
    for (int i = 0; i < 16; ++i) { o0[i] = 0.f; o1[i] = 0.f; }
    float m = -1e30f, l = 0.f;
    for (int j = 0; j < ntiles; ++j) {
        const int buf = j & 1;
        if (j + 1 < ntiles) { rk = *(const v4u*)(gk + (size_t)(j + 1) * 64 * 512); if (tid < 256) rr = *(const v4u*)(gr + (size_t)(j + 1) * 64 * 32); rv = *(const v4u*)(gv + (j + 1) * 64); }
        const LAS unsigned char* Kb = lds + buf * ATT_STAGE;
        f32x16 s0, s1;
#pragma unroll
        for (int i = 0; i < 16; ++i) { s0[i] = 0.f; s1[i] = 0.f; }
#pragma unroll
        for (int ks = 0; ks < 6; ++ks) {
            const bf16x8 a0 = *(const LAS bf16x8*)(Kb + r * ATT_KSTR + ks * 32 + hq * 16), a1 = *(const LAS bf16x8*)(Kb + (32 + r) * ATT_KSTR + ks * 32 + hq * 16);
            s0 = MFMA32(a0, qf[ks], s0); s1 = MFMA32(a1, qf[ks], s1);
        }
        float mx = s0[0];
#pragma unroll
        for (int i = 1; i < 16; ++i) mx = fmaxf(mx, s0[i]);
#pragma unroll
        for (int i = 0; i < 16; ++i) mx = fmaxf(mx, s1[i]);
        mx = fmaxf(mx, __shfl_xor(mx, 32));
        const float mn = fmaxf(m, mx), alpha = __builtin_amdgcn_exp2f(m - mn); m = mn;
        float ps = 0.f;
#pragma unroll
        for (int i = 0; i < 16; ++i) { s0[i] = __builtin_amdgcn_exp2f(s0[i] - mn); s1[i] = __builtin_amdgcn_exp2f(s1[i] - mn); ps += s0[i] + s1[i]; }
        l = l * alpha + ps;
#pragma unroll
        for (int i = 0; i < 16; ++i) { o0[i] *= alpha; o1[i] *= alpha; }
        const LAS unsigned char* Vb = Kb + ATT_VOFF;
#pragma unroll
        for (int ks = 0; ks < 4; ++ks) {
            v4u pw;
            if (ks == 0) { pw.x = cvtpk(s0[0], s0[1]); pw.y = cvtpk(s0[2], s0[3]); pw.z = cvtpk(s0[4], s0[5]); pw.w = cvtpk(s0[6], s0[7]); }
            else if (ks == 1) { pw.x = cvtpk(s0[8], s0[9]); pw.y = cvtpk(s0[10], s0[11]); pw.z = cvtpk(s0[12], s0[13]); pw.w = cvtpk(s0[14], s0[15]); }
            else if (ks == 2) { pw.x = cvtpk(s1[0], s1[1]); pw.y = cvtpk(s1[2], s1[3]); pw.z = cvtpk(s1[4], s1[5]); pw.w = cvtpk(s1[6], s1[7]); }
            else { pw.x = cvtpk(s1[8], s1[9]); pw.y = cvtpk(s1[10], s1[11]); pw.z = cvtpk(s1[12], s1[13]); pw.w = cvtpk(s1[14], s1[15]); }
            const bf16x8 pf = __builtin_bit_cast(bf16x8, pw);
            const v2u va0 = *(const LAS v2u*)(Vb + r * ATT_VSTR + ks * 32 + hq * 8), va1 = *(const LAS v2u*)(Vb + r * ATT_VSTR + ks * 32 + 16 + hq * 8);
            const v2u vb0 = *(const LAS v2u*)(Vb + (32 + r) * ATT_VSTR + ks * 32 + hq * 8), vb1 = *(const LAS v2u*)(Vb + (32 + r) * ATT_VSTR + ks * 32 + 16 + hq * 8);
            const v4u vwa = {va0.x, va0.y, va1.x, va1.y}, vwb = {vb0.x, vb0.y, vb1.x, vb1.y};
            o0 = MFMA32(__builtin_bit_cast(bf16x8, vwa), pf, o0); o1 = MFMA32(__builtin_bit_cast(bf16x8, vwb), pf, o1);
        }
        if (j + 1 < ntiles) {
            LAS unsigned char* Nb = lds + (buf ^ 1) * ATT_STAGE;
            *(LAS v4u*)(Nb + sk) = rk; if (tid < 256) *(LAS v4u*)(Nb + sr) = rr;
            *(LAS v2u*)(Nb + sv) = (v2u){rv.x, rv.y}; *(LAS v2u*)(Nb + sv + 8) = (v2u){rv.z, rv.w};
        }
        __syncthreads();
    }
    l += __shfl_xor(l, 32);
    const float inv = rcp_(l);
#pragma unroll
    for (int mt = 0; mt < 2; ++mt)
#pragma unroll
        for (int g = 0; g < 4; ++g) {
            const int dv0 = 32 * mt + 8 * g + 4 * hq;
            const v2u gm = *(const v2u*)(G1 + (size_t)n * G1W + C_GM + h * 64 + dv0);
            const float x0 = (mt ? o1[4 * g + 0] : o0[4 * g + 0]) * inv, x1 = (mt ? o1[4 * g + 1] : o0[4 * g + 1]) * inv, x2 = (mt ? o1[4 * g + 2] : o0[4 * g + 2]) * inv, x3 = (mt ? o1[4 * g + 3] : o0[4 * g + 3]) * inv;
            v2u ov; ov.x = cvtpk(x0 * siluf_(bflo(gm.x)), x1 * siluf_(bfhi(gm.x))); ov.y = cvtpk(x2 * siluf_(bflo(gm.y)), x3 * siluf_(bfhi(gm.y)));
            *(v2u*)(Q + (size_t)n * 768 + h * 96 + dv0) = ov;
        }
}

constexpr int A2_QSTR = 528, A2_KVSTR = 272, A2_KVOFF = 64 * A2_QSTR;
__device__ __forceinline__ void a2_unit(ArgsP a, LAS unsigned char* lds, int layer, int unit) {
    const int tid = tid_(), lane = tid & 63, wave = tid >> 6, tn = lane & 15, g = lane >> 4;
    constexpr int NU_TOK = T / 64;
    const bool is_tok = unit < NU_TOK;
    const bf16* G2 = (const bf16*)(a->ws + WS_G2);
    bf16* Q = (bf16*)(a->ws + WS_Q); bf16* KN = (bf16*)(a->ws + WS_KN); bf16* KR = (bf16*)(a->ws + WS_KR); bf16* VT = (bf16*)(a->ws + WS_VT);
    const bf16* WUQ = (const bf16*)(a->ws + WS_WUQ) + (size_t)layer * 768 * 256;
    const bf16* WUKV = (const bf16*)(a->ws + WS_WUKV) + (size_t)layer * 1024 * 128;
    const float* ROPE1 = (const float*)(a->ws + WS_ROPE);
    __syncthreads();
    v2u cq8[8], kv8[8]; unsigned kr8[8];
    if (is_tok) {
#pragma unroll
        for (int rr = 0; rr < 8; ++rr) { const size_t n_ = (size_t)(unit * 64 + wave * 8 + rr);
            cq8[rr] = *(const v2u*)(G2 + n_ * G2W + lane * 4); kv8[rr] = *(const v2u*)(G2 + n_ * G2W + 256 + (lane & 31) * 4); kr8[rr] = G2[n_ * G2W + 384 + (lane & 31)]; }
    }
#pragma unroll
    for (int rr = 0; rr < 8; ++rr) {
        const int r = wave * 8 + rr;
        if (is_tok) {
            const int n = unit * 64 + r; const Tok tk = tok_of(n);
            const v2u cqv = cq8[rr];
            const float c0 = bflo(cqv.x), c1 = bfhi(cqv.x), c2 = bflo(cqv.y), c3 = bfhi(cqv.y);
            const float rq = rsqrt_(wave_sum(c0 * c0 + c1 * c1 + c2 * c2 + c3 * c3) * (1.f / 256.f) + 1e-6f);
            const f32x4 qn = *(const f32x4*)(a->in[I_QNORM] + layer * 256 + lane * 4);
            *(LAS v2u*)(lds + r * A2_QSTR + lane * 8) = (v2u){cvtpk(c0 * rq * qn.x, c1 * rq * qn.y), cvtpk(c2 * rq * qn.z, c3 * rq * qn.w)};
            float k0 = 0.f, k1 = 0.f, k2 = 0.f, k3 = 0.f;
            if (lane < 32) { const v2u kv = kv8[rr]; k0 = bflo(kv.x); k1 = bfhi(kv.x); k2 = bflo(kv.y); k3 = bfhi(kv.y); }
            const float rk = rsqrt_(wave_sum(k0 * k0 + k1 * k1 + k2 * k2 + k3 * k3) * (1.f / 128.f) + 1e-6f);
            if (lane < 32) {
                const f32x4 kn = *(const f32x4*)(a->in[I_KVNORM] + layer * 128 + lane * 4);
                f32x4 o; o.x = k0 * rk * kn.x; o.y = k1 * rk * kn.y; o.z = k2 * rk * kn.z; o.w = k3 * rk * kn.w;
                if (!tk.lat) *(f32x4*)(a->out + O_CKV + ((size_t)(tk.b * 2 + layer) * 256 + tk.t) * 128 + lane * 4) = o;
                *(LAS v2u*)(lds + A2_KVOFF + r * A2_KVSTR + lane * 8) = (v2u){cvtpk(o.x, o.y), cvtpk(o.z, o.w)};
            }
            float krv = (lane < 32) ? bf2f(kr8[rr]) : 0.f;
            const float other = __shfl_xor(krv, 1);
            if (lane < 32) {
                if (!tk.lat) a->out[O_KR + ((size_t)(tk.b * 2 + layer) * 256 + tk.t) * 32 + lane] = krv;
                else { const float c = ROPE1[((size_t)tk.t * 16 + (lane >> 1)) * 2], s = ROPE1[((size_t)tk.t * 16 + (lane >> 1)) * 2 + 1]; krv = (lane & 1) ? (other * s + krv * c) : (krv * c - other * s); }
                KR[(size_t)tk.kidx * 32 + lane] = (bf16)f2bf(krv);
            }
        } else {
            const int cr = (unit - NU_TOK) * 64 + r, b = cr >> 8, j = cr & 255;
            const size_t src = ((size_t)(b * 2 + layer) * 256 + j);
            if (lane < 32) { const f32x4 v = *(const f32x4*)(a->in[I_CCKV] + src * 128 + lane * 4);
                *(LAS v2u*)(lds + A2_KVOFF + r * A2_KVSTR + lane * 8) = (v2u){cvtpk(v.x, v.y), cvtpk(v.z, v.w)};
                KR[(size_t)(T_CTX + b * LK_LAT + j) * 32 + lane] = (bf16)f2bf(a->in[I_CKR][src * 32 + lane]); }
        }
    }
    __syncthreads();
    constexpr int A2_STG = 52224, A2_SQSTR = 784, A2_SKSTR = 1040, A2_SVSTR = 144;
    const int n0 = is_tok ? unit * 64 : 0;
    if (is_tok) {
      const float* ROPE = (const float*)(a->ws + WS_ROPE);
      for (int qh = 0; qh < 2; ++qh) {
        f32x4 acc[3][4];
#pragma unroll
        for (int f = 0; f < 3; ++f)
#pragma unroll
            for (int t = 0; t < 4; ++t) acc[f][t] = (f32x4){0.f, 0.f, 0.f, 0.f};
        bf16x8 afq[3][8];
        const bf16* wq = WUQ + (size_t)((qh * 24 + wave * 3) * 16 + tn) * 256 + g * 8;
#pragma unroll
        for (int f = 0; f < 3; ++f)
#pragma unroll
            for (int ks = 0; ks < 8; ++ks) afq[f][ks] = *(const bf16x8*)(wq + f * 16 * 256 + ks * 32);
#pragma unroll
        for (int ks = 0; ks < 8; ++ks) {
            bf16x8 bfr[4];
#pragma unroll
            for (int t = 0; t < 4; ++t) bfr[t] = *(const LAS bf16x8*)(lds + (t * 16 + tn) * A2_QSTR + ks * 64 + g * 16);
#pragma unroll
            for (int f = 0; f < 3; ++f)
#pragma unroll
                for (int t = 0; t < 4; ++t) acc[f][t] = MFMA16(afq[f][ks], bfr[t], acc[f][t]);
        }
#pragma unroll
        for (int f = 0; f < 3; ++f) { const int fl = (wave * 3 + f) * 16 + 4 * g, f0 = qh * 384 + fl, d = f0 % 96;
#pragma unroll
            for (int t = 0; t < 4; ++t) { const int r = t * 16 + tn, n = n0 + r;
                float v0 = acc[f][t][0], v1 = acc[f][t][1], v2 = acc[f][t][2], v3 = acc[f][t][3];
                if (n >= T_CTX && d >= 64) { const int tt = (n - T_CTX) & 2047; const f32x4 cs = *(const f32x4*)(ROPE + ((size_t)tt * 16 + ((d - 64) >> 1)) * 2);
                    const float y0 = v0 * cs.x - v1 * cs.y, y1 = v0 * cs.y + v1 * cs.x, y2 = v2 * cs.z - v3 * cs.w, y3 = v2 * cs.w + v3 * cs.z; v0 = y0; v1 = y1; v2 = y2; v3 = y3; }
                *(LAS v2u*)(lds + A2_STG + r * A2_SQSTR + fl * 2) = (v2u){cvtpk(v0, v1), cvtpk(v2, v3)}; } }
        __syncthreads();
#pragma unroll
        for (int i = 0; i < 6; ++i) { const int c = tid + 512 * i, row = c / 48, c16 = c % 48;
            *(v4u*)(Q + (size_t)(n0 + row) * 768 + qh * 384 + c16 * 8) = *(const LAS v4u*)(lds + A2_STG + row * A2_SQSTR + c16 * 16); }
        __syncthreads();
      }
    }
    int kidx0, latu, bu, kpos0;
    if (is_tok) { const Tok tk = tok_of(n0); kidx0 = tk.kidx; latu = tk.lat; bu = tk.b; kpos0 = tk.lat ? PAST + tk.t : tk.t; }
    else { const int cr = (unit - NU_TOK) * 64; bu = cr >> 8; kpos0 = cr & 255; latu = 1; kidx0 = T_CTX + bu * LK_LAT + kpos0; }
    for (int half = 0; half < 2; ++half) {
        f32x4 acc[4][4];
#pragma unroll
        for (int f = 0; f < 4; ++f)
#pragma unroll
            for (int t = 0; t < 4; ++t) acc[f][t] = (f32x4){0.f, 0.f, 0.f, 0.f};
        bf16x8 afk[4][4];
        const bf16* wk = WUKV + (size_t)(wave * 128 + half * 64 + tn) * 128 + g * 8;
#pragma unroll
        for (int f = 0; f < 4; ++f)
#pragma unroll
            for (int ks = 0; ks < 4; ++ks) afk[f][ks] = *(const bf16x8*)(wk + f * 16 * 128 + ks * 32);
#pragma unroll
        for (int ks = 0; ks < 4; ++ks) {
            bf16x8 bfr[4];
#pragma unroll
            for (int t = 0; t < 4; ++t) bfr[t] = *(const LAS bf16x8*)(lds + A2_KVOFF + (t * 16 + tn) * A2_KVSTR + ks * 64 + g * 16);
#pragma unroll
            for (int f = 0; f < 4; ++f)
#pragma unroll
                for (int t = 0; t < 4; ++t) acc[f][t] = MFMA16(afk[f][ks], bfr[t], acc[f][t]);
        }
#pragma unroll
        for (int f = 0; f < 4; ++f) { const int x = wave * 64 + f * 16 + 4 * g;
#pragma unroll
            for (int t = 0; t < 4; ++t) { const int r = t * 16 + tn;
                if (half == 0) *(LAS v2u*)(lds + A2_STG + r * A2_SKSTR + x * 2) = (v2u){cvtpk(acc[f][t][0], acc[f][t][1]), cvtpk(acc[f][t][2], acc[f][t][3])};
                else { const unsigned p01 = cvtpk(acc[f][t][0], acc[f][t][1]), p23 = cvtpk(acc[f][t][2], acc[f][t][3]);
                    *(LAS bf16*)(lds + A2_STG + (x + 0) * A2_SVSTR + r * 2) = (bf16)(p01 & 0xffffu); *(LAS bf16*)(lds + A2_STG + (x + 1) * A2_SVSTR + r * 2) = (bf16)(p01 >> 16);
                    *(LAS bf16*)(lds + A2_STG + (x + 2) * A2_SVSTR + r * 2) = (bf16)(p23 & 0xffffu); *(LAS bf16*)(lds + A2_STG + (x + 3) * A2_SVSTR + r * 2) = (bf16)(p23 >> 16); } } }
        __syncthreads();
        if (half == 0) {
#pragma unroll
            for (int i = 0; i < 8; ++i) { const int c = tid + 512 * i, row = c >> 6, c16 = c & 63;
                *(v4u*)(KN + (size_t)(kidx0 + row) * 512 + c16 * 8) = *(const LAS v4u*)(lds + A2_STG + row * A2_SKSTR + c16 * 16); }
        } else {
            const int Lk = latu ? LK_LAT : 256;
#pragma unroll
            for (int i = 0; i < 8; ++i) { const int c = tid + 512 * i, row = c >> 3, part = c & 7, h = row >> 6, dv = row & 63;
                const size_t base = latu ? (size_t)VT_LAT + ((size_t)(bu * 8 + h) * 64 + dv) * LK_LAT : ((size_t)(bu * 8 + h) * 64 + dv) * 256;
                *(v4u*)(VT + base + kpos0 + part * 8) = *(const LAS v4u*)(lds + A2_STG + row * A2_SVSTR + part * 16); }
            (void)Lk;
        }
        __syncthreads();
    }
}

constexpr int RW_W2T = 0, RW_A2T = 9216, RW_TH = 18432, RW_HA = 27648, RW_CH0 = 36864, RW_CHB = 20992, RW_YB = 120832;
constexpr int RC_KP = 0, RC_RP = 2304, RC_BP = 4608  , RC_KT = 6912, RC_VR = 9216  , RC_LK = 16896, RC_TM = 17536, RC_ARK = 18176, RC_NARB = 18816, RC_G15 = 19456, RC_LBF = 19712, RC_SSQ = 20736;
template <int MODE = 0> __device__ __forceinline__ void rwkv_unit_mfma(ArgsP a, LAS unsigned char* lds, int layer, int u) {
    const int tid = tid_(), lane = tid & 63, wave = tid >> 6, i16 = lane & 15, g = lane >> 4;
    const int lat = u < 64, uu = lat ? u : u - 64, b = uu >> 3, e = (uu >> 2) & 1, hh = uu & 3;
    const int L = lat ? L_LAT : L_CTX, tok0 = lat ? T_CTX + b * L_LAT : b * L_CTX;
    const bf16* G1 = (const bf16*)(a->ws + WS_G1);
    bf16* YS = (bf16*)(a->ws + WS_G2);
    __syncthreads();
    { const bf16* wsrc = (const bf16*)(a->ws + WS_LORA2) + ((size_t)((layer * 2 + e) * 2) * 256 + hh * 64) * 64; const int row = tid >> 3, c8 = (tid & 7) * 8;
      *(LAS v4u*)(lds + RW_W2T + row * 144 + c8 * 2) = *(const v4u*)(wsrc + row * 64 + c8);
      *(LAS v4u*)(lds + RW_A2T + row * 144 + c8 * 2) = *(const v4u*)(wsrc + 256 * 64 + row * 64 + c8); }
    const int st_tok = tid >> 3, st_c8 = (tid & 7) * 8;
#define RW_STAGE(sc) do { const int step_ = (sc) * 64 + st_tok, t_ = e ? L - 1 - step_ : step_; const bf16* gp_ = G1 + (size_t)(tok0 + t_) * G1W + C_LORA + e * 64 + st_c8; \
        const v4u hw_ = *(const v4u*)gp_, ha_ = *(const v4u*)(gp_ + 128); v4u th_; \
        th_.x = cvtpk(tanh_fast(bflo(hw_.x)), tanh_fast(bfhi(hw_.x))); th_.y = cvtpk(tanh_fast(bflo(hw_.y)), tanh_fast(bfhi(hw_.y))); th_.z = cvtpk(tanh_fast(bflo(hw_.z)), tanh_fast(bfhi(hw_.z))); th_.w = cvtpk(tanh_fast(bflo(hw_.w)), tanh_fast(bfhi(hw_.w))); \
        *(LAS v4u*)(lds + RW_TH + st_tok * 144 + st_c8 * 2) = th_; *(LAS v4u*)(lds + RW_HA + st_tok * 144 + st_c8 * 2) = ha_; } while (0)
    RW_STAGE(0);
    f32x4 ST[4];
    {
        const int v = 16 * (wave & 3) + i16;
#pragma unroll
        for (int kt = 0; kt < 4; ++kt) ST[kt] = lat ? *(const f32x4*)(a->in[I_SRW] + (((size_t)((b * 2 + layer) * 2 + e) * 4 + hh) * 64 + v) * 64 + 16 * kt + 4 * g) : (f32x4){0.f, 0.f, 0.f, 0.f};
    }
    const int pc = wave & 3, ph = wave >> 2;
    LAS unsigned char* CH = lds + RW_CH0 + pc * RW_CHB;
    f32x4 w0r[2], a0r[2], kwr[2], kar[2];
#pragma unroll
    for (int c2 = 0; c2 < 2; ++c2) { const int gch = hh * 64 + (2 * ph + c2) * 16 + 4 * g;
        w0r[c2] = *(const f32x4*)(a->in[I_W0] + (layer * 2 + e) * 256 + gch); a0r[c2] = *(const f32x4*)(a->in[I_A0] + (layer * 2 + e) * 256 + gch);
        kwr[c2] = *(const f32x4*)(a->in[I_KK] + layer * 256 + gch); kar[c2] = *(const f32x4*)(a->in[I_KA] + layer * 256 + gch); }
#pragma unroll
    for (int c2 = 0; c2 < 2; ++c2) asm volatile("" : "+v"(w0r[c2]), "+v"(a0r[c2]), "+v"(kwr[c2]), "+v"(kar[c2]));
#pragma unroll
    for (int kt = 0; kt < 4; ++kt) asm volatile("" : "+v"(ST[kt]));
    __syncthreads();
    const int nsc = L >> 6;
    v2u pk[2], pr[2], pv[2];
#define RW_PREFETCH(sc) do { const int ps_ = (sc) * 64 + pc * 16 + i16, pt_ = e ? L - 1 - ps_ : ps_; const bf16* gq_ = G1 + (size_t)(tok0 + pt_) * G1W + hh * 64 + (2 * ph) * 16 + 4 * g; \
        pk[0] = *(const v2u*)(gq_ + C_K); pk[1] = *(const v2u*)(gq_ + C_K + 16); pr[0] = *(const v2u*)(gq_ + C_R); pr[1] = *(const v2u*)(gq_ + C_R + 16); pv[0] = *(const v2u*)(gq_ + C_V); pv[1] = *(const v2u*)(gq_ + C_V + 16); } while (0)
    RW_PREFETCH(0);
    for (int sc = 0; sc < nsc; ++sc) {
        const v2u ck[2] = {pk[0], pk[1]}, cr[2] = {pr[0], pr[1]}, cv[2] = {pv[0], pv[1]};
        if (sc + 1 < nsc) RW_PREFETCH(sc + 1);
        float dec[8], av[8], kx[8], rx[8], kk[8];
        {
            f32x4 aw[2], aa[2];
#pragma unroll
            for (int c2 = 0; c2 < 2; ++c2) { aw[c2] = (f32x4){0.f, 0.f, 0.f, 0.f}; aa[c2] = (f32x4){0.f, 0.f, 0.f, 0.f}; }
#pragma unroll
            for (int ks = 0; ks < 2; ++ks) {
                const bf16x8 bth = *(const LAS bf16x8*)(lds + RW_TH + (pc * 16 + i16) * 144 + ks * 64 + g * 16), bha = *(const LAS bf16x8*)(lds + RW_HA + (pc * 16 + i16) * 144 + ks * 64 + g * 16);
#pragma unroll
                for (int c2 = 0; c2 < 2; ++c2) { const int row = (2 * ph + c2) * 16 + i16;
                    const bf16x8 w2f = *(const LAS bf16x8*)(lds + RW_W2T + row * 144 + ks * 64 + g * 16), a2f = *(const LAS bf16x8*)(lds + RW_A2T + row * 144 + ks * 64 + g * 16);
                    aw[c2] = MFMA16(w2f, bth, aw[c2]); aa[c2] = MFMA16(a2f, bha, aa[c2]); }
            }
            float ss = 0.f;
#pragma unroll
            for (int c2 = 0; c2 < 2; ++c2) {
                const f32x4 w0 = w0r[c2], a0 = a0r[c2], kw = kwr[c2];
                const v2u kv = ck[c2], rv = cr[c2];
                const float kq[4] = {bflo(kv.x), bfhi(kv.x), bflo(kv.y), bfhi(kv.y)}, rq[4] = {bflo(rv.x), bfhi(rv.x), bflo(rv.y), bfhi(rv.y)};
#pragma unroll
                for (int q = 0; q < 4; ++q) { const int o = c2 * 4 + q;
                    dec[o] = exp_(-0.6065306597126334f * sigmoidf_(aw[c2][q] + w0[q])); av[o] = sigmoidf_(aa[c2][q] + a0[q]);
                    kx[o] = kq[q]; rx[o] = rq[q]; kk[o] = kq[q] * kw[q]; ss += kk[o] * kk[o]; }
            }
            ss += __shfl_xor(ss, 16); ss += __shfl_xor(ss, 32);
            if (g == 0) *(LAS float*)(CH + RC_SSQ + (i16 * 2 + ph) * 4) = ss;
        }
        __syncthreads();
        {
            const float tot = *(const LAS float*)(CH + RC_SSQ + (i16 * 2) * 4) + *(const LAS float*)(CH + RC_SSQ + (i16 * 2 + 1) * 4);
            const float inrm = rcp_(fmaxf(sqrt_(tot), 1e-12f));
            float G8[8], Gx8[8];
#pragma unroll
            for (int o8 = 0; o8 < 8; ++o8) G8[o8] = dec[o8];
#pragma unroll
            for (int o8 = 0; o8 < 8; ++o8) G8[o8] *= dpp_f<0x111>(1.f, G8[o8]);
#pragma unroll
            for (int o8 = 0; o8 < 8; ++o8) G8[o8] *= dpp_f<0x112>(1.f, G8[o8]);
#pragma unroll
            for (int o8 = 0; o8 < 8; ++o8) G8[o8] *= dpp_f<0x114>(1.f, G8[o8]);
#pragma unroll
            for (int o8 = 0; o8 < 8; ++o8) G8[o8] *= dpp_f<0x118>(1.f, G8[o8]);
#pragma unroll
            for (int o8 = 0; o8 < 8; ++o8) Gx8[o8] = dpp_f<0x111>(1.f, G8[o8]);
#pragma unroll
            for (int c2 = 0; c2 < 2; ++c2) { const int ch = (2 * ph + c2) * 16 + 4 * g;
                const f32x4 ka = kar[c2];
                float kp[4], bp[4], kt[4], rp[4];
#pragma unroll
                for (int q = 0; q < 4; ++q) { const int o = c2 * 4 + q;
                    const float G = G8[o], Gex = Gx8[o];
                    const float kkn = kk[o] * inrm, iG = rcp_(G);
                    kp[q] = Gex * kkn; bp[q] = kkn * av[o] * iG; kt[q] = kx[o] * (1.f + (av[o] - 1.f) * ka[q]) * iG; rp[q] = G * rx[o];
                    if (i16 == 15) *(LAS float*)(CH + RC_G15 + (ch + q) * 4) = G;
                }
                *(LAS v2u*)(CH + RC_KP + i16 * 144 + ch * 2) = (v2u){cvtpk(kp[0], kp[1]), cvtpk(kp[2], kp[3])};
                *(LAS v2u*)(CH + RC_BP + i16 * 144 + ch * 2) = (v2u){cvtpk(-bp[0], -bp[1]), cvtpk(-bp[2], -bp[3])};
                *(LAS v2u*)(CH + RC_KT + i16 * 144 + ch * 2) = (v2u){cvtpk(kt[0], kt[1]), cvtpk(kt[2], kt[3])};
                *(LAS v2u*)(CH + RC_RP + i16 * 144 + ch * 2) = (v2u){cvtpk(rp[0], rp[1]), cvtpk(rp[2], rp[3])};
                *(LAS v2u*)(CH + RC_VR + i16 * 144 + ch * 2) = cv[c2];
            }
        }
        __syncthreads();
        {
            f32x4 d0 = (f32x4){0.f, 0.f, 0.f, 0.f}, d1 = (f32x4){0.f, 0.f, 0.f, 0.f};
            const int xoff = ph ? RC_KP : RC_RP, y0off = ph ? RC_BP : RC_KT, y1off = ph ? RC_KT : RC_BP;
#pragma unroll
            for (int ks = 0; ks < 2; ++ks) {
                const bf16x8 xf = *(const LAS bf16x8*)(CH + xoff + i16 * 144 + ks * 64 + g * 16);
                const bf16x8 y0 = *(const LAS bf16x8*)(CH + y0off + i16 * 144 + ks * 64 + g * 16), y1 = *(const LAS bf16x8*)(CH + y1off + i16 * 144 + ks * 64 + g * 16);
                d0 = MFMA16(xf, y0, d0); d1 = MFMA16(xf, y1, d1);
            }
#pragma unroll
            for (int q = 0; q < 4; ++q) { const int i = 4 * g + q, j = i16;
                if (ph) { *(LAS float*)(CH + RC_LBF + (i * 16 + j) * 4) = (j < i) ? -d0[q] : 0.f; *(LAS bf16*)(CH + RC_LK + i * 40 + j * 2) = (bf16)(cvtpk((j < i) ? d1[q] : 0.f, 0.f) & 0xffffu); }
                else { const unsigned pk_ = cvtpk((j <= i) ? d0[q] : 0.f, (j <= i) ? d1[q] : 0.f); *(LAS bf16*)(CH + RC_ARK + i * 40 + j * 2) = (bf16)(pk_ & 0xffffu); *(LAS bf16*)(CH + RC_NARB + i * 40 + j * 2) = (bf16)(pk_ >> 16); }
            }
            if (ph && !(MODE & 2)) {
                float x[16];
#pragma unroll
                for (int i = 0; i < 16; ++i) { float s = (i == i16) ? 1.f : 0.f;
#pragma unroll
                    for (int j4 = 0; j4 < (i + 3) / 4; ++j4) { const f32x4 lr = *(const LAS f32x4*)(CH + RC_LBF + (i * 16 + j4 * 4) * 4);
#pragma unroll
                        for (int jj = 0; jj < 4; ++jj) { const int j = j4 * 4 + jj; if (j < i) s -= lr[jj] * x[j]; } }
                    x[i] = s; }
                if (g == 0) {
#pragma unroll
                    for (int i = 0; i < 16; i += 2) { const unsigned pk_ = cvtpk(x[i], x[i + 1]); *(LAS bf16*)(CH + RC_TM + i * 40 + i16 * 2) = (bf16)(pk_ & 0xffffu); *(LAS bf16*)(CH + RC_TM + (i + 1) * 40 + i16 * 2) = (bf16)(pk_ >> 16); } }
            }
        }
        __syncthreads();
        if (wave < 4) {
            const int vt = wave;
#pragma unroll 1
            for (int c = 0; c < ((MODE & 1) ? 0 : 4); ++c) {
                const LAS unsigned char* C = lds + RW_CH0 + c * RW_CHB;
                v4u sb01, sb23;
                sb01.x = cvtpk(ST[0][0], ST[0][1]); sb01.y = cvtpk(ST[0][2], ST[0][3]); sb01.z = cvtpk(ST[1][0], ST[1][1]); sb01.w = cvtpk(ST[1][2], ST[1][3]);
                sb23.x = cvtpk(ST[2][0], ST[2][1]); sb23.y = cvtpk(ST[2][2], ST[2][3]); sb23.z = cvtpk(ST[3][0], ST[3][1]); sb23.w = cvtpk(ST[3][2], ST[3][3]);
                const bf16x8 s01 = __builtin_bit_cast(bf16x8, sb01), s23 = __builtin_bit_cast(bf16x8, sb23);
                const v2u kp0a = *(const LAS v2u*)(C + RC_KP + i16 * 144 + (4 * g) * 2), kp0b = *(const LAS v2u*)(C + RC_KP + i16 * 144 + (16 + 4 * g) * 2);
                const v2u kp1a = *(const LAS v2u*)(C + RC_KP + i16 * 144 + (32 + 4 * g) * 2), kp1b = *(const LAS v2u*)(C + RC_KP + i16 * 144 + (48 + 4 * g) * 2);
                const v2u rp0a = *(const LAS v2u*)(C + RC_RP + i16 * 144 + (4 * g) * 2), rp0b = *(const LAS v2u*)(C + RC_RP + i16 * 144 + (16 + 4 * g) * 2);
                const v2u rp1a = *(const LAS v2u*)(C + RC_RP + i16 * 144 + (32 + 4 * g) * 2), rp1b = *(const LAS v2u*)(C + RC_RP + i16 * 144 + (48 + 4 * g) * 2);
                const v2u lk = *(const LAS v2u*)(C + RC_LK + i16 * 40 + g * 8), tm = *(const LAS v2u*)(C + RC_TM + i16 * 40 + g * 8);
                const v2u ark = *(const LAS v2u*)(C + RC_ARK + i16 * 40 + g * 8), narb = *(const LAS v2u*)(C + RC_NARB + i16 * 40 + g * 8);
                const int trq = (i16 >> 2) & 3, trp = i16 & 3;
                const v2u vf = __builtin_bit_cast(v2u, __builtin_amdgcn_ds_read_tr16_b64_v4i16((LAS s16x4_t*)(C + RC_VR + (4 * g + trq) * 144 + (16 * vt + 4 * trp) * 2)));
                const v4u z4 = {0u, 0u, 0u, 0u};
                f32x4 rhs = (f32x4){0.f, 0.f, 0.f, 0.f};
                rhs = MFMA16(__builtin_bit_cast(bf16x8, ((v4u){kp0a.x, kp0a.y, kp0b.x, kp0b.y})), s01, rhs);
                rhs = MFMA16(__builtin_bit_cast(bf16x8, ((v4u){kp1a.x, kp1a.y, kp1b.x, kp1b.y})), s23, rhs);
                rhs = MFMA16(__builtin_bit_cast(bf16x8, ((v4u){lk.x, lk.y, 0u, 0u})), __builtin_bit_cast(bf16x8, ((v4u){vf.x, vf.y, 0u, 0u})), rhs);
                f32x4 z = MFMA16(__builtin_bit_cast(bf16x8, ((v4u){tm.x, tm.y, 0u, 0u})), __builtin_bit_cast(bf16x8, ((v4u){cvtpk(rhs[0], rhs[1]), cvtpk(rhs[2], rhs[3]), 0u, 0u})), ((f32x4){0.f, 0.f, 0.f, 0.f}));
                const bf16x8 vz = __builtin_bit_cast(bf16x8, ((v4u){vf.x, vf.y, cvtpk(z[0], z[1]), cvtpk(z[2], z[3])}));
                f32x4 y = (f32x4){0.f, 0.f, 0.f, 0.f};
                y = MFMA16(__builtin_bit_cast(bf16x8, ((v4u){rp0a.x, rp0a.y, rp0b.x, rp0b.y})), s01, y);
                y = MFMA16(__builtin_bit_cast(bf16x8, ((v4u){rp1a.x, rp1a.y, rp1b.x, rp1b.y})), s23, y);
                y = MFMA16(__builtin_bit_cast(bf16x8, ((v4u){ark.x, ark.y, narb.x, narb.y})), vz, y);
#pragma unroll
                for (int kt = 0; kt < 4; ++kt) {
                    const v2u ktf = __builtin_bit_cast(v2u, __builtin_amdgcn_ds_read_tr16_b64_v4i16((LAS s16x4_t*)(C + RC_KT + (4 * g + trq) * 144 + (16 * kt + 4 * trp) * 2)));
                    const v2u nbf = __builtin_bit_cast(v2u, __builtin_amdgcn_ds_read_tr16_b64_v4i16((LAS s16x4_t*)(C + RC_BP + (4 * g + trq) * 144 + (16 * kt + 4 * trp) * 2)));
                    const f32x4 g15 = *(const LAS f32x4*)(C + RC_G15 + (16 * kt + 4 * g) * 4);
                    ST[kt] = MFMA16(__builtin_bit_cast(bf16x8, ((v4u){ktf.x, ktf.y, nbf.x, nbf.y})), vz, ST[kt]);
                    ST[kt] = ST[kt] * g15;
                }
                { const unsigned y01 = cvtpk(y[0], y[1]), y23 = cvtpk(y[2], y[3]); LAS unsigned char* yb = lds + RW_YB + (c * 16 + 4 * g) * 144 + (16 * vt + i16) * 2;
                  *(LAS bf16*)(yb) = (bf16)(y01 & 0xffffu); *(LAS bf16*)(yb + 144) = (bf16)(y01 >> 16); *(LAS bf16*)(yb + 288) = (bf16)(y23 & 0xffffu); *(LAS bf16*)(yb + 432) = (bf16)(y23 >> 16); }
                (void)z4;
            }
        } else if (sc + 1 < nsc) {
            const int r0 = (tid - 256) >> 3;
#pragma unroll
            for (int hrow = 0; hrow < 2; ++hrow) { const int tokr = r0 + 32 * hrow, step_ = (sc + 1) * 64 + tokr, t_ = e ? L - 1 - step_ : step_;
                const bf16* gp_ = G1 + (size_t)(tok0 + t_) * G1W + C_LORA + e * 64 + st_c8;
                const v4u hw_ = *(const v4u*)gp_, ha_ = *(const v4u*)(gp_ + 128); v4u th_;
                th_.x = cvtpk(tanh_fast(bflo(hw_.x)), tanh_fast(bfhi(hw_.x))); th_.y = cvtpk(tanh_fast(bflo(hw_.y)), tanh_fast(bfhi(hw_.y))); th_.z = cvtpk(tanh_fast(bflo(hw_.z)), tanh_fast(bfhi(hw_.z))); th_.w = cvtpk(tanh_fast(bflo(hw_.w)), tanh_fast(bfhi(hw_.w)));
                *(LAS v4u*)(lds + RW_TH + tokr * 144 + st_c8 * 2) = th_; *(LAS v4u*)(lds + RW_HA + tokr * 144 + st_c8 * 2) = ha_; }
        }
        __syncthreads();
        {
            const int row = tid >> 3, part = tid & 7, step = sc * 64 + row, t = e ? L - 1 - step : step;
            *(v4u*)(YS + ((size_t)e * T + tok0 + t) * 256 + hh * 64 + part * 8) = *(const LAS v4u*)(lds + RW_YB + row * 144 + part * 16);
        }
    }
#undef RW_STAGE
#undef RW_PREFETCH
    if (!lat && wave < 4) {
        const int v = 16 * wave + i16;
#pragma unroll
        for (int kt = 0; kt < 4; ++kt) *(f32x4*)(a->out + O_RW + (((size_t)((b * 2 + layer) * 2 + e) * 4 + hh) * 64 + v) * 64 + 16 * kt + 4 * g) = ST[kt];
    }
}

constexpr int LR_WAT = 0, LR_XCB = 18432, LR_XCF = 27648, LR_AA = 44032, LR_BV = 60416, LR_HH = 76800, LR_SP = 93184, LR_SH = 95232, LR_HC = 97280;
__device__ __forceinline__ void lru_unit_mfma(ArgsP a, LAS unsigned char* lds, int layer, int u) {
    const int tid = tid_(), lane = tid & 63, wave = tid >> 6, i16 = lane & 15, g4 = lane >> 4;
    const int lat = u < 32, uu = lat ? u : u - 32, b = uu >> 2, g = uu & 3;
    const int L = lat ? L_LAT : L_CTX, tok0 = lat ? T_CTX + b * L_LAT : b * L_CTX;
    const bf16* G1 = (const bf16*)(a->ws + WS_G1);
    bf16* HF = (bf16*)(a->ws + WS_HF);
    LAS float* XCF = (LAS float*)(lds + LR_XCF); LAS float* AA = (LAS float*)(lds + LR_AA); LAS float* BV = (LAS float*)(lds + LR_BV); LAS float* HH = (LAS float*)(lds + LR_HH);
    LAS float* SP = (LAS float*)(lds + LR_SP); LAS float* SH = (LAS float*)(lds + LR_SH); LAS float* HC = (LAS float*)(lds + LR_HC);
    const int tt = tid >> 3, q8 = (tid & 7) * 8;
    float cw[4][8], cb[8];
#pragma unroll
    for (int i = 0; i < 8; ++i) { const int ch = g * 64 + q8 + i; cb[i] = a->in[I_CONVB][layer * 256 + ch];
#pragma unroll
        for (int j = 0; j < 4; ++j) cw[j][i] = a->in[I_CONVW][(layer * 4 + j) * 256 + ch]; }
    const int ot = wave & 3, tp = wave >> 2;
    const int sch = tid & 63, seg = tid >> 6;
    for (int e = 0; e < 2; ++e) {
        __syncthreads();
        for (int i = tid; i < 4096; i += NTHREADS) { const size_t src = ((size_t)((layer * 2 + e) * 4 + g)) * 4096 + i; const int ii = i >> 6, oo = i & 63;
            *(LAS bf16*)(lds + LR_WAT + (oo * 72 + ii) * 2) = (bf16)f2bf(a->in[I_WA][src]); *(LAS bf16*)(lds + LR_WAT + 9216 + (oo * 72 + ii) * 2) = (bf16)f2bf(a->in[I_WX][src]); }
        if (tid < 64) HC[tid] = lat ? a->in[I_SLRU][((size_t)(b * 2 + layer) * 2 + e) * 256 + g * 64 + tid] : 0.f;
        f32x4 bav, bxv, spl;
        { const int chb = (layer * 2 + e) * 256 + g * 64 + 16 * ot + 4 * g4;
          bav = *(const f32x4*)(a->in[I_BA] + chb); bxv = *(const f32x4*)(a->in[I_BX] + chb); const f32x4 lam = *(const f32x4*)(a->in[I_LAMBDA] + chb);
#pragma unroll
          for (int q = 0; q < 4; ++q) spl[q] = log1pf(exp_(-lam[q])); }
        __syncthreads();
        v4u xr[4], hfr, glr;
#define LR_PREFETCH(cc_) do { const int c_ = e ? L / 64 - 1 - (cc_) : (cc_), t_ = c_ * 64 + tt; \
            _Pragma("unroll") for (int j = 0; j < 4; ++j) { const int ts = t_ + j - 2; xr[j] = (ts >= 0 && ts < L) ? *(const v4u*)(G1 + (size_t)(tok0 + ts) * G1W + C_XL + g * 64 + q8) : (v4u){0u, 0u, 0u, 0u}; } \
            if (e) { hfr = *(const v4u*)(HF + (size_t)(tok0 + t_) * 256 + g * 64 + q8); glr = *(const v4u*)(G1 + (size_t)(tok0 + t_) * G1W + C_GL + g * 64 + q8); } } while (0)
        LR_PREFETCH(0);
        for (int cc = 0; cc < L / 64; ++cc) {
            const int c = e ? L / 64 - 1 - cc : cc, t = c * 64 + tt, n = tok0 + t;
            const v4u xcur[4] = {xr[0], xr[1], xr[2], xr[3]}; const v4u hfc = hfr, glc = glr;
            if (cc + 1 < L / 64) LR_PREFETCH(cc + 1);
            {
                float xc[8];
#pragma unroll
                for (int i = 0; i < 8; ++i) xc[i] = cb[i];
#pragma unroll
                for (int j = 0; j < 4; ++j) {
                    { const v4u x = xcur[j];
                        xc[0] += cw[j][0] * bflo(x.x); xc[1] += cw[j][1] * bfhi(x.x); xc[2] += cw[j][2] * bflo(x.y); xc[3] += cw[j][3] * bfhi(x.y);
                        xc[4] += cw[j][4] * bflo(x.z); xc[5] += cw[j][5] * bfhi(x.z); xc[6] += cw[j][6] * bflo(x.w); xc[7] += cw[j][7] * bfhi(x.w); } }
                *(LAS f32x4*)(XCF + tt * 64 + q8) = (f32x4){xc[0], xc[1], xc[2], xc[3]}; *(LAS f32x4*)(XCF + tt * 64 + q8 + 4) = (f32x4){xc[4], xc[5], xc[6], xc[7]};
                *(LAS v4u*)(lds + LR_XCB + tt * 144 + q8 * 2) = (v4u){cvtpk(xc[0], xc[1]), cvtpk(xc[2], xc[3]), cvtpk(xc[4], xc[5]), cvtpk(xc[6], xc[7])};
            }
            __syncthreads();
            {
#pragma unroll
                for (int t2 = 0; t2 < 2; ++t2) { const int tk = (2 * tp + t2) * 16 + i16;
                    f32x4 ga = (f32x4){0.f, 0.f, 0.f, 0.f}, gx = (f32x4){0.f, 0.f, 0.f, 0.f};
#pragma unroll
                    for (int ks = 0; ks < 2; ++ks) { const bf16x8 xf = *(const LAS bf16x8*)(lds + LR_XCB + tk * 144 + ks * 64 + g4 * 16);
                        const bf16x8 wa = *(const LAS bf16x8*)(lds + LR_WAT + (16 * ot + i16) * 144 + ks * 64 + g4 * 16), wx = *(const LAS bf16x8*)(lds + LR_WAT + 9216 + (16 * ot + i16) * 144 + ks * 64 + g4 * 16);
                        ga = MFMA16(wa, xf, ga); gx = MFMA16(wx, xf, gx); }
                    const f32x4 xcv = *(const LAS f32x4*)(XCF + tk * 64 + 16 * ot + 4 * g4);
                    f32x4 av, bv;
#pragma unroll
                    for (int q = 0; q < 4; ++q) { const float la = -8.f * sigmoidf_(ga[q] + bav[q]) * spl[q]; av[q] = exp_(la); bv[q] = sqrt_(1.f - exp_(2.f * la)) * sigmoidf_(gx[q] + bxv[q]) * xcv[q]; }
                    *(LAS f32x4*)(AA + tk * 64 + 16 * ot + 4 * g4) = av; *(LAS f32x4*)(BV + tk * 64 + 16 * ot + 4 * g4) = bv; }
            }
            __syncthreads();
            float av8[8], bv8[8];
            {
                float P = 1.f, H = 0.f;
#pragma unroll
                for (int s = 0; s < 8; ++s) { const int p = seg * 8 + s, st = e ? 63 - p : p; av8[s] = AA[st * 64 + sch]; bv8[s] = BV[st * 64 + sch]; H = fmaf(av8[s], H, bv8[s]); P *= av8[s]; }
                SP[seg * 64 + sch] = P; SH[seg * 64 + sch] = H;
            }
            __syncthreads();
            {
                float h = HC[sch];
                for (int s2 = 0; s2 < seg; ++s2) h = fmaf(SP[s2 * 64 + sch], h, SH[s2 * 64 + sch]);
#pragma unroll
                for (int s = 0; s < 8; ++s) { const int p = seg * 8 + s, st = e ? 63 - p : p; h = fmaf(av8[s], h, bv8[s]); HH[st * 64 + sch] = h; }
                __syncthreads();
                if (seg == 7) HC[sch] = h;
            }
            __syncthreads();
            {
                bf16* dst = HF + (size_t)n * 256 + g * 64 + q8;
                float o[8];
#pragma unroll
                for (int i = 0; i < 8; ++i) o[i] = HH[tt * 64 + q8 + i];
                if (e) { const v4u hf = hfc, gl = glc;
                    o[0] = (o[0] + bflo(hf.x)) * siluf_(bflo(gl.x)); o[1] = (o[1] + bfhi(hf.x)) * siluf_(bfhi(gl.x)); o[2] = (o[2] + bflo(hf.y)) * siluf_(bflo(gl.y)); o[3] = (o[3] + bfhi(hf.y)) * siluf_(bfhi(gl.y));
                    o[4] = (o[4] + bflo(hf.z)) * siluf_(bflo(gl.z)); o[5] = (o[5] + bfhi(hf.z)) * siluf_(bfhi(gl.z)); o[6] = (o[6] + bflo(hf.w)) * siluf_(bflo(gl.w)); o[7] = (o[7] + bfhi(hf.w)) * siluf_(bfhi(gl.w)); }
                *(v4u*)dst = (v4u){cvtpk(o[0], o[1]), cvtpk(o[2], o[3]), cvtpk(o[4], o[5]), cvtpk(o[6], o[7])};
            }
        }
#undef LR_PREFETCH
        __syncthreads();
        if (tid < 64 && !lat) a->out[O_LRU + ((size_t)(b * 2 + layer) * 2 + e) * 256 + g * 64 + tid] = HC[tid];
    }
}

constexpr int LQ_NQ = 32;
constexpr int LQ_WAT = 0, LQ_S0 = 2 * LQ_NQ * 144;
constexpr int LS_XCB = 0, LS_XCQ = 9216, LS_AA = LS_XCQ + 64 * LQ_NQ * 4, LS_BV = LS_AA + 64 * LQ_NQ * 4, LS_HH = LS_BV + 64 * LQ_NQ * 4,
              LS_SP = LS_HH + 64 * LQ_NQ * 4, LS_SH = LS_SP + 8 * LQ_NQ * 4, LS_HC = LS_SH + 8 * LQ_NQ * 4, LS_BYTES = LS_HC + 2 * LQ_NQ * 4;
__device__ __forceinline__ void lru_unit_q(ArgsP a, LAS unsigned char* lds, int layer, int u) {
    const int tid = tid_(), lane = tid & 63, wave = tid >> 6, i16 = lane & 15, g4 = lane >> 4;
    const int lat = u < 32, uu = lat ? u : u - 32, bp = uu >> 3, g = (uu >> 1) & 3, oq = uu & 1;
    const int L = lat ? L_LAT : L_CTX;
    const int tokb[2] = {lat ? T_CTX + (2 * bp) * L_LAT : (2 * bp) * L_CTX, lat ? T_CTX + (2 * bp + 1) * L_LAT : (2 * bp + 1) * L_CTX};
    const bf16* G1 = (const bf16*)(a->ws + WS_G1);
    bf16* HF = (bf16*)(a->ws + WS_HF);
    const int tt = tid >> 3, q8 = (tid & 7) * 8;
    float cw[4][8], cb[8];
#pragma unroll
    for (int i = 0; i < 8; ++i) { const int ch = g * 64 + q8 + i; cb[i] = a->in[I_CONVB][layer * 256 + ch];
#pragma unroll
        for (int j = 0; j < 4; ++j) cw[j][i] = a->in[I_CONVW][(layer * 4 + j) * 256 + ch]; }
    const int gt = wave & 3, got = wave >> 2;
    const int ssn = tid >> 8, sch = tid & (LQ_NQ - 1), seg = (tid >> 5) & 7;
    const int otok = tid >> 3, oc4 = (tid & 7) * 4;
    const int chq = g * 64 + oq * LQ_NQ;
    LAS unsigned char* SS = lds + LQ_S0 + ssn * LS_BYTES;
    for (int e = 0; e < 2; ++e) {
        __syncthreads();
        { const int m = tid >> 8, row = (tid >> 3) & 31, c8 = (tid & 7) * 8;
          const bf16* wsrc = (const bf16*)(a->ws + WS_LRUW) + ((size_t)(((layer * 2 + e) * 2 + m) * 4 + g) * 64 + oq * LQ_NQ + row) * 64 + c8;
          *(LAS v4u*)(lds + LQ_WAT + m * LQ_NQ * 144 + row * 144 + c8 * 2) = *(const v4u*)wsrc; }
        if (tid < 2 * LQ_NQ) { const int s = tid >> 5, c = tid & 31; ((LAS float*)(lds + LQ_S0 + s * LS_BYTES + LS_HC))[c] = lat ? a->in[I_SLRU][((size_t)((2 * bp + s) * 2 + layer) * 2 + e) * 256 + chq + c] : 0.f; }
        f32x4 bav, bxv, spl;
        { const int chb = (layer * 2 + e) * 256 + chq + 16 * got + 4 * g4;
          bav = *(const f32x4*)(a->in[I_BA] + chb); bxv = *(const f32x4*)(a->in[I_BX] + chb); const f32x4 lam = *(const f32x4*)(a->in[I_LAMBDA] + chb);
#pragma unroll
          for (int q = 0; q < 4; ++q) spl[q] = log1pf(exp_(-lam[q])); }
        v4u xr[2][4]; v2u hfr[2], glr[2];
#define LQ_PREFETCH(cc_) do { const int c_ = e ? L / 64 - 1 - (cc_) : (cc_), t_ = c_ * 64 + tt; \
            _Pragma("unroll") for (int s = 0; s < 2; ++s) { \
              _Pragma("unroll") for (int j = 0; j < 4; ++j) { const int ts = t_ + j - 2; xr[s][j] = (ts >= 0 && ts < L) ? *(const v4u*)(G1 + (size_t)(tokb[s] + ts) * G1W + C_XL + g * 64 + q8) : (v4u){0u, 0u, 0u, 0u}; } \
              if (e) { const int to_ = c_ * 64 + otok; hfr[s] = *(const v2u*)(HF + (size_t)(tokb[s] + to_) * 256 + chq + oc4); glr[s] = *(const v2u*)(G1 + (size_t)(tokb[s] + to_) * G1W + C_GL + chq + oc4); } } } while (0)
        LQ_PREFETCH(0);
        __syncthreads();
        for (int cc = 0; cc < L / 64; ++cc) {
            const int c = e ? L / 64 - 1 - cc : cc;
            v4u xcur[2][4]; v2u hfc[2], glc[2];
#pragma unroll
            for (int s = 0; s < 2; ++s) { xcur[s][0] = xr[s][0]; xcur[s][1] = xr[s][1]; xcur[s][2] = xr[s][2]; xcur[s][3] = xr[s][3]; hfc[s] = hfr[s]; glc[s] = glr[s]; }
            if (cc + 1 < L / 64) LQ_PREFETCH(cc + 1);
#pragma unroll
            for (int s = 0; s < 2; ++s) {
                LAS unsigned char* SB = lds + LQ_S0 + s * LS_BYTES;
                float xc[8];
#pragma unroll
                for (int i = 0; i < 8; ++i) xc[i] = cb[i];
#pragma unroll
                for (int j = 0; j < 4; ++j) { const v4u x = xcur[s][j];
                    xc[0] += cw[j][0] * bflo(x.x); xc[1] += cw[j][1] * bfhi(x.x); xc[2] += cw[j][2] * bflo(x.y); xc[3] += cw[j][3] * bfhi(x.y);
                    xc[4] += cw[j][4] * bflo(x.z); xc[5] += cw[j][5] * bfhi(x.z); xc[6] += cw[j][6] * bflo(x.w); xc[7] += cw[j][7] * bfhi(x.w); }
                *(LAS v4u*)(SB + LS_XCB + tt * 144 + q8 * 2) = (v4u){cvtpk(xc[0], xc[1]), cvtpk(xc[2], xc[3]), cvtpk(xc[4], xc[5]), cvtpk(xc[6], xc[7])};
                if ((q8 / LQ_NQ) == oq) { LAS float* XCQ = (LAS float*)(SB + LS_XCQ); *(LAS f32x4*)(XCQ + tt * LQ_NQ + (q8 % LQ_NQ)) = (f32x4){xc[0], xc[1], xc[2], xc[3]}; *(LAS f32x4*)(XCQ + tt * LQ_NQ + (q8 % LQ_NQ) + 4) = (f32x4){xc[4], xc[5], xc[6], xc[7]}; }
            }
            __syncthreads();
#pragma unroll
            for (int s = 0; s < 2; ++s) {
                LAS unsigned char* SB = lds + LQ_S0 + s * LS_BYTES;
                const int tk = gt * 16 + i16;
                f32x4 ga = (f32x4){0.f, 0.f, 0.f, 0.f}, gx = (f32x4){0.f, 0.f, 0.f, 0.f};
#pragma unroll
                for (int ks = 0; ks < 2; ++ks) { const bf16x8 xf = *(const LAS bf16x8*)(SB + LS_XCB + tk * 144 + ks * 64 + g4 * 16);
                    const bf16x8 wa = *(const LAS bf16x8*)(lds + LQ_WAT + (16 * got + i16) * 144 + ks * 64 + g4 * 16), wx = *(const LAS bf16x8*)(lds + LQ_WAT + LQ_NQ * 144 + (16 * got + i16) * 144 + ks * 64 + g4 * 16);
                    ga = MFMA16(wa, xf, ga); gx = MFMA16(wx, xf, gx); }
                const f32x4 xcv = *(const LAS f32x4*)((LAS float*)(SB + LS_XCQ) + tk * LQ_NQ + 16 * got + 4 * g4);
                f32x4 av, bv;
#pragma unroll
                for (int q = 0; q < 4; ++q) { const float la = -8.f * sigmoidf_(ga[q] + bav[q]) * spl[q], aq = exp_(la); av[q] = aq; bv[q] = sqrt_((1.f - aq) * (1.f + aq)) * sigmoidf_(gx[q] + bxv[q]) * xcv[q]; }
                *(LAS f32x4*)((LAS float*)(SB + LS_AA) + tk * LQ_NQ + 16 * got + 4 * g4) = av; *(LAS f32x4*)((LAS float*)(SB + LS_BV) + tk * LQ_NQ + 16 * got + 4 * g4) = bv;
            }
            __syncthreads();
            LAS float* AA = (LAS float*)(SS + LS_AA); LAS float* BV = (LAS float*)(SS + LS_BV); LAS float* HH = (LAS float*)(SS + LS_HH);
            LAS float* SP = (LAS float*)(SS + LS_SP); LAS float* SH = (LAS float*)(SS + LS_SH); LAS float* HC = (LAS float*)(SS + LS_HC);
            float av8[8], bv8[8];
            {
                float P = 1.f, H = 0.f;
#pragma unroll
                for (int s = 0; s < 8; ++s) { const int p = seg * 8 + s, st = e ? 63 - p : p; av8[s] = AA[st * LQ_NQ + sch]; bv8[s] = BV[st * LQ_NQ + sch]; H = fmaf(av8[s], H, bv8[s]); P *= av8[s]; }
                SP[seg * LQ_NQ + sch] = P; SH[seg * LQ_NQ + sch] = H;
            }
            __syncthreads();
            {
                float h = HC[(cc & 1) * LQ_NQ + sch];
                for (int s2 = 0; s2 < seg; ++s2) h = fmaf(SP[s2 * LQ_NQ + sch], h, SH[s2 * LQ_NQ + sch]);
#pragma unroll
                for (int s = 0; s < 8; ++s) { const int p = seg * 8 + s, st = e ? 63 - p : p; h = fmaf(av8[s], h, bv8[s]); HH[st * LQ_NQ + sch] = h; }
                if (seg == 7) HC[((cc + 1) & 1) * LQ_NQ + sch] = h;
            }
            __syncthreads();
#pragma unroll
            for (int s = 0; s < 2; ++s) {
                const int n = tokb[s] + c * 64 + otok;
                const f32x4 hv = *(const LAS f32x4*)((LAS float*)(lds + LQ_S0 + s * LS_BYTES + LS_HH) + otok * LQ_NQ + oc4);
                float o0 = hv[0], o1 = hv[1], o2 = hv[2], o3 = hv[3];
                if (e) { o0 = (o0 + bflo(hfc[s].x)) * siluf_(bflo(glc[s].x)); o1 = (o1 + bfhi(hfc[s].x)) * siluf_(bfhi(glc[s].x)); o2 = (o2 + bflo(hfc[s].y)) * siluf_(bflo(glc[s].y)); o3 = (o3 + bfhi(hfc[s].y)) * siluf_(bfhi(glc[s].y)); }
                *(v2u*)(HF + (size_t)n * 256 + chq + oc4) = (v2u){cvtpk(o0, o1), cvtpk(o2, o3)};
            }
        }
#undef LQ_PREFETCH
        __syncthreads();
        if (tid < 2 * LQ_NQ && !lat) { const int s = tid >> 5, c = tid & 31; a->out[O_LRU + ((size_t)((2 * bp + s) * 2 + layer) * 2 + e) * 256 + chq + c] = ((LAS float*)(lds + LQ_S0 + s * LS_BYTES + LS_HC))[((L / 64) & 1) * LQ_NQ + c]; }
    }
}

constexpr int ATT2_VSTR = 144, ATT2_STAGE = 64 * ATT_KSTR + 64 * ATT2_VSTR;
#define ATT_KLOAD(KB_) \
        bf16x8 kfa_[6], kfb_[6]; \
        _Pragma("unroll") for (int ks_ = 0; ks_ < 6; ++ks_) { kfa_[ks_] = *(const LAS bf16x8*)((KB_) + r * ATT_KSTR + ks_ * 32 + hq * 16); kfb_[ks_] = *(const LAS bf16x8*)((KB_) + (32 + r) * ATT_KSTR + ks_ * 32 + hq * 16); }
#define ATT_VLOAD(VB_) \
        v2u va0_[4], va1_[4], vb0_[4], vb1_[4]; \
        _Pragma("unroll") for (int ks_ = 0; ks_ < 4; ++ks_) { \
            const LAS unsigned char* vp_ = (VB_) + (ks_ * 16 + 4 * hq + ((lane >> 2) & 3)) * ATT2_VSTR + (16 * ((lane >> 4) & 1) + 4 * (lane & 3)) * 2; \
            va0_[ks_] = __builtin_bit_cast(v2u, __builtin_amdgcn_ds_read_tr16_b64_v4i16((LAS s16x4_t*)(vp_))); \
            va1_[ks_] = __builtin_bit_cast(v2u, __builtin_amdgcn_ds_read_tr16_b64_v4i16((LAS s16x4_t*)(vp_ + 8 * ATT2_VSTR))); \
            vb0_[ks_] = __builtin_bit_cast(v2u, __builtin_amdgcn_ds_read_tr16_b64_v4i16((LAS s16x4_t*)(vp_ + 64))); \
            vb1_[ks_] = __builtin_bit_cast(v2u, __builtin_amdgcn_ds_read_tr16_b64_v4i16((LAS s16x4_t*)(vp_ + 8 * ATT2_VSTR + 64))); }
#define ATT_QKM(S0_, S1_) do { \
        _Pragma("unroll") for (int i_ = 0; i_ < 16; ++i_) { S0_[i_] = 0.f; S1_[i_] = 0.f; } \
        _Pragma("unroll") for (int ks_ = 0; ks_ < 6; ++ks_) { S0_ = MFMA32(kfa_[ks_], qf[ks_], S0_); S1_ = MFMA32(kfb_[ks_], qf[ks_], S1_); } } while (0)
#define ATT_STEP(SC0_, SC1_, SN0_, SN1_, KB_, VB_, HAVE_NEXT_) do { \
        ATT_KLOAD(KB_) \
        float mx_ = SC0_[0]; \
        _Pragma("unroll") for (int i_ = 1; i_ < 16; ++i_) mx_ = fmaxf(mx_, SC0_[i_]); \
        _Pragma("unroll") for (int i_ = 0; i_ < 16; ++i_) mx_ = fmaxf(mx_, SC1_[i_]); \
        mx_ = fmaxf(mx_, __shfl_xor(mx_, 32)); \
        if (!__all(mx_ - m <= 8.f)) { const float mn_ = fmaxf(m, mx_), al_ = __builtin_amdgcn_exp2f(m - mn_); m = mn_; l *= al_; \
            _Pragma("unroll") for (int i_ = 0; i_ < 16; ++i_) { o0[i_] *= al_; o1[i_] *= al_; } } \
        if (HAVE_NEXT_) ATT_QKM(SN0_, SN1_); \
        ATT_VLOAD(VB_) \
        float ps_ = 0.f; \
        _Pragma("unroll") for (int i_ = 0; i_ < 16; ++i_) { SC0_[i_] = __builtin_amdgcn_exp2f(SC0_[i_] - m); SC1_[i_] = __builtin_amdgcn_exp2f(SC1_[i_] - m); ps_ += SC0_[i_] + SC1_[i_]; } \
        l += ps_; \
        _Pragma("unroll") for (int ks_ = 0; ks_ < 4; ++ks_) { \
            v4u pw_; \
            if (ks_ == 0) { pw_.x = cvtpk(SC0_[0], SC0_[1]); pw_.y = cvtpk(SC0_[2], SC0_[3]); pw_.z = cvtpk(SC0_[4], SC0_[5]); pw_.w = cvtpk(SC0_[6], SC0_[7]); } \
            else if (ks_ == 1) { pw_.x = cvtpk(SC0_[8], SC0_[9]); pw_.y = cvtpk(SC0_[10], SC0_[11]); pw_.z = cvtpk(SC0_[12], SC0_[13]); pw_.w = cvtpk(SC0_[14], SC0_[15]); } \
            else if (ks_ == 2) { pw_.x = cvtpk(SC1_[0], SC1_[1]); pw_.y = cvtpk(SC1_[2], SC1_[3]); pw_.z = cvtpk(SC1_[4], SC1_[5]); pw_.w = cvtpk(SC1_[6], SC1_[7]); } \
            else { pw_.x = cvtpk(SC1_[8], SC1_[9]); pw_.y = cvtpk(SC1_[10], SC1_[11]); pw_.z = cvtpk(SC1_[12], SC1_[13]); pw_.w = cvtpk(SC1_[14], SC1_[15]); } \
            const bf16x8 pf_ = __builtin_bit_cast(bf16x8, pw_); \
            const v4u vwa_ = {va0_[ks_].x, va0_[ks_].y, va1_[ks_].x, va1_[ks_].y}, vwb_ = {vb0_[ks_].x, vb0_[ks_].y, vb1_[ks_].x, vb1_[ks_].y}; \
            o0 = MFMA32(__builtin_bit_cast(bf16x8, vwa_), pf_, o0); o1 = MFMA32(__builtin_bit_cast(bf16x8, vwb_), pf_, o1); } } while (0)
__device__ __forceinline__ void att_unit2(ArgsP a, LAS unsigned char* lds, int u) {
    const int tid = tid_(), lane = tid & 63, wave = tid >> 6, r = lane & 31, hq = lane >> 5;
    const bf16* KN = (const bf16*)(a->ws + WS_KN); const bf16* KR = (const bf16*)(a->ws + WS_KR); const bf16* VT = (const bf16*)(a->ws + WS_VT);
    bf16* Q = (bf16*)(a->ws + WS_Q); const bf16* G1 = (const bf16*)(a->ws + WS_G1);
    int b, h, n0, Lk, kidx0; size_t vbase;
    if (u < 512) { b = u >> 6; h = (u >> 3) & 7; n0 = T_CTX + b * 2048 + (u & 7) * 256; Lk = LK_LAT; kidx0 = T_CTX + b * LK_LAT; vbase = (size_t)VT_LAT + (size_t)(b * 8 + h) * 64 * LK_LAT; }
    else { const int uu = u - 512; b = uu >> 3; h = uu & 7; n0 = b * 256; Lk = 256; kidx0 = b * 256; vbase = (size_t)(b * 8 + h) * 64 * 256; }
    const int ntiles = Lk >> 6;
    const int n = n0 + wave * 32 + r;
    bf16x8 qf[6];
#pragma unroll
    for (int ks = 0; ks < 6; ++ks) qf[ks] = *(const bf16x8*)(Q + (size_t)n * 768 + h * 96 + ks * 16 + 8 * hq);
    const int key_k = tid >> 3, ck = tid & 7, key_r = (tid >> 2) & 63, cr = tid & 3;
    const bf16* gk = KN + (size_t)(kidx0 + key_k) * 512 + h * 64 + ck * 8;
    const bf16* gr = KR + (size_t)(kidx0 + key_r) * 32 + cr * 8;
    const bf16* gv = VT + (size_t)(kidx0 + key_k) * 512 + h * 64 + ck * 8;
    const unsigned sk = key_k * ATT_KSTR + ck * 16, sr = key_r * ATT_KSTR + 128 + cr * 16, sv = ATT_VOFF + key_k * ATT2_VSTR + ck * 16;
    v4u rkA, rrA = {0u, 0u, 0u, 0u}, rvA, rkB, rrB = {0u, 0u, 0u, 0u}, rvB;
#define ATT_LOAD(X_, j_) do { rk##X_ = *(const v4u*)(gk + (size_t)(j_) * 64 * 512); if (tid < 256) rr##X_ = *(const v4u*)(gr + (size_t)(j_) * 64 * 32); rv##X_ = *(const v4u*)(gv + (size_t)(j_) * 64 * 512); } while (0)
#define ATT_STORE(X_, B_) do { LAS unsigned char* nb_ = lds + (B_) * ATT2_STAGE; *(LAS v4u*)(nb_ + sk) = rk##X_; if (tid < 256) *(LAS v4u*)(nb_ + sr) = rr##X_; \
        *(LAS v4u*)(nb_ + sv) = rv##X_; } while (0)
    ATT_LOAD(A, 0); ATT_LOAD(B, 1);
    __syncthreads();
    ATT_STORE(A, 0);
    ATT_STORE(B, 1);
    ATT_LOAD(A, 2);
    __syncthreads();
    f32x16 o0, o1, sa0, sa1, sb0, sb1;
#pragma unroll
    for (int i = 0; i < 16; ++i) { o0[i] = 0.f; o1[i] = 0.f; }
    float m = -1e30f, l = 0.f;
    { ATT_KLOAD(lds) ATT_QKM(sa0, sa1); }
    int bcur = 0;
    int j = 0;
    for (; j < ntiles - 2; j += 2) {
        {
            const int b1 = bcur == 2 ? 0 : bcur + 1, b2 = b1 == 2 ? 0 : b1 + 1;
            ATT_LOAD(B, j + 3);
            ATT_STEP(sa0, sa1, sb0, sb1, lds + b1 * ATT2_STAGE, lds + bcur * ATT2_STAGE + ATT_VOFF, true);
            ATT_STORE(A, b2);
            __syncthreads();
            bcur = b1;
        }
        {
            const int b1 = bcur == 2 ? 0 : bcur + 1, b2 = b1 == 2 ? 0 : b1 + 1;
            if (j + 4 < ntiles) ATT_LOAD(A, j + 4);
            ATT_STEP(sb0, sb1, sa0, sa1, lds + b1 * ATT2_STAGE, lds + bcur * ATT2_STAGE + ATT_VOFF, true);
            ATT_STORE(B, b2);
            __syncthreads();
            bcur = b1;
        }
    }
    {
        { const int b1 = bcur == 2 ? 0 : bcur + 1;
          ATT_STEP(sa0, sa1, sb0, sb1, lds + b1 * ATT2_STAGE, lds + bcur * ATT2_STAGE + ATT_VOFF, true);
          bcur = b1; }
        { ATT_STEP(sb0, sb1, sa0, sa1, lds + bcur * ATT2_STAGE, lds + bcur * ATT2_STAGE + ATT_VOFF, false); }
        __syncthreads();
    }
#undef ATT_LOAD
#undef ATT_STORE
    v2u gmv[2][4];
#pragma unroll
    for (int mt = 0; mt < 2; ++mt)
#pragma unroll
        for (int g = 0; g < 4; ++g) gmv[mt][g] = *(const v2u*)(G1 + (size_t)n * G1W + C_GM + h * 64 + 32 * mt + 8 * g + 4 * hq);
    l += __shfl_xor(l, 32);
    const float inv = rcp_(l);
#pragma unroll
    for (int mt = 0; mt < 2; ++mt)
#pragma unroll
        for (int g = 0; g < 4; ++g) {
            const int dv0 = 32 * mt + 8 * g + 4 * hq;
            const v2u gm = gmv[mt][g];
            const float x0 = (mt ? o1[4 * g + 0] : o0[4 * g + 0]) * inv, x1 = (mt ? o1[4 * g + 1] : o0[4 * g + 1]) * inv, x2 = (mt ? o1[4 * g + 2] : o0[4 * g + 2]) * inv, x3 = (mt ? o1[4 * g + 3] : o0[4 * g + 3]) * inv;
            v2u ov; ov.x = cvtpk(x0 * siluf_(bflo(gm.x)), x1 * siluf_(bfhi(gm.x))); ov.y = cvtpk(x2 * siluf_(bflo(gm.y)), x3 * siluf_(bfhi(gm.y)));
            *(v2u*)(Q + (size_t)n * 768 + h * 96 + dv0) = ov;
        }
}
constexpr int N_PHASES = 14;
#ifndef MK_PER_PHASE
#define MK_PER_PHASE 0
#endif
#ifndef VAR_GEMM
#define VAR_GEMM 1
#endif
#ifndef VAR_A2
#define VAR_A2 1
#endif
#ifndef VAR_ATT
#define VAR_ATT 1
#endif
#ifndef VAR_RWKV
#define VAR_RWKV 1
#endif
#ifndef VAR_LRU
#define VAR_LRU 1
#endif

__device__ __forceinline__ void phase_b(ArgsP a, LAS unsigned char* lds, int layer) {
    volatile LAS unsigned* MISC = (volatile LAS unsigned*)(lds + LDS_MISC);
    unsigned* head = (unsigned*)(a->ws + WS_CTL) + CW_Q + layer * 64;
    for (;;) {
        __syncthreads();
        if (tid_() == 0) MISC[16] = atomicAdd(head, 1u);
        __syncthreads();
        const int idx = (int)MISC[16];
        if (idx >= 1248) break;
#ifdef PROBE_UNIT1
        const unsigned long long pt0_ = __builtin_amdgcn_s_memrealtime();
#endif
#ifdef PROBE_RW_MODE
        if (idx < 64) rwkv_unit_mfma<PROBE_RW_MODE>(a, lds, layer, idx); else if (idx >= 608 && idx < 864) rwkv_unit_mfma<PROBE_RW_MODE>(a, lds, layer, 64 + idx - 608);
        if (tid_() == 0 && layer == 0 && (idx < 64 || (idx >= 608 && idx < 864))) { const unsigned d_ = (unsigned)(__builtin_amdgcn_s_memrealtime() - pt0_); atomicMax((unsigned*)(a->ws + WS_CTL) + CW_Q + 1024 + (idx < 64 ? 6 : 7) * 64, d_); }
#endif
        if (idx < 64) rwkv_unit_mfma(a, lds, layer, idx);
        else if (idx < 96) lru_unit_q(a, lds, layer, idx - 64);
        else if (idx < 608) att_unit2(a, lds, idx - 96);
        else if (idx < 864) rwkv_unit_mfma(a, lds, layer, 64 + idx - 608);
        else if (idx < 992) lru_unit_q(a, lds, layer, 32 + idx - 864);
        else att_unit2(a, lds, 512 + idx - 992);
#ifdef PROBE_UNIT1
        if (tid_() == 0 && layer == 0) { const unsigned d_ = (unsigned)(__builtin_amdgcn_s_memrealtime() - pt0_);
            const int ty_ = idx < 64 ? 0 : idx < 96 ? 1 : idx < 608 ? 2 : idx < 864 ? 3 : idx < 992 ? 4 : 5;
            atomicMax((unsigned*)(a->ws + WS_CTL) + CW_Q + 1024 + ty_ * 64, d_); }
#endif
    }
}

#if MK_PER_PHASE
template <int SUB> __global__ void __launch_bounds__(NTHREADS, 2) mk_phase(Args args, int layer) {
    extern __shared__ __attribute__((aligned(16))) unsigned char lds_raw[];
    LAS unsigned char* lds = (LAS unsigned char*)lds_raw;
    ArgsP a = (ArgsP)__builtin_amdgcn_kernarg_segment_ptr();
    if (SUB == 0) phase_p0(a, lds);
    if (SUB == 1) phase_a0(a, layer);
    if (SUB == 2) { if (VAR_GEMM) phase_a1_pg8(a, lds, layer); else phase_a1_naive(a, layer); }
    if (SUB == 3) { if (VAR_A2) { for (int u = blockIdx.x; u < T / 64 + 32; u += gridDim.x) a2_unit(a, lds, layer, u); } else phase_a2_naive(a, lds, layer); }
    if (SUB == 4) { if (VAR_ATT) { for (int u = blockIdx.x; u < 768; u += gridDim.x) att_unit(a, lds, u); } else phase_att_naive(a); }
    if (SUB == 5) { for (int u = blockIdx.x; u < 320; u += gridDim.x) { __syncthreads(); if (VAR_RWKV) rwkv_unit_mfma(a, lds, layer, u); else rwkv_unit_seq(a, lds, layer, u); } }
    if (SUB == 6) { for (int u = blockIdx.x; u < 160; u += gridDim.x) { __syncthreads(); if (VAR_LRU) lru_unit_mfma(a, lds, layer, u); else lru_unit_seq(a, lds, layer, u); } }
    if (SUB == 7) phase_c1(a, layer);
    if (SUB == 8) { if (VAR_GEMM) phase_c2_pg8(a, lds, layer); else phase_c2_naive(a, layer); }
    if (SUB == 9) phase_final(a);
}
#else
#define ARGS_VIEW() ({ ArgsP p_ = (ArgsP)__builtin_amdgcn_kernarg_segment_ptr(); asm volatile("" : "+s"(p_)); p_; })
__global__ void __launch_bounds__(NTHREADS, 2) mk_fwd(Args args) {
    extern __shared__ __attribute__((aligned(16))) unsigned char lds_raw[];
    LAS unsigned char* lds = (LAS unsigned char*)lds_raw;
    volatile LAS unsigned* MISC = (volatile LAS unsigned*)(lds + LDS_MISC);
    for (int u = threadIdx.x; u < 64; u += NTHREADS) MISC[u] = 0u;
    __syncthreads();
    XcdBarrier bar;
    { ArgsP a = ARGS_VIEW(); bar = xcd_barrier_post((unsigned*)(a->ws + WS_CTL) + CW_BAR, MISC + 8); }
    int lo, hi; { ArgsP a = ARGS_VIEW(); lo = a->ph_lo; hi = a->ph_hi; }
#define IN(k) (lo <= (k) && (k) < hi)
#ifdef PROBE_MASK1
#define STAMP(k) do { if (bid_() == 0 && tid_() == 0) { const unsigned long long t_ = __builtin_amdgcn_s_memrealtime(); MISC[32 + 2 * (k)] = (unsigned)t_; MISC[33 + 2 * (k)] = (unsigned)(t_ >> 32); } } while (0)
#else
#define STAMP(k) do { } while (0)
#endif
#define SEAM(k) do { if (IN(k) && IN((k) + 1)) xcd_barrier(bar); STAMP((k) + 1); } while (0)
#ifndef NO_P0
    STAMP(0);
    if (IN(0)) { ArgsP a = ARGS_VIEW(); phase_p0(a, lds); }
#endif
    SEAM(0);
    for (int layer = 0; layer < 2; ++layer) {
        const int p = 1 + 6 * layer;
#ifndef NO_A0
        if (IN(p + 0)) { { ArgsP a = ARGS_VIEW(); phase_a0(a, layer); } if (layer == 0) { ArgsP a = ARGS_VIEW(); phase_p0_weights(a, lds); } }
#endif
        SEAM(p + 0);
#ifndef NO_A1
        if (IN(p + 1)) { ArgsP a = ARGS_VIEW(); phase_a1_pg8(a, lds, layer); }
#endif
        SEAM(p + 1);
#ifndef NO_A2
        if (IN(p + 2)) { { ArgsP a = ARGS_VIEW(); phase_a2a(a, layer); } xcd_barrier(bar); { ArgsP a = ARGS_VIEW(); phase_a2b(a, lds, layer); } }
        if (0) { ArgsP a = ARGS_VIEW(); for (int u = bid_(); u < T / 64 + 32; u += grid_()) {
#ifdef PROBE_UNIT1
            const unsigned long long pt0_ = __builtin_amdgcn_s_memrealtime();
#endif
            a2_unit(a, lds, layer, u);
#ifdef PROBE_A2_TWICE
            a2_unit(a, lds, layer, u);
#endif
#ifdef PROBE_UNIT1
            __syncthreads();
            if (tid_() == 0 && layer == 0) atomicMax((unsigned*)(a->ws + WS_CTL) + CW_Q + 1024 + (u < 256 ? 6 : 7) * 64, (unsigned)(__builtin_amdgcn_s_memrealtime() - pt0_));
#endif
        } }
#endif
        SEAM(p + 2);
#ifndef NO_B
        if (IN(p + 3)) { ArgsP a = ARGS_VIEW(); phase_b(a, lds, layer); }
#endif
        SEAM(p + 3);
#ifndef NO_C1
        if (IN(p + 4)) { ArgsP a = ARGS_VIEW(); phase_c1(a, layer); }
#endif
        SEAM(p + 4);
#ifndef NO_C2
        if (IN(p + 5)) { ArgsP a = ARGS_VIEW(); phase_c2_pg8(a, lds, layer); }
#endif
        SEAM(p + 5);
    }
    if (IN(N_PHASES - 1)) { ArgsP a = ARGS_VIEW(); phase_final(a); }
#ifdef PROBE_MASK1
    STAMP(14);
    __syncthreads();
    if (bid_() == 0) {
        ArgsP a = ARGS_VIEW();
        float t1 = 0.f, t2 = 0.f;
        for (int k = 0; k < 14; ++k) { const unsigned long long s0 = ((unsigned long long)MISC[33 + 2 * k] << 32) | MISC[32 + 2 * k], s1 = ((unsigned long long)MISC[35 + 2 * k] << 32) | MISC[34 + 2 * k];
            const float us = (float)(s1 - s0) * 0.01f; if ((PROBE_MASK1 >> k) & 1) t1 += us; if ((PROBE_MASK2 >> k) & 1) t2 += us; }
#ifdef PROBE_UNIT1
        t1 = (float)((unsigned*)(a->ws + WS_CTL))[CW_Q + 1024 + PROBE_UNIT1 * 64] * 0.01f; t2 = (float)((unsigned*)(a->ws + WS_CTL))[CW_Q + 1024 + PROBE_UNIT2 * 64] * 0.01f;
#endif
        for (int i = tid_(); i < 32768; i += NTHREADS) a->out[O_LRU + i] *= (1.f + t2 * (1.f / 2000.f));
        if (tid_() == 0) a->out[0] += 2.f + t1 * 0.01f;
    }
#endif
#undef IN
#undef SEAM
}

#endif

extern "C" void kernel_launch(void* const* d_in, const int* in_sizes, int n_in, void* d_out, int out_size, void* d_ws, size_t ws_size, hipStream_t stream) {
    static int grid = 0;
    if (grid == 0) {
        if (n_in != N_IN || ws_size < WS_END) { fprintf(stderr, "kernel_launch: unexpected n_in %d / ws_size %zu\n", n_in, ws_size); grid = -1; return; }
        int dev = 0, cus = 0;
        if (hipGetDevice(&dev) != hipSuccess || hipDeviceGetAttribute(&cus, hipDeviceAttributeMultiprocessorCount, dev) != hipSuccess) { grid = -1; return; }
#if MK_PER_PHASE
#define SA(SUB) if (hipFuncSetAttribute((const void*)mk_phase<SUB>, hipFuncAttributeMaxDynamicSharedMemorySize, LDS_BYTES) != hipSuccess) { fprintf(stderr, "kernel_launch: hipFuncSetAttribute failed\n"); grid = -1; return; }
        SA(0) SA(1) SA(2) SA(3) SA(4) SA(5) SA(6) SA(7) SA(8) SA(9)
#undef SA
#else
        if (hipFuncSetAttribute((const void*)mk_fwd, hipFuncAttributeMaxDynamicSharedMemorySize, LDS_BYTES) != hipSuccess) { fprintf(stderr, "kernel_launch: hipFuncSetAttribute failed\n"); grid = -1; return; }
        int per_cu = 0;
        if (hipOccupancyMaxActiveBlocksPerMultiprocessor(&per_cu, (const void*)mk_fwd, NTHREADS, LDS_BYTES) != hipSuccess || per_cu < 1) fprintf(stderr, "kernel_launch: occupancy query reports %d\n", per_cu);
        (void)hipGetLastError();
#endif
        grid = cus;
    }
    if (grid < 0) return;
    if (hipMemsetAsync((char*)d_ws + WS_CTL, 0, CTL_ZERO_BYTES, stream) != hipSuccess) return;
    Args a{};
    for (int i = 0; i < N_IN; ++i) a.in[i] = (const float*)d_in[i];
    a.out = (float*)d_out; a.ws = (unsigned char*)d_ws;
#if MK_PER_PHASE
#define LP(SUB, layer) hipLaunchKernelGGL(mk_phase<SUB>, dim3(grid), dim3(NTHREADS), LDS_BYTES, stream, a, layer)
    LP(0, 0);
    for (int layer = 0; layer < 2; ++layer) { LP(1, layer); LP(2, layer); LP(3, layer); LP(4, layer); LP(5, layer); LP(6, layer); LP(7, layer); LP(8, layer); }
    LP(9, 0);
#undef LP
#else
    a.ph_lo = 0; a.ph_hi = N_PHASES;
    hipLaunchKernelGGL(mk_fwd, dim3(grid), dim3(NTHREADS), LDS_BYTES, stream, a);
#endif
}
```

```cpp
#define MK_PER_PHASE 0
#include <hip/hip_runtime.h>
#include <cstdio>
#include <cstdint>

#define GAS __attribute__((address_space(1)))
#define LAS __attribute__((address_space(3)))
typedef unsigned short bf16;
typedef unsigned v4u __attribute__((ext_vector_type(4)));
typedef unsigned v2u __attribute__((ext_vector_type(2)));
typedef float f32x4 __attribute__((ext_vector_type(4)));
typedef short bf16x8 __attribute__((ext_vector_type(8)));

constexpr int D = 1024, T_CTX = 8192, T_LAT = 16384, T = 24576, L_CTX = 256, L_LAT = 2048, PAST = 256;
constexpr int NIN = 2816, G1W = 2304, G2W = 512;
constexpr int C_R = 0, C_K = 256, C_V = 512, C_G = 768, C_GM = 1024, C_XL = 1536, C_GL = 1792, C_LORA = 2048;
constexpr int LK_LAT = PAST + L_LAT;
constexpr int TK = T_CTX + 8 * LK_LAT;
constexpr int VT_LAT = 32 * 8 * 64 * 256;
constexpr float LN_EPS = 1e-5f, GN_EPS = 64e-5f;
constexpr float ALPHA = 1.4142135623730951f;
constexpr float QSCALE = 0.10206207261596575f * 1.4426950408889634f;
constexpr size_t O_Y = 0, O_RW = 25165824, O_CKV = 27262976, O_KR = 29360128, O_LRU = 29884416;
constexpr size_t MiB = 1u << 20;
constexpr size_t WS_CTL = 0, CTL_ZERO_BYTES = 1 * MiB;
constexpr size_t WS_MOD = 256 * 1024;
constexpr size_t WS_ROPE = 1 * MiB;
constexpr size_t WS_LORA2 = 1280 * 1024;
constexpr size_t WS_LRUW = 2816 * 1024;
constexpr size_t WS_STATS = 1536 * 1024;
constexpr size_t WS_WUQ = 2 * MiB;
constexpr size_t WS_WUKV = 3 * MiB;
constexpr size_t WS_WIN = 4 * MiB;
constexpr size_t WS_WOUT = 16 * MiB;
constexpr size_t WS_G1 = 20 * MiB;
constexpr size_t WS_G2 = 128 * MiB;
constexpr size_t WS_Q = 152 * MiB;
constexpr size_t WS_U = 152 * MiB;
constexpr size_t WS_KN = 188 * MiB;
constexpr size_t WS_KR = 214 * MiB;
constexpr size_t WS_VT = 216 * MiB;
constexpr size_t WS_YMIX = 188 * MiB;
constexpr size_t WS_HF = 242 * MiB;
constexpr size_t WS_END = 254 * MiB;
constexpr int CW_BAR = 4096;
constexpr int CW_Q = 16384;

__device__ __forceinline__ float bf2f(unsigned b) { return __uint_as_float(b << 16); }
__device__ __forceinline__ float bflo(unsigned w) { return __uint_as_float(w << 16); }
__device__ __forceinline__ float bfhi(unsigned w) { return __uint_as_float(w & 0xffff0000u); }
__device__ __forceinline__ unsigned f2bf(float f) { unsigned u = __float_as_uint(f); return (u + 0x7fffu + ((u >> 16) & 1u)) >> 16; }
__device__ __forceinline__ unsigned pk2(float lo, float hi) { return f2bf(lo) | (f2bf(hi) << 16); }
__device__ __forceinline__ float rcp_(float x) { return __builtin_amdgcn_rcpf(x); }
__device__ __forceinline__ float exp_(float x) { return __builtin_amdgcn_exp2f(x * 1.4426950408889634f); }
__device__ __forceinline__ float sqrt_(float x) { return __builtin_amdgcn_sqrtf(x); }
__device__ __forceinline__ float rsqrt_(float x) { return __builtin_amdgcn_rsqf(x); }
__device__ __forceinline__ float sigmoidf_(float x) { return rcp_(1.f + exp_(-x)); }
__device__ __forceinline__ float siluf_(float x) { return x * rcp_(1.f + exp_(-x)); }
template <int CTRL> __device__ __forceinline__ float dpp_f(float old, float x) { return __builtin_bit_cast(float, __builtin_amdgcn_update_dpp(__builtin_bit_cast(int, old), __builtin_bit_cast(int, x), CTRL, 0xf, 0xf, false)); }
__device__ __forceinline__ float row16_sum(float x) { x += dpp_f<0x128>(0.f, x); x += dpp_f<0x124>(0.f, x); x += dpp_f<0x122>(0.f, x); x += dpp_f<0x121>(0.f, x); return x; }
__device__ __forceinline__ float wave_sum_fast(float x) { x = row16_sum(x); x += __shfl_xor(x, 16); x += __shfl_xor(x, 32); return x; }
__device__ __forceinline__ float row16_prefix_prod(float x) { x *= dpp_f<0x111>(1.f, x); x *= dpp_f<0x112>(1.f, x); x *= dpp_f<0x114>(1.f, x); x *= dpp_f<0x118>(1.f, x); return x; }
__device__ __forceinline__ float wave_sum(float v) { return wave_sum_fast(v); }
__device__ __forceinline__ int tid_() { int t = threadIdx.x; asm volatile("" : "+v"(t)); return t; }
__device__ __forceinline__ int bid_() { int b = blockIdx.x; asm volatile("" : "+s"(b)); return b; }
__device__ __forceinline__ int grid_() { int g = gridDim.x; asm volatile("" : "+s"(g)); return g; }
typedef float f32x16 __attribute__((ext_vector_type(16)));
typedef float f32x2_t __attribute__((ext_vector_type(2)));
typedef __bf16 bf16x2_t __attribute__((ext_vector_type(2)));
__device__ __forceinline__ unsigned cvtpk(float lo, float hi) { const f32x2_t v = {lo, hi}; return __builtin_bit_cast(unsigned, __builtin_convertvector(v, bf16x2_t)); }
#define XB_TMO      128
#define XB_XCNT(j)  (256  + 64 * (j))
#define XB_XSUB(j)  (1280 + 64 * (j))
#define XB_XGEN(j)  (2304 + 64 * (j))
#define XB_TOP      3328
#define XB_TOPGEN   3392
#define XCD_BAR_WORDS 3456
#define XB_SPIN_CAP (1u << 24)

__device__ __forceinline__ unsigned xb_ld(unsigned* p)              { return __hip_atomic_load(p, __ATOMIC_RELAXED, __HIP_MEMORY_SCOPE_AGENT); }
__device__ __forceinline__ unsigned xb_add(unsigned* p, unsigned v) { return __hip_atomic_fetch_add(p, v, __ATOMIC_RELAXED, __HIP_MEMORY_SCOPE_AGENT); }
__device__ __forceinline__ unsigned xb_xcc_id() { return (unsigned)__builtin_amdgcn_s_getreg((3 << 11) | 20) & 0xFu; }
#define XB_SPIN(cond, bar) do { unsigned _sp = 0; while (cond) { __builtin_amdgcn_s_sleep(1); \
    if ((++_sp & 255u) == 0u) { if (xb_ld(&(bar)[XB_TMO])) break; if (_sp > XB_SPIN_CAP) { atomicAdd(&(bar)[XB_TMO], 1u); break; } } } } while (0)

struct XcdBarrier {
    unsigned* bar; unsigned x;
    volatile LAS unsigned* st;
};

__device__ __forceinline__ XcdBarrier xcd_barrier_post(unsigned* bar, volatile LAS unsigned* st) {
    XcdBarrier b; b.bar = bar; b.x = xb_xcc_id(); b.st = st;
    if (threadIdx.x == 0) (void)xb_add(&bar[XB_XCNT(b.x)], 1u);
    return b;
}
__device__ __forceinline__ void xcd_barrier_complete(unsigned* bar, unsigned x, unsigned& nloc, unsigned& nx) {
    const unsigned G = gridDim.x * gridDim.y * gridDim.z;
    unsigned sum, cnt, mine, sp = 0u;
    for (;;) {
        sum = 0u; cnt = 0u; mine = 0u;
#pragma unroll
        for (unsigned j = 0; j < 16; ++j) { const unsigned c = xb_ld(&bar[XB_XCNT(j)]); sum += c; cnt += (c > 0u) ? 1u : 0u; mine = (j == x) ? c : mine; }
        if (sum == G) break;
        __builtin_amdgcn_s_sleep(1);
        if ((++sp & 255u) == 0u) { if (xb_ld(&bar[XB_TMO])) break; if (sp > XB_SPIN_CAP) { atomicAdd(&bar[XB_TMO], 1u); break; } }
    }
    nloc = mine > 0u ? mine : 1u; nx = cnt > 0u ? cnt : 1u;
}

__device__ __forceinline__ void xcd_barrier(const XcdBarrier& b) {
    asm volatile("s_waitcnt vmcnt(0)" ::: "memory");
    __syncthreads();
    if (threadIdx.x == 0) {
        unsigned* bar = b.bar;
        __builtin_amdgcn_s_waitcnt(0);
        unsigned nloc = b.st[0], nx = b.st[1];
        if (nloc == 0u) { xcd_barrier_complete(bar, b.x, nloc, nx); b.st[0] = nloc; b.st[1] = nx; }
        const unsigned old = xb_add(&bar[XB_XSUB(b.x)], 1u);
        const unsigned gen = old / nloc;
        if (old + 1u == (gen + 1u) * nloc) {
            __builtin_amdgcn_fence(__ATOMIC_RELEASE, "agent");
            asm volatile("s_waitcnt vmcnt(0)" ::: "memory");
            const unsigned og = xb_add(&bar[XB_TOP], 1u);
            const unsigned tg = og / nx;
            if (og + 1u == (tg + 1u) * nx) xb_add(&bar[XB_TOPGEN], 1u);
            else XB_SPIN(xb_ld(&bar[XB_TOPGEN]) == tg, bar);
            __builtin_amdgcn_fence(__ATOMIC_ACQUIRE, "agent");
            xb_add(&bar[XB_XGEN(b.x)], 1u);
            asm volatile("s_waitcnt vmcnt(0)" ::: "memory");
        } else {
            XB_SPIN(xb_ld(&bar[XB_XGEN(b.x)]) == gen, bar);
            __builtin_amdgcn_fence(__ATOMIC_ACQUIRE, "agent");
            asm volatile("s_waitcnt vmcnt(0)" ::: "memory");
        }
    }
    __syncthreads();
}
enum { I_XP = 0, I_XS, I_SRW, I_CCKV, I_CKR, I_SLRU, I_C, I_CCTX, I_WMOD, I_BMOD, I_WIN, I_W0, I_W1, I_W2, I_A0, I_A1, I_A2, I_KK, I_KA, I_RK,
       I_LNXG, I_LNXB, I_QNORM, I_WUQ, I_KVNORM, I_WUKV, I_CONVW, I_CONVB, I_WA, I_BA, I_WX, I_BX, I_LAMBDA, I_WOUT, I_LNG, I_LNB, N_IN };
struct Args { const float* in[N_IN]; float* out; unsigned char* ws; int ph_lo, ph_hi; };
typedef const Args __attribute__((address_space(4)))* ArgsP;
constexpr int NTHREADS = 512;
constexpr int LDS_MISC = 139264;
constexpr int LDS_BYTES = 147456;

struct Tok { int n, b, t, L, lat, modrow, tok0, kidx; };
__device__ __forceinline__ Tok tok_of(int n) {
    Tok k; k.n = n;
    if (n < T_CTX) { k.lat = 0; k.b = n >> 8; k.t = n & 255; k.L = L_CTX; k.modrow = 0; k.tok0 = k.b * 256; k.kidx = n; }
    else { const int m = n - T_CTX; k.lat = 1; k.b = m >> 11; k.t = m & 2047; k.L = L_LAT; k.modrow = 1 + k.b; k.tok0 = T_CTX + k.b * 2048; k.kidx = T_CTX + k.b * LK_LAT + PAST + k.t; }
    return k;
}
__device__ __forceinline__ const float* xrow_src(ArgsP a, int layer, int n) {
    if (layer == 0) return n < T_CTX ? a->in[I_XP] + (size_t)n * D : a->in[I_XS] + (size_t)(n - T_CTX) * D;
    return a->out + (size_t)n * D;
}
__device__ __forceinline__ float dot8(v4u a, v4u b, float acc) {
    acc = fmaf(bflo(a.x), bflo(b.x), acc); acc = fmaf(bfhi(a.x), bfhi(b.x), acc);
    acc = fmaf(bflo(a.y), bflo(b.y), acc); acc = fmaf(bfhi(a.y), bfhi(b.y), acc);
    acc = fmaf(bflo(a.z), bflo(b.z), acc); acc = fmaf(bfhi(a.z), bfhi(b.z), acc);
    acc = fmaf(bflo(a.w), bflo(b.w), acc); acc = fmaf(bfhi(a.w), bfhi(b.w), acc);
    return acc;
}

__device__ __forceinline__ void tr_item(const float* src, int ld, int col0, int k0, bf16* WT, int K, int row0, float scale, LAS float* scr, int lane) {
    {
        const int kr = lane >> 3, n4 = (lane & 7) * 4;
        f32x4 v[8];
#pragma unroll
        for (int i = 0; i < 8; ++i) v[i] = src ? *(const f32x4*)(src + (size_t)(k0 + i * 8 + kr) * ld + col0 + n4) : (f32x4){0.f, 0.f, 0.f, 0.f};
#pragma unroll
        for (int i = 0; i < 8; ++i) { LAS float* d = scr + (i * 8 + kr) * 33 + n4; d[0] = v[i].x * scale; d[1] = v[i].y * scale; d[2] = v[i].z * scale; d[3] = v[i].w * scale; }
    }
    asm volatile("s_waitcnt lgkmcnt(0)" ::: "memory");
    const int c = lane & 7;
#pragma unroll
    for (int j = 0; j < 4; ++j) { const int n = (lane >> 3) + 8 * j; const LAS float* s = scr + (8 * c) * 33 + n;
        v4u o; o.x = pk2(s[0 * 33], s[1 * 33]); o.y = pk2(s[2 * 33], s[3 * 33]); o.z = pk2(s[4 * 33], s[5 * 33]); o.w = pk2(s[6 * 33], s[7 * 33]);
        *(v4u*)(WT + (size_t)(row0 + n) * K + k0 + 8 * c) = o; }
    asm volatile("s_waitcnt lgkmcnt(0)" ::: "memory");
}
__device__ __forceinline__ void rope_angle(int t, int i, float& c, float& s) {
    const int row = t >> 6, col = t & 63; const int ii = i & 7;
    const float inv = exp2f(-(float)ii * (13.287712379549449f / 8.f));
    const float ang = (float)(i < 8 ? row : col) * inv;
    c = cosf(ang); s = sinf(ang);
}
__device__ __forceinline__ void phase_p0_weights(ArgsP a, LAS unsigned char* lds) {
    const int tid = tid_(), lane = tid & 63, wave = tid >> 6, G = grid_();
    unsigned char* ws = a->ws;
    LAS float* scr = (LAS float*)(lds + wave * 8704);
    const int gw = bid_() * 8 + wave, NGW = G * 8;
    constexpr int N_WIN = 2 * 16 * 88, N_WOUT = 2 * 16 * 32, N_WUQ = 2 * 4 * 24, N_WUKV = 2 * 4 * 32, N_LORA = 2 * 2 * 2 * 8, N_LRUW = 2 * 2 * 2 * 4 * 2;
    for (int it = gw; it < N_WIN + N_WOUT + N_WUQ + N_WUKV + N_LORA + N_LRUW; it += NGW) {
        int r = it;
        if (r < N_WIN) {
            const int l = r / (16 * 88), kb = (r / 88) % 16, nb = r % 88, j0 = nb * 32;
            const float* src; int ld, col0;
            const float* win = a->in[I_WIN] + (size_t)l * 1024 * 2464;
            if (j0 < 1024) { src = win; ld = 2464; col0 = j0; }
            else if (j0 < 1536) { src = win; ld = 2464; col0 = 1440 + (j0 - 1024); }
            else if (j0 < 1792) { src = win; ld = 2464; col0 = 1952 + (j0 - 1536); }
            else if (j0 < 2048) { src = win; ld = 2464; col0 = 2208 + (j0 - 1792); }
            else if (j0 < 2304) { const int q = (j0 - 2048) >> 6; src = (q < 2 ? a->in[I_W1] : a->in[I_A1]) + (size_t)(l * 2 + (q & 1)) * 1024 * 64; ld = 64; col0 = (j0 - 2048) & 63; }
            else if (j0 < 2560) { src = win; ld = 2464; col0 = 1024 + (j0 - 2304); }
            else if (j0 < 2688) { src = win; ld = 2464; col0 = 1280 + (j0 - 2560); }
            else if (j0 < 2720) { src = win; ld = 2464; col0 = 1408 + (j0 - 2688); }
            else { src = nullptr; ld = 0; col0 = 0; }
            tr_item(src, ld, col0, kb * 64, (bf16*)(ws + WS_WIN) + (size_t)l * NIN * 1024, 1024, j0, 1.f, scr, lane);
            continue;
        }
        r -= N_WIN;
        if (r < N_WOUT) { const int l = r / (16 * 32), kb = (r / 32) % 16, nb = r % 32;
            tr_item(a->in[I_WOUT] + (size_t)l * 1024 * 1024, 1024, nb * 32, kb * 64, (bf16*)(ws + WS_WOUT) + (size_t)l * 1024 * 1024, 1024, nb * 32, 1.f, scr, lane); continue; }
        r -= N_WOUT;
        if (r < N_WUQ) { const int l = r / (4 * 24), kb = (r / 24) % 4, nb = r % 24;
            tr_item(a->in[I_WUQ] + (size_t)l * 256 * 768, 768, nb * 32, kb * 64, (bf16*)(ws + WS_WUQ) + (size_t)l * 768 * 256, 256, nb * 32, QSCALE, scr, lane); continue; }
        r -= N_WUQ;
        if (r >= N_WUKV) { r -= N_WUKV;
            if (r < N_LORA) { const int le = r >> 4, m = (r >> 3) & 1, nb = r & 7;
                tr_item((m ? a->in[I_A2] : a->in[I_W2]) + (size_t)le * 64 * 256, 256, nb * 32, 0, (bf16*)(ws + WS_LORA2) + (size_t)(le * 2 + m) * 256 * 64, 64, nb * 32, 1.f, scr, lane); }
            else { r -= N_LORA; const int le = r >> 4, m = (r >> 3) & 1, g = (r >> 1) & 3, nb = r & 1;
                tr_item((m ? a->in[I_WX] : a->in[I_WA]) + (size_t)(le * 4 + g) * 4096, 64, nb * 32, 0, (bf16*)(ws + WS_LRUW) + (size_t)((le * 2 + m) * 4 + g) * 4096, 64, nb * 32, 1.f, scr, lane); }
            continue; }
        { const int l = r / (4 * 32), kb = (r / 32) % 4, nb = r % 32;
            tr_item(kb < 2 ? a->in[I_WUKV] + (size_t)l * 128 * 1024 : nullptr, 1024, nb * 32, kb * 64, (bf16*)(ws + WS_WUKV) + (size_t)l * 1024 * 256, 256, nb * 32, 1.f, scr, lane); }
    }
}
__device__ __forceinline__ void phase_p0(ArgsP a, LAS unsigned char* lds) {
    const int tid = tid_(), G = grid_();
    unsigned char* ws = a->ws;
    { float* ROPE = (float*)(ws + WS_ROPE);
      for (int i = bid_() * NTHREADS + tid; i < 2048 * 16; i += G * NTHREADS) { float c, s; rope_angle(i >> 4, i & 15, c, s); ROPE[i * 2] = c; ROPE[i * 2 + 1] = s; } }
    float* MOD = (float*)(ws + WS_MOD);
    LAS float* SIL = (LAS float*)lds;
    for (int it = bid_(); it < 2 * 6 * 32; it += G) {
        const int l = it / 192, nb = (it / 32) % 6, kq = it % 32, col = nb * 512 + tid;
        __syncthreads();
        if (tid < 288) { const int j = tid >> 5, k = kq * 32 + (tid & 31); const float cj = (j == 0) ? a->in[I_CCTX][k] : a->in[I_C][(j - 1) * 1024 + k]; SIL[tid] = siluf_(cj); }
        float w[32];
#pragma unroll
        for (int kk = 0; kk < 32; ++kk) w[kk] = a->in[I_WMOD][((size_t)l * 1024 + kq * 32 + kk) * 3072 + col];
        __syncthreads();
        const float bias = (kq == 0) ? a->in[I_BMOD][l * 3072 + col] : 0.f;
#pragma unroll
        for (int j = 0; j < 9; ++j) { float acc = bias;
#pragma unroll
            for (int k4 = 0; k4 < 8; ++k4) { const f32x4 sv = *(const LAS f32x4*)(SIL + j * 32 + k4 * 4); acc = fmaf(sv.x, w[k4 * 4], acc); acc = fmaf(sv.y, w[k4 * 4 + 1], acc); acc = fmaf(sv.z, w[k4 * 4 + 2], acc); acc = fmaf(sv.w, w[k4 * 4 + 3], acc); }
            atomicAdd(&MOD[(l * 9 + j) * 3072 + col], acc); }
    }
}

__device__ __forceinline__ void phase_a0(ArgsP a, int layer) {
    const int tid = tid_(), lane = tid & 63, wave = tid >> 6, G = grid_();
    const float* MOD = (const float*)(a->ws + WS_MOD);
    bf16* U = (bf16*)(a->ws + WS_U);
    f32x4 nx[4];
#define A0_LOAD(nn_) do { if (layer == 0) { const float* xr_ = xrow_src(a, 0, (nn_)); \
            _Pragma("unroll") for (int j = 0; j < 4; ++j) nx[j] = *(const f32x4*)(xr_ + lane * 4 + 256 * j); } \
        else { const bf16* zr_ = (const bf16*)a->out + (size_t)(nn_) * 2048; \
            _Pragma("unroll") for (int j = 0; j < 4; ++j) { const v2u w_ = *(const v2u*)(zr_ + lane * 4 + 256 * j); nx[j] = (f32x4){bflo(w_.x), bfhi(w_.x), bflo(w_.y), bfhi(w_.y)}; } } } while (0)
    { const int n0 = bid_() * 8 + wave; if (n0 < T) A0_LOAD(n0); }
    for (int n = bid_() * 8 + wave; n < T; n += G * 8) {
        const Tok tk = tok_of(n);
        f32x4 v[4]; float s = 0.f;
#pragma unroll
        for (int j = 0; j < 4; ++j) { v[j] = nx[j]; s += (v[j].x + v[j].y) + (v[j].z + v[j].w); }
        if (n + G * 8 < T) A0_LOAD(n + G * 8);
        float mean = wave_sum(s) * (1.f / D), s2 = 0.f;
#pragma unroll
        for (int j = 0; j < 4; ++j) { v[j] = v[j] - mean; s2 += (v[j].x * v[j].x + v[j].y * v[j].y) + (v[j].z * v[j].z + v[j].w * v[j].w); }
        float rstd = rsqrt_(wave_sum(s2) * (1.f / D) + LN_EPS);
        if (layer == 1) {
            s = 0.f;
#pragma unroll
            for (int j = 0; j < 4; ++j) { const f32x4 g = *(const f32x4*)(a->in[I_LNG] + lane * 4 + 256 * j), b = *(const f32x4*)(a->in[I_LNB] + lane * 4 + 256 * j);
                v[j] = v[j] * rstd * g + b; s += (v[j].x + v[j].y) + (v[j].z + v[j].w); }
            if (lane == 0) { float* st = (float*)(a->ws + WS_STATS) + (size_t)n * 2; st[0] = mean; st[1] = rstd; }
            mean = wave_sum(s) * (1.f / D); s2 = 0.f;
#pragma unroll
            for (int j = 0; j < 4; ++j) { v[j] = v[j] - mean; s2 += (v[j].x * v[j].x + v[j].y * v[j].y) + (v[j].z * v[j].z + v[j].w * v[j].w); }
            rstd = rsqrt_(wave_sum(s2) * (1.f / D) + LN_EPS);
        }
        const float* m = MOD + (size_t)(layer * 9 + tk.modrow) * 3072;
#pragma unroll
        for (int j = 0; j < 4; ++j) { const int c = lane * 4 + 256 * j; const f32x4 sh = *(const f32x4*)(m + c), sc = *(const f32x4*)(m + 1024 + c);
            const f32x4 o = v[j] * rstd * (sc + 1.f) + sh;
            v2u p; p.x = pk2(o.x, o.y); p.y = pk2(o.z, o.w); *(v2u*)(U + (size_t)n * D + c) = p; }
    }
}
__device__ __forceinline__ void phase_final(ArgsP a) {
    const int tid = tid_(), lane = tid & 63, wave = tid >> 6, G = grid_();
    f32x4 nx[4];
#define FN_LOAD(nn_) do { const bf16* zr_ = (const bf16*)a->out + (size_t)(nn_) * 2048; \
        _Pragma("unroll") for (int j = 0; j < 4; ++j) { const v2u w_ = *(const v2u*)(zr_ + lane * 4 + 256 * j); nx[j] = (f32x4){bflo(w_.x), bfhi(w_.x), bflo(w_.y), bfhi(w_.y)}; } } while (0)
    { const int n0 = bid_() * 8 + wave; if (n0 < T) FN_LOAD(n0); }
    for (int n = bid_() * 8 + wave; n < T; n += G * 8) {
        float* xr = a->out + (size_t)n * D;
        f32x4 v[4]; float s = 0.f;
#pragma unroll
        for (int j = 0; j < 4; ++j) { v[j] = nx[j]; s += (v[j].x + v[j].y) + (v[j].z + v[j].w); }
        if (n + G * 8 < T) FN_LOAD(n + G * 8);
        const float mean = wave_sum(s) * (1.f / D); float s2 = 0.f;
#pragma unroll
        for (int j = 0; j < 4; ++j) { v[j] = v[j] - mean; s2 += (v[j].x * v[j].x + v[j].y * v[j].y) + (v[j].z * v[j].z + v[j].w * v[j].w); }
        const float rstd = rsqrt_(wave_sum(s2) * (1.f / D) + LN_EPS);
#pragma unroll
        for (int j = 0; j < 4; ++j) { const f32x4 g = *(const f32x4*)(a->in[I_LNG] + 1024 + lane * 4 + 256 * j), b = *(const f32x4*)(a->in[I_LNB] + 1024 + lane * 4 + 256 * j);
            *(f32x4*)(xr + lane * 4 + 256 * j) = v[j] * rstd * g + b; }
    }
}

__device__ __forceinline__ void phase_a1_naive(ArgsP a, int layer) {
    const bf16* U = (const bf16*)(a->ws + WS_U); const bf16* W = (const bf16*)(a->ws + WS_WIN) + (size_t)layer * NIN * 1024;
    bf16* G1 = (bf16*)(a->ws + WS_G1); bf16* G2 = (bf16*)(a->ws + WS_G2);
    const size_t total = (size_t)T * (NIN / 8), stride = (size_t)grid_() * NTHREADS;
    for (size_t idx = (size_t)bid_() * NTHREADS + tid_(); idx < total; idx += stride) {
        const int row = (int)(idx / (NIN / 8)), c0 = (int)(idx % (NIN / 8)) * 8;
        float acc[8];
#pragma unroll
        for (int c = 0; c < 8; ++c) acc[c] = 0.f;
        const v4u* ap = (const v4u*)(U + (size_t)row * 1024); const v4u* bp = (const v4u*)(W + (size_t)c0 * 1024);
        for (int kc = 0; kc < 128; ++kc) { const v4u av = ap[kc];
#pragma unroll
            for (int c = 0; c < 8; ++c) acc[c] = dot8(av, bp[c * 128 + kc], acc[c]); }
        v4u o; o.x = pk2(acc[0], acc[1]); o.y = pk2(acc[2], acc[3]); o.z = pk2(acc[4], acc[5]); o.w = pk2(acc[6], acc[7]);
        if (c0 < G1W) *(v4u*)(G1 + (size_t)row * G1W + c0) = o; else *(v4u*)(G2 + (size_t)row * G2W + (c0 - G1W)) = o;
    }
}
__device__ __forceinline__ void phase_c2_naive(ArgsP a, int layer) {
    const bf16* Y = (const bf16*)(a->ws + WS_YMIX); const bf16* W = (const bf16*)(a->ws + WS_WOUT) + (size_t)layer * 1024 * 1024;
    const float* MOD = (const float*)(a->ws + WS_MOD);
    const size_t total = (size_t)T * 256, stride = (size_t)grid_() * NTHREADS;
    for (size_t idx = (size_t)bid_() * NTHREADS + tid_(); idx < total; idx += stride) {
        const int row = (int)(idx >> 8), c0 = (int)(idx & 255) * 4;
        float acc[4] = {0.f, 0.f, 0.f, 0.f};
        const v4u* ap = (const v4u*)(Y + (size_t)row * 1024); const v4u* bp = (const v4u*)(W + (size_t)c0 * 1024);
        for (int kc = 0; kc < 128; ++kc) { const v4u av = ap[kc];
#pragma unroll
            for (int c = 0; c < 4; ++c) acc[c] = dot8(av, bp[c * 128 + kc], acc[c]); }
        const Tok tk = tok_of(row);
        const f32x4 gate = *(const f32x4*)(MOD + (size_t)(layer * 9 + tk.modrow) * 3072 + 2048 + c0);
        const f32x4 x = *(const f32x4*)(xrow_src(a, layer, row) + c0);
        f32x4 z; z.x = ALPHA * x.x + gate.x * acc[0]; z.y = ALPHA * x.y + gate.y * acc[1]; z.z = ALPHA * x.z + gate.z * acc[2]; z.w = ALPHA * x.w + gate.w * acc[3];
        *(f32x4*)(a->out + (size_t)row * D + c0) = z;
    }
}

__device__ __forceinline__ void phase_a2_naive(ArgsP a, LAS unsigned char* lds, int layer) {
    const int tid = tid_(), lane = tid & 63, wave = tid >> 6, G = grid_();
    LAS float* AQ = (LAS float*)lds;
    LAS float* AKV = (LAS float*)(lds + 16384);
    LAS float* OT = (LAS float*)(lds + 24576);
    const bf16* G2 = (const bf16*)(a->ws + WS_G2);
    bf16* Q = (bf16*)(a->ws + WS_Q); bf16* KN = (bf16*)(a->ws + WS_KN); bf16* KR = (bf16*)(a->ws + WS_KR); bf16* VT = (bf16*)(a->ws + WS_VT);
    const bf16* WUQ = (const bf16*)(a->ws + WS_WUQ) + (size_t)layer * 768 * 256;
    const bf16* WUKV = (const bf16*)(a->ws + WS_WUKV) + (size_t)layer * 1024 * 128;
    constexpr int NT_TOK = T / 16, NT_CACHE = 8 * 256 / 16;
    for (int tile = bid_(); tile < NT_TOK + NT_CACHE; tile += G) {
        const bool is_tok = tile < NT_TOK;
        for (int rr = 0; rr < 2; ++rr) {
            const int r = wave * 2 + rr;
            if (is_tok) {
                const int n = tile * 16 + r; const Tok tk = tok_of(n);
                const v2u cqv = *(const v2u*)(G2 + (size_t)n * G2W + lane * 4);
                const float c0 = bflo(cqv.x), c1 = bfhi(cqv.x), c2 = bflo(cqv.y), c3 = bfhi(cqv.y);
                const float rq = rsqrt_(wave_sum(c0 * c0 + c1 * c1 + c2 * c2 + c3 * c3) * (1.f / 256.f) + 1e-6f);
                const f32x4 qn = *(const f32x4*)(a->in[I_QNORM] + layer * 256 + lane * 4);
                AQ[r * 256 + lane * 4 + 0] = bf2f(f2bf(c0 * rq * qn.x)); AQ[r * 256 + lane * 4 + 1] = bf2f(f2bf(c1 * rq * qn.y));
                AQ[r * 256 + lane * 4 + 2] = bf2f(f2bf(c2 * rq * qn.z)); AQ[r * 256 + lane * 4 + 3] = bf2f(f2bf(c3 * rq * qn.w));
                float k0 = 0.f, k1 = 0.f, k2 = 0.f, k3 = 0.f;
                if (lane < 32) { const v2u kv = *(const v2u*)(G2 + (size_t)n * G2W + 256 + lane * 4); k0 = bflo(kv.x); k1 = bfhi(kv.x); k2 = bflo(kv.y); k3 = bfhi(kv.y); }
                const float rk = rsqrt_(wave_sum(k0 * k0 + k1 * k1 + k2 * k2 + k3 * k3) * (1.f / 128.f) + 1e-6f);
                if (lane < 32) {
                    const f32x4 kn = *(const f32x4*)(a->in[I_KVNORM] + layer * 128 + lane * 4);
                    f32x4 o; o.x = k0 * rk * kn.x; o.y = k1 * rk * kn.y; o.z = k2 * rk * kn.z; o.w = k3 * rk * kn.w;
                    if (!tk.lat) *(f32x4*)(a->out + O_CKV + ((size_t)(tk.b * 2 + layer) * 256 + tk.t) * 128 + lane * 4) = o;
                    AKV[r * 128 + lane * 4 + 0] = bf2f(f2bf(o.x)); AKV[r * 128 + lane * 4 + 1] = bf2f(f2bf(o.y));
                    AKV[r * 128 + lane * 4 + 2] = bf2f(f2bf(o.z)); AKV[r * 128 + lane * 4 + 3] = bf2f(f2bf(o.w));
                }
                float krv = (lane < 32) ? bf2f(G2[(size_t)n * G2W + 384 + lane]) : 0.f;
                const float other = __shfl_xor(krv, 1);
                if (lane < 32) {
                    if (!tk.lat) a->out[O_KR + ((size_t)(tk.b * 2 + layer) * 256 + tk.t) * 32 + lane] = krv;
                    else { float c, s; rope_angle(tk.t, lane >> 1, c, s); krv = (lane & 1) ? (other * s + krv * c) : (krv * c - other * s); }
                    KR[(size_t)tk.kidx * 32 + lane] = (bf16)f2bf(krv);
                }
            } else {
                const int cr = (tile - NT_TOK) * 16 + r, b = cr >> 8, j = cr & 255;
                const size_t src = ((size_t)(b * 2 + layer) * 256 + j);
                if (lane < 32) { const f32x4 v = *(const f32x4*)(a->in[I_CCKV] + src * 128 + lane * 4);
                    AKV[r * 128 + lane * 4 + 0] = bf2f(f2bf(v.x)); AKV[r * 128 + lane * 4 + 1] = bf2f(f2bf(v.y)); AKV[r * 128 + lane * 4 + 2] = bf2f(f2bf(v.z)); AKV[r * 128 + lane * 4 + 3] = bf2f(f2bf(v.w));
                    KR[(size_t)(T_CTX + b * LK_LAT + j) * 32 + lane] = (bf16)f2bf(a->in[I_CKR][src * 32 + lane]); }
            }
        }
        __syncthreads();
        if (is_tok) {
            for (int col = tid; col < 768; col += NTHREADS) {
                float acc[16];
#pragma unroll
                for (int r = 0; r < 16; ++r) acc[r] = 0.f;
                const v4u* wp = (const v4u*)(WUQ + (size_t)col * 256);
                for (int kc = 0; kc < 32; ++kc) { const v4u w = wp[kc];
                    const float w0 = bflo(w.x), w1 = bfhi(w.x), w2 = bflo(w.y), w3 = bfhi(w.y), w4 = bflo(w.z), w5 = bfhi(w.z), w6 = bflo(w.w), w7 = bfhi(w.w);
#pragma unroll
                    for (int r = 0; r < 16; ++r) { const f32x4 x0 = *(const LAS f32x4*)(AQ + r * 256 + kc * 8), x1 = *(const LAS f32x4*)(AQ + r * 256 + kc * 8 + 4);
                        acc[r] += x0.x * w0 + x0.y * w1 + x0.z * w2 + x0.w * w3 + x1.x * w4 + x1.y * w5 + x1.z * w6 + x1.w * w7; } }
#pragma unroll
                for (int r = 0; r < 16; ++r) OT[r * 1024 + col] = acc[r];
            }
            __syncthreads();
            for (int idx = tid; idx < 16 * 384; idx += NTHREADS) {
                const int r = idx / 384, col = (idx % 384) * 2, d = col % 96; const int n = tile * 16 + r; const Tok tk = tok_of(n);
                float v0 = OT[r * 1024 + col], v1 = OT[r * 1024 + col + 1];
                if (tk.lat && d >= 64) { float c, s; rope_angle(tk.t, (d - 64) >> 1, c, s); const float y0 = v0 * c - v1 * s, y1 = v0 * s + v1 * c; v0 = y0; v1 = y1; }
                *(unsigned*)(Q + (size_t)n * 768 + col) = pk2(v0, v1);
            }
            __syncthreads();
        }
        for (int col = tid; col < 1024; col += NTHREADS) {
            float acc[16];
#pragma unroll
            for (int r = 0; r < 16; ++r) acc[r] = 0.f;
            const v4u* wp = (const v4u*)(WUKV + (size_t)col * 128);
            for (int kc = 0; kc < 16; ++kc) { const v4u w = wp[kc];
                const float w0 = bflo(w.x), w1 = bfhi(w.x), w2 = bflo(w.y), w3 = bfhi(w.y), w4 = bflo(w.z), w5 = bfhi(w.z), w6 = bflo(w.w), w7 = bfhi(w.w);
#pragma unroll
                for (int r = 0; r < 16; ++r) { const f32x4 x0 = *(const LAS f32x4*)(AKV + r * 128 + kc * 8), x1 = *(const LAS f32x4*)(AKV + r * 128 + kc * 8 + 4);
                    acc[r] += x0.x * w0 + x0.y * w1 + x0.z * w2 + x0.w * w3 + x1.x * w4 + x1.y * w5 + x1.z * w6 + x1.w * w7; } }
#pragma unroll
            for (int r = 0; r < 16; ++r) OT[r * 1024 + col] = acc[r];
        }
        __syncthreads();
        for (int idx = tid; idx < 16 * 1024; idx += NTHREADS) {
            const int r = idx >> 10, col = idx & 1023, h = col >> 7, f = col & 127;
            int kidx, lat, b, kpos;
            if (is_tok) { const Tok tk = tok_of(tile * 16 + r); kidx = tk.kidx; lat = tk.lat; b = tk.b; kpos = tk.lat ? PAST + tk.t : tk.t; }
            else { const int cr = (tile - NT_TOK) * 16 + r; b = cr >> 8; kpos = cr & 255; lat = 1; kidx = T_CTX + b * LK_LAT + kpos; }
            const bf16 v = (bf16)f2bf(OT[r * 1024 + col]);
            if (f < 64) KN[(size_t)kidx * 512 + h * 64 + f] = v;
            else { const int dv = f - 64; const size_t base = lat ? (size_t)VT_LAT + ((size_t)(b * 8 + h) * 64 + dv) * LK_LAT : ((size_t)(b * 8 + h) * 64 + dv) * 256; VT[base + kpos] = v; }
        }
        __syncthreads();
    }
}

__device__ __forceinline__ void phase_att_naive(ArgsP a) {
    const bf16* KN = (const bf16*)(a->ws + WS_KN); const bf16* KR = (const bf16*)(a->ws + WS_KR); const bf16* VT = (const bf16*)(a->ws + WS_VT);
    bf16* Q = (bf16*)(a->ws + WS_Q); const bf16* G1 = (const bf16*)(a->ws + WS_G1);
    const int total = T * 8, stride = grid_() * NTHREADS;
    for (int idx = bid_() * NTHREADS + tid_(); idx < total; idx += stride) {
        int n, h, Lk, kidx0; size_t vbase;
        if (idx < T_CTX * 8) { const int b = idx >> 11, hh = (idx >> 8) & 7, t = idx & 255; n = b * 256 + t; h = hh; Lk = 256; kidx0 = b * 256; vbase = ((size_t)(b * 8 + h) * 64) * 256; }
        else { const int m = idx - T_CTX * 8, b = m >> 14, hh = (m >> 11) & 7, t = m & 2047; n = T_CTX + b * 2048 + t; h = hh; Lk = LK_LAT; kidx0 = T_CTX + b * LK_LAT; vbase = (size_t)VT_LAT + ((size_t)(b * 8 + h) * 64) * LK_LAT; }
        v4u qp[12];
#pragma unroll
        for (int c = 0; c < 12; ++c) qp[c] = *(const v4u*)(Q + (size_t)n * 768 + h * 96 + c * 8);
        float acc[64];
#pragma unroll
        for (int d = 0; d < 64; ++d) acc[d] = 0.f;
        float m = -1e30f, l = 0.f;
        for (int j0 = 0; j0 < Lk; j0 += 8) {
            float s[8];
#pragma unroll
            for (int j = 0; j < 8; ++j) {
                const v4u* kp = (const v4u*)(KN + (size_t)(kidx0 + j0 + j) * 512 + h * 64); const v4u* rp = (const v4u*)(KR + (size_t)(kidx0 + j0 + j) * 32);
                float sv = 0.f;
#pragma unroll
                for (int c = 0; c < 8; ++c) sv = dot8(qp[c], kp[c], sv);
#pragma unroll
                for (int c = 0; c < 4; ++c) sv = dot8(qp[8 + c], rp[c], sv);
                s[j] = sv;
                __builtin_amdgcn_sched_barrier(0);
            }
            float mx = m;
#pragma unroll
            for (int j = 0; j < 8; ++j) mx = fmaxf(mx, s[j]);
            const float alpha = exp2f(m - mx); m = mx; float ps = 0.f;
#pragma unroll
            for (int j = 0; j < 8; ++j) { s[j] = exp2f(s[j] - mx); ps += s[j]; }
            l = l * alpha + ps;
            unsigned lk = (unsigned)Lk; asm volatile("" : "+v"(lk));
            const bf16* vp = VT + vbase + j0;
#pragma unroll
            for (int dg = 0; dg < 8; ++dg) {
#pragma unroll
                for (int dd = 0; dd < 8; ++dd) { const int d = dg * 8 + dd; const v4u w = *(const v4u*)(vp + (unsigned)d * lk);
                    acc[d] = acc[d] * alpha + s[0] * bflo(w.x) + s[1] * bfhi(w.x) + s[2] * bflo(w.y) + s[3] * bfhi(w.y) + s[4] * bflo(w.z) + s[5] * bfhi(w.z) + s[6] * bflo(w.w) + s[7] * bfhi(w.w); }
                __builtin_amdgcn_sched_barrier(0);
            }
        }
        const float inv = rcp_(l);
#pragma unroll
        for (int c = 0; c < 8; ++c) { const v4u g = *(const v4u*)(G1 + (size_t)n * G1W + C_GM + h * 64 + c * 8);
            v4u o;
            o.x = pk2(acc[c * 8 + 0] * inv * siluf_(bflo(g.x)), acc[c * 8 + 1] * inv * siluf_(bfhi(g.x)));
            o.y = pk2(acc[c * 8 + 2] * inv * siluf_(bflo(g.y)), acc[c * 8 + 3] * inv * siluf_(bfhi(g.y)));
            o.z = pk2(acc[c * 8 + 4] * inv * siluf_(bflo(g.z)), acc[c * 8 + 5] * inv * siluf_(bfhi(g.z)));
            o.w = pk2(acc[c * 8 + 6] * inv * siluf_(bflo(g.w)), acc[c * 8 + 7] * inv * siluf_(bfhi(g.w)));
            *(v4u*)(Q + (size_t)n * 768 + h * 96 + c * 8) = o; }
    }
}
namespace pg8 {
#define PG8_LAS __attribute__((address_space(3)))
typedef unsigned short bf16_t;
typedef short bf16x8 __attribute__((ext_vector_type(8)));
typedef float f32x4 __attribute__((ext_vector_type(4)));
typedef unsigned u32x4 __attribute__((ext_vector_type(4)));
constexpr int BM = 256, BK = 64, HALF = 128, HTB = HALF * BK * 2  , STAGE_BYTES = 8 * HTB, NXCD = 8, WGM = 8;

__host__ __device__ __forceinline__ int lds_byte(int r, int c) { const int st = (r >> 4) * 2 + (c >> 5), rr = r & 15, cc = c & 31, ob = rr * 64 + cc * 2; return st * 1024 + (ob ^ (((ob >> 9) & 1) << 5)); }
__host__ __device__ __forceinline__ void stage_rc(int b, int& R, int& C) { const int st = b / 1024, sb = b % 1024, swz = sb ^ (((sb >> 9) & 1) << 5); R = (st >> 1) * 16 + swz / 64; C = (st & 1) * 32 + (swz % 64) / 2; }
__host__ __device__ __forceinline__ int perm32(int rho) { const int n = rho >> 4, i = rho & 15; return 8 * (i >> 2) + 4 * n + (i & 3); }

struct Unit { int pm, pn, gid; };
struct Gemm { const bf16_t* A; const bf16_t* Bt; int M, N, K, lda, ldb; };

struct StaticOrder {
    int nM, nN, nwg, G, c;
    __host__ __device__ void init(int M, int N, int G_, int c_) { nM = M / BM; nN = N / BM; nwg = nM * nN; G = G_; c = c_; }
    __host__ __device__ bool next(int i, Unit& u) const {
        const long L = (long)i * G + c; if (L >= nwg) return false;
        int wgid = (int)L; { const int q = nwg / NXCD, r = nwg % NXCD, xcd = wgid % NXCD, off = wgid / NXCD; wgid = (xcd < r ? xcd * (q + 1) : r * (q + 1) + (xcd - r) * q) + off; }
        const int nig = WGM * nN, gid = wgid / nig, fm = gid * WGM, gsz = (nM - fm) < WGM ? (nM - fm) : WGM;
        u.pm = fm + ((wgid % nig) % gsz); u.pn = (wgid % nig) / gsz; u.gid = 0; return true;
    }
    __device__ __forceinline__ const char* abase(const Gemm& g, const Unit& u) const { return (const char*)g.A + (size_t)u.pm * BM * g.lda * 2; }
    __device__ __forceinline__ const char* bbase(const Gemm& g, const Unit& u) const { return (const char*)g.Bt + (size_t)u.pn * BM * g.ldb * 2; }
    __device__ __forceinline__ void a_ready(const Unit&) const {}
    __device__ __forceinline__ void done(const Unit&) const {}
};
__device__ __forceinline__ unsigned cvt_pk_bf16(float lo, float hi) { unsigned r; asm volatile("v_cvt_pk_bf16_f32 %0, %1, %2" : "=v"(r) : "v"(lo), "v"(hi)); return r; }

template <class Epi, class Sched, bool STAMP = false>
__device__ __forceinline__ void gemm_phase(PG8_LAS unsigned char* lds, const Gemm g, const Sched& S, const Epi& E, unsigned long long* stamps) {
    const int tid = tid_(), wid = __builtin_amdgcn_readfirstlane(tid >> 6), lane = tid & 63, wr = wid >> 2, wc = wid & 3, fr = lane & 15, fq = lane >> 4;
    const int K = g.K, nt = K / BK;
    int ts_lo = 0, ts_hi = 0, nts = 0; const unsigned long long rt_entry = STAMP ? (unsigned long long)wall_clock64() : 0ull;
#define PG8_STAMP() do { if (STAMP && wid == 0 && nts < 64) { const unsigned long long _c = (unsigned long long)clock64(); \
        ts_lo = (lane == nts) ? (int)(unsigned)_c : ts_lo; ts_hi = (lane == nts) ? (int)(unsigned)(_c >> 32) : ts_hi; ++nts; } } while (0)
    PG8_STAMP();
    unsigned voffA[2], voffB[2];
#pragma unroll
    for (int i = 0; i < 2; ++i) { int R, C; stage_rc(tid * 16 + i * 8192, R, C); const int Rb = Epi::PERM ? ((R & ~31) + perm32(R & 31)) : R;
        voffA[i] = (unsigned)(R * g.lda + C) * 2u; voffB[i] = (unsigned)(Rb * g.ldb + C) * 2u; }
    const size_t kstep = (size_t)(BK * 2);
    const size_t hstepA = (size_t)HALF * g.lda * 2, hstepB = (size_t)HALF * g.ldb * 2;
    const unsigned ldsw = (unsigned)wid * 1024u;
    const int aoff = lds_byte(wr * 64 + fr, fq * 8), boff = lds_byte(wc * 32 + fr, fq * 8);
#define PG8_SA(b, h) (((b) * 2 + (h)) * HTB)
#define PG8_SB(b, h) ((4 + (b) * 2 + (h)) * HTB)
#define PG8_STAGE(bufoff, gbase, voff) do { _Pragma("unroll") for (int _i = 0; _i < 2; ++_i) \
        __builtin_amdgcn_global_load_lds((const unsigned*)((const char*)(gbase) + (voff)[_i]), (PG8_LAS unsigned*)(lds + (bufoff) + ldsw + _i * 8192), 16, 0, 0); } while (0)
#define PG8_LDA(dst, b, h) do { _Pragma("unroll") for (int m = 0; m < 4; ++m) _Pragma("unroll") for (int k = 0; k < 2; ++k) dst[m][k] = *(const PG8_LAS bf16x8*)(lds + PG8_SA(b, h) + aoff + m * 2048 + k * 1024); } while (0)
#define PG8_LDB(dst, b, h) do { _Pragma("unroll") for (int n = 0; n < 2; ++n) _Pragma("unroll") for (int k = 0; k < 2; ++k) dst[n][k] = *(const PG8_LAS bf16x8*)(lds + PG8_SB(b, h) + boff + n * 2048 + k * 1024); } while (0)
#define PG8_MMA(ai, bj, At, Bt) do { __builtin_amdgcn_s_setprio(1); _Pragma("unroll") for (int m = 0; m < 4; ++m) _Pragma("unroll") for (int n = 0; n < 2; ++n) _Pragma("unroll") for (int k = 0; k < 2; ++k) \
        acc[ai][bj][m][n] = __builtin_amdgcn_mfma_f32_16x16x32_bf16(Bt[n][k], At[m][k], acc[ai][bj][m][n], 0, 0, 0); __builtin_amdgcn_s_setprio(0); } while (0)
#define PG8_WAIT_V(n) asm volatile("s_waitcnt vmcnt(" #n ")" ::: "memory")
#define PG8_WAIT_L(n) asm volatile("s_waitcnt lgkmcnt(" #n ")" ::: "memory")
#define PG8_BAR __builtin_amdgcn_s_barrier()
#define PG8_SCHED __builtin_amdgcn_sched_barrier(0)
    Unit cur, nxt; int ui = 0;
    if (!S.next(0, cur)) return;
    f32x4 acc[2][2][4][2];
#pragma unroll
    for (int a = 0; a < 2; ++a)
#pragma unroll
        for (int b = 0; b < 2; ++b)
#pragma unroll
            for (int m = 0; m < 4; ++m)
#pragma unroll
                for (int n = 0; n < 2; ++n) acc[a][b][m][n] = (f32x4){0.f, 0.f, 0.f, 0.f};
    bf16x8 At[4][2], B0[2][2], B1[2][2];
    const char* cA = S.abase(g, cur); const char* cB = S.bbase(g, cur);
    S.a_ready(cur);
    PG8_STAGE(PG8_SB(0, 0), cB, voffB); PG8_STAGE(PG8_SA(0, 0), cA, voffA); PG8_STAGE(PG8_SB(0, 1), cB + hstepB, voffB); PG8_STAGE(PG8_SA(0, 1), cA + hstepA, voffA);
    if (wr == 1) PG8_BAR;
    PG8_WAIT_V(4); PG8_BAR;
    PG8_STAGE(PG8_SB(1, 0), cB + kstep, voffB); PG8_STAGE(PG8_SA(1, 0), cA + kstep, voffA); PG8_STAGE(PG8_SB(1, 1), cB + hstepB + kstep, voffB);
    PG8_WAIT_V(6); PG8_BAR;
    PG8_STAMP();
    for (;;) {
        const bool has_next = S.next(ui + 1, nxt);
        const char* nA = has_next ? S.abase(g, nxt) : cA; const char* nB = has_next ? S.bbase(g, nxt) : cB;
        for (int t = 0; t < nt; t += 2) {
            const bool last = (t == nt - 2);
            const char* a1 = cA + (size_t)(t + 1) * kstep;
            const char* a2 = last ? nA : cA + (size_t)(t + 2) * kstep; const char* b2 = last ? nB : cB + (size_t)(t + 2) * kstep;
            const char* a3 = a2 + kstep; const char* b3 = b2 + kstep;
            if (last && has_next) S.a_ready(nxt);
            PG8_LDB(B0, 0, 0); PG8_SCHED; PG8_LDA(At, 0, 0); PG8_STAGE(PG8_SA(1, 1), a1 + hstepA, voffA);
            PG8_WAIT_L(8); PG8_BAR; PG8_WAIT_L(0); PG8_MMA(0, 0, At, B0); PG8_BAR; PG8_SCHED;
            PG8_LDB(B1, 0, 1); PG8_STAGE(PG8_SB(0, 0), b2, voffB);
            PG8_BAR; PG8_WAIT_L(0); PG8_MMA(0, 1, At, B1); PG8_BAR;
            PG8_LDA(At, 0, 1); PG8_STAGE(PG8_SA(0, 0), a2, voffA);
            PG8_BAR; PG8_WAIT_L(0); PG8_MMA(1, 0, At, B0); PG8_BAR; PG8_SCHED;
            PG8_STAGE(PG8_SB(0, 1), b2 + hstepB, voffB);
            PG8_WAIT_V(6); PG8_BAR; PG8_MMA(1, 1, At, B1); PG8_BAR;
            PG8_LDB(B0, 1, 0); PG8_SCHED; PG8_LDA(At, 1, 0); PG8_STAGE(PG8_SA(0, 1), a2 + hstepA, voffA);
            PG8_WAIT_L(8); PG8_BAR; PG8_WAIT_L(0); PG8_MMA(0, 0, At, B0); PG8_BAR; PG8_SCHED;
            PG8_LDB(B1, 1, 1); PG8_STAGE(PG8_SB(1, 0), b3, voffB);
            PG8_BAR; PG8_WAIT_L(0); PG8_MMA(0, 1, At, B1); PG8_BAR;
            PG8_LDA(At, 1, 1); PG8_STAGE(PG8_SA(1, 0), a3, voffA);
            PG8_BAR; PG8_WAIT_L(0); PG8_MMA(1, 0, At, B0); PG8_BAR; PG8_SCHED;
            PG8_STAGE(PG8_SB(1, 1), b3 + hstepB, voffB);
            PG8_WAIT_V(6); PG8_BAR; PG8_MMA(1, 1, At, B1); PG8_BAR;
        }
        PG8_STAMP();
        if constexpr (!Epi::AFTER_DRAIN) { E(acc, cur, wr, wc, fr, fq); S.done(cur); }
        PG8_STAMP();
        if (!has_next) break;
#pragma unroll
        for (int a = 0; a < 2; ++a)
#pragma unroll
            for (int b = 0; b < 2; ++b)
#pragma unroll
                for (int m = 0; m < 4; ++m)
#pragma unroll
                    for (int n = 0; n < 2; ++n) acc[a][b][m][n] = (f32x4){0.f, 0.f, 0.f, 0.f};
        cur = nxt; cA = nA; cB = nB; ++ui;
    }
    PG8_WAIT_V(0);
    if (wr == 0) PG8_BAR;
    PG8_BAR;
    if constexpr (Epi::AFTER_DRAIN) { E.fused(acc, cur, wr, wc, fr, fq, lds, wid, lane); S.done(cur); }
    PG8_STAMP();
    if (STAMP && wid == 0) { stamps[lane] = lane < nts ? (((unsigned long long)(unsigned)ts_hi << 32) | (unsigned)ts_lo) : 0ull;
        if (lane == 62) stamps[62] = rt_entry; if (lane == 63) stamps[63] = (unsigned long long)wall_clock64(); }
#undef PG8_STAMP
#undef PG8_SA
#undef PG8_SB
#undef PG8_STAGE
#undef PG8_LDA
#undef PG8_LDB
#undef PG8_MMA
#undef PG8_WAIT_V
#undef PG8_WAIT_L
#undef PG8_BAR
#undef PG8_SCHED
}
}
namespace pg8 {
struct EpiIn {
    static constexpr bool PERM = true, AFTER_DRAIN = false;
    bf16_t* G1; bf16_t* G2;
    __device__ __forceinline__ void operator()(const f32x4 (&acc)[2][2][4][2], const Unit& u, int wr, int wc, int fr, int fq) const {
        const int row0 = u.pm * BM + wr * 64 + fr;
        bf16_t* base; int ldc, colt;
        if (u.pn < 9) { base = G1; ldc = 2304; colt = u.pn * 256; } else { base = G2; ldc = 512; colt = (u.pn - 9) * 256; }
        const int col0 = colt + wc * 32 + 8 * fq;
#pragma unroll
        for (int ai = 0; ai < 2; ++ai)
#pragma unroll
            for (int m = 0; m < 4; ++m) { bf16_t* rowp = base + (size_t)(row0 + ai * HALF + m * 16) * ldc + col0;
#pragma unroll
                for (int bj = 0; bj < 2; ++bj) { const f32x4 v0 = acc[ai][bj][m][0], v1 = acc[ai][bj][m][1];
                    u32x4 w; w.x = cvt_pk_bf16(v0[0], v0[1]); w.y = cvt_pk_bf16(v0[2], v0[3]); w.z = cvt_pk_bf16(v1[0], v1[1]); w.w = cvt_pk_bf16(v1[2], v1[3]);
                    *(u32x4*)(rowp + bj * HALF) = w; } }
    }
};
struct EpiOut {
    static constexpr bool PERM = true, AFTER_DRAIN = false;
    const float* xp; const float* xs; float* out; const float* mod; int layer;
    const float* stats; const float* lng; const float* lnb;
    __device__ __forceinline__ void operator()(const f32x4 (&acc)[2][2][4][2], const Unit& u, int wr, int wc, int fr, int fq) const {
        const int row0 = u.pm * BM + wr * 64 + fr, col0 = u.pn * BM + wc * 32 + 8 * fq;
        const int rt = u.pm * BM; const int modrow = rt < 8192 ? 0 : 1 + ((rt - 8192) >> 11);
        const float* gp = mod + (size_t)modrow * 3072 + 2048 + col0;
        f32x4 gv[2][2];
#pragma unroll
        for (int bj = 0; bj < 2; ++bj)
#pragma unroll
            for (int n = 0; n < 2; ++n) gv[bj][n] = *(const f32x4*)(gp + bj * HALF + n * 4);
        f32x4 lg[2][2], lb[2][2];
        if (layer) {
#pragma unroll
            for (int bj = 0; bj < 2; ++bj)
#pragma unroll
                for (int n = 0; n < 2; ++n) { lg[bj][n] = *(const f32x4*)(lng + col0 + bj * HALF + n * 4); lb[bj][n] = *(const f32x4*)(lnb + col0 + bj * HALF + n * 4); }
        }
        f32x4 xn[2][2]; float mean_n = 0.f, rstd_n = 1.f;
#define EO_LOAD(am_) do { const int row_ = row0 + ((am_) >> 2) * HALF + ((am_) & 3) * 16; \
            if (layer == 0) { const float* xr_ = (row_ < 8192 ? xp + (size_t)row_ * 1024 : xs + (size_t)(row_ - 8192) * 1024) + col0; \
                xn[0][0] = *(const f32x4*)(xr_); xn[0][1] = *(const f32x4*)(xr_ + 4); xn[1][0] = *(const f32x4*)(xr_ + HALF); xn[1][1] = *(const f32x4*)(xr_ + HALF + 4); } \
            else { const bf16_t* zr_ = (const bf16_t*)out + (size_t)row_ * 2048 + col0; const u32x4 z0_ = *(const u32x4*)zr_, z1_ = *(const u32x4*)(zr_ + HALF); \
                xn[0][0] = (f32x4){__uint_as_float(z0_.x << 16), __uint_as_float(z0_.x & 0xffff0000u), __uint_as_float(z0_.y << 16), __uint_as_float(z0_.y & 0xffff0000u)}; \
                xn[0][1] = (f32x4){__uint_as_float(z0_.z << 16), __uint_as_float(z0_.z & 0xffff0000u), __uint_as_float(z0_.w << 16), __uint_as_float(z0_.w & 0xffff0000u)}; \
                xn[1][0] = (f32x4){__uint_as_float(z1_.x << 16), __uint_as_float(z1_.x & 0xffff0000u), __uint_as_float(z1_.y << 16), __uint_as_float(z1_.y & 0xffff0000u)}; \
                xn[1][1] = (f32x4){__uint_as_float(z1_.z << 16), __uint_as_float(z1_.z & 0xffff0000u), __uint_as_float(z1_.w << 16), __uint_as_float(z1_.w & 0xffff0000u)}; \
                mean_n = stats[(size_t)row_ * 2]; rstd_n = stats[(size_t)row_ * 2 + 1]; } } while (0)
        EO_LOAD(0);
#pragma unroll
        for (int am = 0; am < 8; ++am) { const int ai = am >> 2, m = am & 3, row = row0 + ai * HALF + m * 16;
            const f32x4 xc[2][2] = {{xn[0][0], xn[0][1]}, {xn[1][0], xn[1][1]}}; const float mean = mean_n, rstd = rstd_n;
            if (am + 1 < 8) EO_LOAD(am + 1);
            bf16_t* orow = (bf16_t*)out + (size_t)row * 2048 + col0;
#pragma unroll
            for (int bj = 0; bj < 2; ++bj) { f32x4 z[2];
#pragma unroll
                for (int n = 0; n < 2; ++n) { f32x4 x = xc[bj][n];
                    if (layer) x = (x - mean) * rstd * lg[bj][n] + lb[bj][n];
                    z[n] = x * 1.4142135623730951f + gv[bj][n] * acc[ai][bj][m][n]; }
                u32x4 w; w.x = cvt_pk_bf16(z[0][0], z[0][1]); w.y = cvt_pk_bf16(z[0][2], z[0][3]); w.z = cvt_pk_bf16(z[1][0], z[1][1]); w.w = cvt_pk_bf16(z[1][2], z[1][3]);
                *(u32x4*)(orow + bj * HALF) = w; } }
#undef EO_LOAD
    }
};
}

__device__ __forceinline__ void phase_a1_pg8(ArgsP a, LAS unsigned char* lds, int layer) {
    pg8::Gemm g{(const bf16*)(a->ws + WS_U), (const bf16*)(a->ws + WS_WIN) + (size_t)layer * NIN * 1024, T, NIN, 1024, 1024, 1024};
    pg8::StaticOrder S; S.init(T, NIN, grid_(), bid_());
    pg8::EpiIn E{(bf16*)(a->ws + WS_G1), (bf16*)(a->ws + WS_G2)};
    pg8::gemm_phase<pg8::EpiIn, pg8::StaticOrder, false>(lds, g, S, E, nullptr);
}
__device__ __forceinline__ void phase_c2_pg8(ArgsP a, LAS unsigned char* lds, int layer) {
    pg8::Gemm g{(const bf16*)(a->ws + WS_YMIX), (const bf16*)(a->ws + WS_WOUT) + (size_t)layer * 1024 * 1024, T, 1024, 1024, 1024, 1024};
    pg8::StaticOrder S; S.init(T, 1024, grid_(), bid_());
    pg8::EpiOut E{a->in[I_XP], a->in[I_XS], a->out, (const float*)(a->ws + WS_MOD) + (size_t)layer * 9 * 3072, layer, (const float*)(a->ws + WS_STATS), a->in[I_LNG], a->in[I_LNB]};
    pg8::gemm_phase<pg8::EpiOut, pg8::StaticOrder, false>(lds, g, S, E, nullptr);
}

__device__ __forceinline__ void phase_a2a(ArgsP a, int layer) {
    const int tid = tid_(), lane = tid & 63, wave = tid >> 6, G = grid_();
    bf16* G2 = (bf16*)(a->ws + WS_G2); bf16* KR = (bf16*)(a->ws + WS_KR); bf16* CK = (bf16*)(a->ws + WS_HF);
    const float* ROPE = (const float*)(a->ws + WS_ROPE);
    f32x4 nw0 = {0.f, 0.f, 0.f, 0.f}, nw1 = {0.f, 0.f, 0.f, 0.f};
    if (lane < 32) { nw0 = *(const f32x4*)(a->in[I_QNORM] + layer * 256 + lane * 8); nw1 = *(const f32x4*)(a->in[I_QNORM] + layer * 256 + lane * 8 + 4); }
    else if (lane < 48) { nw0 = *(const f32x4*)(a->in[I_KVNORM] + layer * 128 + (lane - 32) * 8); nw1 = *(const f32x4*)(a->in[I_KVNORM] + layer * 128 + (lane - 32) * 8 + 4); }
    v4u nx = {0u, 0u, 0u, 0u};
    { const int n0 = bid_() * 8 + wave; if (n0 < T) nx = *(const v4u*)(G2 + (size_t)n0 * G2W + lane * 8); }
    for (int n = bid_() * 8 + wave; n < T; n += G * 8) {
        const v4u w = nx;
        if (n + G * 8 < T) nx = *(const v4u*)(G2 + (size_t)(n + G * 8) * G2W + lane * 8);
        const Tok tk = tok_of(n);
        float x[8] = {bflo(w.x), bfhi(w.x), bflo(w.y), bfhi(w.y), bflo(w.z), bfhi(w.z), bflo(w.w), bfhi(w.w)};
        const float ss = (x[0] * x[0] + x[1] * x[1]) + (x[2] * x[2] + x[3] * x[3]) + (x[4] * x[4] + x[5] * x[5]) + (x[6] * x[6] + x[7] * x[7]);
        const float sq = wave_sum(lane < 32 ? ss : 0.f), sk = wave_sum((lane >= 32 && lane < 48) ? ss : 0.f);
        const float rs = lane < 32 ? rsqrt_(sq * (1.f / 256.f) + 1e-6f) : rsqrt_(sk * (1.f / 128.f) + 1e-6f);
        if (lane < 48) {
            const float y0 = x[0] * rs * nw0.x, y1 = x[1] * rs * nw0.y, y2 = x[2] * rs * nw0.z, y3 = x[3] * rs * nw0.w, y4 = x[4] * rs * nw1.x, y5 = x[5] * rs * nw1.y, y6 = x[6] * rs * nw1.z, y7 = x[7] * rs * nw1.w;
            *(v4u*)(G2 + (size_t)n * G2W + lane * 8) = (v4u){cvtpk(y0, y1), cvtpk(y2, y3), cvtpk(y4, y5), cvtpk(y6, y7)};
            if (lane >= 32 && !tk.lat) { float* op = a->out + O_CKV + ((size_t)(tk.b * 2 + layer) * 256 + tk.t) * 128 + (lane - 32) * 8;
                *(f32x4*)op = (f32x4){y0, y1, y2, y3}; *(f32x4*)(op + 4) = (f32x4){y4, y5, y6, y7}; }
        } else if (lane < 52) {
            const int d0 = (lane - 48) * 8;
            if (!tk.lat) { float* op = a->out + O_KR + ((size_t)(tk.b * 2 + layer) * 256 + tk.t) * 32 + d0;
                *(f32x4*)op = (f32x4){x[0], x[1], x[2], x[3]}; *(f32x4*)(op + 4) = (f32x4){x[4], x[5], x[6], x[7]};
                *(v4u*)(KR + (size_t)tk.kidx * 32 + d0) = w; }
            else { const f32x4 c0 = *(const f32x4*)(ROPE + ((size_t)tk.t * 16 + (d0 >> 1)) * 2), c1 = *(const f32x4*)(ROPE + ((size_t)tk.t * 16 + (d0 >> 1) + 2) * 2);
                const float y0 = x[0] * c0.x - x[1] * c0.y, y1 = x[0] * c0.y + x[1] * c0.x, y2 = x[2] * c0.z - x[3] * c0.w, y3 = x[2] * c0.w + x[3] * c0.z;
                const float y4 = x[4] * c1.x - x[5] * c1.y, y5 = x[4] * c1.y + x[5] * c1.x, y6 = x[6] * c1.z - x[7] * c1.w, y7 = x[6] * c1.w + x[7] * c1.z;
                *(v4u*)(KR + (size_t)tk.kidx * 32 + d0) = (v4u){cvtpk(y0, y1), cvtpk(y2, y3), cvtpk(y4, y5), cvtpk(y6, y7)}; }
        }
    }
    for (int r = bid_() * 8 + wave; r < 2048; r += G * 8) {
        const int b = r >> 8, j = r & 255; const size_t src = (size_t)(b * 2 + layer) * 256 + j;
        if (lane < 16) { const f32x4 v0 = *(const f32x4*)(a->in[I_CCKV] + src * 128 + lane * 8), v1 = *(const f32x4*)(a->in[I_CCKV] + src * 128 + lane * 8 + 4);
            *(v4u*)(CK + (size_t)r * 512 + lane * 8) = (v4u){cvtpk(v0.x, v0.y), cvtpk(v0.z, v0.w), cvtpk(v1.x, v1.y), cvtpk(v1.z, v1.w)}; }
        else if (lane < 32) *(v4u*)(CK + (size_t)r * 512 + lane * 8) = (v4u){0u, 0u, 0u, 0u};
        else if (lane < 36) { const f32x4 v0 = *(const f32x4*)(a->in[I_CKR] + src * 32 + (lane - 32) * 8), v1 = *(const f32x4*)(a->in[I_CKR] + src * 32 + (lane - 32) * 8 + 4);
            *(v4u*)(KR + (size_t)(T_CTX + b * LK_LAT + j) * 32 + (lane - 32) * 8) = (v4u){cvtpk(v0.x, v0.y), cvtpk(v0.z, v0.w), cvtpk(v1.x, v1.y), cvtpk(v1.z, v1.w)}; }
    }
}
namespace pg8 {
struct A2Order {
    const char* ws; unsigned oq, okv; int G, c;
    __device__ __forceinline__ bool next(int i, Unit& u) const {
        const int L = i * G + c; if (L >= 704) return false;
        if (L < 288) { u.gid = 0; u.pm = L / 3; u.pn = L % 3; } else if (L < 672) { u.gid = 1; u.pm = (L - 288) >> 2; u.pn = (L - 288) & 3; } else { u.gid = 2; u.pm = (L - 672) >> 2; u.pn = (L - 672) & 3; }
        return true;
    }
    __device__ __forceinline__ const char* abase(const Gemm&, const Unit& u) const { const unsigned off = u.gid == 0 ? (unsigned)WS_G2 : (u.gid == 1 ? (unsigned)WS_G2 + 512u : (unsigned)WS_HF); return ws + off + (size_t)u.pm * 256 * 512 * 2; }
    __device__ __forceinline__ const char* bbase(const Gemm&, const Unit& u) const { const unsigned off = u.gid == 0 ? oq : okv; return ws + off + (size_t)u.pn * 256 * 256 * 2; }
    __device__ __forceinline__ void a_ready(const Unit&) const {}
    __device__ __forceinline__ void done(const Unit&) const {}
};
struct EpiA2 {
    static constexpr bool PERM = true, AFTER_DRAIN = false;
    bf16_t* Q; bf16_t* KN; bf16_t* VR; const float* rope;
    __device__ __forceinline__ void operator()(const f32x4 (&acc)[2][2][4][2], const Unit& u, int wr, int wc, int fr, int fq) const {
        const int row0 = u.pm * BM + wr * 64 + fr;
        if (u.gid == 0) {
            const int fb = u.pn * 256 + wc * 32 + 8 * fq;
#pragma unroll
            for (int ai = 0; ai < 2; ++ai)
#pragma unroll
                for (int m = 0; m < 4; ++m) { const int row = row0 + ai * HALF + m * 16;
                    const float* rp = rope + (unsigned)(((row - 8192) & 2047) * 32);
#pragma unroll
                    for (int bj = 0; bj < 2; ++bj) {
                        f32x4 v0 = acc[ai][bj][m][0], v1 = acc[ai][bj][m][1];
                        const int f0 = fb + bj * HALF, d = f0 % 96;
                        if (row >= 8192 && d >= 64) { const f32x4 c0 = *(const f32x4*)(rp + (d - 64)), c1 = *(const f32x4*)(rp + (d - 64) + 4);
                            const f32x4 a0 = v0, a1 = v1;
                            v0[0] = a0[0] * c0[0] - a0[1] * c0[1]; v0[1] = a0[0] * c0[1] + a0[1] * c0[0]; v0[2] = a0[2] * c0[2] - a0[3] * c0[3]; v0[3] = a0[2] * c0[3] + a0[3] * c0[2];
                            v1[0] = a1[0] * c1[0] - a1[1] * c1[1]; v1[1] = a1[0] * c1[1] + a1[1] * c1[0]; v1[2] = a1[2] * c1[2] - a1[3] * c1[3]; v1[3] = a1[2] * c1[3] + a1[3] * c1[2]; }
                        u32x4 w; w.x = cvt_pk_bf16(v0[0], v0[1]); w.y = cvt_pk_bf16(v0[2], v0[3]); w.z = cvt_pk_bf16(v1[0], v1[1]); w.w = cvt_pk_bf16(v1[2], v1[3]);
                        *(u32x4*)(Q + (unsigned)(row * 768 + f0)) = w; } }
        } else {
            const int x = wc * 32 + 8 * fq;
            bf16_t* base = (wc < 2 ? KN : VR);
            const unsigned xo = (unsigned)(x & 63);
#pragma unroll
            for (int ai = 0; ai < 2; ++ai)
#pragma unroll
                for (int m = 0; m < 4; ++m) { const int row = row0 + ai * HALF + m * 16;
                    int kidx;
                    if (u.gid == 2) kidx = 8192 + (row >> 8) * 2304 + (row & 255);
                    else if (row < 8192) kidx = row;
                    else { const int mrow = row - 8192; kidx = 8192 + (mrow >> 11) * 2304 + 256 + (mrow & 2047); }
#pragma unroll
                    for (int bj = 0; bj < 2; ++bj) { const f32x4 v0 = acc[ai][bj][m][0], v1 = acc[ai][bj][m][1];
                        u32x4 w; w.x = cvt_pk_bf16(v0[0], v0[1]); w.y = cvt_pk_bf16(v0[2], v0[3]); w.z = cvt_pk_bf16(v1[0], v1[1]); w.w = cvt_pk_bf16(v1[2], v1[3]);
                        *(u32x4*)(base + (unsigned)(kidx * 512 + (u.pn * 2 + bj) * 64) + xo) = w; } }
        }
    }
};
}
__device__ __forceinline__ void phase_a2b(ArgsP a, LAS unsigned char* lds, int layer) {
    int kk = 256; asm volatile("" : "+s"(kk));
    pg8::Gemm g{nullptr, nullptr, T, 1024, kk, 512, 256};
    pg8::A2Order S{(const char*)a->ws, (unsigned)(WS_WUQ + (size_t)layer * 768 * 256 * 2), (unsigned)(WS_WUKV + (size_t)layer * 1024 * 256 * 2), grid_(), bid_()};
    pg8::EpiA2 E{(bf16*)(a->ws + WS_Q), (bf16*)(a->ws + WS_KN), (bf16*)(a->ws + WS_VT), (const float*)(a->ws + WS_ROPE)};
    pg8::gemm_phase<pg8::EpiA2, pg8::A2Order, false>(lds, g, S, E, nullptr);
}
__device__ __forceinline__ void rwkv_unit_seq(ArgsP a, LAS unsigned char* lds, int layer, int u) {
    const int tid = tid_();
    LAS float* W2s = (LAS float*)lds;
    LAS float* A2s = W2s + 4096;
    LAS float* TH = A2s + 4096;
    LAS float* HA = TH + 2048;
    LAS float* Wd = HA + 2048;
    LAS float* KT = Wd + 2048; LAS float* KK = KT + 2048; LAS float* BB = KK + 2048; LAS float* RR = BB + 2048; LAS float* VV = RR + 2048; LAS float* YO = VV + 2048;
    const int lat = u < 64, uu = lat ? u : u - 64, b = uu >> 3, e = (uu >> 2) & 1, hh = uu & 3;
    const int L = lat ? L_LAT : L_CTX, tok0 = lat ? T_CTX + b * L_LAT : b * L_CTX;
    const bf16* G1 = (const bf16*)(a->ws + WS_G1);
    bf16* YS = (bf16*)(a->ws + WS_G2);
    for (int i = tid; i < 4096; i += NTHREADS) { const int j = i >> 6, c = i & 63;
        W2s[i] = a->in[I_W2][((size_t)(layer * 2 + e) * 64 + j) * 256 + hh * 64 + c];
        A2s[i] = a->in[I_A2][((size_t)(layer * 2 + e) * 64 + j) * 256 + hh * 64 + c]; }
    const int r = tid >> 3, ks = tid & 7;
    float S[8];
#pragma unroll
    for (int j = 0; j < 8; ++j) S[j] = lat ? a->in[I_SRW][(((size_t)((b * 2 + layer) * 2 + e) * 4 + hh) * 64 + r) * 64 + ks * 8 + j] : 0.f;
    const int tt = tid >> 4, q4 = (tid & 15) * 4;
    float w0v[4], a0v[4], kkw[4], kav[4];
#pragma unroll
    for (int i = 0; i < 4; ++i) { const int ch = hh * 64 + q4 + i;
        w0v[i] = a->in[I_W0][(layer * 2 + e) * 256 + ch]; a0v[i] = a->in[I_A0][(layer * 2 + e) * 256 + ch]; kkw[i] = a->in[I_KK][layer * 256 + ch]; kav[i] = a->in[I_KA][layer * 256 + ch]; }
    __syncthreads();
    for (int c = 0; c < L / 32; ++c) {
        const int step = c * 32 + tt, t = e ? L - 1 - step : step, n = tok0 + t;
        const bf16* g = G1 + (size_t)n * G1W;
        { const v2u hw = *(const v2u*)(g + C_LORA + e * 64 + q4), ha = *(const v2u*)(g + C_LORA + 128 + e * 64 + q4);
          TH[tt * 64 + q4 + 0] = tanhf(bflo(hw.x)); TH[tt * 64 + q4 + 1] = tanhf(bfhi(hw.x)); TH[tt * 64 + q4 + 2] = tanhf(bflo(hw.y)); TH[tt * 64 + q4 + 3] = tanhf(bfhi(hw.y));
          HA[tt * 64 + q4 + 0] = bflo(ha.x); HA[tt * 64 + q4 + 1] = bfhi(ha.x); HA[tt * 64 + q4 + 2] = bflo(ha.y); HA[tt * 64 + q4 + 3] = bfhi(ha.y); }
        __syncthreads();
        {
            float wl[4], al[4];
#pragma unroll
            for (int i = 0; i < 4; ++i) { wl[i] = w0v[i]; al[i] = a0v[i]; }
            for (int j = 0; j < 64; ++j) { const float th = TH[tt * 64 + j], hv = HA[tt * 64 + j];
                const f32x4 w2 = *(const LAS f32x4*)(W2s + j * 64 + q4), a2 = *(const LAS f32x4*)(A2s + j * 64 + q4);
                wl[0] = fmaf(th, w2.x, wl[0]); wl[1] = fmaf(th, w2.y, wl[1]); wl[2] = fmaf(th, w2.z, wl[2]); wl[3] = fmaf(th, w2.w, wl[3]);
                al[0] = fmaf(hv, a2.x, al[0]); al[1] = fmaf(hv, a2.y, al[1]); al[2] = fmaf(hv, a2.z, al[2]); al[3] = fmaf(hv, a2.w, al[3]); }
            const v2u kv = *(const v2u*)(g + C_K + hh * 64 + q4), rv = *(const v2u*)(g + C_R + hh * 64 + q4), vv = *(const v2u*)(g + C_V + hh * 64 + q4);
            const float kx[4] = {bflo(kv.x), bfhi(kv.x), bflo(kv.y), bfhi(kv.y)}, rx[4] = {bflo(rv.x), bfhi(rv.x), bflo(rv.y), bfhi(rv.y)}, vx[4] = {bflo(vv.x), bfhi(vv.x), bflo(vv.y), bfhi(vv.y)};
            float kkr[4], ss = 0.f;
#pragma unroll
            for (int i = 0; i < 4; ++i) { kkr[i] = kx[i] * kkw[i]; ss += kkr[i] * kkr[i]; }
            ss += __shfl_xor(ss, 1); ss += __shfl_xor(ss, 2); ss += __shfl_xor(ss, 4); ss += __shfl_xor(ss, 8);
            const float inrm = rcp_(fmaxf(sqrt_(ss), 1e-12f));
#pragma unroll
            for (int i = 0; i < 4; ++i) {
                const float dec = exp_(-0.6065306597126334f * sigmoidf_(wl[i])), av = sigmoidf_(al[i]), kk = kkr[i] * inrm;
                const int o = tt * 64 + q4 + i;
                Wd[o] = dec; KT[o] = kx[i] * (1.f + (av - 1.f) * kav[i]); KK[o] = kk; BB[o] = kk * av; RR[o] = rx[i]; VV[o] = vx[i]; }
        }
        __syncthreads();
        for (int s = 0; s < 32; ++s) {
            const int o = s * 64 + ks * 8;
            const f32x4 k0 = *(const LAS f32x4*)(KK + o), k1 = *(const LAS f32x4*)(KK + o + 4);
            float p = S[0] * k0.x + S[1] * k0.y + S[2] * k0.z + S[3] * k0.w + S[4] * k1.x + S[5] * k1.y + S[6] * k1.z + S[7] * k1.w;
            p += __shfl_xor(p, 1); p += __shfl_xor(p, 2); p += __shfl_xor(p, 4);
            const float sa = -p, vv = VV[s * 64 + r];
            const f32x4 w0 = *(const LAS f32x4*)(Wd + o), w1 = *(const LAS f32x4*)(Wd + o + 4), b0 = *(const LAS f32x4*)(BB + o), b1 = *(const LAS f32x4*)(BB + o + 4);
            const f32x4 t0 = *(const LAS f32x4*)(KT + o), t1 = *(const LAS f32x4*)(KT + o + 4), r0 = *(const LAS f32x4*)(RR + o), r1 = *(const LAS f32x4*)(RR + o + 4);
            S[0] = S[0] * w0.x + sa * b0.x + vv * t0.x; S[1] = S[1] * w0.y + sa * b0.y + vv * t0.y; S[2] = S[2] * w0.z + sa * b0.z + vv * t0.z; S[3] = S[3] * w0.w + sa * b0.w + vv * t0.w;
            S[4] = S[4] * w1.x + sa * b1.x + vv * t1.x; S[5] = S[5] * w1.y + sa * b1.y + vv * t1.y; S[6] = S[6] * w1.z + sa * b1.z + vv * t1.z; S[7] = S[7] * w1.w + sa * b1.w + vv * t1.w;
            float y = S[0] * r0.x + S[1] * r0.y + S[2] * r0.z + S[3] * r0.w + S[4] * r1.x + S[5] * r1.y + S[6] * r1.z + S[7] * r1.w;
            y += __shfl_xor(y, 1); y += __shfl_xor(y, 2); y += __shfl_xor(y, 4);
            if (ks == 0) YO[s * 64 + r] = y;
        }
        __syncthreads();
        { v2u o; o.x = pk2(YO[tt * 64 + q4], YO[tt * 64 + q4 + 1]); o.y = pk2(YO[tt * 64 + q4 + 2], YO[tt * 64 + q4 + 3]);
          *(v2u*)(YS + ((size_t)e * T + n) * 256 + hh * 64 + q4) = o; }
        __syncthreads();
    }
    if (!lat) {
        float* dst = a->out + O_RW + (((size_t)((b * 2 + layer) * 2 + e) * 4 + hh) * 64 + r) * 64 + ks * 8;
        *(f32x4*)dst = (f32x4){S[0], S[1], S[2], S[3]}; *(f32x4*)(dst + 4) = (f32x4){S[4], S[5], S[6], S[7]};
    }
}

__device__ __forceinline__ void lru_unit_seq(ArgsP a, LAS unsigned char* lds, int layer, int u) {
    const int tid = tid_();
    LAS float* WA = (LAS float*)lds;
    LAS float* WX = WA + 4096;
    LAS float* XC = WX + 4096;
    LAS float* AA = XC + 4096; LAS float* BV = AA + 4096; LAS float* HH = BV + 4096;
    const int lat = u < 32, uu = lat ? u : u - 32, b = uu >> 2, g = uu & 3;
    const int L = lat ? L_LAT : L_CTX, tok0 = lat ? T_CTX + b * L_LAT : b * L_CTX;
    const bf16* G1 = (const bf16*)(a->ws + WS_G1);
    bf16* HF = (bf16*)(a->ws + WS_HF);
    const int tt = tid >> 3, q8 = (tid & 7) * 8;
    float cw[4][8], cb[8];
#pragma unroll
    for (int i = 0; i < 8; ++i) { const int ch = g * 64 + q8 + i; cb[i] = a->in[I_CONVB][layer * 256 + ch];
#pragma unroll
        for (int j = 0; j < 4; ++j) cw[j][i] = a->in[I_CONVW][(layer * 4 + j) * 256 + ch]; }
    for (int e = 0; e < 2; ++e) {
        __syncthreads();
        for (int i = tid; i < 4096; i += NTHREADS) { const size_t src = ((size_t)((layer * 2 + e) * 4 + g)) * 4096 + i; WA[i] = a->in[I_WA][src]; WX[i] = a->in[I_WX][src]; }
        float bav[8], bxv[8], spl[8];
#pragma unroll
        for (int i = 0; i < 8; ++i) { const int ch = (layer * 2 + e) * 256 + g * 64 + q8 + i; bav[i] = a->in[I_BA][ch]; bxv[i] = a->in[I_BX][ch]; spl[i] = log1pf(exp_(-a->in[I_LAMBDA][ch])); }
        float h = 0.f;
        if (tid < 64 && lat) h = a->in[I_SLRU][((size_t)(b * 2 + layer) * 2 + e) * 256 + g * 64 + tid];
        __syncthreads();
        for (int cc = 0; cc < L / 64; ++cc) {
            const int c = e ? L / 64 - 1 - cc : cc, t = c * 64 + tt, n = tok0 + t;
            {
                float xc[8];
#pragma unroll
                for (int i = 0; i < 8; ++i) xc[i] = cb[i];
#pragma unroll
                for (int j = 0; j < 4; ++j) { const int ts = t + j - 2;
                    if (ts >= 0 && ts < L) { const v4u x = *(const v4u*)(G1 + (size_t)(tok0 + ts) * G1W + C_XL + g * 64 + q8);
                        xc[0] += cw[j][0] * bflo(x.x); xc[1] += cw[j][1] * bfhi(x.x); xc[2] += cw[j][2] * bflo(x.y); xc[3] += cw[j][3] * bfhi(x.y);
                        xc[4] += cw[j][4] * bflo(x.z); xc[5] += cw[j][5] * bfhi(x.z); xc[6] += cw[j][6] * bflo(x.w); xc[7] += cw[j][7] * bfhi(x.w); } }
#pragma unroll
                for (int i = 0; i < 8; ++i) XC[tt * 64 + q8 + i] = xc[i];
            }
            __syncthreads();
            {
                float gr[8], gi[8];
#pragma unroll
                for (int i = 0; i < 8; ++i) { gr[i] = bav[i]; gi[i] = bxv[i]; }
                for (int i = 0; i < 64; ++i) { const float x = XC[tt * 64 + i];
                    const f32x4 a0 = *(const LAS f32x4*)(WA + i * 64 + q8), a1 = *(const LAS f32x4*)(WA + i * 64 + q8 + 4), x0 = *(const LAS f32x4*)(WX + i * 64 + q8), x1 = *(const LAS f32x4*)(WX + i * 64 + q8 + 4);
                    gr[0] = fmaf(x, a0.x, gr[0]); gr[1] = fmaf(x, a0.y, gr[1]); gr[2] = fmaf(x, a0.z, gr[2]); gr[3] = fmaf(x, a0.w, gr[3]);
                    gr[4] = fmaf(x, a1.x, gr[4]); gr[5] = fmaf(x, a1.y, gr[5]); gr[6] = fmaf(x, a1.z, gr[6]); gr[7] = fmaf(x, a1.w, gr[7]);
                    gi[0] = fmaf(x, x0.x, gi[0]); gi[1] = fmaf(x, x0.y, gi[1]); gi[2] = fmaf(x, x0.z, gi[2]); gi[3] = fmaf(x, x0.w, gi[3]);
                    gi[4] = fmaf(x, x1.x, gi[4]); gi[5] = fmaf(x, x1.y, gi[5]); gi[6] = fmaf(x, x1.z, gi[6]); gi[7] = fmaf(x, x1.w, gi[7]); }
#pragma unroll
                for (int i = 0; i < 8; ++i) { const float la = -8.f * sigmoidf_(gr[i]) * spl[i];
                    AA[tt * 64 + q8 + i] = exp_(la);
                    BV[tt * 64 + q8 + i] = sqrt_(-expm1f(2.f * la)) * sigmoidf_(gi[i]) * XC[tt * 64 + q8 + i]; }
            }
            __syncthreads();
            if (tid < 64) { for (int s = 0; s < 64; ++s) { const int st = e ? 63 - s : s; h = fmaf(AA[st * 64 + tid], h, BV[st * 64 + tid]); HH[st * 64 + tid] = h; } }
            __syncthreads();
            {
                bf16* dst = HF + (size_t)n * 256 + g * 64 + q8;
                float o[8];
#pragma unroll
                for (int i = 0; i < 8; ++i) o[i] = HH[tt * 64 + q8 + i];
                if (e) { const v4u hf = *(const v4u*)dst, gl = *(const v4u*)(G1 + (size_t)n * G1W + C_GL + g * 64 + q8);
                    o[0] = (o[0] + bflo(hf.x)) * siluf_(bflo(gl.x)); o[1] = (o[1] + bfhi(hf.x)) * siluf_(bfhi(gl.x)); o[2] = (o[2] + bflo(hf.y)) * siluf_(bflo(gl.y)); o[3] = (o[3] + bfhi(hf.y)) * siluf_(bfhi(gl.y));
                    o[4] = (o[4] + bflo(hf.z)) * siluf_(bflo(gl.z)); o[5] = (o[5] + bfhi(hf.z)) * siluf_(bfhi(gl.z)); o[6] = (o[6] + bflo(hf.w)) * siluf_(bflo(gl.w)); o[7] = (o[7] + bfhi(hf.w)) * siluf_(bfhi(gl.w)); }
                v4u ov; ov.x = pk2(o[0], o[1]); ov.y = pk2(o[2], o[3]); ov.z = pk2(o[4], o[5]); ov.w = pk2(o[6], o[7]);
                *(v4u*)dst = ov;
            }
            __syncthreads();
        }
        if (tid < 64 && !lat) a->out[O_LRU + ((size_t)(b * 2 + layer) * 2 + e) * 256 + g * 64 + tid] = h;
    }
}

__device__ __forceinline__ void phase_c1(ArgsP a, int layer) {
    const int tid = tid_(), lane = tid & 63, wave = tid >> 6, G = grid_();
    const bf16* G1 = (const bf16*)(a->ws + WS_G1); const bf16* YS = (const bf16*)(a->ws + WS_G2); const bf16* Q = (const bf16*)(a->ws + WS_Q); const bf16* HF = (const bf16*)(a->ws + WS_HF);
    bf16* Y = (bf16*)(a->ws + WS_YMIX);
    const int ch = lane * 4;
    const f32x4 rk = *(const f32x4*)(a->in[I_RK] + layer * 256 + ch), lg = *(const f32x4*)(a->in[I_LNXG] + layer * 256 + ch), lb = *(const f32x4*)(a->in[I_LNXB] + layer * 256 + ch);
    v2u p_y0, p_y1, p_r, p_k, p_v, p_g, p_h, p_hb, p_gl; v4u p_q;
#define C1_LOAD(nn) do { const bf16* g_ = G1 + (size_t)(nn) * G1W; p_y0 = *(const v2u*)(YS + (size_t)(nn) * 256 + ch); p_y1 = *(const v2u*)(YS + ((size_t)T + (nn)) * 256 + ch); \
        p_r = *(const v2u*)(g_ + C_R + ch); p_k = *(const v2u*)(g_ + C_K + ch); p_v = *(const v2u*)(g_ + C_V + ch); p_g = *(const v2u*)(g_ + C_G + ch); \
        p_q = *(const v4u*)(Q + (size_t)(nn) * 768 + (lane >> 3) * 96 + (lane & 7) * 8); p_h = *(const v2u*)(HF + (size_t)(nn) * 256 + ch); \
        p_hb = *(const v2u*)((const unsigned char*)a->out + (size_t)(nn) * 4096 + 2048 + ch * 2); p_gl = *(const v2u*)(g_ + C_GL + ch); } while (0)
    { const int n0 = bid_() * 8 + wave; if (n0 < T) C1_LOAD(n0); }
    for (int n = bid_() * 8 + wave; n < T; n += G * 8) {
        const v2u y0 = p_y0, y1 = p_y1, rv = p_r, kv = p_k, vv = p_v, gv = p_g, hf = p_h, hb = p_hb, gl = p_gl; const v4u qq = p_q;
        if (n + G * 8 < T) C1_LOAD(n + G * 8);
        float y[4] = {bflo(y0.x) + bflo(y1.x), bfhi(y0.x) + bfhi(y1.x), bflo(y0.y) + bflo(y1.y), bfhi(y0.y) + bfhi(y1.y)};
        float s = (y[0] + y[1]) + (y[2] + y[3]);
        float bon = bflo(rv.x) * bflo(kv.x) * rk.x + bfhi(rv.x) * bfhi(kv.x) * rk.y + bflo(rv.y) * bflo(kv.y) * rk.z + bfhi(rv.y) * bfhi(kv.y) * rk.w;
#pragma unroll
        for (int o = 1; o < 16; o <<= 1) { s += __shfl_xor(s, o); bon += __shfl_xor(bon, o); }
        const float mu = s * (1.f / 64.f);
        float s2 = (y[0] - mu) * (y[0] - mu) + (y[1] - mu) * (y[1] - mu) + (y[2] - mu) * (y[2] - mu) + (y[3] - mu) * (y[3] - mu);
#pragma unroll
        for (int o = 1; o < 16; o <<= 1) s2 += __shfl_xor(s2, o);
        const float rstd = rsqrt_(s2 * (1.f / 64.f) + GN_EPS);
        const float o0 = ((y[0] - mu) * rstd * lg.x + lb.x + bon * bflo(vv.x)) * siluf_(bflo(gv.x));
        const float o1 = ((y[1] - mu) * rstd * lg.y + lb.y + bon * bfhi(vv.x)) * siluf_(bfhi(gv.x));
        const float o2 = ((y[2] - mu) * rstd * lg.z + lb.z + bon * bflo(vv.y)) * siluf_(bflo(gv.y));
        const float o3 = ((y[3] - mu) * rstd * lg.w + lb.w + bon * bfhi(vv.y)) * siluf_(bfhi(gv.y));
        v2u ov; ov.x = pk2(o0, o1); ov.y = pk2(o2, o3);
        bf16* yr = Y + (size_t)n * 1024;
        *(v2u*)(yr + ch) = ov;
        *(v4u*)(yr + 256 + (lane >> 3) * 64 + (lane & 7) * 8) = qq;
        *(v2u*)(yr + 768 + ch) = (v2u){pk2((bflo(hf.x) + bflo(hb.x)) * siluf_(bflo(gl.x)), (bfhi(hf.x) + bfhi(hb.x)) * siluf_(bfhi(gl.x))), pk2((bflo(hf.y) + bflo(hb.y)) * siluf_(bflo(gl.y)), (bfhi(hf.y) + bfhi(hb.y)) * siluf_(bfhi(gl.y)))};
    }
#undef C1_LOAD
}
#define MFMA32(a, b, c) __builtin_amdgcn_mfma_f32_32x32x16_bf16((a), (b), (c), 0, 0, 0)
#define MFMA16(a, b, c) __builtin_amdgcn_mfma_f32_16x16x32_bf16((a), (b), (c), 0, 0, 0)
typedef short s16x4_t __attribute__((ext_vector_type(4)));

__device__ __forceinline__ float tanh_fast(float x) { return 1.f - 2.f * rcp_(1.f + exp_(2.f * x)); }

constexpr int ATT_KSTR = 208, ATT_VSTR = 136, ATT_VOFF = 64 * ATT_KSTR, ATT_STAGE = 64 * ATT_KSTR + 64 * ATT_VSTR;
__device__ __forceinline__ void att_unit(ArgsP a, LAS unsigned char* lds, int u) {
    const int tid = tid_(), lane = tid & 63, wave = tid >> 6, r = lane & 31, hq = lane >> 5;
    const bf16* KN = (const bf16*)(a->ws + WS_KN); const bf16* KR = (const bf16*)(a->ws + WS_KR); const bf16* VT = (const bf16*)(a->ws + WS_VT);
    bf16* Q = (bf16*)(a->ws + WS_Q); const bf16* G1 = (const bf16*)(a->ws + WS_G1);
    int b, h, n0, Lk, kidx0; size_t vbase;
    if (u < 512) { b = u >> 6; h = (u >> 3) & 7; n0 = T_CTX + b * 2048 + (u & 7) * 256; Lk = LK_LAT; kidx0 = T_CTX + b * LK_LAT; vbase = (size_t)VT_LAT + (size_t)(b * 8 + h) * 64 * LK_LAT; }
    else { const int uu = u - 512; b = uu >> 3; h = uu & 7; n0 = b * 256; Lk = 256; kidx0 = b * 256; vbase = (size_t)(b * 8 + h) * 64 * 256; }
    const int ntiles = Lk >> 6;
    const int n = n0 + wave * 32 + r;
    bf16x8 qf[6];
#pragma unroll
    for (int ks = 0; ks < 6; ++ks) qf[ks] = *(const bf16x8*)(Q + (size_t)n * 768 + h * 96 + ks * 16 + 8 * hq);
    const int key_k = tid >> 3, ck = tid & 7, key_r = (tid >> 2) & 63, cr = tid & 3;
    const bf16* gk = KN + (size_t)(kidx0 + key_k) * 512 + h * 64 + ck * 8;
    const bf16* gr = KR + (size_t)(kidx0 + key_r) * 32 + cr * 8;
    const bf16* gv = VT + vbase + (size_t)key_k * Lk + ck * 8;
    const unsigned sk = key_k * ATT_KSTR + ck * 16, sr = key_r * ATT_KSTR + 128 + cr * 16, sv = ATT_VOFF + key_k * ATT_VSTR + ck * 16;
    v4u rk, rr, rv;
    rk = *(const v4u*)gk; rr = (tid < 256) ? *(const v4u*)gr : (v4u){0u, 0u, 0u, 0u}; rv = *(const v4u*)gv;
    __syncthreads();
    *(LAS v4u*)(lds + sk) = rk; if (tid < 256) *(LAS v4u*)(lds + sr) = rr;
    *(LAS v2u*)(lds + sv) = (v2u){rv.x, rv.y}; *(LAS v2u*)(lds + sv + 8) = (v2u){rv.z, rv.w};
    __syncthreads();
    f32x16 o0, o1;
#pragma unroll
    for (int i = 0; i < 16; ++i) { o0[i] = 0.f; o1[i] = 0.f; }
    float m = -1e30f, l = 0.f;
    for (int j = 0; j < ntiles; ++j) {
        const int buf = j & 1;
        if (j + 1 < ntiles) { rk = *(const v4u*)(gk + (size_t)(j + 1) * 64 * 512); if (tid < 256) rr = *(const v4u*)(gr + (size_t)(j + 1) * 64 * 32); rv = *(const v4u*)(gv + (j + 1) * 64); }
        const LAS unsigned char* Kb = lds + buf * ATT_STAGE;
        f32x16 s0, s1;
#pragma unroll
        for (int i = 0; i < 16; ++i) { s0[i] = 0.f; s1[i] = 0.f; }
#pragma unroll
        for (int ks = 0; ks < 6; ++ks) {
            const bf16x8 a0 = *(const LAS bf16x8*)(Kb + r * ATT_KSTR + ks * 32 + hq * 16), a1 = *(const LAS bf16x8*)(Kb + (32 + r) * ATT_KSTR + ks * 32 + hq * 16);
            s0 = MFMA32(a0, qf[ks], s0); s1 = MFMA32(a1, qf[ks], s1);
        }
        float mx = s0[0];
#pragma unroll
        for (int i = 1; i < 16; ++i) mx = fmaxf(mx, s0[i]);
#pragma unroll
        for (int i = 0; i < 16; ++i) mx = fmaxf(mx, s1[i]);
        mx = fmaxf(mx, __shfl_xor(mx, 32));
        const float mn = fmaxf(m, mx), alpha = __builtin_amdgcn_exp2f(m - mn); m = mn;
        float ps = 0.f;
#pragma unroll
        for (int i = 0; i < 16; ++i) { s0[i] = __builtin_amdgcn_exp2f(s0[i] - mn); s1[i] = __builtin_amdgcn_exp2f(s1[i] - mn); ps += s0[i] + s1[i]; }
        l = l * alpha + ps;
#pragma unroll
        for (int i = 0; i < 16; ++i) { o0[i] *= alpha; o1[i] *= alpha; }
        const LAS unsigned char* Vb = Kb + ATT_VOFF;
#pragma unroll
        for (int ks = 0; ks < 4; ++ks) {
            v4u pw;
            if (ks == 0) { pw.x = cvtpk(s0[0], s0[1]); pw.y = cvtpk(s0[2], s0[3]); pw.z = cvtpk(s0[4], s0[5]); pw.w = cvtpk(s0[6], s0[7]); }
            else if (ks == 1) { pw.x = cvtpk(s0[8], s0[9]); pw.y = cvtpk(s0[10], s0[11]); pw.z = cvtpk(s0[12], s0[13]); pw.w = cvtpk(s0[14], s0[15]); }
            else if (ks == 2) { pw.x = cvtpk(s1[0], s1[1]); pw.y = cvtpk(s1[2], s1[3]); pw.z = cvtpk(s1[4], s1[5]); pw.w = cvtpk(s1[6], s1[7]); }
            else { pw.x = cvtpk(s1[8], s1[9]); pw.y = cvtpk(s1[10], s1[11]); pw.z = cvtpk(s1[12], s1[13]); pw.w = cvtpk(s1[14], s1[15]); }
            const bf16x8 pf = __builtin_bit_cast(bf16x8, pw);
            const v2u va0 = *(const LAS v2u*)(Vb + r * ATT_VSTR + ks * 32 + hq * 8), va1 = *(const LAS v2u*)(Vb + r * ATT_VSTR + ks * 32 + 16 + hq * 8);
            const v2u vb0 = *(const LAS v2u*)(Vb + (32 + r) * ATT_VSTR + ks * 32 + hq * 8), vb1 = *(const LAS v2u*)(Vb + (32 + r) * ATT_VSTR + ks * 32 + 16 + hq * 8);
            const v4u vwa = {va0.x, va0.y, va1.x, va1.y}, vwb = {vb0.x, vb0.y, vb1.x, vb1.y};
            o0 = MFMA32(__builtin_bit_cast(bf16x8, vwa), pf, o0); o1 = MFMA32(__builtin_bit_cast(bf16x8, vwb), pf, o1);
        }
        if (j + 1 < ntiles) {
            LAS unsigned char* Nb = lds + (buf ^ 1) * ATT_STAGE;
            *(LAS v4u*)(Nb + sk) = rk; if (tid < 256) *(LAS v4u*)(Nb + sr) = rr;
            *(LAS v2u*)(Nb + sv) = (v2u){rv.x, rv.y}; *(LAS v2u*)(Nb + sv + 8) = (v2u){rv.z, rv.w};
        }
        __syncthreads();
    }
    l += __shfl_xor(l, 32);
    const float inv = rcp_(l);
#pragma unroll
    for (int mt = 0; mt < 2; ++mt)
#pragma unroll
        for (int g = 0; g < 4; ++g) {
            const int dv0 = 32 * mt + 8 * g + 4 * hq;
            const v2u gm = *(const v2u*)(G1 + (size_t)n * G1W + C_GM + h * 64 + dv0);
            const float x0 = (mt ? o1[4 * g + 0] : o0[4 * g + 0]) * inv, x1 = (mt ? o1[4 * g + 1] : o0[4 * g + 1]) * inv, x2 = (mt ? o1[4 * g + 2] : o0[4 * g + 2]) * inv, x3 = (mt ? o1[4 * g + 3] : o0[4 * g + 3]) * inv;
            v2u ov; ov.x = cvtpk(x0 * siluf_(bflo(gm.x)), x1 * siluf_(bfhi(gm.x))); ov.y = cvtpk(x2 * siluf_(bflo(gm.y)), x3 * siluf_(bfhi(gm.y)));
            *(v2u*)(Q + (size_t)n * 768 + h * 96 + dv0) = ov;
        }
}

constexpr int A2_QSTR = 528, A2_KVSTR = 272, A2_KVOFF = 64 * A2_QSTR;
__device__ __forceinline__ void a2_unit(ArgsP a, LAS unsigned char* lds, int layer, int unit) {
    const int tid = tid_(), lane = tid & 63, wave = tid >> 6, tn = lane & 15, g = lane >> 4;
    constexpr int NU_TOK = T / 64;
    const bool is_tok = unit < NU_TOK;
    const bf16* G2 = (const bf16*)(a->ws + WS_G2);
    bf16* Q = (bf16*)(a->ws + WS_Q); bf16* KN = (bf16*)(a->ws + WS_KN); bf16* KR = (bf16*)(a->ws + WS_KR); bf16* VT = (bf16*)(a->ws + WS_VT);
    const bf16* WUQ = (const bf16*)(a->ws + WS_WUQ) + (size_t)layer * 768 * 256;
    const bf16* WUKV = (const bf16*)(a->ws + WS_WUKV) + (size_t)layer * 1024 * 128;
    const float* ROPE1 = (const float*)(a->ws + WS_ROPE);
    __syncthreads();
    v2u cq8[8], kv8[8]; unsigned kr8[8];
    if (is_tok) {
#pragma unroll
        for (int rr = 0; rr < 8; ++rr) { const size_t n_ = (size_t)(unit * 64 + wave * 8 + rr);
            cq8[rr] = *(const v2u*)(G2 + n_ * G2W + lane * 4); kv8[rr] = *(const v2u*)(G2 + n_ * G2W + 256 + (lane & 31) * 4); kr8[rr] = G2[n_ * G2W + 384 + (lane & 31)]; }
    }
#pragma unroll
    for (int rr = 0; rr < 8; ++rr) {
        const int r = wave * 8 + rr;
        if (is_tok) {
            const int n = unit * 64 + r; const Tok tk = tok_of(n);
            const v2u cqv = cq8[rr];
            const float c0 = bflo(cqv.x), c1 = bfhi(cqv.x), c2 = bflo(cqv.y), c3 = bfhi(cqv.y);
            const float rq = rsqrt_(wave_sum(c0 * c0 + c1 * c1 + c2 * c2 + c3 * c3) * (1.f / 256.f) + 1e-6f);
            const f32x4 qn = *(const f32x4*)(a->in[I_QNORM] + layer * 256 + lane * 4);
            *(LAS v2u*)(lds + r * A2_QSTR + lane * 8) = (v2u){cvtpk(c0 * rq * qn.x, c1 * rq * qn.y), cvtpk(c2 * rq * qn.z, c3 * rq * qn.w)};
            float k0 = 0.f, k1 = 0.f, k2 = 0.f, k3 = 0.f;
            if (lane < 32) { const v2u kv = kv8[rr]; k0 = bflo(kv.x); k1 = bfhi(kv.x); k2 = bflo(kv.y); k3 = bfhi(kv.y); }
            const float rk = rsqrt_(wave_sum(k0 * k0 + k1 * k1 + k2 * k2 + k3 * k3) * (1.f / 128.f) + 1e-6f);
            if (lane < 32) {
                const f32x4 kn = *(const f32x4*)(a->in[I_KVNORM] + layer * 128 + lane * 4);
                f32x4 o; o.x = k0 * rk * kn.x; o.y = k1 * rk * kn.y; o.z = k2 * rk * kn.z; o.w = k3 * rk * kn.w;
                if (!tk.lat) *(f32x4*)(a->out + O_CKV + ((size_t)(tk.b * 2 + layer) * 256 + tk.t) * 128 + lane * 4) = o;
                *(LAS v2u*)(lds + A2_KVOFF + r * A2_KVSTR + lane * 8) = (v2u){cvtpk(o.x, o.y), cvtpk(o.z, o.w)};
            }
            float krv = (lane < 32) ? bf2f(kr8[rr]) : 0.f;
            const float other = __shfl_xor(krv, 1);
            if (lane < 32) {
                if (!tk.lat) a->out[O_KR + ((size_t)(tk.b * 2 + layer) * 256 + tk.t) * 32 + lane] = krv;
                else { const float c = ROPE1[((size_t)tk.t * 16 + (lane >> 1)) * 2], s = ROPE1[((size_t)tk.t * 16 + (lane >> 1)) * 2 + 1]; krv = (lane & 1) ? (other * s + krv * c) : (krv * c - other * s); }
                KR[(size_t)tk.kidx * 32 + lane] = (bf16)f2bf(krv);
            }
        } else {
            const int cr = (unit - NU_TOK) * 64 + r, b = cr >> 8, j = cr & 255;
            const size_t src = ((size_t)(b * 2 + layer) * 256 + j);
            if (lane < 32) { const f32x4 v = *(const f32x4*)(a->in[I_CCKV] + src * 128 + lane * 4);
                *(LAS v2u*)(lds + A2_KVOFF + r * A2_KVSTR + lane * 8) = (v2u){cvtpk(v.x, v.y), cvtpk(v.z, v.w)};
                KR[(size_t)(T_CTX + b * LK_LAT + j) * 32 + lane] = (bf16)f2bf(a->in[I_CKR][src * 32 + lane]); }
        }
    }
    __syncthreads();
    constexpr int A2_STG = 52224, A2_SQSTR = 784, A2_SKSTR = 1040, A2_SVSTR = 144;
    const int n0 = is_tok ? unit * 64 : 0;
    if (is_tok) {
      const float* ROPE = (const float*)(a->ws + WS_ROPE);
      for (int qh = 0; qh < 2; ++qh) {
        f32x4 acc[3][4];
#pragma unroll
        for (int f = 0; f < 3; ++f)
#pragma unroll
            for (int t = 0; t < 4; ++t) acc[f][t] = (f32x4){0.f, 0.f, 0.f, 0.f};
        bf16x8 afq[3][8];
        const bf16* wq = WUQ + (size_t)((qh * 24 + wave * 3) * 16 + tn) * 256 + g * 8;
#pragma unroll
        for (int f = 0; f < 3; ++f)
#pragma unroll
            for (int ks = 0; ks < 8; ++ks) afq[f][ks] = *(const bf16x8*)(wq + f * 16 * 256 + ks * 32);
#pragma unroll
        for (int ks = 0; ks < 8; ++ks) {
            bf16x8 bfr[4];
#pragma unroll
            for (int t = 0; t < 4; ++t) bfr[t] = *(const LAS bf16x8*)(lds + (t * 16 + tn) * A2_QSTR + ks * 64 + g * 16);
#pragma unroll
            for (int f = 0; f < 3; ++f)
#pragma unroll
                for (int t = 0; t < 4; ++t) acc[f][t] = MFMA16(afq[f][ks], bfr[t], acc[f][t]);
        }
#pragma unroll
        for (int f = 0; f < 3; ++f) { const int fl = (wave * 3 + f) * 16 + 4 * g, f0 = qh * 384 + fl, d = f0 % 96;
#pragma unroll
            for (int t = 0; t < 4; ++t) { const int r = t * 16 + tn, n = n0 + r;
                float v0 = acc[f][t][0], v1 = acc[f][t][1], v2 = acc[f][t][2], v3 = acc[f][t][3];
                if (n >= T_CTX && d >= 64) { const int tt = (n - T_CTX) & 2047; const f32x4 cs = *(const f32x4*)(ROPE + ((size_t)tt * 16 + ((d - 64) >> 1)) * 2);
                    const float y0 = v0 * cs.x - v1 * cs.y, y1 = v0 * cs.y + v1 * cs.x, y2 = v2 * cs.z - v3 * cs.w, y3 = v2 * cs.w + v3 * cs.z; v0 = y0; v1 = y1; v2 = y2; v3 = y3; }
                *(LAS v2u*)(lds + A2_STG + r * A2_SQSTR + fl * 2) = (v2u){cvtpk(v0, v1), cvtpk(v2, v3)}; } }
        __syncthreads();
#pragma unroll
        for (int i = 0; i < 6; ++i) { const int c = tid + 512 * i, row = c / 48, c16 = c % 48;
            *(v4u*)(Q + (size_t)(n0 + row) * 768 + qh * 384 + c16 * 8) = *(const LAS v4u*)(lds + A2_STG + row * A2_SQSTR + c16 * 16); }
        __syncthreads();
      }
    }
    int kidx0, latu, bu, kpos0;
    if (is_tok) { const Tok tk = tok_of(n0); kidx0 = tk.kidx; latu = tk.lat; bu = tk.b; kpos0 = tk.lat ? PAST + tk.t : tk.t; }
    else { const int cr = (unit - NU_TOK) * 64; bu = cr >> 8; kpos0 = cr & 255; latu = 1; kidx0 = T_CTX + bu * LK_LAT + kpos0; }
    for (int half = 0; half < 2; ++half) {
        f32x4 acc[4][4];
#pragma unroll
        for (int f = 0; f < 4; ++f)
#pragma unroll
            for (int t = 0; t < 4; ++t) acc[f][t] = (f32x4){0.f, 0.f, 0.f, 0.f};
        bf16x8 afk[4][4];
        const bf16* wk = WUKV + (size_t)(wave * 128 + half * 64 + tn) * 128 + g * 8;
#pragma unroll
        for (int f = 0; f < 4; ++f)
#pragma unroll
            for (int ks = 0; ks < 4; ++ks) afk[f][ks] = *(const bf16x8*)(wk + f * 16 * 128 + ks * 32);
#pragma unroll
        for (int ks = 0; ks < 4; ++ks) {
            bf16x8 bfr[4];
#pragma unroll
            for (int t = 0; t < 4; ++t) bfr[t] = *(const LAS bf16x8*)(lds + A2_KVOFF + (t * 16 + tn) * A2_KVSTR + ks * 64 + g * 16);
#pragma unroll
            for (int f = 0; f < 4; ++f)
#pragma unroll
                for (int t = 0; t < 4; ++t) acc[f][t] = MFMA16(afk[f][ks], bfr[t], acc[f][t]);
        }
#pragma unroll
        for (int f = 0; f < 4; ++f) { const int x = wave * 64 + f * 16 + 4 * g;
#pragma unroll
            for (int t = 0; t < 4; ++t) { const int r = t * 16 + tn;
                if (half == 0) *(LAS v2u*)(lds + A2_STG + r * A2_SKSTR + x * 2) = (v2u){cvtpk(acc[f][t][0], acc[f][t][1]), cvtpk(acc[f][t][2], acc[f][t][3])};
                else { const unsigned p01 = cvtpk(acc[f][t][0], acc[f][t][1]), p23 = cvtpk(acc[f][t][2], acc[f][t][3]);
                    *(LAS bf16*)(lds + A2_STG + (x + 0) * A2_SVSTR + r * 2) = (bf16)(p01 & 0xffffu); *(LAS bf16*)(lds + A2_STG + (x + 1) * A2_SVSTR + r * 2) = (bf16)(p01 >> 16);
                    *(LAS bf16*)(lds + A2_STG + (x + 2) * A2_SVSTR + r * 2) = (bf16)(p23 & 0xffffu); *(LAS bf16*)(lds + A2_STG + (x + 3) * A2_SVSTR + r * 2) = (bf16)(p23 >> 16); } } }
        __syncthreads();
        if (half == 0) {
#pragma unroll
            for (int i = 0; i < 8; ++i) { const int c = tid + 512 * i, row = c >> 6, c16 = c & 63;
                *(v4u*)(KN + (size_t)(kidx0 + row) * 512 + c16 * 8) = *(const LAS v4u*)(lds + A2_STG + row * A2_SKSTR + c16 * 16); }
        } else {
            const int Lk = latu ? LK_LAT : 256;
#pragma unroll
            for (int i = 0; i < 8; ++i) { const int c = tid + 512 * i, row = c >> 3, part = c & 7, h = row >> 6, dv = row & 63;
                const size_t base = latu ? (size_t)VT_LAT + ((size_t)(bu * 8 + h) * 64 + dv) * LK_LAT : ((size_t)(bu * 8 + h) * 64 + dv) * 256;
                *(v4u*)(VT + base + kpos0 + part * 8) = *(const LAS v4u*)(lds + A2_STG + row * A2_SVSTR + part * 16); }
            (void)Lk;
        }
        __syncthreads();
    }
}

constexpr int RW_W2T = 0, RW_A2T = 9216, RW_TH = 18432, RW_HA = 27648, RW_CH0 = 36864, RW_CHB = 20992, RW_YB = 120832;
constexpr int RC_KP = 0, RC_RP = 2304, RC_BP = 4608  , RC_KT = 6912, RC_VR = 9216  , RC_LK = 16896, RC_TM = 17536, RC_ARK = 18176, RC_NARB = 18816, RC_G15 = 19456, RC_LBF = 19712, RC_SSQ = 20736;
template <int MODE = 0> __device__ __forceinline__ void rwkv_unit_mfma(ArgsP a, LAS unsigned char* lds, int layer, int u) {
    const int tid = tid_(), lane = tid & 63, wave = tid >> 6, i16 = lane & 15, g = lane >> 4;
    const int lat = u < 64, uu = lat ? u : u - 64, b = uu >> 3, e = (uu >> 2) & 1, hh = uu & 3;
    const int L = lat ? L_LAT : L_CTX, tok0 = lat ? T_CTX + b * L_LAT : b * L_CTX;
    const bf16* G1 = (const bf16*)(a->ws + WS_G1);
    bf16* YS = (bf16*)(a->ws + WS_G2);
    __syncthreads();
    { const bf16* wsrc = (const bf16*)(a->ws + WS_LORA2) + ((size_t)((layer * 2 + e) * 2) * 256 + hh * 64) * 64; const int row = tid >> 3, c8 = (tid & 7) * 8;
      *(LAS v4u*)(lds + RW_W2T + row * 144 + c8 * 2) = *(const v4u*)(wsrc + row * 64 + c8);
      *(LAS v4u*)(lds + RW_A2T + row * 144 + c8 * 2) = *(const v4u*)(wsrc + 256 * 64 + row * 64 + c8); }
    const int st_tok = tid >> 3, st_c8 = (tid & 7) * 8;
#define RW_STAGE(sc) do { const int step_ = (sc) * 64 + st_tok, t_ = e ? L - 1 - step_ : step_; const bf16* gp_ = G1 + (size_t)(tok0 + t_) * G1W + C_LORA + e * 64 + st_c8; \
        const v4u hw_ = *(const v4u*)gp_, ha_ = *(const v4u*)(gp_ + 128); v4u th_; \
        th_.x = cvtpk(tanh_fast(bflo(hw_.x)), tanh_fast(bfhi(hw_.x))); th_.y = cvtpk(tanh_fast(bflo(hw_.y)), tanh_fast(bfhi(hw_.y))); th_.z = cvtpk(tanh_fast(bflo(hw_.z)), tanh_fast(bfhi(hw_.z))); th_.w = cvtpk(tanh_fast(bflo(hw_.w)), tanh_fast(bfhi(hw_.w))); \
        *(LAS v4u*)(lds + RW_TH + st_tok * 144 + st_c8 * 2) = th_; *(LAS v4u*)(lds + RW_HA + st_tok * 144 + st_c8 * 2) = ha_; } while (0)
    RW_STAGE(0);
    f32x4 ST[4];
    {
        const int v = 16 * (wave & 3) + i16;
#pragma unroll
        for (int kt = 0; kt < 4; ++kt) ST[kt] = lat ? *(const f32x4*)(a->in[I_SRW] + (((size_t)((b * 2 + layer) * 2 + e) * 4 + hh) * 64 + v) * 64 + 16 * kt + 4 * g) : (f32x4){0.f, 0.f, 0.f, 0.f};
    }
    const int pc = wave & 3, ph = wave >> 2;
    LAS unsigned char* CH = lds + RW_CH0 + pc * RW_CHB;
    f32x4 w0r[2], a0r[2], kwr[2], kar[2];
#pragma unroll
    for (int c2 = 0; c2 < 2; ++c2) { const int gch = hh * 64 + (2 * ph + c2) * 16 + 4 * g;
        w0r[c2] = *(const f32x4*)(a->in[I_W0] + (layer * 2 + e) * 256 + gch); a0r[c2] = *(const f32x4*)(a->in[I_A0] + (layer * 2 + e) * 256 + gch);
        kwr[c2] = *(const f32x4*)(a->in[I_KK] + layer * 256 + gch); kar[c2] = *(const f32x4*)(a->in[I_KA] + layer * 256 + gch); }
#pragma unroll
    for (int c2 = 0; c2 < 2; ++c2) asm volatile("" : "+v"(w0r[c2]), "+v"(a0r[c2]), "+v"(kwr[c2]), "+v"(kar[c2]));
#pragma unroll
    for (int kt = 0; kt < 4; ++kt) asm volatile("" : "+v"(ST[kt]));
    __syncthreads();
    const int nsc = L >> 6;
    v2u pk[2], pr[2], pv[2];
#define RW_PREFETCH(sc) do { const int ps_ = (sc) * 64 + pc * 16 + i16, pt_ = e ? L - 1 - ps_ : ps_; const bf16* gq_ = G1 + (size_t)(tok0 + pt_) * G1W + hh * 64 + (2 * ph) * 16 + 4 * g; \
        pk[0] = *(const v2u*)(gq_ + C_K); pk[1] = *(const v2u*)(gq_ + C_K + 16); pr[0] = *(const v2u*)(gq_ + C_R); pr[1] = *(const v2u*)(gq_ + C_R + 16); pv[0] = *(const v2u*)(gq_ + C_V); pv[1] = *(const v2u*)(gq_ + C_V + 16); } while (0)
    RW_PREFETCH(0);
    for (int sc = 0; sc < nsc; ++sc) {
        const v2u ck[2] = {pk[0], pk[1]}, cr[2] = {pr[0], pr[1]}, cv[2] = {pv[0], pv[1]};
        if (sc + 1 < nsc) RW_PREFETCH(sc + 1);
        float dec[8], av[8], kx[8], rx[8], kk[8];
        {
            f32x4 aw[2], aa[2];
#pragma unroll
            for (int c2 = 0; c2 < 2; ++c2) { aw[c2] = (f32x4){0.f, 0.f, 0.f, 0.f}; aa[c2] = (f32x4){0.f, 0.f, 0.f, 0.f}; }
#pragma unroll
            for (int ks = 0; ks < 2; ++ks) {
                const bf16x8 bth = *(const LAS bf16x8*)(lds + RW_TH + (pc * 16 + i16) * 144 + ks * 64 + g * 16), bha = *(const LAS bf16x8*)(lds + RW_HA + (pc * 16 + i16) * 144 + ks * 64 + g * 16);
#pragma unroll
                for (int c2 = 0; c2 < 2; ++c2) { const int row = (2 * ph + c2) * 16 + i16;
                    const bf16x8 w2f = *(const LAS bf16x8*)(lds + RW_W2T + row * 144 + ks * 64 + g * 16), a2f = *(const LAS bf16x8*)(lds + RW_A2T + row * 144 + ks * 64 + g * 16);
                    aw[c2] = MFMA16(w2f, bth, aw[c2]); aa[c2] = MFMA16(a2f, bha, aa[c2]); }
            }
            float ss = 0.f;
#pragma unroll
            for (int c2 = 0; c2 < 2; ++c2) {
                const f32x4 w0 = w0r[c2], a0 = a0r[c2], kw = kwr[c2];
                const v2u kv = ck[c2], rv = cr[c2];
                const float kq[4] = {bflo(kv.x), bfhi(kv.x), bflo(kv.y), bfhi(kv.y)}, rq[4] = {bflo(rv.x), bfhi(rv.x), bflo(rv.y), bfhi(rv.y)};
#pragma unroll
                for (int q = 0; q < 4; ++q) { const int o = c2 * 4 + q;
                    dec[o] = exp_(-0.6065306597126334f * sigmoidf_(aw[c2][q] + w0[q])); av[o] = sigmoidf_(aa[c2][q] + a0[q]);
                    kx[o] = kq[q]; rx[o] = rq[q]; kk[o] = kq[q] * kw[q]; ss += kk[o] * kk[o]; }
            }
            ss += __shfl_xor(ss, 16); ss += __shfl_xor(ss, 32);
            if (g == 0) *(LAS float*)(CH + RC_SSQ + (i16 * 2 + ph) * 4) = ss;
        }
        __syncthreads();
        {
            const float tot = *(const LAS float*)(CH + RC_SSQ + (i16 * 2) * 4) + *(const LAS float*)(CH + RC_SSQ + (i16 * 2 + 1) * 4);
            const float inrm = rcp_(fmaxf(sqrt_(tot), 1e-12f));
            float G8[8], Gx8[8];
#pragma unroll
            for (int o8 = 0; o8 < 8; ++o8) G8[o8] = dec[o8];
#pragma unroll
            for (int o8 = 0; o8 < 8; ++o8) G8[o8] *= dpp_f<0x111>(1.f, G8[o8]);
#pragma unroll
            for (int o8 = 0; o8 < 8; ++o8) G8[o8] *= dpp_f<0x112>(1.f, G8[o8]);
#pragma unroll
            for (int o8 = 0; o8 < 8; ++o8) G8[o8] *= dpp_f<0x114>(1.f, G8[o8]);
#pragma unroll
            for (int o8 = 0; o8 < 8; ++o8) G8[o8] *= dpp_f<0x118>(1.f, G8[o8]);
#pragma unroll
            for (int o8 = 0; o8 < 8; ++o8) Gx8[o8] = dpp_f<0x111>(1.f, G8[o8]);
#pragma unroll
            for (int c2 = 0; c2 < 2; ++c2) { const int ch = (2 * ph + c2) * 16 + 4 * g;
                const f32x4 ka = kar[c2];
                float kp[4], bp[4], kt[4], rp[4];
#pragma unroll
                for (int q = 0; q < 4; ++q) { const int o = c2 * 4 + q;
                    const float G = G8[o], Gex = Gx8[o];
                    const float kkn = kk[o] * inrm, iG = rcp_(G);
                    kp[q] = Gex * kkn; bp[q] = kkn * av[o] * iG; kt[q] = kx[o] * (1.f + (av[o] - 1.f) * ka[q]) * iG; rp[q] = G * rx[o];
                    if (i16 == 15) *(LAS float*)(CH + RC_G15 + (ch + q) * 4) = G;
                }
                *(LAS v2u*)(CH + RC_KP + i16 * 144 + ch * 2) = (v2u){cvtpk(kp[0], kp[1]), cvtpk(kp[2], kp[3])};
                *(LAS v2u*)(CH + RC_BP + i16 * 144 + ch * 2) = (v2u){cvtpk(-bp[0], -bp[1]), cvtpk(-bp[2], -bp[3])};
                *(LAS v2u*)(CH + RC_KT + i16 * 144 + ch * 2) = (v2u){cvtpk(kt[0], kt[1]), cvtpk(kt[2], kt[3])};
                *(LAS v2u*)(CH + RC_RP + i16 * 144 + ch * 2) = (v2u){cvtpk(rp[0], rp[1]), cvtpk(rp[2], rp[3])};
                *(LAS v2u*)(CH + RC_VR + i16 * 144 + ch * 2) = cv[c2];
            }
        }
        __syncthreads();
        {
            f32x4 d0 = (f32x4){0.f, 0.f, 0.f, 0.f}, d1 = (f32x4){0.f, 0.f, 0.f, 0.f};
            const int xoff = ph ? RC_KP : RC_RP, y0off = ph ? RC_BP : RC_KT, y1off = ph ? RC_KT : RC_BP;
#pragma unroll
            for (int ks = 0; ks < 2; ++ks) {
                const bf16x8 xf = *(const LAS bf16x8*)(CH + xoff + i16 * 144 + ks * 64 + g * 16);
                const bf16x8 y0 = *(const LAS bf16x8*)(CH + y0off + i16 * 144 + ks * 64 + g * 16), y1 = *(const LAS bf16x8*)(CH + y1off + i16 * 144 + ks * 64 + g * 16);
                d0 = MFMA16(xf, y0, d0); d1 = MFMA16(xf, y1, d1);
            }
#pragma unroll
            for (int q = 0; q < 4; ++q) { const int i = 4 * g + q, j = i16;
                if (ph) { *(LAS float*)(CH + RC_LBF + (i * 16 + j) * 4) = (j < i) ? -d0[q] : 0.f; *(LAS bf16*)(CH + RC_LK + i * 40 + j * 2) = (bf16)(cvtpk((j < i) ? d1[q] : 0.f, 0.f) & 0xffffu); }
                else { const unsigned pk_ = cvtpk((j <= i) ? d0[q] : 0.f, (j <= i) ? d1[q] : 0.f); *(LAS bf16*)(CH + RC_ARK + i * 40 + j * 2) = (bf16)(pk_ & 0xffffu); *(LAS bf16*)(CH + RC_NARB + i * 40 + j * 2) = (bf16)(pk_ >> 16); }
            }
            if (ph && !(MODE & 2)) {
                float x[16];
#pragma unroll
                for (int i = 0; i < 16; ++i) { float s = (i == i16) ? 1.f : 0.f;
#pragma unroll
                    for (int j4 = 0; j4 < (i + 3) / 4; ++j4) { const f32x4 lr = *(const LAS f32x4*)(CH + RC_LBF + (i * 16 + j4 * 4) * 4);
#pragma unroll
                        for (int jj = 0; jj < 4; ++jj) { const int j = j4 * 4 + jj; if (j < i) s -= lr[jj] * x[j]; } }
                    x[i] = s; }
                if (g == 0) {
#pragma unroll
                    for (int i = 0; i < 16; i += 2) { const unsigned pk_ = cvtpk(x[i], x[i + 1]); *(LAS bf16*)(CH + RC_TM + i * 40 + i16 * 2) = (bf16)(pk_ & 0xffffu); *(LAS bf16*)(CH + RC_TM + (i + 1) * 40 + i16 * 2) = (bf16)(pk_ >> 16); } }
            }
        }
        __syncthreads();
        if (wave < 4) {
            const int vt = wave;
#pragma unroll 1
            for (int c = 0; c < ((MODE & 1) ? 0 : 4); ++c) {
                const LAS unsigned char* C = lds + RW_CH0 + c * RW_CHB;
                v4u sb01, sb23;
                sb01.x = cvtpk(ST[0][0], ST[0][1]); sb01.y = cvtpk(ST[0][2], ST[0][3]); sb01.z = cvtpk(ST[1][0], ST[1][1]); sb01.w = cvtpk(ST[1][2], ST[1][3]);
                sb23.x = cvtpk(ST[2][0], ST[2][1]); sb23.y = cvtpk(ST[2][2], ST[2][3]); sb23.z = cvtpk(ST[3][0], ST[3][1]); sb23.w = cvtpk(ST[3][2], ST[3][3]);
                const bf16x8 s01 = __builtin_bit_cast(bf16x8, sb01), s23 = __builtin_bit_cast(bf16x8, sb23);
                const v2u kp0a = *(const LAS v2u*)(C + RC_KP + i16 * 144 + (4 * g) * 2), kp0b = *(const LAS v2u*)(C + RC_KP + i16 * 144 + (16 + 4 * g) * 2);
                const v2u kp1a = *(const LAS v2u*)(C + RC_KP + i16 * 144 + (32 + 4 * g) * 2), kp1b = *(const LAS v2u*)(C + RC_KP + i16 * 144 + (48 + 4 * g) * 2);
                const v2u rp0a = *(const LAS v2u*)(C + RC_RP + i16 * 144 + (4 * g) * 2), rp0b = *(const LAS v2u*)(C + RC_RP + i16 * 144 + (16 + 4 * g) * 2);
                const v2u rp1a = *(const LAS v2u*)(C + RC_RP + i16 * 144 + (32 + 4 * g) * 2), rp1b = *(const LAS v2u*)(C + RC_RP + i16 * 144 + (48 + 4 * g) * 2);
                const v2u lk = *(const LAS v2u*)(C + RC_LK + i16 * 40 + g * 8), tm = *(const LAS v2u*)(C + RC_TM + i16 * 40 + g * 8);
                const v2u ark = *(const LAS v2u*)(C + RC_ARK + i16 * 40 + g * 8), narb = *(const LAS v2u*)(C + RC_NARB + i16 * 40 + g * 8);
                const int trq = (i16 >> 2) & 3, trp = i16 & 3;
                const v2u vf = __builtin_bit_cast(v2u, __builtin_amdgcn_ds_read_tr16_b64_v4i16((LAS s16x4_t*)(C + RC_VR + (4 * g + trq) * 144 + (16 * vt + 4 * trp) * 2)));
                const v4u z4 = {0u, 0u, 0u, 0u};
                f32x4 rhs = (f32x4){0.f, 0.f, 0.f, 0.f};
                rhs = MFMA16(__builtin_bit_cast(bf16x8, ((v4u){kp0a.x, kp0a.y, kp0b.x, kp0b.y})), s01, rhs);
                rhs = MFMA16(__builtin_bit_cast(bf16x8, ((v4u){kp1a.x, kp1a.y, kp1b.x, kp1b.y})), s23, rhs);
                rhs = MFMA16(__builtin_bit_cast(bf16x8, ((v4u){lk.x, lk.y, 0u, 0u})), __builtin_bit_cast(bf16x8, ((v4u){vf.x, vf.y, 0u, 0u})), rhs);
                f32x4 z = MFMA16(__builtin_bit_cast(bf16x8, ((v4u){tm.x, tm.y, 0u, 0u})), __builtin_bit_cast(bf16x8, ((v4u){cvtpk(rhs[0], rhs[1]), cvtpk(rhs[2], rhs[3]), 0u, 0u})), ((f32x4){0.f, 0.f, 0.f, 0.f}));
                const bf16x8 vz = __builtin_bit_cast(bf16x8, ((v4u){vf.x, vf.y, cvtpk(z[0], z[1]), cvtpk(z[2], z[3])}));
                f32x4 y = (f32x4){0.f, 0.f, 0.f, 0.f};
                y = MFMA16(__builtin_bit_cast(bf16x8, ((v4u){rp0a.x, rp0a.y, rp0b.x, rp0b.y})), s01, y);
                y = MFMA16(__builtin_bit_cast(bf16x8, ((v4u){rp1a.x, rp1a.y, rp1b.x, rp1b.y})), s23, y);
                y = MFMA16(__builtin_bit_cast(bf16x8, ((v4u){ark.x, ark.y, narb.x, narb.y})), vz, y);
#pragma unroll
                for (int kt = 0; kt < 4; ++kt) {
                    const v2u ktf = __builtin_bit_cast(v2u, __builtin_amdgcn_ds_read_tr16_b64_v4i16((LAS s16x4_t*)(C + RC_KT + (4 * g + trq) * 144 + (16 * kt + 4 * trp) * 2)));
                    const v2u nbf = __builtin_bit_cast(v2u, __builtin_amdgcn_ds_read_tr16_b64_v4i16((LAS s16x4_t*)(C + RC_BP + (4 * g + trq) * 144 + (16 * kt + 4 * trp) * 2)));
                    const f32x4 g15 = *(const LAS f32x4*)(C + RC_G15 + (16 * kt + 4 * g) * 4);
                    ST[kt] = MFMA16(__builtin_bit_cast(bf16x8, ((v4u){ktf.x, ktf.y, nbf.x, nbf.y})), vz, ST[kt]);
                    ST[kt] = ST[kt] * g15;
                }
                { const unsigned y01 = cvtpk(y[0], y[1]), y23 = cvtpk(y[2], y[3]); LAS unsigned char* yb = lds + RW_YB + (c * 16 + 4 * g) * 144 + (16 * vt + i16) * 2;
                  *(LAS bf16*)(yb) = (bf16)(y01 & 0xffffu); *(LAS bf16*)(yb + 144) = (bf16)(y01 >> 16); *(LAS bf16*)(yb + 288) = (bf16)(y23 & 0xffffu); *(LAS bf16*)(yb + 432) = (bf16)(y23 >> 16); }
                (void)z4;
            }
        } else if (sc + 1 < nsc) {
            const int r0 = (tid - 256) >> 3;
#pragma unroll
            for (int hrow = 0; hrow < 2; ++hrow) { const int tokr = r0 + 32 * hrow, step_ = (sc + 1) * 64 + tokr, t_ = e ? L - 1 - step_ : step_;
                const bf16* gp_ = G1 + (size_t)(tok0 + t_) * G1W + C_LORA + e * 64 + st_c8;
                const v4u hw_ = *(const v4u*)gp_, ha_ = *(const v4u*)(gp_ + 128); v4u th_;
                th_.x = cvtpk(tanh_fast(bflo(hw_.x)), tanh_fast(bfhi(hw_.x))); th_.y = cvtpk(tanh_fast(bflo(hw_.y)), tanh_fast(bfhi(hw_.y))); th_.z = cvtpk(tanh_fast(bflo(hw_.z)), tanh_fast(bfhi(hw_.z))); th_.w = cvtpk(tanh_fast(bflo(hw_.w)), tanh_fast(bfhi(hw_.w)));
                *(LAS v4u*)(lds + RW_TH + tokr * 144 + st_c8 * 2) = th_; *(LAS v4u*)(lds + RW_HA + tokr * 144 + st_c8 * 2) = ha_; }
        }
        __syncthreads();
        {
            const int row = tid >> 3, part = tid & 7, step = sc * 64 + row, t = e ? L - 1 - step : step;
            *(v4u*)(YS + ((size_t)e * T + tok0 + t) * 256 + hh * 64 + part * 8) = *(const LAS v4u*)(lds + RW_YB + row * 144 + part * 16);
        }
    }
#undef RW_STAGE
#undef RW_PREFETCH
    if (!lat && wave < 4) {
        const int v = 16 * wave + i16;
#pragma unroll
        for (int kt = 0; kt < 4; ++kt) *(f32x4*)(a->out + O_RW + (((size_t)((b * 2 + layer) * 2 + e) * 4 + hh) * 64 + v) * 64 + 16 * kt + 4 * g) = ST[kt];
    }
}

constexpr int LR_WAT = 0, LR_XCB = 18432, LR_XCF = 27648, LR_AA = 44032, LR_BV = 60416, LR_HH = 76800, LR_SP = 93184, LR_SH = 95232, LR_HC = 97280;
__device__ __forceinline__ void lru_unit_mfma(ArgsP a, LAS unsigned char* lds, int layer, int u) {
    const int tid = tid_(), lane = tid & 63, wave = tid >> 6, i16 = lane & 15, g4 = lane >> 4;
    const int lat = u < 32, uu = lat ? u : u - 32, b = uu >> 2, g = uu & 3;
    const int L = lat ? L_LAT : L_CTX, tok0 = lat ? T_CTX + b * L_LAT : b * L_CTX;
    const bf16* G1 = (const bf16*)(a->ws + WS_G1);
    bf16* HF = (bf16*)(a->ws + WS_HF);
    LAS float* XCF = (LAS float*)(lds + LR_XCF); LAS float* AA = (LAS float*)(lds + LR_AA); LAS float* BV = (LAS float*)(lds + LR_BV); LAS float* HH = (LAS float*)(lds + LR_HH);
    LAS float* SP = (LAS float*)(lds + LR_SP); LAS float* SH = (LAS float*)(lds + LR_SH); LAS float* HC = (LAS float*)(lds + LR_HC);
    const int tt = tid >> 3, q8 = (tid & 7) * 8;
    float cw[4][8], cb[8];
#pragma unroll
    for (int i = 0; i < 8; ++i) { const int ch = g * 64 + q8 + i; cb[i] = a->in[I_CONVB][layer * 256 + ch];
#pragma unroll
        for (int j = 0; j < 4; ++j) cw[j][i] = a->in[I_CONVW][(layer * 4 + j) * 256 + ch]; }
    const int ot = wave & 3, tp = wave >> 2;
    const int sch = tid & 63, seg = tid >> 6;
    for (int e = 0; e < 2; ++e) {
        __syncthreads();
        for (int i = tid; i < 4096; i += NTHREADS) { const size_t src = ((size_t)((layer * 2 + e) * 4 + g)) * 4096 + i; const int ii = i >> 6, oo = i & 63;
            *(LAS bf16*)(lds + LR_WAT + (oo * 72 + ii) * 2) = (bf16)f2bf(a->in[I_WA][src]); *(LAS bf16*)(lds + LR_WAT + 9216 + (oo * 72 + ii) * 2) = (bf16)f2bf(a->in[I_WX][src]); }
        if (tid < 64) HC[tid] = lat ? a->in[I_SLRU][((size_t)(b * 2 + layer) * 2 + e) * 256 + g * 64 + tid] : 0.f;
        f32x4 bav, bxv, spl;
        { const int chb = (layer * 2 + e) * 256 + g * 64 + 16 * ot + 4 * g4;
          bav = *(const f32x4*)(a->in[I_BA] + chb); bxv = *(const f32x4*)(a->in[I_BX] + chb); const f32x4 lam = *(const f32x4*)(a->in[I_LAMBDA] + chb);
#pragma unroll
          for (int q = 0; q < 4; ++q) spl[q] = log1pf(exp_(-lam[q])); }
        __syncthreads();
        v4u xr[4], hfr, glr;
#define LR_PREFETCH(cc_) do { const int c_ = e ? L / 64 - 1 - (cc_) : (cc_), t_ = c_ * 64 + tt; \
            _Pragma("unroll") for (int j = 0; j < 4; ++j) { const int ts = t_ + j - 2; xr[j] = (ts >= 0 && ts < L) ? *(const v4u*)(G1 + (size_t)(tok0 + ts) * G1W + C_XL + g * 64 + q8) : (v4u){0u, 0u, 0u, 0u}; } \
            if (e) { hfr = *(const v4u*)(HF + (size_t)(tok0 + t_) * 256 + g * 64 + q8); glr = *(const v4u*)(G1 + (size_t)(tok0 + t_) * G1W + C_GL + g * 64 + q8); } } while (0)
        LR_PREFETCH(0);
        for (int cc = 0; cc < L / 64; ++cc) {
            const int c = e ? L / 64 - 1 - cc : cc, t = c * 64 + tt, n = tok0 + t;
            const v4u xcur[4] = {xr[0], xr[1], xr[2], xr[3]}; const v4u hfc = hfr, glc = glr;
            if (cc + 1 < L / 64) LR_PREFETCH(cc + 1);
            {
                float xc[8];
#pragma unroll
                for (int i = 0; i < 8; ++i) xc[i] = cb[i];
#pragma unroll
                for (int j = 0; j < 4; ++j) {
                    { const v4u x = xcur[j];
                        xc[0] += cw[j][0] * bflo(x.x); xc[1] += cw[j][1] * bfhi(x.x); xc[2] += cw[j][2] * bflo(x.y); xc[3] += cw[j][3] * bfhi(x.y);
                        xc[4] += cw[j][4] * bflo(x.z); xc[5] += cw[j][5] * bfhi(x.z); xc[6] += cw[j][6] * bflo(x.w); xc[7] += cw[j][7] * bfhi(x.w); } }
                *(LAS f32x4*)(XCF + tt * 64 + q8) = (f32x4){xc[0], xc[1], xc[2], xc[3]}; *(LAS f32x4*)(XCF + tt * 64 + q8 + 4) = (f32x4){xc[4], xc[5], xc[6], xc[7]};
                *(LAS v4u*)(lds + LR_XCB + tt * 144 + q8 * 2) = (v4u){cvtpk(xc[0], xc[1]), cvtpk(xc[2], xc[3]), cvtpk(xc[4], xc[5]), cvtpk(xc[6], xc[7])};
            }
            __syncthreads();
            {
#pragma unroll
                for (int t2 = 0; t2 < 2; ++t2) { const int tk = (2 * tp + t2) * 16 + i16;
                    f32x4 ga = (f32x4){0.f, 0.f, 0.f, 0.f}, gx = (f32x4){0.f, 0.f, 0.f, 0.f};
#pragma unroll
                    for (int ks = 0; ks < 2; ++ks) { const bf16x8 xf = *(const LAS bf16x8*)(lds + LR_XCB + tk * 144 + ks * 64 + g4 * 16);
                        const bf16x8 wa = *(const LAS bf16x8*)(lds + LR_WAT + (16 * ot + i16) * 144 + ks * 64 + g4 * 16), wx = *(const LAS bf16x8*)(lds + LR_WAT + 9216 + (16 * ot + i16) * 144 + ks * 64 + g4 * 16);
                        ga = MFMA16(wa, xf, ga); gx = MFMA16(wx, xf, gx); }
                    const f32x4 xcv = *(const LAS f32x4*)(XCF + tk * 64 + 16 * ot + 4 * g4);
                    f32x4 av, bv;
#pragma unroll
                    for (int q = 0; q < 4; ++q) { const float la = -8.f * sigmoidf_(ga[q] + bav[q]) * spl[q]; av[q] = exp_(la); bv[q] = sqrt_(1.f - exp_(2.f * la)) * sigmoidf_(gx[q] + bxv[q]) * xcv[q]; }
                    *(LAS f32x4*)(AA + tk * 64 + 16 * ot + 4 * g4) = av; *(LAS f32x4*)(BV + tk * 64 + 16 * ot + 4 * g4) = bv; }
            }
            __syncthreads();
            float av8[8], bv8[8];
            {
                float P = 1.f, H = 0.f;
#pragma unroll
                for (int s = 0; s < 8; ++s) { const int p = seg * 8 + s, st = e ? 63 - p : p; av8[s] = AA[st * 64 + sch]; bv8[s] = BV[st * 64 + sch]; H = fmaf(av8[s], H, bv8[s]); P *= av8[s]; }
                SP[seg * 64 + sch] = P; SH[seg * 64 + sch] = H;
            }
            __syncthreads();
            {
                float h = HC[sch];
                for (int s2 = 0; s2 < seg; ++s2) h = fmaf(SP[s2 * 64 + sch], h, SH[s2 * 64 + sch]);
#pragma unroll
                for (int s = 0; s < 8; ++s) { const int p = seg * 8 + s, st = e ? 63 - p : p; h = fmaf(av8[s], h, bv8[s]); HH[st * 64 + sch] = h; }
                __syncthreads();
                if (seg == 7) HC[sch] = h;
            }
            __syncthreads();
            {
                bf16* dst = HF + (size_t)n * 256 + g * 64 + q8;
                float o[8];
#pragma unroll
                for (int i = 0; i < 8; ++i) o[i] = HH[tt * 64 + q8 + i];
                if (e) { const v4u hf = hfc, gl = glc;
                    o[0] = (o[0] + bflo(hf.x)) * siluf_(bflo(gl.x)); o[1] = (o[1] + bfhi(hf.x)) * siluf_(bfhi(gl.x)); o[2] = (o[2] + bflo(hf.y)) * siluf_(bflo(gl.y)); o[3] = (o[3] + bfhi(hf.y)) * siluf_(bfhi(gl.y));
                    o[4] = (o[4] + bflo(hf.z)) * siluf_(bflo(gl.z)); o[5] = (o[5] + bfhi(hf.z)) * siluf_(bfhi(gl.z)); o[6] = (o[6] + bflo(hf.w)) * siluf_(bflo(gl.w)); o[7] = (o[7] + bfhi(hf.w)) * siluf_(bfhi(gl.w)); }
                *(v4u*)dst = (v4u){cvtpk(o[0], o[1]), cvtpk(o[2], o[3]), cvtpk(o[4], o[5]), cvtpk(o[6], o[7])};
            }
        }
#undef LR_PREFETCH
        __syncthreads();
        if (tid < 64 && !lat) a->out[O_LRU + ((size_t)(b * 2 + layer) * 2 + e) * 256 + g * 64 + tid] = HC[tid];
    }
}

constexpr int LQ_NQ = 32;
constexpr int LQ_WAT = 0, LQ_S0 = 2 * LQ_NQ * 144;
constexpr int LS_XCB = 0, LS_XCQ = 9216, LS_AA = LS_XCQ + 64 * LQ_NQ * 4, LS_BV = LS_AA + 64 * LQ_NQ * 4, LS_HH = LS_BV + 64 * LQ_NQ * 4,
              LS_SP = LS_HH + 64 * LQ_NQ * 4, LS_SH = LS_SP + 8 * LQ_NQ * 4, LS_HC = LS_SH + 8 * LQ_NQ * 4, LS_BYTES = LS_HC + 2 * LQ_NQ * 4;
__device__ __forceinline__ void lru_unit_q(ArgsP a, LAS unsigned char* lds, int layer, int u) {
    const int tid = tid_(), lane = tid & 63, wave = tid >> 6, i16 = lane & 15, g4 = lane >> 4;
    const int lat = u < 64, uu = lat ? u : u - 64, bp = uu >> 4, e = (uu >> 3) & 1, g = (uu >> 1) & 3, oq = uu & 1;
    const int L = lat ? L_LAT : L_CTX;
    const int tokb[2] = {lat ? T_CTX + (2 * bp) * L_LAT : (2 * bp) * L_CTX, lat ? T_CTX + (2 * bp + 1) * L_LAT : (2 * bp + 1) * L_CTX};
    const bf16* G1 = (const bf16*)(a->ws + WS_G1);
    unsigned char* HO = e ? (unsigned char*)a->out + 2048 : a->ws + WS_HF;
    const size_t hstr = e ? 4096 : 512;
    const int tt = tid >> 3, q8 = (tid & 7) * 8;
    float cw[4][8], cb[8];
#pragma unroll
    for (int i = 0; i < 8; ++i) { const int ch = g * 64 + q8 + i; cb[i] = a->in[I_CONVB][layer * 256 + ch];
#pragma unroll
        for (int j = 0; j < 4; ++j) cw[j][i] = a->in[I_CONVW][(layer * 4 + j) * 256 + ch]; }
    const int gt = wave & 3, got = wave >> 2;
    const int ssn = tid >> 8, sch = tid & (LQ_NQ - 1), seg = (tid >> 5) & 7;
    const int otok = tid >> 3, oc4 = (tid & 7) * 4;
    const int chq = g * 64 + oq * LQ_NQ;
    LAS unsigned char* SS = lds + LQ_S0 + ssn * LS_BYTES;
    {
        __syncthreads();
        { const int m = tid >> 8, row = (tid >> 3) & 31, c8 = (tid & 7) * 8;
          const bf16* wsrc = (const bf16*)(a->ws + WS_LRUW) + ((size_t)(((layer * 2 + e) * 2 + m) * 4 + g) * 64 + oq * LQ_NQ + row) * 64 + c8;
          *(LAS v4u*)(lds + LQ_WAT + m * LQ_NQ * 144 + row * 144 + c8 * 2) = *(const v4u*)wsrc; }
        if (tid < 2 * LQ_NQ) { const int s = tid >> 5, c = tid & 31; ((LAS float*)(lds + LQ_S0 + s * LS_BYTES + LS_HC))[c] = lat ? a->in[I_SLRU][((size_t)((2 * bp + s) * 2 + layer) * 2 + e) * 256 + chq + c] : 0.f; }
        f32x4 bav, bxv, spl;
        { const int chb = (layer * 2 + e) * 256 + chq + 16 * got + 4 * g4;
          bav = *(const f32x4*)(a->in[I_BA] + chb); bxv = *(const f32x4*)(a->in[I_BX] + chb); const f32x4 lam = *(const f32x4*)(a->in[I_LAMBDA] + chb);
#pragma unroll
          for (int q = 0; q < 4; ++q) spl[q] = log1pf(exp_(-lam[q])); }
        v4u xr[2][4];
#define LQ_PREFETCH(cc_) do { const int c_ = e ? L / 64 - 1 - (cc_) : (cc_), t_ = c_ * 64 + tt; \
            _Pragma("unroll") for (int s = 0; s < 2; ++s) { \
              _Pragma("unroll") for (int j = 0; j < 4; ++j) { const int ts = t_ + j - 2; xr[s][j] = (ts >= 0 && ts < L) ? *(const v4u*)(G1 + (size_t)(tokb[s] + ts) * G1W + C_XL + g * 64 + q8) : (v4u){0u, 0u, 0u, 0u}; } \
              } } while (0)
        LQ_PREFETCH(0);
        __syncthreads();
        for (int cc = 0; cc < L / 64; ++cc) {
            const int c = e ? L / 64 - 1 - cc : cc;
            v4u xcur[2][4];
#pragma unroll
            for (int s = 0; s < 2; ++s) { xcur[s][0] = xr[s][0]; xcur[s][1] = xr[s][1]; xcur[s][2] = xr[s][2]; xcur[s][3] = xr[s][3]; }
            if (cc + 1 < L / 64) LQ_PREFETCH(cc + 1);
#pragma unroll
            for (int s = 0; s < 2; ++s) {
                LAS unsigned char* SB = lds + LQ_S0 + s * LS_BYTES;
                float xc[8];
#pragma unroll
                for (int i = 0; i < 8; ++i) xc[i] = cb[i];
#pragma unroll
                for (int j = 0; j < 4; ++j) { const v4u x = xcur[s][j];
                    xc[0] += cw[j][0] * bflo(x.x); xc[1] += cw[j][1] * bfhi(x.x); xc[2] += cw[j][2] * bflo(x.y); xc[3] += cw[j][3] * bfhi(x.y);
                    xc[4] += cw[j][4] * bflo(x.z); xc[5] += cw[j][5] * bfhi(x.z); xc[6] += cw[j][6] * bflo(x.w); xc[7] += cw[j][7] * bfhi(x.w); }
                *(LAS v4u*)(SB + LS_XCB + tt * 144 + q8 * 2) = (v4u){cvtpk(xc[0], xc[1]), cvtpk(xc[2], xc[3]), cvtpk(xc[4], xc[5]), cvtpk(xc[6], xc[7])};
                if ((q8 / LQ_NQ) == oq) { LAS float* XCQ = (LAS float*)(SB + LS_XCQ); *(LAS f32x4*)(XCQ + tt * LQ_NQ + (q8 % LQ_NQ)) = (f32x4){xc[0], xc[1], xc[2], xc[3]}; *(LAS f32x4*)(XCQ + tt * LQ_NQ + (q8 % LQ_NQ) + 4) = (f32x4){xc[4], xc[5], xc[6], xc[7]}; }
            }
            __syncthreads();
#pragma unroll
            for (int s = 0; s < 2; ++s) {
                LAS unsigned char* SB = lds + LQ_S0 + s * LS_BYTES;
                const int tk = gt * 16 + i16;
                f32x4 ga = (f32x4){0.f, 0.f, 0.f, 0.f}, gx = (f32x4){0.f, 0.f, 0.f, 0.f};
#pragma unroll
                for (int ks = 0; ks < 2; ++ks) { const bf16x8 xf = *(const LAS bf16x8*)(SB + LS_XCB + tk * 144 + ks * 64 + g4 * 16);
                    const bf16x8 wa = *(const LAS bf16x8*)(lds + LQ_WAT + (16 * got + i16) * 144 + ks * 64 + g4 * 16), wx = *(const LAS bf16x8*)(lds + LQ_WAT + LQ_NQ * 144 + (16 * got + i16) * 144 + ks * 64 + g4 * 16);
                    ga = MFMA16(wa, xf, ga); gx = MFMA16(wx, xf, gx); }
                const f32x4 xcv = *(const LAS f32x4*)((LAS float*)(SB + LS_XCQ) + tk * LQ_NQ + 16 * got + 4 * g4);
                f32x4 av, bv;
#pragma unroll
                for (int q = 0; q < 4; ++q) { const float la = -8.f * sigmoidf_(ga[q] + bav[q]) * spl[q], aq = exp_(la); av[q] = aq; bv[q] = sqrt_((1.f - aq) * (1.f + aq)) * sigmoidf_(gx[q] + bxv[q]) * xcv[q]; }
                *(LAS f32x4*)((LAS float*)(SB + LS_AA) + tk * LQ_NQ + 16 * got + 4 * g4) = av; *(LAS f32x4*)((LAS float*)(SB + LS_BV) + tk * LQ_NQ + 16 * got + 4 * g4) = bv;
            }
            __syncthreads();
            LAS float* AA = (LAS float*)(SS + LS_AA); LAS float* BV = (LAS float*)(SS + LS_BV); LAS float* HH = (LAS float*)(SS + LS_HH);
            LAS float* SP = (LAS float*)(SS + LS_SP); LAS float* SH = (LAS float*)(SS + LS_SH); LAS float* HC = (LAS float*)(SS + LS_HC);
            float av8[8], bv8[8];
            {
                float P = 1.f, H = 0.f;
#pragma unroll
                for (int s = 0; s < 8; ++s) { const int p = seg * 8 + s, st = e ? 63 - p : p; av8[s] = AA[st * LQ_NQ + sch]; bv8[s] = BV[st * LQ_NQ + sch]; H = fmaf(av8[s], H, bv8[s]); P *= av8[s]; }
                SP[seg * LQ_NQ + sch] = P; SH[seg * LQ_NQ + sch] = H;
            }
            __syncthreads();
            {
                float h = HC[(cc & 1) * LQ_NQ + sch];
                for (int s2 = 0; s2 < seg; ++s2) h = fmaf(SP[s2 * LQ_NQ + sch], h, SH[s2 * LQ_NQ + sch]);
#pragma unroll
                for (int s = 0; s < 8; ++s) { const int p = seg * 8 + s, st = e ? 63 - p : p; h = fmaf(av8[s], h, bv8[s]); HH[st * LQ_NQ + sch] = h; }
                if (seg == 7) HC[((cc + 1) & 1) * LQ_NQ + sch] = h;
            }
            __syncthreads();
#pragma unroll
            for (int s = 0; s < 2; ++s) {
                const int n = tokb[s] + c * 64 + otok;
                const f32x4 hv = *(const LAS f32x4*)((LAS float*)(lds + LQ_S0 + s * LS_BYTES + LS_HH) + otok * LQ_NQ + oc4);
                *(v2u*)(HO + (size_t)n * hstr + (chq + oc4) * 2) = (v2u){cvtpk(hv[0], hv[1]), cvtpk(hv[2], hv[3])};
            }
        }
#undef LQ_PREFETCH
        __syncthreads();
        if (tid < 2 * LQ_NQ && !lat) { const int s = tid >> 5, c = tid & 31; a->out[O_LRU + ((size_t)((2 * bp + s) * 2 + layer) * 2 + e) * 256 + chq + c] = ((LAS float*)(lds + LQ_S0 + s * LS_BYTES + LS_HC))[((L / 64) & 1) * LQ_NQ + c]; }
    }
}

constexpr int ATT2_VSTR = 144, ATT2_STAGE = 64 * ATT_KSTR + 64 * ATT2_VSTR;
#define ATT_KLOAD(KB_) \
        bf16x8 kfa_[6], kfb_[6]; \
        _Pragma("unroll") for (int ks_ = 0; ks_ < 6; ++ks_) { kfa_[ks_] = *(const LAS bf16x8*)((KB_) + r * ATT_KSTR + ks_ * 32 + hq * 16); kfb_[ks_] = *(const LAS bf16x8*)((KB_) + (32 + r) * ATT_KSTR + ks_ * 32 + hq * 16); }
#define ATT_VLOAD(VB_) \
        v2u va0_[4], va1_[4], vb0_[4], vb1_[4]; \
        _Pragma("unroll") for (int ks_ = 0; ks_ < 4; ++ks_) { \
            const LAS unsigned char* vp_ = (VB_) + (ks_ * 16 + 4 * hq + ((lane >> 2) & 3)) * ATT2_VSTR + (16 * ((lane >> 4) & 1) + 4 * (lane & 3)) * 2; \
            va0_[ks_] = __builtin_bit_cast(v2u, __builtin_amdgcn_ds_read_tr16_b64_v4i16((LAS s16x4_t*)(vp_))); \
            va1_[ks_] = __builtin_bit_cast(v2u, __builtin_amdgcn_ds_read_tr16_b64_v4i16((LAS s16x4_t*)(vp_ + 8 * ATT2_VSTR))); \
            vb0_[ks_] = __builtin_bit_cast(v2u, __builtin_amdgcn_ds_read_tr16_b64_v4i16((LAS s16x4_t*)(vp_ + 64))); \
            vb1_[ks_] = __builtin_bit_cast(v2u, __builtin_amdgcn_ds_read_tr16_b64_v4i16((LAS s16x4_t*)(vp_ + 8 * ATT2_VSTR + 64))); }
#define ATT_QKM(S0_, S1_) do { \
        _Pragma("unroll") for (int i_ = 0; i_ < 16; ++i_) { S0_[i_] = 0.f; S1_[i_] = 0.f; } \
        _Pragma("unroll") for (int ks_ = 0; ks_ < 6; ++ks_) { S0_ = MFMA32(kfa_[ks_], qf[ks_], S0_); S1_ = MFMA32(kfb_[ks_], qf[ks_], S1_); } } while (0)
#define ATT_STEP(SC0_, SC1_, SN0_, SN1_, KB_, VB_, HAVE_NEXT_) do { \
        ATT_KLOAD(KB_) \
        float mx_ = SC0_[0]; \
        _Pragma("unroll") for (int i_ = 1; i_ < 16; ++i_) mx_ = fmaxf(mx_, SC0_[i_]); \
        _Pragma("unroll") for (int i_ = 0; i_ < 16; ++i_) mx_ = fmaxf(mx_, SC1_[i_]); \
        mx_ = fmaxf(mx_, __shfl_xor(mx_, 32)); \
        if (!__all(mx_ - m <= 8.f)) { const float mn_ = fmaxf(m, mx_), al_ = __builtin_amdgcn_exp2f(m - mn_); m = mn_; l *= al_; \
            _Pragma("unroll") for (int i_ = 0; i_ < 16; ++i_) { o0[i_] *= al_; o1[i_] *= al_; } } \
        if (HAVE_NEXT_) ATT_QKM(SN0_, SN1_); \
        ATT_VLOAD(VB_) \
        float ps_ = 0.f; \
        _Pragma("unroll") for (int i_ = 0; i_ < 16; ++i_) { SC0_[i_] = __builtin_amdgcn_exp2f(SC0_[i_] - m); SC1_[i_] = __builtin_amdgcn_exp2f(SC1_[i_] - m); ps_ += SC0_[i_] + SC1_[i_]; } \
        l += ps_; \
        _Pragma("unroll") for (int ks_ = 0; ks_ < 4; ++ks_) { \
            v4u pw_; \
            if (ks_ == 0) { pw_.x = cvtpk(SC0_[0], SC0_[1]); pw_.y = cvtpk(SC0_[2], SC0_[3]); pw_.z = cvtpk(SC0_[4], SC0_[5]); pw_.w = cvtpk(SC0_[6], SC0_[7]); } \
            else if (ks_ == 1) { pw_.x = cvtpk(SC0_[8], SC0_[9]); pw_.y = cvtpk(SC0_[10], SC0_[11]); pw_.z = cvtpk(SC0_[12], SC0_[13]); pw_.w = cvtpk(SC0_[14], SC0_[15]); } \
            else if (ks_ == 2) { pw_.x = cvtpk(SC1_[0], SC1_[1]); pw_.y = cvtpk(SC1_[2], SC1_[3]); pw_.z = cvtpk(SC1_[4], SC1_[5]); pw_.w = cvtpk(SC1_[6], SC1_[7]); } \
            else { pw_.x = cvtpk(SC1_[8], SC1_[9]); pw_.y = cvtpk(SC1_[10], SC1_[11]); pw_.z = cvtpk(SC1_[12], SC1_[13]); pw_.w = cvtpk(SC1_[14], SC1_[15]); } \
            const bf16x8 pf_ = __builtin_bit_cast(bf16x8, pw_); \
            const v4u vwa_ = {va0_[ks_].x, va0_[ks_].y, va1_[ks_].x, va1_[ks_].y}, vwb_ = {vb0_[ks_].x, vb0_[ks_].y, vb1_[ks_].x, vb1_[ks_].y}; \
            o0 = MFMA32(__builtin_bit_cast(bf16x8, vwa_), pf_, o0); o1 = MFMA32(__builtin_bit_cast(bf16x8, vwb_), pf_, o1); } } while (0)
__device__ __forceinline__ void att_unit2(ArgsP a, LAS unsigned char* lds, int u) {
    const int tid = tid_(), lane = tid & 63, wave = tid >> 6, r = lane & 31, hq = lane >> 5;
    const bf16* KN = (const bf16*)(a->ws + WS_KN); const bf16* KR = (const bf16*)(a->ws + WS_KR); const bf16* VT = (const bf16*)(a->ws + WS_VT);
    bf16* Q = (bf16*)(a->ws + WS_Q); const bf16* G1 = (const bf16*)(a->ws + WS_G1);
    int b, h, n0, Lk, kidx0; size_t vbase;
    if (u < 512) { b = u >> 6; h = (u >> 3) & 7; n0 = T_CTX + b * 2048 + (u & 7) * 256; Lk = LK_LAT; kidx0 = T_CTX + b * LK_LAT; vbase = (size_t)VT_LAT + (size_t)(b * 8 + h) * 64 * LK_LAT; }
    else { const int uu = u - 512; b = uu >> 3; h = uu & 7; n0 = b * 256; Lk = 256; kidx0 = b * 256; vbase = (size_t)(b * 8 + h) * 64 * 256; }
    const int ntiles = Lk >> 6;
    const int n = n0 + wave * 32 + r;
    bf16x8 qf[6];
#pragma unroll
    for (int ks = 0; ks < 6; ++ks) qf[ks] = *(const bf16x8*)(Q + (size_t)n * 768 + h * 96 + ks * 16 + 8 * hq);
    const int key_k = tid >> 3, ck = tid & 7, key_r = (tid >> 2) & 63, cr = tid & 3;
    const bf16* gk = KN + (size_t)(kidx0 + key_k) * 512 + h * 64 + ck * 8;
    const bf16* gr = KR + (size_t)(kidx0 + key_r) * 32 + cr * 8;
    const bf16* gv = VT + (size_t)(kidx0 + key_k) * 512 + h * 64 + ck * 8;
    const unsigned sk = key_k * ATT_KSTR + ck * 16, sr = key_r * ATT_KSTR + 128 + cr * 16, sv = ATT_VOFF + key_k * ATT2_VSTR + ck * 16;
    v4u rkA, rrA = {0u, 0u, 0u, 0u}, rvA, rkB, rrB = {0u, 0u, 0u, 0u}, rvB;
#define ATT_LOAD(X_, j_) do { rk##X_ = *(const v4u*)(gk + (size_t)(j_) * 64 * 512); if (tid < 256) rr##X_ = *(const v4u*)(gr + (size_t)(j_) * 64 * 32); rv##X_ = *(const v4u*)(gv + (size_t)(j_) * 64 * 512); } while (0)
#define ATT_STORE(X_, B_) do { LAS unsigned char* nb_ = lds + (B_) * ATT2_STAGE; *(LAS v4u*)(nb_ + sk) = rk##X_; if (tid < 256) *(LAS v4u*)(nb_ + sr) = rr##X_; \
        *(LAS v4u*)(nb_ + sv) = rv##X_; } while (0)
    ATT_LOAD(A, 0); ATT_LOAD(B, 1);
    __syncthreads();
    ATT_STORE(A, 0);
    ATT_STORE(B, 1);
    ATT_LOAD(A, 2);
    __syncthreads();
    f32x16 o0, o1, sa0, sa1, sb0, sb1;
#pragma unroll
    for (int i = 0; i < 16; ++i) { o0[i] = 0.f; o1[i] = 0.f; }
    float m = -1e30f, l = 0.f;
    { ATT_KLOAD(lds) ATT_QKM(sa0, sa1); }
    int bcur = 0;
    int j = 0;
    for (; j < ntiles - 2; j += 2) {
        {
            const int b1 = bcur == 2 ? 0 : bcur + 1, b2 = b1 == 2 ? 0 : b1 + 1;
            ATT_LOAD(B, j + 3);
            ATT_STEP(sa0, sa1, sb0, sb1, lds + b1 * ATT2_STAGE, lds + bcur * ATT2_STAGE + ATT_VOFF, true);
            ATT_STORE(A, b2);
            __syncthreads();
            bcur = b1;
        }
        {
            const int b1 = bcur == 2 ? 0 : bcur + 1, b2 = b1 == 2 ? 0 : b1 + 1;
            if (j + 4 < ntiles) ATT_LOAD(A, j + 4);
            ATT_STEP(sb0, sb1, sa0, sa1, lds + b1 * ATT2_STAGE, lds + bcur * ATT2_STAGE + ATT_VOFF, true);
            ATT_STORE(B, b2);
            __syncthreads();
            bcur = b1;
        }
    }
    {
        { const int b1 = bcur == 2 ? 0 : bcur + 1;
          ATT_STEP(sa0, sa1, sb0, sb1, lds + b1 * ATT2_STAGE, lds + bcur * ATT2_STAGE + ATT_VOFF, true);
          bcur = b1; }
        { ATT_STEP(sb0, sb1, sa0, sa1, lds + bcur * ATT2_STAGE, lds + bcur * ATT2_STAGE + ATT_VOFF, false); }
        __syncthreads();
    }
#undef ATT_LOAD
#undef ATT_STORE
    v2u gmv[2][4];
#pragma unroll
    for (int mt = 0; mt < 2; ++mt)
#pragma unroll
        for (int g = 0; g < 4; ++g) gmv[mt][g] = *(const v2u*)(G1 + (size_t)n * G1W + C_GM + h * 64 + 32 * mt + 8 * g + 4 * hq);
    l += __shfl_xor(l, 32);
    const float inv = rcp_(l);
#pragma unroll
    for (int mt = 0; mt < 2; ++mt)
#pragma unroll
        for (int g = 0; g < 4; ++g) {
            const int dv0 = 32 * mt + 8 * g + 4 * hq;
            const v2u gm = gmv[mt][g];
            const float x0 = (mt ? o1[4 * g + 0] : o0[4 * g + 0]) * inv, x1 = (mt ? o1[4 * g + 1] : o0[4 * g + 1]) * inv, x2 = (mt ? o1[4 * g + 2] : o0[4 * g + 2]) * inv, x3 = (mt ? o1[4 * g + 3] : o0[4 * g + 3]) * inv;
            v2u ov; ov.x = cvtpk(x0 * siluf_(bflo(gm.x)), x1 * siluf_(bfhi(gm.x))); ov.y = cvtpk(x2 * siluf_(bflo(gm.y)), x3 * siluf_(bfhi(gm.y)));
            *(v2u*)(Q + (size_t)n * 768 + h * 96 + dv0) = ov;
        }
}
constexpr int N_PHASES = 14;
#ifndef MK_PER_PHASE
#define MK_PER_PHASE 0
#endif
#ifndef VAR_GEMM
#define VAR_GEMM 1
#endif
#ifndef VAR_A2
#define VAR_A2 1
#endif
#ifndef VAR_ATT
#define VAR_ATT 1
#endif
#ifndef VAR_RWKV
#define VAR_RWKV 1
#endif
#ifndef VAR_LRU
#define VAR_LRU 1
#endif

__device__ __forceinline__ void phase_b(ArgsP a, LAS unsigned char* lds, int layer) {
    volatile LAS unsigned* MISC = (volatile LAS unsigned*)(lds + LDS_MISC);
    unsigned* head = (unsigned*)(a->ws + WS_CTL) + CW_Q + layer * 64;
    for (;;) {
        __syncthreads();
        if (tid_() == 0) MISC[16] = atomicAdd(head, 1u);
        __syncthreads();
        const int idx = (int)MISC[16];
        if (idx >= 1408) break;
#ifdef PROBE_UNIT1
        const unsigned long long pt0_ = __builtin_amdgcn_s_memrealtime();
#endif
#ifdef PROBE_RW_MODE
        if (idx < 64) rwkv_unit_mfma<PROBE_RW_MODE>(a, lds, layer, idx); else if (idx >= 640 && idx < 896) rwkv_unit_mfma<PROBE_RW_MODE>(a, lds, layer, 64 + idx - 640);
        if (tid_() == 0 && layer == 0 && (idx < 64 || (idx >= 640 && idx < 896))) { const unsigned d_ = (unsigned)(__builtin_amdgcn_s_memrealtime() - pt0_); atomicMax((unsigned*)(a->ws + WS_CTL) + CW_Q + 1024 + (idx < 64 ? 6 : 7) * 64, d_); }
#endif
        if (idx < 64) rwkv_unit_mfma(a, lds, layer, idx);
        else if (idx < 128) lru_unit_q(a, lds, layer, idx - 64);
        else if (idx < 640) att_unit2(a, lds, idx - 128);
        else if (idx < 896) rwkv_unit_mfma(a, lds, layer, 64 + idx - 640);
        else if (idx < 1152) lru_unit_q(a, lds, layer, 64 + idx - 896);
        else att_unit2(a, lds, 512 + idx - 1152);
#ifdef PROBE_UNIT1
        if (tid_() == 0 && layer == 0) { const unsigned d_ = (unsigned)(__builtin_amdgcn_s_memrealtime() - pt0_);
            const int ty_ = idx < 64 ? 0 : idx < 128 ? 1 : idx < 640 ? 2 : idx < 896 ? 3 : idx < 1152 ? 4 : 5;
            atomicMax((unsigned*)(a->ws + WS_CTL) + CW_Q + 1024 + ty_ * 64, d_); }
#endif
    }
}

#if MK_PER_PHASE
template <int SUB> __global__ void __launch_bounds__(NTHREADS, 2) mk_phase(Args args, int layer) {
    extern __shared__ __attribute__((aligned(16))) unsigned char lds_raw[];
    LAS unsigned char* lds = (LAS unsigned char*)lds_raw;
    ArgsP a = (ArgsP)__builtin_amdgcn_kernarg_segment_ptr();
    if (SUB == 0) phase_p0(a, lds);
    if (SUB == 1) phase_a0(a, layer);
    if (SUB == 2) { if (VAR_GEMM) phase_a1_pg8(a, lds, layer); else phase_a1_naive(a, layer); }
    if (SUB == 3) { if (VAR_A2) { for (int u = blockIdx.x; u < T / 64 + 32; u += gridDim.x) a2_unit(a, lds, layer, u); } else phase_a2_naive(a, lds, layer); }
    if (SUB == 4) { if (VAR_ATT) { for (int u = blockIdx.x; u < 768; u += gridDim.x) att_unit(a, lds, u); } else phase_att_naive(a); }
    if (SUB == 5) { for (int u = blockIdx.x; u < 320; u += gridDim.x) { __syncthreads(); if (VAR_RWKV) rwkv_unit_mfma(a, lds, layer, u); else rwkv_unit_seq(a, lds, layer, u); } }
    if (SUB == 6) { for (int u = blockIdx.x; u < 160; u += gridDim.x) { __syncthreads(); if (VAR_LRU) lru_unit_mfma(a, lds, layer, u); else lru_unit_seq(a, lds, layer, u); } }
    if (SUB == 7) phase_c1(a, layer);
    if (SUB == 8) { if (VAR_GEMM) phase_c2_pg8(a, lds, layer); else phase_c2_naive(a, layer); }
    if (SUB == 9) phase_final(a);
}
#else
#define ARGS_VIEW() ({ ArgsP p_ = (ArgsP)__builtin_amdgcn_kernarg_segment_ptr(); asm volatile("" : "+s"(p_)); p_; })
__global__ void __launch_bounds__(NTHREADS, 2) mk_fwd(Args args) {
    extern __shared__ __attribute__((aligned(16))) unsigned char lds_raw[];
    LAS unsigned char* lds = (LAS unsigned char*)lds_raw;
    volatile LAS unsigned* MISC = (volatile LAS unsigned*)(lds + LDS_MISC);
    for (int u = threadIdx.x; u < 64; u += NTHREADS) MISC[u] = 0u;
    __syncthreads();
    XcdBarrier bar;
    { ArgsP a = ARGS_VIEW(); bar = xcd_barrier_post((unsigned*)(a->ws + WS_CTL) + CW_BAR, MISC + 8); }
    int lo, hi; { ArgsP a = ARGS_VIEW(); lo = a->ph_lo; hi = a->ph_hi; }
#define IN(k) (lo <= (k) && (k) < hi)
#ifdef PROBE_MASK1
#define STAMP(k) do { if (bid_() == 0 && tid_() == 0) { const unsigned long long t_ = __builtin_amdgcn_s_memrealtime(); MISC[32 + 2 * (k)] = (unsigned)t_; MISC[33 + 2 * (k)] = (unsigned)(t_ >> 32); } } while (0)
#else
#define STAMP(k) do { } while (0)
#endif
#define SEAM(k) do { if (IN(k) && IN((k) + 1)) xcd_barrier(bar); STAMP((k) + 1); } while (0)
#ifndef NO_P0
    STAMP(0);
    if (IN(0)) { ArgsP a = ARGS_VIEW(); phase_p0(a, lds); }
#endif
    SEAM(0);
    for (int layer = 0; layer < 2; ++layer) {
        const int p = 1 + 6 * layer;
#ifndef NO_A0
        if (IN(p + 0)) { { ArgsP a = ARGS_VIEW(); phase_a0(a, layer); } if (layer == 0) { ArgsP a = ARGS_VIEW(); phase_p0_weights(a, lds); } }
#endif
        SEAM(p + 0);
#ifndef NO_A1
        if (IN(p + 1)) { ArgsP a = ARGS_VIEW(); phase_a1_pg8(a, lds, layer); }
#endif
        SEAM(p + 1);
#ifndef NO_A2
        if (IN(p + 2)) { { ArgsP a = ARGS_VIEW(); phase_a2a(a, layer); } xcd_barrier(bar); { ArgsP a = ARGS_VIEW(); phase_a2b(a, lds, layer); } }
        if (0) { ArgsP a = ARGS_VIEW(); for (int u = bid_(); u < T / 64 + 32; u += grid_()) {
#ifdef PROBE_UNIT1
            const unsigned long long pt0_ = __builtin_amdgcn_s_memrealtime();
#endif
            a2_unit(a, lds, layer, u);
#ifdef PROBE_A2_TWICE
            a2_unit(a, lds, layer, u);
#endif
#ifdef PROBE_UNIT1
            __syncthreads();
            if (tid_() == 0 && layer == 0) atomicMax((unsigned*)(a->ws + WS_CTL) + CW_Q + 1024 + (u < 256 ? 6 : 7) * 64, (unsigned)(__builtin_amdgcn_s_memrealtime() - pt0_));
#endif
        } }
#endif
        SEAM(p + 2);
#ifndef NO_B
        if (IN(p + 3)) { ArgsP a = ARGS_VIEW(); phase_b(a, lds, layer); }
#endif
        SEAM(p + 3);
#ifndef NO_C1
        if (IN(p + 4)) { ArgsP a = ARGS_VIEW(); phase_c1(a, layer); }
#endif
        SEAM(p + 4);
#ifndef NO_C2
        if (IN(p + 5)) { ArgsP a = ARGS_VIEW(); phase_c2_pg8(a, lds, layer); }
#endif
        SEAM(p + 5);
    }
    if (IN(N_PHASES - 1)) { ArgsP a = ARGS_VIEW(); phase_final(a); }
#ifdef PROBE_MASK1
    STAMP(14);
    __syncthreads();
    if (bid_() == 0) {
        ArgsP a = ARGS_VIEW();
        float t1 = 0.f, t2 = 0.f;
        for (int k = 0; k < 14; ++k) { const unsigned long long s0 = ((unsigned long long)MISC[33 + 2 * k] << 32) | MISC[32 + 2 * k], s1 = ((unsigned long long)MISC[35 + 2 * k] << 32) | MISC[34 + 2 * k];
            const float us = (float)(s1 - s0) * 0.01f; if ((PROBE_MASK1 >> k) & 1) t1 += us; if ((PROBE_MASK2 >> k) & 1) t2 += us; }
#ifdef PROBE_UNIT1
        t1 = (float)((unsigned*)(a->ws + WS_CTL))[CW_Q + 1024 + PROBE_UNIT1 * 64] * 0.01f; t2 = (float)((unsigned*)(a->ws + WS_CTL))[CW_Q + 1024 + PROBE_UNIT2 * 64] * 0.01f;
#endif
        for (int i = tid_(); i < 32768; i += NTHREADS) a->out[O_LRU + i] *= (1.f + t2 * (1.f / 2000.f));
        if (tid_() == 0) a->out[0] += 2.f + t1 * 0.01f;
    }
#endif
#undef IN
#undef SEAM
}

#endif

extern "C" void kernel_launch(void* const* d_in, const int* in_sizes, int n_in, void* d_out, int out_size, void* d_ws, size_t ws_size, hipStream_t stream) {
    static int grid = 0;
    if (grid == 0) {
        if (n_in != N_IN || ws_size < WS_END) { fprintf(stderr, "kernel_launch: unexpected n_in %d / ws_size %zu\n", n_in, ws_size); grid = -1; return; }
        int dev = 0, cus = 0;
        if (hipGetDevice(&dev) != hipSuccess || hipDeviceGetAttribute(&cus, hipDeviceAttributeMultiprocessorCount, dev) != hipSuccess) { grid = -1; return; }
#if MK_PER_PHASE
#define SA(SUB) if (hipFuncSetAttribute((const void*)mk_phase<SUB>, hipFuncAttributeMaxDynamicSharedMemorySize, LDS_BYTES) != hipSuccess) { fprintf(stderr, "kernel_launch: hipFuncSetAttribute failed\n"); grid = -1; return; }
        SA(0) SA(1) SA(2) SA(3) SA(4) SA(5) SA(6) SA(7) SA(8) SA(9)
#undef SA
#else
        if (hipFuncSetAttribute((const void*)mk_fwd, hipFuncAttributeMaxDynamicSharedMemorySize, LDS_BYTES) != hipSuccess) { fprintf(stderr, "kernel_launch: hipFuncSetAttribute failed\n"); grid = -1; return; }
        int per_cu = 0;
        if (hipOccupancyMaxActiveBlocksPerMultiprocessor(&per_cu, (const void*)mk_fwd, NTHREADS, LDS_BYTES) != hipSuccess || per_cu < 1) fprintf(stderr, "kernel_launch: occupancy query reports %d\n", per_cu);
        (void)hipGetLastError();
#endif
        grid = cus;
    }
    if (grid < 0) return;
    if (hipMemsetAsync((char*)d_ws + WS_CTL, 0, CTL_ZERO_BYTES, stream) != hipSuccess) return;
    Args a{};
    for (int i = 0; i < N_IN; ++i) a.in[i] = (const float*)d_in[i];
    a.out = (float*)d_out; a.ws = (unsigned char*)d_ws;
#if MK_PER_PHASE
#define LP(SUB, layer) hipLaunchKernelGGL(mk_phase<SUB>, dim3(grid), dim3(NTHREADS), LDS_BYTES, stream, a, layer)
    LP(0, 0);
    for (int layer = 0; layer < 2; ++layer) { LP(1, layer); LP(2, layer); LP(3, layer); LP(4, layer); LP(5, layer); LP(6, layer); LP(7, layer); LP(8, layer); }
    LP(9, 0);
#undef LP
#else
    a.ph_lo = 0; a.ph_hi = N_PHASES;
    hipLaunchKernelGGL(mk_fwd, dim3(grid), dim3(NTHREADS), LDS_BYTES, stream, a);
#endif
}
```

```cpp
#include <hip/hip_runtime.h>
#include <cstdio>
#include <cstdint>

#define GAS __attribute__((address_space(1)))
#define LAS __attribute__((address_space(3)))
typedef unsigned short bf16;
typedef unsigned v4u __attribute__((ext_vector_type(4)));
typedef unsigned v2u __attribute__((ext_vector_type(2)));
typedef float f32x4 __attribute__((ext_vector_type(4)));
typedef short bf16x8 __attribute__((ext_vector_type(8)));

constexpr int D = 1024, T_CTX = 8192, T_LAT = 16384, T = 24576, L_CTX = 256, L_LAT = 2048, PAST = 256;
constexpr int NIN = 2816, G1W = 2304, G2W = 512;
constexpr int C_R = 0, C_K = 256, C_V = 512, C_G = 768, C_GM = 1024, C_XL = 1536, C_GL = 1792, C_LORA = 2048;
constexpr int LK_LAT = PAST + L_LAT;
constexpr int TK = T_CTX + 8 * LK_LAT;
constexpr int VT_LAT = 32 * 8 * 64 * 256;
constexpr float LN_EPS = 1e-5f, GN_EPS = 64e-5f;
constexpr float ALPHA = 1.4142135623730951f;
constexpr float QSCALE = 0.10206207261596575f * 1.4426950408889634f;
constexpr size_t O_Y = 0, O_RW = 25165824, O_CKV = 27262976, O_KR = 29360128, O_LRU = 29884416;
constexpr size_t MiB = 1u << 20;
constexpr size_t WS_CTL = 0, CTL_ZERO_BYTES = 1 * MiB;
constexpr size_t WS_MOD = 256 * 1024;
constexpr size_t WS_ROPE = 1 * MiB;
constexpr size_t WS_LORA2 = 1280 * 1024;
constexpr size_t WS_LRUW = 2816 * 1024;
constexpr size_t WS_STATS = 1536 * 1024;
constexpr size_t WS_WUQ = 2 * MiB;
constexpr size_t WS_WUKV = 3 * MiB;
constexpr size_t WS_WIN = 4 * MiB;
constexpr size_t WS_WOUT = 16 * MiB;
constexpr size_t WS_G1 = 20 * MiB;
constexpr size_t WS_G2 = 128 * MiB;
constexpr size_t WS_Q = 152 * MiB;
constexpr size_t WS_U = 152 * MiB;
constexpr size_t WS_KN = 188 * MiB;
constexpr size_t WS_KR = 214 * MiB;
constexpr size_t WS_VT = 216 * MiB;
constexpr size_t WS_YMIX = 188 * MiB;
constexpr size_t WS_HF = 242 * MiB;
constexpr size_t WS_END = 254 * MiB;
constexpr int CW_BAR = 4096;
constexpr int CW_Q = 16384;

__device__ __forceinline__ float bf2f(unsigned b) { return __uint_as_float(b << 16); }
__device__ __forceinline__ float bflo(unsigned w) { return __uint_as_float(w << 16); }
__device__ __forceinline__ float bfhi(unsigned w) { return __uint_as_float(w & 0xffff0000u); }
__device__ __forceinline__ unsigned f2bf(float f) { unsigned u = __float_as_uint(f); return (u + 0x7fffu + ((u >> 16) & 1u)) >> 16; }
__device__ __forceinline__ unsigned pk2(float lo, float hi) { return f2bf(lo) | (f2bf(hi) << 16); }
__device__ __forceinline__ float rcp_(float x) { return __builtin_amdgcn_rcpf(x); }
__device__ __forceinline__ float exp_(float x) { return __builtin_amdgcn_exp2f(x * 1.4426950408889634f); }
__device__ __forceinline__ float sqrt_(float x) { return __builtin_amdgcn_sqrtf(x); }
__device__ __forceinline__ float rsqrt_(float x) { return __builtin_amdgcn_rsqf(x); }
__device__ __forceinline__ float sigmoidf_(float x) { return rcp_(1.f + exp_(-x)); }
__device__ __forceinline__ float siluf_(float x) { return x * rcp_(1.f + exp_(-x)); }
template <int CTRL> __device__ __forceinline__ float dpp_f(float old, float x) { return __builtin_bit_cast(float, __builtin_amdgcn_update_dpp(__builtin_bit_cast(int, old), __builtin_bit_cast(int, x), CTRL, 0xf, 0xf, false)); }
__device__ __forceinline__ float row16_sum(float x) { x += dpp_f<0x128>(0.f, x); x += dpp_f<0x124>(0.f, x); x += dpp_f<0x122>(0.f, x); x += dpp_f<0x121>(0.f, x); return x; }
__device__ __forceinline__ float wave_sum_fast(float x) { x = row16_sum(x); x += __shfl_xor(x, 16); x += __shfl_xor(x, 32); return x; }
__device__ __forceinline__ float row16_prefix_prod(float x) { x *= dpp_f<0x111>(1.f, x); x *= dpp_f<0x112>(1.f, x); x *= dpp_f<0x114>(1.f, x); x *= dpp_f<0x118>(1.f, x); return x; }
__device__ __forceinline__ float wave_sum(float v) { return wave_sum_fast(v); }
__device__ __forceinline__ int tid_() { int t = threadIdx.x; asm volatile("" : "+v"(t)); return t; }
__device__ __forceinline__ int bid_() { int b = blockIdx.x; asm volatile("" : "+s"(b)); return b; }
__device__ __forceinline__ int grid_() { int g = gridDim.x; asm volatile("" : "+s"(g)); return g; }
typedef float f32x16 __attribute__((ext_vector_type(16)));
typedef float f32x2_t __attribute__((ext_vector_type(2)));
typedef __bf16 bf16x2_t __attribute__((ext_vector_type(2)));
__device__ __forceinline__ unsigned cvtpk(float lo, float hi) { const f32x2_t v = {lo, hi}; return __builtin_bit_cast(unsigned, __builtin_convertvector(v, bf16x2_t)); }
#define XB_TMO      128
#define XB_XCNT(j)  (256  + 64 * (j))
#define XB_XSUB(j)  (1280 + 64 * (j))
#define XB_XGEN(j)  (2304 + 64 * (j))
#define XB_TOP      3328
#define XB_TOPGEN   3392
#define XCD_BAR_WORDS 3456
#define XB_SPIN_CAP (1u << 24)

__device__ __forceinline__ unsigned xb_ld(unsigned* p)              { return __hip_atomic_load(p, __ATOMIC_RELAXED, __HIP_MEMORY_SCOPE_AGENT); }
__device__ __forceinline__ unsigned xb_add(unsigned* p, unsigned v) { return __hip_atomic_fetch_add(p, v, __ATOMIC_RELAXED, __HIP_MEMORY_SCOPE_AGENT); }
__device__ __forceinline__ unsigned xb_xcc_id() { return (unsigned)__builtin_amdgcn_s_getreg((3 << 11) | 20) & 0xFu; }
#define XB_SPIN(cond, bar) do { unsigned _sp = 0; while (cond) { __builtin_amdgcn_s_sleep(1); \
    if ((++_sp & 255u) == 0u) { if (xb_ld(&(bar)[XB_TMO])) break; if (_sp > XB_SPIN_CAP) { atomicAdd(&(bar)[XB_TMO], 1u); break; } } } } while (0)

struct XcdBarrier {
    unsigned* bar; unsigned x;
    volatile LAS unsigned* st;
};

__device__ __forceinline__ XcdBarrier xcd_barrier_post(unsigned* bar, volatile LAS unsigned* st) {
    XcdBarrier b; b.bar = bar; b.x = xb_xcc_id(); b.st = st;
    if (threadIdx.x == 0) (void)xb_add(&bar[XB_XCNT(b.x)], 1u);
    return b;
}
__device__ __forceinline__ void xcd_barrier_complete(unsigned* bar, unsigned x, unsigned& nloc, unsigned& nx) {
    const unsigned G = gridDim.x * gridDim.y * gridDim.z;
    unsigned sum, cnt, mine, sp = 0u;
    for (;;) {
        sum = 0u; cnt = 0u; mine = 0u;
#pragma unroll
        for (unsigned j = 0; j < 16; ++j) { const unsigned c = xb_ld(&bar[XB_XCNT(j)]); sum += c; cnt += (c > 0u) ? 1u : 0u; mine = (j == x) ? c : mine; }
        if (sum == G) break;
        __builtin_amdgcn_s_sleep(1);
        if ((++sp & 255u) == 0u) { if (xb_ld(&bar[XB_TMO])) break; if (sp > XB_SPIN_CAP) { atomicAdd(&bar[XB_TMO], 1u); break; } }
    }
    nloc = mine > 0u ? mine : 1u; nx = cnt > 0u ? cnt : 1u;
}

__device__ __forceinline__ void xcd_barrier(const XcdBarrier& b) {
    asm volatile("s_waitcnt vmcnt(0)" ::: "memory");
    __syncthreads();
    if (threadIdx.x == 0) {
        unsigned* bar = b.bar;
        __builtin_amdgcn_s_waitcnt(0);
        unsigned nloc = b.st[0], nx = b.st[1];
        if (nloc == 0u) { xcd_barrier_complete(bar, b.x, nloc, nx); b.st[0] = nloc; b.st[1] = nx; }
        const unsigned old = xb_add(&bar[XB_XSUB(b.x)], 1u);
        const unsigned gen = old / nloc;
        if (old + 1u == (gen + 1u) * nloc) {
            __builtin_amdgcn_fence(__ATOMIC_RELEASE, "agent");
            asm volatile("s_waitcnt vmcnt(0)" ::: "memory");
            const unsigned og = xb_add(&bar[XB_TOP], 1u);
            const unsigned tg = og / nx;
            if (og + 1u == (tg + 1u) * nx) xb_add(&bar[XB_TOPGEN], 1u);
            else XB_SPIN(xb_ld(&bar[XB_TOPGEN]) == tg, bar);
            __builtin_amdgcn_fence(__ATOMIC_ACQUIRE, "agent");
            xb_add(&bar[XB_XGEN(b.x)], 1u);
            asm volatile("s_waitcnt vmcnt(0)" ::: "memory");
        } else {
            XB_SPIN(xb_ld(&bar[XB_XGEN(b.x)]) == gen, bar);
            __builtin_amdgcn_fence(__ATOMIC_ACQUIRE, "agent");
            asm volatile("s_waitcnt vmcnt(0)" ::: "memory");
        }
    }
    __syncthreads();
}
enum { I_XP = 0, I_XS, I_SRW, I_CCKV, I_CKR, I_SLRU, I_C, I_CCTX, I_WMOD, I_BMOD, I_WIN, I_W0, I_W1, I_W2, I_A0, I_A1, I_A2, I_KK, I_KA, I_RK,
       I_LNXG, I_LNXB, I_QNORM, I_WUQ, I_KVNORM, I_WUKV, I_CONVW, I_CONVB, I_WA, I_BA, I_WX, I_BX, I_LAMBDA, I_WOUT, I_LNG, I_LNB, N_IN };
struct Args { const float* in[N_IN]; float* out; unsigned char* ws; int ph_lo, ph_hi; };
typedef const Args __attribute__((address_space(4)))* ArgsP;
constexpr int NTHREADS = 512;
constexpr int LDS_MISC = 139264;
constexpr int LDS_BYTES = 147456;

struct Tok { int n, b, t, L, lat, modrow, tok0, kidx; };
__device__ __forceinline__ Tok tok_of(int n) {
    Tok k; k.n = n;
    if (n < T_CTX) { k.lat = 0; k.b = n >> 8; k.t = n & 255; k.L = L_CTX; k.modrow = 0; k.tok0 = k.b * 256; k.kidx = n; }
    else { const int m = n - T_CTX; k.lat = 1; k.b = m >> 11; k.t = m & 2047; k.L = L_LAT; k.modrow = 1 + k.b; k.tok0 = T_CTX + k.b * 2048; k.kidx = T_CTX + k.b * LK_LAT + PAST + k.t; }
    return k;
}
__device__ __forceinline__ const float* xrow_src(ArgsP a, int layer, int n) {
    if (layer == 0) return n < T_CTX ? a->in[I_XP] + (size_t)n * D : a->in[I_XS] + (size_t)(n - T_CTX) * D;
    return a->out + (size_t)n * D;
}
__device__ __forceinline__ float dot8(v4u a, v4u b, float acc) {
    acc = fmaf(bflo(a.x), bflo(b.x), acc); acc = fmaf(bfhi(a.x), bfhi(b.x), acc);
    acc = fmaf(bflo(a.y), bflo(b.y), acc); acc = fmaf(bfhi(a.y), bfhi(b.y), acc);
    acc = fmaf(bflo(a.z), bflo(b.z), acc); acc = fmaf(bfhi(a.z), bfhi(b.z), acc);
    acc = fmaf(bflo(a.w), bflo(b.w), acc); acc = fmaf(bfhi(a.w), bfhi(b.w), acc);
    return acc;
}

__device__ __forceinline__ void tr_item(const float* src, int ld, int col0, int k0, bf16* WT, int K, int row0, float scale, LAS float* scr, int lane) {
    {
        const int kr = lane >> 3, n4 = (lane & 7) * 4;
        f32x4 v[8];
#pragma unroll
        for (int i = 0; i < 8; ++i) v[i] = src ? *(const f32x4*)(src + (size_t)(k0 + i * 8 + kr) * ld + col0 + n4) : (f32x4){0.f, 0.f, 0.f, 0.f};
#pragma unroll
        for (int i = 0; i < 8; ++i) { LAS float* d = scr + (i * 8 + kr) * 33 + n4; d[0] = v[i].x * scale; d[1] = v[i].y * scale; d[2] = v[i].z * scale; d[3] = v[i].w * scale; }
    }
    asm volatile("s_waitcnt lgkmcnt(0)" ::: "memory");
    const int c = lane & 7;
#pragma unroll
    for (int j = 0; j < 4; ++j) { const int n = (lane >> 3) + 8 * j; const LAS float* s = scr + (8 * c) * 33 + n;
        v4u o; o.x = pk2(s[0 * 33], s[1 * 33]); o.y = pk2(s[2 * 33], s[3 * 33]); o.z = pk2(s[4 * 33], s[5 * 33]); o.w = pk2(s[6 * 33], s[7 * 33]);
        *(v4u*)(WT + (size_t)(row0 + n) * K + k0 + 8 * c) = o; }
    asm volatile("s_waitcnt lgkmcnt(0)" ::: "memory");
}
__device__ __forceinline__ void rope_angle(int t, int i, float& c, float& s) {
    const int row = t >> 6, col = t & 63; const int ii = i & 7;
    const float inv = exp2f(-(float)ii * (13.287712379549449f / 8.f));
    const float ang = (float)(i < 8 ? row : col) * inv;
    c = cosf(ang); s = sinf(ang);
}
__device__ __forceinline__ void phase_p0_weights(ArgsP a, LAS unsigned char* lds) {
    const int tid = tid_(), lane = tid & 63, wave = tid >> 6, G = grid_();
    unsigned char* ws = a->ws;
    LAS float* scr = (LAS float*)(lds + wave * 8704);
    const int gw = bid_() * 8 + wave, NGW = G * 8;
    constexpr int N_WIN = 2 * 16 * 88, N_WOUT = 2 * 16 * 32, N_WUQ = 2 * 4 * 24, N_WUKV = 2 * 4 * 32, N_LORA = 2 * 2 * 2 * 8, N_LRUW = 2 * 2 * 2 * 4 * 2;
    for (int it = gw; it < N_WIN + N_WOUT + N_WUQ + N_WUKV + N_LORA + N_LRUW; it += NGW) {
        int r = it;
        if (r < N_WIN) {
            const int l = r / (16 * 88), kb = (r / 88) % 16, nb = r % 88, j0 = nb * 32;
            const float* src; int ld, col0;
            const float* win = a->in[I_WIN] + (size_t)l * 1024 * 2464;
            if (j0 < 1024) { src = win; ld = 2464; col0 = j0; }
            else if (j0 < 1536) { src = win; ld = 2464; col0 = 1440 + (j0 - 1024); }
            else if (j0 < 1792) { src = win; ld = 2464; col0 = 1952 + (j0 - 1536); }
            else if (j0 < 2048) { src = win; ld = 2464; col0 = 2208 + (j0 - 1792); }
            else if (j0 < 2304) { const int q = (j0 - 2048) >> 6; src = (q < 2 ? a->in[I_W1] : a->in[I_A1]) + (size_t)(l * 2 + (q & 1)) * 1024 * 64; ld = 64; col0 = (j0 - 2048) & 63; }
            else if (j0 < 2560) { src = win; ld = 2464; col0 = 1024 + (j0 - 2304); }
            else if (j0 < 2688) { src = win; ld = 2464; col0 = 1280 + (j0 - 2560); }
            else if (j0 < 2720) { src = win; ld = 2464; col0 = 1408 + (j0 - 2688); }
            else { src = nullptr; ld = 0; col0 = 0; }
            tr_item(src, ld, col0, kb * 64, (bf16*)(ws + WS_WIN) + (size_t)l * NIN * 1024, 1024, j0, 1.f, scr, lane);
            continue;
        }
        r -= N_WIN;
        if (r < N_WOUT) { const int l = r / (16 * 32), kb = (r / 32) % 16, nb = r % 32;
            tr_item(a->in[I_WOUT] + (size_t)l * 1024 * 1024, 1024, nb * 32, kb * 64, (bf16*)(ws + WS_WOUT) + (size_t)l * 1024 * 1024, 1024, nb * 32, 1.f, scr, lane); continue; }
        r -= N_WOUT;
        if (r < N_WUQ) { const int l = r / (4 * 24), kb = (r / 24) % 4, nb = r % 24;
            tr_item(a->in[I_WUQ] + (size_t)l * 256 * 768, 768, nb * 32, kb * 64, (bf16*)(ws + WS_WUQ) + (size_t)l * 768 * 256, 256, nb * 32, QSCALE, scr, lane); continue; }
        r -= N_WUQ;
        if (r >= N_WUKV) { r -= N_WUKV;
            if (r < N_LORA) { const int le = r >> 4, m = (r >> 3) & 1, nb = r & 7;
                tr_item((m ? a->in[I_A2] : a->in[I_W2]) + (size_t)le * 64 * 256, 256, nb * 32, 0, (bf16*)(ws + WS_LORA2) + (size_t)(le * 2 + m) * 256 * 64, 64, nb * 32, 1.f, scr, lane); }
            else { r -= N_LORA; const int le = r >> 4, m = (r >> 3) & 1, g = (r >> 1) & 3, nb = r & 1;
                tr_item((m ? a->in[I_WX] : a->in[I_WA]) + (size_t)(le * 4 + g) * 4096, 64, nb * 32, 0, (bf16*)(ws + WS_LRUW) + (size_t)((le * 2 + m) * 4 + g) * 4096, 64, nb * 32, 1.f, scr, lane); }
            continue; }
        { const int l = r / (4 * 32), kb = (r / 32) % 4, nb = r % 32;
            tr_item(kb < 2 ? a->in[I_WUKV] + (size_t)l * 128 * 1024 : nullptr, 1024, nb * 32, kb * 64, (bf16*)(ws + WS_WUKV) + (size_t)l * 1024 * 256, 256, nb * 32, 1.f, scr, lane); }
    }
}
__device__ __forceinline__ void phase_p0(ArgsP a, LAS unsigned char* lds) {
    const int tid = tid_(), G = grid_();
    unsigned char* ws = a->ws;
    { float* ROPE = (float*)(ws + WS_ROPE);
      for (int i = bid_() * NTHREADS + tid; i < 2048 * 16; i += G * NTHREADS) { float c, s; rope_angle(i >> 4, i & 15, c, s); ROPE[i * 2] = c; ROPE[i * 2 + 1] = s; } }
    float* MOD = (float*)(ws + WS_MOD);
    LAS float* SIL = (LAS float*)lds;
    for (int it = bid_(); it < 2 * 6 * 32; it += G) {
        const int l = it / 192, nb = (it / 32) % 6, kq = it % 32, col = nb * 512 + tid;
        __syncthreads();
        if (tid < 288) { const int j = tid >> 5, k = kq * 32 + (tid & 31); const float cj = (j == 0) ? a->in[I_CCTX][k] : a->in[I_C][(j - 1) * 1024 + k]; SIL[tid] = siluf_(cj); }
        float w[32];
#pragma unroll
        for (int kk = 0; kk < 32; ++kk) w[kk] = a->in[I_WMOD][((size_t)l * 1024 + kq * 32 + kk) * 3072 + col];
        __syncthreads();
        const float bias = (kq == 0) ? a->in[I_BMOD][l * 3072 + col] : 0.f;
#pragma unroll
        for (int j = 0; j < 9; ++j) { float acc = bias;
#pragma unroll
            for (int k4 = 0; k4 < 8; ++k4) { const f32x4 sv = *(const LAS f32x4*)(SIL + j * 32 + k4 * 4); acc = fmaf(sv.x, w[k4 * 4], acc); acc = fmaf(sv.y, w[k4 * 4 + 1], acc); acc = fmaf(sv.z, w[k4 * 4 + 2], acc); acc = fmaf(sv.w, w[k4 * 4 + 3], acc); }
            atomicAdd(&MOD[(l * 9 + j) * 3072 + col], acc); }
    }
}

__device__ __forceinline__ void phase_a0(ArgsP a, int layer) {
    const int tid = tid_(), lane = tid & 63, wave = tid >> 6, G = grid_();
    const float* MOD = (const float*)(a->ws + WS_MOD);
    bf16* U = (bf16*)(a->ws + WS_U);
    f32x4 nx[4];
#define A0_LOAD(nn_) do { if (layer == 0) { const float* xr_ = xrow_src(a, 0, (nn_)); \
            _Pragma("unroll") for (int j = 0; j < 4; ++j) nx[j] = *(const f32x4*)(xr_ + lane * 4 + 256 * j); } \
        else { const bf16* zr_ = (const bf16*)a->out + (size_t)(nn_) * 2048; \
            _Pragma("unroll") for (int j = 0; j < 4; ++j) { const v2u w_ = *(const v2u*)(zr_ + lane * 4 + 256 * j); nx[j] = (f32x4){bflo(w_.x), bfhi(w_.x), bflo(w_.y), bfhi(w_.y)}; } } } while (0)
    { const int n0 = bid_() * 8 + wave; if (n0 < T) A0_LOAD(n0); }
    for (int n = bid_() * 8 + wave; n < T; n += G * 8) {
        const Tok tk = tok_of(n);
        f32x4 v[4]; float s = 0.f;
#pragma unroll
        for (int j = 0; j < 4; ++j) { v[j] = nx[j]; s += (v[j].x + v[j].y) + (v[j].z + v[j].w); }
        if (n + G * 8 < T) A0_LOAD(n + G * 8);
        float mean = wave_sum(s) * (1.f / D), s2 = 0.f;
#pragma unroll
        for (int j = 0; j < 4; ++j) { v[j] = v[j] - mean; s2 += (v[j].x * v[j].x + v[j].y * v[j].y) + (v[j].z * v[j].z + v[j].w * v[j].w); }
        float rstd = rsqrt_(wave_sum(s2) * (1.f / D) + LN_EPS);
        if (layer == 1) {
            s = 0.f;
#pragma unroll
            for (int j = 0; j < 4; ++j) { const f32x4 g = *(const f32x4*)(a->in[I_LNG] + lane * 4 + 256 * j), b = *(const f32x4*)(a->in[I_LNB] + lane * 4 + 256 * j);
                v[j] = v[j] * rstd * g + b; s += (v[j].x + v[j].y) + (v[j].z + v[j].w); }
            if (lane == 0) { float* st = (float*)(a->ws + WS_STATS) + (size_t)n * 2; st[0] = mean; st[1] = rstd; }
            mean = wave_sum(s) * (1.f / D); s2 = 0.f;
#pragma unroll
            for (int j = 0; j < 4; ++j) { v[j] = v[j] - mean; s2 += (v[j].x * v[j].x + v[j].y * v[j].y) + (v[j].z * v[j].z + v[j].w * v[j].w); }
            rstd = rsqrt_(wave_sum(s2) * (1.f / D) + LN_EPS);
        }
        const float* m = MOD + (size_t)(layer * 9 + tk.modrow) * 3072;
#pragma unroll
        for (int j = 0; j < 4; ++j) { const int c = lane * 4 + 256 * j; const f32x4 sh = *(const f32x4*)(m + c), sc = *(const f32x4*)(m + 1024 + c);
            const f32x4 o = v[j] * rstd * (sc + 1.f) + sh;
            v2u p; p.x = pk2(o.x, o.y); p.y = pk2(o.z, o.w); *(v2u*)(U + (size_t)n * D + c) = p; }
    }
}
__device__ __forceinline__ void phase_final(ArgsP a) {
    const int tid = tid_(), lane = tid & 63, wave = tid >> 6, G = grid_();
    f32x4 nx[4];
#define FN_LOAD(nn_) do { const bf16* zr_ = (const bf16*)a->out + (size_t)(nn_) * 2048; \
        _Pragma("unroll") for (int j = 0; j < 4; ++j) { const v2u w_ = *(const v2u*)(zr_ + lane * 4 + 256 * j); nx[j] = (f32x4){bflo(w_.x), bfhi(w_.x), bflo(w_.y), bfhi(w_.y)}; } } while (0)
    { const int n0 = bid_() * 8 + wave; if (n0 < T) FN_LOAD(n0); }
    for (int n = bid_() * 8 + wave; n < T; n += G * 8) {
        float* xr = a->out + (size_t)n * D;
        f32x4 v[4]; float s = 0.f;
#pragma unroll
        for (int j = 0; j < 4; ++j) { v[j] = nx[j]; s += (v[j].x + v[j].y) + (v[j].z + v[j].w); }
        if (n + G * 8 < T) FN_LOAD(n + G * 8);
        const float mean = wave_sum(s) * (1.f / D); float s2 = 0.f;
#pragma unroll
        for (int j = 0; j < 4; ++j) { v[j] = v[j] - mean; s2 += (v[j].x * v[j].x + v[j].y * v[j].y) + (v[j].z * v[j].z + v[j].w * v[j].w); }
        const float rstd = rsqrt_(wave_sum(s2) * (1.f / D) + LN_EPS);
#pragma unroll
        for (int j = 0; j < 4; ++j) { const f32x4 g = *(const f32x4*)(a->in[I_LNG] + 1024 + lane * 4 + 256 * j), b = *(const f32x4*)(a->in[I_LNB] + 1024 + lane * 4 + 256 * j);
            *(f32x4*)(xr + lane * 4 + 256 * j) = v[j] * rstd * g + b; }
    }
}


namespace pg8 {
#define PG8_LAS __attribute__((address_space(3)))
typedef unsigned short bf16_t;
typedef short bf16x8 __attribute__((ext_vector_type(8)));
typedef float f32x4 __attribute__((ext_vector_type(4)));
typedef unsigned u32x4 __attribute__((ext_vector_type(4)));
constexpr int BM = 256, BK = 64, HALF = 128, HTB = HALF * BK * 2  , STAGE_BYTES = 8 * HTB, NXCD = 8, WGM = 8;

__host__ __device__ __forceinline__ int lds_byte(int r, int c) { const int st = (r >> 4) * 2 + (c >> 5), rr = r & 15, cc = c & 31, ob = rr * 64 + cc * 2; return st * 1024 + (ob ^ (((ob >> 9) & 1) << 5)); }
__host__ __device__ __forceinline__ void stage_rc(int b, int& R, int& C) { const int st = b / 1024, sb = b % 1024, swz = sb ^ (((sb >> 9) & 1) << 5); R = (st >> 1) * 16 + swz / 64; C = (st & 1) * 32 + (swz % 64) / 2; }
__host__ __device__ __forceinline__ int perm32(int rho) { const int n = rho >> 4, i = rho & 15; return 8 * (i >> 2) + 4 * n + (i & 3); }

struct Unit { int pm, pn, gid; };
struct Gemm { const bf16_t* A; const bf16_t* Bt; int M, N, K, lda, ldb; };

struct StaticOrder {
    int nM, nN, nwg, G, c;
    __host__ __device__ void init(int M, int N, int G_, int c_) { nM = M / BM; nN = N / BM; nwg = nM * nN; G = G_; c = c_; }
    __host__ __device__ bool next(int i, Unit& u) const {
        const long L = (long)i * G + c; if (L >= nwg) return false;
        int wgid = (int)L; { const int q = nwg / NXCD, r = nwg % NXCD, xcd = wgid % NXCD, off = wgid / NXCD; wgid = (xcd < r ? xcd * (q + 1) : r * (q + 1) + (xcd - r) * q) + off; }
        const int nig = WGM * nN, gid = wgid / nig, fm = gid * WGM, gsz = (nM - fm) < WGM ? (nM - fm) : WGM;
        u.pm = fm + ((wgid % nig) % gsz); u.pn = (wgid % nig) / gsz; u.gid = 0; return true;
    }
    __device__ __forceinline__ const char* abase(const Gemm& g, const Unit& u) const { return (const char*)g.A + (size_t)u.pm * BM * g.lda * 2; }
    __device__ __forceinline__ const char* bbase(const Gemm& g, const Unit& u) const { return (const char*)g.Bt + (size_t)u.pn * BM * g.ldb * 2; }
    __device__ __forceinline__ void a_ready(const Unit&) const {}
    __device__ __forceinline__ void done(const Unit&) const {}
};
__device__ __forceinline__ unsigned cvt_pk_bf16(float lo, float hi) { unsigned r; asm volatile("v_cvt_pk_bf16_f32 %0, %1, %2" : "=v"(r) : "v"(lo), "v"(hi)); return r; }

template <class Epi, class Sched, bool STAMP = false>
__device__ __forceinline__ void gemm_phase(PG8_LAS unsigned char* lds, const Gemm g, const Sched& S, const Epi& E, unsigned long long* stamps) {
    const int tid = tid_(), wid = __builtin_amdgcn_readfirstlane(tid >> 6), lane = tid & 63, wr = wid >> 2, wc = wid & 3, fr = lane & 15, fq = lane >> 4;
    const int K = g.K, nt = K / BK;
    int ts_lo = 0, ts_hi = 0, nts = 0; const unsigned long long rt_entry = STAMP ? (unsigned long long)wall_clock64() : 0ull;
#define PG8_STAMP() do { if (STAMP && wid == 0 && nts < 64) { const unsigned long long _c = (unsigned long long)clock64(); \
        ts_lo = (lane == nts) ? (int)(unsigned)_c : ts_lo; ts_hi = (lane == nts) ? (int)(unsigned)(_c >> 32) : ts_hi; ++nts; } } while (0)
    PG8_STAMP();
    unsigned voffA[2], voffB[2];
#pragma unroll
    for (int i = 0; i < 2; ++i) { int R, C; stage_rc(tid * 16 + i * 8192, R, C); const int Rb = Epi::PERM ? ((R & ~31) + perm32(R & 31)) : R;
        voffA[i] = (unsigned)(R * g.lda + C) * 2u; voffB[i] = (unsigned)(Rb * g.ldb + C) * 2u; }
    const size_t kstep = (size_t)(BK * 2);
    const size_t hstepA = (size_t)HALF * g.lda * 2, hstepB = (size_t)HALF * g.ldb * 2;
    const unsigned ldsw = (unsigned)wid * 1024u;
    const int aoff = lds_byte(wr * 64 + fr, fq * 8), boff = lds_byte(wc * 32 + fr, fq * 8);
#define PG8_SA(b, h) (((b) * 2 + (h)) * HTB)
#define PG8_SB(b, h) ((4 + (b) * 2 + (h)) * HTB)
#define PG8_STAGE(bufoff, gbase, voff) do { _Pragma("unroll") for (int _i = 0; _i < 2; ++_i) \
        __builtin_amdgcn_global_load_lds((const unsigned*)((const char*)(gbase) + (voff)[_i]), (PG8_LAS unsigned*)(lds + (bufoff) + ldsw + _i * 8192), 16, 0, 0); } while (0)
#define PG8_LDA(dst, b, h) do { _Pragma("unroll") for (int m = 0; m < 4; ++m) _Pragma("unroll") for (int k = 0; k < 2; ++k) dst[m][k] = *(const PG8_LAS bf16x8*)(lds + PG8_SA(b, h) + aoff + m * 2048 + k * 1024); } while (0)
#define PG8_LDB(dst, b, h) do { _Pragma("unroll") for (int n = 0; n < 2; ++n) _Pragma("unroll") for (int k = 0; k < 2; ++k) dst[n][k] = *(const PG8_LAS bf16x8*)(lds + PG8_SB(b, h) + boff + n * 2048 + k * 1024); } while (0)
#define PG8_MMA(ai, bj, At, Bt) do { __builtin_amdgcn_s_setprio(1); _Pragma("unroll") for (int m = 0; m < 4; ++m) _Pragma("unroll") for (int n = 0; n < 2; ++n) _Pragma("unroll") for (int k = 0; k < 2; ++k) \
        acc[ai][bj][m][n] = __builtin_amdgcn_mfma_f32_16x16x32_bf16(Bt[n][k], At[m][k], acc[ai][bj][m][n], 0, 0, 0); __builtin_amdgcn_s_setprio(0); } while (0)
#define PG8_WAIT_V(n) asm volatile("s_waitcnt vmcnt(" #n ")" ::: "memory")
#define PG8_WAIT_L(n) asm volatile("s_waitcnt lgkmcnt(" #n ")" ::: "memory")
#define PG8_BAR __builtin_amdgcn_s_barrier()
#define PG8_SCHED __builtin_amdgcn_sched_barrier(0)
    Unit cur, nxt; int ui = 0;
    if (!S.next(0, cur)) return;
    f32x4 acc[2][2][4][2];
#pragma unroll
    for (int a = 0; a < 2; ++a)
#pragma unroll
        for (int b = 0; b < 2; ++b)
#pragma unroll
            for (int m = 0; m < 4; ++m)
#pragma unroll
                for (int n = 0; n < 2; ++n) acc[a][b][m][n] = (f32x4){0.f, 0.f, 0.f, 0.f};
    bf16x8 At[4][2], B0[2][2], B1[2][2];
    const char* cA = S.abase(g, cur); const char* cB = S.bbase(g, cur);
    S.a_ready(cur);
    PG8_STAGE(PG8_SB(0, 0), cB, voffB); PG8_STAGE(PG8_SA(0, 0), cA, voffA); PG8_STAGE(PG8_SB(0, 1), cB + hstepB, voffB); PG8_STAGE(PG8_SA(0, 1), cA + hstepA, voffA);
    if (wr == 1) PG8_BAR;
    PG8_WAIT_V(4); PG8_BAR;
    PG8_STAGE(PG8_SB(1, 0), cB + kstep, voffB); PG8_STAGE(PG8_SA(1, 0), cA + kstep, voffA); PG8_STAGE(PG8_SB(1, 1), cB + hstepB + kstep, voffB);
    PG8_WAIT_V(6); PG8_BAR;
    PG8_STAMP();
    for (;;) {
        const bool has_next = S.next(ui + 1, nxt);
        const char* nA = has_next ? S.abase(g, nxt) : cA; const char* nB = has_next ? S.bbase(g, nxt) : cB;
        for (int t = 0; t < nt; t += 2) {
            const bool last = (t == nt - 2);
            const char* a1 = cA + (size_t)(t + 1) * kstep;
            const char* a2 = last ? nA : cA + (size_t)(t + 2) * kstep; const char* b2 = last ? nB : cB + (size_t)(t + 2) * kstep;
            const char* a3 = a2 + kstep; const char* b3 = b2 + kstep;
            if (last && has_next) S.a_ready(nxt);
            PG8_LDB(B0, 0, 0); PG8_SCHED; PG8_LDA(At, 0, 0); PG8_STAGE(PG8_SA(1, 1), a1 + hstepA, voffA);
            PG8_WAIT_L(8); PG8_BAR; PG8_WAIT_L(0); PG8_MMA(0, 0, At, B0); PG8_BAR; PG8_SCHED;
            PG8_LDB(B1, 0, 1); PG8_STAGE(PG8_SB(0, 0), b2, voffB);
            PG8_BAR; PG8_WAIT_L(0); PG8_MMA(0, 1, At, B1); PG8_BAR;
            PG8_LDA(At, 0, 1); PG8_STAGE(PG8_SA(0, 0), a2, voffA);
            PG8_BAR; PG8_WAIT_L(0); PG8_MMA(1, 0, At, B0); PG8_BAR; PG8_SCHED;
            PG8_STAGE(PG8_SB(0, 1), b2 + hstepB, voffB);
            PG8_WAIT_V(6); PG8_BAR; PG8_MMA(1, 1, At, B1); PG8_BAR;
            PG8_LDB(B0, 1, 0); PG8_SCHED; PG8_LDA(At, 1, 0); PG8_STAGE(PG8_SA(0, 1), a2 + hstepA, voffA);
            PG8_WAIT_L(8); PG8_BAR; PG8_WAIT_L(0); PG8_MMA(0, 0, At, B0); PG8_BAR; PG8_SCHED;
            PG8_LDB(B1, 1, 1); PG8_STAGE(PG8_SB(1, 0), b3, voffB);
            PG8_BAR; PG8_WAIT_L(0); PG8_MMA(0, 1, At, B1); PG8_BAR;
            PG8_LDA(At, 1, 1); PG8_STAGE(PG8_SA(1, 0), a3, voffA);
            PG8_BAR; PG8_WAIT_L(0); PG8_MMA(1, 0, At, B0); PG8_BAR; PG8_SCHED;
            PG8_STAGE(PG8_SB(1, 1), b3 + hstepB, voffB);
            PG8_WAIT_V(6); PG8_BAR; PG8_MMA(1, 1, At, B1); PG8_BAR;
        }
        PG8_STAMP();
        if constexpr (!Epi::AFTER_DRAIN) { E(acc, cur, wr, wc, fr, fq); S.done(cur); }
        PG8_STAMP();
        if (!has_next) break;
#pragma unroll
        for (int a = 0; a < 2; ++a)
#pragma unroll
            for (int b = 0; b < 2; ++b)
#pragma unroll
                for (int m = 0; m < 4; ++m)
#pragma unroll
                    for (int n = 0; n < 2; ++n) acc[a][b][m][n] = (f32x4){0.f, 0.f, 0.f, 0.f};
        cur = nxt; cA = nA; cB = nB; ++ui;
    }
    PG8_WAIT_V(0);
    if (wr == 0) PG8_BAR;
    PG8_BAR;
    if constexpr (Epi::AFTER_DRAIN) { E.fused(acc, cur, wr, wc, fr, fq, lds, wid, lane); S.done(cur); }
    PG8_STAMP();
    if (STAMP && wid == 0) { stamps[lane] = lane < nts ? (((unsigned long long)(unsigned)ts_hi << 32) | (unsigned)ts_lo) : 0ull;
        if (lane == 62) stamps[62] = rt_entry; if (lane == 63) stamps[63] = (unsigned long long)wall_clock64(); }
#undef PG8_STAMP
#undef PG8_SA
#undef PG8_SB
#undef PG8_STAGE
#undef PG8_LDA
#undef PG8_LDB
#undef PG8_MMA
#undef PG8_WAIT_V
#undef PG8_WAIT_L
#undef PG8_BAR
#undef PG8_SCHED
}
}
namespace pg8 {
struct EpiIn {
    static constexpr bool PERM = true, AFTER_DRAIN = false;
    bf16_t* G1; bf16_t* G2;
    __device__ __forceinline__ void operator()(const f32x4 (&acc)[2][2][4][2], const Unit& u, int wr, int wc, int fr, int fq) const {
        const int row0 = u.pm * BM + wr * 64 + fr;
        bf16_t* base; int ldc, colt;
        if (u.pn < 9) { base = G1; ldc = 2304; colt = u.pn * 256; } else { base = G2; ldc = 512; colt = (u.pn - 9) * 256; }
        const int col0 = colt + wc * 32 + 8 * fq;
#pragma unroll
        for (int ai = 0; ai < 2; ++ai)
#pragma unroll
            for (int m = 0; m < 4; ++m) { bf16_t* rowp = base + (size_t)(row0 + ai * HALF + m * 16) * ldc + col0;
#pragma unroll
                for (int bj = 0; bj < 2; ++bj) { const f32x4 v0 = acc[ai][bj][m][0], v1 = acc[ai][bj][m][1];
                    u32x4 w; w.x = cvt_pk_bf16(v0[0], v0[1]); w.y = cvt_pk_bf16(v0[2], v0[3]); w.z = cvt_pk_bf16(v1[0], v1[1]); w.w = cvt_pk_bf16(v1[2], v1[3]);
                    *(u32x4*)(rowp + bj * HALF) = w; } }
    }
};
struct EpiOut {
    static constexpr bool PERM = true, AFTER_DRAIN = false;
    const float* xp; const float* xs; float* out; const float* mod; int layer;
    const float* stats; const float* lng; const float* lnb;
    __device__ __forceinline__ void operator()(const f32x4 (&acc)[2][2][4][2], const Unit& u, int wr, int wc, int fr, int fq) const {
        const int row0 = u.pm * BM + wr * 64 + fr, col0 = u.pn * BM + wc * 32 + 8 * fq;
        const int rt = u.pm * BM; const int modrow = rt < 8192 ? 0 : 1 + ((rt - 8192) >> 11);
        const float* gp = mod + (size_t)modrow * 3072 + 2048 + col0;
        f32x4 gv[2][2];
#pragma unroll
        for (int bj = 0; bj < 2; ++bj)
#pragma unroll
            for (int n = 0; n < 2; ++n) gv[bj][n] = *(const f32x4*)(gp + bj * HALF + n * 4);
        f32x4 lg[2][2], lb[2][2];
        if (layer) {
#pragma unroll
            for (int bj = 0; bj < 2; ++bj)
#pragma unroll
                for (int n = 0; n < 2; ++n) { lg[bj][n] = *(const f32x4*)(lng + col0 + bj * HALF + n * 4); lb[bj][n] = *(const f32x4*)(lnb + col0 + bj * HALF + n * 4); }
        }
        f32x4 xn[2][2]; float mean_n = 0.f, rstd_n = 1.f;
#define EO_LOAD(am_) do { const int row_ = row0 + ((am_) >> 2) * HALF + ((am_) & 3) * 16; \
            if (layer == 0) { const float* xr_ = (row_ < 8192 ? xp + (size_t)row_ * 1024 : xs + (size_t)(row_ - 8192) * 1024) + col0; \
                xn[0][0] = *(const f32x4*)(xr_); xn[0][1] = *(const f32x4*)(xr_ + 4); xn[1][0] = *(const f32x4*)(xr_ + HALF); xn[1][1] = *(const f32x4*)(xr_ + HALF + 4); } \
            else { const bf16_t* zr_ = (const bf16_t*)out + (size_t)row_ * 2048 + col0; const u32x4 z0_ = *(const u32x4*)zr_, z1_ = *(const u32x4*)(zr_ + HALF); \
                xn[0][0] = (f32x4){__uint_as_float(z0_.x << 16), __uint_as_float(z0_.x & 0xffff0000u), __uint_as_float(z0_.y << 16), __uint_as_float(z0_.y & 0xffff0000u)}; \
                xn[0][1] = (f32x4){__uint_as_float(z0_.z << 16), __uint_as_float(z0_.z & 0xffff0000u), __uint_as_float(z0_.w << 16), __uint_as_float(z0_.w & 0xffff0000u)}; \
                xn[1][0] = (f32x4){__uint_as_float(z1_.x << 16), __uint_as_float(z1_.x & 0xffff0000u), __uint_as_float(z1_.y << 16), __uint_as_float(z1_.y & 0xffff0000u)}; \
                xn[1][1] = (f32x4){__uint_as_float(z1_.z << 16), __uint_as_float(z1_.z & 0xffff0000u), __uint_as_float(z1_.w << 16), __uint_as_float(z1_.w & 0xffff0000u)}; \
                mean_n = stats[(size_t)row_ * 2]; rstd_n = stats[(size_t)row_ * 2 + 1]; } } while (0)
        EO_LOAD(0);
#pragma unroll
        for (int am = 0; am < 8; ++am) { const int ai = am >> 2, m = am & 3, row = row0 + ai * HALF + m * 16;
            const f32x4 xc[2][2] = {{xn[0][0], xn[0][1]}, {xn[1][0], xn[1][1]}}; const float mean = mean_n, rstd = rstd_n;
            if (am + 1 < 8) EO_LOAD(am + 1);
            bf16_t* orow = (bf16_t*)out + (size_t)row * 2048 + col0;
#pragma unroll
            for (int bj = 0; bj < 2; ++bj) { f32x4 z[2];
#pragma unroll
                for (int n = 0; n < 2; ++n) { f32x4 x = xc[bj][n];
                    if (layer) x = (x - mean) * rstd * lg[bj][n] + lb[bj][n];
                    z[n] = x * 1.4142135623730951f + gv[bj][n] * acc[ai][bj][m][n]; }
                u32x4 w; w.x = cvt_pk_bf16(z[0][0], z[0][1]); w.y = cvt_pk_bf16(z[0][2], z[0][3]); w.z = cvt_pk_bf16(z[1][0], z[1][1]); w.w = cvt_pk_bf16(z[1][2], z[1][3]);
                *(u32x4*)(orow + bj * HALF) = w; } }
#undef EO_LOAD
    }
};
}

__device__ __forceinline__ void phase_a1_pg8(ArgsP a, LAS unsigned char* lds, int layer) {
    pg8::Gemm g{(const bf16*)(a->ws + WS_U), (const bf16*)(a->ws + WS_WIN) + (size_t)layer * NIN * 1024, T, NIN, 1024, 1024, 1024};
    pg8::StaticOrder S; S.init(T, NIN, grid_(), bid_());
    pg8::EpiIn E{(bf16*)(a->ws + WS_G1), (bf16*)(a->ws + WS_G2)};
    pg8::gemm_phase<pg8::EpiIn, pg8::StaticOrder, false>(lds, g, S, E, nullptr);
}
__device__ __forceinline__ void phase_c2_pg8(ArgsP a, LAS unsigned char* lds, int layer) {
    pg8::Gemm g{(const bf16*)(a->ws + WS_YMIX), (const bf16*)(a->ws + WS_WOUT) + (size_t)layer * 1024 * 1024, T, 1024, 1024, 1024, 1024};
    pg8::StaticOrder S; S.init(T, 1024, grid_(), bid_());
    pg8::EpiOut E{a->in[I_XP], a->in[I_XS], a->out, (const float*)(a->ws + WS_MOD) + (size_t)layer * 9 * 3072, layer, (const float*)(a->ws + WS_STATS), a->in[I_LNG], a->in[I_LNB]};
    pg8::gemm_phase<pg8::EpiOut, pg8::StaticOrder, false>(lds, g, S, E, nullptr);
}

__device__ __forceinline__ void phase_a2a(ArgsP a, int layer) {
    const int tid = tid_(), lane = tid & 63, wave = tid >> 6, G = grid_();
    bf16* G2 = (bf16*)(a->ws + WS_G2); bf16* KR = (bf16*)(a->ws + WS_KR); bf16* CK = (bf16*)(a->ws + WS_HF);
    const float* ROPE = (const float*)(a->ws + WS_ROPE);
    f32x4 nw0 = {0.f, 0.f, 0.f, 0.f}, nw1 = {0.f, 0.f, 0.f, 0.f};
    if (lane < 32) { nw0 = *(const f32x4*)(a->in[I_QNORM] + layer * 256 + lane * 8); nw1 = *(const f32x4*)(a->in[I_QNORM] + layer * 256 + lane * 8 + 4); }
    else if (lane < 48) { nw0 = *(const f32x4*)(a->in[I_KVNORM] + layer * 128 + (lane - 32) * 8); nw1 = *(const f32x4*)(a->in[I_KVNORM] + layer * 128 + (lane - 32) * 8 + 4); }
    v4u nx = {0u, 0u, 0u, 0u};
    { const int n0 = bid_() * 8 + wave; if (n0 < T) nx = *(const v4u*)(G2 + (size_t)n0 * G2W + lane * 8); }
    for (int n = bid_() * 8 + wave; n < T; n += G * 8) {
        const v4u w = nx;
        if (n + G * 8 < T) nx = *(const v4u*)(G2 + (size_t)(n + G * 8) * G2W + lane * 8);
        const Tok tk = tok_of(n);
        float x[8] = {bflo(w.x), bfhi(w.x), bflo(w.y), bfhi(w.y), bflo(w.z), bfhi(w.z), bflo(w.w), bfhi(w.w)};
        const float ss = (x[0] * x[0] + x[1] * x[1]) + (x[2] * x[2] + x[3] * x[3]) + (x[4] * x[4] + x[5] * x[5]) + (x[6] * x[6] + x[7] * x[7]);
        const float sq = wave_sum(lane < 32 ? ss : 0.f), sk = wave_sum((lane >= 32 && lane < 48) ? ss : 0.f);
        const float rs = lane < 32 ? rsqrt_(sq * (1.f / 256.f) + 1e-6f) : rsqrt_(sk * (1.f / 128.f) + 1e-6f);
        if (lane < 48) {
            const float y0 = x[0] * rs * nw0.x, y1 = x[1] * rs * nw0.y, y2 = x[2] * rs * nw0.z, y3 = x[3] * rs * nw0.w, y4 = x[4] * rs * nw1.x, y5 = x[5] * rs * nw1.y, y6 = x[6] * rs * nw1.z, y7 = x[7] * rs * nw1.w;
            *(v4u*)(G2 + (size_t)n * G2W + lane * 8) = (v4u){cvtpk(y0, y1), cvtpk(y2, y3), cvtpk(y4, y5), cvtpk(y6, y7)};
            if (lane >= 32 && !tk.lat) { float* op = a->out + O_CKV + ((size_t)(tk.b * 2 + layer) * 256 + tk.t) * 128 + (lane - 32) * 8;
                *(f32x4*)op = (f32x4){y0, y1, y2, y3}; *(f32x4*)(op + 4) = (f32x4){y4, y5, y6, y7}; }
        } else if (lane < 52) {
            const int d0 = (lane - 48) * 8;
            if (!tk.lat) { float* op = a->out + O_KR + ((size_t)(tk.b * 2 + layer) * 256 + tk.t) * 32 + d0;
                *(f32x4*)op = (f32x4){x[0], x[1], x[2], x[3]}; *(f32x4*)(op + 4) = (f32x4){x[4], x[5], x[6], x[7]};
                *(v4u*)(KR + (size_t)tk.kidx * 32 + d0) = w; }
            else { const f32x4 c0 = *(const f32x4*)(ROPE + ((size_t)tk.t * 16 + (d0 >> 1)) * 2), c1 = *(const f32x4*)(ROPE + ((size_t)tk.t * 16 + (d0 >> 1) + 2) * 2);
                const float y0 = x[0] * c0.x - x[1] * c0.y, y1 = x[0] * c0.y + x[1] * c0.x, y2 = x[2] * c0.z - x[3] * c0.w, y3 = x[2] * c0.w + x[3] * c0.z;
                const float y4 = x[4] * c1.x - x[5] * c1.y, y5 = x[4] * c1.y + x[5] * c1.x, y6 = x[6] * c1.z - x[7] * c1.w, y7 = x[6] * c1.w + x[7] * c1.z;
                *(v4u*)(KR + (size_t)tk.kidx * 32 + d0) = (v4u){cvtpk(y0, y1), cvtpk(y2, y3), cvtpk(y4, y5), cvtpk(y6, y7)}; }
        }
    }
    for (int r = bid_() * 8 + wave; r < 2048; r += G * 8) {
        const int b = r >> 8, j = r & 255; const size_t src = (size_t)(b * 2 + layer) * 256 + j;
        if (lane < 16) { const f32x4 v0 = *(const f32x4*)(a->in[I_CCKV] + src * 128 + lane * 8), v1 = *(const f32x4*)(a->in[I_CCKV] + src * 128 + lane * 8 + 4);
            *(v4u*)(CK + (size_t)r * 512 + lane * 8) = (v4u){cvtpk(v0.x, v0.y), cvtpk(v0.z, v0.w), cvtpk(v1.x, v1.y), cvtpk(v1.z, v1.w)}; }
        else if (lane < 32) *(v4u*)(CK + (size_t)r * 512 + lane * 8) = (v4u){0u, 0u, 0u, 0u};
        else if (lane < 36) { const f32x4 v0 = *(const f32x4*)(a->in[I_CKR] + src * 32 + (lane - 32) * 8), v1 = *(const f32x4*)(a->in[I_CKR] + src * 32 + (lane - 32) * 8 + 4);
            *(v4u*)(KR + (size_t)(T_CTX + b * LK_LAT + j) * 32 + (lane - 32) * 8) = (v4u){cvtpk(v0.x, v0.y), cvtpk(v0.z, v0.w), cvtpk(v1.x, v1.y), cvtpk(v1.z, v1.w)}; }
    }
}
namespace pg8 {
struct A2Order {
    const char* ws; unsigned oq, okv; int G, c;
    __device__ __forceinline__ bool next(int i, Unit& u) const {
        const int L = i * G + c; if (L >= 704) return false;
        if (L < 288) { u.gid = 0; u.pm = L / 3; u.pn = L % 3; } else if (L < 672) { u.gid = 1; u.pm = (L - 288) >> 2; u.pn = (L - 288) & 3; } else { u.gid = 2; u.pm = (L - 672) >> 2; u.pn = (L - 672) & 3; }
        return true;
    }
    __device__ __forceinline__ const char* abase(const Gemm&, const Unit& u) const { const unsigned off = u.gid == 0 ? (unsigned)WS_G2 : (u.gid == 1 ? (unsigned)WS_G2 + 512u : (unsigned)WS_HF); return ws + off + (size_t)u.pm * 256 * 512 * 2; }
    __device__ __forceinline__ const char* bbase(const Gemm&, const Unit& u) const { const unsigned off = u.gid == 0 ? oq : okv; return ws + off + (size_t)u.pn * 256 * 256 * 2; }
    __device__ __forceinline__ void a_ready(const Unit&) const {}
    __device__ __forceinline__ void done(const Unit&) const {}
};
struct EpiA2 {
    static constexpr bool PERM = true, AFTER_DRAIN = false;
    bf16_t* Q; bf16_t* KN; bf16_t* VR; const float* rope;
    __device__ __forceinline__ void operator()(const f32x4 (&acc)[2][2][4][2], const Unit& u, int wr, int wc, int fr, int fq) const {
        const int row0 = u.pm * BM + wr * 64 + fr;
        if (u.gid == 0) {
            const int fb = u.pn * 256 + wc * 32 + 8 * fq;
#pragma unroll
            for (int ai = 0; ai < 2; ++ai)
#pragma unroll
                for (int m = 0; m < 4; ++m) { const int row = row0 + ai * HALF + m * 16;
                    const float* rp = rope + (unsigned)(((row - 8192) & 2047) * 32);
#pragma unroll
                    for (int bj = 0; bj < 2; ++bj) {
                        f32x4 v0 = acc[ai][bj][m][0], v1 = acc[ai][bj][m][1];
                        const int f0 = fb + bj * HALF, d = f0 % 96;
                        if (row >= 8192 && d >= 64) { const f32x4 c0 = *(const f32x4*)(rp + (d - 64)), c1 = *(const f32x4*)(rp + (d - 64) + 4);
                            const f32x4 a0 = v0, a1 = v1;
                            v0[0] = a0[0] * c0[0] - a0[1] * c0[1]; v0[1] = a0[0] * c0[1] + a0[1] * c0[0]; v0[2] = a0[2] * c0[2] - a0[3] * c0[3]; v0[3] = a0[2] * c0[3] + a0[3] * c0[2];
                            v1[0] = a1[0] * c1[0] - a1[1] * c1[1]; v1[1] = a1[0] * c1[1] + a1[1] * c1[0]; v1[2] = a1[2] * c1[2] - a1[3] * c1[3]; v1[3] = a1[2] * c1[3] + a1[3] * c1[2]; }
                        u32x4 w; w.x = cvt_pk_bf16(v0[0], v0[1]); w.y = cvt_pk_bf16(v0[2], v0[3]); w.z = cvt_pk_bf16(v1[0], v1[1]); w.w = cvt_pk_bf16(v1[2], v1[3]);
                        *(u32x4*)(Q + (unsigned)(row * 768 + f0)) = w; } }
        } else {
            const int x = wc * 32 + 8 * fq;
            bf16_t* base = (wc < 2 ? KN : VR);
            const unsigned xo = (unsigned)(x & 63);
#pragma unroll
            for (int ai = 0; ai < 2; ++ai)
#pragma unroll
                for (int m = 0; m < 4; ++m) { const int row = row0 + ai * HALF + m * 16;
                    int kidx;
                    if (u.gid == 2) kidx = 8192 + (row >> 8) * 2304 + (row & 255);
                    else if (row < 8192) kidx = row;
                    else { const int mrow = row - 8192; kidx = 8192 + (mrow >> 11) * 2304 + 256 + (mrow & 2047); }
#pragma unroll
                    for (int bj = 0; bj < 2; ++bj) { const f32x4 v0 = acc[ai][bj][m][0], v1 = acc[ai][bj][m][1];
                        u32x4 w; w.x = cvt_pk_bf16(v0[0], v0[1]); w.y = cvt_pk_bf16(v0[2], v0[3]); w.z = cvt_pk_bf16(v1[0], v1[1]); w.w = cvt_pk_bf16(v1[2], v1[3]);
                        *(u32x4*)(base + (unsigned)(kidx * 512 + (u.pn * 2 + bj) * 64) + xo) = w; } }
        }
    }
};
}
__device__ __forceinline__ void phase_a2b(ArgsP a, LAS unsigned char* lds, int layer) {
    int kk = 256; asm volatile("" : "+s"(kk));
    pg8::Gemm g{nullptr, nullptr, T, 1024, kk, 512, 256};
    pg8::A2Order S{(const char*)a->ws, (unsigned)(WS_WUQ + (size_t)layer * 768 * 256 * 2), (unsigned)(WS_WUKV + (size_t)layer * 1024 * 256 * 2), grid_(), bid_()};
    pg8::EpiA2 E{(bf16*)(a->ws + WS_Q), (bf16*)(a->ws + WS_KN), (bf16*)(a->ws + WS_VT), (const float*)(a->ws + WS_ROPE)};
    pg8::gemm_phase<pg8::EpiA2, pg8::A2Order, false>(lds, g, S, E, nullptr);
}


__device__ __forceinline__ void phase_c1(ArgsP a, int layer) {
    const int tid = tid_(), lane = tid & 63, wave = tid >> 6, G = grid_();
    const bf16* G1 = (const bf16*)(a->ws + WS_G1); const bf16* YS = (const bf16*)(a->ws + WS_G2); const bf16* Q = (const bf16*)(a->ws + WS_Q); const bf16* HF = (const bf16*)(a->ws + WS_HF);
    bf16* Y = (bf16*)(a->ws + WS_YMIX);
    const int ch = lane * 4;
    const f32x4 rk = *(const f32x4*)(a->in[I_RK] + layer * 256 + ch), lg = *(const f32x4*)(a->in[I_LNXG] + layer * 256 + ch), lb = *(const f32x4*)(a->in[I_LNXB] + layer * 256 + ch);
    v2u p_y0, p_y1, p_r, p_k, p_v, p_g, p_h, p_hb, p_gl; v4u p_q;
#define C1_LOAD(nn) do { const bf16* g_ = G1 + (size_t)(nn) * G1W; p_y0 = *(const v2u*)(YS + (size_t)(nn) * 256 + ch); p_y1 = *(const v2u*)(YS + ((size_t)T + (nn)) * 256 + ch); \
        p_r = *(const v2u*)(g_ + C_R + ch); p_k = *(const v2u*)(g_ + C_K + ch); p_v = *(const v2u*)(g_ + C_V + ch); p_g = *(const v2u*)(g_ + C_G + ch); \
        p_q = *(const v4u*)(Q + (size_t)(nn) * 768 + (lane >> 3) * 96 + (lane & 7) * 8); p_h = *(const v2u*)(HF + (size_t)(nn) * 256 + ch); \
        p_hb = *(const v2u*)((const unsigned char*)a->out + (size_t)(nn) * 4096 + 2048 + ch * 2); p_gl = *(const v2u*)(g_ + C_GL + ch); } while (0)
    { const int n0 = bid_() * 8 + wave; if (n0 < T) C1_LOAD(n0); }
    for (int n = bid_() * 8 + wave; n < T; n += G * 8) {
        const v2u y0 = p_y0, y1 = p_y1, rv = p_r, kv = p_k, vv = p_v, gv = p_g, hf = p_h, hb = p_hb, gl = p_gl; const v4u qq = p_q;
        if (n + G * 8 < T) C1_LOAD(n + G * 8);
        float y[4] = {bflo(y0.x) + bflo(y1.x), bfhi(y0.x) + bfhi(y1.x), bflo(y0.y) + bflo(y1.y), bfhi(y0.y) + bfhi(y1.y)};
        float s = (y[0] + y[1]) + (y[2] + y[3]);
        float bon = bflo(rv.x) * bflo(kv.x) * rk.x + bfhi(rv.x) * bfhi(kv.x) * rk.y + bflo(rv.y) * bflo(kv.y) * rk.z + bfhi(rv.y) * bfhi(kv.y) * rk.w;
#pragma unroll
        for (int o = 1; o < 16; o <<= 1) { s += __shfl_xor(s, o); bon += __shfl_xor(bon, o); }
        const float mu = s * (1.f / 64.f);
        float s2 = (y[0] - mu) * (y[0] - mu) + (y[1] - mu) * (y[1] - mu) + (y[2] - mu) * (y[2] - mu) + (y[3] - mu) * (y[3] - mu);
#pragma unroll
        for (int o = 1; o < 16; o <<= 1) s2 += __shfl_xor(s2, o);
        const float rstd = rsqrt_(s2 * (1.f / 64.f) + GN_EPS);
        const float o0 = ((y[0] - mu) * rstd * lg.x + lb.x + bon * bflo(vv.x)) * siluf_(bflo(gv.x));
        const float o1 = ((y[1] - mu) * rstd * lg.y + lb.y + bon * bfhi(vv.x)) * siluf_(bfhi(gv.x));
        const float o2 = ((y[2] - mu) * rstd * lg.z + lb.z + bon * bflo(vv.y)) * siluf_(bflo(gv.y));
        const float o3 = ((y[3] - mu) * rstd * lg.w + lb.w + bon * bfhi(vv.y)) * siluf_(bfhi(gv.y));
        v2u ov; ov.x = pk2(o0, o1); ov.y = pk2(o2, o3);
        bf16* yr = Y + (size_t)n * 1024;
        *(v2u*)(yr + ch) = ov;
        *(v4u*)(yr + 256 + (lane >> 3) * 64 + (lane & 7) * 8) = qq;
        *(v2u*)(yr + 768 + ch) = (v2u){pk2((bflo(hf.x) + bflo(hb.x)) * siluf_(bflo(gl.x)), (bfhi(hf.x) + bfhi(hb.x)) * siluf_(bfhi(gl.x))), pk2((bflo(hf.y) + bflo(hb.y)) * siluf_(bflo(gl.y)), (bfhi(hf.y) + bfhi(hb.y)) * siluf_(bfhi(gl.y)))};
    }
#undef C1_LOAD
}
#define MFMA32(a, b, c) __builtin_amdgcn_mfma_f32_32x32x16_bf16((a), (b), (c), 0, 0, 0)
#define MFMA16(a, b, c) __builtin_amdgcn_mfma_f32_16x16x32_bf16((a), (b), (c), 0, 0, 0)
typedef short s16x4_t __attribute__((ext_vector_type(4)));

__device__ __forceinline__ float tanh_fast(float x) { return 1.f - 2.f * rcp_(1.f + exp_(2.f * x)); }

constexpr int ATT_KSTR = 208, ATT_VSTR = 136, ATT_VOFF = 64 * ATT_KSTR, ATT_STAGE = 64 * ATT_KSTR + 64 * ATT_VSTR;


constexpr int RW_W2T = 0, RW_A2T = 9216, RW_TH = 18432, RW_HA = 27648, RW_CH0 = 36864, RW_CHB = 20992, RW_YB = 120832;
constexpr int RC_KP = 0, RC_RP = 2304, RC_BP = 4608  , RC_KT = 6912, RC_VR = 9216  , RC_LK = 16896, RC_TM = 17536, RC_ARK = 18176, RC_NARB = 18816, RC_G15 = 19456, RC_LBF = 19712, RC_SSQ = 20736;
template <int MODE = 0> __device__ __forceinline__ void rwkv_unit_mfma(ArgsP a, LAS unsigned char* lds, int layer, int u) {
    const int tid = tid_(), lane = tid & 63, wave = tid >> 6, i16 = lane & 15, g = lane >> 4;
    const int lat = u < 64, uu = lat ? u : u - 64, b = uu >> 3, e = (uu >> 2) & 1, hh = uu & 3;
    const int L = lat ? L_LAT : L_CTX, tok0 = lat ? T_CTX + b * L_LAT : b * L_CTX;
    const bf16* G1 = (const bf16*)(a->ws + WS_G1);
    bf16* YS = (bf16*)(a->ws + WS_G2);
    __syncthreads();
    { const bf16* wsrc = (const bf16*)(a->ws + WS_LORA2) + ((size_t)((layer * 2 + e) * 2) * 256 + hh * 64) * 64; const int row = tid >> 3, c8 = (tid & 7) * 8;
      *(LAS v4u*)(lds + RW_W2T + row * 144 + c8 * 2) = *(const v4u*)(wsrc + row * 64 + c8);
      *(LAS v4u*)(lds + RW_A2T + row * 144 + c8 * 2) = *(const v4u*)(wsrc + 256 * 64 + row * 64 + c8); }
    const int st_tok = tid >> 3, st_c8 = (tid & 7) * 8;
#define RW_STAGE(sc) do { const int step_ = (sc) * 64 + st_tok, t_ = e ? L - 1 - step_ : step_; const bf16* gp_ = G1 + (size_t)(tok0 + t_) * G1W + C_LORA + e * 64 + st_c8; \
        const v4u hw_ = *(const v4u*)gp_, ha_ = *(const v4u*)(gp_ + 128); v4u th_; \
        th_.x = cvtpk(tanh_fast(bflo(hw_.x)), tanh_fast(bfhi(hw_.x))); th_.y = cvtpk(tanh_fast(bflo(hw_.y)), tanh_fast(bfhi(hw_.y))); th_.z = cvtpk(tanh_fast(bflo(hw_.z)), tanh_fast(bfhi(hw_.z))); th_.w = cvtpk(tanh_fast(bflo(hw_.w)), tanh_fast(bfhi(hw_.w))); \
        *(LAS v4u*)(lds + RW_TH + st_tok * 144 + st_c8 * 2) = th_; *(LAS v4u*)(lds + RW_HA + st_tok * 144 + st_c8 * 2) = ha_; } while (0)
    RW_STAGE(0);
    f32x4 ST[4];
    {
        const int v = 16 * (wave & 3) + i16;
#pragma unroll
        for (int kt = 0; kt < 4; ++kt) ST[kt] = lat ? *(const f32x4*)(a->in[I_SRW] + (((size_t)((b * 2 + layer) * 2 + e) * 4 + hh) * 64 + v) * 64 + 16 * kt + 4 * g) : (f32x4){0.f, 0.f, 0.f, 0.f};
    }
    const int pc = wave & 3, ph = wave >> 2;
    LAS unsigned char* CH = lds + RW_CH0 + pc * RW_CHB;
    f32x4 w0r[2], a0r[2], kwr[2], kar[2];
#pragma unroll
    for (int c2 = 0; c2 < 2; ++c2) { const int gch = hh * 64 + (2 * ph + c2) * 16 + 4 * g;
        w0r[c2] = *(const f32x4*)(a->in[I_W0] + (layer * 2 + e) * 256 + gch); a0r[c2] = *(const f32x4*)(a->in[I_A0] + (layer * 2 + e) * 256 + gch);
        kwr[c2] = *(const f32x4*)(a->in[I_KK] + layer * 256 + gch); kar[c2] = *(const f32x4*)(a->in[I_KA] + layer * 256 + gch); }
#pragma unroll
    for (int c2 = 0; c2 < 2; ++c2) asm volatile("" : "+v"(w0r[c2]), "+v"(a0r[c2]), "+v"(kwr[c2]), "+v"(kar[c2]));
#pragma unroll
    for (int kt = 0; kt < 4; ++kt) asm volatile("" : "+v"(ST[kt]));
    __syncthreads();
    const int nsc = L >> 6;
    v2u pk[2], pr[2], pv[2];
#define RW_PREFETCH(sc) do { const int ps_ = (sc) * 64 + pc * 16 + i16, pt_ = e ? L - 1 - ps_ : ps_; const bf16* gq_ = G1 + (size_t)(tok0 + pt_) * G1W + hh * 64 + (2 * ph) * 16 + 4 * g; \
        pk[0] = *(const v2u*)(gq_ + C_K); pk[1] = *(const v2u*)(gq_ + C_K + 16); pr[0] = *(const v2u*)(gq_ + C_R); pr[1] = *(const v2u*)(gq_ + C_R + 16); pv[0] = *(const v2u*)(gq_ + C_V); pv[1] = *(const v2u*)(gq_ + C_V + 16); } while (0)
    RW_PREFETCH(0);
    for (int sc = 0; sc < nsc; ++sc) {
        const v2u ck[2] = {pk[0], pk[1]}, cr[2] = {pr[0], pr[1]}, cv[2] = {pv[0], pv[1]};
        if (sc + 1 < nsc) RW_PREFETCH(sc + 1);
        float dec[8], av[8], kx[8], rx[8], kk[8];
        {
            f32x4 aw[2], aa[2];
#pragma unroll
            for (int c2 = 0; c2 < 2; ++c2) { aw[c2] = (f32x4){0.f, 0.f, 0.f, 0.f}; aa[c2] = (f32x4){0.f, 0.f, 0.f, 0.f}; }
#pragma unroll
            for (int ks = 0; ks < 2; ++ks) {
                const bf16x8 bth = *(const LAS bf16x8*)(lds + RW_TH + (pc * 16 + i16) * 144 + ks * 64 + g * 16), bha = *(const LAS bf16x8*)(lds + RW_HA + (pc * 16 + i16) * 144 + ks * 64 + g * 16);
#pragma unroll
                for (int c2 = 0; c2 < 2; ++c2) { const int row = (2 * ph + c2) * 16 + i16;
                    const bf16x8 w2f = *(const LAS bf16x8*)(lds + RW_W2T + row * 144 + ks * 64 + g * 16), a2f = *(const LAS bf16x8*)(lds + RW_A2T + row * 144 + ks * 64 + g * 16);
                    aw[c2] = MFMA16(w2f, bth, aw[c2]); aa[c2] = MFMA16(a2f, bha, aa[c2]); }
            }
            float ss = 0.f;
#pragma unroll
            for (int c2 = 0; c2 < 2; ++c2) {
                const f32x4 w0 = w0r[c2], a0 = a0r[c2], kw = kwr[c2];
                const v2u kv = ck[c2], rv = cr[c2];
                const float kq[4] = {bflo(kv.x), bfhi(kv.x), bflo(kv.y), bfhi(kv.y)}, rq[4] = {bflo(rv.x), bfhi(rv.x), bflo(rv.y), bfhi(rv.y)};
#pragma unroll
                for (int q = 0; q < 4; ++q) { const int o = c2 * 4 + q;
                    dec[o] = exp_(-0.6065306597126334f * sigmoidf_(aw[c2][q] + w0[q])); av[o] = sigmoidf_(aa[c2][q] + a0[q]);
                    kx[o] = kq[q]; rx[o] = rq[q]; kk[o] = kq[q] * kw[q]; ss += kk[o] * kk[o]; }
            }
            ss += __shfl_xor(ss, 16); ss += __shfl_xor(ss, 32);
            if (g == 0) *(LAS float*)(CH + RC_SSQ + (i16 * 2 + ph) * 4) = ss;
        }
        __syncthreads();
        {
            const float tot = *(const LAS float*)(CH + RC_SSQ + (i16 * 2) * 4) + *(const LAS float*)(CH + RC_SSQ + (i16 * 2 + 1) * 4);
            const float inrm = rcp_(fmaxf(sqrt_(tot), 1e-12f));
            float G8[8], Gx8[8];
#pragma unroll
            for (int o8 = 0; o8 < 8; ++o8) G8[o8] = dec[o8];
#pragma unroll
            for (int o8 = 0; o8 < 8; ++o8) G8[o8] *= dpp_f<0x111>(1.f, G8[o8]);
#pragma unroll
            for (int o8 = 0; o8 < 8; ++o8) G8[o8] *= dpp_f<0x112>(1.f, G8[o8]);
#pragma unroll
            for (int o8 = 0; o8 < 8; ++o8) G8[o8] *= dpp_f<0x114>(1.f, G8[o8]);
#pragma unroll
            for (int o8 = 0; o8 < 8; ++o8) G8[o8] *= dpp_f<0x118>(1.f, G8[o8]);
#pragma unroll
            for (int o8 = 0; o8 < 8; ++o8) Gx8[o8] = dpp_f<0x111>(1.f, G8[o8]);
#pragma unroll
            for (int c2 = 0; c2 < 2; ++c2) { const int ch = (2 * ph + c2) * 16 + 4 * g;
                const f32x4 ka = kar[c2];
                float kp[4], bp[4], kt[4], rp[4];
#pragma unroll
                for (int q = 0; q < 4; ++q) { const int o = c2 * 4 + q;
                    const float G = G8[o], Gex = Gx8[o];
                    const float kkn = kk[o] * inrm, iG = rcp_(G);
                    kp[q] = Gex * kkn; bp[q] = kkn * av[o] * iG; kt[q] = kx[o] * (1.f + (av[o] - 1.f) * ka[q]) * iG; rp[q] = G * rx[o];
                    if (i16 == 15) *(LAS float*)(CH + RC_G15 + (ch + q) * 4) = G;
                }
                *(LAS v2u*)(CH + RC_KP + i16 * 144 + ch * 2) = (v2u){cvtpk(kp[0], kp[1]), cvtpk(kp[2], kp[3])};
                *(LAS v2u*)(CH + RC_BP + i16 * 144 + ch * 2) = (v2u){cvtpk(-bp[0], -bp[1]), cvtpk(-bp[2], -bp[3])};
                *(LAS v2u*)(CH + RC_KT + i16 * 144 + ch * 2) = (v2u){cvtpk(kt[0], kt[1]), cvtpk(kt[2], kt[3])};
                *(LAS v2u*)(CH + RC_RP + i16 * 144 + ch * 2) = (v2u){cvtpk(rp[0], rp[1]), cvtpk(rp[2], rp[3])};
                *(LAS v2u*)(CH + RC_VR + i16 * 144 + ch * 2) = cv[c2];
            }
        }
        __syncthreads();
        {
            f32x4 d0 = (f32x4){0.f, 0.f, 0.f, 0.f}, d1 = (f32x4){0.f, 0.f, 0.f, 0.f};
            const int xoff = ph ? RC_KP : RC_RP, y0off = ph ? RC_BP : RC_KT, y1off = ph ? RC_KT : RC_BP;
#pragma unroll
            for (int ks = 0; ks < 2; ++ks) {
                const bf16x8 xf = *(const LAS bf16x8*)(CH + xoff + i16 * 144 + ks * 64 + g * 16);
                const bf16x8 y0 = *(const LAS bf16x8*)(CH + y0off + i16 * 144 + ks * 64 + g * 16), y1 = *(const LAS bf16x8*)(CH + y1off + i16 * 144 + ks * 64 + g * 16);
                d0 = MFMA16(xf, y0, d0); d1 = MFMA16(xf, y1, d1);
            }
#pragma unroll
            for (int q = 0; q < 4; ++q) { const int i = 4 * g + q, j = i16;
                if (ph) { *(LAS float*)(CH + RC_LBF + (i * 16 + j) * 4) = (j < i) ? -d0[q] : 0.f; *(LAS bf16*)(CH + RC_LK + i * 40 + j * 2) = (bf16)(cvtpk((j < i) ? d1[q] : 0.f, 0.f) & 0xffffu); }
                else { const unsigned pk_ = cvtpk((j <= i) ? d0[q] : 0.f, (j <= i) ? d1[q] : 0.f); *(LAS bf16*)(CH + RC_ARK + i * 40 + j * 2) = (bf16)(pk_ & 0xffffu); *(LAS bf16*)(CH + RC_NARB + i * 40 + j * 2) = (bf16)(pk_ >> 16); }
            }
            if (ph && !(MODE & 2)) {
                float x[16];
#pragma unroll
                for (int i = 0; i < 16; ++i) { float s = (i == i16) ? 1.f : 0.f;
#pragma unroll
                    for (int j4 = 0; j4 < (i + 3) / 4; ++j4) { const f32x4 lr = *(const LAS f32x4*)(CH + RC_LBF + (i * 16 + j4 * 4) * 4);
#pragma unroll
                        for (int jj = 0; jj < 4; ++jj) { const int j = j4 * 4 + jj; if (j < i) s -= lr[jj] * x[j]; } }
                    x[i] = s; }
                if (g == 0) {
#pragma unroll
                    for (int i = 0; i < 16; i += 2) { const unsigned pk_ = cvtpk(x[i], x[i + 1]); *(LAS bf16*)(CH + RC_TM + i * 40 + i16 * 2) = (bf16)(pk_ & 0xffffu); *(LAS bf16*)(CH + RC_TM + (i + 1) * 40 + i16 * 2) = (bf16)(pk_ >> 16); } }
            }
        }
        __syncthreads();
        if (wave < 4) {
            const int vt = wave;
#pragma unroll 1
            for (int c = 0; c < ((MODE & 1) ? 0 : 4); ++c) {
                const LAS unsigned char* C = lds + RW_CH0 + c * RW_CHB;
                v4u sb01, sb23;
                sb01.x = cvtpk(ST[0][0], ST[0][1]); sb01.y = cvtpk(ST[0][2], ST[0][3]); sb01.z = cvtpk(ST[1][0], ST[1][1]); sb01.w = cvtpk(ST[1][2], ST[1][3]);
                sb23.x = cvtpk(ST[2][0], ST[2][1]); sb23.y = cvtpk(ST[2][2], ST[2][3]); sb23.z = cvtpk(ST[3][0], ST[3][1]); sb23.w = cvtpk(ST[3][2], ST[3][3]);
                const bf16x8 s01 = __builtin_bit_cast(bf16x8, sb01), s23 = __builtin_bit_cast(bf16x8, sb23);
                const v2u kp0a = *(const LAS v2u*)(C + RC_KP + i16 * 144 + (4 * g) * 2), kp0b = *(const LAS v2u*)(C + RC_KP + i16 * 144 + (16 + 4 * g) * 2);
                const v2u kp1a = *(const LAS v2u*)(C + RC_KP + i16 * 144 + (32 + 4 * g) * 2), kp1b = *(const LAS v2u*)(C + RC_KP + i16 * 144 + (48 + 4 * g) * 2);
                const v2u rp0a = *(const LAS v2u*)(C + RC_RP + i16 * 144 + (4 * g) * 2), rp0b = *(const LAS v2u*)(C + RC_RP + i16 * 144 + (16 + 4 * g) * 2);
                const v2u rp1a = *(const LAS v2u*)(C + RC_RP + i16 * 144 + (32 + 4 * g) * 2), rp1b = *(const LAS v2u*)(C + RC_RP + i16 * 144 + (48 + 4 * g) * 2);
                const v2u lk = *(const LAS v2u*)(C + RC_LK + i16 * 40 + g * 8), tm = *(const LAS v2u*)(C + RC_TM + i16 * 40 + g * 8);
                const v2u ark = *(const LAS v2u*)(C + RC_ARK + i16 * 40 + g * 8), narb = *(const LAS v2u*)(C + RC_NARB + i16 * 40 + g * 8);
                const int trq = (i16 >> 2) & 3, trp = i16 & 3;
                const v2u vf = __builtin_bit_cast(v2u, __builtin_amdgcn_ds_read_tr16_b64_v4i16((LAS s16x4_t*)(C + RC_VR + (4 * g + trq) * 144 + (16 * vt + 4 * trp) * 2)));
                const v4u z4 = {0u, 0u, 0u, 0u};
                f32x4 rhs = (f32x4){0.f, 0.f, 0.f, 0.f};
                rhs = MFMA16(__builtin_bit_cast(bf16x8, ((v4u){kp0a.x, kp0a.y, kp0b.x, kp0b.y})), s01, rhs);
                rhs = MFMA16(__builtin_bit_cast(bf16x8, ((v4u){kp1a.x, kp1a.y, kp1b.x, kp1b.y})), s23, rhs);
                rhs = MFMA16(__builtin_bit_cast(bf16x8, ((v4u){lk.x, lk.y, 0u, 0u})), __builtin_bit_cast(bf16x8, ((v4u){vf.x, vf.y, 0u, 0u})), rhs);
                f32x4 z = MFMA16(__builtin_bit_cast(bf16x8, ((v4u){tm.x, tm.y, 0u, 0u})), __builtin_bit_cast(bf16x8, ((v4u){cvtpk(rhs[0], rhs[1]), cvtpk(rhs[2], rhs[3]), 0u, 0u})), ((f32x4){0.f, 0.f, 0.f, 0.f}));
                const bf16x8 vz = __builtin_bit_cast(bf16x8, ((v4u){vf.x, vf.y, cvtpk(z[0], z[1]), cvtpk(z[2], z[3])}));
                f32x4 y = (f32x4){0.f, 0.f, 0.f, 0.f};
                y = MFMA16(__builtin_bit_cast(bf16x8, ((v4u){rp0a.x, rp0a.y, rp0b.x, rp0b.y})), s01, y);
                y = MFMA16(__builtin_bit_cast(bf16x8, ((v4u){rp1a.x, rp1a.y, rp1b.x, rp1b.y})), s23, y);
                y = MFMA16(__builtin_bit_cast(bf16x8, ((v4u){ark.x, ark.y, narb.x, narb.y})), vz, y);
#pragma unroll
                for (int kt = 0; kt < 4; ++kt) {
                    const v2u ktf = __builtin_bit_cast(v2u, __builtin_amdgcn_ds_read_tr16_b64_v4i16((LAS s16x4_t*)(C + RC_KT + (4 * g + trq) * 144 + (16 * kt + 4 * trp) * 2)));
                    const v2u nbf = __builtin_bit_cast(v2u, __builtin_amdgcn_ds_read_tr16_b64_v4i16((LAS s16x4_t*)(C + RC_BP + (4 * g + trq) * 144 + (16 * kt + 4 * trp) * 2)));
                    const f32x4 g15 = *(const LAS f32x4*)(C + RC_G15 + (16 * kt + 4 * g) * 4);
                    ST[kt] = MFMA16(__builtin_bit_cast(bf16x8, ((v4u){ktf.x, ktf.y, nbf.x, nbf.y})), vz, ST[kt]);
                    ST[kt] = ST[kt] * g15;
                }
                { const unsigned y01 = cvtpk(y[0], y[1]), y23 = cvtpk(y[2], y[3]); LAS unsigned char* yb = lds + RW_YB + (c * 16 + 4 * g) * 144 + (16 * vt + i16) * 2;
                  *(LAS bf16*)(yb) = (bf16)(y01 & 0xffffu); *(LAS bf16*)(yb + 144) = (bf16)(y01 >> 16); *(LAS bf16*)(yb + 288) = (bf16)(y23 & 0xffffu); *(LAS bf16*)(yb + 432) = (bf16)(y23 >> 16); }
                (void)z4;
            }
        } else if (sc + 1 < nsc) {
            const int r0 = (tid - 256) >> 3;
#pragma unroll
            for (int hrow = 0; hrow < 2; ++hrow) { const int tokr = r0 + 32 * hrow, step_ = (sc + 1) * 64 + tokr, t_ = e ? L - 1 - step_ : step_;
                const bf16* gp_ = G1 + (size_t)(tok0 + t_) * G1W + C_LORA + e * 64 + st_c8;
                const v4u hw_ = *(const v4u*)gp_, ha_ = *(const v4u*)(gp_ + 128); v4u th_;
                th_.x = cvtpk(tanh_fast(bflo(hw_.x)), tanh_fast(bfhi(hw_.x))); th_.y = cvtpk(tanh_fast(bflo(hw_.y)), tanh_fast(bfhi(hw_.y))); th_.z = cvtpk(tanh_fast(bflo(hw_.z)), tanh_fast(bfhi(hw_.z))); th_.w = cvtpk(tanh_fast(bflo(hw_.w)), tanh_fast(bfhi(hw_.w)));
                *(LAS v4u*)(lds + RW_TH + tokr * 144 + st_c8 * 2) = th_; *(LAS v4u*)(lds + RW_HA + tokr * 144 + st_c8 * 2) = ha_; }
        }
        __syncthreads();
        {
            const int row = tid >> 3, part = tid & 7, step = sc * 64 + row, t = e ? L - 1 - step : step;
            *(v4u*)(YS + ((size_t)e * T + tok0 + t) * 256 + hh * 64 + part * 8) = *(const LAS v4u*)(lds + RW_YB + row * 144 + part * 16);
        }
    }
#undef RW_STAGE
#undef RW_PREFETCH
    if (!lat && wave < 4) {
        const int v = 16 * wave + i16;
#pragma unroll
        for (int kt = 0; kt < 4; ++kt) *(f32x4*)(a->out + O_RW + (((size_t)((b * 2 + layer) * 2 + e) * 4 + hh) * 64 + v) * 64 + 16 * kt + 4 * g) = ST[kt];
    }
}


constexpr int LQ_NQ = 32;
constexpr int LQ_WAT = 0, LQ_S0 = 2 * LQ_NQ * 144;
constexpr int LS_XCB = 0, LS_XCQ = 9216, LS_AA = LS_XCQ + 64 * LQ_NQ * 4, LS_BV = LS_AA + 64 * LQ_NQ * 4, LS_HH = LS_BV + 64 * LQ_NQ * 4,
              LS_SP = LS_HH + 64 * LQ_NQ * 4, LS_SH = LS_SP + 8 * LQ_NQ * 4, LS_HC = LS_SH + 8 * LQ_NQ * 4, LS_BYTES = LS_HC + 2 * LQ_NQ * 4;
__device__ __forceinline__ void lru_unit_q(ArgsP a, LAS unsigned char* lds, int layer, int u) {
    const int tid = tid_(), lane = tid & 63, wave = tid >> 6, i16 = lane & 15, g4 = lane >> 4;
    const int lat = u < 64, uu = lat ? u : u - 64, bp = uu >> 4, e = (uu >> 3) & 1, g = (uu >> 1) & 3, oq = uu & 1;
    const int L = lat ? L_LAT : L_CTX;
    const int tokb[2] = {lat ? T_CTX + (2 * bp) * L_LAT : (2 * bp) * L_CTX, lat ? T_CTX + (2 * bp + 1) * L_LAT : (2 * bp + 1) * L_CTX};
    const bf16* G1 = (const bf16*)(a->ws + WS_G1);
    unsigned char* HO = e ? (unsigned char*)a->out + 2048 : a->ws + WS_HF;
    const size_t hstr = e ? 4096 : 512;
    const int tt = tid >> 3, q8 = (tid & 7) * 8;
    float cw[4][8], cb[8];
#pragma unroll
    for (int i = 0; i < 8; ++i) { const int ch = g * 64 + q8 + i; cb[i] = a->in[I_CONVB][layer * 256 + ch];
#pragma unroll
        for (int j = 0; j < 4; ++j) cw[j][i] = a->in[I_CONVW][(layer * 4 + j) * 256 + ch]; }
    const int gt = wave & 3, got = wave >> 2;
    const int ssn = tid >> 8, sch = tid & (LQ_NQ - 1), seg = (tid >> 5) & 7;
    const int otok = tid >> 3, oc4 = (tid & 7) * 4;
    const int chq = g * 64 + oq * LQ_NQ;
    LAS unsigned char* SS = lds + LQ_S0 + ssn * LS_BYTES;
    {
        __syncthreads();
        { const int m = tid >> 8, row = (tid >> 3) & 31, c8 = (tid & 7) * 8;
          const bf16* wsrc = (const bf16*)(a->ws + WS_LRUW) + ((size_t)(((layer * 2 + e) * 2 + m) * 4 + g) * 64 + oq * LQ_NQ + row) * 64 + c8;
          *(LAS v4u*)(lds + LQ_WAT + m * LQ_NQ * 144 + row * 144 + c8 * 2) = *(const v4u*)wsrc; }
        if (tid < 2 * LQ_NQ) { const int s = tid >> 5, c = tid & 31; ((LAS float*)(lds + LQ_S0 + s * LS_BYTES + LS_HC))[c] = lat ? a->in[I_SLRU][((size_t)((2 * bp + s) * 2 + layer) * 2 + e) * 256 + chq + c] : 0.f; }
        f32x4 bav, bxv, spl;
        { const int chb = (layer * 2 + e) * 256 + chq + 16 * got + 4 * g4;
          bav = *(const f32x4*)(a->in[I_BA] + chb); bxv = *(const f32x4*)(a->in[I_BX] + chb); const f32x4 lam = *(const f32x4*)(a->in[I_LAMBDA] + chb);
#pragma unroll
          for (int q = 0; q < 4; ++q) spl[q] = log1pf(exp_(-lam[q])); }
        v4u xr[2][4];
#define LQ_PREFETCH(cc_) do { const int c_ = e ? L / 64 - 1 - (cc_) : (cc_), t_ = c_ * 64 + tt; \
            _Pragma("unroll") for (int s = 0; s < 2; ++s) { \
              _Pragma("unroll") for (int j = 0; j < 4; ++j) { const int ts = t_ + j - 2; xr[s][j] = (ts >= 0 && ts < L) ? *(const v4u*)(G1 + (size_t)(tokb[s] + ts) * G1W + C_XL + g * 64 + q8) : (v4u){0u, 0u, 0u, 0u}; } \
              } } while (0)
        LQ_PREFETCH(0);
        __syncthreads();
        for (int cc = 0; cc < L / 64; ++cc) {
            const int c = e ? L / 64 - 1 - cc : cc;
            v4u xcur[2][4];
#pragma unroll
            for (int s = 0; s < 2; ++s) { xcur[s][0] = xr[s][0]; xcur[s][1] = xr[s][1]; xcur[s][2] = xr[s][2]; xcur[s][3] = xr[s][3]; }
            if (cc + 1 < L / 64) LQ_PREFETCH(cc + 1);
#pragma unroll
            for (int s = 0; s < 2; ++s) {
                LAS unsigned char* SB = lds + LQ_S0 + s * LS_BYTES;
                float xc[8];
#pragma unroll
                for (int i = 0; i < 8; ++i) xc[i] = cb[i];
#pragma unroll
                for (int j = 0; j < 4; ++j) { const v4u x = xcur[s][j];
                    xc[0] += cw[j][0] * bflo(x.x); xc[1] += cw[j][1] * bfhi(x.x); xc[2] += cw[j][2] * bflo(x.y); xc[3] += cw[j][3] * bfhi(x.y);
                    xc[4] += cw[j][4] * bflo(x.z); xc[5] += cw[j][5] * bfhi(x.z); xc[6] += cw[j][6] * bflo(x.w); xc[7] += cw[j][7] * bfhi(x.w); }
                *(LAS v4u*)(SB + LS_XCB + tt * 144 + q8 * 2) = (v4u){cvtpk(xc[0], xc[1]), cvtpk(xc[2], xc[3]), cvtpk(xc[4], xc[5]), cvtpk(xc[6], xc[7])};
                if ((q8 / LQ_NQ) == oq) { LAS float* XCQ = (LAS float*)(SB + LS_XCQ); *(LAS f32x4*)(XCQ + tt * LQ_NQ + (q8 % LQ_NQ)) = (f32x4){xc[0], xc[1], xc[2], xc[3]}; *(LAS f32x4*)(XCQ + tt * LQ_NQ + (q8 % LQ_NQ) + 4) = (f32x4){xc[4], xc[5], xc[6], xc[7]}; }
            }
            __syncthreads();
#pragma unroll
            for (int s = 0; s < 2; ++s) {
                LAS unsigned char* SB = lds + LQ_S0 + s * LS_BYTES;
                const int tk = gt * 16 + i16;
                f32x4 ga = (f32x4){0.f, 0.f, 0.f, 0.f}, gx = (f32x4){0.f, 0.f, 0.f, 0.f};
#pragma unroll
                for (int ks = 0; ks < 2; ++ks) { const bf16x8 xf = *(const LAS bf16x8*)(SB + LS_XCB + tk * 144 + ks * 64 + g4 * 16);
                    const bf16x8 wa = *(const LAS bf16x8*)(lds + LQ_WAT + (16 * got + i16) * 144 + ks * 64 + g4 * 16), wx = *(const LAS bf16x8*)(lds + LQ_WAT + LQ_NQ * 144 + (16 * got + i16) * 144 + ks * 64 + g4 * 16);
                    ga = MFMA16(wa, xf, ga); gx = MFMA16(wx, xf, gx); }
                const f32x4 xcv = *(const LAS f32x4*)((LAS float*)(SB + LS_XCQ) + tk * LQ_NQ + 16 * got + 4 * g4);
                f32x4 av, bv;
#pragma unroll
                for (int q = 0; q < 4; ++q) { const float la = -8.f * sigmoidf_(ga[q] + bav[q]) * spl[q], aq = exp_(la); av[q] = aq; bv[q] = sqrt_((1.f - aq) * (1.f + aq)) * sigmoidf_(gx[q] + bxv[q]) * xcv[q]; }
                *(LAS f32x4*)((LAS float*)(SB + LS_AA) + tk * LQ_NQ + 16 * got + 4 * g4) = av; *(LAS f32x4*)((LAS float*)(SB + LS_BV) + tk * LQ_NQ + 16 * got + 4 * g4) = bv;
            }
            __syncthreads();
            LAS float* AA = (LAS float*)(SS + LS_AA); LAS float* BV = (LAS float*)(SS + LS_BV); LAS float* HH = (LAS float*)(SS + LS_HH);
            LAS float* SP = (LAS float*)(SS + LS_SP); LAS float* SH = (LAS float*)(SS + LS_SH); LAS float* HC = (LAS float*)(SS + LS_HC);
            float av8[8], bv8[8];
            {
                float P = 1.f, H = 0.f;
#pragma unroll
                for (int s = 0; s < 8; ++s) { const int p = seg * 8 + s, st = e ? 63 - p : p; av8[s] = AA[st * LQ_NQ + sch]; bv8[s] = BV[st * LQ_NQ + sch]; H = fmaf(av8[s], H, bv8[s]); P *= av8[s]; }
                SP[seg * LQ_NQ + sch] = P; SH[seg * LQ_NQ + sch] = H;
            }
            __syncthreads();
            {
                float h = HC[(cc & 1) * LQ_NQ + sch];
                for (int s2 = 0; s2 < seg; ++s2) h = fmaf(SP[s2 * LQ_NQ + sch], h, SH[s2 * LQ_NQ + sch]);
#pragma unroll
                for (int s = 0; s < 8; ++s) { const int p = seg * 8 + s, st = e ? 63 - p : p; h = fmaf(av8[s], h, bv8[s]); HH[st * LQ_NQ + sch] = h; }
                if (seg == 7) HC[((cc + 1) & 1) * LQ_NQ + sch] = h;
            }
            __syncthreads();
#pragma unroll
            for (int s = 0; s < 2; ++s) {
                const int n = tokb[s] + c * 64 + otok;
                const f32x4 hv = *(const LAS f32x4*)((LAS float*)(lds + LQ_S0 + s * LS_BYTES + LS_HH) + otok * LQ_NQ + oc4);
                *(v2u*)(HO + (size_t)n * hstr + (chq + oc4) * 2) = (v2u){cvtpk(hv[0], hv[1]), cvtpk(hv[2], hv[3])};
            }
        }
#undef LQ_PREFETCH
        __syncthreads();
        if (tid < 2 * LQ_NQ && !lat) { const int s = tid >> 5, c = tid & 31; a->out[O_LRU + ((size_t)((2 * bp + s) * 2 + layer) * 2 + e) * 256 + chq + c] = ((LAS float*)(lds + LQ_S0 + s * LS_BYTES + LS_HC))[((L / 64) & 1) * LQ_NQ + c]; }
    }
}

constexpr int ATT2_VSTR = 144, ATT2_STAGE = 64 * ATT_KSTR + 64 * ATT2_VSTR;
#define ATT_KLOAD(KB_) \
        bf16x8 kfa_[6], kfb_[6]; \
        _Pragma("unroll") for (int ks_ = 0; ks_ < 6; ++ks_) { kfa_[ks_] = *(const LAS bf16x8*)((KB_) + r * ATT_KSTR + ks_ * 32 + hq * 16); kfb_[ks_] = *(const LAS bf16x8*)((KB_) + (32 + r) * ATT_KSTR + ks_ * 32 + hq * 16); }
#define ATT_VLOAD(VB_) \
        v2u va0_[4], va1_[4], vb0_[4], vb1_[4]; \
        _Pragma("unroll") for (int ks_ = 0; ks_ < 4; ++ks_) { \
            const LAS unsigned char* vp_ = (VB_) + (ks_ * 16 + 4 * hq + ((lane >> 2) & 3)) * ATT2_VSTR + (16 * ((lane >> 4) & 1) + 4 * (lane & 3)) * 2; \
            va0_[ks_] = __builtin_bit_cast(v2u, __builtin_amdgcn_ds_read_tr16_b64_v4i16((LAS s16x4_t*)(vp_))); \
            va1_[ks_] = __builtin_bit_cast(v2u, __builtin_amdgcn_ds_read_tr16_b64_v4i16((LAS s16x4_t*)(vp_ + 8 * ATT2_VSTR))); \
            vb0_[ks_] = __builtin_bit_cast(v2u, __builtin_amdgcn_ds_read_tr16_b64_v4i16((LAS s16x4_t*)(vp_ + 64))); \
            vb1_[ks_] = __builtin_bit_cast(v2u, __builtin_amdgcn_ds_read_tr16_b64_v4i16((LAS s16x4_t*)(vp_ + 8 * ATT2_VSTR + 64))); }
#define ATT_QKM(S0_, S1_) do { \
        _Pragma("unroll") for (int i_ = 0; i_ < 16; ++i_) { S0_[i_] = 0.f; S1_[i_] = 0.f; } \
        _Pragma("unroll") for (int ks_ = 0; ks_ < 6; ++ks_) { S0_ = MFMA32(kfa_[ks_], qf[ks_], S0_); S1_ = MFMA32(kfb_[ks_], qf[ks_], S1_); } } while (0)
#define ATT_STEP(SC0_, SC1_, SN0_, SN1_, KB_, VB_, HAVE_NEXT_) do { \
        ATT_KLOAD(KB_) \
        float mx_ = SC0_[0]; \
        _Pragma("unroll") for (int i_ = 1; i_ < 16; ++i_) mx_ = fmaxf(mx_, SC0_[i_]); \
        _Pragma("unroll") for (int i_ = 0; i_ < 16; ++i_) mx_ = fmaxf(mx_, SC1_[i_]); \
        mx_ = fmaxf(mx_, __shfl_xor(mx_, 32)); \
        if (!__all(mx_ - m <= 8.f)) { const float mn_ = fmaxf(m, mx_), al_ = __builtin_amdgcn_exp2f(m - mn_); m = mn_; l *= al_; \
            _Pragma("unroll") for (int i_ = 0; i_ < 16; ++i_) { o0[i_] *= al_; o1[i_] *= al_; } } \
        if (HAVE_NEXT_) ATT_QKM(SN0_, SN1_); \
        ATT_VLOAD(VB_) \
        float ps_ = 0.f; \
        _Pragma("unroll") for (int i_ = 0; i_ < 16; ++i_) { SC0_[i_] = __builtin_amdgcn_exp2f(SC0_[i_] - m); SC1_[i_] = __builtin_amdgcn_exp2f(SC1_[i_] - m); ps_ += SC0_[i_] + SC1_[i_]; } \
        l += ps_; \
        _Pragma("unroll") for (int ks_ = 0; ks_ < 4; ++ks_) { \
            v4u pw_; \
            if (ks_ == 0) { pw_.x = cvtpk(SC0_[0], SC0_[1]); pw_.y = cvtpk(SC0_[2], SC0_[3]); pw_.z = cvtpk(SC0_[4], SC0_[5]); pw_.w = cvtpk(SC0_[6], SC0_[7]); } \
            else if (ks_ == 1) { pw_.x = cvtpk(SC0_[8], SC0_[9]); pw_.y = cvtpk(SC0_[10], SC0_[11]); pw_.z = cvtpk(SC0_[12], SC0_[13]); pw_.w = cvtpk(SC0_[14], SC0_[15]); } \
            else if (ks_ == 2) { pw_.x = cvtpk(SC1_[0], SC1_[1]); pw_.y = cvtpk(SC1_[2], SC1_[3]); pw_.z = cvtpk(SC1_[4], SC1_[5]); pw_.w = cvtpk(SC1_[6], SC1_[7]); } \
            else { pw_.x = cvtpk(SC1_[8], SC1_[9]); pw_.y = cvtpk(SC1_[10], SC1_[11]); pw_.z = cvtpk(SC1_[12], SC1_[13]); pw_.w = cvtpk(SC1_[14], SC1_[15]); } \
            const bf16x8 pf_ = __builtin_bit_cast(bf16x8, pw_); \
            const v4u vwa_ = {va0_[ks_].x, va0_[ks_].y, va1_[ks_].x, va1_[ks_].y}, vwb_ = {vb0_[ks_].x, vb0_[ks_].y, vb1_[ks_].x, vb1_[ks_].y}; \
            o0 = MFMA32(__builtin_bit_cast(bf16x8, vwa_), pf_, o0); o1 = MFMA32(__builtin_bit_cast(bf16x8, vwb_), pf_, o1); } } while (0)
__device__ __forceinline__ void att_unit2(ArgsP a, LAS unsigned char* lds, int u) {
    const int tid = tid_(), lane = tid & 63, wave = tid >> 6, r = lane & 31, hq = lane >> 5;
    const bf16* KN = (const bf16*)(a->ws + WS_KN); const bf16* KR = (const bf16*)(a->ws + WS_KR); const bf16* VT = (const bf16*)(a->ws + WS_VT);
    bf16* Q = (bf16*)(a->ws + WS_Q); const bf16* G1 = (const bf16*)(a->ws + WS_G1);
    int b, h, n0, Lk, kidx0; size_t vbase;
    if (u < 512) { b = u >> 6; h = (u >> 3) & 7; n0 = T_CTX + b * 2048 + (u & 7) * 256; Lk = LK_LAT; kidx0 = T_CTX + b * LK_LAT; vbase = (size_t)VT_LAT + (size_t)(b * 8 + h) * 64 * LK_LAT; }
    else { const int uu = u - 512; b = uu >> 3; h = uu & 7; n0 = b * 256; Lk = 256; kidx0 = b * 256; vbase = (size_t)(b * 8 + h) * 64 * 256; }
    const int ntiles = Lk >> 6;
    const int n = n0 + wave * 32 + r;
    bf16x8 qf[6];
#pragma unroll
    for (int ks = 0; ks < 6; ++ks) qf[ks] = *(const bf16x8*)(Q + (size_t)n * 768 + h * 96 + ks * 16 + 8 * hq);
    const int key_k = tid >> 3, ck = tid & 7, key_r = (tid >> 2) & 63, cr = tid & 3;
    const bf16* gk = KN + (size_t)(kidx0 + key_k) * 512 + h * 64 + ck * 8;
    const bf16* gr = KR + (size_t)(kidx0 + key_r) * 32 + cr * 8;
    const bf16* gv = VT + (size_t)(kidx0 + key_k) * 512 + h * 64 + ck * 8;
    const unsigned sk = key_k * ATT_KSTR + ck * 16, sr = key_r * ATT_KSTR + 128 + cr * 16, sv = ATT_VOFF + key_k * ATT2_VSTR + ck * 16;
    v4u rkA, rrA = {0u, 0u, 0u, 0u}, rvA, rkB, rrB = {0u, 0u, 0u, 0u}, rvB;
#define ATT_LOAD(X_, j_) do { rk##X_ = *(const v4u*)(gk + (size_t)(j_) * 64 * 512); if (tid < 256) rr##X_ = *(const v4u*)(gr + (size_t)(j_) * 64 * 32); rv##X_ = *(const v4u*)(gv + (size_t)(j_) * 64 * 512); } while (0)
#define ATT_STORE(X_, B_) do { LAS unsigned char* nb_ = lds + (B_) * ATT2_STAGE; *(LAS v4u*)(nb_ + sk) = rk##X_; if (tid < 256) *(LAS v4u*)(nb_ + sr) = rr##X_; \
        *(LAS v4u*)(nb_ + sv) = rv##X_; } while (0)
    ATT_LOAD(A, 0); ATT_LOAD(B, 1);
    __syncthreads();
    ATT_STORE(A, 0);
    ATT_STORE(B, 1);
    ATT_LOAD(A, 2);
    __syncthreads();
    f32x16 o0, o1, sa0, sa1, sb0, sb1;
#pragma unroll
    for (int i = 0; i < 16; ++i) { o0[i] = 0.f; o1[i] = 0.f; }
    float m = -1e30f, l = 0.f;
    { ATT_KLOAD(lds) ATT_QKM(sa0, sa1); }
    int bcur = 0;
    int j = 0;
    for (; j < ntiles - 2; j += 2) {
        {
            const int b1 = bcur == 2 ? 0 : bcur + 1, b2 = b1 == 2 ? 0 : b1 + 1;
            ATT_LOAD(B, j + 3);
            ATT_STEP(sa0, sa1, sb0, sb1, lds + b1 * ATT2_STAGE, lds + bcur * ATT2_STAGE + ATT_VOFF, true);
            ATT_STORE(A, b2);
            __syncthreads();
            bcur = b1;
        }
        {
            const int b1 = bcur == 2 ? 0 : bcur + 1, b2 = b1 == 2 ? 0 : b1 + 1;
            if (j + 4 < ntiles) ATT_LOAD(A, j + 4);
            ATT_STEP(sb0, sb1, sa0, sa1, lds + b1 * ATT2_STAGE, lds + bcur * ATT2_STAGE + ATT_VOFF, true);
            ATT_STORE(B, b2);
            __syncthreads();
            bcur = b1;
        }
    }
    {
        { const int b1 = bcur == 2 ? 0 : bcur + 1;
          ATT_STEP(sa0, sa1, sb0, sb1, lds + b1 * ATT2_STAGE, lds + bcur * ATT2_STAGE + ATT_VOFF, true);
          bcur = b1; }
        { ATT_STEP(sb0, sb1, sa0, sa1, lds + bcur * ATT2_STAGE, lds + bcur * ATT2_STAGE + ATT_VOFF, false); }
        __syncthreads();
    }
#undef ATT_LOAD
#undef ATT_STORE
    v2u gmv[2][4];
#pragma unroll
    for (int mt = 0; mt < 2; ++mt)
#pragma unroll
        for (int g = 0; g < 4; ++g) gmv[mt][g] = *(const v2u*)(G1 + (size_t)n * G1W + C_GM + h * 64 + 32 * mt + 8 * g + 4 * hq);
    l += __shfl_xor(l, 32);
    const float inv = rcp_(l);
#pragma unroll
    for (int mt = 0; mt < 2; ++mt)
#pragma unroll
        for (int g = 0; g < 4; ++g) {
            const int dv0 = 32 * mt + 8 * g + 4 * hq;
            const v2u gm = gmv[mt][g];
            const float x0 = (mt ? o1[4 * g + 0] : o0[4 * g + 0]) * inv, x1 = (mt ? o1[4 * g + 1] : o0[4 * g + 1]) * inv, x2 = (mt ? o1[4 * g + 2] : o0[4 * g + 2]) * inv, x3 = (mt ? o1[4 * g + 3] : o0[4 * g + 3]) * inv;
            v2u ov; ov.x = cvtpk(x0 * siluf_(bflo(gm.x)), x1 * siluf_(bfhi(gm.x))); ov.y = cvtpk(x2 * siluf_(bflo(gm.y)), x3 * siluf_(bfhi(gm.y)));
            *(v2u*)(Q + (size_t)n * 768 + h * 96 + dv0) = ov;
        }
}
constexpr int N_PHASES = 14;

__device__ __forceinline__ void phase_b(ArgsP a, LAS unsigned char* lds, int layer) {
    volatile LAS unsigned* MISC = (volatile LAS unsigned*)(lds + LDS_MISC);
    unsigned* head = (unsigned*)(a->ws + WS_CTL) + CW_Q + layer * 64;
    for (;;) {
        __syncthreads();
        if (tid_() == 0) MISC[16] = atomicAdd(head, 1u);
        __syncthreads();
        const int idx = (int)MISC[16];
        if (idx >= 1408) break;
        if (idx < 64) rwkv_unit_mfma(a, lds, layer, idx);
        else if (idx < 128) lru_unit_q(a, lds, layer, idx - 64);
        else if (idx < 640) att_unit2(a, lds, idx - 128);
        else if (idx < 896) rwkv_unit_mfma(a, lds, layer, 64 + idx - 640);
        else if (idx < 1152) lru_unit_q(a, lds, layer, 64 + idx - 896);
        else att_unit2(a, lds, 512 + idx - 1152);
    }
}

#define ARGS_VIEW() ({ ArgsP p_ = (ArgsP)__builtin_amdgcn_kernarg_segment_ptr(); asm volatile("" : "+s"(p_)); p_; })
__global__ void __launch_bounds__(NTHREADS, 2) mk_fwd(Args args) {
    extern __shared__ __attribute__((aligned(16))) unsigned char lds_raw[];
    LAS unsigned char* lds = (LAS unsigned char*)lds_raw;
    volatile LAS unsigned* MISC = (volatile LAS unsigned*)(lds + LDS_MISC);
    for (int u = threadIdx.x; u < 64; u += NTHREADS) MISC[u] = 0u;
    __syncthreads();
    XcdBarrier bar;
    { ArgsP a = ARGS_VIEW(); bar = xcd_barrier_post((unsigned*)(a->ws + WS_CTL) + CW_BAR, MISC + 8); }
    int lo, hi; { ArgsP a = ARGS_VIEW(); lo = a->ph_lo; hi = a->ph_hi; }
#define IN(k) (lo <= (k) && (k) < hi)
#define SEAM(k) do { if (IN(k) && IN((k) + 1)) xcd_barrier(bar); } while (0)
    if (IN(0)) { ArgsP a = ARGS_VIEW(); phase_p0(a, lds); }
    SEAM(0);
    for (int layer = 0; layer < 2; ++layer) {
        const int p = 1 + 6 * layer;
        if (IN(p + 0)) { { ArgsP a = ARGS_VIEW(); phase_a0(a, layer); } if (layer == 0) { ArgsP a = ARGS_VIEW(); phase_p0_weights(a, lds); } }
        SEAM(p + 0);
        if (IN(p + 1)) { ArgsP a = ARGS_VIEW(); phase_a1_pg8(a, lds, layer); }
        SEAM(p + 1);
        if (IN(p + 2)) { { ArgsP a = ARGS_VIEW(); phase_a2a(a, layer); } xcd_barrier(bar); { ArgsP a = ARGS_VIEW(); phase_a2b(a, lds, layer); } }
        SEAM(p + 2);
        if (IN(p + 3)) { ArgsP a = ARGS_VIEW(); phase_b(a, lds, layer); }
        SEAM(p + 3);
        if (IN(p + 4)) { ArgsP a = ARGS_VIEW(); phase_c1(a, layer); }
        SEAM(p + 4);
        if (IN(p + 5)) { ArgsP a = ARGS_VIEW(); phase_c2_pg8(a, lds, layer); }
        SEAM(p + 5);
    }
    if (IN(N_PHASES - 1)) { ArgsP a = ARGS_VIEW(); phase_final(a); }
#undef IN
#undef SEAM
}

extern "C" void kernel_launch(void* const* d_in, const int* in_sizes, int n_in, void* d_out, int out_size, void* d_ws, size_t ws_size, hipStream_t stream) {
    static int grid = 0;
    if (grid == 0) {
        if (n_in != N_IN || ws_size < WS_END) { fprintf(stderr, "kernel_launch: unexpected n_in %d / ws_size %zu\n", n_in, ws_size); grid = -1; return; }
        int dev = 0, cus = 0;
        if (hipGetDevice(&dev) != hipSuccess || hipDeviceGetAttribute(&cus, hipDeviceAttributeMultiprocessorCount, dev) != hipSuccess) { grid = -1; return; }
        if (hipFuncSetAttribute((const void*)mk_fwd, hipFuncAttributeMaxDynamicSharedMemorySize, LDS_BYTES) != hipSuccess) { fprintf(stderr, "kernel_launch: hipFuncSetAttribute failed\n"); grid = -1; return; }
        int per_cu = 0;
        if (hipOccupancyMaxActiveBlocksPerMultiprocessor(&per_cu, (const void*)mk_fwd, NTHREADS, LDS_BYTES) != hipSuccess || per_cu < 1) fprintf(stderr, "kernel_launch: occupancy query reports %d\n", per_cu);
        (void)hipGetLastError();
        grid = cus;
    }
    if (grid < 0) return;
    if (hipMemsetAsync((char*)d_ws + WS_CTL, 0, CTL_ZERO_BYTES, stream) != hipSuccess) return;
    Args a{};
    for (int i = 0; i < N_IN; ++i) a.in[i] = (const float*)d_in[i];
    a.out = (float*)d_out; a.ws = (unsigned char*)d_ws;
    a.ph_lo = 0; a.ph_hi = N_PHASES;
    hipLaunchKernelGGL(mk_fwd, dim3(grid), dim3(NTHREADS), LDS_BYTES, stream, a);
}
```

```cpp
#include <hip/hip_runtime.h>
#include <cstdio>
#include <cstdint>

#define GAS __attribute__((address_space(1)))
#define LAS __attribute__((address_space(3)))
typedef unsigned short bf16;
typedef unsigned v4u __attribute__((ext_vector_type(4)));
typedef unsigned v2u __attribute__((ext_vector_type(2)));
typedef float f32x4 __attribute__((ext_vector_type(4)));
typedef short bf16x8 __attribute__((ext_vector_type(8)));

constexpr int D = 1024, T_CTX = 8192, T_LAT = 16384, T = 24576, L_CTX = 256, L_LAT = 2048, PAST = 256;
constexpr int NIN = 2816, G1W = 2304, G2W = 512;
constexpr int C_R = 0, C_K = 256, C_V = 512, C_G = 768, C_GM = 1024, C_XL = 1536, C_GL = 1792, C_LORA = 2048;
constexpr int LK_LAT = PAST + L_LAT;
constexpr int TK = T_CTX + 8 * LK_LAT;
constexpr int VT_LAT = 32 * 8 * 64 * 256;
constexpr float LN_EPS = 1e-5f, GN_EPS = 64e-5f;
constexpr float ALPHA = 1.4142135623730951f;
constexpr float QSCALE = 0.10206207261596575f * 1.4426950408889634f;
constexpr size_t O_Y = 0, O_RW = 25165824, O_CKV = 27262976, O_KR = 29360128, O_LRU = 29884416;
constexpr size_t MiB = 1u << 20;
constexpr size_t WS_CTL = 0, CTL_ZERO_BYTES = 1 * MiB;
constexpr size_t WS_MOD = 256 * 1024;
constexpr size_t WS_ROPE = 1 * MiB;
constexpr size_t WS_LORA2 = 1280 * 1024;
constexpr size_t WS_LRUW = 2816 * 1024;
constexpr size_t WS_STATS = 1536 * 1024;
constexpr size_t WS_WUQ = 2 * MiB;
constexpr size_t WS_WUKV = 3 * MiB;
constexpr size_t WS_WIN = 4 * MiB;
constexpr size_t WS_WOUT = 16 * MiB;
constexpr size_t WS_G1 = 20 * MiB;
constexpr size_t WS_G2 = 128 * MiB;
constexpr size_t WS_Q = 152 * MiB;
constexpr size_t WS_U = 152 * MiB;
constexpr size_t WS_KN = 188 * MiB;
constexpr size_t WS_KR = 214 * MiB;
constexpr size_t WS_VT = 216 * MiB;
constexpr size_t WS_YMIX = 188 * MiB;
constexpr size_t WS_HF = 242 * MiB;
constexpr size_t WS_END = 254 * MiB;
constexpr int CW_BAR = 4096;
constexpr int CW_Q = 16384;

__device__ __forceinline__ float bf2f(unsigned b) { return __uint_as_float(b << 16); }
__device__ __forceinline__ float bflo(unsigned w) { return __uint_as_float(w << 16); }
__device__ __forceinline__ float bfhi(unsigned w) { return __uint_as_float(w & 0xffff0000u); }
__device__ __forceinline__ unsigned f2bf(float f) { unsigned u = __float_as_uint(f); return (u + 0x7fffu + ((u >> 16) & 1u)) >> 16; }
__device__ __forceinline__ unsigned pk2(float lo, float hi) { return f2bf(lo) | (f2bf(hi) << 16); }
__device__ __forceinline__ float rcp_(float x) { return __builtin_amdgcn_rcpf(x); }
__device__ __forceinline__ float exp_(float x) { return __builtin_amdgcn_exp2f(x * 1.4426950408889634f); }
__device__ __forceinline__ float sqrt_(float x) { return __builtin_amdgcn_sqrtf(x); }
__device__ __forceinline__ float rsqrt_(float x) { return __builtin_amdgcn_rsqf(x); }
__device__ __forceinline__ float sigmoidf_(float x) { return rcp_(1.f + exp_(-x)); }
__device__ __forceinline__ float siluf_(float x) { return x * rcp_(1.f + exp_(-x)); }
template <int CTRL> __device__ __forceinline__ float dpp_f(float old, float x) { return __builtin_bit_cast(float, __builtin_amdgcn_update_dpp(__builtin_bit_cast(int, old), __builtin_bit_cast(int, x), CTRL, 0xf, 0xf, false)); }
__device__ __forceinline__ float row16_sum(float x) { x += dpp_f<0x128>(0.f, x); x += dpp_f<0x124>(0.f, x); x += dpp_f<0x122>(0.f, x); x += dpp_f<0x121>(0.f, x); return x; }
__device__ __forceinline__ float wave_sum_fast(float x) { x = row16_sum(x); x += __shfl_xor(x, 16); x += __shfl_xor(x, 32); return x; }
__device__ __forceinline__ float row16_prefix_prod(float x) { x *= dpp_f<0x111>(1.f, x); x *= dpp_f<0x112>(1.f, x); x *= dpp_f<0x114>(1.f, x); x *= dpp_f<0x118>(1.f, x); return x; }
__device__ __forceinline__ float wave_sum(float v) { return wave_sum_fast(v); }
__device__ __forceinline__ int tid_() { int t = threadIdx.x; asm volatile("" : "+v"(t)); return t; }
__device__ __forceinline__ int bid_() { int b = blockIdx.x; asm volatile("" : "+s"(b)); return b; }
__device__ __forceinline__ int grid_() { int g = gridDim.x; asm volatile("" : "+s"(g)); return g; }
typedef float f32x16 __attribute__((ext_vector_type(16)));
typedef float f32x2_t __attribute__((ext_vector_type(2)));
typedef __bf16 bf16x2_t __attribute__((ext_vector_type(2)));
__device__ __forceinline__ unsigned cvtpk(float lo, float hi) { const f32x2_t v = {lo, hi}; return __builtin_bit_cast(unsigned, __builtin_convertvector(v, bf16x2_t)); }
#define XB_TMO      128
#define XB_XCNT(j)  (256  + 64 * (j))
#define XB_XSUB(j)  (1280 + 64 * (j))
#define XB_XGEN(j)  (2304 + 64 * (j))
#define XB_TOP      3328
#define XB_TOPGEN   3392
#define XCD_BAR_WORDS 3456
#define XB_SPIN_CAP (1u << 24)

__device__ __forceinline__ unsigned xb_ld(unsigned* p)              { return __hip_atomic_load(p, __ATOMIC_RELAXED, __HIP_MEMORY_SCOPE_AGENT); }
__device__ __forceinline__ unsigned xb_add(unsigned* p, unsigned v) { return __hip_atomic_fetch_add(p, v, __ATOMIC_RELAXED, __HIP_MEMORY_SCOPE_AGENT); }
__device__ __forceinline__ unsigned xb_xcc_id() { return (unsigned)__builtin_amdgcn_s_getreg((3 << 11) | 20) & 0xFu; }
#define XB_SPIN(cond, bar) do { unsigned _sp = 0; while (cond) { __builtin_amdgcn_s_sleep(1); \
    if ((++_sp & 255u) == 0u) { if (xb_ld(&(bar)[XB_TMO])) break; if (_sp > XB_SPIN_CAP) { atomicAdd(&(bar)[XB_TMO], 1u); break; } } } } while (0)

struct XcdBarrier {
    unsigned* bar; unsigned x;
    volatile LAS unsigned* st;
};

__device__ __forceinline__ XcdBarrier xcd_barrier_post(unsigned* bar, volatile LAS unsigned* st) {
    XcdBarrier b; b.bar = bar; b.x = xb_xcc_id(); b.st = st;
    if (threadIdx.x == 0) (void)xb_add(&bar[XB_XCNT(b.x)], 1u);
    return b;
}
__device__ __forceinline__ void xcd_barrier_complete(unsigned* bar, unsigned x, unsigned& nloc, unsigned& nx) {
    const unsigned G = gridDim.x * gridDim.y * gridDim.z;
    unsigned sum, cnt, mine, sp = 0u;
    for (;;) {
        sum = 0u; cnt = 0u; mine = 0u;
#pragma unroll
        for (unsigned j = 0; j < 16; ++j) { const unsigned c = xb_ld(&bar[XB_XCNT(j)]); sum += c; cnt += (c > 0u) ? 1u : 0u; mine = (j == x) ? c : mine; }
        if (sum == G) break;
        __builtin_amdgcn_s_sleep(1);
        if ((++sp & 255u) == 0u) { if (xb_ld(&bar[XB_TMO])) break; if (sp > XB_SPIN_CAP) { atomicAdd(&bar[XB_TMO], 1u); break; } }
    }
    nloc = mine > 0u ? mine : 1u; nx = cnt > 0u ? cnt : 1u;
}

__device__ __forceinline__ void xcd_barrier(const XcdBarrier& b) {
    asm volatile("s_waitcnt vmcnt(0)" ::: "memory");
    __syncthreads();
    if (threadIdx.x == 0) {
        unsigned* bar = b.bar;
        __builtin_amdgcn_s_waitcnt(0);
        unsigned nloc = b.st[0], nx = b.st[1];
        if (nloc == 0u) { xcd_barrier_complete(bar, b.x, nloc, nx); b.st[0] = nloc; b.st[1] = nx; }
        const unsigned old = xb_add(&bar[XB_XSUB(b.x)], 1u);
        const unsigned gen = old / nloc;
        if (old + 1u == (gen + 1u) * nloc) {
            __builtin_amdgcn_fence(__ATOMIC_RELEASE, "agent");
            asm volatile("s_waitcnt vmcnt(0)" ::: "memory");
            const unsigned og = xb_add(&bar[XB_TOP], 1u);
            const unsigned tg = og / nx;
            if (og + 1u == (tg + 1u) * nx) xb_add(&bar[XB_TOPGEN], 1u);
            else XB_SPIN(xb_ld(&bar[XB_TOPGEN]) == tg, bar);
            __builtin_amdgcn_fence(__ATOMIC_ACQUIRE, "agent");
            xb_add(&bar[XB_XGEN(b.x)], 1u);
            asm volatile("s_waitcnt vmcnt(0)" ::: "memory");
        } else {
            XB_SPIN(xb_ld(&bar[XB_XGEN(b.x)]) == gen, bar);
            __builtin_amdgcn_fence(__ATOMIC_ACQUIRE, "agent");
            asm volatile("s_waitcnt vmcnt(0)" ::: "memory");
        }
    }
    __syncthreads();
}
enum { I_XP = 0, I_XS, I_SRW, I_CCKV, I_CKR, I_SLRU, I_C, I_CCTX, I_WMOD, I_BMOD, I_WIN, I_W0, I_W1, I_W2, I_A0, I_A1, I_A2, I_KK, I_KA, I_RK,
       I_LNXG, I_LNXB, I_QNORM, I_WUQ, I_KVNORM, I_WUKV, I_CONVW, I_CONVB, I_WA, I_BA, I_WX, I_BX, I_LAMBDA, I_WOUT, I_LNG, I_LNB, N_IN };
struct Args { const float* in[N_IN]; float* out; unsigned char* ws; int ph_lo, ph_hi; };
typedef const Args __attribute__((address_space(4)))* ArgsP;
constexpr int NTHREADS = 512;
constexpr int LDS_MISC = 139264;
constexpr int LDS_BYTES = 147456;

struct Tok { int n, b, t, L, lat, modrow, tok0, kidx; };
__device__ __forceinline__ Tok tok_of(int n) {
    Tok k; k.n = n;
    if (n < T_CTX) { k.lat = 0; k.b = n >> 8; k.t = n & 255; k.L = L_CTX; k.modrow = 0; k.tok0 = k.b * 256; k.kidx = n; }
    else { const int m = n - T_CTX; k.lat = 1; k.b = m >> 11; k.t = m & 2047; k.L = L_LAT; k.modrow = 1 + k.b; k.tok0 = T_CTX + k.b * 2048; k.kidx = T_CTX + k.b * LK_LAT + PAST + k.t; }
    return k;
}
__device__ __forceinline__ const float* xrow_src(ArgsP a, int layer, int n) {
    if (layer == 0) return n < T_CTX ? a->in[I_XP] + (size_t)n * D : a->in[I_XS] + (size_t)(n - T_CTX) * D;
    return a->out + (size_t)n * D;
}
__device__ __forceinline__ float dot8(v4u a, v4u b, float acc) {
    acc = fmaf(bflo(a.x), bflo(b.x), acc); acc = fmaf(bfhi(a.x), bfhi(b.x), acc);
    acc = fmaf(bflo(a.y), bflo(b.y), acc); acc = fmaf(bfhi(a.y), bfhi(b.y), acc);
    acc = fmaf(bflo(a.z), bflo(b.z), acc); acc = fmaf(bfhi(a.z), bfhi(b.z), acc);
    acc = fmaf(bflo(a.w), bflo(b.w), acc); acc = fmaf(bfhi(a.w), bfhi(b.w), acc);
    return acc;
}

__device__ __forceinline__ void tr_item(const float* src, int ld, int col0, int k0, bf16* WT, int K, int row0, float scale, LAS float* scr, int lane) {
    {
        const int kr = lane >> 3, n4 = (lane & 7) * 4;
        f32x4 v[8];
#pragma unroll
        for (int i = 0; i < 8; ++i) v[i] = src ? *(const f32x4*)(src + (size_t)(k0 + i * 8 + kr) * ld + col0 + n4) : (f32x4){0.f, 0.f, 0.f, 0.f};
#pragma unroll
        for (int i = 0; i < 8; ++i) { LAS float* d = scr + (i * 8 + kr) * 33 + n4; d[0] = v[i].x * scale; d[1] = v[i].y * scale; d[2] = v[i].z * scale; d[3] = v[i].w * scale; }
    }
    asm volatile("s_waitcnt lgkmcnt(0)" ::: "memory");
    const int c = lane & 7;
#pragma unroll
    for (int j = 0; j < 4; ++j) { const int n = (lane >> 3) + 8 * j; const LAS float* s = scr + (8 * c) * 33 + n;
        v4u o; o.x = pk2(s[0 * 33], s[1 * 33]); o.y = pk2(s[2 * 33], s[3 * 33]); o.z = pk2(s[4 * 33], s[5 * 33]); o.w = pk2(s[6 * 33], s[7 * 33]);
        *(v4u*)(WT + (size_t)(row0 + n) * K + k0 + 8 * c) = o; }
    asm volatile("s_waitcnt lgkmcnt(0)" ::: "memory");
}
__device__ __forceinline__ void rope_angle(int t, int i, float& c, float& s) {
    const int row = t >> 6, col = t & 63; const int ii = i & 7;
    const float inv = exp2f(-(float)ii * (13.287712379549449f / 8.f));
    const float ang = (float)(i < 8 ? row : col) * inv;
    c = cosf(ang); s = sinf(ang);
}
__device__ __forceinline__ void phase_p0_weights(ArgsP a, LAS unsigned char* lds) {
    const int tid = tid_(), lane = tid & 63, wave = tid >> 6, G = grid_();
    unsigned char* ws = a->ws;
    LAS float* scr = (LAS float*)(lds + wave * 8704);
    const int gw = bid_() * 8 + wave, NGW = G * 8;
    constexpr int N_WIN = 2 * 16 * 88, N_WOUT = 2 * 16 * 32, N_WUQ = 2 * 4 * 24, N_WUKV = 2 * 4 * 32, N_LORA = 2 * 2 * 2 * 8, N_LRUW = 2 * 2 * 2 * 4 * 2;
    for (int it = gw; it < N_WIN + N_WOUT + N_WUQ + N_WUKV + N_LORA + N_LRUW; it += NGW) {
        int r = it;
        if (r < N_WIN) {
            const int l = r / (16 * 88), kb = (r / 88) % 16, nb = r % 88, j0 = nb * 32;
            const float* src; int ld, col0;
            const float* win = a->in[I_WIN] + (size_t)l * 1024 * 2464;
            if (j0 < 1024) { src = win; ld = 2464; col0 = j0; }
            else if (j0 < 1536) { src = win; ld = 2464; col0 = 1440 + (j0 - 1024); }
            else if (j0 < 1792) { src = win; ld = 2464; col0 = 1952 + (j0 - 1536); }
            else if (j0 < 2048) { src = win; ld = 2464; col0 = 2208 + (j0 - 1792); }
            else if (j0 < 2304) { const int q = (j0 - 2048) >> 6; src = (q < 2 ? a->in[I_W1] : a->in[I_A1]) + (size_t)(l * 2 + (q & 1)) * 1024 * 64; ld = 64; col0 = (j0 - 2048) & 63; }
            else if (j0 < 2560) { src = win; ld = 2464; col0 = 1024 + (j0 - 2304); }
            else if (j0 < 2688) { src = win; ld = 2464; col0 = 1280 + (j0 - 2560); }
            else if (j0 < 2720) { src = win; ld = 2464; col0 = 1408 + (j0 - 2688); }
            else { src = nullptr; ld = 0; col0 = 0; }
            tr_item(src, ld, col0, kb * 64, (bf16*)(ws + WS_WIN) + (size_t)l * NIN * 1024, 1024, j0, 1.f, scr, lane);
            continue;
        }
        r -= N_WIN;
        if (r < N_WOUT) { const int l = r / (16 * 32), kb = (r / 32) % 16, nb = r % 32;
            tr_item(a->in[I_WOUT] + (size_t)l * 1024 * 1024, 1024, nb * 32, kb * 64, (bf16*)(ws + WS_WOUT) + (size_t)l * 1024 * 1024, 1024, nb * 32, 1.f, scr, lane); continue; }
        r -= N_WOUT;
        if (r < N_WUQ) { const int l = r / (4 * 24), kb = (r / 24) % 4, nb = r % 24;
            tr_item(a->in[I_WUQ] + (size_t)l * 256 * 768, 768, nb * 32, kb * 64, (bf16*)(ws + WS_WUQ) + (size_t)l * 768 * 256, 256, nb * 32, QSCALE, scr, lane); continue; }
        r -= N_WUQ;
        if (r >= N_WUKV) { r -= N_WUKV;
            if (r < N_LORA) { const int le = r >> 4, m = (r >> 3) & 1, nb = r & 7;
                tr_item((m ? a->in[I_A2] : a->in[I_W2]) + (size_t)le * 64 * 256, 256, nb * 32, 0, (bf16*)(ws + WS_LORA2) + (size_t)(le * 2 + m) * 256 * 64, 64, nb * 32, 1.f, scr, lane); }
            else { r -= N_LORA; const int le = r >> 4, m = (r >> 3) & 1, g = (r >> 1) & 3, nb = r & 1;
                tr_item((m ? a->in[I_WX] : a->in[I_WA]) + (size_t)(le * 4 + g) * 4096, 64, nb * 32, 0, (bf16*)(ws + WS_LRUW) + (size_t)((le * 2 + m) * 4 + g) * 4096, 64, nb * 32, 1.f, scr, lane); }
            continue; }
        { const int l = r / (4 * 32), kb = (r / 32) % 4, nb = r % 32;
            tr_item(kb < 2 ? a->in[I_WUKV] + (size_t)l * 128 * 1024 : nullptr, 1024, nb * 32, kb * 64, (bf16*)(ws + WS_WUKV) + (size_t)l * 1024 * 256, 256, nb * 32, 1.f, scr, lane); }
    }
}
__device__ __forceinline__ void phase_p0(ArgsP a, LAS unsigned char* lds) {
    const int tid = tid_(), G = grid_();
    unsigned char* ws = a->ws;
    { float* ROPE = (float*)(ws + WS_ROPE);
      for (int i = bid_() * NTHREADS + tid; i < 2048 * 16; i += G * NTHREADS) { float c, s; rope_angle(i >> 4, i & 15, c, s); ROPE[i * 2] = c; ROPE[i * 2 + 1] = s; } }
    float* MOD = (float*)(ws + WS_MOD);
    LAS float* SIL = (LAS float*)lds;
    for (int it = bid_(); it < 2 * 6 * 32; it += G) {
        const int l = it / 192, nb = (it / 32) % 6, kq = it % 32, col = nb * 512 + tid;
        __syncthreads();
        if (tid < 288) { const int j = tid >> 5, k = kq * 32 + (tid & 31); const float cj = (j == 0) ? a->in[I_CCTX][k] : a->in[I_C][(j - 1) * 1024 + k]; SIL[tid] = siluf_(cj); }
        float w[32];
#pragma unroll
        for (int kk = 0; kk < 32; ++kk) w[kk] = a->in[I_WMOD][((size_t)l * 1024 + kq * 32 + kk) * 3072 + col];
        __syncthreads();
        const float bias = (kq == 0) ? a->in[I_BMOD][l * 3072 + col] : 0.f;
#pragma unroll
        for (int j = 0; j < 9; ++j) { float acc = bias;
#pragma unroll
            for (int k4 = 0; k4 < 8; ++k4) { const f32x4 sv = *(const LAS f32x4*)(SIL + j * 32 + k4 * 4); acc = fmaf(sv.x, w[k4 * 4], acc); acc = fmaf(sv.y, w[k4 * 4 + 1], acc); acc = fmaf(sv.z, w[k4 * 4 + 2], acc); acc = fmaf(sv.w, w[k4 * 4 + 3], acc); }
            atomicAdd(&MOD[(l * 9 + j) * 3072 + col], acc); }
    }
}

template <int LAYER> __device__ __forceinline__ void a0_rows(ArgsP a, LAS unsigned char* lds) {
    const int tid = tid_(), lane = tid & 63, wave = tid >> 6, G = grid_();
    bf16* U = (bf16*)(a->ws + WS_U);
    LAS float* ML = (LAS float*)lds;
    { const float* MOD = (const float*)(a->ws + WS_MOD) + (size_t)LAYER * 9 * 3072;
      for (int i = tid; i < 9 * 512; i += NTHREADS) { const int r = i >> 9, c4 = (i & 511) * 4; *(LAS f32x4*)(ML + r * 2048 + c4) = *(const f32x4*)(MOD + r * 3072 + c4); } }
    f32x4 gq[4], bq[4];
#pragma unroll
    for (int j = 0; j < 4; ++j) { gq[j] = LAYER ? *(const f32x4*)(a->in[I_LNG] + lane * 4 + 256 * j) : (f32x4){0.f, 0.f, 0.f, 0.f}; bq[j] = LAYER ? *(const f32x4*)(a->in[I_LNB] + lane * 4 + 256 * j) : (f32x4){0.f, 0.f, 0.f, 0.f}; }
    __syncthreads();
    f32x4 ra[4], rb[4];
    auto load = [&](f32x4 (&r)[4], int nn) __attribute__((always_inline)) {
        if (LAYER == 0) { const float* xr = xrow_src(a, 0, nn);
#pragma unroll
            for (int j = 0; j < 4; ++j) r[j] = *(const f32x4*)(xr + lane * 4 + 256 * j); }
        else { const bf16* zr = (const bf16*)a->out + (size_t)nn * 2048;
#pragma unroll
            for (int j = 0; j < 4; ++j) { const v2u w = *(const v2u*)(zr + lane * 4 + 256 * j); r[j].x = __uint_as_float(w.x); r[j].y = __uint_as_float(w.y); } }
    };
    const int stride = G * 8, n0 = bid_() * 8 + wave;
    if (n0 < T) load(ra, n0);
    if (n0 + stride < T) load(rb, n0 + stride);
    auto row = [&](int n, f32x4 (&r)[4]) __attribute__((always_inline)) {
        const Tok tk = tok_of(n);
        f32x4 v[4]; float s = 0.f;
#pragma unroll
        for (int j = 0; j < 4; ++j) {
            if (LAYER == 0) v[j] = r[j] * 1.f;
            else { const unsigned wx = __float_as_uint(r[j].x), wy = __float_as_uint(r[j].y); v[j] = (f32x4){bflo(wx), bfhi(wx), bflo(wy), bfhi(wy)}; }
            s += (v[j].x + v[j].y) + (v[j].z + v[j].w); }
#pragma unroll
        for (int j = 0; j < 4; ++j) asm volatile("" : "+v"(v[j]));
        if (n + 2 * stride < T) load(r, n + 2 * stride);
        float mean = wave_sum(s) * (1.f / D), s2 = 0.f;
#pragma unroll
        for (int j = 0; j < 4; ++j) { v[j] = v[j] - mean; s2 += (v[j].x * v[j].x + v[j].y * v[j].y) + (v[j].z * v[j].z + v[j].w * v[j].w); }
        float rstd = rsqrt_(wave_sum(s2) * (1.f / D) + LN_EPS);
        if (LAYER == 1) {
            s = 0.f;
#pragma unroll
            for (int j = 0; j < 4; ++j) { v[j] = v[j] * rstd * gq[j] + bq[j]; s += (v[j].x + v[j].y) + (v[j].z + v[j].w); }
            if (lane == 0) { float* st = (float*)(a->ws + WS_STATS) + (size_t)n * 2; st[0] = mean; st[1] = rstd; }
            mean = wave_sum(s) * (1.f / D); s2 = 0.f;
#pragma unroll
            for (int j = 0; j < 4; ++j) { v[j] = v[j] - mean; s2 += (v[j].x * v[j].x + v[j].y * v[j].y) + (v[j].z * v[j].z + v[j].w * v[j].w); }
            rstd = rsqrt_(wave_sum(s2) * (1.f / D) + LN_EPS);
        }
        const LAS float* m = ML + tk.modrow * 2048;
#pragma unroll
        for (int j = 0; j < 4; ++j) { const int c = lane * 4 + 256 * j; const f32x4 sh = *(const LAS f32x4*)(m + c), sc = *(const LAS f32x4*)(m + 1024 + c);
            const f32x4 o = v[j] * rstd * (sc + 1.f) + sh;
            v2u p; p.x = pk2(o.x, o.y); p.y = pk2(o.z, o.w); *(v2u*)(U + (size_t)n * D + c) = p; }
    };
    for (int n = n0; n < T; n += 2 * stride) { row(n, ra); if (n + stride < T) row(n + stride, rb); }
    __syncthreads();
}
__device__ __forceinline__ void phase_a0(ArgsP a, LAS unsigned char* lds, int layer) {
    if (layer == 0) a0_rows<0>(a, lds); else a0_rows<1>(a, lds);
}
__device__ __forceinline__ void phase_final(ArgsP a) {
    const int tid = tid_(), lane = tid & 63, wave = tid >> 6, G = grid_();
    f32x4 nx[4];
#define FN_LOAD(nn_) do { const bf16* zr_ = (const bf16*)a->out + (size_t)(nn_) * 2048; \
        _Pragma("unroll") for (int j = 0; j < 4; ++j) { const v2u w_ = *(const v2u*)(zr_ + lane * 4 + 256 * j); nx[j] = (f32x4){bflo(w_.x), bfhi(w_.x), bflo(w_.y), bfhi(w_.y)}; } } while (0)
    { const int n0 = bid_() * 8 + wave; if (n0 < T) FN_LOAD(n0); }
    for (int n = bid_() * 8 + wave; n < T; n += G * 8) {
        float* xr = a->out + (size_t)n * D;
        f32x4 v[4]; float s = 0.f;
#pragma unroll
        for (int j = 0; j < 4; ++j) { v[j] = nx[j]; s += (v[j].x + v[j].y) + (v[j].z + v[j].w); }
        if (n + G * 8 < T) FN_LOAD(n + G * 8);
        const float mean = wave_sum(s) * (1.f / D); float s2 = 0.f;
#pragma unroll
        for (int j = 0; j < 4; ++j) { v[j] = v[j] - mean; s2 += (v[j].x * v[j].x + v[j].y * v[j].y) + (v[j].z * v[j].z + v[j].w * v[j].w); }
        const float rstd = rsqrt_(wave_sum(s2) * (1.f / D) + LN_EPS);
#pragma unroll
        for (int j = 0; j < 4; ++j) { const f32x4 g = *(const f32x4*)(a->in[I_LNG] + 1024 + lane * 4 + 256 * j), b = *(const f32x4*)(a->in[I_LNB] + 1024 + lane * 4 + 256 * j);
            *(f32x4*)(xr + lane * 4 + 256 * j) = v[j] * rstd * g + b; }
    }
}


namespace pg8 {
#define PG8_LAS __attribute__((address_space(3)))
typedef unsigned short bf16_t;
typedef short bf16x8 __attribute__((ext_vector_type(8)));
typedef float f32x4 __attribute__((ext_vector_type(4)));
typedef unsigned u32x4 __attribute__((ext_vector_type(4)));
constexpr int BM = 256, BK = 64, HALF = 128, HTB = HALF * BK * 2  , STAGE_BYTES = 8 * HTB, NXCD = 8, WGM = 8;

__host__ __device__ __forceinline__ int lds_byte(int r, int c) { const int st = (r >> 4) * 2 + (c >> 5), rr = r & 15, cc = c & 31, ob = rr * 64 + cc * 2; return st * 1024 + (ob ^ (((ob >> 9) & 1) << 5)); }
__host__ __device__ __forceinline__ void stage_rc(int b, int& R, int& C) { const int st = b / 1024, sb = b % 1024, swz = sb ^ (((sb >> 9) & 1) << 5); R = (st >> 1) * 16 + swz / 64; C = (st & 1) * 32 + (swz % 64) / 2; }
__host__ __device__ __forceinline__ int perm32(int rho) { const int n = rho >> 4, i = rho & 15; return 8 * (i >> 2) + 4 * n + (i & 3); }

struct Unit { int pm, pn, gid; };
struct Gemm { const bf16_t* A; const bf16_t* Bt; int M, N, K, lda, ldb; };

struct StaticOrder {
    int nM, nN, nwg, G, c;
    __host__ __device__ void init(int M, int N, int G_, int c_) { nM = M / BM; nN = N / BM; nwg = nM * nN; G = G_; c = c_; }
    __host__ __device__ bool next(int i, Unit& u) const {
        const long L = (long)i * G + c; if (L >= nwg) return false;
        int wgid = (int)L; { const int q = nwg / NXCD, r = nwg % NXCD, xcd = wgid % NXCD, off = wgid / NXCD; wgid = (xcd < r ? xcd * (q + 1) : r * (q + 1) + (xcd - r) * q) + off; }
        const int nig = WGM * nN, gid = wgid / nig, fm = gid * WGM, gsz = (nM - fm) < WGM ? (nM - fm) : WGM;
        u.pm = fm + ((wgid % nig) % gsz); u.pn = (wgid % nig) / gsz; u.gid = 0; return true;
    }
    __device__ __forceinline__ const char* abase(const Gemm& g, const Unit& u) const { return (const char*)g.A + (size_t)u.pm * BM * g.lda * 2; }
    __device__ __forceinline__ const char* bbase(const Gemm& g, const Unit& u) const { return (const char*)g.Bt + (size_t)u.pn * BM * g.ldb * 2; }
    __device__ __forceinline__ void a_ready(const Unit&) const {}
    __device__ __forceinline__ void done(const Unit&) const {}
};
__device__ __forceinline__ unsigned cvt_pk_bf16(float lo, float hi) { unsigned r; asm volatile("v_cvt_pk_bf16_f32 %0, %1, %2" : "=v"(r) : "v"(lo), "v"(hi)); return r; }

template <class Epi, class Sched, bool STAMP = false>
__device__ __forceinline__ void gemm_phase(PG8_LAS unsigned char* lds, const Gemm g, const Sched& S, const Epi& E, unsigned long long* stamps) {
    const int tid = tid_(), wid = __builtin_amdgcn_readfirstlane(tid >> 6), lane = tid & 63, wr = wid >> 2, wc = wid & 3, fr = lane & 15, fq = lane >> 4;
    const int K = g.K, nt = K / BK;
    int ts_lo = 0, ts_hi = 0, nts = 0; const unsigned long long rt_entry = STAMP ? (unsigned long long)wall_clock64() : 0ull;
#define PG8_STAMP() do { if (STAMP && wid == 0 && nts < 64) { const unsigned long long _c = (unsigned long long)clock64(); \
        ts_lo = (lane == nts) ? (int)(unsigned)_c : ts_lo; ts_hi = (lane == nts) ? (int)(unsigned)(_c >> 32) : ts_hi; ++nts; } } while (0)
    PG8_STAMP();
    unsigned voffA[2], voffB[2];
#pragma unroll
    for (int i = 0; i < 2; ++i) { int R, C; stage_rc(tid * 16 + i * 8192, R, C); const int Rb = Epi::PERM ? ((R & ~31) + perm32(R & 31)) : R;
        voffA[i] = (unsigned)(R * g.lda + C) * 2u; voffB[i] = (unsigned)(Rb * g.ldb + C) * 2u; }
    const size_t kstep = (size_t)(BK * 2);
    const size_t hstepA = (size_t)HALF * g.lda * 2, hstepB = (size_t)HALF * g.ldb * 2;
    const unsigned ldsw = (unsigned)wid * 1024u;
    const int aoff = lds_byte(wr * 64 + fr, fq * 8), boff = lds_byte(wc * 32 + fr, fq * 8);
#define PG8_SA(b, h) (((b) * 2 + (h)) * HTB)
#define PG8_SB(b, h) ((4 + (b) * 2 + (h)) * HTB)
#define PG8_STAGE(bufoff, gbase, voff) do { _Pragma("unroll") for (int _i = 0; _i < 2; ++_i) \
        __builtin_amdgcn_global_load_lds((const unsigned*)((const char*)(gbase) + (voff)[_i]), (PG8_LAS unsigned*)(lds + (bufoff) + ldsw + _i * 8192), 16, 0, 0); } while (0)
#define PG8_LDA(dst, b, h) do { _Pragma("unroll") for (int m = 0; m < 4; ++m) _Pragma("unroll") for (int k = 0; k < 2; ++k) dst[m][k] = *(const PG8_LAS bf16x8*)(lds + PG8_SA(b, h) + aoff + m * 2048 + k * 1024); } while (0)
#define PG8_LDB(dst, b, h) do { _Pragma("unroll") for (int n = 0; n < 2; ++n) _Pragma("unroll") for (int k = 0; k < 2; ++k) dst[n][k] = *(const PG8_LAS bf16x8*)(lds + PG8_SB(b, h) + boff + n * 2048 + k * 1024); } while (0)
#define PG8_MMA(ai, bj, At, Bt) do { __builtin_amdgcn_s_setprio(1); _Pragma("unroll") for (int m = 0; m < 4; ++m) _Pragma("unroll") for (int n = 0; n < 2; ++n) _Pragma("unroll") for (int k = 0; k < 2; ++k) \
        acc[ai][bj][m][n] = __builtin_amdgcn_mfma_f32_16x16x32_bf16(Bt[n][k], At[m][k], acc[ai][bj][m][n], 0, 0, 0); __builtin_amdgcn_s_setprio(0); } while (0)
#define PG8_WAIT_V(n) asm volatile("s_waitcnt vmcnt(" #n ")" ::: "memory")
#define PG8_WAIT_L(n) asm volatile("s_waitcnt lgkmcnt(" #n ")" ::: "memory")
#define PG8_BAR __builtin_amdgcn_s_barrier()
#define PG8_SCHED __builtin_amdgcn_sched_barrier(0)
    Unit cur, nxt; int ui = 0;
    if (!S.next(0, cur)) return;
    f32x4 acc[2][2][4][2];
#pragma unroll
    for (int a = 0; a < 2; ++a)
#pragma unroll
        for (int b = 0; b < 2; ++b)
#pragma unroll
            for (int m = 0; m < 4; ++m)
#pragma unroll
                for (int n = 0; n < 2; ++n) acc[a][b][m][n] = (f32x4){0.f, 0.f, 0.f, 0.f};
    bf16x8 At[4][2], B0[2][2], B1[2][2];
    const char* cA = S.abase(g, cur); const char* cB = S.bbase(g, cur);
    S.a_ready(cur);
    PG8_STAGE(PG8_SB(0, 0), cB, voffB); PG8_STAGE(PG8_SA(0, 0), cA, voffA); PG8_STAGE(PG8_SB(0, 1), cB + hstepB, voffB); PG8_STAGE(PG8_SA(0, 1), cA + hstepA, voffA);
    if (wr == 1) PG8_BAR;
    PG8_WAIT_V(4); PG8_BAR;
    PG8_STAGE(PG8_SB(1, 0), cB + kstep, voffB); PG8_STAGE(PG8_SA(1, 0), cA + kstep, voffA); PG8_STAGE(PG8_SB(1, 1), cB + hstepB + kstep, voffB);
    PG8_WAIT_V(6); PG8_BAR;
    PG8_STAMP();
    for (;;) {
        const bool has_next = S.next(ui + 1, nxt);
        const char* nA = has_next ? S.abase(g, nxt) : cA; const char* nB = has_next ? S.bbase(g, nxt) : cB;
        for (int t = 0; t < nt; t += 2) {
            const bool last = (t == nt - 2);
            const char* a1 = cA + (size_t)(t + 1) * kstep;
            const char* a2 = last ? nA : cA + (size_t)(t + 2) * kstep; const char* b2 = last ? nB : cB + (size_t)(t + 2) * kstep;
            const char* a3 = a2 + kstep; const char* b3 = b2 + kstep;
            if (last && has_next) S.a_ready(nxt);
            PG8_LDB(B0, 0, 0); PG8_SCHED; PG8_LDA(At, 0, 0); PG8_STAGE(PG8_SA(1, 1), a1 + hstepA, voffA);
            PG8_WAIT_L(8); PG8_BAR; PG8_WAIT_L(0); PG8_MMA(0, 0, At, B0); PG8_BAR; PG8_SCHED;
            PG8_LDB(B1, 0, 1); PG8_STAGE(PG8_SB(0, 0), b2, voffB);
            PG8_BAR; PG8_WAIT_L(0); PG8_MMA(0, 1, At, B1); PG8_BAR;
            PG8_LDA(At, 0, 1); PG8_STAGE(PG8_SA(0, 0), a2, voffA);
            PG8_BAR; PG8_WAIT_L(0); PG8_MMA(1, 0, At, B0); PG8_BAR; PG8_SCHED;
            PG8_STAGE(PG8_SB(0, 1), b2 + hstepB, voffB);
            PG8_WAIT_V(6); PG8_BAR; PG8_MMA(1, 1, At, B1); PG8_BAR;
            PG8_LDB(B0, 1, 0); PG8_SCHED; PG8_LDA(At, 1, 0); PG8_STAGE(PG8_SA(0, 1), a2 + hstepA, voffA);
            PG8_WAIT_L(8); PG8_BAR; PG8_WAIT_L(0); PG8_MMA(0, 0, At, B0); PG8_BAR; PG8_SCHED;
            PG8_LDB(B1, 1, 1); PG8_STAGE(PG8_SB(1, 0), b3, voffB);
            PG8_BAR; PG8_WAIT_L(0); PG8_MMA(0, 1, At, B1); PG8_BAR;
            PG8_LDA(At, 1, 1); PG8_STAGE(PG8_SA(1, 0), a3, voffA);
            PG8_BAR; PG8_WAIT_L(0); PG8_MMA(1, 0, At, B0); PG8_BAR; PG8_SCHED;
            PG8_STAGE(PG8_SB(1, 1), b3 + hstepB, voffB);
            PG8_WAIT_V(6); PG8_BAR; PG8_MMA(1, 1, At, B1); PG8_BAR;
        }
        PG8_STAMP();
        if constexpr (!Epi::AFTER_DRAIN) { E(acc, cur, wr, wc, fr, fq); S.done(cur); }
        PG8_STAMP();
        if (!has_next) break;
#pragma unroll
        for (int a = 0; a < 2; ++a)
#pragma unroll
            for (int b = 0; b < 2; ++b)
#pragma unroll
                for (int m = 0; m < 4; ++m)
#pragma unroll
                    for (int n = 0; n < 2; ++n) acc[a][b][m][n] = (f32x4){0.f, 0.f, 0.f, 0.f};
        cur = nxt; cA = nA; cB = nB; ++ui;
    }
    PG8_WAIT_V(0);
    if (wr == 0) PG8_BAR;
    PG8_BAR;
    if constexpr (Epi::AFTER_DRAIN) { E.fused(acc, cur, wr, wc, fr, fq, lds, wid, lane); S.done(cur); }
    PG8_STAMP();
    if (STAMP && wid == 0) { stamps[lane] = lane < nts ? (((unsigned long long)(unsigned)ts_hi << 32) | (unsigned)ts_lo) : 0ull;
        if (lane == 62) stamps[62] = rt_entry; if (lane == 63) stamps[63] = (unsigned long long)wall_clock64(); }
#undef PG8_STAMP
#undef PG8_SA
#undef PG8_SB
#undef PG8_STAGE
#undef PG8_LDA
#undef PG8_LDB
#undef PG8_MMA
#undef PG8_WAIT_V
#undef PG8_WAIT_L
#undef PG8_BAR
#undef PG8_SCHED
}
}
namespace pg8 {
struct EpiIn {
    static constexpr bool PERM = true, AFTER_DRAIN = false;
    bf16_t* G1; bf16_t* G2;
    __device__ __forceinline__ void operator()(const f32x4 (&acc)[2][2][4][2], const Unit& u, int wr, int wc, int fr, int fq) const {
        const int row0 = u.pm * BM + wr * 64 + fr;
        bf16_t* base; int ldc, colt;
        if (u.pn < 9) { base = G1; ldc = 2304; colt = u.pn * 256; } else { base = G2; ldc = 512; colt = (u.pn - 9) * 256; }
        const int col0 = colt + wc * 32 + 8 * fq;
#pragma unroll
        for (int ai = 0; ai < 2; ++ai)
#pragma unroll
            for (int m = 0; m < 4; ++m) { bf16_t* rowp = base + (size_t)(row0 + ai * HALF + m * 16) * ldc + col0;
#pragma unroll
                for (int bj = 0; bj < 2; ++bj) { const f32x4 v0 = acc[ai][bj][m][0], v1 = acc[ai][bj][m][1];
                    u32x4 w; w.x = cvt_pk_bf16(v0[0], v0[1]); w.y = cvt_pk_bf16(v0[2], v0[3]); w.z = cvt_pk_bf16(v1[0], v1[1]); w.w = cvt_pk_bf16(v1[2], v1[3]);
                    *(u32x4*)(rowp + bj * HALF) = w; } }
    }
};
struct EpiOut {
    static constexpr bool PERM = true, AFTER_DRAIN = false;
    const float* xp; const float* xs; float* out; const float* mod; int layer;
    const float* stats; const float* lng; const float* lnb;
    __device__ __forceinline__ void operator()(const f32x4 (&acc)[2][2][4][2], const Unit& u, int wr, int wc, int fr, int fq) const {
        const int row0 = u.pm * BM + wr * 64 + fr, col0 = u.pn * BM + wc * 32 + 8 * fq;
        const int rt = u.pm * BM; const int modrow = rt < 8192 ? 0 : 1 + ((rt - 8192) >> 11);
        const float* gp = mod + (size_t)modrow * 3072 + 2048 + col0;
        f32x4 gv[2][2];
#pragma unroll
        for (int bj = 0; bj < 2; ++bj)
#pragma unroll
            for (int n = 0; n < 2; ++n) gv[bj][n] = *(const f32x4*)(gp + bj * HALF + n * 4);
        f32x4 lg[2][2], lb[2][2];
        if (layer) {
#pragma unroll
            for (int bj = 0; bj < 2; ++bj)
#pragma unroll
                for (int n = 0; n < 2; ++n) { lg[bj][n] = *(const f32x4*)(lng + col0 + bj * HALF + n * 4); lb[bj][n] = *(const f32x4*)(lnb + col0 + bj * HALF + n * 4); }
        }
        f32x4 xn[2][2]; float mean_n = 0.f, rstd_n = 1.f;
#define EO_LOAD(am_) do { const int row_ = row0 + ((am_) >> 2) * HALF + ((am_) & 3) * 16; \
            if (layer == 0) { const float* xr_ = (row_ < 8192 ? xp + (size_t)row_ * 1024 : xs + (size_t)(row_ - 8192) * 1024) + col0; \
                xn[0][0] = *(const f32x4*)(xr_); xn[0][1] = *(const f32x4*)(xr_ + 4); xn[1][0] = *(const f32x4*)(xr_ + HALF); xn[1][1] = *(const f32x4*)(xr_ + HALF + 4); } \
            else { const bf16_t* zr_ = (const bf16_t*)out + (size_t)row_ * 2048 + col0; const u32x4 z0_ = *(const u32x4*)zr_, z1_ = *(const u32x4*)(zr_ + HALF); \
                xn[0][0] = (f32x4){__uint_as_float(z0_.x << 16), __uint_as_float(z0_.x & 0xffff0000u), __uint_as_float(z0_.y << 16), __uint_as_float(z0_.y & 0xffff0000u)}; \
                xn[0][1] = (f32x4){__uint_as_float(z0_.z << 16), __uint_as_float(z0_.z & 0xffff0000u), __uint_as_float(z0_.w << 16), __uint_as_float(z0_.w & 0xffff0000u)}; \
                xn[1][0] = (f32x4){__uint_as_float(z1_.x << 16), __uint_as_float(z1_.x & 0xffff0000u), __uint_as_float(z1_.y << 16), __uint_as_float(z1_.y & 0xffff0000u)}; \
                xn[1][1] = (f32x4){__uint_as_float(z1_.z << 16), __uint_as_float(z1_.z & 0xffff0000u), __uint_as_float(z1_.w << 16), __uint_as_float(z1_.w & 0xffff0000u)}; \
                mean_n = stats[(size_t)row_ * 2]; rstd_n = stats[(size_t)row_ * 2 + 1]; } } while (0)
        EO_LOAD(0);
#pragma unroll
        for (int am = 0; am < 8; ++am) { const int ai = am >> 2, m = am & 3, row = row0 + ai * HALF + m * 16;
            const f32x4 xc[2][2] = {{xn[0][0], xn[0][1]}, {xn[1][0], xn[1][1]}}; const float mean = mean_n, rstd = rstd_n;
            if (am + 1 < 8) EO_LOAD(am + 1);
            bf16_t* orow = (bf16_t*)out + (size_t)row * 2048 + col0;
#pragma unroll
            for (int bj = 0; bj < 2; ++bj) { f32x4 z[2];
#pragma unroll
                for (int n = 0; n < 2; ++n) { f32x4 x = xc[bj][n];
                    if (layer) x = (x - mean) * rstd * lg[bj][n] + lb[bj][n];
                    z[n] = x * 1.4142135623730951f + gv[bj][n] * acc[ai][bj][m][n]; }
                u32x4 w; w.x = cvt_pk_bf16(z[0][0], z[0][1]); w.y = cvt_pk_bf16(z[0][2], z[0][3]); w.z = cvt_pk_bf16(z[1][0], z[1][1]); w.w = cvt_pk_bf16(z[1][2], z[1][3]);
                *(u32x4*)(orow + bj * HALF) = w; } }
#undef EO_LOAD
    }
};
}

__device__ __forceinline__ void phase_a1_pg8(ArgsP a, LAS unsigned char* lds, int layer) {
    pg8::Gemm g{(const bf16*)(a->ws + WS_U), (const bf16*)(a->ws + WS_WIN) + (size_t)layer * NIN * 1024, T, NIN, 1024, 1024, 1024};
    pg8::StaticOrder S; S.init(T, NIN, grid_(), bid_());
    pg8::EpiIn E{(bf16*)(a->ws + WS_G1), (bf16*)(a->ws + WS_G2)};
    pg8::gemm_phase<pg8::EpiIn, pg8::StaticOrder, false>(lds, g, S, E, nullptr);
}
__device__ __forceinline__ void phase_c2_pg8(ArgsP a, LAS unsigned char* lds, int layer) {
    pg8::Gemm g{(const bf16*)(a->ws + WS_YMIX), (const bf16*)(a->ws + WS_WOUT) + (size_t)layer * 1024 * 1024, T, 1024, 1024, 1024, 1024};
    pg8::StaticOrder S; S.init(T, 1024, grid_(), bid_());
    pg8::EpiOut E{a->in[I_XP], a->in[I_XS], a->out, (const float*)(a->ws + WS_MOD) + (size_t)layer * 9 * 3072, layer, (const float*)(a->ws + WS_STATS), a->in[I_LNG], a->in[I_LNB]};
    pg8::gemm_phase<pg8::EpiOut, pg8::StaticOrder, false>(lds, g, S, E, nullptr);
}

__device__ __forceinline__ void phase_a2a(ArgsP a, int layer) {
    const int tid = tid_(), lane = tid & 63, wave = tid >> 6, G = grid_();
    bf16* G2 = (bf16*)(a->ws + WS_G2); bf16* KR = (bf16*)(a->ws + WS_KR); bf16* CK = (bf16*)(a->ws + WS_HF);
    const float* ROPE = (const float*)(a->ws + WS_ROPE);
    f32x4 nw0 = {0.f, 0.f, 0.f, 0.f}, nw1 = {0.f, 0.f, 0.f, 0.f};
    if (lane < 32) { nw0 = *(const f32x4*)(a->in[I_QNORM] + layer * 256 + lane * 8); nw1 = *(const f32x4*)(a->in[I_QNORM] + layer * 256 + lane * 8 + 4); }
    else if (lane < 48) { nw0 = *(const f32x4*)(a->in[I_KVNORM] + layer * 128 + (lane - 32) * 8); nw1 = *(const f32x4*)(a->in[I_KVNORM] + layer * 128 + (lane - 32) * 8 + 4); }
    v4u nx = {0u, 0u, 0u, 0u};
    { const int n0 = bid_() * 8 + wave; if (n0 < T) nx = *(const v4u*)(G2 + (size_t)n0 * G2W + lane * 8); }
    for (int n = bid_() * 8 + wave; n < T; n += G * 8) {
        const v4u w = nx;
        if (n + G * 8 < T) nx = *(const v4u*)(G2 + (size_t)(n + G * 8) * G2W + lane * 8);
        const Tok tk = tok_of(n);
        float x[8] = {bflo(w.x), bfhi(w.x), bflo(w.y), bfhi(w.y), bflo(w.z), bfhi(w.z), bflo(w.w), bfhi(w.w)};
        const float ss = (x[0] * x[0] + x[1] * x[1]) + (x[2] * x[2] + x[3] * x[3]) + (x[4] * x[4] + x[5] * x[5]) + (x[6] * x[6] + x[7] * x[7]);
        const float sq = wave_sum(lane < 32 ? ss : 0.f), sk = wave_sum((lane >= 32 && lane < 48) ? ss : 0.f);
        const float rs = lane < 32 ? rsqrt_(sq * (1.f / 256.f) + 1e-6f) : rsqrt_(sk * (1.f / 128.f) + 1e-6f);
        if (lane < 48) {
            const float y0 = x[0] * rs * nw0.x, y1 = x[1] * rs * nw0.y, y2 = x[2] * rs * nw0.z, y3 = x[3] * rs * nw0.w, y4 = x[4] * rs * nw1.x, y5 = x[5] * rs * nw1.y, y6 = x[6] * rs * nw1.z, y7 = x[7] * rs * nw1.w;
            *(v4u*)(G2 + (size_t)n * G2W + lane * 8) = (v4u){cvtpk(y0, y1), cvtpk(y2, y3), cvtpk(y4, y5), cvtpk(y6, y7)};
            if (lane >= 32 && !tk.lat) { float* op = a->out + O_CKV + ((size_t)(tk.b * 2 + layer) * 256 + tk.t) * 128 + (lane - 32) * 8;
                *(f32x4*)op = (f32x4){y0, y1, y2, y3}; *(f32x4*)(op + 4) = (f32x4){y4, y5, y6, y7}; }
        } else if (lane < 52) {
            const int d0 = (lane - 48) * 8;
            if (!tk.lat) { float* op = a->out + O_KR + ((size_t)(tk.b * 2 + layer) * 256 + tk.t) * 32 + d0;
                *(f32x4*)op = (f32x4){x[0], x[1], x[2], x[3]}; *(f32x4*)(op + 4) = (f32x4){x[4], x[5], x[6], x[7]};
                *(v4u*)(KR + (size_t)tk.kidx * 32 + d0) = w; }
            else { const f32x4 c0 = *(const f32x4*)(ROPE + ((size_t)tk.t * 16 + (d0 >> 1)) * 2), c1 = *(const f32x4*)(ROPE + ((size_t)tk.t * 16 + (d0 >> 1) + 2) * 2);
                const float y0 = x[0] * c0.x - x[1] * c0.y, y1 = x[0] * c0.y + x[1] * c0.x, y2 = x[2] * c0.z - x[3] * c0.w, y3 = x[2] * c0.w + x[3] * c0.z;
                const float y4 = x[4] * c1.x - x[5] * c1.y, y5 = x[4] * c1.y + x[5] * c1.x, y6 = x[6] * c1.z - x[7] * c1.w, y7 = x[6] * c1.w + x[7] * c1.z;
                *(v4u*)(KR + (size_t)tk.kidx * 32 + d0) = (v4u){cvtpk(y0, y1), cvtpk(y2, y3), cvtpk(y4, y5), cvtpk(y6, y7)}; }
        }
    }
    for (int r = bid_() * 8 + wave; r < 2048; r += G * 8) {
        const int b = r >> 8, j = r & 255; const size_t src = (size_t)(b * 2 + layer) * 256 + j;
        if (lane < 16) { const f32x4 v0 = *(const f32x4*)(a->in[I_CCKV] + src * 128 + lane * 8), v1 = *(const f32x4*)(a->in[I_CCKV] + src * 128 + lane * 8 + 4);
            *(v4u*)(CK + (size_t)r * 512 + lane * 8) = (v4u){cvtpk(v0.x, v0.y), cvtpk(v0.z, v0.w), cvtpk(v1.x, v1.y), cvtpk(v1.z, v1.w)}; }
        else if (lane < 32) *(v4u*)(CK + (size_t)r * 512 + lane * 8) = (v4u){0u, 0u, 0u, 0u};
        else if (lane < 36) { const f32x4 v0 = *(const f32x4*)(a->in[I_CKR] + src * 32 + (lane - 32) * 8), v1 = *(const f32x4*)(a->in[I_CKR] + src * 32 + (lane - 32) * 8 + 4);
            *(v4u*)(KR + (size_t)(T_CTX + b * LK_LAT + j) * 32 + (lane - 32) * 8) = (v4u){cvtpk(v0.x, v0.y), cvtpk(v0.z, v0.w), cvtpk(v1.x, v1.y), cvtpk(v1.z, v1.w)}; }
    }
}
namespace pg8 {
struct A2Order {
    const char* ws; unsigned oq, okv; int G, c;
    __device__ __forceinline__ bool next(int i, Unit& u) const {
        const int L = i * G + c; if (L >= 704) return false;
        if (L < 288) { u.gid = 0; u.pm = L / 3; u.pn = L % 3; } else if (L < 672) { u.gid = 1; u.pm = (L - 288) >> 2; u.pn = (L - 288) & 3; } else { u.gid = 2; u.pm = (L - 672) >> 2; u.pn = (L - 672) & 3; }
        return true;
    }
    __device__ __forceinline__ const char* abase(const Gemm&, const Unit& u) const { const unsigned off = u.gid == 0 ? (unsigned)WS_G2 : (u.gid == 1 ? (unsigned)WS_G2 + 512u : (unsigned)WS_HF); return ws + off + (size_t)u.pm * 256 * 512 * 2; }
    __device__ __forceinline__ const char* bbase(const Gemm&, const Unit& u) const { const unsigned off = u.gid == 0 ? oq : okv; return ws + off + (size_t)u.pn * 256 * 256 * 2; }
    __device__ __forceinline__ void a_ready(const Unit&) const {}
    __device__ __forceinline__ void done(const Unit&) const {}
};
struct EpiA2 {
    static constexpr bool PERM = true, AFTER_DRAIN = false;
    bf16_t* Q; bf16_t* KN; bf16_t* VR; const float* rope;
    __device__ __forceinline__ void operator()(const f32x4 (&acc)[2][2][4][2], const Unit& u, int wr, int wc, int fr, int fq) const {
        const int row0 = u.pm * BM + wr * 64 + fr;
        if (u.gid == 0) {
            const int fb = u.pn * 256 + wc * 32 + 8 * fq;
#pragma unroll
            for (int ai = 0; ai < 2; ++ai)
#pragma unroll
                for (int m = 0; m < 4; ++m) { const int row = row0 + ai * HALF + m * 16;
                    const float* rp = rope + (unsigned)(((row - 8192) & 2047) * 32);
#pragma unroll
                    for (int bj = 0; bj < 2; ++bj) {
                        f32x4 v0 = acc[ai][bj][m][0], v1 = acc[ai][bj][m][1];
                        const int f0 = fb + bj * HALF, d = f0 % 96;
                        if (row >= 8192 && d >= 64) { const f32x4 c0 = *(const f32x4*)(rp + (d - 64)), c1 = *(const f32x4*)(rp + (d - 64) + 4);
                            const f32x4 a0 = v0, a1 = v1;
                            v0[0] = a0[0] * c0[0] - a0[1] * c0[1]; v0[1] = a0[0] * c0[1] + a0[1] * c0[0]; v0[2] = a0[2] * c0[2] - a0[3] * c0[3]; v0[3] = a0[2] * c0[3] + a0[3] * c0[2];
                            v1[0] = a1[0] * c1[0] - a1[1] * c1[1]; v1[1] = a1[0] * c1[1] + a1[1] * c1[0]; v1[2] = a1[2] * c1[2] - a1[3] * c1[3]; v1[3] = a1[2] * c1[3] + a1[3] * c1[2]; }
                        u32x4 w; w.x = cvt_pk_bf16(v0[0], v0[1]); w.y = cvt_pk_bf16(v0[2], v0[3]); w.z = cvt_pk_bf16(v1[0], v1[1]); w.w = cvt_pk_bf16(v1[2], v1[3]);
                        *(u32x4*)(Q + (unsigned)(row * 768 + f0)) = w; } }
        } else {
            const int x = wc * 32 + 8 * fq;
            bf16_t* base = (wc < 2 ? KN : VR);
            const unsigned xo = (unsigned)(x & 63);
#pragma unroll
            for (int ai = 0; ai < 2; ++ai)
#pragma unroll
                for (int m = 0; m < 4; ++m) { const int row = row0 + ai * HALF + m * 16;
                    int kidx;
                    if (u.gid == 2) kidx = 8192 + (row >> 8) * 2304 + (row & 255);
                    else if (row < 8192) kidx = row;
                    else { const int mrow = row - 8192; kidx = 8192 + (mrow >> 11) * 2304 + 256 + (mrow & 2047); }
#pragma unroll
                    for (int bj = 0; bj < 2; ++bj) { const f32x4 v0 = acc[ai][bj][m][0], v1 = acc[ai][bj][m][1];
                        u32x4 w; w.x = cvt_pk_bf16(v0[0], v0[1]); w.y = cvt_pk_bf16(v0[2], v0[3]); w.z = cvt_pk_bf16(v1[0], v1[1]); w.w = cvt_pk_bf16(v1[2], v1[3]);
                        *(u32x4*)(base + (unsigned)(kidx * 512 + (u.pn * 2 + bj) * 64) + xo) = w; } }
        }
    }
};
}
__device__ __forceinline__ void phase_a2b(ArgsP a, LAS unsigned char* lds, int layer) {
    int kk = 256; asm volatile("" : "+s"(kk));
    pg8::Gemm g{nullptr, nullptr, T, 1024, kk, 512, 256};
    pg8::A2Order S{(const char*)a->ws, (unsigned)(WS_WUQ + (size_t)layer * 768 * 256 * 2), (unsigned)(WS_WUKV + (size_t)layer * 1024 * 256 * 2), grid_(), bid_()};
    pg8::EpiA2 E{(bf16*)(a->ws + WS_Q), (bf16*)(a->ws + WS_KN), (bf16*)(a->ws + WS_VT), (const float*)(a->ws + WS_ROPE)};
    pg8::gemm_phase<pg8::EpiA2, pg8::A2Order, false>(lds, g, S, E, nullptr);
}


__device__ __forceinline__ void phase_c1(ArgsP a, int layer) {
    const int tid = tid_(), lane = tid & 63, wave = tid >> 6, G = grid_();
    const bf16* G1 = (const bf16*)(a->ws + WS_G1); const bf16* YS = (const bf16*)(a->ws + WS_G2); const bf16* Q = (const bf16*)(a->ws + WS_Q); const bf16* HF = (const bf16*)(a->ws + WS_HF);
    bf16* Y = (bf16*)(a->ws + WS_YMIX);
    const int ch = lane * 4;
    const f32x4 rk = *(const f32x4*)(a->in[I_RK] + layer * 256 + ch), lg = *(const f32x4*)(a->in[I_LNXG] + layer * 256 + ch), lb = *(const f32x4*)(a->in[I_LNXB] + layer * 256 + ch);
    v2u p_y0, p_y1, p_r, p_k, p_v, p_g, p_h, p_hb, p_gl; v4u p_q;
#define C1_LOAD(nn) do { const bf16* g_ = G1 + (size_t)(nn) * G1W; p_y0 = *(const v2u*)(YS + (size_t)(nn) * 256 + ch); p_y1 = *(const v2u*)(YS + ((size_t)T + (nn)) * 256 + ch); \
        p_r = *(const v2u*)(g_ + C_R + ch); p_k = *(const v2u*)(g_ + C_K + ch); p_v = *(const v2u*)(g_ + C_V + ch); p_g = *(const v2u*)(g_ + C_G + ch); \
        p_q = *(const v4u*)(Q + (size_t)(nn) * 768 + (lane >> 3) * 96 + (lane & 7) * 8); p_h = *(const v2u*)(HF + (size_t)(nn) * 256 + ch); \
        p_hb = *(const v2u*)((const unsigned char*)a->out + (size_t)(nn) * 4096 + 2048 + ch * 2); p_gl = *(const v2u*)(g_ + C_GL + ch); } while (0)
    { const int n0 = bid_() * 8 + wave; if (n0 < T) C1_LOAD(n0); }
    for (int n = bid_() * 8 + wave; n < T; n += G * 8) {
        const v2u y0 = p_y0, y1 = p_y1, rv = p_r, kv = p_k, vv = p_v, gv = p_g, hf = p_h, hb = p_hb, gl = p_gl; const v4u qq = p_q;
        if (n + G * 8 < T) C1_LOAD(n + G * 8);
        float y[4] = {bflo(y0.x) + bflo(y1.x), bfhi(y0.x) + bfhi(y1.x), bflo(y0.y) + bflo(y1.y), bfhi(y0.y) + bfhi(y1.y)};
        float s = (y[0] + y[1]) + (y[2] + y[3]);
        float bon = bflo(rv.x) * bflo(kv.x) * rk.x + bfhi(rv.x) * bfhi(kv.x) * rk.y + bflo(rv.y) * bflo(kv.y) * rk.z + bfhi(rv.y) * bfhi(kv.y) * rk.w;
#pragma unroll
        for (int o = 1; o < 16; o <<= 1) { s += __shfl_xor(s, o); bon += __shfl_xor(bon, o); }
        const float mu = s * (1.f / 64.f);
        float s2 = (y[0] - mu) * (y[0] - mu) + (y[1] - mu) * (y[1] - mu) + (y[2] - mu) * (y[2] - mu) + (y[3] - mu) * (y[3] - mu);
#pragma unroll
        for (int o = 1; o < 16; o <<= 1) s2 += __shfl_xor(s2, o);
        const float rstd = rsqrt_(s2 * (1.f / 64.f) + GN_EPS);
        const float o0 = ((y[0] - mu) * rstd * lg.x + lb.x + bon * bflo(vv.x)) * siluf_(bflo(gv.x));
        const float o1 = ((y[1] - mu) * rstd * lg.y + lb.y + bon * bfhi(vv.x)) * siluf_(bfhi(gv.x));
        const float o2 = ((y[2] - mu) * rstd * lg.z + lb.z + bon * bflo(vv.y)) * siluf_(bflo(gv.y));
        const float o3 = ((y[3] - mu) * rstd * lg.w + lb.w + bon * bfhi(vv.y)) * siluf_(bfhi(gv.y));
        v2u ov; ov.x = pk2(o0, o1); ov.y = pk2(o2, o3);
        bf16* yr = Y + (size_t)n * 1024;
        *(v2u*)(yr + ch) = ov;
        *(v4u*)(yr + 256 + (lane >> 3) * 64 + (lane & 7) * 8) = qq;
        *(v2u*)(yr + 768 + ch) = (v2u){pk2((bflo(hf.x) + bflo(hb.x)) * siluf_(bflo(gl.x)), (bfhi(hf.x) + bfhi(hb.x)) * siluf_(bfhi(gl.x))), pk2((bflo(hf.y) + bflo(hb.y)) * siluf_(bflo(gl.y)), (bfhi(hf.y) + bfhi(hb.y)) * siluf_(bfhi(gl.y)))};
    }
#undef C1_LOAD
}
#define MFMA32(a, b, c) __builtin_amdgcn_mfma_f32_32x32x16_bf16((a), (b), (c), 0, 0, 0)
#define MFMA16(a, b, c) __builtin_amdgcn_mfma_f32_16x16x32_bf16((a), (b), (c), 0, 0, 0)
typedef short s16x4_t __attribute__((ext_vector_type(4)));

__device__ __forceinline__ float tanh_fast(float x) { return 1.f - 2.f * rcp_(1.f + exp_(2.f * x)); }

constexpr int ATT_KSTR = 208, ATT_VSTR = 136, ATT_VOFF = 64 * ATT_KSTR, ATT_STAGE = 64 * ATT_KSTR + 64 * ATT_VSTR;


constexpr int RW_W2T = 0, RW_A2T = 9216, RW_TH = 18432, RW_HA = 27648, RW_CH0 = 36864, RW_CHB = 20992, RW_YB = 120832;
constexpr int RC_KP = 0, RC_RP = 2304, RC_BP = 4608  , RC_KT = 6912, RC_VR = 9216  , RC_LK = 16896, RC_TM = 17536, RC_ARK = 18176, RC_NARB = 18816, RC_G15 = 19456, RC_LBF = 19712, RC_SSQ = 20736;
template <int MODE = 0> __device__ __forceinline__ void rwkv_unit_mfma(ArgsP a, LAS unsigned char* lds, int layer, int u) {
    const int tid = tid_(), lane = tid & 63, wave = tid >> 6, i16 = lane & 15, g = lane >> 4;
    const int lat = u < 64, uu = lat ? u : u - 64, b = uu >> 3, e = (uu >> 2) & 1, hh = uu & 3;
    const int L = lat ? L_LAT : L_CTX, tok0 = lat ? T_CTX + b * L_LAT : b * L_CTX;
    const bf16* G1 = (const bf16*)(a->ws + WS_G1);
    bf16* YS = (bf16*)(a->ws + WS_G2);
    __syncthreads();
    { const bf16* wsrc = (const bf16*)(a->ws + WS_LORA2) + ((size_t)((layer * 2 + e) * 2) * 256 + hh * 64) * 64; const int row = tid >> 3, c8 = (tid & 7) * 8;
      *(LAS v4u*)(lds + RW_W2T + row * 144 + c8 * 2) = *(const v4u*)(wsrc + row * 64 + c8);
      *(LAS v4u*)(lds + RW_A2T + row * 144 + c8 * 2) = *(const v4u*)(wsrc + 256 * 64 + row * 64 + c8); }
    const int st_tok = tid >> 3, st_c8 = (tid & 7) * 8;
#define RW_STAGE(sc) do { const int step_ = (sc) * 64 + st_tok, t_ = e ? L - 1 - step_ : step_; const bf16* gp_ = G1 + (size_t)(tok0 + t_) * G1W + C_LORA + e * 64 + st_c8; \
        const v4u hw_ = *(const v4u*)gp_, ha_ = *(const v4u*)(gp_ + 128); v4u th_; \
        th_.x = cvtpk(tanh_fast(bflo(hw_.x)), tanh_fast(bfhi(hw_.x))); th_.y = cvtpk(tanh_fast(bflo(hw_.y)), tanh_fast(bfhi(hw_.y))); th_.z = cvtpk(tanh_fast(bflo(hw_.z)), tanh_fast(bfhi(hw_.z))); th_.w = cvtpk(tanh_fast(bflo(hw_.w)), tanh_fast(bfhi(hw_.w))); \
        *(LAS v4u*)(lds + RW_TH + st_tok * 144 + st_c8 * 2) = th_; *(LAS v4u*)(lds + RW_HA + st_tok * 144 + st_c8 * 2) = ha_; } while (0)
    RW_STAGE(0);
    f32x4 ST[4];
    {
        const int v = 16 * (wave & 3) + i16;
#pragma unroll
        for (int kt = 0; kt < 4; ++kt) ST[kt] = lat ? *(const f32x4*)(a->in[I_SRW] + (((size_t)((b * 2 + layer) * 2 + e) * 4 + hh) * 64 + v) * 64 + 16 * kt + 4 * g) : (f32x4){0.f, 0.f, 0.f, 0.f};
    }
    const int pc = wave & 3, ph = wave >> 2;
    LAS unsigned char* CH = lds + RW_CH0 + pc * RW_CHB;
    f32x4 w0r[2], a0r[2], kwr[2], kar[2];
#pragma unroll
    for (int c2 = 0; c2 < 2; ++c2) { const int gch = hh * 64 + (2 * ph + c2) * 16 + 4 * g;
        w0r[c2] = *(const f32x4*)(a->in[I_W0] + (layer * 2 + e) * 256 + gch); a0r[c2] = *(const f32x4*)(a->in[I_A0] + (layer * 2 + e) * 256 + gch);
        kwr[c2] = *(const f32x4*)(a->in[I_KK] + layer * 256 + gch); kar[c2] = *(const f32x4*)(a->in[I_KA] + layer * 256 + gch); }
#pragma unroll
    for (int c2 = 0; c2 < 2; ++c2) asm volatile("" : "+v"(w0r[c2]), "+v"(a0r[c2]), "+v"(kwr[c2]), "+v"(kar[c2]));
#pragma unroll
    for (int kt = 0; kt < 4; ++kt) asm volatile("" : "+v"(ST[kt]));
    __syncthreads();
    const int nsc = L >> 6;
    v2u pk[2], pr[2], pv[2];
#define RW_PREFETCH(sc) do { const int ps_ = (sc) * 64 + pc * 16 + i16, pt_ = e ? L - 1 - ps_ : ps_; const bf16* gq_ = G1 + (size_t)(tok0 + pt_) * G1W + hh * 64 + (2 * ph) * 16 + 4 * g; \
        pk[0] = *(const v2u*)(gq_ + C_K); pk[1] = *(const v2u*)(gq_ + C_K + 16); pr[0] = *(const v2u*)(gq_ + C_R); pr[1] = *(const v2u*)(gq_ + C_R + 16); pv[0] = *(const v2u*)(gq_ + C_V); pv[1] = *(const v2u*)(gq_ + C_V + 16); } while (0)
    RW_PREFETCH(0);
    for (int sc = 0; sc < nsc; ++sc) {
        const v2u ck[2] = {pk[0], pk[1]}, cr[2] = {pr[0], pr[1]}, cv[2] = {pv[0], pv[1]};
        if (sc + 1 < nsc) RW_PREFETCH(sc + 1);
        float dec[8], av[8], kx[8], rx[8], kk[8];
        {
            f32x4 aw[2], aa[2];
#pragma unroll
            for (int c2 = 0; c2 < 2; ++c2) { aw[c2] = (f32x4){0.f, 0.f, 0.f, 0.f}; aa[c2] = (f32x4){0.f, 0.f, 0.f, 0.f}; }
#pragma unroll
            for (int ks = 0; ks < 2; ++ks) {
                const bf16x8 bth = *(const LAS bf16x8*)(lds + RW_TH + (pc * 16 + i16) * 144 + ks * 64 + g * 16), bha = *(const LAS bf16x8*)(lds + RW_HA + (pc * 16 + i16) * 144 + ks * 64 + g * 16);
#pragma unroll
                for (int c2 = 0; c2 < 2; ++c2) { const int row = (2 * ph + c2) * 16 + i16;
                    const bf16x8 w2f = *(const LAS bf16x8*)(lds + RW_W2T + row * 144 + ks * 64 + g * 16), a2f = *(const LAS bf16x8*)(lds + RW_A2T + row * 144 + ks * 64 + g * 16);
                    aw[c2] = MFMA16(w2f, bth, aw[c2]); aa[c2] = MFMA16(a2f, bha, aa[c2]); }
            }
            float ss = 0.f;
#pragma unroll
            for (int c2 = 0; c2 < 2; ++c2) {
                const f32x4 w0 = w0r[c2], a0 = a0r[c2], kw = kwr[c2];
                const v2u kv = ck[c2], rv = cr[c2];
                const float kq[4] = {bflo(kv.x), bfhi(kv.x), bflo(kv.y), bfhi(kv.y)}, rq[4] = {bflo(rv.x), bfhi(rv.x), bflo(rv.y), bfhi(rv.y)};
#pragma unroll
                for (int q = 0; q < 4; ++q) { const int o = c2 * 4 + q;
                    dec[o] = exp_(-0.6065306597126334f * sigmoidf_(aw[c2][q] + w0[q])); av[o] = sigmoidf_(aa[c2][q] + a0[q]);
                    kx[o] = kq[q]; rx[o] = rq[q]; kk[o] = kq[q] * kw[q]; ss += kk[o] * kk[o]; }
            }
            ss += __shfl_xor(ss, 16); ss += __shfl_xor(ss, 32);
            if (g == 0) *(LAS float*)(CH + RC_SSQ + (i16 * 2 + ph) * 4) = ss;
        }
        __syncthreads();
        {
            const float tot = *(const LAS float*)(CH + RC_SSQ + (i16 * 2) * 4) + *(const LAS float*)(CH + RC_SSQ + (i16 * 2 + 1) * 4);
            const float inrm = rcp_(fmaxf(sqrt_(tot), 1e-12f));
            float G8[8], Gx8[8];
#pragma unroll
            for (int o8 = 0; o8 < 8; ++o8) G8[o8] = dec[o8];
#pragma unroll
            for (int o8 = 0; o8 < 8; ++o8) G8[o8] *= dpp_f<0x111>(1.f, G8[o8]);
#pragma unroll
            for (int o8 = 0; o8 < 8; ++o8) G8[o8] *= dpp_f<0x112>(1.f, G8[o8]);
#pragma unroll
            for (int o8 = 0; o8 < 8; ++o8) G8[o8] *= dpp_f<0x114>(1.f, G8[o8]);
#pragma unroll
            for (int o8 = 0; o8 < 8; ++o8) G8[o8] *= dpp_f<0x118>(1.f, G8[o8]);
#pragma unroll
            for (int o8 = 0; o8 < 8; ++o8) Gx8[o8] = dpp_f<0x111>(1.f, G8[o8]);
#pragma unroll
            for (int c2 = 0; c2 < 2; ++c2) { const int ch = (2 * ph + c2) * 16 + 4 * g;
                const f32x4 ka = kar[c2];
                float kp[4], bp[4], kt[4], rp[4];
#pragma unroll
                for (int q = 0; q < 4; ++q) { const int o = c2 * 4 + q;
                    const float G = G8[o], Gex = Gx8[o];
                    const float kkn = kk[o] * inrm, iG = rcp_(G);
                    kp[q] = Gex * kkn; bp[q] = kkn * av[o] * iG; kt[q] = kx[o] * (1.f + (av[o] - 1.f) * ka[q]) * iG; rp[q] = G * rx[o];
                    if (i16 == 15) *(LAS float*)(CH + RC_G15 + (ch + q) * 4) = G;
                }
                *(LAS v2u*)(CH + RC_KP + i16 * 144 + ch * 2) = (v2u){cvtpk(kp[0], kp[1]), cvtpk(kp[2], kp[3])};
                *(LAS v2u*)(CH + RC_BP + i16 * 144 + ch * 2) = (v2u){cvtpk(-bp[0], -bp[1]), cvtpk(-bp[2], -bp[3])};
                *(LAS v2u*)(CH + RC_KT + i16 * 144 + ch * 2) = (v2u){cvtpk(kt[0], kt[1]), cvtpk(kt[2], kt[3])};
                *(LAS v2u*)(CH + RC_RP + i16 * 144 + ch * 2) = (v2u){cvtpk(rp[0], rp[1]), cvtpk(rp[2], rp[3])};
                *(LAS v2u*)(CH + RC_VR + i16 * 144 + ch * 2) = cv[c2];
            }
        }
        __syncthreads();
        {
            f32x4 d0 = (f32x4){0.f, 0.f, 0.f, 0.f}, d1 = (f32x4){0.f, 0.f, 0.f, 0.f};
            const int xoff = ph ? RC_KP : RC_RP, y0off = ph ? RC_BP : RC_KT, y1off = ph ? RC_KT : RC_BP;
#pragma unroll
            for (int ks = 0; ks < 2; ++ks) {
                const bf16x8 xf = *(const LAS bf16x8*)(CH + xoff + i16 * 144 + ks * 64 + g * 16);
                const bf16x8 y0 = *(const LAS bf16x8*)(CH + y0off + i16 * 144 + ks * 64 + g * 16), y1 = *(const LAS bf16x8*)(CH + y1off + i16 * 144 + ks * 64 + g * 16);
                d0 = MFMA16(xf, y0, d0); d1 = MFMA16(xf, y1, d1);
            }
#pragma unroll
            for (int q = 0; q < 4; ++q) { const int i = 4 * g + q, j = i16;
                if (ph) { *(LAS float*)(CH + RC_LBF + (i * 16 + j) * 4) = (j < i) ? -d0[q] : 0.f; *(LAS bf16*)(CH + RC_LK + i * 40 + j * 2) = (bf16)(cvtpk((j < i) ? d1[q] : 0.f, 0.f) & 0xffffu); }
                else { const unsigned pk_ = cvtpk((j <= i) ? d0[q] : 0.f, (j <= i) ? d1[q] : 0.f); *(LAS bf16*)(CH + RC_ARK + i * 40 + j * 2) = (bf16)(pk_ & 0xffffu); *(LAS bf16*)(CH + RC_NARB + i * 40 + j * 2) = (bf16)(pk_ >> 16); }
            }
            if (ph && !(MODE & 2)) {
                float x[16];
#pragma unroll
                for (int i = 0; i < 16; ++i) { float s = (i == i16) ? 1.f : 0.f;
#pragma unroll
                    for (int j4 = 0; j4 < (i + 3) / 4; ++j4) { const f32x4 lr = *(const LAS f32x4*)(CH + RC_LBF + (i * 16 + j4 * 4) * 4);
#pragma unroll
                        for (int jj = 0; jj < 4; ++jj) { const int j = j4 * 4 + jj; if (j < i) s -= lr[jj] * x[j]; } }
                    x[i] = s; }
                if (g == 0) {
#pragma unroll
                    for (int i = 0; i < 16; i += 2) { const unsigned pk_ = cvtpk(x[i], x[i + 1]); *(LAS bf16*)(CH + RC_TM + i * 40 + i16 * 2) = (bf16)(pk_ & 0xffffu); *(LAS bf16*)(CH + RC_TM + (i + 1) * 40 + i16 * 2) = (bf16)(pk_ >> 16); } }
            }
        }
        __syncthreads();
        if (wave < 4) {
            const int vt = wave;
#pragma unroll 1
            for (int c = 0; c < ((MODE & 1) ? 0 : 4); ++c) {
                const LAS unsigned char* C = lds + RW_CH0 + c * RW_CHB;
                v4u sb01, sb23;
                sb01.x = cvtpk(ST[0][0], ST[0][1]); sb01.y = cvtpk(ST[0][2], ST[0][3]); sb01.z = cvtpk(ST[1][0], ST[1][1]); sb01.w = cvtpk(ST[1][2], ST[1][3]);
                sb23.x = cvtpk(ST[2][0], ST[2][1]); sb23.y = cvtpk(ST[2][2], ST[2][3]); sb23.z = cvtpk(ST[3][0], ST[3][1]); sb23.w = cvtpk(ST[3][2], ST[3][3]);
                const bf16x8 s01 = __builtin_bit_cast(bf16x8, sb01), s23 = __builtin_bit_cast(bf16x8, sb23);
                const v2u kp0a = *(const LAS v2u*)(C + RC_KP + i16 * 144 + (4 * g) * 2), kp0b = *(const LAS v2u*)(C + RC_KP + i16 * 144 + (16 + 4 * g) * 2);
                const v2u kp1a = *(const LAS v2u*)(C + RC_KP + i16 * 144 + (32 + 4 * g) * 2), kp1b = *(const LAS v2u*)(C + RC_KP + i16 * 144 + (48 + 4 * g) * 2);
                const v2u rp0a = *(const LAS v2u*)(C + RC_RP + i16 * 144 + (4 * g) * 2), rp0b = *(const LAS v2u*)(C + RC_RP + i16 * 144 + (16 + 4 * g) * 2);
                const v2u rp1a = *(const LAS v2u*)(C + RC_RP + i16 * 144 + (32 + 4 * g) * 2), rp1b = *(const LAS v2u*)(C + RC_RP + i16 * 144 + (48 + 4 * g) * 2);
                const v2u lk = *(const LAS v2u*)(C + RC_LK + i16 * 40 + g * 8), tm = *(const LAS v2u*)(C + RC_TM + i16 * 40 + g * 8);
                const v2u ark = *(const LAS v2u*)(C + RC_ARK + i16 * 40 + g * 8), narb = *(const LAS v2u*)(C + RC_NARB + i16 * 40 + g * 8);
                const int trq = (i16 >> 2) & 3, trp = i16 & 3;
                const v2u vf = __builtin_bit_cast(v2u, __builtin_amdgcn_ds_read_tr16_b64_v4i16((LAS s16x4_t*)(C + RC_VR + (4 * g + trq) * 144 + (16 * vt + 4 * trp) * 2)));
                const v4u z4 = {0u, 0u, 0u, 0u};
                f32x4 rhs = (f32x4){0.f, 0.f, 0.f, 0.f};
                rhs = MFMA16(__builtin_bit_cast(bf16x8, ((v4u){kp0a.x, kp0a.y, kp0b.x, kp0b.y})), s01, rhs);
                rhs = MFMA16(__builtin_bit_cast(bf16x8, ((v4u){kp1a.x, kp1a.y, kp1b.x, kp1b.y})), s23, rhs);
                rhs = MFMA16(__builtin_bit_cast(bf16x8, ((v4u){lk.x, lk.y, 0u, 0u})), __builtin_bit_cast(bf16x8, ((v4u){vf.x, vf.y, 0u, 0u})), rhs);
                f32x4 z = MFMA16(__builtin_bit_cast(bf16x8, ((v4u){tm.x, tm.y, 0u, 0u})), __builtin_bit_cast(bf16x8, ((v4u){cvtpk(rhs[0], rhs[1]), cvtpk(rhs[2], rhs[3]), 0u, 0u})), ((f32x4){0.f, 0.f, 0.f, 0.f}));
                const bf16x8 vz = __builtin_bit_cast(bf16x8, ((v4u){vf.x, vf.y, cvtpk(z[0], z[1]), cvtpk(z[2], z[3])}));
                f32x4 y = (f32x4){0.f, 0.f, 0.f, 0.f};
                y = MFMA16(__builtin_bit_cast(bf16x8, ((v4u){rp0a.x, rp0a.y, rp0b.x, rp0b.y})), s01, y);
                y = MFMA16(__builtin_bit_cast(bf16x8, ((v4u){rp1a.x, rp1a.y, rp1b.x, rp1b.y})), s23, y);
                y = MFMA16(__builtin_bit_cast(bf16x8, ((v4u){ark.x, ark.y, narb.x, narb.y})), vz, y);
#pragma unroll
                for (int kt = 0; kt < 4; ++kt) {
                    const v2u ktf = __builtin_bit_cast(v2u, __builtin_amdgcn_ds_read_tr16_b64_v4i16((LAS s16x4_t*)(C + RC_KT + (4 * g + trq) * 144 + (16 * kt + 4 * trp) * 2)));
                    const v2u nbf = __builtin_bit_cast(v2u, __builtin_amdgcn_ds_read_tr16_b64_v4i16((LAS s16x4_t*)(C + RC_BP + (4 * g + trq) * 144 + (16 * kt + 4 * trp) * 2)));
                    const f32x4 g15 = *(const LAS f32x4*)(C + RC_G15 + (16 * kt + 4 * g) * 4);
                    ST[kt] = MFMA16(__builtin_bit_cast(bf16x8, ((v4u){ktf.x, ktf.y, nbf.x, nbf.y})), vz, ST[kt]);
                    ST[kt] = ST[kt] * g15;
                }
                { const unsigned y01 = cvtpk(y[0], y[1]), y23 = cvtpk(y[2], y[3]); LAS unsigned char* yb = lds + RW_YB + (c * 16 + 4 * g) * 144 + (16 * vt + i16) * 2;
                  *(LAS bf16*)(yb) = (bf16)(y01 & 0xffffu); *(LAS bf16*)(yb + 144) = (bf16)(y01 >> 16); *(LAS bf16*)(yb + 288) = (bf16)(y23 & 0xffffu); *(LAS bf16*)(yb + 432) = (bf16)(y23 >> 16); }
                (void)z4;
            }
        } else if (sc + 1 < nsc) {
            const int r0 = (tid - 256) >> 3;
#pragma unroll
            for (int hrow = 0; hrow < 2; ++hrow) { const int tokr = r0 + 32 * hrow, step_ = (sc + 1) * 64 + tokr, t_ = e ? L - 1 - step_ : step_;
                const bf16* gp_ = G1 + (size_t)(tok0 + t_) * G1W + C_LORA + e * 64 + st_c8;
                const v4u hw_ = *(const v4u*)gp_, ha_ = *(const v4u*)(gp_ + 128); v4u th_;
                th_.x = cvtpk(tanh_fast(bflo(hw_.x)), tanh_fast(bfhi(hw_.x))); th_.y = cvtpk(tanh_fast(bflo(hw_.y)), tanh_fast(bfhi(hw_.y))); th_.z = cvtpk(tanh_fast(bflo(hw_.z)), tanh_fast(bfhi(hw_.z))); th_.w = cvtpk(tanh_fast(bflo(hw_.w)), tanh_fast(bfhi(hw_.w)));
                *(LAS v4u*)(lds + RW_TH + tokr * 144 + st_c8 * 2) = th_; *(LAS v4u*)(lds + RW_HA + tokr * 144 + st_c8 * 2) = ha_; }
        }
        __syncthreads();
        {
            const int row = tid >> 3, part = tid & 7, step = sc * 64 + row, t = e ? L - 1 - step : step;
            *(v4u*)(YS + ((size_t)e * T + tok0 + t) * 256 + hh * 64 + part * 8) = *(const LAS v4u*)(lds + RW_YB + row * 144 + part * 16);
        }
    }
#undef RW_STAGE
#undef RW_PREFETCH
    if (!lat && wave < 4) {
        const int v = 16 * wave + i16;
#pragma unroll
        for (int kt = 0; kt < 4; ++kt) *(f32x4*)(a->out + O_RW + (((size_t)((b * 2 + layer) * 2 + e) * 4 + hh) * 64 + v) * 64 + 16 * kt + 4 * g) = ST[kt];
    }
}


constexpr int LQ_NQ = 32;
constexpr int LQ_WAT = 0, LQ_S0 = 2 * LQ_NQ * 144;
constexpr int LS_XCB = 0, LS_XCQ = 9216, LS_AA = LS_XCQ + 64 * LQ_NQ * 4, LS_BV = LS_AA + 64 * LQ_NQ * 4, LS_HH = LS_BV + 64 * LQ_NQ * 4,
              LS_SP = LS_HH + 64 * LQ_NQ * 4, LS_SH = LS_SP + 8 * LQ_NQ * 4, LS_HC = LS_SH + 8 * LQ_NQ * 4, LS_BYTES = LS_HC + 2 * LQ_NQ * 4;
__device__ __forceinline__ void lru_unit_q(ArgsP a, LAS unsigned char* lds, int layer, int u) {
    const int tid = tid_(), lane = tid & 63, wave = tid >> 6, i16 = lane & 15, g4 = lane >> 4;
    const int lat = u < 64, uu = lat ? u : u - 64, bp = uu >> 4, e = (uu >> 3) & 1, g = (uu >> 1) & 3, oq = uu & 1;
    const int L = lat ? L_LAT : L_CTX;
    const int tokb[2] = {lat ? T_CTX + (2 * bp) * L_LAT : (2 * bp) * L_CTX, lat ? T_CTX + (2 * bp + 1) * L_LAT : (2 * bp + 1) * L_CTX};
    const bf16* G1 = (const bf16*)(a->ws + WS_G1);
    unsigned char* HO = e ? (unsigned char*)a->out + 2048 : a->ws + WS_HF;
    const size_t hstr = e ? 4096 : 512;
    const int tt = tid >> 3, q8 = (tid & 7) * 8;
    float cw[4][8], cb[8];
#pragma unroll
    for (int i = 0; i < 8; ++i) { const int ch = g * 64 + q8 + i; cb[i] = a->in[I_CONVB][layer * 256 + ch];
#pragma unroll
        for (int j = 0; j < 4; ++j) cw[j][i] = a->in[I_CONVW][(layer * 4 + j) * 256 + ch]; }
    const int gt = wave & 3, got = wave >> 2;
    const int ssn = tid >> 8, sch = tid & (LQ_NQ - 1), seg = (tid >> 5) & 7;
    const int otok = tid >> 3, oc4 = (tid & 7) * 4;
    const int chq = g * 64 + oq * LQ_NQ;
    LAS unsigned char* SS = lds + LQ_S0 + ssn * LS_BYTES;
    {
        __syncthreads();
        { const int m = tid >> 8, row = (tid >> 3) & 31, c8 = (tid & 7) * 8;
          const bf16* wsrc = (const bf16*)(a->ws + WS_LRUW) + ((size_t)(((layer * 2 + e) * 2 + m) * 4 + g) * 64 + oq * LQ_NQ + row) * 64 + c8;
          *(LAS v4u*)(lds + LQ_WAT + m * LQ_NQ * 144 + row * 144 + c8 * 2) = *(const v4u*)wsrc; }
        if (tid < 2 * LQ_NQ) { const int s = tid >> 5, c = tid & 31; ((LAS float*)(lds + LQ_S0 + s * LS_BYTES + LS_HC))[c] = lat ? a->in[I_SLRU][((size_t)((2 * bp + s) * 2 + layer) * 2 + e) * 256 + chq + c] : 0.f; }
        f32x4 bav, bxv, spl;
        { const int chb = (layer * 2 + e) * 256 + chq + 16 * got + 4 * g4;
          bav = *(const f32x4*)(a->in[I_BA] + chb); bxv = *(const f32x4*)(a->in[I_BX] + chb); const f32x4 lam = *(const f32x4*)(a->in[I_LAMBDA] + chb);
#pragma unroll
          for (int q = 0; q < 4; ++q) spl[q] = log1pf(exp_(-lam[q])); }
        v4u xr[2][4];
#define LQ_PREFETCH(cc_) do { const int c_ = e ? L / 64 - 1 - (cc_) : (cc_), t_ = c_ * 64 + tt; \
            _Pragma("unroll") for (int s = 0; s < 2; ++s) { \
              _Pragma("unroll") for (int j = 0; j < 4; ++j) { const int ts = t_ + j - 2; xr[s][j] = (ts >= 0 && ts < L) ? *(const v4u*)(G1 + (size_t)(tokb[s] + ts) * G1W + C_XL + g * 64 + q8) : (v4u){0u, 0u, 0u, 0u}; } \
              } } while (0)
        LQ_PREFETCH(0);
        __syncthreads();
        for (int cc = 0; cc < L / 64; ++cc) {
            const int c = e ? L / 64 - 1 - cc : cc;
            v4u xcur[2][4];
#pragma unroll
            for (int s = 0; s < 2; ++s) { xcur[s][0] = xr[s][0]; xcur[s][1] = xr[s][1]; xcur[s][2] = xr[s][2]; xcur[s][3] = xr[s][3]; }
            if (cc + 1 < L / 64) LQ_PREFETCH(cc + 1);
#pragma unroll
            for (int s = 0; s < 2; ++s) {
                LAS unsigned char* SB = lds + LQ_S0 + s * LS_BYTES;
                float xc[8];
#pragma unroll
                for (int i = 0; i < 8; ++i) xc[i] = cb[i];
#pragma unroll
                for (int j = 0; j < 4; ++j) { const v4u x = xcur[s][j];
                    xc[0] += cw[j][0] * bflo(x.x); xc[1] += cw[j][1] * bfhi(x.x); xc[2] += cw[j][2] * bflo(x.y); xc[3] += cw[j][3] * bfhi(x.y);
                    xc[4] += cw[j][4] * bflo(x.z); xc[5] += cw[j][5] * bfhi(x.z); xc[6] += cw[j][6] * bflo(x.w); xc[7] += cw[j][7] * bfhi(x.w); }
                *(LAS v4u*)(SB + LS_XCB + tt * 144 + q8 * 2) = (v4u){cvtpk(xc[0], xc[1]), cvtpk(xc[2], xc[3]), cvtpk(xc[4], xc[5]), cvtpk(xc[6], xc[7])};
                if ((q8 / LQ_NQ) == oq) { LAS float* XCQ = (LAS float*)(SB + LS_XCQ); *(LAS f32x4*)(XCQ + tt * LQ_NQ + (q8 % LQ_NQ)) = (f32x4){xc[0], xc[1], xc[2], xc[3]}; *(LAS f32x4*)(XCQ + tt * LQ_NQ + (q8 % LQ_NQ) + 4) = (f32x4){xc[4], xc[5], xc[6], xc[7]}; }
            }
            __syncthreads();
#pragma unroll
            for (int s = 0; s < 2; ++s) {
                LAS unsigned char* SB = lds + LQ_S0 + s * LS_BYTES;
                const int tk = gt * 16 + i16;
                f32x4 ga = (f32x4){0.f, 0.f, 0.f, 0.f}, gx = (f32x4){0.f, 0.f, 0.f, 0.f};
#pragma unroll
                for (int ks = 0; ks < 2; ++ks) { const bf16x8 xf = *(const LAS bf16x8*)(SB + LS_XCB + tk * 144 + ks * 64 + g4 * 16);
                    const bf16x8 wa = *(const LAS bf16x8*)(lds + LQ_WAT + (16 * got + i16) * 144 + ks * 64 + g4 * 16), wx = *(const LAS bf16x8*)(lds + LQ_WAT + LQ_NQ * 144 + (16 * got + i16) * 144 + ks * 64 + g4 * 16);
                    ga = MFMA16(wa, xf, ga); gx = MFMA16(wx, xf, gx); }
                const f32x4 xcv = *(const LAS f32x4*)((LAS float*)(SB + LS_XCQ) + tk * LQ_NQ + 16 * got + 4 * g4);
                f32x4 av, bv;
#pragma unroll
                for (int q = 0; q < 4; ++q) { const float la = -8.f * sigmoidf_(ga[q] + bav[q]) * spl[q], aq = exp_(la); av[q] = aq; bv[q] = sqrt_((1.f - aq) * (1.f + aq)) * sigmoidf_(gx[q] + bxv[q]) * xcv[q]; }
                *(LAS f32x4*)((LAS float*)(SB + LS_AA) + tk * LQ_NQ + 16 * got + 4 * g4) = av; *(LAS f32x4*)((LAS float*)(SB + LS_BV) + tk * LQ_NQ + 16 * got + 4 * g4) = bv;
            }
            __syncthreads();
            LAS float* AA = (LAS float*)(SS + LS_AA); LAS float* BV = (LAS float*)(SS + LS_BV); LAS float* HH = (LAS float*)(SS + LS_HH);
            LAS float* SP = (LAS float*)(SS + LS_SP); LAS float* SH = (LAS float*)(SS + LS_SH); LAS float* HC = (LAS float*)(SS + LS_HC);
            float av8[8], bv8[8];
            {
                float P = 1.f, H = 0.f;
#pragma unroll
                for (int s = 0; s < 8; ++s) { const int p = seg * 8 + s, st = e ? 63 - p : p; av8[s] = AA[st * LQ_NQ + sch]; bv8[s] = BV[st * LQ_NQ + sch]; H = fmaf(av8[s], H, bv8[s]); P *= av8[s]; }
                SP[seg * LQ_NQ + sch] = P; SH[seg * LQ_NQ + sch] = H;
            }
            __syncthreads();
            {
                float h = HC[(cc & 1) * LQ_NQ + sch];
                for (int s2 = 0; s2 < seg; ++s2) h = fmaf(SP[s2 * LQ_NQ + sch], h, SH[s2 * LQ_NQ + sch]);
#pragma unroll
                for (int s = 0; s < 8; ++s) { const int p = seg * 8 + s, st = e ? 63 - p : p; h = fmaf(av8[s], h, bv8[s]); HH[st * LQ_NQ + sch] = h; }
                if (seg == 7) HC[((cc + 1) & 1) * LQ_NQ + sch] = h;
            }
            __syncthreads();
#pragma unroll
            for (int s = 0; s < 2; ++s) {
                const int n = tokb[s] + c * 64 + otok;
                const f32x4 hv = *(const LAS f32x4*)((LAS float*)(lds + LQ_S0 + s * LS_BYTES + LS_HH) + otok * LQ_NQ + oc4);
                *(v2u*)(HO + (size_t)n * hstr + (chq + oc4) * 2) = (v2u){cvtpk(hv[0], hv[1]), cvtpk(hv[2], hv[3])};
            }
        }
#undef LQ_PREFETCH
        __syncthreads();
        if (tid < 2 * LQ_NQ && !lat) { const int s = tid >> 5, c = tid & 31; a->out[O_LRU + ((size_t)((2 * bp + s) * 2 + layer) * 2 + e) * 256 + chq + c] = ((LAS float*)(lds + LQ_S0 + s * LS_BYTES + LS_HC))[((L / 64) & 1) * LQ_NQ + c]; }
    }
}

constexpr int ATT2_VSTR = 144, ATT2_STAGE = 64 * ATT_KSTR + 64 * ATT2_VSTR;
#define ATT_KLOAD(KB_) \
        bf16x8 kfa_[6], kfb_[6]; \
        _Pragma("unroll") for (int ks_ = 0; ks_ < 6; ++ks_) { kfa_[ks_] = *(const LAS bf16x8*)((KB_) + r * ATT_KSTR + ks_ * 32 + hq * 16); kfb_[ks_] = *(const LAS bf16x8*)((KB_) + (32 + r) * ATT_KSTR + ks_ * 32 + hq * 16); }
#define ATT_VLOAD(VB_) \
        v2u va0_[4], va1_[4], vb0_[4], vb1_[4]; \
        _Pragma("unroll") for (int ks_ = 0; ks_ < 4; ++ks_) { \
            const LAS unsigned char* vp_ = (VB_) + (ks_ * 16 + 4 * hq + ((lane >> 2) & 3)) * ATT2_VSTR + (16 * ((lane >> 4) & 1) + 4 * (lane & 3)) * 2; \
            va0_[ks_] = __builtin_bit_cast(v2u, __builtin_amdgcn_ds_read_tr16_b64_v4i16((LAS s16x4_t*)(vp_))); \
            va1_[ks_] = __builtin_bit_cast(v2u, __builtin_amdgcn_ds_read_tr16_b64_v4i16((LAS s16x4_t*)(vp_ + 8 * ATT2_VSTR))); \
            vb0_[ks_] = __builtin_bit_cast(v2u, __builtin_amdgcn_ds_read_tr16_b64_v4i16((LAS s16x4_t*)(vp_ + 64))); \
            vb1_[ks_] = __builtin_bit_cast(v2u, __builtin_amdgcn_ds_read_tr16_b64_v4i16((LAS s16x4_t*)(vp_ + 8 * ATT2_VSTR + 64))); }
#define ATT_QKM(S0_, S1_) do { \
        _Pragma("unroll") for (int i_ = 0; i_ < 16; ++i_) { S0_[i_] = 0.f; S1_[i_] = 0.f; } \
        _Pragma("unroll") for (int ks_ = 0; ks_ < 6; ++ks_) { S0_ = MFMA32(kfa_[ks_], qf[ks_], S0_); S1_ = MFMA32(kfb_[ks_], qf[ks_], S1_); } } while (0)
#define ATT_STEP(SC0_, SC1_, SN0_, SN1_, KB_, VB_, HAVE_NEXT_) do { \
        ATT_KLOAD(KB_) \
        float mx_ = SC0_[0]; \
        _Pragma("unroll") for (int i_ = 1; i_ < 16; ++i_) mx_ = fmaxf(mx_, SC0_[i_]); \
        _Pragma("unroll") for (int i_ = 0; i_ < 16; ++i_) mx_ = fmaxf(mx_, SC1_[i_]); \
        mx_ = fmaxf(mx_, __shfl_xor(mx_, 32)); \
        if (!__all(mx_ - m <= 8.f)) { const float mn_ = fmaxf(m, mx_), al_ = __builtin_amdgcn_exp2f(m - mn_); m = mn_; l *= al_; \
            _Pragma("unroll") for (int i_ = 0; i_ < 16; ++i_) { o0[i_] *= al_; o1[i_] *= al_; } } \
        if (HAVE_NEXT_) ATT_QKM(SN0_, SN1_); \
        ATT_VLOAD(VB_) \
        float ps_ = 0.f; \
        _Pragma("unroll") for (int i_ = 0; i_ < 16; ++i_) { SC0_[i_] = __builtin_amdgcn_exp2f(SC0_[i_] - m); SC1_[i_] = __builtin_amdgcn_exp2f(SC1_[i_] - m); ps_ += SC0_[i_] + SC1_[i_]; } \
        l += ps_; \
        _Pragma("unroll") for (int ks_ = 0; ks_ < 4; ++ks_) { \
            v4u pw_; \
            if (ks_ == 0) { pw_.x = cvtpk(SC0_[0], SC0_[1]); pw_.y = cvtpk(SC0_[2], SC0_[3]); pw_.z = cvtpk(SC0_[4], SC0_[5]); pw_.w = cvtpk(SC0_[6], SC0_[7]); } \
            else if (ks_ == 1) { pw_.x = cvtpk(SC0_[8], SC0_[9]); pw_.y = cvtpk(SC0_[10], SC0_[11]); pw_.z = cvtpk(SC0_[12], SC0_[13]); pw_.w = cvtpk(SC0_[14], SC0_[15]); } \
            else if (ks_ == 2) { pw_.x = cvtpk(SC1_[0], SC1_[1]); pw_.y = cvtpk(SC1_[2], SC1_[3]); pw_.z = cvtpk(SC1_[4], SC1_[5]); pw_.w = cvtpk(SC1_[6], SC1_[7]); } \
            else { pw_.x = cvtpk(SC1_[8], SC1_[9]); pw_.y = cvtpk(SC1_[10], SC1_[11]); pw_.z = cvtpk(SC1_[12], SC1_[13]); pw_.w = cvtpk(SC1_[14], SC1_[15]); } \
            const bf16x8 pf_ = __builtin_bit_cast(bf16x8, pw_); \
            const v4u vwa_ = {va0_[ks_].x, va0_[ks_].y, va1_[ks_].x, va1_[ks_].y}, vwb_ = {vb0_[ks_].x, vb0_[ks_].y, vb1_[ks_].x, vb1_[ks_].y}; \
            o0 = MFMA32(__builtin_bit_cast(bf16x8, vwa_), pf_, o0); o1 = MFMA32(__builtin_bit_cast(bf16x8, vwb_), pf_, o1); } } while (0)
__device__ __forceinline__ void att_unit2(ArgsP a, LAS unsigned char* lds, int u) {
    const int tid = tid_(), lane = tid & 63, wave = tid >> 6, r = lane & 31, hq = lane >> 5;
    const bf16* KN = (const bf16*)(a->ws + WS_KN); const bf16* KR = (const bf16*)(a->ws + WS_KR); const bf16* VT = (const bf16*)(a->ws + WS_VT);
    bf16* Q = (bf16*)(a->ws + WS_Q); const bf16* G1 = (const bf16*)(a->ws + WS_G1);
    int b, h, n0, Lk, kidx0; size_t vbase;
    if (u < 512) { b = u >> 6; h = (u >> 3) & 7; n0 = T_CTX + b * 2048 + (u & 7) * 256; Lk = LK_LAT; kidx0 = T_CTX + b * LK_LAT; vbase = (size_t)VT_LAT + (size_t)(b * 8 + h) * 64 * LK_LAT; }
    else { const int uu = u - 512; b = uu >> 3; h = uu & 7; n0 = b * 256; Lk = 256; kidx0 = b * 256; vbase = (size_t)(b * 8 + h) * 64 * 256; }
    const int ntiles = Lk >> 6;
    const int n = n0 + wave * 32 + r;
    bf16x8 qf[6];
#pragma unroll
    for (int ks = 0; ks < 6; ++ks) qf[ks] = *(const bf16x8*)(Q + (size_t)n * 768 + h * 96 + ks * 16 + 8 * hq);
    const int key_k = tid >> 3, ck = tid & 7, key_r = (tid >> 2) & 63, cr = tid & 3;
    const bf16* gk = KN + (size_t)(kidx0 + key_k) * 512 + h * 64 + ck * 8;
    const bf16* gr = KR + (size_t)(kidx0 + key_r) * 32 + cr * 8;
    const bf16* gv = VT + (size_t)(kidx0 + key_k) * 512 + h * 64 + ck * 8;
    const unsigned sk = key_k * ATT_KSTR + ck * 16, sr = key_r * ATT_KSTR + 128 + cr * 16, sv = ATT_VOFF + key_k * ATT2_VSTR + ck * 16;
    v4u rkA, rrA = {0u, 0u, 0u, 0u}, rvA, rkB, rrB = {0u, 0u, 0u, 0u}, rvB;
#define ATT_LOAD(X_, j_) do { rk##X_ = *(const v4u*)(gk + (size_t)(j_) * 64 * 512); if (tid < 256) rr##X_ = *(const v4u*)(gr + (size_t)(j_) * 64 * 32); rv##X_ = *(const v4u*)(gv + (size_t)(j_) * 64 * 512); } while (0)
#define ATT_STORE(X_, B_) do { LAS unsigned char* nb_ = lds + (B_) * ATT2_STAGE; *(LAS v4u*)(nb_ + sk) = rk##X_; if (tid < 256) *(LAS v4u*)(nb_ + sr) = rr##X_; \
        *(LAS v4u*)(nb_ + sv) = rv##X_; } while (0)
    ATT_LOAD(A, 0); ATT_LOAD(B, 1);
    __syncthreads();
    ATT_STORE(A, 0);
    ATT_STORE(B, 1);
    ATT_LOAD(A, 2);
    __syncthreads();
    f32x16 o0, o1, sa0, sa1, sb0, sb1;
#pragma unroll
    for (int i = 0; i < 16; ++i) { o0[i] = 0.f; o1[i] = 0.f; }
    float m = -1e30f, l = 0.f;
    { ATT_KLOAD(lds) ATT_QKM(sa0, sa1); }
    int bcur = 0;
    int j = 0;
    for (; j < ntiles - 2; j += 2) {
        {
            const int b1 = bcur == 2 ? 0 : bcur + 1, b2 = b1 == 2 ? 0 : b1 + 1;
            ATT_LOAD(B, j + 3);
            ATT_STEP(sa0, sa1, sb0, sb1, lds + b1 * ATT2_STAGE, lds + bcur * ATT2_STAGE + ATT_VOFF, true);
            ATT_STORE(A, b2);
            __syncthreads();
            bcur = b1;
        }
        {
            const int b1 = bcur == 2 ? 0 : bcur + 1, b2 = b1 == 2 ? 0 : b1 + 1;
            if (j + 4 < ntiles) ATT_LOAD(A, j + 4);
            ATT_STEP(sb0, sb1, sa0, sa1, lds + b1 * ATT2_STAGE, lds + bcur * ATT2_STAGE + ATT_VOFF, true);
            ATT_STORE(B, b2);
            __syncthreads();
            bcur = b1;
        }
    }
    {
        { const int b1 = bcur == 2 ? 0 : bcur + 1;
          ATT_STEP(sa0, sa1, sb0, sb1, lds + b1 * ATT2_STAGE, lds + bcur * ATT2_STAGE + ATT_VOFF, true);
          bcur = b1; }
        { ATT_STEP(sb0, sb1, sa0, sa1, lds + bcur * ATT2_STAGE, lds + bcur * ATT2_STAGE + ATT_VOFF, false); }
        __syncthreads();
    }
#undef ATT_LOAD
#undef ATT_STORE
    v2u gmv[2][4];
#pragma unroll
    for (int mt = 0; mt < 2; ++mt)
#pragma unroll
        for (int g = 0; g < 4; ++g) gmv[mt][g] = *(const v2u*)(G1 + (size_t)n * G1W + C_GM + h * 64 + 32 * mt + 8 * g + 4 * hq);
    l += __shfl_xor(l, 32);
    const float inv = rcp_(l);
#pragma unroll
    for (int mt = 0; mt < 2; ++mt)
#pragma unroll
        for (int g = 0; g < 4; ++g) {
            const int dv0 = 32 * mt + 8 * g + 4 * hq;
            const v2u gm = gmv[mt][g];
            const float x0 = (mt ? o1[4 * g + 0] : o0[4 * g + 0]) * inv, x1 = (mt ? o1[4 * g + 1] : o0[4 * g + 1]) * inv, x2 = (mt ? o1[4 * g + 2] : o0[4 * g + 2]) * inv, x3 = (mt ? o1[4 * g + 3] : o0[4 * g + 3]) * inv;
            v2u ov; ov.x = cvtpk(x0 * siluf_(bflo(gm.x)), x1 * siluf_(bfhi(gm.x))); ov.y = cvtpk(x2 * siluf_(bflo(gm.y)), x3 * siluf_(bfhi(gm.y)));
            *(v2u*)(Q + (size_t)n * 768 + h * 96 + dv0) = ov;
        }
}
constexpr int N_PHASES = 14;

__device__ __forceinline__ void phase_b(ArgsP a, LAS unsigned char* lds, int layer) {
    volatile LAS unsigned* MISC = (volatile LAS unsigned*)(lds + LDS_MISC);
    unsigned* head = (unsigned*)(a->ws + WS_CTL) + CW_Q + layer * 64;
    for (;;) {
        __syncthreads();
        if (tid_() == 0) MISC[16] = atomicAdd(head, 1u);
        __syncthreads();
        const int idx = (int)MISC[16];
        if (idx >= 1408) break;
        if (idx < 64) rwkv_unit_mfma(a, lds, layer, idx);
        else if (idx < 128) lru_unit_q(a, lds, layer, idx - 64);
        else if (idx < 640) att_unit2(a, lds, idx - 128);
        else if (idx < 896) rwkv_unit_mfma(a, lds, layer, 64 + idx - 640);
        else if (idx < 1152) lru_unit_q(a, lds, layer, 64 + idx - 896);
        else att_unit2(a, lds, 512 + idx - 1152);
    }
}

#define ARGS_VIEW() ({ ArgsP p_ = (ArgsP)__builtin_amdgcn_kernarg_segment_ptr(); asm volatile("" : "+s"(p_)); p_; })
__global__ void __launch_bounds__(NTHREADS, 2) mk_fwd(Args args) {
    extern __shared__ __attribute__((aligned(16))) unsigned char lds_raw[];
    LAS unsigned char* lds = (LAS unsigned char*)lds_raw;
    volatile LAS unsigned* MISC = (volatile LAS unsigned*)(lds + LDS_MISC);
    for (int u = threadIdx.x; u < 64; u += NTHREADS) MISC[u] = 0u;
    __syncthreads();
    XcdBarrier bar;
    { ArgsP a = ARGS_VIEW(); bar = xcd_barrier_post((unsigned*)(a->ws + WS_CTL) + CW_BAR, MISC + 8); }
    int lo, hi; { ArgsP a = ARGS_VIEW(); lo = a->ph_lo; hi = a->ph_hi; }
#define IN(k) (lo <= (k) && (k) < hi)
#define SEAM(k) do { if (IN(k) && IN((k) + 1)) xcd_barrier(bar); } while (0)
    if (IN(0)) { ArgsP a = ARGS_VIEW(); phase_p0(a, lds); }
    SEAM(0);
    for (int layer = 0; layer < 2; ++layer) {
        const int p = 1 + 6 * layer;
        if (IN(p + 0)) { { ArgsP a = ARGS_VIEW(); phase_a0(a, lds, layer); } if (layer == 0) { ArgsP a = ARGS_VIEW(); phase_p0_weights(a, lds); } }
        SEAM(p + 0);
        if (IN(p + 1)) { ArgsP a = ARGS_VIEW(); phase_a1_pg8(a, lds, layer); }
        SEAM(p + 1);
        if (IN(p + 2)) { { ArgsP a = ARGS_VIEW(); phase_a2a(a, layer); } xcd_barrier(bar); { ArgsP a = ARGS_VIEW(); phase_a2b(a, lds, layer); } }
        SEAM(p + 2);
        if (IN(p + 3)) { ArgsP a = ARGS_VIEW(); phase_b(a, lds, layer); }
        SEAM(p + 3);
        if (IN(p + 4)) { ArgsP a = ARGS_VIEW(); phase_c1(a, layer); }
        SEAM(p + 4);
        if (IN(p + 5)) { ArgsP a = ARGS_VIEW(); phase_c2_pg8(a, lds, layer); }
        SEAM(p + 5);
    }
    if (IN(N_PHASES - 1)) { ArgsP a = ARGS_VIEW(); phase_final(a); }
#undef IN
#undef SEAM
}

extern "C" void kernel_launch(void* const* d_in, const int* in_sizes, int n_in, void* d_out, int out_size, void* d_ws, size_t ws_size, hipStream_t stream) {
    static int grid = 0;
    if (grid == 0) {
        if (n_in != N_IN || ws_size < WS_END) { fprintf(stderr, "kernel_launch: unexpected n_in %d / ws_size %zu\n", n_in, ws_size); grid = -1; return; }
        int dev = 0, cus = 0;
        if (hipGetDevice(&dev) != hipSuccess || hipDeviceGetAttribute(&cus, hipDeviceAttributeMultiprocessorCount, dev) != hipSuccess) { grid = -1; return; }
        if (hipFuncSetAttribute((const void*)mk_fwd, hipFuncAttributeMaxDynamicSharedMemorySize, LDS_BYTES) != hipSuccess) { fprintf(stderr, "kernel_launch: hipFuncSetAttribute failed\n"); grid = -1; return; }
        int per_cu = 0;
        if (hipOccupancyMaxActiveBlocksPerMultiprocessor(&per_cu, (const void*)mk_fwd, NTHREADS, LDS_BYTES) != hipSuccess || per_cu < 1) fprintf(stderr, "kernel_launch: occupancy query reports %d\n", per_cu);
        (void)hipGetLastError();
        grid = cus;
    }
    if (grid < 0) return;
    if (hipMemsetAsync((char*)d_ws + WS_CTL, 0, CTL_ZERO_BYTES, stream) != hipSuccess) return;
    Args a{};
    for (int i = 0; i < N_IN; ++i) a.in[i] = (const float*)d_in[i];
    a.out = (float*)d_out; a.ws = (unsigned char*)d_ws;
    a.ph_lo = 0; a.ph_hi = N_PHASES;
    hipLaunchKernelGGL(mk_fwd, dim3(grid), dim3(NTHREADS), LDS_BYTES, stream, a);
}
```

```cpp
#include <hip/hip_runtime.h>
#include <cstdio>
#include <cstdint>

#define GAS __attribute__((address_space(1)))
#define LAS __attribute__((address_space(3)))
typedef unsigned short bf16;
typedef unsigned v4u __attribute__((ext_vector_type(4)));
typedef unsigned v2u __attribute__((ext_vector_type(2)));
typedef float f32x4 __attribute__((ext_vector_type(4)));
typedef short bf16x8 __attribute__((ext_vector_type(8)));

constexpr int D = 1024, T_CTX = 8192, T_LAT = 16384, T = 24576, L_CTX = 256, L_LAT = 2048, PAST = 256;
constexpr int NIN = 2816, G1W = 2304, G2W = 512;
constexpr int C_R = 0, C_K = 256, C_V = 512, C_G = 768, C_GM = 1024, C_XL = 1536, C_GL = 1792, C_LORA = 2048;
constexpr int LK_LAT = PAST + L_LAT;
constexpr int TK = T_CTX + 8 * LK_LAT;
constexpr int VT_LAT = 32 * 8 * 64 * 256;
constexpr float LN_EPS = 1e-5f, GN_EPS = 64e-5f;
constexpr float ALPHA = 1.4142135623730951f;
constexpr float QSCALE = 0.10206207261596575f * 1.4426950408889634f;
constexpr size_t O_Y = 0, O_RW = 25165824, O_CKV = 27262976, O_KR = 29360128, O_LRU = 29884416;
constexpr size_t MiB = 1u << 20;
constexpr size_t WS_CTL = 0, CTL_ZERO_BYTES = 1 * MiB;
constexpr size_t WS_MOD = 256 * 1024;
constexpr size_t WS_ROPE = 1 * MiB;
constexpr size_t WS_LORA2 = 1280 * 1024;
constexpr size_t WS_LRUW = 2816 * 1024;
constexpr size_t WS_STATS = 1536 * 1024;
constexpr size_t WS_WUQ = 2 * MiB;
constexpr size_t WS_WUKV = 3 * MiB;
constexpr size_t WS_WIN = 4 * MiB;
constexpr size_t WS_WOUT = 16 * MiB;
constexpr size_t WS_G1 = 20 * MiB;
constexpr size_t WS_G2 = 128 * MiB;
constexpr size_t WS_Q = 152 * MiB;
constexpr size_t WS_U = 152 * MiB;
constexpr size_t WS_KN = 188 * MiB;
constexpr size_t WS_KR = 214 * MiB;
constexpr size_t WS_VT = 216 * MiB;
constexpr size_t WS_YMIX = 188 * MiB;
constexpr size_t WS_HF = 242 * MiB;
constexpr size_t WS_END = 254 * MiB;
constexpr int CW_BAR = 4096;
constexpr int CW_Q = 16384;

__device__ __forceinline__ float bf2f(unsigned b) { return __uint_as_float(b << 16); }
__device__ __forceinline__ float bflo(unsigned w) { return __uint_as_float(w << 16); }
__device__ __forceinline__ float bfhi(unsigned w) { return __uint_as_float(w & 0xffff0000u); }
__device__ __forceinline__ unsigned f2bf(float f) { unsigned u = __float_as_uint(f); return (u + 0x7fffu + ((u >> 16) & 1u)) >> 16; }
__device__ __forceinline__ unsigned pk2(float lo, float hi) { return f2bf(lo) | (f2bf(hi) << 16); }
__device__ __forceinline__ float rcp_(float x) { return __builtin_amdgcn_rcpf(x); }
__device__ __forceinline__ float exp_(float x) { return __builtin_amdgcn_exp2f(x * 1.4426950408889634f); }
__device__ __forceinline__ float sqrt_(float x) { return __builtin_amdgcn_sqrtf(x); }
__device__ __forceinline__ float rsqrt_(float x) { return __builtin_amdgcn_rsqf(x); }
__device__ __forceinline__ float sigmoidf_(float x) { return rcp_(1.f + exp_(-x)); }
__device__ __forceinline__ float siluf_(float x) { return x * rcp_(1.f + exp_(-x)); }
template <int CTRL> __device__ __forceinline__ float dpp_f(float old, float x) { return __builtin_bit_cast(float, __builtin_amdgcn_update_dpp(__builtin_bit_cast(int, old), __builtin_bit_cast(int, x), CTRL, 0xf, 0xf, false)); }
__device__ __forceinline__ float row16_sum(float x) { x += dpp_f<0x128>(0.f, x); x += dpp_f<0x124>(0.f, x); x += dpp_f<0x122>(0.f, x); x += dpp_f<0x121>(0.f, x); return x; }
__device__ __forceinline__ float wave_sum_fast(float x) { x = row16_sum(x); x += __shfl_xor(x, 16); x += __shfl_xor(x, 32); return x; }
__device__ __forceinline__ float row16_prefix_prod(float x) { x *= dpp_f<0x111>(1.f, x); x *= dpp_f<0x112>(1.f, x); x *= dpp_f<0x114>(1.f, x); x *= dpp_f<0x118>(1.f, x); return x; }
__device__ __forceinline__ float wave_sum(float v) { return wave_sum_fast(v); }
__device__ __forceinline__ int tid_() { int t = threadIdx.x; asm volatile("" : "+v"(t)); return t; }
__device__ __forceinline__ int bid_() { int b = blockIdx.x; asm volatile("" : "+s"(b)); return b; }
__device__ __forceinline__ int grid_() { int g = gridDim.x; asm volatile("" : "+s"(g)); return g; }
typedef float f32x16 __attribute__((ext_vector_type(16)));
typedef float f32x2_t __attribute__((ext_vector_type(2)));
typedef __bf16 bf16x2_t __attribute__((ext_vector_type(2)));
__device__ __forceinline__ unsigned cvtpk(float lo, float hi) { const f32x2_t v = {lo, hi}; return __builtin_bit_cast(unsigned, __builtin_convertvector(v, bf16x2_t)); }
#define XB_TMO      128
#define XB_XCNT(j)  (256  + 64 * (j))
#define XB_XSUB(j)  (1280 + 64 * (j))
#define XB_XGEN(j)  (2304 + 64 * (j))
#define XB_TOP      3328
#define XB_TOPGEN   3392
#define XCD_BAR_WORDS 3456
#define XB_SPIN_CAP (1u << 24)

__device__ __forceinline__ unsigned xb_ld(unsigned* p)              { return __hip_atomic_load(p, __ATOMIC_RELAXED, __HIP_MEMORY_SCOPE_AGENT); }
__device__ __forceinline__ unsigned xb_add(unsigned* p, unsigned v) { return __hip_atomic_fetch_add(p, v, __ATOMIC_RELAXED, __HIP_MEMORY_SCOPE_AGENT); }
__device__ __forceinline__ unsigned xb_xcc_id() { return (unsigned)__builtin_amdgcn_s_getreg((3 << 11) | 20) & 0xFu; }
#define XB_SPIN(cond, bar) do { unsigned _sp = 0; while (cond) { __builtin_amdgcn_s_sleep(1); \
    if ((++_sp & 255u) == 0u) { if (xb_ld(&(bar)[XB_TMO])) break; if (_sp > XB_SPIN_CAP) { atomicAdd(&(bar)[XB_TMO], 1u); break; } } } } while (0)

struct XcdBarrier {
    unsigned* bar; unsigned x;
    volatile LAS unsigned* st;
};

__device__ __forceinline__ XcdBarrier xcd_barrier_post(unsigned* bar, volatile LAS unsigned* st) {
    XcdBarrier b; b.bar = bar; b.x = xb_xcc_id(); b.st = st;
    if (threadIdx.x == 0) (void)xb_add(&bar[XB_XCNT(b.x)], 1u);
    return b;
}
__device__ __forceinline__ void xcd_barrier_complete(unsigned* bar, unsigned x, unsigned& nloc, unsigned& nx) {
    const unsigned G = gridDim.x * gridDim.y * gridDim.z;
    unsigned sum, cnt, mine, sp = 0u;
    for (;;) {
        sum = 0u; cnt = 0u; mine = 0u;
#pragma unroll
        for (unsigned j = 0; j < 16; ++j) { const unsigned c = xb_ld(&bar[XB_XCNT(j)]); sum += c; cnt += (c > 0u) ? 1u : 0u; mine = (j == x) ? c : mine; }
        if (sum == G) break;
        __builtin_amdgcn_s_sleep(1);
        if ((++sp & 255u) == 0u) { if (xb_ld(&bar[XB_TMO])) break; if (sp > XB_SPIN_CAP) { atomicAdd(&bar[XB_TMO], 1u); break; } }
    }
    nloc = mine > 0u ? mine : 1u; nx = cnt > 0u ? cnt : 1u;
}

__device__ __forceinline__ void xcd_barrier(const XcdBarrier& b) {
    asm volatile("s_waitcnt vmcnt(0)" ::: "memory");
    __syncthreads();
    if (threadIdx.x == 0) {
        unsigned* bar = b.bar;
        __builtin_amdgcn_s_waitcnt(0);
        unsigned nloc = b.st[0], nx = b.st[1];
        if (nloc == 0u) { xcd_barrier_complete(bar, b.x, nloc, nx); b.st[0] = nloc; b.st[1] = nx; }
        const unsigned old = xb_add(&bar[XB_XSUB(b.x)], 1u);
        const unsigned gen = old / nloc;
        if (old + 1u == (gen + 1u) * nloc) {
            __builtin_amdgcn_fence(__ATOMIC_RELEASE, "agent");
            asm volatile("s_waitcnt vmcnt(0)" ::: "memory");
            const unsigned og = xb_add(&bar[XB_TOP], 1u);
            const unsigned tg = og / nx;
            if (og + 1u == (tg + 1u) * nx) xb_add(&bar[XB_TOPGEN], 1u);
            else XB_SPIN(xb_ld(&bar[XB_TOPGEN]) == tg, bar);
            __builtin_amdgcn_fence(__ATOMIC_ACQUIRE, "agent");
            xb_add(&bar[XB_XGEN(b.x)], 1u);
            asm volatile("s_waitcnt vmcnt(0)" ::: "memory");
        } else {
            XB_SPIN(xb_ld(&bar[XB_XGEN(b.x)]) == gen, bar);
            __builtin_amdgcn_fence(__ATOMIC_ACQUIRE, "agent");
            asm volatile("s_waitcnt vmcnt(0)" ::: "memory");
        }
    }
    __syncthreads();
}
enum { I_XP = 0, I_XS, I_SRW, I_CCKV, I_CKR, I_SLRU, I_C, I_CCTX, I_WMOD, I_BMOD, I_WIN, I_W0, I_W1, I_W2, I_A0, I_A1, I_A2, I_KK, I_KA, I_RK,
       I_LNXG, I_LNXB, I_QNORM, I_WUQ, I_KVNORM, I_WUKV, I_CONVW, I_CONVB, I_WA, I_BA, I_WX, I_BX, I_LAMBDA, I_WOUT, I_LNG, I_LNB, N_IN };
struct Args { const float* in[N_IN]; float* out; unsigned char* ws; int ph_lo, ph_hi; };
typedef const Args __attribute__((address_space(4)))* ArgsP;
constexpr int NTHREADS = 512;
constexpr int LDS_MISC = 139264;
constexpr int LDS_BYTES = 147456;

struct Tok { int n, b, t, L, lat, modrow, tok0, kidx; };
__device__ __forceinline__ Tok tok_of(int n) {
    Tok k; k.n = n;
    if (n < T_CTX) { k.lat = 0; k.b = n >> 8; k.t = n & 255; k.L = L_CTX; k.modrow = 0; k.tok0 = k.b * 256; k.kidx = n; }
    else { const int m = n - T_CTX; k.lat = 1; k.b = m >> 11; k.t = m & 2047; k.L = L_LAT; k.modrow = 1 + k.b; k.tok0 = T_CTX + k.b * 2048; k.kidx = T_CTX + k.b * LK_LAT + PAST + k.t; }
    return k;
}
__device__ __forceinline__ const float* xrow_src(ArgsP a, int layer, int n) {
    if (layer == 0) return n < T_CTX ? a->in[I_XP] + (size_t)n * D : a->in[I_XS] + (size_t)(n - T_CTX) * D;
    return a->out + (size_t)n * D;
}
__device__ __forceinline__ float dot8(v4u a, v4u b, float acc) {
    acc = fmaf(bflo(a.x), bflo(b.x), acc); acc = fmaf(bfhi(a.x), bfhi(b.x), acc);
    acc = fmaf(bflo(a.y), bflo(b.y), acc); acc = fmaf(bfhi(a.y), bfhi(b.y), acc);
    acc = fmaf(bflo(a.z), bflo(b.z), acc); acc = fmaf(bfhi(a.z), bfhi(b.z), acc);
    acc = fmaf(bflo(a.w), bflo(b.w), acc); acc = fmaf(bfhi(a.w), bfhi(b.w), acc);
    return acc;
}

__device__ __forceinline__ void tr_item(const float* src, int ld, int col0, int k0, bf16* WT, int K, int row0, float scale, LAS float* scr, int lane) {
    {
        const int kr = lane >> 3, n4 = (lane & 7) * 4;
        f32x4 v[8];
#pragma unroll
        for (int i = 0; i < 8; ++i) v[i] = src ? *(const f32x4*)(src + (size_t)(k0 + i * 8 + kr) * ld + col0 + n4) : (f32x4){0.f, 0.f, 0.f, 0.f};
#pragma unroll
        for (int i = 0; i < 8; ++i) { LAS float* d = scr + (i * 8 + kr) * 33 + n4; d[0] = v[i].x * scale; d[1] = v[i].y * scale; d[2] = v[i].z * scale; d[3] = v[i].w * scale; }
    }
    asm volatile("s_waitcnt lgkmcnt(0)" ::: "memory");
    const int c = lane & 7;
#pragma unroll
    for (int j = 0; j < 4; ++j) { const int n = (lane >> 3) + 8 * j; const LAS float* s = scr + (8 * c) * 33 + n;
        v4u o; o.x = pk2(s[0 * 33], s[1 * 33]); o.y = pk2(s[2 * 33], s[3 * 33]); o.z = pk2(s[4 * 33], s[5 * 33]); o.w = pk2(s[6 * 33], s[7 * 33]);
        *(v4u*)(WT + (size_t)(row0 + n) * K + k0 + 8 * c) = o; }
    asm volatile("s_waitcnt lgkmcnt(0)" ::: "memory");
}
__device__ __forceinline__ void rope_angle(int t, int i, float& c, float& s) {
    const int row = t >> 6, col = t & 63; const int ii = i & 7;
    const float inv = exp2f(-(float)ii * (13.287712379549449f / 8.f));
    const float ang = (float)(i < 8 ? row : col) * inv;
    c = cosf(ang); s = sinf(ang);
}
__device__ __forceinline__ void phase_p0_weights(ArgsP a, LAS unsigned char* lds) {
    const int tid = tid_(), lane = tid & 63, wave = tid >> 6, G = grid_();
    unsigned char* ws = a->ws;
    LAS float* scr = (LAS float*)(lds + wave * 8704);
    const int gw = bid_() * 8 + wave, NGW = G * 8;
    constexpr int N_WIN = 2 * 16 * 88, N_WOUT = 2 * 16 * 32, N_WUQ = 2 * 4 * 24, N_WUKV = 2 * 4 * 32, N_LORA = 2 * 2 * 2 * 8, N_LRUW = 2 * 2 * 2 * 4 * 2;
    for (int it = gw; it < N_WIN + N_WOUT + N_WUQ + N_WUKV + N_LORA + N_LRUW; it += NGW) {
        int r = it;
        if (r < N_WIN) {
            const int l = r / (16 * 88), kb = (r / 88) % 16, nb = r % 88, j0 = nb * 32;
            const float* src; int ld, col0;
            const float* win = a->in[I_WIN] + (size_t)l * 1024 * 2464;
            if (j0 < 1024) { src = win; ld = 2464; col0 = j0; }
            else if (j0 < 1536) { src = win; ld = 2464; col0 = 1440 + (j0 - 1024); }
            else if (j0 < 1792) { src = win; ld = 2464; col0 = 1952 + (j0 - 1536); }
            else if (j0 < 2048) { src = win; ld = 2464; col0 = 2208 + (j0 - 1792); }
            else if (j0 < 2304) { const int q = (j0 - 2048) >> 6; src = (q < 2 ? a->in[I_W1] : a->in[I_A1]) + (size_t)(l * 2 + (q & 1)) * 1024 * 64; ld = 64; col0 = (j0 - 2048) & 63; }
            else if (j0 < 2560) { src = win; ld = 2464; col0 = 1024 + (j0 - 2304); }
            else if (j0 < 2688) { src = win; ld = 2464; col0 = 1280 + (j0 - 2560); }
            else if (j0 < 2720) { src = win; ld = 2464; col0 = 1408 + (j0 - 2688); }
            else { src = nullptr; ld = 0; col0 = 0; }
            tr_item(src, ld, col0, kb * 64, (bf16*)(ws + WS_WIN) + (size_t)l * NIN * 1024, 1024, j0, 1.f, scr, lane);
            continue;
        }
        r -= N_WIN;
        if (r < N_WOUT) { const int l = r / (16 * 32), kb = (r / 32) % 16, nb = r % 32;
            tr_item(a->in[I_WOUT] + (size_t)l * 1024 * 1024, 1024, nb * 32, kb * 64, (bf16*)(ws + WS_WOUT) + (size_t)l * 1024 * 1024, 1024, nb * 32, 1.f, scr, lane); continue; }
        r -= N_WOUT;
        if (r < N_WUQ) { const int l = r / (4 * 24), kb = (r / 24) % 4, nb = r % 24;
            tr_item(a->in[I_WUQ] + (size_t)l * 256 * 768, 768, nb * 32, kb * 64, (bf16*)(ws + WS_WUQ) + (size_t)l * 768 * 256, 256, nb * 32, QSCALE, scr, lane); continue; }
        r -= N_WUQ;
        if (r >= N_WUKV) { r -= N_WUKV;
            if (r < N_LORA) { const int le = r >> 4, m = (r >> 3) & 1, nb = r & 7;
                tr_item((m ? a->in[I_A2] : a->in[I_W2]) + (size_t)le * 64 * 256, 256, nb * 32, 0, (bf16*)(ws + WS_LORA2) + (size_t)(le * 2 + m) * 256 * 64, 64, nb * 32, 1.f, scr, lane); }
            else { r -= N_LORA; const int le = r >> 4, m = (r >> 3) & 1, g = (r >> 1) & 3, nb = r & 1;
                tr_item((m ? a->in[I_WX] : a->in[I_WA]) + (size_t)(le * 4 + g) * 4096, 64, nb * 32, 0, (bf16*)(ws + WS_LRUW) + (size_t)((le * 2 + m) * 4 + g) * 4096, 64, nb * 32, 1.f, scr, lane); }
            continue; }
        { const int l = r / (4 * 32), kb = (r / 32) % 4, nb = r % 32;
            tr_item(kb < 2 ? a->in[I_WUKV] + (size_t)l * 128 * 1024 : nullptr, 1024, nb * 32, kb * 64, (bf16*)(ws + WS_WUKV) + (size_t)l * 1024 * 256, 256, nb * 32, 1.f, scr, lane); }
    }
}
__device__ __forceinline__ void phase_p0(ArgsP a, LAS unsigned char* lds) {
    const int tid = tid_(), G = grid_();
    unsigned char* ws = a->ws;
    { float* ROPE = (float*)(ws + WS_ROPE);
      for (int i = bid_() * NTHREADS + tid; i < 2048 * 16; i += G * NTHREADS) { float c, s; rope_angle(i >> 4, i & 15, c, s); ROPE[i * 2] = c; ROPE[i * 2 + 1] = s; } }
    float* MOD = (float*)(ws + WS_MOD);
    LAS float* SIL = (LAS float*)lds;
    for (int it = bid_(); it < 2 * 6 * 32; it += G) {
        const int l = it / 192, nb = (it / 32) % 6, kq = it % 32, col = nb * 512 + tid;
        __syncthreads();
        if (tid < 288) { const int j = tid >> 5, k = kq * 32 + (tid & 31); const float cj = (j == 0) ? a->in[I_CCTX][k] : a->in[I_C][(j - 1) * 1024 + k]; SIL[tid] = siluf_(cj); }
        float w[32];
#pragma unroll
        for (int kk = 0; kk < 32; ++kk) w[kk] = a->in[I_WMOD][((size_t)l * 1024 + kq * 32 + kk) * 3072 + col];
        __syncthreads();
        const float bias = (kq == 0) ? a->in[I_BMOD][l * 3072 + col] : 0.f;
#pragma unroll
        for (int j = 0; j < 9; ++j) { float acc = bias;
#pragma unroll
            for (int k4 = 0; k4 < 8; ++k4) { const f32x4 sv = *(const LAS f32x4*)(SIL + j * 32 + k4 * 4); acc = fmaf(sv.x, w[k4 * 4], acc); acc = fmaf(sv.y, w[k4 * 4 + 1], acc); acc = fmaf(sv.z, w[k4 * 4 + 2], acc); acc = fmaf(sv.w, w[k4 * 4 + 3], acc); }
            atomicAdd(&MOD[(l * 9 + j) * 3072 + col], acc); }
    }
}

template <int LAYER> __device__ __forceinline__ void a0_rows(ArgsP a, LAS unsigned char* lds) {
    const int tid = tid_(), lane = tid & 63, wave = tid >> 6, G = grid_();
    bf16* U = (bf16*)(a->ws + WS_U);
    LAS float* ML = (LAS float*)lds;
    { const float* MOD = (const float*)(a->ws + WS_MOD) + (size_t)LAYER * 9 * 3072;
      for (int i = tid; i < 9 * 512; i += NTHREADS) { const int r = i >> 9, c4 = (i & 511) * 4; *(LAS f32x4*)(ML + r * 2048 + c4) = *(const f32x4*)(MOD + r * 3072 + c4); } }
    f32x4 gq[4], bq[4];
#pragma unroll
    for (int j = 0; j < 4; ++j) { gq[j] = LAYER ? *(const f32x4*)(a->in[I_LNG] + lane * 4 + 256 * j) : (f32x4){0.f, 0.f, 0.f, 0.f}; bq[j] = LAYER ? *(const f32x4*)(a->in[I_LNB] + lane * 4 + 256 * j) : (f32x4){0.f, 0.f, 0.f, 0.f}; }
    __syncthreads();
    f32x4 ra[4], rb[4];
    auto load = [&](f32x4 (&r)[4], int nn) __attribute__((always_inline)) {
        if (LAYER == 0) { const float* xr = xrow_src(a, 0, nn);
#pragma unroll
            for (int j = 0; j < 4; ++j) r[j] = *(const f32x4*)(xr + lane * 4 + 256 * j); }
        else { const bf16* zr = (const bf16*)a->out + (size_t)nn * 2048;
#pragma unroll
            for (int j = 0; j < 4; ++j) { const v2u w = *(const v2u*)(zr + lane * 4 + 256 * j); r[j].x = __uint_as_float(w.x); r[j].y = __uint_as_float(w.y); } }
    };
    const int stride = G * 8, n0 = bid_() * 8 + wave;
    if (n0 < T) load(ra, n0);
    if (n0 + stride < T) load(rb, n0 + stride);
    auto row = [&](int n, f32x4 (&r)[4]) __attribute__((always_inline)) {
        const Tok tk = tok_of(n);
        f32x4 v[4]; float s = 0.f;
#pragma unroll
        for (int j = 0; j < 4; ++j) {
            if (LAYER == 0) v[j] = r[j] * 1.f;
            else { const unsigned wx = __float_as_uint(r[j].x), wy = __float_as_uint(r[j].y); v[j] = (f32x4){bflo(wx), bfhi(wx), bflo(wy), bfhi(wy)}; }
            s += (v[j].x + v[j].y) + (v[j].z + v[j].w); }
#pragma unroll
        for (int j = 0; j < 4; ++j) asm volatile("" : "+v"(v[j]));
        if (n + 2 * stride < T) load(r, n + 2 * stride);
        float mean = wave_sum(s) * (1.f / D), s2 = 0.f;
#pragma unroll
        for (int j = 0; j < 4; ++j) { v[j] = v[j] - mean; s2 += (v[j].x * v[j].x + v[j].y * v[j].y) + (v[j].z * v[j].z + v[j].w * v[j].w); }
        float rstd = rsqrt_(wave_sum(s2) * (1.f / D) + LN_EPS);
        if (LAYER == 1) {
            s = 0.f;
#pragma unroll
            for (int j = 0; j < 4; ++j) { v[j] = v[j] * rstd * gq[j] + bq[j]; s += (v[j].x + v[j].y) + (v[j].z + v[j].w); }
            if (lane == 0) { float* st = (float*)(a->ws + WS_STATS) + (size_t)n * 2; st[0] = mean; st[1] = rstd; }
            mean = wave_sum(s) * (1.f / D); s2 = 0.f;
#pragma unroll
            for (int j = 0; j < 4; ++j) { v[j] = v[j] - mean; s2 += (v[j].x * v[j].x + v[j].y * v[j].y) + (v[j].z * v[j].z + v[j].w * v[j].w); }
            rstd = rsqrt_(wave_sum(s2) * (1.f / D) + LN_EPS);
        }
        const LAS float* m = ML + tk.modrow * 2048;
#pragma unroll
        for (int j = 0; j < 4; ++j) { const int c = lane * 4 + 256 * j; const f32x4 sh = *(const LAS f32x4*)(m + c), sc = *(const LAS f32x4*)(m + 1024 + c);
            const f32x4 o = v[j] * rstd * (sc + 1.f) + sh;
            v2u p; p.x = pk2(o.x, o.y); p.y = pk2(o.z, o.w); *(v2u*)(U + (size_t)n * D + c) = p; }
    };
    for (int n = n0; n < T; n += 2 * stride) { row(n, ra); if (n + stride < T) row(n + stride, rb); }
    __syncthreads();
}
__device__ __forceinline__ void phase_a0(ArgsP a, LAS unsigned char* lds, int layer) {
    if (layer == 0) a0_rows<0>(a, lds); else a0_rows<1>(a, lds);
}
__device__ __forceinline__ void phase_final(ArgsP a) {
    const int tid = tid_(), lane = tid & 63, wave = tid >> 6, G = grid_();
    f32x4 nx[4];
#define FN_LOAD(nn_) do { const bf16* zr_ = (const bf16*)a->out + (size_t)(nn_) * 2048; \
        _Pragma("unroll") for (int j = 0; j < 4; ++j) { const v2u w_ = *(const v2u*)(zr_ + lane * 4 + 256 * j); nx[j] = (f32x4){bflo(w_.x), bfhi(w_.x), bflo(w_.y), bfhi(w_.y)}; } } while (0)
    { const int n0 = bid_() * 8 + wave; if (n0 < T) FN_LOAD(n0); }
    for (int n = bid_() * 8 + wave; n < T; n += G * 8) {
        float* xr = a->out + (size_t)n * D;
        f32x4 v[4]; float s = 0.f;
#pragma unroll
        for (int j = 0; j < 4; ++j) { v[j] = nx[j]; s += (v[j].x + v[j].y) + (v[j].z + v[j].w); }
        if (n + G * 8 < T) FN_LOAD(n + G * 8);
        const float mean = wave_sum(s) * (1.f / D); float s2 = 0.f;
#pragma unroll
        for (int j = 0; j < 4; ++j) { v[j] = v[j] - mean; s2 += (v[j].x * v[j].x + v[j].y * v[j].y) + (v[j].z * v[j].z + v[j].w * v[j].w); }
        const float rstd = rsqrt_(wave_sum(s2) * (1.f / D) + LN_EPS);
#pragma unroll
        for (int j = 0; j < 4; ++j) { const f32x4 g = *(const f32x4*)(a->in[I_LNG] + 1024 + lane * 4 + 256 * j), b = *(const f32x4*)(a->in[I_LNB] + 1024 + lane * 4 + 256 * j);
            *(f32x4*)(xr + lane * 4 + 256 * j) = v[j] * rstd * g + b; }
    }
}


namespace pg8 {
#define PG8_LAS __attribute__((address_space(3)))
typedef unsigned short bf16_t;
typedef short bf16x8 __attribute__((ext_vector_type(8)));
typedef float f32x4 __attribute__((ext_vector_type(4)));
typedef unsigned u32x4 __attribute__((ext_vector_type(4)));
constexpr int BM = 256, BK = 64, HALF = 128, HTB = HALF * BK * 2  , STAGE_BYTES = 8 * HTB, NXCD = 8, WGM = 8;

__host__ __device__ __forceinline__ int lds_byte(int r, int c) { const int st = (r >> 4) * 2 + (c >> 5), rr = r & 15, cc = c & 31, ob = rr * 64 + cc * 2; return st * 1024 + (ob ^ (((ob >> 9) & 1) << 5)); }
__host__ __device__ __forceinline__ void stage_rc(int b, int& R, int& C) { const int st = b / 1024, sb = b % 1024, swz = sb ^ (((sb >> 9) & 1) << 5); R = (st >> 1) * 16 + swz / 64; C = (st & 1) * 32 + (swz % 64) / 2; }
__host__ __device__ __forceinline__ int perm32(int rho) { const int n = rho >> 4, i = rho & 15; return 8 * (i >> 2) + 4 * n + (i & 3); }

struct Unit { int pm, pn, gid; };
struct Gemm { const bf16_t* A; const bf16_t* Bt; int M, N, K, lda, ldb; };

struct StaticOrder {
    int nM, nN, nwg, G, c;
    __host__ __device__ void init(int M, int N, int G_, int c_) { nM = M / BM; nN = N / BM; nwg = nM * nN; G = G_; c = c_; }
    __host__ __device__ bool next(int i, Unit& u) const {
        const long L = (long)i * G + c; if (L >= nwg) return false;
        int wgid = (int)L; { const int q = nwg / NXCD, r = nwg % NXCD, xcd = wgid % NXCD, off = wgid / NXCD; wgid = (xcd < r ? xcd * (q + 1) : r * (q + 1) + (xcd - r) * q) + off; }
        const int nig = WGM * nN, gid = wgid / nig, fm = gid * WGM, gsz = (nM - fm) < WGM ? (nM - fm) : WGM;
        u.pm = fm + ((wgid % nig) % gsz); u.pn = (wgid % nig) / gsz; u.gid = 0; return true;
    }
    __device__ __forceinline__ const char* abase(const Gemm& g, const Unit& u) const { return (const char*)g.A + (size_t)u.pm * BM * g.lda * 2; }
    __device__ __forceinline__ const char* bbase(const Gemm& g, const Unit& u) const { return (const char*)g.Bt + (size_t)u.pn * BM * g.ldb * 2; }
    __device__ __forceinline__ void a_ready(const Unit&) const {}
    __device__ __forceinline__ void done(const Unit&) const {}
};
__device__ __forceinline__ unsigned cvt_pk_bf16(float lo, float hi) { unsigned r; asm volatile("v_cvt_pk_bf16_f32 %0, %1, %2" : "=v"(r) : "v"(lo), "v"(hi)); return r; }

template <class Epi, class Sched, bool STAMP = false>
__device__ __forceinline__ void gemm_phase(PG8_LAS unsigned char* lds, const Gemm g, const Sched& S, const Epi& E, unsigned long long* stamps) {
    const int tid = tid_(), wid = __builtin_amdgcn_readfirstlane(tid >> 6), lane = tid & 63, wr = wid >> 2, wc = wid & 3, fr = lane & 15, fq = lane >> 4;
    const int K = g.K, nt = K / BK;
    int ts_lo = 0, ts_hi = 0, nts = 0; const unsigned long long rt_entry = STAMP ? (unsigned long long)wall_clock64() : 0ull;
#define PG8_STAMP() do { if (STAMP && wid == 0 && nts < 64) { const unsigned long long _c = (unsigned long long)clock64(); \
        ts_lo = (lane == nts) ? (int)(unsigned)_c : ts_lo; ts_hi = (lane == nts) ? (int)(unsigned)(_c >> 32) : ts_hi; ++nts; } } while (0)
    PG8_STAMP();
    unsigned voffA[2], voffB[2];
#pragma unroll
    for (int i = 0; i < 2; ++i) { int R, C; stage_rc(tid * 16 + i * 8192, R, C); const int Rb = Epi::PERM ? ((R & ~31) + perm32(R & 31)) : R;
        voffA[i] = (unsigned)(R * g.lda + C) * 2u; voffB[i] = (unsigned)(Rb * g.ldb + C) * 2u; }
    const size_t kstep = (size_t)(BK * 2);
    const size_t hstepA = (size_t)HALF * g.lda * 2, hstepB = (size_t)HALF * g.ldb * 2;
    const unsigned ldsw = (unsigned)wid * 1024u;
    const int aoff = lds_byte(wr * 64 + fr, fq * 8), boff = lds_byte(wc * 32 + fr, fq * 8);
#define PG8_SA(b, h) (((b) * 2 + (h)) * HTB)
#define PG8_SB(b, h) ((4 + (b) * 2 + (h)) * HTB)
#define PG8_STAGE(bufoff, gbase, voff) do { _Pragma("unroll") for (int _i = 0; _i < 2; ++_i) \
        __builtin_amdgcn_global_load_lds((const unsigned*)((const char*)(gbase) + (voff)[_i]), (PG8_LAS unsigned*)(lds + (bufoff) + ldsw + _i * 8192), 16, 0, 0); } while (0)
#define PG8_LDA(dst, b, h) do { _Pragma("unroll") for (int m = 0; m < 4; ++m) _Pragma("unroll") for (int k = 0; k < 2; ++k) dst[m][k] = *(const PG8_LAS bf16x8*)(lds + PG8_SA(b, h) + aoff + m * 2048 + k * 1024); } while (0)
#define PG8_LDB(dst, b, h) do { _Pragma("unroll") for (int n = 0; n < 2; ++n) _Pragma("unroll") for (int k = 0; k < 2; ++k) dst[n][k] = *(const PG8_LAS bf16x8*)(lds + PG8_SB(b, h) + boff + n * 2048 + k * 1024); } while (0)
#define PG8_MMA(ai, bj, At, Bt) do { __builtin_amdgcn_s_setprio(1); _Pragma("unroll") for (int m = 0; m < 4; ++m) _Pragma("unroll") for (int n = 0; n < 2; ++n) _Pragma("unroll") for (int k = 0; k < 2; ++k) \
        acc[ai][bj][m][n] = __builtin_amdgcn_mfma_f32_16x16x32_bf16(Bt[n][k], At[m][k], acc[ai][bj][m][n], 0, 0, 0); __builtin_amdgcn_s_setprio(0); } while (0)
#define PG8_WAIT_V(n) asm volatile("s_waitcnt vmcnt(" #n ")" ::: "memory")
#define PG8_WAIT_L(n) asm volatile("s_waitcnt lgkmcnt(" #n ")" ::: "memory")
#define PG8_BAR __builtin_amdgcn_s_barrier()
#define PG8_SCHED __builtin_amdgcn_sched_barrier(0)
    Unit cur, nxt; int ui = 0;
    if (!S.next(0, cur)) return;
    f32x4 acc[2][2][4][2];
#pragma unroll
    for (int a = 0; a < 2; ++a)
#pragma unroll
        for (int b = 0; b < 2; ++b)
#pragma unroll
            for (int m = 0; m < 4; ++m)
#pragma unroll
                for (int n = 0; n < 2; ++n) acc[a][b][m][n] = (f32x4){0.f, 0.f, 0.f, 0.f};
    bf16x8 At[4][2], B0[2][2], B1[2][2];
    const char* cA = S.abase(g, cur); const char* cB = S.bbase(g, cur);
    S.a_ready(cur);
    PG8_STAGE(PG8_SB(0, 0), cB, voffB); PG8_STAGE(PG8_SA(0, 0), cA, voffA); PG8_STAGE(PG8_SB(0, 1), cB + hstepB, voffB); PG8_STAGE(PG8_SA(0, 1), cA + hstepA, voffA);
    if (wr == 1) PG8_BAR;
    PG8_WAIT_V(4); PG8_BAR;
    PG8_STAGE(PG8_SB(1, 0), cB + kstep, voffB); PG8_STAGE(PG8_SA(1, 0), cA + kstep, voffA); PG8_STAGE(PG8_SB(1, 1), cB + hstepB + kstep, voffB);
    PG8_WAIT_V(6); PG8_BAR;
    PG8_STAMP();
    for (;;) {
        const bool has_next = S.next(ui + 1, nxt);
        const char* nA = has_next ? S.abase(g, nxt) : cA; const char* nB = has_next ? S.bbase(g, nxt) : cB;
        for (int t = 0; t < nt; t += 2) {
            const bool last = (t == nt - 2);
            const char* a1 = cA + (size_t)(t + 1) * kstep;
            const char* a2 = last ? nA : cA + (size_t)(t + 2) * kstep; const char* b2 = last ? nB : cB + (size_t)(t + 2) * kstep;
            const char* a3 = a2 + kstep; const char* b3 = b2 + kstep;
            if (last && has_next) S.a_ready(nxt);
            PG8_LDB(B0, 0, 0); PG8_SCHED; PG8_LDA(At, 0, 0); PG8_STAGE(PG8_SA(1, 1), a1 + hstepA, voffA);
            PG8_WAIT_L(8); PG8_BAR; PG8_WAIT_L(0); PG8_MMA(0, 0, At, B0); PG8_BAR; PG8_SCHED;
            PG8_LDB(B1, 0, 1); PG8_STAGE(PG8_SB(0, 0), b2, voffB);
            PG8_BAR; PG8_WAIT_L(0); PG8_MMA(0, 1, At, B1); PG8_BAR;
            PG8_LDA(At, 0, 1); PG8_STAGE(PG8_SA(0, 0), a2, voffA);
            PG8_BAR; PG8_WAIT_L(0); PG8_MMA(1, 0, At, B0); PG8_BAR; PG8_SCHED;
            PG8_STAGE(PG8_SB(0, 1), b2 + hstepB, voffB);
            PG8_WAIT_V(6); PG8_BAR; PG8_MMA(1, 1, At, B1); PG8_BAR;
            PG8_LDB(B0, 1, 0); PG8_SCHED; PG8_LDA(At, 1, 0); PG8_STAGE(PG8_SA(0, 1), a2 + hstepA, voffA);
            PG8_WAIT_L(8); PG8_BAR; PG8_WAIT_L(0); PG8_MMA(0, 0, At, B0); PG8_BAR; PG8_SCHED;
            PG8_LDB(B1, 1, 1); PG8_STAGE(PG8_SB(1, 0), b3, voffB);
            PG8_BAR; PG8_WAIT_L(0); PG8_MMA(0, 1, At, B1); PG8_BAR;
            PG8_LDA(At, 1, 1); PG8_STAGE(PG8_SA(1, 0), a3, voffA);
            PG8_BAR; PG8_WAIT_L(0); PG8_MMA(1, 0, At, B0); PG8_BAR; PG8_SCHED;
            PG8_STAGE(PG8_SB(1, 1), b3 + hstepB, voffB);
            PG8_WAIT_V(6); PG8_BAR; PG8_MMA(1, 1, At, B1); PG8_BAR;
        }
        PG8_STAMP();
        if constexpr (!Epi::AFTER_DRAIN) { E(acc, cur, wr, wc, fr, fq); S.done(cur); }
        PG8_STAMP();
        if (!has_next) break;
#pragma unroll
        for (int a = 0; a < 2; ++a)
#pragma unroll
            for (int b = 0; b < 2; ++b)
#pragma unroll
                for (int m = 0; m < 4; ++m)
#pragma unroll
                    for (int n = 0; n < 2; ++n) acc[a][b][m][n] = (f32x4){0.f, 0.f, 0.f, 0.f};
        cur = nxt; cA = nA; cB = nB; ++ui;
    }
    PG8_WAIT_V(0);
    if (wr == 0) PG8_BAR;
    PG8_BAR;
    if constexpr (Epi::AFTER_DRAIN) { E.fused(acc, cur, wr, wc, fr, fq, lds, wid, lane); S.done(cur); }
    PG8_STAMP();
    if (STAMP && wid == 0) { stamps[lane] = lane < nts ? (((unsigned long long)(unsigned)ts_hi << 32) | (unsigned)ts_lo) : 0ull;
        if (lane == 62) stamps[62] = rt_entry; if (lane == 63) stamps[63] = (unsigned long long)wall_clock64(); }
#undef PG8_STAMP
#undef PG8_SA
#undef PG8_SB
#undef PG8_STAGE
#undef PG8_LDA
#undef PG8_LDB
#undef PG8_MMA
#undef PG8_WAIT_V
#undef PG8_WAIT_L
#undef PG8_BAR
#undef PG8_SCHED
}
}
namespace pg8 {
struct EpiIn {
    static constexpr bool PERM = true, AFTER_DRAIN = false;
    bf16_t* G1; bf16_t* G2;
    __device__ __forceinline__ void operator()(const f32x4 (&acc)[2][2][4][2], const Unit& u, int wr, int wc, int fr, int fq) const {
        const int row0 = u.pm * BM + wr * 64 + fr;
        bf16_t* base; int ldc, colt;
        if (u.pn < 9) { base = G1; ldc = 2304; colt = u.pn * 256; } else { base = G2; ldc = 512; colt = (u.pn - 9) * 256; }
        const int col0 = colt + wc * 32 + 8 * fq;
#pragma unroll
        for (int ai = 0; ai < 2; ++ai)
#pragma unroll
            for (int m = 0; m < 4; ++m) { bf16_t* rowp = base + (size_t)(row0 + ai * HALF + m * 16) * ldc + col0;
#pragma unroll
                for (int bj = 0; bj < 2; ++bj) { const f32x4 v0 = acc[ai][bj][m][0], v1 = acc[ai][bj][m][1];
                    u32x4 w; w.x = cvt_pk_bf16(v0[0], v0[1]); w.y = cvt_pk_bf16(v0[2], v0[3]); w.z = cvt_pk_bf16(v1[0], v1[1]); w.w = cvt_pk_bf16(v1[2], v1[3]);
                    *(u32x4*)(rowp + bj * HALF) = w; } }
    }
};
struct EpiOut {
    static constexpr bool PERM = true, AFTER_DRAIN = false;
    const float* xp; const float* xs; float* out; const float* mod; int layer;
    const float* stats; const float* lng; const float* lnb;
    __device__ __forceinline__ void operator()(const f32x4 (&acc)[2][2][4][2], const Unit& u, int wr, int wc, int fr, int fq) const {
        const int row0 = u.pm * BM + wr * 64 + fr, col0 = u.pn * BM + wc * 32 + 8 * fq;
        const int rt = u.pm * BM; const int modrow = rt < 8192 ? 0 : 1 + ((rt - 8192) >> 11);
        const float* gp = mod + (size_t)modrow * 3072 + 2048 + col0;
        f32x4 gv[2][2];
#pragma unroll
        for (int bj = 0; bj < 2; ++bj)
#pragma unroll
            for (int n = 0; n < 2; ++n) gv[bj][n] = *(const f32x4*)(gp + bj * HALF + n * 4);
        f32x4 lg[2][2], lb[2][2];
        if (layer) {
#pragma unroll
            for (int bj = 0; bj < 2; ++bj)
#pragma unroll
                for (int n = 0; n < 2; ++n) { lg[bj][n] = *(const f32x4*)(lng + col0 + bj * HALF + n * 4); lb[bj][n] = *(const f32x4*)(lnb + col0 + bj * HALF + n * 4); }
        }
        f32x4 xn[2][2]; float mean_n = 0.f, rstd_n = 1.f;
#define EO_LOAD(am_) do { const int row_ = row0 + ((am_) >> 2) * HALF + ((am_) & 3) * 16; \
            if (layer == 0) { const float* xr_ = (row_ < 8192 ? xp + (size_t)row_ * 1024 : xs + (size_t)(row_ - 8192) * 1024) + col0; \
                xn[0][0] = *(const f32x4*)(xr_); xn[0][1] = *(const f32x4*)(xr_ + 4); xn[1][0] = *(const f32x4*)(xr_ + HALF); xn[1][1] = *(const f32x4*)(xr_ + HALF + 4); } \
            else { const bf16_t* zr_ = (const bf16_t*)out + (size_t)row_ * 2048 + col0; const u32x4 z0_ = *(const u32x4*)zr_, z1_ = *(const u32x4*)(zr_ + HALF); \
                xn[0][0] = (f32x4){__uint_as_float(z0_.x << 16), __uint_as_float(z0_.x & 0xffff0000u), __uint_as_float(z0_.y << 16), __uint_as_float(z0_.y & 0xffff0000u)}; \
                xn[0][1] = (f32x4){__uint_as_float(z0_.z << 16), __uint_as_float(z0_.z & 0xffff0000u), __uint_as_float(z0_.w << 16), __uint_as_float(z0_.w & 0xffff0000u)}; \
                xn[1][0] = (f32x4){__uint_as_float(z1_.x << 16), __uint_as_float(z1_.x & 0xffff0000u), __uint_as_float(z1_.y << 16), __uint_as_float(z1_.y & 0xffff0000u)}; \
                xn[1][1] = (f32x4){__uint_as_float(z1_.z << 16), __uint_as_float(z1_.z & 0xffff0000u), __uint_as_float(z1_.w << 16), __uint_as_float(z1_.w & 0xffff0000u)}; \
                mean_n = stats[(size_t)row_ * 2]; rstd_n = stats[(size_t)row_ * 2 + 1]; } } while (0)
        EO_LOAD(0);
#pragma unroll
        for (int am = 0; am < 8; ++am) { const int ai = am >> 2, m = am & 3, row = row0 + ai * HALF + m * 16;
            const f32x4 xc[2][2] = {{xn[0][0], xn[0][1]}, {xn[1][0], xn[1][1]}}; const float mean = mean_n, rstd = rstd_n;
            if (am + 1 < 8) EO_LOAD(am + 1);
            bf16_t* orow = (bf16_t*)out + (size_t)row * 2048 + col0;
#pragma unroll
            for (int bj = 0; bj < 2; ++bj) { f32x4 z[2];
#pragma unroll
                for (int n = 0; n < 2; ++n) { f32x4 x = xc[bj][n];
                    if (layer) x = (x - mean) * rstd * lg[bj][n] + lb[bj][n];
                    z[n] = x * 1.4142135623730951f + gv[bj][n] * acc[ai][bj][m][n]; }
                u32x4 w; w.x = cvt_pk_bf16(z[0][0], z[0][1]); w.y = cvt_pk_bf16(z[0][2], z[0][3]); w.z = cvt_pk_bf16(z[1][0], z[1][1]); w.w = cvt_pk_bf16(z[1][2], z[1][3]);
                *(u32x4*)(orow + bj * HALF) = w; } }
#undef EO_LOAD
    }
};
}

__device__ __forceinline__ void phase_a1_pg8(ArgsP a, LAS unsigned char* lds, int layer) {
    pg8::Gemm g{(const bf16*)(a->ws + WS_U), (const bf16*)(a->ws + WS_WIN) + (size_t)layer * NIN * 1024, T, NIN, 1024, 1024, 1024};
    pg8::StaticOrder S; S.init(T, NIN, grid_(), bid_());
    pg8::EpiIn E{(bf16*)(a->ws + WS_G1), (bf16*)(a->ws + WS_G2)};
    pg8::gemm_phase<pg8::EpiIn, pg8::StaticOrder, false>(lds, g, S, E, nullptr);
}
__device__ __forceinline__ void phase_c2_pg8(ArgsP a, LAS unsigned char* lds, int layer) {
    pg8::Gemm g{(const bf16*)(a->ws + WS_YMIX), (const bf16*)(a->ws + WS_WOUT) + (size_t)layer * 1024 * 1024, T, 1024, 1024, 1024, 1024};
    pg8::StaticOrder S; S.init(T, 1024, grid_(), bid_());
    pg8::EpiOut E{a->in[I_XP], a->in[I_XS], a->out, (const float*)(a->ws + WS_MOD) + (size_t)layer * 9 * 3072, layer, (const float*)(a->ws + WS_STATS), a->in[I_LNG], a->in[I_LNB]};
    pg8::gemm_phase<pg8::EpiOut, pg8::StaticOrder, false>(lds, g, S, E, nullptr);
}

__device__ __forceinline__ void phase_a2a(ArgsP a, int layer) {
    const int tid = tid_(), lane = tid & 63, wave = tid >> 6, G = grid_();
    bf16* G2 = (bf16*)(a->ws + WS_G2); bf16* KR = (bf16*)(a->ws + WS_KR); bf16* CK = (bf16*)(a->ws + WS_HF);
    const float* ROPE = (const float*)(a->ws + WS_ROPE);
    f32x4 nw0 = {0.f, 0.f, 0.f, 0.f}, nw1 = {0.f, 0.f, 0.f, 0.f};
    if (lane < 32) { nw0 = *(const f32x4*)(a->in[I_QNORM] + layer * 256 + lane * 8); nw1 = *(const f32x4*)(a->in[I_QNORM] + layer * 256 + lane * 8 + 4); }
    else if (lane < 48) { nw0 = *(const f32x4*)(a->in[I_KVNORM] + layer * 128 + (lane - 32) * 8); nw1 = *(const f32x4*)(a->in[I_KVNORM] + layer * 128 + (lane - 32) * 8 + 4); }
    struct Raw { v4u w; f32x4 c0, c1; };
    Raw ra, rb;
    auto load = [&](Raw& r, int nn) __attribute__((always_inline)) {
        r.w = *(const v4u*)(G2 + (size_t)nn * G2W + lane * 8);
        const Tok t2 = tok_of(nn);
        if (lane >= 48 && lane < 52 && t2.lat) { const int d0 = (lane - 48) * 8; r.c0 = *(const f32x4*)(ROPE + ((size_t)t2.t * 16 + (d0 >> 1)) * 2); r.c1 = *(const f32x4*)(ROPE + ((size_t)t2.t * 16 + (d0 >> 1) + 2) * 2); }
    };
    const int stride = G * 8, n0 = bid_() * 8 + wave;
    ra.w = (v4u){0u, 0u, 0u, 0u}; rb.w = (v4u){0u, 0u, 0u, 0u}; ra.c0 = ra.c1 = rb.c0 = rb.c1 = (f32x4){0.f, 0.f, 0.f, 0.f};
    if (n0 < T) load(ra, n0);
    if (n0 + stride < T) load(rb, n0 + stride);
    auto row = [&](int n, Raw& r) __attribute__((always_inline)) {
        const Tok tk = tok_of(n);
        const v4u w = r.w;
        float x[8] = {bflo(w.x), bfhi(w.x), bflo(w.y), bfhi(w.y), bflo(w.z), bfhi(w.z), bflo(w.w), bfhi(w.w)};
        if (lane >= 48 && lane < 52) {
            const int d0 = (lane - 48) * 8;
            if (!tk.lat) { float* op = a->out + O_KR + ((size_t)(tk.b * 2 + layer) * 256 + tk.t) * 32 + d0;
                *(f32x4*)op = (f32x4){x[0], x[1], x[2], x[3]}; *(f32x4*)(op + 4) = (f32x4){x[4], x[5], x[6], x[7]};
                *(v4u*)(KR + (size_t)tk.kidx * 32 + d0) = w; }
            else { const f32x4 c0 = r.c0, c1 = r.c1;
                const float y0 = x[0] * c0.x - x[1] * c0.y, y1 = x[0] * c0.y + x[1] * c0.x, y2 = x[2] * c0.z - x[3] * c0.w, y3 = x[2] * c0.w + x[3] * c0.z;
                const float y4 = x[4] * c1.x - x[5] * c1.y, y5 = x[4] * c1.y + x[5] * c1.x, y6 = x[6] * c1.z - x[7] * c1.w, y7 = x[6] * c1.w + x[7] * c1.z;
                *(v4u*)(KR + (size_t)tk.kidx * 32 + d0) = (v4u){cvtpk(y0, y1), cvtpk(y2, y3), cvtpk(y4, y5), cvtpk(y6, y7)}; }
        }
#pragma unroll
        for (int i = 0; i < 8; ++i) asm volatile("" : "+v"(x[i]));
        if (n + 2 * stride < T) load(r, n + 2 * stride);
        const float ss = (x[0] * x[0] + x[1] * x[1]) + (x[2] * x[2] + x[3] * x[3]) + (x[4] * x[4] + x[5] * x[5]) + (x[6] * x[6] + x[7] * x[7]);
        const float sq = wave_sum(lane < 32 ? ss : 0.f), sk = wave_sum((lane >= 32 && lane < 48) ? ss : 0.f);
        const float rs = lane < 32 ? rsqrt_(sq * (1.f / 256.f) + 1e-6f) : rsqrt_(sk * (1.f / 128.f) + 1e-6f);
        if (lane < 48) {
            const float y0 = x[0] * rs * nw0.x, y1 = x[1] * rs * nw0.y, y2 = x[2] * rs * nw0.z, y3 = x[3] * rs * nw0.w, y4 = x[4] * rs * nw1.x, y5 = x[5] * rs * nw1.y, y6 = x[6] * rs * nw1.z, y7 = x[7] * rs * nw1.w;
            *(v4u*)(G2 + (size_t)n * G2W + lane * 8) = (v4u){cvtpk(y0, y1), cvtpk(y2, y3), cvtpk(y4, y5), cvtpk(y6, y7)};
            if (lane >= 32 && !tk.lat) { float* op = a->out + O_CKV + ((size_t)(tk.b * 2 + layer) * 256 + tk.t) * 128 + (lane - 32) * 8;
                *(f32x4*)op = (f32x4){y0, y1, y2, y3}; *(f32x4*)(op + 4) = (f32x4){y4, y5, y6, y7}; }
        }
    };
    for (int n = n0; n < T; n += 2 * stride) { row(n, ra); if (n + stride < T) row(n + stride, rb); }
    for (int r = bid_() * 8 + wave; r < 2048; r += G * 8) {
        const int b = r >> 8, j = r & 255; const size_t src = (size_t)(b * 2 + layer) * 256 + j;
        if (lane < 16) { const f32x4 v0 = *(const f32x4*)(a->in[I_CCKV] + src * 128 + lane * 8), v1 = *(const f32x4*)(a->in[I_CCKV] + src * 128 + lane * 8 + 4);
            *(v4u*)(CK + (size_t)r * 512 + lane * 8) = (v4u){cvtpk(v0.x, v0.y), cvtpk(v0.z, v0.w), cvtpk(v1.x, v1.y), cvtpk(v1.z, v1.w)}; }
        else if (lane < 32) *(v4u*)(CK + (size_t)r * 512 + lane * 8) = (v4u){0u, 0u, 0u, 0u};
        else if (lane < 36) { const f32x4 v0 = *(const f32x4*)(a->in[I_CKR] + src * 32 + (lane - 32) * 8), v1 = *(const f32x4*)(a->in[I_CKR] + src * 32 + (lane - 32) * 8 + 4);
            *(v4u*)(KR + (size_t)(T_CTX + b * LK_LAT + j) * 32 + (lane - 32) * 8) = (v4u){cvtpk(v0.x, v0.y), cvtpk(v0.z, v0.w), cvtpk(v1.x, v1.y), cvtpk(v1.z, v1.w)}; }
    }
}
namespace pg8 {
struct A2Order {
    const char* ws; unsigned oq, okv; int G, c;
    __device__ __forceinline__ bool next(int i, Unit& u) const {
        const int L = i * G + c; if (L >= 704) return false;
        if (L < 288) { u.gid = 0; u.pm = L / 3; u.pn = L % 3; } else if (L < 672) { u.gid = 1; u.pm = (L - 288) >> 2; u.pn = (L - 288) & 3; } else { u.gid = 2; u.pm = (L - 672) >> 2; u.pn = (L - 672) & 3; }
        return true;
    }
    __device__ __forceinline__ const char* abase(const Gemm&, const Unit& u) const { const unsigned off = u.gid == 0 ? (unsigned)WS_G2 : (u.gid == 1 ? (unsigned)WS_G2 + 512u : (unsigned)WS_HF); return ws + off + (size_t)u.pm * 256 * 512 * 2; }
    __device__ __forceinline__ const char* bbase(const Gemm&, const Unit& u) const { const unsigned off = u.gid == 0 ? oq : okv; return ws + off + (size_t)u.pn * 256 * 256 * 2; }
    __device__ __forceinline__ void a_ready(const Unit&) const {}
    __device__ __forceinline__ void done(const Unit&) const {}
};
struct EpiA2 {
    static constexpr bool PERM = true, AFTER_DRAIN = false;
    bf16_t* Q; bf16_t* KN; bf16_t* VR; const float* rope;
    __device__ __forceinline__ void operator()(const f32x4 (&acc)[2][2][4][2], const Unit& u, int wr, int wc, int fr, int fq) const {
        const int row0 = u.pm * BM + wr * 64 + fr;
        if (u.gid == 0) {
            const int fb = u.pn * 256 + wc * 32 + 8 * fq;
#pragma unroll
            for (int ai = 0; ai < 2; ++ai)
#pragma unroll
                for (int m = 0; m < 4; ++m) { const int row = row0 + ai * HALF + m * 16;
                    const float* rp = rope + (unsigned)(((row - 8192) & 2047) * 32);
#pragma unroll
                    for (int bj = 0; bj < 2; ++bj) {
                        f32x4 v0 = acc[ai][bj][m][0], v1 = acc[ai][bj][m][1];
                        const int f0 = fb + bj * HALF, d = f0 % 96;
                        if (row >= 8192 && d >= 64) { const f32x4 c0 = *(const f32x4*)(rp + (d - 64)), c1 = *(const f32x4*)(rp + (d - 64) + 4);
                            const f32x4 a0 = v0, a1 = v1;
                            v0[0] = a0[0] * c0[0] - a0[1] * c0[1]; v0[1] = a0[0] * c0[1] + a0[1] * c0[0]; v0[2] = a0[2] * c0[2] - a0[3] * c0[3]; v0[3] = a0[2] * c0[3] + a0[3] * c0[2];
                            v1[0] = a1[0] * c1[0] - a1[1] * c1[1]; v1[1] = a1[0] * c1[1] + a1[1] * c1[0]; v1[2] = a1[2] * c1[2] - a1[3] * c1[3]; v1[3] = a1[2] * c1[3] + a1[3] * c1[2]; }
                        u32x4 w; w.x = cvt_pk_bf16(v0[0], v0[1]); w.y = cvt_pk_bf16(v0[2], v0[3]); w.z = cvt_pk_bf16(v1[0], v1[1]); w.w = cvt_pk_bf16(v1[2], v1[3]);
                        *(u32x4*)(Q + (unsigned)(row * 768 + f0)) = w; } }
        } else {
            const int x = wc * 32 + 8 * fq;
            bf16_t* base = (wc < 2 ? KN : VR);
            const unsigned xo = (unsigned)(x & 63);
#pragma unroll
            for (int ai = 0; ai < 2; ++ai)
#pragma unroll
                for (int m = 0; m < 4; ++m) { const int row = row0 + ai * HALF + m * 16;
                    int kidx;
                    if (u.gid == 2) kidx = 8192 + (row >> 8) * 2304 + (row & 255);
                    else if (row < 8192) kidx = row;
                    else { const int mrow = row - 8192; kidx = 8192 + (mrow >> 11) * 2304 + 256 + (mrow & 2047); }
#pragma unroll
                    for (int bj = 0; bj < 2; ++bj) { const f32x4 v0 = acc[ai][bj][m][0], v1 = acc[ai][bj][m][1];
                        u32x4 w; w.x = cvt_pk_bf16(v0[0], v0[1]); w.y = cvt_pk_bf16(v0[2], v0[3]); w.z = cvt_pk_bf16(v1[0], v1[1]); w.w = cvt_pk_bf16(v1[2], v1[3]);
                        *(u32x4*)(base + (unsigned)(kidx * 512 + (u.pn * 2 + bj) * 64) + xo) = w; } }
        }
    }
};
}
__device__ __forceinline__ void phase_a2b(ArgsP a, LAS unsigned char* lds, int layer) {
    int kk = 256; asm volatile("" : "+s"(kk));
    pg8::Gemm g{nullptr, nullptr, T, 1024, kk, 512, 256};
    pg8::A2Order S{(const char*)a->ws, (unsigned)(WS_WUQ + (size_t)layer * 768 * 256 * 2), (unsigned)(WS_WUKV + (size_t)layer * 1024 * 256 * 2), grid_(), bid_()};
    pg8::EpiA2 E{(bf16*)(a->ws + WS_Q), (bf16*)(a->ws + WS_KN), (bf16*)(a->ws + WS_VT), (const float*)(a->ws + WS_ROPE)};
    pg8::gemm_phase<pg8::EpiA2, pg8::A2Order, false>(lds, g, S, E, nullptr);
}


__device__ __forceinline__ void phase_c1(ArgsP a, int layer) {
    const int tid = tid_(), lane = tid & 63, wave = tid >> 6, G = grid_();
    const bf16* G1 = (const bf16*)(a->ws + WS_G1); const bf16* YS = (const bf16*)(a->ws + WS_G2); const bf16* Q = (const bf16*)(a->ws + WS_Q); const bf16* HF = (const bf16*)(a->ws + WS_HF);
    bf16* Y = (bf16*)(a->ws + WS_YMIX);
    const int ch = lane * 4;
    const f32x4 rk = *(const f32x4*)(a->in[I_RK] + layer * 256 + ch), lg = *(const f32x4*)(a->in[I_LNXG] + layer * 256 + ch), lb = *(const f32x4*)(a->in[I_LNXB] + layer * 256 + ch);
    v2u p_y0, p_y1, p_r, p_k, p_v, p_g, p_h, p_hb, p_gl; v4u p_q;
#define C1_LOAD(nn) do { const bf16* g_ = G1 + (size_t)(nn) * G1W; p_y0 = *(const v2u*)(YS + (size_t)(nn) * 256 + ch); p_y1 = *(const v2u*)(YS + ((size_t)T + (nn)) * 256 + ch); \
        p_r = *(const v2u*)(g_ + C_R + ch); p_k = *(const v2u*)(g_ + C_K + ch); p_v = *(const v2u*)(g_ + C_V + ch); p_g = *(const v2u*)(g_ + C_G + ch); \
        p_q = *(const v4u*)(Q + (size_t)(nn) * 768 + (lane >> 3) * 96 + (lane & 7) * 8); p_h = *(const v2u*)(HF + (size_t)(nn) * 256 + ch); \
        p_hb = *(const v2u*)((const unsigned char*)a->out + (size_t)(nn) * 4096 + 2048 + ch * 2); p_gl = *(const v2u*)(g_ + C_GL + ch); } while (0)
    { const int n0 = bid_() * 8 + wave; if (n0 < T) C1_LOAD(n0); }
    for (int n = bid_() * 8 + wave; n < T; n += G * 8) {
        const v2u y0 = p_y0, y1 = p_y1, rv = p_r, kv = p_k, vv = p_v, gv = p_g, hf = p_h, hb = p_hb, gl = p_gl; const v4u qq = p_q;
        if (n + G * 8 < T) C1_LOAD(n + G * 8);
        float y[4] = {bflo(y0.x) + bflo(y1.x), bfhi(y0.x) + bfhi(y1.x), bflo(y0.y) + bflo(y1.y), bfhi(y0.y) + bfhi(y1.y)};
        float s = (y[0] + y[1]) + (y[2] + y[3]);
        float bon = bflo(rv.x) * bflo(kv.x) * rk.x + bfhi(rv.x) * bfhi(kv.x) * rk.y + bflo(rv.y) * bflo(kv.y) * rk.z + bfhi(rv.y) * bfhi(kv.y) * rk.w;
#pragma unroll
        for (int o = 1; o < 16; o <<= 1) { s += __shfl_xor(s, o); bon += __shfl_xor(bon, o); }
        const float mu = s * (1.f / 64.f);
        float s2 = (y[0] - mu) * (y[0] - mu) + (y[1] - mu) * (y[1] - mu) + (y[2] - mu) * (y[2] - mu) + (y[3] - mu) * (y[3] - mu);
#pragma unroll
        for (int o = 1; o < 16; o <<= 1) s2 += __shfl_xor(s2, o);
        const float rstd = rsqrt_(s2 * (1.f / 64.f) + GN_EPS);
        const float o0 = ((y[0] - mu) * rstd * lg.x + lb.x + bon * bflo(vv.x)) * siluf_(bflo(gv.x));
        const float o1 = ((y[1] - mu) * rstd * lg.y + lb.y + bon * bfhi(vv.x)) * siluf_(bfhi(gv.x));
        const float o2 = ((y[2] - mu) * rstd * lg.z + lb.z + bon * bflo(vv.y)) * siluf_(bflo(gv.y));
        const float o3 = ((y[3] - mu) * rstd * lg.w + lb.w + bon * bfhi(vv.y)) * siluf_(bfhi(gv.y));
        v2u ov; ov.x = pk2(o0, o1); ov.y = pk2(o2, o3);
        bf16* yr = Y + (size_t)n * 1024;
        *(v2u*)(yr + ch) = ov;
        *(v4u*)(yr + 256 + (lane >> 3) * 64 + (lane & 7) * 8) = qq;
        *(v2u*)(yr + 768 + ch) = (v2u){pk2((bflo(hf.x) + bflo(hb.x)) * siluf_(bflo(gl.x)), (bfhi(hf.x) + bfhi(hb.x)) * siluf_(bfhi(gl.x))), pk2((bflo(hf.y) + bflo(hb.y)) * siluf_(bflo(gl.y)), (bfhi(hf.y) + bfhi(hb.y)) * siluf_(bfhi(gl.y)))};
    }
#undef C1_LOAD
}
#define MFMA32(a, b, c) __builtin_amdgcn_mfma_f32_32x32x16_bf16((a), (b), (c), 0, 0, 0)
#define MFMA16(a, b, c) __builtin_amdgcn_mfma_f32_16x16x32_bf16((a), (b), (c), 0, 0, 0)
typedef short s16x4_t __attribute__((ext_vector_type(4)));

__device__ __forceinline__ float tanh_fast(float x) { return 1.f - 2.f * rcp_(1.f + exp_(2.f * x)); }

constexpr int ATT_KSTR = 208, ATT_VSTR = 136, ATT_VOFF = 64 * ATT_KSTR, ATT_STAGE = 64 * ATT_KSTR + 64 * ATT_VSTR;


constexpr int RW_W2T = 0, RW_A2T = 9216, RW_TH = 18432, RW_HA = 27648, RW_CH0 = 36864, RW_CHB = 20992, RW_YB = 120832;
constexpr int RC_KP = 0, RC_RP = 2304, RC_BP = 4608  , RC_KT = 6912, RC_VR = 9216  , RC_LK = 16896, RC_TM = 17536, RC_ARK = 18176, RC_NARB = 18816, RC_G15 = 19456, RC_LBF = 19712, RC_SSQ = 20736;
template <int MODE = 0> __device__ __forceinline__ void rwkv_unit_mfma(ArgsP a, LAS unsigned char* lds, int layer, int u) {
    const int tid = tid_(), lane = tid & 63, wave = tid >> 6, i16 = lane & 15, g = lane >> 4;
    const int lat = u < 64, uu = lat ? u : u - 64, b = uu >> 3, e = (uu >> 2) & 1, hh = uu & 3;
    const int L = lat ? L_LAT : L_CTX, tok0 = lat ? T_CTX + b * L_LAT : b * L_CTX;
    const bf16* G1 = (const bf16*)(a->ws + WS_G1);
    bf16* YS = (bf16*)(a->ws + WS_G2);
    __syncthreads();
    { const bf16* wsrc = (const bf16*)(a->ws + WS_LORA2) + ((size_t)((layer * 2 + e) * 2) * 256 + hh * 64) * 64; const int row = tid >> 3, c8 = (tid & 7) * 8;
      *(LAS v4u*)(lds + RW_W2T + row * 144 + c8 * 2) = *(const v4u*)(wsrc + row * 64 + c8);
      *(LAS v4u*)(lds + RW_A2T + row * 144 + c8 * 2) = *(const v4u*)(wsrc + 256 * 64 + row * 64 + c8); }
    const int st_tok = tid >> 3, st_c8 = (tid & 7) * 8;
#define RW_STAGE(sc) do { const int step_ = (sc) * 64 + st_tok, t_ = e ? L - 1 - step_ : step_; const bf16* gp_ = G1 + (size_t)(tok0 + t_) * G1W + C_LORA + e * 64 + st_c8; \
        const v4u hw_ = *(const v4u*)gp_, ha_ = *(const v4u*)(gp_ + 128); v4u th_; \
        th_.x = cvtpk(tanh_fast(bflo(hw_.x)), tanh_fast(bfhi(hw_.x))); th_.y = cvtpk(tanh_fast(bflo(hw_.y)), tanh_fast(bfhi(hw_.y))); th_.z = cvtpk(tanh_fast(bflo(hw_.z)), tanh_fast(bfhi(hw_.z))); th_.w = cvtpk(tanh_fast(bflo(hw_.w)), tanh_fast(bfhi(hw_.w))); \
        *(LAS v4u*)(lds + RW_TH + st_tok * 144 + st_c8 * 2) = th_; *(LAS v4u*)(lds + RW_HA + st_tok * 144 + st_c8 * 2) = ha_; } while (0)
    RW_STAGE(0);
    f32x4 ST[4];
    {
        const int v = 16 * (wave & 3) + i16;
#pragma unroll
        for (int kt = 0; kt < 4; ++kt) ST[kt] = lat ? *(const f32x4*)(a->in[I_SRW] + (((size_t)((b * 2 + layer) * 2 + e) * 4 + hh) * 64 + v) * 64 + 16 * kt + 4 * g) : (f32x4){0.f, 0.f, 0.f, 0.f};
    }
    const int pc = wave & 3, ph = wave >> 2;
    LAS unsigned char* CH = lds + RW_CH0 + pc * RW_CHB;
    f32x4 w0r[2], a0r[2], kwr[2], kar[2];
#pragma unroll
    for (int c2 = 0; c2 < 2; ++c2) { const int gch = hh * 64 + (2 * ph + c2) * 16 + 4 * g;
        w0r[c2] = *(const f32x4*)(a->in[I_W0] + (layer * 2 + e) * 256 + gch); a0r[c2] = *(const f32x4*)(a->in[I_A0] + (layer * 2 + e) * 256 + gch);
        kwr[c2] = *(const f32x4*)(a->in[I_KK] + layer * 256 + gch); kar[c2] = *(const f32x4*)(a->in[I_KA] + layer * 256 + gch); }
#pragma unroll
    for (int c2 = 0; c2 < 2; ++c2) asm volatile("" : "+v"(w0r[c2]), "+v"(a0r[c2]), "+v"(kwr[c2]), "+v"(kar[c2]));
#pragma unroll
    for (int kt = 0; kt < 4; ++kt) asm volatile("" : "+v"(ST[kt]));
    __syncthreads();
    const int nsc = L >> 6;
    v2u pk[2], pr[2], pv[2];
#define RW_PREFETCH(sc) do { const int ps_ = (sc) * 64 + pc * 16 + i16, pt_ = e ? L - 1 - ps_ : ps_; const bf16* gq_ = G1 + (size_t)(tok0 + pt_) * G1W + hh * 64 + (2 * ph) * 16 + 4 * g; \
        pk[0] = *(const v2u*)(gq_ + C_K); pk[1] = *(const v2u*)(gq_ + C_K + 16); pr[0] = *(const v2u*)(gq_ + C_R); pr[1] = *(const v2u*)(gq_ + C_R + 16); pv[0] = *(const v2u*)(gq_ + C_V); pv[1] = *(const v2u*)(gq_ + C_V + 16); } while (0)
    RW_PREFETCH(0);
    for (int sc = 0; sc < nsc; ++sc) {
        const v2u ck[2] = {pk[0], pk[1]}, cr[2] = {pr[0], pr[1]}, cv[2] = {pv[0], pv[1]};
        if (sc + 1 < nsc) RW_PREFETCH(sc + 1);
        float dec[8], av[8], kx[8], rx[8], kk[8];
        {
            f32x4 aw[2], aa[2];
#pragma unroll
            for (int c2 = 0; c2 < 2; ++c2) { aw[c2] = (f32x4){0.f, 0.f, 0.f, 0.f}; aa[c2] = (f32x4){0.f, 0.f, 0.f, 0.f}; }
#pragma unroll
            for (int ks = 0; ks < 2; ++ks) {
                const bf16x8 bth = *(const LAS bf16x8*)(lds + RW_TH + (pc * 16 + i16) * 144 + ks * 64 + g * 16), bha = *(const LAS bf16x8*)(lds + RW_HA + (pc * 16 + i16) * 144 + ks * 64 + g * 16);
#pragma unroll
                for (int c2 = 0; c2 < 2; ++c2) { const int row = (2 * ph + c2) * 16 + i16;
                    const bf16x8 w2f = *(const LAS bf16x8*)(lds + RW_W2T + row * 144 + ks * 64 + g * 16), a2f = *(const LAS bf16x8*)(lds + RW_A2T + row * 144 + ks * 64 + g * 16);
                    aw[c2] = MFMA16(w2f, bth, aw[c2]); aa[c2] = MFMA16(a2f, bha, aa[c2]); }
            }
            float ss = 0.f;
#pragma unroll
            for (int c2 = 0; c2 < 2; ++c2) {
                const f32x4 w0 = w0r[c2], a0 = a0r[c2], kw = kwr[c2];
                const v2u kv = ck[c2], rv = cr[c2];
                const float kq[4] = {bflo(kv.x), bfhi(kv.x), bflo(kv.y), bfhi(kv.y)}, rq[4] = {bflo(rv.x), bfhi(rv.x), bflo(rv.y), bfhi(rv.y)};
#pragma unroll
                for (int q = 0; q < 4; ++q) { const int o = c2 * 4 + q;
                    dec[o] = exp_(-0.6065306597126334f * sigmoidf_(aw[c2][q] + w0[q])); av[o] = sigmoidf_(aa[c2][q] + a0[q]);
                    kx[o] = kq[q]; rx[o] = rq[q]; kk[o] = kq[q] * kw[q]; ss += kk[o] * kk[o]; }
            }
            ss += __shfl_xor(ss, 16); ss += __shfl_xor(ss, 32);
            if (g == 0) *(LAS float*)(CH + RC_SSQ + (i16 * 2 + ph) * 4) = ss;
        }
        __syncthreads();
        {
            const float tot = *(const LAS float*)(CH + RC_SSQ + (i16 * 2) * 4) + *(const LAS float*)(CH + RC_SSQ + (i16 * 2 + 1) * 4);
            const float inrm = rcp_(fmaxf(sqrt_(tot), 1e-12f));
            float G8[8], Gx8[8];
#pragma unroll
            for (int o8 = 0; o8 < 8; ++o8) G8[o8] = dec[o8];
#pragma unroll
            for (int o8 = 0; o8 < 8; ++o8) G8[o8] *= dpp_f<0x111>(1.f, G8[o8]);
#pragma unroll
            for (int o8 = 0; o8 < 8; ++o8) G8[o8] *= dpp_f<0x112>(1.f, G8[o8]);
#pragma unroll
            for (int o8 = 0; o8 < 8; ++o8) G8[o8] *= dpp_f<0x114>(1.f, G8[o8]);
#pragma unroll
            for (int o8 = 0; o8 < 8; ++o8) G8[o8] *= dpp_f<0x118>(1.f, G8[o8]);
#pragma unroll
            for (int o8 = 0; o8 < 8; ++o8) Gx8[o8] = dpp_f<0x111>(1.f, G8[o8]);
#pragma unroll
            for (int c2 = 0; c2 < 2; ++c2) { const int ch = (2 * ph + c2) * 16 + 4 * g;
                const f32x4 ka = kar[c2];
                float kp[4], bp[4], kt[4], rp[4];
#pragma unroll
                for (int q = 0; q < 4; ++q) { const int o = c2 * 4 + q;
                    const float G = G8[o], Gex = Gx8[o];
                    const float kkn = kk[o] * inrm, iG = rcp_(G);
                    kp[q] = Gex * kkn; bp[q] = kkn * av[o] * iG; kt[q] = kx[o] * (1.f + (av[o] - 1.f) * ka[q]) * iG; rp[q] = G * rx[o];
                    if (i16 == 15) *(LAS float*)(CH + RC_G15 + (ch + q) * 4) = G;
                }
                *(LAS v2u*)(CH + RC_KP + i16 * 144 + ch * 2) = (v2u){cvtpk(kp[0], kp[1]), cvtpk(kp[2], kp[3])};
                *(LAS v2u*)(CH + RC_BP + i16 * 144 + ch * 2) = (v2u){cvtpk(-bp[0], -bp[1]), cvtpk(-bp[2], -bp[3])};
                *(LAS v2u*)(CH + RC_KT + i16 * 144 + ch * 2) = (v2u){cvtpk(kt[0], kt[1]), cvtpk(kt[2], kt[3])};
                *(LAS v2u*)(CH + RC_RP + i16 * 144 + ch * 2) = (v2u){cvtpk(rp[0], rp[1]), cvtpk(rp[2], rp[3])};
                *(LAS v2u*)(CH + RC_VR + i16 * 144 + ch * 2) = cv[c2];
            }
        }
        __syncthreads();
        {
            f32x4 d0 = (f32x4){0.f, 0.f, 0.f, 0.f}, d1 = (f32x4){0.f, 0.f, 0.f, 0.f};
            const int xoff = ph ? RC_KP : RC_RP, y0off = ph ? RC_BP : RC_KT, y1off = ph ? RC_KT : RC_BP;
#pragma unroll
            for (int ks = 0; ks < 2; ++ks) {
                const bf16x8 xf = *(const LAS bf16x8*)(CH + xoff + i16 * 144 + ks * 64 + g * 16);
                const bf16x8 y0 = *(const LAS bf16x8*)(CH + y0off + i16 * 144 + ks * 64 + g * 16), y1 = *(const LAS bf16x8*)(CH + y1off + i16 * 144 + ks * 64 + g * 16);
                d0 = MFMA16(xf, y0, d0); d1 = MFMA16(xf, y1, d1);
            }
#pragma unroll
            for (int q = 0; q < 4; ++q) { const int i = 4 * g + q, j = i16;
                if (ph) { *(LAS float*)(CH + RC_LBF + (i * 16 + j) * 4) = (j < i) ? -d0[q] : 0.f; *(LAS bf16*)(CH + RC_LK + i * 40 + j * 2) = (bf16)(cvtpk((j < i) ? d1[q] : 0.f, 0.f) & 0xffffu); }
                else { const unsigned pk_ = cvtpk((j <= i) ? d0[q] : 0.f, (j <= i) ? d1[q] : 0.f); *(LAS bf16*)(CH + RC_ARK + i * 40 + j * 2) = (bf16)(pk_ & 0xffffu); *(LAS bf16*)(CH + RC_NARB + i * 40 + j * 2) = (bf16)(pk_ >> 16); }
            }
            if (ph && !(MODE & 2)) {
                float x[16];
#pragma unroll
                for (int i = 0; i < 16; ++i) { float s = (i == i16) ? 1.f : 0.f;
#pragma unroll
                    for (int j4 = 0; j4 < (i + 3) / 4; ++j4) { const f32x4 lr = *(const LAS f32x4*)(CH + RC_LBF + (i * 16 + j4 * 4) * 4);
#pragma unroll
                        for (int jj = 0; jj < 4; ++jj) { const int j = j4 * 4 + jj; if (j < i) s -= lr[jj] * x[j]; } }
                    x[i] = s; }
                if (g == 0) {
#pragma unroll
                    for (int i = 0; i < 16; i += 2) { const unsigned pk_ = cvtpk(x[i], x[i + 1]); *(LAS bf16*)(CH + RC_TM + i * 40 + i16 * 2) = (bf16)(pk_ & 0xffffu); *(LAS bf16*)(CH + RC_TM + (i + 1) * 40 + i16 * 2) = (bf16)(pk_ >> 16); } }
            }
        }
        __syncthreads();
        if (wave < 4) {
            const int vt = wave;
#pragma unroll 1
            for (int c = 0; c < ((MODE & 1) ? 0 : 4); ++c) {
                const LAS unsigned char* C = lds + RW_CH0 + c * RW_CHB;
                v4u sb01, sb23;
                sb01.x = cvtpk(ST[0][0], ST[0][1]); sb01.y = cvtpk(ST[0][2], ST[0][3]); sb01.z = cvtpk(ST[1][0], ST[1][1]); sb01.w = cvtpk(ST[1][2], ST[1][3]);
                sb23.x = cvtpk(ST[2][0], ST[2][1]); sb23.y = cvtpk(ST[2][2], ST[2][3]); sb23.z = cvtpk(ST[3][0], ST[3][1]); sb23.w = cvtpk(ST[3][2], ST[3][3]);
                const bf16x8 s01 = __builtin_bit_cast(bf16x8, sb01), s23 = __builtin_bit_cast(bf16x8, sb23);
                const v2u kp0a = *(const LAS v2u*)(C + RC_KP + i16 * 144 + (4 * g) * 2), kp0b = *(const LAS v2u*)(C + RC_KP + i16 * 144 + (16 + 4 * g) * 2);
                const v2u kp1a = *(const LAS v2u*)(C + RC_KP + i16 * 144 + (32 + 4 * g) * 2), kp1b = *(const LAS v2u*)(C + RC_KP + i16 * 144 + (48 + 4 * g) * 2);
                const v2u rp0a = *(const LAS v2u*)(C + RC_RP + i16 * 144 + (4 * g) * 2), rp0b = *(const LAS v2u*)(C + RC_RP + i16 * 144 + (16 + 4 * g) * 2);
                const v2u rp1a = *(const LAS v2u*)(C + RC_RP + i16 * 144 + (32 + 4 * g) * 2), rp1b = *(const LAS v2u*)(C + RC_RP + i16 * 144 + (48 + 4 * g) * 2);
                const v2u lk = *(const LAS v2u*)(C + RC_LK + i16 * 40 + g * 8), tm = *(const LAS v2u*)(C + RC_TM + i16 * 40 + g * 8);
                const v2u ark = *(const LAS v2u*)(C + RC_ARK + i16 * 40 + g * 8), narb = *(const LAS v2u*)(C + RC_NARB + i16 * 40 + g * 8);
                const int trq = (i16 >> 2) & 3, trp = i16 & 3;
                const v2u vf = __builtin_bit_cast(v2u, __builtin_amdgcn_ds_read_tr16_b64_v4i16((LAS s16x4_t*)(C + RC_VR + (4 * g + trq) * 144 + (16 * vt + 4 * trp) * 2)));
                const v4u z4 = {0u, 0u, 0u, 0u};
                f32x4 rhs = (f32x4){0.f, 0.f, 0.f, 0.f};
                rhs = MFMA16(__builtin_bit_cast(bf16x8, ((v4u){kp0a.x, kp0a.y, kp0b.x, kp0b.y})), s01, rhs);
                rhs = MFMA16(__builtin_bit_cast(bf16x8, ((v4u){kp1a.x, kp1a.y, kp1b.x, kp1b.y})), s23, rhs);
                rhs = MFMA16(__builtin_bit_cast(bf16x8, ((v4u){lk.x, lk.y, 0u, 0u})), __builtin_bit_cast(bf16x8, ((v4u){vf.x, vf.y, 0u, 0u})), rhs);
                f32x4 z = MFMA16(__builtin_bit_cast(bf16x8, ((v4u){tm.x, tm.y, 0u, 0u})), __builtin_bit_cast(bf16x8, ((v4u){cvtpk(rhs[0], rhs[1]), cvtpk(rhs[2], rhs[3]), 0u, 0u})), ((f32x4){0.f, 0.f, 0.f, 0.f}));
                const bf16x8 vz = __builtin_bit_cast(bf16x8, ((v4u){vf.x, vf.y, cvtpk(z[0], z[1]), cvtpk(z[2], z[3])}));
                f32x4 y = (f32x4){0.f, 0.f, 0.f, 0.f};
                y = MFMA16(__builtin_bit_cast(bf16x8, ((v4u){rp0a.x, rp0a.y, rp0b.x, rp0b.y})), s01, y);
                y = MFMA16(__builtin_bit_cast(bf16x8, ((v4u){rp1a.x, rp1a.y, rp1b.x, rp1b.y})), s23, y);
                y = MFMA16(__builtin_bit_cast(bf16x8, ((v4u){ark.x, ark.y, narb.x, narb.y})), vz, y);
#pragma unroll
                for (int kt = 0; kt < 4; ++kt) {
                    const v2u ktf = __builtin_bit_cast(v2u, __builtin_amdgcn_ds_read_tr16_b64_v4i16((LAS s16x4_t*)(C + RC_KT + (4 * g + trq) * 144 + (16 * kt + 4 * trp) * 2)));
                    const v2u nbf = __builtin_bit_cast(v2u, __builtin_amdgcn_ds_read_tr16_b64_v4i16((LAS s16x4_t*)(C + RC_BP + (4 * g + trq) * 144 + (16 * kt + 4 * trp) * 2)));
                    const f32x4 g15 = *(const LAS f32x4*)(C + RC_G15 + (16 * kt + 4 * g) * 4);
                    ST[kt] = MFMA16(__builtin_bit_cast(bf16x8, ((v4u){ktf.x, ktf.y, nbf.x, nbf.y})), vz, ST[kt]);
                    ST[kt] = ST[kt] * g15;
                }
                { const unsigned y01 = cvtpk(y[0], y[1]), y23 = cvtpk(y[2], y[3]); LAS unsigned char* yb = lds + RW_YB + (c * 16 + 4 * g) * 144 + (16 * vt + i16) * 2;
                  *(LAS bf16*)(yb) = (bf16)(y01 & 0xffffu); *(LAS bf16*)(yb + 144) = (bf16)(y01 >> 16); *(LAS bf16*)(yb + 288) = (bf16)(y23 & 0xffffu); *(LAS bf16*)(yb + 432) = (bf16)(y23 >> 16); }
                (void)z4;
            }
        } else if (sc + 1 < nsc) {
            const int r0 = (tid - 256) >> 3;
#pragma unroll
            for (int hrow = 0; hrow < 2; ++hrow) { const int tokr = r0 + 32 * hrow, step_ = (sc + 1) * 64 + tokr, t_ = e ? L - 1 - step_ : step_;
                const bf16* gp_ = G1 + (size_t)(tok0 + t_) * G1W + C_LORA + e * 64 + st_c8;
                const v4u hw_ = *(const v4u*)gp_, ha_ = *(const v4u*)(gp_ + 128); v4u th_;
                th_.x = cvtpk(tanh_fast(bflo(hw_.x)), tanh_fast(bfhi(hw_.x))); th_.y = cvtpk(tanh_fast(bflo(hw_.y)), tanh_fast(bfhi(hw_.y))); th_.z = cvtpk(tanh_fast(bflo(hw_.z)), tanh_fast(bfhi(hw_.z))); th_.w = cvtpk(tanh_fast(bflo(hw_.w)), tanh_fast(bfhi(hw_.w)));
                *(LAS v4u*)(lds + RW_TH + tokr * 144 + st_c8 * 2) = th_; *(LAS v4u*)(lds + RW_HA + tokr * 144 + st_c8 * 2) = ha_; }
        }
        __syncthreads();
        {
            const int row = tid >> 3, part = tid & 7, step = sc * 64 + row, t = e ? L - 1 - step : step;
            *(v4u*)(YS + ((size_t)e * T + tok0 + t) * 256 + hh * 64 + part * 8) = *(const LAS v4u*)(lds + RW_YB + row * 144 + part * 16);
        }
    }
#undef RW_STAGE
#undef RW_PREFETCH
    if (!lat && wave < 4) {
        const int v = 16 * wave + i16;
#pragma unroll
        for (int kt = 0; kt < 4; ++kt) *(f32x4*)(a->out + O_RW + (((size_t)((b * 2 + layer) * 2 + e) * 4 + hh) * 64 + v) * 64 + 16 * kt + 4 * g) = ST[kt];
    }
}


constexpr int LQ_NQ = 32;
constexpr int LQ_WAT = 0, LQ_S0 = 2 * LQ_NQ * 144;
constexpr int LS_XCB = 0, LS_XCQ = 9216, LS_AA = LS_XCQ + 64 * LQ_NQ * 4, LS_BV = LS_AA + 64 * LQ_NQ * 4, LS_HH = LS_BV + 64 * LQ_NQ * 4,
              LS_SP = LS_HH + 64 * LQ_NQ * 4, LS_SH = LS_SP + 8 * LQ_NQ * 4, LS_HC = LS_SH + 8 * LQ_NQ * 4, LS_BYTES = LS_HC + 2 * LQ_NQ * 4;
__device__ __forceinline__ void lru_unit_q(ArgsP a, LAS unsigned char* lds, int layer, int u) {
    const int tid = tid_(), lane = tid & 63, wave = tid >> 6, i16 = lane & 15, g4 = lane >> 4;
    const int lat = u < 64, uu = lat ? u : u - 64, bp = uu >> 4, e = (uu >> 3) & 1, g = (uu >> 1) & 3, oq = uu & 1;
    const int L = lat ? L_LAT : L_CTX;
    const int tokb[2] = {lat ? T_CTX + (2 * bp) * L_LAT : (2 * bp) * L_CTX, lat ? T_CTX + (2 * bp + 1) * L_LAT : (2 * bp + 1) * L_CTX};
    const bf16* G1 = (const bf16*)(a->ws + WS_G1);
    unsigned char* HO = e ? (unsigned char*)a->out + 2048 : a->ws + WS_HF;
    const size_t hstr = e ? 4096 : 512;
    const int tt = tid >> 3, q8 = (tid & 7) * 8;
    float cw[4][8], cb[8];
#pragma unroll
    for (int i = 0; i < 8; ++i) { const int ch = g * 64 + q8 + i; cb[i] = a->in[I_CONVB][layer * 256 + ch];
#pragma unroll
        for (int j = 0; j < 4; ++j) cw[j][i] = a->in[I_CONVW][(layer * 4 + j) * 256 + ch]; }
    const int gt = wave & 3, got = wave >> 2;
    const int ssn = tid >> 8, sch = tid & (LQ_NQ - 1), seg = (tid >> 5) & 7;
    const int otok = tid >> 3, oc4 = (tid & 7) * 4;
    const int chq = g * 64 + oq * LQ_NQ;
    LAS unsigned char* SS = lds + LQ_S0 + ssn * LS_BYTES;
    {
        __syncthreads();
        { const int m = tid >> 8, row = (tid >> 3) & 31, c8 = (tid & 7) * 8;
          const bf16* wsrc = (const bf16*)(a->ws + WS_LRUW) + ((size_t)(((layer * 2 + e) * 2 + m) * 4 + g) * 64 + oq * LQ_NQ + row) * 64 + c8;
          *(LAS v4u*)(lds + LQ_WAT + m * LQ_NQ * 144 + row * 144 + c8 * 2) = *(const v4u*)wsrc; }
        if (tid < 2 * LQ_NQ) { const int s = tid >> 5, c = tid & 31; ((LAS float*)(lds + LQ_S0 + s * LS_BYTES + LS_HC))[c] = lat ? a->in[I_SLRU][((size_t)((2 * bp + s) * 2 + layer) * 2 + e) * 256 + chq + c] : 0.f; }
        f32x4 bav, bxv, spl;
        { const int chb = (layer * 2 + e) * 256 + chq + 16 * got + 4 * g4;
          bav = *(const f32x4*)(a->in[I_BA] + chb); bxv = *(const f32x4*)(a->in[I_BX] + chb); const f32x4 lam = *(const f32x4*)(a->in[I_LAMBDA] + chb);
#pragma unroll
          for (int q = 0; q < 4; ++q) spl[q] = log1pf(exp_(-lam[q])); }
        v4u xr[2][4];
#define LQ_PREFETCH(cc_) do { const int c_ = e ? L / 64 - 1 - (cc_) : (cc_), t_ = c_ * 64 + tt; \
            _Pragma("unroll") for (int s = 0; s < 2; ++s) { \
              _Pragma("unroll") for (int j = 0; j < 4; ++j) { const int ts = t_ + j - 2; xr[s][j] = (ts >= 0 && ts < L) ? *(const v4u*)(G1 + (size_t)(tokb[s] + ts) * G1W + C_XL + g * 64 + q8) : (v4u){0u, 0u, 0u, 0u}; } \
              } } while (0)
        LQ_PREFETCH(0);
        __syncthreads();
        for (int cc = 0; cc < L / 64; ++cc) {
            const int c = e ? L / 64 - 1 - cc : cc;
            v4u xcur[2][4];
#pragma unroll
            for (int s = 0; s < 2; ++s) { xcur[s][0] = xr[s][0]; xcur[s][1] = xr[s][1]; xcur[s][2] = xr[s][2]; xcur[s][3] = xr[s][3]; }
            if (cc + 1 < L / 64) LQ_PREFETCH(cc + 1);
#pragma unroll
            for (int s = 0; s < 2; ++s) {
                LAS unsigned char* SB = lds + LQ_S0 + s * LS_BYTES;
                float xc[8];
#pragma unroll
                for (int i = 0; i < 8; ++i) xc[i] = cb[i];
#pragma unroll
                for (int j = 0; j < 4; ++j) { const v4u x = xcur[s][j];
                    xc[0] += cw[j][0] * bflo(x.x); xc[1] += cw[j][1] * bfhi(x.x); xc[2] += cw[j][2] * bflo(x.y); xc[3] += cw[j][3] * bfhi(x.y);
                    xc[4] += cw[j][4] * bflo(x.z); xc[5] += cw[j][5] * bfhi(x.z); xc[6] += cw[j][6] * bflo(x.w); xc[7] += cw[j][7] * bfhi(x.w); }
                *(LAS v4u*)(SB + LS_XCB + tt * 144 + q8 * 2) = (v4u){cvtpk(xc[0], xc[1]), cvtpk(xc[2], xc[3]), cvtpk(xc[4], xc[5]), cvtpk(xc[6], xc[7])};
                if ((q8 / LQ_NQ) == oq) { LAS float* XCQ = (LAS float*)(SB + LS_XCQ); *(LAS f32x4*)(XCQ + tt * LQ_NQ + (q8 % LQ_NQ)) = (f32x4){xc[0], xc[1], xc[2], xc[3]}; *(LAS f32x4*)(XCQ + tt * LQ_NQ + (q8 % LQ_NQ) + 4) = (f32x4){xc[4], xc[5], xc[6], xc[7]}; }
            }
            __syncthreads();
#pragma unroll
            for (int s = 0; s < 2; ++s) {
                LAS unsigned char* SB = lds + LQ_S0 + s * LS_BYTES;
                const int tk = gt * 16 + i16;
                f32x4 ga = (f32x4){0.f, 0.f, 0.f, 0.f}, gx = (f32x4){0.f, 0.f, 0.f, 0.f};
#pragma unroll
                for (int ks = 0; ks < 2; ++ks) { const bf16x8 xf = *(const LAS bf16x8*)(SB + LS_XCB + tk * 144 + ks * 64 + g4 * 16);
                    const bf16x8 wa = *(const LAS bf16x8*)(lds + LQ_WAT + (16 * got + i16) * 144 + ks * 64 + g4 * 16), wx = *(const LAS bf16x8*)(lds + LQ_WAT + LQ_NQ * 144 + (16 * got + i16) * 144 + ks * 64 + g4 * 16);
                    ga = MFMA16(wa, xf, ga); gx = MFMA16(wx, xf, gx); }
                const f32x4 xcv = *(const LAS f32x4*)((LAS float*)(SB + LS_XCQ) + tk * LQ_NQ + 16 * got + 4 * g4);
                f32x4 av, bv;
#pragma unroll
                for (int q = 0; q < 4; ++q) { const float la = -8.f * sigmoidf_(ga[q] + bav[q]) * spl[q], aq = exp_(la); av[q] = aq; bv[q] = sqrt_((1.f - aq) * (1.f + aq)) * sigmoidf_(gx[q] + bxv[q]) * xcv[q]; }
                *(LAS f32x4*)((LAS float*)(SB + LS_AA) + tk * LQ_NQ + 16 * got + 4 * g4) = av; *(LAS f32x4*)((LAS float*)(SB + LS_BV) + tk * LQ_NQ + 16 * got + 4 * g4) = bv;
            }
            __syncthreads();
            LAS float* AA = (LAS float*)(SS + LS_AA); LAS float* BV = (LAS float*)(SS + LS_BV); LAS float* HH = (LAS float*)(SS + LS_HH);
            LAS float* SP = (LAS float*)(SS + LS_SP); LAS float* SH = (LAS float*)(SS + LS_SH); LAS float* HC = (LAS float*)(SS + LS_HC);
            float av8[8], bv8[8];
            {
                float P = 1.f, H = 0.f;
#pragma unroll
                for (int s = 0; s < 8; ++s) { const int p = seg * 8 + s, st = e ? 63 - p : p; av8[s] = AA[st * LQ_NQ + sch]; bv8[s] = BV[st * LQ_NQ + sch]; H = fmaf(av8[s], H, bv8[s]); P *= av8[s]; }
                SP[seg * LQ_NQ + sch] = P; SH[seg * LQ_NQ + sch] = H;
            }
            __syncthreads();
            {
                float h = HC[(cc & 1) * LQ_NQ + sch];
                for (int s2 = 0; s2 < seg; ++s2) h = fmaf(SP[s2 * LQ_NQ + sch], h, SH[s2 * LQ_NQ + sch]);
#pragma unroll
                for (int s = 0; s < 8; ++s) { const int p = seg * 8 + s, st = e ? 63 - p : p; h = fmaf(av8[s], h, bv8[s]); HH[st * LQ_NQ + sch] = h; }
                if (seg == 7) HC[((cc + 1) & 1) * LQ_NQ + sch] = h;
            }
            __syncthreads();
#pragma unroll
            for (int s = 0; s < 2; ++s) {
                const int n = tokb[s] + c * 64 + otok;
                const f32x4 hv = *(const LAS f32x4*)((LAS float*)(lds + LQ_S0 + s * LS_BYTES + LS_HH) + otok * LQ_NQ + oc4);
                *(v2u*)(HO + (size_t)n * hstr + (chq + oc4) * 2) = (v2u){cvtpk(hv[0], hv[1]), cvtpk(hv[2], hv[3])};
            }
        }
#undef LQ_PREFETCH
        __syncthreads();
        if (tid < 2 * LQ_NQ && !lat) { const int s = tid >> 5, c = tid & 31; a->out[O_LRU + ((size_t)((2 * bp + s) * 2 + layer) * 2 + e) * 256 + chq + c] = ((LAS float*)(lds + LQ_S0 + s * LS_BYTES + LS_HC))[((L / 64) & 1) * LQ_NQ + c]; }
    }
}

constexpr int ATT2_VSTR = 144, ATT2_STAGE = 64 * ATT_KSTR + 64 * ATT2_VSTR;
#define ATT_KLOAD(KB_) \
        bf16x8 kfa_[6], kfb_[6]; \
        _Pragma("unroll") for (int ks_ = 0; ks_ < 6; ++ks_) { kfa_[ks_] = *(const LAS bf16x8*)((KB_) + r * ATT_KSTR + ks_ * 32 + hq * 16); kfb_[ks_] = *(const LAS bf16x8*)((KB_) + (32 + r) * ATT_KSTR + ks_ * 32 + hq * 16); }
#define ATT_VLOAD(VB_) \
        v2u va0_[4], va1_[4], vb0_[4], vb1_[4]; \
        _Pragma("unroll") for (int ks_ = 0; ks_ < 4; ++ks_) { \
            const LAS unsigned char* vp_ = (VB_) + (ks_ * 16 + 4 * hq + ((lane >> 2) & 3)) * ATT2_VSTR + (16 * ((lane >> 4) & 1) + 4 * (lane & 3)) * 2; \
            va0_[ks_] = __builtin_bit_cast(v2u, __builtin_amdgcn_ds_read_tr16_b64_v4i16((LAS s16x4_t*)(vp_))); \
            va1_[ks_] = __builtin_bit_cast(v2u, __builtin_amdgcn_ds_read_tr16_b64_v4i16((LAS s16x4_t*)(vp_ + 8 * ATT2_VSTR))); \
            vb0_[ks_] = __builtin_bit_cast(v2u, __builtin_amdgcn_ds_read_tr16_b64_v4i16((LAS s16x4_t*)(vp_ + 64))); \
            vb1_[ks_] = __builtin_bit_cast(v2u, __builtin_amdgcn_ds_read_tr16_b64_v4i16((LAS s16x4_t*)(vp_ + 8 * ATT2_VSTR + 64))); }
#define ATT_QKM(S0_, S1_) do { \
        _Pragma("unroll") for (int i_ = 0; i_ < 16; ++i_) { S0_[i_] = 0.f; S1_[i_] = 0.f; } \
        _Pragma("unroll") for (int ks_ = 0; ks_ < 6; ++ks_) { S0_ = MFMA32(kfa_[ks_], qf[ks_], S0_); S1_ = MFMA32(kfb_[ks_], qf[ks_], S1_); } } while (0)
#define ATT_STEP(SC0_, SC1_, SN0_, SN1_, KB_, VB_, HAVE_NEXT_) do { \
        ATT_KLOAD(KB_) \
        float mx_ = SC0_[0]; \
        _Pragma("unroll") for (int i_ = 1; i_ < 16; ++i_) mx_ = fmaxf(mx_, SC0_[i_]); \
        _Pragma("unroll") for (int i_ = 0; i_ < 16; ++i_) mx_ = fmaxf(mx_, SC1_[i_]); \
        mx_ = fmaxf(mx_, __shfl_xor(mx_, 32)); \
        if (!__all(mx_ - m <= 8.f)) { const float mn_ = fmaxf(m, mx_), al_ = __builtin_amdgcn_exp2f(m - mn_); m = mn_; l *= al_; \
            _Pragma("unroll") for (int i_ = 0; i_ < 16; ++i_) { o0[i_] *= al_; o1[i_] *= al_; } } \
        if (HAVE_NEXT_) ATT_QKM(SN0_, SN1_); \
        ATT_VLOAD(VB_) \
        float ps_ = 0.f; \
        _Pragma("unroll") for (int i_ = 0; i_ < 16; ++i_) { SC0_[i_] = __builtin_amdgcn_exp2f(SC0_[i_] - m); SC1_[i_] = __builtin_amdgcn_exp2f(SC1_[i_] - m); ps_ += SC0_[i_] + SC1_[i_]; } \
        l += ps_; \
        _Pragma("unroll") for (int ks_ = 0; ks_ < 4; ++ks_) { \
            v4u pw_; \
            if (ks_ == 0) { pw_.x = cvtpk(SC0_[0], SC0_[1]); pw_.y = cvtpk(SC0_[2], SC0_[3]); pw_.z = cvtpk(SC0_[4], SC0_[5]); pw_.w = cvtpk(SC0_[6], SC0_[7]); } \
            else if (ks_ == 1) { pw_.x = cvtpk(SC0_[8], SC0_[9]); pw_.y = cvtpk(SC0_[10], SC0_[11]); pw_.z = cvtpk(SC0_[12], SC0_[13]); pw_.w = cvtpk(SC0_[14], SC0_[15]); } \
            else if (ks_ == 2) { pw_.x = cvtpk(SC1_[0], SC1_[1]); pw_.y = cvtpk(SC1_[2], SC1_[3]); pw_.z = cvtpk(SC1_[4], SC1_[5]); pw_.w = cvtpk(SC1_[6], SC1_[7]); } \
            else { pw_.x = cvtpk(SC1_[8], SC1_[9]); pw_.y = cvtpk(SC1_[10], SC1_[11]); pw_.z = cvtpk(SC1_[12], SC1_[13]); pw_.w = cvtpk(SC1_[14], SC1_[15]); } \
            const bf16x8 pf_ = __builtin_bit_cast(bf16x8, pw_); \
            const v4u vwa_ = {va0_[ks_].x, va0_[ks_].y, va1_[ks_].x, va1_[ks_].y}, vwb_ = {vb0_[ks_].x, vb0_[ks_].y, vb1_[ks_].x, vb1_[ks_].y}; \
            o0 = MFMA32(__builtin_bit_cast(bf16x8, vwa_), pf_, o0); o1 = MFMA32(__builtin_bit_cast(bf16x8, vwb_), pf_, o1); } } while (0)
__device__ __forceinline__ void att_unit2(ArgsP a, LAS unsigned char* lds, int u) {
    const int tid = tid_(), lane = tid & 63, wave = tid >> 6, r = lane & 31, hq = lane >> 5;
    const bf16* KN = (const bf16*)(a->ws + WS_KN); const bf16* KR = (const bf16*)(a->ws + WS_KR); const bf16* VT = (const bf16*)(a->ws + WS_VT);
    bf16* Q = (bf16*)(a->ws + WS_Q); const bf16* G1 = (const bf16*)(a->ws + WS_G1);
    int b, h, n0, Lk, kidx0; size_t vbase;
    if (u < 512) { b = u >> 6; h = (u >> 3) & 7; n0 = T_CTX + b * 2048 + (u & 7) * 256; Lk = LK_LAT; kidx0 = T_CTX + b * LK_LAT; vbase = (size_t)VT_LAT + (size_t)(b * 8 + h) * 64 * LK_LAT; }
    else { const int uu = u - 512; b = uu >> 3; h = uu & 7; n0 = b * 256; Lk = 256; kidx0 = b * 256; vbase = (size_t)(b * 8 + h) * 64 * 256; }
    const int ntiles = Lk >> 6;
    const int n = n0 + wave * 32 + r;
    bf16x8 qf[6];
#pragma unroll
    for (int ks = 0; ks < 6; ++ks) qf[ks] = *(const bf16x8*)(Q + (size_t)n * 768 + h * 96 + ks * 16 + 8 * hq);
    const int key_k = tid >> 3, ck = tid & 7, key_r = (tid >> 2) & 63, cr = tid & 3;
    const bf16* gk = KN + (size_t)(kidx0 + key_k) * 512 + h * 64 + ck * 8;
    const bf16* gr = KR + (size_t)(kidx0 + key_r) * 32 + cr * 8;
    const bf16* gv = VT + (size_t)(kidx0 + key_k) * 512 + h * 64 + ck * 8;
    const unsigned sk = key_k * ATT_KSTR + ck * 16, sr = key_r * ATT_KSTR + 128 + cr * 16, sv = ATT_VOFF + key_k * ATT2_VSTR + ck * 16;
    v4u rkA, rrA = {0u, 0u, 0u, 0u}, rvA, rkB, rrB = {0u, 0u, 0u, 0u}, rvB;
#define ATT_LOAD(X_, j_) do { rk##X_ = *(const v4u*)(gk + (size_t)(j_) * 64 * 512); if (tid < 256) rr##X_ = *(const v4u*)(gr + (size_t)(j_) * 64 * 32); rv##X_ = *(const v4u*)(gv + (size_t)(j_) * 64 * 512); } while (0)
#define ATT_STORE(X_, B_) do { LAS unsigned char* nb_ = lds + (B_) * ATT2_STAGE; *(LAS v4u*)(nb_ + sk) = rk##X_; if (tid < 256) *(LAS v4u*)(nb_ + sr) = rr##X_; \
        *(LAS v4u*)(nb_ + sv) = rv##X_; } while (0)
    ATT_LOAD(A, 0); ATT_LOAD(B, 1);
    __syncthreads();
    ATT_STORE(A, 0);
    ATT_STORE(B, 1);
    ATT_LOAD(A, 2);
    __syncthreads();
    f32x16 o0, o1, sa0, sa1, sb0, sb1;
#pragma unroll
    for (int i = 0; i < 16; ++i) { o0[i] = 0.f; o1[i] = 0.f; }
    float m = -1e30f, l = 0.f;
    { ATT_KLOAD(lds) ATT_QKM(sa0, sa1); }
    int bcur = 0;
    int j = 0;
    for (; j < ntiles - 2; j += 2) {
        {
            const int b1 = bcur == 2 ? 0 : bcur + 1, b2 = b1 == 2 ? 0 : b1 + 1;
            ATT_LOAD(B, j + 3);
            ATT_STEP(sa0, sa1, sb0, sb1, lds + b1 * ATT2_STAGE, lds + bcur * ATT2_STAGE + ATT_VOFF, true);
            ATT_STORE(A, b2);
            __syncthreads();
            bcur = b1;
        }
        {
            const int b1 = bcur == 2 ? 0 : bcur + 1, b2 = b1 == 2 ? 0 : b1 + 1;
            if (j + 4 < ntiles) ATT_LOAD(A, j + 4);
            ATT_STEP(sb0, sb1, sa0, sa1, lds + b1 * ATT2_STAGE, lds + bcur * ATT2_STAGE + ATT_VOFF, true);
            ATT_STORE(B, b2);
            __syncthreads();
            bcur = b1;
        }
    }
    {
        { const int b1 = bcur == 2 ? 0 : bcur + 1;
          ATT_STEP(sa0, sa1, sb0, sb1, lds + b1 * ATT2_STAGE, lds + bcur * ATT2_STAGE + ATT_VOFF, true);
          bcur = b1; }
        { ATT_STEP(sb0, sb1, sa0, sa1, lds + bcur * ATT2_STAGE, lds + bcur * ATT2_STAGE + ATT_VOFF, false); }
        __syncthreads();
    }
#undef ATT_LOAD
#undef ATT_STORE
    v2u gmv[2][4];
#pragma unroll
    for (int mt = 0; mt < 2; ++mt)
#pragma unroll
        for (int g = 0; g < 4; ++g) gmv[mt][g] = *(const v2u*)(G1 + (size_t)n * G1W + C_GM + h * 64 + 32 * mt + 8 * g + 4 * hq);
    l += __shfl_xor(l, 32);
    const float inv = rcp_(l);
#pragma unroll
    for (int mt = 0; mt < 2; ++mt)
#pragma unroll
        for (int g = 0; g < 4; ++g) {
            const int dv0 = 32 * mt + 8 * g + 4 * hq;
            const v2u gm = gmv[mt][g];
            const float x0 = (mt ? o1[4 * g + 0] : o0[4 * g + 0]) * inv, x1 = (mt ? o1[4 * g + 1] : o0[4 * g + 1]) * inv, x2 = (mt ? o1[4 * g + 2] : o0[4 * g + 2]) * inv, x3 = (mt ? o1[4 * g + 3] : o0[4 * g + 3]) * inv;
            v2u ov; ov.x = cvtpk(x0 * siluf_(bflo(gm.x)), x1 * siluf_(bfhi(gm.x))); ov.y = cvtpk(x2 * siluf_(bflo(gm.y)), x3 * siluf_(bfhi(gm.y)));
            *(v2u*)(Q + (size_t)n * 768 + h * 96 + dv0) = ov;
        }
}
constexpr int N_PHASES = 14;

__device__ __forceinline__ void phase_b(ArgsP a, LAS unsigned char* lds, int layer) {
    volatile LAS unsigned* MISC = (volatile LAS unsigned*)(lds + LDS_MISC);
    unsigned* head = (unsigned*)(a->ws + WS_CTL) + CW_Q + layer * 64;
    for (;;) {
        __syncthreads();
        if (tid_() == 0) MISC[16] = atomicAdd(head, 1u);
        __syncthreads();
        const int idx = (int)MISC[16];
        if (idx >= 1408) break;
        if (idx < 64) rwkv_unit_mfma(a, lds, layer, idx);
        else if (idx < 128) lru_unit_q(a, lds, layer, idx - 64);
        else if (idx < 640) att_unit2(a, lds, idx - 128);
        else if (idx < 896) rwkv_unit_mfma(a, lds, layer, 64 + idx - 640);
        else if (idx < 1152) lru_unit_q(a, lds, layer, 64 + idx - 896);
        else att_unit2(a, lds, 512 + idx - 1152);
    }
}

#define ARGS_VIEW() ({ ArgsP p_ = (ArgsP)__builtin_amdgcn_kernarg_segment_ptr(); asm volatile("" : "+s"(p_)); p_; })
__global__ void __launch_bounds__(NTHREADS, 2) mk_fwd(Args args) {
    extern __shared__ __attribute__((aligned(16))) unsigned char lds_raw[];
    LAS unsigned char* lds = (LAS unsigned char*)lds_raw;
    volatile LAS unsigned* MISC = (volatile LAS unsigned*)(lds + LDS_MISC);
    for (int u = threadIdx.x; u < 64; u += NTHREADS) MISC[u] = 0u;
    __syncthreads();
    XcdBarrier bar;
    { ArgsP a = ARGS_VIEW(); bar = xcd_barrier_post((unsigned*)(a->ws + WS_CTL) + CW_BAR, MISC + 8); }
    int lo, hi; { ArgsP a = ARGS_VIEW(); lo = a->ph_lo; hi = a->ph_hi; }
#define IN(k) (lo <= (k) && (k) < hi)
#define SEAM(k) do { if (IN(k) && IN((k) + 1)) xcd_barrier(bar); } while (0)
    if (IN(0)) { ArgsP a = ARGS_VIEW(); phase_p0(a, lds); }
    SEAM(0);
    for (int layer = 0; layer < 2; ++layer) {
        const int p = 1 + 6 * layer;
        if (IN(p + 0)) { { ArgsP a = ARGS_VIEW(); phase_a0(a, lds, layer); } if (layer == 0) { ArgsP a = ARGS_VIEW(); phase_p0_weights(a, lds); } }
        SEAM(p + 0);
        if (IN(p + 1)) { ArgsP a = ARGS_VIEW(); phase_a1_pg8(a, lds, layer); }
        SEAM(p + 1);
        if (IN(p + 2)) { { ArgsP a = ARGS_VIEW(); phase_a2a(a, layer); } xcd_barrier(bar); { ArgsP a = ARGS_VIEW(); phase_a2b(a, lds, layer); } }
        SEAM(p + 2);
        if (IN(p + 3)) { ArgsP a = ARGS_VIEW(); phase_b(a, lds, layer); }
        SEAM(p + 3);
        if (IN(p + 4)) { ArgsP a = ARGS_VIEW(); phase_c1(a, layer); }
        SEAM(p + 4);
        if (IN(p + 5)) { ArgsP a = ARGS_VIEW(); phase_c2_pg8(a, lds, layer); }
        SEAM(p + 5);
    }
    if (IN(N_PHASES - 1)) { ArgsP a = ARGS_VIEW(); phase_final(a); }
#undef IN
#undef SEAM
}

extern "C" void kernel_launch(void* const* d_in, const int* in_sizes, int n_in, void* d_out, int out_size, void* d_ws, size_t ws_size, hipStream_t stream) {
    static int grid = 0;
    if (grid == 0) {
        if (n_in != N_IN || ws_size < WS_END) { fprintf(stderr, "kernel_launch: unexpected n_in %d / ws_size %zu\n", n_in, ws_size); grid = -1; return; }
        int dev = 0, cus = 0;
        if (hipGetDevice(&dev) != hipSuccess || hipDeviceGetAttribute(&cus, hipDeviceAttributeMultiprocessorCount, dev) != hipSuccess) { grid = -1; return; }
        if (hipFuncSetAttribute((const void*)mk_fwd, hipFuncAttributeMaxDynamicSharedMemorySize, LDS_BYTES) != hipSuccess) { fprintf(stderr, "kernel_launch: hipFuncSetAttribute failed\n"); grid = -1; return; }
        int per_cu = 0;
        if (hipOccupancyMaxActiveBlocksPerMultiprocessor(&per_cu, (const void*)mk_fwd, NTHREADS, LDS_BYTES) != hipSuccess || per_cu < 1) fprintf(stderr, "kernel_launch: occupancy query reports %d\n", per_cu);
        (void)hipGetLastError();
        grid = cus;
    }
    if (grid < 0) return;
    if (hipMemsetAsync((char*)d_ws + WS_CTL, 0, CTL_ZERO_BYTES, stream) != hipSuccess) return;
    Args a{};
    for (int i = 0; i < N_IN; ++i) a.in[i] = (const float*)d_in[i];
    a.out = (float*)d_out; a.ws = (unsigned char*)d_ws;
    a.ph_lo = 0; a.ph_hi = N_PHASES;
    hipLaunchKernelGGL(mk_fwd, dim3(grid), dim3(NTHREADS), LDS_BYTES, stream, a);
}
```

```cpp
#include <hip/hip_runtime.h>
#include <cstdio>
#include <cstdint>

#define GAS __attribute__((address_space(1)))
#define LAS __attribute__((address_space(3)))
typedef unsigned short bf16;
typedef unsigned v4u __attribute__((ext_vector_type(4)));
typedef unsigned v2u __attribute__((ext_vector_type(2)));
typedef float f32x4 __attribute__((ext_vector_type(4)));
typedef short bf16x8 __attribute__((ext_vector_type(8)));

constexpr int D = 1024, T_CTX = 8192, T_LAT = 16384, T = 24576, L_CTX = 256, L_LAT = 2048, PAST = 256;
constexpr int NIN = 2816, G1W = 2304, G2W = 512;
constexpr int C_R = 0, C_K = 256, C_V = 512, C_G = 768, C_GM = 1024, C_XL = 1536, C_GL = 1792, C_LORA = 2048;
constexpr int LK_LAT = PAST + L_LAT;
constexpr int TK = T_CTX + 8 * LK_LAT;
constexpr int VT_LAT = 32 * 8 * 64 * 256;
constexpr float LN_EPS = 1e-5f, GN_EPS = 64e-5f;
constexpr float ALPHA = 1.4142135623730951f;
constexpr float QSCALE = 0.10206207261596575f * 1.4426950408889634f;
constexpr size_t O_Y = 0, O_RW = 25165824, O_CKV = 27262976, O_KR = 29360128, O_LRU = 29884416;
constexpr size_t MiB = 1u << 20;
constexpr size_t WS_CTL = 0, CTL_ZERO_BYTES = 1 * MiB;
constexpr size_t WS_MOD = 256 * 1024;
constexpr size_t WS_ROPE = 1 * MiB;
constexpr size_t WS_LORA2 = 1280 * 1024;
constexpr size_t WS_LRUW = 2816 * 1024;
constexpr size_t WS_STATS = 1536 * 1024;
constexpr size_t WS_WUQ = 2 * MiB;
constexpr size_t WS_WUKV = 3 * MiB;
constexpr size_t WS_WIN = 4 * MiB;
constexpr size_t WS_WOUT = 16 * MiB;
constexpr size_t WS_G1 = 20 * MiB;
constexpr size_t WS_G2 = 128 * MiB;
constexpr size_t WS_Q = 152 * MiB;
constexpr size_t WS_KN = 188 * MiB;
constexpr size_t WS_KR = 214 * MiB;
constexpr size_t WS_VT = 216 * MiB;
constexpr int YM_LD = 2048;
constexpr size_t WS_HF = 242 * MiB;
constexpr size_t WS_END = 254 * MiB;
constexpr int CW_BAR = 4096;
constexpr int CW_Q = 16384;

__device__ __forceinline__ float bf2f(unsigned b) { return __uint_as_float(b << 16); }
__device__ __forceinline__ float bflo(unsigned w) { return __uint_as_float(w << 16); }
__device__ __forceinline__ float bfhi(unsigned w) { return __uint_as_float(w & 0xffff0000u); }
__device__ __forceinline__ unsigned f2bf(float f) { unsigned u = __float_as_uint(f); return (u + 0x7fffu + ((u >> 16) & 1u)) >> 16; }
__device__ __forceinline__ unsigned pk2(float lo, float hi) { return f2bf(lo) | (f2bf(hi) << 16); }
__device__ __forceinline__ float rcp_(float x) { return __builtin_amdgcn_rcpf(x); }
__device__ __forceinline__ float exp_(float x) { return __builtin_amdgcn_exp2f(x * 1.4426950408889634f); }
__device__ __forceinline__ float sqrt_(float x) { return __builtin_amdgcn_sqrtf(x); }
__device__ __forceinline__ float rsqrt_(float x) { return __builtin_amdgcn_rsqf(x); }
__device__ __forceinline__ float sigmoidf_(float x) { return rcp_(1.f + exp_(-x)); }
__device__ __forceinline__ float siluf_(float x) { return x * rcp_(1.f + exp_(-x)); }
template <int CTRL> __device__ __forceinline__ float dpp_f(float old, float x) { return __builtin_bit_cast(float, __builtin_amdgcn_update_dpp(__builtin_bit_cast(int, old), __builtin_bit_cast(int, x), CTRL, 0xf, 0xf, false)); }
__device__ __forceinline__ float row16_sum(float x) { x += dpp_f<0x128>(0.f, x); x += dpp_f<0x124>(0.f, x); x += dpp_f<0x122>(0.f, x); x += dpp_f<0x121>(0.f, x); return x; }
__device__ __forceinline__ float wave_sum_fast(float x) { x = row16_sum(x); x += __shfl_xor(x, 16); x += __shfl_xor(x, 32); return x; }
__device__ __forceinline__ float row16_prefix_prod(float x) { x *= dpp_f<0x111>(1.f, x); x *= dpp_f<0x112>(1.f, x); x *= dpp_f<0x114>(1.f, x); x *= dpp_f<0x118>(1.f, x); return x; }
__device__ __forceinline__ float wave_sum(float v) { return wave_sum_fast(v); }
__device__ __forceinline__ int tid_() { int t = threadIdx.x; asm volatile("" : "+v"(t)); return t; }
__device__ __forceinline__ int bid_() { int b = blockIdx.x; asm volatile("" : "+s"(b)); return b; }
__device__ __forceinline__ int grid_() { int g = gridDim.x; asm volatile("" : "+s"(g)); return g; }
typedef float f32x16 __attribute__((ext_vector_type(16)));
typedef float f32x2_t __attribute__((ext_vector_type(2)));
typedef __bf16 bf16x2_t __attribute__((ext_vector_type(2)));
__device__ __forceinline__ unsigned cvtpk(float lo, float hi) { const f32x2_t v = {lo, hi}; return __builtin_bit_cast(unsigned, __builtin_convertvector(v, bf16x2_t)); }
#define XB_TMO      128
#define XB_XCNT(j)  (256  + 64 * (j))
#define XB_XSUB(j)  (1280 + 64 * (j))
#define XB_XGEN(j)  (2304 + 64 * (j))
#define XB_TOP      3328
#define XB_TOPGEN   3392
#define XCD_BAR_WORDS 3456
#define XB_SPIN_CAP (1u << 24)

__device__ __forceinline__ unsigned xb_ld(unsigned* p)              { return __hip_atomic_load(p, __ATOMIC_RELAXED, __HIP_MEMORY_SCOPE_AGENT); }
__device__ __forceinline__ unsigned xb_add(unsigned* p, unsigned v) { return __hip_atomic_fetch_add(p, v, __ATOMIC_RELAXED, __HIP_MEMORY_SCOPE_AGENT); }
__device__ __forceinline__ unsigned xb_xcc_id() { return (unsigned)__builtin_amdgcn_s_getreg((3 << 11) | 20) & 0xFu; }
#define XB_SPIN(cond, bar) do { unsigned _sp = 0; while (cond) { __builtin_amdgcn_s_sleep(1); \
    if ((++_sp & 255u) == 0u) { if (xb_ld(&(bar)[XB_TMO])) break; if (_sp > XB_SPIN_CAP) { atomicAdd(&(bar)[XB_TMO], 1u); break; } } } } while (0)

struct XcdBarrier {
    unsigned* bar; unsigned x;
    volatile LAS unsigned* st;
};

__device__ __forceinline__ XcdBarrier xcd_barrier_post(unsigned* bar, volatile LAS unsigned* st) {
    XcdBarrier b; b.bar = bar; b.x = xb_xcc_id(); b.st = st;
    if (threadIdx.x == 0) (void)xb_add(&bar[XB_XCNT(b.x)], 1u);
    return b;
}
__device__ __forceinline__ void xcd_barrier_complete(unsigned* bar, unsigned x, unsigned& nloc, unsigned& nx) {
    const unsigned G = gridDim.x * gridDim.y * gridDim.z;
    unsigned sum, cnt, mine, sp = 0u;
    for (;;) {
        sum = 0u; cnt = 0u; mine = 0u;
#pragma unroll
        for (unsigned j = 0; j < 16; ++j) { const unsigned c = xb_ld(&bar[XB_XCNT(j)]); sum += c; cnt += (c > 0u) ? 1u : 0u; mine = (j == x) ? c : mine; }
        if (sum == G) break;
        __builtin_amdgcn_s_sleep(1);
        if ((++sp & 255u) == 0u) { if (xb_ld(&bar[XB_TMO])) break; if (sp > XB_SPIN_CAP) { atomicAdd(&bar[XB_TMO], 1u); break; } }
    }
    nloc = mine > 0u ? mine : 1u; nx = cnt > 0u ? cnt : 1u;
}

__device__ __forceinline__ void xcd_barrier(const XcdBarrier& b) {
    asm volatile("s_waitcnt vmcnt(0)" ::: "memory");
    __syncthreads();
    if (threadIdx.x == 0) {
        unsigned* bar = b.bar;
        __builtin_amdgcn_s_waitcnt(0);
        unsigned nloc = b.st[0], nx = b.st[1];
        if (nloc == 0u) { xcd_barrier_complete(bar, b.x, nloc, nx); b.st[0] = nloc; b.st[1] = nx; }
        const unsigned old = xb_add(&bar[XB_XSUB(b.x)], 1u);
        const unsigned gen = old / nloc;
        if (old + 1u == (gen + 1u) * nloc) {
            __builtin_amdgcn_fence(__ATOMIC_RELEASE, "agent");
            asm volatile("s_waitcnt vmcnt(0)" ::: "memory");
            const unsigned og = xb_add(&bar[XB_TOP], 1u);
            const unsigned tg = og / nx;
            if (og + 1u == (tg + 1u) * nx) xb_add(&bar[XB_TOPGEN], 1u);
            else XB_SPIN(xb_ld(&bar[XB_TOPGEN]) == tg, bar);
            __builtin_amdgcn_fence(__ATOMIC_ACQUIRE, "agent");
            xb_add(&bar[XB_XGEN(b.x)], 1u);
            asm volatile("s_waitcnt vmcnt(0)" ::: "memory");
        } else {
            XB_SPIN(xb_ld(&bar[XB_XGEN(b.x)]) == gen, bar);
            __builtin_amdgcn_fence(__ATOMIC_ACQUIRE, "agent");
            asm volatile("s_waitcnt vmcnt(0)" ::: "memory");
        }
    }
    __syncthreads();
}
enum { I_XP = 0, I_XS, I_SRW, I_CCKV, I_CKR, I_SLRU, I_C, I_CCTX, I_WMOD, I_BMOD, I_WIN, I_W0, I_W1, I_W2, I_A0, I_A1, I_A2, I_KK, I_KA, I_RK,
       I_LNXG, I_LNXB, I_QNORM, I_WUQ, I_KVNORM, I_WUKV, I_CONVW, I_CONVB, I_WA, I_BA, I_WX, I_BX, I_LAMBDA, I_WOUT, I_LNG, I_LNB, N_IN };
struct Args { const float* in[N_IN]; float* out; unsigned char* ws; int ph_lo, ph_hi; };
typedef const Args __attribute__((address_space(4)))* ArgsP;
constexpr int NTHREADS = 512;
constexpr int LDS_MISC = 139264;
constexpr int LDS_BYTES = 147456;

struct Tok { int n, b, t, L, lat, modrow, tok0, kidx; };
__device__ __forceinline__ Tok tok_of(int n) {
    Tok k; k.n = n;
    if (n < T_CTX) { k.lat = 0; k.b = n >> 8; k.t = n & 255; k.L = L_CTX; k.modrow = 0; k.tok0 = k.b * 256; k.kidx = n; }
    else { const int m = n - T_CTX; k.lat = 1; k.b = m >> 11; k.t = m & 2047; k.L = L_LAT; k.modrow = 1 + k.b; k.tok0 = T_CTX + k.b * 2048; k.kidx = T_CTX + k.b * LK_LAT + PAST + k.t; }
    return k;
}
__device__ __forceinline__ const float* xrow_src(ArgsP a, int layer, int n) {
    if (layer == 0) return n < T_CTX ? a->in[I_XP] + (size_t)n * D : a->in[I_XS] + (size_t)(n - T_CTX) * D;
    return a->out + (size_t)n * D;
}
__device__ __forceinline__ float dot8(v4u a, v4u b, float acc) {
    acc = fmaf(bflo(a.x), bflo(b.x), acc); acc = fmaf(bfhi(a.x), bfhi(b.x), acc);
    acc = fmaf(bflo(a.y), bflo(b.y), acc); acc = fmaf(bfhi(a.y), bfhi(b.y), acc);
    acc = fmaf(bflo(a.z), bflo(b.z), acc); acc = fmaf(bfhi(a.z), bfhi(b.z), acc);
    acc = fmaf(bflo(a.w), bflo(b.w), acc); acc = fmaf(bfhi(a.w), bfhi(b.w), acc);
    return acc;
}

__device__ __forceinline__ void tr_item(const float* src, int ld, int col0, int k0, bf16* WT, int K, int row0, float scale, LAS float* scr, int lane) {
    {
        const int kr = lane >> 3, n4 = (lane & 7) * 4;
        f32x4 v[8];
#pragma unroll
        for (int i = 0; i < 8; ++i) v[i] = src ? __builtin_nontemporal_load((const f32x4*)(src + (size_t)(k0 + i * 8 + kr) * ld + col0 + n4)) : (f32x4){0.f, 0.f, 0.f, 0.f};
#pragma unroll
        for (int i = 0; i < 8; ++i) { LAS float* d = scr + (i * 8 + kr) * 33 + n4; d[0] = v[i].x * scale; d[1] = v[i].y * scale; d[2] = v[i].z * scale; d[3] = v[i].w * scale; }
    }
    asm volatile("s_waitcnt lgkmcnt(0)" ::: "memory");
    const int c = lane & 7;
#pragma unroll
    for (int j = 0; j < 4; ++j) { const int n = (lane >> 3) + 8 * j; const LAS float* s = scr + (8 * c) * 33 + n;
        v4u o; o.x = cvtpk(s[0 * 33], s[1 * 33]); o.y = cvtpk(s[2 * 33], s[3 * 33]); o.z = cvtpk(s[4 * 33], s[5 * 33]); o.w = cvtpk(s[6 * 33], s[7 * 33]);
        *(v4u*)(WT + (size_t)(row0 + n) * K + k0 + 8 * c) = o; }
    asm volatile("s_waitcnt lgkmcnt(0)" ::: "memory");
}
__device__ __forceinline__ void rope_angle(int t, int i, float& c, float& s) {
    const int row = t >> 6, col = t & 63; const int ii = i & 7;
    const float inv = exp2f(-(float)ii * (13.287712379549449f / 8.f));
    const float ang = (float)(i < 8 ? row : col) * inv;
    c = cosf(ang); s = sinf(ang);
}
__device__ __forceinline__ void phase_p0_weights(ArgsP a, LAS unsigned char* lds, int lo, int hi, int b0, int b1 = 1 << 30) {
    const int tid = tid_(), lane = tid & 63, wave = tid >> 6, G = grid_() < b1 ? grid_() : b1;
    if (bid_() < b0 || bid_() >= G) return;
    unsigned char* ws = a->ws;
    LAS float* scr = (LAS float*)(lds + wave * 8704);
    const int gw = (bid_() - b0) * 8 + wave, NGW = (G - b0) * 8;
    constexpr int N_WIN = 2 * 16 * 88, N_WOUT = 2 * 16 * 32, N_WUQ = 2 * 4 * 24, N_WUKV = 2 * 4 * 32, N_LORA = 2 * 2 * 2 * 8, N_LRUW = 2 * 2 * 2 * 4 * 2;
    if (hi > N_WIN + N_WOUT + N_WUQ + N_WUKV + N_LORA + N_LRUW) hi = N_WIN + N_WOUT + N_WUQ + N_WUKV + N_LORA + N_LRUW;
    for (int it = lo + gw; it < hi; it += NGW) {
        int r = it;
        if (r < N_WIN) {
            const int l = r / (16 * 88), kb = (r / 88) % 16, nb = r % 88, j0 = nb * 32;
            const float* src; int ld, col0;
            const float* win = a->in[I_WIN] + (size_t)l * 1024 * 2464;
            if (j0 < 1024) { src = win; ld = 2464; col0 = j0; }
            else if (j0 < 1536) { src = win; ld = 2464; col0 = 1440 + (j0 - 1024); }
            else if (j0 < 1792) { src = win; ld = 2464; col0 = 1952 + (j0 - 1536); }
            else if (j0 < 2048) { src = win; ld = 2464; col0 = 2208 + (j0 - 1792); }
            else if (j0 < 2304) { const int q = (j0 - 2048) >> 6; src = (q < 2 ? a->in[I_W1] : a->in[I_A1]) + (size_t)(l * 2 + (q & 1)) * 1024 * 64; ld = 64; col0 = (j0 - 2048) & 63; }
            else if (j0 < 2560) { src = win; ld = 2464; col0 = 1024 + (j0 - 2304); }
            else if (j0 < 2688) { src = win; ld = 2464; col0 = 1280 + (j0 - 2560); }
            else if (j0 < 2720) { src = win; ld = 2464; col0 = 1408 + (j0 - 2688); }
            else { src = nullptr; ld = 0; col0 = 0; }
            tr_item(src, ld, col0, kb * 64, (bf16*)(ws + WS_WIN) + (size_t)l * NIN * 1024, 1024, j0, 1.f, scr, lane);
            continue;
        }
        r -= N_WIN;
        if (r < N_WOUT) { const int l = r / (16 * 32), kb = (r / 32) % 16, nb = r % 32;
            tr_item(a->in[I_WOUT] + (size_t)l * 1024 * 1024, 1024, nb * 32, kb * 64, (bf16*)(ws + WS_WOUT) + (size_t)l * 1024 * 1024, 1024, nb * 32, 1.f, scr, lane); continue; }
        r -= N_WOUT;
        if (r < N_WUQ) { const int l = r / (4 * 24), kb = (r / 24) % 4, nb = r % 24;
            tr_item(a->in[I_WUQ] + (size_t)l * 256 * 768, 768, nb * 32, kb * 64, (bf16*)(ws + WS_WUQ) + (size_t)l * 768 * 256, 256, nb * 32, QSCALE, scr, lane); continue; }
        r -= N_WUQ;
        if (r >= N_WUKV) { r -= N_WUKV;
            if (r < N_LORA) { const int le = r >> 4, m = (r >> 3) & 1, nb = r & 7;
                tr_item((m ? a->in[I_A2] : a->in[I_W2]) + (size_t)le * 64 * 256, 256, nb * 32, 0, (bf16*)(ws + WS_LORA2) + (size_t)(le * 2 + m) * 256 * 64, 64, nb * 32, 1.f, scr, lane); }
            else { r -= N_LORA; const int le = r >> 4, m = (r >> 3) & 1, g = (r >> 1) & 3, nb = r & 1;
                tr_item((m ? a->in[I_WX] : a->in[I_WA]) + (size_t)(le * 4 + g) * 4096, 64, nb * 32, 0, (bf16*)(ws + WS_LRUW) + (size_t)((le * 2 + m) * 4 + g) * 4096, 64, nb * 32, 1.f, scr, lane); }
            continue; }
        { const int l = r / (4 * 32), kb = (r / 32) % 4, nb = r % 32;
            tr_item(kb < 2 ? a->in[I_WUKV] + (size_t)l * 128 * 1024 : nullptr, 1024, nb * 32, kb * 64, (bf16*)(ws + WS_WUKV) + (size_t)l * 1024 * 256, 256, nb * 32, 1.f, scr, lane); }
    }
}
__device__ __forceinline__ void phase_p0(ArgsP a, LAS unsigned char* lds) {
    const int tid = tid_(), G = grid_();
    unsigned char* ws = a->ws;
    { float* ROPE = (float*)(ws + WS_ROPE);
      for (int i = bid_() * NTHREADS + tid; i < 2048 * 16; i += G * NTHREADS) { float c, s; rope_angle(i >> 4, i & 15, c, s); ROPE[i * 2] = c; ROPE[i * 2 + 1] = s; } }
    float* MOD = (float*)(ws + WS_MOD);
    LAS float* SIL = (LAS float*)lds;
    for (int it = bid_(); it < 2 * 6 * 32; it += G) {
        const int l = it / 192, nb = (it / 32) % 6, kq = it % 32, col = nb * 512 + tid;
        __syncthreads();
        if (tid < 288) { const int j = tid >> 5, k = kq * 32 + (tid & 31); const float cj = (j == 0) ? a->in[I_CCTX][k] : a->in[I_C][(j - 1) * 1024 + k]; SIL[tid] = siluf_(cj); }
        float w[32];
#pragma unroll
        for (int kk = 0; kk < 32; ++kk) w[kk] = __builtin_nontemporal_load(&a->in[I_WMOD][((size_t)l * 1024 + kq * 32 + kk) * 3072 + col]);
        __syncthreads();
        const float bias = (kq == 0) ? a->in[I_BMOD][l * 3072 + col] : 0.f;
#pragma unroll
        for (int j = 0; j < 9; ++j) { float acc = bias;
#pragma unroll
            for (int k4 = 0; k4 < 8; ++k4) { const f32x4 sv = *(const LAS f32x4*)(SIL + j * 32 + k4 * 4); acc = fmaf(sv.x, w[k4 * 4], acc); acc = fmaf(sv.y, w[k4 * 4 + 1], acc); acc = fmaf(sv.z, w[k4 * 4 + 2], acc); acc = fmaf(sv.w, w[k4 * 4 + 3], acc); }
            atomicAdd(&MOD[(l * 9 + j) * 3072 + col], acc); }
    }
}

template <int LAYER> __device__ __forceinline__ void a0_rows(ArgsP a, LAS unsigned char* lds) {
    const int tid = tid_(), lane = tid & 63, wave = tid >> 6, G = grid_();
    bf16* U = (bf16*)a->out + 1024;
    LAS float* ML = (LAS float*)lds;
    { const float* MOD = (const float*)(a->ws + WS_MOD) + (size_t)LAYER * 9 * 3072;
      for (int i = tid; i < 9 * 512; i += NTHREADS) { const int r = i >> 9, c4 = (i & 511) * 4; *(LAS f32x4*)(ML + r * 2048 + c4) = *(const f32x4*)(MOD + r * 3072 + c4); } }
    f32x4 gq[4], bq[4];
#pragma unroll
    for (int j = 0; j < 4; ++j) { gq[j] = LAYER ? *(const f32x4*)(a->in[I_LNG] + lane * 4 + 256 * j) : (f32x4){0.f, 0.f, 0.f, 0.f}; bq[j] = LAYER ? *(const f32x4*)(a->in[I_LNB] + lane * 4 + 256 * j) : (f32x4){0.f, 0.f, 0.f, 0.f}; }
    __syncthreads();
    f32x4 ra[4], rb[4];
    auto load = [&](f32x4 (&r)[4], int nn) __attribute__((always_inline)) {
        if (LAYER == 0) { const float* xr = xrow_src(a, 0, nn);
#pragma unroll
            for (int j = 0; j < 4; ++j) r[j] = __builtin_nontemporal_load((const f32x4*)(xr + lane * 4 + 256 * j)); }
        else { const bf16* zr = (const bf16*)a->out + (size_t)nn * 2048;
#pragma unroll
            for (int j = 0; j < 4; ++j) { const v2u w = __builtin_nontemporal_load((const v2u*)(zr + lane * 4 + 256 * j)); r[j].x = __uint_as_float(w.x); r[j].y = __uint_as_float(w.y); } }
    };
    const int stride = G * 8, n0 = bid_() * 8 + wave;
    if (n0 < T) load(ra, n0);
    if (n0 + stride < T) load(rb, n0 + stride);
    auto row = [&](int n, f32x4 (&r)[4]) __attribute__((always_inline)) {
        const Tok tk = tok_of(n);
        f32x4 v[4]; float s = 0.f, s2 = 0.f;
#pragma unroll
        for (int j = 0; j < 4; ++j) {
            if (LAYER == 0) v[j] = r[j] * 1.f;
            else { const unsigned wx = __float_as_uint(r[j].x), wy = __float_as_uint(r[j].y); v[j] = (f32x4){bflo(wx), bfhi(wx), bflo(wy), bfhi(wy)}; }
            s += (v[j].x + v[j].y) + (v[j].z + v[j].w); s2 += (v[j].x * v[j].x + v[j].y * v[j].y) + (v[j].z * v[j].z + v[j].w * v[j].w); }
#pragma unroll
        for (int j = 0; j < 4; ++j) asm volatile("" : "+v"(v[j]));
        if (n + 2 * stride < T) load(r, n + 2 * stride);
        float mean = wave_sum(s) * (1.f / D);
        float rstd = rsqrt_(fmaxf(wave_sum(s2) * (1.f / D) - mean * mean, 0.f) + LN_EPS);
        if (LAYER == 1) {
            s = 0.f; s2 = 0.f;
#pragma unroll
            for (int j = 0; j < 4; ++j) { v[j] = (v[j] - mean) * rstd * gq[j] + bq[j]; s += (v[j].x + v[j].y) + (v[j].z + v[j].w); s2 += (v[j].x * v[j].x + v[j].y * v[j].y) + (v[j].z * v[j].z + v[j].w * v[j].w); }
            if (lane == 0) { float* st = (float*)(a->ws + WS_STATS) + (size_t)n * 2; st[0] = mean; st[1] = rstd; }
            mean = wave_sum(s) * (1.f / D);
            rstd = rsqrt_(fmaxf(wave_sum(s2) * (1.f / D) - mean * mean, 0.f) + LN_EPS);
        }
#pragma unroll
        for (int j = 0; j < 4; ++j) v[j] = v[j] - mean;
        const LAS float* m = ML + tk.modrow * 2048;
#pragma unroll
        for (int j = 0; j < 4; ++j) { const int c = lane * 4 + 256 * j; const f32x4 sh = *(const LAS f32x4*)(m + c), sc = *(const LAS f32x4*)(m + 1024 + c);
            const f32x4 o = v[j] * rstd * (sc + 1.f) + sh;
            v2u p; p.x = cvtpk(o.x, o.y); p.y = cvtpk(o.z, o.w); *(v2u*)(U + (size_t)n * YM_LD + c) = p; }
    };
    for (int n = n0; n < T; n += 2 * stride) { row(n, ra); if (n + stride < T) row(n + stride, rb); }
    __syncthreads();
}
__device__ __forceinline__ void phase_a0(ArgsP a, LAS unsigned char* lds, int layer) {
    const int tid = tid_(), lane = tid & 63, wave = tid >> 6;
    const int r = bid_() * 8 + wave; const bool has = r < 2048;
    const int b = r >> 8, j = r & 255; const size_t src = (size_t)(b * 2 + layer) * 256 + j;
    f32x4 c0 = {0.f, 0.f, 0.f, 0.f}, c1 = {0.f, 0.f, 0.f, 0.f};
    if (has && lane < 16) { c0 = *(const f32x4*)(a->in[I_CCKV] + src * 128 + lane * 8); c1 = *(const f32x4*)(a->in[I_CCKV] + src * 128 + lane * 8 + 4); }
    else if (has && lane >= 32 && lane < 36) { c0 = *(const f32x4*)(a->in[I_CKR] + src * 32 + (lane - 32) * 8); c1 = *(const f32x4*)(a->in[I_CKR] + src * 32 + (lane - 32) * 8 + 4); }
    if (layer == 0) a0_rows<0>(a, lds); else a0_rows<1>(a, lds);
    if (has) { bf16* KR = (bf16*)(a->ws + WS_KR); bf16* CK = (bf16*)(a->ws + WS_HF);
        const v4u w = (v4u){cvtpk(c0.x, c0.y), cvtpk(c0.z, c0.w), cvtpk(c1.x, c1.y), cvtpk(c1.z, c1.w)};
        if (lane < 32) *(v4u*)(CK + (size_t)r * 512 + lane * 8) = w;
        else if (lane < 36) *(v4u*)(KR + (size_t)(T_CTX + b * LK_LAT + j) * 32 + (lane - 32) * 8) = w; }
}
__device__ __forceinline__ void phase_final(ArgsP a) {
    const int tid = tid_(), lane = tid & 63, wave = tid >> 6, G = grid_();
    f32x4 gq[4], bq[4];
#pragma unroll
    for (int j = 0; j < 4; ++j) { gq[j] = *(const f32x4*)(a->in[I_LNG] + 1024 + lane * 4 + 256 * j); bq[j] = *(const f32x4*)(a->in[I_LNB] + 1024 + lane * 4 + 256 * j); }
    v2u ra[4], rb[4];
    auto load = [&](v2u (&r)[4], int nn) __attribute__((always_inline)) { const bf16* zr = (const bf16*)a->out + (size_t)nn * 2048;
#pragma unroll
        for (int j = 0; j < 4; ++j) r[j] = __builtin_nontemporal_load((const v2u*)(zr + lane * 4 + 256 * j)); };
    const int stride = G * 8, n0 = bid_() * 8 + wave;
    if (n0 < T) load(ra, n0);
    if (n0 + stride < T) load(rb, n0 + stride);
    auto row = [&](int n, v2u (&r)[4]) __attribute__((always_inline)) {
        float* xr = a->out + (size_t)n * D;
        f32x4 v[4]; float s = 0.f;
#pragma unroll
        for (int j = 0; j < 4; ++j) { v[j] = (f32x4){bflo(r[j].x), bfhi(r[j].x), bflo(r[j].y), bfhi(r[j].y)}; s += (v[j].x + v[j].y) + (v[j].z + v[j].w); }
#pragma unroll
        for (int j = 0; j < 4; ++j) asm volatile("" : "+v"(v[j]));
        if (n + 2 * stride < T) load(r, n + 2 * stride);
        const float mean = wave_sum(s) * (1.f / D); float s2 = 0.f;
#pragma unroll
        for (int j = 0; j < 4; ++j) { v[j] = v[j] - mean; s2 += (v[j].x * v[j].x + v[j].y * v[j].y) + (v[j].z * v[j].z + v[j].w * v[j].w); }
        const float rstd = rsqrt_(wave_sum(s2) * (1.f / D) + LN_EPS);
#pragma unroll
        for (int j = 0; j < 4; ++j) __builtin_nontemporal_store(v[j] * rstd * gq[j] + bq[j], (f32x4*)(xr + lane * 4 + 256 * j));
    };
    for (int n = n0; n < T; n += 2 * stride) { row(n, ra); if (n + stride < T) row(n + stride, rb); }
}


namespace pg8 {
#define PG8_LAS __attribute__((address_space(3)))
typedef unsigned short bf16_t;
typedef short bf16x8 __attribute__((ext_vector_type(8)));
typedef float f32x4 __attribute__((ext_vector_type(4)));
typedef unsigned u32x4 __attribute__((ext_vector_type(4)));
constexpr int BM = 256, BK = 64, HALF = 128, HTB = HALF * BK * 2  , STAGE_BYTES = 8 * HTB, NXCD = 8, WGM = 8;

__host__ __device__ __forceinline__ int lds_byte(int r, int c) { const int st = (r >> 4) * 2 + (c >> 5), rr = r & 15, cc = c & 31, ob = rr * 64 + cc * 2; return st * 1024 + (ob ^ (((ob >> 9) & 1) << 5)); }
__host__ __device__ __forceinline__ void stage_rc(int b, int& R, int& C) { const int st = b / 1024, sb = b % 1024, swz = sb ^ (((sb >> 9) & 1) << 5); R = (st >> 1) * 16 + swz / 64; C = (st & 1) * 32 + (swz % 64) / 2; }
__host__ __device__ __forceinline__ int perm32(int rho) { const int n = rho >> 4, i = rho & 15; return 8 * (i >> 2) + 4 * n + (i & 3); }

struct Unit { int pm, pn, gid; };
struct Gemm { const bf16_t* A; const bf16_t* Bt; int M, N, K, lda, ldb; };

struct StaticOrder {
    int nM, nN, nwg, G, c, lim;
    __host__ __device__ void init(int M, int N, int G_, int c_) { nM = M / BM; nN = N / BM; nwg = nM * nN; G = G_; c = c_; lim = nwg; }
    __host__ __device__ void tile(int L, Unit& u) const {
        int wgid = L; { const int q = nwg / NXCD, r = nwg % NXCD, xcd = wgid % NXCD, off = wgid / NXCD; wgid = (xcd < r ? xcd * (q + 1) : r * (q + 1) + (xcd - r) * q) + off; }
        const int nig = WGM * nN, gid = wgid / nig, fm = gid * WGM, gsz = (nM - fm) < WGM ? (nM - fm) : WGM;
        u.pm = fm + ((wgid % nig) % gsz); u.pn = (wgid % nig) / gsz; u.gid = 0;
    }
    __host__ __device__ bool next(int i, Unit& u) const { const long L = (long)i * G + c; if (L >= lim) return false; tile((int)L, u); return true; }
    __device__ __forceinline__ const char* abase(const Gemm& g, const Unit& u) const { return (const char*)g.A + (size_t)u.pm * BM * g.lda * 2; }
    __device__ __forceinline__ const char* bbase(const Gemm& g, const Unit& u) const { return (const char*)g.Bt + (size_t)u.pn * BM * g.ldb * 2; }
    __device__ __forceinline__ int ktiles(const Gemm& g, const Unit&) const { return g.K / BK; }
    __device__ __forceinline__ void a_ready(const Unit&) const {}
    __device__ __forceinline__ void done(const Unit&) const {}
};
struct HalfOrder {
    StaticOrder so; int first;
    __device__ __forceinline__ bool next(int i, Unit& u) const { const int h = i * so.G + so.c; if (h >= 2 * (so.nwg - first)) return false; so.tile(first + (h >> 1), u); u.pn = u.pn * 2 + (h & 1); return true; }
    __device__ __forceinline__ const char* abase(const Gemm& g, const Unit& u) const { return (const char*)g.A + (size_t)u.pm * BM * g.lda * 2; }
    __device__ __forceinline__ const char* bbase(const Gemm& g, const Unit& u) const { return (const char*)g.Bt + (size_t)u.pn * HALF * g.ldb * 2; }
    __device__ __forceinline__ int ktiles(const Gemm& g, const Unit&) const { return g.K / BK; }
    __device__ __forceinline__ void a_ready(const Unit&) const {}
    __device__ __forceinline__ void done(const Unit&) const {}
};
__host__ __device__ __forceinline__ int a1_perm(int pn) { return pn == 3 ? 5 : pn == 5 ? 3 : pn == 7 ? 10 : pn == 10 ? 7 : pn; }
struct A1Order {
    StaticOrder so; int one;
    __device__ __forceinline__ bool next(int i, Unit& u) const { if (one >= 0) { if (i > 0) return false; so.tile(one, u); } else if (!so.next(i, u)) return false; u.pn = a1_perm(u.pn); return true; }
    __device__ __forceinline__ const char* abase(const Gemm& g, const Unit& u) const { return (const char*)g.A + (size_t)u.pm * BM * g.lda * 2; }
    __device__ __forceinline__ const char* bbase(const Gemm& g, const Unit& u) const { return (const char*)g.Bt + (size_t)u.pn * BM * g.ldb * 2; }
    __device__ __forceinline__ int ktiles(const Gemm& g, const Unit&) const { return g.K / BK; }
    __device__ __forceinline__ void a_ready(const Unit&) const {}
    __device__ __forceinline__ void done(const Unit&) const {}
};
__device__ __forceinline__ unsigned cvt_pk_bf16(float lo, float hi) { unsigned r; asm volatile("v_cvt_pk_bf16_f32 %0, %1, %2" : "=v"(r) : "v"(lo), "v"(hi)); return r; }

template <class Epi, class Sched, bool STAMP = false, int NB = 2>
__device__ __forceinline__ void gemm_phase(PG8_LAS unsigned char* lds, const Gemm g, const Sched& S, const Epi& E, unsigned long long* stamps) {
    const int tid = tid_(), wid = __builtin_amdgcn_readfirstlane(tid >> 6), lane = tid & 63, wr = wid >> 2, wc = wid & 3, fr = lane & 15, fq = lane >> 4;
    int nt;
    int ts_lo = 0, ts_hi = 0, nts = 0; const unsigned long long rt_entry = STAMP ? (unsigned long long)wall_clock64() : 0ull;
#define PG8_STAMP() do { if (STAMP && wid == 0 && nts < 64) { const unsigned long long _c = (unsigned long long)clock64(); \
        ts_lo = (lane == nts) ? (int)(unsigned)_c : ts_lo; ts_hi = (lane == nts) ? (int)(unsigned)(_c >> 32) : ts_hi; ++nts; } } while (0)
    PG8_STAMP();
    unsigned voffA[2], voffB[2];
#pragma unroll
    for (int i = 0; i < 2; ++i) { int R, C; stage_rc(tid * 16 + i * 8192, R, C); const int Rb = Epi::PERM ? ((R & ~31) + perm32(R & 31)) : R;
        voffA[i] = (unsigned)(R * g.lda + C) * 2u; voffB[i] = (unsigned)(Rb * g.ldb + C) * 2u; }
    const size_t kstep = (size_t)(BK * 2);
    const size_t hstepA = (size_t)HALF * g.lda * 2, hstepB = (size_t)HALF * g.ldb * 2;
    const unsigned ldsw = (unsigned)wid * 1024u;
    const int aoff = lds_byte(wr * 64 + fr, fq * 8), boff = lds_byte(wc * 32 + fr, fq * 8);
#define PG8_SA(b, h) (((b) * 2 + (h)) * HTB)
#define PG8_SB(b, h) ((4 + (b) * 2 + (h)) * HTB)
#define PG8_STAGE(bufoff, gbase, voff) do { _Pragma("unroll") for (int _i = 0; _i < 2; ++_i) \
        __builtin_amdgcn_global_load_lds((const unsigned*)((const char*)(gbase) + (voff)[_i]), (PG8_LAS unsigned*)(lds + (bufoff) + ldsw + _i * 8192), 16, 0, 0); } while (0)
#define PG8_LDA(dst, b, h) do { _Pragma("unroll") for (int m = 0; m < 4; ++m) _Pragma("unroll") for (int k = 0; k < 2; ++k) dst[m][k] = *(const PG8_LAS bf16x8*)(lds + PG8_SA(b, h) + aoff + m * 2048 + k * 1024); } while (0)
#define PG8_LDB(dst, b, h) do { _Pragma("unroll") for (int n = 0; n < 2; ++n) _Pragma("unroll") for (int k = 0; k < 2; ++k) dst[n][k] = *(const PG8_LAS bf16x8*)(lds + PG8_SB(b, h) + boff + n * 2048 + k * 1024); } while (0)
#define PG8_MMA(ai, bj, At, Bt) do { __builtin_amdgcn_s_setprio(1); _Pragma("unroll") for (int m = 0; m < 4; ++m) _Pragma("unroll") for (int n = 0; n < 2; ++n) _Pragma("unroll") for (int k = 0; k < 2; ++k) \
        acc[ai][bj][m][n] = __builtin_amdgcn_mfma_f32_16x16x32_bf16(Bt[n][k], At[m][k], acc[ai][bj][m][n], 0, 0, 0); __builtin_amdgcn_s_setprio(0); } while (0)
#define PG8_WAIT_V(n) asm volatile("s_waitcnt vmcnt(" #n ")" ::: "memory")
#define PG8_WAIT_L(n) asm volatile("s_waitcnt lgkmcnt(" #n ")" ::: "memory")
#define PG8_BAR __builtin_amdgcn_s_barrier()
#define PG8_SCHED __builtin_amdgcn_sched_barrier(0)
    Unit cur, nxt; int ui = 0;
    if (!S.next(0, cur)) return;
    f32x4 acc[2][2][4][2];
#pragma unroll
    for (int a = 0; a < 2; ++a)
#pragma unroll
        for (int b = 0; b < 2; ++b)
#pragma unroll
            for (int m = 0; m < 4; ++m)
#pragma unroll
                for (int n = 0; n < 2; ++n) acc[a][b][m][n] = (f32x4){0.f, 0.f, 0.f, 0.f};
    bf16x8 At[4][2], B0[2][2], B1[2][2];
    const char* cA = S.abase(g, cur); const char* cB = S.bbase(g, cur);
    nt = S.ktiles(g, cur);
    S.a_ready(cur);
    PG8_STAGE(PG8_SB(0, 0), cB, voffB); PG8_STAGE(PG8_SA(0, 0), cA, voffA); if constexpr (NB == 2) PG8_STAGE(PG8_SB(0, 1), cB + hstepB, voffB); PG8_STAGE(PG8_SA(0, 1), cA + hstepA, voffA);
    if (wr == 1) PG8_BAR;
    if constexpr (NB == 2) PG8_WAIT_V(4); else PG8_WAIT_V(2);
    PG8_BAR;
    PG8_STAGE(PG8_SB(1, 0), cB + kstep, voffB); PG8_STAGE(PG8_SA(1, 0), cA + kstep, voffA); if constexpr (NB == 2) PG8_STAGE(PG8_SB(1, 1), cB + hstepB + kstep, voffB);
    if constexpr (NB == 2) PG8_WAIT_V(6); else PG8_WAIT_V(4);
    PG8_BAR;
    PG8_STAMP();
    for (;;) {
        const bool has_next = S.next(ui + 1, nxt);
        const char* nA = has_next ? S.abase(g, nxt) : cA; const char* nB = has_next ? S.bbase(g, nxt) : cB;
        for (int t = 0; t < nt; t += 2) {
            const bool last = (t == nt - 2);
            const char* a1 = cA + (size_t)(t + 1) * kstep;
            const char* a2 = last ? nA : cA + (size_t)(t + 2) * kstep; const char* b2 = last ? nB : cB + (size_t)(t + 2) * kstep;
            const char* a3 = a2 + kstep; const char* b3 = b2 + kstep;
            if (last && has_next) S.a_ready(nxt);
            PG8_LDB(B0, 0, 0); PG8_SCHED; PG8_LDA(At, 0, 0); PG8_STAGE(PG8_SA(1, 1), a1 + hstepA, voffA);
            PG8_WAIT_L(8); PG8_BAR; PG8_WAIT_L(0); PG8_MMA(0, 0, At, B0); PG8_BAR; PG8_SCHED;
            if constexpr (NB == 2) PG8_LDB(B1, 0, 1); PG8_STAGE(PG8_SB(0, 0), b2, voffB);
            PG8_BAR; PG8_WAIT_L(0); if constexpr (NB == 2) PG8_MMA(0, 1, At, B1); PG8_BAR;
            PG8_LDA(At, 0, 1); PG8_STAGE(PG8_SA(0, 0), a2, voffA);
            PG8_BAR; PG8_WAIT_L(0); PG8_MMA(1, 0, At, B0); PG8_BAR; PG8_SCHED;
            if constexpr (NB == 2) PG8_STAGE(PG8_SB(0, 1), b2 + hstepB, voffB);
            if constexpr (NB == 2) PG8_WAIT_V(6); else PG8_WAIT_V(4);
            PG8_BAR; if constexpr (NB == 2) PG8_MMA(1, 1, At, B1); PG8_BAR;
            PG8_LDB(B0, 1, 0); PG8_SCHED; PG8_LDA(At, 1, 0); PG8_STAGE(PG8_SA(0, 1), a2 + hstepA, voffA);
            PG8_WAIT_L(8); PG8_BAR; PG8_WAIT_L(0); PG8_MMA(0, 0, At, B0); PG8_BAR; PG8_SCHED;
            if constexpr (NB == 2) PG8_LDB(B1, 1, 1); PG8_STAGE(PG8_SB(1, 0), b3, voffB);
            PG8_BAR; PG8_WAIT_L(0); if constexpr (NB == 2) PG8_MMA(0, 1, At, B1); PG8_BAR;
            PG8_LDA(At, 1, 1); PG8_STAGE(PG8_SA(1, 0), a3, voffA);
            PG8_BAR; PG8_WAIT_L(0); PG8_MMA(1, 0, At, B0); PG8_BAR; PG8_SCHED;
            if constexpr (NB == 2) PG8_STAGE(PG8_SB(1, 1), b3 + hstepB, voffB);
            if constexpr (NB == 2) PG8_WAIT_V(6); else PG8_WAIT_V(4);
            PG8_BAR; if constexpr (NB == 2) PG8_MMA(1, 1, At, B1); PG8_BAR;
        }
        PG8_STAMP();
        if constexpr (!Epi::AFTER_DRAIN) { E(acc, cur, wr, wc, fr, fq); S.done(cur); }
        PG8_STAMP();
        if (!has_next) break;
#pragma unroll
        for (int a = 0; a < 2; ++a)
#pragma unroll
            for (int b = 0; b < 2; ++b)
#pragma unroll
                for (int m = 0; m < 4; ++m)
#pragma unroll
                    for (int n = 0; n < 2; ++n) acc[a][b][m][n] = (f32x4){0.f, 0.f, 0.f, 0.f};
        cur = nxt; cA = nA; cB = nB; ++ui; nt = S.ktiles(g, cur);
    }
    PG8_WAIT_V(0);
    if (wr == 0) PG8_BAR;
    PG8_BAR;
    if constexpr (Epi::AFTER_DRAIN) { E.fused(acc, cur, wr, wc, fr, fq, lds, wid, lane); S.done(cur); }
    PG8_STAMP();
    if (STAMP && wid == 0) { stamps[lane] = lane < nts ? (((unsigned long long)(unsigned)ts_hi << 32) | (unsigned)ts_lo) : 0ull;
        if (lane == 62) stamps[62] = rt_entry; if (lane == 63) stamps[63] = (unsigned long long)wall_clock64(); }
#undef PG8_STAMP
#undef PG8_SA
#undef PG8_SB
#undef PG8_STAGE
#undef PG8_LDA
#undef PG8_LDB
#undef PG8_MMA
#undef PG8_WAIT_V
#undef PG8_WAIT_L
#undef PG8_BAR
#undef PG8_SCHED
}
}
namespace pg8 {
struct EpiIn {
    static constexpr bool PERM = true, AFTER_DRAIN = false;
    bf16_t* G1; bf16_t* G2; bf16_t* KR; float* out; const float* rope; const float* qnw; const float* kvnw; PG8_LAS float* red; int layer;
    __device__ __forceinline__ void operator()(const f32x4 (&acc)[2][2][4][2], const Unit& u, int wr, int wc, int fr, int fq) const {
        const int row0 = u.pm * BM + wr * 64 + fr;
        if (u.pn < 9) {
            const int col0 = u.pn * 256 + wc * 32 + 8 * fq;
#pragma unroll
            for (int ai = 0; ai < 2; ++ai)
#pragma unroll
                for (int m = 0; m < 4; ++m) { bf16_t* rowp = G1 + (size_t)(row0 + ai * HALF + m * 16) * 2304 + col0;
#pragma unroll
                    for (int bj = 0; bj < 2; ++bj) { const f32x4 v0 = acc[ai][bj][m][0], v1 = acc[ai][bj][m][1];
                        u32x4 w; w.x = cvt_pk_bf16(v0[0], v0[1]); w.y = cvt_pk_bf16(v0[2], v0[3]); w.z = cvt_pk_bf16(v1[0], v1[1]); w.w = cvt_pk_bf16(v1[2], v1[3]);
                        *(u32x4*)(rowp + bj * HALF) = w; } }
            return;
        }
        const bool cqt = u.pn == 9, lat = u.pm * BM >= 8192;
        const int cb = wc * 32 + 8 * fq;
        const int rl0 = wr * 64 + fr;
#pragma unroll
        for (int am = 0; am < 8; ++am) { const int ai = am >> 2, m = am & 3;
            const f32x4 a0 = acc[ai][0][m][0], a1 = acc[ai][0][m][1], b0 = acc[ai][1][m][0], b1 = acc[ai][1][m][1];
            float s = (a0[0] * a0[0] + a0[1] * a0[1]) + (a0[2] * a0[2] + a0[3] * a0[3]) + (a1[0] * a1[0] + a1[1] * a1[1]) + (a1[2] * a1[2] + a1[3] * a1[3]);
            if (cqt) s += (b0[0] * b0[0] + b0[1] * b0[1]) + (b0[2] * b0[2] + b0[3] * b0[3]) + (b1[0] * b1[0] + b1[1] * b1[1]) + (b1[2] * b1[2] + b1[3] * b1[3]);
            s += __shfl_xor(s, 16); s += __shfl_xor(s, 32);
            if (fq == 0) red[(rl0 + ai * HALF + m * 16) * 4 + wc] = s; }
        asm volatile("s_waitcnt lgkmcnt(0)" ::: "memory"); __builtin_amdgcn_s_barrier();
        f32x4 nw[2][2];
#pragma unroll
        for (int n = 0; n < 2; ++n) { nw[0][n] = cqt ? *(const f32x4*)(qnw + layer * 256 + cb + n * 4) : *(const f32x4*)(kvnw + layer * 128 + cb + n * 4);
            nw[1][n] = cqt ? *(const f32x4*)(qnw + layer * 256 + HALF + cb + n * 4) : (f32x4){1.f, 1.f, 1.f, 1.f}; }
        const bool krl = !cqt && wc == 0;
        f32x4 rc[3][2];
#define EI_LOAD(set_, am_) do { const int n_ = row0 + ((am_) >> 2) * HALF + ((am_) & 3) * 16; const float* rp_ = rope + (unsigned)(((n_ - 8192) & 2047) * 32) + 8 * fq; \
            rc[set_][0] = *(const f32x4*)rp_; rc[set_][1] = *(const f32x4*)(rp_ + 4); } while (0)
        if (krl && lat) { EI_LOAD(0, 0); EI_LOAD(1, 1); EI_LOAD(2, 2); }
#pragma unroll
        for (int am = 0; am < 8; ++am) { const int ai = am >> 2, m = am & 3, n = row0 + ai * HALF + m * 16, set = am % 3;
            const f32x4 pt = *(const PG8_LAS f32x4*)(red + (rl0 + ai * HALF + m * 16) * 4);
            const float rs = __builtin_amdgcn_rsqf(((pt[0] + pt[1]) + (pt[2] + pt[3])) * (cqt ? 1.f / 256.f : 1.f / 128.f) + 1e-6f);
            f32x4 y0 = acc[ai][0][m][0] * rs * nw[0][0], y1 = acc[ai][0][m][1] * rs * nw[0][1];
            f32x4 z0 = acc[ai][1][m][0], z1 = acc[ai][1][m][1];
            if (cqt) { z0 = z0 * rs * nw[1][0]; z1 = z1 * rs * nw[1][1]; }
            u32x4 w0, w1; w0.x = cvt_pk_bf16(y0[0], y0[1]); w0.y = cvt_pk_bf16(y0[2], y0[3]); w0.z = cvt_pk_bf16(y1[0], y1[1]); w0.w = cvt_pk_bf16(y1[2], y1[3]);
            w1.x = cvt_pk_bf16(z0[0], z0[1]); w1.y = cvt_pk_bf16(z0[2], z0[3]); w1.z = cvt_pk_bf16(z1[0], z1[1]); w1.w = cvt_pk_bf16(z1[2], z1[3]);
            u32x4 wk = w1;
            if (krl && lat) { const f32x4 c0 = rc[set][0], c1 = rc[set][1];
                const float r0 = z0[0] * c0[0] - z0[1] * c0[1], r1 = z0[0] * c0[1] + z0[1] * c0[0], r2 = z0[2] * c0[2] - z0[3] * c0[3], r3 = z0[2] * c0[3] + z0[3] * c0[2];
                const float r4 = z1[0] * c1[0] - z1[1] * c1[1], r5 = z1[0] * c1[1] + z1[1] * c1[0], r6 = z1[2] * c1[2] - z1[3] * c1[3], r7 = z1[2] * c1[3] + z1[3] * c1[2];
                wk.x = cvt_pk_bf16(r0, r1); wk.y = cvt_pk_bf16(r2, r3); wk.z = cvt_pk_bf16(r4, r5); wk.w = cvt_pk_bf16(r6, r7); }
            if (krl && lat && am + 3 < 8) { if (set == 0) EI_LOAD(0, am + 3); else if (set == 1) EI_LOAD(1, am + 3); else EI_LOAD(2, am + 3); }
            bf16_t* rowp = G2 + (size_t)n * 512 + (cqt ? 0 : 256) + cb;
            *(u32x4*)rowp = w0; *(u32x4*)(rowp + HALF) = w1;
            if (!cqt) {
                int kidx, bt;
                if (!lat) { kidx = n; bt = ((n >> 8) * 2 + layer) * 256 + (n & 255); } else { const int mrow = n - 8192; kidx = 8192 + (mrow >> 11) * 2304 + 256 + (mrow & 2047); bt = 0; }
                if (!lat) { float* op = out + O_CKV + (size_t)bt * 128 + cb; *(f32x4*)op = y0; *(f32x4*)(op + 4) = y1; }
                if (krl) { if (!lat) { float* op = out + O_KR + (size_t)bt * 32 + 8 * fq; *(f32x4*)op = z0; *(f32x4*)(op + 4) = z1; }
                    *(u32x4*)(KR + (size_t)kidx * 32 + 8 * fq) = wk; }
            }
        }
#undef EI_LOAD
    }
};
template <int NB> struct EpiOutT {
    static constexpr bool PERM = true, AFTER_DRAIN = false;
    const float* xp; const float* xs; float* out; const float* mod; int layer;
    const float* stats; const float* lng; const float* lnb;
    __device__ __forceinline__ void operator()(const f32x4 (&acc)[2][2][4][2], const Unit& u, int wr, int wc, int fr, int fq) const {
        const int row0 = u.pm * BM + wr * 64 + fr, col0 = u.pn * (NB == 2 ? BM : HALF) + wc * 32 + 8 * fq;
        const int rt = u.pm * BM; const int modrow = rt < 8192 ? 0 : 1 + ((rt - 8192) >> 11);
        const float* gp = mod + (size_t)modrow * 3072 + 2048 + col0;
        f32x4 gv[2][2];
#pragma unroll
        for (int bj = 0; bj < NB; ++bj)
#pragma unroll
            for (int n = 0; n < 2; ++n) gv[bj][n] = *(const f32x4*)(gp + bj * HALF + n * 4);
        f32x4 lg[2][2], lb[2][2];
        if (layer) {
#pragma unroll
            for (int bj = 0; bj < NB; ++bj)
#pragma unroll
                for (int n = 0; n < 2; ++n) { lg[bj][n] = *(const f32x4*)(lng + col0 + bj * HALF + n * 4); lb[bj][n] = *(const f32x4*)(lnb + col0 + bj * HALF + n * 4); }
        }
        f32x4 raw[2][4];
#define EO_LOAD(set_, am_) do { const int row_ = row0 + ((am_) >> 2) * HALF + ((am_) & 3) * 16; \
            if (layer == 0) { const float* xr_ = (row_ < 8192 ? xp + (size_t)row_ * 1024 : xs + (size_t)(row_ - 8192) * 1024) + col0; \
                raw[set_][0] = __builtin_nontemporal_load((const f32x4*)(xr_)); raw[set_][1] = __builtin_nontemporal_load((const f32x4*)(xr_ + 4)); if (NB == 2) { raw[set_][2] = __builtin_nontemporal_load((const f32x4*)(xr_ + HALF)); raw[set_][3] = __builtin_nontemporal_load((const f32x4*)(xr_ + HALF + 4)); } } \
            else { const bf16_t* zr_ = (const bf16_t*)out + (size_t)row_ * 2048 + col0; raw[set_][0] = __builtin_nontemporal_load((const f32x4*)zr_); if (NB == 2) raw[set_][1] = __builtin_nontemporal_load((const f32x4*)(zr_ + HALF)); \
                const f32x2_t st_ = *(const f32x2_t*)(stats + (size_t)row_ * 2); raw[set_][2].x = st_.x; raw[set_][2].y = st_.y; } } while (0)
        EO_LOAD(0, 0); EO_LOAD(1, 1);
#pragma unroll
        for (int am = 0; am < 8; ++am) { const int ai = am >> 2, m = am & 3, row = row0 + ai * HALF + m * 16, set = am & 1;
            float mean = 0.f, rstd = 1.f; if (layer) { mean = raw[set][2].x; rstd = raw[set][2].y; }
            u32x4 w[2];
#pragma unroll
            for (int bj = 0; bj < NB; ++bj) { f32x4 z[2];
#pragma unroll
                for (int n = 0; n < 2; ++n) { f32x4 x;
                    if (layer == 0) x = raw[set][bj * 2 + n];
                    else { const unsigned lo = __float_as_uint(n ? raw[set][bj].z : raw[set][bj].x), hi = __float_as_uint(n ? raw[set][bj].w : raw[set][bj].y);
                        x = (f32x4){__uint_as_float(lo << 16), __uint_as_float(lo & 0xffff0000u), __uint_as_float(hi << 16), __uint_as_float(hi & 0xffff0000u)};
                        x = (x - mean) * rstd * lg[bj][n] + lb[bj][n]; }
                    z[n] = x * 1.4142135623730951f + gv[bj][n] * acc[ai][bj][m][n]; }
                w[bj].x = cvt_pk_bf16(z[0][0], z[0][1]); w[bj].y = cvt_pk_bf16(z[0][2], z[0][3]); w[bj].z = cvt_pk_bf16(z[1][0], z[1][1]); w[bj].w = cvt_pk_bf16(z[1][2], z[1][3]); }
            if (am + 2 < 8) { if (set == 0) EO_LOAD(0, am + 2); else EO_LOAD(1, am + 2); }
            bf16_t* orow = (bf16_t*)out + (size_t)row * 2048 + col0;
            *(u32x4*)(orow) = w[0]; if (NB == 2) *(u32x4*)(orow + HALF) = w[1]; }
#undef EO_LOAD
    }
};
typedef EpiOutT<2> EpiOut;
}

__device__ __forceinline__ void phase_a1_pg8(ArgsP a, LAS unsigned char* lds, int layer) {
    pg8::Gemm g{(const bf16*)a->out + 1024, (const bf16*)(a->ws + WS_WIN) + (size_t)layer * NIN * 1024, T, NIN, 1024, YM_LD, 1024};
    pg8::StaticOrder S; S.init(T, NIN, grid_(), bid_());
    const bool defer = S.G == 256 && S.nwg == 1056;
    if (defer) S.lim = 1024;
    pg8::A1Order O{S, -1};
    pg8::EpiIn E{(bf16*)(a->ws + WS_G1), (bf16*)(a->ws + WS_G2), (bf16*)(a->ws + WS_KR), a->out, (const float*)(a->ws + WS_ROPE), a->in[I_QNORM], a->in[I_KVNORM], (LAS float*)(lds + LDS_MISC + 2048), layer};
    pg8::gemm_phase<pg8::EpiIn, pg8::A1Order, false>(lds, g, O, E, nullptr);
    if (layer == 0) { __syncthreads(); phase_p0_weights(a, lds, 3840, 4288, 0);
        if (!defer) { phase_p0_weights(a, lds, 1408, 3840, 0); phase_p0_weights(a, lds, 4288, 1 << 30, 0); } }
}
__device__ __forceinline__ void phase_c2_pg8(ArgsP a, LAS unsigned char* lds, int layer) {
    pg8::Gemm g{(const bf16*)a->out + 1024, (const bf16*)(a->ws + WS_WOUT) + (size_t)layer * 1024 * 1024, T, 1024, 1024, YM_LD, 1024};
    pg8::StaticOrder S; S.init(T, 1024, grid_(), bid_());
    const int whole = (S.nwg / S.G) * S.G;
    S.lim = whole;
    const int flip = (whole < S.nwg) ? (bid_() & 1) : 0;
#pragma unroll 1
    for (int it = 0; it < 2; ++it) {
        if ((it ^ flip) == 0) { pg8::EpiOut E{a->in[I_XP], a->in[I_XS], a->out, (const float*)(a->ws + WS_MOD) + (size_t)layer * 9 * 3072, layer, (const float*)(a->ws + WS_STATS), a->in[I_LNG], a->in[I_LNB]};
            pg8::gemm_phase<pg8::EpiOut, pg8::StaticOrder, false>(lds, g, S, E, nullptr); }
        else if (whole < S.nwg) { pg8::HalfOrder H{S, whole};
            pg8::EpiOutT<1> E{a->in[I_XP], a->in[I_XS], a->out, (const float*)(a->ws + WS_MOD) + (size_t)layer * 9 * 3072, layer, (const float*)(a->ws + WS_STATS), a->in[I_LNG], a->in[I_LNB]};
            pg8::gemm_phase<pg8::EpiOutT<1>, pg8::HalfOrder, false, 1>(lds, g, H, E, nullptr); }
    }
}

__device__ __forceinline__ void phase_cache_rows(ArgsP a, int layer) {
    const int tid = tid_(), lane = tid & 63, wave = tid >> 6, G = grid_();
    bf16* KR = (bf16*)(a->ws + WS_KR); bf16* CK = (bf16*)(a->ws + WS_HF);
    for (int r = bid_() * 8 + wave + G * 8; r < 2048; r += G * 8) {
        const int b = r >> 8, j = r & 255; const size_t src = (size_t)(b * 2 + layer) * 256 + j;
        if (lane < 16) { const f32x4 v0 = *(const f32x4*)(a->in[I_CCKV] + src * 128 + lane * 8), v1 = *(const f32x4*)(a->in[I_CCKV] + src * 128 + lane * 8 + 4);
            *(v4u*)(CK + (size_t)r * 512 + lane * 8) = (v4u){cvtpk(v0.x, v0.y), cvtpk(v0.z, v0.w), cvtpk(v1.x, v1.y), cvtpk(v1.z, v1.w)}; }
        else if (lane < 32) *(v4u*)(CK + (size_t)r * 512 + lane * 8) = (v4u){0u, 0u, 0u, 0u};
        else if (lane < 36) { const f32x4 v0 = *(const f32x4*)(a->in[I_CKR] + src * 32 + (lane - 32) * 8), v1 = *(const f32x4*)(a->in[I_CKR] + src * 32 + (lane - 32) * 8 + 4);
            *(v4u*)(KR + (size_t)(T_CTX + b * LK_LAT + j) * 32 + (lane - 32) * 8) = (v4u){cvtpk(v0.x, v0.y), cvtpk(v0.z, v0.w), cvtpk(v1.x, v1.y), cvtpk(v1.z, v1.w)}; }
    }
}
namespace pg8 {
struct A2Order {
    const char* ws; unsigned oq, okv; int G, c, nmain;
    __device__ __forceinline__ bool next(int i, Unit& u) const {
        int L; if (c < nmain) { L = i * nmain + c; if (L >= (nmain == G ? 704 : 672)) return false; } else { if (i > 0) return false; L = 672 + (c - nmain); if (L >= 704) return false; }
        if (L < 288) { u.gid = 0; u.pm = L / 3; u.pn = L % 3; } else if (L < 672) { u.gid = 1; u.pm = (L - 288) >> 2; u.pn = (L - 288) & 3; } else { u.gid = 2; u.pm = (L - 672) >> 2; u.pn = (L - 672) & 3; }
        return true;
    }
    __device__ __forceinline__ const char* abase(const Gemm&, const Unit& u) const { const unsigned off = u.gid == 0 ? (unsigned)WS_G2 : (u.gid == 1 ? (unsigned)WS_G2 + 512u : (unsigned)WS_HF); return ws + off + (size_t)u.pm * 256 * 512 * 2; }
    __device__ __forceinline__ const char* bbase(const Gemm&, const Unit& u) const { const unsigned off = u.gid == 0 ? oq : okv; return ws + off + (size_t)u.pn * 256 * 256 * 2; }
    __device__ __forceinline__ int ktiles(const Gemm& g, const Unit& u) const { return u.gid == 0 ? g.K / BK : g.K / (2 * BK); }
    __device__ __forceinline__ void a_ready(const Unit&) const {}
    __device__ __forceinline__ void done(const Unit&) const {}
};
struct EpiA2 {
    static constexpr bool PERM = true, AFTER_DRAIN = false;
    bf16_t* Q; bf16_t* KN; bf16_t* VR; const float* rope;
    __device__ __forceinline__ void operator()(const f32x4 (&acc)[2][2][4][2], const Unit& u, int wr, int wc, int fr, int fq) const {
        const int row0 = u.pm * BM + wr * 64 + fr;
        if (u.gid == 0) {
            const int fb = u.pn * 256 + wc * 32 + 8 * fq;
            const int d0 = fb % 96, rsel = d0 >= 64 ? 0 : (d0 >= 32 ? 1 : 2), dd = rsel == 0 ? d0 - 64 : (rsel == 1 ? d0 - 32 : 0);
            const bool lat_tile = u.pm * BM >= 8192;
            f32x4 rc[3][2];
#define EA_LOAD(set_, am_) do { const int row_ = row0 + ((am_) >> 2) * HALF + ((am_) & 3) * 16; const float* rp_ = rope + (unsigned)(((row_ - 8192) & 2047) * 32) + dd; \
                rc[set_][0] = *(const f32x4*)rp_; rc[set_][1] = *(const f32x4*)(rp_ + 4); } while (0)
            if (lat_tile) { EA_LOAD(0, 0); EA_LOAD(1, 1); EA_LOAD(2, 2); }
#pragma unroll
            for (int am = 0; am < 8; ++am) { const int ai = am >> 2, m = am & 3, row = row0 + ai * HALF + m * 16, set = am % 3;
                u32x4 w[2];
#pragma unroll
                for (int bj = 0; bj < 2; ++bj) {
                    f32x4 v0 = acc[ai][bj][m][0], v1 = acc[ai][bj][m][1];
                    if (lat_tile && bj == rsel) { const f32x4 c0 = rc[set][0], c1 = rc[set][1];
                        const f32x4 a0 = v0, a1 = v1;
                        v0[0] = a0[0] * c0[0] - a0[1] * c0[1]; v0[1] = a0[0] * c0[1] + a0[1] * c0[0]; v0[2] = a0[2] * c0[2] - a0[3] * c0[3]; v0[3] = a0[2] * c0[3] + a0[3] * c0[2];
                        v1[0] = a1[0] * c1[0] - a1[1] * c1[1]; v1[1] = a1[0] * c1[1] + a1[1] * c1[0]; v1[2] = a1[2] * c1[2] - a1[3] * c1[3]; v1[3] = a1[2] * c1[3] + a1[3] * c1[2]; }
                    w[bj].x = cvt_pk_bf16(v0[0], v0[1]); w[bj].y = cvt_pk_bf16(v0[2], v0[3]); w[bj].z = cvt_pk_bf16(v1[0], v1[1]); w[bj].w = cvt_pk_bf16(v1[2], v1[3]); }
                if (lat_tile && am + 3 < 8) { if (set == 0) EA_LOAD(0, am + 3); else if (set == 1) EA_LOAD(1, am + 3); else EA_LOAD(2, am + 3); }
                *(u32x4*)(Q + (unsigned)(row * 768 + fb)) = w[0]; *(u32x4*)(Q + (unsigned)(row * 768 + fb + HALF)) = w[1]; }
#undef EA_LOAD
        } else {
            const int x = wc * 32 + 8 * fq;
            bf16_t* base = (wc < 2 ? KN : VR);
            const unsigned xo = (unsigned)(x & 63);
#pragma unroll
            for (int ai = 0; ai < 2; ++ai)
#pragma unroll
                for (int m = 0; m < 4; ++m) { const int row = row0 + ai * HALF + m * 16;
                    int kidx;
                    if (u.gid == 2) kidx = 8192 + (row >> 8) * 2304 + (row & 255);
                    else if (row < 8192) kidx = row;
                    else { const int mrow = row - 8192; kidx = 8192 + (mrow >> 11) * 2304 + 256 + (mrow & 2047); }
#pragma unroll
                    for (int bj = 0; bj < 2; ++bj) { const f32x4 v0 = acc[ai][bj][m][0], v1 = acc[ai][bj][m][1];
                        u32x4 w; w.x = cvt_pk_bf16(v0[0], v0[1]); w.y = cvt_pk_bf16(v0[2], v0[3]); w.z = cvt_pk_bf16(v1[0], v1[1]); w.w = cvt_pk_bf16(v1[2], v1[3]);
                        *(u32x4*)(base + (unsigned)(kidx * 512 + (u.pn * 2 + bj) * 64) + xo) = w; } }
        }
    }
};
}
__device__ __forceinline__ void phase_a2b(ArgsP a, LAS unsigned char* lds, int layer) {
    const int G = grid_(), c = bid_(); const bool defer = G == 256;
    if (defer && c >= G - 32) {
        pg8::Gemm g1{(const bf16*)a->out + 1024, (const bf16*)(a->ws + WS_WIN) + (size_t)layer * NIN * 1024, T, NIN, 1024, YM_LD, 1024};
        pg8::StaticOrder S1; S1.init(T, NIN, G, c);
        pg8::A1Order O{S1, 1024 + (c - (G - 32))};
        pg8::EpiIn E1{(bf16*)(a->ws + WS_G1), (bf16*)(a->ws + WS_G2), (bf16*)(a->ws + WS_KR), a->out, (const float*)(a->ws + WS_ROPE), a->in[I_QNORM], a->in[I_KVNORM], (LAS float*)(lds + LDS_MISC + 2048), layer};
        pg8::gemm_phase<pg8::EpiIn, pg8::A1Order, false>(lds, g1, O, E1, nullptr);
    }
    int kk = 256; asm volatile("" : "+s"(kk));
    pg8::Gemm g{nullptr, nullptr, T, 1024, kk, 512, 256};
    pg8::A2Order S{(const char*)a->ws, (unsigned)(WS_WUQ + (size_t)layer * 768 * 256 * 2), (unsigned)(WS_WUKV + (size_t)layer * 1024 * 256 * 2), G, c, defer ? G - 32 : G};
    pg8::EpiA2 E{(bf16*)(a->ws + WS_Q), (bf16*)(a->ws + WS_KN), (bf16*)(a->ws + WS_VT), (const float*)(a->ws + WS_ROPE)};
    pg8::gemm_phase<pg8::EpiA2, pg8::A2Order, false>(lds, g, S, E, nullptr);
    if (defer && layer == 0) { __syncthreads(); phase_p0_weights(a, lds, 1408, 3840, 0, G - 32); phase_p0_weights(a, lds, 4288, 1 << 30, 0, G - 32); }
}


__device__ __forceinline__ void phase_c1(ArgsP a, int layer) {
    const int tid = tid_(), lane = tid & 63, wave = tid >> 6, G = grid_();
    const bf16* G1 = (const bf16*)(a->ws + WS_G1); const bf16* YS = (const bf16*)(a->ws + WS_G2); const bf16* HF = (const bf16*)(a->ws + WS_HF);
    bf16* Y = (bf16*)a->out + 1024;
    const int ch = lane * 4;
    const f32x4 rk = *(const f32x4*)(a->in[I_RK] + layer * 256 + ch), lg = *(const f32x4*)(a->in[I_LNXG] + layer * 256 + ch), lb = *(const f32x4*)(a->in[I_LNXB] + layer * 256 + ch);
    v2u p_y0, p_y1, p_r, p_k, p_v, p_g, p_h, p_hb, p_gl;
#define C1_LOAD(nn) do { const bf16* g_ = G1 + (size_t)(nn) * G1W; p_y0 = __builtin_nontemporal_load((const v2u*)(YS + (size_t)(nn) * 256 + ch)); p_y1 = __builtin_nontemporal_load((const v2u*)(YS + ((size_t)T + (nn)) * 256 + ch)); \
        p_r = __builtin_nontemporal_load((const v2u*)(g_ + C_R + ch)); p_k = __builtin_nontemporal_load((const v2u*)(g_ + C_K + ch)); p_v = __builtin_nontemporal_load((const v2u*)(g_ + C_V + ch)); p_g = __builtin_nontemporal_load((const v2u*)(g_ + C_G + ch)); \
        p_h = __builtin_nontemporal_load((const v2u*)(HF + (size_t)(nn) * 256 + ch)); p_hb = *(const v2u*)(Y + (size_t)(nn) * YM_LD + 768 + ch); p_gl = __builtin_nontemporal_load((const v2u*)(g_ + C_GL + ch)); } while (0)
    { const int n0 = bid_() * 8 + wave; if (n0 < T) C1_LOAD(n0); }
    for (int n = bid_() * 8 + wave; n < T; n += G * 8) {
        const v2u y0 = p_y0, y1 = p_y1, rv = p_r, kv = p_k, vv = p_v, gv = p_g, hf = p_h, hb = p_hb, gl = p_gl;
        if (n + G * 8 < T) C1_LOAD(n + G * 8);
        float y[4] = {bflo(y0.x) + bflo(y1.x), bfhi(y0.x) + bfhi(y1.x), bflo(y0.y) + bflo(y1.y), bfhi(y0.y) + bfhi(y1.y)};
        float s = (y[0] + y[1]) + (y[2] + y[3]);
        float bon = bflo(rv.x) * bflo(kv.x) * rk.x + bfhi(rv.x) * bfhi(kv.x) * rk.y + bflo(rv.y) * bflo(kv.y) * rk.z + bfhi(rv.y) * bfhi(kv.y) * rk.w;
#pragma unroll
        for (int o = 1; o < 16; o <<= 1) { s += __shfl_xor(s, o); bon += __shfl_xor(bon, o); }
        const float mu = s * (1.f / 64.f);
        float s2 = (y[0] - mu) * (y[0] - mu) + (y[1] - mu) * (y[1] - mu) + (y[2] - mu) * (y[2] - mu) + (y[3] - mu) * (y[3] - mu);
#pragma unroll
        for (int o = 1; o < 16; o <<= 1) s2 += __shfl_xor(s2, o);
        const float rstd = rsqrt_(s2 * (1.f / 64.f) + GN_EPS);
        const float o0 = ((y[0] - mu) * rstd * lg.x + lb.x + bon * bflo(vv.x)) * siluf_(bflo(gv.x));
        const float o1 = ((y[1] - mu) * rstd * lg.y + lb.y + bon * bfhi(vv.x)) * siluf_(bfhi(gv.x));
        const float o2 = ((y[2] - mu) * rstd * lg.z + lb.z + bon * bflo(vv.y)) * siluf_(bflo(gv.y));
        const float o3 = ((y[3] - mu) * rstd * lg.w + lb.w + bon * bfhi(vv.y)) * siluf_(bfhi(gv.y));
        v2u ov; ov.x = cvtpk(o0, o1); ov.y = cvtpk(o2, o3);
        bf16* yr = Y + (size_t)n * YM_LD;
        *(v2u*)(yr + ch) = ov;
        *(v2u*)(yr + 768 + ch) = (v2u){cvtpk((bflo(hf.x) + bflo(hb.x)) * siluf_(bflo(gl.x)), (bfhi(hf.x) + bfhi(hb.x)) * siluf_(bfhi(gl.x))), cvtpk((bflo(hf.y) + bflo(hb.y)) * siluf_(bflo(gl.y)), (bfhi(hf.y) + bfhi(hb.y)) * siluf_(bfhi(gl.y)))};
    }
#undef C1_LOAD
}
#define MFMA32(a, b, c) __builtin_amdgcn_mfma_f32_32x32x16_bf16((a), (b), (c), 0, 0, 0)
#define MFMA16(a, b, c) __builtin_amdgcn_mfma_f32_16x16x32_bf16((a), (b), (c), 0, 0, 0)
typedef short s16x4_t __attribute__((ext_vector_type(4)));

__device__ __forceinline__ float tanh_fast(float x) { return 1.f - 2.f * rcp_(1.f + exp_(2.f * x)); }

constexpr int ATT_KSTR = 208, ATT_VSTR = 136, ATT_VOFF = 64 * ATT_KSTR, ATT_STAGE = 64 * ATT_KSTR + 64 * ATT_VSTR;


constexpr int RW_W2T = 0, RW_A2T = 9216, RW_TH = 18432, RW_HA = 27648, RW_CH0 = 36864, RW_CHB = 20992, RW_YB = 120832;
constexpr int RC_KP = 0, RC_RP = 2304, RC_BP = 4608  , RC_KT = 6912, RC_VR = 9216  , RC_LK = 16896, RC_TM = 17536, RC_ARK = 18176, RC_NARB = 18816, RC_G15 = 19456, RC_LBF = 19712, RC_SSQ = 20736;
template <int MODE = 0> __device__ __forceinline__ void rwkv_unit_mfma(ArgsP a, LAS unsigned char* lds, int layer, int u) {
    const int tid = tid_(), lane = tid & 63, wave = tid >> 6, i16 = lane & 15, g = lane >> 4;
    const int lat = u < 64, uu = lat ? u : u - 64, b = uu >> 3, e = (uu >> 2) & 1, hh = uu & 3;
    const int L = lat ? L_LAT : L_CTX, tok0 = lat ? T_CTX + b * L_LAT : b * L_CTX;
    const bf16* G1 = (const bf16*)(a->ws + WS_G1);
    bf16* YS = (bf16*)(a->ws + WS_G2);
    __syncthreads();
    { const bf16* wsrc = (const bf16*)(a->ws + WS_LORA2) + ((size_t)((layer * 2 + e) * 2) * 256 + hh * 64) * 64; const int row = tid >> 3, c8 = (tid & 7) * 8;
      *(LAS v4u*)(lds + RW_W2T + row * 144 + c8 * 2) = *(const v4u*)(wsrc + row * 64 + c8);
      *(LAS v4u*)(lds + RW_A2T + row * 144 + c8 * 2) = *(const v4u*)(wsrc + 256 * 64 + row * 64 + c8); }
    const int st_tok = tid >> 3, st_c8 = (tid & 7) * 8;
#define RW_STAGE(sc) do { const int step_ = (sc) * 64 + st_tok, t_ = e ? L - 1 - step_ : step_; const bf16* gp_ = G1 + (size_t)(tok0 + t_) * G1W + C_LORA + e * 64 + st_c8; \
        const v4u hw_ = *(const v4u*)gp_, ha_ = *(const v4u*)(gp_ + 128); v4u th_; \
        th_.x = cvtpk(tanh_fast(bflo(hw_.x)), tanh_fast(bfhi(hw_.x))); th_.y = cvtpk(tanh_fast(bflo(hw_.y)), tanh_fast(bfhi(hw_.y))); th_.z = cvtpk(tanh_fast(bflo(hw_.z)), tanh_fast(bfhi(hw_.z))); th_.w = cvtpk(tanh_fast(bflo(hw_.w)), tanh_fast(bfhi(hw_.w))); \
        *(LAS v4u*)(lds + RW_TH + st_tok * 144 + st_c8 * 2) = th_; *(LAS v4u*)(lds + RW_HA + st_tok * 144 + st_c8 * 2) = ha_; } while (0)
    RW_STAGE(0);
    f32x4 ST[4];
    {
        const int v = 16 * (wave & 3) + i16;
#pragma unroll
        for (int kt = 0; kt < 4; ++kt) ST[kt] = lat ? *(const f32x4*)(a->in[I_SRW] + (((size_t)((b * 2 + layer) * 2 + e) * 4 + hh) * 64 + v) * 64 + 16 * kt + 4 * g) : (f32x4){0.f, 0.f, 0.f, 0.f};
    }
    const int pc = wave & 3, ph = wave >> 2;
    LAS unsigned char* CH = lds + RW_CH0 + pc * RW_CHB;
    f32x4 w0r[2], a0r[2], kwr[2], kar[2];
#pragma unroll
    for (int c2 = 0; c2 < 2; ++c2) { const int gch = hh * 64 + (2 * ph + c2) * 16 + 4 * g;
        w0r[c2] = *(const f32x4*)(a->in[I_W0] + (layer * 2 + e) * 256 + gch); a0r[c2] = *(const f32x4*)(a->in[I_A0] + (layer * 2 + e) * 256 + gch);
        kwr[c2] = *(const f32x4*)(a->in[I_KK] + layer * 256 + gch); kar[c2] = *(const f32x4*)(a->in[I_KA] + layer * 256 + gch); }
#pragma unroll
    for (int c2 = 0; c2 < 2; ++c2) asm volatile("" : "+v"(w0r[c2]), "+v"(a0r[c2]), "+v"(kwr[c2]), "+v"(kar[c2]));
#pragma unroll
    for (int kt = 0; kt < 4; ++kt) asm volatile("" : "+v"(ST[kt]));
    __syncthreads();
    const int nsc = L >> 6;
    v2u pk[2], pr[2], pv[2];
#define RW_PREFETCH(sc) do { const int ps_ = (sc) * 64 + pc * 16 + i16, pt_ = e ? L - 1 - ps_ : ps_; const bf16* gq_ = G1 + (size_t)(tok0 + pt_) * G1W + hh * 64 + (2 * ph) * 16 + 4 * g; \
        pk[0] = *(const v2u*)(gq_ + C_K); pk[1] = *(const v2u*)(gq_ + C_K + 16); pr[0] = *(const v2u*)(gq_ + C_R); pr[1] = *(const v2u*)(gq_ + C_R + 16); pv[0] = *(const v2u*)(gq_ + C_V); pv[1] = *(const v2u*)(gq_ + C_V + 16); } while (0)
    RW_PREFETCH(0);
    for (int sc = 0; sc < nsc; ++sc) {
        const v2u ck[2] = {pk[0], pk[1]}, cr[2] = {pr[0], pr[1]}, cv[2] = {pv[0], pv[1]};
        if (sc + 1 < nsc) RW_PREFETCH(sc + 1);
        float dec[8], av[8], kx[8], rx[8], kk[8];
        {
            f32x4 aw[2], aa[2];
#pragma unroll
            for (int c2 = 0; c2 < 2; ++c2) { aw[c2] = (f32x4){0.f, 0.f, 0.f, 0.f}; aa[c2] = (f32x4){0.f, 0.f, 0.f, 0.f}; }
#pragma unroll
            for (int ks = 0; ks < 2; ++ks) {
                const bf16x8 bth = *(const LAS bf16x8*)(lds + RW_TH + (pc * 16 + i16) * 144 + ks * 64 + g * 16), bha = *(const LAS bf16x8*)(lds + RW_HA + (pc * 16 + i16) * 144 + ks * 64 + g * 16);
#pragma unroll
                for (int c2 = 0; c2 < 2; ++c2) { const int row = (2 * ph + c2) * 16 + i16;
                    const bf16x8 w2f = *(const LAS bf16x8*)(lds + RW_W2T + row * 144 + ks * 64 + g * 16), a2f = *(const LAS bf16x8*)(lds + RW_A2T + row * 144 + ks * 64 + g * 16);
                    aw[c2] = MFMA16(w2f, bth, aw[c2]); aa[c2] = MFMA16(a2f, bha, aa[c2]); }
            }
            float ss = 0.f;
#pragma unroll
            for (int c2 = 0; c2 < 2; ++c2) {
                const f32x4 w0 = w0r[c2], a0 = a0r[c2], kw = kwr[c2];
                const v2u kv = ck[c2], rv = cr[c2];
                const float kq[4] = {bflo(kv.x), bfhi(kv.x), bflo(kv.y), bfhi(kv.y)}, rq[4] = {bflo(rv.x), bfhi(rv.x), bflo(rv.y), bfhi(rv.y)};
#pragma unroll
                for (int q = 0; q < 4; ++q) { const int o = c2 * 4 + q;
                    dec[o] = exp_(-0.6065306597126334f * sigmoidf_(aw[c2][q] + w0[q])); av[o] = sigmoidf_(aa[c2][q] + a0[q]);
                    kx[o] = kq[q]; rx[o] = rq[q]; kk[o] = kq[q] * kw[q]; ss += kk[o] * kk[o]; }
            }
            ss += __shfl_xor(ss, 16); ss += __shfl_xor(ss, 32);
            if (g == 0) *(LAS float*)(CH + RC_SSQ + (i16 * 2 + ph) * 4) = ss;
        }
        __syncthreads();
        {
            const float tot = *(const LAS float*)(CH + RC_SSQ + (i16 * 2) * 4) + *(const LAS float*)(CH + RC_SSQ + (i16 * 2 + 1) * 4);
            const float inrm = rcp_(fmaxf(sqrt_(tot), 1e-12f));
            float G8[8], Gx8[8];
#pragma unroll
            for (int o8 = 0; o8 < 8; ++o8) G8[o8] = dec[o8];
#pragma unroll
            for (int o8 = 0; o8 < 8; ++o8) G8[o8] *= dpp_f<0x111>(1.f, G8[o8]);
#pragma unroll
            for (int o8 = 0; o8 < 8; ++o8) G8[o8] *= dpp_f<0x112>(1.f, G8[o8]);
#pragma unroll
            for (int o8 = 0; o8 < 8; ++o8) G8[o8] *= dpp_f<0x114>(1.f, G8[o8]);
#pragma unroll
            for (int o8 = 0; o8 < 8; ++o8) G8[o8] *= dpp_f<0x118>(1.f, G8[o8]);
#pragma unroll
            for (int o8 = 0; o8 < 8; ++o8) Gx8[o8] = dpp_f<0x111>(1.f, G8[o8]);
#pragma unroll
            for (int c2 = 0; c2 < 2; ++c2) { const int ch = (2 * ph + c2) * 16 + 4 * g;
                const f32x4 ka = kar[c2];
                float kp[4], bp[4], kt[4], rp[4];
#pragma unroll
                for (int q = 0; q < 4; ++q) { const int o = c2 * 4 + q;
                    const float G = G8[o], Gex = Gx8[o];
                    const float kkn = kk[o] * inrm, iG = rcp_(G);
                    kp[q] = Gex * kkn; bp[q] = kkn * av[o] * iG; kt[q] = kx[o] * (1.f + (av[o] - 1.f) * ka[q]) * iG; rp[q] = G * rx[o];
                }
                { LAS unsigned char* g15p = (i16 == 15) ? CH + RC_G15 + ch * 4 : lds + (RW_YB + 9216) + lane * 16;
                  *(LAS f32x4*)g15p = (f32x4){G8[c2 * 4 + 0], G8[c2 * 4 + 1], G8[c2 * 4 + 2], G8[c2 * 4 + 3]}; }
                *(LAS v2u*)(CH + RC_KP + i16 * 144 + ch * 2) = (v2u){cvtpk(kp[0], kp[1]), cvtpk(kp[2], kp[3])};
                *(LAS v2u*)(CH + RC_BP + i16 * 144 + ch * 2) = (v2u){cvtpk(-bp[0], -bp[1]), cvtpk(-bp[2], -bp[3])};
                *(LAS v2u*)(CH + RC_KT + i16 * 144 + ch * 2) = (v2u){cvtpk(kt[0], kt[1]), cvtpk(kt[2], kt[3])};
                *(LAS v2u*)(CH + RC_RP + i16 * 144 + ch * 2) = (v2u){cvtpk(rp[0], rp[1]), cvtpk(rp[2], rp[3])};
                *(LAS v2u*)(CH + RC_VR + i16 * 144 + ch * 2) = cv[c2];
            }
        }
        __syncthreads();
        {
            f32x4 d0 = (f32x4){0.f, 0.f, 0.f, 0.f}, d1 = (f32x4){0.f, 0.f, 0.f, 0.f};
            const int xoff = ph ? RC_KP : RC_RP, y0off = ph ? RC_BP : RC_KT, y1off = ph ? RC_KT : RC_BP;
#pragma unroll
            for (int ks = 0; ks < 2; ++ks) {
                const bf16x8 xf = *(const LAS bf16x8*)(CH + xoff + i16 * 144 + ks * 64 + g * 16);
                const bf16x8 y0 = *(const LAS bf16x8*)(CH + y0off + i16 * 144 + ks * 64 + g * 16), y1 = *(const LAS bf16x8*)(CH + y1off + i16 * 144 + ks * 64 + g * 16);
                d0 = MFMA16(xf, y0, d0); d1 = MFMA16(xf, y1, d1);
            }
            if (ph) {
#pragma unroll
                for (int q = 0; q < 4; ++q) { const int i = 4 * g + q, j = i16;
                    *(LAS float*)(CH + RC_LBF + (i * 16 + j) * 4) = (j < i) ? -d0[q] : 0.f; *(LAS bf16*)(CH + RC_LK + i * 40 + j * 2) = (bf16)(cvtpk((j < i) ? d1[q] : 0.f, 0.f) & 0xffffu); }
            } else {
#pragma unroll
                for (int q = 0; q < 4; ++q) { const int i = 4 * g + q, j = i16;
                    const unsigned pk_ = cvtpk((j <= i) ? d0[q] : 0.f, (j <= i) ? d1[q] : 0.f); *(LAS bf16*)(CH + RC_ARK + i * 40 + j * 2) = (bf16)(pk_ & 0xffffu); *(LAS bf16*)(CH + RC_NARB + i * 40 + j * 2) = (bf16)(pk_ >> 16); }
            }
            if (ph && !(MODE & 2)) {
                float x[16];
#pragma unroll
                for (int i = 0; i < 16; ++i) { float s = (i == i16) ? 1.f : 0.f;
#pragma unroll
                    for (int j4 = 0; j4 < (i + 3) / 4; ++j4) { const f32x4 lr = *(const LAS f32x4*)(CH + RC_LBF + (i * 16 + j4 * 4) * 4);
#pragma unroll
                        for (int jj = 0; jj < 4; ++jj) { const int j = j4 * 4 + jj; if (j < i) s -= lr[jj] * x[j]; } }
                    x[i] = s; }
                if (g == 0) {
#pragma unroll
                    for (int i = 0; i < 16; i += 2) { const unsigned pk_ = cvtpk(x[i], x[i + 1]); *(LAS bf16*)(CH + RC_TM + i * 40 + i16 * 2) = (bf16)(pk_ & 0xffffu); *(LAS bf16*)(CH + RC_TM + (i + 1) * 40 + i16 * 2) = (bf16)(pk_ >> 16); } }
            }
        }
        __syncthreads();
        if (wave < 4) {
            const int vt = wave;
#pragma unroll 1
            for (int c = 0; c < ((MODE & 1) ? 0 : 4); ++c) {
                const LAS unsigned char* C = lds + RW_CH0 + c * RW_CHB;
                v4u sb01, sb23;
                sb01.x = cvtpk(ST[0][0], ST[0][1]); sb01.y = cvtpk(ST[0][2], ST[0][3]); sb01.z = cvtpk(ST[1][0], ST[1][1]); sb01.w = cvtpk(ST[1][2], ST[1][3]);
                sb23.x = cvtpk(ST[2][0], ST[2][1]); sb23.y = cvtpk(ST[2][2], ST[2][3]); sb23.z = cvtpk(ST[3][0], ST[3][1]); sb23.w = cvtpk(ST[3][2], ST[3][3]);
                const bf16x8 s01 = __builtin_bit_cast(bf16x8, sb01), s23 = __builtin_bit_cast(bf16x8, sb23);
                const v2u kp0a = *(const LAS v2u*)(C + RC_KP + i16 * 144 + (4 * g) * 2), kp0b = *(const LAS v2u*)(C + RC_KP + i16 * 144 + (16 + 4 * g) * 2);
                const v2u kp1a = *(const LAS v2u*)(C + RC_KP + i16 * 144 + (32 + 4 * g) * 2), kp1b = *(const LAS v2u*)(C + RC_KP + i16 * 144 + (48 + 4 * g) * 2);
                const v2u rp0a = *(const LAS v2u*)(C + RC_RP + i16 * 144 + (4 * g) * 2), rp0b = *(const LAS v2u*)(C + RC_RP + i16 * 144 + (16 + 4 * g) * 2);
                const v2u rp1a = *(const LAS v2u*)(C + RC_RP + i16 * 144 + (32 + 4 * g) * 2), rp1b = *(const LAS v2u*)(C + RC_RP + i16 * 144 + (48 + 4 * g) * 2);
                const v2u lk = *(const LAS v2u*)(C + RC_LK + i16 * 40 + g * 8), tm = *(const LAS v2u*)(C + RC_TM + i16 * 40 + g * 8);
                const v2u ark = *(const LAS v2u*)(C + RC_ARK + i16 * 40 + g * 8), narb = *(const LAS v2u*)(C + RC_NARB + i16 * 40 + g * 8);
                const int trq = (i16 >> 2) & 3, trp = i16 & 3;
                const v2u vf = __builtin_bit_cast(v2u, __builtin_amdgcn_ds_read_tr16_b64_v4i16((LAS s16x4_t*)(C + RC_VR + (4 * g + trq) * 144 + (16 * vt + 4 * trp) * 2)));
                const v4u z4 = {0u, 0u, 0u, 0u};
                f32x4 rhs = (f32x4){0.f, 0.f, 0.f, 0.f};
                rhs = MFMA16(__builtin_bit_cast(bf16x8, ((v4u){kp0a.x, kp0a.y, kp0b.x, kp0b.y})), s01, rhs);
                rhs = MFMA16(__builtin_bit_cast(bf16x8, ((v4u){kp1a.x, kp1a.y, kp1b.x, kp1b.y})), s23, rhs);
                rhs = MFMA16(__builtin_bit_cast(bf16x8, ((v4u){lk.x, lk.y, 0u, 0u})), __builtin_bit_cast(bf16x8, ((v4u){vf.x, vf.y, 0u, 0u})), rhs);
                f32x4 z = MFMA16(__builtin_bit_cast(bf16x8, ((v4u){tm.x, tm.y, 0u, 0u})), __builtin_bit_cast(bf16x8, ((v4u){cvtpk(rhs[0], rhs[1]), cvtpk(rhs[2], rhs[3]), 0u, 0u})), ((f32x4){0.f, 0.f, 0.f, 0.f}));
                const bf16x8 vz = __builtin_bit_cast(bf16x8, ((v4u){vf.x, vf.y, cvtpk(z[0], z[1]), cvtpk(z[2], z[3])}));
                f32x4 y = (f32x4){0.f, 0.f, 0.f, 0.f};
                y = MFMA16(__builtin_bit_cast(bf16x8, ((v4u){rp0a.x, rp0a.y, rp0b.x, rp0b.y})), s01, y);
                y = MFMA16(__builtin_bit_cast(bf16x8, ((v4u){rp1a.x, rp1a.y, rp1b.x, rp1b.y})), s23, y);
                y = MFMA16(__builtin_bit_cast(bf16x8, ((v4u){ark.x, ark.y, narb.x, narb.y})), vz, y);
#pragma unroll
                for (int kt = 0; kt < 4; ++kt) {
                    const v2u ktf = __builtin_bit_cast(v2u, __builtin_amdgcn_ds_read_tr16_b64_v4i16((LAS s16x4_t*)(C + RC_KT + (4 * g + trq) * 144 + (16 * kt + 4 * trp) * 2)));
                    const v2u nbf = __builtin_bit_cast(v2u, __builtin_amdgcn_ds_read_tr16_b64_v4i16((LAS s16x4_t*)(C + RC_BP + (4 * g + trq) * 144 + (16 * kt + 4 * trp) * 2)));
                    const f32x4 g15 = *(const LAS f32x4*)(C + RC_G15 + (16 * kt + 4 * g) * 4);
                    ST[kt] = MFMA16(__builtin_bit_cast(bf16x8, ((v4u){ktf.x, ktf.y, nbf.x, nbf.y})), vz, ST[kt]);
                    ST[kt] = ST[kt] * g15;
                }
                { const unsigned y01 = cvtpk(y[0], y[1]), y23 = cvtpk(y[2], y[3]); LAS unsigned char* yb = lds + RW_YB + (c * 16 + 4 * g) * 144 + (16 * vt + i16) * 2;
                  *(LAS bf16*)(yb) = (bf16)(y01 & 0xffffu); *(LAS bf16*)(yb + 144) = (bf16)(y01 >> 16); *(LAS bf16*)(yb + 288) = (bf16)(y23 & 0xffffu); *(LAS bf16*)(yb + 432) = (bf16)(y23 >> 16); }
                (void)z4;
            }
        } else if (sc + 1 < nsc) {
            const int r0 = (tid - 256) >> 3;
#pragma unroll
            for (int hrow = 0; hrow < 2; ++hrow) { const int tokr = r0 + 32 * hrow, step_ = (sc + 1) * 64 + tokr, t_ = e ? L - 1 - step_ : step_;
                const bf16* gp_ = G1 + (size_t)(tok0 + t_) * G1W + C_LORA + e * 64 + st_c8;
                const v4u hw_ = *(const v4u*)gp_, ha_ = *(const v4u*)(gp_ + 128); v4u th_;
                th_.x = cvtpk(tanh_fast(bflo(hw_.x)), tanh_fast(bfhi(hw_.x))); th_.y = cvtpk(tanh_fast(bflo(hw_.y)), tanh_fast(bfhi(hw_.y))); th_.z = cvtpk(tanh_fast(bflo(hw_.z)), tanh_fast(bfhi(hw_.z))); th_.w = cvtpk(tanh_fast(bflo(hw_.w)), tanh_fast(bfhi(hw_.w)));
                *(LAS v4u*)(lds + RW_TH + tokr * 144 + st_c8 * 2) = th_; *(LAS v4u*)(lds + RW_HA + tokr * 144 + st_c8 * 2) = ha_; }
        }
        __syncthreads();
        {
            const int row = tid >> 3, part = tid & 7, step = sc * 64 + row, t = e ? L - 1 - step : step;
            __builtin_nontemporal_store(*(const LAS v4u*)(lds + RW_YB + row * 144 + part * 16), (v4u*)(YS + ((size_t)e * T + tok0 + t) * 256 + hh * 64 + part * 8));
        }
    }
#undef RW_STAGE
#undef RW_PREFETCH
    if (!lat && wave < 4) {
        const int v = 16 * wave + i16;
#pragma unroll
        for (int kt = 0; kt < 4; ++kt) *(f32x4*)(a->out + O_RW + (((size_t)((b * 2 + layer) * 2 + e) * 4 + hh) * 64 + v) * 64 + 16 * kt + 4 * g) = ST[kt];
    }
}


constexpr int LQ_NQ = 32;
constexpr int LQ_WAT = 0, LQ_S0 = 2 * LQ_NQ * 144;
constexpr int LS_XCB = 0, LS_XCQ = 9216, LS_AA = LS_XCQ + 64 * LQ_NQ * 4, LS_BV = LS_AA + 64 * LQ_NQ * 4, LS_HH = LS_BV + 64 * LQ_NQ * 4,
              LS_SP = LS_HH + 64 * LQ_NQ * 4, LS_SH = LS_SP + 8 * LQ_NQ * 4, LS_HC = LS_SH + 8 * LQ_NQ * 4, LS_BYTES = LS_HC + 2 * LQ_NQ * 4;
__device__ __forceinline__ void lru_unit_q(ArgsP a, LAS unsigned char* lds, int layer, int u) {
    const int tid = tid_(), lane = tid & 63, wave = tid >> 6, i16 = lane & 15, g4 = lane >> 4;
    const int lat = u < 64, uu = lat ? u : u - 64, bp = uu >> 4, e = (uu >> 3) & 1, g = (uu >> 1) & 3, oq = uu & 1;
    const int L = lat ? L_LAT : L_CTX;
    const int tokb[2] = {lat ? T_CTX + (2 * bp) * L_LAT : (2 * bp) * L_CTX, lat ? T_CTX + (2 * bp + 1) * L_LAT : (2 * bp + 1) * L_CTX};
    const __amdgpu_buffer_rsrc_t rsx0 = __builtin_amdgcn_make_buffer_rsrc((void*)((const bf16*)(a->ws + WS_G1) + (size_t)tokb[0] * G1W), (short)0, L * G1W * 2, 0x00020000);
    const __amdgpu_buffer_rsrc_t rsx1 = __builtin_amdgcn_make_buffer_rsrc((void*)((const bf16*)(a->ws + WS_G1) + (size_t)tokb[1] * G1W), (short)0, L * G1W * 2, 0x00020000);
    const bf16* G1 = (const bf16*)(a->ws + WS_G1);
    unsigned char* HO = e ? (unsigned char*)a->out + 2048 + 768 * 2 : a->ws + WS_HF;
    const size_t hstr = e ? 4096 : 512;
    const int tt = tid >> 3, q8 = (tid & 7) * 8;
    const unsigned xvo = (unsigned)((C_XL + g * 64 + q8) * 2);
    float cw[4][8], cb[8];
#pragma unroll
    for (int i = 0; i < 8; ++i) { const int ch = g * 64 + q8 + i; cb[i] = a->in[I_CONVB][layer * 256 + ch];
#pragma unroll
        for (int j = 0; j < 4; ++j) cw[j][i] = a->in[I_CONVW][(layer * 4 + j) * 256 + ch]; }
    const int gt = wave & 3, got = wave >> 2;
    const int ssn = tid >> 8, sch = tid & (LQ_NQ - 1), seg = (tid >> 5) & 7;
    const int otok = tid >> 3, oc4 = (tid & 7) * 4;
    const int chq = g * 64 + oq * LQ_NQ;
    LAS unsigned char* SS = lds + LQ_S0 + ssn * LS_BYTES;
    {
        __syncthreads();
        { const int m = tid >> 8, row = (tid >> 3) & 31, c8 = (tid & 7) * 8;
          const bf16* wsrc = (const bf16*)(a->ws + WS_LRUW) + ((size_t)(((layer * 2 + e) * 2 + m) * 4 + g) * 64 + oq * LQ_NQ + row) * 64 + c8;
          *(LAS v4u*)(lds + LQ_WAT + m * LQ_NQ * 144 + row * 144 + c8 * 2) = *(const v4u*)wsrc; }
        if (tid < 2 * LQ_NQ) { const int s = tid >> 5, c = tid & 31; ((LAS float*)(lds + LQ_S0 + s * LS_BYTES + LS_HC))[c] = lat ? a->in[I_SLRU][((size_t)((2 * bp + s) * 2 + layer) * 2 + e) * 256 + chq + c] : 0.f; }
        f32x4 bav, bxv, spl;
        { const int chb = (layer * 2 + e) * 256 + chq + 16 * got + 4 * g4;
          bav = *(const f32x4*)(a->in[I_BA] + chb); bxv = *(const f32x4*)(a->in[I_BX] + chb); const f32x4 lam = *(const f32x4*)(a->in[I_LAMBDA] + chb);
#pragma unroll
          for (int q = 0; q < 4; ++q) spl[q] = log1pf(exp_(-lam[q])); }
        v4u xr[2][4];
#define LQ_PREFETCH(cc_) do { const int c_ = e ? L / 64 - 1 - (cc_) : (cc_), t_ = c_ * 64 + tt; \
            _Pragma("unroll") for (int s = 0; s < 2; ++s) { \
              _Pragma("unroll") for (int j = 0; j < 4; ++j) { const int ts = t_ + j - 2; xr[s][j] = __builtin_amdgcn_raw_buffer_load_b128(s ? rsx1 : rsx0, (unsigned)(ts * (G1W * 2)) + xvo, 0u, 0); }   \
              } } while (0)
        LQ_PREFETCH(0);
        __syncthreads();
        for (int cc = 0; cc < L / 64; ++cc) {
            const int c = e ? L / 64 - 1 - cc : cc;
            v4u xcur[2][4];
#pragma unroll
            for (int s = 0; s < 2; ++s) { xcur[s][0] = xr[s][0]; xcur[s][1] = xr[s][1]; xcur[s][2] = xr[s][2]; xcur[s][3] = xr[s][3]; }
            if (cc + 1 < L / 64) LQ_PREFETCH(cc + 1);
#pragma unroll
            for (int s = 0; s < 2; ++s) {
                LAS unsigned char* SB = lds + LQ_S0 + s * LS_BYTES;
                float xc[8];
#pragma unroll
                for (int i = 0; i < 8; ++i) xc[i] = cb[i];
#pragma unroll
                for (int j = 0; j < 4; ++j) { const v4u x = xcur[s][j];
                    xc[0] += cw[j][0] * bflo(x.x); xc[1] += cw[j][1] * bfhi(x.x); xc[2] += cw[j][2] * bflo(x.y); xc[3] += cw[j][3] * bfhi(x.y);
                    xc[4] += cw[j][4] * bflo(x.z); xc[5] += cw[j][5] * bfhi(x.z); xc[6] += cw[j][6] * bflo(x.w); xc[7] += cw[j][7] * bfhi(x.w); }
                *(LAS v4u*)(SB + LS_XCB + tt * 144 + q8 * 2) = (v4u){cvtpk(xc[0], xc[1]), cvtpk(xc[2], xc[3]), cvtpk(xc[4], xc[5]), cvtpk(xc[6], xc[7])};
                if ((q8 / LQ_NQ) == oq) { LAS float* XCQ = (LAS float*)(SB + LS_XCQ); *(LAS f32x4*)(XCQ + tt * LQ_NQ + (q8 % LQ_NQ)) = (f32x4){xc[0], xc[1], xc[2], xc[3]}; *(LAS f32x4*)(XCQ + tt * LQ_NQ + (q8 % LQ_NQ) + 4) = (f32x4){xc[4], xc[5], xc[6], xc[7]}; }
            }
            __syncthreads();
#pragma unroll
            for (int s = 0; s < 2; ++s) {
                LAS unsigned char* SB = lds + LQ_S0 + s * LS_BYTES;
                const int tk = gt * 16 + i16;
                f32x4 ga = (f32x4){0.f, 0.f, 0.f, 0.f}, gx = (f32x4){0.f, 0.f, 0.f, 0.f};
#pragma unroll
                for (int ks = 0; ks < 2; ++ks) { const bf16x8 xf = *(const LAS bf16x8*)(SB + LS_XCB + tk * 144 + ks * 64 + g4 * 16);
                    const bf16x8 wa = *(const LAS bf16x8*)(lds + LQ_WAT + (16 * got + i16) * 144 + ks * 64 + g4 * 16), wx = *(const LAS bf16x8*)(lds + LQ_WAT + LQ_NQ * 144 + (16 * got + i16) * 144 + ks * 64 + g4 * 16);
                    ga = MFMA16(wa, xf, ga); gx = MFMA16(wx, xf, gx); }
                const f32x4 xcv = *(const LAS f32x4*)((LAS float*)(SB + LS_XCQ) + tk * LQ_NQ + 16 * got + 4 * g4);
                f32x4 av, bv;
#pragma unroll
                for (int q = 0; q < 4; ++q) { const float la = -8.f * sigmoidf_(ga[q] + bav[q]) * spl[q], aq = exp_(la); av[q] = aq; bv[q] = sqrt_((1.f - aq) * (1.f + aq)) * sigmoidf_(gx[q] + bxv[q]) * xcv[q]; }
                *(LAS f32x4*)((LAS float*)(SB + LS_AA) + tk * LQ_NQ + 16 * got + 4 * g4) = av; *(LAS f32x4*)((LAS float*)(SB + LS_BV) + tk * LQ_NQ + 16 * got + 4 * g4) = bv;
            }
            __syncthreads();
            LAS float* AA = (LAS float*)(SS + LS_AA); LAS float* BV = (LAS float*)(SS + LS_BV); LAS float* HH = (LAS float*)(SS + LS_HH);
            LAS float* SP = (LAS float*)(SS + LS_SP); LAS float* SH = (LAS float*)(SS + LS_SH); LAS float* HC = (LAS float*)(SS + LS_HC);
            float av8[8], bv8[8];
            {
                float P = 1.f, H = 0.f;
#pragma unroll
                for (int s = 0; s < 8; ++s) { const int p = seg * 8 + s, st = e ? 63 - p : p; av8[s] = AA[st * LQ_NQ + sch]; bv8[s] = BV[st * LQ_NQ + sch]; H = fmaf(av8[s], H, bv8[s]); P *= av8[s]; }
                SP[seg * LQ_NQ + sch] = P; SH[seg * LQ_NQ + sch] = H;
            }
            __syncthreads();
            {
                float h = HC[(cc & 1) * LQ_NQ + sch];
                for (int s2 = 0; s2 < seg; ++s2) h = fmaf(SP[s2 * LQ_NQ + sch], h, SH[s2 * LQ_NQ + sch]);
#pragma unroll
                for (int s = 0; s < 8; ++s) { const int p = seg * 8 + s, st = e ? 63 - p : p; h = fmaf(av8[s], h, bv8[s]); HH[st * LQ_NQ + sch] = h; }
                if (seg == 7) HC[((cc + 1) & 1) * LQ_NQ + sch] = h;
            }
            __syncthreads();
#pragma unroll
            for (int s = 0; s < 2; ++s) {
                const int n = tokb[s] + c * 64 + otok;
                const f32x4 hv = *(const LAS f32x4*)((LAS float*)(lds + LQ_S0 + s * LS_BYTES + LS_HH) + otok * LQ_NQ + oc4);
                __builtin_nontemporal_store((v2u){cvtpk(hv[0], hv[1]), cvtpk(hv[2], hv[3])}, (v2u*)(HO + (size_t)n * hstr + (chq + oc4) * 2));
            }
        }
#undef LQ_PREFETCH
        __syncthreads();
        if (tid < 2 * LQ_NQ && !lat) { const int s = tid >> 5, c = tid & 31; a->out[O_LRU + ((size_t)((2 * bp + s) * 2 + layer) * 2 + e) * 256 + chq + c] = ((LAS float*)(lds + LQ_S0 + s * LS_BYTES + LS_HC))[((L / 64) & 1) * LQ_NQ + c]; }
    }
}

constexpr int ATT2_VSTR = 144, ATT2_STAGE = 64 * ATT_KSTR + 64 * ATT2_VSTR;
#define ATT_KLOAD(KB_) \
        bf16x8 kfa_[6], kfb_[6]; \
        _Pragma("unroll") for (int ks_ = 0; ks_ < 6; ++ks_) { kfa_[ks_] = *(const LAS bf16x8*)((KB_) + r * ATT_KSTR + ks_ * 32 + hq * 16); kfb_[ks_] = *(const LAS bf16x8*)((KB_) + (32 + r) * ATT_KSTR + ks_ * 32 + hq * 16); }
#define ATT_VLOAD(VB_) \
        v2u va0_[4], va1_[4], vb0_[4], vb1_[4]; \
        _Pragma("unroll") for (int ks_ = 0; ks_ < 4; ++ks_) { \
            const LAS unsigned char* vp_ = (VB_) + (ks_ * 16 + 4 * hq + ((lane >> 2) & 3)) * ATT2_VSTR + (16 * ((lane >> 4) & 1) + 4 * (lane & 3)) * 2; \
            va0_[ks_] = __builtin_bit_cast(v2u, __builtin_amdgcn_ds_read_tr16_b64_v4i16((LAS s16x4_t*)(vp_))); \
            va1_[ks_] = __builtin_bit_cast(v2u, __builtin_amdgcn_ds_read_tr16_b64_v4i16((LAS s16x4_t*)(vp_ + 8 * ATT2_VSTR))); \
            vb0_[ks_] = __builtin_bit_cast(v2u, __builtin_amdgcn_ds_read_tr16_b64_v4i16((LAS s16x4_t*)(vp_ + 64))); \
            vb1_[ks_] = __builtin_bit_cast(v2u, __builtin_amdgcn_ds_read_tr16_b64_v4i16((LAS s16x4_t*)(vp_ + 8 * ATT2_VSTR + 64))); }
#define ATT_QKM(S0_, S1_) do { \
        _Pragma("unroll") for (int i_ = 0; i_ < 16; ++i_) { S0_[i_] = 0.f; S1_[i_] = 0.f; } \
        _Pragma("unroll") for (int ks_ = 0; ks_ < 6; ++ks_) { S0_ = MFMA32(kfa_[ks_], qf[ks_], S0_); S1_ = MFMA32(kfb_[ks_], qf[ks_], S1_); } } while (0)
#define ATT_STEP(SC0_, SC1_, SN0_, SN1_, KB_, VB_, HAVE_NEXT_) do { \
        ATT_KLOAD(KB_) \
        float mx_ = SC0_[0]; \
        _Pragma("unroll") for (int i_ = 1; i_ < 16; ++i_) mx_ = fmaxf(mx_, SC0_[i_]); \
        _Pragma("unroll") for (int i_ = 0; i_ < 16; ++i_) mx_ = fmaxf(mx_, SC1_[i_]); \
        mx_ = fmaxf(mx_, __shfl_xor(mx_, 32)); \
        if (!__all(mx_ - m <= 8.f)) { const float mn_ = fmaxf(m, mx_), al_ = __builtin_amdgcn_exp2f(m - mn_); m = mn_; l *= al_; \
            _Pragma("unroll") for (int i_ = 0; i_ < 16; ++i_) { o0[i_] *= al_; o1[i_] *= al_; } } \
        if (HAVE_NEXT_) ATT_QKM(SN0_, SN1_); \
        ATT_VLOAD(VB_) \
        float ps_ = 0.f; \
        _Pragma("unroll") for (int i_ = 0; i_ < 16; ++i_) { SC0_[i_] = __builtin_amdgcn_exp2f(SC0_[i_] - m); SC1_[i_] = __builtin_amdgcn_exp2f(SC1_[i_] - m); ps_ += SC0_[i_] + SC1_[i_]; } \
        l += ps_; \
        _Pragma("unroll") for (int ks_ = 0; ks_ < 4; ++ks_) { \
            v4u pw_; \
            if (ks_ == 0) { pw_.x = cvtpk(SC0_[0], SC0_[1]); pw_.y = cvtpk(SC0_[2], SC0_[3]); pw_.z = cvtpk(SC0_[4], SC0_[5]); pw_.w = cvtpk(SC0_[6], SC0_[7]); } \
            else if (ks_ == 1) { pw_.x = cvtpk(SC0_[8], SC0_[9]); pw_.y = cvtpk(SC0_[10], SC0_[11]); pw_.z = cvtpk(SC0_[12], SC0_[13]); pw_.w = cvtpk(SC0_[14], SC0_[15]); } \
            else if (ks_ == 2) { pw_.x = cvtpk(SC1_[0], SC1_[1]); pw_.y = cvtpk(SC1_[2], SC1_[3]); pw_.z = cvtpk(SC1_[4], SC1_[5]); pw_.w = cvtpk(SC1_[6], SC1_[7]); } \
            else { pw_.x = cvtpk(SC1_[8], SC1_[9]); pw_.y = cvtpk(SC1_[10], SC1_[11]); pw_.z = cvtpk(SC1_[12], SC1_[13]); pw_.w = cvtpk(SC1_[14], SC1_[15]); } \
            const bf16x8 pf_ = __builtin_bit_cast(bf16x8, pw_); \
            const v4u vwa_ = {va0_[ks_].x, va0_[ks_].y, va1_[ks_].x, va1_[ks_].y}, vwb_ = {vb0_[ks_].x, vb0_[ks_].y, vb1_[ks_].x, vb1_[ks_].y}; \
            o0 = MFMA32(__builtin_bit_cast(bf16x8, vwa_), pf_, o0); o1 = MFMA32(__builtin_bit_cast(bf16x8, vwb_), pf_, o1); } } while (0)
__device__ __forceinline__ void att_unit2(ArgsP a, LAS unsigned char* lds, int u) {
    const int tid = tid_(), lane = tid & 63, wave = tid >> 6, r = lane & 31, hq = lane >> 5;
    const bf16* KN = (const bf16*)(a->ws + WS_KN); const bf16* KR = (const bf16*)(a->ws + WS_KR); const bf16* VT = (const bf16*)(a->ws + WS_VT);
    bf16* Q = (bf16*)(a->ws + WS_Q); const bf16* G1 = (const bf16*)(a->ws + WS_G1);
    int b, h, n0, Lk, kidx0; size_t vbase;
    if (u < 512) { b = u >> 6; h = (u >> 3) & 7; n0 = T_CTX + b * 2048 + (u & 7) * 256; Lk = LK_LAT; kidx0 = T_CTX + b * LK_LAT; vbase = (size_t)VT_LAT + (size_t)(b * 8 + h) * 64 * LK_LAT; }
    else { const int uu = u - 512; b = uu >> 3; h = uu & 7; n0 = b * 256; Lk = 256; kidx0 = b * 256; vbase = (size_t)(b * 8 + h) * 64 * 256; }
    const int ntiles = Lk >> 6;
    const int n = n0 + wave * 32 + r;
    bf16x8 qf[6];
#pragma unroll
    for (int ks = 0; ks < 6; ++ks) qf[ks] = *(const bf16x8*)(Q + (size_t)n * 768 + h * 96 + ks * 16 + 8 * hq);
    const int key_k = tid >> 3, ck = tid & 7, key_r = (tid >> 2) & 63, cr = tid & 3;
    const __amdgpu_buffer_rsrc_t rsk = __builtin_amdgcn_make_buffer_rsrc((void*)(KN + (size_t)kidx0 * 512), (short)0, Lk * 1024, 0x00020000);
    const __amdgpu_buffer_rsrc_t rsr = __builtin_amdgcn_make_buffer_rsrc((void*)(KR + (size_t)kidx0 * 32), (short)0, Lk * 64, 0x00020000);
    const __amdgpu_buffer_rsrc_t rsv = __builtin_amdgcn_make_buffer_rsrc((void*)(VT + (size_t)kidx0 * 512), (short)0, Lk * 1024, 0x00020000);
    const unsigned vok = (unsigned)((key_k * 512 + h * 64 + ck * 8) * 2), vor = (unsigned)((key_r * 32 + cr * 8) * 2);
    const unsigned sk = key_k * ATT_KSTR + ck * 16, sr = key_r * ATT_KSTR + 128 + cr * 16, sv = ATT_VOFF + key_k * ATT2_VSTR + ck * 16;
    v4u rkA, rrA = {0u, 0u, 0u, 0u}, rvA, rkB, rrB = {0u, 0u, 0u, 0u}, rvB;
#define ATT_LOAD(X_, j_) do { rk##X_ = __builtin_amdgcn_raw_buffer_load_b128(rsk, vok, (unsigned)(j_) * 65536u, 2); if (tid < 256) rr##X_ = __builtin_amdgcn_raw_buffer_load_b128(rsr, vor, (unsigned)(j_) * 4096u, 2); rv##X_ = __builtin_amdgcn_raw_buffer_load_b128(rsv, vok, (unsigned)(j_) * 65536u, 2); } while (0)
#define ATT_STORE(X_, B_) do { LAS unsigned char* nb_ = lds + (B_) * ATT2_STAGE; *(LAS v4u*)(nb_ + sk) = rk##X_; if (tid < 256) *(LAS v4u*)(nb_ + sr) = rr##X_; \
        *(LAS v4u*)(nb_ + sv) = rv##X_; } while (0)
    ATT_LOAD(A, 0); ATT_LOAD(B, 1);
    __syncthreads();
    ATT_STORE(A, 0);
    ATT_STORE(B, 1);
    ATT_LOAD(A, 2);
    __syncthreads();
    f32x16 o0, o1, sa0, sa1, sb0, sb1;
#pragma unroll
    for (int i = 0; i < 16; ++i) { o0[i] = 0.f; o1[i] = 0.f; }
    float m = -1e30f, l = 0.f;
    { ATT_KLOAD(lds) ATT_QKM(sa0, sa1); }
    int bcur = 0;
    int j = 0;
    for (; j < ntiles - 2; j += 2) {
        {
            const int b1 = bcur == 2 ? 0 : bcur + 1, b2 = b1 == 2 ? 0 : b1 + 1;
            ATT_LOAD(B, j + 3);
            ATT_STEP(sa0, sa1, sb0, sb1, lds + b1 * ATT2_STAGE, lds + bcur * ATT2_STAGE + ATT_VOFF, true);
            ATT_STORE(A, b2);
            __syncthreads();
            bcur = b1;
        }
        {
            const int b1 = bcur == 2 ? 0 : bcur + 1, b2 = b1 == 2 ? 0 : b1 + 1;
            if (j + 4 < ntiles) ATT_LOAD(A, j + 4);
            ATT_STEP(sb0, sb1, sa0, sa1, lds + b1 * ATT2_STAGE, lds + bcur * ATT2_STAGE + ATT_VOFF, true);
            ATT_STORE(B, b2);
            __syncthreads();
            bcur = b1;
        }
    }
    {
        { const int b1 = bcur == 2 ? 0 : bcur + 1;
          ATT_STEP(sa0, sa1, sb0, sb1, lds + b1 * ATT2_STAGE, lds + bcur * ATT2_STAGE + ATT_VOFF, true);
          bcur = b1; }
        { ATT_STEP(sb0, sb1, sa0, sa1, lds + bcur * ATT2_STAGE, lds + bcur * ATT2_STAGE + ATT_VOFF, false); }
        __syncthreads();
    }
#undef ATT_LOAD
#undef ATT_STORE
    v2u gmv[2][4];
#pragma unroll
    for (int mt = 0; mt < 2; ++mt)
#pragma unroll
        for (int g = 0; g < 4; ++g) gmv[mt][g] = *(const v2u*)(G1 + (size_t)n * G1W + C_GM + h * 64 + 32 * mt + 8 * g + 4 * hq);
    l += __shfl_xor(l, 32);
    const float inv = rcp_(l);
#pragma unroll
    for (int mt = 0; mt < 2; ++mt)
#pragma unroll
        for (int g = 0; g < 4; ++g) {
            const int dv0 = 32 * mt + 8 * g + 4 * hq;
            const v2u gm = gmv[mt][g];
            const float x0 = (mt ? o1[4 * g + 0] : o0[4 * g + 0]) * inv, x1 = (mt ? o1[4 * g + 1] : o0[4 * g + 1]) * inv, x2 = (mt ? o1[4 * g + 2] : o0[4 * g + 2]) * inv, x3 = (mt ? o1[4 * g + 3] : o0[4 * g + 3]) * inv;
            v2u ov; ov.x = cvtpk(x0 * siluf_(bflo(gm.x)), x1 * siluf_(bfhi(gm.x))); ov.y = cvtpk(x2 * siluf_(bflo(gm.y)), x3 * siluf_(bfhi(gm.y)));
            *(v2u*)((bf16*)a->out + 1024 + (size_t)n * YM_LD + 256 + h * 64 + dv0) = ov;
        }
}
constexpr int N_PHASES = 14;

__device__ __forceinline__ void phase_b(ArgsP a, LAS unsigned char* lds, int layer) {
    volatile LAS unsigned* MISC = (volatile LAS unsigned*)(lds + LDS_MISC);
    unsigned* head = (unsigned*)(a->ws + WS_CTL) + CW_Q + layer * 64;
    const int G = grid_();
    bool first = true;
    for (;;) {
        int idx;
        if (first) { idx = bid_(); first = false; }
        else { __syncthreads(); if (tid_() == 0) MISC[16] = atomicAdd(head, 1u) + (unsigned)G; __syncthreads(); idx = (int)MISC[16]; }
        if (idx >= 1408) break;
#ifdef PROBE_UNIT1
        const unsigned long long pt0_ = __builtin_amdgcn_s_memrealtime();
#endif
        if (idx < 64) rwkv_unit_mfma(a, lds, layer, idx);
        else if (idx < 128) lru_unit_q(a, lds, layer, idx - 64);
        else if (idx < 640) att_unit2(a, lds, idx - 128);
        else if (idx < 896) rwkv_unit_mfma(a, lds, layer, 64 + idx - 640);
        else if (idx < 1152) lru_unit_q(a, lds, layer, 64 + idx - 896);
        else att_unit2(a, lds, 512 + idx - 1152);
#ifdef PROBE_UNIT1
        if (tid_() == 0 && layer == 0) { const unsigned d_ = (unsigned)(__builtin_amdgcn_s_memrealtime() - pt0_);
            const int ty_ = idx < 64 ? 0 : idx < 128 ? 1 : idx < 640 ? 2 : idx < 896 ? 3 : idx < 1152 ? 4 : 5;
            atomicMax((unsigned*)(a->ws + WS_CTL) + CW_Q + 1024 + ty_ * 64, d_); }
#endif
    }
}

#define ARGS_VIEW() ({ ArgsP p_ = (ArgsP)__builtin_amdgcn_kernarg_segment_ptr(); asm volatile("" : "+s"(p_)); p_; })
__global__ void __launch_bounds__(NTHREADS, 2) mk_fwd(Args args) {
    extern __shared__ __attribute__((aligned(16))) unsigned char lds_raw[];
    LAS unsigned char* lds = (LAS unsigned char*)lds_raw;
    volatile LAS unsigned* MISC = (volatile LAS unsigned*)(lds + LDS_MISC);
    for (int u = threadIdx.x; u < 64; u += NTHREADS) MISC[u] = 0u;
    __syncthreads();
    XcdBarrier bar;
    { ArgsP a = ARGS_VIEW(); bar = xcd_barrier_post((unsigned*)(a->ws + WS_CTL) + CW_BAR, MISC + 8); }
    int lo, hi; { ArgsP a = ARGS_VIEW(); lo = a->ph_lo; hi = a->ph_hi; }
#define IN(k) (lo <= (k) && (k) < hi)
#ifdef PROBE_MASK1
#define STAMP(k) do { if (bid_() == 0 && tid_() == 0) { const unsigned long long t_ = __builtin_amdgcn_s_memrealtime(); MISC[32 + 2 * (k)] = (unsigned)t_; MISC[33 + 2 * (k)] = (unsigned)(t_ >> 32); } } while (0)
#else
#define STAMP(k) do { } while (0)
#endif
#define SEAM(k) do { if (IN(k) && IN((k) + 1)) xcd_barrier(bar); STAMP((k) + 1); } while (0)
    STAMP(0);
    if (IN(0)) { { ArgsP a = ARGS_VIEW(); phase_p0(a, lds); } __syncthreads(); { ArgsP a = ARGS_VIEW(); phase_p0_weights(a, lds, 0, 1408, 0); } }
    SEAM(0);
    for (int layer = 0; layer < 2; ++layer) {
        const int p = 1 + 6 * layer;
        if (IN(p + 0)) { { ArgsP a = ARGS_VIEW(); phase_a0(a, lds, layer); } { ArgsP a = ARGS_VIEW(); phase_cache_rows(a, layer); } }
        SEAM(p + 0);
        if (IN(p + 1)) { ArgsP a = ARGS_VIEW(); phase_a1_pg8(a, lds, layer); }
        SEAM(p + 1);
        if (IN(p + 2)) { ArgsP a = ARGS_VIEW(); phase_a2b(a, lds, layer); }
        SEAM(p + 2);
        if (IN(p + 3)) { ArgsP a = ARGS_VIEW(); phase_b(a, lds, layer); }
        SEAM(p + 3);
        if (IN(p + 4)) { ArgsP a = ARGS_VIEW(); phase_c1(a, layer); }
        SEAM(p + 4);
        if (IN(p + 5)) { ArgsP a = ARGS_VIEW(); phase_c2_pg8(a, lds, layer); }
        SEAM(p + 5);
    }
    if (IN(N_PHASES - 1)) { ArgsP a = ARGS_VIEW(); phase_final(a); }
#ifdef PROBE_MASK1
    STAMP(14);
    __syncthreads();
    if (bid_() == 0) {
        ArgsP a = ARGS_VIEW();
        float t1 = 0.f, t2 = 0.f;
        for (int k = 0; k < 14; ++k) { const unsigned long long s0 = ((unsigned long long)MISC[33 + 2 * k] << 32) | MISC[32 + 2 * k], s1 = ((unsigned long long)MISC[35 + 2 * k] << 32) | MISC[34 + 2 * k];
            const float us = (float)(s1 - s0) * 0.01f; if ((PROBE_MASK1 >> k) & 1) t1 += us; if ((PROBE_MASK2 >> k) & 1) t2 += us; }
#ifdef PROBE_A2SPLIT
        { const unsigned long long s3 = ((unsigned long long)MISC[33 + 2 * 3] << 32) | MISC[32 + 2 * 3], s20 = ((unsigned long long)MISC[33 + 2 * 20] << 32) | MISC[32 + 2 * 20], s21 = ((unsigned long long)MISC[33 + 2 * 21] << 32) | MISC[32 + 2 * 21], s4 = ((unsigned long long)MISC[33 + 2 * 4] << 32) | MISC[32 + 2 * 4];
          t1 = (float)(s20 - s3) * 0.01f; t2 = (float)(s4 - s21) * 0.01f; }
#endif
#ifdef PROBE_UNIT1
        t1 = (float)((unsigned*)(a->ws + WS_CTL))[CW_Q + 1024 + PROBE_UNIT1 * 64] * 0.01f; t2 = (float)((unsigned*)(a->ws + WS_CTL))[CW_Q + 1024 + PROBE_UNIT2 * 64] * 0.01f;
#endif
        for (int i = tid_(); i < 32768; i += NTHREADS) a->out[O_LRU + i] *= (1.f + t2 * (1.f / 2000.f));
        if (tid_() == 0) a->out[0] += 2.f + t1 * PROBE_T1S;
    }
#endif
#undef IN
#undef SEAM
}

extern "C" void kernel_launch(void* const* d_in, const int* in_sizes, int n_in, void* d_out, int out_size, void* d_ws, size_t ws_size, hipStream_t stream) {
    static int grid = 0;
    if (grid == 0) {
        if (n_in != N_IN || ws_size < WS_END) { fprintf(stderr, "kernel_launch: unexpected n_in %d / ws_size %zu\n", n_in, ws_size); grid = -1; return; }
        int dev = 0, cus = 0;
        if (hipGetDevice(&dev) != hipSuccess || hipDeviceGetAttribute(&cus, hipDeviceAttributeMultiprocessorCount, dev) != hipSuccess) { grid = -1; return; }
        if (hipFuncSetAttribute((const void*)mk_fwd, hipFuncAttributeMaxDynamicSharedMemorySize, LDS_BYTES) != hipSuccess) { fprintf(stderr, "kernel_launch: hipFuncSetAttribute failed\n"); grid = -1; return; }
        int per_cu = 0;
        if (hipOccupancyMaxActiveBlocksPerMultiprocessor(&per_cu, (const void*)mk_fwd, NTHREADS, LDS_BYTES) != hipSuccess || per_cu < 1) fprintf(stderr, "kernel_launch: occupancy query reports %d\n", per_cu);
        (void)hipGetLastError();
        grid = cus;
    }
    if (grid < 0) return;
    if (hipMemsetAsync((char*)d_ws + WS_CTL, 0, CTL_ZERO_BYTES, stream) != hipSuccess) return;
    Args a{};
    for (int i = 0; i < N_IN; ++i) a.in[i] = (const float*)d_in[i];
    a.out = (float*)d_out; a.ws = (unsigned char*)d_ws;
    a.ph_lo = 0; a.ph_hi = N_PHASES;
    hipLaunchKernelGGL(mk_fwd, dim3(grid), dim3(NTHREADS), LDS_BYTES, stream, a);
}
```

```cpp
#include <hip/hip_runtime.h>
#include <cstdio>
#include <cstdint>

#define GAS __attribute__((address_space(1)))
#define LAS __attribute__((address_space(3)))
typedef unsigned short bf16;
typedef unsigned v4u __attribute__((ext_vector_type(4)));
typedef unsigned v2u __attribute__((ext_vector_type(2)));
typedef float f32x4 __attribute__((ext_vector_type(4)));
typedef short bf16x8 __attribute__((ext_vector_type(8)));

constexpr int D = 1024, T_CTX = 8192, T_LAT = 16384, T = 24576, L_CTX = 256, L_LAT = 2048, PAST = 256;
constexpr int NIN = 2816, G1W = 2304, G2W = 512;
constexpr int C_R = 0, C_K = 256, C_V = 512, C_G = 768, C_GM = 1024, C_XL = 1536, C_GL = 1792, C_LORA = 2048;
constexpr int LK_LAT = PAST + L_LAT;
constexpr int TK = T_CTX + 8 * LK_LAT;
constexpr int VT_LAT = 32 * 8 * 64 * 256;
constexpr float LN_EPS = 1e-5f, GN_EPS = 64e-5f;
constexpr float ALPHA = 1.4142135623730951f;
constexpr float QSCALE = 0.10206207261596575f * 1.4426950408889634f;
constexpr size_t O_Y = 0, O_RW = 25165824, O_CKV = 27262976, O_KR = 29360128, O_LRU = 29884416;
constexpr size_t MiB = 1u << 20;
constexpr size_t WS_CTL = 0, CTL_ZERO_BYTES = 1 * MiB;
constexpr size_t WS_MOD = 256 * 1024;
constexpr size_t WS_ROPE = 1 * MiB;
constexpr size_t WS_LORA2 = 1280 * 1024;
constexpr size_t WS_LRUW = 2816 * 1024;
constexpr size_t WS_STATS = 1536 * 1024;
constexpr size_t WS_WUQ = 2 * MiB;
constexpr size_t WS_WUKV = 3 * MiB;
constexpr size_t WS_WIN = 4 * MiB;
constexpr size_t WS_WOUT = 16 * MiB;
constexpr size_t WS_G1 = 20 * MiB;
constexpr size_t WS_G2 = 128 * MiB;
constexpr size_t WS_Q = 152 * MiB;
constexpr size_t WS_KN = 188 * MiB;
constexpr size_t WS_KR = 214 * MiB;
constexpr size_t WS_VT = 216 * MiB;
constexpr int YM_LD = 2048;
constexpr size_t WS_HF = 242 * MiB;
constexpr size_t WS_END = 254 * MiB;
constexpr int CW_BAR = 4096;
constexpr int CW_Q = 16384;

__device__ __forceinline__ float bf2f(unsigned b) { return __uint_as_float(b << 16); }
__device__ __forceinline__ float bflo(unsigned w) { return __uint_as_float(w << 16); }
__device__ __forceinline__ float bfhi(unsigned w) { return __uint_as_float(w & 0xffff0000u); }
__device__ __forceinline__ unsigned f2bf(float f) { unsigned u = __float_as_uint(f); return (u + 0x7fffu + ((u >> 16) & 1u)) >> 16; }
__device__ __forceinline__ unsigned pk2(float lo, float hi) { return f2bf(lo) | (f2bf(hi) << 16); }
__device__ __forceinline__ float rcp_(float x) { return __builtin_amdgcn_rcpf(x); }
__device__ __forceinline__ float exp_(float x) { return __builtin_amdgcn_exp2f(x * 1.4426950408889634f); }
__device__ __forceinline__ float sqrt_(float x) { return __builtin_amdgcn_sqrtf(x); }
__device__ __forceinline__ float rsqrt_(float x) { return __builtin_amdgcn_rsqf(x); }
__device__ __forceinline__ float sigmoidf_(float x) { return rcp_(1.f + exp_(-x)); }
__device__ __forceinline__ float siluf_(float x) { return x * rcp_(1.f + exp_(-x)); }
template <int CTRL> __device__ __forceinline__ float dpp_f(float old, float x) { return __builtin_bit_cast(float, __builtin_amdgcn_update_dpp(__builtin_bit_cast(int, old), __builtin_bit_cast(int, x), CTRL, 0xf, 0xf, false)); }
__device__ __forceinline__ float row16_sum(float x) { x += dpp_f<0x128>(0.f, x); x += dpp_f<0x124>(0.f, x); x += dpp_f<0x122>(0.f, x); x += dpp_f<0x121>(0.f, x); return x; }
__device__ __forceinline__ float wave_sum_fast(float x) { x = row16_sum(x); x += __shfl_xor(x, 16); x += __shfl_xor(x, 32); return x; }
__device__ __forceinline__ float row16_prefix_prod(float x) { x *= dpp_f<0x111>(1.f, x); x *= dpp_f<0x112>(1.f, x); x *= dpp_f<0x114>(1.f, x); x *= dpp_f<0x118>(1.f, x); return x; }
__device__ __forceinline__ float wave_sum(float v) { return wave_sum_fast(v); }
__device__ __forceinline__ int tid_() { int t = threadIdx.x; asm volatile("" : "+v"(t)); return t; }
__device__ __forceinline__ int bid_() { int b = blockIdx.x; asm volatile("" : "+s"(b)); return b; }
__device__ __forceinline__ int grid_() { int g = gridDim.x; asm volatile("" : "+s"(g)); return g; }
typedef float f32x16 __attribute__((ext_vector_type(16)));
typedef float f32x2_t __attribute__((ext_vector_type(2)));
typedef __bf16 bf16x2_t __attribute__((ext_vector_type(2)));
__device__ __forceinline__ unsigned cvtpk(float lo, float hi) { const f32x2_t v = {lo, hi}; return __builtin_bit_cast(unsigned, __builtin_convertvector(v, bf16x2_t)); }
#define XB_TMO      128
#define XB_XCNT(j)  (256  + 64 * (j))
#define XB_XSUB(j)  (1280 + 64 * (j))
#define XB_XGEN(j)  (2304 + 64 * (j))
#define XB_TOP      3328
#define XB_TOPGEN   3392
#define XCD_BAR_WORDS 3456
#define XB_SPIN_CAP (1u << 24)

__device__ __forceinline__ unsigned xb_ld(unsigned* p)              { return __hip_atomic_load(p, __ATOMIC_RELAXED, __HIP_MEMORY_SCOPE_AGENT); }
__device__ __forceinline__ unsigned xb_add(unsigned* p, unsigned v) { return __hip_atomic_fetch_add(p, v, __ATOMIC_RELAXED, __HIP_MEMORY_SCOPE_AGENT); }
__device__ __forceinline__ unsigned xb_xcc_id() { return (unsigned)__builtin_amdgcn_s_getreg((3 << 11) | 20) & 0xFu; }
#define XB_SPIN(cond, bar) do { unsigned _sp = 0; while (cond) { __builtin_amdgcn_s_sleep(1); \
    if ((++_sp & 255u) == 0u) { if (xb_ld(&(bar)[XB_TMO])) break; if (_sp > XB_SPIN_CAP) { atomicAdd(&(bar)[XB_TMO], 1u); break; } } } } while (0)

struct XcdBarrier {
    unsigned* bar; unsigned x;
    volatile LAS unsigned* st;
};

__device__ __forceinline__ XcdBarrier xcd_barrier_post(unsigned* bar, volatile LAS unsigned* st) {
    XcdBarrier b; b.bar = bar; b.x = xb_xcc_id(); b.st = st;
    if (threadIdx.x == 0) (void)xb_add(&bar[XB_XCNT(b.x)], 1u);
    return b;
}
__device__ __forceinline__ void xcd_barrier_complete(unsigned* bar, unsigned x, unsigned& nloc, unsigned& nx) {
    const unsigned G = gridDim.x * gridDim.y * gridDim.z;
    unsigned sum, cnt, mine, sp = 0u;
    for (;;) {
        sum = 0u; cnt = 0u; mine = 0u;
#pragma unroll
        for (unsigned j = 0; j < 16; ++j) { const unsigned c = xb_ld(&bar[XB_XCNT(j)]); sum += c; cnt += (c > 0u) ? 1u : 0u; mine = (j == x) ? c : mine; }
        if (sum == G) break;
        __builtin_amdgcn_s_sleep(1);
        if ((++sp & 255u) == 0u) { if (xb_ld(&bar[XB_TMO])) break; if (sp > XB_SPIN_CAP) { atomicAdd(&bar[XB_TMO], 1u); break; } }
    }
    nloc = mine > 0u ? mine : 1u; nx = cnt > 0u ? cnt : 1u;
}

__device__ __forceinline__ void xcd_barrier(const XcdBarrier& b) {
    asm volatile("s_waitcnt vmcnt(0)" ::: "memory");
    __syncthreads();
    if (threadIdx.x == 0) {
        unsigned* bar = b.bar;
        __builtin_amdgcn_s_waitcnt(0);
        unsigned nloc = b.st[0], nx = b.st[1];
        if (nloc == 0u) { xcd_barrier_complete(bar, b.x, nloc, nx); b.st[0] = nloc; b.st[1] = nx; }
        const unsigned old = xb_add(&bar[XB_XSUB(b.x)], 1u);
        const unsigned gen = old / nloc;
        if (old + 1u == (gen + 1u) * nloc) {
            __builtin_amdgcn_fence(__ATOMIC_RELEASE, "agent");
            asm volatile("s_waitcnt vmcnt(0)" ::: "memory");
            const unsigned og = xb_add(&bar[XB_TOP], 1u);
            const unsigned tg = og / nx;
            if (og + 1u == (tg + 1u) * nx) xb_add(&bar[XB_TOPGEN], 1u);
            else XB_SPIN(xb_ld(&bar[XB_TOPGEN]) == tg, bar);
            __builtin_amdgcn_fence(__ATOMIC_ACQUIRE, "agent");
            xb_add(&bar[XB_XGEN(b.x)], 1u);
            asm volatile("s_waitcnt vmcnt(0)" ::: "memory");
        } else {
            XB_SPIN(xb_ld(&bar[XB_XGEN(b.x)]) == gen, bar);
            __builtin_amdgcn_fence(__ATOMIC_ACQUIRE, "agent");
            asm volatile("s_waitcnt vmcnt(0)" ::: "memory");
        }
    }
    __syncthreads();
}
enum { I_XP = 0, I_XS, I_SRW, I_CCKV, I_CKR, I_SLRU, I_C, I_CCTX, I_WMOD, I_BMOD, I_WIN, I_W0, I_W1, I_W2, I_A0, I_A1, I_A2, I_KK, I_KA, I_RK,
       I_LNXG, I_LNXB, I_QNORM, I_WUQ, I_KVNORM, I_WUKV, I_CONVW, I_CONVB, I_WA, I_BA, I_WX, I_BX, I_LAMBDA, I_WOUT, I_LNG, I_LNB, N_IN };
struct Args { const float* in[N_IN]; float* out; unsigned char* ws; int ph_lo, ph_hi; };
typedef const Args __attribute__((address_space(4)))* ArgsP;
constexpr int NTHREADS = 512;
constexpr int LDS_MISC = 139264;
constexpr int LDS_BYTES = 147456;

struct Tok { int n, b, t, L, lat, modrow, tok0, kidx; };
__device__ __forceinline__ Tok tok_of(int n) {
    Tok k; k.n = n;
    if (n < T_CTX) { k.lat = 0; k.b = n >> 8; k.t = n & 255; k.L = L_CTX; k.modrow = 0; k.tok0 = k.b * 256; k.kidx = n; }
    else { const int m = n - T_CTX; k.lat = 1; k.b = m >> 11; k.t = m & 2047; k.L = L_LAT; k.modrow = 1 + k.b; k.tok0 = T_CTX + k.b * 2048; k.kidx = T_CTX + k.b * LK_LAT + PAST + k.t; }
    return k;
}
__device__ __forceinline__ const float* xrow_src(ArgsP a, int layer, int n) {
    if (layer == 0) return n < T_CTX ? a->in[I_XP] + (size_t)n * D : a->in[I_XS] + (size_t)(n - T_CTX) * D;
    return a->out + (size_t)n * D;
}
__device__ __forceinline__ float dot8(v4u a, v4u b, float acc) {
    acc = fmaf(bflo(a.x), bflo(b.x), acc); acc = fmaf(bfhi(a.x), bfhi(b.x), acc);
    acc = fmaf(bflo(a.y), bflo(b.y), acc); acc = fmaf(bfhi(a.y), bfhi(b.y), acc);
    acc = fmaf(bflo(a.z), bflo(b.z), acc); acc = fmaf(bfhi(a.z), bfhi(b.z), acc);
    acc = fmaf(bflo(a.w), bflo(b.w), acc); acc = fmaf(bfhi(a.w), bfhi(b.w), acc);
    return acc;
}

__device__ __forceinline__ void tr_item(const float* src, int ld, int col0, int k0, bf16* WT, int K, int row0, float scale, LAS float* scr, int lane) {
    {
        const int kr = lane >> 3, n4 = (lane & 7) * 4;
        f32x4 v[8];
#pragma unroll
        for (int i = 0; i < 8; ++i) v[i] = src ? __builtin_nontemporal_load((const f32x4*)(src + (size_t)(k0 + i * 8 + kr) * ld + col0 + n4)) : (f32x4){0.f, 0.f, 0.f, 0.f};
#pragma unroll
        for (int i = 0; i < 8; ++i) { LAS float* d = scr + (i * 8 + kr) * 33 + n4; d[0] = v[i].x * scale; d[1] = v[i].y * scale; d[2] = v[i].z * scale; d[3] = v[i].w * scale; }
    }
    asm volatile("s_waitcnt lgkmcnt(0)" ::: "memory");
    const int c = lane & 7;
#pragma unroll
    for (int j = 0; j < 4; ++j) { const int n = (lane >> 3) + 8 * j; const LAS float* s = scr + (8 * c) * 33 + n;
        v4u o; o.x = cvtpk(s[0 * 33], s[1 * 33]); o.y = cvtpk(s[2 * 33], s[3 * 33]); o.z = cvtpk(s[4 * 33], s[5 * 33]); o.w = cvtpk(s[6 * 33], s[7 * 33]);
        *(v4u*)(WT + (size_t)(row0 + n) * K + k0 + 8 * c) = o; }
    asm volatile("s_waitcnt lgkmcnt(0)" ::: "memory");
}
__device__ __forceinline__ void rope_angle(int t, int i, float& c, float& s) {
    const int row = t >> 6, col = t & 63; const int ii = i & 7;
    const float inv = exp2f(-(float)ii * (13.287712379549449f / 8.f));
    const float ang = (float)(i < 8 ? row : col) * inv;
    c = cosf(ang); s = sinf(ang);
}
__device__ __forceinline__ void phase_p0_weights(ArgsP a, LAS unsigned char* lds, int lo, int hi, int b0, int b1 = 1 << 30) {
    const int tid = tid_(), lane = tid & 63, wave = tid >> 6, G = grid_() < b1 ? grid_() : b1;
    if (bid_() < b0 || bid_() >= G) return;
    unsigned char* ws = a->ws;
    LAS float* scr = (LAS float*)(lds + wave * 8704);
    const int gw = (bid_() - b0) * 8 + wave, NGW = (G - b0) * 8;
    constexpr int N_WIN = 2 * 16 * 88, N_WOUT = 2 * 16 * 32, N_WUQ = 2 * 4 * 24, N_WUKV = 2 * 4 * 32, N_LORA = 2 * 2 * 2 * 8, N_LRUW = 2 * 2 * 2 * 4 * 2;
    if (hi > N_WIN + N_WOUT + N_WUQ + N_WUKV + N_LORA + N_LRUW) hi = N_WIN + N_WOUT + N_WUQ + N_WUKV + N_LORA + N_LRUW;
    for (int it = lo + gw; it < hi; it += NGW) {
        int r = it;
        if (r < N_WIN) {
            const int l = r / (16 * 88), kb = (r / 88) % 16, nb = r % 88, j0 = nb * 32;
            const float* src; int ld, col0;
            const float* win = a->in[I_WIN] + (size_t)l * 1024 * 2464;
            if (j0 < 1024) { src = win; ld = 2464; col0 = j0; }
            else if (j0 < 1536) { src = win; ld = 2464; col0 = 1440 + (j0 - 1024); }
            else if (j0 < 1792) { src = win; ld = 2464; col0 = 1952 + (j0 - 1536); }
            else if (j0 < 2048) { src = win; ld = 2464; col0 = 2208 + (j0 - 1792); }
            else if (j0 < 2304) { const int q = (j0 - 2048) >> 6; src = (q < 2 ? a->in[I_W1] : a->in[I_A1]) + (size_t)(l * 2 + (q & 1)) * 1024 * 64; ld = 64; col0 = (j0 - 2048) & 63; }
            else if (j0 < 2560) { src = win; ld = 2464; col0 = 1024 + (j0 - 2304); }
            else if (j0 < 2688) { src = win; ld = 2464; col0 = 1280 + (j0 - 2560); }
            else if (j0 < 2720) { src = win; ld = 2464; col0 = 1408 + (j0 - 2688); }
            else { src = nullptr; ld = 0; col0 = 0; }
            tr_item(src, ld, col0, kb * 64, (bf16*)(ws + WS_WIN) + (size_t)l * NIN * 1024, 1024, j0, 1.f, scr, lane);
            continue;
        }
        r -= N_WIN;
        if (r < N_WOUT) { const int l = r / (16 * 32), kb = (r / 32) % 16, nb = r % 32;
            tr_item(a->in[I_WOUT] + (size_t)l * 1024 * 1024, 1024, nb * 32, kb * 64, (bf16*)(ws + WS_WOUT) + (size_t)l * 1024 * 1024, 1024, nb * 32, 1.f, scr, lane); continue; }
        r -= N_WOUT;
        if (r < N_WUQ) { const int l = r / (4 * 24), kb = (r / 24) % 4, nb = r % 24;
            tr_item(a->in[I_WUQ] + (size_t)l * 256 * 768, 768, nb * 32, kb * 64, (bf16*)(ws + WS_WUQ) + (size_t)l * 768 * 256, 256, nb * 32, QSCALE, scr, lane); continue; }
        r -= N_WUQ;
        if (r >= N_WUKV) { r -= N_WUKV;
            if (r < N_LORA) { const int le = r >> 4, m = (r >> 3) & 1, nb = r & 7;
                tr_item((m ? a->in[I_A2] : a->in[I_W2]) + (size_t)le * 64 * 256, 256, nb * 32, 0, (bf16*)(ws + WS_LORA2) + (size_t)(le * 2 + m) * 256 * 64, 64, nb * 32, 1.f, scr, lane); }
            else { r -= N_LORA; const int le = r >> 4, m = (r >> 3) & 1, g = (r >> 1) & 3, nb = r & 1;
                tr_item((m ? a->in[I_WX] : a->in[I_WA]) + (size_t)(le * 4 + g) * 4096, 64, nb * 32, 0, (bf16*)(ws + WS_LRUW) + (size_t)((le * 2 + m) * 4 + g) * 4096, 64, nb * 32, 1.f, scr, lane); }
            continue; }
        { const int l = r / (4 * 32), kb = (r / 32) % 4, nb = r % 32;
            tr_item(kb < 2 ? a->in[I_WUKV] + (size_t)l * 128 * 1024 : nullptr, 1024, nb * 32, kb * 64, (bf16*)(ws + WS_WUKV) + (size_t)l * 1024 * 256, 256, nb * 32, 1.f, scr, lane); }
    }
}
__device__ __forceinline__ void phase_p0(ArgsP a, LAS unsigned char* lds) {
    const int tid = tid_(), G = grid_();
    unsigned char* ws = a->ws;
    { float* ROPE = (float*)(ws + WS_ROPE);
      for (int i = bid_() * NTHREADS + tid; i < 2048 * 16; i += G * NTHREADS) { float c, s; rope_angle(i >> 4, i & 15, c, s); ROPE[i * 2] = c; ROPE[i * 2 + 1] = s; } }
    float* MOD = (float*)(ws + WS_MOD);
    LAS float* SIL = (LAS float*)lds;
    for (int it = bid_(); it < 2 * 6 * 32; it += G) {
        const int l = it / 192, nb = (it / 32) % 6, kq = it % 32, col = nb * 512 + tid;
        __syncthreads();
        if (tid < 288) { const int j = tid >> 5, k = kq * 32 + (tid & 31); const float cj = (j == 0) ? a->in[I_CCTX][k] : a->in[I_C][(j - 1) * 1024 + k]; SIL[tid] = siluf_(cj); }
        float w[32];
#pragma unroll
        for (int kk = 0; kk < 32; ++kk) w[kk] = __builtin_nontemporal_load(&a->in[I_WMOD][((size_t)l * 1024 + kq * 32 + kk) * 3072 + col]);
        __syncthreads();
        const float bias = (kq == 0) ? a->in[I_BMOD][l * 3072 + col] : 0.f;
#pragma unroll
        for (int j = 0; j < 9; ++j) { float acc = bias;
#pragma unroll
            for (int k4 = 0; k4 < 8; ++k4) { const f32x4 sv = *(const LAS f32x4*)(SIL + j * 32 + k4 * 4); acc = fmaf(sv.x, w[k4 * 4], acc); acc = fmaf(sv.y, w[k4 * 4 + 1], acc); acc = fmaf(sv.z, w[k4 * 4 + 2], acc); acc = fmaf(sv.w, w[k4 * 4 + 3], acc); }
            atomicAdd(&MOD[(l * 9 + j) * 3072 + col], acc); }
    }
}

template <int LAYER> __device__ __forceinline__ void a0_rows(ArgsP a, LAS unsigned char* lds) {
    const int tid = tid_(), lane = tid & 63, wave = tid >> 6, G = grid_();
    bf16* U = (bf16*)a->out + 1024;
    LAS float* ML = (LAS float*)lds;
    { const float* MOD = (const float*)(a->ws + WS_MOD) + (size_t)LAYER * 9 * 3072;
      for (int i = tid; i < 9 * 512; i += NTHREADS) { const int r = i >> 9, c4 = (i & 511) * 4; *(LAS f32x4*)(ML + r * 2048 + c4) = *(const f32x4*)(MOD + r * 3072 + c4); } }
    f32x4 gq[4], bq[4];
#pragma unroll
    for (int j = 0; j < 4; ++j) { gq[j] = LAYER ? *(const f32x4*)(a->in[I_LNG] + lane * 4 + 256 * j) : (f32x4){0.f, 0.f, 0.f, 0.f}; bq[j] = LAYER ? *(const f32x4*)(a->in[I_LNB] + lane * 4 + 256 * j) : (f32x4){0.f, 0.f, 0.f, 0.f}; }
    __syncthreads();
    f32x4 ra[4], rb[4];
    auto load = [&](f32x4 (&r)[4], int nn) __attribute__((always_inline)) {
        if (LAYER == 0) { const float* xr = xrow_src(a, 0, nn);
#pragma unroll
            for (int j = 0; j < 4; ++j) r[j] = __builtin_nontemporal_load((const f32x4*)(xr + lane * 4 + 256 * j)); }
        else { const bf16* zr = (const bf16*)a->out + (size_t)nn * 2048;
#pragma unroll
            for (int j = 0; j < 4; ++j) { const v2u w = __builtin_nontemporal_load((const v2u*)(zr + lane * 4 + 256 * j)); r[j].x = __uint_as_float(w.x); r[j].y = __uint_as_float(w.y); } }
    };
    const int stride = G * 8, n0 = bid_() * 8 + wave;
    if (n0 < T) load(ra, n0);
    if (n0 + stride < T) load(rb, n0 + stride);
    auto row = [&](int n, f32x4 (&r)[4]) __attribute__((always_inline)) {
        const Tok tk = tok_of(n);
        f32x4 v[4]; float s = 0.f, s2 = 0.f;
#pragma unroll
        for (int j = 0; j < 4; ++j) {
            if (LAYER == 0) v[j] = r[j] * 1.f;
            else { const unsigned wx = __float_as_uint(r[j].x), wy = __float_as_uint(r[j].y); v[j] = (f32x4){bflo(wx), bfhi(wx), bflo(wy), bfhi(wy)}; }
            s += (v[j].x + v[j].y) + (v[j].z + v[j].w); s2 += (v[j].x * v[j].x + v[j].y * v[j].y) + (v[j].z * v[j].z + v[j].w * v[j].w); }
#pragma unroll
        for (int j = 0; j < 4; ++j) asm volatile("" : "+v"(v[j]));
        if (n + 2 * stride < T) load(r, n + 2 * stride);
        float mean = wave_sum(s) * (1.f / D);
        float rstd = rsqrt_(fmaxf(wave_sum(s2) * (1.f / D) - mean * mean, 0.f) + LN_EPS);
        if (LAYER == 1) {
            s = 0.f; s2 = 0.f;
#pragma unroll
            for (int j = 0; j < 4; ++j) { v[j] = (v[j] - mean) * rstd * gq[j] + bq[j]; s += (v[j].x + v[j].y) + (v[j].z + v[j].w); s2 += (v[j].x * v[j].x + v[j].y * v[j].y) + (v[j].z * v[j].z + v[j].w * v[j].w); }
            if (lane == 0) { float* st = (float*)(a->ws + WS_STATS) + (size_t)n * 2; st[0] = mean; st[1] = rstd; }
            mean = wave_sum(s) * (1.f / D);
            rstd = rsqrt_(fmaxf(wave_sum(s2) * (1.f / D) - mean * mean, 0.f) + LN_EPS);
        }
#pragma unroll
        for (int j = 0; j < 4; ++j) v[j] = v[j] - mean;
        const LAS float* m = ML + tk.modrow * 2048;
#pragma unroll
        for (int j = 0; j < 4; ++j) { const int c = lane * 4 + 256 * j; const f32x4 sh = *(const LAS f32x4*)(m + c), sc = *(const LAS f32x4*)(m + 1024 + c);
            const f32x4 o = v[j] * rstd * (sc + 1.f) + sh;
            v2u p; p.x = cvtpk(o.x, o.y); p.y = cvtpk(o.z, o.w); *(v2u*)(U + (size_t)n * YM_LD + c) = p; }
    };
    for (int n = n0; n < T; n += 2 * stride) { row(n, ra); if (n + stride < T) row(n + stride, rb); }
    __syncthreads();
}
__device__ __forceinline__ void phase_a0(ArgsP a, LAS unsigned char* lds, int layer) {
    const int tid = tid_(), lane = tid & 63, wave = tid >> 6;
    const int r = bid_() * 8 + wave; const bool has = r < 2048;
    const int b = r >> 8, j = r & 255; const size_t src = (size_t)(b * 2 + layer) * 256 + j;
    f32x4 c0 = {0.f, 0.f, 0.f, 0.f}, c1 = {0.f, 0.f, 0.f, 0.f};
    if (has && lane < 16) { c0 = *(const f32x4*)(a->in[I_CCKV] + src * 128 + lane * 8); c1 = *(const f32x4*)(a->in[I_CCKV] + src * 128 + lane * 8 + 4); }
    else if (has && lane >= 32 && lane < 36) { c0 = *(const f32x4*)(a->in[I_CKR] + src * 32 + (lane - 32) * 8); c1 = *(const f32x4*)(a->in[I_CKR] + src * 32 + (lane - 32) * 8 + 4); }
    if (layer == 0) a0_rows<0>(a, lds); else a0_rows<1>(a, lds);
    if (has) { bf16* KR = (bf16*)(a->ws + WS_KR); bf16* CK = (bf16*)(a->ws + WS_HF);
        const v4u w = (v4u){cvtpk(c0.x, c0.y), cvtpk(c0.z, c0.w), cvtpk(c1.x, c1.y), cvtpk(c1.z, c1.w)};
        if (lane < 32) *(v4u*)(CK + (size_t)r * 512 + lane * 8) = w;
        else if (lane < 36) *(v4u*)(KR + (size_t)(T_CTX + b * LK_LAT + j) * 32 + (lane - 32) * 8) = w; }
}
__device__ __forceinline__ void phase_final(ArgsP a) {
    const int tid = tid_(), lane = tid & 63, wave = tid >> 6, G = grid_();
    f32x4 gq[4], bq[4];
#pragma unroll
    for (int j = 0; j < 4; ++j) { gq[j] = *(const f32x4*)(a->in[I_LNG] + 1024 + lane * 4 + 256 * j); bq[j] = *(const f32x4*)(a->in[I_LNB] + 1024 + lane * 4 + 256 * j); }
    v2u ra[4], rb[4];
    auto load = [&](v2u (&r)[4], int nn) __attribute__((always_inline)) { const bf16* zr = (const bf16*)a->out + (size_t)nn * 2048;
#pragma unroll
        for (int j = 0; j < 4; ++j) r[j] = __builtin_nontemporal_load((const v2u*)(zr + lane * 4 + 256 * j)); };
    const int stride = G * 8, n0 = bid_() * 8 + wave;
    if (n0 < T) load(ra, n0);
    if (n0 + stride < T) load(rb, n0 + stride);
    auto row = [&](int n, v2u (&r)[4]) __attribute__((always_inline)) {
        float* xr = a->out + (size_t)n * D;
        f32x4 v[4]; float s = 0.f;
#pragma unroll
        for (int j = 0; j < 4; ++j) { v[j] = (f32x4){bflo(r[j].x), bfhi(r[j].x), bflo(r[j].y), bfhi(r[j].y)}; s += (v[j].x + v[j].y) + (v[j].z + v[j].w); }
#pragma unroll
        for (int j = 0; j < 4; ++j) asm volatile("" : "+v"(v[j]));
        if (n + 2 * stride < T) load(r, n + 2 * stride);
        const float mean = wave_sum(s) * (1.f / D); float s2 = 0.f;
#pragma unroll
        for (int j = 0; j < 4; ++j) { v[j] = v[j] - mean; s2 += (v[j].x * v[j].x + v[j].y * v[j].y) + (v[j].z * v[j].z + v[j].w * v[j].w); }
        const float rstd = rsqrt_(wave_sum(s2) * (1.f / D) + LN_EPS);
#pragma unroll
        for (int j = 0; j < 4; ++j) __builtin_nontemporal_store(v[j] * rstd * gq[j] + bq[j], (f32x4*)(xr + lane * 4 + 256 * j));
    };
    for (int n = n0; n < T; n += 2 * stride) { row(n, ra); if (n + stride < T) row(n + stride, rb); }
}


namespace pg8 {
#define PG8_LAS __attribute__((address_space(3)))
typedef unsigned short bf16_t;
typedef short bf16x8 __attribute__((ext_vector_type(8)));
typedef float f32x4 __attribute__((ext_vector_type(4)));
typedef unsigned u32x4 __attribute__((ext_vector_type(4)));
constexpr int BM = 256, BK = 64, HALF = 128, HTB = HALF * BK * 2  , STAGE_BYTES = 8 * HTB, NXCD = 8, WGM = 8;

__host__ __device__ __forceinline__ int lds_byte(int r, int c) { const int st = (r >> 4) * 2 + (c >> 5), rr = r & 15, cc = c & 31, ob = rr * 64 + cc * 2; return st * 1024 + (ob ^ (((ob >> 9) & 1) << 5)); }
__host__ __device__ __forceinline__ void stage_rc(int b, int& R, int& C) { const int st = b / 1024, sb = b % 1024, swz = sb ^ (((sb >> 9) & 1) << 5); R = (st >> 1) * 16 + swz / 64; C = (st & 1) * 32 + (swz % 64) / 2; }
__host__ __device__ __forceinline__ int perm32(int rho) { const int n = rho >> 4, i = rho & 15; return 8 * (i >> 2) + 4 * n + (i & 3); }

struct Unit { int pm, pn, gid; };
struct Gemm { const bf16_t* A; const bf16_t* Bt; int M, N, K, lda, ldb; };

struct StaticOrder {
    int nM, nN, nwg, G, c, lim;
    __host__ __device__ void init(int M, int N, int G_, int c_) { nM = M / BM; nN = N / BM; nwg = nM * nN; G = G_; c = c_; lim = nwg; }
    __host__ __device__ void tile(int L, Unit& u) const {
        int wgid = L; { const int q = nwg / NXCD, r = nwg % NXCD, xcd = wgid % NXCD, off = wgid / NXCD; wgid = (xcd < r ? xcd * (q + 1) : r * (q + 1) + (xcd - r) * q) + off; }
        const int nig = WGM * nN, gid = wgid / nig, fm = gid * WGM, gsz = (nM - fm) < WGM ? (nM - fm) : WGM;
        u.pm = fm + ((wgid % nig) % gsz); u.pn = (wgid % nig) / gsz; u.gid = 0;
    }
    __host__ __device__ bool next(int i, Unit& u) const { const long L = (long)i * G + c; if (L >= lim) return false; tile((int)L, u); return true; }
    __device__ __forceinline__ const char* abase(const Gemm& g, const Unit& u) const { return (const char*)g.A + (size_t)u.pm * BM * g.lda * 2; }
    __device__ __forceinline__ const char* bbase(const Gemm& g, const Unit& u) const { return (const char*)g.Bt + (size_t)u.pn * BM * g.ldb * 2; }
    __device__ __forceinline__ int ktiles(const Gemm& g, const Unit&) const { return g.K / BK; }
    __device__ __forceinline__ void a_ready(const Unit&) const {}
    __device__ __forceinline__ void done(const Unit&) const {}
};
struct HalfOrder {
    StaticOrder so; int first;
    __device__ __forceinline__ bool next(int i, Unit& u) const { const int h = i * so.G + so.c; if (h >= 2 * (so.nwg - first)) return false; so.tile(first + (h >> 1), u); u.pn = u.pn * 2 + (h & 1); return true; }
    __device__ __forceinline__ const char* abase(const Gemm& g, const Unit& u) const { return (const char*)g.A + (size_t)u.pm * BM * g.lda * 2; }
    __device__ __forceinline__ const char* bbase(const Gemm& g, const Unit& u) const { return (const char*)g.Bt + (size_t)u.pn * HALF * g.ldb * 2; }
    __device__ __forceinline__ int ktiles(const Gemm& g, const Unit&) const { return g.K / BK; }
    __device__ __forceinline__ void a_ready(const Unit&) const {}
    __device__ __forceinline__ void done(const Unit&) const {}
};
__host__ __device__ __forceinline__ int a1_perm(int pn) { return pn == 3 ? 5 : pn == 5 ? 3 : pn == 7 ? 10 : pn == 10 ? 7 : pn; }
struct A1Order {
    StaticOrder so; int one;
    __device__ __forceinline__ bool next(int i, Unit& u) const { if (one >= 0) { if (i > 0) return false; so.tile(one, u); } else if (!so.next(i, u)) return false; u.pn = a1_perm(u.pn); return true; }
    __device__ __forceinline__ const char* abase(const Gemm& g, const Unit& u) const { return (const char*)g.A + (size_t)u.pm * BM * g.lda * 2; }
    __device__ __forceinline__ const char* bbase(const Gemm& g, const Unit& u) const { return (const char*)g.Bt + (size_t)u.pn * BM * g.ldb * 2; }
    __device__ __forceinline__ int ktiles(const Gemm& g, const Unit&) const { return g.K / BK; }
    __device__ __forceinline__ void a_ready(const Unit&) const {}
    __device__ __forceinline__ void done(const Unit&) const {}
};
__device__ __forceinline__ unsigned cvt_pk_bf16(float lo, float hi) { unsigned r; asm volatile("v_cvt_pk_bf16_f32 %0, %1, %2" : "=v"(r) : "v"(lo), "v"(hi)); return r; }

template <class Epi, class Sched, bool STAMP = false, int NB = 2>
__device__ __forceinline__ void gemm_phase(PG8_LAS unsigned char* lds, const Gemm g, const Sched& S, const Epi& E, unsigned long long* stamps) {
    const int tid = tid_(), wid = __builtin_amdgcn_readfirstlane(tid >> 6), lane = tid & 63, wr = wid >> 2, wc = wid & 3, fr = lane & 15, fq = lane >> 4;
    int nt;
    int ts_lo = 0, ts_hi = 0, nts = 0; const unsigned long long rt_entry = STAMP ? (unsigned long long)wall_clock64() : 0ull;
#define PG8_STAMP() do { if (STAMP && wid == 0 && nts < 64) { const unsigned long long _c = (unsigned long long)clock64(); \
        ts_lo = (lane == nts) ? (int)(unsigned)_c : ts_lo; ts_hi = (lane == nts) ? (int)(unsigned)(_c >> 32) : ts_hi; ++nts; } } while (0)
    PG8_STAMP();
    unsigned voffA[2], voffB[2];
#pragma unroll
    for (int i = 0; i < 2; ++i) { int R, C; stage_rc(tid * 16 + i * 8192, R, C); const int Rb = Epi::PERM ? ((R & ~31) + perm32(R & 31)) : R;
        voffA[i] = (unsigned)(R * g.lda + C) * 2u; voffB[i] = (unsigned)(Rb * g.ldb + C) * 2u; }
    const size_t kstep = (size_t)(BK * 2);
    const size_t hstepA = (size_t)HALF * g.lda * 2, hstepB = (size_t)HALF * g.ldb * 2;
    const unsigned ldsw = (unsigned)wid * 1024u;
    const int aoff = lds_byte(wr * 64 + fr, fq * 8), boff = lds_byte(wc * 32 + fr, fq * 8);
#define PG8_SA(b, h) (((b) * 2 + (h)) * HTB)
#define PG8_SB(b, h) ((4 + (b) * 2 + (h)) * HTB)
#define PG8_STAGE(bufoff, gbase, voff) do { _Pragma("unroll") for (int _i = 0; _i < 2; ++_i) \
        __builtin_amdgcn_global_load_lds((const unsigned*)((const char*)(gbase) + (voff)[_i]), (PG8_LAS unsigned*)(lds + (bufoff) + ldsw + _i * 8192), 16, 0, 0); } while (0)
#define PG8_LDA(dst, b, h) do { _Pragma("unroll") for (int m = 0; m < 4; ++m) _Pragma("unroll") for (int k = 0; k < 2; ++k) dst[m][k] = *(const PG8_LAS bf16x8*)(lds + PG8_SA(b, h) + aoff + m * 2048 + k * 1024); } while (0)
#define PG8_LDB(dst, b, h) do { _Pragma("unroll") for (int n = 0; n < 2; ++n) _Pragma("unroll") for (int k = 0; k < 2; ++k) dst[n][k] = *(const PG8_LAS bf16x8*)(lds + PG8_SB(b, h) + boff + n * 2048 + k * 1024); } while (0)
#define PG8_MMA(ai, bj, At, Bt) do { __builtin_amdgcn_s_setprio(1); _Pragma("unroll") for (int m = 0; m < 4; ++m) _Pragma("unroll") for (int n = 0; n < 2; ++n) _Pragma("unroll") for (int k = 0; k < 2; ++k) \
        acc[ai][bj][m][n] = __builtin_amdgcn_mfma_f32_16x16x32_bf16(Bt[n][k], At[m][k], acc[ai][bj][m][n], 0, 0, 0); __builtin_amdgcn_s_setprio(0); } while (0)
#define PG8_WAIT_V(n) asm volatile("s_waitcnt vmcnt(" #n ")" ::: "memory")
#define PG8_WAIT_L(n) asm volatile("s_waitcnt lgkmcnt(" #n ")" ::: "memory")
#define PG8_BAR __builtin_amdgcn_s_barrier()
#define PG8_SCHED __builtin_amdgcn_sched_barrier(0)
    Unit cur, nxt; int ui = 0;
    if (!S.next(0, cur)) return;
    f32x4 acc[2][2][4][2];
#pragma unroll
    for (int a = 0; a < 2; ++a)
#pragma unroll
        for (int b = 0; b < 2; ++b)
#pragma unroll
            for (int m = 0; m < 4; ++m)
#pragma unroll
                for (int n = 0; n < 2; ++n) acc[a][b][m][n] = (f32x4){0.f, 0.f, 0.f, 0.f};
    bf16x8 At[4][2], B0[2][2], B1[2][2];
    const char* cA = S.abase(g, cur); const char* cB = S.bbase(g, cur);
    nt = S.ktiles(g, cur);
    S.a_ready(cur);
    PG8_STAGE(PG8_SB(0, 0), cB, voffB); PG8_STAGE(PG8_SA(0, 0), cA, voffA); if constexpr (NB == 2) PG8_STAGE(PG8_SB(0, 1), cB + hstepB, voffB); PG8_STAGE(PG8_SA(0, 1), cA + hstepA, voffA);
    if (wr == 1) PG8_BAR;
    if constexpr (NB == 2) PG8_WAIT_V(4); else PG8_WAIT_V(2);
    PG8_BAR;
    PG8_STAGE(PG8_SB(1, 0), cB + kstep, voffB); PG8_STAGE(PG8_SA(1, 0), cA + kstep, voffA); if constexpr (NB == 2) PG8_STAGE(PG8_SB(1, 1), cB + hstepB + kstep, voffB);
    if constexpr (NB == 2) PG8_WAIT_V(6); else PG8_WAIT_V(4);
    PG8_BAR;
    PG8_STAMP();
    for (;;) {
        const bool has_next = S.next(ui + 1, nxt);
        const char* nA = has_next ? S.abase(g, nxt) : cA; const char* nB = has_next ? S.bbase(g, nxt) : cB;
        for (int t = 0; t < nt; t += 2) {
            const bool last = (t == nt - 2);
            const char* a1 = cA + (size_t)(t + 1) * kstep;
            const char* a2 = last ? nA : cA + (size_t)(t + 2) * kstep; const char* b2 = last ? nB : cB + (size_t)(t + 2) * kstep;
            const char* a3 = a2 + kstep; const char* b3 = b2 + kstep;
            if (last && has_next) S.a_ready(nxt);
            PG8_LDB(B0, 0, 0); PG8_SCHED; PG8_LDA(At, 0, 0); PG8_STAGE(PG8_SA(1, 1), a1 + hstepA, voffA);
            PG8_WAIT_L(8); PG8_BAR; PG8_WAIT_L(0); PG8_MMA(0, 0, At, B0); PG8_BAR; PG8_SCHED;
            if constexpr (NB == 2) PG8_LDB(B1, 0, 1); PG8_STAGE(PG8_SB(0, 0), b2, voffB);
            PG8_BAR; PG8_WAIT_L(0); if constexpr (NB == 2) PG8_MMA(0, 1, At, B1); PG8_BAR;
            PG8_LDA(At, 0, 1); PG8_STAGE(PG8_SA(0, 0), a2, voffA);
            PG8_BAR; PG8_WAIT_L(0); PG8_MMA(1, 0, At, B0); PG8_BAR; PG8_SCHED;
            if constexpr (NB == 2) PG8_STAGE(PG8_SB(0, 1), b2 + hstepB, voffB);
            if constexpr (NB == 2) PG8_WAIT_V(6); else PG8_WAIT_V(4);
            PG8_BAR; if constexpr (NB == 2) PG8_MMA(1, 1, At, B1); PG8_BAR;
            PG8_LDB(B0, 1, 0); PG8_SCHED; PG8_LDA(At, 1, 0); PG8_STAGE(PG8_SA(0, 1), a2 + hstepA, voffA);
            PG8_WAIT_L(8); PG8_BAR; PG8_WAIT_L(0); PG8_MMA(0, 0, At, B0); PG8_BAR; PG8_SCHED;
            if constexpr (NB == 2) PG8_LDB(B1, 1, 1); PG8_STAGE(PG8_SB(1, 0), b3, voffB);
            PG8_BAR; PG8_WAIT_L(0); if constexpr (NB == 2) PG8_MMA(0, 1, At, B1); PG8_BAR;
            PG8_LDA(At, 1, 1); PG8_STAGE(PG8_SA(1, 0), a3, voffA);
            PG8_BAR; PG8_WAIT_L(0); PG8_MMA(1, 0, At, B0); PG8_BAR; PG8_SCHED;
            if constexpr (NB == 2) PG8_STAGE(PG8_SB(1, 1), b3 + hstepB, voffB);
            if constexpr (NB == 2) PG8_WAIT_V(6); else PG8_WAIT_V(4);
            PG8_BAR; if constexpr (NB == 2) PG8_MMA(1, 1, At, B1); PG8_BAR;
        }
        PG8_STAMP();
        if constexpr (!Epi::AFTER_DRAIN) { E(acc, cur, wr, wc, fr, fq); S.done(cur); }
        PG8_STAMP();
        if (!has_next) break;
#pragma unroll
        for (int a = 0; a < 2; ++a)
#pragma unroll
            for (int b = 0; b < 2; ++b)
#pragma unroll
                for (int m = 0; m < 4; ++m)
#pragma unroll
                    for (int n = 0; n < 2; ++n) acc[a][b][m][n] = (f32x4){0.f, 0.f, 0.f, 0.f};
        cur = nxt; cA = nA; cB = nB; ++ui; nt = S.ktiles(g, cur);
    }
    PG8_WAIT_V(0);
    if (wr == 0) PG8_BAR;
    PG8_BAR;
    if constexpr (Epi::AFTER_DRAIN) { E.fused(acc, cur, wr, wc, fr, fq, lds, wid, lane); S.done(cur); }
    PG8_STAMP();
    if (STAMP && wid == 0) { stamps[lane] = lane < nts ? (((unsigned long long)(unsigned)ts_hi << 32) | (unsigned)ts_lo) : 0ull;
        if (lane == 62) stamps[62] = rt_entry; if (lane == 63) stamps[63] = (unsigned long long)wall_clock64(); }
#undef PG8_STAMP
#undef PG8_SA
#undef PG8_SB
#undef PG8_STAGE
#undef PG8_LDA
#undef PG8_LDB
#undef PG8_MMA
#undef PG8_WAIT_V
#undef PG8_WAIT_L
#undef PG8_BAR
#undef PG8_SCHED
}
}
namespace pg8 {
struct EpiIn {
    static constexpr bool PERM = true, AFTER_DRAIN = false;
    bf16_t* G1; bf16_t* G2; bf16_t* KR; float* out; const float* rope; const float* qnw; const float* kvnw; PG8_LAS float* red; int layer;
    __device__ __forceinline__ void operator()(const f32x4 (&acc)[2][2][4][2], const Unit& u, int wr, int wc, int fr, int fq) const {
        const int row0 = u.pm * BM + wr * 64 + fr;
        if (u.pn < 9) {
            const int col0 = u.pn * 256 + wc * 32 + 8 * fq;
#pragma unroll
            for (int ai = 0; ai < 2; ++ai)
#pragma unroll
                for (int m = 0; m < 4; ++m) { bf16_t* rowp = G1 + (size_t)(row0 + ai * HALF + m * 16) * 2304 + col0;
#pragma unroll
                    for (int bj = 0; bj < 2; ++bj) { const f32x4 v0 = acc[ai][bj][m][0], v1 = acc[ai][bj][m][1];
                        u32x4 w; w.x = cvt_pk_bf16(v0[0], v0[1]); w.y = cvt_pk_bf16(v0[2], v0[3]); w.z = cvt_pk_bf16(v1[0], v1[1]); w.w = cvt_pk_bf16(v1[2], v1[3]);
                        *(u32x4*)(rowp + bj * HALF) = w; } }
            return;
        }
        const bool cqt = u.pn == 9, lat = u.pm * BM >= 8192;
        const int cb = wc * 32 + 8 * fq;
        const int rl0 = wr * 64 + fr;
#pragma unroll
        for (int am = 0; am < 8; ++am) { const int ai = am >> 2, m = am & 3;
            const f32x4 a0 = acc[ai][0][m][0], a1 = acc[ai][0][m][1], b0 = acc[ai][1][m][0], b1 = acc[ai][1][m][1];
            float s = (a0[0] * a0[0] + a0[1] * a0[1]) + (a0[2] * a0[2] + a0[3] * a0[3]) + (a1[0] * a1[0] + a1[1] * a1[1]) + (a1[2] * a1[2] + a1[3] * a1[3]);
            if (cqt) s += (b0[0] * b0[0] + b0[1] * b0[1]) + (b0[2] * b0[2] + b0[3] * b0[3]) + (b1[0] * b1[0] + b1[1] * b1[1]) + (b1[2] * b1[2] + b1[3] * b1[3]);
            s += __shfl_xor(s, 16); s += __shfl_xor(s, 32);
            if (fq == 0) red[(rl0 + ai * HALF + m * 16) * 4 + wc] = s; }
        asm volatile("s_waitcnt lgkmcnt(0)" ::: "memory"); __builtin_amdgcn_s_barrier();
        f32x4 nw[2][2];
#pragma unroll
        for (int n = 0; n < 2; ++n) { nw[0][n] = cqt ? *(const f32x4*)(qnw + layer * 256 + cb + n * 4) : *(const f32x4*)(kvnw + layer * 128 + cb + n * 4);
            nw[1][n] = cqt ? *(const f32x4*)(qnw + layer * 256 + HALF + cb + n * 4) : (f32x4){1.f, 1.f, 1.f, 1.f}; }
        const bool krl = !cqt && wc == 0;
        f32x4 rc[3][2];
#define EI_LOAD(set_, am_) do { const int n_ = row0 + ((am_) >> 2) * HALF + ((am_) & 3) * 16; const float* rp_ = rope + (unsigned)(((n_ - 8192) & 2047) * 32) + 8 * fq; \
            rc[set_][0] = *(const f32x4*)rp_; rc[set_][1] = *(const f32x4*)(rp_ + 4); } while (0)
        if (krl && lat) { EI_LOAD(0, 0); EI_LOAD(1, 1); EI_LOAD(2, 2); }
#pragma unroll
        for (int am = 0; am < 8; ++am) { const int ai = am >> 2, m = am & 3, n = row0 + ai * HALF + m * 16, set = am % 3;
            const f32x4 pt = *(const PG8_LAS f32x4*)(red + (rl0 + ai * HALF + m * 16) * 4);
            const float rs = __builtin_amdgcn_rsqf(((pt[0] + pt[1]) + (pt[2] + pt[3])) * (cqt ? 1.f / 256.f : 1.f / 128.f) + 1e-6f);
            f32x4 y0 = acc[ai][0][m][0] * rs * nw[0][0], y1 = acc[ai][0][m][1] * rs * nw[0][1];
            f32x4 z0 = acc[ai][1][m][0], z1 = acc[ai][1][m][1];
            if (cqt) { z0 = z0 * rs * nw[1][0]; z1 = z1 * rs * nw[1][1]; }
            u32x4 w0, w1; w0.x = cvt_pk_bf16(y0[0], y0[1]); w0.y = cvt_pk_bf16(y0[2], y0[3]); w0.z = cvt_pk_bf16(y1[0], y1[1]); w0.w = cvt_pk_bf16(y1[2], y1[3]);
            w1.x = cvt_pk_bf16(z0[0], z0[1]); w1.y = cvt_pk_bf16(z0[2], z0[3]); w1.z = cvt_pk_bf16(z1[0], z1[1]); w1.w = cvt_pk_bf16(z1[2], z1[3]);
            u32x4 wk = w1;
            if (krl && lat) { const f32x4 c0 = rc[set][0], c1 = rc[set][1];
                const float r0 = z0[0] * c0[0] - z0[1] * c0[1], r1 = z0[0] * c0[1] + z0[1] * c0[0], r2 = z0[2] * c0[2] - z0[3] * c0[3], r3 = z0[2] * c0[3] + z0[3] * c0[2];
                const float r4 = z1[0] * c1[0] - z1[1] * c1[1], r5 = z1[0] * c1[1] + z1[1] * c1[0], r6 = z1[2] * c1[2] - z1[3] * c1[3], r7 = z1[2] * c1[3] + z1[3] * c1[2];
                wk.x = cvt_pk_bf16(r0, r1); wk.y = cvt_pk_bf16(r2, r3); wk.z = cvt_pk_bf16(r4, r5); wk.w = cvt_pk_bf16(r6, r7); }
            if (krl && lat && am + 3 < 8) { if (set == 0) EI_LOAD(0, am + 3); else if (set == 1) EI_LOAD(1, am + 3); else EI_LOAD(2, am + 3); }
            bf16_t* rowp = G2 + (size_t)n * 512 + (cqt ? 0 : 256) + cb;
            *(u32x4*)rowp = w0; *(u32x4*)(rowp + HALF) = w1;
            if (!cqt) {
                int kidx, bt;
                if (!lat) { kidx = n; bt = ((n >> 8) * 2 + layer) * 256 + (n & 255); } else { const int mrow = n - 8192; kidx = 8192 + (mrow >> 11) * 2304 + 256 + (mrow & 2047); bt = 0; }
                if (!lat) { float* op = out + O_CKV + (size_t)bt * 128 + cb; *(f32x4*)op = y0; *(f32x4*)(op + 4) = y1; }
                if (krl) { if (!lat) { float* op = out + O_KR + (size_t)bt * 32 + 8 * fq; *(f32x4*)op = z0; *(f32x4*)(op + 4) = z1; }
                    *(u32x4*)(KR + (size_t)kidx * 32 + 8 * fq) = wk; }
            }
        }
#undef EI_LOAD
    }
};
template <int NB> struct EpiOutT {
    static constexpr bool PERM = true, AFTER_DRAIN = false;
    const float* xp; const float* xs; float* out; const float* mod; int layer;
    const float* stats; const float* lng; const float* lnb;
    __device__ __forceinline__ void operator()(const f32x4 (&acc)[2][2][4][2], const Unit& u, int wr, int wc, int fr, int fq) const {
        const int row0 = u.pm * BM + wr * 64 + fr, col0 = u.pn * (NB == 2 ? BM : HALF) + wc * 32 + 8 * fq;
        const int rt = u.pm * BM; const int modrow = rt < 8192 ? 0 : 1 + ((rt - 8192) >> 11);
        const float* gp = mod + (size_t)modrow * 3072 + 2048 + col0;
        f32x4 gv[2][2];
#pragma unroll
        for (int bj = 0; bj < NB; ++bj)
#pragma unroll
            for (int n = 0; n < 2; ++n) gv[bj][n] = *(const f32x4*)(gp + bj * HALF + n * 4);
        f32x4 lg[2][2], lb[2][2];
        if (layer) {
#pragma unroll
            for (int bj = 0; bj < NB; ++bj)
#pragma unroll
                for (int n = 0; n < 2; ++n) { lg[bj][n] = *(const f32x4*)(lng + col0 + bj * HALF + n * 4); lb[bj][n] = *(const f32x4*)(lnb + col0 + bj * HALF + n * 4); }
        }
        f32x4 raw[2][4];
#define EO_LOAD(set_, am_) do { const int row_ = row0 + ((am_) >> 2) * HALF + ((am_) & 3) * 16; \
            if (layer == 0) { const float* xr_ = (row_ < 8192 ? xp + (size_t)row_ * 1024 : xs + (size_t)(row_ - 8192) * 1024) + col0; \
                raw[set_][0] = __builtin_nontemporal_load((const f32x4*)(xr_)); raw[set_][1] = __builtin_nontemporal_load((const f32x4*)(xr_ + 4)); if (NB == 2) { raw[set_][2] = __builtin_nontemporal_load((const f32x4*)(xr_ + HALF)); raw[set_][3] = __builtin_nontemporal_load((const f32x4*)(xr_ + HALF + 4)); } } \
            else { const bf16_t* zr_ = (const bf16_t*)out + (size_t)row_ * 2048 + col0; raw[set_][0] = __builtin_nontemporal_load((const f32x4*)zr_); if (NB == 2) raw[set_][1] = __builtin_nontemporal_load((const f32x4*)(zr_ + HALF)); \
                const f32x2_t st_ = *(const f32x2_t*)(stats + (size_t)row_ * 2); raw[set_][2].x = st_.x; raw[set_][2].y = st_.y; } } while (0)
        EO_LOAD(0, 0); EO_LOAD(1, 1);
#pragma unroll
        for (int am = 0; am < 8; ++am) { const int ai = am >> 2, m = am & 3, row = row0 + ai * HALF + m * 16, set = am & 1;
            float mean = 0.f, rstd = 1.f; if (layer) { mean = raw[set][2].x; rstd = raw[set][2].y; }
            u32x4 w[2];
#pragma unroll
            for (int bj = 0; bj < NB; ++bj) { f32x4 z[2];
#pragma unroll
                for (int n = 0; n < 2; ++n) { f32x4 x;
                    if (layer == 0) x = raw[set][bj * 2 + n];
                    else { const unsigned lo = __float_as_uint(n ? raw[set][bj].z : raw[set][bj].x), hi = __float_as_uint(n ? raw[set][bj].w : raw[set][bj].y);
                        x = (f32x4){__uint_as_float(lo << 16), __uint_as_float(lo & 0xffff0000u), __uint_as_float(hi << 16), __uint_as_float(hi & 0xffff0000u)};
                        x = (x - mean) * rstd * lg[bj][n] + lb[bj][n]; }
                    z[n] = x * 1.4142135623730951f + gv[bj][n] * acc[ai][bj][m][n]; }
                w[bj].x = cvt_pk_bf16(z[0][0], z[0][1]); w[bj].y = cvt_pk_bf16(z[0][2], z[0][3]); w[bj].z = cvt_pk_bf16(z[1][0], z[1][1]); w[bj].w = cvt_pk_bf16(z[1][2], z[1][3]); }
            if (am + 2 < 8) { if (set == 0) EO_LOAD(0, am + 2); else EO_LOAD(1, am + 2); }
            bf16_t* orow = (bf16_t*)out + (size_t)row * 2048 + col0;
            *(u32x4*)(orow) = w[0]; if (NB == 2) *(u32x4*)(orow + HALF) = w[1]; }
#undef EO_LOAD
    }
};
typedef EpiOutT<2> EpiOut;
}

__device__ __forceinline__ void phase_a1_pg8(ArgsP a, LAS unsigned char* lds, int layer) {
    pg8::Gemm g{(const bf16*)a->out + 1024, (const bf16*)(a->ws + WS_WIN) + (size_t)layer * NIN * 1024, T, NIN, 1024, YM_LD, 1024};
    pg8::StaticOrder S; S.init(T, NIN, grid_(), bid_());
    const bool defer = S.G == 256 && S.nwg == 1056;
    if (defer) S.lim = 1024;
    pg8::A1Order O{S, -1};
    pg8::EpiIn E{(bf16*)(a->ws + WS_G1), (bf16*)(a->ws + WS_G2), (bf16*)(a->ws + WS_KR), a->out, (const float*)(a->ws + WS_ROPE), a->in[I_QNORM], a->in[I_KVNORM], (LAS float*)(lds + LDS_MISC + 2048), layer};
    pg8::gemm_phase<pg8::EpiIn, pg8::A1Order, false>(lds, g, O, E, nullptr);
    if (layer == 0) { __syncthreads(); phase_p0_weights(a, lds, 3840, 4288, 0);
        if (!defer) { phase_p0_weights(a, lds, 1408, 3840, 0); phase_p0_weights(a, lds, 4288, 1 << 30, 0); } }
}
__device__ __forceinline__ void phase_c2_pg8(ArgsP a, LAS unsigned char* lds, int layer) {
    pg8::Gemm g{(const bf16*)a->out + 1024, (const bf16*)(a->ws + WS_WOUT) + (size_t)layer * 1024 * 1024, T, 1024, 1024, YM_LD, 1024};
    pg8::StaticOrder S; S.init(T, 1024, grid_(), bid_());
    const int whole = (S.nwg / S.G) * S.G;
    S.lim = whole;
    const int flip = (whole < S.nwg) ? (bid_() & 1) : 0;
#pragma unroll 1
    for (int it = 0; it < 2; ++it) {
        if ((it ^ flip) == 0) { pg8::EpiOut E{a->in[I_XP], a->in[I_XS], a->out, (const float*)(a->ws + WS_MOD) + (size_t)layer * 9 * 3072, layer, (const float*)(a->ws + WS_STATS), a->in[I_LNG], a->in[I_LNB]};
            pg8::gemm_phase<pg8::EpiOut, pg8::StaticOrder, false>(lds, g, S, E, nullptr); }
        else if (whole < S.nwg) { pg8::HalfOrder H{S, whole};
            pg8::EpiOutT<1> E{a->in[I_XP], a->in[I_XS], a->out, (const float*)(a->ws + WS_MOD) + (size_t)layer * 9 * 3072, layer, (const float*)(a->ws + WS_STATS), a->in[I_LNG], a->in[I_LNB]};
            pg8::gemm_phase<pg8::EpiOutT<1>, pg8::HalfOrder, false, 1>(lds, g, H, E, nullptr); }
    }
}

__device__ __forceinline__ void phase_cache_rows(ArgsP a, int layer) {
    const int tid = tid_(), lane = tid & 63, wave = tid >> 6, G = grid_();
    bf16* KR = (bf16*)(a->ws + WS_KR); bf16* CK = (bf16*)(a->ws + WS_HF);
    for (int r = bid_() * 8 + wave + G * 8; r < 2048; r += G * 8) {
        const int b = r >> 8, j = r & 255; const size_t src = (size_t)(b * 2 + layer) * 256 + j;
        if (lane < 16) { const f32x4 v0 = *(const f32x4*)(a->in[I_CCKV] + src * 128 + lane * 8), v1 = *(const f32x4*)(a->in[I_CCKV] + src * 128 + lane * 8 + 4);
            *(v4u*)(CK + (size_t)r * 512 + lane * 8) = (v4u){cvtpk(v0.x, v0.y), cvtpk(v0.z, v0.w), cvtpk(v1.x, v1.y), cvtpk(v1.z, v1.w)}; }
        else if (lane < 32) *(v4u*)(CK + (size_t)r * 512 + lane * 8) = (v4u){0u, 0u, 0u, 0u};
        else if (lane < 36) { const f32x4 v0 = *(const f32x4*)(a->in[I_CKR] + src * 32 + (lane - 32) * 8), v1 = *(const f32x4*)(a->in[I_CKR] + src * 32 + (lane - 32) * 8 + 4);
            *(v4u*)(KR + (size_t)(T_CTX + b * LK_LAT + j) * 32 + (lane - 32) * 8) = (v4u){cvtpk(v0.x, v0.y), cvtpk(v0.z, v0.w), cvtpk(v1.x, v1.y), cvtpk(v1.z, v1.w)}; }
    }
}
namespace pg8 {
struct A2Order {
    const char* ws; unsigned oq, okv; int G, c, nmain;
    __device__ __forceinline__ bool next(int i, Unit& u) const {
        int L; if (c < nmain) { L = i * nmain + c; if (L >= (nmain == G ? 704 : 672)) return false; } else { if (i > 0) return false; L = 672 + (c - nmain); if (L >= 704) return false; }
        if (L < 288) { u.gid = 0; u.pm = L / 3; u.pn = L % 3; } else if (L < 672) { u.gid = 1; u.pm = (L - 288) >> 2; u.pn = (L - 288) & 3; } else { u.gid = 2; u.pm = (L - 672) >> 2; u.pn = (L - 672) & 3; }
        return true;
    }
    __device__ __forceinline__ const char* abase(const Gemm&, const Unit& u) const { const unsigned off = u.gid == 0 ? (unsigned)WS_G2 : (u.gid == 1 ? (unsigned)WS_G2 + 512u : (unsigned)WS_HF); return ws + off + (size_t)u.pm * 256 * 512 * 2; }
    __device__ __forceinline__ const char* bbase(const Gemm&, const Unit& u) const { const unsigned off = u.gid == 0 ? oq : okv; return ws + off + (size_t)u.pn * 256 * 256 * 2; }
    __device__ __forceinline__ int ktiles(const Gemm& g, const Unit& u) const { return u.gid == 0 ? g.K / BK : g.K / (2 * BK); }
    __device__ __forceinline__ void a_ready(const Unit&) const {}
    __device__ __forceinline__ void done(const Unit&) const {}
};
struct EpiA2 {
    static constexpr bool PERM = true, AFTER_DRAIN = false;
    bf16_t* Q; bf16_t* KN; bf16_t* VR; const float* rope;
    __device__ __forceinline__ void operator()(const f32x4 (&acc)[2][2][4][2], const Unit& u, int wr, int wc, int fr, int fq) const {
        const int row0 = u.pm * BM + wr * 64 + fr;
        if (u.gid == 0) {
            const int fb = u.pn * 256 + wc * 32 + 8 * fq;
            const int d0 = fb % 96, rsel = d0 >= 64 ? 0 : (d0 >= 32 ? 1 : 2), dd = rsel == 0 ? d0 - 64 : (rsel == 1 ? d0 - 32 : 0);
            const bool lat_tile = u.pm * BM >= 8192;
            f32x4 rc[3][2];
#define EA_LOAD(set_, am_) do { const int row_ = row0 + ((am_) >> 2) * HALF + ((am_) & 3) * 16; const float* rp_ = rope + (unsigned)(((row_ - 8192) & 2047) * 32) + dd; \
                rc[set_][0] = *(const f32x4*)rp_; rc[set_][1] = *(const f32x4*)(rp_ + 4); } while (0)
            if (lat_tile) { EA_LOAD(0, 0); EA_LOAD(1, 1); EA_LOAD(2, 2); }
#pragma unroll
            for (int am = 0; am < 8; ++am) { const int ai = am >> 2, m = am & 3, row = row0 + ai * HALF + m * 16, set = am % 3;
                u32x4 w[2];
#pragma unroll
                for (int bj = 0; bj < 2; ++bj) {
                    f32x4 v0 = acc[ai][bj][m][0], v1 = acc[ai][bj][m][1];
                    if (lat_tile && bj == rsel) { const f32x4 c0 = rc[set][0], c1 = rc[set][1];
                        const f32x4 a0 = v0, a1 = v1;
                        v0[0] = a0[0] * c0[0] - a0[1] * c0[1]; v0[1] = a0[0] * c0[1] + a0[1] * c0[0]; v0[2] = a0[2] * c0[2] - a0[3] * c0[3]; v0[3] = a0[2] * c0[3] + a0[3] * c0[2];
                        v1[0] = a1[0] * c1[0] - a1[1] * c1[1]; v1[1] = a1[0] * c1[1] + a1[1] * c1[0]; v1[2] = a1[2] * c1[2] - a1[3] * c1[3]; v1[3] = a1[2] * c1[3] + a1[3] * c1[2]; }
                    w[bj].x = cvt_pk_bf16(v0[0], v0[1]); w[bj].y = cvt_pk_bf16(v0[2], v0[3]); w[bj].z = cvt_pk_bf16(v1[0], v1[1]); w[bj].w = cvt_pk_bf16(v1[2], v1[3]); }
                if (lat_tile && am + 3 < 8) { if (set == 0) EA_LOAD(0, am + 3); else if (set == 1) EA_LOAD(1, am + 3); else EA_LOAD(2, am + 3); }
                *(u32x4*)(Q + (unsigned)(row * 768 + fb)) = w[0]; *(u32x4*)(Q + (unsigned)(row * 768 + fb + HALF)) = w[1]; }
#undef EA_LOAD
        } else {
            const int x = wc * 32 + 8 * fq;
            bf16_t* base = (wc < 2 ? KN : VR);
            const unsigned xo = (unsigned)(x & 63);
#pragma unroll
            for (int ai = 0; ai < 2; ++ai)
#pragma unroll
                for (int m = 0; m < 4; ++m) { const int row = row0 + ai * HALF + m * 16;
                    int kidx;
                    if (u.gid == 2) kidx = 8192 + (row >> 8) * 2304 + (row & 255);
                    else if (row < 8192) kidx = row;
                    else { const int mrow = row - 8192; kidx = 8192 + (mrow >> 11) * 2304 + 256 + (mrow & 2047); }
#pragma unroll
                    for (int bj = 0; bj < 2; ++bj) { const f32x4 v0 = acc[ai][bj][m][0], v1 = acc[ai][bj][m][1];
                        u32x4 w; w.x = cvt_pk_bf16(v0[0], v0[1]); w.y = cvt_pk_bf16(v0[2], v0[3]); w.z = cvt_pk_bf16(v1[0], v1[1]); w.w = cvt_pk_bf16(v1[2], v1[3]);
                        *(u32x4*)(base + (unsigned)(kidx * 512 + (u.pn * 2 + bj) * 64) + xo) = w; } }
        }
    }
};
}
__device__ __forceinline__ void phase_a2b(ArgsP a, LAS unsigned char* lds, int layer) {
    const int G = grid_(), c = bid_(); const bool defer = G == 256;
    if (defer && c >= G - 32) {
        pg8::Gemm g1{(const bf16*)a->out + 1024, (const bf16*)(a->ws + WS_WIN) + (size_t)layer * NIN * 1024, T, NIN, 1024, YM_LD, 1024};
        pg8::StaticOrder S1; S1.init(T, NIN, G, c);
        pg8::A1Order O{S1, 1024 + (c - (G - 32))};
        pg8::EpiIn E1{(bf16*)(a->ws + WS_G1), (bf16*)(a->ws + WS_G2), (bf16*)(a->ws + WS_KR), a->out, (const float*)(a->ws + WS_ROPE), a->in[I_QNORM], a->in[I_KVNORM], (LAS float*)(lds + LDS_MISC + 2048), layer};
        pg8::gemm_phase<pg8::EpiIn, pg8::A1Order, false>(lds, g1, O, E1, nullptr);
    }
    int kk = 256; asm volatile("" : "+s"(kk));
    pg8::Gemm g{nullptr, nullptr, T, 1024, kk, 512, 256};
    pg8::A2Order S{(const char*)a->ws, (unsigned)(WS_WUQ + (size_t)layer * 768 * 256 * 2), (unsigned)(WS_WUKV + (size_t)layer * 1024 * 256 * 2), G, c, defer ? G - 32 : G};
    pg8::EpiA2 E{(bf16*)(a->ws + WS_Q), (bf16*)(a->ws + WS_KN), (bf16*)(a->ws + WS_VT), (const float*)(a->ws + WS_ROPE)};
    pg8::gemm_phase<pg8::EpiA2, pg8::A2Order, false>(lds, g, S, E, nullptr);
    if (defer && layer == 0) { __syncthreads(); phase_p0_weights(a, lds, 1408, 3840, 0, G - 32); phase_p0_weights(a, lds, 4288, 1 << 30, 0, G - 32); }
}


__device__ __forceinline__ void phase_c1(ArgsP a, int layer) {
    const int tid = tid_(), lane = tid & 63, wave = tid >> 6, G = grid_();
    const bf16* G1 = (const bf16*)(a->ws + WS_G1); const bf16* YS = (const bf16*)(a->ws + WS_G2); const bf16* HF = (const bf16*)(a->ws + WS_HF);
    bf16* Y = (bf16*)a->out + 1024;
    const int ch = lane * 4;
    const f32x4 rk = *(const f32x4*)(a->in[I_RK] + layer * 256 + ch), lg = *(const f32x4*)(a->in[I_LNXG] + layer * 256 + ch), lb = *(const f32x4*)(a->in[I_LNXB] + layer * 256 + ch);
    v2u p_y0, p_y1, p_r, p_k, p_v, p_g, p_h, p_hb, p_gl;
#define C1_LOAD(nn) do { const bf16* g_ = G1 + (size_t)(nn) * G1W; p_y0 = __builtin_nontemporal_load((const v2u*)(YS + (size_t)(nn) * 256 + ch)); p_y1 = __builtin_nontemporal_load((const v2u*)(YS + ((size_t)T + (nn)) * 256 + ch)); \
        p_r = __builtin_nontemporal_load((const v2u*)(g_ + C_R + ch)); p_k = __builtin_nontemporal_load((const v2u*)(g_ + C_K + ch)); p_v = __builtin_nontemporal_load((const v2u*)(g_ + C_V + ch)); p_g = __builtin_nontemporal_load((const v2u*)(g_ + C_G + ch)); \
        p_h = __builtin_nontemporal_load((const v2u*)(HF + (size_t)(nn) * 256 + ch)); p_hb = *(const v2u*)(Y + (size_t)(nn) * YM_LD + 768 + ch); p_gl = __builtin_nontemporal_load((const v2u*)(g_ + C_GL + ch)); } while (0)
    { const int n0 = bid_() * 8 + wave; if (n0 < T) C1_LOAD(n0); }
    for (int n = bid_() * 8 + wave; n < T; n += G * 8) {
        const v2u y0 = p_y0, y1 = p_y1, rv = p_r, kv = p_k, vv = p_v, gv = p_g, hf = p_h, hb = p_hb, gl = p_gl;
        if (n + G * 8 < T) C1_LOAD(n + G * 8);
        float y[4] = {bflo(y0.x) + bflo(y1.x), bfhi(y0.x) + bfhi(y1.x), bflo(y0.y) + bflo(y1.y), bfhi(y0.y) + bfhi(y1.y)};
        float s = (y[0] + y[1]) + (y[2] + y[3]);
        float bon = bflo(rv.x) * bflo(kv.x) * rk.x + bfhi(rv.x) * bfhi(kv.x) * rk.y + bflo(rv.y) * bflo(kv.y) * rk.z + bfhi(rv.y) * bfhi(kv.y) * rk.w;
#pragma unroll
        for (int o = 1; o < 16; o <<= 1) { s += __shfl_xor(s, o); bon += __shfl_xor(bon, o); }
        const float mu = s * (1.f / 64.f);
        float s2 = (y[0] - mu) * (y[0] - mu) + (y[1] - mu) * (y[1] - mu) + (y[2] - mu) * (y[2] - mu) + (y[3] - mu) * (y[3] - mu);
#pragma unroll
        for (int o = 1; o < 16; o <<= 1) s2 += __shfl_xor(s2, o);
        const float rstd = rsqrt_(s2 * (1.f / 64.f) + GN_EPS);
        const float o0 = ((y[0] - mu) * rstd * lg.x + lb.x + bon * bflo(vv.x)) * siluf_(bflo(gv.x));
        const float o1 = ((y[1] - mu) * rstd * lg.y + lb.y + bon * bfhi(vv.x)) * siluf_(bfhi(gv.x));
        const float o2 = ((y[2] - mu) * rstd * lg.z + lb.z + bon * bflo(vv.y)) * siluf_(bflo(gv.y));
        const float o3 = ((y[3] - mu) * rstd * lg.w + lb.w + bon * bfhi(vv.y)) * siluf_(bfhi(gv.y));
        v2u ov; ov.x = cvtpk(o0, o1); ov.y = cvtpk(o2, o3);
        bf16* yr = Y + (size_t)n * YM_LD;
        *(v2u*)(yr + ch) = ov;
        *(v2u*)(yr + 768 + ch) = (v2u){cvtpk((bflo(hf.x) + bflo(hb.x)) * siluf_(bflo(gl.x)), (bfhi(hf.x) + bfhi(hb.x)) * siluf_(bfhi(gl.x))), cvtpk((bflo(hf.y) + bflo(hb.y)) * siluf_(bflo(gl.y)), (bfhi(hf.y) + bfhi(hb.y)) * siluf_(bfhi(gl.y)))};
    }
#undef C1_LOAD
}
#define MFMA32(a, b, c) __builtin_amdgcn_mfma_f32_32x32x16_bf16((a), (b), (c), 0, 0, 0)
#define MFMA16(a, b, c) __builtin_amdgcn_mfma_f32_16x16x32_bf16((a), (b), (c), 0, 0, 0)
typedef short s16x4_t __attribute__((ext_vector_type(4)));

__device__ __forceinline__ float tanh_fast(float x) { return 1.f - 2.f * rcp_(1.f + exp_(2.f * x)); }

constexpr int ATT_KSTR = 208, ATT_VSTR = 136, ATT_VOFF = 64 * ATT_KSTR, ATT_STAGE = 64 * ATT_KSTR + 64 * ATT_VSTR;


constexpr int RW_W2T = 0, RW_A2T = 9216, RW_TH = 18432, RW_HA = 27648, RW_CH0 = 36864, RW_CHB = 20992, RW_YB = 120832;
constexpr int RC_KP = 0, RC_RP = 2304, RC_BP = 4608  , RC_KT = 6912, RC_VR = 9216  , RC_LK = 16896, RC_TM = 17536, RC_ARK = 18176, RC_NARB = 18816, RC_G15 = 19456, RC_LBF = 19712, RC_SSQ = 20736;
template <int MODE = 0> __device__ __forceinline__ void rwkv_unit_mfma(ArgsP a, LAS unsigned char* lds, int layer, int u) {
    const int tid = tid_(), lane = tid & 63, wave = tid >> 6, i16 = lane & 15, g = lane >> 4;
    const int lat = u < 64, uu = lat ? u : u - 64, b = uu >> 3, e = (uu >> 2) & 1, hh = uu & 3;
    const int L = lat ? L_LAT : L_CTX, tok0 = lat ? T_CTX + b * L_LAT : b * L_CTX;
    const bf16* G1 = (const bf16*)(a->ws + WS_G1);
    bf16* YS = (bf16*)(a->ws + WS_G2);
    __syncthreads();
    { const bf16* wsrc = (const bf16*)(a->ws + WS_LORA2) + ((size_t)((layer * 2 + e) * 2) * 256 + hh * 64) * 64; const int row = tid >> 3, c8 = (tid & 7) * 8;
      *(LAS v4u*)(lds + RW_W2T + row * 144 + c8 * 2) = *(const v4u*)(wsrc + row * 64 + c8);
      *(LAS v4u*)(lds + RW_A2T + row * 144 + c8 * 2) = *(const v4u*)(wsrc + 256 * 64 + row * 64 + c8); }
    const int st_tok = tid >> 3, st_c8 = (tid & 7) * 8;
#define RW_STAGE(sc) do { const int step_ = (sc) * 64 + st_tok, t_ = e ? L - 1 - step_ : step_; const bf16* gp_ = G1 + (size_t)(tok0 + t_) * G1W + C_LORA + e * 64 + st_c8; \
        const v4u hw_ = *(const v4u*)gp_, ha_ = *(const v4u*)(gp_ + 128); v4u th_; \
        th_.x = cvtpk(tanh_fast(bflo(hw_.x)), tanh_fast(bfhi(hw_.x))); th_.y = cvtpk(tanh_fast(bflo(hw_.y)), tanh_fast(bfhi(hw_.y))); th_.z = cvtpk(tanh_fast(bflo(hw_.z)), tanh_fast(bfhi(hw_.z))); th_.w = cvtpk(tanh_fast(bflo(hw_.w)), tanh_fast(bfhi(hw_.w))); \
        *(LAS v4u*)(lds + RW_TH + st_tok * 144 + st_c8 * 2) = th_; *(LAS v4u*)(lds + RW_HA + st_tok * 144 + st_c8 * 2) = ha_; } while (0)
    RW_STAGE(0);
    f32x4 ST[4];
    {
        const int v = 16 * (wave & 3) + i16;
#pragma unroll
        for (int kt = 0; kt < 4; ++kt) ST[kt] = lat ? *(const f32x4*)(a->in[I_SRW] + (((size_t)((b * 2 + layer) * 2 + e) * 4 + hh) * 64 + v) * 64 + 16 * kt + 4 * g) : (f32x4){0.f, 0.f, 0.f, 0.f};
    }
    const int pc = wave & 3, ph = wave >> 2;
    LAS unsigned char* CH = lds + RW_CH0 + pc * RW_CHB;
    f32x4 w0r[2], a0r[2], kwr[2], kar[2];
#pragma unroll
    for (int c2 = 0; c2 < 2; ++c2) { const int gch = hh * 64 + (2 * ph + c2) * 16 + 4 * g;
        w0r[c2] = *(const f32x4*)(a->in[I_W0] + (layer * 2 + e) * 256 + gch); a0r[c2] = *(const f32x4*)(a->in[I_A0] + (layer * 2 + e) * 256 + gch);
        kwr[c2] = *(const f32x4*)(a->in[I_KK] + layer * 256 + gch); kar[c2] = *(const f32x4*)(a->in[I_KA] + layer * 256 + gch); }
#pragma unroll
    for (int c2 = 0; c2 < 2; ++c2) asm volatile("" : "+v"(w0r[c2]), "+v"(a0r[c2]), "+v"(kwr[c2]), "+v"(kar[c2]));
#pragma unroll
    for (int kt = 0; kt < 4; ++kt) asm volatile("" : "+v"(ST[kt]));
    __syncthreads();
    const int nsc = L >> 6;
    v2u pk[2], pr[2], pv[2];
#define RW_PREFETCH(sc) do { const int ps_ = (sc) * 64 + pc * 16 + i16, pt_ = e ? L - 1 - ps_ : ps_; const bf16* gq_ = G1 + (size_t)(tok0 + pt_) * G1W + hh * 64 + (2 * ph) * 16 + 4 * g; \
        pk[0] = *(const v2u*)(gq_ + C_K); pk[1] = *(const v2u*)(gq_ + C_K + 16); pr[0] = *(const v2u*)(gq_ + C_R); pr[1] = *(const v2u*)(gq_ + C_R + 16); pv[0] = *(const v2u*)(gq_ + C_V); pv[1] = *(const v2u*)(gq_ + C_V + 16); } while (0)
    RW_PREFETCH(0);
    for (int sc = 0; sc < nsc; ++sc) {
        const v2u ck[2] = {pk[0], pk[1]}, cr[2] = {pr[0], pr[1]}, cv[2] = {pv[0], pv[1]};
        if (sc + 1 < nsc) RW_PREFETCH(sc + 1);
        float dec[8], av[8], kx[8], rx[8], kk[8];
        {
            f32x4 aw[2], aa[2];
#pragma unroll
            for (int c2 = 0; c2 < 2; ++c2) { aw[c2] = (f32x4){0.f, 0.f, 0.f, 0.f}; aa[c2] = (f32x4){0.f, 0.f, 0.f, 0.f}; }
#pragma unroll
            for (int ks = 0; ks < 2; ++ks) {
                const bf16x8 bth = *(const LAS bf16x8*)(lds + RW_TH + (pc * 16 + i16) * 144 + ks * 64 + g * 16), bha = *(const LAS bf16x8*)(lds + RW_HA + (pc * 16 + i16) * 144 + ks * 64 + g * 16);
#pragma unroll
                for (int c2 = 0; c2 < 2; ++c2) { const int row = (2 * ph + c2) * 16 + i16;
                    const bf16x8 w2f = *(const LAS bf16x8*)(lds + RW_W2T + row * 144 + ks * 64 + g * 16), a2f = *(const LAS bf16x8*)(lds + RW_A2T + row * 144 + ks * 64 + g * 16);
                    aw[c2] = MFMA16(w2f, bth, aw[c2]); aa[c2] = MFMA16(a2f, bha, aa[c2]); }
            }
            float ss = 0.f;
#pragma unroll
            for (int c2 = 0; c2 < 2; ++c2) {
                const f32x4 w0 = w0r[c2], a0 = a0r[c2], kw = kwr[c2];
                const v2u kv = ck[c2], rv = cr[c2];
                const float kq[4] = {bflo(kv.x), bfhi(kv.x), bflo(kv.y), bfhi(kv.y)}, rq[4] = {bflo(rv.x), bfhi(rv.x), bflo(rv.y), bfhi(rv.y)};
#pragma unroll
                for (int q = 0; q < 4; ++q) { const int o = c2 * 4 + q;
                    dec[o] = exp_(-0.6065306597126334f * sigmoidf_(aw[c2][q] + w0[q])); av[o] = sigmoidf_(aa[c2][q] + a0[q]);
                    kx[o] = kq[q]; rx[o] = rq[q]; kk[o] = kq[q] * kw[q]; ss += kk[o] * kk[o]; }
            }
            ss += __shfl_xor(ss, 16); ss += __shfl_xor(ss, 32);
            if (g == 0) *(LAS float*)(CH + RC_SSQ + (i16 * 2 + ph) * 4) = ss;
        }
        __syncthreads();
        {
            const float tot = *(const LAS float*)(CH + RC_SSQ + (i16 * 2) * 4) + *(const LAS float*)(CH + RC_SSQ + (i16 * 2 + 1) * 4);
            const float inrm = rcp_(fmaxf(sqrt_(tot), 1e-12f));
            float G8[8], Gx8[8];
#pragma unroll
            for (int o8 = 0; o8 < 8; ++o8) G8[o8] = dec[o8];
#pragma unroll
            for (int o8 = 0; o8 < 8; ++o8) G8[o8] *= dpp_f<0x111>(1.f, G8[o8]);
#pragma unroll
            for (int o8 = 0; o8 < 8; ++o8) G8[o8] *= dpp_f<0x112>(1.f, G8[o8]);
#pragma unroll
            for (int o8 = 0; o8 < 8; ++o8) G8[o8] *= dpp_f<0x114>(1.f, G8[o8]);
#pragma unroll
            for (int o8 = 0; o8 < 8; ++o8) G8[o8] *= dpp_f<0x118>(1.f, G8[o8]);
#pragma unroll
            for (int o8 = 0; o8 < 8; ++o8) Gx8[o8] = dpp_f<0x111>(1.f, G8[o8]);
#pragma unroll
            for (int c2 = 0; c2 < 2; ++c2) { const int ch = (2 * ph + c2) * 16 + 4 * g;
                const f32x4 ka = kar[c2];
                float kp[4], bp[4], kt[4], rp[4];
#pragma unroll
                for (int q = 0; q < 4; ++q) { const int o = c2 * 4 + q;
                    const float G = G8[o], Gex = Gx8[o];
                    const float kkn = kk[o] * inrm, iG = rcp_(G);
                    kp[q] = Gex * kkn; bp[q] = kkn * av[o] * iG; kt[q] = kx[o] * (1.f + (av[o] - 1.f) * ka[q]) * iG; rp[q] = G * rx[o];
                }
                { LAS unsigned char* g15p = (i16 == 15) ? CH + RC_G15 + ch * 4 : lds + (RW_YB + 9216) + lane * 16;
                  *(LAS f32x4*)g15p = (f32x4){G8[c2 * 4 + 0], G8[c2 * 4 + 1], G8[c2 * 4 + 2], G8[c2 * 4 + 3]}; }
                *(LAS v2u*)(CH + RC_KP + i16 * 144 + ch * 2) = (v2u){cvtpk(kp[0], kp[1]), cvtpk(kp[2], kp[3])};
                *(LAS v2u*)(CH + RC_BP + i16 * 144 + ch * 2) = (v2u){cvtpk(-bp[0], -bp[1]), cvtpk(-bp[2], -bp[3])};
                *(LAS v2u*)(CH + RC_KT + i16 * 144 + ch * 2) = (v2u){cvtpk(kt[0], kt[1]), cvtpk(kt[2], kt[3])};
                *(LAS v2u*)(CH + RC_RP + i16 * 144 + ch * 2) = (v2u){cvtpk(rp[0], rp[1]), cvtpk(rp[2], rp[3])};
                *(LAS v2u*)(CH + RC_VR + i16 * 144 + ch * 2) = cv[c2];
            }
        }
        __syncthreads();
        {
            f32x4 d0 = (f32x4){0.f, 0.f, 0.f, 0.f}, d1 = (f32x4){0.f, 0.f, 0.f, 0.f};
            const int xoff = ph ? RC_KP : RC_RP, y0off = ph ? RC_BP : RC_KT, y1off = ph ? RC_KT : RC_BP;
#pragma unroll
            for (int ks = 0; ks < 2; ++ks) {
                const bf16x8 xf = *(const LAS bf16x8*)(CH + xoff + i16 * 144 + ks * 64 + g * 16);
                const bf16x8 y0 = *(const LAS bf16x8*)(CH + y0off + i16 * 144 + ks * 64 + g * 16), y1 = *(const LAS bf16x8*)(CH + y1off + i16 * 144 + ks * 64 + g * 16);
                d0 = MFMA16(xf, y0, d0); d1 = MFMA16(xf, y1, d1);
            }
#pragma unroll
            for (int q = 0; q < 4; ++q) { const int i = 4 * g + q, j = i16;
                if (ph) { *(LAS float*)(CH + RC_LBF + (i * 16 + j) * 4) = (j < i) ? -d0[q] : 0.f; *(LAS bf16*)(CH + RC_LK + i * 40 + j * 2) = (bf16)(cvtpk((j < i) ? d1[q] : 0.f, 0.f) & 0xffffu); }
                else { const unsigned pk_ = cvtpk((j <= i) ? d0[q] : 0.f, (j <= i) ? d1[q] : 0.f); *(LAS bf16*)(CH + RC_ARK + i * 40 + j * 2) = (bf16)(pk_ & 0xffffu); *(LAS bf16*)(CH + RC_NARB + i * 40 + j * 2) = (bf16)(pk_ >> 16); }
            }
            if (ph && !(MODE & 2)) {
                float x[16];
#pragma unroll
                for (int i = 0; i < 16; ++i) { float s = (i == i16) ? 1.f : 0.f;
#pragma unroll
                    for (int j4 = 0; j4 < (i + 3) / 4; ++j4) { const f32x4 lr = *(const LAS f32x4*)(CH + RC_LBF + (i * 16 + j4 * 4) * 4);
#pragma unroll
                        for (int jj = 0; jj < 4; ++jj) { const int j = j4 * 4 + jj; if (j < i) s -= lr[jj] * x[j]; } }
                    x[i] = s; }
                if (g == 0) {
#pragma unroll
                    for (int i = 0; i < 16; i += 2) { const unsigned pk_ = cvtpk(x[i], x[i + 1]); *(LAS bf16*)(CH + RC_TM + i * 40 + i16 * 2) = (bf16)(pk_ & 0xffffu); *(LAS bf16*)(CH + RC_TM + (i + 1) * 40 + i16 * 2) = (bf16)(pk_ >> 16); } }
            }
        }
        __syncthreads();
        if (wave < 4) {
            const int vt = wave;
#pragma unroll 1
            for (int c = 0; c < ((MODE & 1) ? 0 : 4); ++c) {
                const LAS unsigned char* C = lds + RW_CH0 + c * RW_CHB;
                v4u sb01, sb23;
                sb01.x = cvtpk(ST[0][0], ST[0][1]); sb01.y = cvtpk(ST[0][2], ST[0][3]); sb01.z = cvtpk(ST[1][0], ST[1][1]); sb01.w = cvtpk(ST[1][2], ST[1][3]);
                sb23.x = cvtpk(ST[2][0], ST[2][1]); sb23.y = cvtpk(ST[2][2], ST[2][3]); sb23.z = cvtpk(ST[3][0], ST[3][1]); sb23.w = cvtpk(ST[3][2], ST[3][3]);
                const bf16x8 s01 = __builtin_bit_cast(bf16x8, sb01), s23 = __builtin_bit_cast(bf16x8, sb23);
                const v2u kp0a = *(const LAS v2u*)(C + RC_KP + i16 * 144 + (4 * g) * 2), kp0b = *(const LAS v2u*)(C + RC_KP + i16 * 144 + (16 + 4 * g) * 2);
                const v2u kp1a = *(const LAS v2u*)(C + RC_KP + i16 * 144 + (32 + 4 * g) * 2), kp1b = *(const LAS v2u*)(C + RC_KP + i16 * 144 + (48 + 4 * g) * 2);
                const v2u rp0a = *(const LAS v2u*)(C + RC_RP + i16 * 144 + (4 * g) * 2), rp0b = *(const LAS v2u*)(C + RC_RP + i16 * 144 + (16 + 4 * g) * 2);
                const v2u rp1a = *(const LAS v2u*)(C + RC_RP + i16 * 144 + (32 + 4 * g) * 2), rp1b = *(const LAS v2u*)(C + RC_RP + i16 * 144 + (48 + 4 * g) * 2);
                const v2u lk = *(const LAS v2u*)(C + RC_LK + i16 * 40 + g * 8), tm = *(const LAS v2u*)(C + RC_TM + i16 * 40 + g * 8);
                const v2u ark = *(const LAS v2u*)(C + RC_ARK + i16 * 40 + g * 8), narb = *(const LAS v2u*)(C + RC_NARB + i16 * 40 + g * 8);
                const int trq = (i16 >> 2) & 3, trp = i16 & 3;
                const v2u vf = __builtin_bit_cast(v2u, __builtin_amdgcn_ds_read_tr16_b64_v4i16((LAS s16x4_t*)(C + RC_VR + (4 * g + trq) * 144 + (16 * vt + 4 * trp) * 2)));
                const v4u z4 = {0u, 0u, 0u, 0u};
                f32x4 rhs = (f32x4){0.f, 0.f, 0.f, 0.f};
                rhs = MFMA16(__builtin_bit_cast(bf16x8, ((v4u){kp0a.x, kp0a.y, kp0b.x, kp0b.y})), s01, rhs);
                rhs = MFMA16(__builtin_bit_cast(bf16x8, ((v4u){kp1a.x, kp1a.y, kp1b.x, kp1b.y})), s23, rhs);
                rhs = MFMA16(__builtin_bit_cast(bf16x8, ((v4u){lk.x, lk.y, 0u, 0u})), __builtin_bit_cast(bf16x8, ((v4u){vf.x, vf.y, 0u, 0u})), rhs);
                f32x4 z = MFMA16(__builtin_bit_cast(bf16x8, ((v4u){tm.x, tm.y, 0u, 0u})), __builtin_bit_cast(bf16x8, ((v4u){cvtpk(rhs[0], rhs[1]), cvtpk(rhs[2], rhs[3]), 0u, 0u})), ((f32x4){0.f, 0.f, 0.f, 0.f}));
                const bf16x8 vz = __builtin_bit_cast(bf16x8, ((v4u){vf.x, vf.y, cvtpk(z[0], z[1]), cvtpk(z[2], z[3])}));
                f32x4 y = (f32x4){0.f, 0.f, 0.f, 0.f};
                y = MFMA16(__builtin_bit_cast(bf16x8, ((v4u){rp0a.x, rp0a.y, rp0b.x, rp0b.y})), s01, y);
                y = MFMA16(__builtin_bit_cast(bf16x8, ((v4u){rp1a.x, rp1a.y, rp1b.x, rp1b.y})), s23, y);
                y = MFMA16(__builtin_bit_cast(bf16x8, ((v4u){ark.x, ark.y, narb.x, narb.y})), vz, y);
#pragma unroll
                for (int kt = 0; kt < 4; ++kt) {
                    const v2u ktf = __builtin_bit_cast(v2u, __builtin_amdgcn_ds_read_tr16_b64_v4i16((LAS s16x4_t*)(C + RC_KT + (4 * g + trq) * 144 + (16 * kt + 4 * trp) * 2)));
                    const v2u nbf = __builtin_bit_cast(v2u, __builtin_amdgcn_ds_read_tr16_b64_v4i16((LAS s16x4_t*)(C + RC_BP + (4 * g + trq) * 144 + (16 * kt + 4 * trp) * 2)));
                    const f32x4 g15 = *(const LAS f32x4*)(C + RC_G15 + (16 * kt + 4 * g) * 4);
                    ST[kt] = MFMA16(__builtin_bit_cast(bf16x8, ((v4u){ktf.x, ktf.y, nbf.x, nbf.y})), vz, ST[kt]);
                    ST[kt] = ST[kt] * g15;
                }
                { const unsigned y01 = cvtpk(y[0], y[1]), y23 = cvtpk(y[2], y[3]); LAS unsigned char* yb = lds + RW_YB + (c * 16 + 4 * g) * 144 + (16 * vt + i16) * 2;
                  *(LAS bf16*)(yb) = (bf16)(y01 & 0xffffu); *(LAS bf16*)(yb + 144) = (bf16)(y01 >> 16); *(LAS bf16*)(yb + 288) = (bf16)(y23 & 0xffffu); *(LAS bf16*)(yb + 432) = (bf16)(y23 >> 16); }
                (void)z4;
            }
        } else if (sc + 1 < nsc) {
            const int r0 = (tid - 256) >> 3;
#pragma unroll
            for (int hrow = 0; hrow < 2; ++hrow) { const int tokr = r0 + 32 * hrow, step_ = (sc + 1) * 64 + tokr, t_ = e ? L - 1 - step_ : step_;
                const bf16* gp_ = G1 + (size_t)(tok0 + t_) * G1W + C_LORA + e * 64 + st_c8;
                const v4u hw_ = *(const v4u*)gp_, ha_ = *(const v4u*)(gp_ + 128); v4u th_;
                th_.x = cvtpk(tanh_fast(bflo(hw_.x)), tanh_fast(bfhi(hw_.x))); th_.y = cvtpk(tanh_fast(bflo(hw_.y)), tanh_fast(bfhi(hw_.y))); th_.z = cvtpk(tanh_fast(bflo(hw_.z)), tanh_fast(bfhi(hw_.z))); th_.w = cvtpk(tanh_fast(bflo(hw_.w)), tanh_fast(bfhi(hw_.w)));
                *(LAS v4u*)(lds + RW_TH + tokr * 144 + st_c8 * 2) = th_; *(LAS v4u*)(lds + RW_HA + tokr * 144 + st_c8 * 2) = ha_; }
        }
        __syncthreads();
        {
            const int row = tid >> 3, part = tid & 7, step = sc * 64 + row, t = e ? L - 1 - step : step;
            __builtin_nontemporal_store(*(const LAS v4u*)(lds + RW_YB + row * 144 + part * 16), (v4u*)(YS + ((size_t)e * T + tok0 + t) * 256 + hh * 64 + part * 8));
        }
    }
#undef RW_STAGE
#undef RW_PREFETCH
    if (!lat && wave < 4) {
        const int v = 16 * wave + i16;
#pragma unroll
        for (int kt = 0; kt < 4; ++kt) *(f32x4*)(a->out + O_RW + (((size_t)((b * 2 + layer) * 2 + e) * 4 + hh) * 64 + v) * 64 + 16 * kt + 4 * g) = ST[kt];
    }
}


constexpr int LQ_NQ = 32;
constexpr int LQ_WAT = 0, LQ_S0 = 2 * LQ_NQ * 144;
constexpr int LS_XCB = 0, LS_XCQ = 9216, LS_AA = LS_XCQ + 64 * LQ_NQ * 4, LS_BV = LS_AA + 64 * LQ_NQ * 4, LS_HH = LS_BV + 64 * LQ_NQ * 4,
              LS_SP = LS_HH + 64 * LQ_NQ * 4, LS_SH = LS_SP + 8 * LQ_NQ * 4, LS_HC = LS_SH + 8 * LQ_NQ * 4, LS_BYTES = LS_HC + 2 * LQ_NQ * 4;
__device__ __forceinline__ void lru_unit_q(ArgsP a, LAS unsigned char* lds, int layer, int u) {
    const int tid = tid_(), lane = tid & 63, wave = tid >> 6, i16 = lane & 15, g4 = lane >> 4;
    const int lat = u < 64, uu = lat ? u : u - 64, bp = uu >> 4, e = (uu >> 3) & 1, g = (uu >> 1) & 3, oq = uu & 1;
    const int L = lat ? L_LAT : L_CTX;
    const int tokb[2] = {lat ? T_CTX + (2 * bp) * L_LAT : (2 * bp) * L_CTX, lat ? T_CTX + (2 * bp + 1) * L_LAT : (2 * bp + 1) * L_CTX};
    const __amdgpu_buffer_rsrc_t rsx0 = __builtin_amdgcn_make_buffer_rsrc((void*)((const bf16*)(a->ws + WS_G1) + (size_t)tokb[0] * G1W), (short)0, L * G1W * 2, 0x00020000);
    const __amdgpu_buffer_rsrc_t rsx1 = __builtin_amdgcn_make_buffer_rsrc((void*)((const bf16*)(a->ws + WS_G1) + (size_t)tokb[1] * G1W), (short)0, L * G1W * 2, 0x00020000);
    const bf16* G1 = (const bf16*)(a->ws + WS_G1);
    unsigned char* HO = e ? (unsigned char*)a->out + 2048 + 768 * 2 : a->ws + WS_HF;
    const size_t hstr = e ? 4096 : 512;
    const int tt = tid >> 3, q8 = (tid & 7) * 8;
    const unsigned xvo = (unsigned)((C_XL + g * 64 + q8) * 2);
    float cw[4][8], cb[8];
#pragma unroll
    for (int i = 0; i < 8; ++i) { const int ch = g * 64 + q8 + i; cb[i] = a->in[I_CONVB][layer * 256 + ch];
#pragma unroll
        for (int j = 0; j < 4; ++j) cw[j][i] = a->in[I_CONVW][(layer * 4 + j) * 256 + ch]; }
    const int gt = wave & 3, got = wave >> 2;
    const int ssn = tid >> 8, sch = tid & (LQ_NQ - 1), seg = (tid >> 5) & 7;
    const int otok = tid >> 3, oc4 = (tid & 7) * 4;
    const int chq = g * 64 + oq * LQ_NQ;
    LAS unsigned char* SS = lds + LQ_S0 + ssn * LS_BYTES;
    {
        __syncthreads();
        { const int m = tid >> 8, row = (tid >> 3) & 31, c8 = (tid & 7) * 8;
          const bf16* wsrc = (const bf16*)(a->ws + WS_LRUW) + ((size_t)(((layer * 2 + e) * 2 + m) * 4 + g) * 64 + oq * LQ_NQ + row) * 64 + c8;
          *(LAS v4u*)(lds + LQ_WAT + m * LQ_NQ * 144 + row * 144 + c8 * 2) = *(const v4u*)wsrc; }
        if (tid < 2 * LQ_NQ) { const int s = tid >> 5, c = tid & 31; ((LAS float*)(lds + LQ_S0 + s * LS_BYTES + LS_HC))[c] = lat ? a->in[I_SLRU][((size_t)((2 * bp + s) * 2 + layer) * 2 + e) * 256 + chq + c] : 0.f; }
        f32x4 bav, bxv, spl;
        { const int chb = (layer * 2 + e) * 256 + chq + 16 * got + 4 * g4;
          bav = *(const f32x4*)(a->in[I_BA] + chb); bxv = *(const f32x4*)(a->in[I_BX] + chb); const f32x4 lam = *(const f32x4*)(a->in[I_LAMBDA] + chb);
#pragma unroll
          for (int q = 0; q < 4; ++q) spl[q] = log1pf(exp_(-lam[q])); }
        v4u xr[2][4];
#define LQ_PREFETCH(cc_) do { const int c_ = e ? L / 64 - 1 - (cc_) : (cc_), t_ = c_ * 64 + tt; \
            _Pragma("unroll") for (int s = 0; s < 2; ++s) { \
              _Pragma("unroll") for (int j = 0; j < 4; ++j) { const int ts = t_ + j - 2; xr[s][j] = __builtin_amdgcn_raw_buffer_load_b128(s ? rsx1 : rsx0, (unsigned)(ts * (G1W * 2)) + xvo, 0u, 0); }   \
              } } while (0)
        LQ_PREFETCH(0);
        __syncthreads();
        for (int cc = 0; cc < L / 64; ++cc) {
            const int c = e ? L / 64 - 1 - cc : cc;
            v4u xcur[2][4];
#pragma unroll
            for (int s = 0; s < 2; ++s) { xcur[s][0] = xr[s][0]; xcur[s][1] = xr[s][1]; xcur[s][2] = xr[s][2]; xcur[s][3] = xr[s][3]; }
            if (cc + 1 < L / 64) LQ_PREFETCH(cc + 1);
#pragma unroll
            for (int s = 0; s < 2; ++s) {
                LAS unsigned char* SB = lds + LQ_S0 + s * LS_BYTES;
                float xc[8];
#pragma unroll
                for (int i = 0; i < 8; ++i) xc[i] = cb[i];
#pragma unroll
                for (int j = 0; j < 4; ++j) { const v4u x = xcur[s][j];
                    xc[0] += cw[j][0] * bflo(x.x); xc[1] += cw[j][1] * bfhi(x.x); xc[2] += cw[j][2] * bflo(x.y); xc[3] += cw[j][3] * bfhi(x.y);
                    xc[4] += cw[j][4] * bflo(x.z); xc[5] += cw[j][5] * bfhi(x.z); xc[6] += cw[j][6] * bflo(x.w); xc[7] += cw[j][7] * bfhi(x.w); }
                *(LAS v4u*)(SB + LS_XCB + tt * 144 + q8 * 2) = (v4u){cvtpk(xc[0], xc[1]), cvtpk(xc[2], xc[3]), cvtpk(xc[4], xc[5]), cvtpk(xc[6], xc[7])};
                if ((q8 / LQ_NQ) == oq) { LAS float* XCQ = (LAS float*)(SB + LS_XCQ); *(LAS f32x4*)(XCQ + tt * LQ_NQ + (q8 % LQ_NQ)) = (f32x4){xc[0], xc[1], xc[2], xc[3]}; *(LAS f32x4*)(XCQ + tt * LQ_NQ + (q8 % LQ_NQ) + 4) = (f32x4){xc[4], xc[5], xc[6], xc[7]}; }
            }
            __syncthreads();
#pragma unroll
            for (int s = 0; s < 2; ++s) {
                LAS unsigned char* SB = lds + LQ_S0 + s * LS_BYTES;
                const int tk = gt * 16 + i16;
                f32x4 ga = (f32x4){0.f, 0.f, 0.f, 0.f}, gx = (f32x4){0.f, 0.f, 0.f, 0.f};
#pragma unroll
                for (int ks = 0; ks < 2; ++ks) { const bf16x8 xf = *(const LAS bf16x8*)(SB + LS_XCB + tk * 144 + ks * 64 + g4 * 16);
                    const bf16x8 wa = *(const LAS bf16x8*)(lds + LQ_WAT + (16 * got + i16) * 144 + ks * 64 + g4 * 16), wx = *(const LAS bf16x8*)(lds + LQ_WAT + LQ_NQ * 144 + (16 * got + i16) * 144 + ks * 64 + g4 * 16);
                    ga = MFMA16(wa, xf, ga); gx = MFMA16(wx, xf, gx); }
                const f32x4 xcv = *(const LAS f32x4*)((LAS float*)(SB + LS_XCQ) + tk * LQ_NQ + 16 * got + 4 * g4);
                f32x4 av, bv;
#pragma unroll
                for (int q = 0; q < 4; ++q) { const float la = -8.f * sigmoidf_(ga[q] + bav[q]) * spl[q], aq = exp_(la); av[q] = aq; bv[q] = sqrt_((1.f - aq) * (1.f + aq)) * sigmoidf_(gx[q] + bxv[q]) * xcv[q]; }
                *(LAS f32x4*)((LAS float*)(SB + LS_AA) + tk * LQ_NQ + 16 * got + 4 * g4) = av; *(LAS f32x4*)((LAS float*)(SB + LS_BV) + tk * LQ_NQ + 16 * got + 4 * g4) = bv;
            }
            __syncthreads();
            LAS float* AA = (LAS float*)(SS + LS_AA); LAS float* BV = (LAS float*)(SS + LS_BV); LAS float* HH = (LAS float*)(SS + LS_HH);
            LAS float* SP = (LAS float*)(SS + LS_SP); LAS float* SH = (LAS float*)(SS + LS_SH); LAS float* HC = (LAS float*)(SS + LS_HC);
            float av8[8], bv8[8];
            {
                float P = 1.f, H = 0.f;
#pragma unroll
                for (int s = 0; s < 8; ++s) { const int p = seg * 8 + s, st = e ? 63 - p : p; av8[s] = AA[st * LQ_NQ + sch]; bv8[s] = BV[st * LQ_NQ + sch]; H = fmaf(av8[s], H, bv8[s]); P *= av8[s]; }
                SP[seg * LQ_NQ + sch] = P; SH[seg * LQ_NQ + sch] = H;
            }
            __syncthreads();
            {
                float h = HC[(cc & 1) * LQ_NQ + sch];
                for (int s2 = 0; s2 < seg; ++s2) h = fmaf(SP[s2 * LQ_NQ + sch], h, SH[s2 * LQ_NQ + sch]);
#pragma unroll
                for (int s = 0; s < 8; ++s) { const int p = seg * 8 + s, st = e ? 63 - p : p; h = fmaf(av8[s], h, bv8[s]); HH[st * LQ_NQ + sch] = h; }
                if (seg == 7) HC[((cc + 1) & 1) * LQ_NQ + sch] = h;
            }
            __syncthreads();
#pragma unroll
            for (int s = 0; s < 2; ++s) {
                const int n = tokb[s] + c * 64 + otok;
                const f32x4 hv = *(const LAS f32x4*)((LAS float*)(lds + LQ_S0 + s * LS_BYTES + LS_HH) + otok * LQ_NQ + oc4);
                __builtin_nontemporal_store((v2u){cvtpk(hv[0], hv[1]), cvtpk(hv[2], hv[3])}, (v2u*)(HO + (size_t)n * hstr + (chq + oc4) * 2));
            }
        }
#undef LQ_PREFETCH
        __syncthreads();
        if (tid < 2 * LQ_NQ && !lat) { const int s = tid >> 5, c = tid & 31; a->out[O_LRU + ((size_t)((2 * bp + s) * 2 + layer) * 2 + e) * 256 + chq + c] = ((LAS float*)(lds + LQ_S0 + s * LS_BYTES + LS_HC))[((L / 64) & 1) * LQ_NQ + c]; }
    }
}

constexpr int ATT2_VSTR = 144, ATT2_STAGE = 64 * ATT_KSTR + 64 * ATT2_VSTR;
#define ATT_KLOAD(KB_) \
        bf16x8 kfa_[6], kfb_[6]; \
        _Pragma("unroll") for (int ks_ = 0; ks_ < 6; ++ks_) { kfa_[ks_] = *(const LAS bf16x8*)((KB_) + r * ATT_KSTR + ks_ * 32 + hq * 16); kfb_[ks_] = *(const LAS bf16x8*)((KB_) + (32 + r) * ATT_KSTR + ks_ * 32 + hq * 16); }
#define ATT_VLOAD(VB_) \
        v2u va0_[4], va1_[4], vb0_[4], vb1_[4]; \
        _Pragma("unroll") for (int ks_ = 0; ks_ < 4; ++ks_) { \
            const LAS unsigned char* vp_ = (VB_) + (ks_ * 16 + 4 * hq + ((lane >> 2) & 3)) * ATT2_VSTR + (16 * ((lane >> 4) & 1) + 4 * (lane & 3)) * 2; \
            va0_[ks_] = __builtin_bit_cast(v2u, __builtin_amdgcn_ds_read_tr16_b64_v4i16((LAS s16x4_t*)(vp_))); \
            va1_[ks_] = __builtin_bit_cast(v2u, __builtin_amdgcn_ds_read_tr16_b64_v4i16((LAS s16x4_t*)(vp_ + 8 * ATT2_VSTR))); \
            vb0_[ks_] = __builtin_bit_cast(v2u, __builtin_amdgcn_ds_read_tr16_b64_v4i16((LAS s16x4_t*)(vp_ + 64))); \
            vb1_[ks_] = __builtin_bit_cast(v2u, __builtin_amdgcn_ds_read_tr16_b64_v4i16((LAS s16x4_t*)(vp_ + 8 * ATT2_VSTR + 64))); }
#define ATT_QKM(S0_, S1_) do { \
        _Pragma("unroll") for (int i_ = 0; i_ < 16; ++i_) { S0_[i_] = 0.f; S1_[i_] = 0.f; } \
        _Pragma("unroll") for (int ks_ = 0; ks_ < 6; ++ks_) { S0_ = MFMA32(kfa_[ks_], qf[ks_], S0_); S1_ = MFMA32(kfb_[ks_], qf[ks_], S1_); } } while (0)
#define ATT_STEP(SC0_, SC1_, SN0_, SN1_, KB_, VB_, HAVE_NEXT_) do { \
        ATT_KLOAD(KB_) \
        float mx_ = SC0_[0]; \
        _Pragma("unroll") for (int i_ = 1; i_ < 16; ++i_) mx_ = fmaxf(mx_, SC0_[i_]); \
        _Pragma("unroll") for (int i_ = 0; i_ < 16; ++i_) mx_ = fmaxf(mx_, SC1_[i_]); \
        mx_ = fmaxf(mx_, __shfl_xor(mx_, 32)); \
        if (!__all(mx_ - m <= 8.f)) { const float mn_ = fmaxf(m, mx_), al_ = __builtin_amdgcn_exp2f(m - mn_); m = mn_; l *= al_; \
            _Pragma("unroll") for (int i_ = 0; i_ < 16; ++i_) { o0[i_] *= al_; o1[i_] *= al_; } } \
        if (HAVE_NEXT_) ATT_QKM(SN0_, SN1_); \
        ATT_VLOAD(VB_) \
        float ps_ = 0.f; \
        _Pragma("unroll") for (int i_ = 0; i_ < 16; ++i_) { SC0_[i_] = __builtin_amdgcn_exp2f(SC0_[i_] - m); SC1_[i_] = __builtin_amdgcn_exp2f(SC1_[i_] - m); ps_ += SC0_[i_] + SC1_[i_]; } \
        l += ps_; \
        _Pragma("unroll") for (int ks_ = 0; ks_ < 4; ++ks_) { \
            v4u pw_; \
            if (ks_ == 0) { pw_.x = cvtpk(SC0_[0], SC0_[1]); pw_.y = cvtpk(SC0_[2], SC0_[3]); pw_.z = cvtpk(SC0_[4], SC0_[5]); pw_.w = cvtpk(SC0_[6], SC0_[7]); } \
            else if (ks_ == 1) { pw_.x = cvtpk(SC0_[8], SC0_[9]); pw_.y = cvtpk(SC0_[10], SC0_[11]); pw_.z = cvtpk(SC0_[12], SC0_[13]); pw_.w = cvtpk(SC0_[14], SC0_[15]); } \
            else if (ks_ == 2) { pw_.x = cvtpk(SC1_[0], SC1_[1]); pw_.y = cvtpk(SC1_[2], SC1_[3]); pw_.z = cvtpk(SC1_[4], SC1_[5]); pw_.w = cvtpk(SC1_[6], SC1_[7]); } \
            else { pw_.x = cvtpk(SC1_[8], SC1_[9]); pw_.y = cvtpk(SC1_[10], SC1_[11]); pw_.z = cvtpk(SC1_[12], SC1_[13]); pw_.w = cvtpk(SC1_[14], SC1_[15]); } \
            const bf16x8 pf_ = __builtin_bit_cast(bf16x8, pw_); \
            const v4u vwa_ = {va0_[ks_].x, va0_[ks_].y, va1_[ks_].x, va1_[ks_].y}, vwb_ = {vb0_[ks_].x, vb0_[ks_].y, vb1_[ks_].x, vb1_[ks_].y}; \
            o0 = MFMA32(__builtin_bit_cast(bf16x8, vwa_), pf_, o0); o1 = MFMA32(__builtin_bit_cast(bf16x8, vwb_), pf_, o1); } } while (0)
__device__ __forceinline__ void att_unit2(ArgsP a, LAS unsigned char* lds, int u) {
    const int tid = tid_(), lane = tid & 63, wave = tid >> 6, r = lane & 31, hq = lane >> 5;
    const bf16* KN = (const bf16*)(a->ws + WS_KN); const bf16* KR = (const bf16*)(a->ws + WS_KR); const bf16* VT = (const bf16*)(a->ws + WS_VT);
    bf16* Q = (bf16*)(a->ws + WS_Q); const bf16* G1 = (const bf16*)(a->ws + WS_G1);
    int b, h, n0, Lk, kidx0; size_t vbase;
    if (u < 512) { b = u >> 6; h = (u >> 3) & 7; n0 = T_CTX + b * 2048 + (u & 7) * 256; Lk = LK_LAT; kidx0 = T_CTX + b * LK_LAT; vbase = (size_t)VT_LAT + (size_t)(b * 8 + h) * 64 * LK_LAT; }
    else { const int uu = u - 512; b = uu >> 3; h = uu & 7; n0 = b * 256; Lk = 256; kidx0 = b * 256; vbase = (size_t)(b * 8 + h) * 64 * 256; }
    const int ntiles = Lk >> 6;
    const int n = n0 + wave * 32 + r;
    bf16x8 qf[6];
#pragma unroll
    for (int ks = 0; ks < 6; ++ks) qf[ks] = *(const bf16x8*)(Q + (size_t)n * 768 + h * 96 + ks * 16 + 8 * hq);
    const int key_k = tid >> 3, ck = tid & 7, key_r = (tid >> 2) & 63, cr = tid & 3;
    const __amdgpu_buffer_rsrc_t rsk = __builtin_amdgcn_make_buffer_rsrc((void*)(KN + (size_t)kidx0 * 512), (short)0, Lk * 1024, 0x00020000);
    const __amdgpu_buffer_rsrc_t rsr = __builtin_amdgcn_make_buffer_rsrc((void*)(KR + (size_t)kidx0 * 32), (short)0, Lk * 64, 0x00020000);
    const __amdgpu_buffer_rsrc_t rsv = __builtin_amdgcn_make_buffer_rsrc((void*)(VT + (size_t)kidx0 * 512), (short)0, Lk * 1024, 0x00020000);
    const unsigned vok = (unsigned)((key_k * 512 + h * 64 + ck * 8) * 2), vor = (unsigned)((key_r * 32 + cr * 8) * 2);
    const unsigned sk = key_k * ATT_KSTR + ck * 16, sr = key_r * ATT_KSTR + 128 + cr * 16, sv = ATT_VOFF + key_k * ATT2_VSTR + ck * 16;
    v4u rkA, rrA = {0u, 0u, 0u, 0u}, rvA, rkB, rrB = {0u, 0u, 0u, 0u}, rvB;
#define ATT_LOAD(X_, j_) do { rk##X_ = __builtin_amdgcn_raw_buffer_load_b128(rsk, vok, (unsigned)(j_) * 65536u, 2); rr##X_ = __builtin_amdgcn_raw_buffer_load_b128(rsr, vor, (unsigned)(j_) * 4096u, 2);     rv##X_ = __builtin_amdgcn_raw_buffer_load_b128(rsv, vok, (unsigned)(j_) * 65536u, 2); } while (0)
#define ATT_STORE(X_, B_) do { LAS unsigned char* nb_ = lds + (B_) * ATT2_STAGE; *(LAS v4u*)(nb_ + sk) = rk##X_; *(LAS v4u*)(nb_ + sr) = rr##X_; \
        *(LAS v4u*)(nb_ + sv) = rv##X_; } while (0)
    ATT_LOAD(A, 0); ATT_LOAD(B, 1);
    __syncthreads();
    ATT_STORE(A, 0);
    ATT_STORE(B, 1);
    ATT_LOAD(A, 2);
    __syncthreads();
    f32x16 o0, o1, sa0, sa1, sb0, sb1;
#pragma unroll
    for (int i = 0; i < 16; ++i) { o0[i] = 0.f; o1[i] = 0.f; }
    float m = -1e30f, l = 0.f;
    { ATT_KLOAD(lds) ATT_QKM(sa0, sa1); }
    int bcur = 0;
    int j = 0;
    for (; j < ntiles - 2; j += 2) {
        {
            const int b1 = bcur == 2 ? 0 : bcur + 1, b2 = b1 == 2 ? 0 : b1 + 1;
            ATT_LOAD(B, j + 3);
            ATT_STEP(sa0, sa1, sb0, sb1, lds + b1 * ATT2_STAGE, lds + bcur * ATT2_STAGE + ATT_VOFF, true);
            ATT_STORE(A, b2);
            __syncthreads();
            bcur = b1;
        }
        {
            const int b1 = bcur == 2 ? 0 : bcur + 1, b2 = b1 == 2 ? 0 : b1 + 1;
            if (j + 4 < ntiles) ATT_LOAD(A, j + 4);
            ATT_STEP(sb0, sb1, sa0, sa1, lds + b1 * ATT2_STAGE, lds + bcur * ATT2_STAGE + ATT_VOFF, true);
            ATT_STORE(B, b2);
            __syncthreads();
            bcur = b1;
        }
    }
    {
        { const int b1 = bcur == 2 ? 0 : bcur + 1;
          ATT_STEP(sa0, sa1, sb0, sb1, lds + b1 * ATT2_STAGE, lds + bcur * ATT2_STAGE + ATT_VOFF, true);
          bcur = b1; }
        { ATT_STEP(sb0, sb1, sa0, sa1, lds + bcur * ATT2_STAGE, lds + bcur * ATT2_STAGE + ATT_VOFF, false); }
        __syncthreads();
    }
#undef ATT_LOAD
#undef ATT_STORE
    v2u gmv[2][4];
#pragma unroll
    for (int mt = 0; mt < 2; ++mt)
#pragma unroll
        for (int g = 0; g < 4; ++g) gmv[mt][g] = *(const v2u*)(G1 + (size_t)n * G1W + C_GM + h * 64 + 32 * mt + 8 * g + 4 * hq);
    l += __shfl_xor(l, 32);
    const float inv = rcp_(l);
#pragma unroll
    for (int mt = 0; mt < 2; ++mt)
#pragma unroll
        for (int g = 0; g < 4; ++g) {
            const int dv0 = 32 * mt + 8 * g + 4 * hq;
            const v2u gm = gmv[mt][g];
            const float x0 = (mt ? o1[4 * g + 0] : o0[4 * g + 0]) * inv, x1 = (mt ? o1[4 * g + 1] : o0[4 * g + 1]) * inv, x2 = (mt ? o1[4 * g + 2] : o0[4 * g + 2]) * inv, x3 = (mt ? o1[4 * g + 3] : o0[4 * g + 3]) * inv;
            v2u ov; ov.x = cvtpk(x0 * siluf_(bflo(gm.x)), x1 * siluf_(bfhi(gm.x))); ov.y = cvtpk(x2 * siluf_(bflo(gm.y)), x3 * siluf_(bfhi(gm.y)));
            *(v2u*)((bf16*)a->out + 1024 + (size_t)n * YM_LD + 256 + h * 64 + dv0) = ov;
        }
}
constexpr int N_PHASES = 14;

__device__ __forceinline__ void phase_b(ArgsP a, LAS unsigned char* lds, int layer) {
    volatile LAS unsigned* MISC = (volatile LAS unsigned*)(lds + LDS_MISC);
    unsigned* head = (unsigned*)(a->ws + WS_CTL) + CW_Q + layer * 64;
    const int G = grid_();
    bool first = true;
    for (;;) {
        int idx;
        if (first) { idx = bid_(); first = false; }
        else { __syncthreads(); if (tid_() == 0) MISC[16] = atomicAdd(head, 1u) + (unsigned)G; __syncthreads(); idx = (int)MISC[16]; }
        if (idx >= 1408) break;
#ifdef PROBE_UNIT1
        const unsigned long long pt0_ = __builtin_amdgcn_s_memrealtime();
#endif
        if (idx < 64) rwkv_unit_mfma(a, lds, layer, idx);
        else if (idx < 128) lru_unit_q(a, lds, layer, idx - 64);
        else if (idx < 640) att_unit2(a, lds, idx - 128);
        else if (idx < 896) rwkv_unit_mfma(a, lds, layer, 64 + idx - 640);
        else if (idx < 1152) lru_unit_q(a, lds, layer, 64 + idx - 896);
        else att_unit2(a, lds, 512 + idx - 1152);
#ifdef PROBE_UNIT1
        if (tid_() == 0 && layer == 0) { const unsigned d_ = (unsigned)(__builtin_amdgcn_s_memrealtime() - pt0_);
            const int ty_ = idx < 64 ? 0 : idx < 128 ? 1 : idx < 640 ? 2 : idx < 896 ? 3 : idx < 1152 ? 4 : 5;
            atomicMax((unsigned*)(a->ws + WS_CTL) + CW_Q + 1024 + ty_ * 64, d_); }
#endif
    }
}

#define ARGS_VIEW() ({ ArgsP p_ = (ArgsP)__builtin_amdgcn_kernarg_segment_ptr(); asm volatile("" : "+s"(p_)); p_; })
__global__ void __launch_bounds__(NTHREADS, 2) mk_fwd(Args args) {
    extern __shared__ __attribute__((aligned(16))) unsigned char lds_raw[];
    LAS unsigned char* lds = (LAS unsigned char*)lds_raw;
    volatile LAS unsigned* MISC = (volatile LAS unsigned*)(lds + LDS_MISC);
    for (int u = threadIdx.x; u < 64; u += NTHREADS) MISC[u] = 0u;
    __syncthreads();
    XcdBarrier bar;
    { ArgsP a = ARGS_VIEW(); bar = xcd_barrier_post((unsigned*)(a->ws + WS_CTL) + CW_BAR, MISC + 8); }
    int lo, hi; { ArgsP a = ARGS_VIEW(); lo = a->ph_lo; hi = a->ph_hi; }
#define IN(k) (lo <= (k) && (k) < hi)
#ifdef PROBE_MASK1
#define STAMP(k) do { if (bid_() == 0 && tid_() == 0) { const unsigned long long t_ = __builtin_amdgcn_s_memrealtime(); MISC[32 + 2 * (k)] = (unsigned)t_; MISC[33 + 2 * (k)] = (unsigned)(t_ >> 32); } } while (0)
#else
#define STAMP(k) do { } while (0)
#endif
#define SEAM(k) do { if (IN(k) && IN((k) + 1)) xcd_barrier(bar); STAMP((k) + 1); } while (0)
    STAMP(0);
    if (IN(0)) { { ArgsP a = ARGS_VIEW(); phase_p0(a, lds); } __syncthreads(); { ArgsP a = ARGS_VIEW(); phase_p0_weights(a, lds, 0, 1408, 0); } }
    SEAM(0);
    for (int layer = 0; layer < 2; ++layer) {
        const int p = 1 + 6 * layer;
        if (IN(p + 0)) { { ArgsP a = ARGS_VIEW(); phase_a0(a, lds, layer); } { ArgsP a = ARGS_VIEW(); phase_cache_rows(a, layer); } }
        SEAM(p + 0);
        if (IN(p + 1)) { ArgsP a = ARGS_VIEW(); phase_a1_pg8(a, lds, layer); }
        SEAM(p + 1);
        if (IN(p + 2)) { ArgsP a = ARGS_VIEW(); phase_a2b(a, lds, layer); }
        SEAM(p + 2);
        if (IN(p + 3)) { ArgsP a = ARGS_VIEW(); phase_b(a, lds, layer); }
        SEAM(p + 3);
        if (IN(p + 4)) { ArgsP a = ARGS_VIEW(); phase_c1(a, layer); }
        SEAM(p + 4);
        if (IN(p + 5)) { ArgsP a = ARGS_VIEW(); phase_c2_pg8(a, lds, layer); }
        SEAM(p + 5);
    }
    if (IN(N_PHASES - 1)) { ArgsP a = ARGS_VIEW(); phase_final(a); }
#ifdef PROBE_MASK1
    STAMP(14);
    __syncthreads();
    if (bid_() == 0) {
        ArgsP a = ARGS_VIEW();
        float t1 = 0.f, t2 = 0.f;
        for (int k = 0; k < 14; ++k) { const unsigned long long s0 = ((unsigned long long)MISC[33 + 2 * k] << 32) | MISC[32 + 2 * k], s1 = ((unsigned long long)MISC[35 + 2 * k] << 32) | MISC[34 + 2 * k];
            const float us = (float)(s1 - s0) * 0.01f; if ((PROBE_MASK1 >> k) & 1) t1 += us; if ((PROBE_MASK2 >> k) & 1) t2 += us; }
#ifdef PROBE_A2SPLIT
        { const unsigned long long s3 = ((unsigned long long)MISC[33 + 2 * 3] << 32) | MISC[32 + 2 * 3], s20 = ((unsigned long long)MISC[33 + 2 * 20] << 32) | MISC[32 + 2 * 20], s21 = ((unsigned long long)MISC[33 + 2 * 21] << 32) | MISC[32 + 2 * 21], s4 = ((unsigned long long)MISC[33 + 2 * 4] << 32) | MISC[32 + 2 * 4];
          t1 = (float)(s20 - s3) * 0.01f; t2 = (float)(s4 - s21) * 0.01f; }
#endif
#ifdef PROBE_UNIT1
        t1 = (float)((unsigned*)(a->ws + WS_CTL))[CW_Q + 1024 + PROBE_UNIT1 * 64] * 0.01f; t2 = (float)((unsigned*)(a->ws + WS_CTL))[CW_Q + 1024 + PROBE_UNIT2 * 64] * 0.01f;
#endif
        for (int i = tid_(); i < 32768; i += NTHREADS) a->out[O_LRU + i] *= (1.f + t2 * (1.f / 2000.f));
        if (tid_() == 0) a->out[0] += 2.f + t1 * PROBE_T1S;
    }
#endif
#undef IN
#undef SEAM
}

extern "C" void kernel_launch(void* const* d_in, const int* in_sizes, int n_in, void* d_out, int out_size, void* d_ws, size_t ws_size, hipStream_t stream) {
    static int grid = 0;
    if (grid == 0) {
        if (n_in != N_IN || ws_size < WS_END) { fprintf(stderr, "kernel_launch: unexpected n_in %d / ws_size %zu\n", n_in, ws_size); grid = -1; return; }
        int dev = 0, cus = 0;
        if (hipGetDevice(&dev) != hipSuccess || hipDeviceGetAttribute(&cus, hipDeviceAttributeMultiprocessorCount, dev) != hipSuccess) { grid = -1; return; }
        if (hipFuncSetAttribute((const void*)mk_fwd, hipFuncAttributeMaxDynamicSharedMemorySize, LDS_BYTES) != hipSuccess) { fprintf(stderr, "kernel_launch: hipFuncSetAttribute failed\n"); grid = -1; return; }
        int per_cu = 0;
        if (hipOccupancyMaxActiveBlocksPerMultiprocessor(&per_cu, (const void*)mk_fwd, NTHREADS, LDS_BYTES) != hipSuccess || per_cu < 1) fprintf(stderr, "kernel_launch: occupancy query reports %d\n", per_cu);
        (void)hipGetLastError();
        grid = cus;
    }
    if (grid < 0) return;
    if (hipMemsetAsync((char*)d_ws + WS_CTL, 0, CTL_ZERO_BYTES, stream) != hipSuccess) return;
    Args a{};
    for (int i = 0; i < N_IN; ++i) a.in[i] = (const float*)d_in[i];
    a.out = (float*)d_out; a.ws = (unsigned char*)d_ws;
    a.ph_lo = 0; a.ph_hi = N_PHASES;
    hipLaunchKernelGGL(mk_fwd, dim3(grid), dim3(NTHREADS), LDS_BYTES, stream, a);
}
```
